# Optimizing an MI355X kernel written in HIP

```python
import math
import jax, jax.numpy as jnp
from jax import lax
import numpy as np


D_MODEL = 1024
BATCH = 2
SEQ = 8192
DEPTH = 2

PLE_DIM = 256
N_EVEN = (DEPTH + 1) // 2
N_ODD = DEPTH // 2

H_A = 8
D_NOPE = 64
D_VA = 64
R_Q = 256
R_KV = 128
H_IDX = 8
D_IDX = 64
TOPK_MAX = 256
Q_BLOCK = 128

H_B = 4
D_B = 128
CONV_K = 4
DN_CHUNK = 64

H_C = 12
DH_C = 64
DILATED_PATTERNS = ((128, 1), (512, 4), (2048, 16))

POOL_WINDOWS = (2, 4, 8, 16)
POOL_GROUP = 64

N_EXPERTS = 32
TOP_K = 4
D_EXPERT = 1024
SWIGLU_LIMIT = 7.0
SWIGLU_ALPHA = 1.702
EXPERT_BLOCK = 128

ALPHA = (2 * DEPTH) ** 0.25
BETA = (8 * DEPTH) ** -0.25

AB_SPLITS = (R_Q, R_KV, D_IDX, H_IDX, H_B * D_B, H_B * D_B, H_B * D_B, H_B * D_B, H_B, H_B)
CD_SPLITS = (H_C * DH_C, H_C * DH_C, H_C * DH_C, len(POOL_WINDOWS) * POOL_GROUP)
W_AB = H_A * D_VA + H_B * D_B
W_CD = H_C * DH_C + len(POOL_WINDOWS) * POOL_GROUP

kernel_name = "hybrid_dsa_gdn_dilated_pool_moe"

F32 = jnp.float32


def _split(t, sizes):
    outs, start = [], 0
    for n in sizes:
        outs.append(t[..., start:start + n])
        start += n
    return outs


def _layernorm(x, g, b, eps=1e-5):
    xf = x.astype(F32)
    mu = xf.mean(-1, keepdims=True)
    var = jnp.square(xf - mu).mean(-1, keepdims=True)
    return ((xf - mu) * lax.rsqrt(var + eps) * g + b).astype(x.dtype)


def _rmsnorm(x, g, eps=1e-6):
    xf = x.astype(F32)
    return (xf * lax.rsqrt(jnp.mean(xf * xf, -1, keepdims=True) + eps) * g).astype(x.dtype)


def _l2norm(x, eps=1e-6):
    return x * lax.rsqrt(jnp.sum(x * x, -1, keepdims=True) + eps)


def _dsa_attention(c_q, c_kv, k_idx, w_idx, w_uq, w_uk, w_uv, w_qidx):
    B, S, _ = c_q.shape
    topk = min(TOPK_MAX, S // 4)
    nb = S // Q_BLOCK
    q = jnp.einsum('bsr,rhd->bshd', c_q, w_uq)
    q_lat = jnp.einsum('bshd,rhd->bshr', q, w_uk) * D_NOPE ** -0.5
    q_idx = jnp.einsum('bsr,rhd->bshd', c_q, w_qidx)
    w_idx = w_idx * (H_IDX ** -0.5 * D_IDX ** -0.5)
    key_pos = jnp.arange(S)
    q_pos = key_pos.reshape(nb, Q_BLOCK)

    def blocks(t):
        return jnp.moveaxis(t.reshape(B, nb, Q_BLOCK, *t.shape[2:]), 1, 0)

    def attend(args):
        qi_idx, wi, qi_lat, pos = args
        sc = jnp.einsum('bqhd,bkd->bqhk', qi_idx, k_idx)
        isc = jnp.einsum('bqhk,bqh->bqk', jax.nn.relu(sc), wi).astype(F32)
        causal = key_pos[None, :] <= pos[:, None]
        isc = jnp.where(causal[None], isc, -jnp.inf)
        _, sel = lax.top_k(isc, topk)
        kv_sel = jax.vmap(lambda c, i: c[i])(c_kv, sel)
        s = jnp.einsum('bqhr,bqkr->bqhk', qi_lat, kv_sel).astype(F32)
        valid = sel <= pos[None, :, None]
        s = jnp.where(valid[:, :, None, :], s, -jnp.inf)
        pr = jax.nn.softmax(s, axis=-1).astype(kv_sel.dtype)
        return jnp.einsum('bqhk,bqkr->bqhr', pr, kv_sel)

    o_lat = lax.map(attend, (blocks(q_idx), blocks(w_idx), blocks(q_lat), q_pos))
    o_lat = jnp.moveaxis(o_lat, 0, 1).reshape(B, S, H_A, R_KV)
    o = jnp.einsum('bshr,rhv->bshv', o_lat, w_uv)
    return o.reshape(B, S, H_A * D_VA)


def _causal_conv(x, w):
    C = x.shape[-1]
    K = w.shape[0]
    return lax.conv_general_dilated(x, w[:, None, :], window_strides=(1,), padding=[(K - 1, 0)],
                                    dimension_numbers=('NWC', 'WIO', 'NWC'), feature_group_count=C)


def _chunk_gated_delta(q, k, v, g, beta):
    B, S, H, Dk = q.shape
    Dv = v.shape[-1]
    C = DN_CHUNK
    n = S // C

    def chunks(t):
        return t.reshape(B, n, C, H, -1).transpose(1, 0, 3, 2, 4)

    q, k, v = chunks(q), chunks(k), chunks(v)
    g = g.reshape(B, n, C, H).transpose(1, 0, 3, 2)
    beta = beta.reshape(B, n, C, H).transpose(1, 0, 3, 2)
    gc = jnp.cumsum(g, axis=-1)
    lower = jnp.tril(jnp.ones((C, C), bool))
    strict = jnp.tril(jnp.ones((C, C), bool), -1)
    decay = jnp.exp(jnp.where(lower, gc[..., :, None] - gc[..., None, :], -jnp.inf))
    kb = k * beta[..., None]
    vb = v * beta[..., None]
    a_mat = jnp.where(strict, jnp.einsum('...id,...jd->...ij', kb, k) * decay, 0.0)
    eye = jnp.eye(C, dtype=F32)
    t_mat = lax.linalg.triangular_solve(a_mat + eye, jnp.broadcast_to(eye, a_mat.shape),
                                        left_side=True, lower=True, unit_diagonal=True)
    u = t_mat @ vb
    w = t_mat @ (kb * jnp.exp(gc)[..., None])
    qk = jnp.where(lower, jnp.einsum('...id,...jd->...ij', q, k) * decay, 0.0)
    q_dec = q * jnp.exp(gc)[..., None]
    k_dec = k * jnp.exp(gc[..., -1:] - gc)[..., None]
    g_last = jnp.exp(gc[..., -1])

    def step(state, xs):
        q_i, k_i, u_i, w_i, qk_i, gl_i = xs
        v_new = u_i - w_i @ state
        o_i = q_i @ state + qk_i @ v_new
        state = state * gl_i[..., None, None] + jnp.einsum('bhck,bhcv->bhkv', k_i, v_new)
        return state, o_i

    state0 = jnp.zeros((B, H, Dk, Dv), F32)
    _, o = lax.scan(step, state0, (q_dec, k_dec, u, w, qk, g_last))
    return o.transpose(1, 0, 3, 2, 4).reshape(B, S, H, Dv)


def _gated_deltanet(q, k, v, z, b, a, conv_w, a_log, dt_bias, norm_g):
    B, S, _ = q.shape
    W = H_B * D_B
    qkv = jax.nn.silu(_causal_conv(jnp.concatenate([q, k, v], -1), conv_w))
    q, k, v = [t.reshape(B, S, H_B, D_B).astype(F32) for t in _split(qkv, (W, W, W))]
    q = _l2norm(q) * D_B ** -0.5
    k = _l2norm(k)
    beta = jax.nn.sigmoid(b.astype(F32))
    g = -jnp.exp(a_log.astype(F32)) * jax.nn.softplus(a.astype(F32) + dt_bias.astype(F32))
    o = _chunk_gated_delta(q, k, v, g, beta)
    o = _rmsnorm(o, norm_g) * jax.nn.silu(z.reshape(B, S, H_B, D_B).astype(F32))
    return o.reshape(B, S, W).astype(z.dtype)


def _mixer_ab(x, w_in, q_norm_g, kv_norm_g, w_uq, w_uk, w_uv, w_qidx, kidx_norm_g, kidx_norm_b,
              conv_w, a_log, dt_bias, out_norm_g, w_out):
    c_q, c_kv, k_idx, w_idx, qb, kb, vb, zb, bb, ab = _split(x @ w_in, AB_SPLITS)
    c_q = _rmsnorm(c_q, q_norm_g)
    c_kv = _rmsnorm(c_kv, kv_norm_g)
    k_idx = _layernorm(k_idx, kidx_norm_g, kidx_norm_b)
    o_a = _dsa_attention(c_q, c_kv, k_idx, w_idx, w_uq, w_uk, w_uv, w_qidx)
    o_b = _gated_deltanet(qb, kb, vb, zb, bb, ab, conv_w, a_log, dt_bias, out_norm_g)
    return jnp.concatenate([o_a.astype(x.dtype), o_b.astype(x.dtype)], -1) @ w_out


def _dilated_branch(q, k, v, window, dilation):
    B, S, H, Dh = q.shape
    R = window // dilation
    seg = dilation * R
    S_pad = -(-S // seg) * seg
    N = S_pad // dilation
    nb = N // R

    def to_blocks(t):
        t = jnp.pad(t, ((0, 0), (0, S_pad - S), (0, 0), (0, 0)))
        t = t.reshape(B, N, dilation, H, Dh).transpose(0, 2, 1, 3, 4)
        return t.reshape(B, dilation, nb, R, H, Dh)

    def with_prev(t):
        prev = jnp.pad(t, ((0, 0), (0, 0), (1, 0), (0, 0), (0, 0), (0, 0)))[:, :, :-1]
        return jnp.concatenate([prev, t], axis=3)

    qb = to_blocks(q)
    k2 = with_prev(to_blocks(k))
    v2 = with_prev(to_blocks(v))
    s = jnp.einsum('bcnqhd,bcnkhd->bcnqhk', qb, k2).astype(F32) * Dh ** -0.5
    r = jnp.arange(R)[:, None]
    j = jnp.arange(2 * R)[None, :]
    dist = R + r - j
    band = (dist >= 0) & (dist <= R)
    has_prev = (jnp.arange(nb) > 0)[:, None, None] | (j >= R)[None]
    mask = band[None] & has_prev
    s = jnp.where(mask[:, :, None, :], s, -jnp.inf)
    m = s.max(-1)
    e = jnp.exp(s - m[..., None])
    den = e.sum(-1)
    o = jnp.einsum('bcnqhk,bcnkhd->bcnqhd', e, v2.astype(F32)) / den[..., None]

    def from_blocks(t):
        t = t.reshape(B, dilation, N, *t.shape[4:])
        t = jnp.moveaxis(t, 1, 2)
        return t.reshape(B, S_pad, *t.shape[3:])[:, :S]

    return from_blocks(o), from_blocks(m), from_blocks(den)


def _dilated_attention(q, k, v):
    res = [_dilated_branch(q, k, v, w, d) for (w, d) in DILATED_PATTERNS]
    o = jnp.stack([t[0] for t in res])
    m = jnp.stack([t[1] for t in res])
    den = jnp.stack([t[2] for t in res])
    wgt = den * jnp.exp(m - m.max(0))
    return (wgt[..., None] * o).sum(0) / wgt.sum(0)[..., None]


def _multiscale_pool(u, pool_w, pool_scale):
    B, S, _ = u.shape
    count = jnp.arange(1, S + 1).astype(F32)
    outs = []
    for gi, w in enumerate(POOL_WINDOWS):
        xg = u[..., gi * POOL_GROUP:(gi + 1) * POOL_GROUP].astype(F32)
        c = jnp.cumsum(xg, axis=1)
        c_prev = jnp.pad(c, ((0, 0), (w, 0), (0, 0)))[:, :S]
        mean = (c - c_prev) / jnp.minimum(count, w)[None, :, None]
        outs.append((mean - xg) @ pool_w[gi].astype(F32))
    return (jnp.concatenate(outs, -1) * pool_scale).astype(u.dtype)


def _mixer_cd(x, w_in, pool_w, pool_scale, w_out):
    B, S, _ = x.shape
    qc, kc, vc, ud = _split(x @ w_in, CD_SPLITS)
    shp = (B, S, H_C, DH_C)
    o_c = _dilated_attention(qc.reshape(shp), kc.reshape(shp), vc.reshape(shp))
    o_d = _multiscale_pool(ud, pool_w, pool_scale)
    return jnp.concatenate([o_c.reshape(B, S, H_C * DH_C).astype(x.dtype), o_d], -1) @ w_out


def _moe(x, router_w, router_b, w_gu, b_gu, w_down, b_down):
    B, S, D = x.shape
    xt = x.reshape(-1, D)
    T = xt.shape[0]
    logits = (xt @ router_w + router_b).astype(F32)
    top_logit, top_e = lax.top_k(logits, TOP_K)
    gate = jax.nn.softmax(top_logit, axis=-1)
    TK = T * TOP_K
    flat_e = top_e.reshape(-1).astype(jnp.int32)
    flat_tok = jnp.arange(TK, dtype=jnp.int32) // TOP_K
    flat_gate = gate.reshape(-1)
    order = jnp.argsort(flat_e)
    se = flat_e[order]
    counts = jnp.zeros((N_EXPERTS,), jnp.int32).at[flat_e].add(1)
    padded = (counts + EXPERT_BLOCK - 1) // EXPERT_BLOCK * EXPERT_BLOCK
    pad_end = jnp.cumsum(padded)
    pad_start = pad_end - padded
    start = jnp.cumsum(counts) - counts
    dest = pad_start[se] + jnp.arange(TK, dtype=jnp.int32) - start[se]
    nblk = -(-TK // EXPERT_BLOCK) + N_EXPERTS
    P = nblk * EXPERT_BLOCK
    slot_tok = jnp.full((P,), T, jnp.int32).at[dest].set(flat_tok[order])
    slot_gate = jnp.zeros((P,), F32).at[dest].set(flat_gate[order])
    blk_e = jnp.minimum(jnp.searchsorted(pad_end, jnp.arange(nblk) * EXPERT_BLOCK, side='right'),
                        N_EXPERTS - 1)
    x_pad = jnp.concatenate([xt, jnp.zeros((1, D), xt.dtype)], 0)
    xs = x_pad[slot_tok].reshape(nblk, EXPERT_BLOCK, D)

    def expert_block(args):
        xb, e = args
        gu = xb @ w_gu[e] + b_gu[e]
        gt = jnp.minimum(gu[:, ::2], SWIGLU_LIMIT)
        up = jnp.clip(gu[:, 1::2], -SWIGLU_LIMIT, SWIGLU_LIMIT)
        hid = (up + 1.0) * (gt * jax.nn.sigmoid(gt * SWIGLU_ALPHA))
        return hid @ w_down[e] + b_down[e]

    ys = lax.map(expert_block, (xs, blk_e)).reshape(P, D)
    out = jnp.zeros((T + 1, D), F32).at[slot_tok].add(ys.astype(F32) * slot_gate[:, None])[:T]
    return out.reshape(B, S, D).astype(x.dtype)


def setup_inputs(seed: int = 0) -> dict:
    key = jax.random.key(seed)
    ks = iter(jax.random.split(key, 48))

    def nrm(shape, scale=1.0):
        return jax.random.normal(next(ks), shape, F32) * scale

    def gain(shape):
        return 1.0 + nrm(shape, 0.02)

    d_ab_in = sum(AB_SPLITS)
    d_cd_in = sum(CD_SPLITS)
    n_pool = len(POOL_WINDOWS)
    x = nrm((BATCH, SEQ, D_MODEL))
    p = nrm((DEPTH, BATCH, SEQ, PLE_DIM))
    ab_w_in = nrm((N_EVEN, D_MODEL, d_ab_in), D_MODEL ** -0.5)
    ab_q_norm_g = gain((N_EVEN, R_Q))
    ab_kv_norm_g = gain((N_EVEN, R_KV))
    ab_w_uq = nrm((N_EVEN, R_Q, H_A, D_NOPE), R_Q ** -0.5)
    ab_w_uk = nrm((N_EVEN, R_KV, H_A, D_NOPE), R_KV ** -0.5)
    ab_w_uv = nrm((N_EVEN, R_KV, H_A, D_VA), R_KV ** -0.5)
    ab_w_qidx = nrm((N_EVEN, R_Q, H_IDX, D_IDX), R_Q ** -0.5)
    ab_kidx_norm_g = gain((N_EVEN, D_IDX))
    ab_kidx_norm_b = nrm((N_EVEN, D_IDX), 0.02)
    ab_conv_w = nrm((N_EVEN, CONV_K, 3 * H_B * D_B), CONV_K ** -0.5)
    ab_a_log = jnp.log(jax.random.uniform(next(ks), (N_EVEN, H_B), F32, 1.0, 16.0))
    dt = jnp.exp(jax.random.uniform(next(ks), (N_EVEN, H_B), F32, math.log(1e-3), math.log(1e-1)))
    ab_dt_bias = dt + jnp.log(-jnp.expm1(-dt))
    ab_out_norm_g = gain((N_EVEN, D_B))
    ab_w_out = nrm((N_EVEN, W_AB, D_MODEL), W_AB ** -0.5 * BETA)
    cd_w_in = nrm((N_ODD, D_MODEL, d_cd_in), D_MODEL ** -0.5)
    cd_pool_w = nrm((N_ODD, n_pool, POOL_GROUP, POOL_GROUP), POOL_GROUP ** -0.5)
    cd_pool_scale = gain((N_ODD, n_pool * POOL_GROUP))
    cd_w_out = nrm((N_ODD, W_CD, D_MODEL), W_CD ** -0.5 * BETA)
    ln_mix_g = gain((DEPTH, D_MODEL))
    ln_mix_b = nrm((DEPTH, D_MODEL), 0.02)
    router_w = nrm((DEPTH, D_MODEL, N_EXPERTS), D_MODEL ** -0.5)
    router_b = nrm((DEPTH, N_EXPERTS), 0.01)
    w_gu = nrm((DEPTH, N_EXPERTS, D_MODEL, 2 * D_EXPERT), D_MODEL ** -0.5)
    b_gu = nrm((DEPTH, N_EXPERTS, 2 * D_EXPERT), 0.01)
    w_down = nrm((DEPTH, N_EXPERTS, D_EXPERT, D_MODEL), D_EXPERT ** -0.5 * BETA)
    b_down = nrm((DEPTH, N_EXPERTS, D_MODEL), 0.01)
    ple_w_proj = nrm((DEPTH, PLE_DIM, D_MODEL), PLE_DIM ** -0.5)
    ple_w_gate = nrm((DEPTH, D_MODEL, D_MODEL), D_MODEL ** -0.5)
    ln_ffn_g = gain((DEPTH, D_MODEL))
    ln_ffn_b = nrm((DEPTH, D_MODEL), 0.02)
    return {
        'x': x, 'p': p,
        'ab_w_in': ab_w_in, 'ab_q_norm_g': ab_q_norm_g, 'ab_kv_norm_g': ab_kv_norm_g,
        'ab_w_uq': ab_w_uq, 'ab_w_uk': ab_w_uk, 'ab_w_uv': ab_w_uv, 'ab_w_qidx': ab_w_qidx,
        'ab_kidx_norm_g': ab_kidx_norm_g, 'ab_kidx_norm_b': ab_kidx_norm_b, 'ab_conv_w': ab_conv_w,
        'ab_a_log': ab_a_log, 'ab_dt_bias': ab_dt_bias, 'ab_out_norm_g': ab_out_norm_g, 'ab_w_out': ab_w_out,
        'cd_w_in': cd_w_in, 'cd_pool_w': cd_pool_w, 'cd_pool_scale': cd_pool_scale, 'cd_w_out': cd_w_out,
        'ln_mix_g': ln_mix_g, 'ln_mix_b': ln_mix_b, 'router_w': router_w, 'router_b': router_b,
        'w_gu': w_gu, 'b_gu': b_gu, 'w_down': w_down, 'b_down': b_down,
        'ple_w_proj': ple_w_proj, 'ple_w_gate': ple_w_gate, 'ln_ffn_g': ln_ffn_g, 'ln_ffn_b': ln_ffn_b,
    }


def reference(x, p, ab_w_in, ab_q_norm_g, ab_kv_norm_g, ab_w_uq, ab_w_uk, ab_w_uv, ab_w_qidx,
              ab_kidx_norm_g, ab_kidx_norm_b, ab_conv_w, ab_a_log, ab_dt_bias, ab_out_norm_g, ab_w_out,
              cd_w_in, cd_pool_w, cd_pool_scale, cd_w_out, ln_mix_g, ln_mix_b, router_w, router_b,
              w_gu, b_gu, w_down, b_down, ple_w_proj, ple_w_gate, ln_ffn_g, ln_ffn_b):
    h = x
    for i in range(DEPTH):
        j = i // 2
        if i % 2 == 0:
            mix = _mixer_ab(h, ab_w_in[j], ab_q_norm_g[j], ab_kv_norm_g[j], ab_w_uq[j], ab_w_uk[j],
                            ab_w_uv[j], ab_w_qidx[j], ab_kidx_norm_g[j], ab_kidx_norm_b[j],
                            ab_conv_w[j], ab_a_log[j], ab_dt_bias[j], ab_out_norm_g[j], ab_w_out[j])
        else:
            mix = _mixer_cd(h, cd_w_in[j], cd_pool_w[j], cd_pool_scale[j], cd_w_out[j])
        h = _layernorm(ALPHA * h + mix, ln_mix_g[i], ln_mix_b[i])
        ffn = _moe(h, router_w[i], router_b[i], w_gu[i], b_gu[i], w_down[i], b_down[i])
        ple = jax.nn.sigmoid(h @ ple_w_gate[i]) * (p[i] @ ple_w_proj[i])
        h = _layernorm(ALPHA * h + ffn + ple, ln_ffn_g[i], ln_ffn_b[i])
    return h
```

```cpp
#include <hip/hip_runtime.h>
#include <cstdio>
#include <cstdint>

namespace pg8 {
#define PG8_LAS __attribute__((address_space(3)))
typedef unsigned short bf16_t;
typedef short bf16x8 __attribute__((ext_vector_type(8)));
typedef float f32x4 __attribute__((ext_vector_type(4)));
typedef unsigned u32x4 __attribute__((ext_vector_type(4)));
constexpr int BM = 256, BK = 64, HALF = 128, HTB = HALF * BK * 2  , STAGE_BYTES = 8 * HTB, NXCD = 8, WGM = 8;

__host__ __device__ __forceinline__ int lds_byte(int r, int c) { const int st = (r >> 4) * 2 + (c >> 5), rr = r & 15, cc = c & 31, ob = rr * 64 + cc * 2; return st * 1024 + (ob ^ (((ob >> 9) & 1) << 5)); }
__host__ __device__ __forceinline__ void stage_rc(int b, int& R, int& C) { const int st = b / 1024, sb = b % 1024, swz = sb ^ (((sb >> 9) & 1) << 5); R = (st >> 1) * 16 + swz / 64; C = (st & 1) * 32 + (swz % 64) / 2; }
__host__ __device__ __forceinline__ int perm32(int rho) { const int n = rho >> 4, i = rho & 15; return 8 * (i >> 2) + 4 * n + (i & 3); }

struct Unit { int pm, pn, e; long bofs; };
struct Gemm { const bf16_t* A; const bf16_t* Bt; int M, N, K; };

struct StaticOrder {
    int nM, nN, nwg, G, c;
    __host__ __device__ void init(int M, int N, int G_, int c_) { nM = M / BM; nN = N / BM; nwg = nM * nN; G = G_; c = c_; }
    __host__ __device__ bool next(int i, Unit& u) const {
        const long L = (long)i * G + c; if (L >= nwg) return false;
        int wgid = (int)L; { const int q = nwg / NXCD, r = nwg % NXCD, xcd = wgid % NXCD, off = wgid / NXCD; wgid = (xcd < r ? xcd * (q + 1) : r * (q + 1) + (xcd - r) * q) + off; }
        const int nig = WGM * nN, gid = wgid / nig, fm = gid * WGM, gsz = (nM - fm) < WGM ? (nM - fm) : WGM;
        u.pm = fm + ((wgid % nig) % gsz); u.pn = (wgid % nig) / gsz; u.e = 0; u.bofs = 0; return true;
    }
    __device__ __forceinline__ void a_ready(const Unit&) const {}
    __device__ __forceinline__ void done(const Unit&) const {}
};
struct MoeOrder {
    const int* tile_e; int nT, nN, G, c; long estride;
    __device__ __forceinline__ bool next(int i, Unit& u) const {
        const long L = (long)i * G + c; if (L >= (long)nT * nN) return false;
        u.pm = (int)(L / nN); u.pn = (int)(L % nN); const int e = tile_e[u.pm]; u.e = e; u.bofs = (long)e * estride; return true;
    }
    __device__ __forceinline__ void a_ready(const Unit&) const {}
    __device__ __forceinline__ void done(const Unit&) const {}
};

struct BatchOrder {
    int nN, nwg, G, c, tiles_per_batch; long bstride;
    __device__ __forceinline__ bool next(int i, Unit& u) const {
        const long L = (long)i * G + c; if (L >= nwg) return false;
        u.pm = (int)(L / nN); u.pn = (int)(L % nN); const int e = u.pm / tiles_per_batch; u.e = e; u.bofs = (long)e * bstride; return true;
    }
    __device__ __forceinline__ void a_ready(const Unit&) const {}
    __device__ __forceinline__ void done(const Unit&) const {}
};

__device__ __forceinline__ unsigned cvt_pk_bf16(float lo, float hi) { unsigned r; asm volatile("v_cvt_pk_bf16_f32 %0, %1, %2" : "=v"(r) : "v"(lo), "v"(hi)); return r; }
__device__ __forceinline__ u32x4 pack8(const f32x4 v0, const f32x4 v1) { u32x4 w; w.x = cvt_pk_bf16(v0[0], v0[1]); w.y = cvt_pk_bf16(v0[2], v0[3]); w.z = cvt_pk_bf16(v1[0], v1[1]); w.w = cvt_pk_bf16(v1[2], v1[3]); return w; }
__device__ __forceinline__ float bf_lo(unsigned w) { return __uint_as_float(w << 16); }
__device__ __forceinline__ float bf_hi(unsigned w) { return __uint_as_float(w & 0xffff0000u); }
__device__ __forceinline__ float sigmoidf_(float x) { return 1.0f / (1.0f + __expf(-x)); }
typedef unsigned u32x2 __attribute__((ext_vector_type(2)));

template <class T> struct Epi {
    static constexpr bool PERM = true, AFTER_DRAIN = false;
    T t;
    __device__ __forceinline__ void operator()(const f32x4 (&acc)[2][2][4][2], const Unit& u, int wr, int wc, int fr, int fq) const {
        const int row0 = u.pm * BM + wr * 64 + fr, col0 = u.pn * BM + wc * 32 + 8 * fq;
#pragma unroll
        for (int ai = 0; ai < 2; ++ai)
#pragma unroll
            for (int m = 0; m < 4; ++m) {
#pragma unroll
                for (int bj = 0; bj < 2; ++bj) t.store(row0 + ai * HALF + m * 16, col0 + bj * HALF, acc[ai][bj][m][0], acc[ai][bj][m][1], u);
                asm volatile("" ::: "memory"); }
    }
};
struct StBf16 { bf16_t* O; int ld;
    __device__ __forceinline__ void store(int row, int col, f32x4 v0, f32x4 v1, const Unit&) const { *(u32x4*)(O + (size_t)row * ld + col) = pack8(v0, v1); } };
struct StInAB { float* SM; bf16_t* Q;
    __device__ __forceinline__ void store(int row, int col, f32x4 v0, f32x4 v1, const Unit&) const {
        if (col < 512) { float* p = SM + (size_t)row * 512 + col; *(f32x4*)p = v0; *(f32x4*)(p + 4) = v1; }
        else *(u32x4*)(Q + (size_t)row * 2048 + (col - 512)) = pack8(v0, v1); } };
struct StPre { const float* base; float* P; float alpha;
    __device__ __forceinline__ void store(int row, int col, f32x4 v0, f32x4 v1, const Unit&) const {
        const size_t o = (size_t)row * 1024 + col; const f32x4 b0 = *(const f32x4*)(base + o), b1 = *(const f32x4*)(base + o + 4);
        *(f32x4*)(P + o) = b0 * alpha + v0; *(f32x4*)(P + o + 4) = b1 * alpha + v1; } };
struct StPleGate { const bf16_t* PP; bf16_t* O;
    __device__ __forceinline__ void store(int row, int col, f32x4 v0, f32x4 v1, const Unit&) const {
        const size_t o = (size_t)row * 1024 + col; const u32x4 p = *(const u32x4*)(PP + o);
        f32x4 r0, r1;
        r0[0] = sigmoidf_(v0[0]) * bf_lo(p.x); r0[1] = sigmoidf_(v0[1]) * bf_hi(p.x); r0[2] = sigmoidf_(v0[2]) * bf_lo(p.y); r0[3] = sigmoidf_(v0[3]) * bf_hi(p.y);
        r1[0] = sigmoidf_(v1[0]) * bf_lo(p.z); r1[1] = sigmoidf_(v1[1]) * bf_hi(p.z); r1[2] = sigmoidf_(v1[2]) * bf_lo(p.w); r1[3] = sigmoidf_(v1[3]) * bf_hi(p.w);
        *(u32x4*)(O + o) = pack8(r0, r1); } };
struct StSwiglu { const float* bgu; bf16_t* H;
    __device__ __forceinline__ float act(float g, float u) const { const float gt = fminf(g, 7.0f), up = fminf(fmaxf(u, -7.0f), 7.0f); return (up + 1.0f) * (gt * sigmoidf_(gt * 1.702f)); }
    __device__ __forceinline__ void store(int row, int col, f32x4 v0, f32x4 v1, const Unit& u) const {
        const float* b = bgu + (size_t)u.e * 2048 + col; const f32x4 b0 = *(const f32x4*)b, b1 = *(const f32x4*)(b + 4);
        v0 = v0 + b0; v1 = v1 + b1;
        u32x2 w; w.x = cvt_pk_bf16(act(v0[0], v0[1]), act(v0[2], v0[3])); w.y = cvt_pk_bf16(act(v1[0], v1[1]), act(v1[2], v1[3]));
        *(u32x2*)(H + (size_t)row * 1024 + (col >> 1)) = w; } };
struct StDown { const float* bd; bf16_t* Y;
    __device__ __forceinline__ void store(int row, int col, f32x4 v0, f32x4 v1, const Unit& u) const {
        const float* b = bd + (size_t)u.e * 1024 + col; const f32x4 b0 = *(const f32x4*)b, b1 = *(const f32x4*)(b + 4);
        *(u32x4*)(Y + (size_t)row * 1024 + col) = pack8(v0 + b0, v1 + b1); } };

template <class Epi, class Sched, bool ALIGN_EPI = false, bool SP2 = false>
__device__ __forceinline__ void gemm_phase(PG8_LAS unsigned char* lds, const Gemm g, const Sched& S, const Epi& E) {
    int tid = threadIdx.x; asm volatile("" : "+v"(tid));
    const int wid = __builtin_amdgcn_readfirstlane(tid >> 6), lane = tid & 63, wr = wid >> 2, wc = wid & 3, fr = lane & 15, fq = lane >> 4;
    int K = g.K; asm volatile("" : "+s"(K));
    const int nt = K / BK;
    unsigned voffA[2], voffB[2];
#pragma unroll
    for (int i = 0; i < 2; ++i) { int R, C; stage_rc(tid * 16 + i * 8192, R, C); const int Rb = Epi::PERM ? ((R & ~31) + perm32(R & 31)) : R;
        voffA[i] = (unsigned)(R * K + C) * 2u; voffB[i] = (unsigned)(Rb * K + C) * 2u; }
    const size_t kstep = (size_t)(BK * 2);
    const size_t hstep = (size_t)HALF * K * 2;
    const size_t tstep = 2 * hstep;
    const unsigned ldsw = (unsigned)wid * 1024u;
    const int aoff = lds_byte(wr * 64 + fr, fq * 8), boff = lds_byte(wc * 32 + fr, fq * 8);
#define PG8_SA(b, h) (((b) * 2 + (h)) * HTB)
#define PG8_SB(b, h) ((4 + (b) * 2 + (h)) * HTB)
#define PG8_STAGE(bufoff, gbase, voff) do { _Pragma("unroll") for (int _i = 0; _i < 2; ++_i) \
        __builtin_amdgcn_global_load_lds((const unsigned*)((const char*)(gbase) + (voff)[_i]), (PG8_LAS unsigned*)(lds + (bufoff) + ldsw + _i * 8192), 16, 0, 0); } while (0)
#define PG8_LDA(dst, b, h) do { _Pragma("unroll") for (int m = 0; m < 4; ++m) _Pragma("unroll") for (int k = 0; k < 2; ++k) dst[m][k] = *(const PG8_LAS bf16x8*)(lds + PG8_SA(b, h) + aoff + m * 2048 + k * 1024); } while (0)
#define PG8_LDB(dst, b, h) do { _Pragma("unroll") for (int n = 0; n < 2; ++n) _Pragma("unroll") for (int k = 0; k < 2; ++k) dst[n][k] = *(const PG8_LAS bf16x8*)(lds + PG8_SB(b, h) + boff + n * 2048 + k * 1024); } while (0)
#define PG8_MMA(ai, bj, At, Bt) do { __builtin_amdgcn_s_setprio(1); _Pragma("unroll") for (int m = 0; m < 4; ++m) _Pragma("unroll") for (int n = 0; n < 2; ++n) _Pragma("unroll") for (int k = 0; k < 2; ++k) \
        acc[ai][bj][m][n] = __builtin_amdgcn_mfma_f32_16x16x32_bf16(Bt[n][k], At[m][k], acc[ai][bj][m][n], 0, 0, 0); __builtin_amdgcn_s_setprio(0); } while (0)
#define PG8_WAIT_V(n) asm volatile("s_waitcnt vmcnt(" #n ")" ::: "memory")
#define PG8_WAIT_L(n) asm volatile("s_waitcnt lgkmcnt(" #n ")" ::: "memory")
#define PG8_BAR __builtin_amdgcn_s_barrier()
#define PG8_SCHED __builtin_amdgcn_sched_barrier(0)
    Unit cur, nxt; int ui = 0;
    if (!S.next(0, cur)) return;
    f32x4 acc[2][2][4][2];
#pragma unroll
    for (int a = 0; a < 2; ++a)
#pragma unroll
        for (int b = 0; b < 2; ++b)
#pragma unroll
            for (int m = 0; m < 4; ++m)
#pragma unroll
                for (int n = 0; n < 2; ++n) acc[a][b][m][n] = (f32x4){0.f, 0.f, 0.f, 0.f};
    bf16x8 At[4][2], B0[2][2], B1[2][2];
    const char* cA = (const char*)g.A + (size_t)cur.pm * tstep; const char* cB = (const char*)g.Bt + (size_t)cur.pn * tstep + cur.bofs;
    S.a_ready(cur);
    if constexpr (SP2) {
        PG8_STAGE(PG8_SB(0, 0), cB, voffB); PG8_STAGE(PG8_SB(0, 1), cB + hstep, voffB); PG8_STAGE(PG8_SA(0, 0), cA, voffA); PG8_STAGE(PG8_SA(0, 1), cA + hstep, voffA);
        if (wr == 1) PG8_BAR;
        PG8_WAIT_V(2); PG8_BAR;
        PG8_STAGE(PG8_SB(1, 0), cB + kstep, voffB); PG8_STAGE(PG8_SA(1, 0), cA + kstep, voffA); PG8_STAGE(PG8_SB(1, 1), cB + hstep + kstep, voffB);
        PG8_WAIT_V(6); PG8_BAR;
    } else {
        PG8_STAGE(PG8_SB(0, 0), cB, voffB); PG8_STAGE(PG8_SA(0, 0), cA, voffA); PG8_STAGE(PG8_SB(0, 1), cB + hstep, voffB); PG8_STAGE(PG8_SA(0, 1), cA + hstep, voffA);
        if (wr == 1) PG8_BAR;
        PG8_WAIT_V(4); PG8_BAR;
        PG8_STAGE(PG8_SB(1, 0), cB + kstep, voffB); PG8_STAGE(PG8_SA(1, 0), cA + kstep, voffA); PG8_STAGE(PG8_SB(1, 1), cB + hstep + kstep, voffB);
        PG8_WAIT_V(6); PG8_BAR;
    }
    for (;;) {
        const bool has_next = S.next(ui + 1, nxt);
        const char* nA = has_next ? (const char*)g.A + (size_t)nxt.pm * tstep : cA; const char* nB = has_next ? (const char*)g.Bt + (size_t)nxt.pn * tstep + nxt.bofs : cB;
        for (int t = 0; t < nt; t += 2) {
            const bool last = (t == nt - 2);
            const char* a1 = cA + (size_t)(t + 1) * kstep;
            const char* a2 = last ? nA : cA + (size_t)(t + 2) * kstep; const char* b2 = last ? nB : cB + (size_t)(t + 2) * kstep;
            const char* a3 = a2 + kstep; const char* b3 = b2 + kstep;
            if (last && has_next) S.a_ready(nxt);
            if constexpr (SP2) {
            PG8_LDB(B0, 0, 0); PG8_LDB(B1, 0, 1); PG8_SCHED; PG8_LDA(At, 0, 0); PG8_STAGE(PG8_SA(1, 1), a1 + hstep, voffA);
            PG8_WAIT_V(8); PG8_WAIT_L(0); PG8_BAR; PG8_MMA(0, 0, At, B0); PG8_MMA(0, 1, At, B1); PG8_BAR; PG8_SCHED;
            PG8_LDA(At, 0, 1); PG8_STAGE(PG8_SB(0, 0), b2, voffB); PG8_STAGE(PG8_SB(0, 1), b2 + hstep, voffB); PG8_STAGE(PG8_SA(0, 0), a2, voffA);
            PG8_WAIT_V(8); PG8_WAIT_L(0); PG8_BAR; PG8_MMA(1, 0, At, B0); PG8_MMA(1, 1, At, B1); PG8_BAR; PG8_SCHED;
            PG8_LDB(B0, 1, 0); PG8_LDB(B1, 1, 1); PG8_SCHED; PG8_LDA(At, 1, 0); PG8_STAGE(PG8_SA(0, 1), a2 + hstep, voffA);
            PG8_WAIT_V(8); PG8_WAIT_L(0); PG8_BAR; PG8_MMA(0, 0, At, B0); PG8_MMA(0, 1, At, B1); PG8_BAR; PG8_SCHED;
            PG8_LDA(At, 1, 1); PG8_STAGE(PG8_SB(1, 0), b3, voffB); PG8_STAGE(PG8_SB(1, 1), b3 + hstep, voffB); PG8_STAGE(PG8_SA(1, 0), a3, voffA);
            PG8_WAIT_V(8); PG8_WAIT_L(0); PG8_BAR; PG8_MMA(1, 0, At, B0); PG8_MMA(1, 1, At, B1); PG8_BAR; PG8_SCHED;
            } else {
            PG8_LDB(B0, 0, 0); PG8_SCHED; PG8_LDA(At, 0, 0); PG8_STAGE(PG8_SA(1, 1), a1 + hstep, voffA);
            PG8_WAIT_L(8); PG8_BAR; PG8_WAIT_L(0); PG8_MMA(0, 0, At, B0); PG8_BAR; PG8_SCHED;
            PG8_LDB(B1, 0, 1); PG8_STAGE(PG8_SB(0, 0), b2, voffB);
            PG8_BAR; PG8_WAIT_L(0); PG8_MMA(0, 1, At, B1); PG8_BAR;
            PG8_LDA(At, 0, 1); PG8_STAGE(PG8_SA(0, 0), a2, voffA);
            PG8_BAR; PG8_WAIT_L(0); PG8_MMA(1, 0, At, B0); PG8_BAR; PG8_SCHED;
            PG8_STAGE(PG8_SB(0, 1), b2 + hstep, voffB);
            PG8_WAIT_V(6); PG8_BAR; PG8_MMA(1, 1, At, B1); PG8_BAR;
            PG8_LDB(B0, 1, 0); PG8_SCHED; PG8_LDA(At, 1, 0); PG8_STAGE(PG8_SA(0, 1), a2 + hstep, voffA);
            PG8_WAIT_L(8); PG8_BAR; PG8_WAIT_L(0); PG8_MMA(0, 0, At, B0); PG8_BAR; PG8_SCHED;
            PG8_LDB(B1, 1, 1); PG8_STAGE(PG8_SB(1, 0), b3, voffB);
            PG8_BAR; PG8_WAIT_L(0); PG8_MMA(0, 1, At, B1); PG8_BAR;
            PG8_LDA(At, 1, 1); PG8_STAGE(PG8_SA(1, 0), a3, voffA);
            PG8_BAR; PG8_WAIT_L(0); PG8_MMA(1, 0, At, B0); PG8_BAR; PG8_SCHED;
            PG8_STAGE(PG8_SB(1, 1), b3 + hstep, voffB);
            PG8_WAIT_V(6); PG8_BAR; PG8_MMA(1, 1, At, B1); PG8_BAR;
            }
        }
        if constexpr (ALIGN_EPI) { if (wr == 0) PG8_BAR; }
        if constexpr (!Epi::AFTER_DRAIN) { E(acc, cur, wr, wc, fr, fq); S.done(cur); }
        if (!has_next) break;
#pragma unroll
        for (int a = 0; a < 2; ++a)
#pragma unroll
            for (int b = 0; b < 2; ++b)
#pragma unroll
                for (int m = 0; m < 4; ++m)
#pragma unroll
                    for (int n = 0; n < 2; ++n) acc[a][b][m][n] = (f32x4){0.f, 0.f, 0.f, 0.f};
        cur = nxt; cA = nA; cB = nB; ++ui;
        if constexpr (ALIGN_EPI) { if (wr == 1) PG8_BAR; }
    }
    PG8_WAIT_V(0);
    if constexpr (!ALIGN_EPI) { if (wr == 0) PG8_BAR; }
    PG8_BAR;
    if constexpr (Epi::AFTER_DRAIN) { E.fused(acc, cur, wr, wc, fr, fq, lds, wid, lane); S.done(cur); }
#undef PG8_SA
#undef PG8_SB
#undef PG8_STAGE
#undef PG8_LDA
#undef PG8_LDB
#undef PG8_MMA
#undef PG8_WAIT_V
#undef PG8_WAIT_L
#undef PG8_BAR
#undef PG8_SCHED
}
}

constexpr int NWAVES = 8, NTHREADS = 512;
constexpr int BATCH = 2, SEQ = 8192, M = BATCH * SEQ, D = 1024;
constexpr int NEXP = 32, DEXP = 1024;
constexpr int PMAX = M * 4 + NEXP * 256, NTMAX = PMAX / 256;
constexpr float ALPHA = 1.41421356237f;
constexpr int NPHASES = 21;
#ifndef MK_N_LAUNCHES
#define MK_N_LAUNCHES 21
#endif
constexpr int N_LAUNCHES = MK_N_LAUNCHES;

enum { I_X = 0, I_P, I_AB_WIN, I_AB_QG, I_AB_KVG, I_AB_WUQ, I_AB_WUK, I_AB_WUV, I_AB_WQIDX, I_AB_KIG, I_AB_KIB, I_AB_CONVW, I_AB_ALOG, I_AB_DTB, I_AB_ONG, I_AB_WOUT,
       I_CD_WIN, I_CD_POOLW, I_CD_POOLS, I_CD_WOUT, I_LNM_G, I_LNM_B, I_RW, I_RB, I_WGU, I_BGU, I_WDN, I_BDN, I_PLE_WP, I_PLE_WG, I_LNF_G, I_LNF_B, N_IN };

constexpr size_t MiB = 1u << 20;
constexpr size_t WS_CTL = 0, CTL_ZERO_BYTES = 1 * MiB;
constexpr size_t WS_W_INAB = 1 * MiB;
constexpr size_t WS_W_ABS = 6 * MiB;
constexpr size_t WS_W_OUTAB = 7 * MiB;
constexpr size_t WS_W_INCD = 10 * MiB;
constexpr size_t WS_W_OUTCD = 15 * MiB;
constexpr size_t WS_W_PG = 17 * MiB;
constexpr size_t WS_W_PP = 21 * MiB;
constexpr size_t WS_W_GU = 22 * MiB;
constexpr size_t WS_W_DN = 278 * MiB;
constexpr size_t WS_XB = 406 * MiB;
constexpr size_t WS_PB = 438 * MiB;
constexpr size_t WS_PP = 454 * MiB;
constexpr size_t WS_SM = 518 * MiB;
constexpr size_t WS_QKVZ = 550 * MiB;
constexpr size_t WS_CQ = 630 * MiB;
constexpr size_t WS_CKV = 638 * MiB;
constexpr size_t WS_KIDX = 642 * MiB;
constexpr size_t WS_WIDX = 644 * MiB;
constexpr size_t WS_BETA = 645 * MiB;
constexpr size_t WS_GG = WS_BETA + 512 * 1024;
constexpr size_t WS_QN = 646 * MiB, WS_KN = 662 * MiB, WS_VN = 678 * MiB;
constexpr size_t WS_QL = 694 * MiB;
constexpr size_t WS_CHK = 742 * MiB;
constexpr size_t WS_SEL = 838 * MiB;
constexpr size_t WS_NSEL = 854 * MiB;
constexpr size_t WS_ODELTA = 855 * MiB;
constexpr size_t WS_AO = 887 * MiB;
constexpr size_t WS_PRE = 935 * MiB;
constexpr size_t WS_H1 = 999 * MiB;
constexpr size_t WS_H2 = 1063 * MiB;
constexpr size_t WS_H1B = 1127 * MiB;
constexpr size_t WS_PLE = 1159 * MiB;
constexpr size_t WS_ROUTE = 1191 * MiB;
constexpr size_t WS_BIG = 1193 * MiB;
constexpr size_t WS_XS = WS_BIG, WS_HID = WS_BIG + 144 * MiB, WS_YS = WS_BIG + 288 * MiB;
constexpr size_t WS_END = WS_BIG + 512 * MiB;
static_assert((size_t)PMAX * 1024 * 2 <= 144 * MiB && WS_END <= 2048 * MiB, "d_ws map");
constexpr size_t CHK_WP = 0, CHK_QD = 16384, CHK_KDT = 32768, CHK_QK = 49152, CHK_UT = 57344, CHK_GL = 90112, CHK_STRIDE = 92160;
static_assert(CHK_STRIDE * 1024 <= 96 * MiB, "chunk operands");
constexpr int CW_TMO = 0, CW_CODE = 1;
constexpr int CW_BAR = 4096;
constexpr int CW_CNT = 16384;

constexpr int RING_OFF = 0, RING_BYTES = 131072;
constexpr int WSCR_OFF = 132096, WSCR_BYTES = 1024;
constexpr int MISC_OFF = 140288;
constexpr int LDS_BYTES = 147456;

#define GAS __attribute__((address_space(1)))
#define LAS __attribute__((address_space(3)))
typedef unsigned short bf16;
typedef unsigned v4u __attribute__((ext_vector_type(4)));
typedef unsigned v2u __attribute__((ext_vector_type(2)));
typedef float f32x4 __attribute__((ext_vector_type(4)));
typedef short bf16x8 __attribute__((ext_vector_type(8)));
typedef GAS unsigned gu32;
#define RLX_AGENT __ATOMIC_RELAXED, __HIP_MEMORY_SCOPE_AGENT
__device__ __forceinline__ unsigned f2bf(float f) { unsigned u = __builtin_bit_cast(unsigned, f); return (u + 0x7fffu + ((u >> 16) & 1u)) >> 16; }
__device__ __forceinline__ unsigned pk2(float lo, float hi) { return f2bf(lo) | (f2bf(hi) << 16); }
__device__ __forceinline__ float bflo(unsigned w) { return __uint_as_float(w << 16); }
__device__ __forceinline__ float bfhi(unsigned w) { return __uint_as_float(w & 0xffff0000u); }
__device__ __forceinline__ float bf1(bf16 h) { return __uint_as_float(((unsigned)h) << 16); }
__device__ __forceinline__ float sigm(float x) { return 1.0f / (1.0f + __expf(-x)); }
__device__ __forceinline__ float siluf(float x) { return x / (1.0f + __expf(-x)); }
__device__ __forceinline__ float wave_sum(float v) {
#pragma unroll
    for (int o = 1; o < 64; o <<= 1) v += __shfl_xor(v, o);
    return v;
}
__device__ __forceinline__ float wave_max(float v) {
#pragma unroll
    for (int o = 1; o < 64; o <<= 1) v = fmaxf(v, __shfl_xor(v, o));
    return v;
}
__device__ __forceinline__ int wave_sum_i(int v) {
#pragma unroll
    for (int o = 1; o < 64; o <<= 1) v += __shfl_xor(v, o);
    return v;
}
__device__ __forceinline__ void unpack8(const v4u w, float (&f)[8]) { f[0] = bflo(w.x); f[1] = bfhi(w.x); f[2] = bflo(w.y); f[3] = bfhi(w.y); f[4] = bflo(w.z); f[5] = bfhi(w.z); f[6] = bflo(w.w); f[7] = bfhi(w.w); }
__device__ __forceinline__ v4u pack8f(const float (&f)[8]) { v4u w; w.x = pk2(f[0], f[1]); w.y = pk2(f[2], f[3]); w.z = pk2(f[4], f[5]); w.w = pk2(f[6], f[7]); return w; }

#define XB_TMO      128
#define XB_XCNT(j)  (256  + 64 * (j))
#define XB_XSUB(j)  (1280 + 64 * (j))
#define XB_XGEN(j)  (2304 + 64 * (j))
#define XB_TOP      3328
#define XB_TOPGEN   3392
#define XCD_BAR_WORDS 3456
#define XB_SPIN_CAP (1u << 18)

__device__ __forceinline__ unsigned xb_ld(unsigned* p)              { return __hip_atomic_load(p, __ATOMIC_RELAXED, __HIP_MEMORY_SCOPE_AGENT); }
__device__ __forceinline__ unsigned xb_add(unsigned* p, unsigned v) { return __hip_atomic_fetch_add(p, v, __ATOMIC_RELAXED, __HIP_MEMORY_SCOPE_AGENT); }
__device__ __forceinline__ unsigned xb_xcc_id() { return (unsigned)__builtin_amdgcn_s_getreg((3 << 11) | 20) & 0xFu; }
#define XB_SPIN(cond, bar) do { unsigned _sp = 0; while (cond) { __builtin_amdgcn_s_sleep(1); \
    if ((++_sp & 255u) == 0u) { if (xb_ld(&(bar)[XB_TMO])) break; if (_sp > XB_SPIN_CAP) { atomicAdd(&(bar)[XB_TMO], 1u); break; } } } } while (0)

struct XcdBarrier {
    unsigned* bar; unsigned x;
    volatile LAS unsigned* st;
};

__device__ __forceinline__ XcdBarrier xcd_barrier_post(unsigned* bar, volatile LAS unsigned* st) {
    XcdBarrier b; b.bar = bar; b.x = xb_xcc_id(); b.st = st;
    if (threadIdx.x == 0) (void)xb_add(&bar[XB_XCNT(b.x)], 1u);
    return b;
}
__device__ __forceinline__ void xcd_barrier_complete(unsigned* bar, unsigned x, unsigned& nloc, unsigned& nx) {
    const unsigned G = gridDim.x * gridDim.y * gridDim.z;
    unsigned sum, cnt, mine, sp = 0u;
    for (;;) {
        sum = 0u; cnt = 0u; mine = 0u;
#pragma unroll
        for (unsigned j = 0; j < 16; ++j) { const unsigned c = xb_ld(&bar[XB_XCNT(j)]); sum += c; cnt += (c > 0u) ? 1u : 0u; mine = (j == x) ? c : mine; }
        if (sum == G) break;
        __builtin_amdgcn_s_sleep(1);
        if ((++sp & 255u) == 0u) { if (xb_ld(&bar[XB_TMO])) break; if (sp > XB_SPIN_CAP) { atomicAdd(&bar[XB_TMO], 1u); break; } }
    }
    nloc = mine > 0u ? mine : 1u; nx = cnt > 0u ? cnt : 1u;
}

__device__ __forceinline__ void xcd_barrier(const XcdBarrier& b) {
    asm volatile("s_waitcnt vmcnt(0)" ::: "memory");
    __syncthreads();
    if (threadIdx.x == 0) {
        unsigned* bar = b.bar;
        __builtin_amdgcn_s_waitcnt(0);
        unsigned nloc = b.st[0], nx = b.st[1];
        if (nloc == 0u) { xcd_barrier_complete(bar, b.x, nloc, nx); b.st[0] = nloc; b.st[1] = nx; }
        const unsigned old = xb_add(&bar[XB_XSUB(b.x)], 1u);
        const unsigned gen = old / nloc;
        if (old + 1u == (gen + 1u) * nloc) {
            __builtin_amdgcn_fence(__ATOMIC_RELEASE, "agent");
            asm volatile("s_waitcnt vmcnt(0)" ::: "memory");
            const unsigned og = xb_add(&bar[XB_TOP], 1u);
            const unsigned tg = og / nx;
            if (og + 1u == (tg + 1u) * nx) xb_add(&bar[XB_TOPGEN], 1u);
            else XB_SPIN(xb_ld(&bar[XB_TOPGEN]) == tg, bar);
            __builtin_amdgcn_fence(__ATOMIC_ACQUIRE, "agent");
            xb_add(&bar[XB_XGEN(b.x)], 1u);
            asm volatile("s_waitcnt vmcnt(0)" ::: "memory");
        } else {
            XB_SPIN(xb_ld(&bar[XB_XGEN(b.x)]) == gen, bar);
            __builtin_amdgcn_fence(__ATOMIC_ACQUIRE, "agent");
            asm volatile("s_waitcnt vmcnt(0)" ::: "memory");
        }
    }
    __syncthreads();
}

struct Args { const float* in[N_IN]; float* out; unsigned char* ws; int ph_lo, ph_hi, li, pad; };
typedef const __attribute__((address_space(4))) Args* KArgs;
__device__ __forceinline__ KArgs kargs() { auto p = __builtin_amdgcn_kernarg_segment_ptr(); asm volatile("" : "+s"(p)); return (KArgs)p; }
struct Frame {
    LAS unsigned char* lds;
    int tid, lane, wave, G, bid;
    unsigned char* ws;
    gu32* ctl;
};
#define WSP(T, off) ((T*)(F.ws + (off)))

struct MapId { __device__ __forceinline__ int operator()(int n) const { return n; } };
struct MapAdd { int off; __device__ __forceinline__ int operator()(int n) const { return n + off; } };
struct MapAB { __device__ __forceinline__ int operator()(int n) const { return n < 456 ? n : (n < 2504 ? n + 56 : n - 2048); } };
template <class Map> __device__ __forceinline__ void wg_transpose_item(const float* W, int N, int ldw, bf16* WT, int ldt, int koff, Map map, LAS float* scr, int item, int tid) {
    const int nblk = (N + 127) >> 7, kb = item / nblk, nb = item - kb * nblk, k0 = kb * 128, n0 = nb * 128;
#pragma unroll
    for (int it = 0; it < 8; ++it) {
        const int row = it * 16 + (tid >> 5), c4 = (tid & 31) * 4, n = n0 + c4;
        f32x4 v = (f32x4){0.f, 0.f, 0.f, 0.f};
        if (n + 3 < N) v = *(const f32x4*)(W + (size_t)(k0 + row) * ldw + n);
        LAS float* s = scr + row * 129 + c4; s[0] = v[0]; s[1] = v[1]; s[2] = v[2]; s[3] = v[3];
    }
    __syncthreads();
#pragma unroll
    for (int j = 0; j < 4; ++j) {
        const int idx = j * 512 + tid, nl = idx >> 4, ch = idx & 15, n = n0 + nl;
        if (n < N) { const LAS float* s = scr + (ch * 8) * 129 + nl;
            v4u o; o.x = pk2(s[0], s[129]); o.y = pk2(s[2 * 129], s[3 * 129]); o.z = pk2(s[4 * 129], s[5 * 129]); o.w = pk2(s[6 * 129], s[7 * 129]);
            *(v4u*)(WT + (size_t)map(n) * ldt + koff + k0 + ch * 8) = o; }
    }
    __syncthreads();
}
__device__ __forceinline__ void p0_prologue(Frame& F, KArgs A) {
    LAS float* scr = (LAS float*)(F.lds + RING_OFF);
    const int tid = F.tid;
    constexpr int IT_GU = 128, IT_DN = 64;
    constexpr int N_GU = 64 * IT_GU, N_DN = 64 * IT_DN;
    constexpr int N_INAB = 8 * 20, N_INCD = 8 * 20, N_OUTCD = 64, N_PG = 2 * 64, N_PP = 2 * 2 * 8, N_QIDX = 2 * 4, N_OUTB = 4 * 8;
    constexpr int NITEMS = N_GU + N_DN + N_INAB + N_INCD + N_OUTCD + N_PG + N_PP + N_QIDX + N_OUTB;
    for (int it = F.bid; it < NITEMS; it += F.G) {
        int r = it;
        if (r < N_GU) { const int m = r / IT_GU; wg_transpose_item(A->in[I_WGU] + (size_t)m * 1024 * 2048, 2048, 2048, WSP(bf16, WS_W_GU) + (size_t)m * 2048 * 1024, 1024, 0, MapId{}, scr, r % IT_GU, tid); continue; } r -= N_GU;
        if (r < N_DN) { const int m = r / IT_DN; wg_transpose_item(A->in[I_WDN] + (size_t)m * 1024 * 1024, 1024, 1024, WSP(bf16, WS_W_DN) + (size_t)m * 1024 * 1024, 1024, 0, MapId{}, scr, r % IT_DN, tid); continue; } r -= N_DN;
        if (r < N_INAB) { wg_transpose_item(A->in[I_AB_WIN], 2512, 2512, WSP(bf16, WS_W_INAB), 1024, 0, MapAB{}, scr, r, tid); continue; } r -= N_INAB;
        if (r < N_INCD) { wg_transpose_item(A->in[I_CD_WIN], 2560, 2560, WSP(bf16, WS_W_INCD), 1024, 0, MapId{}, scr, r, tid); continue; } r -= N_INCD;
        if (r < N_OUTCD) { wg_transpose_item(A->in[I_CD_WOUT], 1024, 1024, WSP(bf16, WS_W_OUTCD), 1024, 0, MapId{}, scr, r, tid); continue; } r -= N_OUTCD;
        if (r < N_PG) { const int l = r / 64; wg_transpose_item(A->in[I_PLE_WG] + (size_t)l * 1024 * 1024, 1024, 1024, WSP(bf16, WS_W_PG) + (size_t)l * 1024 * 1024, 1024, 0, MapId{}, scr, r % 64, tid); continue; } r -= N_PG;
        if (r < N_PP) { const int l = r / 16; wg_transpose_item(A->in[I_PLE_WP] + (size_t)l * 256 * 1024, 1024, 1024, WSP(bf16, WS_W_PP) + (size_t)l * 1024 * 256, 256, 0, MapId{}, scr, r % 16, tid); continue; } r -= N_PP;
        if (r < N_QIDX) { wg_transpose_item(A->in[I_AB_WQIDX], 512, 512, WSP(bf16, WS_W_ABS), 256, 0, MapAdd{1024}, scr, r, tid); continue; } r -= N_QIDX;
        wg_transpose_item(A->in[I_AB_WOUT] + (size_t)512 * 1024, 1024, 1024, WSP(bf16, WS_W_OUTAB), 1536, 1024, MapId{}, scr, r, tid);
    }
    const size_t gt = (size_t)F.bid * NTHREADS + tid, GT = (size_t)F.G * NTHREADS;
    for (size_t i = gt; i < (size_t)48 * 1024 / 8; i += GT) *(v4u*)(WSP(bf16, WS_W_INAB) + (size_t)464 * 1024 + i * 8) = (v4u){0u, 0u, 0u, 0u};
    for (size_t i = gt; i < (size_t)1024 * 256; i += GT) {
        const int n = (int)(i >> 8), c = (int)(i & 255), h = n >> 7, r = n & 127;
        const float* a = A->in[I_AB_WUQ] + (size_t)c * 512 + h * 64; const float* b = A->in[I_AB_WUK] + (size_t)r * 512 + h * 64;
        float s = 0.f;
#pragma unroll 8
        for (int d = 0; d < 64; d += 4) { const f32x4 x = *(const f32x4*)(a + d), y = *(const f32x4*)(b + d); s += x[0] * y[0] + x[1] * y[1] + x[2] * y[2] + x[3] * y[3]; }
        WSP(bf16, WS_W_ABS)[i] = (bf16)f2bf(s * 0.125f);
    }
    for (size_t i = gt; i < (size_t)1024 * 1024; i += GT) {
        const int n = (int)(i >> 10), k = (int)(i & 1023), h = k >> 7, r = k & 127;
        const float* a = A->in[I_AB_WUV] + (size_t)r * 512 + h * 64; const float* b = A->in[I_AB_WOUT] + (size_t)(h * 64) * 1024 + n;
        float s = 0.f;
#pragma unroll 8
        for (int v = 0; v < 64; ++v) s += a[v] * b[(size_t)v * 1024];
        WSP(bf16, WS_W_OUTAB)[(size_t)n * 1536 + k] = (bf16)f2bf(s);
    }
    for (size_t i = gt; i < (size_t)M * D / 8; i += GT) { const f32x4 a = *(const f32x4*)(A->in[I_X] + i * 8), b = *(const f32x4*)(A->in[I_X] + i * 8 + 4);
        v4u o; o.x = pk2(a[0], a[1]); o.y = pk2(a[2], a[3]); o.z = pk2(b[0], b[1]); o.w = pk2(b[2], b[3]); *(v4u*)(WSP(bf16, WS_XB) + i * 8) = o; }
    for (size_t i = gt; i < (size_t)2 * M * 256 / 8; i += GT) { const f32x4 a = *(const f32x4*)(A->in[I_P] + i * 8), b = *(const f32x4*)(A->in[I_P] + i * 8 + 4);
        v4u o; o.x = pk2(a[0], a[1]); o.y = pk2(a[2], a[3]); o.z = pk2(b[0], b[1]); o.w = pk2(b[2], b[3]); *(v4u*)(WSP(bf16, WS_PB) + i * 8) = o; }
}

__device__ __forceinline__ void p2_prep(Frame& F, KArgs A) {
    const int lane = F.lane, gw = F.bid * NWAVES + F.wave, NGW = F.G * NWAVES;
    const float* SM = WSP(float, WS_SM); const bf16* QZ = WSP(bf16, WS_QKVZ);
    const f32x4 qg = *(const f32x4*)(A->in[I_AB_QG] + 4 * lane);
    const f32x4 kvg = *(const f32x4*)(A->in[I_AB_KVG] + 4 * (lane & 31));
    const f32x4 kig = *(const f32x4*)(A->in[I_AB_KIG] + 4 * (lane & 15)), kib = *(const f32x4*)(A->in[I_AB_KIB] + 4 * (lane & 15));
    const f32x4 alog = *(const f32x4*)(A->in[I_AB_ALOG]), dtb = *(const f32x4*)(A->in[I_AB_DTB]);
    for (int row = gw; row < M; row += NGW) {
        const int t = row & (SEQ - 1);
        const f32x4 a = *(const f32x4*)(SM + (size_t)row * 512 + 4 * lane), b = *(const f32x4*)(SM + (size_t)row * 512 + 256 + 4 * lane);
        {
            const float ss = wave_sum(a[0] * a[0] + a[1] * a[1] + a[2] * a[2] + a[3] * a[3]);
            const float r = rsqrtf(ss * (1.0f / 256.0f) + 1e-6f);
            v2u o; o.x = pk2(a[0] * r * qg[0], a[1] * r * qg[1]); o.y = pk2(a[2] * r * qg[2], a[3] * r * qg[3]);
            *(v2u*)(WSP(bf16, WS_CQ) + (size_t)row * 256 + 4 * lane) = o;
        }
        {
            const float ss = wave_sum(lane < 32 ? (b[0] * b[0] + b[1] * b[1] + b[2] * b[2] + b[3] * b[3]) : 0.f);
            const float r = rsqrtf(ss * (1.0f / 128.0f) + 1e-6f);
            if (lane < 32) { v2u o; o.x = pk2(b[0] * r * kvg[0], b[1] * r * kvg[1]); o.y = pk2(b[2] * r * kvg[2], b[3] * r * kvg[3]);
                *(v2u*)(WSP(bf16, WS_CKV) + (size_t)row * 128 + 4 * lane) = o; }
        }
        {
            const bool in = (lane >= 32 && lane < 48);
            const float mean = wave_sum(in ? (b[0] + b[1] + b[2] + b[3]) : 0.f) * (1.0f / 64.0f);
            const f32x4 d = b - mean;
            const float var = wave_sum(in ? (d[0] * d[0] + d[1] * d[1] + d[2] * d[2] + d[3] * d[3]) : 0.f) * (1.0f / 64.0f);
            const float r = rsqrtf(var + 1e-5f);
            if (in) { v2u o; o.x = pk2(d[0] * r * kig[0] + kib[0], d[1] * r * kig[1] + kib[1]); o.y = pk2(d[2] * r * kig[2] + kib[2], d[3] * r * kig[3] + kib[3]);
                *(v2u*)(WSP(bf16, WS_KIDX) + (size_t)row * 64 + 4 * (lane - 32)) = o; }
        }
        if (lane == 48 || lane == 49) *(f32x4*)(WSP(float, WS_WIDX) + (size_t)row * 8 + 4 * (lane - 48)) = b * 0.044194173824159216f;
        if (lane == 50) { f32x4 o; o[0] = sigm(b[0]); o[1] = sigm(b[1]); o[2] = sigm(b[2]); o[3] = sigm(b[3]); *(f32x4*)(WSP(float, WS_BETA) + (size_t)row * 4) = o; }
        if (lane == 51) { f32x4 o;
#pragma unroll
            for (int h = 0; h < 4; ++h) { const float xx = b[h] + dtb[h]; const float sp = xx > 20.f ? xx : log1pf(__expf(xx)); o[h] = -__expf(alog[h]) * sp; }
            *(f32x4*)(WSP(float, WS_GG) + (size_t)row * 4) = o; }
#pragma unroll
        for (int sel = 0; sel < 3; ++sel) {
            const int col0 = sel * 512 + 8 * lane;
            float acc[8];
#pragma unroll
            for (int i = 0; i < 8; ++i) acc[i] = 0.f;
#pragma unroll
            for (int j = 0; j < 4; ++j) {
                if (t - 3 + j >= 0) {
                    const v4u xr = *(const v4u*)(QZ + (size_t)(row - 3 + j) * 2048 + col0); float xv[8]; unpack8(xr, xv);
                    const f32x4 w0 = *(const f32x4*)(A->in[I_AB_CONVW] + (size_t)j * 1536 + col0), w1 = *(const f32x4*)(A->in[I_AB_CONVW] + (size_t)j * 1536 + col0 + 4);
#pragma unroll
                    for (int i = 0; i < 4; ++i) { acc[i] += w0[i] * xv[i]; acc[4 + i] += w1[i] * xv[4 + i]; }
                }
            }
            float ss = 0.f;
#pragma unroll
            for (int i = 0; i < 8; ++i) { acc[i] = siluf(acc[i]); ss += acc[i] * acc[i]; }
            if (sel < 2) {
                ss += __shfl_xor(ss, 1); ss += __shfl_xor(ss, 2); ss += __shfl_xor(ss, 4); ss += __shfl_xor(ss, 8);
                const float sc = rsqrtf(ss + 1e-6f) * (sel == 0 ? 0.08838834764831845f : 1.0f);
#pragma unroll
                for (int i = 0; i < 8; ++i) acc[i] *= sc;
            }
            bf16* dst = (sel == 0 ? WSP(bf16, WS_QN) : (sel == 1 ? WSP(bf16, WS_KN) : WSP(bf16, WS_VN))) + (size_t)row * 512 + 8 * lane;
            *(v4u*)dst = pack8f(acc);
        }
    }
}

__device__ __forceinline__ void p3_chunk_prep(Frame& F, KArgs A) {
    const int tid = F.tid, lane = F.lane;
    LAS float* qs = (LAS float*)(F.lds); LAS float* ks = qs + 64 * 129; LAS float* vs = ks + 64 * 129;
    LAS float* As = vs + 64 * 129;
    LAS float* gcS = As + 64 * 65; LAS float* egS = gcS + 64; LAS float* ekS = egS + 64; LAS float* btS = ekS + 64;
    LAS float* Ts = qs;
    for (int cidx = F.bid; cidx < 1024; cidx += F.G) {
        const int b = cidx >> 9, h = (cidx >> 7) & 3, n = cidx & 127, row0 = b * SEQ + n * 64;
        unsigned char* blk = F.ws + WS_CHK + (size_t)cidx * CHK_STRIDE;
        if (tid < 64) {
            const float g = WSP(float, WS_GG)[(size_t)(row0 + tid) * 4 + h];
            float gc = g;
#pragma unroll
            for (int o = 1; o < 64; o <<= 1) { const float t = __shfl_up(gc, o); if (lane >= o) gc += t; }
            const float g63 = __shfl(gc, 63);
            gcS[tid] = gc; egS[tid] = __expf(gc); ekS[tid] = __expf(g63 - gc); btS[tid] = WSP(float, WS_BETA)[(size_t)(row0 + tid) * 4 + h];
            if (tid == 0) *(float*)(blk + CHK_GL) = __expf(g63);
        }
#pragma unroll
        for (int i = 0; i < 2; ++i) {
            const int id = tid + 512 * i, r = id >> 4, c8 = (id & 15) * 8; const size_t so = (size_t)(row0 + r) * 512 + h * 128 + c8;
            float f[8];
            unpack8(*(const v4u*)(WSP(bf16, WS_QN) + so), f);
#pragma unroll
            for (int x = 0; x < 8; ++x) qs[r * 129 + c8 + x] = f[x];
            unpack8(*(const v4u*)(WSP(bf16, WS_KN) + so), f);
#pragma unroll
            for (int x = 0; x < 8; ++x) ks[r * 129 + c8 + x] = f[x];
            unpack8(*(const v4u*)(WSP(bf16, WS_VN) + so), f);
#pragma unroll
            for (int x = 0; x < 8; ++x) vs[r * 129 + c8 + x] = f[x];
        }
        __syncthreads();
        {
            const int i = tid >> 3, jb = (tid & 7) * 8;
            float aK[8], aQ[8];
#pragma unroll
            for (int x = 0; x < 8; ++x) { aK[x] = 0.f; aQ[x] = 0.f; }
            for (int d = 0; d < 128; ++d) {
                const float ki = ks[i * 129 + d], qi = qs[i * 129 + d];
#pragma unroll
                for (int x = 0; x < 8; ++x) { const float kj = ks[(jb + x) * 129 + d]; aK[x] += ki * kj; aQ[x] += qi * kj; }
            }
            const float gci = gcS[i], bti = btS[i];
            float qk[8];
#pragma unroll
            for (int x = 0; x < 8; ++x) { const int j = jb + x; const float dec = __expf(j <= i ? gci - gcS[j] : 0.f);
                As[i * 65 + j] = (j < i) ? bti * aK[x] * dec : 0.f; qk[x] = (j <= i) ? aQ[x] * dec : 0.f; }
            const int s = jb >> 5, a = (jb >> 4) & 1, q0 = (jb >> 2) & 3;
            bf16* QKp = (bf16*)(blk + CHK_QK) + i * 64;
            v2u w0, w1; w0.x = pk2(qk[0], qk[1]); w0.y = pk2(qk[2], qk[3]); w1.x = pk2(qk[4], qk[5]); w1.y = pk2(qk[6], qk[7]);
            *(v2u*)(QKp + 32 * s + 8 * q0 + 4 * a) = w0; *(v2u*)(QKp + 32 * s + 8 * (q0 + 1) + 4 * a) = w1;
        }
        {
            const int i = tid >> 3, d0 = (tid & 7) * 16, s = d0 >> 5, a = (d0 >> 4) & 1; const float e = egS[i];
            bf16* Qd = (bf16*)(blk + CHK_QD) + i * 128;
#pragma unroll
            for (int q = 0; q < 4; ++q) { const LAS float* p = qs + i * 129 + d0 + 4 * q; v2u w; w.x = pk2(p[0] * e, p[1] * e); w.y = pk2(p[2] * e, p[3] * e); *(v2u*)(Qd + 32 * s + 8 * q + 4 * a) = w; }
        }
        {
            const int d = tid >> 2, c0 = (tid & 3) * 16, s = c0 >> 5, a = (c0 >> 4) & 1;
            bf16* Kd = (bf16*)(blk + CHK_KDT) + d * 64;
#pragma unroll
            for (int q = 0; q < 4; ++q) { const int c = c0 + 4 * q;
                v2u w; w.x = pk2(ks[c * 129 + d] * ekS[c], ks[(c + 1) * 129 + d] * ekS[c + 1]); w.y = pk2(ks[(c + 2) * 129 + d] * ekS[c + 2], ks[(c + 3) * 129 + d] * ekS[c + 3]);
                *(v2u*)(Kd + 32 * s + 8 * q + 4 * a) = w; }
        }
        __syncthreads();
        if (tid < 64) {
            for (int i = 0; i < 64; ++i) {
                float acc = (i == tid) ? 1.f : 0.f;
#pragma unroll 4
                for (int j = 0; j < i; ++j) acc -= As[i * 65 + j] * Ts[j * 65 + tid];
                Ts[i * 65 + tid] = acc;
            }
        }
        __syncthreads();
        {
            const int i = tid >> 3, c0 = (tid & 7) * 16;
            float aU[16], aW[16];
#pragma unroll
            for (int x = 0; x < 16; ++x) { aU[x] = 0.f; aW[x] = 0.f; }
            for (int j = 0; j <= i; ++j) {
                const float tb = Ts[i * 65 + j] * btS[j], tbe = tb * egS[j];
#pragma unroll
                for (int x = 0; x < 16; ++x) { aU[x] += tb * vs[j * 129 + c0 + x]; aW[x] += tbe * ks[j * 129 + c0 + x]; }
            }
            float* UT = (float*)(blk + CHK_UT);
#pragma unroll
            for (int x = 0; x < 16; ++x) UT[(c0 + x) * 64 + i] = aU[x];
            const int s = c0 >> 5, a = (c0 >> 4) & 1;
            bf16* Wp = (bf16*)(blk + CHK_WP) + i * 128;
#pragma unroll
            for (int q = 0; q < 4; ++q) { v2u w; w.x = pk2(aW[4 * q], aW[4 * q + 1]); w.y = pk2(aW[4 * q + 2], aW[4 * q + 3]); *(v2u*)(Wp + 32 * s + 8 * q + 4 * a) = w; }
        }
        __syncthreads();
    }
}

constexpr int SEQ_WGS = 16;
constexpr int SQ_WP = 0, SQ_QD = 16384, SQ_KDT = 32768, SQ_QK = 49152, SQ_BUF = 57344;
__device__ __forceinline__ bf16x8 packfrag(const f32x4 lo, const f32x4 hi) { v4u w; w.x = pg8::cvt_pk_bf16(lo[0], lo[1]); w.y = pg8::cvt_pk_bf16(lo[2], lo[3]); w.z = pg8::cvt_pk_bf16(hi[0], hi[1]); w.w = pg8::cvt_pk_bf16(hi[2], hi[3]); return __builtin_bit_cast(bf16x8, w); }
__device__ __forceinline__ void seq_stage(LAS unsigned char* buf, const unsigned char* blk, int lt) {
    v4u r[14];
#pragma unroll
    for (int i = 0; i < 14; ++i) r[i] = *(const v4u*)(blk + (size_t)(lt + 256 * i) * 16);
#pragma unroll
    for (int i = 0; i < 14; ++i) {
        const int id = lt + 256 * i; int dst;
        if (id < 2048) { const int rr = (id & 1023) >> 4, ch = id & 15; dst = (id & ~1023) * 16 + rr * 256 + 16 * (ch ^ (rr & 15)); }
        else { const int rr = (id - 2048) >> 3, ch = id & 7; dst = 32768 + rr * 128 + 16 * (ch ^ (rr & 7)); }
        *(LAS v4u*)(buf + dst) = r[i];
    }
}
__device__ __forceinline__ void p4_delta_seq(Frame& F, int sid) {
    const int lane = F.lane, wave = F.wave, tid = F.tid;
    const int bh = sid >> 1, half = sid & 1, b = bh >> 2, h = bh & 3;
    const int fr = lane & 15, fq = lane >> 4;
    const int v0 = half * 64 + (wave & 3) * 16;
    const unsigned char* cbase = F.ws + WS_CHK + (size_t)(bh * 128) * CHK_STRIDE;
    float* OD = WSP(float, WS_ODELTA);
    f32x4 Sacc[8];
#pragma unroll
    for (int T = 0; T < 8; ++T) Sacc[T] = (f32x4){0.f, 0.f, 0.f, 0.f};
    if (wave >= 4) seq_stage(F.lds, cbase, tid - 256);
    __syncthreads();
    for (int n = 0; n < 128; ++n) {
        LAS unsigned char* buf = F.lds + (n & 1) * SQ_BUF;
        if (wave >= 4) { if (n + 1 < 128) seq_stage(F.lds + ((n + 1) & 1) * SQ_BUF, cbase + (size_t)(n + 1) * CHK_STRIDE, tid - 256); }
        else {
            const unsigned char* blk = cbase + (size_t)n * CHK_STRIDE;
            const float gl = *(const float*)(blk + CHK_GL);
            const float* UT = (const float*)(blk + CHK_UT) + (size_t)(v0 + fr) * 64 + 4 * fq;
            f32x4 U[4];
#pragma unroll
            for (int tc = 0; tc < 4; ++tc) U[tc] = *(const f32x4*)(UT + 16 * tc);
            bf16x8 sf[4];
#pragma unroll
            for (int s = 0; s < 4; ++s) sf[s] = packfrag(Sacc[2 * s], Sacc[2 * s + 1]);
            f32x4 Vn[4], Oa[4];
#pragma unroll
            for (int tc = 0; tc < 4; ++tc) {
                const int rr = 16 * tc + fr; f32x4 av = (f32x4){0.f, 0.f, 0.f, 0.f}, ao = (f32x4){0.f, 0.f, 0.f, 0.f};
#pragma unroll
                for (int s = 0; s < 4; ++s) {
                    const int off = rr * 256 + 16 * ((4 * s + fq) ^ (rr & 15));
                    const bf16x8 wf = *(const LAS bf16x8*)(buf + SQ_WP + off), qf = *(const LAS bf16x8*)(buf + SQ_QD + off);
                    av = __builtin_amdgcn_mfma_f32_16x16x32_bf16(wf, sf[s], av, 0, 0, 0);
                    ao = __builtin_amdgcn_mfma_f32_16x16x32_bf16(qf, sf[s], ao, 0, 0, 0);
                }
                Vn[tc] = U[tc] - av; Oa[tc] = ao;
            }
            bf16x8 vf[2];
            vf[0] = packfrag(Vn[0], Vn[1]); vf[1] = packfrag(Vn[2], Vn[3]);
#pragma unroll
            for (int tc = 0; tc < 4; ++tc) {
                const int rr = 16 * tc + fr;
#pragma unroll
                for (int s = 0; s < 2; ++s) {
                    const bf16x8 kf = *(const LAS bf16x8*)(buf + SQ_QK + rr * 128 + 16 * ((4 * s + fq) ^ (rr & 7)));
                    Oa[tc] = __builtin_amdgcn_mfma_f32_16x16x32_bf16(kf, vf[s], Oa[tc], 0, 0, 0);
                }
                float* op = OD + (size_t)(b * SEQ + n * 64 + 16 * tc + 4 * fq) * 512 + h * 128 + v0 + fr;
#pragma unroll
                for (int j = 0; j < 4; ++j) op[(size_t)j * 512] = Oa[tc][j];
            }
#pragma unroll
            for (int T = 0; T < 8; ++T) {
                const int rr = 16 * T + fr; f32x4 a = Sacc[T] * gl;
#pragma unroll
                for (int s = 0; s < 2; ++s) {
                    const bf16x8 kf = *(const LAS bf16x8*)(buf + SQ_KDT + rr * 128 + 16 * ((4 * s + fq) ^ (rr & 7)));
                    a = __builtin_amdgcn_mfma_f32_16x16x32_bf16(kf, vf[s], a, 0, 0, 0);
                }
                Sacc[T] = a;
            }
        }
        __syncthreads();
    }
}

__device__ __forceinline__ void p4_indexer(Frame& F, int widx, int nw) {
    const int lane = F.lane, fr = lane & 15, fq = lane >> 4;
    const bf16* QL = WSP(bf16, WS_QL); const bf16* KI = WSP(bf16, WS_KIDX); const float* WI = WSP(float, WS_WIDX); float* SC = WSP(float, WS_BIG);
    for (int task = widx; task < 2 * 4352; task += nw) {
        const int b = task / 4352; int tau = task - b * 4352;
        int g = 0; while (16 * (g + 1) * (g + 2) <= tau) ++g;
        tau -= 16 * g * (g + 1);
        const int qt = 32 * g + tau / (g + 1), seg = tau % (g + 1);
        const int row0 = b * SEQ + 16 * qt;
        bf16x8 Qf[8][2];
#pragma unroll
        for (int hh = 0; hh < 8; ++hh)
#pragma unroll
            for (int s = 0; s < 2; ++s) Qf[hh][s] = *(const bf16x8*)(QL + (size_t)(row0 + fr) * 1536 + 1024 + hh * 64 + 32 * s + 8 * fq);
        f32x4 wv[4][2];
#pragma unroll
        for (int j = 0; j < 4; ++j) { wv[j][0] = *(const f32x4*)(WI + (size_t)(row0 + 4 * fq + j) * 8); wv[j][1] = *(const f32x4*)(WI + (size_t)(row0 + 4 * fq + j) * 8 + 4); }
        const int kt1 = (32 * seg + 31 < qt) ? 32 * seg + 31 : qt;
        for (int kt = 32 * seg; kt <= kt1; ++kt) {
            const bf16* kp = KI + (size_t)(b * SEQ + 16 * kt + fr) * 64 + 8 * fq;
            const bf16x8 k0 = *(const bf16x8*)kp, k1 = *(const bf16x8*)(kp + 32);
            f32x4 isc = (f32x4){0.f, 0.f, 0.f, 0.f};
#pragma unroll
            for (int hh = 0; hh < 8; ++hh) {
                f32x4 c = __builtin_amdgcn_mfma_f32_16x16x32_bf16(Qf[hh][0], k0, (f32x4){0.f, 0.f, 0.f, 0.f}, 0, 0, 0);
                c = __builtin_amdgcn_mfma_f32_16x16x32_bf16(Qf[hh][1], k1, c, 0, 0, 0);
#pragma unroll
                for (int j = 0; j < 4; ++j) isc[j] += fmaxf(c[j], 0.f) * wv[j][hh >> 2][hh & 3];
            }
            float* sp = SC + (size_t)(row0 + 4 * fq) * 8192 + 16 * kt + fr;
#pragma unroll
            for (int j = 0; j < 4; ++j) sp[(size_t)j * 8192] = isc[j];
        }
    }
}

__device__ __forceinline__ void p5_topk(Frame& F) {
    const int lane = F.lane, gw = F.bid * NWAVES + F.wave, NGW = F.G * NWAVES;
    const float* SC = WSP(float, WS_BIG); int* SEL = WSP(int, WS_SEL); int* NSEL = WSP(int, WS_NSEL);
    for (int rix = gw; rix < M; rix += NGW) {
        const int row = ((rix & 1) ? (M - 1 - (rix >> 1)) : (rix >> 1));
        const int pos = row & (SEQ - 1), n = pos + 1;
        int* sel = SEL + (size_t)row * 256;
        if (n <= 256) {
#pragma unroll
            for (int i = 0; i < 4; ++i) { const int j = 64 * i + lane; sel[j] = (j < n) ? j : 0; }
            if (lane == 0) NSEL[row] = n;
            continue;
        }
        const int nblk = (n + 1023) >> 10;
        const float* sr = SC + (size_t)row * 8192;
        unsigned u[128];
#pragma unroll
        for (int bk = 0; bk < 8; ++bk) {
            if (bk < nblk) {
#pragma unroll
                for (int i = 0; i < 16; ++i) { const int idx = (bk * 16 + i) * 64 + lane; unsigned x = 0u;
                    if (idx < n) { const unsigned bits = __float_as_uint(sr[idx]); x = (bits & 0x80000000u) ? ~bits : (bits | 0x80000000u); }
                    u[bk * 16 + i] = x; }
            } else {
#pragma unroll
                for (int i = 0; i < 16; ++i) u[bk * 16 + i] = 0u;
            }
        }
        unsigned T = 0u;
        for (int bit = 31; bit >= 0; --bit) {
            const unsigned cand = T | (1u << bit); int c = 0;
#pragma unroll
            for (int bk = 0; bk < 8; ++bk) {
                if (bk < nblk) {
#pragma unroll
                    for (int i = 0; i < 16; ++i) c += (u[bk * 16 + i] >= cand) ? 1 : 0;
                }
            }
            c = wave_sum_i(c);
            if (c >= 256) T = cand;
        }
        int cgt = 0;
#pragma unroll
        for (int bk = 0; bk < 8; ++bk) {
            if (bk < nblk) {
#pragma unroll
                for (int i = 0; i < 16; ++i) cgt += (u[bk * 16 + i] > T) ? 1 : 0;
            }
        }
        cgt = wave_sum_i(cgt);
        const int need_eq = 256 - cgt;
        int running = 0, eq_taken = 0;
        const unsigned long long ltmask = (1ull << lane) - 1ull;
#pragma unroll
        for (int bk = 0; bk < 8; ++bk) {
            if (bk < nblk) {
#pragma unroll
                for (int i = 0; i < 16; ++i) {
                    const unsigned x = u[bk * 16 + i];
                    const bool gt = x > T, eq = x == T;
                    const unsigned long long meq = __ballot(eq);
                    const bool take = gt || (eq && (eq_taken + __popcll(meq & ltmask)) < need_eq);
                    const unsigned long long mt = __ballot(take);
                    if (take) sel[running + __popcll(mt & ltmask)] = (bk * 16 + i) * 64 + lane;
                    running += __popcll(mt); eq_taken += __popcll(meq);
                }
            }
        }
        if (lane == 0) NSEL[row] = 256;
    }
}

__device__ __forceinline__ void p6_sparse_attn(Frame& F) {
    const int lane = F.lane, gw = F.bid * NWAVES + F.wave, NGW = F.G * NWAVES;
    LAS float* ql = (LAS float*)(F.lds + F.wave * 12288);
    LAS float* pp = ql + 1024;
    const bf16* QL = WSP(bf16, WS_QL); const bf16* CKV = WSP(bf16, WS_CKV); const int* SEL = WSP(int, WS_SEL); const int* NSEL = WSP(int, WS_NSEL); bf16* AO = WSP(bf16, WS_AO);
    for (int row = gw; row < M; row += NGW) {
        const int b = row >> 13, n = NSEL[row];
        const int* sel = SEL + (size_t)row * 256;
        {
            float f[8];
            unpack8(*(const v4u*)(QL + (size_t)row * 1536 + 8 * lane), f);
#pragma unroll
            for (int x = 0; x < 8; ++x) ql[8 * lane + x] = f[x];
            unpack8(*(const v4u*)(QL + (size_t)row * 1536 + 512 + 8 * lane), f);
#pragma unroll
            for (int x = 0; x < 8; ++x) ql[512 + 8 * lane + x] = f[x];
        }
        float s[4][8];
#pragma unroll
        for (int kb = 0; kb < 4; ++kb) {
            const int j = 64 * kb + lane; const bool valid = j < n; const int key = valid ? sel[j] : 0;
            const bf16* kr = CKV + (size_t)(b * SEQ + key) * 128;
#pragma unroll
            for (int hh = 0; hh < 8; ++hh) s[kb][hh] = 0.f;
#pragma unroll 4
            for (int r8 = 0; r8 < 16; ++r8) {
                float x[8]; unpack8(*(const v4u*)(kr + 8 * r8), x);
#pragma unroll
                for (int hh = 0; hh < 8; ++hh) { const f32x4 q0 = *(const LAS f32x4*)(ql + hh * 128 + 8 * r8), q1 = *(const LAS f32x4*)(ql + hh * 128 + 8 * r8 + 4);
                    s[kb][hh] += x[0] * q0[0] + x[1] * q0[1] + x[2] * q0[2] + x[3] * q0[3] + x[4] * q1[0] + x[5] * q1[1] + x[6] * q1[2] + x[7] * q1[3]; }
            }
            if (!valid) {
#pragma unroll
                for (int hh = 0; hh < 8; ++hh) s[kb][hh] = -INFINITY;
            }
        }
#pragma unroll
        for (int hh = 0; hh < 8; ++hh) {
            const float mx = wave_max(fmaxf(fmaxf(s[0][hh], s[1][hh]), fmaxf(s[2][hh], s[3][hh])));
            float e[4], l = 0.f;
#pragma unroll
            for (int kb = 0; kb < 4; ++kb) { e[kb] = __expf(s[kb][hh] - mx); l += e[kb]; }
            const float inv = 1.0f / wave_sum(l);
#pragma unroll
            for (int kb = 0; kb < 4; ++kb) pp[(64 * kb + lane) * 8 + hh] = e[kb] * inv;
        }
        float o[8][2];
#pragma unroll
        for (int hh = 0; hh < 8; ++hh) { o[hh][0] = 0.f; o[hh][1] = 0.f; }
        for (int j = 0; j < n; ++j) {
            const int key = sel[j];
            const unsigned kv = *(const unsigned*)(CKV + (size_t)(b * SEQ + key) * 128 + 2 * lane);
            const float lo = bflo(kv), hi = bfhi(kv);
            const f32x4 p0 = *(const LAS f32x4*)(pp + j * 8), p1 = *(const LAS f32x4*)(pp + j * 8 + 4);
#pragma unroll
            for (int hh = 0; hh < 4; ++hh) { o[hh][0] += p0[hh] * lo; o[hh][1] += p0[hh] * hi; o[4 + hh][0] += p1[hh] * lo; o[4 + hh][1] += p1[hh] * hi; }
        }
#pragma unroll
        for (int hh = 0; hh < 8; ++hh) *(unsigned*)(AO + (size_t)row * 1536 + hh * 128 + 2 * lane) = pk2(o[hh][0], o[hh][1]);
    }
}
__device__ __forceinline__ void p6_gdn_out(Frame& F, KArgs A) {
    const int lane = F.lane, gw = F.bid * NWAVES + F.wave, NGW = F.G * NWAVES;
    const f32x4 g0 = *(const f32x4*)(A->in[I_AB_ONG] + 8 * (lane & 15)), g1 = *(const f32x4*)(A->in[I_AB_ONG] + 8 * (lane & 15) + 4);
    for (int row = gw; row < M; row += NGW) {
        const float* op = WSP(float, WS_ODELTA) + (size_t)row * 512 + 8 * lane;
        const f32x4 a = *(const f32x4*)op, b = *(const f32x4*)(op + 4);
        float ss = a[0] * a[0] + a[1] * a[1] + a[2] * a[2] + a[3] * a[3] + b[0] * b[0] + b[1] * b[1] + b[2] * b[2] + b[3] * b[3];
        ss += __shfl_xor(ss, 1); ss += __shfl_xor(ss, 2); ss += __shfl_xor(ss, 4); ss += __shfl_xor(ss, 8);
        const float r = rsqrtf(ss * (1.0f / 128.0f) + 1e-6f);
        float z[8]; unpack8(*(const v4u*)(WSP(bf16, WS_QKVZ) + (size_t)row * 2048 + 1536 + 8 * lane), z);
        float o[8];
#pragma unroll
        for (int i = 0; i < 4; ++i) { o[i] = a[i] * r * g0[i] * siluf(z[i]); o[4 + i] = b[i] * r * g1[i] * siluf(z[4 + i]); }
        *(v4u*)(WSP(bf16, WS_AO) + (size_t)row * 1536 + 1024 + 8 * lane) = pack8f(o);
    }
}

__device__ __forceinline__ void p8_ln_router(Frame& F, KArgs A, int l, float* HOUT, bf16* HB) {
    const int lane = F.lane, tid = F.tid, gw = F.bid * NWAVES + F.wave, NGW = F.G * NWAVES;
    LAS float* wT = (LAS float*)(F.lds);
    LAS float* lg = (LAS float*)(F.lds + WSCR_OFF + F.wave * WSCR_BYTES);
    const float* rw = A->in[I_RW] + (size_t)l * 1024 * 32;
    for (int i = tid; i < 1024 * 32; i += NTHREADS) { const int k = i >> 5, e = i & 31; wT[e * 1028 + k] = rw[i]; }
    __syncthreads();
    const float* PRE = WSP(float, WS_PRE);
    const float* lg_g = A->in[I_LNM_G] + (size_t)l * 1024; const float* lg_b = A->in[I_LNM_B] + (size_t)l * 1024;
    const float rb = A->in[I_RB][l * 32 + (lane & 31)];
    int* TOKE = WSP(int, WS_ROUTE); int* TOKPOS = TOKE + M * 4; float* TOKG = (float*)(TOKPOS + M * 4);
    gu32* cnt = F.ctl + CW_CNT + 64 * l;
    for (int row = gw; row < M; row += NGW) {
        f32x4 v[4]; float s = 0.f;
#pragma unroll
        for (int j = 0; j < 4; ++j) { v[j] = *(const f32x4*)(PRE + (size_t)row * 1024 + 256 * j + 4 * lane); s += (v[j][0] + v[j][1]) + (v[j][2] + v[j][3]); }
        const float mean = wave_sum(s) * (1.0f / 1024.0f); float s2 = 0.f;
#pragma unroll
        for (int j = 0; j < 4; ++j) { v[j] = v[j] - mean; s2 += (v[j][0] * v[j][0] + v[j][1] * v[j][1]) + (v[j][2] * v[j][2] + v[j][3] * v[j][3]); }
        const float rstd = rsqrtf(wave_sum(s2) * (1.0f / 1024.0f) + 1e-5f);
#pragma unroll
        for (int j = 0; j < 4; ++j) {
            const f32x4 g = *(const f32x4*)(lg_g + 256 * j + 4 * lane), bb = *(const f32x4*)(lg_b + 256 * j + 4 * lane);
            v[j] = v[j] * rstd * g + bb;
            *(f32x4*)(HOUT + (size_t)row * 1024 + 256 * j + 4 * lane) = v[j];
            v2u o; o.x = pk2(v[j][0], v[j][1]); o.y = pk2(v[j][2], v[j][3]); *(v2u*)(HB + (size_t)row * 1024 + 256 * j + 4 * lane) = o;
        }
        float part[32];
#pragma unroll
        for (int e = 0; e < 32; ++e) {
            float a = 0.f;
#pragma unroll
            for (int j = 0; j < 4; ++j) { const f32x4 w = *(const LAS f32x4*)(wT + e * 1028 + 256 * j + 4 * lane); a += v[j][0] * w[0] + v[j][1] * w[1] + v[j][2] * w[2] + v[j][3] * w[3]; }
            part[e] = a;
        }
#pragma unroll
        for (int i = 0; i < 16; ++i) { const bool up = (lane & 32) != 0; const float keep = up ? part[i + 16] : part[i], send = up ? part[i] : part[i + 16]; part[i] = keep + __shfl_xor(send, 32); }
#pragma unroll
        for (int i = 0; i < 8; ++i) { const bool up = (lane & 16) != 0; const float keep = up ? part[i + 8] : part[i], send = up ? part[i] : part[i + 8]; part[i] = keep + __shfl_xor(send, 16); }
#pragma unroll
        for (int i = 0; i < 4; ++i) { const bool up = (lane & 8) != 0; const float keep = up ? part[i + 4] : part[i], send = up ? part[i] : part[i + 4]; part[i] = keep + __shfl_xor(send, 8); }
#pragma unroll
        for (int i = 0; i < 2; ++i) { const bool up = (lane & 4) != 0; const float keep = up ? part[i + 2] : part[i], send = up ? part[i] : part[i + 2]; part[i] = keep + __shfl_xor(send, 4); }
        { const bool up = (lane & 2) != 0; const float keep = up ? part[1] : part[0], send = up ? part[0] : part[1]; part[0] = keep + __shfl_xor(send, 2); }
        part[0] += __shfl_xor(part[0], 1);
        const int eidx = ((lane >> 5) & 1) * 16 + ((lane >> 4) & 1) * 8 + ((lane >> 3) & 1) * 4 + ((lane >> 2) & 1) * 2 + ((lane >> 1) & 1);
        if ((lane & 1) == 0) lg[eidx] = part[0];
        float val = (lane < 32) ? lg[lane & 31] + rb : -INFINITY;
        float tl[4]; int te[4];
#pragma unroll
        for (int k = 0; k < 4; ++k) {
            const float mx = wave_max(val);
            const unsigned long long mm = __ballot(val == mx && lane < 32);
            const int idx = __ffsll((long long)mm) - 1;
            tl[k] = mx; te[k] = idx;
            if (lane == idx) val = -INFINITY;
        }
        const float e1 = __expf(tl[1] - tl[0]), e2 = __expf(tl[2] - tl[0]), e3 = __expf(tl[3] - tl[0]);
        const float inv = 1.0f / (1.0f + e1 + e2 + e3);
        if (lane < 4) {
            const int e = lane == 0 ? te[0] : (lane == 1 ? te[1] : (lane == 2 ? te[2] : te[3]));
            const float g = (lane == 0 ? 1.0f : (lane == 1 ? e1 : (lane == 2 ? e2 : e3))) * inv;
            const unsigned pos = __hip_atomic_fetch_add(cnt + e, 1u, RLX_AGENT);
            TOKE[(size_t)row * 4 + lane] = e; TOKPOS[(size_t)row * 4 + lane] = (int)pos; TOKG[(size_t)row * 4 + lane] = g;
        }
    }
}

__device__ __forceinline__ void p9_scatter(Frame& F, int l, const bf16* HB) {
    const int lane = F.lane, tid = F.tid, gw = F.bid * NWAVES + F.wave, NGW = F.G * NWAVES;
    LAS int* base = (LAS int*)(F.lds + MISC_OFF + 256);
    int* TOKE = WSP(int, WS_ROUTE); int* TOKPOS = TOKE + M * 4; int* TILE = TOKE + 3 * M * 4;
    if (tid == 0) {
        int acc = 0;
        for (int e = 0; e < NEXP; ++e) { const int c = (int)__hip_atomic_load(F.ctl + CW_CNT + 64 * l + e, RLX_AGENT); base[e] = acc; acc += ((c + 255) >> 8) << 8; }
        base[32] = acc >> 8;
    }
    __syncthreads();
    if (F.bid == 0 && tid < 64) {
        const int nT = base[32];
        for (int t = tid; t < NTMAX; t += 64) { int e = 0;
            for (int x = 1; x < NEXP; ++x) if (base[x] <= t * 256) e = x;
            TILE[t] = (t < nT) ? e : 0; }
        if (tid == 0) TILE[NTMAX] = nT;
    }
    bf16* XS = WSP(bf16, WS_XS);
    for (int row = gw; row < M; row += NGW) {
        const v4u a = *(const v4u*)(HB + (size_t)row * 1024 + 8 * lane), b = *(const v4u*)(HB + (size_t)row * 1024 + 512 + 8 * lane);
#pragma unroll
        for (int k = 0; k < 4; ++k) {
            const int slot = base[TOKE[(size_t)row * 4 + k]] + TOKPOS[(size_t)row * 4 + k];
            *(v4u*)(XS + (size_t)slot * 1024 + 8 * lane) = a; *(v4u*)(XS + (size_t)slot * 1024 + 512 + 8 * lane) = b;
        }
    }
}

__device__ __forceinline__ void p12_combine(Frame& F, KArgs A, int l, const float* HIN, float* HOUT, bf16* HB) {
    const int lane = F.lane, tid = F.tid, gw = F.bid * NWAVES + F.wave, NGW = F.G * NWAVES;
    LAS int* base = (LAS int*)(F.lds + MISC_OFF + 256);
    if (tid == 0) { int acc = 0; for (int e = 0; e < NEXP; ++e) { const int c = (int)__hip_atomic_load(F.ctl + CW_CNT + 64 * l + e, RLX_AGENT); base[e] = acc; acc += ((c + 255) >> 8) << 8; } }
    __syncthreads();
    const int* TOKE = WSP(int, WS_ROUTE); const int* TOKPOS = TOKE + M * 4; const float* TOKG = (const float*)(TOKPOS + M * 4);
    const bf16* YS = WSP(bf16, WS_YS); const bf16* PLE = WSP(bf16, WS_PLE);
    const float* lg_g = A->in[I_LNF_G] + (size_t)l * 1024; const float* lg_b = A->in[I_LNF_B] + (size_t)l * 1024;
    for (int row = gw; row < M; row += NGW) {
        float x[16];
        {   const f32x4 h0 = *(const f32x4*)(HIN + (size_t)row * 1024 + 8 * lane), h1 = *(const f32x4*)(HIN + (size_t)row * 1024 + 8 * lane + 4);
            const f32x4 h2 = *(const f32x4*)(HIN + (size_t)row * 1024 + 512 + 8 * lane), h3 = *(const f32x4*)(HIN + (size_t)row * 1024 + 512 + 8 * lane + 4);
            float p0[8], p1[8]; unpack8(*(const v4u*)(PLE + (size_t)row * 1024 + 8 * lane), p0); unpack8(*(const v4u*)(PLE + (size_t)row * 1024 + 512 + 8 * lane), p1);
#pragma unroll
            for (int i = 0; i < 4; ++i) { x[i] = ALPHA * h0[i] + p0[i]; x[4 + i] = ALPHA * h1[i] + p0[4 + i]; x[8 + i] = ALPHA * h2[i] + p1[i]; x[12 + i] = ALPHA * h3[i] + p1[4 + i]; }
        }
#pragma unroll
        for (int k = 0; k < 4; ++k) {
            const int slot = base[TOKE[(size_t)row * 4 + k]] + TOKPOS[(size_t)row * 4 + k]; const float g = TOKG[(size_t)row * 4 + k];
            float y0[8], y1[8]; unpack8(*(const v4u*)(YS + (size_t)slot * 1024 + 8 * lane), y0); unpack8(*(const v4u*)(YS + (size_t)slot * 1024 + 512 + 8 * lane), y1);
#pragma unroll
            for (int i = 0; i < 8; ++i) { x[i] += g * y0[i]; x[8 + i] += g * y1[i]; }
        }
        float s = 0.f;
#pragma unroll
        for (int i = 0; i < 16; ++i) s += x[i];
        const float mean = wave_sum(s) * (1.0f / 1024.0f); float s2 = 0.f;
#pragma unroll
        for (int i = 0; i < 16; ++i) { x[i] -= mean; s2 += x[i] * x[i]; }
        const float rstd = rsqrtf(wave_sum(s2) * (1.0f / 1024.0f) + 1e-5f);
#pragma unroll
        for (int hf = 0; hf < 2; ++hf) {
            const int c0 = 512 * hf + 8 * lane;
            const f32x4 g0 = *(const f32x4*)(lg_g + c0), g1 = *(const f32x4*)(lg_g + c0 + 4), b0 = *(const f32x4*)(lg_b + c0), b1 = *(const f32x4*)(lg_b + c0 + 4);
            f32x4 o0, o1;
#pragma unroll
            for (int i = 0; i < 4; ++i) { o0[i] = x[8 * hf + i] * rstd * g0[i] + b0[i]; o1[i] = x[8 * hf + 4 + i] * rstd * g1[i] + b1[i]; }
            *(f32x4*)(HOUT + (size_t)row * 1024 + c0) = o0; *(f32x4*)(HOUT + (size_t)row * 1024 + c0 + 4) = o1;
            if (HB) { v4u w; w.x = pk2(o0[0], o0[1]); w.y = pk2(o0[2], o0[3]); w.z = pk2(o1[0], o1[1]); w.w = pk2(o1[2], o1[3]); *(v4u*)(HB + (size_t)row * 1024 + c0) = w; }
        }
    }
}

__device__ __forceinline__ void p14_dilated(Frame& F) {
    const int lane = F.lane, gw = F.bid * NWAVES + F.wave, NGW = F.G * NWAVES;
    LAS float* pe = (LAS float*)(F.lds + F.wave * 2048);
    const bf16* QK = WSP(bf16, WS_QKVZ); bf16* AO = WSP(bf16, WS_AO);
    for (int task = gw; task < M * 12; task += NGW) {
        const int row = task / 12, hh = task - row * 12, b = row >> 13, pos = row & (SEQ - 1);
        float q[64];
#pragma unroll
        for (int c = 0; c < 8; ++c) { float f[8]; unpack8(*(const v4u*)(QK + (size_t)row * 2560 + hh * 64 + 8 * c), f);
#pragma unroll
            for (int x = 0; x < 8; ++x) q[8 * c + x] = f[x]; }
        float s[7];
#pragma unroll
        for (int i = 0; i < 7; ++i) {
            const int e = lane + 64 * i, p = e / 129, m = e - p * 129;
            const int dd = (p == 0) ? 1 : (p == 1 ? 4 : 16);
            const int kpos = pos - m * dd; const bool valid = (e < 387) && (kpos >= 0);
            float a = -INFINITY;
            if (valid) {
                const bf16* kr = QK + (size_t)(b * SEQ + kpos) * 2560 + 768 + hh * 64; a = 0.f;
#pragma unroll
                for (int c = 0; c < 8; ++c) { float f[8]; unpack8(*(const v4u*)(kr + 8 * c), f);
#pragma unroll
                    for (int x = 0; x < 8; ++x) a += q[8 * c + x] * f[x]; }
                a *= 0.125f;
            }
            s[i] = a;
        }
        float mx = s[0];
#pragma unroll
        for (int i = 1; i < 7; ++i) mx = fmaxf(mx, s[i]);
        mx = wave_max(mx);
        float l = 0.f;
#pragma unroll
        for (int i = 0; i < 7; ++i) { const float ev = __expf(s[i] - mx); pe[lane + 64 * i] = ev; l += ev; }
        l = wave_sum(l);
        float o = 0.f;
#pragma unroll
        for (int p = 0; p < 3; ++p) {
            const int dd = (p == 0) ? 1 : (p == 1 ? 4 : 16);
            int mmax = pos / dd; if (mmax > 128) mmax = 128;
            const bf16* vb = QK + (size_t)(b * SEQ + pos) * 2560 + 1536 + hh * 64 + lane;
            for (int m = 0; m <= mmax; ++m) o += pe[p * 129 + m] * bf1(vb[-(ptrdiff_t)m * dd * 2560]);
        }
        AO[(size_t)row * 1024 + hh * 64 + lane] = (bf16)f2bf(o / l);
    }
}
__device__ __forceinline__ void p14_pool(Frame& F, KArgs A) {
    const int lane = F.lane, tid = F.tid, gw = F.bid * NWAVES + F.wave, NGW = F.G * NWAVES;
    LAS float* pw = (LAS float*)(F.lds + 16384);
    LAS float* dl = (LAS float*)(F.lds + 16384 + 65536 + F.wave * 1024);
    for (int i = tid; i < 4 * 64 * 64; i += NTHREADS) pw[i] = A->in[I_CD_POOLW][i];
    __syncthreads();
    const bf16* QK = WSP(bf16, WS_QKVZ); bf16* AO = WSP(bf16, WS_AO);
    const int gi = lane >> 4, w = 2 << gi;
    float sc[4];
#pragma unroll
    for (int g = 0; g < 4; ++g) sc[g] = A->in[I_CD_POOLS][g * 64 + lane];
    for (int row = gw; row < M; row += NGW) {
        const int pos = row & (SEQ - 1);
        const int cntw = (pos + 1 < w) ? pos + 1 : w;
        float sum[4] = {0.f, 0.f, 0.f, 0.f}, cur[4] = {0.f, 0.f, 0.f, 0.f};
        for (int j = 0; j < cntw; ++j) {
            const v2u xr = *(const v2u*)(QK + (size_t)(row - j) * 2560 + 2304 + 4 * lane);
            const float f0 = bflo(xr.x), f1 = bfhi(xr.x), f2 = bflo(xr.y), f3 = bfhi(xr.y);
            sum[0] += f0; sum[1] += f1; sum[2] += f2; sum[3] += f3;
            if (j == 0) { cur[0] = f0; cur[1] = f1; cur[2] = f2; cur[3] = f3; }
        }
        const float inv = 1.0f / (float)cntw;
#pragma unroll
        for (int i = 0; i < 4; ++i) dl[4 * lane + i] = sum[i] * inv - cur[i];
        float o[4] = {0.f, 0.f, 0.f, 0.f};
        for (int c = 0; c < 64; ++c) {
#pragma unroll
            for (int g = 0; g < 4; ++g) o[g] += dl[g * 64 + c] * pw[(g * 64 + c) * 64 + lane];
        }
#pragma unroll
        for (int g = 0; g < 4; ++g) AO[(size_t)row * 1024 + 768 + g * 64 + lane] = (bf16)f2bf(o[g] * sc[g]);
    }
}


#define IN(k) (lo <= (k) && (k) < hi)
#define SEAM(k) do { if (IN(k) && IN((k) + 1)) xcd_barrier(bar); } while (0)
template <int l> __device__ __forceinline__ void layer_tail(Frame& F, const XcdBarrier& bar, const int lo, const int hi) {
    LAS unsigned char* ring = F.lds + RING_OFF;
    const int bid = F.bid, G = F.G;
        const int pb = 8 * l;

        if (IN(7 + pb)) {
            pg8::Gemm g{WSP(bf16, WS_AO), (l == 0) ? WSP(bf16, WS_W_OUTAB) : WSP(bf16, WS_W_OUTCD), M, 1024, (l == 0) ? 1536 : 1024}; pg8::StaticOrder S; S.init(M, 1024, G, bid);
            pg8::Epi<pg8::StPre> E{{(l == 0) ? kargs()->in[I_X] : WSP(float, WS_H2), WSP(float, WS_PRE), ALPHA}};
            pg8::gemm_phase<pg8::Epi<pg8::StPre>, pg8::StaticOrder, true, true>(ring, g, S, E);
        } SEAM(7 + pb);
        if (IN(8 + pb)) { p8_ln_router(F, kargs(), l, WSP(float, WS_H1), WSP(bf16, WS_H1B)); } SEAM(8 + pb);
        if (IN(9 + pb)) {
            p9_scatter(F, l, WSP(bf16, WS_H1B));
            __syncthreads();
            pg8::Gemm g{WSP(bf16, WS_H1B), WSP(bf16, WS_W_PG) + (size_t)l * 1024 * 1024, M, 1024, 1024}; pg8::StaticOrder S; S.init(M, 1024, G, bid);
            pg8::Epi<pg8::StPleGate> E{{WSP(bf16, WS_PP) + (size_t)l * M * 1024, WSP(bf16, WS_PLE)}};
            pg8::gemm_phase<pg8::Epi<pg8::StPleGate>, pg8::StaticOrder, true, true>(ring, g, S, E);
        } SEAM(9 + pb);
        const int* TILE = WSP(int, WS_ROUTE) + 3 * M * 4;
        if (IN(10 + pb)) {
            const int nT = __builtin_amdgcn_readfirstlane(TILE[NTMAX]);
            pg8::Gemm g{WSP(bf16, WS_XS), WSP(bf16, WS_W_GU) + (size_t)l * NEXP * 2048 * 1024, PMAX, 2048, 1024};
            pg8::MoeOrder S{TILE, nT, 8, G, bid, (long)2048 * 1024 * 2};
            pg8::Epi<pg8::StSwiglu> E{{kargs()->in[I_BGU] + (size_t)l * NEXP * 2048, WSP(bf16, WS_HID)}};
            pg8::gemm_phase<pg8::Epi<pg8::StSwiglu>, pg8::MoeOrder, true, true>(ring, g, S, E);
        } SEAM(10 + pb);
        if (IN(11 + pb)) {
            const int nT = __builtin_amdgcn_readfirstlane(TILE[NTMAX]);
            pg8::Gemm g{WSP(bf16, WS_HID), WSP(bf16, WS_W_DN) + (size_t)l * NEXP * 1024 * 1024, PMAX, 1024, 1024};
            pg8::MoeOrder S{TILE, nT, 4, G, bid, (long)1024 * 1024 * 2};
            pg8::Epi<pg8::StDown> E{{kargs()->in[I_BDN] + (size_t)l * NEXP * 1024, WSP(bf16, WS_YS)}};
            pg8::gemm_phase<pg8::Epi<pg8::StDown>, pg8::MoeOrder, true, true>(ring, g, S, E);
        } SEAM(11 + pb);
        if (IN(12 + pb)) { p12_combine(F, kargs(), l, WSP(float, WS_H1), (l == 0) ? WSP(float, WS_H2) : kargs()->out, (l == 0) ? WSP(bf16, WS_XB) : (bf16*)nullptr); }
}
#undef IN
#undef SEAM
__global__ void __launch_bounds__(NTHREADS, 2) mk_fwd(Args args_by_value) {
    const KArgs KA = kargs();
    extern __shared__ __attribute__((aligned(16))) unsigned char lds[];
    Frame F;
    F.lds = (LAS unsigned char*)lds;
    F.tid = threadIdx.x; F.lane = F.tid & 63; F.wave = __builtin_amdgcn_readfirstlane(F.tid >> 6);
    F.G = gridDim.x; F.bid = blockIdx.x; F.ws = KA->ws; F.ctl = (gu32*)(KA->ws + WS_CTL);
    volatile LAS unsigned* MISC = (volatile LAS unsigned*)(F.lds + MISC_OFF);
    { int t0 = threadIdx.x; asm volatile("" : "+v"(t0)); for (int u = t0; u < (LDS_BYTES - MISC_OFF) / 4; u += NTHREADS) MISC[u] = 0u; }
    __syncthreads();
    const bool use_bar = (N_LAUNCHES != NPHASES);
    XcdBarrier bar; bar.bar = (unsigned*)(F.ctl + CW_BAR) + KA->li * XCD_BAR_WORDS; bar.x = 0; bar.st = nullptr;
    if (use_bar) bar = xcd_barrier_post((unsigned*)(F.ctl + CW_BAR) + KA->li * XCD_BAR_WORDS, MISC + 8);
    const int lo = KA->ph_lo, hi = KA->ph_hi;
#define IN(k) (lo <= (k) && (k) < hi)
#define SEAM(k) do { if (IN(k) && IN((k) + 1)) xcd_barrier(bar); } while (0)
    LAS unsigned char* ring = F.lds + RING_OFF;
    const int bid = F.bid, G = F.G;

    if (IN(0)) { p0_prologue(F, kargs()); } SEAM(0);

            if (IN(1)) {
                { pg8::Gemm g{WSP(bf16, WS_XB), WSP(bf16, WS_W_INAB), M, 2560, 1024}; pg8::StaticOrder S; S.init(M, 2560, G, bid);
                  pg8::Epi<pg8::StInAB> E{{WSP(float, WS_SM), WSP(bf16, WS_QKVZ)}};
                  pg8::gemm_phase<pg8::Epi<pg8::StInAB>, pg8::StaticOrder, true, true>(ring, g, S, E); }
                __syncthreads();
                { pg8::Gemm g{WSP(bf16, WS_PB), WSP(bf16, WS_W_PP), 2 * M, 1024, 256}; pg8::BatchOrder S{4, (2 * M / 256) * 4, G, bid, M / 256, (long)1024 * 256 * 2};
                  pg8::Epi<pg8::StBf16> E{{WSP(bf16, WS_PP), 1024}};
                  pg8::gemm_phase<pg8::Epi<pg8::StBf16>, pg8::BatchOrder, true, true>(ring, g, S, E); }
            } SEAM(1);
            if (IN(2)) { p2_prep(F, kargs()); } SEAM(2);
            if (IN(3)) {
                { pg8::Gemm g{WSP(bf16, WS_CQ), WSP(bf16, WS_W_ABS), M, 1536, 256}; pg8::StaticOrder S; S.init(M, 1536, G, bid);
                  pg8::Epi<pg8::StBf16> E{{WSP(bf16, WS_QL), 1536}};
                  pg8::gemm_phase<pg8::Epi<pg8::StBf16>, pg8::StaticOrder, true, true>(ring, g, S, E); }
                __syncthreads();
                p3_chunk_prep(F, kargs());
            } SEAM(3);
            if (IN(4)) {
                if (bid < SEQ_WGS && G > SEQ_WGS) p4_delta_seq(F, bid);
                else p4_indexer(F, (bid - SEQ_WGS) * NWAVES + F.wave, (G - SEQ_WGS) * NWAVES);
            } SEAM(4);
            if (IN(5)) { p5_topk(F); } SEAM(5);
            if (IN(6)) { p6_sparse_attn(F); p6_gdn_out(F, kargs()); } SEAM(6);
    layer_tail<0>(F, bar, lo, hi);
    SEAM(12);
            if (IN(13)) {
                pg8::Gemm g{WSP(bf16, WS_XB), WSP(bf16, WS_W_INCD), M, 2560, 1024}; pg8::StaticOrder S; S.init(M, 2560, G, bid);
                pg8::Epi<pg8::StBf16> E{{WSP(bf16, WS_QKVZ), 2560}};
                pg8::gemm_phase<pg8::Epi<pg8::StBf16>, pg8::StaticOrder, true, true>(ring, g, S, E);
            } SEAM(13);
            if (IN(14)) { p14_dilated(F); p14_pool(F, kargs()); } SEAM(14);
    layer_tail<1>(F, bar, lo, hi);
#undef IN
#undef SEAM
}

extern "C" void kernel_launch(void* const* d_in, const int* in_sizes, int n_in, void* d_out, int out_size, void* d_ws, size_t ws_size, hipStream_t stream) {
    static int grid = 0;
    if (grid == 0) {
        if (n_in != N_IN || in_sizes[0] != M * D || out_size != M * D || ws_size < WS_END) {
            fprintf(stderr, "kernel_launch: built for %d inputs, x/out of %d floats, >= %zu bytes of workspace; got n_in %d, in0 %d, out %d, ws %zu; nothing launched\n", N_IN, M * D, (size_t)WS_END, n_in, n_in > 0 ? in_sizes[0] : -1, out_size, ws_size);
            grid = -1; return; }
        int dev = 0, cus = 0, per_cu = 0;
        if (hipGetDevice(&dev) != hipSuccess || hipDeviceGetAttribute(&cus, hipDeviceAttributeMultiprocessorCount, dev) != hipSuccess) { fprintf(stderr, "kernel_launch: device query failed\n"); grid = -1; return; }
        if (hipFuncSetAttribute((const void*)mk_fwd, hipFuncAttributeMaxDynamicSharedMemorySize, LDS_BYTES) != hipSuccess) { fprintf(stderr, "kernel_launch: hipFuncSetAttribute failed\n"); grid = -1; return; }
        if (hipOccupancyMaxActiveBlocksPerMultiprocessor(&per_cu, (const void*)mk_fwd, NTHREADS, LDS_BYTES) != hipSuccess || per_cu < 1)
            fprintf(stderr, "kernel_launch: note: occupancy query reports %d workgroups per CU\n", per_cu);
        (void)hipGetLastError();
        grid = cus;
    }
    if (grid < 0) return;
    if (hipMemsetAsync((char*)d_ws + WS_CTL, 0, CTL_ZERO_BYTES, stream) != hipSuccess) { fprintf(stderr, "kernel_launch: memset failed\n"); return; }
    Args a{};
    for (int i = 0; i < N_IN; ++i) a.in[i] = (const float*)d_in[i];
    a.out = (float*)d_out; a.ws = (unsigned char*)d_ws;
    for (int li = 0; li < N_LAUNCHES; ++li) {
        if (N_LAUNCHES == NPHASES) { a.ph_lo = li; a.ph_hi = li + 1; } else { a.ph_lo = (int)((long)li * NPHASES / N_LAUNCHES); a.ph_hi = (int)((long)(li + 1) * NPHASES / N_LAUNCHES); }
        a.li = li;
        hipLaunchKernelGGL(mk_fwd, dim3(grid), dim3(NTHREADS), LDS_BYTES, stream, a);
        const hipError_t le = hipPeekAtLastError();
        if (le != hipSuccess) { fprintf(stderr, "kernel_launch: launch %d failed: %s\n", li, hipGetErrorName(le)); break; }
    }
}
```

```cpp
#include <hip/hip_runtime.h>
#include <cstdio>
#include <cstdint>

namespace pg8 {
#define PG8_LAS __attribute__((address_space(3)))
typedef unsigned short bf16_t;
typedef short bf16x8 __attribute__((ext_vector_type(8)));
typedef float f32x4 __attribute__((ext_vector_type(4)));
typedef unsigned u32x4 __attribute__((ext_vector_type(4)));
constexpr int BM = 256, BK = 64, HALF = 128, HTB = HALF * BK * 2  , STAGE_BYTES = 8 * HTB, NXCD = 8, WGM = 8;

__host__ __device__ __forceinline__ int lds_byte(int r, int c) { const int st = (r >> 4) * 2 + (c >> 5), rr = r & 15, cc = c & 31, ob = rr * 64 + cc * 2; return st * 1024 + (ob ^ (((ob >> 9) & 1) << 5)); }
__host__ __device__ __forceinline__ void stage_rc(int b, int& R, int& C) { const int st = b / 1024, sb = b % 1024, swz = sb ^ (((sb >> 9) & 1) << 5); R = (st >> 1) * 16 + swz / 64; C = (st & 1) * 32 + (swz % 64) / 2; }
__host__ __device__ __forceinline__ int perm32(int rho) { const int n = rho >> 4, i = rho & 15; return 8 * (i >> 2) + 4 * n + (i & 3); }

struct Unit { int pm, pn, e; long bofs; };
struct Gemm { const bf16_t* A; const bf16_t* Bt; int M, N, K; };

struct StaticOrder {
    int nM, nN, nwg, G, c;
    __host__ __device__ void init(int M, int N, int G_, int c_) { nM = M / BM; nN = N / BM; nwg = nM * nN; G = G_; c = c_; }
    __host__ __device__ bool next(int i, Unit& u) const {
        const long L = (long)i * G + c; if (L >= nwg) return false;
        int wgid = (int)L; { const int q = nwg / NXCD, r = nwg % NXCD, xcd = wgid % NXCD, off = wgid / NXCD; wgid = (xcd < r ? xcd * (q + 1) : r * (q + 1) + (xcd - r) * q) + off; }
        const int nig = WGM * nN, gid = wgid / nig, fm = gid * WGM, gsz = (nM - fm) < WGM ? (nM - fm) : WGM;
        u.pm = fm + ((wgid % nig) % gsz); u.pn = (wgid % nig) / gsz; u.e = 0; u.bofs = 0; return true;
    }
    __device__ __forceinline__ void a_ready(const Unit&) const {}
    __device__ __forceinline__ void done(const Unit&) const {}
};
struct MoeOrder {
    const int* tile_e; int nT, nN, G, c; long estride;
    __device__ __forceinline__ bool next(int i, Unit& u) const {
        const long L = (long)i * G + c; if (L >= (long)nT * nN) return false;
        u.pm = (int)(L / nN); u.pn = (int)(L % nN); const int e = tile_e[u.pm]; u.e = e; u.bofs = (long)e * estride; return true;
    }
    __device__ __forceinline__ void a_ready(const Unit&) const {}
    __device__ __forceinline__ void done(const Unit&) const {}
};

struct BatchOrder {
    int nN, nwg, G, c, tiles_per_batch; long bstride;
    __device__ __forceinline__ bool next(int i, Unit& u) const {
        const long L = (long)i * G + c; if (L >= nwg) return false;
        u.pm = (int)(L / nN); u.pn = (int)(L % nN); const int e = u.pm / tiles_per_batch; u.e = e; u.bofs = (long)e * bstride; return true;
    }
    __device__ __forceinline__ void a_ready(const Unit&) const {}
    __device__ __forceinline__ void done(const Unit&) const {}
};

__device__ __forceinline__ unsigned cvt_pk_bf16(float lo, float hi) { unsigned r; asm volatile("v_cvt_pk_bf16_f32 %0, %1, %2" : "=v"(r) : "v"(lo), "v"(hi)); return r; }
__device__ __forceinline__ u32x4 pack8(const f32x4 v0, const f32x4 v1) { u32x4 w; w.x = cvt_pk_bf16(v0[0], v0[1]); w.y = cvt_pk_bf16(v0[2], v0[3]); w.z = cvt_pk_bf16(v1[0], v1[1]); w.w = cvt_pk_bf16(v1[2], v1[3]); return w; }
__device__ __forceinline__ float bf_lo(unsigned w) { return __uint_as_float(w << 16); }
__device__ __forceinline__ float bf_hi(unsigned w) { return __uint_as_float(w & 0xffff0000u); }
__device__ __forceinline__ float sigmoidf_(float x) { return 1.0f / (1.0f + __expf(-x)); }
typedef unsigned u32x2 __attribute__((ext_vector_type(2)));

template <class T> struct Epi {
    static constexpr bool PERM = true, AFTER_DRAIN = false;
    T t;
    __device__ __forceinline__ void operator()(const f32x4 (&acc)[2][2][4][2], const Unit& u, int wr, int wc, int fr, int fq) const {
        const int row0 = u.pm * BM + wr * 64 + fr, col0 = u.pn * BM + wc * 32 + 8 * fq;
#pragma unroll
        for (int ai = 0; ai < 2; ++ai)
#pragma unroll
            for (int m = 0; m < 4; ++m) {
#pragma unroll
                for (int bj = 0; bj < 2; ++bj) t.store(row0 + ai * HALF + m * 16, col0 + bj * HALF, acc[ai][bj][m][0], acc[ai][bj][m][1], u);
                asm volatile("" ::: "memory"); }
    }
};
struct StBf16 { bf16_t* O; int ld;
    __device__ __forceinline__ void store(int row, int col, f32x4 v0, f32x4 v1, const Unit&) const { *(u32x4*)(O + (size_t)row * ld + col) = pack8(v0, v1); } };
struct StInAB { float* SM; bf16_t* Q;
    __device__ __forceinline__ void store(int row, int col, f32x4 v0, f32x4 v1, const Unit&) const {
        if (col < 512) { float* p = SM + (size_t)row * 512 + col; *(f32x4*)p = v0; *(f32x4*)(p + 4) = v1; }
        else *(u32x4*)(Q + (size_t)row * 2048 + (col - 512)) = pack8(v0, v1); } };
struct StPre { const float* base; float* P; float alpha;
    __device__ __forceinline__ void store(int row, int col, f32x4 v0, f32x4 v1, const Unit&) const {
        const size_t o = (size_t)row * 1024 + col; const f32x4 b0 = *(const f32x4*)(base + o), b1 = *(const f32x4*)(base + o + 4);
        *(f32x4*)(P + o) = b0 * alpha + v0; *(f32x4*)(P + o + 4) = b1 * alpha + v1; } };
struct StPleGate { const bf16_t* PP; bf16_t* O;
    __device__ __forceinline__ void store(int row, int col, f32x4 v0, f32x4 v1, const Unit&) const {
        const size_t o = (size_t)row * 1024 + col; const u32x4 p = *(const u32x4*)(PP + o);
        f32x4 r0, r1;
        r0[0] = sigmoidf_(v0[0]) * bf_lo(p.x); r0[1] = sigmoidf_(v0[1]) * bf_hi(p.x); r0[2] = sigmoidf_(v0[2]) * bf_lo(p.y); r0[3] = sigmoidf_(v0[3]) * bf_hi(p.y);
        r1[0] = sigmoidf_(v1[0]) * bf_lo(p.z); r1[1] = sigmoidf_(v1[1]) * bf_hi(p.z); r1[2] = sigmoidf_(v1[2]) * bf_lo(p.w); r1[3] = sigmoidf_(v1[3]) * bf_hi(p.w);
        *(u32x4*)(O + o) = pack8(r0, r1); } };
struct StSwiglu { const float* bgu; bf16_t* H;
    __device__ __forceinline__ float act(float g, float u) const { const float gt = fminf(g, 7.0f), up = fminf(fmaxf(u, -7.0f), 7.0f); return (up + 1.0f) * (gt * sigmoidf_(gt * 1.702f)); }
    __device__ __forceinline__ void store(int row, int col, f32x4 v0, f32x4 v1, const Unit& u) const {
        const float* b = bgu + (size_t)u.e * 2048 + col; const f32x4 b0 = *(const f32x4*)b, b1 = *(const f32x4*)(b + 4);
        v0 = v0 + b0; v1 = v1 + b1;
        u32x2 w; w.x = cvt_pk_bf16(act(v0[0], v0[1]), act(v0[2], v0[3])); w.y = cvt_pk_bf16(act(v1[0], v1[1]), act(v1[2], v1[3]));
        *(u32x2*)(H + (size_t)row * 1024 + (col >> 1)) = w; } };
struct StDown { const float* bd; bf16_t* Y;
    __device__ __forceinline__ void store(int row, int col, f32x4 v0, f32x4 v1, const Unit& u) const {
        const float* b = bd + (size_t)u.e * 1024 + col; const f32x4 b0 = *(const f32x4*)b, b1 = *(const f32x4*)(b + 4);
        *(u32x4*)(Y + (size_t)row * 1024 + col) = pack8(v0 + b0, v1 + b1); } };

template <class Epi, class Sched, bool ALIGN_EPI = false, bool SP2 = false>
__device__ __forceinline__ void gemm_phase(PG8_LAS unsigned char* lds, const Gemm g, const Sched& S, const Epi& E) {
    int tid = threadIdx.x; asm volatile("" : "+v"(tid));
    const int wid = __builtin_amdgcn_readfirstlane(tid >> 6), lane = tid & 63, wr = wid >> 2, wc = wid & 3, fr = lane & 15, fq = lane >> 4;
    int K = g.K; asm volatile("" : "+s"(K));
    const int nt = K / BK;
    unsigned voffA[2], voffB[2];
#pragma unroll
    for (int i = 0; i < 2; ++i) { int R, C; stage_rc(tid * 16 + i * 8192, R, C); const int Rb = Epi::PERM ? ((R & ~31) + perm32(R & 31)) : R;
        voffA[i] = (unsigned)(R * K + C) * 2u; voffB[i] = (unsigned)(Rb * K + C) * 2u; }
    const size_t kstep = (size_t)(BK * 2);
    const size_t hstep = (size_t)HALF * K * 2;
    const size_t tstep = 2 * hstep;
    const unsigned ldsw = (unsigned)wid * 1024u;
    const int aoff = lds_byte(wr * 64 + fr, fq * 8), boff = lds_byte(wc * 32 + fr, fq * 8);
#define PG8_SA(b, h) (((b) * 2 + (h)) * HTB)
#define PG8_SB(b, h) ((4 + (b) * 2 + (h)) * HTB)
#define PG8_STAGE(bufoff, gbase, voff) do { _Pragma("unroll") for (int _i = 0; _i < 2; ++_i) \
        __builtin_amdgcn_global_load_lds((const unsigned*)((const char*)(gbase) + (voff)[_i]), (PG8_LAS unsigned*)(lds + (bufoff) + ldsw + _i * 8192), 16, 0, 0); } while (0)
#define PG8_LDA(dst, b, h) do { _Pragma("unroll") for (int m = 0; m < 4; ++m) _Pragma("unroll") for (int k = 0; k < 2; ++k) dst[m][k] = *(const PG8_LAS bf16x8*)(lds + PG8_SA(b, h) + aoff + m * 2048 + k * 1024); } while (0)
#define PG8_LDB(dst, b, h) do { _Pragma("unroll") for (int n = 0; n < 2; ++n) _Pragma("unroll") for (int k = 0; k < 2; ++k) dst[n][k] = *(const PG8_LAS bf16x8*)(lds + PG8_SB(b, h) + boff + n * 2048 + k * 1024); } while (0)
#define PG8_MMA(ai, bj, At, Bt) do { __builtin_amdgcn_s_setprio(1); _Pragma("unroll") for (int m = 0; m < 4; ++m) _Pragma("unroll") for (int n = 0; n < 2; ++n) _Pragma("unroll") for (int k = 0; k < 2; ++k) \
        acc[ai][bj][m][n] = __builtin_amdgcn_mfma_f32_16x16x32_bf16(Bt[n][k], At[m][k], acc[ai][bj][m][n], 0, 0, 0); __builtin_amdgcn_s_setprio(0); } while (0)
#define PG8_WAIT_V(n) asm volatile("s_waitcnt vmcnt(" #n ")" ::: "memory")
#define PG8_WAIT_L(n) asm volatile("s_waitcnt lgkmcnt(" #n ")" ::: "memory")
#define PG8_BAR __builtin_amdgcn_s_barrier()
#define PG8_SCHED __builtin_amdgcn_sched_barrier(0)
    Unit cur, nxt; int ui = 0;
    if (!S.next(0, cur)) return;
    f32x4 acc[2][2][4][2];
#pragma unroll
    for (int a = 0; a < 2; ++a)
#pragma unroll
        for (int b = 0; b < 2; ++b)
#pragma unroll
            for (int m = 0; m < 4; ++m)
#pragma unroll
                for (int n = 0; n < 2; ++n) acc[a][b][m][n] = (f32x4){0.f, 0.f, 0.f, 0.f};
    bf16x8 At[4][2], B0[2][2], B1[2][2];
    const char* cA = (const char*)g.A + (size_t)cur.pm * tstep; const char* cB = (const char*)g.Bt + (size_t)cur.pn * tstep + cur.bofs;
    S.a_ready(cur);
    if constexpr (SP2) {
        PG8_STAGE(PG8_SB(0, 0), cB, voffB); PG8_STAGE(PG8_SB(0, 1), cB + hstep, voffB); PG8_STAGE(PG8_SA(0, 0), cA, voffA); PG8_STAGE(PG8_SA(0, 1), cA + hstep, voffA);
        if (wr == 1) PG8_BAR;
        PG8_WAIT_V(2); PG8_BAR;
        PG8_STAGE(PG8_SB(1, 0), cB + kstep, voffB); PG8_STAGE(PG8_SA(1, 0), cA + kstep, voffA); PG8_STAGE(PG8_SB(1, 1), cB + hstep + kstep, voffB);
        PG8_WAIT_V(6); PG8_BAR;
    } else {
        PG8_STAGE(PG8_SB(0, 0), cB, voffB); PG8_STAGE(PG8_SA(0, 0), cA, voffA); PG8_STAGE(PG8_SB(0, 1), cB + hstep, voffB); PG8_STAGE(PG8_SA(0, 1), cA + hstep, voffA);
        if (wr == 1) PG8_BAR;
        PG8_WAIT_V(4); PG8_BAR;
        PG8_STAGE(PG8_SB(1, 0), cB + kstep, voffB); PG8_STAGE(PG8_SA(1, 0), cA + kstep, voffA); PG8_STAGE(PG8_SB(1, 1), cB + hstep + kstep, voffB);
        PG8_WAIT_V(6); PG8_BAR;
    }
    for (;;) {
        const bool has_next = S.next(ui + 1, nxt);
        const char* nA = has_next ? (const char*)g.A + (size_t)nxt.pm * tstep : cA; const char* nB = has_next ? (const char*)g.Bt + (size_t)nxt.pn * tstep + nxt.bofs : cB;
        for (int t = 0; t < nt; t += 2) {
            const bool last = (t == nt - 2);
            const char* a1 = cA + (size_t)(t + 1) * kstep;
            const char* a2 = last ? nA : cA + (size_t)(t + 2) * kstep; const char* b2 = last ? nB : cB + (size_t)(t + 2) * kstep;
            const char* a3 = a2 + kstep; const char* b3 = b2 + kstep;
            if (last && has_next) S.a_ready(nxt);
            if constexpr (SP2) {
            PG8_LDB(B0, 0, 0); PG8_LDB(B1, 0, 1); PG8_SCHED; PG8_LDA(At, 0, 0); PG8_STAGE(PG8_SA(1, 1), a1 + hstep, voffA);
            PG8_WAIT_V(8); PG8_WAIT_L(0); PG8_BAR; PG8_MMA(0, 0, At, B0); PG8_MMA(0, 1, At, B1); PG8_BAR; PG8_SCHED;
            PG8_LDA(At, 0, 1); PG8_STAGE(PG8_SB(0, 0), b2, voffB); PG8_STAGE(PG8_SB(0, 1), b2 + hstep, voffB); PG8_STAGE(PG8_SA(0, 0), a2, voffA);
            PG8_WAIT_V(8); PG8_WAIT_L(0); PG8_BAR; PG8_MMA(1, 0, At, B0); PG8_MMA(1, 1, At, B1); PG8_BAR; PG8_SCHED;
            PG8_LDB(B0, 1, 0); PG8_LDB(B1, 1, 1); PG8_SCHED; PG8_LDA(At, 1, 0); PG8_STAGE(PG8_SA(0, 1), a2 + hstep, voffA);
            PG8_WAIT_V(8); PG8_WAIT_L(0); PG8_BAR; PG8_MMA(0, 0, At, B0); PG8_MMA(0, 1, At, B1); PG8_BAR; PG8_SCHED;
            PG8_LDA(At, 1, 1); PG8_STAGE(PG8_SB(1, 0), b3, voffB); PG8_STAGE(PG8_SB(1, 1), b3 + hstep, voffB); PG8_STAGE(PG8_SA(1, 0), a3, voffA);
            PG8_WAIT_V(8); PG8_WAIT_L(0); PG8_BAR; PG8_MMA(1, 0, At, B0); PG8_MMA(1, 1, At, B1); PG8_BAR; PG8_SCHED;
            } else {
            PG8_LDB(B0, 0, 0); PG8_SCHED; PG8_LDA(At, 0, 0); PG8_STAGE(PG8_SA(1, 1), a1 + hstep, voffA);
            PG8_WAIT_L(8); PG8_BAR; PG8_WAIT_L(0); PG8_MMA(0, 0, At, B0); PG8_BAR; PG8_SCHED;
            PG8_LDB(B1, 0, 1); PG8_STAGE(PG8_SB(0, 0), b2, voffB);
            PG8_BAR; PG8_WAIT_L(0); PG8_MMA(0, 1, At, B1); PG8_BAR;
            PG8_LDA(At, 0, 1); PG8_STAGE(PG8_SA(0, 0), a2, voffA);
            PG8_BAR; PG8_WAIT_L(0); PG8_MMA(1, 0, At, B0); PG8_BAR; PG8_SCHED;
            PG8_STAGE(PG8_SB(0, 1), b2 + hstep, voffB);
            PG8_WAIT_V(6); PG8_BAR; PG8_MMA(1, 1, At, B1); PG8_BAR;
            PG8_LDB(B0, 1, 0); PG8_SCHED; PG8_LDA(At, 1, 0); PG8_STAGE(PG8_SA(0, 1), a2 + hstep, voffA);
            PG8_WAIT_L(8); PG8_BAR; PG8_WAIT_L(0); PG8_MMA(0, 0, At, B0); PG8_BAR; PG8_SCHED;
            PG8_LDB(B1, 1, 1); PG8_STAGE(PG8_SB(1, 0), b3, voffB);
            PG8_BAR; PG8_WAIT_L(0); PG8_MMA(0, 1, At, B1); PG8_BAR;
            PG8_LDA(At, 1, 1); PG8_STAGE(PG8_SA(1, 0), a3, voffA);
            PG8_BAR; PG8_WAIT_L(0); PG8_MMA(1, 0, At, B0); PG8_BAR; PG8_SCHED;
            PG8_STAGE(PG8_SB(1, 1), b3 + hstep, voffB);
            PG8_WAIT_V(6); PG8_BAR; PG8_MMA(1, 1, At, B1); PG8_BAR;
            }
        }
        if constexpr (ALIGN_EPI) { if (wr == 0) PG8_BAR; }
        if constexpr (!Epi::AFTER_DRAIN) { E(acc, cur, wr, wc, fr, fq); S.done(cur); }
        if (!has_next) break;
#pragma unroll
        for (int a = 0; a < 2; ++a)
#pragma unroll
            for (int b = 0; b < 2; ++b)
#pragma unroll
                for (int m = 0; m < 4; ++m)
#pragma unroll
                    for (int n = 0; n < 2; ++n) acc[a][b][m][n] = (f32x4){0.f, 0.f, 0.f, 0.f};
        cur = nxt; cA = nA; cB = nB; ++ui;
        if constexpr (ALIGN_EPI) { if (wr == 1) PG8_BAR; }
    }
    PG8_WAIT_V(0);
    if constexpr (!ALIGN_EPI) { if (wr == 0) PG8_BAR; }
    PG8_BAR;
    if constexpr (Epi::AFTER_DRAIN) { E.fused(acc, cur, wr, wc, fr, fq, lds, wid, lane); S.done(cur); }
#undef PG8_SA
#undef PG8_SB
#undef PG8_STAGE
#undef PG8_LDA
#undef PG8_LDB
#undef PG8_MMA
#undef PG8_WAIT_V
#undef PG8_WAIT_L
#undef PG8_BAR
#undef PG8_SCHED
}
}

constexpr int NWAVES = 8, NTHREADS = 512;
constexpr int BATCH = 2, SEQ = 8192, M = BATCH * SEQ, D = 1024;
constexpr int NEXP = 32, DEXP = 1024;
constexpr int PMAX = M * 4 + NEXP * 256, NTMAX = PMAX / 256;
constexpr float ALPHA = 1.41421356237f;
constexpr int NPHASES = 21;
#ifndef MK_N_LAUNCHES
#define MK_N_LAUNCHES 1
#endif
constexpr int N_LAUNCHES = MK_N_LAUNCHES;

enum { I_X = 0, I_P, I_AB_WIN, I_AB_QG, I_AB_KVG, I_AB_WUQ, I_AB_WUK, I_AB_WUV, I_AB_WQIDX, I_AB_KIG, I_AB_KIB, I_AB_CONVW, I_AB_ALOG, I_AB_DTB, I_AB_ONG, I_AB_WOUT,
       I_CD_WIN, I_CD_POOLW, I_CD_POOLS, I_CD_WOUT, I_LNM_G, I_LNM_B, I_RW, I_RB, I_WGU, I_BGU, I_WDN, I_BDN, I_PLE_WP, I_PLE_WG, I_LNF_G, I_LNF_B, N_IN };

constexpr size_t MiB = 1u << 20;
constexpr size_t WS_CTL = 0, CTL_ZERO_BYTES = 1 * MiB;
constexpr size_t WS_W_INAB = 1 * MiB;
constexpr size_t WS_W_ABS = 6 * MiB;
constexpr size_t WS_W_OUTAB = 7 * MiB;
constexpr size_t WS_W_INCD = 10 * MiB;
constexpr size_t WS_W_OUTCD = 15 * MiB;
constexpr size_t WS_W_PG = 17 * MiB;
constexpr size_t WS_W_PP = 21 * MiB;
constexpr size_t WS_W_GU = 22 * MiB;
constexpr size_t WS_W_DN = 278 * MiB;
constexpr size_t WS_XB = 406 * MiB;
constexpr size_t WS_PB = 438 * MiB;
constexpr size_t WS_PP = 454 * MiB;
constexpr size_t WS_SM = 518 * MiB;
constexpr size_t WS_QKVZ = 550 * MiB;
constexpr size_t WS_CQ = 630 * MiB;
constexpr size_t WS_CKV = 638 * MiB;
constexpr size_t WS_KIDX = 642 * MiB;
constexpr size_t WS_WIDX = 644 * MiB;
constexpr size_t WS_BETA = 645 * MiB;
constexpr size_t WS_GG = WS_BETA + 512 * 1024;
constexpr size_t WS_QN = 646 * MiB, WS_KN = 662 * MiB, WS_VN = 678 * MiB;
constexpr size_t WS_QL = 694 * MiB;
constexpr size_t WS_CHK = 742 * MiB;
constexpr size_t WS_SEL = 838 * MiB;
constexpr size_t WS_NSEL = 854 * MiB;
constexpr size_t WS_ODELTA = 855 * MiB;
constexpr size_t WS_AO = 887 * MiB;
constexpr size_t WS_PRE = 935 * MiB;
constexpr size_t WS_H1 = 999 * MiB;
constexpr size_t WS_H2 = 1063 * MiB;
constexpr size_t WS_H1B = 1127 * MiB;
constexpr size_t WS_PLE = 1159 * MiB;
constexpr size_t WS_ROUTE = 1191 * MiB;
constexpr size_t WS_BIG = 1193 * MiB;
constexpr size_t WS_XS = WS_BIG, WS_HID = WS_BIG + 144 * MiB, WS_YS = WS_BIG + 288 * MiB;
constexpr size_t WS_END = WS_BIG + 512 * MiB;
static_assert((size_t)PMAX * 1024 * 2 <= 144 * MiB && WS_END <= 2048 * MiB, "d_ws map");
constexpr size_t CHK_WP = 0, CHK_QD = 16384, CHK_KDT = 32768, CHK_QK = 49152, CHK_UT = 57344, CHK_GL = 90112, CHK_STRIDE = 92160;
static_assert(CHK_STRIDE * 1024 <= 96 * MiB, "chunk operands");
constexpr int CW_TMO = 0, CW_CODE = 1;
constexpr int CW_BAR = 4096;
constexpr int CW_CNT = 16384;

constexpr int RING_OFF = 0, RING_BYTES = 131072;
constexpr int WSCR_OFF = 132096, WSCR_BYTES = 1024;
constexpr int MISC_OFF = 140288;
constexpr int LDS_BYTES = 147456;

#define GAS __attribute__((address_space(1)))
#define LAS __attribute__((address_space(3)))
typedef unsigned short bf16;
typedef unsigned v4u __attribute__((ext_vector_type(4)));
typedef unsigned v2u __attribute__((ext_vector_type(2)));
typedef float f32x4 __attribute__((ext_vector_type(4)));
typedef short bf16x8 __attribute__((ext_vector_type(8)));
typedef GAS unsigned gu32;
#define RLX_AGENT __ATOMIC_RELAXED, __HIP_MEMORY_SCOPE_AGENT
__device__ __forceinline__ unsigned f2bf(float f) { unsigned u = __builtin_bit_cast(unsigned, f); return (u + 0x7fffu + ((u >> 16) & 1u)) >> 16; }
__device__ __forceinline__ unsigned pk2(float lo, float hi) { return f2bf(lo) | (f2bf(hi) << 16); }
__device__ __forceinline__ float bflo(unsigned w) { return __uint_as_float(w << 16); }
__device__ __forceinline__ float bfhi(unsigned w) { return __uint_as_float(w & 0xffff0000u); }
__device__ __forceinline__ float bf1(bf16 h) { return __uint_as_float(((unsigned)h) << 16); }
__device__ __forceinline__ float sigm(float x) { return 1.0f / (1.0f + __expf(-x)); }
__device__ __forceinline__ float siluf(float x) { return x / (1.0f + __expf(-x)); }
__device__ __forceinline__ float wave_sum(float v) {
#pragma unroll
    for (int o = 1; o < 64; o <<= 1) v += __shfl_xor(v, o);
    return v;
}
__device__ __forceinline__ float wave_max(float v) {
#pragma unroll
    for (int o = 1; o < 64; o <<= 1) v = fmaxf(v, __shfl_xor(v, o));
    return v;
}
__device__ __forceinline__ int wave_sum_i(int v) {
#pragma unroll
    for (int o = 1; o < 64; o <<= 1) v += __shfl_xor(v, o);
    return v;
}
__device__ __forceinline__ void unpack8(const v4u w, float (&f)[8]) { f[0] = bflo(w.x); f[1] = bfhi(w.x); f[2] = bflo(w.y); f[3] = bfhi(w.y); f[4] = bflo(w.z); f[5] = bfhi(w.z); f[6] = bflo(w.w); f[7] = bfhi(w.w); }
__device__ __forceinline__ v4u pack8f(const float (&f)[8]) { v4u w; w.x = pk2(f[0], f[1]); w.y = pk2(f[2], f[3]); w.z = pk2(f[4], f[5]); w.w = pk2(f[6], f[7]); return w; }

#define XB_TMO      128
#define XB_XCNT(j)  (256  + 64 * (j))
#define XB_XSUB(j)  (1280 + 64 * (j))
#define XB_XGEN(j)  (2304 + 64 * (j))
#define XB_TOP      3328
#define XB_TOPGEN   3392
#define XCD_BAR_WORDS 3456
#define XB_SPIN_CAP (1u << 18)

__device__ __forceinline__ unsigned xb_ld(unsigned* p)              { return __hip_atomic_load(p, __ATOMIC_RELAXED, __HIP_MEMORY_SCOPE_AGENT); }
__device__ __forceinline__ unsigned xb_add(unsigned* p, unsigned v) { return __hip_atomic_fetch_add(p, v, __ATOMIC_RELAXED, __HIP_MEMORY_SCOPE_AGENT); }
__device__ __forceinline__ unsigned xb_xcc_id() { return (unsigned)__builtin_amdgcn_s_getreg((3 << 11) | 20) & 0xFu; }
#define XB_SPIN(cond, bar) do { unsigned _sp = 0; while (cond) { __builtin_amdgcn_s_sleep(1); \
    if ((++_sp & 255u) == 0u) { if (xb_ld(&(bar)[XB_TMO])) break; if (_sp > XB_SPIN_CAP) { atomicAdd(&(bar)[XB_TMO], 1u); break; } } } } while (0)

struct XcdBarrier {
    unsigned* bar; unsigned x;
    volatile LAS unsigned* st;
};

__device__ __forceinline__ XcdBarrier xcd_barrier_post(unsigned* bar, volatile LAS unsigned* st) {
    XcdBarrier b; b.bar = bar; b.x = xb_xcc_id(); b.st = st;
    if (threadIdx.x == 0) (void)xb_add(&bar[XB_XCNT(b.x)], 1u);
    return b;
}
__device__ __forceinline__ void xcd_barrier_complete(unsigned* bar, unsigned x, unsigned& nloc, unsigned& nx) {
    const unsigned G = gridDim.x * gridDim.y * gridDim.z;
    unsigned sum, cnt, mine, sp = 0u;
    for (;;) {
        sum = 0u; cnt = 0u; mine = 0u;
#pragma unroll
        for (unsigned j = 0; j < 16; ++j) { const unsigned c = xb_ld(&bar[XB_XCNT(j)]); sum += c; cnt += (c > 0u) ? 1u : 0u; mine = (j == x) ? c : mine; }
        if (sum == G) break;
        __builtin_amdgcn_s_sleep(1);
        if ((++sp & 255u) == 0u) { if (xb_ld(&bar[XB_TMO])) break; if (sp > XB_SPIN_CAP) { atomicAdd(&bar[XB_TMO], 1u); break; } }
    }
    nloc = mine > 0u ? mine : 1u; nx = cnt > 0u ? cnt : 1u;
}

__device__ __forceinline__ void xcd_barrier(const XcdBarrier& b) {
    asm volatile("s_waitcnt vmcnt(0)" ::: "memory");
    __syncthreads();
    if (threadIdx.x == 0) {
        unsigned* bar = b.bar;
        __builtin_amdgcn_s_waitcnt(0);
        unsigned nloc = b.st[0], nx = b.st[1];
        if (nloc == 0u) { xcd_barrier_complete(bar, b.x, nloc, nx); b.st[0] = nloc; b.st[1] = nx; }
        const unsigned old = xb_add(&bar[XB_XSUB(b.x)], 1u);
        const unsigned gen = old / nloc;
        if (old + 1u == (gen + 1u) * nloc) {
            __builtin_amdgcn_fence(__ATOMIC_RELEASE, "agent");
            asm volatile("s_waitcnt vmcnt(0)" ::: "memory");
            const unsigned og = xb_add(&bar[XB_TOP], 1u);
            const unsigned tg = og / nx;
            if (og + 1u == (tg + 1u) * nx) xb_add(&bar[XB_TOPGEN], 1u);
            else XB_SPIN(xb_ld(&bar[XB_TOPGEN]) == tg, bar);
            __builtin_amdgcn_fence(__ATOMIC_ACQUIRE, "agent");
            xb_add(&bar[XB_XGEN(b.x)], 1u);
            asm volatile("s_waitcnt vmcnt(0)" ::: "memory");
        } else {
            XB_SPIN(xb_ld(&bar[XB_XGEN(b.x)]) == gen, bar);
            __builtin_amdgcn_fence(__ATOMIC_ACQUIRE, "agent");
            asm volatile("s_waitcnt vmcnt(0)" ::: "memory");
        }
    }
    __syncthreads();
}

struct Args { const float* in[N_IN]; float* out; unsigned char* ws; int ph_lo, ph_hi, li, pad; };
typedef const __attribute__((address_space(4))) Args* KArgs;
__device__ __forceinline__ KArgs kargs() { auto p = __builtin_amdgcn_kernarg_segment_ptr(); asm volatile("" : "+s"(p)); return (KArgs)p; }
struct Frame {
    LAS unsigned char* lds;
    int tid, lane, wave, G, bid;
    unsigned char* ws;
    gu32* ctl;
};
#define WSP(T, off) ((T*)(F.ws + (off)))

struct MapId { __device__ __forceinline__ int operator()(int n) const { return n; } };
struct MapAdd { int off; __device__ __forceinline__ int operator()(int n) const { return n + off; } };
struct MapAB { __device__ __forceinline__ int operator()(int n) const { return n < 456 ? n : (n < 2504 ? n + 56 : n - 2048); } };
template <class Map> __device__ __forceinline__ void wg_transpose_item(const float* W, int N, int ldw, bf16* WT, int ldt, int koff, Map map, LAS float* scr, int item, int tid) {
    const int nblk = (N + 127) >> 7, kb = item / nblk, nb = item - kb * nblk, k0 = kb * 128, n0 = nb * 128;
#pragma unroll
    for (int it = 0; it < 8; ++it) {
        const int row = it * 16 + (tid >> 5), c4 = (tid & 31) * 4, n = n0 + c4;
        f32x4 v = (f32x4){0.f, 0.f, 0.f, 0.f};
        if (n + 3 < N) v = *(const f32x4*)(W + (size_t)(k0 + row) * ldw + n);
        LAS float* s = scr + row * 129 + c4; s[0] = v[0]; s[1] = v[1]; s[2] = v[2]; s[3] = v[3];
    }
    __syncthreads();
#pragma unroll
    for (int j = 0; j < 4; ++j) {
        const int idx = j * 512 + tid, nl = idx >> 4, ch = idx & 15, n = n0 + nl;
        if (n < N) { const LAS float* s = scr + (ch * 8) * 129 + nl;
            v4u o; o.x = pk2(s[0], s[129]); o.y = pk2(s[2 * 129], s[3 * 129]); o.z = pk2(s[4 * 129], s[5 * 129]); o.w = pk2(s[6 * 129], s[7 * 129]);
            *(v4u*)(WT + (size_t)map(n) * ldt + koff + k0 + ch * 8) = o; }
    }
    __syncthreads();
}
__device__ __forceinline__ void p0_prologue(Frame& F, KArgs A) {
    LAS float* scr = (LAS float*)(F.lds + RING_OFF);
    const int tid = F.tid;
    constexpr int IT_GU = 128, IT_DN = 64;
    constexpr int N_GU = 64 * IT_GU, N_DN = 64 * IT_DN;
    constexpr int N_INAB = 8 * 20, N_INCD = 8 * 20, N_OUTCD = 64, N_PG = 2 * 64, N_PP = 2 * 2 * 8, N_QIDX = 2 * 4, N_OUTB = 4 * 8;
    constexpr int NITEMS = N_GU + N_DN + N_INAB + N_INCD + N_OUTCD + N_PG + N_PP + N_QIDX + N_OUTB;
    for (int it = F.bid; it < NITEMS; it += F.G) {
        int r = it;
        if (r < N_GU) { const int m = r / IT_GU; wg_transpose_item(A->in[I_WGU] + (size_t)m * 1024 * 2048, 2048, 2048, WSP(bf16, WS_W_GU) + (size_t)m * 2048 * 1024, 1024, 0, MapId{}, scr, r % IT_GU, tid); continue; } r -= N_GU;
        if (r < N_DN) { const int m = r / IT_DN; wg_transpose_item(A->in[I_WDN] + (size_t)m * 1024 * 1024, 1024, 1024, WSP(bf16, WS_W_DN) + (size_t)m * 1024 * 1024, 1024, 0, MapId{}, scr, r % IT_DN, tid); continue; } r -= N_DN;
        if (r < N_INAB) { wg_transpose_item(A->in[I_AB_WIN], 2512, 2512, WSP(bf16, WS_W_INAB), 1024, 0, MapAB{}, scr, r, tid); continue; } r -= N_INAB;
        if (r < N_INCD) { wg_transpose_item(A->in[I_CD_WIN], 2560, 2560, WSP(bf16, WS_W_INCD), 1024, 0, MapId{}, scr, r, tid); continue; } r -= N_INCD;
        if (r < N_OUTCD) { wg_transpose_item(A->in[I_CD_WOUT], 1024, 1024, WSP(bf16, WS_W_OUTCD), 1024, 0, MapId{}, scr, r, tid); continue; } r -= N_OUTCD;
        if (r < N_PG) { const int l = r / 64; wg_transpose_item(A->in[I_PLE_WG] + (size_t)l * 1024 * 1024, 1024, 1024, WSP(bf16, WS_W_PG) + (size_t)l * 1024 * 1024, 1024, 0, MapId{}, scr, r % 64, tid); continue; } r -= N_PG;
        if (r < N_PP) { const int l = r / 16; wg_transpose_item(A->in[I_PLE_WP] + (size_t)l * 256 * 1024, 1024, 1024, WSP(bf16, WS_W_PP) + (size_t)l * 1024 * 256, 256, 0, MapId{}, scr, r % 16, tid); continue; } r -= N_PP;
        if (r < N_QIDX) { wg_transpose_item(A->in[I_AB_WQIDX], 512, 512, WSP(bf16, WS_W_ABS), 256, 0, MapAdd{1024}, scr, r, tid); continue; } r -= N_QIDX;
        wg_transpose_item(A->in[I_AB_WOUT] + (size_t)512 * 1024, 1024, 1024, WSP(bf16, WS_W_OUTAB), 1536, 1024, MapId{}, scr, r, tid);
    }
    const size_t gt = (size_t)F.bid * NTHREADS + tid, GT = (size_t)F.G * NTHREADS;
    for (size_t i = gt; i < (size_t)48 * 1024 / 8; i += GT) *(v4u*)(WSP(bf16, WS_W_INAB) + (size_t)464 * 1024 + i * 8) = (v4u){0u, 0u, 0u, 0u};
    for (size_t i = gt; i < (size_t)1024 * 256; i += GT) {
        const int n = (int)(i >> 8), c = (int)(i & 255), h = n >> 7, r = n & 127;
        const float* a = A->in[I_AB_WUQ] + (size_t)c * 512 + h * 64; const float* b = A->in[I_AB_WUK] + (size_t)r * 512 + h * 64;
        float s = 0.f;
#pragma unroll 8
        for (int d = 0; d < 64; d += 4) { const f32x4 x = *(const f32x4*)(a + d), y = *(const f32x4*)(b + d); s += x[0] * y[0] + x[1] * y[1] + x[2] * y[2] + x[3] * y[3]; }
        WSP(bf16, WS_W_ABS)[i] = (bf16)f2bf(s * 0.125f);
    }
    for (size_t i = gt; i < (size_t)1024 * 1024; i += GT) {
        const int n = (int)(i >> 10), k = (int)(i & 1023), h = k >> 7, r = k & 127;
        const float* a = A->in[I_AB_WUV] + (size_t)r * 512 + h * 64; const float* b = A->in[I_AB_WOUT] + (size_t)(h * 64) * 1024 + n;
        float s = 0.f;
#pragma unroll 8
        for (int v = 0; v < 64; ++v) s += a[v] * b[(size_t)v * 1024];
        WSP(bf16, WS_W_OUTAB)[(size_t)n * 1536 + k] = (bf16)f2bf(s);
    }
    for (size_t i = gt; i < (size_t)M * D / 8; i += GT) { const f32x4 a = *(const f32x4*)(A->in[I_X] + i * 8), b = *(const f32x4*)(A->in[I_X] + i * 8 + 4);
        v4u o; o.x = pk2(a[0], a[1]); o.y = pk2(a[2], a[3]); o.z = pk2(b[0], b[1]); o.w = pk2(b[2], b[3]); *(v4u*)(WSP(bf16, WS_XB) + i * 8) = o; }
    for (size_t i = gt; i < (size_t)2 * M * 256 / 8; i += GT) { const f32x4 a = *(const f32x4*)(A->in[I_P] + i * 8), b = *(const f32x4*)(A->in[I_P] + i * 8 + 4);
        v4u o; o.x = pk2(a[0], a[1]); o.y = pk2(a[2], a[3]); o.z = pk2(b[0], b[1]); o.w = pk2(b[2], b[3]); *(v4u*)(WSP(bf16, WS_PB) + i * 8) = o; }
}

__device__ __forceinline__ void p2_prep(Frame& F, KArgs A) {
    const int lane = F.lane, gw = F.bid * NWAVES + F.wave, NGW = F.G * NWAVES;
    const float* SM = WSP(float, WS_SM); const bf16* QZ = WSP(bf16, WS_QKVZ);
    const f32x4 qg = *(const f32x4*)(A->in[I_AB_QG] + 4 * lane);
    const f32x4 kvg = *(const f32x4*)(A->in[I_AB_KVG] + 4 * (lane & 31));
    const f32x4 kig = *(const f32x4*)(A->in[I_AB_KIG] + 4 * (lane & 15)), kib = *(const f32x4*)(A->in[I_AB_KIB] + 4 * (lane & 15));
    const f32x4 alog = *(const f32x4*)(A->in[I_AB_ALOG]), dtb = *(const f32x4*)(A->in[I_AB_DTB]);
    for (int row = gw; row < M; row += NGW) {
        const int t = row & (SEQ - 1);
        const f32x4 a = *(const f32x4*)(SM + (size_t)row * 512 + 4 * lane), b = *(const f32x4*)(SM + (size_t)row * 512 + 256 + 4 * lane);
        {
            const float ss = wave_sum(a[0] * a[0] + a[1] * a[1] + a[2] * a[2] + a[3] * a[3]);
            const float r = rsqrtf(ss * (1.0f / 256.0f) + 1e-6f);
            v2u o; o.x = pk2(a[0] * r * qg[0], a[1] * r * qg[1]); o.y = pk2(a[2] * r * qg[2], a[3] * r * qg[3]);
            *(v2u*)(WSP(bf16, WS_CQ) + (size_t)row * 256 + 4 * lane) = o;
        }
        {
            const float ss = wave_sum(lane < 32 ? (b[0] * b[0] + b[1] * b[1] + b[2] * b[2] + b[3] * b[3]) : 0.f);
            const float r = rsqrtf(ss * (1.0f / 128.0f) + 1e-6f);
            if (lane < 32) { v2u o; o.x = pk2(b[0] * r * kvg[0], b[1] * r * kvg[1]); o.y = pk2(b[2] * r * kvg[2], b[3] * r * kvg[3]);
                *(v2u*)(WSP(bf16, WS_CKV) + (size_t)row * 128 + 4 * lane) = o; }
        }
        {
            const bool in = (lane >= 32 && lane < 48);
            const float mean = wave_sum(in ? (b[0] + b[1] + b[2] + b[3]) : 0.f) * (1.0f / 64.0f);
            const f32x4 d = b - mean;
            const float var = wave_sum(in ? (d[0] * d[0] + d[1] * d[1] + d[2] * d[2] + d[3] * d[3]) : 0.f) * (1.0f / 64.0f);
            const float r = rsqrtf(var + 1e-5f);
            if (in) { v2u o; o.x = pk2(d[0] * r * kig[0] + kib[0], d[1] * r * kig[1] + kib[1]); o.y = pk2(d[2] * r * kig[2] + kib[2], d[3] * r * kig[3] + kib[3]);
                *(v2u*)(WSP(bf16, WS_KIDX) + (size_t)row * 64 + 4 * (lane - 32)) = o; }
        }
        if (lane == 48 || lane == 49) *(f32x4*)(WSP(float, WS_WIDX) + (size_t)row * 8 + 4 * (lane - 48)) = b * 0.044194173824159216f;
        if (lane == 50) { f32x4 o; o[0] = sigm(b[0]); o[1] = sigm(b[1]); o[2] = sigm(b[2]); o[3] = sigm(b[3]); *(f32x4*)(WSP(float, WS_BETA) + (size_t)row * 4) = o; }
        if (lane == 51) { f32x4 o;
#pragma unroll
            for (int h = 0; h < 4; ++h) { const float xx = b[h] + dtb[h]; const float sp = xx > 20.f ? xx : log1pf(__expf(xx)); o[h] = -__expf(alog[h]) * sp; }
            *(f32x4*)(WSP(float, WS_GG) + (size_t)row * 4) = o; }
#pragma unroll
        for (int sel = 0; sel < 3; ++sel) {
            const int col0 = sel * 512 + 8 * lane;
            float acc[8];
#pragma unroll
            for (int i = 0; i < 8; ++i) acc[i] = 0.f;
#pragma unroll
            for (int j = 0; j < 4; ++j) {
                if (t - 3 + j >= 0) {
                    const v4u xr = *(const v4u*)(QZ + (size_t)(row - 3 + j) * 2048 + col0); float xv[8]; unpack8(xr, xv);
                    const f32x4 w0 = *(const f32x4*)(A->in[I_AB_CONVW] + (size_t)j * 1536 + col0), w1 = *(const f32x4*)(A->in[I_AB_CONVW] + (size_t)j * 1536 + col0 + 4);
#pragma unroll
                    for (int i = 0; i < 4; ++i) { acc[i] += w0[i] * xv[i]; acc[4 + i] += w1[i] * xv[4 + i]; }
                }
            }
            float ss = 0.f;
#pragma unroll
            for (int i = 0; i < 8; ++i) { acc[i] = siluf(acc[i]); ss += acc[i] * acc[i]; }
            if (sel < 2) {
                ss += __shfl_xor(ss, 1); ss += __shfl_xor(ss, 2); ss += __shfl_xor(ss, 4); ss += __shfl_xor(ss, 8);
                const float sc = rsqrtf(ss + 1e-6f) * (sel == 0 ? 0.08838834764831845f : 1.0f);
#pragma unroll
                for (int i = 0; i < 8; ++i) acc[i] *= sc;
            }
            bf16* dst = (sel == 0 ? WSP(bf16, WS_QN) : (sel == 1 ? WSP(bf16, WS_KN) : WSP(bf16, WS_VN))) + (size_t)row * 512 + 8 * lane;
            *(v4u*)dst = pack8f(acc);
        }
    }
}

__device__ __forceinline__ void p3_chunk_prep(Frame& F, KArgs A) {
    const int tid = F.tid, lane = F.lane;
    LAS float* qs = (LAS float*)(F.lds); LAS float* ks = qs + 64 * 129; LAS float* vs = ks + 64 * 129;
    LAS float* As = vs + 64 * 129;
    LAS float* gcS = As + 64 * 65; LAS float* egS = gcS + 64; LAS float* ekS = egS + 64; LAS float* btS = ekS + 64;
    LAS float* Ts = qs;
    for (int cidx = F.bid; cidx < 1024; cidx += F.G) {
        const int b = cidx >> 9, h = (cidx >> 7) & 3, n = cidx & 127, row0 = b * SEQ + n * 64;
        unsigned char* blk = F.ws + WS_CHK + (size_t)cidx * CHK_STRIDE;
        if (tid < 64) {
            const float g = WSP(float, WS_GG)[(size_t)(row0 + tid) * 4 + h];
            float gc = g;
#pragma unroll
            for (int o = 1; o < 64; o <<= 1) { const float t = __shfl_up(gc, o); if (lane >= o) gc += t; }
            const float g63 = __shfl(gc, 63);
            gcS[tid] = gc; egS[tid] = __expf(gc); ekS[tid] = __expf(g63 - gc); btS[tid] = WSP(float, WS_BETA)[(size_t)(row0 + tid) * 4 + h];
            if (tid == 0) *(float*)(blk + CHK_GL) = __expf(g63);
        }
#pragma unroll
        for (int i = 0; i < 2; ++i) {
            const int id = tid + 512 * i, r = id >> 4, c8 = (id & 15) * 8; const size_t so = (size_t)(row0 + r) * 512 + h * 128 + c8;
            float f[8];
            unpack8(*(const v4u*)(WSP(bf16, WS_QN) + so), f);
#pragma unroll
            for (int x = 0; x < 8; ++x) qs[r * 129 + c8 + x] = f[x];
            unpack8(*(const v4u*)(WSP(bf16, WS_KN) + so), f);
#pragma unroll
            for (int x = 0; x < 8; ++x) ks[r * 129 + c8 + x] = f[x];
            unpack8(*(const v4u*)(WSP(bf16, WS_VN) + so), f);
#pragma unroll
            for (int x = 0; x < 8; ++x) vs[r * 129 + c8 + x] = f[x];
        }
        __syncthreads();
        {
            const int i = tid >> 3, jb = (tid & 7) * 8;
            float aK[8], aQ[8];
#pragma unroll
            for (int x = 0; x < 8; ++x) { aK[x] = 0.f; aQ[x] = 0.f; }
            for (int d = 0; d < 128; ++d) {
                const float ki = ks[i * 129 + d], qi = qs[i * 129 + d];
#pragma unroll
                for (int x = 0; x < 8; ++x) { const float kj = ks[(jb + x) * 129 + d]; aK[x] += ki * kj; aQ[x] += qi * kj; }
            }
            const float gci = gcS[i], bti = btS[i];
            float qk[8];
#pragma unroll
            for (int x = 0; x < 8; ++x) { const int j = jb + x; const float dec = __expf(j <= i ? gci - gcS[j] : 0.f);
                As[i * 65 + j] = (j < i) ? bti * aK[x] * dec : 0.f; qk[x] = (j <= i) ? aQ[x] * dec : 0.f; }
            const int s = jb >> 5, a = (jb >> 4) & 1, q0 = (jb >> 2) & 3;
            bf16* QKp = (bf16*)(blk + CHK_QK) + i * 64;
            v2u w0, w1; w0.x = pk2(qk[0], qk[1]); w0.y = pk2(qk[2], qk[3]); w1.x = pk2(qk[4], qk[5]); w1.y = pk2(qk[6], qk[7]);
            *(v2u*)(QKp + 32 * s + 8 * q0 + 4 * a) = w0; *(v2u*)(QKp + 32 * s + 8 * (q0 + 1) + 4 * a) = w1;
        }
        {
            const int i = tid >> 3, d0 = (tid & 7) * 16, s = d0 >> 5, a = (d0 >> 4) & 1; const float e = egS[i];
            bf16* Qd = (bf16*)(blk + CHK_QD) + i * 128;
#pragma unroll
            for (int q = 0; q < 4; ++q) { const LAS float* p = qs + i * 129 + d0 + 4 * q; v2u w; w.x = pk2(p[0] * e, p[1] * e); w.y = pk2(p[2] * e, p[3] * e); *(v2u*)(Qd + 32 * s + 8 * q + 4 * a) = w; }
        }
        {
            const int d = tid >> 2, c0 = (tid & 3) * 16, s = c0 >> 5, a = (c0 >> 4) & 1;
            bf16* Kd = (bf16*)(blk + CHK_KDT) + d * 64;
#pragma unroll
            for (int q = 0; q < 4; ++q) { const int c = c0 + 4 * q;
                v2u w; w.x = pk2(ks[c * 129 + d] * ekS[c], ks[(c + 1) * 129 + d] * ekS[c + 1]); w.y = pk2(ks[(c + 2) * 129 + d] * ekS[c + 2], ks[(c + 3) * 129 + d] * ekS[c + 3]);
                *(v2u*)(Kd + 32 * s + 8 * q + 4 * a) = w; }
        }
        __syncthreads();
        if (tid < 64) {
            for (int i = 0; i < 64; ++i) {
                float acc = (i == tid) ? 1.f : 0.f;
#pragma unroll 4
                for (int j = 0; j < i; ++j) acc -= As[i * 65 + j] * Ts[j * 65 + tid];
                Ts[i * 65 + tid] = acc;
            }
        }
        __syncthreads();
        {
            const int i = tid >> 3, c0 = (tid & 7) * 16;
            float aU[16], aW[16];
#pragma unroll
            for (int x = 0; x < 16; ++x) { aU[x] = 0.f; aW[x] = 0.f; }
            for (int j = 0; j <= i; ++j) {
                const float tb = Ts[i * 65 + j] * btS[j], tbe = tb * egS[j];
#pragma unroll
                for (int x = 0; x < 16; ++x) { aU[x] += tb * vs[j * 129 + c0 + x]; aW[x] += tbe * ks[j * 129 + c0 + x]; }
            }
            float* UT = (float*)(blk + CHK_UT);
#pragma unroll
            for (int x = 0; x < 16; ++x) UT[(c0 + x) * 64 + i] = aU[x];
            const int s = c0 >> 5, a = (c0 >> 4) & 1;
            bf16* Wp = (bf16*)(blk + CHK_WP) + i * 128;
#pragma unroll
            for (int q = 0; q < 4; ++q) { v2u w; w.x = pk2(aW[4 * q], aW[4 * q + 1]); w.y = pk2(aW[4 * q + 2], aW[4 * q + 3]); *(v2u*)(Wp + 32 * s + 8 * q + 4 * a) = w; }
        }
        __syncthreads();
    }
}

constexpr int SEQ_WGS = 16;
constexpr int SQ_WP = 0, SQ_QD = 16384, SQ_KDT = 32768, SQ_QK = 49152, SQ_BUF = 57344;
__device__ __forceinline__ bf16x8 packfrag(const f32x4 lo, const f32x4 hi) { v4u w; w.x = pg8::cvt_pk_bf16(lo[0], lo[1]); w.y = pg8::cvt_pk_bf16(lo[2], lo[3]); w.z = pg8::cvt_pk_bf16(hi[0], hi[1]); w.w = pg8::cvt_pk_bf16(hi[2], hi[3]); return __builtin_bit_cast(bf16x8, w); }
__device__ __forceinline__ void seq_stage(LAS unsigned char* buf, const unsigned char* blk, int lt) {
    v4u r[14];
#pragma unroll
    for (int i = 0; i < 14; ++i) r[i] = *(const v4u*)(blk + (size_t)(lt + 256 * i) * 16);
#pragma unroll
    for (int i = 0; i < 14; ++i) {
        const int id = lt + 256 * i; int dst;
        if (id < 2048) { const int rr = (id & 1023) >> 4, ch = id & 15; dst = (id & ~1023) * 16 + rr * 256 + 16 * (ch ^ (rr & 15)); }
        else { const int rr = (id - 2048) >> 3, ch = id & 7; dst = 32768 + rr * 128 + 16 * (ch ^ (rr & 7)); }
        *(LAS v4u*)(buf + dst) = r[i];
    }
}
__device__ __forceinline__ void p4_delta_seq(Frame& F, int sid) {
    const int lane = F.lane, wave = F.wave, tid = F.tid;
    const int bh = sid >> 1, half = sid & 1, b = bh >> 2, h = bh & 3;
    const int fr = lane & 15, fq = lane >> 4;
    const int v0 = half * 64 + (wave & 3) * 16;
    const unsigned char* cbase = F.ws + WS_CHK + (size_t)(bh * 128) * CHK_STRIDE;
    float* OD = WSP(float, WS_ODELTA);
    f32x4 Sacc[8];
#pragma unroll
    for (int T = 0; T < 8; ++T) Sacc[T] = (f32x4){0.f, 0.f, 0.f, 0.f};
    if (wave >= 4) seq_stage(F.lds, cbase, tid - 256);
    __syncthreads();
    for (int n = 0; n < 128; ++n) {
        LAS unsigned char* buf = F.lds + (n & 1) * SQ_BUF;
        if (wave >= 4) { if (n + 1 < 128) seq_stage(F.lds + ((n + 1) & 1) * SQ_BUF, cbase + (size_t)(n + 1) * CHK_STRIDE, tid - 256); }
        else {
            const unsigned char* blk = cbase + (size_t)n * CHK_STRIDE;
            const float gl = *(const float*)(blk + CHK_GL);
            const float* UT = (const float*)(blk + CHK_UT) + (size_t)(v0 + fr) * 64 + 4 * fq;
            f32x4 U[4];
#pragma unroll
            for (int tc = 0; tc < 4; ++tc) U[tc] = *(const f32x4*)(UT + 16 * tc);
            bf16x8 sf[4];
#pragma unroll
            for (int s = 0; s < 4; ++s) sf[s] = packfrag(Sacc[2 * s], Sacc[2 * s + 1]);
            f32x4 Vn[4], Oa[4];
#pragma unroll
            for (int tc = 0; tc < 4; ++tc) {
                const int rr = 16 * tc + fr; f32x4 av = (f32x4){0.f, 0.f, 0.f, 0.f}, ao = (f32x4){0.f, 0.f, 0.f, 0.f};
#pragma unroll
                for (int s = 0; s < 4; ++s) {
                    const int off = rr * 256 + 16 * ((4 * s + fq) ^ (rr & 15));
                    const bf16x8 wf = *(const LAS bf16x8*)(buf + SQ_WP + off), qf = *(const LAS bf16x8*)(buf + SQ_QD + off);
                    av = __builtin_amdgcn_mfma_f32_16x16x32_bf16(wf, sf[s], av, 0, 0, 0);
                    ao = __builtin_amdgcn_mfma_f32_16x16x32_bf16(qf, sf[s], ao, 0, 0, 0);
                }
                Vn[tc] = U[tc] - av; Oa[tc] = ao;
            }
            bf16x8 vf[2];
            vf[0] = packfrag(Vn[0], Vn[1]); vf[1] = packfrag(Vn[2], Vn[3]);
#pragma unroll
            for (int tc = 0; tc < 4; ++tc) {
                const int rr = 16 * tc + fr;
#pragma unroll
                for (int s = 0; s < 2; ++s) {
                    const bf16x8 kf = *(const LAS bf16x8*)(buf + SQ_QK + rr * 128 + 16 * ((4 * s + fq) ^ (rr & 7)));
                    Oa[tc] = __builtin_amdgcn_mfma_f32_16x16x32_bf16(kf, vf[s], Oa[tc], 0, 0, 0);
                }
                float* op = OD + (size_t)(b * SEQ + n * 64 + 16 * tc + 4 * fq) * 512 + h * 128 + v0 + fr;
#pragma unroll
                for (int j = 0; j < 4; ++j) op[(size_t)j * 512] = Oa[tc][j];
            }
#pragma unroll
            for (int T = 0; T < 8; ++T) {
                const int rr = 16 * T + fr; f32x4 a = Sacc[T] * gl;
#pragma unroll
                for (int s = 0; s < 2; ++s) {
                    const bf16x8 kf = *(const LAS bf16x8*)(buf + SQ_KDT + rr * 128 + 16 * ((4 * s + fq) ^ (rr & 7)));
                    a = __builtin_amdgcn_mfma_f32_16x16x32_bf16(kf, vf[s], a, 0, 0, 0);
                }
                Sacc[T] = a;
            }
        }
        __syncthreads();
    }
}

__device__ __forceinline__ void p4_indexer(Frame& F, int widx, int nw) {
    const int lane = F.lane, fr = lane & 15, fq = lane >> 4;
    const bf16* QL = WSP(bf16, WS_QL); const bf16* KI = WSP(bf16, WS_KIDX); const float* WI = WSP(float, WS_WIDX); float* SC = WSP(float, WS_BIG);
    for (int task = widx; task < 2 * 4352; task += nw) {
        const int b = task / 4352; int tau = task - b * 4352;
        int g = 0; while (16 * (g + 1) * (g + 2) <= tau) ++g;
        tau -= 16 * g * (g + 1);
        const int qt = 32 * g + tau / (g + 1), seg = tau % (g + 1);
        const int row0 = b * SEQ + 16 * qt;
        bf16x8 Qf[8][2];
#pragma unroll
        for (int hh = 0; hh < 8; ++hh)
#pragma unroll
            for (int s = 0; s < 2; ++s) Qf[hh][s] = *(const bf16x8*)(QL + (size_t)(row0 + fr) * 1536 + 1024 + hh * 64 + 32 * s + 8 * fq);
        f32x4 wv[4][2];
#pragma unroll
        for (int j = 0; j < 4; ++j) { wv[j][0] = *(const f32x4*)(WI + (size_t)(row0 + 4 * fq + j) * 8); wv[j][1] = *(const f32x4*)(WI + (size_t)(row0 + 4 * fq + j) * 8 + 4); }
        const int kt1 = (32 * seg + 31 < qt) ? 32 * seg + 31 : qt;
        for (int kt = 32 * seg; kt <= kt1; ++kt) {
            const bf16* kp = KI + (size_t)(b * SEQ + 16 * kt + fr) * 64 + 8 * fq;
            const bf16x8 k0 = *(const bf16x8*)kp, k1 = *(const bf16x8*)(kp + 32);
            f32x4 isc = (f32x4){0.f, 0.f, 0.f, 0.f};
#pragma unroll
            for (int hh = 0; hh < 8; ++hh) {
                f32x4 c = __builtin_amdgcn_mfma_f32_16x16x32_bf16(Qf[hh][0], k0, (f32x4){0.f, 0.f, 0.f, 0.f}, 0, 0, 0);
                c = __builtin_amdgcn_mfma_f32_16x16x32_bf16(Qf[hh][1], k1, c, 0, 0, 0);
#pragma unroll
                for (int j = 0; j < 4; ++j) isc[j] += fmaxf(c[j], 0.f) * wv[j][hh >> 2][hh & 3];
            }
            float* sp = SC + (size_t)(row0 + 4 * fq) * 8192 + 16 * kt + fr;
#pragma unroll
            for (int j = 0; j < 4; ++j) sp[(size_t)j * 8192] = isc[j];
        }
    }
}

__device__ __forceinline__ void p5_topk(Frame& F) {
    const int lane = F.lane, gw = F.bid * NWAVES + F.wave, NGW = F.G * NWAVES;
    const float* SC = WSP(float, WS_BIG); int* SEL = WSP(int, WS_SEL); int* NSEL = WSP(int, WS_NSEL);
    for (int rix = gw; rix < M; rix += NGW) {
        const int row = ((rix & 1) ? (M - 1 - (rix >> 1)) : (rix >> 1));
        const int pos = row & (SEQ - 1), n = pos + 1;
        int* sel = SEL + (size_t)row * 256;
        if (n <= 256) {
#pragma unroll
            for (int i = 0; i < 4; ++i) { const int j = 64 * i + lane; sel[j] = (j < n) ? j : 0; }
            if (lane == 0) NSEL[row] = n;
            continue;
        }
        const int nblk = (n + 1023) >> 10;
        const float* sr = SC + (size_t)row * 8192;
        unsigned u[128];
#pragma unroll
        for (int bk = 0; bk < 8; ++bk) {
            if (bk < nblk) {
#pragma unroll
                for (int i = 0; i < 16; ++i) { const int idx = (bk * 16 + i) * 64 + lane; unsigned x = 0u;
                    if (idx < n) { const unsigned bits = __float_as_uint(sr[idx]); x = (bits & 0x80000000u) ? ~bits : (bits | 0x80000000u); }
                    u[bk * 16 + i] = x; }
            } else {
#pragma unroll
                for (int i = 0; i < 16; ++i) u[bk * 16 + i] = 0u;
            }
        }
        unsigned T = 0u;
        for (int bit = 31; bit >= 0; --bit) {
            const unsigned cand = T | (1u << bit); int c = 0;
#pragma unroll
            for (int bk = 0; bk < 8; ++bk) {
                if (bk < nblk) {
#pragma unroll
                    for (int i = 0; i < 16; ++i) c += (u[bk * 16 + i] >= cand) ? 1 : 0;
                }
            }
            c = wave_sum_i(c);
            if (c >= 256) T = cand;
        }
        int cgt = 0;
#pragma unroll
        for (int bk = 0; bk < 8; ++bk) {
            if (bk < nblk) {
#pragma unroll
                for (int i = 0; i < 16; ++i) cgt += (u[bk * 16 + i] > T) ? 1 : 0;
            }
        }
        cgt = wave_sum_i(cgt);
        const int need_eq = 256 - cgt;
        int running = 0, eq_taken = 0;
        const unsigned long long ltmask = (1ull << lane) - 1ull;
#pragma unroll
        for (int bk = 0; bk < 8; ++bk) {
            if (bk < nblk) {
#pragma unroll
                for (int i = 0; i < 16; ++i) {
                    const unsigned x = u[bk * 16 + i];
                    const bool gt = x > T, eq = x == T;
                    const unsigned long long meq = __ballot(eq);
                    const bool take = gt || (eq && (eq_taken + __popcll(meq & ltmask)) < need_eq);
                    const unsigned long long mt = __ballot(take);
                    if (take) sel[running + __popcll(mt & ltmask)] = (bk * 16 + i) * 64 + lane;
                    running += __popcll(mt); eq_taken += __popcll(meq);
                }
            }
        }
        if (lane == 0) NSEL[row] = 256;
    }
}

__device__ __forceinline__ void p6_sparse_attn(Frame& F) {
    const int lane = F.lane, gw = F.bid * NWAVES + F.wave, NGW = F.G * NWAVES;
    LAS float* ql = (LAS float*)(F.lds + F.wave * 12288);
    LAS float* pp = ql + 1024;
    const bf16* QL = WSP(bf16, WS_QL); const bf16* CKV = WSP(bf16, WS_CKV); const int* SEL = WSP(int, WS_SEL); const int* NSEL = WSP(int, WS_NSEL); bf16* AO = WSP(bf16, WS_AO);
    for (int row = gw; row < M; row += NGW) {
        const int b = row >> 13, n = NSEL[row];
        const int* sel = SEL + (size_t)row * 256;
        {
            float f[8];
            unpack8(*(const v4u*)(QL + (size_t)row * 1536 + 8 * lane), f);
#pragma unroll
            for (int x = 0; x < 8; ++x) ql[8 * lane + x] = f[x];
            unpack8(*(const v4u*)(QL + (size_t)row * 1536 + 512 + 8 * lane), f);
#pragma unroll
            for (int x = 0; x < 8; ++x) ql[512 + 8 * lane + x] = f[x];
        }
        float s[4][8];
#pragma unroll
        for (int kb = 0; kb < 4; ++kb) {
            const int j = 64 * kb + lane; const bool valid = j < n; const int key = valid ? sel[j] : 0;
            const bf16* kr = CKV + (size_t)(b * SEQ + key) * 128;
#pragma unroll
            for (int hh = 0; hh < 8; ++hh) s[kb][hh] = 0.f;
#pragma unroll 4
            for (int r8 = 0; r8 < 16; ++r8) {
                float x[8]; unpack8(*(const v4u*)(kr + 8 * r8), x);
#pragma unroll
                for (int hh = 0; hh < 8; ++hh) { const f32x4 q0 = *(const LAS f32x4*)(ql + hh * 128 + 8 * r8), q1 = *(const LAS f32x4*)(ql + hh * 128 + 8 * r8 + 4);
                    s[kb][hh] += x[0] * q0[0] + x[1] * q0[1] + x[2] * q0[2] + x[3] * q0[3] + x[4] * q1[0] + x[5] * q1[1] + x[6] * q1[2] + x[7] * q1[3]; }
            }
            if (!valid) {
#pragma unroll
                for (int hh = 0; hh < 8; ++hh) s[kb][hh] = -INFINITY;
            }
        }
#pragma unroll
        for (int hh = 0; hh < 8; ++hh) {
            const float mx = wave_max(fmaxf(fmaxf(s[0][hh], s[1][hh]), fmaxf(s[2][hh], s[3][hh])));
            float e[4], l = 0.f;
#pragma unroll
            for (int kb = 0; kb < 4; ++kb) { e[kb] = __expf(s[kb][hh] - mx); l += e[kb]; }
            const float inv = 1.0f / wave_sum(l);
#pragma unroll
            for (int kb = 0; kb < 4; ++kb) pp[(64 * kb + lane) * 8 + hh] = e[kb] * inv;
        }
        float o[8][2];
#pragma unroll
        for (int hh = 0; hh < 8; ++hh) { o[hh][0] = 0.f; o[hh][1] = 0.f; }
        for (int j = 0; j < n; ++j) {
            const int key = sel[j];
            const unsigned kv = *(const unsigned*)(CKV + (size_t)(b * SEQ + key) * 128 + 2 * lane);
            const float lo = bflo(kv), hi = bfhi(kv);
            const f32x4 p0 = *(const LAS f32x4*)(pp + j * 8), p1 = *(const LAS f32x4*)(pp + j * 8 + 4);
#pragma unroll
            for (int hh = 0; hh < 4; ++hh) { o[hh][0] += p0[hh] * lo; o[hh][1] += p0[hh] * hi; o[4 + hh][0] += p1[hh] * lo; o[4 + hh][1] += p1[hh] * hi; }
        }
#pragma unroll
        for (int hh = 0; hh < 8; ++hh) *(unsigned*)(AO + (size_t)row * 1536 + hh * 128 + 2 * lane) = pk2(o[hh][0], o[hh][1]);
    }
}
__device__ __forceinline__ void p6_gdn_out(Frame& F, KArgs A) {
    const int lane = F.lane, gw = F.bid * NWAVES + F.wave, NGW = F.G * NWAVES;
    const f32x4 g0 = *(const f32x4*)(A->in[I_AB_ONG] + 8 * (lane & 15)), g1 = *(const f32x4*)(A->in[I_AB_ONG] + 8 * (lane & 15) + 4);
    for (int row = gw; row < M; row += NGW) {
        const float* op = WSP(float, WS_ODELTA) + (size_t)row * 512 + 8 * lane;
        const f32x4 a = *(const f32x4*)op, b = *(const f32x4*)(op + 4);
        float ss = a[0] * a[0] + a[1] * a[1] + a[2] * a[2] + a[3] * a[3] + b[0] * b[0] + b[1] * b[1] + b[2] * b[2] + b[3] * b[3];
        ss += __shfl_xor(ss, 1); ss += __shfl_xor(ss, 2); ss += __shfl_xor(ss, 4); ss += __shfl_xor(ss, 8);
        const float r = rsqrtf(ss * (1.0f / 128.0f) + 1e-6f);
        float z[8]; unpack8(*(const v4u*)(WSP(bf16, WS_QKVZ) + (size_t)row * 2048 + 1536 + 8 * lane), z);
        float o[8];
#pragma unroll
        for (int i = 0; i < 4; ++i) { o[i] = a[i] * r * g0[i] * siluf(z[i]); o[4 + i] = b[i] * r * g1[i] * siluf(z[4 + i]); }
        *(v4u*)(WSP(bf16, WS_AO) + (size_t)row * 1536 + 1024 + 8 * lane) = pack8f(o);
    }
}

__device__ __forceinline__ void p8_ln_router(Frame& F, KArgs A, int l, float* HOUT, bf16* HB) {
    const int lane = F.lane, tid = F.tid, gw = F.bid * NWAVES + F.wave, NGW = F.G * NWAVES;
    LAS float* wT = (LAS float*)(F.lds);
    LAS float* lg = (LAS float*)(F.lds + WSCR_OFF + F.wave * WSCR_BYTES);
    const float* rw = A->in[I_RW] + (size_t)l * 1024 * 32;
    for (int i = tid; i < 1024 * 32; i += NTHREADS) { const int k = i >> 5, e = i & 31; wT[e * 1028 + k] = rw[i]; }
    __syncthreads();
    const float* PRE = WSP(float, WS_PRE);
    const float* lg_g = A->in[I_LNM_G] + (size_t)l * 1024; const float* lg_b = A->in[I_LNM_B] + (size_t)l * 1024;
    const float rb = A->in[I_RB][l * 32 + (lane & 31)];
    int* TOKE = WSP(int, WS_ROUTE); int* TOKPOS = TOKE + M * 4; float* TOKG = (float*)(TOKPOS + M * 4);
    gu32* cnt = F.ctl + CW_CNT + 64 * l;
    for (int row = gw; row < M; row += NGW) {
        f32x4 v[4]; float s = 0.f;
#pragma unroll
        for (int j = 0; j < 4; ++j) { v[j] = *(const f32x4*)(PRE + (size_t)row * 1024 + 256 * j + 4 * lane); s += (v[j][0] + v[j][1]) + (v[j][2] + v[j][3]); }
        const float mean = wave_sum(s) * (1.0f / 1024.0f); float s2 = 0.f;
#pragma unroll
        for (int j = 0; j < 4; ++j) { v[j] = v[j] - mean; s2 += (v[j][0] * v[j][0] + v[j][1] * v[j][1]) + (v[j][2] * v[j][2] + v[j][3] * v[j][3]); }
        const float rstd = rsqrtf(wave_sum(s2) * (1.0f / 1024.0f) + 1e-5f);
#pragma unroll
        for (int j = 0; j < 4; ++j) {
            const f32x4 g = *(const f32x4*)(lg_g + 256 * j + 4 * lane), bb = *(const f32x4*)(lg_b + 256 * j + 4 * lane);
            v[j] = v[j] * rstd * g + bb;
            *(f32x4*)(HOUT + (size_t)row * 1024 + 256 * j + 4 * lane) = v[j];
            v2u o; o.x = pk2(v[j][0], v[j][1]); o.y = pk2(v[j][2], v[j][3]); *(v2u*)(HB + (size_t)row * 1024 + 256 * j + 4 * lane) = o;
        }
        float part[32];
#pragma unroll
        for (int e = 0; e < 32; ++e) {
            float a = 0.f;
#pragma unroll
            for (int j = 0; j < 4; ++j) { const f32x4 w = *(const LAS f32x4*)(wT + e * 1028 + 256 * j + 4 * lane); a += v[j][0] * w[0] + v[j][1] * w[1] + v[j][2] * w[2] + v[j][3] * w[3]; }
            part[e] = a;
        }
#pragma unroll
        for (int i = 0; i < 16; ++i) { const bool up = (lane & 32) != 0; const float keep = up ? part[i + 16] : part[i], send = up ? part[i] : part[i + 16]; part[i] = keep + __shfl_xor(send, 32); }
#pragma unroll
        for (int i = 0; i < 8; ++i) { const bool up = (lane & 16) != 0; const float keep = up ? part[i + 8] : part[i], send = up ? part[i] : part[i + 8]; part[i] = keep + __shfl_xor(send, 16); }
#pragma unroll
        for (int i = 0; i < 4; ++i) { const bool up = (lane & 8) != 0; const float keep = up ? part[i + 4] : part[i], send = up ? part[i] : part[i + 4]; part[i] = keep + __shfl_xor(send, 8); }
#pragma unroll
        for (int i = 0; i < 2; ++i) { const bool up = (lane & 4) != 0; const float keep = up ? part[i + 2] : part[i], send = up ? part[i] : part[i + 2]; part[i] = keep + __shfl_xor(send, 4); }
        { const bool up = (lane & 2) != 0; const float keep = up ? part[1] : part[0], send = up ? part[0] : part[1]; part[0] = keep + __shfl_xor(send, 2); }
        part[0] += __shfl_xor(part[0], 1);
        const int eidx = ((lane >> 5) & 1) * 16 + ((lane >> 4) & 1) * 8 + ((lane >> 3) & 1) * 4 + ((lane >> 2) & 1) * 2 + ((lane >> 1) & 1);
        if ((lane & 1) == 0) lg[eidx] = part[0];
        float val = (lane < 32) ? lg[lane & 31] + rb : -INFINITY;
        float tl[4]; int te[4];
#pragma unroll
        for (int k = 0; k < 4; ++k) {
            const float mx = wave_max(val);
            const unsigned long long mm = __ballot(val == mx && lane < 32);
            const int idx = __ffsll((long long)mm) - 1;
            tl[k] = mx; te[k] = idx;
            if (lane == idx) val = -INFINITY;
        }
        const float e1 = __expf(tl[1] - tl[0]), e2 = __expf(tl[2] - tl[0]), e3 = __expf(tl[3] - tl[0]);
        const float inv = 1.0f / (1.0f + e1 + e2 + e3);
        if (lane < 4) {
            const int e = lane == 0 ? te[0] : (lane == 1 ? te[1] : (lane == 2 ? te[2] : te[3]));
            const float g = (lane == 0 ? 1.0f : (lane == 1 ? e1 : (lane == 2 ? e2 : e3))) * inv;
            const unsigned pos = __hip_atomic_fetch_add(cnt + e, 1u, RLX_AGENT);
            TOKE[(size_t)row * 4 + lane] = e; TOKPOS[(size_t)row * 4 + lane] = (int)pos; TOKG[(size_t)row * 4 + lane] = g;
        }
    }
}

__device__ __forceinline__ void p9_scatter(Frame& F, int l, const bf16* HB) {
    const int lane = F.lane, tid = F.tid, gw = F.bid * NWAVES + F.wave, NGW = F.G * NWAVES;
    LAS int* base = (LAS int*)(F.lds + MISC_OFF + 256);
    int* TOKE = WSP(int, WS_ROUTE); int* TOKPOS = TOKE + M * 4; int* TILE = TOKE + 3 * M * 4;
    if (tid == 0) {
        int acc = 0;
        for (int e = 0; e < NEXP; ++e) { const int c = (int)__hip_atomic_load(F.ctl + CW_CNT + 64 * l + e, RLX_AGENT); base[e] = acc; acc += ((c + 255) >> 8) << 8; }
        base[32] = acc >> 8;
    }
    __syncthreads();
    if (F.bid == 0 && tid < 64) {
        const int nT = base[32];
        for (int t = tid; t < NTMAX; t += 64) { int e = 0;
            for (int x = 1; x < NEXP; ++x) if (base[x] <= t * 256) e = x;
            TILE[t] = (t < nT) ? e : 0; }
        if (tid == 0) TILE[NTMAX] = nT;
    }
    bf16* XS = WSP(bf16, WS_XS);
    for (int row = gw; row < M; row += NGW) {
        const v4u a = *(const v4u*)(HB + (size_t)row * 1024 + 8 * lane), b = *(const v4u*)(HB + (size_t)row * 1024 + 512 + 8 * lane);
#pragma unroll
        for (int k = 0; k < 4; ++k) {
            const int slot = base[TOKE[(size_t)row * 4 + k]] + TOKPOS[(size_t)row * 4 + k];
            *(v4u*)(XS + (size_t)slot * 1024 + 8 * lane) = a; *(v4u*)(XS + (size_t)slot * 1024 + 512 + 8 * lane) = b;
        }
    }
}

__device__ __forceinline__ void p12_combine(Frame& F, KArgs A, int l, const float* HIN, float* HOUT, bf16* HB) {
    const int lane = F.lane, tid = F.tid, gw = F.bid * NWAVES + F.wave, NGW = F.G * NWAVES;
    LAS int* base = (LAS int*)(F.lds + MISC_OFF + 256);
    if (tid == 0) { int acc = 0; for (int e = 0; e < NEXP; ++e) { const int c = (int)__hip_atomic_load(F.ctl + CW_CNT + 64 * l + e, RLX_AGENT); base[e] = acc; acc += ((c + 255) >> 8) << 8; } }
    __syncthreads();
    const int* TOKE = WSP(int, WS_ROUTE); const int* TOKPOS = TOKE + M * 4; const float* TOKG = (const float*)(TOKPOS + M * 4);
    const bf16* YS = WSP(bf16, WS_YS); const bf16* PLE = WSP(bf16, WS_PLE);
    const float* lg_g = A->in[I_LNF_G] + (size_t)l * 1024; const float* lg_b = A->in[I_LNF_B] + (size_t)l * 1024;
    for (int row = gw; row < M; row += NGW) {
        float x[16];
        {   const f32x4 h0 = *(const f32x4*)(HIN + (size_t)row * 1024 + 8 * lane), h1 = *(const f32x4*)(HIN + (size_t)row * 1024 + 8 * lane + 4);
            const f32x4 h2 = *(const f32x4*)(HIN + (size_t)row * 1024 + 512 + 8 * lane), h3 = *(const f32x4*)(HIN + (size_t)row * 1024 + 512 + 8 * lane + 4);
            float p0[8], p1[8]; unpack8(*(const v4u*)(PLE + (size_t)row * 1024 + 8 * lane), p0); unpack8(*(const v4u*)(PLE + (size_t)row * 1024 + 512 + 8 * lane), p1);
#pragma unroll
            for (int i = 0; i < 4; ++i) { x[i] = ALPHA * h0[i] + p0[i]; x[4 + i] = ALPHA * h1[i] + p0[4 + i]; x[8 + i] = ALPHA * h2[i] + p1[i]; x[12 + i] = ALPHA * h3[i] + p1[4 + i]; }
        }
#pragma unroll
        for (int k = 0; k < 4; ++k) {
            const int slot = base[TOKE[(size_t)row * 4 + k]] + TOKPOS[(size_t)row * 4 + k]; const float g = TOKG[(size_t)row * 4 + k];
            float y0[8], y1[8]; unpack8(*(const v4u*)(YS + (size_t)slot * 1024 + 8 * lane), y0); unpack8(*(const v4u*)(YS + (size_t)slot * 1024 + 512 + 8 * lane), y1);
#pragma unroll
            for (int i = 0; i < 8; ++i) { x[i] += g * y0[i]; x[8 + i] += g * y1[i]; }
        }
        float s = 0.f;
#pragma unroll
        for (int i = 0; i < 16; ++i) s += x[i];
        const float mean = wave_sum(s) * (1.0f / 1024.0f); float s2 = 0.f;
#pragma unroll
        for (int i = 0; i < 16; ++i) { x[i] -= mean; s2 += x[i] * x[i]; }
        const float rstd = rsqrtf(wave_sum(s2) * (1.0f / 1024.0f) + 1e-5f);
#pragma unroll
        for (int hf = 0; hf < 2; ++hf) {
            const int c0 = 512 * hf + 8 * lane;
            const f32x4 g0 = *(const f32x4*)(lg_g + c0), g1 = *(const f32x4*)(lg_g + c0 + 4), b0 = *(const f32x4*)(lg_b + c0), b1 = *(const f32x4*)(lg_b + c0 + 4);
            f32x4 o0, o1;
#pragma unroll
            for (int i = 0; i < 4; ++i) { o0[i] = x[8 * hf + i] * rstd * g0[i] + b0[i]; o1[i] = x[8 * hf + 4 + i] * rstd * g1[i] + b1[i]; }
            *(f32x4*)(HOUT + (size_t)row * 1024 + c0) = o0; *(f32x4*)(HOUT + (size_t)row * 1024 + c0 + 4) = o1;
            if (HB) { v4u w; w.x = pk2(o0[0], o0[1]); w.y = pk2(o0[2], o0[3]); w.z = pk2(o1[0], o1[1]); w.w = pk2(o1[2], o1[3]); *(v4u*)(HB + (size_t)row * 1024 + c0) = w; }
        }
    }
}

__device__ __forceinline__ void p14_dilated(Frame& F) {
    const int lane = F.lane, gw = F.bid * NWAVES + F.wave, NGW = F.G * NWAVES;
    LAS float* pe = (LAS float*)(F.lds + F.wave * 2048);
    const bf16* QK = WSP(bf16, WS_QKVZ); bf16* AO = WSP(bf16, WS_AO);
    for (int task = gw; task < M * 12; task += NGW) {
        const int row = task / 12, hh = task - row * 12, b = row >> 13, pos = row & (SEQ - 1);
        float q[64];
#pragma unroll
        for (int c = 0; c < 8; ++c) { float f[8]; unpack8(*(const v4u*)(QK + (size_t)row * 2560 + hh * 64 + 8 * c), f);
#pragma unroll
            for (int x = 0; x < 8; ++x) q[8 * c + x] = f[x]; }
        float s[7];
#pragma unroll
        for (int i = 0; i < 7; ++i) {
            const int e = lane + 64 * i, p = e / 129, m = e - p * 129;
            const int dd = (p == 0) ? 1 : (p == 1 ? 4 : 16);
            const int kpos = pos - m * dd; const bool valid = (e < 387) && (kpos >= 0);
            float a = -INFINITY;
            if (valid) {
                const bf16* kr = QK + (size_t)(b * SEQ + kpos) * 2560 + 768 + hh * 64; a = 0.f;
#pragma unroll
                for (int c = 0; c < 8; ++c) { float f[8]; unpack8(*(const v4u*)(kr + 8 * c), f);
#pragma unroll
                    for (int x = 0; x < 8; ++x) a += q[8 * c + x] * f[x]; }
                a *= 0.125f;
            }
            s[i] = a;
        }
        float mx = s[0];
#pragma unroll
        for (int i = 1; i < 7; ++i) mx = fmaxf(mx, s[i]);
        mx = wave_max(mx);
        float l = 0.f;
#pragma unroll
        for (int i = 0; i < 7; ++i) { const float ev = __expf(s[i] - mx); pe[lane + 64 * i] = ev; l += ev; }
        l = wave_sum(l);
        float o = 0.f;
#pragma unroll
        for (int p = 0; p < 3; ++p) {
            const int dd = (p == 0) ? 1 : (p == 1 ? 4 : 16);
            int mmax = pos / dd; if (mmax > 128) mmax = 128;
            const bf16* vb = QK + (size_t)(b * SEQ + pos) * 2560 + 1536 + hh * 64 + lane;
            for (int m = 0; m <= mmax; ++m) o += pe[p * 129 + m] * bf1(vb[-(ptrdiff_t)m * dd * 2560]);
        }
        AO[(size_t)row * 1024 + hh * 64 + lane] = (bf16)f2bf(o / l);
    }
}
__device__ __forceinline__ void p14_pool(Frame& F, KArgs A) {
    const int lane = F.lane, tid = F.tid, gw = F.bid * NWAVES + F.wave, NGW = F.G * NWAVES;
    LAS float* pw = (LAS float*)(F.lds + 16384);
    LAS float* dl = (LAS float*)(F.lds + 16384 + 65536 + F.wave * 1024);
    for (int i = tid; i < 4 * 64 * 64; i += NTHREADS) pw[i] = A->in[I_CD_POOLW][i];
    __syncthreads();
    const bf16* QK = WSP(bf16, WS_QKVZ); bf16* AO = WSP(bf16, WS_AO);
    const int gi = lane >> 4, w = 2 << gi;
    float sc[4];
#pragma unroll
    for (int g = 0; g < 4; ++g) sc[g] = A->in[I_CD_POOLS][g * 64 + lane];
    for (int row = gw; row < M; row += NGW) {
        const int pos = row & (SEQ - 1);
        const int cntw = (pos + 1 < w) ? pos + 1 : w;
        float sum[4] = {0.f, 0.f, 0.f, 0.f}, cur[4] = {0.f, 0.f, 0.f, 0.f};
        for (int j = 0; j < cntw; ++j) {
            const v2u xr = *(const v2u*)(QK + (size_t)(row - j) * 2560 + 2304 + 4 * lane);
            const float f0 = bflo(xr.x), f1 = bfhi(xr.x), f2 = bflo(xr.y), f3 = bfhi(xr.y);
            sum[0] += f0; sum[1] += f1; sum[2] += f2; sum[3] += f3;
            if (j == 0) { cur[0] = f0; cur[1] = f1; cur[2] = f2; cur[3] = f3; }
        }
        const float inv = 1.0f / (float)cntw;
#pragma unroll
        for (int i = 0; i < 4; ++i) dl[4 * lane + i] = sum[i] * inv - cur[i];
        float o[4] = {0.f, 0.f, 0.f, 0.f};
        for (int c = 0; c < 64; ++c) {
#pragma unroll
            for (int g = 0; g < 4; ++g) o[g] += dl[g * 64 + c] * pw[(g * 64 + c) * 64 + lane];
        }
#pragma unroll
        for (int g = 0; g < 4; ++g) AO[(size_t)row * 1024 + 768 + g * 64 + lane] = (bf16)f2bf(o[g] * sc[g]);
    }
}


#define IN(k) (lo <= (k) && (k) < hi)
#define SEAM(k) do { if (IN(k) && IN((k) + 1)) xcd_barrier(bar); } while (0)
template <int l> __device__ __forceinline__ void layer_tail(Frame& F, const XcdBarrier& bar, const int lo, const int hi) {
    LAS unsigned char* ring = F.lds + RING_OFF;
    const int bid = F.bid, G = F.G;
        const int pb = 8 * l;

        if (IN(7 + pb)) {
            pg8::Gemm g{WSP(bf16, WS_AO), (l == 0) ? WSP(bf16, WS_W_OUTAB) : WSP(bf16, WS_W_OUTCD), M, 1024, (l == 0) ? 1536 : 1024}; pg8::StaticOrder S; S.init(M, 1024, G, bid);
            pg8::Epi<pg8::StPre> E{{(l == 0) ? kargs()->in[I_X] : WSP(float, WS_H2), WSP(float, WS_PRE), ALPHA}};
            pg8::gemm_phase<pg8::Epi<pg8::StPre>, pg8::StaticOrder, true, true>(ring, g, S, E);
        } SEAM(7 + pb);
        if (IN(8 + pb)) { p8_ln_router(F, kargs(), l, WSP(float, WS_H1), WSP(bf16, WS_H1B)); } SEAM(8 + pb);
        if (IN(9 + pb)) {
            p9_scatter(F, l, WSP(bf16, WS_H1B));
            __syncthreads();
            pg8::Gemm g{WSP(bf16, WS_H1B), WSP(bf16, WS_W_PG) + (size_t)l * 1024 * 1024, M, 1024, 1024}; pg8::StaticOrder S; S.init(M, 1024, G, bid);
            pg8::Epi<pg8::StPleGate> E{{WSP(bf16, WS_PP) + (size_t)l * M * 1024, WSP(bf16, WS_PLE)}};
            pg8::gemm_phase<pg8::Epi<pg8::StPleGate>, pg8::StaticOrder, true, true>(ring, g, S, E);
        } SEAM(9 + pb);
        const int* TILE = WSP(int, WS_ROUTE) + 3 * M * 4;
        if (IN(10 + pb)) {
            const int nT = __builtin_amdgcn_readfirstlane(TILE[NTMAX]);
            pg8::Gemm g{WSP(bf16, WS_XS), WSP(bf16, WS_W_GU) + (size_t)l * NEXP * 2048 * 1024, PMAX, 2048, 1024};
            pg8::MoeOrder S{TILE, nT, 8, G, bid, (long)2048 * 1024 * 2};
            pg8::Epi<pg8::StSwiglu> E{{kargs()->in[I_BGU] + (size_t)l * NEXP * 2048, WSP(bf16, WS_HID)}};
            pg8::gemm_phase<pg8::Epi<pg8::StSwiglu>, pg8::MoeOrder, true, true>(ring, g, S, E);
        } SEAM(10 + pb);
        if (IN(11 + pb)) {
            const int nT = __builtin_amdgcn_readfirstlane(TILE[NTMAX]);
            pg8::Gemm g{WSP(bf16, WS_HID), WSP(bf16, WS_W_DN) + (size_t)l * NEXP * 1024 * 1024, PMAX, 1024, 1024};
            pg8::MoeOrder S{TILE, nT, 4, G, bid, (long)1024 * 1024 * 2};
            pg8::Epi<pg8::StDown> E{{kargs()->in[I_BDN] + (size_t)l * NEXP * 1024, WSP(bf16, WS_YS)}};
            pg8::gemm_phase<pg8::Epi<pg8::StDown>, pg8::MoeOrder, true, true>(ring, g, S, E);
        } SEAM(11 + pb);
        if (IN(12 + pb)) { p12_combine(F, kargs(), l, WSP(float, WS_H1), (l == 0) ? WSP(float, WS_H2) : kargs()->out, (l == 0) ? WSP(bf16, WS_XB) : (bf16*)nullptr); }
}
#undef IN
#undef SEAM
__global__ void __launch_bounds__(NTHREADS, 2) mk_fwd(Args args_by_value) {
    const KArgs KA = kargs();
    extern __shared__ __attribute__((aligned(16))) unsigned char lds[];
    Frame F;
    F.lds = (LAS unsigned char*)lds;
    F.tid = threadIdx.x; F.lane = F.tid & 63; F.wave = __builtin_amdgcn_readfirstlane(F.tid >> 6);
    F.G = gridDim.x; F.bid = blockIdx.x; F.ws = KA->ws; F.ctl = (gu32*)(KA->ws + WS_CTL);
    volatile LAS unsigned* MISC = (volatile LAS unsigned*)(F.lds + MISC_OFF);
    { int t0 = threadIdx.x; asm volatile("" : "+v"(t0)); for (int u = t0; u < (LDS_BYTES - MISC_OFF) / 4; u += NTHREADS) MISC[u] = 0u; }
    __syncthreads();
    const bool use_bar = (N_LAUNCHES != NPHASES);
    XcdBarrier bar; bar.bar = (unsigned*)(F.ctl + CW_BAR) + KA->li * XCD_BAR_WORDS; bar.x = 0; bar.st = nullptr;
    if (use_bar) bar = xcd_barrier_post((unsigned*)(F.ctl + CW_BAR) + KA->li * XCD_BAR_WORDS, MISC + 8);
    const int lo = KA->ph_lo, hi = KA->ph_hi;
#define IN(k) (lo <= (k) && (k) < hi)
#define SEAM(k) do { if (IN(k) && IN((k) + 1)) xcd_barrier(bar); } while (0)
    LAS unsigned char* ring = F.lds + RING_OFF;
    const int bid = F.bid, G = F.G;

    if (IN(0)) { p0_prologue(F, kargs()); } SEAM(0);

            if (IN(1)) {
                { pg8::Gemm g{WSP(bf16, WS_XB), WSP(bf16, WS_W_INAB), M, 2560, 1024}; pg8::StaticOrder S; S.init(M, 2560, G, bid);
                  pg8::Epi<pg8::StInAB> E{{WSP(float, WS_SM), WSP(bf16, WS_QKVZ)}};
                  pg8::gemm_phase<pg8::Epi<pg8::StInAB>, pg8::StaticOrder, true, true>(ring, g, S, E); }
                __syncthreads();
                { pg8::Gemm g{WSP(bf16, WS_PB), WSP(bf16, WS_W_PP), 2 * M, 1024, 256}; pg8::BatchOrder S{4, (2 * M / 256) * 4, G, bid, M / 256, (long)1024 * 256 * 2};
                  pg8::Epi<pg8::StBf16> E{{WSP(bf16, WS_PP), 1024}};
                  pg8::gemm_phase<pg8::Epi<pg8::StBf16>, pg8::BatchOrder, true, true>(ring, g, S, E); }
            } SEAM(1);
            if (IN(2)) { p2_prep(F, kargs()); } SEAM(2);
            if (IN(3)) {
                { pg8::Gemm g{WSP(bf16, WS_CQ), WSP(bf16, WS_W_ABS), M, 1536, 256}; pg8::StaticOrder S; S.init(M, 1536, G, bid);
                  pg8::Epi<pg8::StBf16> E{{WSP(bf16, WS_QL), 1536}};
                  pg8::gemm_phase<pg8::Epi<pg8::StBf16>, pg8::StaticOrder, true, true>(ring, g, S, E); }
                __syncthreads();
                p3_chunk_prep(F, kargs());
            } SEAM(3);
            if (IN(4)) {
                if (bid < SEQ_WGS && G > SEQ_WGS) p4_delta_seq(F, bid);
                else p4_indexer(F, (bid - SEQ_WGS) * NWAVES + F.wave, (G - SEQ_WGS) * NWAVES);
            } SEAM(4);
            if (IN(5)) { p5_topk(F); } SEAM(5);
            if (IN(6)) { p6_sparse_attn(F); p6_gdn_out(F, kargs()); } SEAM(6);
    layer_tail<0>(F, bar, lo, hi);
    SEAM(12);
            if (IN(13)) {
                pg8::Gemm g{WSP(bf16, WS_XB), WSP(bf16, WS_W_INCD), M, 2560, 1024}; pg8::StaticOrder S; S.init(M, 2560, G, bid);
                pg8::Epi<pg8::StBf16> E{{WSP(bf16, WS_QKVZ), 2560}};
                pg8::gemm_phase<pg8::Epi<pg8::StBf16>, pg8::StaticOrder, true, true>(ring, g, S, E);
            } SEAM(13);
            if (IN(14)) { p14_dilated(F); p14_pool(F, kargs()); } SEAM(14);
    layer_tail<1>(F, bar, lo, hi);
#undef IN
#undef SEAM
}

extern "C" void kernel_launch(void* const* d_in, const int* in_sizes, int n_in, void* d_out, int out_size, void* d_ws, size_t ws_size, hipStream_t stream) {
    static int grid = 0;
    if (grid == 0) {
        if (n_in != N_IN || in_sizes[0] != M * D || out_size != M * D || ws_size < WS_END) {
            fprintf(stderr, "kernel_launch: built for %d inputs, x/out of %d floats, >= %zu bytes of workspace; got n_in %d, in0 %d, out %d, ws %zu; nothing launched\n", N_IN, M * D, (size_t)WS_END, n_in, n_in > 0 ? in_sizes[0] : -1, out_size, ws_size);
            grid = -1; return; }
        int dev = 0, cus = 0, per_cu = 0;
        if (hipGetDevice(&dev) != hipSuccess || hipDeviceGetAttribute(&cus, hipDeviceAttributeMultiprocessorCount, dev) != hipSuccess) { fprintf(stderr, "kernel_launch: device query failed\n"); grid = -1; return; }
        if (hipFuncSetAttribute((const void*)mk_fwd, hipFuncAttributeMaxDynamicSharedMemorySize, LDS_BYTES) != hipSuccess) { fprintf(stderr, "kernel_launch: hipFuncSetAttribute failed\n"); grid = -1; return; }
        if (hipOccupancyMaxActiveBlocksPerMultiprocessor(&per_cu, (const void*)mk_fwd, NTHREADS, LDS_BYTES) != hipSuccess || per_cu < 1)
            fprintf(stderr, "kernel_launch: note: occupancy query reports %d workgroups per CU\n", per_cu);
        (void)hipGetLastError();
        grid = cus;
    }
    if (grid < 0) return;
    if (hipMemsetAsync((char*)d_ws + WS_CTL, 0, CTL_ZERO_BYTES, stream) != hipSuccess) { fprintf(stderr, "kernel_launch: memset failed\n"); return; }
    Args a{};
    for (int i = 0; i < N_IN; ++i) a.in[i] = (const float*)d_in[i];
    a.out = (float*)d_out; a.ws = (unsigned char*)d_ws;
    for (int li = 0; li < N_LAUNCHES; ++li) {
        if (N_LAUNCHES == NPHASES) { a.ph_lo = li; a.ph_hi = li + 1; } else { a.ph_lo = (int)((long)li * NPHASES / N_LAUNCHES); a.ph_hi = (int)((long)(li + 1) * NPHASES / N_LAUNCHES); }
        a.li = li;
        hipLaunchKernelGGL(mk_fwd, dim3(grid), dim3(NTHREADS), LDS_BYTES, stream, a);
        const hipError_t le = hipPeekAtLastError();
        if (le != hipSuccess) { fprintf(stderr, "kernel_launch: launch %d failed: %s\n", li, hipGetErrorName(le)); break; }
    }
}
```

```cpp
#include <hip/hip_runtime.h>
#include <cstdio>
#include <cstdint>

namespace pg8 {
#define PG8_LAS __attribute__((address_space(3)))
typedef unsigned short bf16_t;
typedef short bf16x8 __attribute__((ext_vector_type(8)));
typedef float f32x4 __attribute__((ext_vector_type(4)));
typedef unsigned u32x4 __attribute__((ext_vector_type(4)));
constexpr int BM = 256, BK = 64, HALF = 128, HTB = HALF * BK * 2  , STAGE_BYTES = 8 * HTB, NXCD = 8, WGM = 8;

__host__ __device__ __forceinline__ int lds_byte(int r, int c) { const int st = (r >> 4) * 2 + (c >> 5), rr = r & 15, cc = c & 31, ob = rr * 64 + cc * 2; return st * 1024 + (ob ^ (((ob >> 9) & 1) << 5)); }
__host__ __device__ __forceinline__ void stage_rc(int b, int& R, int& C) { const int st = b / 1024, sb = b % 1024, swz = sb ^ (((sb >> 9) & 1) << 5); R = (st >> 1) * 16 + swz / 64; C = (st & 1) * 32 + (swz % 64) / 2; }
__host__ __device__ __forceinline__ int perm32(int rho) { const int n = rho >> 4, i = rho & 15; return 8 * (i >> 2) + 4 * n + (i & 3); }

struct Unit { int pm, pn, e; long bofs; };
struct Gemm { const bf16_t* A; const bf16_t* Bt; int M, N, K; };

struct StaticOrder {
    int nM, nN, nwg, G, c;
    __host__ __device__ void init(int M, int N, int G_, int c_) { nM = M / BM; nN = N / BM; nwg = nM * nN; G = G_; c = c_; }
    __host__ __device__ bool next(int i, Unit& u) const {
        const long L = (long)i * G + c; if (L >= nwg) return false;
        int wgid = (int)L; { const int q = nwg / NXCD, r = nwg % NXCD, xcd = wgid % NXCD, off = wgid / NXCD; wgid = (xcd < r ? xcd * (q + 1) : r * (q + 1) + (xcd - r) * q) + off; }
        const int nig = WGM * nN, gid = wgid / nig, fm = gid * WGM, gsz = (nM - fm) < WGM ? (nM - fm) : WGM;
        u.pm = fm + ((wgid % nig) % gsz); u.pn = (wgid % nig) / gsz; u.e = 0; u.bofs = 0; return true;
    }
    __device__ __forceinline__ void a_ready(const Unit&) const {}
    __device__ __forceinline__ void done(const Unit&) const {}
};
struct MoeOrder {
    const int* tile_e; int nT, nN, G, c; long estride;
    __device__ __forceinline__ bool next(int i, Unit& u) const {
        const long L = (long)i * G + c; if (L >= (long)nT * nN) return false;
        u.pm = (int)(L / nN); u.pn = (int)(L % nN); const int e = tile_e[u.pm]; u.e = e; u.bofs = (long)e * estride; return true;
    }
    __device__ __forceinline__ void a_ready(const Unit&) const {}
    __device__ __forceinline__ void done(const Unit&) const {}
};

struct BatchOrder {
    int nN, nwg, G, c, tiles_per_batch; long bstride;
    __device__ __forceinline__ bool next(int i, Unit& u) const {
        const long L = (long)i * G + c; if (L >= nwg) return false;
        u.pm = (int)(L / nN); u.pn = (int)(L % nN); const int e = u.pm / tiles_per_batch; u.e = e; u.bofs = (long)e * bstride; return true;
    }
    __device__ __forceinline__ void a_ready(const Unit&) const {}
    __device__ __forceinline__ void done(const Unit&) const {}
};

__device__ __forceinline__ unsigned cvt_pk_bf16(float lo, float hi) { unsigned r; asm volatile("v_cvt_pk_bf16_f32 %0, %1, %2" : "=v"(r) : "v"(lo), "v"(hi)); return r; }
__device__ __forceinline__ u32x4 pack8(const f32x4 v0, const f32x4 v1) { u32x4 w; w.x = cvt_pk_bf16(v0[0], v0[1]); w.y = cvt_pk_bf16(v0[2], v0[3]); w.z = cvt_pk_bf16(v1[0], v1[1]); w.w = cvt_pk_bf16(v1[2], v1[3]); return w; }
__device__ __forceinline__ float bf_lo(unsigned w) { return __uint_as_float(w << 16); }
__device__ __forceinline__ float bf_hi(unsigned w) { return __uint_as_float(w & 0xffff0000u); }
__device__ __forceinline__ float sigmoidf_(float x) { return 1.0f / (1.0f + __expf(-x)); }
typedef unsigned u32x2 __attribute__((ext_vector_type(2)));

template <class T> struct Epi {
    static constexpr bool PERM = true, AFTER_DRAIN = false;
    T t;
    __device__ __forceinline__ void operator()(const f32x4 (&acc)[2][2][4][2], const Unit& u, int wr, int wc, int fr, int fq) const {
        const int row0 = u.pm * BM + wr * 64 + fr, col0 = u.pn * BM + wc * 32 + 8 * fq;
#pragma unroll
        for (int ai = 0; ai < 2; ++ai)
#pragma unroll
            for (int m = 0; m < 4; ++m) {
#pragma unroll
                for (int bj = 0; bj < 2; ++bj) t.store(row0 + ai * HALF + m * 16, col0 + bj * HALF, acc[ai][bj][m][0], acc[ai][bj][m][1], u);
                asm volatile("" ::: "memory"); }
    }
};
struct StBf16 { bf16_t* O; int ld;
    __device__ __forceinline__ void store(int row, int col, f32x4 v0, f32x4 v1, const Unit&) const { *(u32x4*)(O + (size_t)row * ld + col) = pack8(v0, v1); } };
struct StInAB { float* SM; bf16_t* Q;
    __device__ __forceinline__ void store(int row, int col, f32x4 v0, f32x4 v1, const Unit&) const {
        if (col < 512) { float* p = SM + (size_t)row * 512 + col; *(f32x4*)p = v0; *(f32x4*)(p + 4) = v1; }
        else *(u32x4*)(Q + (size_t)row * 2048 + (col - 512)) = pack8(v0, v1); } };
struct StPre { const float* base; float* P; float alpha;
    __device__ __forceinline__ void store(int row, int col, f32x4 v0, f32x4 v1, const Unit&) const {
        const size_t o = (size_t)row * 1024 + col; const f32x4 b0 = *(const f32x4*)(base + o), b1 = *(const f32x4*)(base + o + 4);
        *(f32x4*)(P + o) = b0 * alpha + v0; *(f32x4*)(P + o + 4) = b1 * alpha + v1; } };
struct StPleGate { const bf16_t* PP; bf16_t* O;
    __device__ __forceinline__ void store(int row, int col, f32x4 v0, f32x4 v1, const Unit&) const {
        const size_t o = (size_t)row * 1024 + col; const u32x4 p = *(const u32x4*)(PP + o);
        f32x4 r0, r1;
        r0[0] = sigmoidf_(v0[0]) * bf_lo(p.x); r0[1] = sigmoidf_(v0[1]) * bf_hi(p.x); r0[2] = sigmoidf_(v0[2]) * bf_lo(p.y); r0[3] = sigmoidf_(v0[3]) * bf_hi(p.y);
        r1[0] = sigmoidf_(v1[0]) * bf_lo(p.z); r1[1] = sigmoidf_(v1[1]) * bf_hi(p.z); r1[2] = sigmoidf_(v1[2]) * bf_lo(p.w); r1[3] = sigmoidf_(v1[3]) * bf_hi(p.w);
        *(u32x4*)(O + o) = pack8(r0, r1); } };
struct StSwiglu { const float* bgu; bf16_t* H;
    __device__ __forceinline__ float act(float g, float u) const { const float gt = fminf(g, 7.0f), up = fminf(fmaxf(u, -7.0f), 7.0f); return (up + 1.0f) * (gt * sigmoidf_(gt * 1.702f)); }
    __device__ __forceinline__ void store(int row, int col, f32x4 v0, f32x4 v1, const Unit& u) const {
        const float* b = bgu + (size_t)u.e * 2048 + col; const f32x4 b0 = *(const f32x4*)b, b1 = *(const f32x4*)(b + 4);
        v0 = v0 + b0; v1 = v1 + b1;
        u32x2 w; w.x = cvt_pk_bf16(act(v0[0], v0[1]), act(v0[2], v0[3])); w.y = cvt_pk_bf16(act(v1[0], v1[1]), act(v1[2], v1[3]));
        *(u32x2*)(H + (size_t)row * 1024 + (col >> 1)) = w; } };
struct StDown { const float* bd; bf16_t* Y;
    __device__ __forceinline__ void store(int row, int col, f32x4 v0, f32x4 v1, const Unit& u) const {
        const float* b = bd + (size_t)u.e * 1024 + col; const f32x4 b0 = *(const f32x4*)b, b1 = *(const f32x4*)(b + 4);
        *(u32x4*)(Y + (size_t)row * 1024 + col) = pack8(v0 + b0, v1 + b1); } };

template <class Epi, class Sched, bool ALIGN_EPI = false, bool SP2 = false>
__device__ __forceinline__ void gemm_phase(PG8_LAS unsigned char* lds, const Gemm g, const Sched& S, const Epi& E) {
    int tid = threadIdx.x; asm volatile("" : "+v"(tid));
    const int wid = __builtin_amdgcn_readfirstlane(tid >> 6), lane = tid & 63, wr = wid >> 2, wc = wid & 3, fr = lane & 15, fq = lane >> 4;
    int K = g.K; asm volatile("" : "+s"(K));
    const int nt = K / BK;
    unsigned voffA[2], voffB[2];
#pragma unroll
    for (int i = 0; i < 2; ++i) { int R, C; stage_rc(tid * 16 + i * 8192, R, C); const int Rb = Epi::PERM ? ((R & ~31) + perm32(R & 31)) : R;
        voffA[i] = (unsigned)(R * K + C) * 2u; voffB[i] = (unsigned)(Rb * K + C) * 2u; }
    const size_t kstep = (size_t)(BK * 2);
    const size_t hstep = (size_t)HALF * K * 2;
    const size_t tstep = 2 * hstep;
    const unsigned ldsw = (unsigned)wid * 1024u;
    const int aoff = lds_byte(wr * 64 + fr, fq * 8), boff = lds_byte(wc * 32 + fr, fq * 8);
#define PG8_SA(b, h) (((b) * 2 + (h)) * HTB)
#define PG8_SB(b, h) ((4 + (b) * 2 + (h)) * HTB)
#define PG8_STAGE(bufoff, gbase, voff) do { _Pragma("unroll") for (int _i = 0; _i < 2; ++_i) \
        __builtin_amdgcn_global_load_lds((const unsigned*)((const char*)(gbase) + (voff)[_i]), (PG8_LAS unsigned*)(lds + (bufoff) + ldsw + _i * 8192), 16, 0, 0); } while (0)
#define PG8_LDA(dst, b, h) do { _Pragma("unroll") for (int m = 0; m < 4; ++m) _Pragma("unroll") for (int k = 0; k < 2; ++k) dst[m][k] = *(const PG8_LAS bf16x8*)(lds + PG8_SA(b, h) + aoff + m * 2048 + k * 1024); } while (0)
#define PG8_LDB(dst, b, h) do { _Pragma("unroll") for (int n = 0; n < 2; ++n) _Pragma("unroll") for (int k = 0; k < 2; ++k) dst[n][k] = *(const PG8_LAS bf16x8*)(lds + PG8_SB(b, h) + boff + n * 2048 + k * 1024); } while (0)
#define PG8_MMA(ai, bj, At, Bt) do { __builtin_amdgcn_s_setprio(1); _Pragma("unroll") for (int m = 0; m < 4; ++m) _Pragma("unroll") for (int n = 0; n < 2; ++n) _Pragma("unroll") for (int k = 0; k < 2; ++k) \
        acc[ai][bj][m][n] = __builtin_amdgcn_mfma_f32_16x16x32_bf16(Bt[n][k], At[m][k], acc[ai][bj][m][n], 0, 0, 0); __builtin_amdgcn_s_setprio(0); } while (0)
#define PG8_WAIT_V(n) asm volatile("s_waitcnt vmcnt(" #n ")" ::: "memory")
#define PG8_WAIT_L(n) asm volatile("s_waitcnt lgkmcnt(" #n ")" ::: "memory")
#define PG8_BAR __builtin_amdgcn_s_barrier()
#define PG8_SCHED __builtin_amdgcn_sched_barrier(0)
    Unit cur, nxt; int ui = 0;
    if (!S.next(0, cur)) return;
    f32x4 acc[2][2][4][2];
#pragma unroll
    for (int a = 0; a < 2; ++a)
#pragma unroll
        for (int b = 0; b < 2; ++b)
#pragma unroll
            for (int m = 0; m < 4; ++m)
#pragma unroll
                for (int n = 0; n < 2; ++n) acc[a][b][m][n] = (f32x4){0.f, 0.f, 0.f, 0.f};
    bf16x8 At[4][2], B0[2][2], B1[2][2];
    const char* cA = (const char*)g.A + (size_t)cur.pm * tstep; const char* cB = (const char*)g.Bt + (size_t)cur.pn * tstep + cur.bofs;
    S.a_ready(cur);
    if constexpr (SP2) {
        PG8_STAGE(PG8_SB(0, 0), cB, voffB); PG8_STAGE(PG8_SB(0, 1), cB + hstep, voffB); PG8_STAGE(PG8_SA(0, 0), cA, voffA); PG8_STAGE(PG8_SA(0, 1), cA + hstep, voffA);
        if (wr == 1) PG8_BAR;
        PG8_WAIT_V(2); PG8_BAR;
        PG8_STAGE(PG8_SB(1, 0), cB + kstep, voffB); PG8_STAGE(PG8_SA(1, 0), cA + kstep, voffA); PG8_STAGE(PG8_SB(1, 1), cB + hstep + kstep, voffB);
        PG8_WAIT_V(6); PG8_BAR;
    } else {
        PG8_STAGE(PG8_SB(0, 0), cB, voffB); PG8_STAGE(PG8_SA(0, 0), cA, voffA); PG8_STAGE(PG8_SB(0, 1), cB + hstep, voffB); PG8_STAGE(PG8_SA(0, 1), cA + hstep, voffA);
        if (wr == 1) PG8_BAR;
        PG8_WAIT_V(4); PG8_BAR;
        PG8_STAGE(PG8_SB(1, 0), cB + kstep, voffB); PG8_STAGE(PG8_SA(1, 0), cA + kstep, voffA); PG8_STAGE(PG8_SB(1, 1), cB + hstep + kstep, voffB);
        PG8_WAIT_V(6); PG8_BAR;
    }
    for (;;) {
        const bool has_next = S.next(ui + 1, nxt);
        const char* nA = has_next ? (const char*)g.A + (size_t)nxt.pm * tstep : cA; const char* nB = has_next ? (const char*)g.Bt + (size_t)nxt.pn * tstep + nxt.bofs : cB;
        for (int t = 0; t < nt; t += 2) {
            const bool last = (t == nt - 2);
            const char* a1 = cA + (size_t)(t + 1) * kstep;
            const char* a2 = last ? nA : cA + (size_t)(t + 2) * kstep; const char* b2 = last ? nB : cB + (size_t)(t + 2) * kstep;
            const char* a3 = a2 + kstep; const char* b3 = b2 + kstep;
            if (last && has_next) S.a_ready(nxt);
            if constexpr (SP2) {
            PG8_LDB(B0, 0, 0); PG8_LDB(B1, 0, 1); PG8_SCHED; PG8_LDA(At, 0, 0); PG8_STAGE(PG8_SA(1, 1), a1 + hstep, voffA);
            PG8_WAIT_V(8); PG8_WAIT_L(0); PG8_BAR; PG8_MMA(0, 0, At, B0); PG8_MMA(0, 1, At, B1); PG8_BAR; PG8_SCHED;
            PG8_LDA(At, 0, 1); PG8_STAGE(PG8_SB(0, 0), b2, voffB); PG8_STAGE(PG8_SB(0, 1), b2 + hstep, voffB); PG8_STAGE(PG8_SA(0, 0), a2, voffA);
            PG8_WAIT_V(8); PG8_WAIT_L(0); PG8_BAR; PG8_MMA(1, 0, At, B0); PG8_MMA(1, 1, At, B1); PG8_BAR; PG8_SCHED;
            PG8_LDB(B0, 1, 0); PG8_LDB(B1, 1, 1); PG8_SCHED; PG8_LDA(At, 1, 0); PG8_STAGE(PG8_SA(0, 1), a2 + hstep, voffA);
            PG8_WAIT_V(8); PG8_WAIT_L(0); PG8_BAR; PG8_MMA(0, 0, At, B0); PG8_MMA(0, 1, At, B1); PG8_BAR; PG8_SCHED;
            PG8_LDA(At, 1, 1); PG8_STAGE(PG8_SB(1, 0), b3, voffB); PG8_STAGE(PG8_SB(1, 1), b3 + hstep, voffB); PG8_STAGE(PG8_SA(1, 0), a3, voffA);
            PG8_WAIT_V(8); PG8_WAIT_L(0); PG8_BAR; PG8_MMA(1, 0, At, B0); PG8_MMA(1, 1, At, B1); PG8_BAR; PG8_SCHED;
            } else {
            PG8_LDB(B0, 0, 0); PG8_SCHED; PG8_LDA(At, 0, 0); PG8_STAGE(PG8_SA(1, 1), a1 + hstep, voffA);
            PG8_WAIT_L(8); PG8_BAR; PG8_WAIT_L(0); PG8_MMA(0, 0, At, B0); PG8_BAR; PG8_SCHED;
            PG8_LDB(B1, 0, 1); PG8_STAGE(PG8_SB(0, 0), b2, voffB);
            PG8_BAR; PG8_WAIT_L(0); PG8_MMA(0, 1, At, B1); PG8_BAR;
            PG8_LDA(At, 0, 1); PG8_STAGE(PG8_SA(0, 0), a2, voffA);
            PG8_BAR; PG8_WAIT_L(0); PG8_MMA(1, 0, At, B0); PG8_BAR; PG8_SCHED;
            PG8_STAGE(PG8_SB(0, 1), b2 + hstep, voffB);
            PG8_WAIT_V(6); PG8_BAR; PG8_MMA(1, 1, At, B1); PG8_BAR;
            PG8_LDB(B0, 1, 0); PG8_SCHED; PG8_LDA(At, 1, 0); PG8_STAGE(PG8_SA(0, 1), a2 + hstep, voffA);
            PG8_WAIT_L(8); PG8_BAR; PG8_WAIT_L(0); PG8_MMA(0, 0, At, B0); PG8_BAR; PG8_SCHED;
            PG8_LDB(B1, 1, 1); PG8_STAGE(PG8_SB(1, 0), b3, voffB);
            PG8_BAR; PG8_WAIT_L(0); PG8_MMA(0, 1, At, B1); PG8_BAR;
            PG8_LDA(At, 1, 1); PG8_STAGE(PG8_SA(1, 0), a3, voffA);
            PG8_BAR; PG8_WAIT_L(0); PG8_MMA(1, 0, At, B0); PG8_BAR; PG8_SCHED;
            PG8_STAGE(PG8_SB(1, 1), b3 + hstep, voffB);
            PG8_WAIT_V(6); PG8_BAR; PG8_MMA(1, 1, At, B1); PG8_BAR;
            }
        }
        if constexpr (ALIGN_EPI) { if (wr == 0) PG8_BAR; }
        if constexpr (!Epi::AFTER_DRAIN) { E(acc, cur, wr, wc, fr, fq); S.done(cur); }
        if (!has_next) break;
#pragma unroll
        for (int a = 0; a < 2; ++a)
#pragma unroll
            for (int b = 0; b < 2; ++b)
#pragma unroll
                for (int m = 0; m < 4; ++m)
#pragma unroll
                    for (int n = 0; n < 2; ++n) acc[a][b][m][n] = (f32x4){0.f, 0.f, 0.f, 0.f};
        cur = nxt; cA = nA; cB = nB; ++ui;
        if constexpr (ALIGN_EPI) { if (wr == 1) PG8_BAR; }
    }
    PG8_WAIT_V(0);
    if constexpr (!ALIGN_EPI) { if (wr == 0) PG8_BAR; }
    PG8_BAR;
    if constexpr (Epi::AFTER_DRAIN) { E.fused(acc, cur, wr, wc, fr, fq, lds, wid, lane); S.done(cur); }
#undef PG8_SA
#undef PG8_SB
#undef PG8_STAGE
#undef PG8_LDA
#undef PG8_LDB
#undef PG8_MMA
#undef PG8_WAIT_V
#undef PG8_WAIT_L
#undef PG8_BAR
#undef PG8_SCHED
}
}

constexpr int NWAVES = 8, NTHREADS = 512;
constexpr int BATCH = 2, SEQ = 8192, M = BATCH * SEQ, D = 1024;
constexpr int NEXP = 32, DEXP = 1024;
constexpr int PMAX = M * 4 + NEXP * 256, NTMAX = PMAX / 256;
constexpr float ALPHA = 1.41421356237f;
constexpr int NPHASES = 21;
#ifndef MK_N_LAUNCHES
#define MK_N_LAUNCHES 1
#endif
constexpr int N_LAUNCHES = MK_N_LAUNCHES;

enum { I_X = 0, I_P, I_AB_WIN, I_AB_QG, I_AB_KVG, I_AB_WUQ, I_AB_WUK, I_AB_WUV, I_AB_WQIDX, I_AB_KIG, I_AB_KIB, I_AB_CONVW, I_AB_ALOG, I_AB_DTB, I_AB_ONG, I_AB_WOUT,
       I_CD_WIN, I_CD_POOLW, I_CD_POOLS, I_CD_WOUT, I_LNM_G, I_LNM_B, I_RW, I_RB, I_WGU, I_BGU, I_WDN, I_BDN, I_PLE_WP, I_PLE_WG, I_LNF_G, I_LNF_B, N_IN };

constexpr size_t MiB = 1u << 20;
constexpr size_t WS_CTL = 0, CTL_ZERO_BYTES = 1 * MiB;
constexpr size_t WS_W_INAB = 1 * MiB;
constexpr size_t WS_W_ABS = 6 * MiB;
constexpr size_t WS_W_OUTAB = 7 * MiB;
constexpr size_t WS_W_INCD = 10 * MiB;
constexpr size_t WS_W_OUTCD = 15 * MiB;
constexpr size_t WS_W_PG = 17 * MiB;
constexpr size_t WS_W_PP = 21 * MiB;
constexpr size_t WS_W_GU = 22 * MiB;
constexpr size_t WS_W_DN = 278 * MiB;
constexpr size_t WS_XB = 406 * MiB;
constexpr size_t WS_PB = 438 * MiB;
constexpr size_t WS_PP = 454 * MiB;
constexpr size_t WS_SM = 518 * MiB;
constexpr size_t WS_QKVZ = 550 * MiB;
constexpr size_t WS_CQ = 630 * MiB;
constexpr size_t WS_CKV = 638 * MiB;
constexpr size_t WS_KIDX = 642 * MiB;
constexpr size_t WS_WIDX = 644 * MiB;
constexpr size_t WS_BETA = 645 * MiB;
constexpr size_t WS_GG = WS_BETA + 512 * 1024;
constexpr size_t WS_QN = 646 * MiB, WS_KN = 662 * MiB, WS_VN = 678 * MiB;
constexpr size_t WS_QL = 694 * MiB;
constexpr size_t WS_CHK = 742 * MiB;
constexpr size_t WS_SEL = 838 * MiB;
constexpr size_t WS_NSEL = 854 * MiB;
constexpr size_t WS_ODELTA = 855 * MiB;
constexpr size_t WS_AO = 887 * MiB;
constexpr size_t WS_PRE = 935 * MiB;
constexpr size_t WS_H1 = 999 * MiB;
constexpr size_t WS_H2 = 1063 * MiB;
constexpr size_t WS_H1B = 1127 * MiB;
constexpr size_t WS_PLE = 1159 * MiB;
constexpr size_t WS_ROUTE = 1191 * MiB;
constexpr size_t WS_BIG = 1193 * MiB;
constexpr size_t WS_XS = WS_BIG, WS_HID = WS_BIG + 144 * MiB, WS_YS = WS_BIG + 288 * MiB;
constexpr size_t WS_END = WS_BIG + 512 * MiB;
static_assert((size_t)PMAX * 1024 * 2 <= 144 * MiB && WS_END <= 2048 * MiB, "d_ws map");
constexpr size_t CHK_WP = 0, CHK_QD = 16384, CHK_KDT = 32768, CHK_QK = 49152, CHK_UT = 57344, CHK_GL = 90112, CHK_STRIDE = 92160;
static_assert(CHK_STRIDE * 1024 <= 96 * MiB, "chunk operands");
constexpr int CW_TMO = 0, CW_CODE = 1;
constexpr int CW_BAR = 4096;
constexpr int CW_CNT = 16384;

constexpr int RING_OFF = 0, RING_BYTES = 131072;
constexpr int WSCR_OFF = 132096, WSCR_BYTES = 1024;
constexpr int MISC_OFF = 140288;
constexpr int LDS_BYTES = 147456;

#define GAS __attribute__((address_space(1)))
#define LAS __attribute__((address_space(3)))
typedef unsigned short bf16;
typedef unsigned v4u __attribute__((ext_vector_type(4)));
typedef unsigned v2u __attribute__((ext_vector_type(2)));
typedef float f32x4 __attribute__((ext_vector_type(4)));
typedef short bf16x8 __attribute__((ext_vector_type(8)));
typedef GAS unsigned gu32;
#define RLX_AGENT __ATOMIC_RELAXED, __HIP_MEMORY_SCOPE_AGENT
__device__ __forceinline__ unsigned f2bf(float f) { unsigned u = __builtin_bit_cast(unsigned, f); return (u + 0x7fffu + ((u >> 16) & 1u)) >> 16; }
__device__ __forceinline__ unsigned pk2(float lo, float hi) { return f2bf(lo) | (f2bf(hi) << 16); }
__device__ __forceinline__ float bflo(unsigned w) { return __uint_as_float(w << 16); }
__device__ __forceinline__ float bfhi(unsigned w) { return __uint_as_float(w & 0xffff0000u); }
__device__ __forceinline__ float bf1(bf16 h) { return __uint_as_float(((unsigned)h) << 16); }
__device__ __forceinline__ float sigm(float x) { return 1.0f / (1.0f + __expf(-x)); }
__device__ __forceinline__ float siluf(float x) { return x / (1.0f + __expf(-x)); }
__device__ __forceinline__ float wave_sum(float v) {
#pragma unroll
    for (int o = 1; o < 64; o <<= 1) v += __shfl_xor(v, o);
    return v;
}
__device__ __forceinline__ float wave_max(float v) {
#pragma unroll
    for (int o = 1; o < 64; o <<= 1) v = fmaxf(v, __shfl_xor(v, o));
    return v;
}
__device__ __forceinline__ int wave_sum_i(int v) {
#pragma unroll
    for (int o = 1; o < 64; o <<= 1) v += __shfl_xor(v, o);
    return v;
}
__device__ __forceinline__ void unpack8(const v4u w, float (&f)[8]) { f[0] = bflo(w.x); f[1] = bfhi(w.x); f[2] = bflo(w.y); f[3] = bfhi(w.y); f[4] = bflo(w.z); f[5] = bfhi(w.z); f[6] = bflo(w.w); f[7] = bfhi(w.w); }
__device__ __forceinline__ v4u pack8f(const float (&f)[8]) { v4u w; w.x = pk2(f[0], f[1]); w.y = pk2(f[2], f[3]); w.z = pk2(f[4], f[5]); w.w = pk2(f[6], f[7]); return w; }

#define XB_TMO      128
#define XB_XCNT(j)  (256  + 64 * (j))
#define XB_XSUB(j)  (1280 + 64 * (j))
#define XB_XGEN(j)  (2304 + 64 * (j))
#define XB_TOP      3328
#define XB_TOPGEN   3392
#define XCD_BAR_WORDS 3456
#define XB_SPIN_CAP (1u << 18)

__device__ __forceinline__ unsigned xb_ld(unsigned* p)              { return __hip_atomic_load(p, __ATOMIC_RELAXED, __HIP_MEMORY_SCOPE_AGENT); }
__device__ __forceinline__ unsigned xb_add(unsigned* p, unsigned v) { return __hip_atomic_fetch_add(p, v, __ATOMIC_RELAXED, __HIP_MEMORY_SCOPE_AGENT); }
__device__ __forceinline__ unsigned xb_xcc_id() { return (unsigned)__builtin_amdgcn_s_getreg((3 << 11) | 20) & 0xFu; }
#define XB_SPIN(cond, bar) do { unsigned _sp = 0; while (cond) { __builtin_amdgcn_s_sleep(1); \
    if ((++_sp & 255u) == 0u) { if (xb_ld(&(bar)[XB_TMO])) break; if (_sp > XB_SPIN_CAP) { atomicAdd(&(bar)[XB_TMO], 1u); break; } } } } while (0)

struct XcdBarrier {
    unsigned* bar; unsigned x;
    volatile LAS unsigned* st;
};

__device__ __forceinline__ XcdBarrier xcd_barrier_post(unsigned* bar, volatile LAS unsigned* st) {
    XcdBarrier b; b.bar = bar; b.x = xb_xcc_id(); b.st = st;
    if (threadIdx.x == 0) (void)xb_add(&bar[XB_XCNT(b.x)], 1u);
    return b;
}
__device__ __forceinline__ void xcd_barrier_complete(unsigned* bar, unsigned x, unsigned& nloc, unsigned& nx) {
    const unsigned G = gridDim.x * gridDim.y * gridDim.z;
    unsigned sum, cnt, mine, sp = 0u;
    for (;;) {
        sum = 0u; cnt = 0u; mine = 0u;
#pragma unroll
        for (unsigned j = 0; j < 16; ++j) { const unsigned c = xb_ld(&bar[XB_XCNT(j)]); sum += c; cnt += (c > 0u) ? 1u : 0u; mine = (j == x) ? c : mine; }
        if (sum == G) break;
        __builtin_amdgcn_s_sleep(1);
        if ((++sp & 255u) == 0u) { if (xb_ld(&bar[XB_TMO])) break; if (sp > XB_SPIN_CAP) { atomicAdd(&bar[XB_TMO], 1u); break; } }
    }
    nloc = mine > 0u ? mine : 1u; nx = cnt > 0u ? cnt : 1u;
}

__device__ __forceinline__ void xcd_barrier(const XcdBarrier& b) {
    asm volatile("s_waitcnt vmcnt(0)" ::: "memory");
    __syncthreads();
    if (threadIdx.x == 0) {
        unsigned* bar = b.bar;
        __builtin_amdgcn_s_waitcnt(0);
        unsigned nloc = b.st[0], nx = b.st[1];
        if (nloc == 0u) { xcd_barrier_complete(bar, b.x, nloc, nx); b.st[0] = nloc; b.st[1] = nx; }
        const unsigned old = xb_add(&bar[XB_XSUB(b.x)], 1u);
        const unsigned gen = old / nloc;
        if (old + 1u == (gen + 1u) * nloc) {
            __builtin_amdgcn_fence(__ATOMIC_RELEASE, "agent");
            asm volatile("s_waitcnt vmcnt(0)" ::: "memory");
            const unsigned og = xb_add(&bar[XB_TOP], 1u);
            const unsigned tg = og / nx;
            if (og + 1u == (tg + 1u) * nx) xb_add(&bar[XB_TOPGEN], 1u);
            else XB_SPIN(xb_ld(&bar[XB_TOPGEN]) == tg, bar);
            __builtin_amdgcn_fence(__ATOMIC_ACQUIRE, "agent");
            xb_add(&bar[XB_XGEN(b.x)], 1u);
            asm volatile("s_waitcnt vmcnt(0)" ::: "memory");
        } else {
            XB_SPIN(xb_ld(&bar[XB_XGEN(b.x)]) == gen, bar);
            __builtin_amdgcn_fence(__ATOMIC_ACQUIRE, "agent");
            asm volatile("s_waitcnt vmcnt(0)" ::: "memory");
        }
    }
    __syncthreads();
}

struct Args { const float* in[N_IN]; float* out; unsigned char* ws; int ph_lo, ph_hi, li, pad; };
typedef const __attribute__((address_space(4))) Args* KArgs;
__device__ __forceinline__ KArgs kargs() { auto p = __builtin_amdgcn_kernarg_segment_ptr(); asm volatile("" : "+s"(p)); return (KArgs)p; }
struct Frame {
    LAS unsigned char* lds;
    int tid, lane, wave, G, bid;
    unsigned char* ws;
    gu32* ctl;
};
#define WSP(T, off) ((T*)(F.ws + (off)))

struct MapId { __device__ __forceinline__ int operator()(int n) const { return n; } };
struct MapAdd { int off; __device__ __forceinline__ int operator()(int n) const { return n + off; } };
struct MapAB { __device__ __forceinline__ int operator()(int n) const { return n < 456 ? n : (n < 2504 ? n + 56 : n - 2048); } };
template <class Map> __device__ __forceinline__ void wg_transpose_item(const float* W, int N, int ldw, bf16* WT, int ldt, int koff, Map map, LAS float* scr, int item, int tid) {
    const int nblk = (N + 127) >> 7, kb = item / nblk, nb = item - kb * nblk, k0 = kb * 128, n0 = nb * 128;
#pragma unroll
    for (int it = 0; it < 8; ++it) {
        const int row = it * 16 + (tid >> 5), c4 = (tid & 31) * 4, n = n0 + c4;
        f32x4 v = (f32x4){0.f, 0.f, 0.f, 0.f};
        if (n + 3 < N) v = *(const f32x4*)(W + (size_t)(k0 + row) * ldw + n);
        LAS float* s = scr + row * 129 + c4; s[0] = v[0]; s[1] = v[1]; s[2] = v[2]; s[3] = v[3];
    }
    __syncthreads();
#pragma unroll
    for (int j = 0; j < 4; ++j) {
        const int idx = j * 512 + tid, nl = idx >> 4, ch = idx & 15, n = n0 + nl;
        if (n < N) { const LAS float* s = scr + (ch * 8) * 129 + nl;
            v4u o; o.x = pk2(s[0], s[129]); o.y = pk2(s[2 * 129], s[3 * 129]); o.z = pk2(s[4 * 129], s[5 * 129]); o.w = pk2(s[6 * 129], s[7 * 129]);
            *(v4u*)(WT + (size_t)map(n) * ldt + koff + k0 + ch * 8) = o; }
    }
    __syncthreads();
}
__device__ __forceinline__ void p0_prologue(Frame& F, KArgs A) {
    LAS float* scr = (LAS float*)(F.lds + RING_OFF);
    const int tid = F.tid;
    constexpr int IT_GU = 128, IT_DN = 64;
    constexpr int N_GU = 64 * IT_GU, N_DN = 64 * IT_DN;
    constexpr int N_INAB = 8 * 20, N_INCD = 8 * 20, N_OUTCD = 64, N_PG = 2 * 64, N_PP = 2 * 2 * 8, N_QIDX = 2 * 4, N_OUTB = 4 * 8;
    constexpr int NITEMS = N_GU + N_DN + N_INAB + N_INCD + N_OUTCD + N_PG + N_PP + N_QIDX + N_OUTB;
    for (int it = F.bid; it < NITEMS; it += F.G) {
        int r = it;
        if (r < N_GU) { const int m = r / IT_GU; wg_transpose_item(A->in[I_WGU] + (size_t)m * 1024 * 2048, 2048, 2048, WSP(bf16, WS_W_GU) + (size_t)m * 2048 * 1024, 1024, 0, MapId{}, scr, r % IT_GU, tid); continue; } r -= N_GU;
        if (r < N_DN) { const int m = r / IT_DN; wg_transpose_item(A->in[I_WDN] + (size_t)m * 1024 * 1024, 1024, 1024, WSP(bf16, WS_W_DN) + (size_t)m * 1024 * 1024, 1024, 0, MapId{}, scr, r % IT_DN, tid); continue; } r -= N_DN;
        if (r < N_INAB) { wg_transpose_item(A->in[I_AB_WIN], 2512, 2512, WSP(bf16, WS_W_INAB), 1024, 0, MapAB{}, scr, r, tid); continue; } r -= N_INAB;
        if (r < N_INCD) { wg_transpose_item(A->in[I_CD_WIN], 2560, 2560, WSP(bf16, WS_W_INCD), 1024, 0, MapId{}, scr, r, tid); continue; } r -= N_INCD;
        if (r < N_OUTCD) { wg_transpose_item(A->in[I_CD_WOUT], 1024, 1024, WSP(bf16, WS_W_OUTCD), 1024, 0, MapId{}, scr, r, tid); continue; } r -= N_OUTCD;
        if (r < N_PG) { const int l = r / 64; wg_transpose_item(A->in[I_PLE_WG] + (size_t)l * 1024 * 1024, 1024, 1024, WSP(bf16, WS_W_PG) + (size_t)l * 1024 * 1024, 1024, 0, MapId{}, scr, r % 64, tid); continue; } r -= N_PG;
        if (r < N_PP) { const int l = r / 16; wg_transpose_item(A->in[I_PLE_WP] + (size_t)l * 256 * 1024, 1024, 1024, WSP(bf16, WS_W_PP) + (size_t)l * 1024 * 256, 256, 0, MapId{}, scr, r % 16, tid); continue; } r -= N_PP;
        if (r < N_QIDX) { wg_transpose_item(A->in[I_AB_WQIDX], 512, 512, WSP(bf16, WS_W_ABS), 256, 0, MapAdd{1024}, scr, r, tid); continue; } r -= N_QIDX;
        wg_transpose_item(A->in[I_AB_WOUT] + (size_t)512 * 1024, 1024, 1024, WSP(bf16, WS_W_OUTAB), 1536, 1024, MapId{}, scr, r, tid);
    }
    const size_t gt = (size_t)F.bid * NTHREADS + tid, GT = (size_t)F.G * NTHREADS;
    for (size_t i = gt; i < (size_t)48 * 1024 / 8; i += GT) *(v4u*)(WSP(bf16, WS_W_INAB) + (size_t)464 * 1024 + i * 8) = (v4u){0u, 0u, 0u, 0u};
    for (size_t i = gt; i < (size_t)1024 * 256; i += GT) {
        const int n = (int)(i >> 8), c = (int)(i & 255), h = n >> 7, r = n & 127;
        const float* a = A->in[I_AB_WUQ] + (size_t)c * 512 + h * 64; const float* b = A->in[I_AB_WUK] + (size_t)r * 512 + h * 64;
        float s = 0.f;
#pragma unroll 8
        for (int d = 0; d < 64; d += 4) { const f32x4 x = *(const f32x4*)(a + d), y = *(const f32x4*)(b + d); s += x[0] * y[0] + x[1] * y[1] + x[2] * y[2] + x[3] * y[3]; }
        WSP(bf16, WS_W_ABS)[i] = (bf16)f2bf(s * 0.125f);
    }
    for (size_t i = gt; i < (size_t)1024 * 1024; i += GT) {
        const int n = (int)(i >> 10), k = (int)(i & 1023), h = k >> 7, r = k & 127;
        const float* a = A->in[I_AB_WUV] + (size_t)r * 512 + h * 64; const float* b = A->in[I_AB_WOUT] + (size_t)(h * 64) * 1024 + n;
        float s = 0.f;
#pragma unroll 8
        for (int v = 0; v < 64; ++v) s += a[v] * b[(size_t)v * 1024];
        WSP(bf16, WS_W_OUTAB)[(size_t)n * 1536 + k] = (bf16)f2bf(s);
    }
    for (size_t i = gt; i < (size_t)M * D / 8; i += GT) { const f32x4 a = *(const f32x4*)(A->in[I_X] + i * 8), b = *(const f32x4*)(A->in[I_X] + i * 8 + 4);
        v4u o; o.x = pk2(a[0], a[1]); o.y = pk2(a[2], a[3]); o.z = pk2(b[0], b[1]); o.w = pk2(b[2], b[3]); *(v4u*)(WSP(bf16, WS_XB) + i * 8) = o; }
    for (size_t i = gt; i < (size_t)2 * M * 256 / 8; i += GT) { const f32x4 a = *(const f32x4*)(A->in[I_P] + i * 8), b = *(const f32x4*)(A->in[I_P] + i * 8 + 4);
        v4u o; o.x = pk2(a[0], a[1]); o.y = pk2(a[2], a[3]); o.z = pk2(b[0], b[1]); o.w = pk2(b[2], b[3]); *(v4u*)(WSP(bf16, WS_PB) + i * 8) = o; }
}

__device__ __forceinline__ void p2_prep(Frame& F, KArgs A) {
    const int lane = F.lane, gw = F.bid * NWAVES + F.wave, NGW = F.G * NWAVES;
    const float* SM = WSP(float, WS_SM); const bf16* QZ = WSP(bf16, WS_QKVZ);
    const f32x4 qg = *(const f32x4*)(A->in[I_AB_QG] + 4 * lane);
    const f32x4 kvg = *(const f32x4*)(A->in[I_AB_KVG] + 4 * (lane & 31));
    const f32x4 kig = *(const f32x4*)(A->in[I_AB_KIG] + 4 * (lane & 15)), kib = *(const f32x4*)(A->in[I_AB_KIB] + 4 * (lane & 15));
    const f32x4 alog = *(const f32x4*)(A->in[I_AB_ALOG]), dtb = *(const f32x4*)(A->in[I_AB_DTB]);
    for (int row = gw; row < M; row += NGW) {
        const int t = row & (SEQ - 1);
        const f32x4 a = *(const f32x4*)(SM + (size_t)row * 512 + 4 * lane), b = *(const f32x4*)(SM + (size_t)row * 512 + 256 + 4 * lane);
        {
            const float ss = wave_sum(a[0] * a[0] + a[1] * a[1] + a[2] * a[2] + a[3] * a[3]);
            const float r = rsqrtf(ss * (1.0f / 256.0f) + 1e-6f);
            v2u o; o.x = pk2(a[0] * r * qg[0], a[1] * r * qg[1]); o.y = pk2(a[2] * r * qg[2], a[3] * r * qg[3]);
            *(v2u*)(WSP(bf16, WS_CQ) + (size_t)row * 256 + 4 * lane) = o;
        }
        {
            const float ss = wave_sum(lane < 32 ? (b[0] * b[0] + b[1] * b[1] + b[2] * b[2] + b[3] * b[3]) : 0.f);
            const float r = rsqrtf(ss * (1.0f / 128.0f) + 1e-6f);
            if (lane < 32) { v2u o; o.x = pk2(b[0] * r * kvg[0], b[1] * r * kvg[1]); o.y = pk2(b[2] * r * kvg[2], b[3] * r * kvg[3]);
                *(v2u*)(WSP(bf16, WS_CKV) + (size_t)row * 128 + 4 * lane) = o; }
        }
        {
            const bool in = (lane >= 32 && lane < 48);
            const float mean = wave_sum(in ? (b[0] + b[1] + b[2] + b[3]) : 0.f) * (1.0f / 64.0f);
            const f32x4 d = b - mean;
            const float var = wave_sum(in ? (d[0] * d[0] + d[1] * d[1] + d[2] * d[2] + d[3] * d[3]) : 0.f) * (1.0f / 64.0f);
            const float r = rsqrtf(var + 1e-5f);
            if (in) { v2u o; o.x = pk2(d[0] * r * kig[0] + kib[0], d[1] * r * kig[1] + kib[1]); o.y = pk2(d[2] * r * kig[2] + kib[2], d[3] * r * kig[3] + kib[3]);
                *(v2u*)(WSP(bf16, WS_KIDX) + (size_t)row * 64 + 4 * (lane - 32)) = o; }
        }
        if (lane == 48 || lane == 49) *(f32x4*)(WSP(float, WS_WIDX) + (size_t)row * 8 + 4 * (lane - 48)) = b * 0.044194173824159216f;
        if (lane == 50) { f32x4 o; o[0] = sigm(b[0]); o[1] = sigm(b[1]); o[2] = sigm(b[2]); o[3] = sigm(b[3]); *(f32x4*)(WSP(float, WS_BETA) + (size_t)row * 4) = o; }
        if (lane == 51) { f32x4 o;
#pragma unroll
            for (int h = 0; h < 4; ++h) { const float xx = b[h] + dtb[h]; const float sp = xx > 20.f ? xx : log1pf(__expf(xx)); o[h] = -__expf(alog[h]) * sp; }
            *(f32x4*)(WSP(float, WS_GG) + (size_t)row * 4) = o; }
#pragma unroll
        for (int sel = 0; sel < 3; ++sel) {
            const int col0 = sel * 512 + 8 * lane;
            float acc[8];
#pragma unroll
            for (int i = 0; i < 8; ++i) acc[i] = 0.f;
#pragma unroll
            for (int j = 0; j < 4; ++j) {
                if (t - 3 + j >= 0) {
                    const v4u xr = *(const v4u*)(QZ + (size_t)(row - 3 + j) * 2048 + col0); float xv[8]; unpack8(xr, xv);
                    const f32x4 w0 = *(const f32x4*)(A->in[I_AB_CONVW] + (size_t)j * 1536 + col0), w1 = *(const f32x4*)(A->in[I_AB_CONVW] + (size_t)j * 1536 + col0 + 4);
#pragma unroll
                    for (int i = 0; i < 4; ++i) { acc[i] += w0[i] * xv[i]; acc[4 + i] += w1[i] * xv[4 + i]; }
                }
            }
            float ss = 0.f;
#pragma unroll
            for (int i = 0; i < 8; ++i) { acc[i] = siluf(acc[i]); ss += acc[i] * acc[i]; }
            if (sel < 2) {
                ss += __shfl_xor(ss, 1); ss += __shfl_xor(ss, 2); ss += __shfl_xor(ss, 4); ss += __shfl_xor(ss, 8);
                const float sc = rsqrtf(ss + 1e-6f) * (sel == 0 ? 0.08838834764831845f : 1.0f);
#pragma unroll
                for (int i = 0; i < 8; ++i) acc[i] *= sc;
            }
            bf16* dst = (sel == 0 ? WSP(bf16, WS_QN) : (sel == 1 ? WSP(bf16, WS_KN) : WSP(bf16, WS_VN))) + (size_t)row * 512 + 8 * lane;
            *(v4u*)dst = pack8f(acc);
        }
    }
}

__device__ __forceinline__ void p3_chunk_prep(Frame& F, KArgs A) {
    int tid = F.tid; asm volatile("" : "+v"(tid));
    const int lane = tid & 63;
    constexpr int P = 132;
    LAS float* qs = (LAS float*)(F.lds); LAS float* ks = qs + 64 * P; LAS float* vs = ks + 64 * P;
    LAS float* As = vs + 64 * P;
    LAS float* gcS = As + 64 * 65; LAS float* egS = gcS + 64; LAS float* ekS = egS + 64; LAS float* btS = ekS + 64;
    LAS float* Ts = qs;
    for (int cidx = F.bid; cidx < 1024; cidx += F.G) {
        const int b = cidx >> 9, h = (cidx >> 7) & 3, n = cidx & 127, row0 = b * SEQ + n * 64;
        unsigned char* blk = F.ws + WS_CHK + (size_t)cidx * CHK_STRIDE;
        if (tid < 64) {
            const float g = WSP(float, WS_GG)[(size_t)(row0 + tid) * 4 + h];
            float gc = g;
#pragma unroll
            for (int o = 1; o < 64; o <<= 1) { const float t = __shfl_up(gc, o); if (lane >= o) gc += t; }
            const float g63 = __shfl(gc, 63);
            gcS[tid] = gc; egS[tid] = __expf(gc); ekS[tid] = __expf(g63 - gc); btS[tid] = WSP(float, WS_BETA)[(size_t)(row0 + tid) * 4 + h];
            if (tid == 0) *(float*)(blk + CHK_GL) = __expf(g63);
        }
#pragma unroll
        for (int i = 0; i < 2; ++i) {
            const int id = tid + 512 * i, r = id >> 4, c8 = (id & 15) * 8; const size_t so = (size_t)(row0 + r) * 512 + h * 128 + c8;
            float f[8];
            unpack8(*(const v4u*)(WSP(bf16, WS_QN) + so), f);
            *(LAS f32x4*)(qs + r * P + c8) = (f32x4){f[0], f[1], f[2], f[3]}; *(LAS f32x4*)(qs + r * P + c8 + 4) = (f32x4){f[4], f[5], f[6], f[7]};
            unpack8(*(const v4u*)(WSP(bf16, WS_KN) + so), f);
            *(LAS f32x4*)(ks + r * P + c8) = (f32x4){f[0], f[1], f[2], f[3]}; *(LAS f32x4*)(ks + r * P + c8 + 4) = (f32x4){f[4], f[5], f[6], f[7]};
            unpack8(*(const v4u*)(WSP(bf16, WS_VN) + so), f);
            *(LAS f32x4*)(vs + r * P + c8) = (f32x4){f[0], f[1], f[2], f[3]}; *(LAS f32x4*)(vs + r * P + c8 + 4) = (f32x4){f[4], f[5], f[6], f[7]};
        }
        __syncthreads();
        {
            const int i = tid >> 3, t7 = tid & 7;
            float aK[8], aQ[8];
#pragma unroll
            for (int x = 0; x < 8; ++x) { aK[x] = 0.f; aQ[x] = 0.f; }
#pragma unroll 1
            for (int d = 0; d < 128; d += 4) {
                const f32x4 ki = *(const LAS f32x4*)(ks + i * P + d), qi = *(const LAS f32x4*)(qs + i * P + d);
#pragma unroll
                for (int x = 0; x < 8; ++x) { const f32x4 kj = *(const LAS f32x4*)(ks + (t7 + 8 * x) * P + d);
                    aK[x] += ki[0] * kj[0] + ki[1] * kj[1] + ki[2] * kj[2] + ki[3] * kj[3]; aQ[x] += qi[0] * kj[0] + qi[1] * kj[1] + qi[2] * kj[2] + qi[3] * kj[3]; }
            }
            const float gci = gcS[i], bti = btS[i];
            bf16* QKp = (bf16*)(blk + CHK_QK) + i * 64;
#pragma unroll
            for (int x = 0; x < 8; ++x) { const int j = t7 + 8 * x; const float dec = __expf(j <= i ? gci - gcS[j] : 0.f);
                As[i * 65 + j] = (j < i) ? bti * aK[x] * dec : 0.f;
                QKp[32 * (j >> 5) + 8 * ((j >> 2) & 3) + 4 * ((j >> 4) & 1) + (j & 3)] = (bf16)f2bf((j <= i) ? aQ[x] * dec : 0.f); }
        }
        {
            const int i = tid >> 3, d0 = (tid & 7) * 16, s = d0 >> 5, a = (d0 >> 4) & 1; const float e = egS[i];
            bf16* Qd = (bf16*)(blk + CHK_QD) + i * 128;
#pragma unroll
            for (int q = 0; q < 4; ++q) { const f32x4 p = *(const LAS f32x4*)(qs + i * P + d0 + 4 * q); v2u w; w.x = pk2(p[0] * e, p[1] * e); w.y = pk2(p[2] * e, p[3] * e); *(v2u*)(Qd + 32 * s + 8 * q + 4 * a) = w; }
        }
        {
            const int d = tid >> 2, c0 = (tid & 3) * 16, s = c0 >> 5, a = (c0 >> 4) & 1;
            bf16* Kd = (bf16*)(blk + CHK_KDT) + d * 64;
#pragma unroll
            for (int q = 0; q < 4; ++q) { const int c = c0 + 4 * q;
                v2u w; w.x = pk2(ks[c * P + d] * ekS[c], ks[(c + 1) * P + d] * ekS[c + 1]); w.y = pk2(ks[(c + 2) * P + d] * ekS[c + 2], ks[(c + 3) * P + d] * ekS[c + 3]);
                *(v2u*)(Kd + 32 * s + 8 * q + 4 * a) = w; }
        }
        __syncthreads();
        {
            const int c = tid >> 3, part = tid & 7;
            for (int i = 0; i < 64; ++i) {
                float acc = 0.f;
                for (int j = part; j < i; j += 8) acc += As[i * 65 + j] * Ts[j * 65 + c];
                acc += __shfl_xor(acc, 1); acc += __shfl_xor(acc, 2); acc += __shfl_xor(acc, 4);
                if (part == 0) Ts[i * 65 + c] = ((i == c) ? 1.f : 0.f) - acc;
                __builtin_amdgcn_fence(__ATOMIC_RELEASE, "wavefront"); asm volatile("s_waitcnt lgkmcnt(0)" ::: "memory");
            }
        }
        __syncthreads();
        {
            const int i = tid >> 3, t7 = tid & 7;
            f32x4 aU[4], aW[4];
#pragma unroll
            for (int xx = 0; xx < 4; ++xx) { aU[xx] = (f32x4){0.f, 0.f, 0.f, 0.f}; aW[xx] = (f32x4){0.f, 0.f, 0.f, 0.f}; }
#pragma unroll 1
            for (int j = 0; j <= i; ++j) {
                const float tb = Ts[i * 65 + j] * btS[j], tbe = tb * egS[j];
#pragma unroll
                for (int xx = 0; xx < 4; ++xx) { aU[xx] += *(const LAS f32x4*)(vs + j * P + 4 * t7 + 32 * xx) * tb; aW[xx] += *(const LAS f32x4*)(ks + j * P + 4 * t7 + 32 * xx) * tbe; }
            }
            float* UT = (float*)(blk + CHK_UT);
            bf16* Wp = (bf16*)(blk + CHK_WP) + i * 128;
#pragma unroll
            for (int xx = 0; xx < 4; ++xx) {
                const int c = 4 * t7 + 32 * xx;
#pragma unroll
                for (int e = 0; e < 4; ++e) UT[(c + e) * 64 + i] = aU[xx][e];
                v2u w; w.x = pk2(aW[xx][0], aW[xx][1]); w.y = pk2(aW[xx][2], aW[xx][3]); *(v2u*)(Wp + 32 * xx + 8 * (t7 & 3) + 4 * (t7 >> 2)) = w;
            }
        }
        __syncthreads();
    }
}

constexpr int SEQ_WGS = 16;
constexpr int SQ_WP = 0, SQ_QD = 16384, SQ_KDT = 32768, SQ_QK = 49152, SQ_BUF = 57344;
__device__ __forceinline__ bf16x8 packfrag(const f32x4 lo, const f32x4 hi) { v4u w; w.x = pg8::cvt_pk_bf16(lo[0], lo[1]); w.y = pg8::cvt_pk_bf16(lo[2], lo[3]); w.z = pg8::cvt_pk_bf16(hi[0], hi[1]); w.w = pg8::cvt_pk_bf16(hi[2], hi[3]); return __builtin_bit_cast(bf16x8, w); }
__device__ __forceinline__ void seq_stage(LAS unsigned char* buf, const unsigned char* blk, int lt) {
    v4u r[14];
#pragma unroll
    for (int i = 0; i < 14; ++i) r[i] = *(const v4u*)(blk + (size_t)(lt + 256 * i) * 16);
#pragma unroll
    for (int i = 0; i < 14; ++i) {
        const int id = lt + 256 * i; int dst;
        if (id < 2048) { const int rr = (id & 1023) >> 4, ch = id & 15; dst = (id & ~1023) * 16 + rr * 256 + 16 * (ch ^ (rr & 15)); }
        else { const int rr = (id - 2048) >> 3, ch = id & 7; dst = 32768 + rr * 128 + 16 * (ch ^ (rr & 7)); }
        *(LAS v4u*)(buf + dst) = r[i];
    }
}
__device__ __forceinline__ void p4_delta_seq(Frame& F, int sid) {
    const int lane = F.lane, wave = F.wave, tid = F.tid;
    const int bh = sid >> 1, half = sid & 1, b = bh >> 2, h = bh & 3;
    const int fr = lane & 15, fq = lane >> 4;
    const int v0 = half * 64 + (wave & 3) * 16;
    const unsigned char* cbase = F.ws + WS_CHK + (size_t)(bh * 128) * CHK_STRIDE;
    float* OD = WSP(float, WS_ODELTA);
    f32x4 Sacc[8];
#pragma unroll
    for (int T = 0; T < 8; ++T) Sacc[T] = (f32x4){0.f, 0.f, 0.f, 0.f};
    if (wave >= 4) seq_stage(F.lds, cbase, tid - 256);
    __syncthreads();
    for (int n = 0; n < 128; ++n) {
        LAS unsigned char* buf = F.lds + (n & 1) * SQ_BUF;
        if (wave >= 4) { if (n + 1 < 128) seq_stage(F.lds + ((n + 1) & 1) * SQ_BUF, cbase + (size_t)(n + 1) * CHK_STRIDE, tid - 256); }
        else {
            const unsigned char* blk = cbase + (size_t)n * CHK_STRIDE;
            const float gl = *(const float*)(blk + CHK_GL);
            const float* UT = (const float*)(blk + CHK_UT) + (size_t)(v0 + fr) * 64 + 4 * fq;
            f32x4 U[4];
#pragma unroll
            for (int tc = 0; tc < 4; ++tc) U[tc] = *(const f32x4*)(UT + 16 * tc);
            bf16x8 sf[4];
#pragma unroll
            for (int s = 0; s < 4; ++s) sf[s] = packfrag(Sacc[2 * s], Sacc[2 * s + 1]);
            f32x4 Vn[4], Oa[4];
#pragma unroll
            for (int tc = 0; tc < 4; ++tc) {
                const int rr = 16 * tc + fr; f32x4 av = (f32x4){0.f, 0.f, 0.f, 0.f}, ao = (f32x4){0.f, 0.f, 0.f, 0.f};
#pragma unroll
                for (int s = 0; s < 4; ++s) {
                    const int off = rr * 256 + 16 * ((4 * s + fq) ^ (rr & 15));
                    const bf16x8 wf = *(const LAS bf16x8*)(buf + SQ_WP + off), qf = *(const LAS bf16x8*)(buf + SQ_QD + off);
                    av = __builtin_amdgcn_mfma_f32_16x16x32_bf16(wf, sf[s], av, 0, 0, 0);
                    ao = __builtin_amdgcn_mfma_f32_16x16x32_bf16(qf, sf[s], ao, 0, 0, 0);
                }
                Vn[tc] = U[tc] - av; Oa[tc] = ao;
            }
            bf16x8 vf[2];
            vf[0] = packfrag(Vn[0], Vn[1]); vf[1] = packfrag(Vn[2], Vn[3]);
#pragma unroll
            for (int tc = 0; tc < 4; ++tc) {
                const int rr = 16 * tc + fr;
#pragma unroll
                for (int s = 0; s < 2; ++s) {
                    const bf16x8 kf = *(const LAS bf16x8*)(buf + SQ_QK + rr * 128 + 16 * ((4 * s + fq) ^ (rr & 7)));
                    Oa[tc] = __builtin_amdgcn_mfma_f32_16x16x32_bf16(kf, vf[s], Oa[tc], 0, 0, 0);
                }
                float* op = OD + (size_t)(b * SEQ + n * 64 + 16 * tc + 4 * fq) * 512 + h * 128 + v0 + fr;
#pragma unroll
                for (int j = 0; j < 4; ++j) op[(size_t)j * 512] = Oa[tc][j];
            }
#pragma unroll
            for (int T = 0; T < 8; ++T) {
                const int rr = 16 * T + fr; f32x4 a = Sacc[T] * gl;
#pragma unroll
                for (int s = 0; s < 2; ++s) {
                    const bf16x8 kf = *(const LAS bf16x8*)(buf + SQ_KDT + rr * 128 + 16 * ((4 * s + fq) ^ (rr & 7)));
                    a = __builtin_amdgcn_mfma_f32_16x16x32_bf16(kf, vf[s], a, 0, 0, 0);
                }
                Sacc[T] = a;
            }
        }
        __syncthreads();
    }
}

__device__ __forceinline__ void p4_indexer(Frame& F, int widx, int nw) {
    const int lane = F.lane, fr = lane & 15, fq = lane >> 4;
    const bf16* QL = WSP(bf16, WS_QL); const bf16* KI = WSP(bf16, WS_KIDX); const float* WI = WSP(float, WS_WIDX); float* SC = WSP(float, WS_BIG);
    for (int task = widx; task < 2 * 4352; task += nw) {
        const int b = task / 4352; int tau = task - b * 4352;
        int g = 0; while (16 * (g + 1) * (g + 2) <= tau) ++g;
        tau -= 16 * g * (g + 1);
        const int qt = 32 * g + tau / (g + 1), seg = tau % (g + 1);
        const int row0 = b * SEQ + 16 * qt;
        bf16x8 Qf[8][2];
#pragma unroll
        for (int hh = 0; hh < 8; ++hh)
#pragma unroll
            for (int s = 0; s < 2; ++s) Qf[hh][s] = *(const bf16x8*)(QL + (size_t)(row0 + fr) * 1536 + 1024 + hh * 64 + 32 * s + 8 * fq);
        f32x4 wv[4][2];
#pragma unroll
        for (int j = 0; j < 4; ++j) { wv[j][0] = *(const f32x4*)(WI + (size_t)(row0 + 4 * fq + j) * 8); wv[j][1] = *(const f32x4*)(WI + (size_t)(row0 + 4 * fq + j) * 8 + 4); }
        const int kt1 = (32 * seg + 31 < qt) ? 32 * seg + 31 : qt;
        for (int kt = 32 * seg; kt <= kt1; ++kt) {
            const bf16* kp = KI + (size_t)(b * SEQ + 16 * kt + fr) * 64 + 8 * fq;
            const bf16x8 k0 = *(const bf16x8*)kp, k1 = *(const bf16x8*)(kp + 32);
            f32x4 isc = (f32x4){0.f, 0.f, 0.f, 0.f};
#pragma unroll
            for (int hh = 0; hh < 8; ++hh) {
                f32x4 c = __builtin_amdgcn_mfma_f32_16x16x32_bf16(Qf[hh][0], k0, (f32x4){0.f, 0.f, 0.f, 0.f}, 0, 0, 0);
                c = __builtin_amdgcn_mfma_f32_16x16x32_bf16(Qf[hh][1], k1, c, 0, 0, 0);
#pragma unroll
                for (int j = 0; j < 4; ++j) isc[j] += fmaxf(c[j], 0.f) * wv[j][hh >> 2][hh & 3];
            }
            float* sp = SC + (size_t)(row0 + 4 * fq) * 8192 + 16 * kt + fr;
#pragma unroll
            for (int j = 0; j < 4; ++j) sp[(size_t)j * 8192] = isc[j];
        }
    }
}

__device__ __forceinline__ unsigned long long mask_ge(unsigned x, unsigned t) { unsigned long long m; asm("v_cmp_ge_u32_e64 %0, %1, %2" : "=s"(m) : "v"(x), "s"(t)); return m; }
__device__ __forceinline__ void mask_ge8(unsigned long long (&m)[8], unsigned x0, unsigned x1, unsigned x2, unsigned x3, unsigned x4, unsigned x5, unsigned x6, unsigned x7, unsigned t) {
    asm("v_cmp_ge_u32_e64 %0, %8, %16\n\tv_cmp_ge_u32_e64 %1, %9, %16\n\tv_cmp_ge_u32_e64 %2, %10, %16\n\tv_cmp_ge_u32_e64 %3, %11, %16\n\t"
        "v_cmp_ge_u32_e64 %4, %12, %16\n\tv_cmp_ge_u32_e64 %5, %13, %16\n\tv_cmp_ge_u32_e64 %6, %14, %16\n\tv_cmp_ge_u32_e64 %7, %15, %16"
        : "=&s"(m[0]), "=&s"(m[1]), "=&s"(m[2]), "=&s"(m[3]), "=&s"(m[4]), "=&s"(m[5]), "=&s"(m[6]), "=&s"(m[7])
        : "v"(x0), "v"(x1), "v"(x2), "v"(x3), "v"(x4), "v"(x5), "v"(x6), "v"(x7), "s"(t));
}
__device__ __forceinline__ unsigned long long mask_eq(unsigned x, unsigned t) { unsigned long long m; asm("v_cmp_eq_u32_e64 %0, %1, %2" : "=s"(m) : "v"(x), "s"(t)); return m; }
__device__ __forceinline__ void p5_topk(Frame& F) {
    const int lane = F.lane, gw = F.bid * NWAVES + F.wave, NGW = F.G * NWAVES;
    const float* SC = WSP(float, WS_BIG); int* SEL = WSP(int, WS_SEL); int* NSEL = WSP(int, WS_NSEL);
    for (int rix = gw; rix < M; rix += NGW) {
        const int row = ((rix & 1) ? (M - 1 - (rix >> 1)) : (rix >> 1));
        const int pos = row & (SEQ - 1), n = pos + 1;
        int* sel = SEL + (size_t)row * 256;
        if (n <= 256) {
#pragma unroll
            for (int i = 0; i < 4; ++i) { const int j = 64 * i + lane; sel[j] = (j < n) ? j : 0; }
            if (lane == 0) NSEL[row] = n;
            continue;
        }
        const int nblk = (n + 1023) >> 10;
        const float* sr = SC + (size_t)row * 8192;
        int lane_l = lane; asm volatile("" : "+v"(lane_l));
        unsigned u[128];
#pragma unroll
        for (int i = 0; i < 64; ++i) u[i] = __float_as_uint((sr + (i >> 4) * 1024)[(i & 15) * 64 + lane_l]);
        if (nblk > 4) {
#pragma unroll
            for (int i = 64; i < 128; ++i) u[i] = __float_as_uint((sr + (i >> 4) * 1024)[(i & 15) * 64 + lane_l]);
        } else {
#pragma unroll
            for (int i = 64; i < 128; ++i) u[i] = 0u;
        }
        asm volatile("" ::: "memory");
#pragma unroll
        for (int i = 0; i < 128; ++i) { const int lim = n - i * 64; const unsigned bits = u[i];
            const unsigned x = (bits & 0x80000000u) ? ~bits : (bits | 0x80000000u);
            u[i] = (lane < lim) ? x : 0u; }
        unsigned T = 0u;
        for (int bit = 31; bit >= 0; --bit) {
            const unsigned cand = T | (1u << bit); int c = 0;
#pragma unroll
            for (int bk = 0; bk < 8; ++bk) {
                if (bk < nblk) {
#pragma unroll
                    for (int g8 = 0; g8 < 2; ++g8) {
                        unsigned long long mm[8];
#pragma unroll
                        for (int i = 0; i < 1; ++i) { const int b0 = bk * 16 + g8 * 8; mask_ge8(mm, u[b0], u[b0 + 1], u[b0 + 2], u[b0 + 3], u[b0 + 4], u[b0 + 5], u[b0 + 6], u[b0 + 7], cand); }
#pragma unroll
                        for (int i = 0; i < 8; ++i) c += __popcll(mm[i]);
                    }
                }
            }
            if (c >= 256) T = cand;
        }
        int cgt = 0;
#pragma unroll
        for (int bk = 0; bk < 8; ++bk) {
            if (bk < nblk) {
#pragma unroll
                for (int g8 = 0; g8 < 2; ++g8) {
                    unsigned long long mm[8];
#pragma unroll
                    for (int i = 0; i < 1; ++i) { const int b0 = bk * 16 + g8 * 8; mask_ge8(mm, u[b0], u[b0 + 1], u[b0 + 2], u[b0 + 3], u[b0 + 4], u[b0 + 5], u[b0 + 6], u[b0 + 7], T + 1u); }
#pragma unroll
                    for (int i = 0; i < 8; ++i) cgt += __popcll(mm[i]);
                }
            }
        }
        const int need_eq = 256 - cgt;
        int running = 0, eq_taken = 0;
        const unsigned long long ltmask = (1ull << lane) - 1ull;
#pragma unroll
        for (int bk = 0; bk < 8; ++bk) {
            if (bk < nblk) {
#pragma unroll
                for (int g8 = 0; g8 < 2; ++g8) {
                    unsigned long long mg[8], me[8];
#pragma unroll
                    for (int i = 0; i < 1; ++i) { const int b0 = bk * 16 + g8 * 8; mask_ge8(mg, u[b0], u[b0 + 1], u[b0 + 2], u[b0 + 3], u[b0 + 4], u[b0 + 5], u[b0 + 6], u[b0 + 7], T); mask_ge8(me, u[b0], u[b0 + 1], u[b0 + 2], u[b0 + 3], u[b0 + 4], u[b0 + 5], u[b0 + 6], u[b0 + 7], T + 1u); }
#pragma unroll
                    for (int i = 0; i < 8; ++i) me[i] = mg[i] & ~me[i];
#pragma unroll
                    for (int i = 0; i < 8; ++i) {
                        unsigned long long mt = mg[i];
                        if (me[i] != 0ull) {
                            const int room = need_eq - eq_taken; unsigned long long keep = 0ull, rest = me[i];
                            for (int k = 0; k < room && rest != 0ull; ++k) { const unsigned long long low = rest & (~rest + 1ull); keep |= low; rest ^= low; }
                            mt = (mg[i] & ~me[i]) | keep; eq_taken += __popcll(me[i]);
                        }
                        if (mt != 0ull) {
                            if ((mt >> lane) & 1ull) sel[running + __popcll(mt & ltmask)] = (bk * 16 + g8 * 8 + i) * 64 + lane;
                            running += __popcll(mt);
                        }
                    }
                }
            }
        }
        if (lane == 0) NSEL[row] = 256;
    }
}

__device__ __forceinline__ void p6_sparse_attn(Frame& F) {
    const int lane = F.lane, gw = F.bid * NWAVES + F.wave, NGW = F.G * NWAVES;
    LAS float* ql = (LAS float*)(F.lds + F.wave * 12288);
    LAS float* pp = ql + 1024;
    const bf16* QL = WSP(bf16, WS_QL); const bf16* CKV = WSP(bf16, WS_CKV); const int* SEL = WSP(int, WS_SEL); const int* NSEL = WSP(int, WS_NSEL); bf16* AO = WSP(bf16, WS_AO);
    for (int row = gw; row < M; row += NGW) {
        const int b = row >> 13, n = NSEL[row];
        const int* sel = SEL + (size_t)row * 256;
        {
            float f[8];
            unpack8(*(const v4u*)(QL + (size_t)row * 1536 + 8 * lane), f);
#pragma unroll
            for (int x = 0; x < 8; ++x) ql[8 * lane + x] = f[x];
            unpack8(*(const v4u*)(QL + (size_t)row * 1536 + 512 + 8 * lane), f);
#pragma unroll
            for (int x = 0; x < 8; ++x) ql[512 + 8 * lane + x] = f[x];
        }
        float s[4][8];
#pragma unroll
        for (int kb = 0; kb < 4; ++kb) {
            const int j = 64 * kb + lane; const bool valid = j < n; const int key = valid ? sel[j] : 0;
            const bf16* kr = CKV + (size_t)(b * SEQ + key) * 128;
#pragma unroll
            for (int hh = 0; hh < 8; ++hh) s[kb][hh] = 0.f;
#pragma unroll 4
            for (int r8 = 0; r8 < 16; ++r8) {
                float x[8]; unpack8(*(const v4u*)(kr + 8 * r8), x);
#pragma unroll
                for (int hh = 0; hh < 8; ++hh) { const f32x4 q0 = *(const LAS f32x4*)(ql + hh * 128 + 8 * r8), q1 = *(const LAS f32x4*)(ql + hh * 128 + 8 * r8 + 4);
                    s[kb][hh] += x[0] * q0[0] + x[1] * q0[1] + x[2] * q0[2] + x[3] * q0[3] + x[4] * q1[0] + x[5] * q1[1] + x[6] * q1[2] + x[7] * q1[3]; }
            }
            if (!valid) {
#pragma unroll
                for (int hh = 0; hh < 8; ++hh) s[kb][hh] = -INFINITY;
            }
        }
#pragma unroll
        for (int hh = 0; hh < 8; ++hh) {
            const float mx = wave_max(fmaxf(fmaxf(s[0][hh], s[1][hh]), fmaxf(s[2][hh], s[3][hh])));
            float e[4], l = 0.f;
#pragma unroll
            for (int kb = 0; kb < 4; ++kb) { e[kb] = __expf(s[kb][hh] - mx); l += e[kb]; }
            const float inv = 1.0f / wave_sum(l);
#pragma unroll
            for (int kb = 0; kb < 4; ++kb) pp[(64 * kb + lane) * 8 + hh] = e[kb] * inv;
        }
        float o[8][2];
#pragma unroll
        for (int hh = 0; hh < 8; ++hh) { o[hh][0] = 0.f; o[hh][1] = 0.f; }
        for (int j = 0; j < n; ++j) {
            const int key = sel[j];
            const unsigned kv = *(const unsigned*)(CKV + (size_t)(b * SEQ + key) * 128 + 2 * lane);
            const float lo = bflo(kv), hi = bfhi(kv);
            const f32x4 p0 = *(const LAS f32x4*)(pp + j * 8), p1 = *(const LAS f32x4*)(pp + j * 8 + 4);
#pragma unroll
            for (int hh = 0; hh < 4; ++hh) { o[hh][0] += p0[hh] * lo; o[hh][1] += p0[hh] * hi; o[4 + hh][0] += p1[hh] * lo; o[4 + hh][1] += p1[hh] * hi; }
        }
#pragma unroll
        for (int hh = 0; hh < 8; ++hh) *(unsigned*)(AO + (size_t)row * 1536 + hh * 128 + 2 * lane) = pk2(o[hh][0], o[hh][1]);
    }
}
__device__ __forceinline__ void p6_gdn_out(Frame& F, KArgs A) {
    const int lane = F.lane, gw = F.bid * NWAVES + F.wave, NGW = F.G * NWAVES;
    const f32x4 g0 = *(const f32x4*)(A->in[I_AB_ONG] + 8 * (lane & 15)), g1 = *(const f32x4*)(A->in[I_AB_ONG] + 8 * (lane & 15) + 4);
    for (int row = gw; row < M; row += NGW) {
        const float* op = WSP(float, WS_ODELTA) + (size_t)row * 512 + 8 * lane;
        const f32x4 a = *(const f32x4*)op, b = *(const f32x4*)(op + 4);
        float ss = a[0] * a[0] + a[1] * a[1] + a[2] * a[2] + a[3] * a[3] + b[0] * b[0] + b[1] * b[1] + b[2] * b[2] + b[3] * b[3];
        ss += __shfl_xor(ss, 1); ss += __shfl_xor(ss, 2); ss += __shfl_xor(ss, 4); ss += __shfl_xor(ss, 8);
        const float r = rsqrtf(ss * (1.0f / 128.0f) + 1e-6f);
        float z[8]; unpack8(*(const v4u*)(WSP(bf16, WS_QKVZ) + (size_t)row * 2048 + 1536 + 8 * lane), z);
        float o[8];
#pragma unroll
        for (int i = 0; i < 4; ++i) { o[i] = a[i] * r * g0[i] * siluf(z[i]); o[4 + i] = b[i] * r * g1[i] * siluf(z[4 + i]); }
        *(v4u*)(WSP(bf16, WS_AO) + (size_t)row * 1536 + 1024 + 8 * lane) = pack8f(o);
    }
}

__device__ __forceinline__ void p8_ln_router(Frame& F, KArgs A, int l, float* HOUT, bf16* HB) {
    const int lane = F.lane, tid = F.tid, gw = F.bid * NWAVES + F.wave, NGW = F.G * NWAVES;
    LAS float* wT = (LAS float*)(F.lds);
    LAS float* lg = (LAS float*)(F.lds + WSCR_OFF + F.wave * WSCR_BYTES);
    const float* rw = A->in[I_RW] + (size_t)l * 1024 * 32;
    for (int i = tid; i < 1024 * 32; i += NTHREADS) { const int k = i >> 5, e = i & 31; wT[e * 1028 + k] = rw[i]; }
    __syncthreads();
    const float* PRE = WSP(float, WS_PRE);
    const float* lg_g = A->in[I_LNM_G] + (size_t)l * 1024; const float* lg_b = A->in[I_LNM_B] + (size_t)l * 1024;
    const float rb = A->in[I_RB][l * 32 + (lane & 31)];
    int* TOKE = WSP(int, WS_ROUTE); int* TOKPOS = TOKE + M * 4; float* TOKG = (float*)(TOKPOS + M * 4);
    gu32* cnt = F.ctl + CW_CNT + 64 * l;
    for (int row = gw; row < M; row += NGW) {
        f32x4 v[4]; float s = 0.f;
#pragma unroll
        for (int j = 0; j < 4; ++j) { v[j] = *(const f32x4*)(PRE + (size_t)row * 1024 + 256 * j + 4 * lane); s += (v[j][0] + v[j][1]) + (v[j][2] + v[j][3]); }
        const float mean = wave_sum(s) * (1.0f / 1024.0f); float s2 = 0.f;
#pragma unroll
        for (int j = 0; j < 4; ++j) { v[j] = v[j] - mean; s2 += (v[j][0] * v[j][0] + v[j][1] * v[j][1]) + (v[j][2] * v[j][2] + v[j][3] * v[j][3]); }
        const float rstd = rsqrtf(wave_sum(s2) * (1.0f / 1024.0f) + 1e-5f);
#pragma unroll
        for (int j = 0; j < 4; ++j) {
            const f32x4 g = *(const f32x4*)(lg_g + 256 * j + 4 * lane), bb = *(const f32x4*)(lg_b + 256 * j + 4 * lane);
            v[j] = v[j] * rstd * g + bb;
            *(f32x4*)(HOUT + (size_t)row * 1024 + 256 * j + 4 * lane) = v[j];
            v2u o; o.x = pk2(v[j][0], v[j][1]); o.y = pk2(v[j][2], v[j][3]); *(v2u*)(HB + (size_t)row * 1024 + 256 * j + 4 * lane) = o;
        }
        float part[32];
#pragma unroll
        for (int e = 0; e < 32; ++e) {
            float a = 0.f;
#pragma unroll
            for (int j = 0; j < 4; ++j) { const f32x4 w = *(const LAS f32x4*)(wT + e * 1028 + 256 * j + 4 * lane); a += v[j][0] * w[0] + v[j][1] * w[1] + v[j][2] * w[2] + v[j][3] * w[3]; }
            part[e] = a;
        }
#pragma unroll
        for (int i = 0; i < 16; ++i) { const bool up = (lane & 32) != 0; const float keep = up ? part[i + 16] : part[i], send = up ? part[i] : part[i + 16]; part[i] = keep + __shfl_xor(send, 32); }
#pragma unroll
        for (int i = 0; i < 8; ++i) { const bool up = (lane & 16) != 0; const float keep = up ? part[i + 8] : part[i], send = up ? part[i] : part[i + 8]; part[i] = keep + __shfl_xor(send, 16); }
#pragma unroll
        for (int i = 0; i < 4; ++i) { const bool up = (lane & 8) != 0; const float keep = up ? part[i + 4] : part[i], send = up ? part[i] : part[i + 4]; part[i] = keep + __shfl_xor(send, 8); }
#pragma unroll
        for (int i = 0; i < 2; ++i) { const bool up = (lane & 4) != 0; const float keep = up ? part[i + 2] : part[i], send = up ? part[i] : part[i + 2]; part[i] = keep + __shfl_xor(send, 4); }
        { const bool up = (lane & 2) != 0; const float keep = up ? part[1] : part[0], send = up ? part[0] : part[1]; part[0] = keep + __shfl_xor(send, 2); }
        part[0] += __shfl_xor(part[0], 1);
        const int eidx = ((lane >> 5) & 1) * 16 + ((lane >> 4) & 1) * 8 + ((lane >> 3) & 1) * 4 + ((lane >> 2) & 1) * 2 + ((lane >> 1) & 1);
        if ((lane & 1) == 0) lg[eidx] = part[0];
        float val = (lane < 32) ? lg[lane & 31] + rb : -INFINITY;
        float tl[4]; int te[4];
#pragma unroll
        for (int k = 0; k < 4; ++k) {
            const float mx = wave_max(val);
            const unsigned long long mm = __ballot(val == mx && lane < 32);
            const int idx = __ffsll((long long)mm) - 1;
            tl[k] = mx; te[k] = idx;
            if (lane == idx) val = -INFINITY;
        }
        const float e1 = __expf(tl[1] - tl[0]), e2 = __expf(tl[2] - tl[0]), e3 = __expf(tl[3] - tl[0]);
        const float inv = 1.0f / (1.0f + e1 + e2 + e3);
        if (lane < 4) {
            const int e = lane == 0 ? te[0] : (lane == 1 ? te[1] : (lane == 2 ? te[2] : te[3]));
            const float g = (lane == 0 ? 1.0f : (lane == 1 ? e1 : (lane == 2 ? e2 : e3))) * inv;
            const unsigned pos = __hip_atomic_fetch_add(cnt + e, 1u, RLX_AGENT);
            TOKE[(size_t)row * 4 + lane] = e; TOKPOS[(size_t)row * 4 + lane] = (int)pos; TOKG[(size_t)row * 4 + lane] = g;
        }
    }
}

__device__ __forceinline__ void p9_scatter(Frame& F, int l, const bf16* HB) {
    const int lane = F.lane, tid = F.tid, gw = F.bid * NWAVES + F.wave, NGW = F.G * NWAVES;
    LAS int* base = (LAS int*)(F.lds + MISC_OFF + 256);
    int* TOKE = WSP(int, WS_ROUTE); int* TOKPOS = TOKE + M * 4; int* TILE = TOKE + 3 * M * 4;
    if (tid == 0) {
        int acc = 0;
        for (int e = 0; e < NEXP; ++e) { const int c = (int)__hip_atomic_load(F.ctl + CW_CNT + 64 * l + e, RLX_AGENT); base[e] = acc; acc += ((c + 255) >> 8) << 8; }
        base[32] = acc >> 8;
    }
    __syncthreads();
    if (F.bid == 0 && tid < 64) {
        const int nT = base[32];
        for (int t = tid; t < NTMAX; t += 64) { int e = 0;
            for (int x = 1; x < NEXP; ++x) if (base[x] <= t * 256) e = x;
            TILE[t] = (t < nT) ? e : 0; }
        if (tid == 0) TILE[NTMAX] = nT;
    }
    bf16* XS = WSP(bf16, WS_XS);
    for (int row = gw; row < M; row += NGW) {
        const v4u a = *(const v4u*)(HB + (size_t)row * 1024 + 8 * lane), b = *(const v4u*)(HB + (size_t)row * 1024 + 512 + 8 * lane);
#pragma unroll
        for (int k = 0; k < 4; ++k) {
            const int slot = base[TOKE[(size_t)row * 4 + k]] + TOKPOS[(size_t)row * 4 + k];
            *(v4u*)(XS + (size_t)slot * 1024 + 8 * lane) = a; *(v4u*)(XS + (size_t)slot * 1024 + 512 + 8 * lane) = b;
        }
    }
}

__device__ __forceinline__ void p12_combine(Frame& F, KArgs A, int l, const float* HIN, float* HOUT, bf16* HB) {
    const int lane = F.lane, tid = F.tid, gw = F.bid * NWAVES + F.wave, NGW = F.G * NWAVES;
    LAS int* base = (LAS int*)(F.lds + MISC_OFF + 256);
    if (tid == 0) { int acc = 0; for (int e = 0; e < NEXP; ++e) { const int c = (int)__hip_atomic_load(F.ctl + CW_CNT + 64 * l + e, RLX_AGENT); base[e] = acc; acc += ((c + 255) >> 8) << 8; } }
    __syncthreads();
    const int* TOKE = WSP(int, WS_ROUTE); const int* TOKPOS = TOKE + M * 4; const float* TOKG = (const float*)(TOKPOS + M * 4);
    const bf16* YS = WSP(bf16, WS_YS); const bf16* PLE = WSP(bf16, WS_PLE);
    const float* lg_g = A->in[I_LNF_G] + (size_t)l * 1024; const float* lg_b = A->in[I_LNF_B] + (size_t)l * 1024;
    for (int row = gw; row < M; row += NGW) {
        float x[16];
        {   const f32x4 h0 = *(const f32x4*)(HIN + (size_t)row * 1024 + 8 * lane), h1 = *(const f32x4*)(HIN + (size_t)row * 1024 + 8 * lane + 4);
            const f32x4 h2 = *(const f32x4*)(HIN + (size_t)row * 1024 + 512 + 8 * lane), h3 = *(const f32x4*)(HIN + (size_t)row * 1024 + 512 + 8 * lane + 4);
            float p0[8], p1[8]; unpack8(*(const v4u*)(PLE + (size_t)row * 1024 + 8 * lane), p0); unpack8(*(const v4u*)(PLE + (size_t)row * 1024 + 512 + 8 * lane), p1);
#pragma unroll
            for (int i = 0; i < 4; ++i) { x[i] = ALPHA * h0[i] + p0[i]; x[4 + i] = ALPHA * h1[i] + p0[4 + i]; x[8 + i] = ALPHA * h2[i] + p1[i]; x[12 + i] = ALPHA * h3[i] + p1[4 + i]; }
        }
#pragma unroll
        for (int k = 0; k < 4; ++k) {
            const int slot = base[TOKE[(size_t)row * 4 + k]] + TOKPOS[(size_t)row * 4 + k]; const float g = TOKG[(size_t)row * 4 + k];
            float y0[8], y1[8]; unpack8(*(const v4u*)(YS + (size_t)slot * 1024 + 8 * lane), y0); unpack8(*(const v4u*)(YS + (size_t)slot * 1024 + 512 + 8 * lane), y1);
#pragma unroll
            for (int i = 0; i < 8; ++i) { x[i] += g * y0[i]; x[8 + i] += g * y1[i]; }
        }
        float s = 0.f;
#pragma unroll
        for (int i = 0; i < 16; ++i) s += x[i];
        const float mean = wave_sum(s) * (1.0f / 1024.0f); float s2 = 0.f;
#pragma unroll
        for (int i = 0; i < 16; ++i) { x[i] -= mean; s2 += x[i] * x[i]; }
        const float rstd = rsqrtf(wave_sum(s2) * (1.0f / 1024.0f) + 1e-5f);
#pragma unroll
        for (int hf = 0; hf < 2; ++hf) {
            const int c0 = 512 * hf + 8 * lane;
            const f32x4 g0 = *(const f32x4*)(lg_g + c0), g1 = *(const f32x4*)(lg_g + c0 + 4), b0 = *(const f32x4*)(lg_b + c0), b1 = *(const f32x4*)(lg_b + c0 + 4);
            f32x4 o0, o1;
#pragma unroll
            for (int i = 0; i < 4; ++i) { o0[i] = x[8 * hf + i] * rstd * g0[i] + b0[i]; o1[i] = x[8 * hf + 4 + i] * rstd * g1[i] + b1[i]; }
            *(f32x4*)(HOUT + (size_t)row * 1024 + c0) = o0; *(f32x4*)(HOUT + (size_t)row * 1024 + c0 + 4) = o1;
            if (HB) { v4u w; w.x = pk2(o0[0], o0[1]); w.y = pk2(o0[2], o0[3]); w.z = pk2(o1[0], o1[1]); w.w = pk2(o1[2], o1[3]); *(v4u*)(HB + (size_t)row * 1024 + c0) = w; }
        }
    }
}

__device__ __forceinline__ void p14_dilated(Frame& F) {
    const int lane = F.lane, gw = F.bid * NWAVES + F.wave, NGW = F.G * NWAVES;
    LAS float* pe = (LAS float*)(F.lds + F.wave * 2048);
    const bf16* QK = WSP(bf16, WS_QKVZ); bf16* AO = WSP(bf16, WS_AO);
    for (int task = gw; task < M * 12; task += NGW) {
        const int row = task / 12, hh = task - row * 12, b = row >> 13, pos = row & (SEQ - 1);
        float q[64];
#pragma unroll
        for (int c = 0; c < 8; ++c) { float f[8]; unpack8(*(const v4u*)(QK + (size_t)row * 2560 + hh * 64 + 8 * c), f);
#pragma unroll
            for (int x = 0; x < 8; ++x) q[8 * c + x] = f[x]; }
        float s[7];
#pragma unroll
        for (int i = 0; i < 7; ++i) {
            const int e = lane + 64 * i, p = e / 129, m = e - p * 129;
            const int dd = (p == 0) ? 1 : (p == 1 ? 4 : 16);
            const int kpos = pos - m * dd; const bool valid = (e < 387) && (kpos >= 0);
            float a = -INFINITY;
            if (valid) {
                const bf16* kr = QK + (size_t)(b * SEQ + kpos) * 2560 + 768 + hh * 64; a = 0.f;
#pragma unroll
                for (int c = 0; c < 8; ++c) { float f[8]; unpack8(*(const v4u*)(kr + 8 * c), f);
#pragma unroll
                    for (int x = 0; x < 8; ++x) a += q[8 * c + x] * f[x]; }
                a *= 0.125f;
            }
            s[i] = a;
        }
        float mx = s[0];
#pragma unroll
        for (int i = 1; i < 7; ++i) mx = fmaxf(mx, s[i]);
        mx = wave_max(mx);
        float l = 0.f;
#pragma unroll
        for (int i = 0; i < 7; ++i) { const float ev = __expf(s[i] - mx); pe[lane + 64 * i] = ev; l += ev; }
        l = wave_sum(l);
        float o = 0.f;
#pragma unroll
        for (int p = 0; p < 3; ++p) {
            const int dd = (p == 0) ? 1 : (p == 1 ? 4 : 16);
            int mmax = pos / dd; if (mmax > 128) mmax = 128;
            const bf16* vb = QK + (size_t)(b * SEQ + pos) * 2560 + 1536 + hh * 64 + lane;
            for (int m = 0; m <= mmax; ++m) o += pe[p * 129 + m] * bf1(vb[-(ptrdiff_t)m * dd * 2560]);
        }
        AO[(size_t)row * 1024 + hh * 64 + lane] = (bf16)f2bf(o / l);
    }
}
typedef short v4i16_t __attribute__((ext_vector_type(4)));
__device__ __forceinline__ v4i16_t lds_tr16(LAS unsigned char* p) { return __builtin_amdgcn_ds_read_tr16_b64_v4i16((LAS v4i16_t*)p); }
constexpr int DV_PITCH = 144, DV_BUF = 32 * DV_PITCH;
template <int DL  > __device__ __forceinline__ void dil_branch(const bf16* __restrict__ KV, LAS unsigned char* vbuf, const int s0, const int lane,
                                                                                 const bf16x8 (&qf)[2], f32x4 (&O)[4], float& m_run, float& l_run) {
    constexpr int d = 1 << DL, sigma = 16 >> DL, NS = (129 + 15 * sigma + 31) / 32;
    const int fr = lane & 15, fq = lane >> 4;
    const int c = s0 & (d - 1), n0 = s0 >> DL, kstart = n0 - 128;
#define DIL_POS(n) ({ int _p = c + d * (n); _p = _p < 0 ? 0 : (_p > SEQ - 1 ? SEQ - 1 : _p); _p; })
    bf16x8 kf[2][2]; v4u vr[4];
#pragma unroll
    for (int tl = 0; tl < 2; ++tl) { const bf16* kp = KV + (size_t)DIL_POS(kstart + 16 * tl + fr) * 2560 + 768 + 8 * fq; kf[tl][0] = *(const bf16x8*)kp; kf[tl][1] = *(const bf16x8*)(kp + 32); }
#pragma unroll
    for (int i = 0; i < 4; ++i) vr[i] = *(const v4u*)(KV + (size_t)DIL_POS(kstart + (lane >> 3) + 8 * i) * 2560 + 1536 + 8 * (lane & 7));
#pragma unroll 1
    for (int g = 0; g < NS; ++g) {
        LAS unsigned char* vb = vbuf + (g & 1) * DV_BUF;
#pragma unroll
        for (int i = 0; i < 4; ++i) *(LAS v4u*)(vb + ((lane >> 3) + 8 * i) * DV_PITCH + 16 * (lane & 7)) = vr[i];
        bf16x8 kc[2][2];
#pragma unroll
        for (int tl = 0; tl < 2; ++tl) { kc[tl][0] = kf[tl][0]; kc[tl][1] = kf[tl][1]; }
        if (g + 1 < NS) {
            const int kb = kstart + 32 * (g + 1);
#pragma unroll
            for (int tl = 0; tl < 2; ++tl) { const bf16* kp = KV + (size_t)DIL_POS(kb + 16 * tl + fr) * 2560 + 768 + 8 * fq; kf[tl][0] = *(const bf16x8*)kp; kf[tl][1] = *(const bf16x8*)(kp + 32); }
#pragma unroll
            for (int i = 0; i < 4; ++i) vr[i] = *(const v4u*)(KV + (size_t)DIL_POS(kb + (lane >> 3) + 8 * i) * 2560 + 1536 + 8 * (lane & 7));
        }
        float sv[8];
#pragma unroll
        for (int tl = 0; tl < 2; ++tl) {
            f32x4 cc = __builtin_amdgcn_mfma_f32_16x16x32_bf16(kc[tl][0], qf[0], (f32x4){0.f, 0.f, 0.f, 0.f}, 0, 0, 0);
            cc = __builtin_amdgcn_mfma_f32_16x16x32_bf16(kc[tl][1], qf[1], cc, 0, 0, 0);
#pragma unroll
            for (int j = 0; j < 4; ++j) {
                const int rel = 32 * g + 16 * tl + 4 * fq + j;
                const int delta = 128 + sigma * fr - rel;
                const bool ok = (delta >= 0) && (delta <= 128) && (kstart + rel >= 0);
                sv[4 * tl + j] = ok ? cc[j] * 0.125f : -INFINITY;
            }
        }
        float mx = fmaxf(fmaxf(fmaxf(sv[0], sv[1]), fmaxf(sv[2], sv[3])), fmaxf(fmaxf(sv[4], sv[5]), fmaxf(sv[6], sv[7])));
        mx = fmaxf(mx, __shfl_xor(mx, 16)); mx = fmaxf(mx, __shfl_xor(mx, 32));
        const float m_new = fmaxf(m_run, mx);
        if (!__all(m_new == m_run)) {
            const float alpha = __expf(m_run - m_new);
            l_run *= alpha;
#pragma unroll
            for (int j = 0; j < 4; ++j) { const float aj = __shfl(alpha, 4 * fq + j);
#pragma unroll
                for (int dt = 0; dt < 4; ++dt) O[dt][j] *= aj; }
            m_run = m_new;
        }
        float p[8], ps = 0.f;
#pragma unroll
        for (int e = 0; e < 8; ++e) { p[e] = __expf(sv[e] - m_run); ps += p[e]; }
        l_run += ps;
        v4u pw; pw.x = pg8::cvt_pk_bf16(p[0], p[1]); pw.y = pg8::cvt_pk_bf16(p[2], p[3]); pw.z = pg8::cvt_pk_bf16(p[4], p[5]); pw.w = pg8::cvt_pk_bf16(p[6], p[7]);
        const bf16x8 pf = __builtin_bit_cast(bf16x8, pw);
        LAS unsigned char* tb = vb + (4 * fq + ((lane & 15) >> 2)) * DV_PITCH + 8 * (lane & 3);
#pragma unroll
        for (int dt = 0; dt < 4; ++dt) {
            const v4i16_t lo = lds_tr16(tb + 32 * dt), hi = lds_tr16(tb + 16 * DV_PITCH + 32 * dt);
            bf16x8 vf; vf[0] = lo[0]; vf[1] = lo[1]; vf[2] = lo[2]; vf[3] = lo[3]; vf[4] = hi[0]; vf[5] = hi[1]; vf[6] = hi[2]; vf[7] = hi[3];
            O[dt] = __builtin_amdgcn_mfma_f32_16x16x32_bf16(pf, vf, O[dt], 0, 0, 0);
        }
    }
#undef DIL_POS
}
__device__ __forceinline__ void p14_dilated_mfma(Frame& F) {
    const int lane = F.lane, fr = lane & 15, fq = lane >> 4;
    LAS unsigned char* vbuf = F.lds + F.wave * (2 * DV_BUF);
    const bf16* QK = WSP(bf16, WS_QKVZ); bf16* AO = WSP(bf16, WS_AO);
    for (int u = F.bid; u < 24 * 32 * 2; u += F.G) {
        const int bh = u >> 6, blk = (u >> 1) & 31, o = (u & 1) * 8 + F.wave;
        const int b = bh / 12, hh = bh - b * 12, s0 = 256 * blk + o;
        const bf16* KV = QK + (size_t)b * SEQ * 2560 + hh * 64;
        bf16x8 qf[2];
        { const bf16* qp = KV + (size_t)(s0 + 16 * fr) * 2560 + 8 * fq; qf[0] = *(const bf16x8*)qp; qf[1] = *(const bf16x8*)(qp + 32); }
        f32x4 O[4];
#pragma unroll
        for (int dt = 0; dt < 4; ++dt) O[dt] = (f32x4){0.f, 0.f, 0.f, 0.f};
        float m_run = -1e30f, l_run = 0.f;
        dil_branch<4>(KV, vbuf, s0, lane, qf, O, m_run, l_run);
        dil_branch<2>(KV, vbuf, s0, lane, qf, O, m_run, l_run);
        dil_branch<0>(KV, vbuf, s0, lane, qf, O, m_run, l_run);
        float lt = l_run; lt += __shfl_xor(lt, 16); lt += __shfl_xor(lt, 32);
        const float inv = 1.0f / lt;
#pragma unroll
        for (int j = 0; j < 4; ++j) {
            const float ij = __shfl(inv, 4 * fq + j);
            bf16* op = AO + (size_t)(b * SEQ + s0 + 16 * (4 * fq + j)) * 1024 + hh * 64 + fr;
#pragma unroll
            for (int dt = 0; dt < 4; ++dt) op[16 * dt] = (bf16)f2bf(O[dt][j] * ij);
        }
    }
}
constexpr int SA_PITCH = 272, SA_TILE = 32 * SA_PITCH;
__device__ __forceinline__ void p6_sparse_attn_mfma(Frame& F) {
    const int lane = F.lane, fr = lane & 15, fq = lane >> 4, gw = F.bid * NWAVES + F.wave, NGW = F.G * NWAVES;
    LAS unsigned char* tile = F.lds + F.wave * SA_TILE;
    const bf16* QL = WSP(bf16, WS_QL); const bf16* CKV = WSP(bf16, WS_CKV); const int* SEL = WSP(int, WS_SEL); const int* NSEL = WSP(int, WS_NSEL); bf16* AO = WSP(bf16, WS_AO);
    for (int row = gw; row < M; row += NGW) {
        const int b = row >> 13, n = __builtin_amdgcn_readfirstlane(NSEL[row]);
        const int* sel = SEL + (size_t)row * 256;
        const bf16* kvb = CKV + (size_t)b * SEQ * 128;
        bf16x8 qf[4];
#pragma unroll
        for (int s = 0; s < 4; ++s) { const v4u z = (v4u){0u, 0u, 0u, 0u}; qf[s] = (fr < 8) ? *(const bf16x8*)(QL + (size_t)row * 1536 + fr * 128 + 32 * s + 8 * fq) : __builtin_bit_cast(bf16x8, z); }
        f32x4 O[8];
#pragma unroll
        for (int rt = 0; rt < 8; ++rt) O[rt] = (f32x4){0.f, 0.f, 0.f, 0.f};
        float m_run = -1e30f, l_run = 0.f;
        const int nsteps = (n + 31) >> 5;
        v4u vr[8];
        { const int j = lane & 31; const int kidx = (j < n) ? sel[j] : 0;
#pragma unroll
          for (int i = 0; i < 8; ++i) { const int key = __shfl(kidx, (lane >> 4) + 4 * i); vr[i] = *(const v4u*)(kvb + (size_t)key * 128 + 8 * (lane & 15)); } }
#pragma unroll 1
        for (int g = 0; g < nsteps; ++g) {
#pragma unroll
            for (int i = 0; i < 8; ++i) *(LAS v4u*)(tile + ((lane >> 4) + 4 * i) * SA_PITCH + 16 * (lane & 15)) = vr[i];
            if (g + 1 < nsteps) {
                const int j = 32 * (g + 1) + (lane & 31); const int kidx = (j < n) ? sel[j] : 0;
#pragma unroll
                for (int i = 0; i < 8; ++i) { const int key = __shfl(kidx, (lane >> 4) + 4 * i); vr[i] = *(const v4u*)(kvb + (size_t)key * 128 + 8 * (lane & 15)); }
            }
            float sv[8];
#pragma unroll
            for (int tl = 0; tl < 2; ++tl) {
                f32x4 cc = (f32x4){0.f, 0.f, 0.f, 0.f};
#pragma unroll
                for (int s = 0; s < 4; ++s) { const bf16x8 kf = *(const LAS bf16x8*)(tile + (16 * tl + fr) * SA_PITCH + 64 * s + 16 * fq); cc = __builtin_amdgcn_mfma_f32_16x16x32_bf16(kf, qf[s], cc, 0, 0, 0); }
#pragma unroll
                for (int j = 0; j < 4; ++j) sv[4 * tl + j] = (32 * g + 16 * tl + 4 * fq + j < n) ? cc[j] : -INFINITY;
            }
            float mx = fmaxf(fmaxf(fmaxf(sv[0], sv[1]), fmaxf(sv[2], sv[3])), fmaxf(fmaxf(sv[4], sv[5]), fmaxf(sv[6], sv[7])));
            mx = fmaxf(mx, __shfl_xor(mx, 16)); mx = fmaxf(mx, __shfl_xor(mx, 32));
            const float m_new = fmaxf(m_run, mx);
            if (!__all(m_new == m_run)) {
                const float alpha = __expf(m_run - m_new);
                l_run *= alpha;
#pragma unroll
                for (int j = 0; j < 4; ++j) { const float aj = __shfl(alpha, 4 * fq + j);
#pragma unroll
                    for (int rt = 0; rt < 8; ++rt) O[rt][j] *= aj; }
                m_run = m_new;
            }
            float p[8], ps = 0.f;
#pragma unroll
            for (int e = 0; e < 8; ++e) { p[e] = __expf(sv[e] - m_run); ps += p[e]; }
            l_run += ps;
            v4u pw; pw.x = pg8::cvt_pk_bf16(p[0], p[1]); pw.y = pg8::cvt_pk_bf16(p[2], p[3]); pw.z = pg8::cvt_pk_bf16(p[4], p[5]); pw.w = pg8::cvt_pk_bf16(p[6], p[7]);
            const bf16x8 pf = __builtin_bit_cast(bf16x8, pw);
            LAS unsigned char* tb = tile + (4 * fq + ((lane & 15) >> 2)) * SA_PITCH + 8 * (lane & 3);
#pragma unroll
            for (int rt = 0; rt < 8; ++rt) {
                const v4i16_t lo = lds_tr16(tb + 32 * rt), hi = lds_tr16(tb + 16 * SA_PITCH + 32 * rt);
                bf16x8 vf; vf[0] = lo[0]; vf[1] = lo[1]; vf[2] = lo[2]; vf[3] = lo[3]; vf[4] = hi[0]; vf[5] = hi[1]; vf[6] = hi[2]; vf[7] = hi[3];
                O[rt] = __builtin_amdgcn_mfma_f32_16x16x32_bf16(pf, vf, O[rt], 0, 0, 0);
            }
        }
        float lt = l_run; lt += __shfl_xor(lt, 16); lt += __shfl_xor(lt, 32);
        const float inv = 1.0f / lt;
#pragma unroll
        for (int j = 0; j < 4; ++j) {
            const float ij = __shfl(inv, 4 * fq + j);
            if (fq < 2) { bf16* op = AO + (size_t)row * 1536 + (4 * fq + j) * 128 + fr;
#pragma unroll
                for (int rt = 0; rt < 8; ++rt) op[16 * rt] = (bf16)f2bf(O[rt][j] * ij); }
        }
    }
}
__device__ __forceinline__ void p14_pool(Frame& F, KArgs A) {
    const int lane = F.lane, tid = F.tid, gw = F.bid * NWAVES + F.wave, NGW = F.G * NWAVES;
    LAS float* pw = (LAS float*)(F.lds + 16384);
    LAS float* dl = (LAS float*)(F.lds + 16384 + 65536 + F.wave * 1024);
    for (int i = tid; i < 4 * 64 * 64; i += NTHREADS) pw[i] = A->in[I_CD_POOLW][i];
    __syncthreads();
    const bf16* QK = WSP(bf16, WS_QKVZ); bf16* AO = WSP(bf16, WS_AO);
    const int gi = lane >> 4, w = 2 << gi;
    float sc[4];
#pragma unroll
    for (int g = 0; g < 4; ++g) sc[g] = A->in[I_CD_POOLS][g * 64 + lane];
    for (int row = gw; row < M; row += NGW) {
        const int pos = row & (SEQ - 1);
        const int cntw = (pos + 1 < w) ? pos + 1 : w;
        float sum[4] = {0.f, 0.f, 0.f, 0.f}, cur[4] = {0.f, 0.f, 0.f, 0.f};
        for (int j = 0; j < cntw; ++j) {
            const v2u xr = *(const v2u*)(QK + (size_t)(row - j) * 2560 + 2304 + 4 * lane);
            const float f0 = bflo(xr.x), f1 = bfhi(xr.x), f2 = bflo(xr.y), f3 = bfhi(xr.y);
            sum[0] += f0; sum[1] += f1; sum[2] += f2; sum[3] += f3;
            if (j == 0) { cur[0] = f0; cur[1] = f1; cur[2] = f2; cur[3] = f3; }
        }
        const float inv = 1.0f / (float)cntw;
#pragma unroll
        for (int i = 0; i < 4; ++i) dl[4 * lane + i] = sum[i] * inv - cur[i];
        float o[4] = {0.f, 0.f, 0.f, 0.f};
        for (int c = 0; c < 64; ++c) {
#pragma unroll
            for (int g = 0; g < 4; ++g) o[g] += dl[g * 64 + c] * pw[(g * 64 + c) * 64 + lane];
        }
#pragma unroll
        for (int g = 0; g < 4; ++g) AO[(size_t)row * 1024 + 768 + g * 64 + lane] = (bf16)f2bf(o[g] * sc[g]);
    }
}


#define IN(k) (lo <= (k) && (k) < hi)
#define SEAM(k) do { if (IN(k) && IN((k) + 1)) xcd_barrier(bar); } while (0)
template <int l> __device__ __forceinline__ void layer_tail(Frame& F, const XcdBarrier& bar, const int lo, const int hi) {
    LAS unsigned char* ring = F.lds + RING_OFF;
    const int bid = F.bid, G = F.G;
        const int pb = 8 * l;

        if (IN(7 + pb)) {
            pg8::Gemm g{WSP(bf16, WS_AO), (l == 0) ? WSP(bf16, WS_W_OUTAB) : WSP(bf16, WS_W_OUTCD), M, 1024, (l == 0) ? 1536 : 1024}; pg8::StaticOrder S; S.init(M, 1024, G, bid);
            pg8::Epi<pg8::StPre> E{{(l == 0) ? kargs()->in[I_X] : WSP(float, WS_H2), WSP(float, WS_PRE), ALPHA}};
            pg8::gemm_phase<pg8::Epi<pg8::StPre>, pg8::StaticOrder, true, true>(ring, g, S, E);
        } SEAM(7 + pb);
        if (IN(8 + pb)) { p8_ln_router(F, kargs(), l, WSP(float, WS_H1), WSP(bf16, WS_H1B)); } SEAM(8 + pb);
        if (IN(9 + pb)) {
            p9_scatter(F, l, WSP(bf16, WS_H1B));
            __syncthreads();
            pg8::Gemm g{WSP(bf16, WS_H1B), WSP(bf16, WS_W_PG) + (size_t)l * 1024 * 1024, M, 1024, 1024}; pg8::StaticOrder S; S.init(M, 1024, G, bid);
            pg8::Epi<pg8::StPleGate> E{{WSP(bf16, WS_PP) + (size_t)l * M * 1024, WSP(bf16, WS_PLE)}};
            pg8::gemm_phase<pg8::Epi<pg8::StPleGate>, pg8::StaticOrder, true, true>(ring, g, S, E);
        } SEAM(9 + pb);
        const int* TILE = WSP(int, WS_ROUTE) + 3 * M * 4;
        if (IN(10 + pb)) {
            const int nT = __builtin_amdgcn_readfirstlane(TILE[NTMAX]);
            pg8::Gemm g{WSP(bf16, WS_XS), WSP(bf16, WS_W_GU) + (size_t)l * NEXP * 2048 * 1024, PMAX, 2048, 1024};
            pg8::MoeOrder S{TILE, nT, 8, G, bid, (long)2048 * 1024 * 2};
            pg8::Epi<pg8::StSwiglu> E{{kargs()->in[I_BGU] + (size_t)l * NEXP * 2048, WSP(bf16, WS_HID)}};
            pg8::gemm_phase<pg8::Epi<pg8::StSwiglu>, pg8::MoeOrder, true, true>(ring, g, S, E);
        } SEAM(10 + pb);
        if (IN(11 + pb)) {
            const int nT = __builtin_amdgcn_readfirstlane(TILE[NTMAX]);
            pg8::Gemm g{WSP(bf16, WS_HID), WSP(bf16, WS_W_DN) + (size_t)l * NEXP * 1024 * 1024, PMAX, 1024, 1024};
            pg8::MoeOrder S{TILE, nT, 4, G, bid, (long)1024 * 1024 * 2};
            pg8::Epi<pg8::StDown> E{{kargs()->in[I_BDN] + (size_t)l * NEXP * 1024, WSP(bf16, WS_YS)}};
            pg8::gemm_phase<pg8::Epi<pg8::StDown>, pg8::MoeOrder, true, true>(ring, g, S, E);
        } SEAM(11 + pb);
        if (IN(12 + pb)) { p12_combine(F, kargs(), l, WSP(float, WS_H1), (l == 0) ? WSP(float, WS_H2) : kargs()->out, (l == 0) ? WSP(bf16, WS_XB) : (bf16*)nullptr); }
}
#undef IN
#undef SEAM
__global__ void __launch_bounds__(NTHREADS, 2) mk_fwd(Args args_by_value) {
    const KArgs KA = kargs();
    extern __shared__ __attribute__((aligned(16))) unsigned char lds[];
    Frame F;
    F.lds = (LAS unsigned char*)lds;
    F.tid = threadIdx.x; F.lane = F.tid & 63; F.wave = __builtin_amdgcn_readfirstlane(F.tid >> 6);
    F.G = gridDim.x; F.bid = blockIdx.x; F.ws = KA->ws; F.ctl = (gu32*)(KA->ws + WS_CTL);
    volatile LAS unsigned* MISC = (volatile LAS unsigned*)(F.lds + MISC_OFF);
    { int t0 = threadIdx.x; asm volatile("" : "+v"(t0)); for (int u = t0; u < (LDS_BYTES - MISC_OFF) / 4; u += NTHREADS) MISC[u] = 0u; }
    __syncthreads();
    const bool use_bar = (N_LAUNCHES != NPHASES);
    XcdBarrier bar; bar.bar = (unsigned*)(F.ctl + CW_BAR) + KA->li * XCD_BAR_WORDS; bar.x = 0; bar.st = nullptr;
    if (use_bar) bar = xcd_barrier_post((unsigned*)(F.ctl + CW_BAR) + KA->li * XCD_BAR_WORDS, MISC + 8);
    const int lo = KA->ph_lo, hi = KA->ph_hi;
#define IN(k) (lo <= (k) && (k) < hi)
#define SEAM(k) do { if (IN(k) && IN((k) + 1)) xcd_barrier(bar); } while (0)
    LAS unsigned char* ring = F.lds + RING_OFF;
    const int bid = F.bid, G = F.G;

    if (IN(0)) { p0_prologue(F, kargs()); } SEAM(0);

            if (IN(1)) {
                { pg8::Gemm g{WSP(bf16, WS_XB), WSP(bf16, WS_W_INAB), M, 2560, 1024}; pg8::StaticOrder S; S.init(M, 2560, G, bid);
                  pg8::Epi<pg8::StInAB> E{{WSP(float, WS_SM), WSP(bf16, WS_QKVZ)}};
                  pg8::gemm_phase<pg8::Epi<pg8::StInAB>, pg8::StaticOrder, true, true>(ring, g, S, E); }
                __syncthreads();
                { pg8::Gemm g{WSP(bf16, WS_PB), WSP(bf16, WS_W_PP), 2 * M, 1024, 256}; pg8::BatchOrder S{4, (2 * M / 256) * 4, G, bid, M / 256, (long)1024 * 256 * 2};
                  pg8::Epi<pg8::StBf16> E{{WSP(bf16, WS_PP), 1024}};
                  pg8::gemm_phase<pg8::Epi<pg8::StBf16>, pg8::BatchOrder, true, true>(ring, g, S, E); }
            } SEAM(1);
            if (IN(2)) { p2_prep(F, kargs()); } SEAM(2);
            if (IN(3)) {
                p3_chunk_prep(F, kargs());
                __syncthreads();
                { pg8::Gemm g{WSP(bf16, WS_CQ), WSP(bf16, WS_W_ABS), M, 1536, 256}; pg8::StaticOrder S; S.init(M, 1536, G, bid);
                  pg8::Epi<pg8::StBf16> E{{WSP(bf16, WS_QL), 1536}};
                  pg8::gemm_phase<pg8::Epi<pg8::StBf16>, pg8::StaticOrder, true, true>(ring, g, S, E); }
            } SEAM(3);
            if (IN(4)) {
                if (bid < SEQ_WGS && G > SEQ_WGS) p4_delta_seq(F, bid);
                else p4_indexer(F, (bid - SEQ_WGS) * NWAVES + F.wave, (G - SEQ_WGS) * NWAVES);
            } SEAM(4);
            if (IN(5)) { p5_topk(F); } SEAM(5);
            if (IN(6)) { p6_sparse_attn_mfma(F); p6_gdn_out(F, kargs()); } SEAM(6);
    layer_tail<0>(F, bar, lo, hi);
    SEAM(12);
            if (IN(13)) {
                pg8::Gemm g{WSP(bf16, WS_XB), WSP(bf16, WS_W_INCD), M, 2560, 1024}; pg8::StaticOrder S; S.init(M, 2560, G, bid);
                pg8::Epi<pg8::StBf16> E{{WSP(bf16, WS_QKVZ), 2560}};
                pg8::gemm_phase<pg8::Epi<pg8::StBf16>, pg8::StaticOrder, true, true>(ring, g, S, E);
            } SEAM(13);
            if (IN(14)) { p14_dilated_mfma(F); __syncthreads(); p14_pool(F, kargs()); } SEAM(14);
    layer_tail<1>(F, bar, lo, hi);
#undef IN
#undef SEAM
}

extern "C" void kernel_launch(void* const* d_in, const int* in_sizes, int n_in, void* d_out, int out_size, void* d_ws, size_t ws_size, hipStream_t stream) {
    static int grid = 0;
    if (grid == 0) {
        if (n_in != N_IN || in_sizes[0] != M * D || out_size != M * D || ws_size < WS_END) {
            fprintf(stderr, "kernel_launch: built for %d inputs, x/out of %d floats, >= %zu bytes of workspace; got n_in %d, in0 %d, out %d, ws %zu; nothing launched\n", N_IN, M * D, (size_t)WS_END, n_in, n_in > 0 ? in_sizes[0] : -1, out_size, ws_size);
            grid = -1; return; }
        int dev = 0, cus = 0, per_cu = 0;
        if (hipGetDevice(&dev) != hipSuccess || hipDeviceGetAttribute(&cus, hipDeviceAttributeMultiprocessorCount, dev) != hipSuccess) { fprintf(stderr, "kernel_launch: device query failed\n"); grid = -1; return; }
        if (hipFuncSetAttribute((const void*)mk_fwd, hipFuncAttributeMaxDynamicSharedMemorySize, LDS_BYTES) != hipSuccess) { fprintf(stderr, "kernel_launch: hipFuncSetAttribute failed\n"); grid = -1; return; }
        if (hipOccupancyMaxActiveBlocksPerMultiprocessor(&per_cu, (const void*)mk_fwd, NTHREADS, LDS_BYTES) != hipSuccess || per_cu < 1)
            fprintf(stderr, "kernel_launch: note: occupancy query reports %d workgroups per CU\n", per_cu);
        (void)hipGetLastError();
        grid = cus;
    }
    if (grid < 0) return;
    if (hipMemsetAsync((char*)d_ws + WS_CTL, 0, CTL_ZERO_BYTES, stream) != hipSuccess) { fprintf(stderr, "kernel_launch: memset failed\n"); return; }
    Args a{};
    for (int i = 0; i < N_IN; ++i) a.in[i] = (const float*)d_in[i];
    a.out = (float*)d_out; a.ws = (unsigned char*)d_ws;
    for (int li = 0; li < N_LAUNCHES; ++li) {
        if (N_LAUNCHES == NPHASES) { a.ph_lo = li; a.ph_hi = li + 1; } else { a.ph_lo = (int)((long)li * NPHASES / N_LAUNCHES); a.ph_hi = (int)((long)(li + 1) * NPHASES / N_LAUNCHES); }
        a.li = li;
        hipLaunchKernelGGL(mk_fwd, dim3(grid), dim3(NTHREADS), LDS_BYTES, stream, a);
        const hipError_t le = hipPeekAtLastError();
        if (le != hipSuccess) { fprintf(stderr, "kernel_launch: launch %d failed: %s\n", li, hipGetErrorName(le)); break; }
    }
}
```

```cpp
#include <hip/hip_runtime.h>
#include <cstdio>
#include <cstdint>

namespace pg8 {
#define PG8_LAS __attribute__((address_space(3)))
typedef unsigned short bf16_t;
typedef short bf16x8 __attribute__((ext_vector_type(8)));
typedef float f32x4 __attribute__((ext_vector_type(4)));
typedef unsigned u32x4 __attribute__((ext_vector_type(4)));
constexpr int BM = 256, BK = 64, HALF = 128, HTB = HALF * BK * 2  , STAGE_BYTES = 8 * HTB, NXCD = 8, WGM = 8;

__host__ __device__ __forceinline__ int lds_byte(int r, int c) { const int st = (r >> 4) * 2 + (c >> 5), rr = r & 15, cc = c & 31, ob = rr * 64 + cc * 2; return st * 1024 + (ob ^ (((ob >> 9) & 1) << 5)); }
__host__ __device__ __forceinline__ void stage_rc(int b, int& R, int& C) { const int st = b / 1024, sb = b % 1024, swz = sb ^ (((sb >> 9) & 1) << 5); R = (st >> 1) * 16 + swz / 64; C = (st & 1) * 32 + (swz % 64) / 2; }
__host__ __device__ __forceinline__ int perm32(int rho) { const int n = rho >> 4, i = rho & 15; return 8 * (i >> 2) + 4 * n + (i & 3); }

struct Unit { int pm, pn, e; long bofs; };
struct Gemm { const bf16_t* A; const bf16_t* Bt; int M, N, K; };

struct StaticOrder {
    int nM, nN, nwg, G, c;
    __host__ __device__ void init(int M, int N, int G_, int c_) { nM = M / BM; nN = N / BM; nwg = nM * nN; G = G_; c = c_; }
    __host__ __device__ bool next(int i, Unit& u) const {
        const long L = (long)i * G + c; if (L >= nwg) return false;
        int wgid = (int)L; { const int q = nwg / NXCD, r = nwg % NXCD, xcd = wgid % NXCD, off = wgid / NXCD; wgid = (xcd < r ? xcd * (q + 1) : r * (q + 1) + (xcd - r) * q) + off; }
        const int nig = WGM * nN, gid = wgid / nig, fm = gid * WGM, gsz = (nM - fm) < WGM ? (nM - fm) : WGM;
        u.pm = fm + ((wgid % nig) % gsz); u.pn = (wgid % nig) / gsz; u.e = 0; u.bofs = 0; return true;
    }
    __device__ __forceinline__ void a_ready(const Unit&) const {}
    __device__ __forceinline__ void done(const Unit&) const {}
};
struct MoeOrder {
    const int* tile_e; int nT, nN, G, c; long estride;
    __device__ __forceinline__ bool next(int i, Unit& u) const {
        const long L = (long)i * G + c; if (L >= (long)nT * nN) return false;
        u.pm = (int)(L / nN); u.pn = (int)(L % nN); const int e = tile_e[u.pm]; u.e = e; u.bofs = (long)e * estride; return true;
    }
    __device__ __forceinline__ void a_ready(const Unit&) const {}
    __device__ __forceinline__ void done(const Unit&) const {}
};

struct BatchOrder {
    int nN, nwg, G, c, tiles_per_batch; long bstride;
    __device__ __forceinline__ bool next(int i, Unit& u) const {
        const long L = (long)i * G + c; if (L >= nwg) return false;
        u.pm = (int)(L / nN); u.pn = (int)(L % nN); const int e = u.pm / tiles_per_batch; u.e = e; u.bofs = (long)e * bstride; return true;
    }
    __device__ __forceinline__ void a_ready(const Unit&) const {}
    __device__ __forceinline__ void done(const Unit&) const {}
};

__device__ __forceinline__ unsigned cvt_pk_bf16(float lo, float hi) { unsigned r; asm volatile("v_cvt_pk_bf16_f32 %0, %1, %2" : "=v"(r) : "v"(lo), "v"(hi)); return r; }
__device__ __forceinline__ u32x4 pack8(const f32x4 v0, const f32x4 v1) { u32x4 w; w.x = cvt_pk_bf16(v0[0], v0[1]); w.y = cvt_pk_bf16(v0[2], v0[3]); w.z = cvt_pk_bf16(v1[0], v1[1]); w.w = cvt_pk_bf16(v1[2], v1[3]); return w; }
__device__ __forceinline__ float bf_lo(unsigned w) { return __uint_as_float(w << 16); }
__device__ __forceinline__ float bf_hi(unsigned w) { return __uint_as_float(w & 0xffff0000u); }
__device__ __forceinline__ float sigmoidf_(float x) { return 1.0f / (1.0f + __expf(-x)); }
typedef unsigned u32x2 __attribute__((ext_vector_type(2)));

template <class T> struct Epi {
    static constexpr bool PERM = true, AFTER_DRAIN = false;
    T t;
    __device__ __forceinline__ void operator()(const f32x4 (&acc)[2][2][4][2], const Unit& u, int wr, int wc, int fr, int fq) const {
        const int row0 = u.pm * BM + wr * 64 + fr, col0 = u.pn * BM + wc * 32 + 8 * fq;
#pragma unroll
        for (int ai = 0; ai < 2; ++ai)
#pragma unroll
            for (int m = 0; m < 4; ++m) {
#pragma unroll
                for (int bj = 0; bj < 2; ++bj) t.store(row0 + ai * HALF + m * 16, col0 + bj * HALF, acc[ai][bj][m][0], acc[ai][bj][m][1], u);
                asm volatile("" ::: "memory"); }
    }
};
struct StBf16 { bf16_t* O; int ld;
    __device__ __forceinline__ void store(int row, int col, f32x4 v0, f32x4 v1, const Unit&) const { *(u32x4*)(O + (size_t)row * ld + col) = pack8(v0, v1); } };
struct StInAB { float* SM; bf16_t* Q;
    __device__ __forceinline__ void store(int row, int col, f32x4 v0, f32x4 v1, const Unit&) const {
        if (col < 512) { float* p = SM + (size_t)row * 512 + col; *(f32x4*)p = v0; *(f32x4*)(p + 4) = v1; }
        else *(u32x4*)(Q + (size_t)row * 2048 + (col - 512)) = pack8(v0, v1); } };
struct StPre { const float* base; float* P; float alpha;
    __device__ __forceinline__ void store(int row, int col, f32x4 v0, f32x4 v1, const Unit&) const {
        const size_t o = (size_t)row * 1024 + col; const f32x4 b0 = *(const f32x4*)(base + o), b1 = *(const f32x4*)(base + o + 4);
        *(f32x4*)(P + o) = b0 * alpha + v0; *(f32x4*)(P + o + 4) = b1 * alpha + v1; } };
struct StPleGate { const bf16_t* PP; bf16_t* O;
    __device__ __forceinline__ void store(int row, int col, f32x4 v0, f32x4 v1, const Unit&) const {
        const size_t o = (size_t)row * 1024 + col; const u32x4 p = *(const u32x4*)(PP + o);
        f32x4 r0, r1;
        r0[0] = sigmoidf_(v0[0]) * bf_lo(p.x); r0[1] = sigmoidf_(v0[1]) * bf_hi(p.x); r0[2] = sigmoidf_(v0[2]) * bf_lo(p.y); r0[3] = sigmoidf_(v0[3]) * bf_hi(p.y);
        r1[0] = sigmoidf_(v1[0]) * bf_lo(p.z); r1[1] = sigmoidf_(v1[1]) * bf_hi(p.z); r1[2] = sigmoidf_(v1[2]) * bf_lo(p.w); r1[3] = sigmoidf_(v1[3]) * bf_hi(p.w);
        *(u32x4*)(O + o) = pack8(r0, r1); } };
template <bool F8> struct StSwiglu { const float* bgu; bf16_t* H;
    __device__ __forceinline__ float act(float g, float u) const { const float gt = fminf(g, 7.0f), up = fminf(fmaxf(u, -7.0f), 7.0f); return (up + 1.0f) * (gt * sigmoidf_(gt * 1.702f)); }
    __device__ __forceinline__ void store(int row, int col, f32x4 v0, f32x4 v1, const Unit& u) const {
        const float* b = bgu + (size_t)u.e * 2048 + col; const f32x4 b0 = *(const f32x4*)b, b1 = *(const f32x4*)(b + 4);
        v0 = v0 + b0; v1 = v1 + b1;
        if (F8) { unsigned w = 0u; w = __builtin_amdgcn_cvt_pk_fp8_f32(act(v0[0], v0[1]), act(v0[2], v0[3]), w, false); w = __builtin_amdgcn_cvt_pk_fp8_f32(act(v1[0], v1[1]), act(v1[2], v1[3]), w, true);
            *(unsigned*)((unsigned char*)H + (size_t)row * 1024 + (col >> 1)) = w; }
        else { u32x2 w; w.x = cvt_pk_bf16(act(v0[0], v0[1]), act(v0[2], v0[3])); w.y = cvt_pk_bf16(act(v1[0], v1[1]), act(v1[2], v1[3]));
            *(u32x2*)(H + (size_t)row * 1024 + (col >> 1)) = w; } } };
struct StDown { const float* bd; bf16_t* Y;
    __device__ __forceinline__ void store(int row, int col, f32x4 v0, f32x4 v1, const Unit& u) const {
        const float* b = bd + (size_t)u.e * 1024 + col; const f32x4 b0 = *(const f32x4*)b, b1 = *(const f32x4*)(b + 4);
        *(u32x4*)(Y + (size_t)row * 1024 + col) = pack8(v0 + b0, v1 + b1); } };

typedef int i32x8 __attribute__((ext_vector_type(8)));
typedef int i32x4 __attribute__((ext_vector_type(4)));
template <class Epi, class Sched, bool ALIGN_EPI = false, bool SP2 = false, unsigned FP8W = 0u>
__device__ __forceinline__ void gemm_phase(PG8_LAS unsigned char* lds, const Gemm g, const Sched& S, const Epi& E) {
    int tid = threadIdx.x; asm volatile("" : "+v"(tid));
    const int wid = __builtin_amdgcn_readfirstlane(tid >> 6), lane = tid & 63, wr = wid >> 2, wc = wid & 3, fr = lane & 15, fq = lane >> 4;
    int K = g.K; asm volatile("" : "+s"(K));
    const int nt = K / BK;
    unsigned voffA[2], voffB[2];
#pragma unroll
    for (int i = 0; i < 2; ++i) { int R, C; stage_rc(tid * 16 + i * 8192, R, C); const int Rb = Epi::PERM ? ((R & ~31) + perm32(R & 31)) : R;
        voffA[i] = (unsigned)(R * K + C) * 2u; voffB[i] = (unsigned)(Rb * K + C) * 2u; }
    const size_t kstep = (size_t)(BK * 2);
    const size_t hstep = (size_t)HALF * K * 2;
    const size_t tstep = 2 * hstep;
    const unsigned ldsw = (unsigned)wid * 1024u;
    const int aoff = lds_byte(wr * 64 + fr, fq * 8), boff = lds_byte(wc * 32 + fr, fq * 8);
#define PG8_SA(b, h) (((b) * 2 + (h)) * HTB)
#define PG8_SB(b, h) ((4 + (b) * 2 + (h)) * HTB)
#define PG8_STAGE(bufoff, gbase, voff) do { _Pragma("unroll") for (int _i = 0; _i < 2; ++_i) \
        __builtin_amdgcn_global_load_lds((const unsigned*)((const char*)(gbase) + (voff)[_i]), (PG8_LAS unsigned*)(lds + (bufoff) + ldsw + _i * 8192), 16, 0, 0); } while (0)
#define PG8_CAT(lo, hi) __builtin_shufflevector((lo), (hi), 0, 1, 2, 3, 4, 5, 6, 7)
#define PG8_LDA(dst, b, h) do { if constexpr (FP8W != 0u) { _Pragma("unroll") for (int m = 0; m < 4; ++m) dst##8[m] = PG8_CAT(*(const PG8_LAS i32x4*)(lds + PG8_SA(b, h) + aoff + m * 2048), *(const PG8_LAS i32x4*)(lds + PG8_SA(b, h) + aoff + m * 2048 + 1024)); } \
        else { _Pragma("unroll") for (int m = 0; m < 4; ++m) _Pragma("unroll") for (int k = 0; k < 2; ++k) dst[m][k] = *(const PG8_LAS bf16x8*)(lds + PG8_SA(b, h) + aoff + m * 2048 + k * 1024); } } while (0)
#define PG8_LDB(dst, b, h) do { if constexpr (FP8W != 0u) { _Pragma("unroll") for (int n = 0; n < 2; ++n) dst##8[n] = PG8_CAT(*(const PG8_LAS i32x4*)(lds + PG8_SB(b, h) + boff + n * 2048), *(const PG8_LAS i32x4*)(lds + PG8_SB(b, h) + boff + n * 2048 + 1024)); } \
        else { _Pragma("unroll") for (int n = 0; n < 2; ++n) _Pragma("unroll") for (int k = 0; k < 2; ++k) dst[n][k] = *(const PG8_LAS bf16x8*)(lds + PG8_SB(b, h) + boff + n * 2048 + k * 1024); } } while (0)
#define PG8_MMA(ai, bj, At, Bt) do { __builtin_amdgcn_s_setprio(1); _Pragma("unroll") for (int m = 0; m < 4; ++m) _Pragma("unroll") for (int n = 0; n < 2; ++n) { \
        if constexpr (FP8W != 0u) asm volatile("v_mfma_scale_f32_16x16x128_f8f6f4 %0, %1, %2, %0, %3, %4 op_sel_hi:[0,0,0]" : "+v"(acc[ai][bj][m][n]) : "v"(Bt##8[n]), "v"(At##8[m]), "v"(sc_w), "v"(sc_x));   \
        else { _Pragma("unroll") for (int k = 0; k < 2; ++k) acc[ai][bj][m][n] = __builtin_amdgcn_mfma_f32_16x16x32_bf16(Bt[n][k], At[m][k], acc[ai][bj][m][n], 0, 0, 0); } } __builtin_amdgcn_s_setprio(0); } while (0)
#define PG8_WAIT_V(n) asm volatile("s_waitcnt vmcnt(" #n ")" ::: "memory")
#define PG8_WAIT_L(n) asm volatile("s_waitcnt lgkmcnt(" #n ")" ::: "memory")
#define PG8_BAR __builtin_amdgcn_s_barrier()
#define PG8_SCHED __builtin_amdgcn_sched_barrier(0)
    Unit cur, nxt; int ui = 0;
    if (!S.next(0, cur)) return;
    f32x4 acc[2][2][4][2];
#pragma unroll
    for (int a = 0; a < 2; ++a)
#pragma unroll
        for (int b = 0; b < 2; ++b)
#pragma unroll
            for (int m = 0; m < 4; ++m)
#pragma unroll
                for (int n = 0; n < 2; ++n) acc[a][b][m][n] = (f32x4){0.f, 0.f, 0.f, 0.f};
    bf16x8 At[4][2], B0[2][2], B1[2][2];
    int sc_w = (int)FP8W, sc_x = 0x7f7f7f7f; asm volatile("" : "+v"(sc_w), "+v"(sc_x));
    i32x8 At8[4], B08[2], B18[2];
    const char* cA = (const char*)g.A + (size_t)cur.pm * tstep; const char* cB = (const char*)g.Bt + (size_t)cur.pn * tstep + cur.bofs;
    S.a_ready(cur);
    if constexpr (SP2) {
        PG8_STAGE(PG8_SB(0, 0), cB, voffB); PG8_STAGE(PG8_SB(0, 1), cB + hstep, voffB); PG8_STAGE(PG8_SA(0, 0), cA, voffA); PG8_STAGE(PG8_SA(0, 1), cA + hstep, voffA);
        if (wr == 1) PG8_BAR;
        PG8_WAIT_V(2); PG8_BAR;
        PG8_STAGE(PG8_SB(1, 0), cB + kstep, voffB); PG8_STAGE(PG8_SA(1, 0), cA + kstep, voffA); PG8_STAGE(PG8_SB(1, 1), cB + hstep + kstep, voffB);
        PG8_WAIT_V(6); PG8_BAR;
    } else {
        PG8_STAGE(PG8_SB(0, 0), cB, voffB); PG8_STAGE(PG8_SA(0, 0), cA, voffA); PG8_STAGE(PG8_SB(0, 1), cB + hstep, voffB); PG8_STAGE(PG8_SA(0, 1), cA + hstep, voffA);
        if (wr == 1) PG8_BAR;
        PG8_WAIT_V(4); PG8_BAR;
        PG8_STAGE(PG8_SB(1, 0), cB + kstep, voffB); PG8_STAGE(PG8_SA(1, 0), cA + kstep, voffA); PG8_STAGE(PG8_SB(1, 1), cB + hstep + kstep, voffB);
        PG8_WAIT_V(6); PG8_BAR;
    }
    for (;;) {
        const bool has_next = S.next(ui + 1, nxt);
        const char* nA = has_next ? (const char*)g.A + (size_t)nxt.pm * tstep : cA; const char* nB = has_next ? (const char*)g.Bt + (size_t)nxt.pn * tstep + nxt.bofs : cB;
        for (int t = 0; t < nt; t += 2) {
            const bool last = (t == nt - 2);
            const char* a1 = cA + (size_t)(t + 1) * kstep;
            const char* a2 = last ? nA : cA + (size_t)(t + 2) * kstep; const char* b2 = last ? nB : cB + (size_t)(t + 2) * kstep;
            const char* a3 = a2 + kstep; const char* b3 = b2 + kstep;
            if (last && has_next) S.a_ready(nxt);
            if constexpr (SP2) {
            PG8_LDB(B0, 0, 0); PG8_LDB(B1, 0, 1); PG8_SCHED; PG8_LDA(At, 0, 0); PG8_STAGE(PG8_SA(1, 1), a1 + hstep, voffA);
            PG8_WAIT_V(8); PG8_WAIT_L(0); PG8_BAR; PG8_MMA(0, 0, At, B0); PG8_MMA(0, 1, At, B1); PG8_BAR; PG8_SCHED;
            PG8_LDA(At, 0, 1); PG8_STAGE(PG8_SB(0, 0), b2, voffB); PG8_STAGE(PG8_SB(0, 1), b2 + hstep, voffB); PG8_STAGE(PG8_SA(0, 0), a2, voffA);
            PG8_WAIT_V(8); PG8_WAIT_L(0); PG8_BAR; PG8_MMA(1, 0, At, B0); PG8_MMA(1, 1, At, B1); PG8_BAR; PG8_SCHED;
            PG8_LDB(B0, 1, 0); PG8_LDB(B1, 1, 1); PG8_SCHED; PG8_LDA(At, 1, 0); PG8_STAGE(PG8_SA(0, 1), a2 + hstep, voffA);
            PG8_WAIT_V(8); PG8_WAIT_L(0); PG8_BAR; PG8_MMA(0, 0, At, B0); PG8_MMA(0, 1, At, B1); PG8_BAR; PG8_SCHED;
            PG8_LDA(At, 1, 1); PG8_STAGE(PG8_SB(1, 0), b3, voffB); PG8_STAGE(PG8_SB(1, 1), b3 + hstep, voffB); PG8_STAGE(PG8_SA(1, 0), a3, voffA);
            PG8_WAIT_V(8); PG8_WAIT_L(0); PG8_BAR; PG8_MMA(1, 0, At, B0); PG8_MMA(1, 1, At, B1); PG8_BAR; PG8_SCHED;
            } else {
            PG8_LDB(B0, 0, 0); PG8_SCHED; PG8_LDA(At, 0, 0); PG8_STAGE(PG8_SA(1, 1), a1 + hstep, voffA);
            PG8_WAIT_L(8); PG8_BAR; PG8_WAIT_L(0); PG8_MMA(0, 0, At, B0); PG8_BAR; PG8_SCHED;
            PG8_LDB(B1, 0, 1); PG8_STAGE(PG8_SB(0, 0), b2, voffB);
            PG8_BAR; PG8_WAIT_L(0); PG8_MMA(0, 1, At, B1); PG8_BAR;
            PG8_LDA(At, 0, 1); PG8_STAGE(PG8_SA(0, 0), a2, voffA);
            PG8_BAR; PG8_WAIT_L(0); PG8_MMA(1, 0, At, B0); PG8_BAR; PG8_SCHED;
            PG8_STAGE(PG8_SB(0, 1), b2 + hstep, voffB);
            PG8_WAIT_V(6); PG8_BAR; PG8_MMA(1, 1, At, B1); PG8_BAR;
            PG8_LDB(B0, 1, 0); PG8_SCHED; PG8_LDA(At, 1, 0); PG8_STAGE(PG8_SA(0, 1), a2 + hstep, voffA);
            PG8_WAIT_L(8); PG8_BAR; PG8_WAIT_L(0); PG8_MMA(0, 0, At, B0); PG8_BAR; PG8_SCHED;
            PG8_LDB(B1, 1, 1); PG8_STAGE(PG8_SB(1, 0), b3, voffB);
            PG8_BAR; PG8_WAIT_L(0); PG8_MMA(0, 1, At, B1); PG8_BAR;
            PG8_LDA(At, 1, 1); PG8_STAGE(PG8_SA(1, 0), a3, voffA);
            PG8_BAR; PG8_WAIT_L(0); PG8_MMA(1, 0, At, B0); PG8_BAR; PG8_SCHED;
            PG8_STAGE(PG8_SB(1, 1), b3 + hstep, voffB);
            PG8_WAIT_V(6); PG8_BAR; PG8_MMA(1, 1, At, B1); PG8_BAR;
            }
        }
        if constexpr (FP8W != 0u) asm volatile("s_nop 15\n\ts_nop 15" ::: "memory");
        if constexpr (ALIGN_EPI) { if (wr == 0) PG8_BAR; }
        if constexpr (!Epi::AFTER_DRAIN) { E(acc, cur, wr, wc, fr, fq); S.done(cur); }
        if (!has_next) break;
#pragma unroll
        for (int a = 0; a < 2; ++a)
#pragma unroll
            for (int b = 0; b < 2; ++b)
#pragma unroll
                for (int m = 0; m < 4; ++m)
#pragma unroll
                    for (int n = 0; n < 2; ++n) acc[a][b][m][n] = (f32x4){0.f, 0.f, 0.f, 0.f};
        cur = nxt; cA = nA; cB = nB; ++ui;
        if constexpr (ALIGN_EPI) { if (wr == 1) PG8_BAR; }
    }
    PG8_WAIT_V(0);
    if constexpr (!ALIGN_EPI) { if (wr == 0) PG8_BAR; }
    PG8_BAR;
    if constexpr (Epi::AFTER_DRAIN) { E.fused(acc, cur, wr, wc, fr, fq, lds, wid, lane); S.done(cur); }
#undef PG8_SA
#undef PG8_SB
#undef PG8_STAGE
#undef PG8_LDA
#undef PG8_CAT
#undef PG8_LDB
#undef PG8_MMA
#undef PG8_WAIT_V
#undef PG8_WAIT_L
#undef PG8_BAR
#undef PG8_SCHED
}
}

constexpr int NWAVES = 8, NTHREADS = 512;
constexpr int BATCH = 2, SEQ = 8192, M = BATCH * SEQ, D = 1024;
constexpr int NEXP = 32, DEXP = 1024;
constexpr int PMAX = M * 4 + NEXP * 256, NTMAX = PMAX / 256;
constexpr float ALPHA = 1.41421356237f;
constexpr int NPHASES = 21;
#ifndef MOE_FP8
#define MOE_FP8 1
#endif
constexpr bool kMoeFp8 = (MOE_FP8 != 0);
constexpr unsigned kScaleGU = 0x79797979u, kScaleDN = 0x78787878u;
#ifndef MK_N_LAUNCHES
#define MK_N_LAUNCHES 1
#endif
constexpr int N_LAUNCHES = MK_N_LAUNCHES;

enum { I_X = 0, I_P, I_AB_WIN, I_AB_QG, I_AB_KVG, I_AB_WUQ, I_AB_WUK, I_AB_WUV, I_AB_WQIDX, I_AB_KIG, I_AB_KIB, I_AB_CONVW, I_AB_ALOG, I_AB_DTB, I_AB_ONG, I_AB_WOUT,
       I_CD_WIN, I_CD_POOLW, I_CD_POOLS, I_CD_WOUT, I_LNM_G, I_LNM_B, I_RW, I_RB, I_WGU, I_BGU, I_WDN, I_BDN, I_PLE_WP, I_PLE_WG, I_LNF_G, I_LNF_B, N_IN };

constexpr size_t MiB = 1u << 20;
constexpr size_t WS_CTL = 0, CTL_ZERO_BYTES = 1 * MiB;
constexpr size_t WS_W_INAB = 1 * MiB;
constexpr size_t WS_W_ABS = 6 * MiB;
constexpr size_t WS_W_OUTAB = 7 * MiB;
constexpr size_t WS_W_INCD = 10 * MiB;
constexpr size_t WS_W_OUTCD = 15 * MiB;
constexpr size_t WS_W_PG = 17 * MiB;
constexpr size_t WS_W_PP = 21 * MiB;
constexpr size_t WS_W_GU = 22 * MiB;
constexpr size_t WS_W_DN = 278 * MiB;
constexpr size_t WS_XB = 406 * MiB;
constexpr size_t WS_PB = 438 * MiB;
constexpr size_t WS_PP = 454 * MiB;
constexpr size_t WS_SM = 518 * MiB;
constexpr size_t WS_QKVZ = 550 * MiB;
constexpr size_t WS_CQ = 630 * MiB;
constexpr size_t WS_CKV = 638 * MiB;
constexpr size_t WS_KIDX = 642 * MiB;
constexpr size_t WS_WIDX = 644 * MiB;
constexpr size_t WS_BETA = 645 * MiB;
constexpr size_t WS_GG = WS_BETA + 512 * 1024;
constexpr size_t WS_QN = 646 * MiB, WS_KN = 662 * MiB, WS_VN = 678 * MiB;
constexpr size_t WS_QL = 694 * MiB;
constexpr size_t WS_CHK = 742 * MiB;
constexpr size_t WS_SEL = 838 * MiB;
constexpr size_t WS_NSEL = 854 * MiB;
constexpr size_t WS_ODELTA = 855 * MiB;
constexpr size_t WS_AO = 887 * MiB;
constexpr size_t WS_PRE = 935 * MiB;
constexpr size_t WS_H1 = 999 * MiB;
constexpr size_t WS_H2 = 1063 * MiB;
constexpr size_t WS_H1B = 1127 * MiB;
constexpr size_t WS_PLE = 1159 * MiB;
constexpr size_t WS_ROUTE = 1191 * MiB;
constexpr size_t WS_BIG = 1193 * MiB;
constexpr size_t WS_XS = WS_BIG, WS_HID = WS_BIG + 144 * MiB, WS_YS = WS_BIG + 288 * MiB;
constexpr size_t WS_END = WS_BIG + 512 * MiB;
static_assert((size_t)PMAX * 1024 * 2 <= 144 * MiB && WS_END <= 2048 * MiB, "d_ws map");
constexpr size_t CHK_WP = 0, CHK_QD = 16384, CHK_KDT = 32768, CHK_QK = 49152, CHK_UT = 57344, CHK_GL = 90112, CHK_STRIDE = 92160;
static_assert(CHK_STRIDE * 1024 <= 96 * MiB, "chunk operands");
constexpr int CW_TMO = 0, CW_CODE = 1;
constexpr int CW_BAR = 4096;
constexpr int CW_CNT = 16384;

constexpr int RING_OFF = 0, RING_BYTES = 131072;
constexpr int WSCR_OFF = 132096, WSCR_BYTES = 1024;
constexpr int MISC_OFF = 140288;
constexpr int LDS_BYTES = 147456;

#define GAS __attribute__((address_space(1)))
#define LAS __attribute__((address_space(3)))
typedef unsigned short bf16;
typedef unsigned v4u __attribute__((ext_vector_type(4)));
typedef unsigned v2u __attribute__((ext_vector_type(2)));
typedef float f32x4 __attribute__((ext_vector_type(4)));
typedef short bf16x8 __attribute__((ext_vector_type(8)));
typedef GAS unsigned gu32;
#define RLX_AGENT __ATOMIC_RELAXED, __HIP_MEMORY_SCOPE_AGENT
__device__ __forceinline__ unsigned f2bf(float f) { unsigned u = __builtin_bit_cast(unsigned, f); return (u + 0x7fffu + ((u >> 16) & 1u)) >> 16; }
__device__ __forceinline__ unsigned pk2(float lo, float hi) { return f2bf(lo) | (f2bf(hi) << 16); }
__device__ __forceinline__ float bflo(unsigned w) { return __uint_as_float(w << 16); }
__device__ __forceinline__ float bfhi(unsigned w) { return __uint_as_float(w & 0xffff0000u); }
__device__ __forceinline__ float bf1(bf16 h) { return __uint_as_float(((unsigned)h) << 16); }
__device__ __forceinline__ float sigm(float x) { return 1.0f / (1.0f + __expf(-x)); }
__device__ __forceinline__ float siluf(float x) { return x / (1.0f + __expf(-x)); }
__device__ __forceinline__ float wave_sum(float v) {
#pragma unroll
    for (int o = 1; o < 64; o <<= 1) v += __shfl_xor(v, o);
    return v;
}
__device__ __forceinline__ float wave_max(float v) {
#pragma unroll
    for (int o = 1; o < 64; o <<= 1) v = fmaxf(v, __shfl_xor(v, o));
    return v;
}
__device__ __forceinline__ int wave_sum_i(int v) {
#pragma unroll
    for (int o = 1; o < 64; o <<= 1) v += __shfl_xor(v, o);
    return v;
}
__device__ __forceinline__ void unpack8(const v4u w, float (&f)[8]) { f[0] = bflo(w.x); f[1] = bfhi(w.x); f[2] = bflo(w.y); f[3] = bfhi(w.y); f[4] = bflo(w.z); f[5] = bfhi(w.z); f[6] = bflo(w.w); f[7] = bfhi(w.w); }
__device__ __forceinline__ v4u pack8f(const float (&f)[8]) { v4u w; w.x = pk2(f[0], f[1]); w.y = pk2(f[2], f[3]); w.z = pk2(f[4], f[5]); w.w = pk2(f[6], f[7]); return w; }

#define XB_TMO      128
#define XB_XCNT(j)  (256  + 64 * (j))
#define XB_XSUB(j)  (1280 + 64 * (j))
#define XB_XGEN(j)  (2304 + 64 * (j))
#define XB_TOP      3328
#define XB_TOPGEN   3392
#define XCD_BAR_WORDS 3456
#define XB_SPIN_CAP (1u << 18)

__device__ __forceinline__ unsigned xb_ld(unsigned* p)              { return __hip_atomic_load(p, __ATOMIC_RELAXED, __HIP_MEMORY_SCOPE_AGENT); }
__device__ __forceinline__ unsigned xb_add(unsigned* p, unsigned v) { return __hip_atomic_fetch_add(p, v, __ATOMIC_RELAXED, __HIP_MEMORY_SCOPE_AGENT); }
__device__ __forceinline__ unsigned xb_xcc_id() { return (unsigned)__builtin_amdgcn_s_getreg((3 << 11) | 20) & 0xFu; }
#define XB_SPIN(cond, bar) do { unsigned _sp = 0; while (cond) { __builtin_amdgcn_s_sleep(1); \
    if ((++_sp & 255u) == 0u) { if (xb_ld(&(bar)[XB_TMO])) break; if (_sp > XB_SPIN_CAP) { atomicAdd(&(bar)[XB_TMO], 1u); break; } } } } while (0)

struct XcdBarrier {
    unsigned* bar; unsigned x;
    volatile LAS unsigned* st;
};

__device__ __forceinline__ XcdBarrier xcd_barrier_post(unsigned* bar, volatile LAS unsigned* st) {
    XcdBarrier b; b.bar = bar; b.x = xb_xcc_id(); b.st = st;
    if (threadIdx.x == 0) (void)xb_add(&bar[XB_XCNT(b.x)], 1u);
    return b;
}
__device__ __forceinline__ void xcd_barrier_complete(unsigned* bar, unsigned x, unsigned& nloc, unsigned& nx) {
    const unsigned G = gridDim.x * gridDim.y * gridDim.z;
    unsigned sum, cnt, mine, sp = 0u;
    for (;;) {
        sum = 0u; cnt = 0u; mine = 0u;
#pragma unroll
        for (unsigned j = 0; j < 16; ++j) { const unsigned c = xb_ld(&bar[XB_XCNT(j)]); sum += c; cnt += (c > 0u) ? 1u : 0u; mine = (j == x) ? c : mine; }
        if (sum == G) break;
        __builtin_amdgcn_s_sleep(1);
        if ((++sp & 255u) == 0u) { if (xb_ld(&bar[XB_TMO])) break; if (sp > XB_SPIN_CAP) { atomicAdd(&bar[XB_TMO], 1u); break; } }
    }
    nloc = mine > 0u ? mine : 1u; nx = cnt > 0u ? cnt : 1u;
}

__device__ __forceinline__ void xcd_barrier(const XcdBarrier& b) {
    asm volatile("s_waitcnt vmcnt(0)" ::: "memory");
    __syncthreads();
    if (threadIdx.x == 0) {
        unsigned* bar = b.bar;
        __builtin_amdgcn_s_waitcnt(0);
        unsigned nloc = b.st[0], nx = b.st[1];
        if (nloc == 0u) { xcd_barrier_complete(bar, b.x, nloc, nx); b.st[0] = nloc; b.st[1] = nx; }
        const unsigned old = xb_add(&bar[XB_XSUB(b.x)], 1u);
        const unsigned gen = old / nloc;
        if (old + 1u == (gen + 1u) * nloc) {
            __builtin_amdgcn_fence(__ATOMIC_RELEASE, "agent");
            asm volatile("s_waitcnt vmcnt(0)" ::: "memory");
            const unsigned og = xb_add(&bar[XB_TOP], 1u);
            const unsigned tg = og / nx;
            if (og + 1u == (tg + 1u) * nx) xb_add(&bar[XB_TOPGEN], 1u);
            else XB_SPIN(xb_ld(&bar[XB_TOPGEN]) == tg, bar);
            __builtin_amdgcn_fence(__ATOMIC_ACQUIRE, "agent");
            xb_add(&bar[XB_XGEN(b.x)], 1u);
            asm volatile("s_waitcnt vmcnt(0)" ::: "memory");
        } else {
            XB_SPIN(xb_ld(&bar[XB_XGEN(b.x)]) == gen, bar);
            __builtin_amdgcn_fence(__ATOMIC_ACQUIRE, "agent");
            asm volatile("s_waitcnt vmcnt(0)" ::: "memory");
        }
    }
    __syncthreads();
}

struct Args { const float* in[N_IN]; float* out; unsigned char* ws; int ph_lo, ph_hi, li, pad; };
typedef const __attribute__((address_space(4))) Args* KArgs;
__device__ __forceinline__ KArgs kargs() { auto p = __builtin_amdgcn_kernarg_segment_ptr(); asm volatile("" : "+s"(p)); return (KArgs)p; }
struct Frame {
    LAS unsigned char* lds;
    int tid, lane, wave, G, bid;
    unsigned char* ws;
    gu32* ctl;
};
#define WSP(T, off) ((T*)(F.ws + (off)))

struct MapId { __device__ __forceinline__ int operator()(int n) const { return n; } };
struct MapAdd { int off; __device__ __forceinline__ int operator()(int n) const { return n + off; } };
struct MapAB { __device__ __forceinline__ int operator()(int n) const { return n < 456 ? n : (n < 2504 ? n + 56 : n - 2048); } };
template <class Map> __device__ __forceinline__ void wg_transpose_item(const float* W, int N, int ldw, bf16* WT, int ldt, int koff, Map map, LAS float* scr, int item, int tid) {
    const int nblk = (N + 127) >> 7, kb = item / nblk, nb = item - kb * nblk, k0 = kb * 128, n0 = nb * 128;
#pragma unroll
    for (int it = 0; it < 8; ++it) {
        const int row = it * 16 + (tid >> 5), c4 = (tid & 31) * 4, n = n0 + c4;
        f32x4 v = (f32x4){0.f, 0.f, 0.f, 0.f};
        if (n + 3 < N) v = *(const f32x4*)(W + (size_t)(k0 + row) * ldw + n);
        LAS float* s = scr + row * 129 + c4; s[0] = v[0]; s[1] = v[1]; s[2] = v[2]; s[3] = v[3];
    }
    __syncthreads();
#pragma unroll
    for (int j = 0; j < 4; ++j) {
        const int idx = j * 512 + tid, nl = idx >> 4, ch = idx & 15, n = n0 + nl;
        if (n < N) { const LAS float* s = scr + (ch * 8) * 129 + nl;
            v4u o; o.x = pk2(s[0], s[129]); o.y = pk2(s[2 * 129], s[3 * 129]); o.z = pk2(s[4 * 129], s[5 * 129]); o.w = pk2(s[6 * 129], s[7 * 129]);
            *(v4u*)(WT + (size_t)map(n) * ldt + koff + k0 + ch * 8) = o; }
    }
    __syncthreads();
}
__device__ __forceinline__ void wg_transpose_item_fp8(const float* W, int N, int ldw, unsigned char* WT, int ldt, float mul, LAS float* scr, int item, int tid) {
    const int nblk = (N + 127) >> 7, kb = item / nblk, nb = item - kb * nblk, k0 = kb * 128, n0 = nb * 128;
#pragma unroll
    for (int it = 0; it < 8; ++it) {
        const int row = it * 16 + (tid >> 5), c4 = (tid & 31) * 4;
        const f32x4 v = *(const f32x4*)(W + (size_t)(k0 + row) * ldw + n0 + c4);
        LAS float* s = scr + row * 129 + c4; s[0] = v[0]; s[1] = v[1]; s[2] = v[2]; s[3] = v[3];
    }
    __syncthreads();
#pragma unroll
    for (int j = 0; j < 2; ++j) {
        const int idx = j * 512 + tid, nl = idx >> 3, ch = idx & 7;
        const LAS float* s = scr + (ch * 16) * 129 + nl;
        v4u o;
#pragma unroll
        for (int q = 0; q < 4; ++q) { unsigned w = 0u;
            w = __builtin_amdgcn_cvt_pk_fp8_f32(s[(4 * q) * 129] * mul, s[(4 * q + 1) * 129] * mul, w, false);
            w = __builtin_amdgcn_cvt_pk_fp8_f32(s[(4 * q + 2) * 129] * mul, s[(4 * q + 3) * 129] * mul, w, true);
            o[q] = w; }
        *(v4u*)(WT + (size_t)(n0 + nl) * ldt + k0 + ch * 16) = o;
    }
    __syncthreads();
}
__device__ __forceinline__ void p0_prologue(Frame& F, KArgs A) {
    LAS float* scr = (LAS float*)(F.lds + RING_OFF);
    const int tid = F.tid;
    constexpr int IT_GU = 128, IT_DN = 64;
    constexpr int N_GU = 64 * IT_GU, N_DN = 64 * IT_DN;
    constexpr int N_INAB = 8 * 20, N_INCD = 8 * 20, N_OUTCD = 64, N_PG = 2 * 64, N_PP = 2 * 2 * 8, N_QIDX = 2 * 4, N_OUTB = 4 * 8;
    constexpr int NITEMS = N_GU + N_DN + N_INAB + N_INCD + N_OUTCD + N_PG + N_PP + N_QIDX + N_OUTB;
    for (int it = F.bid; it < NITEMS; it += F.G) {
        int r = it;
        if (r < N_GU) { const int m = r / IT_GU;
            if (kMoeFp8) wg_transpose_item_fp8(A->in[I_WGU] + (size_t)m * 1024 * 2048, 2048, 2048, WSP(unsigned char, WS_W_GU) + (size_t)m * 2048 * 1024, 1024, 64.0f, scr, r % IT_GU, tid);
            else wg_transpose_item(A->in[I_WGU] + (size_t)m * 1024 * 2048, 2048, 2048, WSP(bf16, WS_W_GU) + (size_t)m * 2048 * 1024, 1024, 0, MapId{}, scr, r % IT_GU, tid);
            continue; } r -= N_GU;
        if (r < N_DN) { const int m = r / IT_DN;
            if (kMoeFp8) wg_transpose_item_fp8(A->in[I_WDN] + (size_t)m * 1024 * 1024, 1024, 1024, WSP(unsigned char, WS_W_DN) + (size_t)m * 1024 * 1024, 1024, 128.0f, scr, r % IT_DN, tid);
            else wg_transpose_item(A->in[I_WDN] + (size_t)m * 1024 * 1024, 1024, 1024, WSP(bf16, WS_W_DN) + (size_t)m * 1024 * 1024, 1024, 0, MapId{}, scr, r % IT_DN, tid);
            continue; } r -= N_DN;
        if (r < N_INAB) { wg_transpose_item(A->in[I_AB_WIN], 2512, 2512, WSP(bf16, WS_W_INAB), 1024, 0, MapAB{}, scr, r, tid); continue; } r -= N_INAB;
        if (r < N_INCD) { wg_transpose_item(A->in[I_CD_WIN], 2560, 2560, WSP(bf16, WS_W_INCD), 1024, 0, MapId{}, scr, r, tid); continue; } r -= N_INCD;
        if (r < N_OUTCD) { wg_transpose_item(A->in[I_CD_WOUT], 1024, 1024, WSP(bf16, WS_W_OUTCD), 1024, 0, MapId{}, scr, r, tid); continue; } r -= N_OUTCD;
        if (r < N_PG) { const int l = r / 64; wg_transpose_item(A->in[I_PLE_WG] + (size_t)l * 1024 * 1024, 1024, 1024, WSP(bf16, WS_W_PG) + (size_t)l * 1024 * 1024, 1024, 0, MapId{}, scr, r % 64, tid); continue; } r -= N_PG;
        if (r < N_PP) { const int l = r / 16; wg_transpose_item(A->in[I_PLE_WP] + (size_t)l * 256 * 1024, 1024, 1024, WSP(bf16, WS_W_PP) + (size_t)l * 1024 * 256, 256, 0, MapId{}, scr, r % 16, tid); continue; } r -= N_PP;
        if (r < N_QIDX) { wg_transpose_item(A->in[I_AB_WQIDX], 512, 512, WSP(bf16, WS_W_ABS), 256, 0, MapAdd{1024}, scr, r, tid); continue; } r -= N_QIDX;
        wg_transpose_item(A->in[I_AB_WOUT] + (size_t)512 * 1024, 1024, 1024, WSP(bf16, WS_W_OUTAB), 1536, 1024, MapId{}, scr, r, tid);
    }
    const size_t gt = (size_t)F.bid * NTHREADS + tid, GT = (size_t)F.G * NTHREADS;
    for (size_t i = gt; i < (size_t)48 * 1024 / 8; i += GT) *(v4u*)(WSP(bf16, WS_W_INAB) + (size_t)464 * 1024 + i * 8) = (v4u){0u, 0u, 0u, 0u};
    for (size_t i = gt; i < (size_t)1024 * 256; i += GT) {
        const int n = (int)(i >> 8), c = (int)(i & 255), h = n >> 7, r = n & 127;
        const float* a = A->in[I_AB_WUQ] + (size_t)c * 512 + h * 64; const float* b = A->in[I_AB_WUK] + (size_t)r * 512 + h * 64;
        float s = 0.f;
#pragma unroll 8
        for (int d = 0; d < 64; d += 4) { const f32x4 x = *(const f32x4*)(a + d), y = *(const f32x4*)(b + d); s += x[0] * y[0] + x[1] * y[1] + x[2] * y[2] + x[3] * y[3]; }
        WSP(bf16, WS_W_ABS)[i] = (bf16)f2bf(s * 0.125f);
    }
    for (size_t i = gt; i < (size_t)1024 * 1024; i += GT) {
        const int n = (int)(i >> 10), k = (int)(i & 1023), h = k >> 7, r = k & 127;
        const float* a = A->in[I_AB_WUV] + (size_t)r * 512 + h * 64; const float* b = A->in[I_AB_WOUT] + (size_t)(h * 64) * 1024 + n;
        float s = 0.f;
#pragma unroll 8
        for (int v = 0; v < 64; ++v) s += a[v] * b[(size_t)v * 1024];
        WSP(bf16, WS_W_OUTAB)[(size_t)n * 1536 + k] = (bf16)f2bf(s);
    }
    for (size_t i = gt; i < (size_t)M * D / 8; i += GT) { const f32x4 a = *(const f32x4*)(A->in[I_X] + i * 8), b = *(const f32x4*)(A->in[I_X] + i * 8 + 4);
        v4u o; o.x = pk2(a[0], a[1]); o.y = pk2(a[2], a[3]); o.z = pk2(b[0], b[1]); o.w = pk2(b[2], b[3]); *(v4u*)(WSP(bf16, WS_XB) + i * 8) = o; }
    for (size_t i = gt; i < (size_t)2 * M * 256 / 8; i += GT) { const f32x4 a = *(const f32x4*)(A->in[I_P] + i * 8), b = *(const f32x4*)(A->in[I_P] + i * 8 + 4);
        v4u o; o.x = pk2(a[0], a[1]); o.y = pk2(a[2], a[3]); o.z = pk2(b[0], b[1]); o.w = pk2(b[2], b[3]); *(v4u*)(WSP(bf16, WS_PB) + i * 8) = o; }
}

__device__ __forceinline__ void p2_prep(Frame& F, KArgs A) {
    const int lane = F.lane, gw = F.bid * NWAVES + F.wave, NGW = F.G * NWAVES;
    const float* SM = WSP(float, WS_SM); const bf16* QZ = WSP(bf16, WS_QKVZ);
    const f32x4 qg = *(const f32x4*)(A->in[I_AB_QG] + 4 * lane);
    const f32x4 kvg = *(const f32x4*)(A->in[I_AB_KVG] + 4 * (lane & 31));
    const f32x4 kig = *(const f32x4*)(A->in[I_AB_KIG] + 4 * (lane & 15)), kib = *(const f32x4*)(A->in[I_AB_KIB] + 4 * (lane & 15));
    const f32x4 alog = *(const f32x4*)(A->in[I_AB_ALOG]), dtb = *(const f32x4*)(A->in[I_AB_DTB]);
    for (int row = gw; row < M; row += NGW) {
        const int t = row & (SEQ - 1);
        const f32x4 a = *(const f32x4*)(SM + (size_t)row * 512 + 4 * lane), b = *(const f32x4*)(SM + (size_t)row * 512 + 256 + 4 * lane);
        {
            const float ss = wave_sum(a[0] * a[0] + a[1] * a[1] + a[2] * a[2] + a[3] * a[3]);
            const float r = rsqrtf(ss * (1.0f / 256.0f) + 1e-6f);
            v2u o; o.x = pk2(a[0] * r * qg[0], a[1] * r * qg[1]); o.y = pk2(a[2] * r * qg[2], a[3] * r * qg[3]);
            *(v2u*)(WSP(bf16, WS_CQ) + (size_t)row * 256 + 4 * lane) = o;
        }
        {
            const float ss = wave_sum(lane < 32 ? (b[0] * b[0] + b[1] * b[1] + b[2] * b[2] + b[3] * b[3]) : 0.f);
            const float r = rsqrtf(ss * (1.0f / 128.0f) + 1e-6f);
            if (lane < 32) { v2u o; o.x = pk2(b[0] * r * kvg[0], b[1] * r * kvg[1]); o.y = pk2(b[2] * r * kvg[2], b[3] * r * kvg[3]);
                *(v2u*)(WSP(bf16, WS_CKV) + (size_t)row * 128 + 4 * lane) = o; }
        }
        {
            const bool in = (lane >= 32 && lane < 48);
            const float mean = wave_sum(in ? (b[0] + b[1] + b[2] + b[3]) : 0.f) * (1.0f / 64.0f);
            const f32x4 d = b - mean;
            const float var = wave_sum(in ? (d[0] * d[0] + d[1] * d[1] + d[2] * d[2] + d[3] * d[3]) : 0.f) * (1.0f / 64.0f);
            const float r = rsqrtf(var + 1e-5f);
            if (in) { v2u o; o.x = pk2(d[0] * r * kig[0] + kib[0], d[1] * r * kig[1] + kib[1]); o.y = pk2(d[2] * r * kig[2] + kib[2], d[3] * r * kig[3] + kib[3]);
                *(v2u*)(WSP(bf16, WS_KIDX) + (size_t)row * 64 + 4 * (lane - 32)) = o; }
        }
        if (lane == 48 || lane == 49) *(f32x4*)(WSP(float, WS_WIDX) + (size_t)row * 8 + 4 * (lane - 48)) = b * 0.044194173824159216f;
        if (lane == 50) { f32x4 o; o[0] = sigm(b[0]); o[1] = sigm(b[1]); o[2] = sigm(b[2]); o[3] = sigm(b[3]); *(f32x4*)(WSP(float, WS_BETA) + (size_t)row * 4) = o; }
        if (lane == 51) { f32x4 o;
#pragma unroll
            for (int h = 0; h < 4; ++h) { const float xx = b[h] + dtb[h]; const float sp = xx > 20.f ? xx : log1pf(__expf(xx)); o[h] = -__expf(alog[h]) * sp; }
            *(f32x4*)(WSP(float, WS_GG) + (size_t)row * 4) = o; }
#pragma unroll
        for (int sel = 0; sel < 3; ++sel) {
            const int col0 = sel * 512 + 8 * lane;
            float acc[8];
#pragma unroll
            for (int i = 0; i < 8; ++i) acc[i] = 0.f;
#pragma unroll
            for (int j = 0; j < 4; ++j) {
                if (t - 3 + j >= 0) {
                    const v4u xr = *(const v4u*)(QZ + (size_t)(row - 3 + j) * 2048 + col0); float xv[8]; unpack8(xr, xv);
                    const f32x4 w0 = *(const f32x4*)(A->in[I_AB_CONVW] + (size_t)j * 1536 + col0), w1 = *(const f32x4*)(A->in[I_AB_CONVW] + (size_t)j * 1536 + col0 + 4);
#pragma unroll
                    for (int i = 0; i < 4; ++i) { acc[i] += w0[i] * xv[i]; acc[4 + i] += w1[i] * xv[4 + i]; }
                }
            }
            float ss = 0.f;
#pragma unroll
            for (int i = 0; i < 8; ++i) { acc[i] = siluf(acc[i]); ss += acc[i] * acc[i]; }
            if (sel < 2) {
                ss += __shfl_xor(ss, 1); ss += __shfl_xor(ss, 2); ss += __shfl_xor(ss, 4); ss += __shfl_xor(ss, 8);
                const float sc = rsqrtf(ss + 1e-6f) * (sel == 0 ? 0.08838834764831845f : 1.0f);
#pragma unroll
                for (int i = 0; i < 8; ++i) acc[i] *= sc;
            }
            bf16* dst = (sel == 0 ? WSP(bf16, WS_QN) : (sel == 1 ? WSP(bf16, WS_KN) : WSP(bf16, WS_VN))) + (size_t)row * 512 + 8 * lane;
            *(v4u*)dst = pack8f(acc);
        }
    }
}

__device__ __forceinline__ void p3_chunk_prep(Frame& F, KArgs A) {
    int tid = F.tid; asm volatile("" : "+v"(tid));
    const int lane = tid & 63;
    constexpr int P = 132;
    LAS float* qs = (LAS float*)(F.lds); LAS float* ks = qs + 64 * P; LAS float* vs = ks + 64 * P;
    LAS float* As = vs + 64 * P;
    LAS float* gcS = As + 64 * 65; LAS float* egS = gcS + 64; LAS float* ekS = egS + 64; LAS float* btS = ekS + 64;
    LAS float* Ts = qs;
    for (int cidx = F.bid; cidx < 1024; cidx += F.G) {
        const int b = cidx >> 9, h = (cidx >> 7) & 3, n = cidx & 127, row0 = b * SEQ + n * 64;
        unsigned char* blk = F.ws + WS_CHK + (size_t)cidx * CHK_STRIDE;
        if (tid < 64) {
            const float g = WSP(float, WS_GG)[(size_t)(row0 + tid) * 4 + h];
            float gc = g;
#pragma unroll
            for (int o = 1; o < 64; o <<= 1) { const float t = __shfl_up(gc, o); if (lane >= o) gc += t; }
            const float g63 = __shfl(gc, 63);
            gcS[tid] = gc; egS[tid] = __expf(gc); ekS[tid] = __expf(g63 - gc); btS[tid] = WSP(float, WS_BETA)[(size_t)(row0 + tid) * 4 + h];
            if (tid == 0) *(float*)(blk + CHK_GL) = __expf(g63);
        }
#pragma unroll
        for (int i = 0; i < 2; ++i) {
            const int id = tid + 512 * i, r = id >> 4, c8 = (id & 15) * 8; const size_t so = (size_t)(row0 + r) * 512 + h * 128 + c8;
            float f[8];
            unpack8(*(const v4u*)(WSP(bf16, WS_QN) + so), f);
            *(LAS f32x4*)(qs + r * P + c8) = (f32x4){f[0], f[1], f[2], f[3]}; *(LAS f32x4*)(qs + r * P + c8 + 4) = (f32x4){f[4], f[5], f[6], f[7]};
            unpack8(*(const v4u*)(WSP(bf16, WS_KN) + so), f);
            *(LAS f32x4*)(ks + r * P + c8) = (f32x4){f[0], f[1], f[2], f[3]}; *(LAS f32x4*)(ks + r * P + c8 + 4) = (f32x4){f[4], f[5], f[6], f[7]};
            unpack8(*(const v4u*)(WSP(bf16, WS_VN) + so), f);
            *(LAS f32x4*)(vs + r * P + c8) = (f32x4){f[0], f[1], f[2], f[3]}; *(LAS f32x4*)(vs + r * P + c8 + 4) = (f32x4){f[4], f[5], f[6], f[7]};
        }
        __syncthreads();
        {
            const int i = tid >> 3, t7 = tid & 7;
            float aK[8], aQ[8];
#pragma unroll
            for (int x = 0; x < 8; ++x) { aK[x] = 0.f; aQ[x] = 0.f; }
#pragma unroll 1
            for (int d = 0; d < 128; d += 4) {
                const f32x4 ki = *(const LAS f32x4*)(ks + i * P + d), qi = *(const LAS f32x4*)(qs + i * P + d);
#pragma unroll
                for (int x = 0; x < 8; ++x) { const f32x4 kj = *(const LAS f32x4*)(ks + (t7 + 8 * x) * P + d);
                    aK[x] += ki[0] * kj[0] + ki[1] * kj[1] + ki[2] * kj[2] + ki[3] * kj[3]; aQ[x] += qi[0] * kj[0] + qi[1] * kj[1] + qi[2] * kj[2] + qi[3] * kj[3]; }
            }
            const float gci = gcS[i], bti = btS[i];
            bf16* QKp = (bf16*)(blk + CHK_QK) + i * 64;
#pragma unroll
            for (int x = 0; x < 8; ++x) { const int j = t7 + 8 * x; const float dec = __expf(j <= i ? gci - gcS[j] : 0.f);
                As[i * 65 + j] = (j < i) ? bti * aK[x] * dec : 0.f;
                QKp[32 * (j >> 5) + 8 * ((j >> 2) & 3) + 4 * ((j >> 4) & 1) + (j & 3)] = (bf16)f2bf((j <= i) ? aQ[x] * dec : 0.f); }
        }
        {
            const int i = tid >> 3, d0 = (tid & 7) * 16, s = d0 >> 5, a = (d0 >> 4) & 1; const float e = egS[i];
            bf16* Qd = (bf16*)(blk + CHK_QD) + i * 128;
#pragma unroll
            for (int q = 0; q < 4; ++q) { const f32x4 p = *(const LAS f32x4*)(qs + i * P + d0 + 4 * q); v2u w; w.x = pk2(p[0] * e, p[1] * e); w.y = pk2(p[2] * e, p[3] * e); *(v2u*)(Qd + 32 * s + 8 * q + 4 * a) = w; }
        }
        {
            const int d = tid >> 2, c0 = (tid & 3) * 16, s = c0 >> 5, a = (c0 >> 4) & 1;
            bf16* Kd = (bf16*)(blk + CHK_KDT) + d * 64;
#pragma unroll
            for (int q = 0; q < 4; ++q) { const int c = c0 + 4 * q;
                v2u w; w.x = pk2(ks[c * P + d] * ekS[c], ks[(c + 1) * P + d] * ekS[c + 1]); w.y = pk2(ks[(c + 2) * P + d] * ekS[c + 2], ks[(c + 3) * P + d] * ekS[c + 3]);
                *(v2u*)(Kd + 32 * s + 8 * q + 4 * a) = w; }
        }
        __syncthreads();
        {
            const int c = tid >> 3, part = tid & 7;
            for (int i = 0; i < 64; ++i) {
                float acc = 0.f;
                for (int j = part; j < i; j += 8) acc += As[i * 65 + j] * Ts[j * 65 + c];
                acc += __shfl_xor(acc, 1); acc += __shfl_xor(acc, 2); acc += __shfl_xor(acc, 4);
                if (part == 0) Ts[i * 65 + c] = ((i == c) ? 1.f : 0.f) - acc;
                __builtin_amdgcn_fence(__ATOMIC_RELEASE, "wavefront"); asm volatile("s_waitcnt lgkmcnt(0)" ::: "memory");
            }
        }
        __syncthreads();
        {
            const int i = tid >> 3, t7 = tid & 7;
            f32x4 aU[4], aW[4];
#pragma unroll
            for (int xx = 0; xx < 4; ++xx) { aU[xx] = (f32x4){0.f, 0.f, 0.f, 0.f}; aW[xx] = (f32x4){0.f, 0.f, 0.f, 0.f}; }
#pragma unroll 1
            for (int j = 0; j <= i; ++j) {
                const float tb = Ts[i * 65 + j] * btS[j], tbe = tb * egS[j];
#pragma unroll
                for (int xx = 0; xx < 4; ++xx) { aU[xx] += *(const LAS f32x4*)(vs + j * P + 4 * t7 + 32 * xx) * tb; aW[xx] += *(const LAS f32x4*)(ks + j * P + 4 * t7 + 32 * xx) * tbe; }
            }
            float* UT = (float*)(blk + CHK_UT);
            bf16* Wp = (bf16*)(blk + CHK_WP) + i * 128;
#pragma unroll
            for (int xx = 0; xx < 4; ++xx) {
                const int c = 4 * t7 + 32 * xx;
#pragma unroll
                for (int e = 0; e < 4; ++e) UT[(c + e) * 64 + i] = aU[xx][e];
                v2u w; w.x = pk2(aW[xx][0], aW[xx][1]); w.y = pk2(aW[xx][2], aW[xx][3]); *(v2u*)(Wp + 32 * xx + 8 * (t7 & 3) + 4 * (t7 >> 2)) = w;
            }
        }
        __syncthreads();
    }
}

constexpr int SEQ_WGS = 16;
constexpr int SQ_WP = 0, SQ_QD = 16384, SQ_KDT = 32768, SQ_QK = 49152, SQ_BUF = 57344;
__device__ __forceinline__ bf16x8 packfrag(const f32x4 lo, const f32x4 hi) { v4u w; w.x = pg8::cvt_pk_bf16(lo[0], lo[1]); w.y = pg8::cvt_pk_bf16(lo[2], lo[3]); w.z = pg8::cvt_pk_bf16(hi[0], hi[1]); w.w = pg8::cvt_pk_bf16(hi[2], hi[3]); return __builtin_bit_cast(bf16x8, w); }
__device__ __forceinline__ void seq_stage(LAS unsigned char* buf, const unsigned char* blk, int lt) {
    v4u r[14];
#pragma unroll
    for (int i = 0; i < 14; ++i) r[i] = *(const v4u*)(blk + (size_t)(lt + 256 * i) * 16);
#pragma unroll
    for (int i = 0; i < 14; ++i) {
        const int id = lt + 256 * i; int dst;
        if (id < 2048) { const int rr = (id & 1023) >> 4, ch = id & 15; dst = (id & ~1023) * 16 + rr * 256 + 16 * (ch ^ (rr & 15)); }
        else { const int rr = (id - 2048) >> 3, ch = id & 7; dst = 32768 + rr * 128 + 16 * (ch ^ (rr & 7)); }
        *(LAS v4u*)(buf + dst) = r[i];
    }
}
__device__ __forceinline__ void p4_delta_seq(Frame& F, int sid) {
    const int lane = F.lane, wave = F.wave, tid = F.tid;
    const int bh = sid >> 1, half = sid & 1, b = bh >> 2, h = bh & 3;
    const int fr = lane & 15, fq = lane >> 4;
    const int v0 = half * 64 + (wave & 3) * 16;
    const unsigned char* cbase = F.ws + WS_CHK + (size_t)(bh * 128) * CHK_STRIDE;
    float* OD = WSP(float, WS_ODELTA);
    f32x4 Sacc[8];
#pragma unroll
    for (int T = 0; T < 8; ++T) Sacc[T] = (f32x4){0.f, 0.f, 0.f, 0.f};
    if (wave >= 4) seq_stage(F.lds, cbase, tid - 256);
    __syncthreads();
    for (int n = 0; n < 128; ++n) {
        LAS unsigned char* buf = F.lds + (n & 1) * SQ_BUF;
        if (wave >= 4) { if (n + 1 < 128) seq_stage(F.lds + ((n + 1) & 1) * SQ_BUF, cbase + (size_t)(n + 1) * CHK_STRIDE, tid - 256); }
        else {
            const unsigned char* blk = cbase + (size_t)n * CHK_STRIDE;
            const float gl = *(const float*)(blk + CHK_GL);
            const float* UT = (const float*)(blk + CHK_UT) + (size_t)(v0 + fr) * 64 + 4 * fq;
            f32x4 U[4];
#pragma unroll
            for (int tc = 0; tc < 4; ++tc) U[tc] = *(const f32x4*)(UT + 16 * tc);
            bf16x8 sf[4];
#pragma unroll
            for (int s = 0; s < 4; ++s) sf[s] = packfrag(Sacc[2 * s], Sacc[2 * s + 1]);
            f32x4 Vn[4], Oa[4];
#pragma unroll
            for (int tc = 0; tc < 4; ++tc) {
                const int rr = 16 * tc + fr; f32x4 av = (f32x4){0.f, 0.f, 0.f, 0.f}, ao = (f32x4){0.f, 0.f, 0.f, 0.f};
#pragma unroll
                for (int s = 0; s < 4; ++s) {
                    const int off = rr * 256 + 16 * ((4 * s + fq) ^ (rr & 15));
                    const bf16x8 wf = *(const LAS bf16x8*)(buf + SQ_WP + off), qf = *(const LAS bf16x8*)(buf + SQ_QD + off);
                    av = __builtin_amdgcn_mfma_f32_16x16x32_bf16(wf, sf[s], av, 0, 0, 0);
                    ao = __builtin_amdgcn_mfma_f32_16x16x32_bf16(qf, sf[s], ao, 0, 0, 0);
                }
                Vn[tc] = U[tc] - av; Oa[tc] = ao;
            }
            bf16x8 vf[2];
            vf[0] = packfrag(Vn[0], Vn[1]); vf[1] = packfrag(Vn[2], Vn[3]);
#pragma unroll
            for (int tc = 0; tc < 4; ++tc) {
                const int rr = 16 * tc + fr;
#pragma unroll
                for (int s = 0; s < 2; ++s) {
                    const bf16x8 kf = *(const LAS bf16x8*)(buf + SQ_QK + rr * 128 + 16 * ((4 * s + fq) ^ (rr & 7)));
                    Oa[tc] = __builtin_amdgcn_mfma_f32_16x16x32_bf16(kf, vf[s], Oa[tc], 0, 0, 0);
                }
                float* op = OD + (size_t)(b * SEQ + n * 64 + 16 * tc + 4 * fq) * 512 + h * 128 + v0 + fr;
#pragma unroll
                for (int j = 0; j < 4; ++j) op[(size_t)j * 512] = Oa[tc][j];
            }
#pragma unroll
            for (int T = 0; T < 8; ++T) {
                const int rr = 16 * T + fr; f32x4 a = Sacc[T] * gl;
#pragma unroll
                for (int s = 0; s < 2; ++s) {
                    const bf16x8 kf = *(const LAS bf16x8*)(buf + SQ_KDT + rr * 128 + 16 * ((4 * s + fq) ^ (rr & 7)));
                    a = __builtin_amdgcn_mfma_f32_16x16x32_bf16(kf, vf[s], a, 0, 0, 0);
                }
                Sacc[T] = a;
            }
        }
        __syncthreads();
    }
}

__device__ __forceinline__ void p4_indexer(Frame& F, int widx, int nw) {
    const int lane = F.lane, fr = lane & 15, fq = lane >> 4;
    const bf16* QL = WSP(bf16, WS_QL); const bf16* KI = WSP(bf16, WS_KIDX); const float* WI = WSP(float, WS_WIDX); float* SC = WSP(float, WS_BIG);
    for (int task = widx; task < 2 * 4352; task += nw) {
        const int b = task / 4352; int tau = task - b * 4352;
        int g = 0; while (16 * (g + 1) * (g + 2) <= tau) ++g;
        tau -= 16 * g * (g + 1);
        const int qt = 32 * g + tau / (g + 1), seg = tau % (g + 1);
        const int row0 = b * SEQ + 16 * qt;
        bf16x8 Qf[8][2];
#pragma unroll
        for (int hh = 0; hh < 8; ++hh)
#pragma unroll
            for (int s = 0; s < 2; ++s) Qf[hh][s] = *(const bf16x8*)(QL + (size_t)(row0 + fr) * 1536 + 1024 + hh * 64 + 32 * s + 8 * fq);
        f32x4 wv[4][2];
#pragma unroll
        for (int j = 0; j < 4; ++j) { wv[j][0] = *(const f32x4*)(WI + (size_t)(row0 + 4 * fq + j) * 8); wv[j][1] = *(const f32x4*)(WI + (size_t)(row0 + 4 * fq + j) * 8 + 4); }
        const int kt1 = (32 * seg + 31 < qt) ? 32 * seg + 31 : qt;
        for (int kt = 32 * seg; kt <= kt1; ++kt) {
            const bf16* kp = KI + (size_t)(b * SEQ + 16 * kt + fr) * 64 + 8 * fq;
            const bf16x8 k0 = *(const bf16x8*)kp, k1 = *(const bf16x8*)(kp + 32);
            f32x4 isc = (f32x4){0.f, 0.f, 0.f, 0.f};
#pragma unroll
            for (int hh = 0; hh < 8; ++hh) {
                f32x4 c = __builtin_amdgcn_mfma_f32_16x16x32_bf16(Qf[hh][0], k0, (f32x4){0.f, 0.f, 0.f, 0.f}, 0, 0, 0);
                c = __builtin_amdgcn_mfma_f32_16x16x32_bf16(Qf[hh][1], k1, c, 0, 0, 0);
#pragma unroll
                for (int j = 0; j < 4; ++j) isc[j] += fmaxf(c[j], 0.f) * wv[j][hh >> 2][hh & 3];
            }
            float* sp = SC + (size_t)(row0 + 4 * fq) * 8192 + 16 * kt + fr;
#pragma unroll
            for (int j = 0; j < 4; ++j) sp[(size_t)j * 8192] = isc[j];
        }
    }
}

__device__ __forceinline__ unsigned long long mask_ge(unsigned x, unsigned t) { unsigned long long m; asm("v_cmp_ge_u32_e64 %0, %1, %2" : "=s"(m) : "v"(x), "s"(t)); return m; }
__device__ __forceinline__ void mask_ge8(unsigned long long (&m)[8], unsigned x0, unsigned x1, unsigned x2, unsigned x3, unsigned x4, unsigned x5, unsigned x6, unsigned x7, unsigned t) {
    asm("v_cmp_ge_u32_e64 %0, %8, %16\n\tv_cmp_ge_u32_e64 %1, %9, %16\n\tv_cmp_ge_u32_e64 %2, %10, %16\n\tv_cmp_ge_u32_e64 %3, %11, %16\n\t"
        "v_cmp_ge_u32_e64 %4, %12, %16\n\tv_cmp_ge_u32_e64 %5, %13, %16\n\tv_cmp_ge_u32_e64 %6, %14, %16\n\tv_cmp_ge_u32_e64 %7, %15, %16"
        : "=&s"(m[0]), "=&s"(m[1]), "=&s"(m[2]), "=&s"(m[3]), "=&s"(m[4]), "=&s"(m[5]), "=&s"(m[6]), "=&s"(m[7])
        : "v"(x0), "v"(x1), "v"(x2), "v"(x3), "v"(x4), "v"(x5), "v"(x6), "v"(x7), "s"(t));
}
__device__ __forceinline__ unsigned long long mask_eq(unsigned x, unsigned t) { unsigned long long m; asm("v_cmp_eq_u32_e64 %0, %1, %2" : "=s"(m) : "v"(x), "s"(t)); return m; }
__device__ __forceinline__ void p5_topk(Frame& F) {
    const int lane = F.lane, gw = F.bid * NWAVES + F.wave, NGW = F.G * NWAVES;
    const float* SC = WSP(float, WS_BIG); int* SEL = WSP(int, WS_SEL); int* NSEL = WSP(int, WS_NSEL);
    for (int rix = gw; rix < M; rix += NGW) {
        const int row = ((rix & 1) ? (M - 1 - (rix >> 1)) : (rix >> 1));
        const int pos = row & (SEQ - 1), n = pos + 1;
        int* sel = SEL + (size_t)row * 256;
        if (n <= 256) {
#pragma unroll
            for (int i = 0; i < 4; ++i) { const int j = 64 * i + lane; sel[j] = (j < n) ? j : 0; }
            if (lane == 0) NSEL[row] = n;
            continue;
        }
        const int nblk = (n + 1023) >> 10;
        const float* sr = SC + (size_t)row * 8192;
        int lane_l = lane; asm volatile("" : "+v"(lane_l));
        unsigned u[128];
#pragma unroll
        for (int i = 0; i < 64; ++i) u[i] = __float_as_uint((sr + (i >> 4) * 1024)[(i & 15) * 64 + lane_l]);
        if (nblk > 4) {
#pragma unroll
            for (int i = 64; i < 128; ++i) u[i] = __float_as_uint((sr + (i >> 4) * 1024)[(i & 15) * 64 + lane_l]);
        } else {
#pragma unroll
            for (int i = 64; i < 128; ++i) u[i] = 0u;
        }
        asm volatile("" ::: "memory");
#pragma unroll
        for (int i = 0; i < 128; ++i) { const int lim = n - i * 64; const unsigned bits = u[i];
            const unsigned x = (bits & 0x80000000u) ? ~bits : (bits | 0x80000000u);
            u[i] = (lane < lim) ? x : 0u; }
        unsigned T = 0u;
        for (int bit = 31; bit >= 0; --bit) {
            const unsigned cand = T | (1u << bit); int c = 0;
#pragma unroll
            for (int bk = 0; bk < 8; ++bk) {
                if (bk < nblk) {
#pragma unroll
                    for (int g8 = 0; g8 < 2; ++g8) {
                        unsigned long long mm[8];
#pragma unroll
                        for (int i = 0; i < 1; ++i) { const int b0 = bk * 16 + g8 * 8; mask_ge8(mm, u[b0], u[b0 + 1], u[b0 + 2], u[b0 + 3], u[b0 + 4], u[b0 + 5], u[b0 + 6], u[b0 + 7], cand); }
#pragma unroll
                        for (int i = 0; i < 8; ++i) c += __popcll(mm[i]);
                    }
                }
            }
            if (c >= 256) T = cand;
        }
        int cgt = 0;
#pragma unroll
        for (int bk = 0; bk < 8; ++bk) {
            if (bk < nblk) {
#pragma unroll
                for (int g8 = 0; g8 < 2; ++g8) {
                    unsigned long long mm[8];
#pragma unroll
                    for (int i = 0; i < 1; ++i) { const int b0 = bk * 16 + g8 * 8; mask_ge8(mm, u[b0], u[b0 + 1], u[b0 + 2], u[b0 + 3], u[b0 + 4], u[b0 + 5], u[b0 + 6], u[b0 + 7], T + 1u); }
#pragma unroll
                    for (int i = 0; i < 8; ++i) cgt += __popcll(mm[i]);
                }
            }
        }
        const int need_eq = 256 - cgt;
        int running = 0, eq_taken = 0;
        const unsigned long long ltmask = (1ull << lane) - 1ull;
#pragma unroll
        for (int bk = 0; bk < 8; ++bk) {
            if (bk < nblk) {
#pragma unroll
                for (int g8 = 0; g8 < 2; ++g8) {
                    unsigned long long mg[8], me[8];
#pragma unroll
                    for (int i = 0; i < 1; ++i) { const int b0 = bk * 16 + g8 * 8; mask_ge8(mg, u[b0], u[b0 + 1], u[b0 + 2], u[b0 + 3], u[b0 + 4], u[b0 + 5], u[b0 + 6], u[b0 + 7], T); mask_ge8(me, u[b0], u[b0 + 1], u[b0 + 2], u[b0 + 3], u[b0 + 4], u[b0 + 5], u[b0 + 6], u[b0 + 7], T + 1u); }
#pragma unroll
                    for (int i = 0; i < 8; ++i) me[i] = mg[i] & ~me[i];
#pragma unroll
                    for (int i = 0; i < 8; ++i) {
                        unsigned long long mt = mg[i];
                        if (me[i] != 0ull) {
                            const int room = need_eq - eq_taken; unsigned long long keep = 0ull, rest = me[i];
                            for (int k = 0; k < room && rest != 0ull; ++k) { const unsigned long long low = rest & (~rest + 1ull); keep |= low; rest ^= low; }
                            mt = (mg[i] & ~me[i]) | keep; eq_taken += __popcll(me[i]);
                        }
                        if (mt != 0ull) {
                            if ((mt >> lane) & 1ull) sel[running + __popcll(mt & ltmask)] = (bk * 16 + g8 * 8 + i) * 64 + lane;
                            running += __popcll(mt);
                        }
                    }
                }
            }
        }
        if (lane == 0) NSEL[row] = 256;
    }
}

__device__ __forceinline__ void p6_sparse_attn(Frame& F) {
    const int lane = F.lane, gw = F.bid * NWAVES + F.wave, NGW = F.G * NWAVES;
    LAS float* ql = (LAS float*)(F.lds + F.wave * 12288);
    LAS float* pp = ql + 1024;
    const bf16* QL = WSP(bf16, WS_QL); const bf16* CKV = WSP(bf16, WS_CKV); const int* SEL = WSP(int, WS_SEL); const int* NSEL = WSP(int, WS_NSEL); bf16* AO = WSP(bf16, WS_AO);
    for (int row = gw; row < M; row += NGW) {
        const int b = row >> 13, n = NSEL[row];
        const int* sel = SEL + (size_t)row * 256;
        {
            float f[8];
            unpack8(*(const v4u*)(QL + (size_t)row * 1536 + 8 * lane), f);
#pragma unroll
            for (int x = 0; x < 8; ++x) ql[8 * lane + x] = f[x];
            unpack8(*(const v4u*)(QL + (size_t)row * 1536 + 512 + 8 * lane), f);
#pragma unroll
            for (int x = 0; x < 8; ++x) ql[512 + 8 * lane + x] = f[x];
        }
        float s[4][8];
#pragma unroll
        for (int kb = 0; kb < 4; ++kb) {
            const int j = 64 * kb + lane; const bool valid = j < n; const int key = valid ? sel[j] : 0;
            const bf16* kr = CKV + (size_t)(b * SEQ + key) * 128;
#pragma unroll
            for (int hh = 0; hh < 8; ++hh) s[kb][hh] = 0.f;
#pragma unroll 4
            for (int r8 = 0; r8 < 16; ++r8) {
                float x[8]; unpack8(*(const v4u*)(kr + 8 * r8), x);
#pragma unroll
                for (int hh = 0; hh < 8; ++hh) { const f32x4 q0 = *(const LAS f32x4*)(ql + hh * 128 + 8 * r8), q1 = *(const LAS f32x4*)(ql + hh * 128 + 8 * r8 + 4);
                    s[kb][hh] += x[0] * q0[0] + x[1] * q0[1] + x[2] * q0[2] + x[3] * q0[3] + x[4] * q1[0] + x[5] * q1[1] + x[6] * q1[2] + x[7] * q1[3]; }
            }
            if (!valid) {
#pragma unroll
                for (int hh = 0; hh < 8; ++hh) s[kb][hh] = -INFINITY;
            }
        }
#pragma unroll
        for (int hh = 0; hh < 8; ++hh) {
            const float mx = wave_max(fmaxf(fmaxf(s[0][hh], s[1][hh]), fmaxf(s[2][hh], s[3][hh])));
            float e[4], l = 0.f;
#pragma unroll
            for (int kb = 0; kb < 4; ++kb) { e[kb] = __expf(s[kb][hh] - mx); l += e[kb]; }
            const float inv = 1.0f / wave_sum(l);
#pragma unroll
            for (int kb = 0; kb < 4; ++kb) pp[(64 * kb + lane) * 8 + hh] = e[kb] * inv;
        }
        float o[8][2];
#pragma unroll
        for (int hh = 0; hh < 8; ++hh) { o[hh][0] = 0.f; o[hh][1] = 0.f; }
        for (int j = 0; j < n; ++j) {
            const int key = sel[j];
            const unsigned kv = *(const unsigned*)(CKV + (size_t)(b * SEQ + key) * 128 + 2 * lane);
            const float lo = bflo(kv), hi = bfhi(kv);
            const f32x4 p0 = *(const LAS f32x4*)(pp + j * 8), p1 = *(const LAS f32x4*)(pp + j * 8 + 4);
#pragma unroll
            for (int hh = 0; hh < 4; ++hh) { o[hh][0] += p0[hh] * lo; o[hh][1] += p0[hh] * hi; o[4 + hh][0] += p1[hh] * lo; o[4 + hh][1] += p1[hh] * hi; }
        }
#pragma unroll
        for (int hh = 0; hh < 8; ++hh) *(unsigned*)(AO + (size_t)row * 1536 + hh * 128 + 2 * lane) = pk2(o[hh][0], o[hh][1]);
    }
}
__device__ __forceinline__ void p6_gdn_out(Frame& F, KArgs A) {
    const int lane = F.lane, gw = F.bid * NWAVES + F.wave, NGW = F.G * NWAVES;
    const f32x4 g0 = *(const f32x4*)(A->in[I_AB_ONG] + 8 * (lane & 15)), g1 = *(const f32x4*)(A->in[I_AB_ONG] + 8 * (lane & 15) + 4);
    for (int row = gw; row < M; row += NGW) {
        const float* op = WSP(float, WS_ODELTA) + (size_t)row * 512 + 8 * lane;
        const f32x4 a = *(const f32x4*)op, b = *(const f32x4*)(op + 4);
        float ss = a[0] * a[0] + a[1] * a[1] + a[2] * a[2] + a[3] * a[3] + b[0] * b[0] + b[1] * b[1] + b[2] * b[2] + b[3] * b[3];
        ss += __shfl_xor(ss, 1); ss += __shfl_xor(ss, 2); ss += __shfl_xor(ss, 4); ss += __shfl_xor(ss, 8);
        const float r = rsqrtf(ss * (1.0f / 128.0f) + 1e-6f);
        float z[8]; unpack8(*(const v4u*)(WSP(bf16, WS_QKVZ) + (size_t)row * 2048 + 1536 + 8 * lane), z);
        float o[8];
#pragma unroll
        for (int i = 0; i < 4; ++i) { o[i] = a[i] * r * g0[i] * siluf(z[i]); o[4 + i] = b[i] * r * g1[i] * siluf(z[4 + i]); }
        *(v4u*)(WSP(bf16, WS_AO) + (size_t)row * 1536 + 1024 + 8 * lane) = pack8f(o);
    }
}

__device__ __forceinline__ void p8_ln_router(Frame& F, KArgs A, int l, float* HOUT, bf16* HB) {
    const int lane = F.lane, tid = F.tid, gw = F.bid * NWAVES + F.wave, NGW = F.G * NWAVES;
    LAS float* wT = (LAS float*)(F.lds);
    LAS float* lg = (LAS float*)(F.lds + WSCR_OFF + F.wave * WSCR_BYTES);
    const float* rw = A->in[I_RW] + (size_t)l * 1024 * 32;
    for (int i = tid; i < 1024 * 32; i += NTHREADS) { const int k = i >> 5, e = i & 31; wT[e * 1028 + k] = rw[i]; }
    __syncthreads();
    const float* PRE = WSP(float, WS_PRE);
    const float* lg_g = A->in[I_LNM_G] + (size_t)l * 1024; const float* lg_b = A->in[I_LNM_B] + (size_t)l * 1024;
    const float rb = A->in[I_RB][l * 32 + (lane & 31)];
    int* TOKE = WSP(int, WS_ROUTE); int* TOKPOS = TOKE + M * 4; float* TOKG = (float*)(TOKPOS + M * 4);
    gu32* cnt = F.ctl + CW_CNT + 64 * l;
    for (int row = gw; row < M; row += NGW) {
        f32x4 v[4]; float s = 0.f;
#pragma unroll
        for (int j = 0; j < 4; ++j) { v[j] = *(const f32x4*)(PRE + (size_t)row * 1024 + 256 * j + 4 * lane); s += (v[j][0] + v[j][1]) + (v[j][2] + v[j][3]); }
        const float mean = wave_sum(s) * (1.0f / 1024.0f); float s2 = 0.f;
#pragma unroll
        for (int j = 0; j < 4; ++j) { v[j] = v[j] - mean; s2 += (v[j][0] * v[j][0] + v[j][1] * v[j][1]) + (v[j][2] * v[j][2] + v[j][3] * v[j][3]); }
        const float rstd = rsqrtf(wave_sum(s2) * (1.0f / 1024.0f) + 1e-5f);
#pragma unroll
        for (int j = 0; j < 4; ++j) {
            const f32x4 g = *(const f32x4*)(lg_g + 256 * j + 4 * lane), bb = *(const f32x4*)(lg_b + 256 * j + 4 * lane);
            v[j] = v[j] * rstd * g + bb;
            *(f32x4*)(HOUT + (size_t)row * 1024 + 256 * j + 4 * lane) = v[j];
            v2u o; o.x = pk2(v[j][0], v[j][1]); o.y = pk2(v[j][2], v[j][3]); *(v2u*)(HB + (size_t)row * 1024 + 256 * j + 4 * lane) = o;
        }
        float part[32];
#pragma unroll
        for (int e = 0; e < 32; ++e) {
            float a = 0.f;
#pragma unroll
            for (int j = 0; j < 4; ++j) { const f32x4 w = *(const LAS f32x4*)(wT + e * 1028 + 256 * j + 4 * lane); a += v[j][0] * w[0] + v[j][1] * w[1] + v[j][2] * w[2] + v[j][3] * w[3]; }
            part[e] = a;
        }
#pragma unroll
        for (int i = 0; i < 16; ++i) { const bool up = (lane & 32) != 0; const float keep = up ? part[i + 16] : part[i], send = up ? part[i] : part[i + 16]; part[i] = keep + __shfl_xor(send, 32); }
#pragma unroll
        for (int i = 0; i < 8; ++i) { const bool up = (lane & 16) != 0; const float keep = up ? part[i + 8] : part[i], send = up ? part[i] : part[i + 8]; part[i] = keep + __shfl_xor(send, 16); }
#pragma unroll
        for (int i = 0; i < 4; ++i) { const bool up = (lane & 8) != 0; const float keep = up ? part[i + 4] : part[i], send = up ? part[i] : part[i + 4]; part[i] = keep + __shfl_xor(send, 8); }
#pragma unroll
        for (int i = 0; i < 2; ++i) { const bool up = (lane & 4) != 0; const float keep = up ? part[i + 2] : part[i], send = up ? part[i] : part[i + 2]; part[i] = keep + __shfl_xor(send, 4); }
        { const bool up = (lane & 2) != 0; const float keep = up ? part[1] : part[0], send = up ? part[0] : part[1]; part[0] = keep + __shfl_xor(send, 2); }
        part[0] += __shfl_xor(part[0], 1);
        const int eidx = ((lane >> 5) & 1) * 16 + ((lane >> 4) & 1) * 8 + ((lane >> 3) & 1) * 4 + ((lane >> 2) & 1) * 2 + ((lane >> 1) & 1);
        if ((lane & 1) == 0) lg[eidx] = part[0];
        float val = (lane < 32) ? lg[lane & 31] + rb : -INFINITY;
        float tl[4]; int te[4];
#pragma unroll
        for (int k = 0; k < 4; ++k) {
            const float mx = wave_max(val);
            const unsigned long long mm = __ballot(val == mx && lane < 32);
            const int idx = __ffsll((long long)mm) - 1;
            tl[k] = mx; te[k] = idx;
            if (lane == idx) val = -INFINITY;
        }
        const float e1 = __expf(tl[1] - tl[0]), e2 = __expf(tl[2] - tl[0]), e3 = __expf(tl[3] - tl[0]);
        const float inv = 1.0f / (1.0f + e1 + e2 + e3);
        if (lane < 4) {
            const int e = lane == 0 ? te[0] : (lane == 1 ? te[1] : (lane == 2 ? te[2] : te[3]));
            const float g = (lane == 0 ? 1.0f : (lane == 1 ? e1 : (lane == 2 ? e2 : e3))) * inv;
            const unsigned pos = __hip_atomic_fetch_add(cnt + e, 1u, RLX_AGENT);
            TOKE[(size_t)row * 4 + lane] = e; TOKPOS[(size_t)row * 4 + lane] = (int)pos; TOKG[(size_t)row * 4 + lane] = g;
        }
    }
}

__device__ __forceinline__ void p9_scatter(Frame& F, int l, const bf16* HB, const float* HF) {
    const int lane = F.lane, tid = F.tid, gw = F.bid * NWAVES + F.wave, NGW = F.G * NWAVES;
    LAS int* base = (LAS int*)(F.lds + MISC_OFF + 256);
    int* TOKE = WSP(int, WS_ROUTE); int* TOKPOS = TOKE + M * 4; int* TILE = TOKE + 3 * M * 4;
    if (tid == 0) {
        int acc = 0;
        for (int e = 0; e < NEXP; ++e) { const int c = (int)__hip_atomic_load(F.ctl + CW_CNT + 64 * l + e, RLX_AGENT); base[e] = acc; acc += ((c + 255) >> 8) << 8; }
        base[32] = acc >> 8;
    }
    __syncthreads();
    if (F.bid == 0 && tid < 64) {
        const int nT = base[32];
        for (int t = tid; t < NTMAX; t += 64) { int e = 0;
            for (int x = 1; x < NEXP; ++x) if (base[x] <= t * 256) e = x;
            TILE[t] = (t < nT) ? e : 0; }
        if (tid == 0) TILE[NTMAX] = nT;
    }
    bf16* XS = WSP(bf16, WS_XS);
    if (kMoeFp8) {
        unsigned char* XB8 = WSP(unsigned char, WS_XS);
        for (int row = gw; row < M; row += NGW) {
            const float* hp = HF + (size_t)row * 1024 + 16 * lane; v4u o;
#pragma unroll
            for (int q = 0; q < 4; ++q) { const f32x4 v = *(const f32x4*)(hp + 4 * q); unsigned w = 0u; w = __builtin_amdgcn_cvt_pk_fp8_f32(v[0], v[1], w, false); w = __builtin_amdgcn_cvt_pk_fp8_f32(v[2], v[3], w, true); o[q] = w; }
#pragma unroll
            for (int k = 0; k < 4; ++k) { const int slot = base[TOKE[(size_t)row * 4 + k]] + TOKPOS[(size_t)row * 4 + k]; *(v4u*)(XB8 + (size_t)slot * 1024 + 16 * lane) = o; }
        }
        return;
    }
    for (int row = gw; row < M; row += NGW) {
        const v4u a = *(const v4u*)(HB + (size_t)row * 1024 + 8 * lane), b = *(const v4u*)(HB + (size_t)row * 1024 + 512 + 8 * lane);
#pragma unroll
        for (int k = 0; k < 4; ++k) {
            const int slot = base[TOKE[(size_t)row * 4 + k]] + TOKPOS[(size_t)row * 4 + k];
            *(v4u*)(XS + (size_t)slot * 1024 + 8 * lane) = a; *(v4u*)(XS + (size_t)slot * 1024 + 512 + 8 * lane) = b;
        }
    }
}

__device__ __forceinline__ void p12_combine(Frame& F, KArgs A, int l, const float* HIN, float* HOUT, bf16* HB) {
    const int lane = F.lane, tid = F.tid, gw = F.bid * NWAVES + F.wave, NGW = F.G * NWAVES;
    LAS int* base = (LAS int*)(F.lds + MISC_OFF + 256);
    if (tid == 0) { int acc = 0; for (int e = 0; e < NEXP; ++e) { const int c = (int)__hip_atomic_load(F.ctl + CW_CNT + 64 * l + e, RLX_AGENT); base[e] = acc; acc += ((c + 255) >> 8) << 8; } }
    __syncthreads();
    const int* TOKE = WSP(int, WS_ROUTE); const int* TOKPOS = TOKE + M * 4; const float* TOKG = (const float*)(TOKPOS + M * 4);
    const bf16* YS = WSP(bf16, WS_YS); const bf16* PLE = WSP(bf16, WS_PLE);
    const float* lg_g = A->in[I_LNF_G] + (size_t)l * 1024; const float* lg_b = A->in[I_LNF_B] + (size_t)l * 1024;
    for (int row = gw; row < M; row += NGW) {
        float x[16];
        {   const f32x4 h0 = *(const f32x4*)(HIN + (size_t)row * 1024 + 8 * lane), h1 = *(const f32x4*)(HIN + (size_t)row * 1024 + 8 * lane + 4);
            const f32x4 h2 = *(const f32x4*)(HIN + (size_t)row * 1024 + 512 + 8 * lane), h3 = *(const f32x4*)(HIN + (size_t)row * 1024 + 512 + 8 * lane + 4);
            float p0[8], p1[8]; unpack8(*(const v4u*)(PLE + (size_t)row * 1024 + 8 * lane), p0); unpack8(*(const v4u*)(PLE + (size_t)row * 1024 + 512 + 8 * lane), p1);
#pragma unroll
            for (int i = 0; i < 4; ++i) { x[i] = ALPHA * h0[i] + p0[i]; x[4 + i] = ALPHA * h1[i] + p0[4 + i]; x[8 + i] = ALPHA * h2[i] + p1[i]; x[12 + i] = ALPHA * h3[i] + p1[4 + i]; }
        }
#pragma unroll
        for (int k = 0; k < 4; ++k) {
            const int slot = base[TOKE[(size_t)row * 4 + k]] + TOKPOS[(size_t)row * 4 + k]; const float g = TOKG[(size_t)row * 4 + k];
            float y0[8], y1[8]; unpack8(*(const v4u*)(YS + (size_t)slot * 1024 + 8 * lane), y0); unpack8(*(const v4u*)(YS + (size_t)slot * 1024 + 512 + 8 * lane), y1);
#pragma unroll
            for (int i = 0; i < 8; ++i) { x[i] += g * y0[i]; x[8 + i] += g * y1[i]; }
        }
        float s = 0.f;
#pragma unroll
        for (int i = 0; i < 16; ++i) s += x[i];
        const float mean = wave_sum(s) * (1.0f / 1024.0f); float s2 = 0.f;
#pragma unroll
        for (int i = 0; i < 16; ++i) { x[i] -= mean; s2 += x[i] * x[i]; }
        const float rstd = rsqrtf(wave_sum(s2) * (1.0f / 1024.0f) + 1e-5f);
#pragma unroll
        for (int hf = 0; hf < 2; ++hf) {
            const int c0 = 512 * hf + 8 * lane;
            const f32x4 g0 = *(const f32x4*)(lg_g + c0), g1 = *(const f32x4*)(lg_g + c0 + 4), b0 = *(const f32x4*)(lg_b + c0), b1 = *(const f32x4*)(lg_b + c0 + 4);
            f32x4 o0, o1;
#pragma unroll
            for (int i = 0; i < 4; ++i) { o0[i] = x[8 * hf + i] * rstd * g0[i] + b0[i]; o1[i] = x[8 * hf + 4 + i] * rstd * g1[i] + b1[i]; }
            *(f32x4*)(HOUT + (size_t)row * 1024 + c0) = o0; *(f32x4*)(HOUT + (size_t)row * 1024 + c0 + 4) = o1;
            if (HB) { v4u w; w.x = pk2(o0[0], o0[1]); w.y = pk2(o0[2], o0[3]); w.z = pk2(o1[0], o1[1]); w.w = pk2(o1[2], o1[3]); *(v4u*)(HB + (size_t)row * 1024 + c0) = w; }
        }
    }
}

__device__ __forceinline__ void p14_dilated(Frame& F) {
    const int lane = F.lane, gw = F.bid * NWAVES + F.wave, NGW = F.G * NWAVES;
    LAS float* pe = (LAS float*)(F.lds + F.wave * 2048);
    const bf16* QK = WSP(bf16, WS_QKVZ); bf16* AO = WSP(bf16, WS_AO);
    for (int task = gw; task < M * 12; task += NGW) {
        const int row = task / 12, hh = task - row * 12, b = row >> 13, pos = row & (SEQ - 1);
        float q[64];
#pragma unroll
        for (int c = 0; c < 8; ++c) { float f[8]; unpack8(*(const v4u*)(QK + (size_t)row * 2560 + hh * 64 + 8 * c), f);
#pragma unroll
            for (int x = 0; x < 8; ++x) q[8 * c + x] = f[x]; }
        float s[7];
#pragma unroll
        for (int i = 0; i < 7; ++i) {
            const int e = lane + 64 * i, p = e / 129, m = e - p * 129;
            const int dd = (p == 0) ? 1 : (p == 1 ? 4 : 16);
            const int kpos = pos - m * dd; const bool valid = (e < 387) && (kpos >= 0);
            float a = -INFINITY;
            if (valid) {
                const bf16* kr = QK + (size_t)(b * SEQ + kpos) * 2560 + 768 + hh * 64; a = 0.f;
#pragma unroll
                for (int c = 0; c < 8; ++c) { float f[8]; unpack8(*(const v4u*)(kr + 8 * c), f);
#pragma unroll
                    for (int x = 0; x < 8; ++x) a += q[8 * c + x] * f[x]; }
                a *= 0.125f;
            }
            s[i] = a;
        }
        float mx = s[0];
#pragma unroll
        for (int i = 1; i < 7; ++i) mx = fmaxf(mx, s[i]);
        mx = wave_max(mx);
        float l = 0.f;
#pragma unroll
        for (int i = 0; i < 7; ++i) { const float ev = __expf(s[i] - mx); pe[lane + 64 * i] = ev; l += ev; }
        l = wave_sum(l);
        float o = 0.f;
#pragma unroll
        for (int p = 0; p < 3; ++p) {
            const int dd = (p == 0) ? 1 : (p == 1 ? 4 : 16);
            int mmax = pos / dd; if (mmax > 128) mmax = 128;
            const bf16* vb = QK + (size_t)(b * SEQ + pos) * 2560 + 1536 + hh * 64 + lane;
            for (int m = 0; m <= mmax; ++m) o += pe[p * 129 + m] * bf1(vb[-(ptrdiff_t)m * dd * 2560]);
        }
        AO[(size_t)row * 1024 + hh * 64 + lane] = (bf16)f2bf(o / l);
    }
}
typedef short v4i16_t __attribute__((ext_vector_type(4)));
__device__ __forceinline__ v4i16_t lds_tr16(LAS unsigned char* p) { return __builtin_amdgcn_ds_read_tr16_b64_v4i16((LAS v4i16_t*)p); }
constexpr int DV_PITCH = 144, DV_BUF = 32 * DV_PITCH;
template <int DL  > __device__ __forceinline__ void dil_branch(const bf16* __restrict__ KV, LAS unsigned char* vbuf, const int s0, const int lane,
                                                                                 const bf16x8 (&qf)[2], f32x4 (&O)[4], float& m_run, float& l_run) {
    constexpr int d = 1 << DL, sigma = 16 >> DL, NS = (129 + 15 * sigma + 31) / 32;
    const int fr = lane & 15, fq = lane >> 4;
    const int c = s0 & (d - 1), n0 = s0 >> DL, kstart = n0 - 128;
#define DIL_POS(n) ({ int _p = c + d * (n); _p = _p < 0 ? 0 : (_p > SEQ - 1 ? SEQ - 1 : _p); _p; })
    bf16x8 kf[2][2]; v4u vr[4];
#pragma unroll
    for (int tl = 0; tl < 2; ++tl) { const bf16* kp = KV + (size_t)DIL_POS(kstart + 16 * tl + fr) * 2560 + 768 + 8 * fq; kf[tl][0] = *(const bf16x8*)kp; kf[tl][1] = *(const bf16x8*)(kp + 32); }
#pragma unroll
    for (int i = 0; i < 4; ++i) vr[i] = *(const v4u*)(KV + (size_t)DIL_POS(kstart + (lane >> 3) + 8 * i) * 2560 + 1536 + 8 * (lane & 7));
#pragma unroll 1
    for (int g = 0; g < NS; ++g) {
        LAS unsigned char* vb = vbuf + (g & 1) * DV_BUF;
#pragma unroll
        for (int i = 0; i < 4; ++i) *(LAS v4u*)(vb + ((lane >> 3) + 8 * i) * DV_PITCH + 16 * (lane & 7)) = vr[i];
        bf16x8 kc[2][2];
#pragma unroll
        for (int tl = 0; tl < 2; ++tl) { kc[tl][0] = kf[tl][0]; kc[tl][1] = kf[tl][1]; }
        if (g + 1 < NS) {
            const int kb = kstart + 32 * (g + 1);
#pragma unroll
            for (int tl = 0; tl < 2; ++tl) { const bf16* kp = KV + (size_t)DIL_POS(kb + 16 * tl + fr) * 2560 + 768 + 8 * fq; kf[tl][0] = *(const bf16x8*)kp; kf[tl][1] = *(const bf16x8*)(kp + 32); }
#pragma unroll
            for (int i = 0; i < 4; ++i) vr[i] = *(const v4u*)(KV + (size_t)DIL_POS(kb + (lane >> 3) + 8 * i) * 2560 + 1536 + 8 * (lane & 7));
        }
        float sv[8];
#pragma unroll
        for (int tl = 0; tl < 2; ++tl) {
            f32x4 cc = __builtin_amdgcn_mfma_f32_16x16x32_bf16(kc[tl][0], qf[0], (f32x4){0.f, 0.f, 0.f, 0.f}, 0, 0, 0);
            cc = __builtin_amdgcn_mfma_f32_16x16x32_bf16(kc[tl][1], qf[1], cc, 0, 0, 0);
#pragma unroll
            for (int j = 0; j < 4; ++j) {
                const int rel = 32 * g + 16 * tl + 4 * fq + j;
                const int delta = 128 + sigma * fr - rel;
                const bool ok = (delta >= 0) && (delta <= 128) && (kstart + rel >= 0);
                sv[4 * tl + j] = ok ? cc[j] * 0.125f : -INFINITY;
            }
        }
        float mx = fmaxf(fmaxf(fmaxf(sv[0], sv[1]), fmaxf(sv[2], sv[3])), fmaxf(fmaxf(sv[4], sv[5]), fmaxf(sv[6], sv[7])));
        mx = fmaxf(mx, __shfl_xor(mx, 16)); mx = fmaxf(mx, __shfl_xor(mx, 32));
        const float m_new = fmaxf(m_run, mx);
        if (!__all(m_new == m_run)) {
            const float alpha = __expf(m_run - m_new);
            l_run *= alpha;
#pragma unroll
            for (int j = 0; j < 4; ++j) { const float aj = __shfl(alpha, 4 * fq + j);
#pragma unroll
                for (int dt = 0; dt < 4; ++dt) O[dt][j] *= aj; }
            m_run = m_new;
        }
        float p[8], ps = 0.f;
#pragma unroll
        for (int e = 0; e < 8; ++e) { p[e] = __expf(sv[e] - m_run); ps += p[e]; }
        l_run += ps;
        v4u pw; pw.x = pg8::cvt_pk_bf16(p[0], p[1]); pw.y = pg8::cvt_pk_bf16(p[2], p[3]); pw.z = pg8::cvt_pk_bf16(p[4], p[5]); pw.w = pg8::cvt_pk_bf16(p[6], p[7]);
        const bf16x8 pf = __builtin_bit_cast(bf16x8, pw);
        LAS unsigned char* tb = vb + (4 * fq + ((lane & 15) >> 2)) * DV_PITCH + 8 * (lane & 3);
#pragma unroll
        for (int dt = 0; dt < 4; ++dt) {
            const v4i16_t lo = lds_tr16(tb + 32 * dt), hi = lds_tr16(tb + 16 * DV_PITCH + 32 * dt);
            bf16x8 vf; vf[0] = lo[0]; vf[1] = lo[1]; vf[2] = lo[2]; vf[3] = lo[3]; vf[4] = hi[0]; vf[5] = hi[1]; vf[6] = hi[2]; vf[7] = hi[3];
            O[dt] = __builtin_amdgcn_mfma_f32_16x16x32_bf16(pf, vf, O[dt], 0, 0, 0);
        }
    }
#undef DIL_POS
}
__device__ __forceinline__ void p14_dilated_mfma(Frame& F) {
    const int lane = F.lane, fr = lane & 15, fq = lane >> 4;
    LAS unsigned char* vbuf = F.lds + F.wave * (2 * DV_BUF);
    const bf16* QK = WSP(bf16, WS_QKVZ); bf16* AO = WSP(bf16, WS_AO);
    for (int u = F.bid; u < 24 * 32 * 2; u += F.G) {
        const int bh = u >> 6, blk = (u >> 1) & 31, o = (u & 1) * 8 + F.wave;
        const int b = bh / 12, hh = bh - b * 12, s0 = 256 * blk + o;
        const bf16* KV = QK + (size_t)b * SEQ * 2560 + hh * 64;
        bf16x8 qf[2];
        { const bf16* qp = KV + (size_t)(s0 + 16 * fr) * 2560 + 8 * fq; qf[0] = *(const bf16x8*)qp; qf[1] = *(const bf16x8*)(qp + 32); }
        f32x4 O[4];
#pragma unroll
        for (int dt = 0; dt < 4; ++dt) O[dt] = (f32x4){0.f, 0.f, 0.f, 0.f};
        float m_run = -1e30f, l_run = 0.f;
        dil_branch<4>(KV, vbuf, s0, lane, qf, O, m_run, l_run);
        dil_branch<2>(KV, vbuf, s0, lane, qf, O, m_run, l_run);
        dil_branch<0>(KV, vbuf, s0, lane, qf, O, m_run, l_run);
        float lt = l_run; lt += __shfl_xor(lt, 16); lt += __shfl_xor(lt, 32);
        const float inv = 1.0f / lt;
#pragma unroll
        for (int j = 0; j < 4; ++j) {
            const float ij = __shfl(inv, 4 * fq + j);
            bf16* op = AO + (size_t)(b * SEQ + s0 + 16 * (4 * fq + j)) * 1024 + hh * 64 + fr;
#pragma unroll
            for (int dt = 0; dt < 4; ++dt) op[16 * dt] = (bf16)f2bf(O[dt][j] * ij);
        }
    }
}
constexpr int SA_PITCH = 272, SA_TILE = 32 * SA_PITCH;
__device__ __forceinline__ void p6_sparse_attn_mfma(Frame& F) {
    const int lane = F.lane, fr = lane & 15, fq = lane >> 4, gw = F.bid * NWAVES + F.wave, NGW = F.G * NWAVES;
    LAS unsigned char* tile = F.lds + F.wave * SA_TILE;
    const bf16* QL = WSP(bf16, WS_QL); const bf16* CKV = WSP(bf16, WS_CKV); const int* SEL = WSP(int, WS_SEL); const int* NSEL = WSP(int, WS_NSEL); bf16* AO = WSP(bf16, WS_AO);
    for (int row = gw; row < M; row += NGW) {
        const int b = row >> 13, n = __builtin_amdgcn_readfirstlane(NSEL[row]);
        const int* sel = SEL + (size_t)row * 256;
        const bf16* kvb = CKV + (size_t)b * SEQ * 128;
        bf16x8 qf[4];
#pragma unroll
        for (int s = 0; s < 4; ++s) { const v4u z = (v4u){0u, 0u, 0u, 0u}; qf[s] = (fr < 8) ? *(const bf16x8*)(QL + (size_t)row * 1536 + fr * 128 + 32 * s + 8 * fq) : __builtin_bit_cast(bf16x8, z); }
        f32x4 O[8];
#pragma unroll
        for (int rt = 0; rt < 8; ++rt) O[rt] = (f32x4){0.f, 0.f, 0.f, 0.f};
        float m_run = -1e30f, l_run = 0.f;
        const int nsteps = (n + 31) >> 5;
        v4u vr[8];
        { const int j = lane & 31; const int kidx = (j < n) ? sel[j] : 0;
#pragma unroll
          for (int i = 0; i < 8; ++i) { const int key = __shfl(kidx, (lane >> 4) + 4 * i); vr[i] = *(const v4u*)(kvb + (size_t)key * 128 + 8 * (lane & 15)); } }
#pragma unroll 1
        for (int g = 0; g < nsteps; ++g) {
#pragma unroll
            for (int i = 0; i < 8; ++i) *(LAS v4u*)(tile + ((lane >> 4) + 4 * i) * SA_PITCH + 16 * (lane & 15)) = vr[i];
            if (g + 1 < nsteps) {
                const int j = 32 * (g + 1) + (lane & 31); const int kidx = (j < n) ? sel[j] : 0;
#pragma unroll
                for (int i = 0; i < 8; ++i) { const int key = __shfl(kidx, (lane >> 4) + 4 * i); vr[i] = *(const v4u*)(kvb + (size_t)key * 128 + 8 * (lane & 15)); }
            }
            float sv[8];
#pragma unroll
            for (int tl = 0; tl < 2; ++tl) {
                f32x4 cc = (f32x4){0.f, 0.f, 0.f, 0.f};
#pragma unroll
                for (int s = 0; s < 4; ++s) { const bf16x8 kf = *(const LAS bf16x8*)(tile + (16 * tl + fr) * SA_PITCH + 64 * s + 16 * fq); cc = __builtin_amdgcn_mfma_f32_16x16x32_bf16(kf, qf[s], cc, 0, 0, 0); }
#pragma unroll
                for (int j = 0; j < 4; ++j) sv[4 * tl + j] = (32 * g + 16 * tl + 4 * fq + j < n) ? cc[j] : -INFINITY;
            }
            float mx = fmaxf(fmaxf(fmaxf(sv[0], sv[1]), fmaxf(sv[2], sv[3])), fmaxf(fmaxf(sv[4], sv[5]), fmaxf(sv[6], sv[7])));
            mx = fmaxf(mx, __shfl_xor(mx, 16)); mx = fmaxf(mx, __shfl_xor(mx, 32));
            const float m_new = fmaxf(m_run, mx);
            if (!__all(m_new == m_run)) {
                const float alpha = __expf(m_run - m_new);
                l_run *= alpha;
#pragma unroll
                for (int j = 0; j < 4; ++j) { const float aj = __shfl(alpha, 4 * fq + j);
#pragma unroll
                    for (int rt = 0; rt < 8; ++rt) O[rt][j] *= aj; }
                m_run = m_new;
            }
            float p[8], ps = 0.f;
#pragma unroll
            for (int e = 0; e < 8; ++e) { p[e] = __expf(sv[e] - m_run); ps += p[e]; }
            l_run += ps;
            v4u pw; pw.x = pg8::cvt_pk_bf16(p[0], p[1]); pw.y = pg8::cvt_pk_bf16(p[2], p[3]); pw.z = pg8::cvt_pk_bf16(p[4], p[5]); pw.w = pg8::cvt_pk_bf16(p[6], p[7]);
            const bf16x8 pf = __builtin_bit_cast(bf16x8, pw);
            LAS unsigned char* tb = tile + (4 * fq + ((lane & 15) >> 2)) * SA_PITCH + 8 * (lane & 3);
#pragma unroll
            for (int rt = 0; rt < 8; ++rt) {
                const v4i16_t lo = lds_tr16(tb + 32 * rt), hi = lds_tr16(tb + 16 * SA_PITCH + 32 * rt);
                bf16x8 vf; vf[0] = lo[0]; vf[1] = lo[1]; vf[2] = lo[2]; vf[3] = lo[3]; vf[4] = hi[0]; vf[5] = hi[1]; vf[6] = hi[2]; vf[7] = hi[3];
                O[rt] = __builtin_amdgcn_mfma_f32_16x16x32_bf16(pf, vf, O[rt], 0, 0, 0);
            }
        }
        float lt = l_run; lt += __shfl_xor(lt, 16); lt += __shfl_xor(lt, 32);
        const float inv = 1.0f / lt;
#pragma unroll
        for (int j = 0; j < 4; ++j) {
            const float ij = __shfl(inv, 4 * fq + j);
            if (fq < 2) { bf16* op = AO + (size_t)row * 1536 + (4 * fq + j) * 128 + fr;
#pragma unroll
                for (int rt = 0; rt < 8; ++rt) op[16 * rt] = (bf16)f2bf(O[rt][j] * ij); }
        }
    }
}
__device__ __forceinline__ void p14_pool(Frame& F, KArgs A) {
    const int lane = F.lane, tid = F.tid, gw = F.bid * NWAVES + F.wave, NGW = F.G * NWAVES;
    LAS float* pw = (LAS float*)(F.lds + 16384);
    LAS float* dl = (LAS float*)(F.lds + 16384 + 65536 + F.wave * 1024);
    for (int i = tid; i < 4 * 64 * 64; i += NTHREADS) pw[i] = A->in[I_CD_POOLW][i];
    __syncthreads();
    const bf16* QK = WSP(bf16, WS_QKVZ); bf16* AO = WSP(bf16, WS_AO);
    const int gi = lane >> 4, w = 2 << gi;
    float sc[4];
#pragma unroll
    for (int g = 0; g < 4; ++g) sc[g] = A->in[I_CD_POOLS][g * 64 + lane];
    for (int row = gw; row < M; row += NGW) {
        const int pos = row & (SEQ - 1);
        const int cntw = (pos + 1 < w) ? pos + 1 : w;
        float sum[4] = {0.f, 0.f, 0.f, 0.f}, cur[4] = {0.f, 0.f, 0.f, 0.f};
        for (int j = 0; j < cntw; ++j) {
            const v2u xr = *(const v2u*)(QK + (size_t)(row - j) * 2560 + 2304 + 4 * lane);
            const float f0 = bflo(xr.x), f1 = bfhi(xr.x), f2 = bflo(xr.y), f3 = bfhi(xr.y);
            sum[0] += f0; sum[1] += f1; sum[2] += f2; sum[3] += f3;
            if (j == 0) { cur[0] = f0; cur[1] = f1; cur[2] = f2; cur[3] = f3; }
        }
        const float inv = 1.0f / (float)cntw;
#pragma unroll
        for (int i = 0; i < 4; ++i) dl[4 * lane + i] = sum[i] * inv - cur[i];
        float o[4] = {0.f, 0.f, 0.f, 0.f};
        for (int c = 0; c < 64; ++c) {
#pragma unroll
            for (int g = 0; g < 4; ++g) o[g] += dl[g * 64 + c] * pw[(g * 64 + c) * 64 + lane];
        }
#pragma unroll
        for (int g = 0; g < 4; ++g) AO[(size_t)row * 1024 + 768 + g * 64 + lane] = (bf16)f2bf(o[g] * sc[g]);
    }
}


#define IN(k) (lo <= (k) && (k) < hi)
#define SEAM(k) do { if (IN(k) && IN((k) + 1)) xcd_barrier(bar); } while (0)
template <int l> __device__ __forceinline__ void layer_tail(Frame& F, const XcdBarrier& bar, const int lo, const int hi) {
    LAS unsigned char* ring = F.lds + RING_OFF;
    const int bid = F.bid, G = F.G;
        const int pb = 8 * l;

        if (IN(7 + pb)) {
            pg8::Gemm g{WSP(bf16, WS_AO), (l == 0) ? WSP(bf16, WS_W_OUTAB) : WSP(bf16, WS_W_OUTCD), M, 1024, (l == 0) ? 1536 : 1024}; pg8::StaticOrder S; S.init(M, 1024, G, bid);
            pg8::Epi<pg8::StPre> E{{(l == 0) ? kargs()->in[I_X] : WSP(float, WS_H2), WSP(float, WS_PRE), ALPHA}};
            pg8::gemm_phase<pg8::Epi<pg8::StPre>, pg8::StaticOrder, true, true>(ring, g, S, E);
        } SEAM(7 + pb);
        if (IN(8 + pb)) { p8_ln_router(F, kargs(), l, WSP(float, WS_H1), WSP(bf16, WS_H1B)); } SEAM(8 + pb);
        if (IN(9 + pb)) {
            p9_scatter(F, l, WSP(bf16, WS_H1B), WSP(float, WS_H1));
            __syncthreads();
            pg8::Gemm g{WSP(bf16, WS_H1B), WSP(bf16, WS_W_PG) + (size_t)l * 1024 * 1024, M, 1024, 1024}; pg8::StaticOrder S; S.init(M, 1024, G, bid);
            pg8::Epi<pg8::StPleGate> E{{WSP(bf16, WS_PP) + (size_t)l * M * 1024, WSP(bf16, WS_PLE)}};
            pg8::gemm_phase<pg8::Epi<pg8::StPleGate>, pg8::StaticOrder, true, true>(ring, g, S, E);
        } SEAM(9 + pb);
        const int* TILE = WSP(int, WS_ROUTE) + 3 * M * 4;
        if (IN(10 + pb)) {
            const int nT = __builtin_amdgcn_readfirstlane(TILE[NTMAX]);
            constexpr int EB = kMoeFp8 ? 1 : 2;
            pg8::Gemm g{WSP(bf16, WS_XS), (const bf16*)(F.ws + WS_W_GU + (size_t)l * NEXP * 2048 * 1024 * EB), PMAX, 2048, 1024 * EB / 2};
            pg8::MoeOrder S{TILE, nT, 8, G, bid, (long)2048 * 1024 * EB};
            pg8::Epi<pg8::StSwiglu<kMoeFp8>> E{{kargs()->in[I_BGU] + (size_t)l * NEXP * 2048, WSP(bf16, WS_HID)}};
            pg8::gemm_phase<pg8::Epi<pg8::StSwiglu<kMoeFp8>>, pg8::MoeOrder, true, true, kMoeFp8 ? kScaleGU : 0u>(ring, g, S, E);
        } SEAM(10 + pb);
        if (IN(11 + pb)) {
            const int nT = __builtin_amdgcn_readfirstlane(TILE[NTMAX]);
            constexpr int EB = kMoeFp8 ? 1 : 2;
            pg8::Gemm g{WSP(bf16, WS_HID), (const bf16*)(F.ws + WS_W_DN + (size_t)l * NEXP * 1024 * 1024 * EB), PMAX, 1024, 1024 * EB / 2};
            pg8::MoeOrder S{TILE, nT, 4, G, bid, (long)1024 * 1024 * EB};
            pg8::Epi<pg8::StDown> E{{kargs()->in[I_BDN] + (size_t)l * NEXP * 1024, WSP(bf16, WS_YS)}};
            pg8::gemm_phase<pg8::Epi<pg8::StDown>, pg8::MoeOrder, true, true, kMoeFp8 ? kScaleDN : 0u>(ring, g, S, E);
        } SEAM(11 + pb);
        if (IN(12 + pb)) { p12_combine(F, kargs(), l, WSP(float, WS_H1), (l == 0) ? WSP(float, WS_H2) : kargs()->out, (l == 0) ? WSP(bf16, WS_XB) : (bf16*)nullptr); }
}
#undef IN
#undef SEAM
__global__ void __launch_bounds__(NTHREADS, 2) mk_fwd(Args args_by_value) {
    const KArgs KA = kargs();
    extern __shared__ __attribute__((aligned(16))) unsigned char lds[];
    Frame F;
    F.lds = (LAS unsigned char*)lds;
    F.tid = threadIdx.x; F.lane = F.tid & 63; F.wave = __builtin_amdgcn_readfirstlane(F.tid >> 6);
    F.G = gridDim.x; F.bid = blockIdx.x; F.ws = KA->ws; F.ctl = (gu32*)(KA->ws + WS_CTL);
    volatile LAS unsigned* MISC = (volatile LAS unsigned*)(F.lds + MISC_OFF);
    { int t0 = threadIdx.x; asm volatile("" : "+v"(t0)); for (int u = t0; u < (LDS_BYTES - MISC_OFF) / 4; u += NTHREADS) MISC[u] = 0u; }
    __syncthreads();
    const bool use_bar = (N_LAUNCHES != NPHASES);
    XcdBarrier bar; bar.bar = (unsigned*)(F.ctl + CW_BAR) + KA->li * XCD_BAR_WORDS; bar.x = 0; bar.st = nullptr;
    if (use_bar) bar = xcd_barrier_post((unsigned*)(F.ctl + CW_BAR) + KA->li * XCD_BAR_WORDS, MISC + 8);
    const int lo = KA->ph_lo, hi = KA->ph_hi;
#define IN(k) (lo <= (k) && (k) < hi)
#define SEAM(k) do { if (IN(k) && IN((k) + 1)) xcd_barrier(bar); } while (0)
    LAS unsigned char* ring = F.lds + RING_OFF;
    const int bid = F.bid, G = F.G;

    if (IN(0)) { p0_prologue(F, kargs()); } SEAM(0);

            if (IN(1)) {
                { pg8::Gemm g{WSP(bf16, WS_XB), WSP(bf16, WS_W_INAB), M, 2560, 1024}; pg8::StaticOrder S; S.init(M, 2560, G, bid);
                  pg8::Epi<pg8::StInAB> E{{WSP(float, WS_SM), WSP(bf16, WS_QKVZ)}};
                  pg8::gemm_phase<pg8::Epi<pg8::StInAB>, pg8::StaticOrder, true, true>(ring, g, S, E); }
                __syncthreads();
                { pg8::Gemm g{WSP(bf16, WS_PB), WSP(bf16, WS_W_PP), 2 * M, 1024, 256}; pg8::BatchOrder S{4, (2 * M / 256) * 4, G, bid, M / 256, (long)1024 * 256 * 2};
                  pg8::Epi<pg8::StBf16> E{{WSP(bf16, WS_PP), 1024}};
                  pg8::gemm_phase<pg8::Epi<pg8::StBf16>, pg8::BatchOrder, true, true>(ring, g, S, E); }
            } SEAM(1);
            if (IN(2)) { p2_prep(F, kargs()); } SEAM(2);
            if (IN(3)) {
                p3_chunk_prep(F, kargs());
                __syncthreads();
                { pg8::Gemm g{WSP(bf16, WS_CQ), WSP(bf16, WS_W_ABS), M, 1536, 256}; pg8::StaticOrder S; S.init(M, 1536, G, bid);
                  pg8::Epi<pg8::StBf16> E{{WSP(bf16, WS_QL), 1536}};
                  pg8::gemm_phase<pg8::Epi<pg8::StBf16>, pg8::StaticOrder, true, true>(ring, g, S, E); }
            } SEAM(3);
            if (IN(4)) {
                if (bid < SEQ_WGS && G > SEQ_WGS) p4_delta_seq(F, bid);
                else p4_indexer(F, (bid - SEQ_WGS) * NWAVES + F.wave, (G - SEQ_WGS) * NWAVES);
            } SEAM(4);
            if (IN(5)) { p5_topk(F); } SEAM(5);
            if (IN(6)) { p6_sparse_attn_mfma(F); p6_gdn_out(F, kargs()); } SEAM(6);
    layer_tail<0>(F, bar, lo, hi);
    SEAM(12);
            if (IN(13)) {
                pg8::Gemm g{WSP(bf16, WS_XB), WSP(bf16, WS_W_INCD), M, 2560, 1024}; pg8::StaticOrder S; S.init(M, 2560, G, bid);
                pg8::Epi<pg8::StBf16> E{{WSP(bf16, WS_QKVZ), 2560}};
                pg8::gemm_phase<pg8::Epi<pg8::StBf16>, pg8::StaticOrder, true, true>(ring, g, S, E);
            } SEAM(13);
            if (IN(14)) { p14_dilated_mfma(F); __syncthreads(); p14_pool(F, kargs()); } SEAM(14);
    layer_tail<1>(F, bar, lo, hi);
#undef IN
#undef SEAM
}

extern "C" void kernel_launch(void* const* d_in, const int* in_sizes, int n_in, void* d_out, int out_size, void* d_ws, size_t ws_size, hipStream_t stream) {
    static int grid = 0;
    if (grid == 0) {
        if (n_in != N_IN || in_sizes[0] != M * D || out_size != M * D || ws_size < WS_END) {
            fprintf(stderr, "kernel_launch: built for %d inputs, x/out of %d floats, >= %zu bytes of workspace; got n_in %d, in0 %d, out %d, ws %zu; nothing launched\n", N_IN, M * D, (size_t)WS_END, n_in, n_in > 0 ? in_sizes[0] : -1, out_size, ws_size);
            grid = -1; return; }
        int dev = 0, cus = 0, per_cu = 0;
        if (hipGetDevice(&dev) != hipSuccess || hipDeviceGetAttribute(&cus, hipDeviceAttributeMultiprocessorCount, dev) != hipSuccess) { fprintf(stderr, "kernel_launch: device query failed\n"); grid = -1; return; }
        if (hipFuncSetAttribute((const void*)mk_fwd, hipFuncAttributeMaxDynamicSharedMemorySize, LDS_BYTES) != hipSuccess) { fprintf(stderr, "kernel_launch: hipFuncSetAttribute failed\n"); grid = -1; return; }
        if (hipOccupancyMaxActiveBlocksPerMultiprocessor(&per_cu, (const void*)mk_fwd, NTHREADS, LDS_BYTES) != hipSuccess || per_cu < 1)
            fprintf(stderr, "kernel_launch: note: occupancy query reports %d workgroups per CU\n", per_cu);
        (void)hipGetLastError();
        grid = cus;
    }
    if (grid < 0) return;
    if (hipMemsetAsync((char*)d_ws + WS_CTL, 0, CTL_ZERO_BYTES, stream) != hipSuccess) { fprintf(stderr, "kernel_launch: memset failed\n"); return; }
    Args a{};
    for (int i = 0; i < N_IN; ++i) a.in[i] = (const float*)d_in[i];
    a.out = (float*)d_out; a.ws = (unsigned char*)d_ws;
    for (int li = 0; li < N_LAUNCHES; ++li) {
        if (N_LAUNCHES == NPHASES) { a.ph_lo = li; a.ph_hi = li + 1; } else { a.ph_lo = (int)((long)li * NPHASES / N_LAUNCHES); a.ph_hi = (int)((long)(li + 1) * NPHASES / N_LAUNCHES); }
        a.li = li;
        hipLaunchKernelGGL(mk_fwd, dim3(grid), dim3(NTHREADS), LDS_BYTES, stream, a);
        const hipError_t le = hipPeekAtLastError();
        if (le != hipSuccess) { fprintf(stderr, "kernel_launch: launch %d failed: %s\n", li, hipGetErrorName(le)); break; }
    }
}
```

```cpp
#include <hip/hip_runtime.h>
#include <cstdio>
#include <cstdint>

namespace pg8 {
#define PG8_LAS __attribute__((address_space(3)))
typedef unsigned short bf16_t;
typedef short bf16x8 __attribute__((ext_vector_type(8)));
typedef float f32x4 __attribute__((ext_vector_type(4)));
typedef unsigned u32x4 __attribute__((ext_vector_type(4)));
constexpr int BM = 256, BK = 64, HALF = 128, HTB = HALF * BK * 2  , STAGE_BYTES = 8 * HTB, NXCD = 8, WGM = 8;

__host__ __device__ __forceinline__ int lds_byte(int r, int c) { const int st = (r >> 4) * 2 + (c >> 5), rr = r & 15, cc = c & 31, ob = rr * 64 + cc * 2; return st * 1024 + (ob ^ (((ob >> 9) & 1) << 5)); }
__host__ __device__ __forceinline__ void stage_rc(int b, int& R, int& C) { const int st = b / 1024, sb = b % 1024, swz = sb ^ (((sb >> 9) & 1) << 5); R = (st >> 1) * 16 + swz / 64; C = (st & 1) * 32 + (swz % 64) / 2; }
__host__ __device__ __forceinline__ int perm32(int rho) { const int n = rho >> 4, i = rho & 15; return 8 * (i >> 2) + 4 * n + (i & 3); }

struct Unit { int pm, pn, e; long bofs; };
struct Gemm { const bf16_t* A; const bf16_t* Bt; int M, N, K; };

struct StaticOrder {
    int nM, nN, nwg, G, c;
    __host__ __device__ void init(int M, int N, int G_, int c_) { nM = M / BM; nN = N / BM; nwg = nM * nN; G = G_; c = c_; }
    __host__ __device__ bool next(int i, Unit& u) const {
        const long L = (long)i * G + c; if (L >= nwg) return false;
        int wgid = (int)L; { const int q = nwg / NXCD, r = nwg % NXCD, xcd = wgid % NXCD, off = wgid / NXCD; wgid = (xcd < r ? xcd * (q + 1) : r * (q + 1) + (xcd - r) * q) + off; }
        const int nig = WGM * nN, gid = wgid / nig, fm = gid * WGM, gsz = (nM - fm) < WGM ? (nM - fm) : WGM;
        u.pm = fm + ((wgid % nig) % gsz); u.pn = (wgid % nig) / gsz; u.e = 0; u.bofs = 0; return true;
    }
    __device__ __forceinline__ void a_ready(const Unit&) const {}
    __device__ __forceinline__ void done(const Unit&) const {}
};
struct MoeOrder {
    const int* tile_e; int nT, nN, G, c; long estride;
    __device__ __forceinline__ bool next(int i, Unit& u) const {
        const long L = (long)i * G + c; if (L >= (long)nT * nN) return false;
        u.pm = (int)(L / nN); u.pn = (int)(L % nN); const int e = tile_e[u.pm]; u.e = e; u.bofs = (long)e * estride; return true;
    }
    __device__ __forceinline__ void a_ready(const Unit&) const {}
    __device__ __forceinline__ void done(const Unit&) const {}
};

struct BatchOrder {
    int nN, nwg, G, c, tiles_per_batch; long bstride;
    __device__ __forceinline__ bool next(int i, Unit& u) const {
        const long L = (long)i * G + c; if (L >= nwg) return false;
        u.pm = (int)(L / nN); u.pn = (int)(L % nN); const int e = u.pm / tiles_per_batch; u.e = e; u.bofs = (long)e * bstride; return true;
    }
    __device__ __forceinline__ void a_ready(const Unit&) const {}
    __device__ __forceinline__ void done(const Unit&) const {}
};

__device__ __forceinline__ unsigned cvt_pk_bf16(float lo, float hi) { unsigned r; asm volatile("v_cvt_pk_bf16_f32 %0, %1, %2" : "=v"(r) : "v"(lo), "v"(hi)); return r; }
__device__ __forceinline__ u32x4 pack8(const f32x4 v0, const f32x4 v1) { u32x4 w; w.x = cvt_pk_bf16(v0[0], v0[1]); w.y = cvt_pk_bf16(v0[2], v0[3]); w.z = cvt_pk_bf16(v1[0], v1[1]); w.w = cvt_pk_bf16(v1[2], v1[3]); return w; }
__device__ __forceinline__ float bf_lo(unsigned w) { return __uint_as_float(w << 16); }
__device__ __forceinline__ float bf_hi(unsigned w) { return __uint_as_float(w & 0xffff0000u); }
__device__ __forceinline__ float sigmoidf_(float x) { return 1.0f / (1.0f + __expf(-x)); }
typedef unsigned u32x2 __attribute__((ext_vector_type(2)));

template <class T> struct Epi {
    static constexpr bool PERM = true, AFTER_DRAIN = false;
    T t;
    __device__ __forceinline__ void operator()(const f32x4 (&acc)[2][2][4][2], const Unit& u, int wr, int wc, int fr, int fq) const {
        const int row0 = u.pm * BM + wr * 64 + fr, col0 = u.pn * BM + wc * 32 + 8 * fq;
#pragma unroll
        for (int ai = 0; ai < 2; ++ai)
#pragma unroll
            for (int m = 0; m < 4; ++m) {
#pragma unroll
                for (int bj = 0; bj < 2; ++bj) t.store(row0 + ai * HALF + m * 16, col0 + bj * HALF, acc[ai][bj][m][0], acc[ai][bj][m][1], u);
                asm volatile("" ::: "memory"); }
    }
};
struct StBf16 { bf16_t* O; int ld;
    __device__ __forceinline__ void store(int row, int col, f32x4 v0, f32x4 v1, const Unit&) const { *(u32x4*)(O + (size_t)row * ld + col) = pack8(v0, v1); } };
struct StInAB { float* SM; bf16_t* Q;
    __device__ __forceinline__ void store(int row, int col, f32x4 v0, f32x4 v1, const Unit&) const {
        if (col < 512) { float* p = SM + (size_t)row * 512 + col; *(f32x4*)p = v0; *(f32x4*)(p + 4) = v1; }
        else *(u32x4*)(Q + (size_t)row * 2048 + (col - 512)) = pack8(v0, v1); } };
struct StPre { const float* base; float* P; float alpha;
    __device__ __forceinline__ void store(int row, int col, f32x4 v0, f32x4 v1, const Unit&) const {
        const size_t o = (size_t)row * 1024 + col; const f32x4 b0 = *(const f32x4*)(base + o), b1 = *(const f32x4*)(base + o + 4);
        *(f32x4*)(P + o) = b0 * alpha + v0; *(f32x4*)(P + o + 4) = b1 * alpha + v1; } };
struct StPleGate { const bf16_t* PP; bf16_t* O;
    __device__ __forceinline__ void store(int row, int col, f32x4 v0, f32x4 v1, const Unit&) const {
        const size_t o = (size_t)row * 1024 + col; const u32x4 p = *(const u32x4*)(PP + o);
        f32x4 r0, r1;
        r0[0] = sigmoidf_(v0[0]) * bf_lo(p.x); r0[1] = sigmoidf_(v0[1]) * bf_hi(p.x); r0[2] = sigmoidf_(v0[2]) * bf_lo(p.y); r0[3] = sigmoidf_(v0[3]) * bf_hi(p.y);
        r1[0] = sigmoidf_(v1[0]) * bf_lo(p.z); r1[1] = sigmoidf_(v1[1]) * bf_hi(p.z); r1[2] = sigmoidf_(v1[2]) * bf_lo(p.w); r1[3] = sigmoidf_(v1[3]) * bf_hi(p.w);
        *(u32x4*)(O + o) = pack8(r0, r1); } };
template <bool F8> struct StSwiglu { const float* bgu; bf16_t* H;
    __device__ __forceinline__ float act(float g, float u) const { const float gt = fminf(g, 7.0f), up = fminf(fmaxf(u, -7.0f), 7.0f); return (up + 1.0f) * (gt * sigmoidf_(gt * 1.702f)); }
    __device__ __forceinline__ void store(int row, int col, f32x4 v0, f32x4 v1, const Unit& u) const {
        const float* b = bgu + (size_t)u.e * 2048 + col; const f32x4 b0 = *(const f32x4*)b, b1 = *(const f32x4*)(b + 4);
        v0 = v0 + b0; v1 = v1 + b1;
        if (F8) { unsigned w = 0u; w = __builtin_amdgcn_cvt_pk_fp8_f32(act(v0[0], v0[1]), act(v0[2], v0[3]), w, false); w = __builtin_amdgcn_cvt_pk_fp8_f32(act(v1[0], v1[1]), act(v1[2], v1[3]), w, true);
            *(unsigned*)((unsigned char*)H + (size_t)row * 1024 + (col >> 1)) = w; }
        else { u32x2 w; w.x = cvt_pk_bf16(act(v0[0], v0[1]), act(v0[2], v0[3])); w.y = cvt_pk_bf16(act(v1[0], v1[1]), act(v1[2], v1[3]));
            *(u32x2*)(H + (size_t)row * 1024 + (col >> 1)) = w; } } };
struct StDown { const float* bd; bf16_t* Y;
    __device__ __forceinline__ void store(int row, int col, f32x4 v0, f32x4 v1, const Unit& u) const {
        const float* b = bd + (size_t)u.e * 1024 + col; const f32x4 b0 = *(const f32x4*)b, b1 = *(const f32x4*)(b + 4);
        *(u32x4*)(Y + (size_t)row * 1024 + col) = pack8(v0 + b0, v1 + b1); } };

typedef int i32x8 __attribute__((ext_vector_type(8)));
typedef int i32x4 __attribute__((ext_vector_type(4)));
template <class Epi, class Sched, bool ALIGN_EPI = false, bool SP2 = false, unsigned FP8W = 0u>
__device__ __forceinline__ void gemm_phase(PG8_LAS unsigned char* lds, const Gemm g, const Sched& S, const Epi& E) {
    int tid = threadIdx.x; asm volatile("" : "+v"(tid));
    const int wid = __builtin_amdgcn_readfirstlane(tid >> 6), lane = tid & 63, wr = wid >> 2, wc = wid & 3, fr = lane & 15, fq = lane >> 4;
    int K = g.K; asm volatile("" : "+s"(K));
    const int nt = K / BK;
    unsigned voffA[2], voffB[2];
#pragma unroll
    for (int i = 0; i < 2; ++i) { int R, C; stage_rc(tid * 16 + i * 8192, R, C); const int Rb = Epi::PERM ? ((R & ~31) + perm32(R & 31)) : R;
        voffA[i] = (unsigned)(R * K + C) * 2u; voffB[i] = (unsigned)(Rb * K + C) * 2u; }
    const size_t kstep = (size_t)(BK * 2);
    const size_t hstep = (size_t)HALF * K * 2;
    const size_t tstep = 2 * hstep;
    const unsigned ldsw = (unsigned)wid * 1024u;
    const int aoff = lds_byte(wr * 64 + fr, fq * 8), boff = lds_byte(wc * 32 + fr, fq * 8);
#define PG8_SA(b, h) (((b) * 2 + (h)) * HTB)
#define PG8_SB(b, h) ((4 + (b) * 2 + (h)) * HTB)
#define PG8_STAGE(bufoff, gbase, voff) do { _Pragma("unroll") for (int _i = 0; _i < 2; ++_i) \
        __builtin_amdgcn_global_load_lds((const unsigned*)((const char*)(gbase) + (voff)[_i]), (PG8_LAS unsigned*)(lds + (bufoff) + ldsw + _i * 8192), 16, 0, 0); } while (0)
#define PG8_CAT(lo, hi) __builtin_shufflevector((lo), (hi), 0, 1, 2, 3, 4, 5, 6, 7)
#define PG8_LDA(dst, b, h) do { if constexpr (FP8W != 0u) { _Pragma("unroll") for (int m = 0; m < 4; ++m) dst##8[m] = PG8_CAT(*(const PG8_LAS i32x4*)(lds + PG8_SA(b, h) + aoff + m * 2048), *(const PG8_LAS i32x4*)(lds + PG8_SA(b, h) + aoff + m * 2048 + 1024)); } \
        else { _Pragma("unroll") for (int m = 0; m < 4; ++m) _Pragma("unroll") for (int k = 0; k < 2; ++k) dst[m][k] = *(const PG8_LAS bf16x8*)(lds + PG8_SA(b, h) + aoff + m * 2048 + k * 1024); } } while (0)
#define PG8_LDB(dst, b, h) do { if constexpr (FP8W != 0u) { _Pragma("unroll") for (int n = 0; n < 2; ++n) dst##8[n] = PG8_CAT(*(const PG8_LAS i32x4*)(lds + PG8_SB(b, h) + boff + n * 2048), *(const PG8_LAS i32x4*)(lds + PG8_SB(b, h) + boff + n * 2048 + 1024)); } \
        else { _Pragma("unroll") for (int n = 0; n < 2; ++n) _Pragma("unroll") for (int k = 0; k < 2; ++k) dst[n][k] = *(const PG8_LAS bf16x8*)(lds + PG8_SB(b, h) + boff + n * 2048 + k * 1024); } } while (0)
#define PG8_MMA(ai, bj, At, Bt) do { __builtin_amdgcn_s_setprio(1); _Pragma("unroll") for (int m = 0; m < 4; ++m) _Pragma("unroll") for (int n = 0; n < 2; ++n) { \
        if constexpr (FP8W != 0u) asm volatile("v_mfma_scale_f32_16x16x128_f8f6f4 %0, %1, %2, %0, %3, %4 op_sel_hi:[0,0,0]" : "+v"(acc[ai][bj][m][n]) : "v"(Bt##8[n]), "v"(At##8[m]), "v"(sc_w), "v"(sc_x));   \
        else { _Pragma("unroll") for (int k = 0; k < 2; ++k) acc[ai][bj][m][n] = __builtin_amdgcn_mfma_f32_16x16x32_bf16(Bt[n][k], At[m][k], acc[ai][bj][m][n], 0, 0, 0); } } __builtin_amdgcn_s_setprio(0); } while (0)
#define PG8_WAIT_V(n) asm volatile("s_waitcnt vmcnt(" #n ")" ::: "memory")
#define PG8_WAIT_L(n) asm volatile("s_waitcnt lgkmcnt(" #n ")" ::: "memory")
#define PG8_BAR __builtin_amdgcn_s_barrier()
#define PG8_SCHED __builtin_amdgcn_sched_barrier(0)
    Unit cur, nxt; int ui = 0;
    if (!S.next(0, cur)) return;
    f32x4 acc[2][2][4][2];
#pragma unroll
    for (int a = 0; a < 2; ++a)
#pragma unroll
        for (int b = 0; b < 2; ++b)
#pragma unroll
            for (int m = 0; m < 4; ++m)
#pragma unroll
                for (int n = 0; n < 2; ++n) acc[a][b][m][n] = (f32x4){0.f, 0.f, 0.f, 0.f};
    bf16x8 At[4][2], B0[2][2], B1[2][2];
    int sc_w = (int)FP8W, sc_x = 0x7f7f7f7f; asm volatile("" : "+v"(sc_w), "+v"(sc_x));
    i32x8 At8[4], B08[2], B18[2];
    const char* cA = (const char*)g.A + (size_t)cur.pm * tstep; const char* cB = (const char*)g.Bt + (size_t)cur.pn * tstep + cur.bofs;
    S.a_ready(cur);
    if constexpr (SP2) {
        PG8_STAGE(PG8_SB(0, 0), cB, voffB); PG8_STAGE(PG8_SB(0, 1), cB + hstep, voffB); PG8_STAGE(PG8_SA(0, 0), cA, voffA); PG8_STAGE(PG8_SA(0, 1), cA + hstep, voffA);
        if (wr == 1) PG8_BAR;
        PG8_WAIT_V(2); PG8_BAR;
        PG8_STAGE(PG8_SB(1, 0), cB + kstep, voffB); PG8_STAGE(PG8_SA(1, 0), cA + kstep, voffA); PG8_STAGE(PG8_SB(1, 1), cB + hstep + kstep, voffB);
        PG8_WAIT_V(6); PG8_BAR;
    } else {
        PG8_STAGE(PG8_SB(0, 0), cB, voffB); PG8_STAGE(PG8_SA(0, 0), cA, voffA); PG8_STAGE(PG8_SB(0, 1), cB + hstep, voffB); PG8_STAGE(PG8_SA(0, 1), cA + hstep, voffA);
        if (wr == 1) PG8_BAR;
        PG8_WAIT_V(4); PG8_BAR;
        PG8_STAGE(PG8_SB(1, 0), cB + kstep, voffB); PG8_STAGE(PG8_SA(1, 0), cA + kstep, voffA); PG8_STAGE(PG8_SB(1, 1), cB + hstep + kstep, voffB);
        PG8_WAIT_V(6); PG8_BAR;
    }
    for (;;) {
        const bool has_next = S.next(ui + 1, nxt);
        const char* nA = has_next ? (const char*)g.A + (size_t)nxt.pm * tstep : cA; const char* nB = has_next ? (const char*)g.Bt + (size_t)nxt.pn * tstep + nxt.bofs : cB;
        for (int t = 0; t < nt; t += 2) {
            const bool last = (t == nt - 2);
            const char* a1 = cA + (size_t)(t + 1) * kstep;
            const char* a2 = last ? nA : cA + (size_t)(t + 2) * kstep; const char* b2 = last ? nB : cB + (size_t)(t + 2) * kstep;
            const char* a3 = a2 + kstep; const char* b3 = b2 + kstep;
            if (last && has_next) S.a_ready(nxt);
            if constexpr (SP2) {
            PG8_LDB(B0, 0, 0); PG8_LDB(B1, 0, 1); PG8_SCHED; PG8_LDA(At, 0, 0); PG8_STAGE(PG8_SA(1, 1), a1 + hstep, voffA);
            PG8_WAIT_V(8); PG8_WAIT_L(0); PG8_BAR; PG8_MMA(0, 0, At, B0); PG8_MMA(0, 1, At, B1); PG8_BAR; PG8_SCHED;
            PG8_LDA(At, 0, 1); PG8_STAGE(PG8_SB(0, 0), b2, voffB); PG8_STAGE(PG8_SB(0, 1), b2 + hstep, voffB); PG8_STAGE(PG8_SA(0, 0), a2, voffA);
            PG8_WAIT_V(8); PG8_WAIT_L(0); PG8_BAR; PG8_MMA(1, 0, At, B0); PG8_MMA(1, 1, At, B1); PG8_BAR; PG8_SCHED;
            PG8_LDB(B0, 1, 0); PG8_LDB(B1, 1, 1); PG8_SCHED; PG8_LDA(At, 1, 0); PG8_STAGE(PG8_SA(0, 1), a2 + hstep, voffA);
            PG8_WAIT_V(8); PG8_WAIT_L(0); PG8_BAR; PG8_MMA(0, 0, At, B0); PG8_MMA(0, 1, At, B1); PG8_BAR; PG8_SCHED;
            PG8_LDA(At, 1, 1); PG8_STAGE(PG8_SB(1, 0), b3, voffB); PG8_STAGE(PG8_SB(1, 1), b3 + hstep, voffB); PG8_STAGE(PG8_SA(1, 0), a3, voffA);
            PG8_WAIT_V(8); PG8_WAIT_L(0); PG8_BAR; PG8_MMA(1, 0, At, B0); PG8_MMA(1, 1, At, B1); PG8_BAR; PG8_SCHED;
            } else {
            PG8_LDB(B0, 0, 0); PG8_SCHED; PG8_LDA(At, 0, 0); PG8_STAGE(PG8_SA(1, 1), a1 + hstep, voffA);
            PG8_WAIT_L(8); PG8_BAR; PG8_WAIT_L(0); PG8_MMA(0, 0, At, B0); PG8_BAR; PG8_SCHED;
            PG8_LDB(B1, 0, 1); PG8_STAGE(PG8_SB(0, 0), b2, voffB);
            PG8_BAR; PG8_WAIT_L(0); PG8_MMA(0, 1, At, B1); PG8_BAR;
            PG8_LDA(At, 0, 1); PG8_STAGE(PG8_SA(0, 0), a2, voffA);
            PG8_BAR; PG8_WAIT_L(0); PG8_MMA(1, 0, At, B0); PG8_BAR; PG8_SCHED;
            PG8_STAGE(PG8_SB(0, 1), b2 + hstep, voffB);
            PG8_WAIT_V(6); PG8_BAR; PG8_MMA(1, 1, At, B1); PG8_BAR;
            PG8_LDB(B0, 1, 0); PG8_SCHED; PG8_LDA(At, 1, 0); PG8_STAGE(PG8_SA(0, 1), a2 + hstep, voffA);
            PG8_WAIT_L(8); PG8_BAR; PG8_WAIT_L(0); PG8_MMA(0, 0, At, B0); PG8_BAR; PG8_SCHED;
            PG8_LDB(B1, 1, 1); PG8_STAGE(PG8_SB(1, 0), b3, voffB);
            PG8_BAR; PG8_WAIT_L(0); PG8_MMA(0, 1, At, B1); PG8_BAR;
            PG8_LDA(At, 1, 1); PG8_STAGE(PG8_SA(1, 0), a3, voffA);
            PG8_BAR; PG8_WAIT_L(0); PG8_MMA(1, 0, At, B0); PG8_BAR; PG8_SCHED;
            PG8_STAGE(PG8_SB(1, 1), b3 + hstep, voffB);
            PG8_WAIT_V(6); PG8_BAR; PG8_MMA(1, 1, At, B1); PG8_BAR;
            }
        }
        if constexpr (FP8W != 0u) asm volatile("s_nop 15\n\ts_nop 15" ::: "memory");
        if constexpr (ALIGN_EPI) { if (wr == 0) PG8_BAR; }
        if constexpr (!Epi::AFTER_DRAIN) { E(acc, cur, wr, wc, fr, fq); S.done(cur); }
        if (!has_next) break;
#pragma unroll
        for (int a = 0; a < 2; ++a)
#pragma unroll
            for (int b = 0; b < 2; ++b)
#pragma unroll
                for (int m = 0; m < 4; ++m)
#pragma unroll
                    for (int n = 0; n < 2; ++n) acc[a][b][m][n] = (f32x4){0.f, 0.f, 0.f, 0.f};
        cur = nxt; cA = nA; cB = nB; ++ui;
        if constexpr (ALIGN_EPI) { if (wr == 1) PG8_BAR; }
    }
    PG8_WAIT_V(0);
    if constexpr (!ALIGN_EPI) { if (wr == 0) PG8_BAR; }
    PG8_BAR;
    if constexpr (Epi::AFTER_DRAIN) { E.fused(acc, cur, wr, wc, fr, fq, lds, wid, lane); S.done(cur); }
#undef PG8_SA
#undef PG8_SB
#undef PG8_STAGE
#undef PG8_LDA
#undef PG8_CAT
#undef PG8_LDB
#undef PG8_MMA
#undef PG8_WAIT_V
#undef PG8_WAIT_L
#undef PG8_BAR
#undef PG8_SCHED
}
}

constexpr int NWAVES = 8, NTHREADS = 512;
constexpr int BATCH = 2, SEQ = 8192, M = BATCH * SEQ, D = 1024;
constexpr int NEXP = 32, DEXP = 1024;
constexpr int PMAX = M * 4 + NEXP * 256, NTMAX = PMAX / 256;
constexpr float ALPHA = 1.41421356237f;
constexpr int NPHASES = 21;
#ifndef MOE_FP8
#define MOE_FP8 1
#endif
constexpr bool kMoeFp8 = (MOE_FP8 != 0);
constexpr unsigned kScaleGU = 0x79797979u, kScaleDN = 0x78787878u;
#ifndef MK_N_LAUNCHES
#define MK_N_LAUNCHES 1
#endif
constexpr int N_LAUNCHES = MK_N_LAUNCHES;

enum { I_X = 0, I_P, I_AB_WIN, I_AB_QG, I_AB_KVG, I_AB_WUQ, I_AB_WUK, I_AB_WUV, I_AB_WQIDX, I_AB_KIG, I_AB_KIB, I_AB_CONVW, I_AB_ALOG, I_AB_DTB, I_AB_ONG, I_AB_WOUT,
       I_CD_WIN, I_CD_POOLW, I_CD_POOLS, I_CD_WOUT, I_LNM_G, I_LNM_B, I_RW, I_RB, I_WGU, I_BGU, I_WDN, I_BDN, I_PLE_WP, I_PLE_WG, I_LNF_G, I_LNF_B, N_IN };

constexpr size_t MiB = 1u << 20;
constexpr size_t WS_CTL = 0, CTL_ZERO_BYTES = 1 * MiB;
constexpr size_t WS_W_INAB = 1 * MiB;
constexpr size_t WS_W_ABS = 6 * MiB;
constexpr size_t WS_W_OUTAB = 7 * MiB;
constexpr size_t WS_W_INCD = 10 * MiB;
constexpr size_t WS_W_OUTCD = 15 * MiB;
constexpr size_t WS_W_PG = 17 * MiB;
constexpr size_t WS_W_PP = 21 * MiB;
constexpr size_t WS_W_GU = 22 * MiB;
constexpr size_t WS_W_DN = 278 * MiB;
constexpr size_t WS_XB = 406 * MiB;
constexpr size_t WS_PB = 438 * MiB;
constexpr size_t WS_PP = 454 * MiB;
constexpr size_t WS_SM = 518 * MiB;
constexpr size_t WS_QKVZ = 550 * MiB;
constexpr size_t WS_CQ = 630 * MiB;
constexpr size_t WS_CKV = 638 * MiB;
constexpr size_t WS_KIDX = 642 * MiB;
constexpr size_t WS_WIDX = 644 * MiB;
constexpr size_t WS_BETA = 645 * MiB;
constexpr size_t WS_GG = WS_BETA + 512 * 1024;
constexpr size_t WS_QN = 646 * MiB, WS_KN = 662 * MiB, WS_VN = 678 * MiB;
constexpr size_t WS_QL = 694 * MiB;
constexpr size_t WS_CHK = 742 * MiB;
constexpr size_t WS_SEL = 838 * MiB;
constexpr size_t WS_NSEL = 854 * MiB;
constexpr size_t WS_ODELTA = 855 * MiB;
constexpr size_t WS_AO = 887 * MiB;
constexpr size_t WS_PRE = 935 * MiB;
constexpr size_t WS_H1 = 999 * MiB;
constexpr size_t WS_H2 = 1063 * MiB;
constexpr size_t WS_H1B = 1127 * MiB;
constexpr size_t WS_PLE = 1159 * MiB;
constexpr size_t WS_ROUTE = 1191 * MiB;
constexpr size_t WS_BIG = 1193 * MiB;
constexpr size_t WS_XS = WS_BIG, WS_HID = WS_BIG + 144 * MiB, WS_YS = WS_BIG + 288 * MiB;
constexpr size_t WS_END = WS_BIG + 512 * MiB;
static_assert((size_t)PMAX * 1024 * 2 <= 144 * MiB && WS_END <= 2048 * MiB, "d_ws map");
constexpr size_t CHK_WP = 0, CHK_QD = 16384, CHK_KDT = 32768, CHK_QK = 49152, CHK_UT = 57344, CHK_GL = 90112, CHK_STRIDE = 92160;
static_assert(CHK_STRIDE * 1024 <= 96 * MiB, "chunk operands");
constexpr int CW_TMO = 0, CW_CODE = 1;
constexpr int CW_BAR = 4096;
constexpr int CW_CNT = 16384;

constexpr int RING_OFF = 0, RING_BYTES = 131072;
constexpr int WSCR_OFF = 132096, WSCR_BYTES = 1024;
constexpr int MISC_OFF = 140288;
constexpr int LDS_BYTES = 147456;

#define GAS __attribute__((address_space(1)))
#define LAS __attribute__((address_space(3)))
typedef unsigned short bf16;
typedef unsigned v4u __attribute__((ext_vector_type(4)));
typedef unsigned v2u __attribute__((ext_vector_type(2)));
typedef float f32x4 __attribute__((ext_vector_type(4)));
typedef short bf16x8 __attribute__((ext_vector_type(8)));
typedef GAS unsigned gu32;
#define RLX_AGENT __ATOMIC_RELAXED, __HIP_MEMORY_SCOPE_AGENT
__device__ __forceinline__ unsigned f2bf(float f) { unsigned u = __builtin_bit_cast(unsigned, f); return (u + 0x7fffu + ((u >> 16) & 1u)) >> 16; }
__device__ __forceinline__ unsigned pk2(float lo, float hi) { return f2bf(lo) | (f2bf(hi) << 16); }
__device__ __forceinline__ float bflo(unsigned w) { return __uint_as_float(w << 16); }
__device__ __forceinline__ float bfhi(unsigned w) { return __uint_as_float(w & 0xffff0000u); }
__device__ __forceinline__ float bf1(bf16 h) { return __uint_as_float(((unsigned)h) << 16); }
__device__ __forceinline__ float sigm(float x) { return 1.0f / (1.0f + __expf(-x)); }
__device__ __forceinline__ float siluf(float x) { return x / (1.0f + __expf(-x)); }
__device__ __forceinline__ float wave_sum(float v) {
#pragma unroll
    for (int o = 1; o < 64; o <<= 1) v += __shfl_xor(v, o);
    return v;
}
__device__ __forceinline__ float wave_max(float v) {
#pragma unroll
    for (int o = 1; o < 64; o <<= 1) v = fmaxf(v, __shfl_xor(v, o));
    return v;
}
__device__ __forceinline__ int wave_sum_i(int v) {
#pragma unroll
    for (int o = 1; o < 64; o <<= 1) v += __shfl_xor(v, o);
    return v;
}
__device__ __forceinline__ void unpack8(const v4u w, float (&f)[8]) { f[0] = bflo(w.x); f[1] = bfhi(w.x); f[2] = bflo(w.y); f[3] = bfhi(w.y); f[4] = bflo(w.z); f[5] = bfhi(w.z); f[6] = bflo(w.w); f[7] = bfhi(w.w); }
__device__ __forceinline__ v4u pack8f(const float (&f)[8]) { v4u w; w.x = pk2(f[0], f[1]); w.y = pk2(f[2], f[3]); w.z = pk2(f[4], f[5]); w.w = pk2(f[6], f[7]); return w; }

#define XB_TMO      128
#define XB_XCNT(j)  (256  + 64 * (j))
#define XB_XSUB(j)  (1280 + 64 * (j))
#define XB_XGEN(j)  (2304 + 64 * (j))
#define XB_TOP      3328
#define XB_TOPGEN   3392
#define XCD_BAR_WORDS 3456
#define XB_SPIN_CAP (1u << 18)

__device__ __forceinline__ unsigned xb_ld(unsigned* p)              { return __hip_atomic_load(p, __ATOMIC_RELAXED, __HIP_MEMORY_SCOPE_AGENT); }
__device__ __forceinline__ unsigned xb_add(unsigned* p, unsigned v) { return __hip_atomic_fetch_add(p, v, __ATOMIC_RELAXED, __HIP_MEMORY_SCOPE_AGENT); }
__device__ __forceinline__ unsigned xb_xcc_id() { return (unsigned)__builtin_amdgcn_s_getreg((3 << 11) | 20) & 0xFu; }
#define XB_SPIN(cond, bar) do { unsigned _sp = 0; while (cond) { __builtin_amdgcn_s_sleep(1); \
    if ((++_sp & 255u) == 0u) { if (xb_ld(&(bar)[XB_TMO])) break; if (_sp > XB_SPIN_CAP) { atomicAdd(&(bar)[XB_TMO], 1u); break; } } } } while (0)

struct XcdBarrier {
    unsigned* bar; unsigned x;
    volatile LAS unsigned* st;
};

__device__ __forceinline__ XcdBarrier xcd_barrier_post(unsigned* bar, volatile LAS unsigned* st) {
    XcdBarrier b; b.bar = bar; b.x = xb_xcc_id(); b.st = st;
    if (threadIdx.x == 0) (void)xb_add(&bar[XB_XCNT(b.x)], 1u);
    return b;
}
__device__ __forceinline__ void xcd_barrier_complete(unsigned* bar, unsigned x, unsigned& nloc, unsigned& nx) {
    const unsigned G = gridDim.x * gridDim.y * gridDim.z;
    unsigned sum, cnt, mine, sp = 0u;
    for (;;) {
        sum = 0u; cnt = 0u; mine = 0u;
#pragma unroll
        for (unsigned j = 0; j < 16; ++j) { const unsigned c = xb_ld(&bar[XB_XCNT(j)]); sum += c; cnt += (c > 0u) ? 1u : 0u; mine = (j == x) ? c : mine; }
        if (sum == G) break;
        __builtin_amdgcn_s_sleep(1);
        if ((++sp & 255u) == 0u) { if (xb_ld(&bar[XB_TMO])) break; if (sp > XB_SPIN_CAP) { atomicAdd(&bar[XB_TMO], 1u); break; } }
    }
    nloc = mine > 0u ? mine : 1u; nx = cnt > 0u ? cnt : 1u;
}

__device__ __forceinline__ void xcd_barrier(const XcdBarrier& b) {
    asm volatile("s_waitcnt vmcnt(0)" ::: "memory");
    __syncthreads();
    if (threadIdx.x == 0) {
        unsigned* bar = b.bar;
        __builtin_amdgcn_s_waitcnt(0);
        unsigned nloc = b.st[0], nx = b.st[1];
        if (nloc == 0u) { xcd_barrier_complete(bar, b.x, nloc, nx); b.st[0] = nloc; b.st[1] = nx; }
        const unsigned old = xb_add(&bar[XB_XSUB(b.x)], 1u);
        const unsigned gen = old / nloc;
        if (old + 1u == (gen + 1u) * nloc) {
            __builtin_amdgcn_fence(__ATOMIC_RELEASE, "agent");
            asm volatile("s_waitcnt vmcnt(0)" ::: "memory");
            const unsigned og = xb_add(&bar[XB_TOP], 1u);
            const unsigned tg = og / nx;
            if (og + 1u == (tg + 1u) * nx) xb_add(&bar[XB_TOPGEN], 1u);
            else XB_SPIN(xb_ld(&bar[XB_TOPGEN]) == tg, bar);
            __builtin_amdgcn_fence(__ATOMIC_ACQUIRE, "agent");
            xb_add(&bar[XB_XGEN(b.x)], 1u);
            asm volatile("s_waitcnt vmcnt(0)" ::: "memory");
        } else {
            XB_SPIN(xb_ld(&bar[XB_XGEN(b.x)]) == gen, bar);
            __builtin_amdgcn_fence(__ATOMIC_ACQUIRE, "agent");
            asm volatile("s_waitcnt vmcnt(0)" ::: "memory");
        }
    }
    __syncthreads();
}

struct Args { const float* in[N_IN]; float* out; unsigned char* ws; int ph_lo, ph_hi, li, pad; };
typedef const __attribute__((address_space(4))) Args* KArgs;
__device__ __forceinline__ KArgs kargs() { auto p = __builtin_amdgcn_kernarg_segment_ptr(); asm volatile("" : "+s"(p)); return (KArgs)p; }
struct Frame {
    LAS unsigned char* lds;
    int tid, lane, wave, G, bid;
    unsigned char* ws;
    gu32* ctl;
};
#define WSP(T, off) ((T*)(F.ws + (off)))

struct MapId { __device__ __forceinline__ int operator()(int n) const { return n; } };
struct MapAdd { int off; __device__ __forceinline__ int operator()(int n) const { return n + off; } };
struct MapAB { __device__ __forceinline__ int operator()(int n) const { return n < 456 ? n : (n < 2504 ? n + 56 : n - 2048); } };
template <class Map> __device__ __forceinline__ void wg_transpose_item(const float* W, int N, int ldw, bf16* WT, int ldt, int koff, Map map, LAS float* scr, int item, int tid) {
    const int nblk = (N + 127) >> 7, kb = item / nblk, nb = item - kb * nblk, k0 = kb * 128, n0 = nb * 128;
#pragma unroll
    for (int it = 0; it < 8; ++it) {
        const int row = it * 16 + (tid >> 5), c4 = (tid & 31) * 4, n = n0 + c4;
        f32x4 v = (f32x4){0.f, 0.f, 0.f, 0.f};
        if (n + 3 < N) v = *(const f32x4*)(W + (size_t)(k0 + row) * ldw + n);
        LAS float* s = scr + row * 129 + c4; s[0] = v[0]; s[1] = v[1]; s[2] = v[2]; s[3] = v[3];
    }
    __syncthreads();
#pragma unroll
    for (int j = 0; j < 4; ++j) {
        const int idx = j * 512 + tid, nl = idx >> 4, ch = idx & 15, n = n0 + nl;
        if (n < N) { const LAS float* s = scr + (ch * 8) * 129 + nl;
            v4u o; o.x = pk2(s[0], s[129]); o.y = pk2(s[2 * 129], s[3 * 129]); o.z = pk2(s[4 * 129], s[5 * 129]); o.w = pk2(s[6 * 129], s[7 * 129]);
            *(v4u*)(WT + (size_t)map(n) * ldt + koff + k0 + ch * 8) = o; }
    }
    __syncthreads();
}
__device__ __forceinline__ void wg_transpose_item_fp8(const float* W, int N, int ldw, unsigned char* WT, int ldt, float mul, LAS float* scr, int item, int tid) {
    const int nblk = (N + 127) >> 7, kb = item / nblk, nb = item - kb * nblk, k0 = kb * 128, n0 = nb * 128;
#pragma unroll
    for (int it = 0; it < 8; ++it) {
        const int row = it * 16 + (tid >> 5), c4 = (tid & 31) * 4;
        const f32x4 v = *(const f32x4*)(W + (size_t)(k0 + row) * ldw + n0 + c4);
        LAS float* s = scr + row * 129 + c4; s[0] = v[0]; s[1] = v[1]; s[2] = v[2]; s[3] = v[3];
    }
    __syncthreads();
#pragma unroll
    for (int j = 0; j < 2; ++j) {
        const int idx = j * 512 + tid, nl = idx >> 3, ch = idx & 7;
        const LAS float* s = scr + (ch * 16) * 129 + nl;
        v4u o;
#pragma unroll
        for (int q = 0; q < 4; ++q) { unsigned w = 0u;
            w = __builtin_amdgcn_cvt_pk_fp8_f32(s[(4 * q) * 129] * mul, s[(4 * q + 1) * 129] * mul, w, false);
            w = __builtin_amdgcn_cvt_pk_fp8_f32(s[(4 * q + 2) * 129] * mul, s[(4 * q + 3) * 129] * mul, w, true);
            o[q] = w; }
        *(v4u*)(WT + (size_t)(n0 + nl) * ldt + k0 + ch * 16) = o;
    }
    __syncthreads();
}
struct MoeItem { const float* W; unsigned char* WT; int N; float mul; int k0, n0; };
__device__ __forceinline__ MoeItem moe_item(KArgs A, unsigned char* ws, int it) {
    MoeItem d; int sub;
    if (it < 64 * 128) { const int m = it >> 7; sub = it & 127; d.W = A->in[I_WGU] + (size_t)m * 1024 * 2048; d.N = 2048; d.WT = ws + WS_W_GU + (size_t)m * 2048 * 1024; d.mul = 64.0f; }
    else { it -= 64 * 128; const int m = it >> 6; sub = it & 63; d.W = A->in[I_WDN] + (size_t)m * 1024 * 1024; d.N = 1024; d.WT = ws + WS_W_DN + (size_t)m * 1024 * 1024; d.mul = 128.0f; }
    const int nblk = d.N >> 7, kb = sub / nblk, nb = sub - kb * nblk; d.k0 = kb * 128; d.n0 = nb * 128; return d;
}
__device__ __forceinline__ void p0_moe_fp8(Frame& F, KArgs A) {
    LAS float* scr = (LAS float*)(F.lds + RING_OFF);
    const int tid = F.tid; constexpr int NIT = 64 * 128 + 64 * 64;
    int it = F.bid; if (it >= NIT) return;
    MoeItem cur = moe_item(A, F.ws, it);
    f32x4 r[8];
#pragma unroll
    for (int x = 0; x < 8; ++x) r[x] = *(const f32x4*)(cur.W + (size_t)(cur.k0 + x * 16 + (tid >> 5)) * cur.N + cur.n0 + (tid & 31) * 4);
    for (;;) {
#pragma unroll
        for (int x = 0; x < 8; ++x) { LAS float* sp = scr + (x * 16 + (tid >> 5)) * 129 + (tid & 31) * 4; sp[0] = r[x][0]; sp[1] = r[x][1]; sp[2] = r[x][2]; sp[3] = r[x][3]; }
        __syncthreads();
        const int nx = it + F.G; MoeItem nxt = cur;
        if (nx < NIT) { nxt = moe_item(A, F.ws, nx);
#pragma unroll
            for (int x = 0; x < 8; ++x) r[x] = *(const f32x4*)(nxt.W + (size_t)(nxt.k0 + x * 16 + (tid >> 5)) * nxt.N + nxt.n0 + (tid & 31) * 4); }
#pragma unroll
        for (int j = 0; j < 2; ++j) {
            const int idx = j * 512 + tid, nl = idx >> 3, ch = idx & 7;
            const LAS float* sp = scr + (ch * 16) * 129 + nl;
            v4u o;
#pragma unroll
            for (int q = 0; q < 4; ++q) { unsigned w = 0u;
                w = __builtin_amdgcn_cvt_pk_fp8_f32(sp[(4 * q) * 129] * cur.mul, sp[(4 * q + 1) * 129] * cur.mul, w, false);
                w = __builtin_amdgcn_cvt_pk_fp8_f32(sp[(4 * q + 2) * 129] * cur.mul, sp[(4 * q + 3) * 129] * cur.mul, w, true);
                o[q] = w; }
            *(v4u*)(cur.WT + (size_t)(cur.n0 + nl) * 1024 + cur.k0 + ch * 16) = o;
        }
        __syncthreads();
        if (nx >= NIT) break;
        cur = nxt; it = nx;
    }
}
__device__ __forceinline__ void p0_prologue(Frame& F, KArgs A) {
    LAS float* scr = (LAS float*)(F.lds + RING_OFF);
    const int tid = F.tid;
    constexpr int IT_GU = 128, IT_DN = 64;
    constexpr int N_GU = 64 * IT_GU, N_DN = 64 * IT_DN;
    constexpr int N_INAB = 8 * 20, N_INCD = 8 * 20, N_OUTCD = 64, N_PG = 2 * 64, N_PP = 2 * 2 * 8, N_QIDX = 2 * 4, N_OUTB = 4 * 8;
    constexpr int NITEMS = N_GU + N_DN + N_INAB + N_INCD + N_OUTCD + N_PG + N_PP + N_QIDX + N_OUTB;
    if (kMoeFp8) p0_moe_fp8(F, A);
    for (int it = F.bid + (kMoeFp8 ? N_GU + N_DN : 0); it < NITEMS; it += F.G) {
        int r = it;
        if (r < N_GU) { const int m = r / IT_GU;
            if (kMoeFp8) wg_transpose_item_fp8(A->in[I_WGU] + (size_t)m * 1024 * 2048, 2048, 2048, WSP(unsigned char, WS_W_GU) + (size_t)m * 2048 * 1024, 1024, 64.0f, scr, r % IT_GU, tid);
            else wg_transpose_item(A->in[I_WGU] + (size_t)m * 1024 * 2048, 2048, 2048, WSP(bf16, WS_W_GU) + (size_t)m * 2048 * 1024, 1024, 0, MapId{}, scr, r % IT_GU, tid);
            continue; } r -= N_GU;
        if (r < N_DN) { const int m = r / IT_DN;
            if (kMoeFp8) wg_transpose_item_fp8(A->in[I_WDN] + (size_t)m * 1024 * 1024, 1024, 1024, WSP(unsigned char, WS_W_DN) + (size_t)m * 1024 * 1024, 1024, 128.0f, scr, r % IT_DN, tid);
            else wg_transpose_item(A->in[I_WDN] + (size_t)m * 1024 * 1024, 1024, 1024, WSP(bf16, WS_W_DN) + (size_t)m * 1024 * 1024, 1024, 0, MapId{}, scr, r % IT_DN, tid);
            continue; } r -= N_DN;
        if (r < N_INAB) { wg_transpose_item(A->in[I_AB_WIN], 2512, 2512, WSP(bf16, WS_W_INAB), 1024, 0, MapAB{}, scr, r, tid); continue; } r -= N_INAB;
        if (r < N_INCD) { wg_transpose_item(A->in[I_CD_WIN], 2560, 2560, WSP(bf16, WS_W_INCD), 1024, 0, MapId{}, scr, r, tid); continue; } r -= N_INCD;
        if (r < N_OUTCD) { wg_transpose_item(A->in[I_CD_WOUT], 1024, 1024, WSP(bf16, WS_W_OUTCD), 1024, 0, MapId{}, scr, r, tid); continue; } r -= N_OUTCD;
        if (r < N_PG) { const int l = r / 64; wg_transpose_item(A->in[I_PLE_WG] + (size_t)l * 1024 * 1024, 1024, 1024, WSP(bf16, WS_W_PG) + (size_t)l * 1024 * 1024, 1024, 0, MapId{}, scr, r % 64, tid); continue; } r -= N_PG;
        if (r < N_PP) { const int l = r / 16; wg_transpose_item(A->in[I_PLE_WP] + (size_t)l * 256 * 1024, 1024, 1024, WSP(bf16, WS_W_PP) + (size_t)l * 1024 * 256, 256, 0, MapId{}, scr, r % 16, tid); continue; } r -= N_PP;
        if (r < N_QIDX) { wg_transpose_item(A->in[I_AB_WQIDX], 512, 512, WSP(bf16, WS_W_ABS), 256, 0, MapAdd{1024}, scr, r, tid); continue; } r -= N_QIDX;
        wg_transpose_item(A->in[I_AB_WOUT] + (size_t)512 * 1024, 1024, 1024, WSP(bf16, WS_W_OUTAB), 1536, 1024, MapId{}, scr, r, tid);
    }
    const size_t gt = (size_t)F.bid * NTHREADS + tid, GT = (size_t)F.G * NTHREADS;
    for (size_t i = gt; i < (size_t)48 * 1024 / 8; i += GT) *(v4u*)(WSP(bf16, WS_W_INAB) + (size_t)464 * 1024 + i * 8) = (v4u){0u, 0u, 0u, 0u};
    for (size_t i = gt; i < (size_t)1024 * 256; i += GT) {
        const int n = (int)(i >> 8), c = (int)(i & 255), h = n >> 7, r = n & 127;
        const float* a = A->in[I_AB_WUQ] + (size_t)c * 512 + h * 64; const float* b = A->in[I_AB_WUK] + (size_t)r * 512 + h * 64;
        float s = 0.f;
#pragma unroll 8
        for (int d = 0; d < 64; d += 4) { const f32x4 x = *(const f32x4*)(a + d), y = *(const f32x4*)(b + d); s += x[0] * y[0] + x[1] * y[1] + x[2] * y[2] + x[3] * y[3]; }
        WSP(bf16, WS_W_ABS)[i] = (bf16)f2bf(s * 0.125f);
    }
    for (size_t i = gt; i < (size_t)1024 * 1024; i += GT) {
        const int n = (int)(i >> 10), k = (int)(i & 1023), h = k >> 7, r = k & 127;
        const float* a = A->in[I_AB_WUV] + (size_t)r * 512 + h * 64; const float* b = A->in[I_AB_WOUT] + (size_t)(h * 64) * 1024 + n;
        float s = 0.f;
#pragma unroll 8
        for (int v = 0; v < 64; ++v) s += a[v] * b[(size_t)v * 1024];
        WSP(bf16, WS_W_OUTAB)[(size_t)n * 1536 + k] = (bf16)f2bf(s);
    }
    for (size_t i = gt; i < (size_t)M * D / 8; i += GT) { const f32x4 a = *(const f32x4*)(A->in[I_X] + i * 8), b = *(const f32x4*)(A->in[I_X] + i * 8 + 4);
        v4u o; o.x = pk2(a[0], a[1]); o.y = pk2(a[2], a[3]); o.z = pk2(b[0], b[1]); o.w = pk2(b[2], b[3]); *(v4u*)(WSP(bf16, WS_XB) + i * 8) = o; }
    for (size_t i = gt; i < (size_t)2 * M * 256 / 8; i += GT) { const f32x4 a = *(const f32x4*)(A->in[I_P] + i * 8), b = *(const f32x4*)(A->in[I_P] + i * 8 + 4);
        v4u o; o.x = pk2(a[0], a[1]); o.y = pk2(a[2], a[3]); o.z = pk2(b[0], b[1]); o.w = pk2(b[2], b[3]); *(v4u*)(WSP(bf16, WS_PB) + i * 8) = o; }
}

__device__ __forceinline__ void p2_prep(Frame& F, KArgs A) {
    const int lane = F.lane, gw = F.bid * NWAVES + F.wave, NGW = F.G * NWAVES;
    const float* SM = WSP(float, WS_SM); const bf16* QZ = WSP(bf16, WS_QKVZ);
    const f32x4 qg = *(const f32x4*)(A->in[I_AB_QG] + 4 * lane);
    const f32x4 kvg = *(const f32x4*)(A->in[I_AB_KVG] + 4 * (lane & 31));
    const f32x4 kig = *(const f32x4*)(A->in[I_AB_KIG] + 4 * (lane & 15)), kib = *(const f32x4*)(A->in[I_AB_KIB] + 4 * (lane & 15));
    const f32x4 alog = *(const f32x4*)(A->in[I_AB_ALOG]), dtb = *(const f32x4*)(A->in[I_AB_DTB]);
    for (int row = gw; row < M; row += NGW) {
        const int t = row & (SEQ - 1);
        const f32x4 a = *(const f32x4*)(SM + (size_t)row * 512 + 4 * lane), b = *(const f32x4*)(SM + (size_t)row * 512 + 256 + 4 * lane);
        {
            const float ss = wave_sum(a[0] * a[0] + a[1] * a[1] + a[2] * a[2] + a[3] * a[3]);
            const float r = rsqrtf(ss * (1.0f / 256.0f) + 1e-6f);
            v2u o; o.x = pk2(a[0] * r * qg[0], a[1] * r * qg[1]); o.y = pk2(a[2] * r * qg[2], a[3] * r * qg[3]);
            *(v2u*)(WSP(bf16, WS_CQ) + (size_t)row * 256 + 4 * lane) = o;
        }
        {
            const float ss = wave_sum(lane < 32 ? (b[0] * b[0] + b[1] * b[1] + b[2] * b[2] + b[3] * b[3]) : 0.f);
            const float r = rsqrtf(ss * (1.0f / 128.0f) + 1e-6f);
            if (lane < 32) { v2u o; o.x = pk2(b[0] * r * kvg[0], b[1] * r * kvg[1]); o.y = pk2(b[2] * r * kvg[2], b[3] * r * kvg[3]);
                *(v2u*)(WSP(bf16, WS_CKV) + (size_t)row * 128 + 4 * lane) = o; }
        }
        {
            const bool in = (lane >= 32 && lane < 48);
            const float mean = wave_sum(in ? (b[0] + b[1] + b[2] + b[3]) : 0.f) * (1.0f / 64.0f);
            const f32x4 d = b - mean;
            const float var = wave_sum(in ? (d[0] * d[0] + d[1] * d[1] + d[2] * d[2] + d[3] * d[3]) : 0.f) * (1.0f / 64.0f);
            const float r = rsqrtf(var + 1e-5f);
            if (in) { v2u o; o.x = pk2(d[0] * r * kig[0] + kib[0], d[1] * r * kig[1] + kib[1]); o.y = pk2(d[2] * r * kig[2] + kib[2], d[3] * r * kig[3] + kib[3]);
                *(v2u*)(WSP(bf16, WS_KIDX) + (size_t)row * 64 + 4 * (lane - 32)) = o; }
        }
        if (lane == 48 || lane == 49) *(f32x4*)(WSP(float, WS_WIDX) + (size_t)row * 8 + 4 * (lane - 48)) = b * 0.044194173824159216f;
        if (lane == 50) { f32x4 o; o[0] = sigm(b[0]); o[1] = sigm(b[1]); o[2] = sigm(b[2]); o[3] = sigm(b[3]); *(f32x4*)(WSP(float, WS_BETA) + (size_t)row * 4) = o; }
        if (lane == 51) { f32x4 o;
#pragma unroll
            for (int h = 0; h < 4; ++h) { const float xx = b[h] + dtb[h]; const float sp = xx > 20.f ? xx : log1pf(__expf(xx)); o[h] = -__expf(alog[h]) * sp; }
            *(f32x4*)(WSP(float, WS_GG) + (size_t)row * 4) = o; }
#pragma unroll
        for (int sel = 0; sel < 3; ++sel) {
            const int col0 = sel * 512 + 8 * lane;
            float acc[8];
#pragma unroll
            for (int i = 0; i < 8; ++i) acc[i] = 0.f;
#pragma unroll
            for (int j = 0; j < 4; ++j) {
                if (t - 3 + j >= 0) {
                    const v4u xr = *(const v4u*)(QZ + (size_t)(row - 3 + j) * 2048 + col0); float xv[8]; unpack8(xr, xv);
                    const f32x4 w0 = *(const f32x4*)(A->in[I_AB_CONVW] + (size_t)j * 1536 + col0), w1 = *(const f32x4*)(A->in[I_AB_CONVW] + (size_t)j * 1536 + col0 + 4);
#pragma unroll
                    for (int i = 0; i < 4; ++i) { acc[i] += w0[i] * xv[i]; acc[4 + i] += w1[i] * xv[4 + i]; }
                }
            }
            float ss = 0.f;
#pragma unroll
            for (int i = 0; i < 8; ++i) { acc[i] = siluf(acc[i]); ss += acc[i] * acc[i]; }
            if (sel < 2) {
                ss += __shfl_xor(ss, 1); ss += __shfl_xor(ss, 2); ss += __shfl_xor(ss, 4); ss += __shfl_xor(ss, 8);
                const float sc = rsqrtf(ss + 1e-6f) * (sel == 0 ? 0.08838834764831845f : 1.0f);
#pragma unroll
                for (int i = 0; i < 8; ++i) acc[i] *= sc;
            }
            bf16* dst = (sel == 0 ? WSP(bf16, WS_QN) : (sel == 1 ? WSP(bf16, WS_KN) : WSP(bf16, WS_VN))) + (size_t)row * 512 + 8 * lane;
            *(v4u*)dst = pack8f(acc);
        }
    }
}

__device__ __forceinline__ void p3_chunk_prep(Frame& F, KArgs A) {
    int tid = F.tid; asm volatile("" : "+v"(tid));
    const int lane = tid & 63;
    constexpr int P = 132;
    LAS float* qs = (LAS float*)(F.lds); LAS float* ks = qs + 64 * P; LAS float* vs = ks + 64 * P;
    LAS float* As = vs + 64 * P;
    LAS float* gcS = As + 64 * 65; LAS float* egS = gcS + 64; LAS float* ekS = egS + 64; LAS float* btS = ekS + 64;
    LAS float* Ts = qs;
    for (int cidx = F.bid; cidx < 1024; cidx += F.G) {
        const int b = cidx >> 9, h = (cidx >> 7) & 3, n = cidx & 127, row0 = b * SEQ + n * 64;
        unsigned char* blk = F.ws + WS_CHK + (size_t)cidx * CHK_STRIDE;
        if (tid < 64) {
            const float g = WSP(float, WS_GG)[(size_t)(row0 + tid) * 4 + h];
            float gc = g;
#pragma unroll
            for (int o = 1; o < 64; o <<= 1) { const float t = __shfl_up(gc, o); if (lane >= o) gc += t; }
            const float g63 = __shfl(gc, 63);
            gcS[tid] = gc; egS[tid] = __expf(gc); ekS[tid] = __expf(g63 - gc); btS[tid] = WSP(float, WS_BETA)[(size_t)(row0 + tid) * 4 + h];
            if (tid == 0) *(float*)(blk + CHK_GL) = __expf(g63);
        }
#pragma unroll
        for (int i = 0; i < 2; ++i) {
            const int id = tid + 512 * i, r = id >> 4, c8 = (id & 15) * 8; const size_t so = (size_t)(row0 + r) * 512 + h * 128 + c8;
            float f[8];
            unpack8(*(const v4u*)(WSP(bf16, WS_QN) + so), f);
            *(LAS f32x4*)(qs + r * P + c8) = (f32x4){f[0], f[1], f[2], f[3]}; *(LAS f32x4*)(qs + r * P + c8 + 4) = (f32x4){f[4], f[5], f[6], f[7]};
            unpack8(*(const v4u*)(WSP(bf16, WS_KN) + so), f);
            *(LAS f32x4*)(ks + r * P + c8) = (f32x4){f[0], f[1], f[2], f[3]}; *(LAS f32x4*)(ks + r * P + c8 + 4) = (f32x4){f[4], f[5], f[6], f[7]};
            unpack8(*(const v4u*)(WSP(bf16, WS_VN) + so), f);
            *(LAS f32x4*)(vs + r * P + c8) = (f32x4){f[0], f[1], f[2], f[3]}; *(LAS f32x4*)(vs + r * P + c8 + 4) = (f32x4){f[4], f[5], f[6], f[7]};
        }
        __syncthreads();
        {
            const int i = tid >> 3, t7 = tid & 7;
            float aK[8], aQ[8];
#pragma unroll
            for (int x = 0; x < 8; ++x) { aK[x] = 0.f; aQ[x] = 0.f; }
#pragma unroll 1
            for (int d = 0; d < 128; d += 4) {
                const f32x4 ki = *(const LAS f32x4*)(ks + i * P + d), qi = *(const LAS f32x4*)(qs + i * P + d);
#pragma unroll
                for (int x = 0; x < 8; ++x) { const f32x4 kj = *(const LAS f32x4*)(ks + (t7 + 8 * x) * P + d);
                    aK[x] += ki[0] * kj[0] + ki[1] * kj[1] + ki[2] * kj[2] + ki[3] * kj[3]; aQ[x] += qi[0] * kj[0] + qi[1] * kj[1] + qi[2] * kj[2] + qi[3] * kj[3]; }
            }
            const float gci = gcS[i], bti = btS[i];
            bf16* QKp = (bf16*)(blk + CHK_QK) + i * 64;
#pragma unroll
            for (int x = 0; x < 8; ++x) { const int j = t7 + 8 * x; const float dec = __expf(j <= i ? gci - gcS[j] : 0.f);
                As[i * 65 + j] = (j < i) ? bti * aK[x] * dec : 0.f;
                QKp[32 * (j >> 5) + 8 * ((j >> 2) & 3) + 4 * ((j >> 4) & 1) + (j & 3)] = (bf16)f2bf((j <= i) ? aQ[x] * dec : 0.f); }
        }
        {
            const int i = tid >> 3, d0 = (tid & 7) * 16, s = d0 >> 5, a = (d0 >> 4) & 1; const float e = egS[i];
            bf16* Qd = (bf16*)(blk + CHK_QD) + i * 128;
#pragma unroll
            for (int q = 0; q < 4; ++q) { const f32x4 p = *(const LAS f32x4*)(qs + i * P + d0 + 4 * q); v2u w; w.x = pk2(p[0] * e, p[1] * e); w.y = pk2(p[2] * e, p[3] * e); *(v2u*)(Qd + 32 * s + 8 * q + 4 * a) = w; }
        }
        {
            const int d = tid >> 2, c0 = (tid & 3) * 16, s = c0 >> 5, a = (c0 >> 4) & 1;
            bf16* Kd = (bf16*)(blk + CHK_KDT) + d * 64;
#pragma unroll
            for (int q = 0; q < 4; ++q) { const int c = c0 + 4 * q;
                v2u w; w.x = pk2(ks[c * P + d] * ekS[c], ks[(c + 1) * P + d] * ekS[c + 1]); w.y = pk2(ks[(c + 2) * P + d] * ekS[c + 2], ks[(c + 3) * P + d] * ekS[c + 3]);
                *(v2u*)(Kd + 32 * s + 8 * q + 4 * a) = w; }
        }
        __syncthreads();
        {
            const int c = tid >> 3, part = tid & 7;
            for (int i = 0; i < 64; ++i) {
                float acc = 0.f;
                for (int j = part; j < i; j += 8) acc += As[i * 65 + j] * Ts[j * 65 + c];
                acc += __shfl_xor(acc, 1); acc += __shfl_xor(acc, 2); acc += __shfl_xor(acc, 4);
                if (part == 0) Ts[i * 65 + c] = ((i == c) ? 1.f : 0.f) - acc;
                __builtin_amdgcn_fence(__ATOMIC_RELEASE, "wavefront"); asm volatile("s_waitcnt lgkmcnt(0)" ::: "memory");
            }
        }
        __syncthreads();
        {
            const int i = tid >> 3, t7 = tid & 7;
            f32x4 aU[4], aW[4];
#pragma unroll
            for (int xx = 0; xx < 4; ++xx) { aU[xx] = (f32x4){0.f, 0.f, 0.f, 0.f}; aW[xx] = (f32x4){0.f, 0.f, 0.f, 0.f}; }
#pragma unroll 1
            for (int j = 0; j <= i; ++j) {
                const float tb = Ts[i * 65 + j] * btS[j], tbe = tb * egS[j];
#pragma unroll
                for (int xx = 0; xx < 4; ++xx) { aU[xx] += *(const LAS f32x4*)(vs + j * P + 4 * t7 + 32 * xx) * tb; aW[xx] += *(const LAS f32x4*)(ks + j * P + 4 * t7 + 32 * xx) * tbe; }
            }
            float* UT = (float*)(blk + CHK_UT);
            bf16* Wp = (bf16*)(blk + CHK_WP) + i * 128;
#pragma unroll
            for (int xx = 0; xx < 4; ++xx) {
                const int c = 4 * t7 + 32 * xx;
#pragma unroll
                for (int e = 0; e < 4; ++e) UT[(c + e) * 64 + i] = aU[xx][e];
                v2u w; w.x = pk2(aW[xx][0], aW[xx][1]); w.y = pk2(aW[xx][2], aW[xx][3]); *(v2u*)(Wp + 32 * xx + 8 * (t7 & 3) + 4 * (t7 >> 2)) = w;
            }
        }
        __syncthreads();
    }
}

constexpr int SEQ_WGS = 16;
constexpr int SQ_WP = 0, SQ_QD = 16384, SQ_KDT = 32768, SQ_QK = 49152, SQ_BUF = 57344;
__device__ __forceinline__ bf16x8 packfrag(const f32x4 lo, const f32x4 hi) { v4u w; w.x = pg8::cvt_pk_bf16(lo[0], lo[1]); w.y = pg8::cvt_pk_bf16(lo[2], lo[3]); w.z = pg8::cvt_pk_bf16(hi[0], hi[1]); w.w = pg8::cvt_pk_bf16(hi[2], hi[3]); return __builtin_bit_cast(bf16x8, w); }
__device__ __forceinline__ void seq_stage(LAS unsigned char* buf, const unsigned char* blk, int lt) {
    v4u r[14];
#pragma unroll
    for (int i = 0; i < 14; ++i) r[i] = *(const v4u*)(blk + (size_t)(lt + 256 * i) * 16);
#pragma unroll
    for (int i = 0; i < 14; ++i) {
        const int id = lt + 256 * i; int dst;
        if (id < 2048) { const int rr = (id & 1023) >> 4, ch = id & 15; dst = (id & ~1023) * 16 + rr * 256 + 16 * (ch ^ (rr & 15)); }
        else { const int rr = (id - 2048) >> 3, ch = id & 7; dst = 32768 + rr * 128 + 16 * (ch ^ (rr & 7)); }
        *(LAS v4u*)(buf + dst) = r[i];
    }
}
__device__ __forceinline__ void p4_delta_seq(Frame& F, int sid) {
    const int lane = F.lane, wave = F.wave, tid = F.tid;
    const int bh = sid >> 1, half = sid & 1, b = bh >> 2, h = bh & 3;
    const int fr = lane & 15, fq = lane >> 4;
    const int v0 = half * 64 + (wave & 3) * 16;
    const unsigned char* cbase = F.ws + WS_CHK + (size_t)(bh * 128) * CHK_STRIDE;
    float* OD = WSP(float, WS_ODELTA);
    f32x4 Sacc[8];
#pragma unroll
    for (int T = 0; T < 8; ++T) Sacc[T] = (f32x4){0.f, 0.f, 0.f, 0.f};
    if (wave >= 4) seq_stage(F.lds, cbase, tid - 256);
    __syncthreads();
    for (int n = 0; n < 128; ++n) {
        LAS unsigned char* buf = F.lds + (n & 1) * SQ_BUF;
        if (wave >= 4) { if (n + 1 < 128) seq_stage(F.lds + ((n + 1) & 1) * SQ_BUF, cbase + (size_t)(n + 1) * CHK_STRIDE, tid - 256); }
        else {
            const unsigned char* blk = cbase + (size_t)n * CHK_STRIDE;
            const float gl = *(const float*)(blk + CHK_GL);
            const float* UT = (const float*)(blk + CHK_UT) + (size_t)(v0 + fr) * 64 + 4 * fq;
            f32x4 U[4];
#pragma unroll
            for (int tc = 0; tc < 4; ++tc) U[tc] = *(const f32x4*)(UT + 16 * tc);
            bf16x8 sf[4];
#pragma unroll
            for (int s = 0; s < 4; ++s) sf[s] = packfrag(Sacc[2 * s], Sacc[2 * s + 1]);
            f32x4 Vn[4], Oa[4];
#pragma unroll
            for (int tc = 0; tc < 4; ++tc) {
                const int rr = 16 * tc + fr; f32x4 av = (f32x4){0.f, 0.f, 0.f, 0.f}, ao = (f32x4){0.f, 0.f, 0.f, 0.f};
#pragma unroll
                for (int s = 0; s < 4; ++s) {
                    const int off = rr * 256 + 16 * ((4 * s + fq) ^ (rr & 15));
                    const bf16x8 wf = *(const LAS bf16x8*)(buf + SQ_WP + off), qf = *(const LAS bf16x8*)(buf + SQ_QD + off);
                    av = __builtin_amdgcn_mfma_f32_16x16x32_bf16(wf, sf[s], av, 0, 0, 0);
                    ao = __builtin_amdgcn_mfma_f32_16x16x32_bf16(qf, sf[s], ao, 0, 0, 0);
                }
                Vn[tc] = U[tc] - av; Oa[tc] = ao;
            }
            bf16x8 vf[2];
            vf[0] = packfrag(Vn[0], Vn[1]); vf[1] = packfrag(Vn[2], Vn[3]);
#pragma unroll
            for (int tc = 0; tc < 4; ++tc) {
                const int rr = 16 * tc + fr;
#pragma unroll
                for (int s = 0; s < 2; ++s) {
                    const bf16x8 kf = *(const LAS bf16x8*)(buf + SQ_QK + rr * 128 + 16 * ((4 * s + fq) ^ (rr & 7)));
                    Oa[tc] = __builtin_amdgcn_mfma_f32_16x16x32_bf16(kf, vf[s], Oa[tc], 0, 0, 0);
                }
                float* op = OD + (size_t)(b * SEQ + n * 64 + 16 * tc + 4 * fq) * 512 + h * 128 + v0 + fr;
#pragma unroll
                for (int j = 0; j < 4; ++j) op[(size_t)j * 512] = Oa[tc][j];
            }
#pragma unroll
            for (int T = 0; T < 8; ++T) {
                const int rr = 16 * T + fr; f32x4 a = Sacc[T] * gl;
#pragma unroll
                for (int s = 0; s < 2; ++s) {
                    const bf16x8 kf = *(const LAS bf16x8*)(buf + SQ_KDT + rr * 128 + 16 * ((4 * s + fq) ^ (rr & 7)));
                    a = __builtin_amdgcn_mfma_f32_16x16x32_bf16(kf, vf[s], a, 0, 0, 0);
                }
                Sacc[T] = a;
            }
        }
        __syncthreads();
    }
}

__device__ __forceinline__ void p4_indexer(Frame& F, int widx, int nw) {
    const int lane = F.lane, fr = lane & 15, fq = lane >> 4;
    const bf16* QL = WSP(bf16, WS_QL); const bf16* KI = WSP(bf16, WS_KIDX); const float* WI = WSP(float, WS_WIDX); float* SC = WSP(float, WS_BIG);
    for (int task = widx; task < 2 * 4352; task += nw) {
        const int b = task / 4352; int tau = task - b * 4352;
        int g = 0; while (16 * (g + 1) * (g + 2) <= tau) ++g;
        tau -= 16 * g * (g + 1);
        const int qt = 32 * g + tau / (g + 1), seg = tau % (g + 1);
        const int row0 = b * SEQ + 16 * qt;
        bf16x8 Qf[8][2];
#pragma unroll
        for (int hh = 0; hh < 8; ++hh)
#pragma unroll
            for (int s = 0; s < 2; ++s) Qf[hh][s] = *(const bf16x8*)(QL + (size_t)(row0 + fr) * 1536 + 1024 + hh * 64 + 32 * s + 8 * fq);
        f32x4 wv[4][2];
#pragma unroll
        for (int j = 0; j < 4; ++j) { wv[j][0] = *(const f32x4*)(WI + (size_t)(row0 + 4 * fq + j) * 8); wv[j][1] = *(const f32x4*)(WI + (size_t)(row0 + 4 * fq + j) * 8 + 4); }
        const int kt1 = (32 * seg + 31 < qt) ? 32 * seg + 31 : qt;
        for (int kt = 32 * seg; kt <= kt1; ++kt) {
            const bf16* kp = KI + (size_t)(b * SEQ + 16 * kt + fr) * 64 + 8 * fq;
            const bf16x8 k0 = *(const bf16x8*)kp, k1 = *(const bf16x8*)(kp + 32);
            f32x4 isc = (f32x4){0.f, 0.f, 0.f, 0.f};
#pragma unroll
            for (int hh = 0; hh < 8; ++hh) {
                f32x4 c = __builtin_amdgcn_mfma_f32_16x16x32_bf16(Qf[hh][0], k0, (f32x4){0.f, 0.f, 0.f, 0.f}, 0, 0, 0);
                c = __builtin_amdgcn_mfma_f32_16x16x32_bf16(Qf[hh][1], k1, c, 0, 0, 0);
#pragma unroll
                for (int j = 0; j < 4; ++j) isc[j] += fmaxf(c[j], 0.f) * wv[j][hh >> 2][hh & 3];
            }
            float* sp = SC + (size_t)(row0 + 4 * fq) * 8192 + 16 * kt + fr;
#pragma unroll
            for (int j = 0; j < 4; ++j) sp[(size_t)j * 8192] = isc[j];
        }
    }
}

__device__ __forceinline__ unsigned long long mask_ge(unsigned x, unsigned t) { unsigned long long m; asm("v_cmp_ge_u32_e64 %0, %1, %2" : "=s"(m) : "v"(x), "s"(t)); return m; }
__device__ __forceinline__ void mask_ge8(unsigned long long (&m)[8], unsigned x0, unsigned x1, unsigned x2, unsigned x3, unsigned x4, unsigned x5, unsigned x6, unsigned x7, unsigned t) {
    asm("v_cmp_ge_u32_e64 %0, %8, %16\n\tv_cmp_ge_u32_e64 %1, %9, %16\n\tv_cmp_ge_u32_e64 %2, %10, %16\n\tv_cmp_ge_u32_e64 %3, %11, %16\n\t"
        "v_cmp_ge_u32_e64 %4, %12, %16\n\tv_cmp_ge_u32_e64 %5, %13, %16\n\tv_cmp_ge_u32_e64 %6, %14, %16\n\tv_cmp_ge_u32_e64 %7, %15, %16"
        : "=&s"(m[0]), "=&s"(m[1]), "=&s"(m[2]), "=&s"(m[3]), "=&s"(m[4]), "=&s"(m[5]), "=&s"(m[6]), "=&s"(m[7])
        : "v"(x0), "v"(x1), "v"(x2), "v"(x3), "v"(x4), "v"(x5), "v"(x6), "v"(x7), "s"(t));
}
__device__ __forceinline__ unsigned long long mask_eq(unsigned x, unsigned t) { unsigned long long m; asm("v_cmp_eq_u32_e64 %0, %1, %2" : "=s"(m) : "v"(x), "s"(t)); return m; }
__device__ __forceinline__ unsigned tk_key(float f) { const unsigned b = __float_as_uint(f); return (b & 0x80000000u) ? ~b : (b | 0x80000000u); }
__device__ __forceinline__ void topk_row_slow(const float* sr, const int n, const int lane, LAS int* sel) {
    const int nseg = (n + 63) >> 6;
    unsigned T = 0u;
    for (int bit = 31; bit >= 0; --bit) {
        const unsigned cnd = T | (1u << bit); int c = 0;
        for (int sg = 0; sg < nseg; ++sg) { const int idx = sg * 64 + lane; const unsigned x = (idx < n) ? tk_key(sr[idx < n ? idx : 0]) : 0u; c += __popcll(__ballot(x >= cnd)); }
        if (c >= 256) T = cnd;
    }
    int cgt = 0;
    for (int sg = 0; sg < nseg; ++sg) { const int idx = sg * 64 + lane; const unsigned x = (idx < n) ? tk_key(sr[idx < n ? idx : 0]) : 0u; cgt += __popcll(__ballot(x > T)); }
    const int need_eq = 256 - cgt; int running = 0, eq_taken = 0;
    const unsigned long long lt = (1ull << lane) - 1ull;
    for (int sg = 0; sg < nseg; ++sg) {
        const int idx = sg * 64 + lane; const unsigned x = (idx < n) ? tk_key(sr[idx < n ? idx : 0]) : 0u;
        const bool gt = x > T, eq = x == T;
        const unsigned long long meq = __ballot(eq);
        const bool take = gt || (eq && (eq_taken + __popcll(meq & lt)) < need_eq);
        const unsigned long long mt = __ballot(take);
        if (take) sel[running + __popcll(mt & lt)] = idx;
        running += __popcll(mt); eq_taken += __popcll(meq);
    }
}
constexpr int TK_CAP = 832;
__device__ __forceinline__ int topk_row(Frame& F, const int row, LAS int* sel, LAS unsigned long long* cand) {
    const int lane = F.lane;
    const float* SC = WSP(float, WS_BIG);
    {
        const int pos = row & (SEQ - 1), n = pos + 1;
        if (n <= 256) {
#pragma unroll
            for (int i = 0; i < 4; ++i) { const int j = 64 * i + lane; sel[j] = (j < n) ? j : 0; }
            return n;
        }
        const int nblk = (n + 1023) >> 10;
        const float* sr = SC + (size_t)row * 8192;
        int lane_l = lane; asm volatile("" : "+v"(lane_l));
        unsigned u[128];
#pragma unroll
        for (int i = 0; i < 64; ++i) u[i] = __float_as_uint((sr + (i >> 4) * 1024)[(i & 15) * 64 + lane_l]);
        if (nblk > 4) {
#pragma unroll
            for (int i = 64; i < 128; ++i) u[i] = __float_as_uint((sr + (i >> 4) * 1024)[(i & 15) * 64 + lane_l]);
        } else {
#pragma unroll
            for (int i = 64; i < 128; ++i) u[i] = 0u;
        }
        asm volatile("" ::: "memory");
#pragma unroll
        for (int i = 0; i < 128; ++i) { const int lim = n - i * 64; const unsigned bits = u[i];
            const unsigned x = (bits & 0x80000000u) ? ~bits : (bits | 0x80000000u);
            u[i] = (lane < lim) ? x : 0u; }
        const unsigned long long ltmask_s = (1ull << lane) - 1ull;
        bool done = false;
        {
            int ns = 0;
#pragma unroll
            for (int k = 0; k < 16; ++k) { int v = n - 512 * k; v = v < 0 ? 0 : (v > 64 ? 64 : v); ns += v; }
            const float mean = 256.0f * (float)ns / (float)n;
            const int rs = (int)(mean + 4.0f * sqrtf(mean) + 5.0f);
            unsigned Ts = 0u;
            for (int bit = 31; bit >= 16; --bit) {
                const unsigned cnd = Ts | (1u << bit); unsigned long long m0[8], m1[8];
                mask_ge8(m0, u[0], u[8], u[16], u[24], u[32], u[40], u[48], u[56], cnd); mask_ge8(m1, u[64], u[72], u[80], u[88], u[96], u[104], u[112], u[120], cnd);
                int c = 0;
#pragma unroll
                for (int i = 0; i < 8; ++i) c += __popcll(m0[i]) + __popcll(m1[i]);
                if (c >= rs) Ts = cnd;
            }
            if (Ts == 0u) Ts = 1u;
            int nc = 0;
#pragma unroll
            for (int bk = 0; bk < 8; ++bk) {
                if (bk < nblk) {
#pragma unroll
                    for (int g8 = 0; g8 < 2; ++g8) {
                        unsigned long long mg[8]; const int b0 = bk * 16 + g8 * 8;
                        mask_ge8(mg, u[b0], u[b0 + 1], u[b0 + 2], u[b0 + 3], u[b0 + 4], u[b0 + 5], u[b0 + 6], u[b0 + 7], Ts);
#pragma unroll
                        for (int i = 0; i < 8; ++i) {
                            const unsigned long long mt = mg[i];
                            if (mt != 0ull) {
                                const int off = nc + __popcll(mt & ltmask_s);
                                if (((mt >> lane) & 1ull) && off < TK_CAP) cand[off] = ((unsigned long long)u[b0 + i] << 32) | (unsigned)((b0 + i) * 64 + lane_l);
                                nc += __popcll(mt);
                            }
                        }
                    }
                }
            }
            if (nc >= 256 && nc <= TK_CAP) {
                unsigned ck[16]; int ci[13];
#pragma unroll
                for (int t = 0; t < 13; ++t) { const int j = lane + 64 * t; const unsigned long long e = (j < nc) ? cand[j] : 0ull; ck[t] = (unsigned)(e >> 32); ci[t] = (int)(unsigned)e; }
                ck[13] = 0u; ck[14] = 0u; ck[15] = 0u;
                unsigned T = 0u;
                for (int bit = 31; bit >= 0; --bit) {
                    const unsigned cnd = T | (1u << bit); unsigned long long m0[8], m1[8];
                    mask_ge8(m0, ck[0], ck[1], ck[2], ck[3], ck[4], ck[5], ck[6], ck[7], cnd); mask_ge8(m1, ck[8], ck[9], ck[10], ck[11], ck[12], ck[13], ck[14], ck[15], cnd);
                    int c = 0;
#pragma unroll
                    for (int i = 0; i < 8; ++i) c += __popcll(m0[i]) + __popcll(m1[i]);
                    if (c >= 256) T = cnd;
                }
                unsigned long long g0[8], g1[8], h0[8], h1[8];
                mask_ge8(g0, ck[0], ck[1], ck[2], ck[3], ck[4], ck[5], ck[6], ck[7], T); mask_ge8(g1, ck[8], ck[9], ck[10], ck[11], ck[12], ck[13], ck[14], ck[15], T);
                mask_ge8(h0, ck[0], ck[1], ck[2], ck[3], ck[4], ck[5], ck[6], ck[7], T + 1u); mask_ge8(h1, ck[8], ck[9], ck[10], ck[11], ck[12], ck[13], ck[14], ck[15], T + 1u);
                int cgt = 0;
#pragma unroll
                for (int t = 0; t < 13; ++t) cgt += __popcll(t < 8 ? h0[t & 7] : h1[t & 7]);
                const int need_eq = 256 - cgt;
                int running = 0, eq_taken = 0;
#pragma unroll
                for (int t = 0; t < 13; ++t) {
                    const unsigned long long mge = (t < 8 ? g0[t & 7] : g1[t & 7]), mgt = (t < 8 ? h0[t & 7] : h1[t & 7]);
                    unsigned long long mt = mge; const unsigned long long me = mge & ~mgt;
                    if (me != 0ull) {
                        const int room = need_eq - eq_taken; unsigned long long keep = 0ull, rest = me;
                        for (int k = 0; k < room && rest != 0ull; ++k) { const unsigned long long low = rest & (~rest + 1ull); keep |= low; rest ^= low; }
                        mt = (mge & ~me) | keep; eq_taken += __popcll(me);
                    }
                    if (mt != 0ull) { if ((mt >> lane) & 1ull) sel[running + __popcll(mt & ltmask_s)] = ci[t]; running += __popcll(mt); }
                }
                done = true;
            }
        }
        if (!done) topk_row_slow(sr, n, lane, sel);
    }
    return 256;
}

__device__ __forceinline__ void p6_sparse_attn(Frame& F) {
    const int lane = F.lane, gw = F.bid * NWAVES + F.wave, NGW = F.G * NWAVES;
    LAS float* ql = (LAS float*)(F.lds + F.wave * 12288);
    LAS float* pp = ql + 1024;
    const bf16* QL = WSP(bf16, WS_QL); const bf16* CKV = WSP(bf16, WS_CKV); const int* SEL = WSP(int, WS_SEL); const int* NSEL = WSP(int, WS_NSEL); bf16* AO = WSP(bf16, WS_AO);
    for (int row = gw; row < M; row += NGW) {
        const int b = row >> 13, n = NSEL[row];
        const int* sel = SEL + (size_t)row * 256;
        {
            float f[8];
            unpack8(*(const v4u*)(QL + (size_t)row * 1536 + 8 * lane), f);
#pragma unroll
            for (int x = 0; x < 8; ++x) ql[8 * lane + x] = f[x];
            unpack8(*(const v4u*)(QL + (size_t)row * 1536 + 512 + 8 * lane), f);
#pragma unroll
            for (int x = 0; x < 8; ++x) ql[512 + 8 * lane + x] = f[x];
        }
        float s[4][8];
#pragma unroll
        for (int kb = 0; kb < 4; ++kb) {
            const int j = 64 * kb + lane; const bool valid = j < n; const int key = valid ? sel[j] : 0;
            const bf16* kr = CKV + (size_t)(b * SEQ + key) * 128;
#pragma unroll
            for (int hh = 0; hh < 8; ++hh) s[kb][hh] = 0.f;
#pragma unroll 4
            for (int r8 = 0; r8 < 16; ++r8) {
                float x[8]; unpack8(*(const v4u*)(kr + 8 * r8), x);
#pragma unroll
                for (int hh = 0; hh < 8; ++hh) { const f32x4 q0 = *(const LAS f32x4*)(ql + hh * 128 + 8 * r8), q1 = *(const LAS f32x4*)(ql + hh * 128 + 8 * r8 + 4);
                    s[kb][hh] += x[0] * q0[0] + x[1] * q0[1] + x[2] * q0[2] + x[3] * q0[3] + x[4] * q1[0] + x[5] * q1[1] + x[6] * q1[2] + x[7] * q1[3]; }
            }
            if (!valid) {
#pragma unroll
                for (int hh = 0; hh < 8; ++hh) s[kb][hh] = -INFINITY;
            }
        }
#pragma unroll
        for (int hh = 0; hh < 8; ++hh) {
            const float mx = wave_max(fmaxf(fmaxf(s[0][hh], s[1][hh]), fmaxf(s[2][hh], s[3][hh])));
            float e[4], l = 0.f;
#pragma unroll
            for (int kb = 0; kb < 4; ++kb) { e[kb] = __expf(s[kb][hh] - mx); l += e[kb]; }
            const float inv = 1.0f / wave_sum(l);
#pragma unroll
            for (int kb = 0; kb < 4; ++kb) pp[(64 * kb + lane) * 8 + hh] = e[kb] * inv;
        }
        float o[8][2];
#pragma unroll
        for (int hh = 0; hh < 8; ++hh) { o[hh][0] = 0.f; o[hh][1] = 0.f; }
        for (int j = 0; j < n; ++j) {
            const int key = sel[j];
            const unsigned kv = *(const unsigned*)(CKV + (size_t)(b * SEQ + key) * 128 + 2 * lane);
            const float lo = bflo(kv), hi = bfhi(kv);
            const f32x4 p0 = *(const LAS f32x4*)(pp + j * 8), p1 = *(const LAS f32x4*)(pp + j * 8 + 4);
#pragma unroll
            for (int hh = 0; hh < 4; ++hh) { o[hh][0] += p0[hh] * lo; o[hh][1] += p0[hh] * hi; o[4 + hh][0] += p1[hh] * lo; o[4 + hh][1] += p1[hh] * hi; }
        }
#pragma unroll
        for (int hh = 0; hh < 8; ++hh) *(unsigned*)(AO + (size_t)row * 1536 + hh * 128 + 2 * lane) = pk2(o[hh][0], o[hh][1]);
    }
}
__device__ __forceinline__ void p6_gdn_out(Frame& F, KArgs A) {
    const int lane = F.lane, gw = F.bid * NWAVES + F.wave, NGW = F.G * NWAVES;
    const f32x4 g0 = *(const f32x4*)(A->in[I_AB_ONG] + 8 * (lane & 15)), g1 = *(const f32x4*)(A->in[I_AB_ONG] + 8 * (lane & 15) + 4);
    for (int row = gw; row < M; row += NGW) {
        const float* op = WSP(float, WS_ODELTA) + (size_t)row * 512 + 8 * lane;
        const f32x4 a = *(const f32x4*)op, b = *(const f32x4*)(op + 4);
        float ss = a[0] * a[0] + a[1] * a[1] + a[2] * a[2] + a[3] * a[3] + b[0] * b[0] + b[1] * b[1] + b[2] * b[2] + b[3] * b[3];
        ss += __shfl_xor(ss, 1); ss += __shfl_xor(ss, 2); ss += __shfl_xor(ss, 4); ss += __shfl_xor(ss, 8);
        const float r = rsqrtf(ss * (1.0f / 128.0f) + 1e-6f);
        float z[8]; unpack8(*(const v4u*)(WSP(bf16, WS_QKVZ) + (size_t)row * 2048 + 1536 + 8 * lane), z);
        float o[8];
#pragma unroll
        for (int i = 0; i < 4; ++i) { o[i] = a[i] * r * g0[i] * siluf(z[i]); o[4 + i] = b[i] * r * g1[i] * siluf(z[4 + i]); }
        *(v4u*)(WSP(bf16, WS_AO) + (size_t)row * 1536 + 1024 + 8 * lane) = pack8f(o);
    }
}

__device__ __forceinline__ void p8_ln_router(Frame& F, KArgs A, int l, float* HOUT, bf16* HB) {
    const int lane = F.lane, tid = F.tid, gw = F.bid * NWAVES + F.wave, NGW = F.G * NWAVES;
    LAS float* wT = (LAS float*)(F.lds);
    LAS float* lg = (LAS float*)(F.lds + WSCR_OFF + F.wave * WSCR_BYTES);
    const float* rw = A->in[I_RW] + (size_t)l * 1024 * 32;
    for (int i = tid; i < 1024 * 32; i += NTHREADS) { const int k = i >> 5, e = i & 31; wT[e * 1028 + k] = rw[i]; }
    __syncthreads();
    const float* PRE = WSP(float, WS_PRE);
    const float* lg_g = A->in[I_LNM_G] + (size_t)l * 1024; const float* lg_b = A->in[I_LNM_B] + (size_t)l * 1024;
    const float rb = A->in[I_RB][l * 32 + (lane & 31)];
    int* TOKE = WSP(int, WS_ROUTE); int* TOKPOS = TOKE + M * 4; float* TOKG = (float*)(TOKPOS + M * 4);
    gu32* cnt = F.ctl + CW_CNT + 64 * l;
    for (int row = gw; row < M; row += NGW) {
        f32x4 v[4]; float s = 0.f;
#pragma unroll
        for (int j = 0; j < 4; ++j) { v[j] = *(const f32x4*)(PRE + (size_t)row * 1024 + 256 * j + 4 * lane); s += (v[j][0] + v[j][1]) + (v[j][2] + v[j][3]); }
        const float mean = wave_sum(s) * (1.0f / 1024.0f); float s2 = 0.f;
#pragma unroll
        for (int j = 0; j < 4; ++j) { v[j] = v[j] - mean; s2 += (v[j][0] * v[j][0] + v[j][1] * v[j][1]) + (v[j][2] * v[j][2] + v[j][3] * v[j][3]); }
        const float rstd = rsqrtf(wave_sum(s2) * (1.0f / 1024.0f) + 1e-5f);
#pragma unroll
        for (int j = 0; j < 4; ++j) {
            const f32x4 g = *(const f32x4*)(lg_g + 256 * j + 4 * lane), bb = *(const f32x4*)(lg_b + 256 * j + 4 * lane);
            v[j] = v[j] * rstd * g + bb;
            *(f32x4*)(HOUT + (size_t)row * 1024 + 256 * j + 4 * lane) = v[j];
            v2u o; o.x = pk2(v[j][0], v[j][1]); o.y = pk2(v[j][2], v[j][3]); *(v2u*)(HB + (size_t)row * 1024 + 256 * j + 4 * lane) = o;
        }
        float part[32];
#pragma unroll
        for (int e = 0; e < 32; ++e) {
            float a = 0.f;
#pragma unroll
            for (int j = 0; j < 4; ++j) { const f32x4 w = *(const LAS f32x4*)(wT + e * 1028 + 256 * j + 4 * lane); a += v[j][0] * w[0] + v[j][1] * w[1] + v[j][2] * w[2] + v[j][3] * w[3]; }
            part[e] = a;
        }
#pragma unroll
        for (int i = 0; i < 16; ++i) { const bool up = (lane & 32) != 0; const float keep = up ? part[i + 16] : part[i], send = up ? part[i] : part[i + 16]; part[i] = keep + __shfl_xor(send, 32); }
#pragma unroll
        for (int i = 0; i < 8; ++i) { const bool up = (lane & 16) != 0; const float keep = up ? part[i + 8] : part[i], send = up ? part[i] : part[i + 8]; part[i] = keep + __shfl_xor(send, 16); }
#pragma unroll
        for (int i = 0; i < 4; ++i) { const bool up = (lane & 8) != 0; const float keep = up ? part[i + 4] : part[i], send = up ? part[i] : part[i + 4]; part[i] = keep + __shfl_xor(send, 8); }
#pragma unroll
        for (int i = 0; i < 2; ++i) { const bool up = (lane & 4) != 0; const float keep = up ? part[i + 2] : part[i], send = up ? part[i] : part[i + 2]; part[i] = keep + __shfl_xor(send, 4); }
        { const bool up = (lane & 2) != 0; const float keep = up ? part[1] : part[0], send = up ? part[0] : part[1]; part[0] = keep + __shfl_xor(send, 2); }
        part[0] += __shfl_xor(part[0], 1);
        const int eidx = ((lane >> 5) & 1) * 16 + ((lane >> 4) & 1) * 8 + ((lane >> 3) & 1) * 4 + ((lane >> 2) & 1) * 2 + ((lane >> 1) & 1);
        if ((lane & 1) == 0) lg[eidx] = part[0];
        float val = (lane < 32) ? lg[lane & 31] + rb : -INFINITY;
        float tl[4]; int te[4];
#pragma unroll
        for (int k = 0; k < 4; ++k) {
            const float mx = wave_max(val);
            const unsigned long long mm = __ballot(val == mx && lane < 32);
            const int idx = __ffsll((long long)mm) - 1;
            tl[k] = mx; te[k] = idx;
            if (lane == idx) val = -INFINITY;
        }
        const float e1 = __expf(tl[1] - tl[0]), e2 = __expf(tl[2] - tl[0]), e3 = __expf(tl[3] - tl[0]);
        const float inv = 1.0f / (1.0f + e1 + e2 + e3);
        if (lane < 4) {
            const int e = lane == 0 ? te[0] : (lane == 1 ? te[1] : (lane == 2 ? te[2] : te[3]));
            const float g = (lane == 0 ? 1.0f : (lane == 1 ? e1 : (lane == 2 ? e2 : e3))) * inv;
            const unsigned pos = __hip_atomic_fetch_add(cnt + e, 1u, RLX_AGENT);
            TOKE[(size_t)row * 4 + lane] = e; TOKPOS[(size_t)row * 4 + lane] = (int)pos; TOKG[(size_t)row * 4 + lane] = g;
        }
    }
}

__device__ __forceinline__ void p9_scatter(Frame& F, int l, const bf16* HB, const float* HF) {
    const int lane = F.lane, tid = F.tid, gw = F.bid * NWAVES + F.wave, NGW = F.G * NWAVES;
    LAS int* base = (LAS int*)(F.lds + MISC_OFF + 256);
    int* TOKE = WSP(int, WS_ROUTE); int* TOKPOS = TOKE + M * 4; int* TILE = TOKE + 3 * M * 4;
    if (tid == 0) {
        int acc = 0;
        for (int e = 0; e < NEXP; ++e) { const int c = (int)__hip_atomic_load(F.ctl + CW_CNT + 64 * l + e, RLX_AGENT); base[e] = acc; acc += ((c + 255) >> 8) << 8; }
        base[32] = acc >> 8;
    }
    __syncthreads();
    if (F.bid == 0 && tid < 64) {
        const int nT = base[32];
        for (int t = tid; t < NTMAX; t += 64) { int e = 0;
            for (int x = 1; x < NEXP; ++x) if (base[x] <= t * 256) e = x;
            TILE[t] = (t < nT) ? e : 0; }
        if (tid == 0) TILE[NTMAX] = nT;
    }
    bf16* XS = WSP(bf16, WS_XS);
    if (kMoeFp8) {
        unsigned char* XB8 = WSP(unsigned char, WS_XS);
        for (int row = gw; row < M; row += NGW) {
            const float* hp = HF + (size_t)row * 1024 + 16 * lane; v4u o;
#pragma unroll
            for (int q = 0; q < 4; ++q) { const f32x4 v = *(const f32x4*)(hp + 4 * q); unsigned w = 0u; w = __builtin_amdgcn_cvt_pk_fp8_f32(v[0], v[1], w, false); w = __builtin_amdgcn_cvt_pk_fp8_f32(v[2], v[3], w, true); o[q] = w; }
#pragma unroll
            for (int k = 0; k < 4; ++k) { const int slot = base[TOKE[(size_t)row * 4 + k]] + TOKPOS[(size_t)row * 4 + k]; *(v4u*)(XB8 + (size_t)slot * 1024 + 16 * lane) = o; }
        }
        return;
    }
    for (int row = gw; row < M; row += NGW) {
        const v4u a = *(const v4u*)(HB + (size_t)row * 1024 + 8 * lane), b = *(const v4u*)(HB + (size_t)row * 1024 + 512 + 8 * lane);
#pragma unroll
        for (int k = 0; k < 4; ++k) {
            const int slot = base[TOKE[(size_t)row * 4 + k]] + TOKPOS[(size_t)row * 4 + k];
            *(v4u*)(XS + (size_t)slot * 1024 + 8 * lane) = a; *(v4u*)(XS + (size_t)slot * 1024 + 512 + 8 * lane) = b;
        }
    }
}

__device__ __forceinline__ void p12_combine(Frame& F, KArgs A, int l, const float* HIN, float* HOUT, bf16* HB) {
    const int lane = F.lane, tid = F.tid, gw = F.bid * NWAVES + F.wave, NGW = F.G * NWAVES;
    LAS int* base = (LAS int*)(F.lds + MISC_OFF + 256);
    if (tid == 0) { int acc = 0; for (int e = 0; e < NEXP; ++e) { const int c = (int)__hip_atomic_load(F.ctl + CW_CNT + 64 * l + e, RLX_AGENT); base[e] = acc; acc += ((c + 255) >> 8) << 8; } }
    __syncthreads();
    const int* TOKE = WSP(int, WS_ROUTE); const int* TOKPOS = TOKE + M * 4; const float* TOKG = (const float*)(TOKPOS + M * 4);
    const bf16* YS = WSP(bf16, WS_YS); const bf16* PLE = WSP(bf16, WS_PLE);
    const float* lg_g = A->in[I_LNF_G] + (size_t)l * 1024; const float* lg_b = A->in[I_LNF_B] + (size_t)l * 1024;
    for (int row = gw; row < M; row += NGW) {
        float x[16];
        {   const f32x4 h0 = *(const f32x4*)(HIN + (size_t)row * 1024 + 8 * lane), h1 = *(const f32x4*)(HIN + (size_t)row * 1024 + 8 * lane + 4);
            const f32x4 h2 = *(const f32x4*)(HIN + (size_t)row * 1024 + 512 + 8 * lane), h3 = *(const f32x4*)(HIN + (size_t)row * 1024 + 512 + 8 * lane + 4);
            float p0[8], p1[8]; unpack8(*(const v4u*)(PLE + (size_t)row * 1024 + 8 * lane), p0); unpack8(*(const v4u*)(PLE + (size_t)row * 1024 + 512 + 8 * lane), p1);
#pragma unroll
            for (int i = 0; i < 4; ++i) { x[i] = ALPHA * h0[i] + p0[i]; x[4 + i] = ALPHA * h1[i] + p0[4 + i]; x[8 + i] = ALPHA * h2[i] + p1[i]; x[12 + i] = ALPHA * h3[i] + p1[4 + i]; }
        }
#pragma unroll
        for (int k = 0; k < 4; ++k) {
            const int slot = base[TOKE[(size_t)row * 4 + k]] + TOKPOS[(size_t)row * 4 + k]; const float g = TOKG[(size_t)row * 4 + k];
            float y0[8], y1[8]; unpack8(*(const v4u*)(YS + (size_t)slot * 1024 + 8 * lane), y0); unpack8(*(const v4u*)(YS + (size_t)slot * 1024 + 512 + 8 * lane), y1);
#pragma unroll
            for (int i = 0; i < 8; ++i) { x[i] += g * y0[i]; x[8 + i] += g * y1[i]; }
        }
        float s = 0.f;
#pragma unroll
        for (int i = 0; i < 16; ++i) s += x[i];
        const float mean = wave_sum(s) * (1.0f / 1024.0f); float s2 = 0.f;
#pragma unroll
        for (int i = 0; i < 16; ++i) { x[i] -= mean; s2 += x[i] * x[i]; }
        const float rstd = rsqrtf(wave_sum(s2) * (1.0f / 1024.0f) + 1e-5f);
#pragma unroll
        for (int hf = 0; hf < 2; ++hf) {
            const int c0 = 512 * hf + 8 * lane;
            const f32x4 g0 = *(const f32x4*)(lg_g + c0), g1 = *(const f32x4*)(lg_g + c0 + 4), b0 = *(const f32x4*)(lg_b + c0), b1 = *(const f32x4*)(lg_b + c0 + 4);
            f32x4 o0, o1;
#pragma unroll
            for (int i = 0; i < 4; ++i) { o0[i] = x[8 * hf + i] * rstd * g0[i] + b0[i]; o1[i] = x[8 * hf + 4 + i] * rstd * g1[i] + b1[i]; }
            *(f32x4*)(HOUT + (size_t)row * 1024 + c0) = o0; *(f32x4*)(HOUT + (size_t)row * 1024 + c0 + 4) = o1;
            if (HB) { v4u w; w.x = pk2(o0[0], o0[1]); w.y = pk2(o0[2], o0[3]); w.z = pk2(o1[0], o1[1]); w.w = pk2(o1[2], o1[3]); *(v4u*)(HB + (size_t)row * 1024 + c0) = w; }
        }
    }
}

__device__ __forceinline__ void p14_dilated(Frame& F) {
    const int lane = F.lane, gw = F.bid * NWAVES + F.wave, NGW = F.G * NWAVES;
    LAS float* pe = (LAS float*)(F.lds + F.wave * 2048);
    const bf16* QK = WSP(bf16, WS_QKVZ); bf16* AO = WSP(bf16, WS_AO);
    for (int task = gw; task < M * 12; task += NGW) {
        const int row = task / 12, hh = task - row * 12, b = row >> 13, pos = row & (SEQ - 1);
        float q[64];
#pragma unroll
        for (int c = 0; c < 8; ++c) { float f[8]; unpack8(*(const v4u*)(QK + (size_t)row * 2560 + hh * 64 + 8 * c), f);
#pragma unroll
            for (int x = 0; x < 8; ++x) q[8 * c + x] = f[x]; }
        float s[7];
#pragma unroll
        for (int i = 0; i < 7; ++i) {
            const int e = lane + 64 * i, p = e / 129, m = e - p * 129;
            const int dd = (p == 0) ? 1 : (p == 1 ? 4 : 16);
            const int kpos = pos - m * dd; const bool valid = (e < 387) && (kpos >= 0);
            float a = -INFINITY;
            if (valid) {
                const bf16* kr = QK + (size_t)(b * SEQ + kpos) * 2560 + 768 + hh * 64; a = 0.f;
#pragma unroll
                for (int c = 0; c < 8; ++c) { float f[8]; unpack8(*(const v4u*)(kr + 8 * c), f);
#pragma unroll
                    for (int x = 0; x < 8; ++x) a += q[8 * c + x] * f[x]; }
                a *= 0.125f;
            }
            s[i] = a;
        }
        float mx = s[0];
#pragma unroll
        for (int i = 1; i < 7; ++i) mx = fmaxf(mx, s[i]);
        mx = wave_max(mx);
        float l = 0.f;
#pragma unroll
        for (int i = 0; i < 7; ++i) { const float ev = __expf(s[i] - mx); pe[lane + 64 * i] = ev; l += ev; }
        l = wave_sum(l);
        float o = 0.f;
#pragma unroll
        for (int p = 0; p < 3; ++p) {
            const int dd = (p == 0) ? 1 : (p == 1 ? 4 : 16);
            int mmax = pos / dd; if (mmax > 128) mmax = 128;
            const bf16* vb = QK + (size_t)(b * SEQ + pos) * 2560 + 1536 + hh * 64 + lane;
            for (int m = 0; m <= mmax; ++m) o += pe[p * 129 + m] * bf1(vb[-(ptrdiff_t)m * dd * 2560]);
        }
        AO[(size_t)row * 1024 + hh * 64 + lane] = (bf16)f2bf(o / l);
    }
}
typedef short v4i16_t __attribute__((ext_vector_type(4)));
__device__ __forceinline__ v4i16_t lds_tr16(LAS unsigned char* p) { return __builtin_amdgcn_ds_read_tr16_b64_v4i16((LAS v4i16_t*)p); }
constexpr int DV_PITCH = 144, DV_BUF = 32 * DV_PITCH;
template <int DL  > __device__ __forceinline__ void dil_branch(const bf16* __restrict__ KV, LAS unsigned char* vbuf, const int s0, const int lane,
                                                                                 const bf16x8 (&qf)[2], f32x4 (&O)[4], float& m_run, float& l_run) {
    constexpr int d = 1 << DL, sigma = 16 >> DL, NS = (129 + 15 * sigma + 31) / 32;
    const int fr = lane & 15, fq = lane >> 4;
    const int c = s0 & (d - 1), n0 = s0 >> DL, kstart = n0 - 128;
#define DIL_POS(n) ({ int _p = c + d * (n); _p = _p < 0 ? 0 : (_p > SEQ - 1 ? SEQ - 1 : _p); _p; })
    bf16x8 kf[2][2]; v4u vr[4];
#pragma unroll
    for (int tl = 0; tl < 2; ++tl) { const bf16* kp = KV + (size_t)DIL_POS(kstart + 16 * tl + fr) * 2560 + 768 + 8 * fq; kf[tl][0] = *(const bf16x8*)kp; kf[tl][1] = *(const bf16x8*)(kp + 32); }
#pragma unroll
    for (int i = 0; i < 4; ++i) vr[i] = *(const v4u*)(KV + (size_t)DIL_POS(kstart + (lane >> 3) + 8 * i) * 2560 + 1536 + 8 * (lane & 7));
#pragma unroll 1
    for (int g = 0; g < NS; ++g) {
        LAS unsigned char* vb = vbuf + (g & 1) * DV_BUF;
#pragma unroll
        for (int i = 0; i < 4; ++i) *(LAS v4u*)(vb + ((lane >> 3) + 8 * i) * DV_PITCH + 16 * (lane & 7)) = vr[i];
        bf16x8 kc[2][2];
#pragma unroll
        for (int tl = 0; tl < 2; ++tl) { kc[tl][0] = kf[tl][0]; kc[tl][1] = kf[tl][1]; }
        if (g + 1 < NS) {
            const int kb = kstart + 32 * (g + 1);
#pragma unroll
            for (int tl = 0; tl < 2; ++tl) { const bf16* kp = KV + (size_t)DIL_POS(kb + 16 * tl + fr) * 2560 + 768 + 8 * fq; kf[tl][0] = *(const bf16x8*)kp; kf[tl][1] = *(const bf16x8*)(kp + 32); }
#pragma unroll
            for (int i = 0; i < 4; ++i) vr[i] = *(const v4u*)(KV + (size_t)DIL_POS(kb + (lane >> 3) + 8 * i) * 2560 + 1536 + 8 * (lane & 7));
        }
        float sv[8];
#pragma unroll
        for (int tl = 0; tl < 2; ++tl) {
            f32x4 cc = __builtin_amdgcn_mfma_f32_16x16x32_bf16(kc[tl][0], qf[0], (f32x4){0.f, 0.f, 0.f, 0.f}, 0, 0, 0);
            cc = __builtin_amdgcn_mfma_f32_16x16x32_bf16(kc[tl][1], qf[1], cc, 0, 0, 0);
#pragma unroll
            for (int j = 0; j < 4; ++j) {
                const int rel = 32 * g + 16 * tl + 4 * fq + j;
                const int delta = 128 + sigma * fr - rel;
                const bool ok = (delta >= 0) && (delta <= 128) && (kstart + rel >= 0);
                sv[4 * tl + j] = ok ? cc[j] * 0.125f : -INFINITY;
            }
        }
        float mx = fmaxf(fmaxf(fmaxf(sv[0], sv[1]), fmaxf(sv[2], sv[3])), fmaxf(fmaxf(sv[4], sv[5]), fmaxf(sv[6], sv[7])));
        mx = fmaxf(mx, __shfl_xor(mx, 16)); mx = fmaxf(mx, __shfl_xor(mx, 32));
        const float m_new = fmaxf(m_run, mx);
        if (!__all(m_new == m_run)) {
            const float alpha = __expf(m_run - m_new);
            l_run *= alpha;
#pragma unroll
            for (int j = 0; j < 4; ++j) { const float aj = __shfl(alpha, 4 * fq + j);
#pragma unroll
                for (int dt = 0; dt < 4; ++dt) O[dt][j] *= aj; }
            m_run = m_new;
        }
        float p[8], ps = 0.f;
#pragma unroll
        for (int e = 0; e < 8; ++e) { p[e] = __expf(sv[e] - m_run); ps += p[e]; }
        l_run += ps;
        v4u pw; pw.x = pg8::cvt_pk_bf16(p[0], p[1]); pw.y = pg8::cvt_pk_bf16(p[2], p[3]); pw.z = pg8::cvt_pk_bf16(p[4], p[5]); pw.w = pg8::cvt_pk_bf16(p[6], p[7]);
        const bf16x8 pf = __builtin_bit_cast(bf16x8, pw);
        LAS unsigned char* tb = vb + (4 * fq + ((lane & 15) >> 2)) * DV_PITCH + 8 * (lane & 3);
#pragma unroll
        for (int dt = 0; dt < 4; ++dt) {
            const v4i16_t lo = lds_tr16(tb + 32 * dt), hi = lds_tr16(tb + 16 * DV_PITCH + 32 * dt);
            bf16x8 vf; vf[0] = lo[0]; vf[1] = lo[1]; vf[2] = lo[2]; vf[3] = lo[3]; vf[4] = hi[0]; vf[5] = hi[1]; vf[6] = hi[2]; vf[7] = hi[3];
            O[dt] = __builtin_amdgcn_mfma_f32_16x16x32_bf16(pf, vf, O[dt], 0, 0, 0);
        }
    }
#undef DIL_POS
}
__device__ __forceinline__ void p14_dilated_mfma(Frame& F) {
    const int lane = F.lane, fr = lane & 15, fq = lane >> 4;
    LAS unsigned char* vbuf = F.lds + F.wave * (2 * DV_BUF);
    const bf16* QK = WSP(bf16, WS_QKVZ); bf16* AO = WSP(bf16, WS_AO);
    for (int u = F.bid; u < 24 * 32 * 2; u += F.G) {
        const int bh = u >> 6, blk = (u >> 1) & 31, o = (u & 1) * 8 + F.wave;
        const int b = bh / 12, hh = bh - b * 12, s0 = 256 * blk + o;
        const bf16* KV = QK + (size_t)b * SEQ * 2560 + hh * 64;
        bf16x8 qf[2];
        { const bf16* qp = KV + (size_t)(s0 + 16 * fr) * 2560 + 8 * fq; qf[0] = *(const bf16x8*)qp; qf[1] = *(const bf16x8*)(qp + 32); }
        f32x4 O[4];
#pragma unroll
        for (int dt = 0; dt < 4; ++dt) O[dt] = (f32x4){0.f, 0.f, 0.f, 0.f};
        float m_run = -1e30f, l_run = 0.f;
        dil_branch<4>(KV, vbuf, s0, lane, qf, O, m_run, l_run);
        dil_branch<2>(KV, vbuf, s0, lane, qf, O, m_run, l_run);
        dil_branch<0>(KV, vbuf, s0, lane, qf, O, m_run, l_run);
        float lt = l_run; lt += __shfl_xor(lt, 16); lt += __shfl_xor(lt, 32);
        const float inv = 1.0f / lt;
#pragma unroll
        for (int j = 0; j < 4; ++j) {
            const float ij = __shfl(inv, 4 * fq + j);
            bf16* op = AO + (size_t)(b * SEQ + s0 + 16 * (4 * fq + j)) * 1024 + hh * 64 + fr;
#pragma unroll
            for (int dt = 0; dt < 4; ++dt) op[16 * dt] = (bf16)f2bf(O[dt][j] * ij);
        }
    }
}
constexpr int SA_PITCH = 272, SA_TILE = 32 * SA_PITCH;
__device__ __forceinline__ void sparse_row(Frame& F, const int row, const int n, const LAS int* sel, LAS unsigned char* tile) {
    const int lane = F.lane, fr = lane & 15, fq = lane >> 4;
    const bf16* QL = WSP(bf16, WS_QL); const bf16* CKV = WSP(bf16, WS_CKV); bf16* AO = WSP(bf16, WS_AO);
    {
        const int b = row >> 13;
        const bf16* kvb = CKV + (size_t)b * SEQ * 128;
        bf16x8 qf[4];
#pragma unroll
        for (int s = 0; s < 4; ++s) { const v4u z = (v4u){0u, 0u, 0u, 0u}; qf[s] = (fr < 8) ? *(const bf16x8*)(QL + (size_t)row * 1536 + fr * 128 + 32 * s + 8 * fq) : __builtin_bit_cast(bf16x8, z); }
        f32x4 O[8];
#pragma unroll
        for (int rt = 0; rt < 8; ++rt) O[rt] = (f32x4){0.f, 0.f, 0.f, 0.f};
        float m_run = -1e30f, l_run = 0.f;
        const int nsteps = (n + 31) >> 5;
        v4u vr[8];
        { const int j = lane & 31; const int kidx = (j < n) ? sel[j] : 0;
#pragma unroll
          for (int i = 0; i < 8; ++i) { const int key = __shfl(kidx, (lane >> 4) + 4 * i); vr[i] = *(const v4u*)(kvb + (size_t)key * 128 + 8 * (lane & 15)); } }
#pragma unroll 1
        for (int g = 0; g < nsteps; ++g) {
#pragma unroll
            for (int i = 0; i < 8; ++i) *(LAS v4u*)(tile + ((lane >> 4) + 4 * i) * SA_PITCH + 16 * (lane & 15)) = vr[i];
            if (g + 1 < nsteps) {
                const int j = 32 * (g + 1) + (lane & 31); const int kidx = (j < n) ? sel[j] : 0;
#pragma unroll
                for (int i = 0; i < 8; ++i) { const int key = __shfl(kidx, (lane >> 4) + 4 * i); vr[i] = *(const v4u*)(kvb + (size_t)key * 128 + 8 * (lane & 15)); }
            }
            float sv[8];
#pragma unroll
            for (int tl = 0; tl < 2; ++tl) {
                f32x4 cc = (f32x4){0.f, 0.f, 0.f, 0.f};
#pragma unroll
                for (int s = 0; s < 4; ++s) { const bf16x8 kf = *(const LAS bf16x8*)(tile + (16 * tl + fr) * SA_PITCH + 64 * s + 16 * fq); cc = __builtin_amdgcn_mfma_f32_16x16x32_bf16(kf, qf[s], cc, 0, 0, 0); }
#pragma unroll
                for (int j = 0; j < 4; ++j) sv[4 * tl + j] = (32 * g + 16 * tl + 4 * fq + j < n) ? cc[j] : -INFINITY;
            }
            float mx = fmaxf(fmaxf(fmaxf(sv[0], sv[1]), fmaxf(sv[2], sv[3])), fmaxf(fmaxf(sv[4], sv[5]), fmaxf(sv[6], sv[7])));
            mx = fmaxf(mx, __shfl_xor(mx, 16)); mx = fmaxf(mx, __shfl_xor(mx, 32));
            const float m_new = fmaxf(m_run, mx);
            if (!__all(m_new == m_run)) {
                const float alpha = __expf(m_run - m_new);
                l_run *= alpha;
#pragma unroll
                for (int j = 0; j < 4; ++j) { const float aj = __shfl(alpha, 4 * fq + j);
#pragma unroll
                    for (int rt = 0; rt < 8; ++rt) O[rt][j] *= aj; }
                m_run = m_new;
            }
            float p[8], ps = 0.f;
#pragma unroll
            for (int e = 0; e < 8; ++e) { p[e] = __expf(sv[e] - m_run); ps += p[e]; }
            l_run += ps;
            v4u pw; pw.x = pg8::cvt_pk_bf16(p[0], p[1]); pw.y = pg8::cvt_pk_bf16(p[2], p[3]); pw.z = pg8::cvt_pk_bf16(p[4], p[5]); pw.w = pg8::cvt_pk_bf16(p[6], p[7]);
            const bf16x8 pf = __builtin_bit_cast(bf16x8, pw);
            LAS unsigned char* tb = tile + (4 * fq + ((lane & 15) >> 2)) * SA_PITCH + 8 * (lane & 3);
#pragma unroll
            for (int rt = 0; rt < 8; ++rt) {
                const v4i16_t lo = lds_tr16(tb + 32 * rt), hi = lds_tr16(tb + 16 * SA_PITCH + 32 * rt);
                bf16x8 vf; vf[0] = lo[0]; vf[1] = lo[1]; vf[2] = lo[2]; vf[3] = lo[3]; vf[4] = hi[0]; vf[5] = hi[1]; vf[6] = hi[2]; vf[7] = hi[3];
                O[rt] = __builtin_amdgcn_mfma_f32_16x16x32_bf16(pf, vf, O[rt], 0, 0, 0);
            }
        }
        float lt = l_run; lt += __shfl_xor(lt, 16); lt += __shfl_xor(lt, 32);
        const float inv = 1.0f / lt;
#pragma unroll
        for (int j = 0; j < 4; ++j) {
            const float ij = __shfl(inv, 4 * fq + j);
            if (fq < 2) { bf16* op = AO + (size_t)row * 1536 + (4 * fq + j) * 128 + fr;
#pragma unroll
                for (int rt = 0; rt < 8; ++rt) op[16 * rt] = (bf16)f2bf(O[rt][j] * ij); }
        }
    }
}
__device__ __forceinline__ void p5_topk_attn(Frame& F) {
    const int gw = F.bid * NWAVES + F.wave, NGW = F.G * NWAVES;
    LAS int* sel = (LAS int*)(F.lds + F.wave * 16384);
    LAS unsigned char* tile = F.lds + F.wave * 16384 + 1024;
    LAS unsigned long long* cand = (LAS unsigned long long*)(F.lds + F.wave * 16384 + 1024 + SA_TILE);
    static_assert(1024 + SA_TILE + TK_CAP * 8 <= 16384, "per-wave LDS");
    for (int rix = gw; rix < M; rix += NGW) {
        const int row = ((rix & 1) ? (M - 1 - (rix >> 1)) : (rix >> 1));
        const int n = __builtin_amdgcn_readfirstlane(topk_row(F, row, sel, cand));
        sparse_row(F, row, n, sel, tile);
    }
}
__device__ __forceinline__ void p14_pool(Frame& F, KArgs A) {
    const int lane = F.lane, tid = F.tid, gw = F.bid * NWAVES + F.wave, NGW = F.G * NWAVES;
    LAS float* pw = (LAS float*)(F.lds + 16384);
    LAS float* dl = (LAS float*)(F.lds + 16384 + 65536 + F.wave * 1024);
    for (int i = tid; i < 4 * 64 * 64; i += NTHREADS) pw[i] = A->in[I_CD_POOLW][i];
    __syncthreads();
    const bf16* QK = WSP(bf16, WS_QKVZ); bf16* AO = WSP(bf16, WS_AO);
    const int gi = lane >> 4, w = 2 << gi;
    float sc[4];
#pragma unroll
    for (int g = 0; g < 4; ++g) sc[g] = A->in[I_CD_POOLS][g * 64 + lane];
    for (int row = gw; row < M; row += NGW) {
        const int pos = row & (SEQ - 1);
        const int cntw = (pos + 1 < w) ? pos + 1 : w;
        float sum[4] = {0.f, 0.f, 0.f, 0.f}, cur[4] = {0.f, 0.f, 0.f, 0.f};
        for (int j = 0; j < cntw; ++j) {
            const v2u xr = *(const v2u*)(QK + (size_t)(row - j) * 2560 + 2304 + 4 * lane);
            const float f0 = bflo(xr.x), f1 = bfhi(xr.x), f2 = bflo(xr.y), f3 = bfhi(xr.y);
            sum[0] += f0; sum[1] += f1; sum[2] += f2; sum[3] += f3;
            if (j == 0) { cur[0] = f0; cur[1] = f1; cur[2] = f2; cur[3] = f3; }
        }
        const float inv = 1.0f / (float)cntw;
#pragma unroll
        for (int i = 0; i < 4; ++i) dl[4 * lane + i] = sum[i] * inv - cur[i];
        float o[4] = {0.f, 0.f, 0.f, 0.f};
        for (int c = 0; c < 64; ++c) {
#pragma unroll
            for (int g = 0; g < 4; ++g) o[g] += dl[g * 64 + c] * pw[(g * 64 + c) * 64 + lane];
        }
#pragma unroll
        for (int g = 0; g < 4; ++g) AO[(size_t)row * 1024 + 768 + g * 64 + lane] = (bf16)f2bf(o[g] * sc[g]);
    }
}


#define IN(k) (lo <= (k) && (k) < hi)
#define SEAM(k) do { if (IN(k) && IN((k) + 1)) xcd_barrier(bar); } while (0)
template <int l> __device__ __forceinline__ void layer_tail(Frame& F, const XcdBarrier& bar, const int lo, const int hi) {
    LAS unsigned char* ring = F.lds + RING_OFF;
    const int bid = F.bid, G = F.G;
        const int pb = 8 * l;

        if (IN(7 + pb)) {
            pg8::Gemm g{WSP(bf16, WS_AO), (l == 0) ? WSP(bf16, WS_W_OUTAB) : WSP(bf16, WS_W_OUTCD), M, 1024, (l == 0) ? 1536 : 1024}; pg8::StaticOrder S; S.init(M, 1024, G, bid);
            pg8::Epi<pg8::StPre> E{{(l == 0) ? kargs()->in[I_X] : WSP(float, WS_H2), WSP(float, WS_PRE), ALPHA}};
            pg8::gemm_phase<pg8::Epi<pg8::StPre>, pg8::StaticOrder, true, true>(ring, g, S, E);
        } SEAM(7 + pb);
        if (IN(8 + pb)) { p8_ln_router(F, kargs(), l, WSP(float, WS_H1), WSP(bf16, WS_H1B)); } SEAM(8 + pb);
        if (IN(9 + pb)) {
            p9_scatter(F, l, WSP(bf16, WS_H1B), WSP(float, WS_H1));
            __syncthreads();
            pg8::Gemm g{WSP(bf16, WS_H1B), WSP(bf16, WS_W_PG) + (size_t)l * 1024 * 1024, M, 1024, 1024}; pg8::StaticOrder S; S.init(M, 1024, G, bid);
            pg8::Epi<pg8::StPleGate> E{{WSP(bf16, WS_PP) + (size_t)l * M * 1024, WSP(bf16, WS_PLE)}};
            pg8::gemm_phase<pg8::Epi<pg8::StPleGate>, pg8::StaticOrder, true, true>(ring, g, S, E);
        } SEAM(9 + pb);
        const int* TILE = WSP(int, WS_ROUTE) + 3 * M * 4;
        if (IN(10 + pb)) {
            const int nT = __builtin_amdgcn_readfirstlane(TILE[NTMAX]);
            constexpr int EB = kMoeFp8 ? 1 : 2;
            pg8::Gemm g{WSP(bf16, WS_XS), (const bf16*)(F.ws + WS_W_GU + (size_t)l * NEXP * 2048 * 1024 * EB), PMAX, 2048, 1024 * EB / 2};
            pg8::MoeOrder S{TILE, nT, 8, G, bid, (long)2048 * 1024 * EB};
            pg8::Epi<pg8::StSwiglu<kMoeFp8>> E{{kargs()->in[I_BGU] + (size_t)l * NEXP * 2048, WSP(bf16, WS_HID)}};
            pg8::gemm_phase<pg8::Epi<pg8::StSwiglu<kMoeFp8>>, pg8::MoeOrder, true, true, kMoeFp8 ? kScaleGU : 0u>(ring, g, S, E);
        } SEAM(10 + pb);
        if (IN(11 + pb)) {
            const int nT = __builtin_amdgcn_readfirstlane(TILE[NTMAX]);
            constexpr int EB = kMoeFp8 ? 1 : 2;
            pg8::Gemm g{WSP(bf16, WS_HID), (const bf16*)(F.ws + WS_W_DN + (size_t)l * NEXP * 1024 * 1024 * EB), PMAX, 1024, 1024 * EB / 2};
            pg8::MoeOrder S{TILE, nT, 4, G, bid, (long)1024 * 1024 * EB};
            pg8::Epi<pg8::StDown> E{{kargs()->in[I_BDN] + (size_t)l * NEXP * 1024, WSP(bf16, WS_YS)}};
            pg8::gemm_phase<pg8::Epi<pg8::StDown>, pg8::MoeOrder, true, true, kMoeFp8 ? kScaleDN : 0u>(ring, g, S, E);
        } SEAM(11 + pb);
        if (IN(12 + pb)) { p12_combine(F, kargs(), l, WSP(float, WS_H1), (l == 0) ? WSP(float, WS_H2) : kargs()->out, (l == 0) ? WSP(bf16, WS_XB) : (bf16*)nullptr); }
}
#undef IN
#undef SEAM
__global__ void __launch_bounds__(NTHREADS, 2) mk_fwd(Args args_by_value) {
    const KArgs KA = kargs();
    extern __shared__ __attribute__((aligned(16))) unsigned char lds[];
    Frame F;
    F.lds = (LAS unsigned char*)lds;
    F.tid = threadIdx.x; F.lane = F.tid & 63; F.wave = __builtin_amdgcn_readfirstlane(F.tid >> 6);
    F.G = gridDim.x; F.bid = blockIdx.x; F.ws = KA->ws; F.ctl = (gu32*)(KA->ws + WS_CTL);
    volatile LAS unsigned* MISC = (volatile LAS unsigned*)(F.lds + MISC_OFF);
    { int t0 = threadIdx.x; asm volatile("" : "+v"(t0)); for (int u = t0; u < (LDS_BYTES - MISC_OFF) / 4; u += NTHREADS) MISC[u] = 0u; }
    __syncthreads();
    const bool use_bar = (N_LAUNCHES != NPHASES);
    XcdBarrier bar; bar.bar = (unsigned*)(F.ctl + CW_BAR) + KA->li * XCD_BAR_WORDS; bar.x = 0; bar.st = nullptr;
    if (use_bar) bar = xcd_barrier_post((unsigned*)(F.ctl + CW_BAR) + KA->li * XCD_BAR_WORDS, MISC + 8);
    const int lo = KA->ph_lo, hi = KA->ph_hi;
#define IN(k) (lo <= (k) && (k) < hi)
#define SEAM(k) do { if (IN(k) && IN((k) + 1)) xcd_barrier(bar); } while (0)
    LAS unsigned char* ring = F.lds + RING_OFF;
    const int bid = F.bid, G = F.G;

    if (IN(0)) { p0_prologue(F, kargs()); } SEAM(0);

            if (IN(1)) {
                { pg8::Gemm g{WSP(bf16, WS_XB), WSP(bf16, WS_W_INAB), M, 2560, 1024}; pg8::StaticOrder S; S.init(M, 2560, G, bid);
                  pg8::Epi<pg8::StInAB> E{{WSP(float, WS_SM), WSP(bf16, WS_QKVZ)}};
                  pg8::gemm_phase<pg8::Epi<pg8::StInAB>, pg8::StaticOrder, true, true>(ring, g, S, E); }
                __syncthreads();
                { pg8::Gemm g{WSP(bf16, WS_PB), WSP(bf16, WS_W_PP), 2 * M, 1024, 256}; pg8::BatchOrder S{4, (2 * M / 256) * 4, G, bid, M / 256, (long)1024 * 256 * 2};
                  pg8::Epi<pg8::StBf16> E{{WSP(bf16, WS_PP), 1024}};
                  pg8::gemm_phase<pg8::Epi<pg8::StBf16>, pg8::BatchOrder, true, true>(ring, g, S, E); }
            } SEAM(1);
            if (IN(2)) { p2_prep(F, kargs()); } SEAM(2);
            if (IN(3)) {
                p3_chunk_prep(F, kargs());
                __syncthreads();
                { pg8::Gemm g{WSP(bf16, WS_CQ), WSP(bf16, WS_W_ABS), M, 1536, 256}; pg8::StaticOrder S; S.init(M, 1536, G, bid);
                  pg8::Epi<pg8::StBf16> E{{WSP(bf16, WS_QL), 1536}};
                  pg8::gemm_phase<pg8::Epi<pg8::StBf16>, pg8::StaticOrder, true, true>(ring, g, S, E); }
            } SEAM(3);
            if (IN(4)) {
                if (bid < SEQ_WGS && G > SEQ_WGS) p4_delta_seq(F, bid);
                else p4_indexer(F, (bid - SEQ_WGS) * NWAVES + F.wave, (G - SEQ_WGS) * NWAVES);
            } SEAM(4);
            if (IN(5)) { p5_topk_attn(F); p6_gdn_out(F, kargs()); } SEAM(5);
    layer_tail<0>(F, bar, lo, hi);
    SEAM(12);
            if (IN(13)) {
                pg8::Gemm g{WSP(bf16, WS_XB), WSP(bf16, WS_W_INCD), M, 2560, 1024}; pg8::StaticOrder S; S.init(M, 2560, G, bid);
                pg8::Epi<pg8::StBf16> E{{WSP(bf16, WS_QKVZ), 2560}};
                pg8::gemm_phase<pg8::Epi<pg8::StBf16>, pg8::StaticOrder, true, true>(ring, g, S, E);
            } SEAM(13);
            if (IN(14)) { p14_dilated_mfma(F); __syncthreads(); p14_pool(F, kargs()); } SEAM(14);
    layer_tail<1>(F, bar, lo, hi);
#undef IN
#undef SEAM
}

extern "C" void kernel_launch(void* const* d_in, const int* in_sizes, int n_in, void* d_out, int out_size, void* d_ws, size_t ws_size, hipStream_t stream) {
    static int grid = 0;
    if (grid == 0) {
        if (n_in != N_IN || in_sizes[0] != M * D || out_size != M * D || ws_size < WS_END) {
            fprintf(stderr, "kernel_launch: built for %d inputs, x/out of %d floats, >= %zu bytes of workspace; got n_in %d, in0 %d, out %d, ws %zu; nothing launched\n", N_IN, M * D, (size_t)WS_END, n_in, n_in > 0 ? in_sizes[0] : -1, out_size, ws_size);
            grid = -1; return; }
        int dev = 0, cus = 0, per_cu = 0;
        if (hipGetDevice(&dev) != hipSuccess || hipDeviceGetAttribute(&cus, hipDeviceAttributeMultiprocessorCount, dev) != hipSuccess) { fprintf(stderr, "kernel_launch: device query failed\n"); grid = -1; return; }
        if (hipFuncSetAttribute((const void*)mk_fwd, hipFuncAttributeMaxDynamicSharedMemorySize, LDS_BYTES) != hipSuccess) { fprintf(stderr, "kernel_launch: hipFuncSetAttribute failed\n"); grid = -1; return; }
        if (hipOccupancyMaxActiveBlocksPerMultiprocessor(&per_cu, (const void*)mk_fwd, NTHREADS, LDS_BYTES) != hipSuccess || per_cu < 1)
            fprintf(stderr, "kernel_launch: note: occupancy query reports %d workgroups per CU\n", per_cu);
        (void)hipGetLastError();
        grid = cus;
    }
    if (grid < 0) return;
    if (hipMemsetAsync((char*)d_ws + WS_CTL, 0, CTL_ZERO_BYTES, stream) != hipSuccess) { fprintf(stderr, "kernel_launch: memset failed\n"); return; }
    Args a{};
    for (int i = 0; i < N_IN; ++i) a.in[i] = (const float*)d_in[i];
    a.out = (float*)d_out; a.ws = (unsigned char*)d_ws;
    for (int li = 0; li < N_LAUNCHES; ++li) {
        if (N_LAUNCHES == NPHASES) { a.ph_lo = li; a.ph_hi = li + 1; } else { a.ph_lo = (int)((long)li * NPHASES / N_LAUNCHES); a.ph_hi = (int)((long)(li + 1) * NPHASES / N_LAUNCHES); }
        a.li = li;
        hipLaunchKernelGGL(mk_fwd, dim3(grid), dim3(NTHREADS), LDS_BYTES, stream, a);
        const hipError_t le = hipPeekAtLastError();
        if (le != hipSuccess) { fprintf(stderr, "kernel_launch: launch %d failed: %s\n", li, hipGetErrorName(le)); break; }
    }
}
```

```cpp
#include <hip/hip_runtime.h>
#include <cstdio>
#include <cstdint>

namespace pg8 {
#define PG8_LAS __attribute__((address_space(3)))
typedef unsigned short bf16_t;
typedef short bf16x8 __attribute__((ext_vector_type(8)));
typedef float f32x4 __attribute__((ext_vector_type(4)));
typedef unsigned u32x4 __attribute__((ext_vector_type(4)));
constexpr int BM = 256, BK = 64, HALF = 128, HTB = HALF * BK * 2  , STAGE_BYTES = 8 * HTB, NXCD = 8, WGM = 8;

__host__ __device__ __forceinline__ int lds_byte(int r, int c) { const int st = (r >> 4) * 2 + (c >> 5), rr = r & 15, cc = c & 31, ob = rr * 64 + cc * 2; return st * 1024 + (ob ^ (((ob >> 9) & 1) << 5)); }
__host__ __device__ __forceinline__ void stage_rc(int b, int& R, int& C) { const int st = b / 1024, sb = b % 1024, swz = sb ^ (((sb >> 9) & 1) << 5); R = (st >> 1) * 16 + swz / 64; C = (st & 1) * 32 + (swz % 64) / 2; }
__host__ __device__ __forceinline__ int perm32(int rho) { const int n = rho >> 4, i = rho & 15; return 8 * (i >> 2) + 4 * n + (i & 3); }

struct Unit { int pm, pn, e; long bofs; };
struct Gemm { const bf16_t* A; const bf16_t* Bt; int M, N, K; };

struct StaticOrder {
    int nM, nN, nwg, G, c;
    __host__ __device__ void init(int M, int N, int G_, int c_) { nM = M / BM; nN = N / BM; nwg = nM * nN; G = G_; c = c_; }
    __host__ __device__ bool next(int i, Unit& u) const {
        const long L = (long)i * G + c; if (L >= nwg) return false;
        int wgid = (int)L; { const int q = nwg / NXCD, r = nwg % NXCD, xcd = wgid % NXCD, off = wgid / NXCD; wgid = (xcd < r ? xcd * (q + 1) : r * (q + 1) + (xcd - r) * q) + off; }
        const int nig = WGM * nN, gid = wgid / nig, fm = gid * WGM, gsz = (nM - fm) < WGM ? (nM - fm) : WGM;
        u.pm = fm + ((wgid % nig) % gsz); u.pn = (wgid % nig) / gsz; u.e = 0; u.bofs = 0; return true;
    }
    __device__ __forceinline__ void a_ready(const Unit&) const {}
    __device__ __forceinline__ void done(const Unit&) const {}
};
struct MoeOrder {
    const int* tile_e; int nT, nN, G, c; long estride;
    __device__ __forceinline__ bool next(int i, Unit& u) const {
        const long L = (long)i * G + c; if (L >= (long)nT * nN) return false;
        u.pm = (int)(L / nN); u.pn = (int)(L % nN); const int e = tile_e[u.pm]; u.e = e; u.bofs = (long)e * estride; return true;
    }
    __device__ __forceinline__ void a_ready(const Unit&) const {}
    __device__ __forceinline__ void done(const Unit&) const {}
};

struct BatchOrder {
    int nN, nwg, G, c, tiles_per_batch; long bstride;
    __device__ __forceinline__ bool next(int i, Unit& u) const {
        const long L = (long)i * G + c; if (L >= nwg) return false;
        u.pm = (int)(L / nN); u.pn = (int)(L % nN); const int e = u.pm / tiles_per_batch; u.e = e; u.bofs = (long)e * bstride; return true;
    }
    __device__ __forceinline__ void a_ready(const Unit&) const {}
    __device__ __forceinline__ void done(const Unit&) const {}
};

__device__ __forceinline__ unsigned cvt_pk_bf16(float lo, float hi) { unsigned r; asm volatile("v_cvt_pk_bf16_f32 %0, %1, %2" : "=v"(r) : "v"(lo), "v"(hi)); return r; }
__device__ __forceinline__ u32x4 pack8(const f32x4 v0, const f32x4 v1) { u32x4 w; w.x = cvt_pk_bf16(v0[0], v0[1]); w.y = cvt_pk_bf16(v0[2], v0[3]); w.z = cvt_pk_bf16(v1[0], v1[1]); w.w = cvt_pk_bf16(v1[2], v1[3]); return w; }
__device__ __forceinline__ float bf_lo(unsigned w) { return __uint_as_float(w << 16); }
__device__ __forceinline__ float bf_hi(unsigned w) { return __uint_as_float(w & 0xffff0000u); }
__device__ __forceinline__ float sigmoidf_(float x) { return 1.0f / (1.0f + __expf(-x)); }
typedef unsigned u32x2 __attribute__((ext_vector_type(2)));

template <class T> struct Epi {
    static constexpr bool PERM = true, AFTER_DRAIN = false;
    T t;
    __device__ __forceinline__ void operator()(const f32x4 (&acc)[2][2][4][2], const Unit& u, int wr, int wc, int fr, int fq) const {
        const int row0 = u.pm * BM + wr * 64 + fr, col0 = u.pn * BM + wc * 32 + 8 * fq;
#pragma unroll
        for (int ai = 0; ai < 2; ++ai)
#pragma unroll
            for (int m = 0; m < 4; ++m) {
#pragma unroll
                for (int bj = 0; bj < 2; ++bj) t.store(row0 + ai * HALF + m * 16, col0 + bj * HALF, acc[ai][bj][m][0], acc[ai][bj][m][1], u);
                asm volatile("" ::: "memory"); }
    }
};
struct StBf16 { bf16_t* O; int ld;
    __device__ __forceinline__ void store(int row, int col, f32x4 v0, f32x4 v1, const Unit&) const { *(u32x4*)(O + (size_t)row * ld + col) = pack8(v0, v1); } };
struct StInAB { float* SM; bf16_t* Q;
    __device__ __forceinline__ void store(int row, int col, f32x4 v0, f32x4 v1, const Unit&) const {
        if (col < 512) { float* p = SM + (size_t)row * 512 + col; *(f32x4*)p = v0; *(f32x4*)(p + 4) = v1; }
        else *(u32x4*)(Q + (size_t)row * 2048 + (col - 512)) = pack8(v0, v1); } };
struct StPre { const float* base; float* P; float alpha;
    __device__ __forceinline__ void store(int row, int col, f32x4 v0, f32x4 v1, const Unit&) const {
        const size_t o = (size_t)row * 1024 + col; const f32x4 b0 = *(const f32x4*)(base + o), b1 = *(const f32x4*)(base + o + 4);
        *(f32x4*)(P + o) = b0 * alpha + v0; *(f32x4*)(P + o + 4) = b1 * alpha + v1; } };
struct StPleGate { const bf16_t* PP; bf16_t* O;
    __device__ __forceinline__ void store(int row, int col, f32x4 v0, f32x4 v1, const Unit&) const {
        const size_t o = (size_t)row * 1024 + col; const u32x4 p = *(const u32x4*)(PP + o);
        f32x4 r0, r1;
        r0[0] = sigmoidf_(v0[0]) * bf_lo(p.x); r0[1] = sigmoidf_(v0[1]) * bf_hi(p.x); r0[2] = sigmoidf_(v0[2]) * bf_lo(p.y); r0[3] = sigmoidf_(v0[3]) * bf_hi(p.y);
        r1[0] = sigmoidf_(v1[0]) * bf_lo(p.z); r1[1] = sigmoidf_(v1[1]) * bf_hi(p.z); r1[2] = sigmoidf_(v1[2]) * bf_lo(p.w); r1[3] = sigmoidf_(v1[3]) * bf_hi(p.w);
        *(u32x4*)(O + o) = pack8(r0, r1); } };
template <bool F8> struct StSwiglu { const float* bgu; bf16_t* H;
    __device__ __forceinline__ float act(float g, float u) const { const float gt = fminf(g, 7.0f), up = fminf(fmaxf(u, -7.0f), 7.0f); return (up + 1.0f) * (gt * sigmoidf_(gt * 1.702f)); }
    __device__ __forceinline__ void store(int row, int col, f32x4 v0, f32x4 v1, const Unit& u) const {
        const float* b = bgu + (size_t)u.e * 2048 + col; const f32x4 b0 = *(const f32x4*)b, b1 = *(const f32x4*)(b + 4);
        v0 = v0 + b0; v1 = v1 + b1;
        if (F8) { unsigned w = 0u; w = __builtin_amdgcn_cvt_pk_fp8_f32(act(v0[0], v0[1]), act(v0[2], v0[3]), w, false); w = __builtin_amdgcn_cvt_pk_fp8_f32(act(v1[0], v1[1]), act(v1[2], v1[3]), w, true);
            *(unsigned*)((unsigned char*)H + (size_t)row * 1024 + (col >> 1)) = w; }
        else { u32x2 w; w.x = cvt_pk_bf16(act(v0[0], v0[1]), act(v0[2], v0[3])); w.y = cvt_pk_bf16(act(v1[0], v1[1]), act(v1[2], v1[3]));
            *(u32x2*)(H + (size_t)row * 1024 + (col >> 1)) = w; } } };
struct StDown { const float* bd; bf16_t* Y;
    __device__ __forceinline__ void store(int row, int col, f32x4 v0, f32x4 v1, const Unit& u) const {
        const float* b = bd + (size_t)u.e * 1024 + col; const f32x4 b0 = *(const f32x4*)b, b1 = *(const f32x4*)(b + 4);
        *(u32x4*)(Y + (size_t)row * 1024 + col) = pack8(v0 + b0, v1 + b1); } };

typedef int i32x8 __attribute__((ext_vector_type(8)));
typedef int i32x4 __attribute__((ext_vector_type(4)));
template <class Epi, class Sched, bool ALIGN_EPI = false, bool SP2 = false, unsigned FP8W = 0u>
__device__ __forceinline__ void gemm_phase(PG8_LAS unsigned char* lds, const Gemm g, const Sched& S, const Epi& E) {
    int tid = threadIdx.x; asm volatile("" : "+v"(tid));
    const int wid = __builtin_amdgcn_readfirstlane(tid >> 6), lane = tid & 63, wr = wid >> 2, wc = wid & 3, fr = lane & 15, fq = lane >> 4;
    int K = g.K; asm volatile("" : "+s"(K));
    const int nt = K / BK;
    unsigned voffA[2], voffB[2];
#pragma unroll
    for (int i = 0; i < 2; ++i) { int R, C; stage_rc(tid * 16 + i * 8192, R, C); const int Rb = Epi::PERM ? ((R & ~31) + perm32(R & 31)) : R;
        voffA[i] = (unsigned)(R * K + C) * 2u; voffB[i] = (unsigned)(Rb * K + C) * 2u; }
    const size_t kstep = (size_t)(BK * 2);
    const size_t hstep = (size_t)HALF * K * 2;
    const size_t tstep = 2 * hstep;
    const unsigned ldsw = (unsigned)wid * 1024u;
    const int aoff = lds_byte(wr * 64 + fr, fq * 8), boff = lds_byte(wc * 32 + fr, fq * 8);
#define PG8_SA(b, h) (((b) * 2 + (h)) * HTB)
#define PG8_SB(b, h) ((4 + (b) * 2 + (h)) * HTB)
#define PG8_STAGE(bufoff, gbase, voff) do { _Pragma("unroll") for (int _i = 0; _i < 2; ++_i) \
        __builtin_amdgcn_global_load_lds((const unsigned*)((const char*)(gbase) + (voff)[_i]), (PG8_LAS unsigned*)(lds + (bufoff) + ldsw + _i * 8192), 16, 0, 0); } while (0)
#define PG8_CAT(lo, hi) __builtin_shufflevector((lo), (hi), 0, 1, 2, 3, 4, 5, 6, 7)
#define PG8_LDA(dst, b, h) do { if constexpr (FP8W != 0u) { _Pragma("unroll") for (int m = 0; m < 4; ++m) dst##8[m] = PG8_CAT(*(const PG8_LAS i32x4*)(lds + PG8_SA(b, h) + aoff + m * 2048), *(const PG8_LAS i32x4*)(lds + PG8_SA(b, h) + aoff + m * 2048 + 1024)); } \
        else { _Pragma("unroll") for (int m = 0; m < 4; ++m) _Pragma("unroll") for (int k = 0; k < 2; ++k) dst[m][k] = *(const PG8_LAS bf16x8*)(lds + PG8_SA(b, h) + aoff + m * 2048 + k * 1024); } } while (0)
#define PG8_LDB(dst, b, h) do { if constexpr (FP8W != 0u) { _Pragma("unroll") for (int n = 0; n < 2; ++n) dst##8[n] = PG8_CAT(*(const PG8_LAS i32x4*)(lds + PG8_SB(b, h) + boff + n * 2048), *(const PG8_LAS i32x4*)(lds + PG8_SB(b, h) + boff + n * 2048 + 1024)); } \
        else { _Pragma("unroll") for (int n = 0; n < 2; ++n) _Pragma("unroll") for (int k = 0; k < 2; ++k) dst[n][k] = *(const PG8_LAS bf16x8*)(lds + PG8_SB(b, h) + boff + n * 2048 + k * 1024); } } while (0)
#define PG8_MMA(ai, bj, At, Bt) do { __builtin_amdgcn_s_setprio(1); _Pragma("unroll") for (int m = 0; m < 4; ++m) _Pragma("unroll") for (int n = 0; n < 2; ++n) { \
        if constexpr (FP8W != 0u) asm volatile("v_mfma_scale_f32_16x16x128_f8f6f4 %0, %1, %2, %0, %3, %4 op_sel_hi:[0,0,0]" : "+v"(acc[ai][bj][m][n]) : "v"(Bt##8[n]), "v"(At##8[m]), "v"(sc_w), "v"(sc_x));   \
        else { _Pragma("unroll") for (int k = 0; k < 2; ++k) acc[ai][bj][m][n] = __builtin_amdgcn_mfma_f32_16x16x32_bf16(Bt[n][k], At[m][k], acc[ai][bj][m][n], 0, 0, 0); } } __builtin_amdgcn_s_setprio(0); } while (0)
#define PG8_WAIT_V(n) asm volatile("s_waitcnt vmcnt(" #n ")" ::: "memory")
#define PG8_WAIT_L(n) asm volatile("s_waitcnt lgkmcnt(" #n ")" ::: "memory")
#define PG8_BAR __builtin_amdgcn_s_barrier()
#define PG8_SCHED __builtin_amdgcn_sched_barrier(0)
    Unit cur, nxt; int ui = 0;
    if (!S.next(0, cur)) return;
    f32x4 acc[2][2][4][2];
#pragma unroll
    for (int a = 0; a < 2; ++a)
#pragma unroll
        for (int b = 0; b < 2; ++b)
#pragma unroll
            for (int m = 0; m < 4; ++m)
#pragma unroll
                for (int n = 0; n < 2; ++n) acc[a][b][m][n] = (f32x4){0.f, 0.f, 0.f, 0.f};
    bf16x8 At[4][2], B0[2][2], B1[2][2];
    int sc_w = (int)FP8W, sc_x = 0x7f7f7f7f; asm volatile("" : "+v"(sc_w), "+v"(sc_x));
    i32x8 At8[4], B08[2], B18[2];
    const char* cA = (const char*)g.A + (size_t)cur.pm * tstep; const char* cB = (const char*)g.Bt + (size_t)cur.pn * tstep + cur.bofs;
    S.a_ready(cur);
    if constexpr (SP2) {
        PG8_STAGE(PG8_SB(0, 0), cB, voffB); PG8_STAGE(PG8_SB(0, 1), cB + hstep, voffB); PG8_STAGE(PG8_SA(0, 0), cA, voffA); PG8_STAGE(PG8_SA(0, 1), cA + hstep, voffA);
        if (wr == 1) PG8_BAR;
        PG8_WAIT_V(2); PG8_BAR;
        PG8_STAGE(PG8_SB(1, 0), cB + kstep, voffB); PG8_STAGE(PG8_SA(1, 0), cA + kstep, voffA); PG8_STAGE(PG8_SB(1, 1), cB + hstep + kstep, voffB);
        PG8_WAIT_V(6); PG8_BAR;
    } else {
        PG8_STAGE(PG8_SB(0, 0), cB, voffB); PG8_STAGE(PG8_SA(0, 0), cA, voffA); PG8_STAGE(PG8_SB(0, 1), cB + hstep, voffB); PG8_STAGE(PG8_SA(0, 1), cA + hstep, voffA);
        if (wr == 1) PG8_BAR;
        PG8_WAIT_V(4); PG8_BAR;
        PG8_STAGE(PG8_SB(1, 0), cB + kstep, voffB); PG8_STAGE(PG8_SA(1, 0), cA + kstep, voffA); PG8_STAGE(PG8_SB(1, 1), cB + hstep + kstep, voffB);
        PG8_WAIT_V(6); PG8_BAR;
    }
    for (;;) {
        const bool has_next = S.next(ui + 1, nxt);
        const char* nA = has_next ? (const char*)g.A + (size_t)nxt.pm * tstep : cA; const char* nB = has_next ? (const char*)g.Bt + (size_t)nxt.pn * tstep + nxt.bofs : cB;
        for (int t = 0; t < nt; t += 2) {
            const bool last = (t == nt - 2);
            const char* a1 = cA + (size_t)(t + 1) * kstep;
            const char* a2 = last ? nA : cA + (size_t)(t + 2) * kstep; const char* b2 = last ? nB : cB + (size_t)(t + 2) * kstep;
            const char* a3 = a2 + kstep; const char* b3 = b2 + kstep;
            if (last && has_next) S.a_ready(nxt);
            if constexpr (SP2) {
            PG8_LDB(B0, 0, 0); PG8_LDB(B1, 0, 1); PG8_SCHED; PG8_LDA(At, 0, 0); PG8_STAGE(PG8_SA(1, 1), a1 + hstep, voffA);
            PG8_WAIT_V(8); PG8_WAIT_L(0); PG8_BAR; PG8_MMA(0, 0, At, B0); PG8_MMA(0, 1, At, B1); PG8_BAR; PG8_SCHED;
            PG8_LDA(At, 0, 1); PG8_STAGE(PG8_SB(0, 0), b2, voffB); PG8_STAGE(PG8_SB(0, 1), b2 + hstep, voffB); PG8_STAGE(PG8_SA(0, 0), a2, voffA);
            PG8_WAIT_V(8); PG8_WAIT_L(0); PG8_BAR; PG8_MMA(1, 0, At, B0); PG8_MMA(1, 1, At, B1); PG8_BAR; PG8_SCHED;
            PG8_LDB(B0, 1, 0); PG8_LDB(B1, 1, 1); PG8_SCHED; PG8_LDA(At, 1, 0); PG8_STAGE(PG8_SA(0, 1), a2 + hstep, voffA);
            PG8_WAIT_V(8); PG8_WAIT_L(0); PG8_BAR; PG8_MMA(0, 0, At, B0); PG8_MMA(0, 1, At, B1); PG8_BAR; PG8_SCHED;
            PG8_LDA(At, 1, 1); PG8_STAGE(PG8_SB(1, 0), b3, voffB); PG8_STAGE(PG8_SB(1, 1), b3 + hstep, voffB); PG8_STAGE(PG8_SA(1, 0), a3, voffA);
            PG8_WAIT_V(8); PG8_WAIT_L(0); PG8_BAR; PG8_MMA(1, 0, At, B0); PG8_MMA(1, 1, At, B1); PG8_BAR; PG8_SCHED;
            } else {
            PG8_LDB(B0, 0, 0); PG8_SCHED; PG8_LDA(At, 0, 0); PG8_STAGE(PG8_SA(1, 1), a1 + hstep, voffA);
            PG8_WAIT_L(8); PG8_BAR; PG8_WAIT_L(0); PG8_MMA(0, 0, At, B0); PG8_BAR; PG8_SCHED;
            PG8_LDB(B1, 0, 1); PG8_STAGE(PG8_SB(0, 0), b2, voffB);
            PG8_BAR; PG8_WAIT_L(0); PG8_MMA(0, 1, At, B1); PG8_BAR;
            PG8_LDA(At, 0, 1); PG8_STAGE(PG8_SA(0, 0), a2, voffA);
            PG8_BAR; PG8_WAIT_L(0); PG8_MMA(1, 0, At, B0); PG8_BAR; PG8_SCHED;
            PG8_STAGE(PG8_SB(0, 1), b2 + hstep, voffB);
            PG8_WAIT_V(6); PG8_BAR; PG8_MMA(1, 1, At, B1); PG8_BAR;
            PG8_LDB(B0, 1, 0); PG8_SCHED; PG8_LDA(At, 1, 0); PG8_STAGE(PG8_SA(0, 1), a2 + hstep, voffA);
            PG8_WAIT_L(8); PG8_BAR; PG8_WAIT_L(0); PG8_MMA(0, 0, At, B0); PG8_BAR; PG8_SCHED;
            PG8_LDB(B1, 1, 1); PG8_STAGE(PG8_SB(1, 0), b3, voffB);
            PG8_BAR; PG8_WAIT_L(0); PG8_MMA(0, 1, At, B1); PG8_BAR;
            PG8_LDA(At, 1, 1); PG8_STAGE(PG8_SA(1, 0), a3, voffA);
            PG8_BAR; PG8_WAIT_L(0); PG8_MMA(1, 0, At, B0); PG8_BAR; PG8_SCHED;
            PG8_STAGE(PG8_SB(1, 1), b3 + hstep, voffB);
            PG8_WAIT_V(6); PG8_BAR; PG8_MMA(1, 1, At, B1); PG8_BAR;
            }
        }
        if constexpr (FP8W != 0u) asm volatile("s_nop 15\n\ts_nop 15" ::: "memory");
        if constexpr (ALIGN_EPI) { if (wr == 0) PG8_BAR; }
        if constexpr (!Epi::AFTER_DRAIN) { E(acc, cur, wr, wc, fr, fq); S.done(cur); }
        if (!has_next) break;
#pragma unroll
        for (int a = 0; a < 2; ++a)
#pragma unroll
            for (int b = 0; b < 2; ++b)
#pragma unroll
                for (int m = 0; m < 4; ++m)
#pragma unroll
                    for (int n = 0; n < 2; ++n) acc[a][b][m][n] = (f32x4){0.f, 0.f, 0.f, 0.f};
        cur = nxt; cA = nA; cB = nB; ++ui;
        if constexpr (ALIGN_EPI) { if (wr == 1) PG8_BAR; }
    }
    PG8_WAIT_V(0);
    if constexpr (!ALIGN_EPI) { if (wr == 0) PG8_BAR; }
    PG8_BAR;
    if constexpr (Epi::AFTER_DRAIN) { E.fused(acc, cur, wr, wc, fr, fq, lds, wid, lane); S.done(cur); }
#undef PG8_SA
#undef PG8_SB
#undef PG8_STAGE
#undef PG8_LDA
#undef PG8_CAT
#undef PG8_LDB
#undef PG8_MMA
#undef PG8_WAIT_V
#undef PG8_WAIT_L
#undef PG8_BAR
#undef PG8_SCHED
}
}

constexpr int NWAVES = 8, NTHREADS = 512;
constexpr int BATCH = 2, SEQ = 8192, M = BATCH * SEQ, D = 1024;
constexpr int NEXP = 32, DEXP = 1024;
constexpr int PMAX = M * 4 + NEXP * 256, NTMAX = PMAX / 256;
constexpr float ALPHA = 1.41421356237f;
constexpr int NPHASES = 21;
#ifndef MOE_FP8
#define MOE_FP8 1
#endif
constexpr bool kMoeFp8 = (MOE_FP8 != 0);
constexpr unsigned kScaleGU = 0x79797979u, kScaleDN = 0x78787878u;
#ifndef MK_N_LAUNCHES
#define MK_N_LAUNCHES 1
#endif
constexpr int N_LAUNCHES = MK_N_LAUNCHES;

enum { I_X = 0, I_P, I_AB_WIN, I_AB_QG, I_AB_KVG, I_AB_WUQ, I_AB_WUK, I_AB_WUV, I_AB_WQIDX, I_AB_KIG, I_AB_KIB, I_AB_CONVW, I_AB_ALOG, I_AB_DTB, I_AB_ONG, I_AB_WOUT,
       I_CD_WIN, I_CD_POOLW, I_CD_POOLS, I_CD_WOUT, I_LNM_G, I_LNM_B, I_RW, I_RB, I_WGU, I_BGU, I_WDN, I_BDN, I_PLE_WP, I_PLE_WG, I_LNF_G, I_LNF_B, N_IN };

constexpr size_t MiB = 1u << 20;
constexpr size_t WS_CTL = 0, CTL_ZERO_BYTES = 1 * MiB;
constexpr size_t WS_W_INAB = 1 * MiB;
constexpr size_t WS_W_ABS = 6 * MiB;
constexpr size_t WS_W_OUTAB = 7 * MiB;
constexpr size_t WS_W_INCD = 10 * MiB;
constexpr size_t WS_W_OUTCD = 15 * MiB;
constexpr size_t WS_W_PG = 17 * MiB;
constexpr size_t WS_W_PP = 21 * MiB;
constexpr size_t WS_W_GU = 22 * MiB;
constexpr size_t WS_W_DN = 278 * MiB;
constexpr size_t WS_XB = 406 * MiB;
constexpr size_t WS_PB = 438 * MiB;
constexpr size_t WS_PP = 454 * MiB;
constexpr size_t WS_SM = 518 * MiB;
constexpr size_t WS_QKVZ = 550 * MiB;
constexpr size_t WS_CQ = 630 * MiB;
constexpr size_t WS_CKV = 638 * MiB;
constexpr size_t WS_KIDX = 642 * MiB;
constexpr size_t WS_WIDX = 644 * MiB;
constexpr size_t WS_BETA = 645 * MiB;
constexpr size_t WS_GG = WS_BETA + 512 * 1024;
constexpr size_t WS_QN = 646 * MiB, WS_KN = 662 * MiB, WS_VN = 678 * MiB;
constexpr size_t WS_QL = 694 * MiB;
constexpr size_t WS_CHK = 742 * MiB;
constexpr size_t WS_SEL = 838 * MiB;
constexpr size_t WS_NSEL = 854 * MiB;
constexpr size_t WS_ODELTA = 855 * MiB;
constexpr size_t WS_AO = 887 * MiB;
constexpr size_t WS_PRE = 935 * MiB;
constexpr size_t WS_H1 = 999 * MiB;
constexpr size_t WS_H2 = 1063 * MiB;
constexpr size_t WS_H1B = 1127 * MiB;
constexpr size_t WS_PLE = 1159 * MiB;
constexpr size_t WS_ROUTE = 1191 * MiB;
constexpr size_t WS_BIG = 1193 * MiB;
constexpr size_t WS_XS = WS_BIG, WS_HID = WS_BIG + 144 * MiB, WS_YS = WS_BIG + 288 * MiB;
constexpr size_t WS_END = WS_BIG + 512 * MiB;
static_assert((size_t)PMAX * 1024 * 2 <= 144 * MiB && WS_END <= 2048 * MiB, "d_ws map");
constexpr size_t CHK_WP = 0, CHK_QD = 16384, CHK_KDT = 32768, CHK_QK = 49152, CHK_UT = 57344, CHK_GL = 90112, CHK_STRIDE = 92160;
static_assert(CHK_STRIDE * 1024 <= 96 * MiB, "chunk operands");
constexpr int CW_TMO = 0, CW_CODE = 1;
constexpr int CW_BAR = 4096;
constexpr int CW_BAR2 = 8192;
constexpr int CW_CNT = 16384;

constexpr int RING_OFF = 0, RING_BYTES = 131072;
constexpr int WSCR_OFF = 132096, WSCR_BYTES = 1024;
constexpr int MISC_OFF = 140288;
constexpr int LDS_BYTES = 147456;

#define GAS __attribute__((address_space(1)))
#define LAS __attribute__((address_space(3)))
typedef unsigned short bf16;
typedef unsigned v4u __attribute__((ext_vector_type(4)));
typedef unsigned v2u __attribute__((ext_vector_type(2)));
typedef float f32x4 __attribute__((ext_vector_type(4)));
typedef short bf16x8 __attribute__((ext_vector_type(8)));
typedef GAS unsigned gu32;
#define RLX_AGENT __ATOMIC_RELAXED, __HIP_MEMORY_SCOPE_AGENT
__device__ __forceinline__ unsigned f2bf(float f) { unsigned u = __builtin_bit_cast(unsigned, f); return (u + 0x7fffu + ((u >> 16) & 1u)) >> 16; }
__device__ __forceinline__ unsigned pk2(float lo, float hi) { return f2bf(lo) | (f2bf(hi) << 16); }
__device__ __forceinline__ float bflo(unsigned w) { return __uint_as_float(w << 16); }
__device__ __forceinline__ float bfhi(unsigned w) { return __uint_as_float(w & 0xffff0000u); }
__device__ __forceinline__ float bf1(bf16 h) { return __uint_as_float(((unsigned)h) << 16); }
__device__ __forceinline__ float sigm(float x) { return 1.0f / (1.0f + __expf(-x)); }
__device__ __forceinline__ float siluf(float x) { return x / (1.0f + __expf(-x)); }
__device__ __forceinline__ float wave_sum(float v) {
#pragma unroll
    for (int o = 1; o < 64; o <<= 1) v += __shfl_xor(v, o);
    return v;
}
__device__ __forceinline__ float wave_max(float v) {
#pragma unroll
    for (int o = 1; o < 64; o <<= 1) v = fmaxf(v, __shfl_xor(v, o));
    return v;
}
__device__ __forceinline__ int wave_sum_i(int v) {
#pragma unroll
    for (int o = 1; o < 64; o <<= 1) v += __shfl_xor(v, o);
    return v;
}
__device__ __forceinline__ void unpack8(const v4u w, float (&f)[8]) { f[0] = bflo(w.x); f[1] = bfhi(w.x); f[2] = bflo(w.y); f[3] = bfhi(w.y); f[4] = bflo(w.z); f[5] = bfhi(w.z); f[6] = bflo(w.w); f[7] = bfhi(w.w); }
__device__ __forceinline__ v4u pack8f(const float (&f)[8]) { v4u w; w.x = pk2(f[0], f[1]); w.y = pk2(f[2], f[3]); w.z = pk2(f[4], f[5]); w.w = pk2(f[6], f[7]); return w; }

#define XB_TMO      128
#define XB_XCNT(j)  (256  + 64 * (j))
#define XB_XSUB(j)  (1280 + 64 * (j))
#define XB_XGEN(j)  (2304 + 64 * (j))
#define XB_TOP      3328
#define XB_TOPGEN   3392
#define XCD_BAR_WORDS 3456
#define XB_SPIN_CAP (1u << 18)

__device__ __forceinline__ unsigned xb_ld(unsigned* p)              { return __hip_atomic_load(p, __ATOMIC_RELAXED, __HIP_MEMORY_SCOPE_AGENT); }
__device__ __forceinline__ unsigned xb_add(unsigned* p, unsigned v) { return __hip_atomic_fetch_add(p, v, __ATOMIC_RELAXED, __HIP_MEMORY_SCOPE_AGENT); }
__device__ __forceinline__ unsigned xb_xcc_id() { return (unsigned)__builtin_amdgcn_s_getreg((3 << 11) | 20) & 0xFu; }
#define XB_SPIN(cond, bar) do { unsigned _sp = 0; while (cond) { __builtin_amdgcn_s_sleep(1); \
    if ((++_sp & 255u) == 0u) { if (xb_ld(&(bar)[XB_TMO])) break; if (_sp > XB_SPIN_CAP) { atomicAdd(&(bar)[XB_TMO], 1u); break; } } } } while (0)

struct XcdBarrier {
    unsigned* bar; unsigned x;
    unsigned expect;
    volatile LAS unsigned* st;
};

__device__ __forceinline__ XcdBarrier xcd_barrier_post(unsigned* bar, volatile LAS unsigned* st, unsigned expect = 0u) {
    XcdBarrier b; b.bar = bar; b.x = xb_xcc_id(); b.st = st; b.expect = expect ? expect : gridDim.x * gridDim.y * gridDim.z;
    if (threadIdx.x == 0) (void)xb_add(&bar[XB_XCNT(b.x)], 1u);
    return b;
}
__device__ __forceinline__ void xcd_barrier_complete(unsigned* bar, unsigned x, unsigned& nloc, unsigned& nx, const unsigned G) {
    unsigned sum, cnt, mine, sp = 0u;
    for (;;) {
        sum = 0u; cnt = 0u; mine = 0u;
#pragma unroll
        for (unsigned j = 0; j < 16; ++j) { const unsigned c = xb_ld(&bar[XB_XCNT(j)]); sum += c; cnt += (c > 0u) ? 1u : 0u; mine = (j == x) ? c : mine; }
        if (sum == G) break;
        __builtin_amdgcn_s_sleep(1);
        if ((++sp & 255u) == 0u) { if (xb_ld(&bar[XB_TMO])) break; if (sp > XB_SPIN_CAP) { atomicAdd(&bar[XB_TMO], 1u); break; } }
    }
    nloc = mine > 0u ? mine : 1u; nx = cnt > 0u ? cnt : 1u;
}

__device__ __forceinline__ void xcd_barrier(const XcdBarrier& b) {
    asm volatile("s_waitcnt vmcnt(0)" ::: "memory");
    __syncthreads();
    if (threadIdx.x == 0) {
        unsigned* bar = b.bar;
        __builtin_amdgcn_s_waitcnt(0);
        unsigned nloc = b.st[0], nx = b.st[1];
        if (nloc == 0u) { xcd_barrier_complete(bar, b.x, nloc, nx, b.expect); b.st[0] = nloc; b.st[1] = nx; }
        const unsigned old = xb_add(&bar[XB_XSUB(b.x)], 1u);
        const unsigned gen = old / nloc;
        if (old + 1u == (gen + 1u) * nloc) {
            __builtin_amdgcn_fence(__ATOMIC_RELEASE, "agent");
            asm volatile("s_waitcnt vmcnt(0)" ::: "memory");
            const unsigned og = xb_add(&bar[XB_TOP], 1u);
            const unsigned tg = og / nx;
            if (og + 1u == (tg + 1u) * nx) xb_add(&bar[XB_TOPGEN], 1u);
            else XB_SPIN(xb_ld(&bar[XB_TOPGEN]) == tg, bar);
            __builtin_amdgcn_fence(__ATOMIC_ACQUIRE, "agent");
            xb_add(&bar[XB_XGEN(b.x)], 1u);
            asm volatile("s_waitcnt vmcnt(0)" ::: "memory");
        } else {
            XB_SPIN(xb_ld(&bar[XB_XGEN(b.x)]) == gen, bar);
            __builtin_amdgcn_fence(__ATOMIC_ACQUIRE, "agent");
            asm volatile("s_waitcnt vmcnt(0)" ::: "memory");
        }
    }
    __syncthreads();
}

struct Args { const float* in[N_IN]; float* out; unsigned char* ws; int ph_lo, ph_hi, li, pad; };
typedef const __attribute__((address_space(4))) Args* KArgs;
__device__ __forceinline__ KArgs kargs() { auto p = __builtin_amdgcn_kernarg_segment_ptr(); asm volatile("" : "+s"(p)); return (KArgs)p; }
struct Frame {
    LAS unsigned char* lds;
    int tid, lane, wave, G, bid;
    unsigned char* ws;
    gu32* ctl;
};
#define WSP(T, off) ((T*)(F.ws + (off)))

struct MapId { __device__ __forceinline__ int operator()(int n) const { return n; } };
struct MapAdd { int off; __device__ __forceinline__ int operator()(int n) const { return n + off; } };
struct MapAB { __device__ __forceinline__ int operator()(int n) const { return n < 456 ? n : (n < 2504 ? n + 56 : n - 2048); } };
template <class Map> __device__ __forceinline__ void wg_transpose_item(const float* W, int N, int ldw, bf16* WT, int ldt, int koff, Map map, LAS float* scr, int item, int tid) {
    const int nblk = (N + 127) >> 7, kb = item / nblk, nb = item - kb * nblk, k0 = kb * 128, n0 = nb * 128;
#pragma unroll
    for (int it = 0; it < 8; ++it) {
        const int row = it * 16 + (tid >> 5), c4 = (tid & 31) * 4, n = n0 + c4;
        f32x4 v = (f32x4){0.f, 0.f, 0.f, 0.f};
        if (n + 3 < N) v = *(const f32x4*)(W + (size_t)(k0 + row) * ldw + n);
        LAS float* s = scr + row * 129 + c4; s[0] = v[0]; s[1] = v[1]; s[2] = v[2]; s[3] = v[3];
    }
    __syncthreads();
#pragma unroll
    for (int j = 0; j < 4; ++j) {
        const int idx = j * 512 + tid, nl = idx >> 4, ch = idx & 15, n = n0 + nl;
        if (n < N) { const LAS float* s = scr + (ch * 8) * 129 + nl;
            v4u o; o.x = pk2(s[0], s[129]); o.y = pk2(s[2 * 129], s[3 * 129]); o.z = pk2(s[4 * 129], s[5 * 129]); o.w = pk2(s[6 * 129], s[7 * 129]);
            *(v4u*)(WT + (size_t)map(n) * ldt + koff + k0 + ch * 8) = o; }
    }
    __syncthreads();
}
__device__ __forceinline__ void wg_transpose_item_fp8(const float* W, int N, int ldw, unsigned char* WT, int ldt, float mul, LAS float* scr, int item, int tid) {
    const int nblk = (N + 127) >> 7, kb = item / nblk, nb = item - kb * nblk, k0 = kb * 128, n0 = nb * 128;
#pragma unroll
    for (int it = 0; it < 8; ++it) {
        const int row = it * 16 + (tid >> 5), c4 = (tid & 31) * 4;
        const f32x4 v = *(const f32x4*)(W + (size_t)(k0 + row) * ldw + n0 + c4);
        LAS float* s = scr + row * 129 + c4; s[0] = v[0]; s[1] = v[1]; s[2] = v[2]; s[3] = v[3];
    }
    __syncthreads();
#pragma unroll
    for (int j = 0; j < 2; ++j) {
        const int idx = j * 512 + tid, nl = idx >> 3, ch = idx & 7;
        const LAS float* s = scr + (ch * 16) * 129 + nl;
        v4u o;
#pragma unroll
        for (int q = 0; q < 4; ++q) { unsigned w = 0u;
            w = __builtin_amdgcn_cvt_pk_fp8_f32(s[(4 * q) * 129] * mul, s[(4 * q + 1) * 129] * mul, w, false);
            w = __builtin_amdgcn_cvt_pk_fp8_f32(s[(4 * q + 2) * 129] * mul, s[(4 * q + 3) * 129] * mul, w, true);
            o[q] = w; }
        *(v4u*)(WT + (size_t)(n0 + nl) * ldt + k0 + ch * 16) = o;
    }
    __syncthreads();
}
struct MoeItem { const float* W; unsigned char* WT; int N; float mul; int k0, n0; };
__device__ __forceinline__ MoeItem moe_item(KArgs A, unsigned char* ws, int it) {
    MoeItem d; int sub;
    if (it < 64 * 128) { const int m = it >> 7; sub = it & 127; d.W = A->in[I_WGU] + (size_t)m * 1024 * 2048; d.N = 2048; d.WT = ws + WS_W_GU + (size_t)m * 2048 * 1024; d.mul = 64.0f; }
    else { it -= 64 * 128; const int m = it >> 6; sub = it & 63; d.W = A->in[I_WDN] + (size_t)m * 1024 * 1024; d.N = 1024; d.WT = ws + WS_W_DN + (size_t)m * 1024 * 1024; d.mul = 128.0f; }
    const int nblk = d.N >> 7, kb = sub / nblk, nb = sub - kb * nblk; d.k0 = kb * 128; d.n0 = nb * 128; return d;
}
__device__ __forceinline__ void p0_moe_fp8(Frame& F, KArgs A) {
    LAS float* scr = (LAS float*)(F.lds + RING_OFF);
    const int tid = F.tid; constexpr int NIT = 64 * 128 + 64 * 64;
    int it = F.bid; if (it >= NIT) return;
    MoeItem cur = moe_item(A, F.ws, it);
    f32x4 r[8];
#pragma unroll
    for (int x = 0; x < 8; ++x) r[x] = *(const f32x4*)(cur.W + (size_t)(cur.k0 + x * 16 + (tid >> 5)) * cur.N + cur.n0 + (tid & 31) * 4);
    for (;;) {
#pragma unroll
        for (int x = 0; x < 8; ++x) { LAS float* sp = scr + (x * 16 + (tid >> 5)) * 129 + (tid & 31) * 4; sp[0] = r[x][0]; sp[1] = r[x][1]; sp[2] = r[x][2]; sp[3] = r[x][3]; }
        __syncthreads();
        const int nx = it + F.G; MoeItem nxt = cur;
        if (nx < NIT) { nxt = moe_item(A, F.ws, nx);
#pragma unroll
            for (int x = 0; x < 8; ++x) r[x] = *(const f32x4*)(nxt.W + (size_t)(nxt.k0 + x * 16 + (tid >> 5)) * nxt.N + nxt.n0 + (tid & 31) * 4); }
#pragma unroll
        for (int j = 0; j < 2; ++j) {
            const int idx = j * 512 + tid, nl = idx >> 3, ch = idx & 7;
            const LAS float* sp = scr + (ch * 16) * 129 + nl;
            v4u o;
#pragma unroll
            for (int q = 0; q < 4; ++q) { unsigned w = 0u;
                w = __builtin_amdgcn_cvt_pk_fp8_f32(sp[(4 * q) * 129] * cur.mul, sp[(4 * q + 1) * 129] * cur.mul, w, false);
                w = __builtin_amdgcn_cvt_pk_fp8_f32(sp[(4 * q + 2) * 129] * cur.mul, sp[(4 * q + 3) * 129] * cur.mul, w, true);
                o[q] = w; }
            *(v4u*)(cur.WT + (size_t)(cur.n0 + nl) * 1024 + cur.k0 + ch * 16) = o;
        }
        __syncthreads();
        if (nx >= NIT) break;
        cur = nxt; it = nx;
    }
}
__device__ __forceinline__ void p0_prologue(Frame& F, KArgs A) {
    LAS float* scr = (LAS float*)(F.lds + RING_OFF);
    const int tid = F.tid;
    constexpr int IT_GU = 128, IT_DN = 64;
    constexpr int N_GU = 64 * IT_GU, N_DN = 64 * IT_DN;
    constexpr int N_INAB = 8 * 20, N_INCD = 8 * 20, N_OUTCD = 64, N_PG = 2 * 64, N_PP = 2 * 2 * 8, N_QIDX = 2 * 4, N_OUTB = 4 * 8;
    constexpr int NITEMS = N_GU + N_DN + N_INAB + N_INCD + N_OUTCD + N_PG + N_PP + N_QIDX + N_OUTB;
    if (kMoeFp8) p0_moe_fp8(F, A);
    for (int it = F.bid + (kMoeFp8 ? N_GU + N_DN : 0); it < NITEMS; it += F.G) {
        int r = it;
        if (r < N_GU) { const int m = r / IT_GU;
            if (kMoeFp8) wg_transpose_item_fp8(A->in[I_WGU] + (size_t)m * 1024 * 2048, 2048, 2048, WSP(unsigned char, WS_W_GU) + (size_t)m * 2048 * 1024, 1024, 64.0f, scr, r % IT_GU, tid);
            else wg_transpose_item(A->in[I_WGU] + (size_t)m * 1024 * 2048, 2048, 2048, WSP(bf16, WS_W_GU) + (size_t)m * 2048 * 1024, 1024, 0, MapId{}, scr, r % IT_GU, tid);
            continue; } r -= N_GU;
        if (r < N_DN) { const int m = r / IT_DN;
            if (kMoeFp8) wg_transpose_item_fp8(A->in[I_WDN] + (size_t)m * 1024 * 1024, 1024, 1024, WSP(unsigned char, WS_W_DN) + (size_t)m * 1024 * 1024, 1024, 128.0f, scr, r % IT_DN, tid);
            else wg_transpose_item(A->in[I_WDN] + (size_t)m * 1024 * 1024, 1024, 1024, WSP(bf16, WS_W_DN) + (size_t)m * 1024 * 1024, 1024, 0, MapId{}, scr, r % IT_DN, tid);
            continue; } r -= N_DN;
        if (r < N_INAB) { wg_transpose_item(A->in[I_AB_WIN], 2512, 2512, WSP(bf16, WS_W_INAB), 1024, 0, MapAB{}, scr, r, tid); continue; } r -= N_INAB;
        if (r < N_INCD) { wg_transpose_item(A->in[I_CD_WIN], 2560, 2560, WSP(bf16, WS_W_INCD), 1024, 0, MapId{}, scr, r, tid); continue; } r -= N_INCD;
        if (r < N_OUTCD) { wg_transpose_item(A->in[I_CD_WOUT], 1024, 1024, WSP(bf16, WS_W_OUTCD), 1024, 0, MapId{}, scr, r, tid); continue; } r -= N_OUTCD;
        if (r < N_PG) { const int l = r / 64; wg_transpose_item(A->in[I_PLE_WG] + (size_t)l * 1024 * 1024, 1024, 1024, WSP(bf16, WS_W_PG) + (size_t)l * 1024 * 1024, 1024, 0, MapId{}, scr, r % 64, tid); continue; } r -= N_PG;
        if (r < N_PP) { const int l = r / 16; wg_transpose_item(A->in[I_PLE_WP] + (size_t)l * 256 * 1024, 1024, 1024, WSP(bf16, WS_W_PP) + (size_t)l * 1024 * 256, 256, 0, MapId{}, scr, r % 16, tid); continue; } r -= N_PP;
        if (r < N_QIDX) { wg_transpose_item(A->in[I_AB_WQIDX], 512, 512, WSP(bf16, WS_W_ABS), 256, 0, MapAdd{1024}, scr, r, tid); continue; } r -= N_QIDX;
        wg_transpose_item(A->in[I_AB_WOUT] + (size_t)512 * 1024, 1024, 1024, WSP(bf16, WS_W_OUTAB), 1536, 1024, MapId{}, scr, r, tid);
    }
    const size_t gt = (size_t)F.bid * NTHREADS + tid, GT = (size_t)F.G * NTHREADS;
    for (size_t i = gt; i < (size_t)48 * 1024 / 8; i += GT) *(v4u*)(WSP(bf16, WS_W_INAB) + (size_t)464 * 1024 + i * 8) = (v4u){0u, 0u, 0u, 0u};
    for (size_t i = gt; i < (size_t)1024 * 256; i += GT) {
        const int n = (int)(i >> 8), c = (int)(i & 255), h = n >> 7, r = n & 127;
        const float* a = A->in[I_AB_WUQ] + (size_t)c * 512 + h * 64; const float* b = A->in[I_AB_WUK] + (size_t)r * 512 + h * 64;
        float s = 0.f;
#pragma unroll 8
        for (int d = 0; d < 64; d += 4) { const f32x4 x = *(const f32x4*)(a + d), y = *(const f32x4*)(b + d); s += x[0] * y[0] + x[1] * y[1] + x[2] * y[2] + x[3] * y[3]; }
        WSP(bf16, WS_W_ABS)[i] = (bf16)f2bf(s * 0.125f);
    }
    for (size_t i = gt; i < (size_t)1024 * 1024; i += GT) {
        const int n = (int)(i >> 10), k = (int)(i & 1023), h = k >> 7, r = k & 127;
        const float* a = A->in[I_AB_WUV] + (size_t)r * 512 + h * 64; const float* b = A->in[I_AB_WOUT] + (size_t)(h * 64) * 1024 + n;
        float s = 0.f;
#pragma unroll 8
        for (int v = 0; v < 64; ++v) s += a[v] * b[(size_t)v * 1024];
        WSP(bf16, WS_W_OUTAB)[(size_t)n * 1536 + k] = (bf16)f2bf(s);
    }
    for (size_t i = gt; i < (size_t)M * D / 8; i += GT) { const f32x4 a = *(const f32x4*)(A->in[I_X] + i * 8), b = *(const f32x4*)(A->in[I_X] + i * 8 + 4);
        v4u o; o.x = pk2(a[0], a[1]); o.y = pk2(a[2], a[3]); o.z = pk2(b[0], b[1]); o.w = pk2(b[2], b[3]); *(v4u*)(WSP(bf16, WS_XB) + i * 8) = o; }
    for (size_t i = gt; i < (size_t)2 * M * 256 / 8; i += GT) { const f32x4 a = *(const f32x4*)(A->in[I_P] + i * 8), b = *(const f32x4*)(A->in[I_P] + i * 8 + 4);
        v4u o; o.x = pk2(a[0], a[1]); o.y = pk2(a[2], a[3]); o.z = pk2(b[0], b[1]); o.w = pk2(b[2], b[3]); *(v4u*)(WSP(bf16, WS_PB) + i * 8) = o; }
}

__device__ __forceinline__ void p2_prep(Frame& F, KArgs A) {
    const int lane = F.lane, gw = F.bid * NWAVES + F.wave, NGW = F.G * NWAVES;
    const float* SM = WSP(float, WS_SM); const bf16* QZ = WSP(bf16, WS_QKVZ);
    const f32x4 qg = *(const f32x4*)(A->in[I_AB_QG] + 4 * lane);
    const f32x4 kvg = *(const f32x4*)(A->in[I_AB_KVG] + 4 * (lane & 31));
    const f32x4 kig = *(const f32x4*)(A->in[I_AB_KIG] + 4 * (lane & 15)), kib = *(const f32x4*)(A->in[I_AB_KIB] + 4 * (lane & 15));
    const f32x4 alog = *(const f32x4*)(A->in[I_AB_ALOG]), dtb = *(const f32x4*)(A->in[I_AB_DTB]);
    for (int row = gw; row < M; row += NGW) {
        const int t = row & (SEQ - 1);
        const f32x4 a = *(const f32x4*)(SM + (size_t)row * 512 + 4 * lane), b = *(const f32x4*)(SM + (size_t)row * 512 + 256 + 4 * lane);
        {
            const float ss = wave_sum(a[0] * a[0] + a[1] * a[1] + a[2] * a[2] + a[3] * a[3]);
            const float r = rsqrtf(ss * (1.0f / 256.0f) + 1e-6f);
            v2u o; o.x = pk2(a[0] * r * qg[0], a[1] * r * qg[1]); o.y = pk2(a[2] * r * qg[2], a[3] * r * qg[3]);
            *(v2u*)(WSP(bf16, WS_CQ) + (size_t)row * 256 + 4 * lane) = o;
        }
        {
            const float ss = wave_sum(lane < 32 ? (b[0] * b[0] + b[1] * b[1] + b[2] * b[2] + b[3] * b[3]) : 0.f);
            const float r = rsqrtf(ss * (1.0f / 128.0f) + 1e-6f);
            if (lane < 32) { v2u o; o.x = pk2(b[0] * r * kvg[0], b[1] * r * kvg[1]); o.y = pk2(b[2] * r * kvg[2], b[3] * r * kvg[3]);
                *(v2u*)(WSP(bf16, WS_CKV) + (size_t)row * 128 + 4 * lane) = o; }
        }
        {
            const bool in = (lane >= 32 && lane < 48);
            const float mean = wave_sum(in ? (b[0] + b[1] + b[2] + b[3]) : 0.f) * (1.0f / 64.0f);
            const f32x4 d = b - mean;
            const float var = wave_sum(in ? (d[0] * d[0] + d[1] * d[1] + d[2] * d[2] + d[3] * d[3]) : 0.f) * (1.0f / 64.0f);
            const float r = rsqrtf(var + 1e-5f);
            if (in) { v2u o; o.x = pk2(d[0] * r * kig[0] + kib[0], d[1] * r * kig[1] + kib[1]); o.y = pk2(d[2] * r * kig[2] + kib[2], d[3] * r * kig[3] + kib[3]);
                *(v2u*)(WSP(bf16, WS_KIDX) + (size_t)row * 64 + 4 * (lane - 32)) = o; }
        }
        if (lane == 48 || lane == 49) *(f32x4*)(WSP(float, WS_WIDX) + (size_t)row * 8 + 4 * (lane - 48)) = b * 0.044194173824159216f;
        if (lane == 50) { f32x4 o; o[0] = sigm(b[0]); o[1] = sigm(b[1]); o[2] = sigm(b[2]); o[3] = sigm(b[3]); *(f32x4*)(WSP(float, WS_BETA) + (size_t)row * 4) = o; }
        if (lane == 51) { f32x4 o;
#pragma unroll
            for (int h = 0; h < 4; ++h) { const float xx = b[h] + dtb[h]; const float sp = xx > 20.f ? xx : log1pf(__expf(xx)); o[h] = -__expf(alog[h]) * sp; }
            *(f32x4*)(WSP(float, WS_GG) + (size_t)row * 4) = o; }
#pragma unroll
        for (int sel = 0; sel < 3; ++sel) {
            const int col0 = sel * 512 + 8 * lane;
            float acc[8];
#pragma unroll
            for (int i = 0; i < 8; ++i) acc[i] = 0.f;
#pragma unroll
            for (int j = 0; j < 4; ++j) {
                if (t - 3 + j >= 0) {
                    const v4u xr = *(const v4u*)(QZ + (size_t)(row - 3 + j) * 2048 + col0); float xv[8]; unpack8(xr, xv);
                    const f32x4 w0 = *(const f32x4*)(A->in[I_AB_CONVW] + (size_t)j * 1536 + col0), w1 = *(const f32x4*)(A->in[I_AB_CONVW] + (size_t)j * 1536 + col0 + 4);
#pragma unroll
                    for (int i = 0; i < 4; ++i) { acc[i] += w0[i] * xv[i]; acc[4 + i] += w1[i] * xv[4 + i]; }
                }
            }
            float ss = 0.f;
#pragma unroll
            for (int i = 0; i < 8; ++i) { acc[i] = siluf(acc[i]); ss += acc[i] * acc[i]; }
            if (sel < 2) {
                ss += __shfl_xor(ss, 1); ss += __shfl_xor(ss, 2); ss += __shfl_xor(ss, 4); ss += __shfl_xor(ss, 8);
                const float sc = rsqrtf(ss + 1e-6f) * (sel == 0 ? 0.08838834764831845f : 1.0f);
#pragma unroll
                for (int i = 0; i < 8; ++i) acc[i] *= sc;
            }
            bf16* dst = (sel == 0 ? WSP(bf16, WS_QN) : (sel == 1 ? WSP(bf16, WS_KN) : WSP(bf16, WS_VN))) + (size_t)row * 512 + 8 * lane;
            *(v4u*)dst = pack8f(acc);
        }
    }
}

__device__ __forceinline__ void p3_chunk_prep(Frame& F, KArgs A) {
    int tid = F.tid; asm volatile("" : "+v"(tid));
    const int lane = tid & 63;
    constexpr int P = 132;
    LAS float* qs = (LAS float*)(F.lds); LAS float* ks = qs + 64 * P; LAS float* vs = ks + 64 * P;
    LAS float* As = vs + 64 * P;
    LAS float* gcS = As + 64 * 65; LAS float* egS = gcS + 64; LAS float* ekS = egS + 64; LAS float* btS = ekS + 64;
    LAS float* Ts = qs;
    for (int cidx = F.bid; cidx < 1024; cidx += F.G) {
        const int b = cidx >> 9, h = (cidx >> 7) & 3, n = cidx & 127, row0 = b * SEQ + n * 64;
        unsigned char* blk = F.ws + WS_CHK + (size_t)cidx * CHK_STRIDE;
        if (tid < 64) {
            const float g = WSP(float, WS_GG)[(size_t)(row0 + tid) * 4 + h];
            float gc = g;
#pragma unroll
            for (int o = 1; o < 64; o <<= 1) { const float t = __shfl_up(gc, o); if (lane >= o) gc += t; }
            const float g63 = __shfl(gc, 63);
            gcS[tid] = gc; egS[tid] = __expf(gc); ekS[tid] = __expf(g63 - gc); btS[tid] = WSP(float, WS_BETA)[(size_t)(row0 + tid) * 4 + h];
            if (tid == 0) *(float*)(blk + CHK_GL) = __expf(g63);
        }
#pragma unroll
        for (int i = 0; i < 2; ++i) {
            const int id = tid + 512 * i, r = id >> 4, c8 = (id & 15) * 8; const size_t so = (size_t)(row0 + r) * 512 + h * 128 + c8;
            float f[8];
            unpack8(*(const v4u*)(WSP(bf16, WS_QN) + so), f);
            *(LAS f32x4*)(qs + r * P + c8) = (f32x4){f[0], f[1], f[2], f[3]}; *(LAS f32x4*)(qs + r * P + c8 + 4) = (f32x4){f[4], f[5], f[6], f[7]};
            unpack8(*(const v4u*)(WSP(bf16, WS_KN) + so), f);
            *(LAS f32x4*)(ks + r * P + c8) = (f32x4){f[0], f[1], f[2], f[3]}; *(LAS f32x4*)(ks + r * P + c8 + 4) = (f32x4){f[4], f[5], f[6], f[7]};
            unpack8(*(const v4u*)(WSP(bf16, WS_VN) + so), f);
            *(LAS f32x4*)(vs + r * P + c8) = (f32x4){f[0], f[1], f[2], f[3]}; *(LAS f32x4*)(vs + r * P + c8 + 4) = (f32x4){f[4], f[5], f[6], f[7]};
        }
        __syncthreads();
        {
            const int i = tid >> 3, t7 = tid & 7;
            float aK[8], aQ[8];
#pragma unroll
            for (int x = 0; x < 8; ++x) { aK[x] = 0.f; aQ[x] = 0.f; }
#pragma unroll 1
            for (int d = 0; d < 128; d += 4) {
                const f32x4 ki = *(const LAS f32x4*)(ks + i * P + d), qi = *(const LAS f32x4*)(qs + i * P + d);
#pragma unroll
                for (int x = 0; x < 8; ++x) { const f32x4 kj = *(const LAS f32x4*)(ks + (t7 + 8 * x) * P + d);
                    aK[x] += ki[0] * kj[0] + ki[1] * kj[1] + ki[2] * kj[2] + ki[3] * kj[3]; aQ[x] += qi[0] * kj[0] + qi[1] * kj[1] + qi[2] * kj[2] + qi[3] * kj[3]; }
            }
            const float gci = gcS[i], bti = btS[i];
            bf16* QKp = (bf16*)(blk + CHK_QK) + i * 64;
#pragma unroll
            for (int x = 0; x < 8; ++x) { const int j = t7 + 8 * x; const float dec = __expf(j <= i ? gci - gcS[j] : 0.f);
                As[i * 65 + j] = (j < i) ? bti * aK[x] * dec : 0.f;
                QKp[32 * (j >> 5) + 8 * ((j >> 2) & 3) + 4 * ((j >> 4) & 1) + (j & 3)] = (bf16)f2bf((j <= i) ? aQ[x] * dec : 0.f); }
        }
        {
            const int i = tid >> 3, d0 = (tid & 7) * 16, s = d0 >> 5, a = (d0 >> 4) & 1; const float e = egS[i];
            bf16* Qd = (bf16*)(blk + CHK_QD) + i * 128;
#pragma unroll
            for (int q = 0; q < 4; ++q) { const f32x4 p = *(const LAS f32x4*)(qs + i * P + d0 + 4 * q); v2u w; w.x = pk2(p[0] * e, p[1] * e); w.y = pk2(p[2] * e, p[3] * e); *(v2u*)(Qd + 32 * s + 8 * q + 4 * a) = w; }
        }
        {
            const int d = tid >> 2, c0 = (tid & 3) * 16, s = c0 >> 5, a = (c0 >> 4) & 1;
            bf16* Kd = (bf16*)(blk + CHK_KDT) + d * 64;
#pragma unroll
            for (int q = 0; q < 4; ++q) { const int c = c0 + 4 * q;
                v2u w; w.x = pk2(ks[c * P + d] * ekS[c], ks[(c + 1) * P + d] * ekS[c + 1]); w.y = pk2(ks[(c + 2) * P + d] * ekS[c + 2], ks[(c + 3) * P + d] * ekS[c + 3]);
                *(v2u*)(Kd + 32 * s + 8 * q + 4 * a) = w; }
        }
        __syncthreads();
        {
            const int c = tid >> 3, part = tid & 7;
            for (int i = 0; i < 64; ++i) {
                float acc = 0.f;
                for (int j = part; j < i; j += 8) acc += As[i * 65 + j] * Ts[j * 65 + c];
                acc += __shfl_xor(acc, 1); acc += __shfl_xor(acc, 2); acc += __shfl_xor(acc, 4);
                if (part == 0) Ts[i * 65 + c] = ((i == c) ? 1.f : 0.f) - acc;
                __builtin_amdgcn_fence(__ATOMIC_RELEASE, "wavefront"); asm volatile("s_waitcnt lgkmcnt(0)" ::: "memory");
            }
        }
        __syncthreads();
        {
            const int i = tid >> 3, t7 = tid & 7;
            f32x4 aU[4], aW[4];
#pragma unroll
            for (int xx = 0; xx < 4; ++xx) { aU[xx] = (f32x4){0.f, 0.f, 0.f, 0.f}; aW[xx] = (f32x4){0.f, 0.f, 0.f, 0.f}; }
#pragma unroll 1
            for (int j = 0; j <= i; ++j) {
                const float tb = Ts[i * 65 + j] * btS[j], tbe = tb * egS[j];
#pragma unroll
                for (int xx = 0; xx < 4; ++xx) { aU[xx] += *(const LAS f32x4*)(vs + j * P + 4 * t7 + 32 * xx) * tb; aW[xx] += *(const LAS f32x4*)(ks + j * P + 4 * t7 + 32 * xx) * tbe; }
            }
            float* UT = (float*)(blk + CHK_UT);
            bf16* Wp = (bf16*)(blk + CHK_WP) + i * 128;
#pragma unroll
            for (int xx = 0; xx < 4; ++xx) {
                const int c = 4 * t7 + 32 * xx;
#pragma unroll
                for (int e = 0; e < 4; ++e) UT[(c + e) * 64 + i] = aU[xx][e];
                v2u w; w.x = pk2(aW[xx][0], aW[xx][1]); w.y = pk2(aW[xx][2], aW[xx][3]); *(v2u*)(Wp + 32 * xx + 8 * (t7 & 3) + 4 * (t7 >> 2)) = w;
            }
        }
        __syncthreads();
    }
}

constexpr int SEQ_WGS = 16;
constexpr int SQ_WP = 0, SQ_QD = 16384, SQ_KDT = 32768, SQ_QK = 49152, SQ_BUF = 57344;
__device__ __forceinline__ bf16x8 packfrag(const f32x4 lo, const f32x4 hi) { v4u w; w.x = pg8::cvt_pk_bf16(lo[0], lo[1]); w.y = pg8::cvt_pk_bf16(lo[2], lo[3]); w.z = pg8::cvt_pk_bf16(hi[0], hi[1]); w.w = pg8::cvt_pk_bf16(hi[2], hi[3]); return __builtin_bit_cast(bf16x8, w); }
__device__ __forceinline__ void seq_load(v4u (&r)[14], const unsigned char* blk, int lt) {
#pragma unroll
    for (int i = 0; i < 14; ++i) r[i] = *(const v4u*)(blk + (size_t)(lt + 256 * i) * 16);
}
__device__ __forceinline__ void seq_write(LAS unsigned char* buf, const v4u (&r)[14], int lt) {
#pragma unroll
    for (int i = 0; i < 14; ++i) {
        const int id = lt + 256 * i; int dst;
        if (id < 2048) { const int rr = (id & 1023) >> 4, ch = id & 15; dst = (id & ~1023) * 16 + rr * 256 + 16 * (ch ^ (rr & 15)); }
        else { const int rr = (id - 2048) >> 3, ch = id & 7; dst = 32768 + rr * 128 + 16 * (ch ^ (rr & 7)); }
        *(LAS v4u*)(buf + dst) = r[i];
    }
}
__device__ __forceinline__ void seq_compute(LAS unsigned char* buf, f32x4 (&Sacc)[8], const f32x4 (&U)[4], const float gl, float* op0, const int fr, const int fq) {
    bf16x8 sf[4];
#pragma unroll
    for (int s = 0; s < 4; ++s) sf[s] = packfrag(Sacc[2 * s], Sacc[2 * s + 1]);
    f32x4 Vn[4], Oa[4];
#pragma unroll
    for (int tc = 0; tc < 4; ++tc) {
        const int rr = 16 * tc + fr; f32x4 av = (f32x4){0.f, 0.f, 0.f, 0.f}, ao = (f32x4){0.f, 0.f, 0.f, 0.f};
#pragma unroll
        for (int s = 0; s < 4; ++s) {
            const int off = rr * 256 + 16 * ((4 * s + fq) ^ (rr & 15));
            const bf16x8 wf = *(const LAS bf16x8*)(buf + SQ_WP + off), qf = *(const LAS bf16x8*)(buf + SQ_QD + off);
            av = __builtin_amdgcn_mfma_f32_16x16x32_bf16(wf, sf[s], av, 0, 0, 0);
            ao = __builtin_amdgcn_mfma_f32_16x16x32_bf16(qf, sf[s], ao, 0, 0, 0);
        }
        Vn[tc] = U[tc] - av; Oa[tc] = ao;
    }
    bf16x8 vf[2];
    vf[0] = packfrag(Vn[0], Vn[1]); vf[1] = packfrag(Vn[2], Vn[3]);
#pragma unroll
    for (int tc = 0; tc < 4; ++tc) {
        const int rr = 16 * tc + fr;
#pragma unroll
        for (int s = 0; s < 2; ++s) {
            const bf16x8 kf = *(const LAS bf16x8*)(buf + SQ_QK + rr * 128 + 16 * ((4 * s + fq) ^ (rr & 7)));
            Oa[tc] = __builtin_amdgcn_mfma_f32_16x16x32_bf16(kf, vf[s], Oa[tc], 0, 0, 0);
        }
        float* op = op0 + (size_t)(16 * tc) * 512;
#pragma unroll
        for (int j = 0; j < 4; ++j) op[(size_t)j * 512] = Oa[tc][j];
    }
#pragma unroll
    for (int T = 0; T < 8; ++T) {
        const int rr = 16 * T + fr; f32x4 a = Sacc[T] * gl;
#pragma unroll
        for (int s = 0; s < 2; ++s) {
            const bf16x8 kf = *(const LAS bf16x8*)(buf + SQ_KDT + rr * 128 + 16 * ((4 * s + fq) ^ (rr & 7)));
            a = __builtin_amdgcn_mfma_f32_16x16x32_bf16(kf, vf[s], a, 0, 0, 0);
        }
        Sacc[T] = a;
    }
}
#define SEQ_BAR() do { asm volatile("s_waitcnt lgkmcnt(0)" ::: "memory"); __builtin_amdgcn_s_barrier(); asm volatile("" ::: "memory"); } while (0)
__device__ __forceinline__ void p4_delta_seq(Frame& F, int sid) {
    const int lane = F.lane, wave = F.wave, tid = F.tid;
    const int bh = sid >> 1, half = sid & 1, b = bh >> 2, h = bh & 3;
    const int fr = lane & 15, fq = lane >> 4;
    const int v0 = half * 64 + (wave & 3) * 16;
    const unsigned char* cbase = F.ws + WS_CHK + (size_t)(bh * 128) * CHK_STRIDE;
    if (wave >= 4) {
        const int lt = tid - 256;
        v4u RA[14], RB[14];
#define SEQ_LD(R, blk) do { const unsigned char* _b = (blk); _Pragma("unroll") for (int _i = 0; _i < 14; ++_i) asm volatile("global_load_dwordx4 %0, %1, off" : "=v"(R[_i]) : "v"(_b + (size_t)(lt + 256 * _i) * 16) : "memory"); } while (0)
#define SEQ_WAIT(younger) do { if (younger) asm volatile("s_waitcnt vmcnt(14)" ::: "memory"); else asm volatile("s_waitcnt vmcnt(0)" ::: "memory"); } while (0)
        SEQ_LD(RA, cbase); SEQ_LD(RB, cbase + CHK_STRIDE); SEQ_WAIT(true); seq_write(F.lds, RA, lt); SEQ_LD(RA, cbase + 2 * CHK_STRIDE);
        SEQ_BAR();
#pragma unroll 1
        for (int n = 0; n < 128; n += 2) {
            if (n + 1 < 128) { SEQ_WAIT(n + 2 < 128); seq_write(F.lds + ((n + 1) & 1) * SQ_BUF, RB, lt); } if (n + 3 < 128) SEQ_LD(RB, cbase + (size_t)(n + 3) * CHK_STRIDE);
            SEQ_BAR();
            if (n + 2 < 128) { SEQ_WAIT(n + 3 < 128); seq_write(F.lds + (n & 1) * SQ_BUF, RA, lt); } if (n + 4 < 128) SEQ_LD(RA, cbase + (size_t)(n + 4) * CHK_STRIDE);
            SEQ_BAR();
        }
        asm volatile("s_waitcnt vmcnt(0)" ::: "memory");
#undef SEQ_LD
#undef SEQ_WAIT
    } else {
        float* OD = WSP(float, WS_ODELTA);
        f32x4 Sacc[8], Ucur[4], Unxt[4]; float glc, gln;
#pragma unroll
        for (int T = 0; T < 8; ++T) Sacc[T] = (f32x4){0.f, 0.f, 0.f, 0.f};
#pragma unroll
        for (int tc = 0; tc < 4; ++tc) { Ucur[tc] = *(const f32x4*)((const float*)(cbase + CHK_UT) + (size_t)(v0 + fr) * 64 + 4 * fq + 16 * tc);
                                          Unxt[tc] = *(const f32x4*)((const float*)(cbase + CHK_STRIDE + CHK_UT) + (size_t)(v0 + fr) * 64 + 4 * fq + 16 * tc); }
        glc = *(const float*)(cbase + CHK_GL); gln = *(const float*)(cbase + CHK_STRIDE + CHK_GL);
        SEQ_BAR();
#pragma unroll 1
        for (int n = 0; n < 128; ++n) {
            seq_compute(F.lds + (n & 1) * SQ_BUF, Sacc, Ucur, glc, OD + (size_t)(b * SEQ + n * 64 + 4 * fq) * 512 + h * 128 + v0 + fr, fr, fq);
#pragma unroll
            for (int tc = 0; tc < 4; ++tc) Ucur[tc] = Unxt[tc];
            glc = gln;
            if (n + 2 < 128) { const unsigned char* nb = cbase + (size_t)(n + 2) * CHK_STRIDE; gln = *(const float*)(nb + CHK_GL);
#pragma unroll
                for (int tc = 0; tc < 4; ++tc) Unxt[tc] = *(const f32x4*)((const float*)(nb + CHK_UT) + (size_t)(v0 + fr) * 64 + 4 * fq + 16 * tc); }
            SEQ_BAR();
        }
    }
}
#undef SEQ_BAR

__device__ __forceinline__ void p4_indexer(Frame& F, int widx, int nw) {
    const int lane = F.lane, fr = lane & 15, fq = lane >> 4;
    const bf16* QL = WSP(bf16, WS_QL); const bf16* KI = WSP(bf16, WS_KIDX); const float* WI = WSP(float, WS_WIDX); float* SC = WSP(float, WS_BIG);
    for (int task = widx; task < 2 * 4352; task += nw) {
        const int b = task / 4352; int tau = task - b * 4352;
        int g = 0; while (16 * (g + 1) * (g + 2) <= tau) ++g;
        tau -= 16 * g * (g + 1);
        const int qt = 32 * g + tau / (g + 1), seg = tau % (g + 1);
        const int row0 = b * SEQ + 16 * qt;
        bf16x8 Qf[8][2];
#pragma unroll
        for (int hh = 0; hh < 8; ++hh)
#pragma unroll
            for (int s = 0; s < 2; ++s) Qf[hh][s] = *(const bf16x8*)(QL + (size_t)(row0 + fr) * 1536 + 1024 + hh * 64 + 32 * s + 8 * fq);
        f32x4 wv[4][2];
#pragma unroll
        for (int j = 0; j < 4; ++j) { wv[j][0] = *(const f32x4*)(WI + (size_t)(row0 + 4 * fq + j) * 8); wv[j][1] = *(const f32x4*)(WI + (size_t)(row0 + 4 * fq + j) * 8 + 4); }
        const int kt1 = (32 * seg + 31 < qt) ? 32 * seg + 31 : qt;
        for (int kt = 32 * seg; kt <= kt1; ++kt) {
            const bf16* kp = KI + (size_t)(b * SEQ + 16 * kt + fr) * 64 + 8 * fq;
            const bf16x8 k0 = *(const bf16x8*)kp, k1 = *(const bf16x8*)(kp + 32);
            f32x4 isc = (f32x4){0.f, 0.f, 0.f, 0.f};
#pragma unroll
            for (int hh = 0; hh < 8; ++hh) {
                f32x4 c = __builtin_amdgcn_mfma_f32_16x16x32_bf16(Qf[hh][0], k0, (f32x4){0.f, 0.f, 0.f, 0.f}, 0, 0, 0);
                c = __builtin_amdgcn_mfma_f32_16x16x32_bf16(Qf[hh][1], k1, c, 0, 0, 0);
#pragma unroll
                for (int j = 0; j < 4; ++j) isc[j] += fmaxf(c[j], 0.f) * wv[j][hh >> 2][hh & 3];
            }
            float* sp = SC + (size_t)(row0 + 4 * fq) * 8192 + 16 * kt + fr;
#pragma unroll
            for (int j = 0; j < 4; ++j) sp[(size_t)j * 8192] = isc[j];
        }
    }
}

__device__ __forceinline__ unsigned long long mask_ge(unsigned x, unsigned t) { unsigned long long m; asm("v_cmp_ge_u32_e64 %0, %1, %2" : "=s"(m) : "v"(x), "s"(t)); return m; }
__device__ __forceinline__ void mask_ge8(unsigned long long (&m)[8], unsigned x0, unsigned x1, unsigned x2, unsigned x3, unsigned x4, unsigned x5, unsigned x6, unsigned x7, unsigned t) {
    asm("v_cmp_ge_u32_e64 %0, %8, %16\n\tv_cmp_ge_u32_e64 %1, %9, %16\n\tv_cmp_ge_u32_e64 %2, %10, %16\n\tv_cmp_ge_u32_e64 %3, %11, %16\n\t"
        "v_cmp_ge_u32_e64 %4, %12, %16\n\tv_cmp_ge_u32_e64 %5, %13, %16\n\tv_cmp_ge_u32_e64 %6, %14, %16\n\tv_cmp_ge_u32_e64 %7, %15, %16"
        : "=&s"(m[0]), "=&s"(m[1]), "=&s"(m[2]), "=&s"(m[3]), "=&s"(m[4]), "=&s"(m[5]), "=&s"(m[6]), "=&s"(m[7])
        : "v"(x0), "v"(x1), "v"(x2), "v"(x3), "v"(x4), "v"(x5), "v"(x6), "v"(x7), "s"(t));
}
__device__ __forceinline__ unsigned long long mask_eq(unsigned x, unsigned t) { unsigned long long m; asm("v_cmp_eq_u32_e64 %0, %1, %2" : "=s"(m) : "v"(x), "s"(t)); return m; }
__device__ __forceinline__ unsigned tk_key(float f) { const unsigned b = __float_as_uint(f); return (b & 0x80000000u) ? ~b : (b | 0x80000000u); }
__device__ __forceinline__ void topk_row_slow(const float* sr, const int n, const int lane, LAS int* sel) {
    const int nseg = (n + 63) >> 6;
    unsigned T = 0u;
    for (int bit = 31; bit >= 0; --bit) {
        const unsigned cnd = T | (1u << bit); int c = 0;
        for (int sg = 0; sg < nseg; ++sg) { const int idx = sg * 64 + lane; const unsigned x = (idx < n) ? tk_key(sr[idx < n ? idx : 0]) : 0u; c += __popcll(__ballot(x >= cnd)); }
        if (c >= 256) T = cnd;
    }
    int cgt = 0;
    for (int sg = 0; sg < nseg; ++sg) { const int idx = sg * 64 + lane; const unsigned x = (idx < n) ? tk_key(sr[idx < n ? idx : 0]) : 0u; cgt += __popcll(__ballot(x > T)); }
    const int need_eq = 256 - cgt; int running = 0, eq_taken = 0;
    const unsigned long long lt = (1ull << lane) - 1ull;
    for (int sg = 0; sg < nseg; ++sg) {
        const int idx = sg * 64 + lane; const unsigned x = (idx < n) ? tk_key(sr[idx < n ? idx : 0]) : 0u;
        const bool gt = x > T, eq = x == T;
        const unsigned long long meq = __ballot(eq);
        const bool take = gt || (eq && (eq_taken + __popcll(meq & lt)) < need_eq);
        const unsigned long long mt = __ballot(take);
        if (take) sel[running + __popcll(mt & lt)] = idx;
        running += __popcll(mt); eq_taken += __popcll(meq);
    }
}
constexpr int TK_CAP = 832;
__device__ __forceinline__ int topk_row(Frame& F, const int row, LAS int* sel, LAS unsigned long long* cand) {
    const int lane = F.lane;
    const float* SC = WSP(float, WS_BIG);
    {
        const int pos = row & (SEQ - 1), n = pos + 1;
        if (n <= 256) {
#pragma unroll
            for (int i = 0; i < 4; ++i) { const int j = 64 * i + lane; sel[j] = (j < n) ? j : 0; }
            return n;
        }
        const int nblk = (n + 1023) >> 10;
        const float* sr = SC + (size_t)row * 8192;
        int lane_l = lane; asm volatile("" : "+v"(lane_l));
        unsigned u[128];
#pragma unroll
        for (int i = 0; i < 64; ++i) u[i] = __float_as_uint((sr + (i >> 4) * 1024)[(i & 15) * 64 + lane_l]);
        if (nblk > 4) {
#pragma unroll
            for (int i = 64; i < 128; ++i) u[i] = __float_as_uint((sr + (i >> 4) * 1024)[(i & 15) * 64 + lane_l]);
        } else {
#pragma unroll
            for (int i = 64; i < 128; ++i) u[i] = 0u;
        }
        asm volatile("" ::: "memory");
#pragma unroll
        for (int i = 0; i < 128; ++i) { const int lim = n - i * 64; const unsigned bits = u[i];
            const unsigned x = (bits & 0x80000000u) ? ~bits : (bits | 0x80000000u);
            u[i] = (lane < lim) ? x : 0u; }
        const unsigned long long ltmask_s = (1ull << lane) - 1ull;
        bool done = false;
        {
            int ns = 0;
#pragma unroll
            for (int k = 0; k < 16; ++k) { int v = n - 512 * k; v = v < 0 ? 0 : (v > 64 ? 64 : v); ns += v; }
            const float mean = 256.0f * (float)ns / (float)n;
            const int rs = (int)(mean + 4.0f * sqrtf(mean) + 5.0f);
            unsigned Ts = 0u;
            for (int bit = 31; bit >= 16; --bit) {
                const unsigned cnd = Ts | (1u << bit); unsigned long long m0[8], m1[8];
                mask_ge8(m0, u[0], u[8], u[16], u[24], u[32], u[40], u[48], u[56], cnd); mask_ge8(m1, u[64], u[72], u[80], u[88], u[96], u[104], u[112], u[120], cnd);
                int c = 0;
#pragma unroll
                for (int i = 0; i < 8; ++i) c += __popcll(m0[i]) + __popcll(m1[i]);
                if (c >= rs) Ts = cnd;
            }
            if (Ts == 0u) Ts = 1u;
            int nc = 0;
#pragma unroll
            for (int bk = 0; bk < 8; ++bk) {
                if (bk < nblk) {
#pragma unroll
                    for (int g8 = 0; g8 < 2; ++g8) {
                        unsigned long long mg[8]; const int b0 = bk * 16 + g8 * 8;
                        mask_ge8(mg, u[b0], u[b0 + 1], u[b0 + 2], u[b0 + 3], u[b0 + 4], u[b0 + 5], u[b0 + 6], u[b0 + 7], Ts);
#pragma unroll
                        for (int i = 0; i < 8; ++i) {
                            const unsigned long long mt = mg[i];
                            if (mt != 0ull) {
                                const int off = nc + __popcll(mt & ltmask_s);
                                if (((mt >> lane) & 1ull) && off < TK_CAP) cand[off] = ((unsigned long long)u[b0 + i] << 32) | (unsigned)((b0 + i) * 64 + lane_l);
                                nc += __popcll(mt);
                            }
                        }
                    }
                }
            }
            if (nc >= 256 && nc <= TK_CAP) {
                unsigned ck[16]; int ci[13];
#pragma unroll
                for (int t = 0; t < 13; ++t) { const int j = lane + 64 * t; const unsigned long long e = (j < nc) ? cand[j] : 0ull; ck[t] = (unsigned)(e >> 32); ci[t] = (int)(unsigned)e; }
                ck[13] = 0u; ck[14] = 0u; ck[15] = 0u;
                unsigned T = 0u;
                for (int bit = 31; bit >= 0; --bit) {
                    const unsigned cnd = T | (1u << bit); unsigned long long m0[8], m1[8];
                    mask_ge8(m0, ck[0], ck[1], ck[2], ck[3], ck[4], ck[5], ck[6], ck[7], cnd); mask_ge8(m1, ck[8], ck[9], ck[10], ck[11], ck[12], ck[13], ck[14], ck[15], cnd);
                    int c = 0;
#pragma unroll
                    for (int i = 0; i < 8; ++i) c += __popcll(m0[i]) + __popcll(m1[i]);
                    if (c >= 256) T = cnd;
                }
                unsigned long long g0[8], g1[8], h0[8], h1[8];
                mask_ge8(g0, ck[0], ck[1], ck[2], ck[3], ck[4], ck[5], ck[6], ck[7], T); mask_ge8(g1, ck[8], ck[9], ck[10], ck[11], ck[12], ck[13], ck[14], ck[15], T);
                mask_ge8(h0, ck[0], ck[1], ck[2], ck[3], ck[4], ck[5], ck[6], ck[7], T + 1u); mask_ge8(h1, ck[8], ck[9], ck[10], ck[11], ck[12], ck[13], ck[14], ck[15], T + 1u);
                int cgt = 0;
#pragma unroll
                for (int t = 0; t < 13; ++t) cgt += __popcll(t < 8 ? h0[t & 7] : h1[t & 7]);
                const int need_eq = 256 - cgt;
                int running = 0, eq_taken = 0;
#pragma unroll
                for (int t = 0; t < 13; ++t) {
                    const unsigned long long mge = (t < 8 ? g0[t & 7] : g1[t & 7]), mgt = (t < 8 ? h0[t & 7] : h1[t & 7]);
                    unsigned long long mt = mge; const unsigned long long me = mge & ~mgt;
                    if (me != 0ull) {
                        const int room = need_eq - eq_taken; unsigned long long keep = 0ull, rest = me;
                        for (int k = 0; k < room && rest != 0ull; ++k) { const unsigned long long low = rest & (~rest + 1ull); keep |= low; rest ^= low; }
                        mt = (mge & ~me) | keep; eq_taken += __popcll(me);
                    }
                    if (mt != 0ull) { if ((mt >> lane) & 1ull) sel[running + __popcll(mt & ltmask_s)] = ci[t]; running += __popcll(mt); }
                }
                done = true;
            }
        }
        if (!done) topk_row_slow(sr, n, lane, sel);
    }
    return 256;
}

__device__ __forceinline__ void p6_sparse_attn(Frame& F) {
    const int lane = F.lane, gw = F.bid * NWAVES + F.wave, NGW = F.G * NWAVES;
    LAS float* ql = (LAS float*)(F.lds + F.wave * 12288);
    LAS float* pp = ql + 1024;
    const bf16* QL = WSP(bf16, WS_QL); const bf16* CKV = WSP(bf16, WS_CKV); const int* SEL = WSP(int, WS_SEL); const int* NSEL = WSP(int, WS_NSEL); bf16* AO = WSP(bf16, WS_AO);
    for (int row = gw; row < M; row += NGW) {
        const int b = row >> 13, n = NSEL[row];
        const int* sel = SEL + (size_t)row * 256;
        {
            float f[8];
            unpack8(*(const v4u*)(QL + (size_t)row * 1536 + 8 * lane), f);
#pragma unroll
            for (int x = 0; x < 8; ++x) ql[8 * lane + x] = f[x];
            unpack8(*(const v4u*)(QL + (size_t)row * 1536 + 512 + 8 * lane), f);
#pragma unroll
            for (int x = 0; x < 8; ++x) ql[512 + 8 * lane + x] = f[x];
        }
        float s[4][8];
#pragma unroll
        for (int kb = 0; kb < 4; ++kb) {
            const int j = 64 * kb + lane; const bool valid = j < n; const int key = valid ? sel[j] : 0;
            const bf16* kr = CKV + (size_t)(b * SEQ + key) * 128;
#pragma unroll
            for (int hh = 0; hh < 8; ++hh) s[kb][hh] = 0.f;
#pragma unroll 4
            for (int r8 = 0; r8 < 16; ++r8) {
                float x[8]; unpack8(*(const v4u*)(kr + 8 * r8), x);
#pragma unroll
                for (int hh = 0; hh < 8; ++hh) { const f32x4 q0 = *(const LAS f32x4*)(ql + hh * 128 + 8 * r8), q1 = *(const LAS f32x4*)(ql + hh * 128 + 8 * r8 + 4);
                    s[kb][hh] += x[0] * q0[0] + x[1] * q0[1] + x[2] * q0[2] + x[3] * q0[3] + x[4] * q1[0] + x[5] * q1[1] + x[6] * q1[2] + x[7] * q1[3]; }
            }
            if (!valid) {
#pragma unroll
                for (int hh = 0; hh < 8; ++hh) s[kb][hh] = -INFINITY;
            }
        }
#pragma unroll
        for (int hh = 0; hh < 8; ++hh) {
            const float mx = wave_max(fmaxf(fmaxf(s[0][hh], s[1][hh]), fmaxf(s[2][hh], s[3][hh])));
            float e[4], l = 0.f;
#pragma unroll
            for (int kb = 0; kb < 4; ++kb) { e[kb] = __expf(s[kb][hh] - mx); l += e[kb]; }
            const float inv = 1.0f / wave_sum(l);
#pragma unroll
            for (int kb = 0; kb < 4; ++kb) pp[(64 * kb + lane) * 8 + hh] = e[kb] * inv;
        }
        float o[8][2];
#pragma unroll
        for (int hh = 0; hh < 8; ++hh) { o[hh][0] = 0.f; o[hh][1] = 0.f; }
        for (int j = 0; j < n; ++j) {
            const int key = sel[j];
            const unsigned kv = *(const unsigned*)(CKV + (size_t)(b * SEQ + key) * 128 + 2 * lane);
            const float lo = bflo(kv), hi = bfhi(kv);
            const f32x4 p0 = *(const LAS f32x4*)(pp + j * 8), p1 = *(const LAS f32x4*)(pp + j * 8 + 4);
#pragma unroll
            for (int hh = 0; hh < 4; ++hh) { o[hh][0] += p0[hh] * lo; o[hh][1] += p0[hh] * hi; o[4 + hh][0] += p1[hh] * lo; o[4 + hh][1] += p1[hh] * hi; }
        }
#pragma unroll
        for (int hh = 0; hh < 8; ++hh) *(unsigned*)(AO + (size_t)row * 1536 + hh * 128 + 2 * lane) = pk2(o[hh][0], o[hh][1]);
    }
}
__device__ __forceinline__ void p6_gdn_out(Frame& F, KArgs A) {
    const int lane = F.lane, gw = F.bid * NWAVES + F.wave, NGW = F.G * NWAVES;
    const f32x4 g0 = *(const f32x4*)(A->in[I_AB_ONG] + 8 * (lane & 15)), g1 = *(const f32x4*)(A->in[I_AB_ONG] + 8 * (lane & 15) + 4);
    for (int row = gw; row < M; row += NGW) {
        const float* op = WSP(float, WS_ODELTA) + (size_t)row * 512 + 8 * lane;
        const f32x4 a = *(const f32x4*)op, b = *(const f32x4*)(op + 4);
        float ss = a[0] * a[0] + a[1] * a[1] + a[2] * a[2] + a[3] * a[3] + b[0] * b[0] + b[1] * b[1] + b[2] * b[2] + b[3] * b[3];
        ss += __shfl_xor(ss, 1); ss += __shfl_xor(ss, 2); ss += __shfl_xor(ss, 4); ss += __shfl_xor(ss, 8);
        const float r = rsqrtf(ss * (1.0f / 128.0f) + 1e-6f);
        float z[8]; unpack8(*(const v4u*)(WSP(bf16, WS_QKVZ) + (size_t)row * 2048 + 1536 + 8 * lane), z);
        float o[8];
#pragma unroll
        for (int i = 0; i < 4; ++i) { o[i] = a[i] * r * g0[i] * siluf(z[i]); o[4 + i] = b[i] * r * g1[i] * siluf(z[4 + i]); }
        *(v4u*)(WSP(bf16, WS_AO) + (size_t)row * 1536 + 1024 + 8 * lane) = pack8f(o);
    }
}

__device__ __forceinline__ void p8_ln_router(Frame& F, KArgs A, int l, float* HOUT, bf16* HB) {
    const int lane = F.lane, tid = F.tid, gw = F.bid * NWAVES + F.wave, NGW = F.G * NWAVES;
    LAS float* wT = (LAS float*)(F.lds);
    LAS float* lg = (LAS float*)(F.lds + WSCR_OFF + F.wave * WSCR_BYTES);
    const float* rw = A->in[I_RW] + (size_t)l * 1024 * 32;
    for (int i = tid; i < 1024 * 32; i += NTHREADS) { const int k = i >> 5, e = i & 31; wT[e * 1028 + k] = rw[i]; }
    __syncthreads();
    const float* PRE = WSP(float, WS_PRE);
    const float* lg_g = A->in[I_LNM_G] + (size_t)l * 1024; const float* lg_b = A->in[I_LNM_B] + (size_t)l * 1024;
    const float rb = A->in[I_RB][l * 32 + (lane & 31)];
    int* TOKE = WSP(int, WS_ROUTE); int* TOKPOS = TOKE + M * 4; float* TOKG = (float*)(TOKPOS + M * 4);
    gu32* cnt = F.ctl + CW_CNT + 64 * 32 * l;
    LAS int* lcnt = (LAS int*)(F.lds + MISC_OFF + 512);
    LAS int* lbase = lcnt + 32;
    LAS int* myrt = (LAS int*)(F.lds + WSCR_OFF + F.wave * WSCR_BYTES + 128);
    if (tid < 32) lcnt[tid] = 0;
    __syncthreads();
    int nrow = 0;
    for (int row = gw; row < M; row += NGW) {
        f32x4 v[4]; float s = 0.f;
#pragma unroll
        for (int j = 0; j < 4; ++j) { v[j] = *(const f32x4*)(PRE + (size_t)row * 1024 + 256 * j + 4 * lane); s += (v[j][0] + v[j][1]) + (v[j][2] + v[j][3]); }
        const float mean = wave_sum(s) * (1.0f / 1024.0f); float s2 = 0.f;
#pragma unroll
        for (int j = 0; j < 4; ++j) { v[j] = v[j] - mean; s2 += (v[j][0] * v[j][0] + v[j][1] * v[j][1]) + (v[j][2] * v[j][2] + v[j][3] * v[j][3]); }
        const float rstd = rsqrtf(wave_sum(s2) * (1.0f / 1024.0f) + 1e-5f);
#pragma unroll
        for (int j = 0; j < 4; ++j) {
            const f32x4 g = *(const f32x4*)(lg_g + 256 * j + 4 * lane), bb = *(const f32x4*)(lg_b + 256 * j + 4 * lane);
            v[j] = v[j] * rstd * g + bb;
            *(f32x4*)(HOUT + (size_t)row * 1024 + 256 * j + 4 * lane) = v[j];
            v2u o; o.x = pk2(v[j][0], v[j][1]); o.y = pk2(v[j][2], v[j][3]); *(v2u*)(HB + (size_t)row * 1024 + 256 * j + 4 * lane) = o;
        }
        float part[32];
#pragma unroll
        for (int e = 0; e < 32; ++e) {
            float a = 0.f;
#pragma unroll
            for (int j = 0; j < 4; ++j) { const f32x4 w = *(const LAS f32x4*)(wT + e * 1028 + 256 * j + 4 * lane); a += v[j][0] * w[0] + v[j][1] * w[1] + v[j][2] * w[2] + v[j][3] * w[3]; }
            part[e] = a;
        }
#pragma unroll
        for (int i = 0; i < 16; ++i) { const bool up = (lane & 32) != 0; const float keep = up ? part[i + 16] : part[i], send = up ? part[i] : part[i + 16]; part[i] = keep + __shfl_xor(send, 32); }
#pragma unroll
        for (int i = 0; i < 8; ++i) { const bool up = (lane & 16) != 0; const float keep = up ? part[i + 8] : part[i], send = up ? part[i] : part[i + 8]; part[i] = keep + __shfl_xor(send, 16); }
#pragma unroll
        for (int i = 0; i < 4; ++i) { const bool up = (lane & 8) != 0; const float keep = up ? part[i + 4] : part[i], send = up ? part[i] : part[i + 4]; part[i] = keep + __shfl_xor(send, 8); }
#pragma unroll
        for (int i = 0; i < 2; ++i) { const bool up = (lane & 4) != 0; const float keep = up ? part[i + 2] : part[i], send = up ? part[i] : part[i + 2]; part[i] = keep + __shfl_xor(send, 4); }
        { const bool up = (lane & 2) != 0; const float keep = up ? part[1] : part[0], send = up ? part[0] : part[1]; part[0] = keep + __shfl_xor(send, 2); }
        part[0] += __shfl_xor(part[0], 1);
        const int eidx = ((lane >> 5) & 1) * 16 + ((lane >> 4) & 1) * 8 + ((lane >> 3) & 1) * 4 + ((lane >> 2) & 1) * 2 + ((lane >> 1) & 1);
        if ((lane & 1) == 0) lg[eidx] = part[0];
        float val = (lane < 32) ? lg[lane & 31] + rb : -INFINITY;
        float tl[4]; int te[4];
#pragma unroll
        for (int k = 0; k < 4; ++k) {
            const float mx = wave_max(val);
            const unsigned long long mm = __ballot(val == mx && lane < 32);
            const int idx = __ffsll((long long)mm) - 1;
            tl[k] = mx; te[k] = idx;
            if (lane == idx) val = -INFINITY;
        }
        const float e1 = __expf(tl[1] - tl[0]), e2 = __expf(tl[2] - tl[0]), e3 = __expf(tl[3] - tl[0]);
        const float inv = 1.0f / (1.0f + e1 + e2 + e3);
        if (lane < 4) {
            const int e = lane == 0 ? te[0] : (lane == 1 ? te[1] : (lane == 2 ? te[2] : te[3]));
            const float g = (lane == 0 ? 1.0f : (lane == 1 ? e1 : (lane == 2 ? e2 : e3))) * inv;
            const int lp = __hip_atomic_fetch_add(lcnt + e, 1, __ATOMIC_RELAXED, __HIP_MEMORY_SCOPE_WORKGROUP);
            LAS int* rt = myrt + (nrow * 4 + lane) * 3; rt[0] = e; rt[1] = lp; rt[2] = __float_as_int(g);
        }
        ++nrow;
    }
    __syncthreads();
    if (tid < 32) lbase[tid] = (int)__hip_atomic_fetch_add(cnt + 64 * tid, (unsigned)lcnt[tid], RLX_AGENT);
    __syncthreads();
    if (lane < 4) {
        int j = 0;
        for (int row = gw; row < M; row += NGW, ++j) {
            const LAS int* rt = myrt + (j * 4 + lane) * 3; const int e = rt[0];
            TOKE[(size_t)row * 4 + lane] = e; TOKPOS[(size_t)row * 4 + lane] = lbase[e] + rt[1]; TOKG[(size_t)row * 4 + lane] = __int_as_float(rt[2]);
        }
    }
}

__device__ __forceinline__ void p9_scatter(Frame& F, int l, const bf16* HB, const float* HF) {
    const int lane = F.lane, tid = F.tid, gw = F.bid * NWAVES + F.wave, NGW = F.G * NWAVES;
    LAS int* base = (LAS int*)(F.lds + MISC_OFF + 256);
    int* TOKE = WSP(int, WS_ROUTE); int* TOKPOS = TOKE + M * 4; int* TILE = TOKE + 3 * M * 4;
    if (tid == 0) {
        int acc = 0;
        for (int e = 0; e < NEXP; ++e) { const int c = (int)__hip_atomic_load(F.ctl + CW_CNT + 64 * (32 * l + e), RLX_AGENT); base[e] = acc; acc += ((c + 255) >> 8) << 8; }
        base[32] = acc >> 8;
    }
    __syncthreads();
    if (F.bid == 0 && tid < 64) {
        const int nT = base[32];
        for (int t = tid; t < NTMAX; t += 64) { int e = 0;
            for (int x = 1; x < NEXP; ++x) if (base[x] <= t * 256) e = x;
            TILE[t] = (t < nT) ? e : 0; }
        if (tid == 0) TILE[NTMAX] = nT;
    }
    bf16* XS = WSP(bf16, WS_XS);
    if (kMoeFp8) {
        unsigned char* XB8 = WSP(unsigned char, WS_XS);
        for (int row = gw; row < M; row += NGW) {
            const float* hp = HF + (size_t)row * 1024 + 16 * lane; v4u o;
#pragma unroll
            for (int q = 0; q < 4; ++q) { const f32x4 v = *(const f32x4*)(hp + 4 * q); unsigned w = 0u; w = __builtin_amdgcn_cvt_pk_fp8_f32(v[0], v[1], w, false); w = __builtin_amdgcn_cvt_pk_fp8_f32(v[2], v[3], w, true); o[q] = w; }
#pragma unroll
            for (int k = 0; k < 4; ++k) { const int slot = base[TOKE[(size_t)row * 4 + k]] + TOKPOS[(size_t)row * 4 + k]; *(v4u*)(XB8 + (size_t)slot * 1024 + 16 * lane) = o; }
        }
        return;
    }
    for (int row = gw; row < M; row += NGW) {
        const v4u a = *(const v4u*)(HB + (size_t)row * 1024 + 8 * lane), b = *(const v4u*)(HB + (size_t)row * 1024 + 512 + 8 * lane);
#pragma unroll
        for (int k = 0; k < 4; ++k) {
            const int slot = base[TOKE[(size_t)row * 4 + k]] + TOKPOS[(size_t)row * 4 + k];
            *(v4u*)(XS + (size_t)slot * 1024 + 8 * lane) = a; *(v4u*)(XS + (size_t)slot * 1024 + 512 + 8 * lane) = b;
        }
    }
}

__device__ __forceinline__ void p12_combine(Frame& F, KArgs A, int l, const float* HIN, float* HOUT, bf16* HB) {
    const int lane = F.lane, tid = F.tid, gw = F.bid * NWAVES + F.wave, NGW = F.G * NWAVES;
    LAS int* base = (LAS int*)(F.lds + MISC_OFF + 256);
    if (tid == 0) { int acc = 0; for (int e = 0; e < NEXP; ++e) { const int c = (int)__hip_atomic_load(F.ctl + CW_CNT + 64 * (32 * l + e), RLX_AGENT); base[e] = acc; acc += ((c + 255) >> 8) << 8; } }
    __syncthreads();
    const int* TOKE = WSP(int, WS_ROUTE); const int* TOKPOS = TOKE + M * 4; const float* TOKG = (const float*)(TOKPOS + M * 4);
    const bf16* YS = WSP(bf16, WS_YS); const bf16* PLE = WSP(bf16, WS_PLE);
    const float* lg_g = A->in[I_LNF_G] + (size_t)l * 1024; const float* lg_b = A->in[I_LNF_B] + (size_t)l * 1024;
    for (int row = gw; row < M; row += NGW) {
        float x[16];
        {   const f32x4 h0 = *(const f32x4*)(HIN + (size_t)row * 1024 + 8 * lane), h1 = *(const f32x4*)(HIN + (size_t)row * 1024 + 8 * lane + 4);
            const f32x4 h2 = *(const f32x4*)(HIN + (size_t)row * 1024 + 512 + 8 * lane), h3 = *(const f32x4*)(HIN + (size_t)row * 1024 + 512 + 8 * lane + 4);
            float p0[8], p1[8]; unpack8(*(const v4u*)(PLE + (size_t)row * 1024 + 8 * lane), p0); unpack8(*(const v4u*)(PLE + (size_t)row * 1024 + 512 + 8 * lane), p1);
#pragma unroll
            for (int i = 0; i < 4; ++i) { x[i] = ALPHA * h0[i] + p0[i]; x[4 + i] = ALPHA * h1[i] + p0[4 + i]; x[8 + i] = ALPHA * h2[i] + p1[i]; x[12 + i] = ALPHA * h3[i] + p1[4 + i]; }
        }
#pragma unroll
        for (int k = 0; k < 4; ++k) {
            const int slot = base[TOKE[(size_t)row * 4 + k]] + TOKPOS[(size_t)row * 4 + k]; const float g = TOKG[(size_t)row * 4 + k];
            float y0[8], y1[8]; unpack8(*(const v4u*)(YS + (size_t)slot * 1024 + 8 * lane), y0); unpack8(*(const v4u*)(YS + (size_t)slot * 1024 + 512 + 8 * lane), y1);
#pragma unroll
            for (int i = 0; i < 8; ++i) { x[i] += g * y0[i]; x[8 + i] += g * y1[i]; }
        }
        float s = 0.f;
#pragma unroll
        for (int i = 0; i < 16; ++i) s += x[i];
        const float mean = wave_sum(s) * (1.0f / 1024.0f); float s2 = 0.f;
#pragma unroll
        for (int i = 0; i < 16; ++i) { x[i] -= mean; s2 += x[i] * x[i]; }
        const float rstd = rsqrtf(wave_sum(s2) * (1.0f / 1024.0f) + 1e-5f);
#pragma unroll
        for (int hf = 0; hf < 2; ++hf) {
            const int c0 = 512 * hf + 8 * lane;
            const f32x4 g0 = *(const f32x4*)(lg_g + c0), g1 = *(const f32x4*)(lg_g + c0 + 4), b0 = *(const f32x4*)(lg_b + c0), b1 = *(const f32x4*)(lg_b + c0 + 4);
            f32x4 o0, o1;
#pragma unroll
            for (int i = 0; i < 4; ++i) { o0[i] = x[8 * hf + i] * rstd * g0[i] + b0[i]; o1[i] = x[8 * hf + 4 + i] * rstd * g1[i] + b1[i]; }
            *(f32x4*)(HOUT + (size_t)row * 1024 + c0) = o0; *(f32x4*)(HOUT + (size_t)row * 1024 + c0 + 4) = o1;
            if (HB) { v4u w; w.x = pk2(o0[0], o0[1]); w.y = pk2(o0[2], o0[3]); w.z = pk2(o1[0], o1[1]); w.w = pk2(o1[2], o1[3]); *(v4u*)(HB + (size_t)row * 1024 + c0) = w; }
        }
    }
}

__device__ __forceinline__ void p14_dilated(Frame& F) {
    const int lane = F.lane, gw = F.bid * NWAVES + F.wave, NGW = F.G * NWAVES;
    LAS float* pe = (LAS float*)(F.lds + F.wave * 2048);
    const bf16* QK = WSP(bf16, WS_QKVZ); bf16* AO = WSP(bf16, WS_AO);
    for (int task = gw; task < M * 12; task += NGW) {
        const int row = task / 12, hh = task - row * 12, b = row >> 13, pos = row & (SEQ - 1);
        float q[64];
#pragma unroll
        for (int c = 0; c < 8; ++c) { float f[8]; unpack8(*(const v4u*)(QK + (size_t)row * 2560 + hh * 64 + 8 * c), f);
#pragma unroll
            for (int x = 0; x < 8; ++x) q[8 * c + x] = f[x]; }
        float s[7];
#pragma unroll
        for (int i = 0; i < 7; ++i) {
            const int e = lane + 64 * i, p = e / 129, m = e - p * 129;
            const int dd = (p == 0) ? 1 : (p == 1 ? 4 : 16);
            const int kpos = pos - m * dd; const bool valid = (e < 387) && (kpos >= 0);
            float a = -INFINITY;
            if (valid) {
                const bf16* kr = QK + (size_t)(b * SEQ + kpos) * 2560 + 768 + hh * 64; a = 0.f;
#pragma unroll
                for (int c = 0; c < 8; ++c) { float f[8]; unpack8(*(const v4u*)(kr + 8 * c), f);
#pragma unroll
                    for (int x = 0; x < 8; ++x) a += q[8 * c + x] * f[x]; }
                a *= 0.125f;
            }
            s[i] = a;
        }
        float mx = s[0];
#pragma unroll
        for (int i = 1; i < 7; ++i) mx = fmaxf(mx, s[i]);
        mx = wave_max(mx);
        float l = 0.f;
#pragma unroll
        for (int i = 0; i < 7; ++i) { const float ev = __expf(s[i] - mx); pe[lane + 64 * i] = ev; l += ev; }
        l = wave_sum(l);
        float o = 0.f;
#pragma unroll
        for (int p = 0; p < 3; ++p) {
            const int dd = (p == 0) ? 1 : (p == 1 ? 4 : 16);
            int mmax = pos / dd; if (mmax > 128) mmax = 128;
            const bf16* vb = QK + (size_t)(b * SEQ + pos) * 2560 + 1536 + hh * 64 + lane;
            for (int m = 0; m <= mmax; ++m) o += pe[p * 129 + m] * bf1(vb[-(ptrdiff_t)m * dd * 2560]);
        }
        AO[(size_t)row * 1024 + hh * 64 + lane] = (bf16)f2bf(o / l);
    }
}
typedef short v4i16_t __attribute__((ext_vector_type(4)));
__device__ __forceinline__ v4i16_t lds_tr16(LAS unsigned char* p) { return __builtin_amdgcn_ds_read_tr16_b64_v4i16((LAS v4i16_t*)p); }
constexpr int DV_PITCH = 144, DV_BUF = 32 * DV_PITCH;
template <int DL  > __device__ __forceinline__ void dil_branch(const bf16* __restrict__ KV, LAS unsigned char* vbuf, const int s0, const int lane,
                                                                                 const bf16x8 (&qf)[2], f32x4 (&O)[4], float& m_run, float& l_run) {
    constexpr int d = 1 << DL, sigma = 16 >> DL, NS = (129 + 15 * sigma + 31) / 32;
    const int fr = lane & 15, fq = lane >> 4;
    const int c = s0 & (d - 1), n0 = s0 >> DL, kstart = n0 - 128;
#define DIL_POS(n) ({ int _p = c + d * (n); _p = _p < 0 ? 0 : (_p > SEQ - 1 ? SEQ - 1 : _p); _p; })
    bf16x8 kf[2][2]; v4u vr[4];
#pragma unroll
    for (int tl = 0; tl < 2; ++tl) { const bf16* kp = KV + (size_t)DIL_POS(kstart + 16 * tl + fr) * 2560 + 768 + 8 * fq; kf[tl][0] = *(const bf16x8*)kp; kf[tl][1] = *(const bf16x8*)(kp + 32); }
#pragma unroll
    for (int i = 0; i < 4; ++i) vr[i] = *(const v4u*)(KV + (size_t)DIL_POS(kstart + (lane >> 3) + 8 * i) * 2560 + 1536 + 8 * (lane & 7));
#pragma unroll 1
    for (int g = 0; g < NS; ++g) {
        LAS unsigned char* vb = vbuf + (g & 1) * DV_BUF;
#pragma unroll
        for (int i = 0; i < 4; ++i) *(LAS v4u*)(vb + ((lane >> 3) + 8 * i) * DV_PITCH + 16 * (lane & 7)) = vr[i];
        bf16x8 kc[2][2];
#pragma unroll
        for (int tl = 0; tl < 2; ++tl) { kc[tl][0] = kf[tl][0]; kc[tl][1] = kf[tl][1]; }
        if (g + 1 < NS) {
            const int kb = kstart + 32 * (g + 1);
#pragma unroll
            for (int tl = 0; tl < 2; ++tl) { const bf16* kp = KV + (size_t)DIL_POS(kb + 16 * tl + fr) * 2560 + 768 + 8 * fq; kf[tl][0] = *(const bf16x8*)kp; kf[tl][1] = *(const bf16x8*)(kp + 32); }
#pragma unroll
            for (int i = 0; i < 4; ++i) vr[i] = *(const v4u*)(KV + (size_t)DIL_POS(kb + (lane >> 3) + 8 * i) * 2560 + 1536 + 8 * (lane & 7));
        }
        float sv[8];
#pragma unroll
        for (int tl = 0; tl < 2; ++tl) {
            f32x4 cc = __builtin_amdgcn_mfma_f32_16x16x32_bf16(kc[tl][0], qf[0], (f32x4){0.f, 0.f, 0.f, 0.f}, 0, 0, 0);
            cc = __builtin_amdgcn_mfma_f32_16x16x32_bf16(kc[tl][1], qf[1], cc, 0, 0, 0);
#pragma unroll
            for (int j = 0; j < 4; ++j) {
                const int rel = 32 * g + 16 * tl + 4 * fq + j;
                const int delta = 128 + sigma * fr - rel;
                const bool ok = (delta >= 0) && (delta <= 128) && (kstart + rel >= 0);
                sv[4 * tl + j] = ok ? cc[j] * 0.125f : -INFINITY;
            }
        }
        float mx = fmaxf(fmaxf(fmaxf(sv[0], sv[1]), fmaxf(sv[2], sv[3])), fmaxf(fmaxf(sv[4], sv[5]), fmaxf(sv[6], sv[7])));
        mx = fmaxf(mx, __shfl_xor(mx, 16)); mx = fmaxf(mx, __shfl_xor(mx, 32));
        const float m_new = fmaxf(m_run, mx);
        if (!__all(m_new == m_run)) {
            const float alpha = __expf(m_run - m_new);
            l_run *= alpha;
#pragma unroll
            for (int j = 0; j < 4; ++j) { const float aj = __shfl(alpha, 4 * fq + j);
#pragma unroll
                for (int dt = 0; dt < 4; ++dt) O[dt][j] *= aj; }
            m_run = m_new;
        }
        float p[8], ps = 0.f;
#pragma unroll
        for (int e = 0; e < 8; ++e) { p[e] = __expf(sv[e] - m_run); ps += p[e]; }
        l_run += ps;
        v4u pw; pw.x = pg8::cvt_pk_bf16(p[0], p[1]); pw.y = pg8::cvt_pk_bf16(p[2], p[3]); pw.z = pg8::cvt_pk_bf16(p[4], p[5]); pw.w = pg8::cvt_pk_bf16(p[6], p[7]);
        const bf16x8 pf = __builtin_bit_cast(bf16x8, pw);
        LAS unsigned char* tb = vb + (4 * fq + ((lane & 15) >> 2)) * DV_PITCH + 8 * (lane & 3);
#pragma unroll
        for (int dt = 0; dt < 4; ++dt) {
            const v4i16_t lo = lds_tr16(tb + 32 * dt), hi = lds_tr16(tb + 16 * DV_PITCH + 32 * dt);
            bf16x8 vf; vf[0] = lo[0]; vf[1] = lo[1]; vf[2] = lo[2]; vf[3] = lo[3]; vf[4] = hi[0]; vf[5] = hi[1]; vf[6] = hi[2]; vf[7] = hi[3];
            O[dt] = __builtin_amdgcn_mfma_f32_16x16x32_bf16(pf, vf, O[dt], 0, 0, 0);
        }
    }
#undef DIL_POS
}
__device__ __forceinline__ void p14_dilated_mfma(Frame& F) {
    const int lane = F.lane, fr = lane & 15, fq = lane >> 4;
    LAS unsigned char* vbuf = F.lds + F.wave * (2 * DV_BUF);
    const bf16* QK = WSP(bf16, WS_QKVZ); bf16* AO = WSP(bf16, WS_AO);
    for (int u = F.bid; u < 24 * 32 * 2; u += F.G) {
        const int bh = u >> 6, blk = (u >> 1) & 31, o = (u & 1) * 8 + F.wave;
        const int b = bh / 12, hh = bh - b * 12, s0 = 256 * blk + o;
        const bf16* KV = QK + (size_t)b * SEQ * 2560 + hh * 64;
        bf16x8 qf[2];
        { const bf16* qp = KV + (size_t)(s0 + 16 * fr) * 2560 + 8 * fq; qf[0] = *(const bf16x8*)qp; qf[1] = *(const bf16x8*)(qp + 32); }
        f32x4 O[4];
#pragma unroll
        for (int dt = 0; dt < 4; ++dt) O[dt] = (f32x4){0.f, 0.f, 0.f, 0.f};
        float m_run = -1e30f, l_run = 0.f;
        dil_branch<4>(KV, vbuf, s0, lane, qf, O, m_run, l_run);
        dil_branch<2>(KV, vbuf, s0, lane, qf, O, m_run, l_run);
        dil_branch<0>(KV, vbuf, s0, lane, qf, O, m_run, l_run);
        float lt = l_run; lt += __shfl_xor(lt, 16); lt += __shfl_xor(lt, 32);
        const float inv = 1.0f / lt;
#pragma unroll
        for (int j = 0; j < 4; ++j) {
            const float ij = __shfl(inv, 4 * fq + j);
            bf16* op = AO + (size_t)(b * SEQ + s0 + 16 * (4 * fq + j)) * 1024 + hh * 64 + fr;
#pragma unroll
            for (int dt = 0; dt < 4; ++dt) op[16 * dt] = (bf16)f2bf(O[dt][j] * ij);
        }
    }
}
constexpr int SA_PITCH = 272, SA_TILE = 32 * SA_PITCH;
__device__ __forceinline__ void sparse_row(Frame& F, const int row, const int n, const LAS int* sel, LAS unsigned char* tile) {
    const int lane = F.lane, fr = lane & 15, fq = lane >> 4;
    const bf16* QL = WSP(bf16, WS_QL); const bf16* CKV = WSP(bf16, WS_CKV); bf16* AO = WSP(bf16, WS_AO);
    {
        const int b = row >> 13;
        const bf16* kvb = CKV + (size_t)b * SEQ * 128;
        bf16x8 qf[4];
#pragma unroll
        for (int s = 0; s < 4; ++s) { const v4u z = (v4u){0u, 0u, 0u, 0u}; qf[s] = (fr < 8) ? *(const bf16x8*)(QL + (size_t)row * 1536 + fr * 128 + 32 * s + 8 * fq) : __builtin_bit_cast(bf16x8, z); }
        f32x4 O[8];
#pragma unroll
        for (int rt = 0; rt < 8; ++rt) O[rt] = (f32x4){0.f, 0.f, 0.f, 0.f};
        float m_run = -1e30f, l_run = 0.f;
        const int nsteps = (n + 31) >> 5;
        v4u vr[8];
        { const int j = lane & 31; const int kidx = (j < n) ? sel[j] : 0;
#pragma unroll
          for (int i = 0; i < 8; ++i) { const int key = __shfl(kidx, (lane >> 4) + 4 * i); vr[i] = *(const v4u*)(kvb + (size_t)key * 128 + 8 * (lane & 15)); } }
#pragma unroll 1
        for (int g = 0; g < nsteps; ++g) {
#pragma unroll
            for (int i = 0; i < 8; ++i) *(LAS v4u*)(tile + ((lane >> 4) + 4 * i) * SA_PITCH + 16 * (lane & 15)) = vr[i];
            if (g + 1 < nsteps) {
                const int j = 32 * (g + 1) + (lane & 31); const int kidx = (j < n) ? sel[j] : 0;
#pragma unroll
                for (int i = 0; i < 8; ++i) { const int key = __shfl(kidx, (lane >> 4) + 4 * i); vr[i] = *(const v4u*)(kvb + (size_t)key * 128 + 8 * (lane & 15)); }
            }
            float sv[8];
#pragma unroll
            for (int tl = 0; tl < 2; ++tl) {
                f32x4 cc = (f32x4){0.f, 0.f, 0.f, 0.f};
#pragma unroll
                for (int s = 0; s < 4; ++s) { const bf16x8 kf = *(const LAS bf16x8*)(tile + (16 * tl + fr) * SA_PITCH + 64 * s + 16 * fq); cc = __builtin_amdgcn_mfma_f32_16x16x32_bf16(kf, qf[s], cc, 0, 0, 0); }
#pragma unroll
                for (int j = 0; j < 4; ++j) sv[4 * tl + j] = (32 * g + 16 * tl + 4 * fq + j < n) ? cc[j] : -INFINITY;
            }
            float mx = fmaxf(fmaxf(fmaxf(sv[0], sv[1]), fmaxf(sv[2], sv[3])), fmaxf(fmaxf(sv[4], sv[5]), fmaxf(sv[6], sv[7])));
            mx = fmaxf(mx, __shfl_xor(mx, 16)); mx = fmaxf(mx, __shfl_xor(mx, 32));
            const float m_new = fmaxf(m_run, mx);
            if (!__all(m_new == m_run)) {
                const float alpha = __expf(m_run - m_new);
                l_run *= alpha;
#pragma unroll
                for (int j = 0; j < 4; ++j) { const float aj = __shfl(alpha, 4 * fq + j);
#pragma unroll
                    for (int rt = 0; rt < 8; ++rt) O[rt][j] *= aj; }
                m_run = m_new;
            }
            float p[8], ps = 0.f;
#pragma unroll
            for (int e = 0; e < 8; ++e) { p[e] = __expf(sv[e] - m_run); ps += p[e]; }
            l_run += ps;
            v4u pw; pw.x = pg8::cvt_pk_bf16(p[0], p[1]); pw.y = pg8::cvt_pk_bf16(p[2], p[3]); pw.z = pg8::cvt_pk_bf16(p[4], p[5]); pw.w = pg8::cvt_pk_bf16(p[6], p[7]);
            const bf16x8 pf = __builtin_bit_cast(bf16x8, pw);
            LAS unsigned char* tb = tile + (4 * fq + ((lane & 15) >> 2)) * SA_PITCH + 8 * (lane & 3);
#pragma unroll
            for (int rt = 0; rt < 8; ++rt) {
                const v4i16_t lo = lds_tr16(tb + 32 * rt), hi = lds_tr16(tb + 16 * SA_PITCH + 32 * rt);
                bf16x8 vf; vf[0] = lo[0]; vf[1] = lo[1]; vf[2] = lo[2]; vf[3] = lo[3]; vf[4] = hi[0]; vf[5] = hi[1]; vf[6] = hi[2]; vf[7] = hi[3];
                O[rt] = __builtin_amdgcn_mfma_f32_16x16x32_bf16(pf, vf, O[rt], 0, 0, 0);
            }
        }
        float lt = l_run; lt += __shfl_xor(lt, 16); lt += __shfl_xor(lt, 32);
        const float inv = 1.0f / lt;
#pragma unroll
        for (int j = 0; j < 4; ++j) {
            const float ij = __shfl(inv, 4 * fq + j);
            if (fq < 2) { bf16* op = AO + (size_t)row * 1536 + (4 * fq + j) * 128 + fr;
#pragma unroll
                for (int rt = 0; rt < 8; ++rt) op[16 * rt] = (bf16)f2bf(O[rt][j] * ij); }
        }
    }
}
__device__ __forceinline__ void p5_topk_attn(Frame& F, const int gw, const int NGW) {
    LAS int* sel = (LAS int*)(F.lds + F.wave * 16384);
    LAS unsigned char* tile = F.lds + F.wave * 16384 + 1024;
    LAS unsigned long long* cand = (LAS unsigned long long*)(F.lds + F.wave * 16384 + 1024 + SA_TILE);
    static_assert(1024 + SA_TILE + TK_CAP * 8 <= 16384, "per-wave LDS");
    for (int rix = gw; rix < M; rix += NGW) {
        const int row = ((rix & 1) ? (M - 1 - (rix >> 1)) : (rix >> 1));
        const int n = __builtin_amdgcn_readfirstlane(topk_row(F, row, sel, cand));
        sparse_row(F, row, n, sel, tile);
    }
}
__device__ __forceinline__ void p14_pool(Frame& F, KArgs A) {
    const int lane = F.lane, tid = F.tid, gw = F.bid * NWAVES + F.wave, NGW = F.G * NWAVES;
    LAS float* pw = (LAS float*)(F.lds + 16384);
    LAS float* dl = (LAS float*)(F.lds + 16384 + 65536 + F.wave * 1024);
    for (int i = tid; i < 4 * 64 * 64; i += NTHREADS) pw[i] = A->in[I_CD_POOLW][i];
    __syncthreads();
    const bf16* QK = WSP(bf16, WS_QKVZ); bf16* AO = WSP(bf16, WS_AO);
    const int gi = lane >> 4, w = 2 << gi;
    float sc[4];
#pragma unroll
    for (int g = 0; g < 4; ++g) sc[g] = A->in[I_CD_POOLS][g * 64 + lane];
    for (int row = gw; row < M; row += NGW) {
        const int pos = row & (SEQ - 1);
        const int cntw = (pos + 1 < w) ? pos + 1 : w;
        float sum[4] = {0.f, 0.f, 0.f, 0.f}, cur[4] = {0.f, 0.f, 0.f, 0.f};
        for (int j = 0; j < cntw; ++j) {
            const v2u xr = *(const v2u*)(QK + (size_t)(row - j) * 2560 + 2304 + 4 * lane);
            const float f0 = bflo(xr.x), f1 = bfhi(xr.x), f2 = bflo(xr.y), f3 = bfhi(xr.y);
            sum[0] += f0; sum[1] += f1; sum[2] += f2; sum[3] += f3;
            if (j == 0) { cur[0] = f0; cur[1] = f1; cur[2] = f2; cur[3] = f3; }
        }
        const float inv = 1.0f / (float)cntw;
#pragma unroll
        for (int i = 0; i < 4; ++i) dl[4 * lane + i] = sum[i] * inv - cur[i];
        float o[4] = {0.f, 0.f, 0.f, 0.f};
        for (int c = 0; c < 64; ++c) {
#pragma unroll
            for (int g = 0; g < 4; ++g) o[g] += dl[g * 64 + c] * pw[(g * 64 + c) * 64 + lane];
        }
#pragma unroll
        for (int g = 0; g < 4; ++g) AO[(size_t)row * 1024 + 768 + g * 64 + lane] = (bf16)f2bf(o[g] * sc[g]);
    }
}


#define IN(k) (lo <= (k) && (k) < hi)
#define SEAM(k) do { if (IN(k) && IN((k) + 1)) xcd_barrier(bar); } while (0)
template <int l> __device__ __forceinline__ void layer_tail(Frame& F, const XcdBarrier& bar, const int lo, const int hi) {
    LAS unsigned char* ring = F.lds + RING_OFF;
    const int bid = F.bid, G = F.G;
        const int pb = 8 * l;

        if (IN(7 + pb)) {
            pg8::Gemm g{WSP(bf16, WS_AO), (l == 0) ? WSP(bf16, WS_W_OUTAB) : WSP(bf16, WS_W_OUTCD), M, 1024, (l == 0) ? 1536 : 1024}; pg8::StaticOrder S; S.init(M, 1024, G, bid);
            pg8::Epi<pg8::StPre> E{{(l == 0) ? kargs()->in[I_X] : WSP(float, WS_H2), WSP(float, WS_PRE), ALPHA}};
            pg8::gemm_phase<pg8::Epi<pg8::StPre>, pg8::StaticOrder, true, true>(ring, g, S, E);
        } SEAM(7 + pb);
        if (IN(8 + pb)) { p8_ln_router(F, kargs(), l, WSP(float, WS_H1), WSP(bf16, WS_H1B)); } SEAM(8 + pb);
        if (IN(9 + pb)) {
            p9_scatter(F, l, WSP(bf16, WS_H1B), WSP(float, WS_H1));
            __syncthreads();
            pg8::Gemm g{WSP(bf16, WS_H1B), WSP(bf16, WS_W_PG) + (size_t)l * 1024 * 1024, M, 1024, 1024}; pg8::StaticOrder S; S.init(M, 1024, G, bid);
            pg8::Epi<pg8::StPleGate> E{{WSP(bf16, WS_PP) + (size_t)l * M * 1024, WSP(bf16, WS_PLE)}};
            pg8::gemm_phase<pg8::Epi<pg8::StPleGate>, pg8::StaticOrder, true, true>(ring, g, S, E);
        } SEAM(9 + pb);
        const int* TILE = WSP(int, WS_ROUTE) + 3 * M * 4;
        if (IN(10 + pb)) {
            const int nT = __builtin_amdgcn_readfirstlane(TILE[NTMAX]);
            constexpr int EB = kMoeFp8 ? 1 : 2;
            pg8::Gemm g{WSP(bf16, WS_XS), (const bf16*)(F.ws + WS_W_GU + (size_t)l * NEXP * 2048 * 1024 * EB), PMAX, 2048, 1024 * EB / 2};
            pg8::MoeOrder S{TILE, nT, 8, G, bid, (long)2048 * 1024 * EB};
            pg8::Epi<pg8::StSwiglu<kMoeFp8>> E{{kargs()->in[I_BGU] + (size_t)l * NEXP * 2048, WSP(bf16, WS_HID)}};
            pg8::gemm_phase<pg8::Epi<pg8::StSwiglu<kMoeFp8>>, pg8::MoeOrder, true, true, kMoeFp8 ? kScaleGU : 0u>(ring, g, S, E);
        } SEAM(10 + pb);
        if (IN(11 + pb)) {
            const int nT = __builtin_amdgcn_readfirstlane(TILE[NTMAX]);
            constexpr int EB = kMoeFp8 ? 1 : 2;
            pg8::Gemm g{WSP(bf16, WS_HID), (const bf16*)(F.ws + WS_W_DN + (size_t)l * NEXP * 1024 * 1024 * EB), PMAX, 1024, 1024 * EB / 2};
            pg8::MoeOrder S{TILE, nT, 4, G, bid, (long)1024 * 1024 * EB};
            pg8::Epi<pg8::StDown> E{{kargs()->in[I_BDN] + (size_t)l * NEXP * 1024, WSP(bf16, WS_YS)}};
            pg8::gemm_phase<pg8::Epi<pg8::StDown>, pg8::MoeOrder, true, true, kMoeFp8 ? kScaleDN : 0u>(ring, g, S, E);
        } SEAM(11 + pb);
        if (IN(12 + pb)) { p12_combine(F, kargs(), l, WSP(float, WS_H1), (l == 0) ? WSP(float, WS_H2) : kargs()->out, (l == 0) ? WSP(bf16, WS_XB) : (bf16*)nullptr); }
}
#undef IN
#undef SEAM
__global__ void __launch_bounds__(NTHREADS, 2) mk_fwd(Args args_by_value) {
    const KArgs KA = kargs();
    extern __shared__ __attribute__((aligned(16))) unsigned char lds[];
    Frame F;
    F.lds = (LAS unsigned char*)lds;
    F.tid = threadIdx.x; F.lane = F.tid & 63; F.wave = __builtin_amdgcn_readfirstlane(F.tid >> 6);
    F.G = gridDim.x; F.bid = blockIdx.x; F.ws = KA->ws; F.ctl = (gu32*)(KA->ws + WS_CTL);
    volatile LAS unsigned* MISC = (volatile LAS unsigned*)(F.lds + MISC_OFF);
    { int t0 = threadIdx.x; asm volatile("" : "+v"(t0)); for (int u = t0; u < (LDS_BYTES - MISC_OFF) / 4; u += NTHREADS) MISC[u] = 0u; }
    __syncthreads();
    const bool use_bar = (N_LAUNCHES != NPHASES);
    XcdBarrier bar; bar.bar = (unsigned*)(F.ctl + CW_BAR) + KA->li * XCD_BAR_WORDS; bar.x = 0; bar.st = nullptr; bar.expect = 0;
    XcdBarrier bar2 = bar;
    if (use_bar && F.bid >= SEQ_WGS && F.G > SEQ_WGS) bar2 = xcd_barrier_post((unsigned*)(F.ctl + CW_BAR2), MISC + 10, (unsigned)(F.G - SEQ_WGS));
    if (use_bar) bar = xcd_barrier_post((unsigned*)(F.ctl + CW_BAR) + KA->li * XCD_BAR_WORDS, MISC + 8);
    const int lo = KA->ph_lo, hi = KA->ph_hi;
#define IN(k) (lo <= (k) && (k) < hi)
#define SEAM(k) do { if (IN(k) && IN((k) + 1)) xcd_barrier(bar); } while (0)
    LAS unsigned char* ring = F.lds + RING_OFF;
    const int bid = F.bid, G = F.G;

    if (IN(0)) { p0_prologue(F, kargs()); } SEAM(0);

            if (IN(1)) {
                { pg8::Gemm g{WSP(bf16, WS_XB), WSP(bf16, WS_W_INAB), M, 2560, 1024}; pg8::StaticOrder S; S.init(M, 2560, G, bid);
                  pg8::Epi<pg8::StInAB> E{{WSP(float, WS_SM), WSP(bf16, WS_QKVZ)}};
                  pg8::gemm_phase<pg8::Epi<pg8::StInAB>, pg8::StaticOrder, true, true>(ring, g, S, E); }
                __syncthreads();
                { pg8::Gemm g{WSP(bf16, WS_PB), WSP(bf16, WS_W_PP), 2 * M, 1024, 256}; pg8::BatchOrder S{4, (2 * M / 256) * 4, G, bid, M / 256, (long)1024 * 256 * 2};
                  pg8::Epi<pg8::StBf16> E{{WSP(bf16, WS_PP), 1024}};
                  pg8::gemm_phase<pg8::Epi<pg8::StBf16>, pg8::BatchOrder, true, true>(ring, g, S, E); }
            } SEAM(1);
            if (IN(2)) { p2_prep(F, kargs()); } SEAM(2);
            if (IN(3)) {
                p3_chunk_prep(F, kargs());
                __syncthreads();
                { pg8::Gemm g{WSP(bf16, WS_CQ), WSP(bf16, WS_W_ABS), M, 1536, 256}; pg8::StaticOrder S; S.init(M, 1536, G, bid);
                  pg8::Epi<pg8::StBf16> E{{WSP(bf16, WS_QL), 1536}};
                  pg8::gemm_phase<pg8::Epi<pg8::StBf16>, pg8::StaticOrder, true, true>(ring, g, S, E); }
            } SEAM(3);
            if (IN(4)) {
                if (bid < SEQ_WGS && G > SEQ_WGS) p4_delta_seq(F, bid);
                else { p4_indexer(F, (bid - SEQ_WGS) * NWAVES + F.wave, (G - SEQ_WGS) * NWAVES);
                    if (use_bar) { xcd_barrier(bar2);
                        p5_topk_attn(F, (bid - SEQ_WGS) * NWAVES + F.wave, (G - SEQ_WGS) * NWAVES); } }
            } SEAM(4);
            if (IN(5)) { if (!use_bar) p5_topk_attn(F, bid * NWAVES + F.wave, G * NWAVES); p6_gdn_out(F, kargs()); } SEAM(5);
    layer_tail<0>(F, bar, lo, hi);
    SEAM(12);
            if (IN(13)) {
                pg8::Gemm g{WSP(bf16, WS_XB), WSP(bf16, WS_W_INCD), M, 2560, 1024}; pg8::StaticOrder S; S.init(M, 2560, G, bid);
                pg8::Epi<pg8::StBf16> E{{WSP(bf16, WS_QKVZ), 2560}};
                pg8::gemm_phase<pg8::Epi<pg8::StBf16>, pg8::StaticOrder, true, true>(ring, g, S, E);
            } SEAM(13);
            if (IN(14)) { p14_dilated_mfma(F); __syncthreads(); p14_pool(F, kargs()); } SEAM(14);
    layer_tail<1>(F, bar, lo, hi);
#undef IN
#undef SEAM
}

extern "C" void kernel_launch(void* const* d_in, const int* in_sizes, int n_in, void* d_out, int out_size, void* d_ws, size_t ws_size, hipStream_t stream) {
    static int grid = 0;
    if (grid == 0) {
        if (n_in != N_IN || in_sizes[0] != M * D || out_size != M * D || ws_size < WS_END) {
            fprintf(stderr, "kernel_launch: built for %d inputs, x/out of %d floats, >= %zu bytes of workspace; got n_in %d, in0 %d, out %d, ws %zu; nothing launched\n", N_IN, M * D, (size_t)WS_END, n_in, n_in > 0 ? in_sizes[0] : -1, out_size, ws_size);
            grid = -1; return; }
        int dev = 0, cus = 0, per_cu = 0;
        if (hipGetDevice(&dev) != hipSuccess || hipDeviceGetAttribute(&cus, hipDeviceAttributeMultiprocessorCount, dev) != hipSuccess) { fprintf(stderr, "kernel_launch: device query failed\n"); grid = -1; return; }
        if (hipFuncSetAttribute((const void*)mk_fwd, hipFuncAttributeMaxDynamicSharedMemorySize, LDS_BYTES) != hipSuccess) { fprintf(stderr, "kernel_launch: hipFuncSetAttribute failed\n"); grid = -1; return; }
        if (hipOccupancyMaxActiveBlocksPerMultiprocessor(&per_cu, (const void*)mk_fwd, NTHREADS, LDS_BYTES) != hipSuccess || per_cu < 1)
            fprintf(stderr, "kernel_launch: note: occupancy query reports %d workgroups per CU\n", per_cu);
        (void)hipGetLastError();
        grid = cus;
    }
    if (grid < 0) return;
    if (hipMemsetAsync((char*)d_ws + WS_CTL, 0, CTL_ZERO_BYTES, stream) != hipSuccess) { fprintf(stderr, "kernel_launch: memset failed\n"); return; }
    Args a{};
    for (int i = 0; i < N_IN; ++i) a.in[i] = (const float*)d_in[i];
    a.out = (float*)d_out; a.ws = (unsigned char*)d_ws;
    for (int li = 0; li < N_LAUNCHES; ++li) {
        if (N_LAUNCHES == NPHASES) { a.ph_lo = li; a.ph_hi = li + 1; } else { a.ph_lo = (int)((long)li * NPHASES / N_LAUNCHES); a.ph_hi = (int)((long)(li + 1) * NPHASES / N_LAUNCHES); }
        a.li = li;
        hipLaunchKernelGGL(mk_fwd, dim3(grid), dim3(NTHREADS), LDS_BYTES, stream, a);
        const hipError_t le = hipPeekAtLastError();
        if (le != hipSuccess) { fprintf(stderr, "kernel_launch: launch %d failed: %s\n", li, hipGetErrorName(le)); break; }
    }
}
```

```cpp
#include <hip/hip_runtime.h>
#include <cstdio>
#include <cstdint>

namespace pg8 {
#define PG8_LAS __attribute__((address_space(3)))
typedef unsigned short bf16_t;
typedef short bf16x8 __attribute__((ext_vector_type(8)));
typedef float f32x4 __attribute__((ext_vector_type(4)));
typedef unsigned u32x4 __attribute__((ext_vector_type(4)));
constexpr int BM = 256, BK = 64, HALF = 128, HTB = HALF * BK * 2  , STAGE_BYTES = 8 * HTB, NXCD = 8, WGM = 8;

__host__ __device__ __forceinline__ int lds_byte(int r, int c) { const int st = (r >> 4) * 2 + (c >> 5), rr = r & 15, cc = c & 31, ob = rr * 64 + cc * 2; return st * 1024 + (ob ^ (((ob >> 9) & 1) << 5)); }
__host__ __device__ __forceinline__ void stage_rc(int b, int& R, int& C) { const int st = b / 1024, sb = b % 1024, swz = sb ^ (((sb >> 9) & 1) << 5); R = (st >> 1) * 16 + swz / 64; C = (st & 1) * 32 + (swz % 64) / 2; }
__host__ __device__ __forceinline__ int perm32(int rho) { const int n = rho >> 4, i = rho & 15; return 8 * (i >> 2) + 4 * n + (i & 3); }

struct Unit { int pm, pn, e; long bofs; };
struct Gemm { const bf16_t* A; const bf16_t* Bt; int M, N, K; };

struct StaticOrder {
    int nM, nN, nwg, G, c;
    __host__ __device__ void init(int M, int N, int G_, int c_) { nM = M / BM; nN = N / BM; nwg = nM * nN; G = G_; c = c_; }
    __host__ __device__ bool next(int i, Unit& u) const {
        const long L = (long)i * G + c; if (L >= nwg) return false;
        int wgid = (int)L; { const int q = nwg / NXCD, r = nwg % NXCD, xcd = wgid % NXCD, off = wgid / NXCD; wgid = (xcd < r ? xcd * (q + 1) : r * (q + 1) + (xcd - r) * q) + off; }
        const int nig = WGM * nN, gid = wgid / nig, fm = gid * WGM, gsz = (nM - fm) < WGM ? (nM - fm) : WGM;
        u.pm = fm + ((wgid % nig) % gsz); u.pn = (wgid % nig) / gsz; u.e = 0; u.bofs = 0; return true;
    }
    __device__ __forceinline__ void a_ready(const Unit&) const {}
    __device__ __forceinline__ void done(const Unit&) const {}
};
struct MoeOrder {
    const int* tile_e; int nT, nN, G, c; long estride;
    __device__ __forceinline__ bool next(int i, Unit& u) const {
        const long L = (long)i * G + c; if (L >= (long)nT * nN) return false;
        u.pm = (int)(L / nN); u.pn = (int)(L % nN); const int e = tile_e[u.pm]; u.e = e; u.bofs = (long)e * estride; return true;
    }
    __device__ __forceinline__ void a_ready(const Unit&) const {}
    __device__ __forceinline__ void done(const Unit&) const {}
};

struct BatchOrder {
    int nN, nwg, G, c, tiles_per_batch; long bstride;
    __device__ __forceinline__ bool next(int i, Unit& u) const {
        const long L = (long)i * G + c; if (L >= nwg) return false;
        u.pm = (int)(L / nN); u.pn = (int)(L % nN); const int e = u.pm / tiles_per_batch; u.e = e; u.bofs = (long)e * bstride; return true;
    }
    __device__ __forceinline__ void a_ready(const Unit&) const {}
    __device__ __forceinline__ void done(const Unit&) const {}
};

__device__ __forceinline__ unsigned cvt_pk_bf16(float lo, float hi) { unsigned r; asm volatile("v_cvt_pk_bf16_f32 %0, %1, %2" : "=v"(r) : "v"(lo), "v"(hi)); return r; }
__device__ __forceinline__ u32x4 pack8(const f32x4 v0, const f32x4 v1) { u32x4 w; w.x = cvt_pk_bf16(v0[0], v0[1]); w.y = cvt_pk_bf16(v0[2], v0[3]); w.z = cvt_pk_bf16(v1[0], v1[1]); w.w = cvt_pk_bf16(v1[2], v1[3]); return w; }
__device__ __forceinline__ float bf_lo(unsigned w) { return __uint_as_float(w << 16); }
__device__ __forceinline__ float bf_hi(unsigned w) { return __uint_as_float(w & 0xffff0000u); }
__device__ __forceinline__ float sigmoidf_(float x) { return 1.0f / (1.0f + __expf(-x)); }
typedef unsigned u32x2 __attribute__((ext_vector_type(2)));

template <class T> struct Epi {
    static constexpr bool PERM = true, AFTER_DRAIN = false;
    T t;
    __device__ __forceinline__ void operator()(const f32x4 (&acc)[2][2][4][2], const Unit& u, int wr, int wc, int fr, int fq) const {
        const int row0 = u.pm * BM + wr * 64 + fr, col0 = u.pn * BM + wc * 32 + 8 * fq;
        f32x4 cb[2][2];
#pragma unroll
        for (int bj = 0; bj < 2; ++bj) t.colctx(col0 + bj * HALF, u, cb[bj][0], cb[bj][1]);
#pragma unroll
        for (int ai = 0; ai < 2; ++ai)
#pragma unroll
            for (int m = 0; m < 4; ++m) {
#pragma unroll
                for (int bj = 0; bj < 2; ++bj) t.store(row0 + ai * HALF + m * 16, col0 + bj * HALF, acc[ai][bj][m][0] + cb[bj][0], acc[ai][bj][m][1] + cb[bj][1], u);
                asm volatile("" ::: "memory"); }
    }
};
struct StBf16 { bf16_t* O; int ld;
    __device__ __forceinline__ void colctx(int, const Unit&, f32x4& c0, f32x4& c1) const { c0 = (f32x4){0.f, 0.f, 0.f, 0.f}; c1 = c0; }
    __device__ __forceinline__ void store(int row, int col, f32x4 v0, f32x4 v1, const Unit&) const { *(u32x4*)(O + (size_t)row * ld + col) = pack8(v0, v1); } };
struct StInAB { float* SM; bf16_t* Q;
    __device__ __forceinline__ void colctx(int, const Unit&, f32x4& c0, f32x4& c1) const { c0 = (f32x4){0.f, 0.f, 0.f, 0.f}; c1 = c0; }
    __device__ __forceinline__ void store(int row, int col, f32x4 v0, f32x4 v1, const Unit&) const {
        if (col < 512) { float* p = SM + (size_t)row * 512 + col; *(f32x4*)p = v0; *(f32x4*)(p + 4) = v1; }
        else *(u32x4*)(Q + (size_t)row * 2048 + (col - 512)) = pack8(v0, v1); } };
struct StPre { const float* base; float* P; float alpha;
    __device__ __forceinline__ void colctx(int, const Unit&, f32x4& c0, f32x4& c1) const { c0 = (f32x4){0.f, 0.f, 0.f, 0.f}; c1 = c0; }
    __device__ __forceinline__ void store(int row, int col, f32x4 v0, f32x4 v1, const Unit&) const {
        const size_t o = (size_t)row * 1024 + col; const f32x4 b0 = *(const f32x4*)(base + o), b1 = *(const f32x4*)(base + o + 4);
        *(f32x4*)(P + o) = b0 * alpha + v0; *(f32x4*)(P + o + 4) = b1 * alpha + v1; } };
struct StPleGate { const bf16_t* PP; bf16_t* O;
    __device__ __forceinline__ void colctx(int, const Unit&, f32x4& c0, f32x4& c1) const { c0 = (f32x4){0.f, 0.f, 0.f, 0.f}; c1 = c0; }
    __device__ __forceinline__ void store(int row, int col, f32x4 v0, f32x4 v1, const Unit&) const {
        const size_t o = (size_t)row * 1024 + col; const u32x4 p = *(const u32x4*)(PP + o);
        f32x4 r0, r1;
        r0[0] = sigmoidf_(v0[0]) * bf_lo(p.x); r0[1] = sigmoidf_(v0[1]) * bf_hi(p.x); r0[2] = sigmoidf_(v0[2]) * bf_lo(p.y); r0[3] = sigmoidf_(v0[3]) * bf_hi(p.y);
        r1[0] = sigmoidf_(v1[0]) * bf_lo(p.z); r1[1] = sigmoidf_(v1[1]) * bf_hi(p.z); r1[2] = sigmoidf_(v1[2]) * bf_lo(p.w); r1[3] = sigmoidf_(v1[3]) * bf_hi(p.w);
        *(u32x4*)(O + o) = pack8(r0, r1); } };
template <bool F8> struct StSwiglu { const float* bgu; bf16_t* H;
    __device__ __forceinline__ float act(float g, float u) const { const float gt = fminf(g, 7.0f), up = fminf(fmaxf(u, -7.0f), 7.0f); return (up + 1.0f) * (gt * sigmoidf_(gt * 1.702f)); }
    __device__ __forceinline__ void colctx(int col, const Unit& u, f32x4& c0, f32x4& c1) const { const float* b = bgu + (size_t)u.e * 2048 + col; c0 = *(const f32x4*)b; c1 = *(const f32x4*)(b + 4); }
    __device__ __forceinline__ void store(int row, int col, f32x4 v0, f32x4 v1, const Unit& u) const {
        if (F8) { unsigned w = 0u; w = __builtin_amdgcn_cvt_pk_fp8_f32(act(v0[0], v0[1]), act(v0[2], v0[3]), w, false); w = __builtin_amdgcn_cvt_pk_fp8_f32(act(v1[0], v1[1]), act(v1[2], v1[3]), w, true);
            *(unsigned*)((unsigned char*)H + (size_t)row * 1024 + (col >> 1)) = w; }
        else { u32x2 w; w.x = cvt_pk_bf16(act(v0[0], v0[1]), act(v0[2], v0[3])); w.y = cvt_pk_bf16(act(v1[0], v1[1]), act(v1[2], v1[3]));
            *(u32x2*)(H + (size_t)row * 1024 + (col >> 1)) = w; } } };
struct StDown { const float* bd; bf16_t* Y;
    __device__ __forceinline__ void colctx(int col, const Unit& u, f32x4& c0, f32x4& c1) const { const float* b = bd + (size_t)u.e * 1024 + col; c0 = *(const f32x4*)b; c1 = *(const f32x4*)(b + 4); }
    __device__ __forceinline__ void store(int row, int col, f32x4 v0, f32x4 v1, const Unit& u) const {
        *(u32x4*)(Y + (size_t)row * 1024 + col) = pack8(v0, v1); } };

typedef int i32x8 __attribute__((ext_vector_type(8)));
typedef int i32x4 __attribute__((ext_vector_type(4)));
template <class Epi, class Sched, bool ALIGN_EPI = false, bool SP2 = false, unsigned FP8W = 0u>
__device__ __forceinline__ void gemm_phase(PG8_LAS unsigned char* lds, const Gemm g, const Sched& S, const Epi& E) {
    int tid = threadIdx.x; asm volatile("" : "+v"(tid));
    const int wid = __builtin_amdgcn_readfirstlane(tid >> 6), lane = tid & 63, wr = wid >> 2, wc = wid & 3, fr = lane & 15, fq = lane >> 4;
    int K = g.K; asm volatile("" : "+s"(K));
    const int nt = K / BK;
    unsigned voffA[2], voffB[2];
#pragma unroll
    for (int i = 0; i < 2; ++i) { int R, C; stage_rc(tid * 16 + i * 8192, R, C); const int Rb = Epi::PERM ? ((R & ~31) + perm32(R & 31)) : R;
        voffA[i] = (unsigned)(R * K + C) * 2u; voffB[i] = (unsigned)(Rb * K + C) * 2u; }
    const size_t kstep = (size_t)(BK * 2);
    const size_t hstep = (size_t)HALF * K * 2;
    const size_t tstep = 2 * hstep;
    const unsigned ldsw = (unsigned)wid * 1024u;
    const int aoff = lds_byte(wr * 64 + fr, fq * 8), boff = lds_byte(wc * 32 + fr, fq * 8);
#define PG8_SA(b, h) (((b) * 2 + (h)) * HTB)
#define PG8_SB(b, h) ((4 + (b) * 2 + (h)) * HTB)
#define PG8_STAGE(bufoff, gbase, voff) do { _Pragma("unroll") for (int _i = 0; _i < 2; ++_i) \
        __builtin_amdgcn_global_load_lds((const unsigned*)((const char*)(gbase) + (voff)[_i]), (PG8_LAS unsigned*)(lds + (bufoff) + ldsw + _i * 8192), 16, 0, 0); } while (0)
#define PG8_CAT(lo, hi) __builtin_shufflevector((lo), (hi), 0, 1, 2, 3, 4, 5, 6, 7)
#define PG8_LDA(dst, b, h) do { if constexpr (FP8W != 0u) { _Pragma("unroll") for (int m = 0; m < 4; ++m) dst##8[m] = PG8_CAT(*(const PG8_LAS i32x4*)(lds + PG8_SA(b, h) + aoff + m * 2048), *(const PG8_LAS i32x4*)(lds + PG8_SA(b, h) + aoff + m * 2048 + 1024)); } \
        else { _Pragma("unroll") for (int m = 0; m < 4; ++m) _Pragma("unroll") for (int k = 0; k < 2; ++k) dst[m][k] = *(const PG8_LAS bf16x8*)(lds + PG8_SA(b, h) + aoff + m * 2048 + k * 1024); } } while (0)
#define PG8_LDB(dst, b, h) do { if constexpr (FP8W != 0u) { _Pragma("unroll") for (int n = 0; n < 2; ++n) dst##8[n] = PG8_CAT(*(const PG8_LAS i32x4*)(lds + PG8_SB(b, h) + boff + n * 2048), *(const PG8_LAS i32x4*)(lds + PG8_SB(b, h) + boff + n * 2048 + 1024)); } \
        else { _Pragma("unroll") for (int n = 0; n < 2; ++n) _Pragma("unroll") for (int k = 0; k < 2; ++k) dst[n][k] = *(const PG8_LAS bf16x8*)(lds + PG8_SB(b, h) + boff + n * 2048 + k * 1024); } } while (0)
#define PG8_MMA(ai, bj, At, Bt) do { __builtin_amdgcn_s_setprio(1); _Pragma("unroll") for (int m = 0; m < 4; ++m) _Pragma("unroll") for (int n = 0; n < 2; ++n) { \
        if constexpr (FP8W != 0u) asm volatile("v_mfma_scale_f32_16x16x128_f8f6f4 %0, %1, %2, %0, %3, %4 op_sel_hi:[0,0,0]" : "+v"(acc[ai][bj][m][n]) : "v"(Bt##8[n]), "v"(At##8[m]), "v"(sc_w), "v"(sc_x));   \
        else { _Pragma("unroll") for (int k = 0; k < 2; ++k) acc[ai][bj][m][n] = __builtin_amdgcn_mfma_f32_16x16x32_bf16(Bt[n][k], At[m][k], acc[ai][bj][m][n], 0, 0, 0); } } __builtin_amdgcn_s_setprio(0); } while (0)
#define PG8_WAIT_V(n) asm volatile("s_waitcnt vmcnt(" #n ")" ::: "memory")
#define PG8_WAIT_L(n) asm volatile("s_waitcnt lgkmcnt(" #n ")" ::: "memory")
#define PG8_BAR __builtin_amdgcn_s_barrier()
#define PG8_SCHED __builtin_amdgcn_sched_barrier(0)
    Unit cur, nxt; int ui = 0;
    if (!S.next(0, cur)) return;
    f32x4 acc[2][2][4][2];
#pragma unroll
    for (int a = 0; a < 2; ++a)
#pragma unroll
        for (int b = 0; b < 2; ++b)
#pragma unroll
            for (int m = 0; m < 4; ++m)
#pragma unroll
                for (int n = 0; n < 2; ++n) acc[a][b][m][n] = (f32x4){0.f, 0.f, 0.f, 0.f};
    bf16x8 At[4][2], B0[2][2], B1[2][2];
    int sc_w = (int)FP8W, sc_x = 0x7f7f7f7f; asm volatile("" : "+v"(sc_w), "+v"(sc_x));
    i32x8 At8[4], B08[2], B18[2];
    const char* cA = (const char*)g.A + (size_t)cur.pm * tstep; const char* cB = (const char*)g.Bt + (size_t)cur.pn * tstep + cur.bofs;
    S.a_ready(cur);
    if constexpr (SP2) {
        PG8_STAGE(PG8_SB(0, 0), cB, voffB); PG8_STAGE(PG8_SB(0, 1), cB + hstep, voffB); PG8_STAGE(PG8_SA(0, 0), cA, voffA); PG8_STAGE(PG8_SA(0, 1), cA + hstep, voffA);
        if (wr == 1) PG8_BAR;
        PG8_WAIT_V(2); PG8_BAR;
        PG8_STAGE(PG8_SB(1, 0), cB + kstep, voffB); PG8_STAGE(PG8_SA(1, 0), cA + kstep, voffA); PG8_STAGE(PG8_SB(1, 1), cB + hstep + kstep, voffB);
        PG8_WAIT_V(6); PG8_BAR;
    } else {
        PG8_STAGE(PG8_SB(0, 0), cB, voffB); PG8_STAGE(PG8_SA(0, 0), cA, voffA); PG8_STAGE(PG8_SB(0, 1), cB + hstep, voffB); PG8_STAGE(PG8_SA(0, 1), cA + hstep, voffA);
        if (wr == 1) PG8_BAR;
        PG8_WAIT_V(4); PG8_BAR;
        PG8_STAGE(PG8_SB(1, 0), cB + kstep, voffB); PG8_STAGE(PG8_SA(1, 0), cA + kstep, voffA); PG8_STAGE(PG8_SB(1, 1), cB + hstep + kstep, voffB);
        PG8_WAIT_V(6); PG8_BAR;
    }
    for (;;) {
        const bool has_next = S.next(ui + 1, nxt);
        const char* nA = has_next ? (const char*)g.A + (size_t)nxt.pm * tstep : cA; const char* nB = has_next ? (const char*)g.Bt + (size_t)nxt.pn * tstep + nxt.bofs : cB;
        for (int t = 0; t < nt; t += 2) {
            const bool last = (t == nt - 2);
            const char* a1 = cA + (size_t)(t + 1) * kstep;
            const char* a2 = last ? nA : cA + (size_t)(t + 2) * kstep; const char* b2 = last ? nB : cB + (size_t)(t + 2) * kstep;
            const char* a3 = a2 + kstep; const char* b3 = b2 + kstep;
            if (last && has_next) S.a_ready(nxt);
            if constexpr (SP2) {
            PG8_LDB(B0, 0, 0); PG8_LDB(B1, 0, 1); PG8_SCHED; PG8_LDA(At, 0, 0); PG8_STAGE(PG8_SA(1, 1), a1 + hstep, voffA);
            PG8_WAIT_V(8); PG8_WAIT_L(0); PG8_BAR; PG8_MMA(0, 0, At, B0); PG8_MMA(0, 1, At, B1); PG8_BAR; PG8_SCHED;
            PG8_LDA(At, 0, 1); PG8_STAGE(PG8_SB(0, 0), b2, voffB); PG8_STAGE(PG8_SB(0, 1), b2 + hstep, voffB); PG8_STAGE(PG8_SA(0, 0), a2, voffA);
            PG8_WAIT_V(8); PG8_WAIT_L(0); PG8_BAR; PG8_MMA(1, 0, At, B0); PG8_MMA(1, 1, At, B1); PG8_BAR; PG8_SCHED;
            PG8_LDB(B0, 1, 0); PG8_LDB(B1, 1, 1); PG8_SCHED; PG8_LDA(At, 1, 0); PG8_STAGE(PG8_SA(0, 1), a2 + hstep, voffA);
            PG8_WAIT_V(8); PG8_WAIT_L(0); PG8_BAR; PG8_MMA(0, 0, At, B0); PG8_MMA(0, 1, At, B1); PG8_BAR; PG8_SCHED;
            PG8_LDA(At, 1, 1); PG8_STAGE(PG8_SB(1, 0), b3, voffB); PG8_STAGE(PG8_SB(1, 1), b3 + hstep, voffB); PG8_STAGE(PG8_SA(1, 0), a3, voffA);
            PG8_WAIT_V(8); PG8_WAIT_L(0); PG8_BAR; PG8_MMA(1, 0, At, B0); PG8_MMA(1, 1, At, B1); PG8_BAR; PG8_SCHED;
            } else {
            PG8_LDB(B0, 0, 0); PG8_SCHED; PG8_LDA(At, 0, 0); PG8_STAGE(PG8_SA(1, 1), a1 + hstep, voffA);
            PG8_WAIT_L(8); PG8_BAR; PG8_WAIT_L(0); PG8_MMA(0, 0, At, B0); PG8_BAR; PG8_SCHED;
            PG8_LDB(B1, 0, 1); PG8_STAGE(PG8_SB(0, 0), b2, voffB);
            PG8_BAR; PG8_WAIT_L(0); PG8_MMA(0, 1, At, B1); PG8_BAR;
            PG8_LDA(At, 0, 1); PG8_STAGE(PG8_SA(0, 0), a2, voffA);
            PG8_BAR; PG8_WAIT_L(0); PG8_MMA(1, 0, At, B0); PG8_BAR; PG8_SCHED;
            PG8_STAGE(PG8_SB(0, 1), b2 + hstep, voffB);
            PG8_WAIT_V(6); PG8_BAR; PG8_MMA(1, 1, At, B1); PG8_BAR;
            PG8_LDB(B0, 1, 0); PG8_SCHED; PG8_LDA(At, 1, 0); PG8_STAGE(PG8_SA(0, 1), a2 + hstep, voffA);
            PG8_WAIT_L(8); PG8_BAR; PG8_WAIT_L(0); PG8_MMA(0, 0, At, B0); PG8_BAR; PG8_SCHED;
            PG8_LDB(B1, 1, 1); PG8_STAGE(PG8_SB(1, 0), b3, voffB);
            PG8_BAR; PG8_WAIT_L(0); PG8_MMA(0, 1, At, B1); PG8_BAR;
            PG8_LDA(At, 1, 1); PG8_STAGE(PG8_SA(1, 0), a3, voffA);
            PG8_BAR; PG8_WAIT_L(0); PG8_MMA(1, 0, At, B0); PG8_BAR; PG8_SCHED;
            PG8_STAGE(PG8_SB(1, 1), b3 + hstep, voffB);
            PG8_WAIT_V(6); PG8_BAR; PG8_MMA(1, 1, At, B1); PG8_BAR;
            }
        }
        if constexpr (FP8W != 0u) asm volatile("s_nop 15\n\ts_nop 15" ::: "memory");
        if constexpr (ALIGN_EPI) { if (wr == 0) PG8_BAR; }
        if constexpr (!Epi::AFTER_DRAIN) { E(acc, cur, wr, wc, fr, fq); S.done(cur); }
        if (!has_next) break;
#pragma unroll
        for (int a = 0; a < 2; ++a)
#pragma unroll
            for (int b = 0; b < 2; ++b)
#pragma unroll
                for (int m = 0; m < 4; ++m)
#pragma unroll
                    for (int n = 0; n < 2; ++n) acc[a][b][m][n] = (f32x4){0.f, 0.f, 0.f, 0.f};
        cur = nxt; cA = nA; cB = nB; ++ui;
        if constexpr (ALIGN_EPI) { if (wr == 1) PG8_BAR; }
    }
    PG8_WAIT_V(0);
    if constexpr (!ALIGN_EPI) { if (wr == 0) PG8_BAR; }
    PG8_BAR;
    if constexpr (Epi::AFTER_DRAIN) { E.fused(acc, cur, wr, wc, fr, fq, lds, wid, lane); S.done(cur); }
#undef PG8_SA
#undef PG8_SB
#undef PG8_STAGE
#undef PG8_LDA
#undef PG8_CAT
#undef PG8_LDB
#undef PG8_MMA
#undef PG8_WAIT_V
#undef PG8_WAIT_L
#undef PG8_BAR
#undef PG8_SCHED
}
}

constexpr int NWAVES = 8, NTHREADS = 512;
constexpr int BATCH = 2, SEQ = 8192, M = BATCH * SEQ, D = 1024;
constexpr int NEXP = 32, DEXP = 1024;
constexpr int PMAX = M * 4 + NEXP * 256, NTMAX = PMAX / 256;
constexpr float ALPHA = 1.41421356237f;
constexpr int NPHASES = 21;
#ifndef MOE_FP8
#define MOE_FP8 1
#endif
constexpr bool kMoeFp8 = (MOE_FP8 != 0);
constexpr unsigned kScaleGU = 0x79797979u, kScaleDN = 0x78787878u;
#ifndef MK_N_LAUNCHES
#define MK_N_LAUNCHES 1
#endif
constexpr int N_LAUNCHES = MK_N_LAUNCHES;

enum { I_X = 0, I_P, I_AB_WIN, I_AB_QG, I_AB_KVG, I_AB_WUQ, I_AB_WUK, I_AB_WUV, I_AB_WQIDX, I_AB_KIG, I_AB_KIB, I_AB_CONVW, I_AB_ALOG, I_AB_DTB, I_AB_ONG, I_AB_WOUT,
       I_CD_WIN, I_CD_POOLW, I_CD_POOLS, I_CD_WOUT, I_LNM_G, I_LNM_B, I_RW, I_RB, I_WGU, I_BGU, I_WDN, I_BDN, I_PLE_WP, I_PLE_WG, I_LNF_G, I_LNF_B, N_IN };

constexpr size_t MiB = 1u << 20;
constexpr size_t WS_CTL = 0, CTL_ZERO_BYTES = 1 * MiB;
constexpr size_t WS_W_INAB = 1 * MiB;
constexpr size_t WS_W_ABS = 6 * MiB;
constexpr size_t WS_W_OUTAB = 7 * MiB;
constexpr size_t WS_W_INCD = 10 * MiB;
constexpr size_t WS_W_OUTCD = 15 * MiB;
constexpr size_t WS_W_PG = 17 * MiB;
constexpr size_t WS_W_PP = 21 * MiB;
constexpr size_t WS_W_GU = 22 * MiB;
constexpr size_t WS_W_DN = 278 * MiB;
constexpr size_t WS_XB = 406 * MiB;
constexpr size_t WS_PB = 438 * MiB;
constexpr size_t WS_PP = 454 * MiB;
constexpr size_t WS_SM = 518 * MiB;
constexpr size_t WS_QKVZ = 550 * MiB;
constexpr size_t WS_CQ = 630 * MiB;
constexpr size_t WS_CKV = 638 * MiB;
constexpr size_t WS_KIDX = 642 * MiB;
constexpr size_t WS_WIDX = 644 * MiB;
constexpr size_t WS_BETA = 645 * MiB;
constexpr size_t WS_GG = WS_BETA + 512 * 1024;
constexpr size_t WS_QN = 646 * MiB, WS_KN = 662 * MiB, WS_VN = 678 * MiB;
constexpr size_t WS_QL = 694 * MiB;
constexpr size_t WS_CHK = 742 * MiB;
constexpr size_t WS_SEL = 838 * MiB;
constexpr size_t WS_NSEL = 854 * MiB;
constexpr size_t WS_ODELTA = 855 * MiB;
constexpr size_t WS_AO = 887 * MiB;
constexpr size_t WS_PRE = 935 * MiB;
constexpr size_t WS_H1 = 999 * MiB;
constexpr size_t WS_H2 = 1063 * MiB;
constexpr size_t WS_H1B = 1127 * MiB;
constexpr size_t WS_PLE = 1159 * MiB;
constexpr size_t WS_ROUTE = 1191 * MiB;
constexpr size_t WS_BIG = 1193 * MiB;
constexpr size_t WS_XS = WS_BIG, WS_HID = WS_BIG + 144 * MiB, WS_YS = WS_BIG + 288 * MiB;
constexpr size_t WS_END = WS_BIG + 512 * MiB;
static_assert((size_t)PMAX * 1024 * 2 <= 144 * MiB && WS_END <= 2048 * MiB, "d_ws map");
constexpr size_t CHK_WP = 0, CHK_QD = 16384, CHK_KDT = 32768, CHK_QK = 49152, CHK_UT = 57344, CHK_GL = 90112, CHK_STRIDE = 92160;
static_assert(CHK_STRIDE * 1024 <= 96 * MiB, "chunk operands");
constexpr int CW_TMO = 0, CW_CODE = 1;
constexpr int CW_BAR = 4096;
constexpr int CW_BAR2 = 8192;
constexpr int CW_CNT = 16384;

constexpr int RING_OFF = 0, RING_BYTES = 131072;
constexpr int WSCR_OFF = 132096, WSCR_BYTES = 1024;
constexpr int MISC_OFF = 140288;
constexpr int LDS_BYTES = 147456;

#define GAS __attribute__((address_space(1)))
#define LAS __attribute__((address_space(3)))
typedef unsigned short bf16;
typedef unsigned v4u __attribute__((ext_vector_type(4)));
typedef unsigned v2u __attribute__((ext_vector_type(2)));
typedef float f32x4 __attribute__((ext_vector_type(4)));
typedef short bf16x8 __attribute__((ext_vector_type(8)));
typedef GAS unsigned gu32;
#define RLX_AGENT __ATOMIC_RELAXED, __HIP_MEMORY_SCOPE_AGENT
__device__ __forceinline__ unsigned f2bf(float f) { unsigned u = __builtin_bit_cast(unsigned, f); return (u + 0x7fffu + ((u >> 16) & 1u)) >> 16; }
__device__ __forceinline__ unsigned pk2(float lo, float hi) { return f2bf(lo) | (f2bf(hi) << 16); }
__device__ __forceinline__ float bflo(unsigned w) { return __uint_as_float(w << 16); }
__device__ __forceinline__ float bfhi(unsigned w) { return __uint_as_float(w & 0xffff0000u); }
__device__ __forceinline__ float bf1(bf16 h) { return __uint_as_float(((unsigned)h) << 16); }
__device__ __forceinline__ float sigm(float x) { return 1.0f / (1.0f + __expf(-x)); }
__device__ __forceinline__ float siluf(float x) { return x / (1.0f + __expf(-x)); }
__device__ __forceinline__ float wave_sum(float v) {
#pragma unroll
    for (int o = 1; o < 64; o <<= 1) v += __shfl_xor(v, o);
    return v;
}
__device__ __forceinline__ float wave_max(float v) {
#pragma unroll
    for (int o = 1; o < 64; o <<= 1) v = fmaxf(v, __shfl_xor(v, o));
    return v;
}
__device__ __forceinline__ int wave_sum_i(int v) {
#pragma unroll
    for (int o = 1; o < 64; o <<= 1) v += __shfl_xor(v, o);
    return v;
}
__device__ __forceinline__ void unpack8(const v4u w, float (&f)[8]) { f[0] = bflo(w.x); f[1] = bfhi(w.x); f[2] = bflo(w.y); f[3] = bfhi(w.y); f[4] = bflo(w.z); f[5] = bfhi(w.z); f[6] = bflo(w.w); f[7] = bfhi(w.w); }
__device__ __forceinline__ v4u pack8f(const float (&f)[8]) { v4u w; w.x = pk2(f[0], f[1]); w.y = pk2(f[2], f[3]); w.z = pk2(f[4], f[5]); w.w = pk2(f[6], f[7]); return w; }

#define XB_TMO      128
#define XB_XCNT(j)  (256  + 64 * (j))
#define XB_XSUB(j)  (1280 + 64 * (j))
#define XB_XGEN(j)  (2304 + 64 * (j))
#define XB_TOP      3328
#define XB_TOPGEN   3392
#define XCD_BAR_WORDS 3456
#define XB_SPIN_CAP (1u << 18)

__device__ __forceinline__ unsigned xb_ld(unsigned* p)              { return __hip_atomic_load(p, __ATOMIC_RELAXED, __HIP_MEMORY_SCOPE_AGENT); }
__device__ __forceinline__ unsigned xb_add(unsigned* p, unsigned v) { return __hip_atomic_fetch_add(p, v, __ATOMIC_RELAXED, __HIP_MEMORY_SCOPE_AGENT); }
__device__ __forceinline__ unsigned xb_xcc_id() { return (unsigned)__builtin_amdgcn_s_getreg((3 << 11) | 20) & 0xFu; }
#define XB_SPIN(cond, bar) do { unsigned _sp = 0; while (cond) { __builtin_amdgcn_s_sleep(1); \
    if ((++_sp & 255u) == 0u) { if (xb_ld(&(bar)[XB_TMO])) break; if (_sp > XB_SPIN_CAP) { atomicAdd(&(bar)[XB_TMO], 1u); break; } } } } while (0)

struct XcdBarrier {
    unsigned* bar; unsigned x;
    unsigned expect;
    volatile LAS unsigned* st;
};

__device__ __forceinline__ XcdBarrier xcd_barrier_post(unsigned* bar, volatile LAS unsigned* st, unsigned expect = 0u) {
    XcdBarrier b; b.bar = bar; b.x = xb_xcc_id(); b.st = st; b.expect = expect ? expect : gridDim.x * gridDim.y * gridDim.z;
    if (threadIdx.x == 0) (void)xb_add(&bar[XB_XCNT(b.x)], 1u);
    return b;
}
__device__ __forceinline__ void xcd_barrier_complete(unsigned* bar, unsigned x, unsigned& nloc, unsigned& nx, const unsigned G) {
    unsigned sum, cnt, mine, sp = 0u;
    for (;;) {
        sum = 0u; cnt = 0u; mine = 0u;
#pragma unroll
        for (unsigned j = 0; j < 16; ++j) { const unsigned c = xb_ld(&bar[XB_XCNT(j)]); sum += c; cnt += (c > 0u) ? 1u : 0u; mine = (j == x) ? c : mine; }
        if (sum == G) break;
        __builtin_amdgcn_s_sleep(1);
        if ((++sp & 255u) == 0u) { if (xb_ld(&bar[XB_TMO])) break; if (sp > XB_SPIN_CAP) { atomicAdd(&bar[XB_TMO], 1u); break; } }
    }
    nloc = mine > 0u ? mine : 1u; nx = cnt > 0u ? cnt : 1u;
}

__device__ __forceinline__ void xcd_barrier(const XcdBarrier& b) {
    asm volatile("s_waitcnt vmcnt(0)" ::: "memory");
    __syncthreads();
    if (threadIdx.x == 0) {
        unsigned* bar = b.bar;
        __builtin_amdgcn_s_waitcnt(0);
        unsigned nloc = b.st[0], nx = b.st[1];
        if (nloc == 0u) { xcd_barrier_complete(bar, b.x, nloc, nx, b.expect); b.st[0] = nloc; b.st[1] = nx; }
        const unsigned old = xb_add(&bar[XB_XSUB(b.x)], 1u);
        const unsigned gen = old / nloc;
        if (old + 1u == (gen + 1u) * nloc) {
            __builtin_amdgcn_fence(__ATOMIC_RELEASE, "agent");
            asm volatile("s_waitcnt vmcnt(0)" ::: "memory");
            const unsigned og = xb_add(&bar[XB_TOP], 1u);
            const unsigned tg = og / nx;
            if (og + 1u == (tg + 1u) * nx) xb_add(&bar[XB_TOPGEN], 1u);
            else XB_SPIN(xb_ld(&bar[XB_TOPGEN]) == tg, bar);
            __builtin_amdgcn_fence(__ATOMIC_ACQUIRE, "agent");
            xb_add(&bar[XB_XGEN(b.x)], 1u);
            asm volatile("s_waitcnt vmcnt(0)" ::: "memory");
        } else {
            XB_SPIN(xb_ld(&bar[XB_XGEN(b.x)]) == gen, bar);
            __builtin_amdgcn_fence(__ATOMIC_ACQUIRE, "agent");
            asm volatile("s_waitcnt vmcnt(0)" ::: "memory");
        }
    }
    __syncthreads();
}

struct Args { const float* in[N_IN]; float* out; unsigned char* ws; int ph_lo, ph_hi, li, pad; };
typedef const __attribute__((address_space(4))) Args* KArgs;
__device__ __forceinline__ KArgs kargs() { auto p = __builtin_amdgcn_kernarg_segment_ptr(); asm volatile("" : "+s"(p)); return (KArgs)p; }
struct Frame {
    LAS unsigned char* lds;
    int tid, lane, wave, G, bid;
    unsigned char* ws;
    gu32* ctl;
};
#define WSP(T, off) ((T*)(F.ws + (off)))

struct MapId { __device__ __forceinline__ int operator()(int n) const { return n; } };
struct MapAdd { int off; __device__ __forceinline__ int operator()(int n) const { return n + off; } };
struct MapAB { __device__ __forceinline__ int operator()(int n) const { return n < 456 ? n : (n < 2504 ? n + 56 : n - 2048); } };
template <class Map> __device__ __forceinline__ void wg_transpose_item(const float* W, int N, int ldw, bf16* WT, int ldt, int koff, Map map, LAS float* scr, int item, int tid) {
    const int nblk = (N + 127) >> 7, kb = item / nblk, nb = item - kb * nblk, k0 = kb * 128, n0 = nb * 128;
#pragma unroll
    for (int it = 0; it < 8; ++it) {
        const int row = it * 16 + (tid >> 5), c4 = (tid & 31) * 4, n = n0 + c4;
        f32x4 v = (f32x4){0.f, 0.f, 0.f, 0.f};
        if (n + 3 < N) v = *(const f32x4*)(W + (size_t)(k0 + row) * ldw + n);
        LAS float* s = scr + row * 129 + c4; s[0] = v[0]; s[1] = v[1]; s[2] = v[2]; s[3] = v[3];
    }
    __syncthreads();
#pragma unroll
    for (int j = 0; j < 4; ++j) {
        const int idx = j * 512 + tid, nl = idx >> 4, ch = idx & 15, n = n0 + nl;
        if (n < N) { const LAS float* s = scr + (ch * 8) * 129 + nl;
            v4u o; o.x = pk2(s[0], s[129]); o.y = pk2(s[2 * 129], s[3 * 129]); o.z = pk2(s[4 * 129], s[5 * 129]); o.w = pk2(s[6 * 129], s[7 * 129]);
            *(v4u*)(WT + (size_t)map(n) * ldt + koff + k0 + ch * 8) = o; }
    }
    __syncthreads();
}
__device__ __forceinline__ void wg_transpose_item_fp8(const float* W, int N, int ldw, unsigned char* WT, int ldt, float mul, LAS float* scr, int item, int tid) {
    const int nblk = (N + 127) >> 7, kb = item / nblk, nb = item - kb * nblk, k0 = kb * 128, n0 = nb * 128;
#pragma unroll
    for (int it = 0; it < 8; ++it) {
        const int row = it * 16 + (tid >> 5), c4 = (tid & 31) * 4;
        const f32x4 v = *(const f32x4*)(W + (size_t)(k0 + row) * ldw + n0 + c4);
        LAS float* s = scr + row * 129 + c4; s[0] = v[0]; s[1] = v[1]; s[2] = v[2]; s[3] = v[3];
    }
    __syncthreads();
#pragma unroll
    for (int j = 0; j < 2; ++j) {
        const int idx = j * 512 + tid, nl = idx >> 3, ch = idx & 7;
        const LAS float* s = scr + (ch * 16) * 129 + nl;
        v4u o;
#pragma unroll
        for (int q = 0; q < 4; ++q) { unsigned w = 0u;
            w = __builtin_amdgcn_cvt_pk_fp8_f32(s[(4 * q) * 129] * mul, s[(4 * q + 1) * 129] * mul, w, false);
            w = __builtin_amdgcn_cvt_pk_fp8_f32(s[(4 * q + 2) * 129] * mul, s[(4 * q + 3) * 129] * mul, w, true);
            o[q] = w; }
        *(v4u*)(WT + (size_t)(n0 + nl) * ldt + k0 + ch * 16) = o;
    }
    __syncthreads();
}
struct MoeItem { const float* W; unsigned char* WT; int N; float mul; int k0, n0; };
__device__ __forceinline__ MoeItem moe_item(KArgs A, unsigned char* ws, int it) {
    MoeItem d; int sub;
    if (it < 64 * 128) { const int m = it >> 7; sub = it & 127; d.W = A->in[I_WGU] + (size_t)m * 1024 * 2048; d.N = 2048; d.WT = ws + WS_W_GU + (size_t)m * 2048 * 1024; d.mul = 64.0f; }
    else { it -= 64 * 128; const int m = it >> 6; sub = it & 63; d.W = A->in[I_WDN] + (size_t)m * 1024 * 1024; d.N = 1024; d.WT = ws + WS_W_DN + (size_t)m * 1024 * 1024; d.mul = 128.0f; }
    const int nblk = d.N >> 7, kb = sub / nblk, nb = sub - kb * nblk; d.k0 = kb * 128; d.n0 = nb * 128; return d;
}
__device__ __forceinline__ void p0_moe_fp8(Frame& F, KArgs A) {
    LAS float* scr = (LAS float*)(F.lds + RING_OFF);
    const int tid = F.tid; constexpr int NIT = 64 * 128 + 64 * 64;
    int it = F.bid; if (it >= NIT) return;
    MoeItem cur = moe_item(A, F.ws, it);
    f32x4 r[8];
#pragma unroll
    for (int x = 0; x < 8; ++x) r[x] = *(const f32x4*)(cur.W + (size_t)(cur.k0 + x * 16 + (tid >> 5)) * cur.N + cur.n0 + (tid & 31) * 4);
    for (;;) {
#pragma unroll
        for (int x = 0; x < 8; ++x) { LAS float* sp = scr + (x * 16 + (tid >> 5)) * 129 + (tid & 31) * 4; sp[0] = r[x][0]; sp[1] = r[x][1]; sp[2] = r[x][2]; sp[3] = r[x][3]; }
        __syncthreads();
        const int nx = it + F.G; MoeItem nxt = cur;
        if (nx < NIT) { nxt = moe_item(A, F.ws, nx);
#pragma unroll
            for (int x = 0; x < 8; ++x) r[x] = *(const f32x4*)(nxt.W + (size_t)(nxt.k0 + x * 16 + (tid >> 5)) * nxt.N + nxt.n0 + (tid & 31) * 4); }
#pragma unroll
        for (int j = 0; j < 2; ++j) {
            const int idx = j * 512 + tid, nl = idx >> 3, ch = idx & 7;
            const LAS float* sp = scr + (ch * 16) * 129 + nl;
            v4u o;
#pragma unroll
            for (int q = 0; q < 4; ++q) { unsigned w = 0u;
                w = __builtin_amdgcn_cvt_pk_fp8_f32(sp[(4 * q) * 129] * cur.mul, sp[(4 * q + 1) * 129] * cur.mul, w, false);
                w = __builtin_amdgcn_cvt_pk_fp8_f32(sp[(4 * q + 2) * 129] * cur.mul, sp[(4 * q + 3) * 129] * cur.mul, w, true);
                o[q] = w; }
            *(v4u*)(cur.WT + (size_t)(cur.n0 + nl) * 1024 + cur.k0 + ch * 16) = o;
        }
        __syncthreads();
        if (nx >= NIT) break;
        cur = nxt; it = nx;
    }
}
__device__ __forceinline__ void p0_prologue(Frame& F, KArgs A) {
    LAS float* scr = (LAS float*)(F.lds + RING_OFF);
    const int tid = F.tid;
    constexpr int IT_GU = 128, IT_DN = 64;
    constexpr int N_GU = 64 * IT_GU, N_DN = 64 * IT_DN;
    constexpr int N_INAB = 8 * 20, N_INCD = 8 * 20, N_OUTCD = 64, N_PG = 2 * 64, N_PP = 2 * 2 * 8, N_QIDX = 2 * 4, N_OUTB = 4 * 8;
    constexpr int NITEMS = N_GU + N_DN + N_INAB + N_INCD + N_OUTCD + N_PG + N_PP + N_QIDX + N_OUTB;
    if (kMoeFp8) p0_moe_fp8(F, A);
    for (int it = F.bid + (kMoeFp8 ? N_GU + N_DN : 0); it < NITEMS; it += F.G) {
        int r = it;
        if (r < N_GU) { const int m = r / IT_GU;
            if (kMoeFp8) wg_transpose_item_fp8(A->in[I_WGU] + (size_t)m * 1024 * 2048, 2048, 2048, WSP(unsigned char, WS_W_GU) + (size_t)m * 2048 * 1024, 1024, 64.0f, scr, r % IT_GU, tid);
            else wg_transpose_item(A->in[I_WGU] + (size_t)m * 1024 * 2048, 2048, 2048, WSP(bf16, WS_W_GU) + (size_t)m * 2048 * 1024, 1024, 0, MapId{}, scr, r % IT_GU, tid);
            continue; } r -= N_GU;
        if (r < N_DN) { const int m = r / IT_DN;
            if (kMoeFp8) wg_transpose_item_fp8(A->in[I_WDN] + (size_t)m * 1024 * 1024, 1024, 1024, WSP(unsigned char, WS_W_DN) + (size_t)m * 1024 * 1024, 1024, 128.0f, scr, r % IT_DN, tid);
            else wg_transpose_item(A->in[I_WDN] + (size_t)m * 1024 * 1024, 1024, 1024, WSP(bf16, WS_W_DN) + (size_t)m * 1024 * 1024, 1024, 0, MapId{}, scr, r % IT_DN, tid);
            continue; } r -= N_DN;
        if (r < N_INAB) { wg_transpose_item(A->in[I_AB_WIN], 2512, 2512, WSP(bf16, WS_W_INAB), 1024, 0, MapAB{}, scr, r, tid); continue; } r -= N_INAB;
        if (r < N_INCD) { wg_transpose_item(A->in[I_CD_WIN], 2560, 2560, WSP(bf16, WS_W_INCD), 1024, 0, MapId{}, scr, r, tid); continue; } r -= N_INCD;
        if (r < N_OUTCD) { wg_transpose_item(A->in[I_CD_WOUT], 1024, 1024, WSP(bf16, WS_W_OUTCD), 1024, 0, MapId{}, scr, r, tid); continue; } r -= N_OUTCD;
        if (r < N_PG) { const int l = r / 64; wg_transpose_item(A->in[I_PLE_WG] + (size_t)l * 1024 * 1024, 1024, 1024, WSP(bf16, WS_W_PG) + (size_t)l * 1024 * 1024, 1024, 0, MapId{}, scr, r % 64, tid); continue; } r -= N_PG;
        if (r < N_PP) { const int l = r / 16; wg_transpose_item(A->in[I_PLE_WP] + (size_t)l * 256 * 1024, 1024, 1024, WSP(bf16, WS_W_PP) + (size_t)l * 1024 * 256, 256, 0, MapId{}, scr, r % 16, tid); continue; } r -= N_PP;
        if (r < N_QIDX) { wg_transpose_item(A->in[I_AB_WQIDX], 512, 512, WSP(bf16, WS_W_ABS), 256, 0, MapAdd{1024}, scr, r, tid); continue; } r -= N_QIDX;
        wg_transpose_item(A->in[I_AB_WOUT] + (size_t)512 * 1024, 1024, 1024, WSP(bf16, WS_W_OUTAB), 1536, 1024, MapId{}, scr, r, tid);
    }
    const size_t gt = (size_t)F.bid * NTHREADS + tid, GT = (size_t)F.G * NTHREADS;
    for (size_t i = gt; i < (size_t)48 * 1024 / 8; i += GT) *(v4u*)(WSP(bf16, WS_W_INAB) + (size_t)464 * 1024 + i * 8) = (v4u){0u, 0u, 0u, 0u};
    for (size_t i = gt; i < (size_t)1024 * 256; i += GT) {
        const int n = (int)(i >> 8), c = (int)(i & 255), h = n >> 7, r = n & 127;
        const float* a = A->in[I_AB_WUQ] + (size_t)c * 512 + h * 64; const float* b = A->in[I_AB_WUK] + (size_t)r * 512 + h * 64;
        float s = 0.f;
#pragma unroll 8
        for (int d = 0; d < 64; d += 4) { const f32x4 x = *(const f32x4*)(a + d), y = *(const f32x4*)(b + d); s += x[0] * y[0] + x[1] * y[1] + x[2] * y[2] + x[3] * y[3]; }
        WSP(bf16, WS_W_ABS)[i] = (bf16)f2bf(s * 0.125f);
    }
    for (size_t i = gt; i < (size_t)1024 * 1024; i += GT) {
        const int n = (int)(i >> 10), k = (int)(i & 1023), h = k >> 7, r = k & 127;
        const float* a = A->in[I_AB_WUV] + (size_t)r * 512 + h * 64; const float* b = A->in[I_AB_WOUT] + (size_t)(h * 64) * 1024 + n;
        float s = 0.f;
#pragma unroll 8
        for (int v = 0; v < 64; ++v) s += a[v] * b[(size_t)v * 1024];
        WSP(bf16, WS_W_OUTAB)[(size_t)n * 1536 + k] = (bf16)f2bf(s);
    }
    for (size_t i = gt; i < (size_t)M * D / 8; i += GT) { const f32x4 a = *(const f32x4*)(A->in[I_X] + i * 8), b = *(const f32x4*)(A->in[I_X] + i * 8 + 4);
        v4u o; o.x = pk2(a[0], a[1]); o.y = pk2(a[2], a[3]); o.z = pk2(b[0], b[1]); o.w = pk2(b[2], b[3]); *(v4u*)(WSP(bf16, WS_XB) + i * 8) = o; }
    for (size_t i = gt; i < (size_t)2 * M * 256 / 8; i += GT) { const f32x4 a = *(const f32x4*)(A->in[I_P] + i * 8), b = *(const f32x4*)(A->in[I_P] + i * 8 + 4);
        v4u o; o.x = pk2(a[0], a[1]); o.y = pk2(a[2], a[3]); o.z = pk2(b[0], b[1]); o.w = pk2(b[2], b[3]); *(v4u*)(WSP(bf16, WS_PB) + i * 8) = o; }
}

__device__ __forceinline__ void p2_prep(Frame& F, KArgs A) {
    const int lane = F.lane, gw = F.bid * NWAVES + F.wave, NGW = F.G * NWAVES;
    const float* SM = WSP(float, WS_SM); const bf16* QZ = WSP(bf16, WS_QKVZ);
    const f32x4 qg = *(const f32x4*)(A->in[I_AB_QG] + 4 * lane);
    const f32x4 kvg = *(const f32x4*)(A->in[I_AB_KVG] + 4 * (lane & 31));
    const f32x4 kig = *(const f32x4*)(A->in[I_AB_KIG] + 4 * (lane & 15)), kib = *(const f32x4*)(A->in[I_AB_KIB] + 4 * (lane & 15));
    const f32x4 alog = *(const f32x4*)(A->in[I_AB_ALOG]), dtb = *(const f32x4*)(A->in[I_AB_DTB]);
    for (int row = gw; row < M; row += NGW) {
        const int t = row & (SEQ - 1);
        const f32x4 a = *(const f32x4*)(SM + (size_t)row * 512 + 4 * lane), b = *(const f32x4*)(SM + (size_t)row * 512 + 256 + 4 * lane);
        {
            const float ss = wave_sum(a[0] * a[0] + a[1] * a[1] + a[2] * a[2] + a[3] * a[3]);
            const float r = rsqrtf(ss * (1.0f / 256.0f) + 1e-6f);
            v2u o; o.x = pk2(a[0] * r * qg[0], a[1] * r * qg[1]); o.y = pk2(a[2] * r * qg[2], a[3] * r * qg[3]);
            *(v2u*)(WSP(bf16, WS_CQ) + (size_t)row * 256 + 4 * lane) = o;
        }
        {
            const float ss = wave_sum(lane < 32 ? (b[0] * b[0] + b[1] * b[1] + b[2] * b[2] + b[3] * b[3]) : 0.f);
            const float r = rsqrtf(ss * (1.0f / 128.0f) + 1e-6f);
            if (lane < 32) { v2u o; o.x = pk2(b[0] * r * kvg[0], b[1] * r * kvg[1]); o.y = pk2(b[2] * r * kvg[2], b[3] * r * kvg[3]);
                *(v2u*)(WSP(bf16, WS_CKV) + (size_t)row * 128 + 4 * lane) = o; }
        }
        {
            const bool in = (lane >= 32 && lane < 48);
            const float mean = wave_sum(in ? (b[0] + b[1] + b[2] + b[3]) : 0.f) * (1.0f / 64.0f);
            const f32x4 d = b - mean;
            const float var = wave_sum(in ? (d[0] * d[0] + d[1] * d[1] + d[2] * d[2] + d[3] * d[3]) : 0.f) * (1.0f / 64.0f);
            const float r = rsqrtf(var + 1e-5f);
            if (in) { v2u o; o.x = pk2(d[0] * r * kig[0] + kib[0], d[1] * r * kig[1] + kib[1]); o.y = pk2(d[2] * r * kig[2] + kib[2], d[3] * r * kig[3] + kib[3]);
                *(v2u*)(WSP(bf16, WS_KIDX) + (size_t)row * 64 + 4 * (lane - 32)) = o; }
        }
        if (lane == 48 || lane == 49) *(f32x4*)(WSP(float, WS_WIDX) + (size_t)row * 8 + 4 * (lane - 48)) = b * 0.044194173824159216f;
        if (lane == 50) { f32x4 o; o[0] = sigm(b[0]); o[1] = sigm(b[1]); o[2] = sigm(b[2]); o[3] = sigm(b[3]); *(f32x4*)(WSP(float, WS_BETA) + (size_t)row * 4) = o; }
        if (lane == 51) { f32x4 o;
#pragma unroll
            for (int h = 0; h < 4; ++h) { const float xx = b[h] + dtb[h]; const float sp = xx > 20.f ? xx : log1pf(__expf(xx)); o[h] = -__expf(alog[h]) * sp; }
            *(f32x4*)(WSP(float, WS_GG) + (size_t)row * 4) = o; }
#pragma unroll
        for (int sel = 0; sel < 3; ++sel) {
            const int col0 = sel * 512 + 8 * lane;
            float acc[8];
#pragma unroll
            for (int i = 0; i < 8; ++i) acc[i] = 0.f;
#pragma unroll
            for (int j = 0; j < 4; ++j) {
                if (t - 3 + j >= 0) {
                    const v4u xr = *(const v4u*)(QZ + (size_t)(row - 3 + j) * 2048 + col0); float xv[8]; unpack8(xr, xv);
                    const f32x4 w0 = *(const f32x4*)(A->in[I_AB_CONVW] + (size_t)j * 1536 + col0), w1 = *(const f32x4*)(A->in[I_AB_CONVW] + (size_t)j * 1536 + col0 + 4);
#pragma unroll
                    for (int i = 0; i < 4; ++i) { acc[i] += w0[i] * xv[i]; acc[4 + i] += w1[i] * xv[4 + i]; }
                }
            }
            float ss = 0.f;
#pragma unroll
            for (int i = 0; i < 8; ++i) { acc[i] = siluf(acc[i]); ss += acc[i] * acc[i]; }
            if (sel < 2) {
                ss += __shfl_xor(ss, 1); ss += __shfl_xor(ss, 2); ss += __shfl_xor(ss, 4); ss += __shfl_xor(ss, 8);
                const float sc = rsqrtf(ss + 1e-6f) * (sel == 0 ? 0.08838834764831845f : 1.0f);
#pragma unroll
                for (int i = 0; i < 8; ++i) acc[i] *= sc;
            }
            bf16* dst = (sel == 0 ? WSP(bf16, WS_QN) : (sel == 1 ? WSP(bf16, WS_KN) : WSP(bf16, WS_VN))) + (size_t)row * 512 + 8 * lane;
            *(v4u*)dst = pack8f(acc);
        }
    }
}

__device__ __forceinline__ void p3_chunk_prep(Frame& F, KArgs A) {
    int tid = F.tid; asm volatile("" : "+v"(tid));
    const int lane = tid & 63;
    constexpr int P = 132;
    LAS float* qs = (LAS float*)(F.lds); LAS float* ks = qs + 64 * P; LAS float* vs = ks + 64 * P;
    LAS float* As = vs + 64 * P;
    LAS float* gcS = As + 64 * 65; LAS float* egS = gcS + 64; LAS float* ekS = egS + 64; LAS float* btS = ekS + 64;
    LAS float* Ts = qs;
    for (int cidx = F.bid; cidx < 1024; cidx += F.G) {
        const int b = cidx >> 9, h = (cidx >> 7) & 3, n = cidx & 127, row0 = b * SEQ + n * 64;
        unsigned char* blk = F.ws + WS_CHK + (size_t)cidx * CHK_STRIDE;
        if (tid < 64) {
            const float g = WSP(float, WS_GG)[(size_t)(row0 + tid) * 4 + h];
            float gc = g;
#pragma unroll
            for (int o = 1; o < 64; o <<= 1) { const float t = __shfl_up(gc, o); if (lane >= o) gc += t; }
            const float g63 = __shfl(gc, 63);
            gcS[tid] = gc; egS[tid] = __expf(gc); ekS[tid] = __expf(g63 - gc); btS[tid] = WSP(float, WS_BETA)[(size_t)(row0 + tid) * 4 + h];
            if (tid == 0) *(float*)(blk + CHK_GL) = __expf(g63);
        }
#pragma unroll
        for (int i = 0; i < 2; ++i) {
            const int id = tid + 512 * i, r = id >> 4, c8 = (id & 15) * 8; const size_t so = (size_t)(row0 + r) * 512 + h * 128 + c8;
            float f[8];
            unpack8(*(const v4u*)(WSP(bf16, WS_QN) + so), f);
            *(LAS f32x4*)(qs + r * P + c8) = (f32x4){f[0], f[1], f[2], f[3]}; *(LAS f32x4*)(qs + r * P + c8 + 4) = (f32x4){f[4], f[5], f[6], f[7]};
            unpack8(*(const v4u*)(WSP(bf16, WS_KN) + so), f);
            *(LAS f32x4*)(ks + r * P + c8) = (f32x4){f[0], f[1], f[2], f[3]}; *(LAS f32x4*)(ks + r * P + c8 + 4) = (f32x4){f[4], f[5], f[6], f[7]};
            unpack8(*(const v4u*)(WSP(bf16, WS_VN) + so), f);
            *(LAS f32x4*)(vs + r * P + c8) = (f32x4){f[0], f[1], f[2], f[3]}; *(LAS f32x4*)(vs + r * P + c8 + 4) = (f32x4){f[4], f[5], f[6], f[7]};
        }
        __syncthreads();
        {
            const int i = tid >> 3, t7 = tid & 7;
            float aK[8], aQ[8];
#pragma unroll
            for (int x = 0; x < 8; ++x) { aK[x] = 0.f; aQ[x] = 0.f; }
#pragma unroll 1
            for (int d = 0; d < 128; d += 4) {
                const f32x4 ki = *(const LAS f32x4*)(ks + i * P + d), qi = *(const LAS f32x4*)(qs + i * P + d);
#pragma unroll
                for (int x = 0; x < 8; ++x) { const f32x4 kj = *(const LAS f32x4*)(ks + (t7 + 8 * x) * P + d);
                    aK[x] += ki[0] * kj[0] + ki[1] * kj[1] + ki[2] * kj[2] + ki[3] * kj[3]; aQ[x] += qi[0] * kj[0] + qi[1] * kj[1] + qi[2] * kj[2] + qi[3] * kj[3]; }
            }
            const float gci = gcS[i], bti = btS[i];
            bf16* QKp = (bf16*)(blk + CHK_QK) + i * 64;
#pragma unroll
            for (int x = 0; x < 8; ++x) { const int j = t7 + 8 * x; const float dec = __expf(j <= i ? gci - gcS[j] : 0.f);
                As[i * 65 + j] = (j < i) ? bti * aK[x] * dec : 0.f;
                QKp[32 * (j >> 5) + 8 * ((j >> 2) & 3) + 4 * ((j >> 4) & 1) + (j & 3)] = (bf16)f2bf((j <= i) ? aQ[x] * dec : 0.f); }
        }
        {
            const int i = tid >> 3, d0 = (tid & 7) * 16, s = d0 >> 5, a = (d0 >> 4) & 1; const float e = egS[i];
            bf16* Qd = (bf16*)(blk + CHK_QD) + i * 128;
#pragma unroll
            for (int q = 0; q < 4; ++q) { const f32x4 p = *(const LAS f32x4*)(qs + i * P + d0 + 4 * q); v2u w; w.x = pk2(p[0] * e, p[1] * e); w.y = pk2(p[2] * e, p[3] * e); *(v2u*)(Qd + 32 * s + 8 * q + 4 * a) = w; }
        }
        {
            const int d = tid >> 2, c0 = (tid & 3) * 16, s = c0 >> 5, a = (c0 >> 4) & 1;
            bf16* Kd = (bf16*)(blk + CHK_KDT) + d * 64;
#pragma unroll
            for (int q = 0; q < 4; ++q) { const int c = c0 + 4 * q;
                v2u w; w.x = pk2(ks[c * P + d] * ekS[c], ks[(c + 1) * P + d] * ekS[c + 1]); w.y = pk2(ks[(c + 2) * P + d] * ekS[c + 2], ks[(c + 3) * P + d] * ekS[c + 3]);
                *(v2u*)(Kd + 32 * s + 8 * q + 4 * a) = w; }
        }
        __syncthreads();
        {
            const int c = tid >> 3, part = tid & 7;
            for (int i = 0; i < 64; ++i) {
                float acc = 0.f;
                for (int j = part; j < i; j += 8) acc += As[i * 65 + j] * Ts[j * 65 + c];
                acc += __shfl_xor(acc, 1); acc += __shfl_xor(acc, 2); acc += __shfl_xor(acc, 4);
                if (part == 0) Ts[i * 65 + c] = ((i == c) ? 1.f : 0.f) - acc;
                __builtin_amdgcn_fence(__ATOMIC_RELEASE, "wavefront"); asm volatile("s_waitcnt lgkmcnt(0)" ::: "memory");
            }
        }
        __syncthreads();
        {
            const int i = tid >> 3, t7 = tid & 7;
            f32x4 aU[4], aW[4];
#pragma unroll
            for (int xx = 0; xx < 4; ++xx) { aU[xx] = (f32x4){0.f, 0.f, 0.f, 0.f}; aW[xx] = (f32x4){0.f, 0.f, 0.f, 0.f}; }
#pragma unroll 1
            for (int j = 0; j <= i; ++j) {
                const float tb = Ts[i * 65 + j] * btS[j], tbe = tb * egS[j];
#pragma unroll
                for (int xx = 0; xx < 4; ++xx) { aU[xx] += *(const LAS f32x4*)(vs + j * P + 4 * t7 + 32 * xx) * tb; aW[xx] += *(const LAS f32x4*)(ks + j * P + 4 * t7 + 32 * xx) * tbe; }
            }
            float* UT = (float*)(blk + CHK_UT);
            bf16* Wp = (bf16*)(blk + CHK_WP) + i * 128;
#pragma unroll
            for (int xx = 0; xx < 4; ++xx) {
                const int c = 4 * t7 + 32 * xx;
#pragma unroll
                for (int e = 0; e < 4; ++e) UT[(c + e) * 64 + i] = aU[xx][e];
                v2u w; w.x = pk2(aW[xx][0], aW[xx][1]); w.y = pk2(aW[xx][2], aW[xx][3]); *(v2u*)(Wp + 32 * xx + 8 * (t7 & 3) + 4 * (t7 >> 2)) = w;
            }
        }
        __syncthreads();
    }
}

constexpr int SEQ_WGS = 16;
constexpr int SQ_WP = 0, SQ_QD = 16384, SQ_KDT = 32768, SQ_QK = 49152, SQ_BUF = 57344;
__device__ __forceinline__ bf16x8 packfrag(const f32x4 lo, const f32x4 hi) { v4u w; w.x = pg8::cvt_pk_bf16(lo[0], lo[1]); w.y = pg8::cvt_pk_bf16(lo[2], lo[3]); w.z = pg8::cvt_pk_bf16(hi[0], hi[1]); w.w = pg8::cvt_pk_bf16(hi[2], hi[3]); return __builtin_bit_cast(bf16x8, w); }
__device__ __forceinline__ void seq_load(v4u (&r)[14], const unsigned char* blk, int lt) {
#pragma unroll
    for (int i = 0; i < 14; ++i) r[i] = *(const v4u*)(blk + (size_t)(lt + 256 * i) * 16);
}
__device__ __forceinline__ void seq_write(LAS unsigned char* buf, const v4u (&r)[14], int lt) {
#pragma unroll
    for (int i = 0; i < 14; ++i) {
        const int id = lt + 256 * i; int dst;
        if (id < 2048) { const int rr = (id & 1023) >> 4, ch = id & 15; dst = (id & ~1023) * 16 + rr * 256 + 16 * (ch ^ (rr & 15)); }
        else { const int rr = (id - 2048) >> 3, ch = id & 7; dst = 32768 + rr * 128 + 16 * (ch ^ (rr & 7)); }
        *(LAS v4u*)(buf + dst) = r[i];
    }
}
__device__ __forceinline__ void seq_compute(LAS unsigned char* buf, f32x4 (&Sacc)[8], const f32x4 (&U)[4], const float gl, float* op0, const int fr, const int fq) {
    bf16x8 sf[4];
#pragma unroll
    for (int s = 0; s < 4; ++s) sf[s] = packfrag(Sacc[2 * s], Sacc[2 * s + 1]);
    f32x4 Vn[4], Oa[4];
#pragma unroll
    for (int tc = 0; tc < 4; ++tc) {
        const int rr = 16 * tc + fr; f32x4 av = (f32x4){0.f, 0.f, 0.f, 0.f}, ao = (f32x4){0.f, 0.f, 0.f, 0.f};
#pragma unroll
        for (int s = 0; s < 4; ++s) {
            const int off = rr * 256 + 16 * ((4 * s + fq) ^ (rr & 15));
            const bf16x8 wf = *(const LAS bf16x8*)(buf + SQ_WP + off), qf = *(const LAS bf16x8*)(buf + SQ_QD + off);
            av = __builtin_amdgcn_mfma_f32_16x16x32_bf16(wf, sf[s], av, 0, 0, 0);
            ao = __builtin_amdgcn_mfma_f32_16x16x32_bf16(qf, sf[s], ao, 0, 0, 0);
        }
        Vn[tc] = U[tc] - av; Oa[tc] = ao;
    }
    bf16x8 vf[2];
    vf[0] = packfrag(Vn[0], Vn[1]); vf[1] = packfrag(Vn[2], Vn[3]);
#pragma unroll
    for (int tc = 0; tc < 4; ++tc) {
        const int rr = 16 * tc + fr;
#pragma unroll
        for (int s = 0; s < 2; ++s) {
            const bf16x8 kf = *(const LAS bf16x8*)(buf + SQ_QK + rr * 128 + 16 * ((4 * s + fq) ^ (rr & 7)));
            Oa[tc] = __builtin_amdgcn_mfma_f32_16x16x32_bf16(kf, vf[s], Oa[tc], 0, 0, 0);
        }
        float* op = op0 + (size_t)(16 * tc) * 512;
#pragma unroll
        for (int j = 0; j < 4; ++j) op[(size_t)j * 512] = Oa[tc][j];
    }
#pragma unroll
    for (int T = 0; T < 8; ++T) {
        const int rr = 16 * T + fr; f32x4 a = Sacc[T] * gl;
#pragma unroll
        for (int s = 0; s < 2; ++s) {
            const bf16x8 kf = *(const LAS bf16x8*)(buf + SQ_KDT + rr * 128 + 16 * ((4 * s + fq) ^ (rr & 7)));
            a = __builtin_amdgcn_mfma_f32_16x16x32_bf16(kf, vf[s], a, 0, 0, 0);
        }
        Sacc[T] = a;
    }
}
#define SEQ_BAR() do { asm volatile("s_waitcnt lgkmcnt(0)" ::: "memory"); __builtin_amdgcn_s_barrier(); asm volatile("" ::: "memory"); } while (0)
__device__ __forceinline__ void p4_delta_seq(Frame& F, int sid) {
    const int lane = F.lane, wave = F.wave, tid = F.tid;
    const int bh = sid >> 1, half = sid & 1, b = bh >> 2, h = bh & 3;
    const int fr = lane & 15, fq = lane >> 4;
    const int v0 = half * 64 + (wave & 3) * 16;
    const unsigned char* cbase = F.ws + WS_CHK + (size_t)(bh * 128) * CHK_STRIDE;
    if (wave >= 4) {
        const int lt = tid - 256;
        v4u RA[14], RB[14];
#define SEQ_LD(R, blk) do { const unsigned char* _b = (blk); _Pragma("unroll") for (int _i = 0; _i < 14; ++_i) asm volatile("global_load_dwordx4 %0, %1, off" : "=v"(R[_i]) : "v"(_b + (size_t)(lt + 256 * _i) * 16) : "memory"); } while (0)
#define SEQ_WAIT(younger) do { if (younger) asm volatile("s_waitcnt vmcnt(14)" ::: "memory"); else asm volatile("s_waitcnt vmcnt(0)" ::: "memory"); } while (0)
        SEQ_LD(RA, cbase); SEQ_LD(RB, cbase + CHK_STRIDE); SEQ_WAIT(true); seq_write(F.lds, RA, lt); SEQ_LD(RA, cbase + 2 * CHK_STRIDE);
        SEQ_BAR();
#pragma unroll 1
        for (int n = 0; n < 128; n += 2) {
            if (n + 1 < 128) { SEQ_WAIT(n + 2 < 128); seq_write(F.lds + ((n + 1) & 1) * SQ_BUF, RB, lt); } if (n + 3 < 128) SEQ_LD(RB, cbase + (size_t)(n + 3) * CHK_STRIDE);
            SEQ_BAR();
            if (n + 2 < 128) { SEQ_WAIT(n + 3 < 128); seq_write(F.lds + (n & 1) * SQ_BUF, RA, lt); } if (n + 4 < 128) SEQ_LD(RA, cbase + (size_t)(n + 4) * CHK_STRIDE);
            SEQ_BAR();
        }
        asm volatile("s_waitcnt vmcnt(0)" ::: "memory");
#undef SEQ_LD
#undef SEQ_WAIT
    } else {
        float* OD = WSP(float, WS_ODELTA);
        f32x4 Sacc[8], Ucur[4], Unxt[4]; float glc, gln;
#pragma unroll
        for (int T = 0; T < 8; ++T) Sacc[T] = (f32x4){0.f, 0.f, 0.f, 0.f};
#pragma unroll
        for (int tc = 0; tc < 4; ++tc) { Ucur[tc] = *(const f32x4*)((const float*)(cbase + CHK_UT) + (size_t)(v0 + fr) * 64 + 4 * fq + 16 * tc);
                                          Unxt[tc] = *(const f32x4*)((const float*)(cbase + CHK_STRIDE + CHK_UT) + (size_t)(v0 + fr) * 64 + 4 * fq + 16 * tc); }
        glc = *(const float*)(cbase + CHK_GL); gln = *(const float*)(cbase + CHK_STRIDE + CHK_GL);
        SEQ_BAR();
#pragma unroll 1
        for (int n = 0; n < 128; ++n) {
            seq_compute(F.lds + (n & 1) * SQ_BUF, Sacc, Ucur, glc, OD + (size_t)(b * SEQ + n * 64 + 4 * fq) * 512 + h * 128 + v0 + fr, fr, fq);
#pragma unroll
            for (int tc = 0; tc < 4; ++tc) Ucur[tc] = Unxt[tc];
            glc = gln;
            if (n + 2 < 128) { const unsigned char* nb = cbase + (size_t)(n + 2) * CHK_STRIDE; gln = *(const float*)(nb + CHK_GL);
#pragma unroll
                for (int tc = 0; tc < 4; ++tc) Unxt[tc] = *(const f32x4*)((const float*)(nb + CHK_UT) + (size_t)(v0 + fr) * 64 + 4 * fq + 16 * tc); }
            SEQ_BAR();
        }
    }
}
#undef SEQ_BAR

__device__ __forceinline__ void p4_indexer(Frame& F, int widx, int nw) {
    const int lane = F.lane, fr = lane & 15, fq = lane >> 4;
    const bf16* QL = WSP(bf16, WS_QL); const bf16* KI = WSP(bf16, WS_KIDX); const float* WI = WSP(float, WS_WIDX); float* SC = WSP(float, WS_BIG);
    for (int task = widx; task < 2 * 4352; task += nw) {
        const int b = task / 4352; int tau = task - b * 4352;
        int g = 0; while (16 * (g + 1) * (g + 2) <= tau) ++g;
        tau -= 16 * g * (g + 1);
        const int qt = 32 * g + tau / (g + 1), seg = tau % (g + 1);
        const int row0 = b * SEQ + 16 * qt;
        bf16x8 Qf[8][2];
#pragma unroll
        for (int hh = 0; hh < 8; ++hh)
#pragma unroll
            for (int s = 0; s < 2; ++s) Qf[hh][s] = *(const bf16x8*)(QL + (size_t)(row0 + fr) * 1536 + 1024 + hh * 64 + 32 * s + 8 * fq);
        f32x4 wv[4][2];
#pragma unroll
        for (int j = 0; j < 4; ++j) { wv[j][0] = *(const f32x4*)(WI + (size_t)(row0 + 4 * fq + j) * 8); wv[j][1] = *(const f32x4*)(WI + (size_t)(row0 + 4 * fq + j) * 8 + 4); }
        const int kt1 = (32 * seg + 31 < qt) ? 32 * seg + 31 : qt;
        for (int kt = 32 * seg; kt <= kt1; ++kt) {
            const bf16* kp = KI + (size_t)(b * SEQ + 16 * kt + fr) * 64 + 8 * fq;
            const bf16x8 k0 = *(const bf16x8*)kp, k1 = *(const bf16x8*)(kp + 32);
            f32x4 isc = (f32x4){0.f, 0.f, 0.f, 0.f};
#pragma unroll
            for (int hh = 0; hh < 8; ++hh) {
                f32x4 c = __builtin_amdgcn_mfma_f32_16x16x32_bf16(Qf[hh][0], k0, (f32x4){0.f, 0.f, 0.f, 0.f}, 0, 0, 0);
                c = __builtin_amdgcn_mfma_f32_16x16x32_bf16(Qf[hh][1], k1, c, 0, 0, 0);
#pragma unroll
                for (int j = 0; j < 4; ++j) isc[j] += fmaxf(c[j], 0.f) * wv[j][hh >> 2][hh & 3];
            }
            float* sp = SC + (size_t)(row0 + 4 * fq) * 8192 + 16 * kt + fr;
#pragma unroll
            for (int j = 0; j < 4; ++j) sp[(size_t)j * 8192] = isc[j];
        }
    }
}

__device__ __forceinline__ unsigned long long mask_ge(unsigned x, unsigned t) { unsigned long long m; asm("v_cmp_ge_u32_e64 %0, %1, %2" : "=s"(m) : "v"(x), "s"(t)); return m; }
__device__ __forceinline__ void mask_ge8(unsigned long long (&m)[8], unsigned x0, unsigned x1, unsigned x2, unsigned x3, unsigned x4, unsigned x5, unsigned x6, unsigned x7, unsigned t) {
    asm("v_cmp_ge_u32_e64 %0, %8, %16\n\tv_cmp_ge_u32_e64 %1, %9, %16\n\tv_cmp_ge_u32_e64 %2, %10, %16\n\tv_cmp_ge_u32_e64 %3, %11, %16\n\t"
        "v_cmp_ge_u32_e64 %4, %12, %16\n\tv_cmp_ge_u32_e64 %5, %13, %16\n\tv_cmp_ge_u32_e64 %6, %14, %16\n\tv_cmp_ge_u32_e64 %7, %15, %16"
        : "=&s"(m[0]), "=&s"(m[1]), "=&s"(m[2]), "=&s"(m[3]), "=&s"(m[4]), "=&s"(m[5]), "=&s"(m[6]), "=&s"(m[7])
        : "v"(x0), "v"(x1), "v"(x2), "v"(x3), "v"(x4), "v"(x5), "v"(x6), "v"(x7), "s"(t));
}
__device__ __forceinline__ unsigned long long mask_eq(unsigned x, unsigned t) { unsigned long long m; asm("v_cmp_eq_u32_e64 %0, %1, %2" : "=s"(m) : "v"(x), "s"(t)); return m; }
__device__ __forceinline__ unsigned tk_key(float f) { const unsigned b = __float_as_uint(f); return (b & 0x80000000u) ? ~b : (b | 0x80000000u); }
__device__ __forceinline__ void topk_row_slow(const float* sr, const int n, const int lane, LAS int* sel) {
    const int nseg = (n + 63) >> 6;
    unsigned T = 0u;
    for (int bit = 31; bit >= 0; --bit) {
        const unsigned cnd = T | (1u << bit); int c = 0;
        for (int sg = 0; sg < nseg; ++sg) { const int idx = sg * 64 + lane; const unsigned x = (idx < n) ? tk_key(sr[idx < n ? idx : 0]) : 0u; c += __popcll(__ballot(x >= cnd)); }
        if (c >= 256) T = cnd;
    }
    int cgt = 0;
    for (int sg = 0; sg < nseg; ++sg) { const int idx = sg * 64 + lane; const unsigned x = (idx < n) ? tk_key(sr[idx < n ? idx : 0]) : 0u; cgt += __popcll(__ballot(x > T)); }
    const int need_eq = 256 - cgt; int running = 0, eq_taken = 0;
    const unsigned long long lt = (1ull << lane) - 1ull;
    for (int sg = 0; sg < nseg; ++sg) {
        const int idx = sg * 64 + lane; const unsigned x = (idx < n) ? tk_key(sr[idx < n ? idx : 0]) : 0u;
        const bool gt = x > T, eq = x == T;
        const unsigned long long meq = __ballot(eq);
        const bool take = gt || (eq && (eq_taken + __popcll(meq & lt)) < need_eq);
        const unsigned long long mt = __ballot(take);
        if (take) sel[running + __popcll(mt & lt)] = idx;
        running += __popcll(mt); eq_taken += __popcll(meq);
    }
}
constexpr int TK_CAP = 832;
__device__ __forceinline__ int topk_row(Frame& F, const int row, LAS int* sel, LAS unsigned long long* cand) {
    const int lane = F.lane;
    const float* SC = WSP(float, WS_BIG);
    {
        const int pos = row & (SEQ - 1), n = pos + 1;
        if (n <= 256) {
#pragma unroll
            for (int i = 0; i < 4; ++i) { const int j = 64 * i + lane; sel[j] = (j < n) ? j : 0; }
            return n;
        }
        const int nblk = (n + 1023) >> 10;
        const float* sr = SC + (size_t)row * 8192;
        int lane_l = lane; asm volatile("" : "+v"(lane_l));
        unsigned u[128];
#pragma unroll
        for (int i = 0; i < 64; ++i) u[i] = __float_as_uint((sr + (i >> 4) * 1024)[(i & 15) * 64 + lane_l]);
        if (nblk > 4) {
#pragma unroll
            for (int i = 64; i < 128; ++i) u[i] = __float_as_uint((sr + (i >> 4) * 1024)[(i & 15) * 64 + lane_l]);
        } else {
#pragma unroll
            for (int i = 64; i < 128; ++i) u[i] = 0u;
        }
        asm volatile("" ::: "memory");
#pragma unroll
        for (int i = 0; i < 128; ++i) { const int lim = n - i * 64; const unsigned bits = u[i];
            const unsigned x = (bits & 0x80000000u) ? ~bits : (bits | 0x80000000u);
            u[i] = (lane < lim) ? x : 0u; }
        const unsigned long long ltmask_s = (1ull << lane) - 1ull;
        bool done = false;
        {
            int ns = 0;
#pragma unroll
            for (int k = 0; k < 16; ++k) { int v = n - 512 * k; v = v < 0 ? 0 : (v > 64 ? 64 : v); ns += v; }
            const float mean = 256.0f * (float)ns / (float)n;
            const int rs = (int)(mean + 4.0f * sqrtf(mean) + 5.0f);
            unsigned Ts = 0u;
            for (int bit = 31; bit >= 16; --bit) {
                const unsigned cnd = Ts | (1u << bit); unsigned long long m0[8], m1[8];
                mask_ge8(m0, u[0], u[8], u[16], u[24], u[32], u[40], u[48], u[56], cnd); mask_ge8(m1, u[64], u[72], u[80], u[88], u[96], u[104], u[112], u[120], cnd);
                int c = 0;
#pragma unroll
                for (int i = 0; i < 8; ++i) c += __popcll(m0[i]) + __popcll(m1[i]);
                if (c >= rs) Ts = cnd;
            }
            if (Ts == 0u) Ts = 1u;
            int nc = 0;
#pragma unroll
            for (int bk = 0; bk < 8; ++bk) {
                if (bk < nblk) {
#pragma unroll
                    for (int g8 = 0; g8 < 2; ++g8) {
                        unsigned long long mg[8]; const int b0 = bk * 16 + g8 * 8;
                        mask_ge8(mg, u[b0], u[b0 + 1], u[b0 + 2], u[b0 + 3], u[b0 + 4], u[b0 + 5], u[b0 + 6], u[b0 + 7], Ts);
#pragma unroll
                        for (int i = 0; i < 8; ++i) {
                            const unsigned long long mt = mg[i];
                            if (mt != 0ull) {
                                const int off = nc + __popcll(mt & ltmask_s);
                                if (((mt >> lane) & 1ull) && off < TK_CAP) cand[off] = ((unsigned long long)u[b0 + i] << 32) | (unsigned)((b0 + i) * 64 + lane_l);
                                nc += __popcll(mt);
                            }
                        }
                    }
                }
            }
            if (nc >= 256 && nc <= TK_CAP) {
                unsigned ck[16]; int ci[13];
#pragma unroll
                for (int t = 0; t < 13; ++t) { const int j = lane + 64 * t; const unsigned long long e = (j < nc) ? cand[j] : 0ull; ck[t] = (unsigned)(e >> 32); ci[t] = (int)(unsigned)e; }
                ck[13] = 0u; ck[14] = 0u; ck[15] = 0u;
                unsigned T = 0u;
                for (int bit = 31; bit >= 0; --bit) {
                    const unsigned cnd = T | (1u << bit); unsigned long long m0[8], m1[8];
                    mask_ge8(m0, ck[0], ck[1], ck[2], ck[3], ck[4], ck[5], ck[6], ck[7], cnd); mask_ge8(m1, ck[8], ck[9], ck[10], ck[11], ck[12], ck[13], ck[14], ck[15], cnd);
                    int c = 0;
#pragma unroll
                    for (int i = 0; i < 8; ++i) c += __popcll(m0[i]) + __popcll(m1[i]);
                    if (c >= 256) T = cnd;
                }
                unsigned long long g0[8], g1[8], h0[8], h1[8];
                mask_ge8(g0, ck[0], ck[1], ck[2], ck[3], ck[4], ck[5], ck[6], ck[7], T); mask_ge8(g1, ck[8], ck[9], ck[10], ck[11], ck[12], ck[13], ck[14], ck[15], T);
                mask_ge8(h0, ck[0], ck[1], ck[2], ck[3], ck[4], ck[5], ck[6], ck[7], T + 1u); mask_ge8(h1, ck[8], ck[9], ck[10], ck[11], ck[12], ck[13], ck[14], ck[15], T + 1u);
                int cgt = 0;
#pragma unroll
                for (int t = 0; t < 13; ++t) cgt += __popcll(t < 8 ? h0[t & 7] : h1[t & 7]);
                const int need_eq = 256 - cgt;
                int running = 0, eq_taken = 0;
#pragma unroll
                for (int t = 0; t < 13; ++t) {
                    const unsigned long long mge = (t < 8 ? g0[t & 7] : g1[t & 7]), mgt = (t < 8 ? h0[t & 7] : h1[t & 7]);
                    unsigned long long mt = mge; const unsigned long long me = mge & ~mgt;
                    if (me != 0ull) {
                        const int room = need_eq - eq_taken; unsigned long long keep = 0ull, rest = me;
                        for (int k = 0; k < room && rest != 0ull; ++k) { const unsigned long long low = rest & (~rest + 1ull); keep |= low; rest ^= low; }
                        mt = (mge & ~me) | keep; eq_taken += __popcll(me);
                    }
                    if (mt != 0ull) { if ((mt >> lane) & 1ull) sel[running + __popcll(mt & ltmask_s)] = ci[t]; running += __popcll(mt); }
                }
                done = true;
            }
        }
        if (!done) topk_row_slow(sr, n, lane, sel);
    }
    return 256;
}

__device__ __forceinline__ void p6_sparse_attn(Frame& F) {
    const int lane = F.lane, gw = F.bid * NWAVES + F.wave, NGW = F.G * NWAVES;
    LAS float* ql = (LAS float*)(F.lds + F.wave * 12288);
    LAS float* pp = ql + 1024;
    const bf16* QL = WSP(bf16, WS_QL); const bf16* CKV = WSP(bf16, WS_CKV); const int* SEL = WSP(int, WS_SEL); const int* NSEL = WSP(int, WS_NSEL); bf16* AO = WSP(bf16, WS_AO);
    for (int row = gw; row < M; row += NGW) {
        const int b = row >> 13, n = NSEL[row];
        const int* sel = SEL + (size_t)row * 256;
        {
            float f[8];
            unpack8(*(const v4u*)(QL + (size_t)row * 1536 + 8 * lane), f);
#pragma unroll
            for (int x = 0; x < 8; ++x) ql[8 * lane + x] = f[x];
            unpack8(*(const v4u*)(QL + (size_t)row * 1536 + 512 + 8 * lane), f);
#pragma unroll
            for (int x = 0; x < 8; ++x) ql[512 + 8 * lane + x] = f[x];
        }
        float s[4][8];
#pragma unroll
        for (int kb = 0; kb < 4; ++kb) {
            const int j = 64 * kb + lane; const bool valid = j < n; const int key = valid ? sel[j] : 0;
            const bf16* kr = CKV + (size_t)(b * SEQ + key) * 128;
#pragma unroll
            for (int hh = 0; hh < 8; ++hh) s[kb][hh] = 0.f;
#pragma unroll 4
            for (int r8 = 0; r8 < 16; ++r8) {
                float x[8]; unpack8(*(const v4u*)(kr + 8 * r8), x);
#pragma unroll
                for (int hh = 0; hh < 8; ++hh) { const f32x4 q0 = *(const LAS f32x4*)(ql + hh * 128 + 8 * r8), q1 = *(const LAS f32x4*)(ql + hh * 128 + 8 * r8 + 4);
                    s[kb][hh] += x[0] * q0[0] + x[1] * q0[1] + x[2] * q0[2] + x[3] * q0[3] + x[4] * q1[0] + x[5] * q1[1] + x[6] * q1[2] + x[7] * q1[3]; }
            }
            if (!valid) {
#pragma unroll
                for (int hh = 0; hh < 8; ++hh) s[kb][hh] = -INFINITY;
            }
        }
#pragma unroll
        for (int hh = 0; hh < 8; ++hh) {
            const float mx = wave_max(fmaxf(fmaxf(s[0][hh], s[1][hh]), fmaxf(s[2][hh], s[3][hh])));
            float e[4], l = 0.f;
#pragma unroll
            for (int kb = 0; kb < 4; ++kb) { e[kb] = __expf(s[kb][hh] - mx); l += e[kb]; }
            const float inv = 1.0f / wave_sum(l);
#pragma unroll
            for (int kb = 0; kb < 4; ++kb) pp[(64 * kb + lane) * 8 + hh] = e[kb] * inv;
        }
        float o[8][2];
#pragma unroll
        for (int hh = 0; hh < 8; ++hh) { o[hh][0] = 0.f; o[hh][1] = 0.f; }
        for (int j = 0; j < n; ++j) {
            const int key = sel[j];
            const unsigned kv = *(const unsigned*)(CKV + (size_t)(b * SEQ + key) * 128 + 2 * lane);
            const float lo = bflo(kv), hi = bfhi(kv);
            const f32x4 p0 = *(const LAS f32x4*)(pp + j * 8), p1 = *(const LAS f32x4*)(pp + j * 8 + 4);
#pragma unroll
            for (int hh = 0; hh < 4; ++hh) { o[hh][0] += p0[hh] * lo; o[hh][1] += p0[hh] * hi; o[4 + hh][0] += p1[hh] * lo; o[4 + hh][1] += p1[hh] * hi; }
        }
#pragma unroll
        for (int hh = 0; hh < 8; ++hh) *(unsigned*)(AO + (size_t)row * 1536 + hh * 128 + 2 * lane) = pk2(o[hh][0], o[hh][1]);
    }
}
__device__ __forceinline__ void p6_gdn_out(Frame& F, KArgs A) {
    const int lane = F.lane, gw = F.bid * NWAVES + F.wave, NGW = F.G * NWAVES;
    const f32x4 g0 = *(const f32x4*)(A->in[I_AB_ONG] + 8 * (lane & 15)), g1 = *(const f32x4*)(A->in[I_AB_ONG] + 8 * (lane & 15) + 4);
    for (int row = gw; row < M; row += NGW) {
        const float* op = WSP(float, WS_ODELTA) + (size_t)row * 512 + 8 * lane;
        const f32x4 a = *(const f32x4*)op, b = *(const f32x4*)(op + 4);
        float ss = a[0] * a[0] + a[1] * a[1] + a[2] * a[2] + a[3] * a[3] + b[0] * b[0] + b[1] * b[1] + b[2] * b[2] + b[3] * b[3];
        ss += __shfl_xor(ss, 1); ss += __shfl_xor(ss, 2); ss += __shfl_xor(ss, 4); ss += __shfl_xor(ss, 8);
        const float r = rsqrtf(ss * (1.0f / 128.0f) + 1e-6f);
        float z[8]; unpack8(*(const v4u*)(WSP(bf16, WS_QKVZ) + (size_t)row * 2048 + 1536 + 8 * lane), z);
        float o[8];
#pragma unroll
        for (int i = 0; i < 4; ++i) { o[i] = a[i] * r * g0[i] * siluf(z[i]); o[4 + i] = b[i] * r * g1[i] * siluf(z[4 + i]); }
        *(v4u*)(WSP(bf16, WS_AO) + (size_t)row * 1536 + 1024 + 8 * lane) = pack8f(o);
    }
}

__device__ __forceinline__ void p8_ln_router(Frame& F, KArgs A, int l, float* HOUT, bf16* HB) {
    const int lane = F.lane, tid = F.tid, gw = F.bid * NWAVES + F.wave, NGW = F.G * NWAVES;
    LAS float* wT = (LAS float*)(F.lds);
    LAS float* lg = (LAS float*)(F.lds + WSCR_OFF + F.wave * WSCR_BYTES);
    const float* rw = A->in[I_RW] + (size_t)l * 1024 * 32;
    {
        f32x4 wv[16];
#pragma unroll
        for (int j = 0; j < 16; ++j) wv[j] = *(const f32x4*)(rw + (size_t)(tid + NTHREADS * j) * 4);
#pragma unroll
        for (int j = 0; j < 16; ++j) { const int i4 = tid + NTHREADS * j, k = i4 >> 3, e0 = (i4 & 7) * 4;
            wT[(e0 + 0) * 1028 + k] = wv[j][0]; wT[(e0 + 1) * 1028 + k] = wv[j][1]; wT[(e0 + 2) * 1028 + k] = wv[j][2]; wT[(e0 + 3) * 1028 + k] = wv[j][3]; }
    }
    __syncthreads();
    const float* PRE = WSP(float, WS_PRE);
    const float* lg_g = A->in[I_LNM_G] + (size_t)l * 1024; const float* lg_b = A->in[I_LNM_B] + (size_t)l * 1024;
    const float rb = A->in[I_RB][l * 32 + (lane & 31)];
    int* TOKE = WSP(int, WS_ROUTE); int* TOKPOS = TOKE + M * 4; float* TOKG = (float*)(TOKPOS + M * 4);
    gu32* cnt = F.ctl + CW_CNT + 64 * 32 * l;
    LAS int* lcnt = (LAS int*)(F.lds + MISC_OFF + 512);
    LAS int* lbase = lcnt + 32;
    LAS int* myrt = (LAS int*)(F.lds + WSCR_OFF + F.wave * WSCR_BYTES + 128);
    if (tid < 32) lcnt[tid] = 0;
    __syncthreads();
    int nrow = 0;
    for (int row = gw; row < M; row += NGW) {
        f32x4 v[4]; float s = 0.f;
#pragma unroll
        for (int j = 0; j < 4; ++j) { v[j] = *(const f32x4*)(PRE + (size_t)row * 1024 + 256 * j + 4 * lane); s += (v[j][0] + v[j][1]) + (v[j][2] + v[j][3]); }
        const float mean = wave_sum(s) * (1.0f / 1024.0f); float s2 = 0.f;
#pragma unroll
        for (int j = 0; j < 4; ++j) { v[j] = v[j] - mean; s2 += (v[j][0] * v[j][0] + v[j][1] * v[j][1]) + (v[j][2] * v[j][2] + v[j][3] * v[j][3]); }
        const float rstd = rsqrtf(wave_sum(s2) * (1.0f / 1024.0f) + 1e-5f);
#pragma unroll
        for (int j = 0; j < 4; ++j) {
            const f32x4 g = *(const f32x4*)(lg_g + 256 * j + 4 * lane), bb = *(const f32x4*)(lg_b + 256 * j + 4 * lane);
            v[j] = v[j] * rstd * g + bb;
            *(f32x4*)(HOUT + (size_t)row * 1024 + 256 * j + 4 * lane) = v[j];
            v2u o; o.x = pk2(v[j][0], v[j][1]); o.y = pk2(v[j][2], v[j][3]); *(v2u*)(HB + (size_t)row * 1024 + 256 * j + 4 * lane) = o;
        }
        float part[32];
#pragma unroll
        for (int e = 0; e < 32; ++e) {
            float a = 0.f;
#pragma unroll
            for (int j = 0; j < 4; ++j) { const f32x4 w = *(const LAS f32x4*)(wT + e * 1028 + 256 * j + 4 * lane); a += v[j][0] * w[0] + v[j][1] * w[1] + v[j][2] * w[2] + v[j][3] * w[3]; }
            part[e] = a;
        }
#pragma unroll
        for (int i = 0; i < 16; ++i) { const bool up = (lane & 32) != 0; const float keep = up ? part[i + 16] : part[i], send = up ? part[i] : part[i + 16]; part[i] = keep + __shfl_xor(send, 32); }
#pragma unroll
        for (int i = 0; i < 8; ++i) { const bool up = (lane & 16) != 0; const float keep = up ? part[i + 8] : part[i], send = up ? part[i] : part[i + 8]; part[i] = keep + __shfl_xor(send, 16); }
#pragma unroll
        for (int i = 0; i < 4; ++i) { const bool up = (lane & 8) != 0; const float keep = up ? part[i + 4] : part[i], send = up ? part[i] : part[i + 4]; part[i] = keep + __shfl_xor(send, 8); }
#pragma unroll
        for (int i = 0; i < 2; ++i) { const bool up = (lane & 4) != 0; const float keep = up ? part[i + 2] : part[i], send = up ? part[i] : part[i + 2]; part[i] = keep + __shfl_xor(send, 4); }
        { const bool up = (lane & 2) != 0; const float keep = up ? part[1] : part[0], send = up ? part[0] : part[1]; part[0] = keep + __shfl_xor(send, 2); }
        part[0] += __shfl_xor(part[0], 1);
        const int eidx = ((lane >> 5) & 1) * 16 + ((lane >> 4) & 1) * 8 + ((lane >> 3) & 1) * 4 + ((lane >> 2) & 1) * 2 + ((lane >> 1) & 1);
        if ((lane & 1) == 0) lg[eidx] = part[0];
        float val = (lane < 32) ? lg[lane & 31] + rb : -INFINITY;
        float tl[4]; int te[4];
#pragma unroll
        for (int k = 0; k < 4; ++k) {
            const float mx = wave_max(val);
            const unsigned long long mm = __ballot(val == mx && lane < 32);
            const int idx = __ffsll((long long)mm) - 1;
            tl[k] = mx; te[k] = idx;
            if (lane == idx) val = -INFINITY;
        }
        const float e1 = __expf(tl[1] - tl[0]), e2 = __expf(tl[2] - tl[0]), e3 = __expf(tl[3] - tl[0]);
        const float inv = 1.0f / (1.0f + e1 + e2 + e3);
        if (lane < 4) {
            const int e = lane == 0 ? te[0] : (lane == 1 ? te[1] : (lane == 2 ? te[2] : te[3]));
            const float g = (lane == 0 ? 1.0f : (lane == 1 ? e1 : (lane == 2 ? e2 : e3))) * inv;
            const int lp = __hip_atomic_fetch_add(lcnt + e, 1, __ATOMIC_RELAXED, __HIP_MEMORY_SCOPE_WORKGROUP);
            LAS int* rt = myrt + (nrow * 4 + lane) * 3; rt[0] = e; rt[1] = lp; rt[2] = __float_as_int(g);
        }
        ++nrow;
    }
    __syncthreads();
    if (tid < 32) lbase[tid] = (int)__hip_atomic_fetch_add(cnt + 64 * tid, (unsigned)lcnt[tid], RLX_AGENT);
    __syncthreads();
    if (lane < 4) {
        int j = 0;
        for (int row = gw; row < M; row += NGW, ++j) {
            const LAS int* rt = myrt + (j * 4 + lane) * 3; const int e = rt[0];
            TOKE[(size_t)row * 4 + lane] = e; TOKPOS[(size_t)row * 4 + lane] = lbase[e] + rt[1]; TOKG[(size_t)row * 4 + lane] = __int_as_float(rt[2]);
        }
    }
}

__device__ __forceinline__ void p9_scatter(Frame& F, int l, const bf16* HB, const float* HF) {
    const int lane = F.lane, tid = F.tid, gw = F.bid * NWAVES + F.wave, NGW = F.G * NWAVES;
    LAS int* base = (LAS int*)(F.lds + MISC_OFF + 256);
    int* TOKE = WSP(int, WS_ROUTE); int* TOKPOS = TOKE + M * 4; int* TILE = TOKE + 3 * M * 4;
    if (tid < 32) base[tid] = (int)__hip_atomic_load(F.ctl + CW_CNT + 64 * (32 * l + tid), RLX_AGENT);
    __syncthreads();
    if (tid == 0) {
        int acc = 0;
        for (int e = 0; e < NEXP; ++e) { const int c = base[e]; base[e] = acc; acc += ((c + 255) >> 8) << 8; }
        base[32] = acc >> 8;
    }
    __syncthreads();
    if (F.bid == 0 && tid < 64) {
        const int nT = base[32];
        for (int t = tid; t < NTMAX; t += 64) { int e = 0;
            for (int x = 1; x < NEXP; ++x) if (base[x] <= t * 256) e = x;
            TILE[t] = (t < nT) ? e : 0; }
        if (tid == 0) TILE[NTMAX] = nT;
    }
    bf16* XS = WSP(bf16, WS_XS);
    if (kMoeFp8) {
        unsigned char* XB8 = WSP(unsigned char, WS_XS);
        for (int row = gw; row < M; row += NGW) {
            const float* hp = HF + (size_t)row * 1024 + 16 * lane; v4u o;
#pragma unroll
            for (int q = 0; q < 4; ++q) { const f32x4 v = *(const f32x4*)(hp + 4 * q); unsigned w = 0u; w = __builtin_amdgcn_cvt_pk_fp8_f32(v[0], v[1], w, false); w = __builtin_amdgcn_cvt_pk_fp8_f32(v[2], v[3], w, true); o[q] = w; }
#pragma unroll
            for (int k = 0; k < 4; ++k) { const int slot = base[TOKE[(size_t)row * 4 + k]] + TOKPOS[(size_t)row * 4 + k]; *(v4u*)(XB8 + (size_t)slot * 1024 + 16 * lane) = o; }
        }
        return;
    }
    for (int row = gw; row < M; row += NGW) {
        const v4u a = *(const v4u*)(HB + (size_t)row * 1024 + 8 * lane), b = *(const v4u*)(HB + (size_t)row * 1024 + 512 + 8 * lane);
#pragma unroll
        for (int k = 0; k < 4; ++k) {
            const int slot = base[TOKE[(size_t)row * 4 + k]] + TOKPOS[(size_t)row * 4 + k];
            *(v4u*)(XS + (size_t)slot * 1024 + 8 * lane) = a; *(v4u*)(XS + (size_t)slot * 1024 + 512 + 8 * lane) = b;
        }
    }
}

__device__ __forceinline__ void p12_combine(Frame& F, KArgs A, int l, const float* HIN, float* HOUT, bf16* HB) {
    const int lane = F.lane, tid = F.tid, gw = F.bid * NWAVES + F.wave, NGW = F.G * NWAVES;
    LAS int* base = (LAS int*)(F.lds + MISC_OFF + 256);
    if (tid < 32) base[tid] = (int)__hip_atomic_load(F.ctl + CW_CNT + 64 * (32 * l + tid), RLX_AGENT);
    __syncthreads();
    if (tid == 0) { int acc = 0; for (int e = 0; e < NEXP; ++e) { const int c = base[e]; base[e] = acc; acc += ((c + 255) >> 8) << 8; } }
    __syncthreads();
    const int* TOKE = WSP(int, WS_ROUTE); const int* TOKPOS = TOKE + M * 4; const float* TOKG = (const float*)(TOKPOS + M * 4);
    const bf16* YS = WSP(bf16, WS_YS); const bf16* PLE = WSP(bf16, WS_PLE);
    const float* lg_g = A->in[I_LNF_G] + (size_t)l * 1024; const float* lg_b = A->in[I_LNF_B] + (size_t)l * 1024;
    for (int row = gw; row < M; row += NGW) {
        float x[16];
        {   const f32x4 h0 = *(const f32x4*)(HIN + (size_t)row * 1024 + 8 * lane), h1 = *(const f32x4*)(HIN + (size_t)row * 1024 + 8 * lane + 4);
            const f32x4 h2 = *(const f32x4*)(HIN + (size_t)row * 1024 + 512 + 8 * lane), h3 = *(const f32x4*)(HIN + (size_t)row * 1024 + 512 + 8 * lane + 4);
            float p0[8], p1[8]; unpack8(*(const v4u*)(PLE + (size_t)row * 1024 + 8 * lane), p0); unpack8(*(const v4u*)(PLE + (size_t)row * 1024 + 512 + 8 * lane), p1);
#pragma unroll
            for (int i = 0; i < 4; ++i) { x[i] = ALPHA * h0[i] + p0[i]; x[4 + i] = ALPHA * h1[i] + p0[4 + i]; x[8 + i] = ALPHA * h2[i] + p1[i]; x[12 + i] = ALPHA * h3[i] + p1[4 + i]; }
        }
#pragma unroll
        for (int k = 0; k < 4; ++k) {
            const int slot = base[TOKE[(size_t)row * 4 + k]] + TOKPOS[(size_t)row * 4 + k]; const float g = TOKG[(size_t)row * 4 + k];
            float y0[8], y1[8]; unpack8(*(const v4u*)(YS + (size_t)slot * 1024 + 8 * lane), y0); unpack8(*(const v4u*)(YS + (size_t)slot * 1024 + 512 + 8 * lane), y1);
#pragma unroll
            for (int i = 0; i < 8; ++i) { x[i] += g * y0[i]; x[8 + i] += g * y1[i]; }
        }
        float s = 0.f;
#pragma unroll
        for (int i = 0; i < 16; ++i) s += x[i];
        const float mean = wave_sum(s) * (1.0f / 1024.0f); float s2 = 0.f;
#pragma unroll
        for (int i = 0; i < 16; ++i) { x[i] -= mean; s2 += x[i] * x[i]; }
        const float rstd = rsqrtf(wave_sum(s2) * (1.0f / 1024.0f) + 1e-5f);
#pragma unroll
        for (int hf = 0; hf < 2; ++hf) {
            const int c0 = 512 * hf + 8 * lane;
            const f32x4 g0 = *(const f32x4*)(lg_g + c0), g1 = *(const f32x4*)(lg_g + c0 + 4), b0 = *(const f32x4*)(lg_b + c0), b1 = *(const f32x4*)(lg_b + c0 + 4);
            f32x4 o0, o1;
#pragma unroll
            for (int i = 0; i < 4; ++i) { o0[i] = x[8 * hf + i] * rstd * g0[i] + b0[i]; o1[i] = x[8 * hf + 4 + i] * rstd * g1[i] + b1[i]; }
            *(f32x4*)(HOUT + (size_t)row * 1024 + c0) = o0; *(f32x4*)(HOUT + (size_t)row * 1024 + c0 + 4) = o1;
            if (HB) { v4u w; w.x = pk2(o0[0], o0[1]); w.y = pk2(o0[2], o0[3]); w.z = pk2(o1[0], o1[1]); w.w = pk2(o1[2], o1[3]); *(v4u*)(HB + (size_t)row * 1024 + c0) = w; }
        }
    }
}

__device__ __forceinline__ void p14_dilated(Frame& F) {
    const int lane = F.lane, gw = F.bid * NWAVES + F.wave, NGW = F.G * NWAVES;
    LAS float* pe = (LAS float*)(F.lds + F.wave * 2048);
    const bf16* QK = WSP(bf16, WS_QKVZ); bf16* AO = WSP(bf16, WS_AO);
    for (int task = gw; task < M * 12; task += NGW) {
        const int row = task / 12, hh = task - row * 12, b = row >> 13, pos = row & (SEQ - 1);
        float q[64];
#pragma unroll
        for (int c = 0; c < 8; ++c) { float f[8]; unpack8(*(const v4u*)(QK + (size_t)row * 2560 + hh * 64 + 8 * c), f);
#pragma unroll
            for (int x = 0; x < 8; ++x) q[8 * c + x] = f[x]; }
        float s[7];
#pragma unroll
        for (int i = 0; i < 7; ++i) {
            const int e = lane + 64 * i, p = e / 129, m = e - p * 129;
            const int dd = (p == 0) ? 1 : (p == 1 ? 4 : 16);
            const int kpos = pos - m * dd; const bool valid = (e < 387) && (kpos >= 0);
            float a = -INFINITY;
            if (valid) {
                const bf16* kr = QK + (size_t)(b * SEQ + kpos) * 2560 + 768 + hh * 64; a = 0.f;
#pragma unroll
                for (int c = 0; c < 8; ++c) { float f[8]; unpack8(*(const v4u*)(kr + 8 * c), f);
#pragma unroll
                    for (int x = 0; x < 8; ++x) a += q[8 * c + x] * f[x]; }
                a *= 0.125f;
            }
            s[i] = a;
        }
        float mx = s[0];
#pragma unroll
        for (int i = 1; i < 7; ++i) mx = fmaxf(mx, s[i]);
        mx = wave_max(mx);
        float l = 0.f;
#pragma unroll
        for (int i = 0; i < 7; ++i) { const float ev = __expf(s[i] - mx); pe[lane + 64 * i] = ev; l += ev; }
        l = wave_sum(l);
        float o = 0.f;
#pragma unroll
        for (int p = 0; p < 3; ++p) {
            const int dd = (p == 0) ? 1 : (p == 1 ? 4 : 16);
            int mmax = pos / dd; if (mmax > 128) mmax = 128;
            const bf16* vb = QK + (size_t)(b * SEQ + pos) * 2560 + 1536 + hh * 64 + lane;
            for (int m = 0; m <= mmax; ++m) o += pe[p * 129 + m] * bf1(vb[-(ptrdiff_t)m * dd * 2560]);
        }
        AO[(size_t)row * 1024 + hh * 64 + lane] = (bf16)f2bf(o / l);
    }
}
typedef short v4i16_t __attribute__((ext_vector_type(4)));
__device__ __forceinline__ v4i16_t lds_tr16(LAS unsigned char* p) { return __builtin_amdgcn_ds_read_tr16_b64_v4i16((LAS v4i16_t*)p); }
constexpr int DV_PITCH = 144, DV_BUF = 32 * DV_PITCH;
template <int DL  > __device__ __forceinline__ void dil_branch(const bf16* __restrict__ KV, LAS unsigned char* vbuf, const int s0, const int lane,
                                                                                 const bf16x8 (&qf)[2], f32x4 (&O)[4], float& m_run, float& l_run) {
    constexpr int d = 1 << DL, sigma = 16 >> DL, NS = (129 + 15 * sigma + 31) / 32;
    const int fr = lane & 15, fq = lane >> 4;
    const int c = s0 & (d - 1), n0 = s0 >> DL, kstart = n0 - 128;
#define DIL_POS(n) ({ int _p = c + d * (n); _p = _p < 0 ? 0 : (_p > SEQ - 1 ? SEQ - 1 : _p); _p; })
    bf16x8 kf[2][2]; v4u vr[4];
#pragma unroll
    for (int tl = 0; tl < 2; ++tl) { const bf16* kp = KV + (size_t)DIL_POS(kstart + 16 * tl + fr) * 2560 + 768 + 8 * fq; kf[tl][0] = *(const bf16x8*)kp; kf[tl][1] = *(const bf16x8*)(kp + 32); }
#pragma unroll
    for (int i = 0; i < 4; ++i) vr[i] = *(const v4u*)(KV + (size_t)DIL_POS(kstart + (lane >> 3) + 8 * i) * 2560 + 1536 + 8 * (lane & 7));
#pragma unroll 1
    for (int g = 0; g < NS; ++g) {
        LAS unsigned char* vb = vbuf + (g & 1) * DV_BUF;
#pragma unroll
        for (int i = 0; i < 4; ++i) *(LAS v4u*)(vb + ((lane >> 3) + 8 * i) * DV_PITCH + 16 * (lane & 7)) = vr[i];
        bf16x8 kc[2][2];
#pragma unroll
        for (int tl = 0; tl < 2; ++tl) { kc[tl][0] = kf[tl][0]; kc[tl][1] = kf[tl][1]; }
        if (g + 1 < NS) {
            const int kb = kstart + 32 * (g + 1);
#pragma unroll
            for (int tl = 0; tl < 2; ++tl) { const bf16* kp = KV + (size_t)DIL_POS(kb + 16 * tl + fr) * 2560 + 768 + 8 * fq; kf[tl][0] = *(const bf16x8*)kp; kf[tl][1] = *(const bf16x8*)(kp + 32); }
#pragma unroll
            for (int i = 0; i < 4; ++i) vr[i] = *(const v4u*)(KV + (size_t)DIL_POS(kb + (lane >> 3) + 8 * i) * 2560 + 1536 + 8 * (lane & 7));
        }
        float sv[8];
#pragma unroll
        for (int tl = 0; tl < 2; ++tl) {
            f32x4 cc = __builtin_amdgcn_mfma_f32_16x16x32_bf16(kc[tl][0], qf[0], (f32x4){0.f, 0.f, 0.f, 0.f}, 0, 0, 0);
            cc = __builtin_amdgcn_mfma_f32_16x16x32_bf16(kc[tl][1], qf[1], cc, 0, 0, 0);
#pragma unroll
            for (int j = 0; j < 4; ++j) {
                const int rel = 32 * g + 16 * tl + 4 * fq + j;
                const int delta = 128 + sigma * fr - rel;
                const bool ok = (delta >= 0) && (delta <= 128) && (kstart + rel >= 0);
                sv[4 * tl + j] = ok ? cc[j] * 0.125f : -INFINITY;
            }
        }
        float mx = fmaxf(fmaxf(fmaxf(sv[0], sv[1]), fmaxf(sv[2], sv[3])), fmaxf(fmaxf(sv[4], sv[5]), fmaxf(sv[6], sv[7])));
        mx = fmaxf(mx, __shfl_xor(mx, 16)); mx = fmaxf(mx, __shfl_xor(mx, 32));
        const float m_new = fmaxf(m_run, mx);
        if (!__all(m_new == m_run)) {
            const float alpha = __expf(m_run - m_new);
            l_run *= alpha;
#pragma unroll
            for (int j = 0; j < 4; ++j) { const float aj = __shfl(alpha, 4 * fq + j);
#pragma unroll
                for (int dt = 0; dt < 4; ++dt) O[dt][j] *= aj; }
            m_run = m_new;
        }
        float p[8], ps = 0.f;
#pragma unroll
        for (int e = 0; e < 8; ++e) { p[e] = __expf(sv[e] - m_run); ps += p[e]; }
        l_run += ps;
        v4u pw; pw.x = pg8::cvt_pk_bf16(p[0], p[1]); pw.y = pg8::cvt_pk_bf16(p[2], p[3]); pw.z = pg8::cvt_pk_bf16(p[4], p[5]); pw.w = pg8::cvt_pk_bf16(p[6], p[7]);
        const bf16x8 pf = __builtin_bit_cast(bf16x8, pw);
        LAS unsigned char* tb = vb + (4 * fq + ((lane & 15) >> 2)) * DV_PITCH + 8 * (lane & 3);
#pragma unroll
        for (int dt = 0; dt < 4; ++dt) {
            const v4i16_t lo = lds_tr16(tb + 32 * dt), hi = lds_tr16(tb + 16 * DV_PITCH + 32 * dt);
            bf16x8 vf; vf[0] = lo[0]; vf[1] = lo[1]; vf[2] = lo[2]; vf[3] = lo[3]; vf[4] = hi[0]; vf[5] = hi[1]; vf[6] = hi[2]; vf[7] = hi[3];
            O[dt] = __builtin_amdgcn_mfma_f32_16x16x32_bf16(pf, vf, O[dt], 0, 0, 0);
        }
    }
#undef DIL_POS
}
__device__ __forceinline__ void p14_dilated_mfma(Frame& F) {
    const int lane = F.lane, fr = lane & 15, fq = lane >> 4;
    LAS unsigned char* vbuf = F.lds + F.wave * (2 * DV_BUF);
    const bf16* QK = WSP(bf16, WS_QKVZ); bf16* AO = WSP(bf16, WS_AO);
    for (int u = F.bid; u < 24 * 32 * 2; u += F.G) {
        const int bh = u >> 6, blk = (u >> 1) & 31, o = (u & 1) * 8 + F.wave;
        const int b = bh / 12, hh = bh - b * 12, s0 = 256 * blk + o;
        const bf16* KV = QK + (size_t)b * SEQ * 2560 + hh * 64;
        bf16x8 qf[2];
        { const bf16* qp = KV + (size_t)(s0 + 16 * fr) * 2560 + 8 * fq; qf[0] = *(const bf16x8*)qp; qf[1] = *(const bf16x8*)(qp + 32); }
        f32x4 O[4];
#pragma unroll
        for (int dt = 0; dt < 4; ++dt) O[dt] = (f32x4){0.f, 0.f, 0.f, 0.f};
        float m_run = -1e30f, l_run = 0.f;
        dil_branch<4>(KV, vbuf, s0, lane, qf, O, m_run, l_run);
        dil_branch<2>(KV, vbuf, s0, lane, qf, O, m_run, l_run);
        dil_branch<0>(KV, vbuf, s0, lane, qf, O, m_run, l_run);
        float lt = l_run; lt += __shfl_xor(lt, 16); lt += __shfl_xor(lt, 32);
        const float inv = 1.0f / lt;
#pragma unroll
        for (int j = 0; j < 4; ++j) {
            const float ij = __shfl(inv, 4 * fq + j);
            bf16* op = AO + (size_t)(b * SEQ + s0 + 16 * (4 * fq + j)) * 1024 + hh * 64 + fr;
#pragma unroll
            for (int dt = 0; dt < 4; ++dt) op[16 * dt] = (bf16)f2bf(O[dt][j] * ij);
        }
    }
}
constexpr int SA_PITCH = 272, SA_TILE = 32 * SA_PITCH;
__device__ __forceinline__ void sparse_row(Frame& F, const int row, const int n, const LAS int* sel, LAS unsigned char* tile) {
    const int lane = F.lane, fr = lane & 15, fq = lane >> 4;
    const bf16* QL = WSP(bf16, WS_QL); const bf16* CKV = WSP(bf16, WS_CKV); bf16* AO = WSP(bf16, WS_AO);
    {
        const int b = row >> 13;
        const bf16* kvb = CKV + (size_t)b * SEQ * 128;
        bf16x8 qf[4];
#pragma unroll
        for (int s = 0; s < 4; ++s) { const v4u z = (v4u){0u, 0u, 0u, 0u}; qf[s] = (fr < 8) ? *(const bf16x8*)(QL + (size_t)row * 1536 + fr * 128 + 32 * s + 8 * fq) : __builtin_bit_cast(bf16x8, z); }
        f32x4 O[8];
#pragma unroll
        for (int rt = 0; rt < 8; ++rt) O[rt] = (f32x4){0.f, 0.f, 0.f, 0.f};
        float m_run = -1e30f, l_run = 0.f;
        const int nsteps = (n + 31) >> 5;
        v4u vr[8];
        { const int j = lane & 31; const int kidx = (j < n) ? sel[j] : 0;
#pragma unroll
          for (int i = 0; i < 8; ++i) { const int key = __shfl(kidx, (lane >> 4) + 4 * i); vr[i] = *(const v4u*)(kvb + (size_t)key * 128 + 8 * (lane & 15)); } }
#pragma unroll 1
        for (int g = 0; g < nsteps; ++g) {
#pragma unroll
            for (int i = 0; i < 8; ++i) *(LAS v4u*)(tile + ((lane >> 4) + 4 * i) * SA_PITCH + 16 * (lane & 15)) = vr[i];
            if (g + 1 < nsteps) {
                const int j = 32 * (g + 1) + (lane & 31); const int kidx = (j < n) ? sel[j] : 0;
#pragma unroll
                for (int i = 0; i < 8; ++i) { const int key = __shfl(kidx, (lane >> 4) + 4 * i); vr[i] = *(const v4u*)(kvb + (size_t)key * 128 + 8 * (lane & 15)); }
            }
            float sv[8];
#pragma unroll
            for (int tl = 0; tl < 2; ++tl) {
                f32x4 cc = (f32x4){0.f, 0.f, 0.f, 0.f};
#pragma unroll
                for (int s = 0; s < 4; ++s) { const bf16x8 kf = *(const LAS bf16x8*)(tile + (16 * tl + fr) * SA_PITCH + 64 * s + 16 * fq); cc = __builtin_amdgcn_mfma_f32_16x16x32_bf16(kf, qf[s], cc, 0, 0, 0); }
#pragma unroll
                for (int j = 0; j < 4; ++j) sv[4 * tl + j] = (32 * g + 16 * tl + 4 * fq + j < n) ? cc[j] : -INFINITY;
            }
            float mx = fmaxf(fmaxf(fmaxf(sv[0], sv[1]), fmaxf(sv[2], sv[3])), fmaxf(fmaxf(sv[4], sv[5]), fmaxf(sv[6], sv[7])));
            mx = fmaxf(mx, __shfl_xor(mx, 16)); mx = fmaxf(mx, __shfl_xor(mx, 32));
            const float m_new = fmaxf(m_run, mx);
            if (!__all(m_new == m_run)) {
                const float alpha = __expf(m_run - m_new);
                l_run *= alpha;
#pragma unroll
                for (int j = 0; j < 4; ++j) { const float aj = __shfl(alpha, 4 * fq + j);
#pragma unroll
                    for (int rt = 0; rt < 8; ++rt) O[rt][j] *= aj; }
                m_run = m_new;
            }
            float p[8], ps = 0.f;
#pragma unroll
            for (int e = 0; e < 8; ++e) { p[e] = __expf(sv[e] - m_run); ps += p[e]; }
            l_run += ps;
            v4u pw; pw.x = pg8::cvt_pk_bf16(p[0], p[1]); pw.y = pg8::cvt_pk_bf16(p[2], p[3]); pw.z = pg8::cvt_pk_bf16(p[4], p[5]); pw.w = pg8::cvt_pk_bf16(p[6], p[7]);
            const bf16x8 pf = __builtin_bit_cast(bf16x8, pw);
            LAS unsigned char* tb = tile + (4 * fq + ((lane & 15) >> 2)) * SA_PITCH + 8 * (lane & 3);
#pragma unroll
            for (int rt = 0; rt < 8; ++rt) {
                const v4i16_t lo = lds_tr16(tb + 32 * rt), hi = lds_tr16(tb + 16 * SA_PITCH + 32 * rt);
                bf16x8 vf; vf[0] = lo[0]; vf[1] = lo[1]; vf[2] = lo[2]; vf[3] = lo[3]; vf[4] = hi[0]; vf[5] = hi[1]; vf[6] = hi[2]; vf[7] = hi[3];
                O[rt] = __builtin_amdgcn_mfma_f32_16x16x32_bf16(pf, vf, O[rt], 0, 0, 0);
            }
        }
        float lt = l_run; lt += __shfl_xor(lt, 16); lt += __shfl_xor(lt, 32);
        const float inv = 1.0f / lt;
#pragma unroll
        for (int j = 0; j < 4; ++j) {
            const float ij = __shfl(inv, 4 * fq + j);
            if (fq < 2) { bf16* op = AO + (size_t)row * 1536 + (4 * fq + j) * 128 + fr;
#pragma unroll
                for (int rt = 0; rt < 8; ++rt) op[16 * rt] = (bf16)f2bf(O[rt][j] * ij); }
        }
    }
}
__device__ __forceinline__ void p5_topk_attn(Frame& F, const int gw, const int NGW) {
    LAS int* sel = (LAS int*)(F.lds + F.wave * 16384);
    LAS unsigned char* tile = F.lds + F.wave * 16384 + 1024;
    LAS unsigned long long* cand = (LAS unsigned long long*)(F.lds + F.wave * 16384 + 1024 + SA_TILE);
    static_assert(1024 + SA_TILE + TK_CAP * 8 <= 16384, "per-wave LDS");
    for (int rix = gw; rix < M; rix += NGW) {
        const int row = ((rix & 1) ? (M - 1 - (rix >> 1)) : (rix >> 1));
        const int n = __builtin_amdgcn_readfirstlane(topk_row(F, row, sel, cand));
        sparse_row(F, row, n, sel, tile);
    }
}
constexpr int CP_KV_PITCH = 272;
__device__ __forceinline__ void p3_chunk_prep_mfma(Frame& F, KArgs A) {
    int tid = F.tid; asm volatile("" : "+v"(tid));
    const int lane = tid & 63, wave = __builtin_amdgcn_readfirstlane(tid >> 6), fr = lane & 15, fq = lane >> 4;
    LAS unsigned char* kt = F.lds;
    LAS unsigned char* vt = F.lds + 64 * CP_KV_PITCH;
    LAS float* As = (LAS float*)(F.lds + 2 * 64 * CP_KV_PITCH);
    LAS float* Ts = As + 64 * 65;
    LAS float* gcS = Ts + 64 * 68; LAS float* egS = gcS + 64; LAS float* ekS = egS + 64; LAS float* btS = ekS + 64;
    for (int cidx = F.bid; cidx < 1024; cidx += F.G) {
        const int b = cidx >> 9, h = (cidx >> 7) & 3, n = cidx & 127, row0 = b * SEQ + n * 64;
        unsigned char* blk = F.ws + WS_CHK + (size_t)cidx * CHK_STRIDE;
        const bf16* Qg = WSP(bf16, WS_QN) + (size_t)row0 * 512 + h * 128; const bf16* Kg = WSP(bf16, WS_KN) + (size_t)row0 * 512 + h * 128; const bf16* Vg = WSP(bf16, WS_VN) + (size_t)row0 * 512 + h * 128;
        if (tid < 64) {
            const float g = WSP(float, WS_GG)[(size_t)(row0 + tid) * 4 + h];
            float gc = g;
#pragma unroll
            for (int o = 1; o < 64; o <<= 1) { const float t = __shfl_up(gc, o); if (lane >= o) gc += t; }
            const float g63 = __shfl(gc, 63);
            gcS[tid] = gc; egS[tid] = __expf(gc); ekS[tid] = __expf(g63 - gc); btS[tid] = WSP(float, WS_BETA)[(size_t)(row0 + tid) * 4 + h];
            if (tid == 0) *(float*)(blk + CHK_GL) = __expf(g63);
        }
        {
            v4u kc[2], vc[2];
#pragma unroll
            for (int i = 0; i < 2; ++i) { const int id = tid + 512 * i, r = id >> 4, c = id & 15; kc[i] = *(const v4u*)(Kg + (size_t)r * 512 + 8 * c); vc[i] = *(const v4u*)(Vg + (size_t)r * 512 + 8 * c); }
#pragma unroll
            for (int i = 0; i < 2; ++i) { const int id = tid + 512 * i, r = id >> 4, c = id & 15; *(LAS v4u*)(kt + r * CP_KV_PITCH + 16 * c) = kc[i]; *(LAS v4u*)(vt + r * CP_KV_PITCH + 16 * c) = vc[i]; }
        }
        __syncthreads();
        {
            const int ti = wave >> 1;
            bf16x8 ka[4], qa[4];
#pragma unroll
            for (int s = 0; s < 4; ++s) { ka[s] = *(const bf16x8*)(Kg + (size_t)(16 * ti + fr) * 512 + 32 * s + 8 * fq); qa[s] = *(const bf16x8*)(Qg + (size_t)(16 * ti + fr) * 512 + 32 * s + 8 * fq); }
#pragma unroll
            for (int t2 = 0; t2 < 2; ++t2) {
                const int tj = 2 * (wave & 1) + t2;
                f32x4 ck = (f32x4){0.f, 0.f, 0.f, 0.f}, cq = (f32x4){0.f, 0.f, 0.f, 0.f};
#pragma unroll
                for (int s = 0; s < 4; ++s) { const bf16x8 kb = *(const bf16x8*)(Kg + (size_t)(16 * tj + fr) * 512 + 32 * s + 8 * fq);
                    ck = __builtin_amdgcn_mfma_f32_16x16x32_bf16(ka[s], kb, ck, 0, 0, 0); cq = __builtin_amdgcn_mfma_f32_16x16x32_bf16(qa[s], kb, cq, 0, 0, 0); }
                const int j = 16 * tj + fr; const float gcj = gcS[j];
                bf16* QKp = (bf16*)(blk + CHK_QK);
#pragma unroll
                for (int jj = 0; jj < 4; ++jj) { const int i = 16 * ti + 4 * fq + jj; const float dec = __expf(j <= i ? gcS[i] - gcj : 0.f);
                    As[i * 65 + j] = (j < i) ? btS[i] * ck[jj] * dec : 0.f;
                    QKp[i * 64 + 32 * (j >> 5) + 8 * ((j >> 2) & 3) + 4 * ((j >> 4) & 1) + (j & 3)] = (bf16)f2bf((j <= i) ? cq[jj] * dec : 0.f); }
            }
        }
        {
#pragma unroll
            for (int x = 0; x < 2; ++x) { const int id = tid + 512 * x, i = id >> 4, d0 = (id & 15) * 8; const float e = egS[i];
                float f[8]; unpack8(*(const v4u*)(Qg + (size_t)i * 512 + d0), f);
                bf16* Qd = (bf16*)(blk + CHK_QD) + i * 128 + 32 * (d0 >> 5) + 4 * ((d0 >> 4) & 1);
                const int q0 = (d0 >> 2) & 3;
                v2u w0, w1; w0.x = pk2(f[0] * e, f[1] * e); w0.y = pk2(f[2] * e, f[3] * e); w1.x = pk2(f[4] * e, f[5] * e); w1.y = pk2(f[6] * e, f[7] * e);
                *(v2u*)(Qd + 8 * q0) = w0; *(v2u*)(Qd + 8 * (q0 + 1)) = w1; }
        }
        {
            const int d = tid >> 2, c0 = (tid & 3) * 16, s = c0 >> 5, a = (c0 >> 4) & 1;
            bf16* Kd = (bf16*)(blk + CHK_KDT) + d * 64;
#pragma unroll
            for (int q = 0; q < 4; ++q) { const int c = c0 + 4 * q; float kv[4];
#pragma unroll
                for (int e = 0; e < 4; ++e) kv[e] = bf1(*(const LAS bf16*)(kt + (c + e) * CP_KV_PITCH + 2 * d)) * ekS[c + e];
                v2u w; w.x = pk2(kv[0], kv[1]); w.y = pk2(kv[2], kv[3]); *(v2u*)(Kd + 32 * s + 8 * q + 4 * a) = w; }
        }
        __syncthreads();
        {
            const int c = tid >> 3, part = tid & 7;
            for (int i = 0; i < 64; ++i) {
                float acc = 0.f;
                for (int j = part; j < i; j += 8) acc += As[i * 65 + j] * Ts[j * 68 + c];
                acc += __shfl_xor(acc, 1); acc += __shfl_xor(acc, 2); acc += __shfl_xor(acc, 4);
                if (part == 0) Ts[i * 68 + c] = ((i == c) ? 1.f : 0.f) - acc;
                __builtin_amdgcn_fence(__ATOMIC_RELEASE, "wavefront"); asm volatile("s_waitcnt lgkmcnt(0)" ::: "memory");
            }
        }
        __syncthreads();
        {
            bf16x8 vf[2], kf[2];
            LAS unsigned char* vb = vt + (8 * fq + ((lane & 15) >> 2)) * CP_KV_PITCH + 32 * wave + 8 * (lane & 3);
            LAS unsigned char* kb = kt + (8 * fq + ((lane & 15) >> 2)) * CP_KV_PITCH + 32 * wave + 8 * (lane & 3);
#pragma unroll
            for (int s = 0; s < 2; ++s) {
                const v4i16_t v0 = lds_tr16(vb + (32 * s) * CP_KV_PITCH), v1 = lds_tr16(vb + (32 * s + 4) * CP_KV_PITCH), k0 = lds_tr16(kb + (32 * s) * CP_KV_PITCH), k1 = lds_tr16(kb + (32 * s + 4) * CP_KV_PITCH);
                vf[s][0] = v0[0]; vf[s][1] = v0[1]; vf[s][2] = v0[2]; vf[s][3] = v0[3]; vf[s][4] = v1[0]; vf[s][5] = v1[1]; vf[s][6] = v1[2]; vf[s][7] = v1[3];
                kf[s][0] = k0[0]; kf[s][1] = k0[1]; kf[s][2] = k0[2]; kf[s][3] = k0[3]; kf[s][4] = k1[0]; kf[s][5] = k1[1]; kf[s][6] = k1[2]; kf[s][7] = k1[3];
            }
            float* UT = (float*)(blk + CHK_UT);
            bf16* Wp = (bf16*)(blk + CHK_WP);
#pragma unroll
            for (int ti = 0; ti < 4; ++ti) {
                f32x4 cu = (f32x4){0.f, 0.f, 0.f, 0.f}, cw = (f32x4){0.f, 0.f, 0.f, 0.f};
#pragma unroll
                for (int s = 0; s < 2; ++s) {
                    const LAS float* tr = Ts + (16 * ti + fr) * 68 + 32 * s + 8 * fq;
                    const f32x4 t0 = *(const LAS f32x4*)tr, t1 = *(const LAS f32x4*)(tr + 4);
                    const f32x4 b0 = *(const LAS f32x4*)(btS + 32 * s + 8 * fq), b1 = *(const LAS f32x4*)(btS + 32 * s + 8 * fq + 4), e0 = *(const LAS f32x4*)(egS + 32 * s + 8 * fq), e1 = *(const LAS f32x4*)(egS + 32 * s + 8 * fq + 4);
                    const f32x4 u0 = t0 * b0, u1 = t1 * b1, w0 = u0 * e0, w1 = u1 * e1;
                    cu = __builtin_amdgcn_mfma_f32_16x16x32_bf16(packfrag(u0, u1), vf[s], cu, 0, 0, 0);
                    cw = __builtin_amdgcn_mfma_f32_16x16x32_bf16(packfrag(w0, w1), kf[s], cw, 0, 0, 0);
                }
                *(f32x4*)(UT + (size_t)(16 * wave + fr) * 64 + 16 * ti + 4 * fq) = cu;
#pragma unroll
                for (int jj = 0; jj < 4; ++jj) Wp[(16 * ti + 4 * fq + jj) * 128 + 32 * (wave >> 1) + 8 * (fr >> 2) + 4 * (wave & 1) + (fr & 3)] = (bf16)f2bf(cw[jj]);
            }
        }
        __syncthreads();
    }
}
__device__ __forceinline__ void p14_pool(Frame& F, KArgs A) {
    const int lane = F.lane, tid = F.tid, gw = F.bid * NWAVES + F.wave, NGW = F.G * NWAVES;
    LAS float* pw = (LAS float*)(F.lds + 16384);
    LAS float* dl = (LAS float*)(F.lds + 16384 + 65536 + F.wave * 1024);
    {   f32x4 pv[8];
#pragma unroll
        for (int j = 0; j < 8; ++j) pv[j] = *(const f32x4*)(A->in[I_CD_POOLW] + (size_t)(tid + NTHREADS * j) * 4);
#pragma unroll
        for (int j = 0; j < 8; ++j) *(LAS f32x4*)(pw + (tid + NTHREADS * j) * 4) = pv[j];
    }
    __syncthreads();
    const bf16* QK = WSP(bf16, WS_QKVZ); bf16* AO = WSP(bf16, WS_AO);
    const int gi = lane >> 4, w = 2 << gi;
    float sc[4];
#pragma unroll
    for (int g = 0; g < 4; ++g) sc[g] = A->in[I_CD_POOLS][g * 64 + lane];
    for (int row = gw; row < M; row += NGW) {
        const int pos = row & (SEQ - 1);
        const int cntw = (pos + 1 < w) ? pos + 1 : w;
        float sum[4] = {0.f, 0.f, 0.f, 0.f}, cur[4] = {0.f, 0.f, 0.f, 0.f};
        v2u xw[16];
#pragma unroll
        for (int j = 0; j < 16; ++j) xw[j] = *(const v2u*)(QK + (size_t)(row - (j <= pos ? j : pos)) * 2560 + 2304 + 4 * lane);
#pragma unroll
        for (int j = 0; j < 16; ++j) {
            const float f0 = bflo(xw[j].x), f1 = bfhi(xw[j].x), f2 = bflo(xw[j].y), f3 = bfhi(xw[j].y);
            if (j < cntw) { sum[0] += f0; sum[1] += f1; sum[2] += f2; sum[3] += f3; }
            if (j == 0) { cur[0] = f0; cur[1] = f1; cur[2] = f2; cur[3] = f3; }
        }
        const float inv = 1.0f / (float)cntw;
#pragma unroll
        for (int i = 0; i < 4; ++i) dl[4 * lane + i] = sum[i] * inv - cur[i];
        float o[4] = {0.f, 0.f, 0.f, 0.f};
        for (int c = 0; c < 64; ++c) {
#pragma unroll
            for (int g = 0; g < 4; ++g) o[g] += dl[g * 64 + c] * pw[(g * 64 + c) * 64 + lane];
        }
#pragma unroll
        for (int g = 0; g < 4; ++g) AO[(size_t)row * 1024 + 768 + g * 64 + lane] = (bf16)f2bf(o[g] * sc[g]);
    }
}


#define IN(k) (lo <= (k) && (k) < hi)
#define SEAM(k) do { if (IN(k) && IN((k) + 1)) xcd_barrier(bar); } while (0)
template <int l> __device__ __forceinline__ void layer_tail(Frame& F, const XcdBarrier& bar, const int lo, const int hi) {
    LAS unsigned char* ring = F.lds + RING_OFF;
    const int bid = F.bid, G = F.G;
        const int pb = 8 * l;

        if (IN(7 + pb)) {
            pg8::Gemm g{WSP(bf16, WS_AO), (l == 0) ? WSP(bf16, WS_W_OUTAB) : WSP(bf16, WS_W_OUTCD), M, 1024, (l == 0) ? 1536 : 1024}; pg8::StaticOrder S; S.init(M, 1024, G, bid);
            pg8::Epi<pg8::StPre> E{{(l == 0) ? kargs()->in[I_X] : WSP(float, WS_H2), WSP(float, WS_PRE), ALPHA}};
            pg8::gemm_phase<pg8::Epi<pg8::StPre>, pg8::StaticOrder, true, true>(ring, g, S, E);
        } SEAM(7 + pb);
        if (IN(8 + pb)) { p8_ln_router(F, kargs(), l, WSP(float, WS_H1), WSP(bf16, WS_H1B)); } SEAM(8 + pb);
        if (IN(9 + pb)) {
            p9_scatter(F, l, WSP(bf16, WS_H1B), WSP(float, WS_H1));
            __syncthreads();
            pg8::Gemm g{WSP(bf16, WS_H1B), WSP(bf16, WS_W_PG) + (size_t)l * 1024 * 1024, M, 1024, 1024}; pg8::StaticOrder S; S.init(M, 1024, G, bid);
            pg8::Epi<pg8::StPleGate> E{{WSP(bf16, WS_PP) + (size_t)l * M * 1024, WSP(bf16, WS_PLE)}};
            pg8::gemm_phase<pg8::Epi<pg8::StPleGate>, pg8::StaticOrder, true, true>(ring, g, S, E);
        } SEAM(9 + pb);
        const int* TILE = WSP(int, WS_ROUTE) + 3 * M * 4;
        if (IN(10 + pb)) {
            const int nT = __builtin_amdgcn_readfirstlane(TILE[NTMAX]);
            constexpr int EB = kMoeFp8 ? 1 : 2;
            pg8::Gemm g{WSP(bf16, WS_XS), (const bf16*)(F.ws + WS_W_GU + (size_t)l * NEXP * 2048 * 1024 * EB), PMAX, 2048, 1024 * EB / 2};
            pg8::MoeOrder S{TILE, nT, 8, G, bid, (long)2048 * 1024 * EB};
            pg8::Epi<pg8::StSwiglu<kMoeFp8>> E{{kargs()->in[I_BGU] + (size_t)l * NEXP * 2048, WSP(bf16, WS_HID)}};
            pg8::gemm_phase<pg8::Epi<pg8::StSwiglu<kMoeFp8>>, pg8::MoeOrder, true, true, kMoeFp8 ? kScaleGU : 0u>(ring, g, S, E);
        } SEAM(10 + pb);
        if (IN(11 + pb)) {
            const int nT = __builtin_amdgcn_readfirstlane(TILE[NTMAX]);
            constexpr int EB = kMoeFp8 ? 1 : 2;
            pg8::Gemm g{WSP(bf16, WS_HID), (const bf16*)(F.ws + WS_W_DN + (size_t)l * NEXP * 1024 * 1024 * EB), PMAX, 1024, 1024 * EB / 2};
            pg8::MoeOrder S{TILE, nT, 4, G, bid, (long)1024 * 1024 * EB};
            pg8::Epi<pg8::StDown> E{{kargs()->in[I_BDN] + (size_t)l * NEXP * 1024, WSP(bf16, WS_YS)}};
            pg8::gemm_phase<pg8::Epi<pg8::StDown>, pg8::MoeOrder, true, true, kMoeFp8 ? kScaleDN : 0u>(ring, g, S, E);
        } SEAM(11 + pb);
        if (IN(12 + pb)) { p12_combine(F, kargs(), l, WSP(float, WS_H1), (l == 0) ? WSP(float, WS_H2) : kargs()->out, (l == 0) ? WSP(bf16, WS_XB) : (bf16*)nullptr); }
}
#undef IN
#undef SEAM
__global__ void __launch_bounds__(NTHREADS, 2) mk_fwd(Args args_by_value) {
    const KArgs KA = kargs();
    extern __shared__ __attribute__((aligned(16))) unsigned char lds[];
    Frame F;
    F.lds = (LAS unsigned char*)lds;
    F.tid = threadIdx.x; F.lane = F.tid & 63; F.wave = __builtin_amdgcn_readfirstlane(F.tid >> 6);
    F.G = gridDim.x; F.bid = blockIdx.x; F.ws = KA->ws; F.ctl = (gu32*)(KA->ws + WS_CTL);
    volatile LAS unsigned* MISC = (volatile LAS unsigned*)(F.lds + MISC_OFF);
    { int t0 = threadIdx.x; asm volatile("" : "+v"(t0)); for (int u = t0; u < (LDS_BYTES - MISC_OFF) / 4; u += NTHREADS) MISC[u] = 0u; }
    __syncthreads();
    const bool use_bar = (N_LAUNCHES != NPHASES);
    XcdBarrier bar; bar.bar = (unsigned*)(F.ctl + CW_BAR) + KA->li * XCD_BAR_WORDS; bar.x = 0; bar.st = nullptr; bar.expect = 0;
    XcdBarrier bar2 = bar;
    if (use_bar && F.bid >= SEQ_WGS && F.G > SEQ_WGS) bar2 = xcd_barrier_post((unsigned*)(F.ctl + CW_BAR2), MISC + 10, (unsigned)(F.G - SEQ_WGS));
    if (use_bar) bar = xcd_barrier_post((unsigned*)(F.ctl + CW_BAR) + KA->li * XCD_BAR_WORDS, MISC + 8);
    const int lo = KA->ph_lo, hi = KA->ph_hi;
#define IN(k) (lo <= (k) && (k) < hi)
#define SEAM(k) do { if (IN(k) && IN((k) + 1)) xcd_barrier(bar); } while (0)
    LAS unsigned char* ring = F.lds + RING_OFF;
    const int bid = F.bid, G = F.G;

    if (IN(0)) { p0_prologue(F, kargs()); } SEAM(0);

            if (IN(1)) {
                { pg8::Gemm g{WSP(bf16, WS_XB), WSP(bf16, WS_W_INAB), M, 2560, 1024}; pg8::StaticOrder S; S.init(M, 2560, G, bid);
                  pg8::Epi<pg8::StInAB> E{{WSP(float, WS_SM), WSP(bf16, WS_QKVZ)}};
                  pg8::gemm_phase<pg8::Epi<pg8::StInAB>, pg8::StaticOrder, true, true>(ring, g, S, E); }
                __syncthreads();
                { pg8::Gemm g{WSP(bf16, WS_PB), WSP(bf16, WS_W_PP), 2 * M, 1024, 256}; pg8::BatchOrder S{4, (2 * M / 256) * 4, G, bid, M / 256, (long)1024 * 256 * 2};
                  pg8::Epi<pg8::StBf16> E{{WSP(bf16, WS_PP), 1024}};
                  pg8::gemm_phase<pg8::Epi<pg8::StBf16>, pg8::BatchOrder, true, true>(ring, g, S, E); }
            } SEAM(1);
            if (IN(2)) { p2_prep(F, kargs()); } SEAM(2);
            if (IN(3)) {
                p3_chunk_prep_mfma(F, kargs());
                __syncthreads();
                { pg8::Gemm g{WSP(bf16, WS_CQ), WSP(bf16, WS_W_ABS), M, 1536, 256}; pg8::StaticOrder S; S.init(M, 1536, G, bid);
                  pg8::Epi<pg8::StBf16> E{{WSP(bf16, WS_QL), 1536}};
                  pg8::gemm_phase<pg8::Epi<pg8::StBf16>, pg8::StaticOrder, true, true>(ring, g, S, E); }
            } SEAM(3);
            if (IN(4)) {
                if (bid < SEQ_WGS && G > SEQ_WGS) p4_delta_seq(F, bid);
                else { p4_indexer(F, (bid - SEQ_WGS) * NWAVES + F.wave, (G - SEQ_WGS) * NWAVES);
                    if (use_bar) { xcd_barrier(bar2);
                        p5_topk_attn(F, (bid - SEQ_WGS) * NWAVES + F.wave, (G - SEQ_WGS) * NWAVES); } }
            } SEAM(4);
            if (IN(5)) { if (!use_bar) p5_topk_attn(F, bid * NWAVES + F.wave, G * NWAVES); p6_gdn_out(F, kargs()); } SEAM(5);
    layer_tail<0>(F, bar, lo, hi);
    SEAM(12);
            if (IN(13)) {
                pg8::Gemm g{WSP(bf16, WS_XB), WSP(bf16, WS_W_INCD), M, 2560, 1024}; pg8::StaticOrder S; S.init(M, 2560, G, bid);
                pg8::Epi<pg8::StBf16> E{{WSP(bf16, WS_QKVZ), 2560}};
                pg8::gemm_phase<pg8::Epi<pg8::StBf16>, pg8::StaticOrder, true, true>(ring, g, S, E);
            } SEAM(13);
            if (IN(14)) { p14_dilated_mfma(F); __syncthreads(); p14_pool(F, kargs()); } SEAM(14);
    layer_tail<1>(F, bar, lo, hi);
#undef IN
#undef SEAM
}

extern "C" void kernel_launch(void* const* d_in, const int* in_sizes, int n_in, void* d_out, int out_size, void* d_ws, size_t ws_size, hipStream_t stream) {
    static int grid = 0;
    if (grid == 0) {
        if (n_in != N_IN || in_sizes[0] != M * D || out_size != M * D || ws_size < WS_END) {
            fprintf(stderr, "kernel_launch: built for %d inputs, x/out of %d floats, >= %zu bytes of workspace; got n_in %d, in0 %d, out %d, ws %zu; nothing launched\n", N_IN, M * D, (size_t)WS_END, n_in, n_in > 0 ? in_sizes[0] : -1, out_size, ws_size);
            grid = -1; return; }
        int dev = 0, cus = 0, per_cu = 0;
        if (hipGetDevice(&dev) != hipSuccess || hipDeviceGetAttribute(&cus, hipDeviceAttributeMultiprocessorCount, dev) != hipSuccess) { fprintf(stderr, "kernel_launch: device query failed\n"); grid = -1; return; }
        if (hipFuncSetAttribute((const void*)mk_fwd, hipFuncAttributeMaxDynamicSharedMemorySize, LDS_BYTES) != hipSuccess) { fprintf(stderr, "kernel_launch: hipFuncSetAttribute failed\n"); grid = -1; return; }
        if (hipOccupancyMaxActiveBlocksPerMultiprocessor(&per_cu, (const void*)mk_fwd, NTHREADS, LDS_BYTES) != hipSuccess || per_cu < 1)
            fprintf(stderr, "kernel_launch: note: occupancy query reports %d workgroups per CU\n", per_cu);
        (void)hipGetLastError();
        grid = cus;
    }
    if (grid < 0) return;
    if (hipMemsetAsync((char*)d_ws + WS_CTL, 0, CTL_ZERO_BYTES, stream) != hipSuccess) { fprintf(stderr, "kernel_launch: memset failed\n"); return; }
    Args a{};
    for (int i = 0; i < N_IN; ++i) a.in[i] = (const float*)d_in[i];
    a.out = (float*)d_out; a.ws = (unsigned char*)d_ws;
    for (int li = 0; li < N_LAUNCHES; ++li) {
        if (N_LAUNCHES == NPHASES) { a.ph_lo = li; a.ph_hi = li + 1; } else { a.ph_lo = (int)((long)li * NPHASES / N_LAUNCHES); a.ph_hi = (int)((long)(li + 1) * NPHASES / N_LAUNCHES); }
        a.li = li;
        hipLaunchKernelGGL(mk_fwd, dim3(grid), dim3(NTHREADS), LDS_BYTES, stream, a);
        const hipError_t le = hipPeekAtLastError();
        if (le != hipSuccess) { fprintf(stderr, "kernel_launch: launch %d failed: %s\n", li, hipGetErrorName(le)); break; }
    }
}
```

```cpp
#include <hip/hip_runtime.h>
#include <cstdio>
#include <cstdint>

namespace pg8 {
#define PG8_LAS __attribute__((address_space(3)))
typedef unsigned short bf16_t;
typedef short bf16x8 __attribute__((ext_vector_type(8)));
typedef float f32x4 __attribute__((ext_vector_type(4)));
typedef unsigned u32x4 __attribute__((ext_vector_type(4)));
constexpr int BM = 256, BK = 64, HALF = 128, HTB = HALF * BK * 2  , STAGE_BYTES = 8 * HTB, NXCD = 8, WGM = 8;

__host__ __device__ __forceinline__ int lds_byte(int r, int c) { const int st = (r >> 4) * 2 + (c >> 5), rr = r & 15, cc = c & 31, ob = rr * 64 + cc * 2; return st * 1024 + (ob ^ (((ob >> 9) & 1) << 5)); }
__host__ __device__ __forceinline__ void stage_rc(int b, int& R, int& C) { const int st = b / 1024, sb = b % 1024, swz = sb ^ (((sb >> 9) & 1) << 5); R = (st >> 1) * 16 + swz / 64; C = (st & 1) * 32 + (swz % 64) / 2; }
__host__ __device__ __forceinline__ int perm32(int rho) { const int n = rho >> 4, i = rho & 15; return 8 * (i >> 2) + 4 * n + (i & 3); }

struct Unit { int pm, pn, e; long bofs; };
struct Gemm { const bf16_t* A; const bf16_t* Bt; int M, N, K; };

struct StaticOrder {
    int nM, nN, nwg, G, c;
    __host__ __device__ void init(int M, int N, int G_, int c_) { nM = M / BM; nN = N / BM; nwg = nM * nN; G = G_; c = c_; }
    __host__ __device__ bool next(int i, Unit& u) const {
        const long L = (long)i * G + c; if (L >= nwg) return false;
        int wgid = (int)L; { const int q = nwg / NXCD, r = nwg % NXCD, xcd = wgid % NXCD, off = wgid / NXCD; wgid = (xcd < r ? xcd * (q + 1) : r * (q + 1) + (xcd - r) * q) + off; }
        const int nig = WGM * nN, gid = wgid / nig, fm = gid * WGM, gsz = (nM - fm) < WGM ? (nM - fm) : WGM;
        u.pm = fm + ((wgid % nig) % gsz); u.pn = (wgid % nig) / gsz; u.e = 0; u.bofs = 0; return true;
    }
    __device__ __forceinline__ void a_ready(const Unit&) const {}
    __device__ __forceinline__ void done(const Unit&) const {}
};
struct MoeOrder {
    const int* tile_e; int nT, nN, G, c; long estride;
    __device__ __forceinline__ bool next(int i, Unit& u) const {
        if (G % (8 * nN) == 0) {
            const int rpx = G / (8 * nN), xcd = c & 7, idx = c >> 3;
            u.pm = (i * 8 + xcd) * rpx + idx % rpx; u.pn = idx / rpx;
            if (u.pm >= nT) return false;
        } else {
            const long L = (long)i * G + c; if (L >= (long)nT * nN) return false;
            u.pm = (int)(L / nN); u.pn = (int)(L % nN);
        }
        const int e = tile_e[u.pm]; u.e = e; u.bofs = (long)e * estride; return true;
    }
    __device__ __forceinline__ void a_ready(const Unit&) const {}
    __device__ __forceinline__ void done(const Unit&) const {}
};

struct BatchOrder {
    int nN, nwg, G, c, tiles_per_batch; long bstride;
    __device__ __forceinline__ bool next(int i, Unit& u) const {
        const long L = (long)i * G + c; if (L >= nwg) return false;
        u.pm = (int)(L / nN); u.pn = (int)(L % nN); const int e = u.pm / tiles_per_batch; u.e = e; u.bofs = (long)e * bstride; return true;
    }
    __device__ __forceinline__ void a_ready(const Unit&) const {}
    __device__ __forceinline__ void done(const Unit&) const {}
};

__device__ __forceinline__ unsigned cvt_pk_bf16(float lo, float hi) { unsigned r; asm volatile("v_cvt_pk_bf16_f32 %0, %1, %2" : "=v"(r) : "v"(lo), "v"(hi)); return r; }
__device__ __forceinline__ u32x4 pack8(const f32x4 v0, const f32x4 v1) { u32x4 w; w.x = cvt_pk_bf16(v0[0], v0[1]); w.y = cvt_pk_bf16(v0[2], v0[3]); w.z = cvt_pk_bf16(v1[0], v1[1]); w.w = cvt_pk_bf16(v1[2], v1[3]); return w; }
__device__ __forceinline__ float bf_lo(unsigned w) { return __uint_as_float(w << 16); }
__device__ __forceinline__ float bf_hi(unsigned w) { return __uint_as_float(w & 0xffff0000u); }
__device__ __forceinline__ float sigmoidf_(float x) { return 1.0f / (1.0f + __expf(-x)); }
typedef unsigned u32x2 __attribute__((ext_vector_type(2)));

template <class T> struct Epi {
    static constexpr bool PERM = true, AFTER_DRAIN = false;
    T t;
    __device__ __forceinline__ void operator()(const f32x4 (&acc)[2][2][4][2], const Unit& u, int wr, int wc, int fr, int fq) const {
        const int row0 = u.pm * BM + wr * 64 + fr, col0 = u.pn * BM + wc * 32 + 8 * fq;
        f32x4 cb[2][2];
#pragma unroll
        for (int bj = 0; bj < 2; ++bj) t.colctx(col0 + bj * HALF, u, cb[bj][0], cb[bj][1]);
        f32x4 rc[2][2], rn[2][2];
#pragma unroll
        for (int bj = 0; bj < 2; ++bj) t.rowctx(row0, col0 + bj * HALF, rc[bj][0], rc[bj][1]);
#pragma unroll
        for (int g = 0; g < 8; ++g) {
            const int ai = g >> 2, m = g & 3, row = row0 + ai * HALF + m * 16;
            if (g < 7) { const int nrow = row0 + ((g + 1) >> 2) * HALF + ((g + 1) & 3) * 16;
#pragma unroll
                for (int bj = 0; bj < 2; ++bj) t.rowctx(nrow, col0 + bj * HALF, rn[bj][0], rn[bj][1]); }
#pragma unroll
            for (int bj = 0; bj < 2; ++bj) t.store(row, col0 + bj * HALF, acc[ai][bj][m][0] + cb[bj][0], acc[ai][bj][m][1] + cb[bj][1], u, rc[bj][0], rc[bj][1]);
            asm volatile("" ::: "memory");
#pragma unroll
            for (int bj = 0; bj < 2; ++bj) { rc[bj][0] = rn[bj][0]; rc[bj][1] = rn[bj][1]; }
        }
    }
};
struct StBf16 { bf16_t* O; int ld;
    __device__ __forceinline__ void rowctx(int, int, f32x4& r0, f32x4& r1) const { r0 = (f32x4){0.f, 0.f, 0.f, 0.f}; r1 = r0; }
    __device__ __forceinline__ void colctx(int, const Unit&, f32x4& c0, f32x4& c1) const { c0 = (f32x4){0.f, 0.f, 0.f, 0.f}; c1 = c0; }
    __device__ __forceinline__ void store(int row, int col, f32x4 v0, f32x4 v1, const Unit&, f32x4, f32x4) const { *(u32x4*)(O + (size_t)row * ld + col) = pack8(v0, v1); } };
struct StInAB { float* SM; bf16_t* Q;
    __device__ __forceinline__ void rowctx(int, int, f32x4& r0, f32x4& r1) const { r0 = (f32x4){0.f, 0.f, 0.f, 0.f}; r1 = r0; }
    __device__ __forceinline__ void colctx(int, const Unit&, f32x4& c0, f32x4& c1) const { c0 = (f32x4){0.f, 0.f, 0.f, 0.f}; c1 = c0; }
    __device__ __forceinline__ void store(int row, int col, f32x4 v0, f32x4 v1, const Unit&, f32x4, f32x4) const {
        if (col < 512) { float* p = SM + (size_t)row * 512 + col; *(f32x4*)p = v0; *(f32x4*)(p + 4) = v1; }
        else *(u32x4*)(Q + (size_t)row * 2048 + (col - 512)) = pack8(v0, v1); } };
struct StPre { const float* base; float* P; float alpha;
    __device__ __forceinline__ void colctx(int, const Unit&, f32x4& c0, f32x4& c1) const { c0 = (f32x4){0.f, 0.f, 0.f, 0.f}; c1 = c0; }
    __device__ __forceinline__ void rowctx(int row, int col, f32x4& r0, f32x4& r1) const { const size_t o = (size_t)row * 1024 + col; r0 = *(const f32x4*)(base + o); r1 = *(const f32x4*)(base + o + 4); }
    __device__ __forceinline__ void store(int row, int col, f32x4 v0, f32x4 v1, const Unit&, f32x4 b0, f32x4 b1) const {
        const size_t o = (size_t)row * 1024 + col;
        *(f32x4*)(P + o) = b0 * alpha + v0; *(f32x4*)(P + o + 4) = b1 * alpha + v1; } };
struct StPleGate { const bf16_t* PP; bf16_t* O;
    __device__ __forceinline__ void colctx(int, const Unit&, f32x4& c0, f32x4& c1) const { c0 = (f32x4){0.f, 0.f, 0.f, 0.f}; c1 = c0; }
    __device__ __forceinline__ void rowctx(int row, int col, f32x4& r0, f32x4& r1) const { r0 = *(const f32x4*)(PP + (size_t)row * 1024 + col); r1 = r0; }
    __device__ __forceinline__ void store(int row, int col, f32x4 v0, f32x4 v1, const Unit&, f32x4 pr, f32x4) const {
        const size_t o = (size_t)row * 1024 + col; const u32x4 p = __builtin_bit_cast(u32x4, pr);
        f32x4 r0, r1;
        r0[0] = sigmoidf_(v0[0]) * bf_lo(p.x); r0[1] = sigmoidf_(v0[1]) * bf_hi(p.x); r0[2] = sigmoidf_(v0[2]) * bf_lo(p.y); r0[3] = sigmoidf_(v0[3]) * bf_hi(p.y);
        r1[0] = sigmoidf_(v1[0]) * bf_lo(p.z); r1[1] = sigmoidf_(v1[1]) * bf_hi(p.z); r1[2] = sigmoidf_(v1[2]) * bf_lo(p.w); r1[3] = sigmoidf_(v1[3]) * bf_hi(p.w);
        *(u32x4*)(O + o) = pack8(r0, r1); } };
template <bool F8> struct StSwiglu { const float* bgu; bf16_t* H;
    __device__ __forceinline__ void rowctx(int, int, f32x4& r0, f32x4& r1) const { r0 = (f32x4){0.f, 0.f, 0.f, 0.f}; r1 = r0; }
    __device__ __forceinline__ float act(float g, float u) const { const float gt = fminf(g, 7.0f), up = fminf(fmaxf(u, -7.0f), 7.0f); return (up + 1.0f) * (gt * sigmoidf_(gt * 1.702f)); }
    __device__ __forceinline__ void colctx(int col, const Unit& u, f32x4& c0, f32x4& c1) const { const float* b = bgu + (size_t)u.e * 2048 + col; c0 = *(const f32x4*)b; c1 = *(const f32x4*)(b + 4); }
    __device__ __forceinline__ void store(int row, int col, f32x4 v0, f32x4 v1, const Unit& u, f32x4, f32x4) const {
        if (F8) { unsigned w = 0u; w = __builtin_amdgcn_cvt_pk_fp8_f32(act(v0[0], v0[1]), act(v0[2], v0[3]), w, false); w = __builtin_amdgcn_cvt_pk_fp8_f32(act(v1[0], v1[1]), act(v1[2], v1[3]), w, true);
            *(unsigned*)((unsigned char*)H + (size_t)row * 1024 + (col >> 1)) = w; }
        else { u32x2 w; w.x = cvt_pk_bf16(act(v0[0], v0[1]), act(v0[2], v0[3])); w.y = cvt_pk_bf16(act(v1[0], v1[1]), act(v1[2], v1[3]));
            *(u32x2*)(H + (size_t)row * 1024 + (col >> 1)) = w; } } };
struct StDown { const float* bd; bf16_t* Y;
    __device__ __forceinline__ void rowctx(int, int, f32x4& r0, f32x4& r1) const { r0 = (f32x4){0.f, 0.f, 0.f, 0.f}; r1 = r0; }
    __device__ __forceinline__ void colctx(int col, const Unit& u, f32x4& c0, f32x4& c1) const { const float* b = bd + (size_t)u.e * 1024 + col; c0 = *(const f32x4*)b; c1 = *(const f32x4*)(b + 4); }
    __device__ __forceinline__ void store(int row, int col, f32x4 v0, f32x4 v1, const Unit& u, f32x4, f32x4) const {
        *(u32x4*)(Y + (size_t)row * 1024 + col) = pack8(v0, v1); } };

typedef int i32x8 __attribute__((ext_vector_type(8)));
typedef int i32x4 __attribute__((ext_vector_type(4)));
template <class Epi, class Sched, bool ALIGN_EPI = false, bool SP2 = false, unsigned FP8W = 0u>
__device__ __forceinline__ void gemm_phase(PG8_LAS unsigned char* lds, const Gemm g, const Sched& S, const Epi& E) {
    int tid = threadIdx.x; asm volatile("" : "+v"(tid));
    const int wid = __builtin_amdgcn_readfirstlane(tid >> 6), lane = tid & 63, wr = wid >> 2, wc = wid & 3, fr = lane & 15, fq = lane >> 4;
    int K = g.K; asm volatile("" : "+s"(K));
    const int nt = K / BK;
    unsigned voffA[2], voffB[2];
#pragma unroll
    for (int i = 0; i < 2; ++i) { int R, C; stage_rc(tid * 16 + i * 8192, R, C); const int Rb = Epi::PERM ? ((R & ~31) + perm32(R & 31)) : R;
        voffA[i] = (unsigned)(R * K + C) * 2u; voffB[i] = (unsigned)(Rb * K + C) * 2u; }
    const size_t kstep = (size_t)(BK * 2);
    const size_t hstep = (size_t)HALF * K * 2;
    const size_t tstep = 2 * hstep;
    const unsigned ldsw = (unsigned)wid * 1024u;
    const int aoff = lds_byte(wr * 64 + fr, fq * 8), boff = lds_byte(wc * 32 + fr, fq * 8);
#define PG8_SA(b, h) (((b) * 2 + (h)) * HTB)
#define PG8_SB(b, h) ((4 + (b) * 2 + (h)) * HTB)
#define PG8_STAGE(bufoff, gbase, voff) do { _Pragma("unroll") for (int _i = 0; _i < 2; ++_i) \
        __builtin_amdgcn_global_load_lds((const unsigned*)((const char*)(gbase) + (voff)[_i]), (PG8_LAS unsigned*)(lds + (bufoff) + ldsw + _i * 8192), 16, 0, 0); } while (0)
#define PG8_CAT(lo, hi) __builtin_shufflevector((lo), (hi), 0, 1, 2, 3, 4, 5, 6, 7)
#define PG8_LDA(dst, b, h) do { if constexpr (FP8W != 0u) { _Pragma("unroll") for (int m = 0; m < 4; ++m) dst##8[m] = PG8_CAT(*(const PG8_LAS i32x4*)(lds + PG8_SA(b, h) + aoff + m * 2048), *(const PG8_LAS i32x4*)(lds + PG8_SA(b, h) + aoff + m * 2048 + 1024)); } \
        else { _Pragma("unroll") for (int m = 0; m < 4; ++m) _Pragma("unroll") for (int k = 0; k < 2; ++k) dst[m][k] = *(const PG8_LAS bf16x8*)(lds + PG8_SA(b, h) + aoff + m * 2048 + k * 1024); } } while (0)
#define PG8_LDB(dst, b, h) do { if constexpr (FP8W != 0u) { _Pragma("unroll") for (int n = 0; n < 2; ++n) dst##8[n] = PG8_CAT(*(const PG8_LAS i32x4*)(lds + PG8_SB(b, h) + boff + n * 2048), *(const PG8_LAS i32x4*)(lds + PG8_SB(b, h) + boff + n * 2048 + 1024)); } \
        else { _Pragma("unroll") for (int n = 0; n < 2; ++n) _Pragma("unroll") for (int k = 0; k < 2; ++k) dst[n][k] = *(const PG8_LAS bf16x8*)(lds + PG8_SB(b, h) + boff + n * 2048 + k * 1024); } } while (0)
#define PG8_MMA(ai, bj, At, Bt) do { __builtin_amdgcn_s_setprio(1); _Pragma("unroll") for (int m = 0; m < 4; ++m) _Pragma("unroll") for (int n = 0; n < 2; ++n) { \
        if constexpr (FP8W != 0u) asm volatile("v_mfma_scale_f32_16x16x128_f8f6f4 %0, %1, %2, %0, %3, %4 op_sel_hi:[0,0,0]" : "+v"(acc[ai][bj][m][n]) : "v"(Bt##8[n]), "v"(At##8[m]), "v"(sc_w), "v"(sc_x));   \
        else { _Pragma("unroll") for (int k = 0; k < 2; ++k) acc[ai][bj][m][n] = __builtin_amdgcn_mfma_f32_16x16x32_bf16(Bt[n][k], At[m][k], acc[ai][bj][m][n], 0, 0, 0); } } __builtin_amdgcn_s_setprio(0); } while (0)
#define PG8_WAIT_V(n) asm volatile("s_waitcnt vmcnt(" #n ")" ::: "memory")
#define PG8_WAIT_L(n) asm volatile("s_waitcnt lgkmcnt(" #n ")" ::: "memory")
#define PG8_BAR __builtin_amdgcn_s_barrier()
#define PG8_SCHED __builtin_amdgcn_sched_barrier(0)
    Unit cur, nxt; int ui = 0;
    if (!S.next(0, cur)) return;
    f32x4 acc[2][2][4][2];
#pragma unroll
    for (int a = 0; a < 2; ++a)
#pragma unroll
        for (int b = 0; b < 2; ++b)
#pragma unroll
            for (int m = 0; m < 4; ++m)
#pragma unroll
                for (int n = 0; n < 2; ++n) acc[a][b][m][n] = (f32x4){0.f, 0.f, 0.f, 0.f};
    bf16x8 At[4][2], B0[2][2], B1[2][2];
    int sc_w = (int)FP8W, sc_x = 0x7f7f7f7f; asm volatile("" : "+v"(sc_w), "+v"(sc_x));
    i32x8 At8[4], B08[2], B18[2];
    const char* cA = (const char*)g.A + (size_t)cur.pm * tstep; const char* cB = (const char*)g.Bt + (size_t)cur.pn * tstep + cur.bofs;
    S.a_ready(cur);
    if constexpr (SP2) {
        PG8_STAGE(PG8_SB(0, 0), cB, voffB); PG8_STAGE(PG8_SB(0, 1), cB + hstep, voffB); PG8_STAGE(PG8_SA(0, 0), cA, voffA); PG8_STAGE(PG8_SA(0, 1), cA + hstep, voffA);
        if (wr == 1) PG8_BAR;
        PG8_WAIT_V(2); PG8_BAR;
        PG8_STAGE(PG8_SB(1, 0), cB + kstep, voffB); PG8_STAGE(PG8_SA(1, 0), cA + kstep, voffA); PG8_STAGE(PG8_SB(1, 1), cB + hstep + kstep, voffB);
        PG8_WAIT_V(6); PG8_BAR;
    } else {
        PG8_STAGE(PG8_SB(0, 0), cB, voffB); PG8_STAGE(PG8_SA(0, 0), cA, voffA); PG8_STAGE(PG8_SB(0, 1), cB + hstep, voffB); PG8_STAGE(PG8_SA(0, 1), cA + hstep, voffA);
        if (wr == 1) PG8_BAR;
        PG8_WAIT_V(4); PG8_BAR;
        PG8_STAGE(PG8_SB(1, 0), cB + kstep, voffB); PG8_STAGE(PG8_SA(1, 0), cA + kstep, voffA); PG8_STAGE(PG8_SB(1, 1), cB + hstep + kstep, voffB);
        PG8_WAIT_V(6); PG8_BAR;
    }
    for (;;) {
        const bool has_next = S.next(ui + 1, nxt);
        const char* nA = has_next ? (const char*)g.A + (size_t)nxt.pm * tstep : cA; const char* nB = has_next ? (const char*)g.Bt + (size_t)nxt.pn * tstep + nxt.bofs : cB;
        for (int t = 0; t < nt; t += 2) {
            const bool last = (t == nt - 2);
            const char* a1 = cA + (size_t)(t + 1) * kstep;
            const char* a2 = last ? nA : cA + (size_t)(t + 2) * kstep; const char* b2 = last ? nB : cB + (size_t)(t + 2) * kstep;
            const char* a3 = a2 + kstep; const char* b3 = b2 + kstep;
            if (last && has_next) S.a_ready(nxt);
            if constexpr (SP2) {
            PG8_LDB(B0, 0, 0); PG8_LDB(B1, 0, 1); PG8_SCHED; PG8_LDA(At, 0, 0); PG8_STAGE(PG8_SA(1, 1), a1 + hstep, voffA);
            PG8_WAIT_V(8); PG8_WAIT_L(0); PG8_BAR; PG8_MMA(0, 0, At, B0); PG8_MMA(0, 1, At, B1); PG8_BAR; PG8_SCHED;
            PG8_LDA(At, 0, 1); PG8_STAGE(PG8_SB(0, 0), b2, voffB); PG8_STAGE(PG8_SB(0, 1), b2 + hstep, voffB); PG8_STAGE(PG8_SA(0, 0), a2, voffA);
            PG8_WAIT_V(8); PG8_WAIT_L(0); PG8_BAR; PG8_MMA(1, 0, At, B0); PG8_MMA(1, 1, At, B1); PG8_BAR; PG8_SCHED;
            PG8_LDB(B0, 1, 0); PG8_LDB(B1, 1, 1); PG8_SCHED; PG8_LDA(At, 1, 0); PG8_STAGE(PG8_SA(0, 1), a2 + hstep, voffA);
            PG8_WAIT_V(8); PG8_WAIT_L(0); PG8_BAR; PG8_MMA(0, 0, At, B0); PG8_MMA(0, 1, At, B1); PG8_BAR; PG8_SCHED;
            PG8_LDA(At, 1, 1); PG8_STAGE(PG8_SB(1, 0), b3, voffB); PG8_STAGE(PG8_SB(1, 1), b3 + hstep, voffB); PG8_STAGE(PG8_SA(1, 0), a3, voffA);
            PG8_WAIT_V(8); PG8_WAIT_L(0); PG8_BAR; PG8_MMA(1, 0, At, B0); PG8_MMA(1, 1, At, B1); PG8_BAR; PG8_SCHED;
            } else {
            PG8_LDB(B0, 0, 0); PG8_SCHED; PG8_LDA(At, 0, 0); PG8_STAGE(PG8_SA(1, 1), a1 + hstep, voffA);
            PG8_WAIT_L(8); PG8_BAR; PG8_WAIT_L(0); PG8_MMA(0, 0, At, B0); PG8_BAR; PG8_SCHED;
            PG8_LDB(B1, 0, 1); PG8_STAGE(PG8_SB(0, 0), b2, voffB);
            PG8_BAR; PG8_WAIT_L(0); PG8_MMA(0, 1, At, B1); PG8_BAR;
            PG8_LDA(At, 0, 1); PG8_STAGE(PG8_SA(0, 0), a2, voffA);
            PG8_BAR; PG8_WAIT_L(0); PG8_MMA(1, 0, At, B0); PG8_BAR; PG8_SCHED;
            PG8_STAGE(PG8_SB(0, 1), b2 + hstep, voffB);
            PG8_WAIT_V(6); PG8_BAR; PG8_MMA(1, 1, At, B1); PG8_BAR;
            PG8_LDB(B0, 1, 0); PG8_SCHED; PG8_LDA(At, 1, 0); PG8_STAGE(PG8_SA(0, 1), a2 + hstep, voffA);
            PG8_WAIT_L(8); PG8_BAR; PG8_WAIT_L(0); PG8_MMA(0, 0, At, B0); PG8_BAR; PG8_SCHED;
            PG8_LDB(B1, 1, 1); PG8_STAGE(PG8_SB(1, 0), b3, voffB);
            PG8_BAR; PG8_WAIT_L(0); PG8_MMA(0, 1, At, B1); PG8_BAR;
            PG8_LDA(At, 1, 1); PG8_STAGE(PG8_SA(1, 0), a3, voffA);
            PG8_BAR; PG8_WAIT_L(0); PG8_MMA(1, 0, At, B0); PG8_BAR; PG8_SCHED;
            PG8_STAGE(PG8_SB(1, 1), b3 + hstep, voffB);
            PG8_WAIT_V(6); PG8_BAR; PG8_MMA(1, 1, At, B1); PG8_BAR;
            }
        }
        if constexpr (FP8W != 0u) asm volatile("s_nop 15\n\ts_nop 15" ::: "memory");
        if constexpr (ALIGN_EPI) { if (wr == 0) PG8_BAR; }
        if constexpr (!Epi::AFTER_DRAIN) { E(acc, cur, wr, wc, fr, fq); S.done(cur); }
        if (!has_next) break;
#pragma unroll
        for (int a = 0; a < 2; ++a)
#pragma unroll
            for (int b = 0; b < 2; ++b)
#pragma unroll
                for (int m = 0; m < 4; ++m)
#pragma unroll
                    for (int n = 0; n < 2; ++n) acc[a][b][m][n] = (f32x4){0.f, 0.f, 0.f, 0.f};
        cur = nxt; cA = nA; cB = nB; ++ui;
        if constexpr (ALIGN_EPI) { if (wr == 1) PG8_BAR; }
    }
    PG8_WAIT_V(0);
    if constexpr (!ALIGN_EPI) { if (wr == 0) PG8_BAR; }
    PG8_BAR;
    if constexpr (Epi::AFTER_DRAIN) { E.fused(acc, cur, wr, wc, fr, fq, lds, wid, lane); S.done(cur); }
#undef PG8_SA
#undef PG8_SB
#undef PG8_STAGE
#undef PG8_LDA
#undef PG8_CAT
#undef PG8_LDB
#undef PG8_MMA
#undef PG8_WAIT_V
#undef PG8_WAIT_L
#undef PG8_BAR
#undef PG8_SCHED
}
}

constexpr int NWAVES = 8, NTHREADS = 512;
constexpr int BATCH = 2, SEQ = 8192, M = BATCH * SEQ, D = 1024;
constexpr int NEXP = 32, DEXP = 1024;
constexpr int PMAX = M * 4 + NEXP * 256, NTMAX = PMAX / 256;
constexpr float ALPHA = 1.41421356237f;
constexpr int NPHASES = 21;
#ifndef MOE_FP8
#define MOE_FP8 1
#endif
constexpr bool kMoeFp8 = (MOE_FP8 != 0);
constexpr unsigned kScaleGU = 0x79797979u, kScaleDN = 0x78787878u;
#ifndef MK_N_LAUNCHES
#define MK_N_LAUNCHES 1
#endif
constexpr int N_LAUNCHES = MK_N_LAUNCHES;

enum { I_X = 0, I_P, I_AB_WIN, I_AB_QG, I_AB_KVG, I_AB_WUQ, I_AB_WUK, I_AB_WUV, I_AB_WQIDX, I_AB_KIG, I_AB_KIB, I_AB_CONVW, I_AB_ALOG, I_AB_DTB, I_AB_ONG, I_AB_WOUT,
       I_CD_WIN, I_CD_POOLW, I_CD_POOLS, I_CD_WOUT, I_LNM_G, I_LNM_B, I_RW, I_RB, I_WGU, I_BGU, I_WDN, I_BDN, I_PLE_WP, I_PLE_WG, I_LNF_G, I_LNF_B, N_IN };

constexpr size_t MiB = 1u << 20;
constexpr size_t WS_CTL = 0, CTL_ZERO_BYTES = 1 * MiB;
constexpr size_t WS_W_INAB = 1 * MiB;
constexpr size_t WS_W_ABS = 6 * MiB;
constexpr size_t WS_W_OUTAB = 7 * MiB;
constexpr size_t WS_W_INCD = 10 * MiB;
constexpr size_t WS_W_OUTCD = 15 * MiB;
constexpr size_t WS_W_PG = 17 * MiB;
constexpr size_t WS_W_PP = 21 * MiB;
constexpr size_t WS_W_GU = 22 * MiB;
constexpr size_t WS_W_DN = 278 * MiB;
constexpr size_t WS_XB = 406 * MiB;
constexpr size_t WS_PB = 438 * MiB;
constexpr size_t WS_PP = 454 * MiB;
constexpr size_t WS_SM = 518 * MiB;
constexpr size_t WS_QKVZ = 550 * MiB;
constexpr size_t WS_CQ = 630 * MiB;
constexpr size_t WS_CKV = 638 * MiB;
constexpr size_t WS_KIDX = 642 * MiB;
constexpr size_t WS_WIDX = 644 * MiB;
constexpr size_t WS_BETA = 645 * MiB;
constexpr size_t WS_GG = WS_BETA + 512 * 1024;
constexpr size_t WS_QN = 646 * MiB, WS_KN = 662 * MiB, WS_VN = 678 * MiB;
constexpr size_t WS_QL = 694 * MiB;
constexpr size_t WS_CHK = 742 * MiB;
constexpr size_t WS_SEL = 838 * MiB;
constexpr size_t WS_NSEL = 854 * MiB;
constexpr size_t WS_ODELTA = 855 * MiB;
constexpr size_t WS_AO = 887 * MiB;
constexpr size_t WS_PRE = 935 * MiB;
constexpr size_t WS_H1 = 999 * MiB;
constexpr size_t WS_H2 = 1063 * MiB;
constexpr size_t WS_H1B = 1127 * MiB;
constexpr size_t WS_PLE = 1159 * MiB;
constexpr size_t WS_ROUTE = 1191 * MiB;
constexpr size_t WS_BIG = 1193 * MiB;
constexpr size_t WS_XS = WS_BIG, WS_HID = WS_BIG + 144 * MiB, WS_YS = WS_BIG + 288 * MiB;
constexpr size_t WS_END = WS_BIG + 512 * MiB;
static_assert((size_t)PMAX * 1024 * 2 <= 144 * MiB && WS_END <= 2048 * MiB, "d_ws map");
constexpr size_t CHK_WP = 0, CHK_QD = 16384, CHK_KDT = 32768, CHK_QK = 49152, CHK_UT = 57344, CHK_GL = 90112, CHK_STRIDE = 92160;
static_assert(CHK_STRIDE * 1024 <= 96 * MiB, "chunk operands");
constexpr int CW_TMO = 0, CW_CODE = 1;
constexpr int CW_BAR = 4096;
constexpr int CW_BAR2 = 8192;
constexpr int CW_CNT = 16384;

constexpr int RING_OFF = 0, RING_BYTES = 131072;
constexpr int WSCR_OFF = 132096, WSCR_BYTES = 1024;
constexpr int MISC_OFF = 140288;
constexpr int LDS_BYTES = 147456;

#define GAS __attribute__((address_space(1)))
#define LAS __attribute__((address_space(3)))
typedef unsigned short bf16;
typedef unsigned v4u __attribute__((ext_vector_type(4)));
typedef unsigned v2u __attribute__((ext_vector_type(2)));
typedef float f32x4 __attribute__((ext_vector_type(4)));
typedef short bf16x8 __attribute__((ext_vector_type(8)));
typedef GAS unsigned gu32;
#define RLX_AGENT __ATOMIC_RELAXED, __HIP_MEMORY_SCOPE_AGENT
__device__ __forceinline__ unsigned f2bf(float f) { unsigned u = __builtin_bit_cast(unsigned, f); return (u + 0x7fffu + ((u >> 16) & 1u)) >> 16; }
__device__ __forceinline__ unsigned pk2(float lo, float hi) { return f2bf(lo) | (f2bf(hi) << 16); }
__device__ __forceinline__ float bflo(unsigned w) { return __uint_as_float(w << 16); }
__device__ __forceinline__ float bfhi(unsigned w) { return __uint_as_float(w & 0xffff0000u); }
__device__ __forceinline__ float bf1(bf16 h) { return __uint_as_float(((unsigned)h) << 16); }
__device__ __forceinline__ float sigm(float x) { return 1.0f / (1.0f + __expf(-x)); }
__device__ __forceinline__ float siluf(float x) { return x / (1.0f + __expf(-x)); }
__device__ __forceinline__ float wave_sum(float v) {
#pragma unroll
    for (int o = 1; o < 64; o <<= 1) v += __shfl_xor(v, o);
    return v;
}
__device__ __forceinline__ float wave_max(float v) {
#pragma unroll
    for (int o = 1; o < 64; o <<= 1) v = fmaxf(v, __shfl_xor(v, o));
    return v;
}
__device__ __forceinline__ int wave_sum_i(int v) {
#pragma unroll
    for (int o = 1; o < 64; o <<= 1) v += __shfl_xor(v, o);
    return v;
}
__device__ __forceinline__ void unpack8(const v4u w, float (&f)[8]) { f[0] = bflo(w.x); f[1] = bfhi(w.x); f[2] = bflo(w.y); f[3] = bfhi(w.y); f[4] = bflo(w.z); f[5] = bfhi(w.z); f[6] = bflo(w.w); f[7] = bfhi(w.w); }
__device__ __forceinline__ v4u pack8f(const float (&f)[8]) { v4u w; w.x = pk2(f[0], f[1]); w.y = pk2(f[2], f[3]); w.z = pk2(f[4], f[5]); w.w = pk2(f[6], f[7]); return w; }

#define XB_TMO      128
#define XB_XCNT(j)  (256  + 64 * (j))
#define XB_XSUB(j)  (1280 + 64 * (j))
#define XB_XGEN(j)  (2304 + 64 * (j))
#define XB_TOP      3328
#define XB_TOPGEN   3392
#define XCD_BAR_WORDS 3456
#define XB_SPIN_CAP (1u << 18)

__device__ __forceinline__ unsigned xb_ld(unsigned* p)              { return __hip_atomic_load(p, __ATOMIC_RELAXED, __HIP_MEMORY_SCOPE_AGENT); }
__device__ __forceinline__ unsigned xb_add(unsigned* p, unsigned v) { return __hip_atomic_fetch_add(p, v, __ATOMIC_RELAXED, __HIP_MEMORY_SCOPE_AGENT); }
__device__ __forceinline__ unsigned xb_xcc_id() { return (unsigned)__builtin_amdgcn_s_getreg((3 << 11) | 20) & 0xFu; }
#define XB_SPIN(cond, bar) do { unsigned _sp = 0; while (cond) { __builtin_amdgcn_s_sleep(1); \
    if ((++_sp & 255u) == 0u) { if (xb_ld(&(bar)[XB_TMO])) break; if (_sp > XB_SPIN_CAP) { atomicAdd(&(bar)[XB_TMO], 1u); break; } } } } while (0)

struct XcdBarrier {
    unsigned* bar; unsigned x;
    unsigned expect;
    volatile LAS unsigned* st;
};

__device__ __forceinline__ XcdBarrier xcd_barrier_post(unsigned* bar, volatile LAS unsigned* st, unsigned expect = 0u) {
    XcdBarrier b; b.bar = bar; b.x = xb_xcc_id(); b.st = st; b.expect = expect ? expect : gridDim.x * gridDim.y * gridDim.z;
    if (threadIdx.x == 0) (void)xb_add(&bar[XB_XCNT(b.x)], 1u);
    return b;
}
__device__ __forceinline__ void xcd_barrier_complete(unsigned* bar, unsigned x, unsigned& nloc, unsigned& nx, const unsigned G) {
    unsigned sum, cnt, mine, sp = 0u;
    for (;;) {
        sum = 0u; cnt = 0u; mine = 0u;
#pragma unroll
        for (unsigned j = 0; j < 16; ++j) { const unsigned c = xb_ld(&bar[XB_XCNT(j)]); sum += c; cnt += (c > 0u) ? 1u : 0u; mine = (j == x) ? c : mine; }
        if (sum == G) break;
        __builtin_amdgcn_s_sleep(1);
        if ((++sp & 255u) == 0u) { if (xb_ld(&bar[XB_TMO])) break; if (sp > XB_SPIN_CAP) { atomicAdd(&bar[XB_TMO], 1u); break; } }
    }
    nloc = mine > 0u ? mine : 1u; nx = cnt > 0u ? cnt : 1u;
}

__device__ __forceinline__ void xcd_barrier(const XcdBarrier& b) {
    asm volatile("s_waitcnt vmcnt(0)" ::: "memory");
    __syncthreads();
    if (threadIdx.x == 0) {
        unsigned* bar = b.bar;
        __builtin_amdgcn_s_waitcnt(0);
        unsigned nloc = b.st[0], nx = b.st[1];
        if (nloc == 0u) { xcd_barrier_complete(bar, b.x, nloc, nx, b.expect); b.st[0] = nloc; b.st[1] = nx; }
        const unsigned old = xb_add(&bar[XB_XSUB(b.x)], 1u);
        const unsigned gen = old / nloc;
        if (old + 1u == (gen + 1u) * nloc) {
            __builtin_amdgcn_fence(__ATOMIC_RELEASE, "agent");
            asm volatile("s_waitcnt vmcnt(0)" ::: "memory");
            const unsigned og = xb_add(&bar[XB_TOP], 1u);
            const unsigned tg = og / nx;
            if (og + 1u == (tg + 1u) * nx) xb_add(&bar[XB_TOPGEN], 1u);
            else XB_SPIN(xb_ld(&bar[XB_TOPGEN]) == tg, bar);
            __builtin_amdgcn_fence(__ATOMIC_ACQUIRE, "agent");
            xb_add(&bar[XB_XGEN(b.x)], 1u);
            asm volatile("s_waitcnt vmcnt(0)" ::: "memory");
        } else {
            XB_SPIN(xb_ld(&bar[XB_XGEN(b.x)]) == gen, bar);
            __builtin_amdgcn_fence(__ATOMIC_ACQUIRE, "agent");
            asm volatile("s_waitcnt vmcnt(0)" ::: "memory");
        }
    }
    __syncthreads();
}

struct Args { const float* in[N_IN]; float* out; unsigned char* ws; int ph_lo, ph_hi, li, pad; };
typedef const __attribute__((address_space(4))) Args* KArgs;
__device__ __forceinline__ KArgs kargs() { auto p = __builtin_amdgcn_kernarg_segment_ptr(); asm volatile("" : "+s"(p)); return (KArgs)p; }
struct Frame {
    LAS unsigned char* lds;
    int tid, lane, wave, G, bid;
    unsigned char* ws;
    gu32* ctl;
};
#define WSP(T, off) ((T*)(F.ws + (off)))

struct MapId { __device__ __forceinline__ int operator()(int n) const { return n; } };
struct MapAdd { int off; __device__ __forceinline__ int operator()(int n) const { return n + off; } };
struct MapAB { __device__ __forceinline__ int operator()(int n) const { return n < 456 ? n : (n < 2504 ? n + 56 : n - 2048); } };
template <class Map> __device__ __forceinline__ void wg_transpose_item(const float* W, int N, int ldw, bf16* WT, int ldt, int koff, Map map, LAS float* scr, int item, int tid) {
    const int nblk = (N + 127) >> 7, kb = item / nblk, nb = item - kb * nblk, k0 = kb * 128, n0 = nb * 128;
#pragma unroll
    for (int it = 0; it < 8; ++it) {
        const int row = it * 16 + (tid >> 5), c4 = (tid & 31) * 4, n = n0 + c4;
        f32x4 v = (f32x4){0.f, 0.f, 0.f, 0.f};
        if (n + 3 < N) v = *(const f32x4*)(W + (size_t)(k0 + row) * ldw + n);
        LAS float* s = scr + row * 129 + c4; s[0] = v[0]; s[1] = v[1]; s[2] = v[2]; s[3] = v[3];
    }
    __syncthreads();
#pragma unroll
    for (int j = 0; j < 4; ++j) {
        const int idx = j * 512 + tid, nl = idx >> 4, ch = idx & 15, n = n0 + nl;
        if (n < N) { const LAS float* s = scr + (ch * 8) * 129 + nl;
            v4u o; o.x = pk2(s[0], s[129]); o.y = pk2(s[2 * 129], s[3 * 129]); o.z = pk2(s[4 * 129], s[5 * 129]); o.w = pk2(s[6 * 129], s[7 * 129]);
            *(v4u*)(WT + (size_t)map(n) * ldt + koff + k0 + ch * 8) = o; }
    }
    __syncthreads();
}
__device__ __forceinline__ void wg_transpose_item_fp8(const float* W, int N, int ldw, unsigned char* WT, int ldt, float mul, LAS float* scr, int item, int tid) {
    const int nblk = (N + 127) >> 7, kb = item / nblk, nb = item - kb * nblk, k0 = kb * 128, n0 = nb * 128;
#pragma unroll
    for (int it = 0; it < 8; ++it) {
        const int row = it * 16 + (tid >> 5), c4 = (tid & 31) * 4;
        const f32x4 v = *(const f32x4*)(W + (size_t)(k0 + row) * ldw + n0 + c4);
        LAS float* s = scr + row * 129 + c4; s[0] = v[0]; s[1] = v[1]; s[2] = v[2]; s[3] = v[3];
    }
    __syncthreads();
#pragma unroll
    for (int j = 0; j < 2; ++j) {
        const int idx = j * 512 + tid, nl = idx >> 3, ch = idx & 7;
        const LAS float* s = scr + (ch * 16) * 129 + nl;
        v4u o;
#pragma unroll
        for (int q = 0; q < 4; ++q) { unsigned w = 0u;
            w = __builtin_amdgcn_cvt_pk_fp8_f32(s[(4 * q) * 129] * mul, s[(4 * q + 1) * 129] * mul, w, false);
            w = __builtin_amdgcn_cvt_pk_fp8_f32(s[(4 * q + 2) * 129] * mul, s[(4 * q + 3) * 129] * mul, w, true);
            o[q] = w; }
        *(v4u*)(WT + (size_t)(n0 + nl) * ldt + k0 + ch * 16) = o;
    }
    __syncthreads();
}
struct MoeItem { const float* W; unsigned char* WT; int N; float mul; int k0, n0; };
__device__ __forceinline__ MoeItem moe_item(KArgs A, unsigned char* ws, int it) {
    MoeItem d; int sub;
    if (it < 64 * 128) { const int m = it >> 7; sub = it & 127; d.W = A->in[I_WGU] + (size_t)m * 1024 * 2048; d.N = 2048; d.WT = ws + WS_W_GU + (size_t)m * 2048 * 1024; d.mul = 64.0f; }
    else { it -= 64 * 128; const int m = it >> 6; sub = it & 63; d.W = A->in[I_WDN] + (size_t)m * 1024 * 1024; d.N = 1024; d.WT = ws + WS_W_DN + (size_t)m * 1024 * 1024; d.mul = 128.0f; }
    const int nblk = d.N >> 7, kb = sub / nblk, nb = sub - kb * nblk; d.k0 = kb * 128; d.n0 = nb * 128; return d;
}
__device__ __forceinline__ void p0_moe_fp8(Frame& F, KArgs A) {
    LAS float* scr = (LAS float*)(F.lds + RING_OFF);
    const int tid = F.tid; constexpr int NIT = 64 * 128 + 64 * 64;
    int it = F.bid; if (it >= NIT) return;
    MoeItem cur = moe_item(A, F.ws, it);
    f32x4 r[8];
#pragma unroll
    for (int x = 0; x < 8; ++x) r[x] = __builtin_nontemporal_load((const f32x4*)(cur.W + (size_t)(cur.k0 + x * 16 + (tid >> 5)) * cur.N + cur.n0 + (tid & 31) * 4));
    for (;;) {
#pragma unroll
        for (int x = 0; x < 8; ++x) { LAS float* sp = scr + (x * 16 + (tid >> 5)) * 129 + (tid & 31) * 4; sp[0] = r[x][0]; sp[1] = r[x][1]; sp[2] = r[x][2]; sp[3] = r[x][3]; }
        __syncthreads();
        const int nx = it + F.G; MoeItem nxt = cur;
        if (nx < NIT) { nxt = moe_item(A, F.ws, nx);
#pragma unroll
            for (int x = 0; x < 8; ++x) r[x] = __builtin_nontemporal_load((const f32x4*)(nxt.W + (size_t)(nxt.k0 + x * 16 + (tid >> 5)) * nxt.N + nxt.n0 + (tid & 31) * 4)); }
#pragma unroll
        for (int j = 0; j < 2; ++j) {
            const int idx = j * 512 + tid, nl = idx >> 3, ch = idx & 7;
            const LAS float* sp = scr + (ch * 16) * 129 + nl;
            v4u o;
#pragma unroll
            for (int q = 0; q < 4; ++q) { unsigned w = 0u;
                w = __builtin_amdgcn_cvt_pk_fp8_f32(sp[(4 * q) * 129] * cur.mul, sp[(4 * q + 1) * 129] * cur.mul, w, false);
                w = __builtin_amdgcn_cvt_pk_fp8_f32(sp[(4 * q + 2) * 129] * cur.mul, sp[(4 * q + 3) * 129] * cur.mul, w, true);
                o[q] = w; }
            *(v4u*)(cur.WT + (size_t)(cur.n0 + nl) * 1024 + cur.k0 + ch * 16) = o;
        }
        __syncthreads();
        if (nx >= NIT) break;
        cur = nxt; it = nx;
    }
}
__device__ __forceinline__ void p0_prologue(Frame& F, KArgs A) {
    LAS float* scr = (LAS float*)(F.lds + RING_OFF);
    const int tid = F.tid;
    constexpr int IT_GU = 128, IT_DN = 64;
    constexpr int N_GU = 64 * IT_GU, N_DN = 64 * IT_DN;
    constexpr int N_INAB = 8 * 20, N_INCD = 8 * 20, N_OUTCD = 64, N_PG = 2 * 64, N_PP = 2 * 2 * 8, N_QIDX = 2 * 4, N_OUTB = 4 * 8;
    constexpr int NITEMS = N_GU + N_DN + N_INAB + N_INCD + N_OUTCD + N_PG + N_PP + N_QIDX + N_OUTB;
    if (kMoeFp8) p0_moe_fp8(F, A);
    for (int it = F.bid + (kMoeFp8 ? N_GU + N_DN : 0); it < NITEMS; it += F.G) {
        int r = it;
        if (r < N_GU) { const int m = r / IT_GU;
            if (kMoeFp8) wg_transpose_item_fp8(A->in[I_WGU] + (size_t)m * 1024 * 2048, 2048, 2048, WSP(unsigned char, WS_W_GU) + (size_t)m * 2048 * 1024, 1024, 64.0f, scr, r % IT_GU, tid);
            else wg_transpose_item(A->in[I_WGU] + (size_t)m * 1024 * 2048, 2048, 2048, WSP(bf16, WS_W_GU) + (size_t)m * 2048 * 1024, 1024, 0, MapId{}, scr, r % IT_GU, tid);
            continue; } r -= N_GU;
        if (r < N_DN) { const int m = r / IT_DN;
            if (kMoeFp8) wg_transpose_item_fp8(A->in[I_WDN] + (size_t)m * 1024 * 1024, 1024, 1024, WSP(unsigned char, WS_W_DN) + (size_t)m * 1024 * 1024, 1024, 128.0f, scr, r % IT_DN, tid);
            else wg_transpose_item(A->in[I_WDN] + (size_t)m * 1024 * 1024, 1024, 1024, WSP(bf16, WS_W_DN) + (size_t)m * 1024 * 1024, 1024, 0, MapId{}, scr, r % IT_DN, tid);
            continue; } r -= N_DN;
        if (r < N_INAB) { wg_transpose_item(A->in[I_AB_WIN], 2512, 2512, WSP(bf16, WS_W_INAB), 1024, 0, MapAB{}, scr, r, tid); continue; } r -= N_INAB;
        if (r < N_INCD) { wg_transpose_item(A->in[I_CD_WIN], 2560, 2560, WSP(bf16, WS_W_INCD), 1024, 0, MapId{}, scr, r, tid); continue; } r -= N_INCD;
        if (r < N_OUTCD) { wg_transpose_item(A->in[I_CD_WOUT], 1024, 1024, WSP(bf16, WS_W_OUTCD), 1024, 0, MapId{}, scr, r, tid); continue; } r -= N_OUTCD;
        if (r < N_PG) { const int l = r / 64; wg_transpose_item(A->in[I_PLE_WG] + (size_t)l * 1024 * 1024, 1024, 1024, WSP(bf16, WS_W_PG) + (size_t)l * 1024 * 1024, 1024, 0, MapId{}, scr, r % 64, tid); continue; } r -= N_PG;
        if (r < N_PP) { const int l = r / 16; wg_transpose_item(A->in[I_PLE_WP] + (size_t)l * 256 * 1024, 1024, 1024, WSP(bf16, WS_W_PP) + (size_t)l * 1024 * 256, 256, 0, MapId{}, scr, r % 16, tid); continue; } r -= N_PP;
        if (r < N_QIDX) { wg_transpose_item(A->in[I_AB_WQIDX], 512, 512, WSP(bf16, WS_W_ABS), 256, 0, MapAdd{1024}, scr, r, tid); continue; } r -= N_QIDX;
        wg_transpose_item(A->in[I_AB_WOUT] + (size_t)512 * 1024, 1024, 1024, WSP(bf16, WS_W_OUTAB), 1536, 1024, MapId{}, scr, r, tid);
    }
    const size_t gt = (size_t)F.bid * NTHREADS + tid, GT = (size_t)F.G * NTHREADS;
    for (size_t i = gt; i < (size_t)48 * 1024 / 8; i += GT) *(v4u*)(WSP(bf16, WS_W_INAB) + (size_t)464 * 1024 + i * 8) = (v4u){0u, 0u, 0u, 0u};
    for (size_t i = gt; i < (size_t)1024 * 256; i += GT) {
        const int n = (int)(i >> 8), c = (int)(i & 255), h = n >> 7, r = n & 127;
        const float* a = A->in[I_AB_WUQ] + (size_t)c * 512 + h * 64; const float* b = A->in[I_AB_WUK] + (size_t)r * 512 + h * 64;
        float s = 0.f;
#pragma unroll 8
        for (int d = 0; d < 64; d += 4) { const f32x4 x = *(const f32x4*)(a + d), y = *(const f32x4*)(b + d); s += x[0] * y[0] + x[1] * y[1] + x[2] * y[2] + x[3] * y[3]; }
        WSP(bf16, WS_W_ABS)[i] = (bf16)f2bf(s * 0.125f);
    }
    for (size_t i = gt; i < (size_t)1024 * 1024; i += GT) {
        const int n = (int)(i >> 10), k = (int)(i & 1023), h = k >> 7, r = k & 127;
        const float* a = A->in[I_AB_WUV] + (size_t)r * 512 + h * 64; const float* b = A->in[I_AB_WOUT] + (size_t)(h * 64) * 1024 + n;
        float s = 0.f;
#pragma unroll 8
        for (int v = 0; v < 64; ++v) s += a[v] * b[(size_t)v * 1024];
        WSP(bf16, WS_W_OUTAB)[(size_t)n * 1536 + k] = (bf16)f2bf(s);
    }
    for (size_t i = gt; i < (size_t)M * D / 8; i += GT) { const f32x4 a = *(const f32x4*)(A->in[I_X] + i * 8), b = *(const f32x4*)(A->in[I_X] + i * 8 + 4);
        v4u o; o.x = pk2(a[0], a[1]); o.y = pk2(a[2], a[3]); o.z = pk2(b[0], b[1]); o.w = pk2(b[2], b[3]); *(v4u*)(WSP(bf16, WS_XB) + i * 8) = o; }
    for (size_t i = gt; i < (size_t)2 * M * 256 / 8; i += GT) { const f32x4 a = *(const f32x4*)(A->in[I_P] + i * 8), b = *(const f32x4*)(A->in[I_P] + i * 8 + 4);
        v4u o; o.x = pk2(a[0], a[1]); o.y = pk2(a[2], a[3]); o.z = pk2(b[0], b[1]); o.w = pk2(b[2], b[3]); *(v4u*)(WSP(bf16, WS_PB) + i * 8) = o; }
}

__device__ __forceinline__ void p2_prep(Frame& F, KArgs A) {
    const int lane = F.lane, gw = F.bid * NWAVES + F.wave, NGW = F.G * NWAVES;
    const float* SM = WSP(float, WS_SM); const bf16* QZ = WSP(bf16, WS_QKVZ);
    const f32x4 qg = *(const f32x4*)(A->in[I_AB_QG] + 4 * lane);
    const f32x4 kvg = *(const f32x4*)(A->in[I_AB_KVG] + 4 * (lane & 31));
    const f32x4 kig = *(const f32x4*)(A->in[I_AB_KIG] + 4 * (lane & 15)), kib = *(const f32x4*)(A->in[I_AB_KIB] + 4 * (lane & 15));
    const f32x4 alog = *(const f32x4*)(A->in[I_AB_ALOG]), dtb = *(const f32x4*)(A->in[I_AB_DTB]);
    LAS float* cw = (LAS float*)(F.lds);
    {   f32x4 wv[3]; int t0 = F.tid; asm volatile("" : "+v"(t0));
#pragma unroll
        for (int j = 0; j < 3; ++j) wv[j] = *(const f32x4*)(A->in[I_AB_CONVW] + (size_t)(t0 + NTHREADS * j) * 4);
#pragma unroll
        for (int j = 0; j < 3; ++j) *(LAS f32x4*)(cw + (t0 + NTHREADS * j) * 4) = wv[j];
    }
    __syncthreads();
    for (int row = gw; row < M; row += NGW) {
        const int t = row & (SEQ - 1);
        const f32x4 a = *(const f32x4*)(SM + (size_t)row * 512 + 4 * lane), b = *(const f32x4*)(SM + (size_t)row * 512 + 256 + 4 * lane);
        {
            const float ss = wave_sum(a[0] * a[0] + a[1] * a[1] + a[2] * a[2] + a[3] * a[3]);
            const float r = rsqrtf(ss * (1.0f / 256.0f) + 1e-6f);
            v2u o; o.x = pk2(a[0] * r * qg[0], a[1] * r * qg[1]); o.y = pk2(a[2] * r * qg[2], a[3] * r * qg[3]);
            *(v2u*)(WSP(bf16, WS_CQ) + (size_t)row * 256 + 4 * lane) = o;
        }
        {
            const float ss = wave_sum(lane < 32 ? (b[0] * b[0] + b[1] * b[1] + b[2] * b[2] + b[3] * b[3]) : 0.f);
            const float r = rsqrtf(ss * (1.0f / 128.0f) + 1e-6f);
            if (lane < 32) { v2u o; o.x = pk2(b[0] * r * kvg[0], b[1] * r * kvg[1]); o.y = pk2(b[2] * r * kvg[2], b[3] * r * kvg[3]);
                *(v2u*)(WSP(bf16, WS_CKV) + (size_t)row * 128 + 4 * lane) = o; }
        }
        {
            const bool in = (lane >= 32 && lane < 48);
            const float mean = wave_sum(in ? (b[0] + b[1] + b[2] + b[3]) : 0.f) * (1.0f / 64.0f);
            const f32x4 d = b - mean;
            const float var = wave_sum(in ? (d[0] * d[0] + d[1] * d[1] + d[2] * d[2] + d[3] * d[3]) : 0.f) * (1.0f / 64.0f);
            const float r = rsqrtf(var + 1e-5f);
            if (in) { v2u o; o.x = pk2(d[0] * r * kig[0] + kib[0], d[1] * r * kig[1] + kib[1]); o.y = pk2(d[2] * r * kig[2] + kib[2], d[3] * r * kig[3] + kib[3]);
                *(v2u*)(WSP(bf16, WS_KIDX) + (size_t)row * 64 + 4 * (lane - 32)) = o; }
        }
        if (lane == 48 || lane == 49) *(f32x4*)(WSP(float, WS_WIDX) + (size_t)row * 8 + 4 * (lane - 48)) = b * 0.044194173824159216f;
        if (lane == 50) { f32x4 o; o[0] = sigm(b[0]); o[1] = sigm(b[1]); o[2] = sigm(b[2]); o[3] = sigm(b[3]); *(f32x4*)(WSP(float, WS_BETA) + (size_t)row * 4) = o; }
        if (lane == 51) { f32x4 o;
#pragma unroll
            for (int h = 0; h < 4; ++h) { const float xx = b[h] + dtb[h]; const float sp = xx > 20.f ? xx : log1pf(__expf(xx)); o[h] = -__expf(alog[h]) * sp; }
            *(f32x4*)(WSP(float, WS_GG) + (size_t)row * 4) = o; }
        v4u xr[3][4];
#pragma unroll
        for (int sel = 0; sel < 3; ++sel)
#pragma unroll
            for (int j = 0; j < 4; ++j) { const int back = (t - 3 + j >= 0) ? (3 - j) : 0; xr[sel][j] = *(const v4u*)(QZ + (size_t)(row - back) * 2048 + sel * 512 + 8 * lane); }
#pragma unroll
        for (int sel = 0; sel < 3; ++sel) {
            const int col0 = sel * 512 + 8 * lane;
            float acc[8];
#pragma unroll
            for (int i = 0; i < 8; ++i) acc[i] = 0.f;
#pragma unroll
            for (int j = 0; j < 4; ++j) {
                float xv[8]; unpack8(xr[sel][j], xv);
                const f32x4 w0 = *(const LAS f32x4*)(cw + j * 1536 + col0), w1 = *(const LAS f32x4*)(cw + j * 1536 + col0 + 4);
                const float m = (t - 3 + j >= 0) ? 1.f : 0.f;
#pragma unroll
                for (int i = 0; i < 4; ++i) { acc[i] += w0[i] * m * xv[i]; acc[4 + i] += w1[i] * m * xv[4 + i]; }
            }
            float ss = 0.f;
#pragma unroll
            for (int i = 0; i < 8; ++i) { acc[i] = siluf(acc[i]); ss += acc[i] * acc[i]; }
            if (sel < 2) {
                ss += __shfl_xor(ss, 1); ss += __shfl_xor(ss, 2); ss += __shfl_xor(ss, 4); ss += __shfl_xor(ss, 8);
                const float sc = rsqrtf(ss + 1e-6f) * (sel == 0 ? 0.08838834764831845f : 1.0f);
#pragma unroll
                for (int i = 0; i < 8; ++i) acc[i] *= sc;
            }
            bf16* dst = (sel == 0 ? WSP(bf16, WS_QN) : (sel == 1 ? WSP(bf16, WS_KN) : WSP(bf16, WS_VN))) + (size_t)row * 512 + 8 * lane;
            *(v4u*)dst = pack8f(acc);
        }
    }
}

__device__ __forceinline__ void p3_chunk_prep(Frame& F, KArgs A) {
    int tid = F.tid; asm volatile("" : "+v"(tid));
    const int lane = tid & 63;
    constexpr int P = 132;
    LAS float* qs = (LAS float*)(F.lds); LAS float* ks = qs + 64 * P; LAS float* vs = ks + 64 * P;
    LAS float* As = vs + 64 * P;
    LAS float* gcS = As + 64 * 65; LAS float* egS = gcS + 64; LAS float* ekS = egS + 64; LAS float* btS = ekS + 64;
    LAS float* Ts = qs;
    for (int cidx = F.bid; cidx < 1024; cidx += F.G) {
        const int b = cidx >> 9, h = (cidx >> 7) & 3, n = cidx & 127, row0 = b * SEQ + n * 64;
        unsigned char* blk = F.ws + WS_CHK + (size_t)cidx * CHK_STRIDE;
        if (tid < 64) {
            const float g = WSP(float, WS_GG)[(size_t)(row0 + tid) * 4 + h];
            float gc = g;
#pragma unroll
            for (int o = 1; o < 64; o <<= 1) { const float t = __shfl_up(gc, o); if (lane >= o) gc += t; }
            const float g63 = __shfl(gc, 63);
            gcS[tid] = gc; egS[tid] = __expf(gc); ekS[tid] = __expf(g63 - gc); btS[tid] = WSP(float, WS_BETA)[(size_t)(row0 + tid) * 4 + h];
            if (tid == 0) *(float*)(blk + CHK_GL) = __expf(g63);
        }
#pragma unroll
        for (int i = 0; i < 2; ++i) {
            const int id = tid + 512 * i, r = id >> 4, c8 = (id & 15) * 8; const size_t so = (size_t)(row0 + r) * 512 + h * 128 + c8;
            float f[8];
            unpack8(*(const v4u*)(WSP(bf16, WS_QN) + so), f);
            *(LAS f32x4*)(qs + r * P + c8) = (f32x4){f[0], f[1], f[2], f[3]}; *(LAS f32x4*)(qs + r * P + c8 + 4) = (f32x4){f[4], f[5], f[6], f[7]};
            unpack8(*(const v4u*)(WSP(bf16, WS_KN) + so), f);
            *(LAS f32x4*)(ks + r * P + c8) = (f32x4){f[0], f[1], f[2], f[3]}; *(LAS f32x4*)(ks + r * P + c8 + 4) = (f32x4){f[4], f[5], f[6], f[7]};
            unpack8(*(const v4u*)(WSP(bf16, WS_VN) + so), f);
            *(LAS f32x4*)(vs + r * P + c8) = (f32x4){f[0], f[1], f[2], f[3]}; *(LAS f32x4*)(vs + r * P + c8 + 4) = (f32x4){f[4], f[5], f[6], f[7]};
        }
        __syncthreads();
        {
            const int i = tid >> 3, t7 = tid & 7;
            float aK[8], aQ[8];
#pragma unroll
            for (int x = 0; x < 8; ++x) { aK[x] = 0.f; aQ[x] = 0.f; }
#pragma unroll 1
            for (int d = 0; d < 128; d += 4) {
                const f32x4 ki = *(const LAS f32x4*)(ks + i * P + d), qi = *(const LAS f32x4*)(qs + i * P + d);
#pragma unroll
                for (int x = 0; x < 8; ++x) { const f32x4 kj = *(const LAS f32x4*)(ks + (t7 + 8 * x) * P + d);
                    aK[x] += ki[0] * kj[0] + ki[1] * kj[1] + ki[2] * kj[2] + ki[3] * kj[3]; aQ[x] += qi[0] * kj[0] + qi[1] * kj[1] + qi[2] * kj[2] + qi[3] * kj[3]; }
            }
            const float gci = gcS[i], bti = btS[i];
            bf16* QKp = (bf16*)(blk + CHK_QK) + i * 64;
#pragma unroll
            for (int x = 0; x < 8; ++x) { const int j = t7 + 8 * x; const float dec = __expf(j <= i ? gci - gcS[j] : 0.f);
                As[i * 65 + j] = (j < i) ? bti * aK[x] * dec : 0.f;
                QKp[32 * (j >> 5) + 8 * ((j >> 2) & 3) + 4 * ((j >> 4) & 1) + (j & 3)] = (bf16)f2bf((j <= i) ? aQ[x] * dec : 0.f); }
        }
        {
            const int i = tid >> 3, d0 = (tid & 7) * 16, s = d0 >> 5, a = (d0 >> 4) & 1; const float e = egS[i];
            bf16* Qd = (bf16*)(blk + CHK_QD) + i * 128;
#pragma unroll
            for (int q = 0; q < 4; ++q) { const f32x4 p = *(const LAS f32x4*)(qs + i * P + d0 + 4 * q); v2u w; w.x = pk2(p[0] * e, p[1] * e); w.y = pk2(p[2] * e, p[3] * e); *(v2u*)(Qd + 32 * s + 8 * q + 4 * a) = w; }
        }
        {
            const int d = tid >> 2, c0 = (tid & 3) * 16, s = c0 >> 5, a = (c0 >> 4) & 1;
            bf16* Kd = (bf16*)(blk + CHK_KDT) + d * 64;
#pragma unroll
            for (int q = 0; q < 4; ++q) { const int c = c0 + 4 * q;
                v2u w; w.x = pk2(ks[c * P + d] * ekS[c], ks[(c + 1) * P + d] * ekS[c + 1]); w.y = pk2(ks[(c + 2) * P + d] * ekS[c + 2], ks[(c + 3) * P + d] * ekS[c + 3]);
                *(v2u*)(Kd + 32 * s + 8 * q + 4 * a) = w; }
        }
        __syncthreads();
        {
            const int c = tid >> 3, part = tid & 7;
            for (int i = 0; i < 64; ++i) {
                float acc = 0.f;
                for (int j = part; j < i; j += 8) acc += As[i * 65 + j] * Ts[j * 65 + c];
                acc += __shfl_xor(acc, 1); acc += __shfl_xor(acc, 2); acc += __shfl_xor(acc, 4);
                if (part == 0) Ts[i * 65 + c] = ((i == c) ? 1.f : 0.f) - acc;
                __builtin_amdgcn_fence(__ATOMIC_RELEASE, "wavefront"); asm volatile("s_waitcnt lgkmcnt(0)" ::: "memory");
            }
        }
        __syncthreads();
        {
            const int i = tid >> 3, t7 = tid & 7;
            f32x4 aU[4], aW[4];
#pragma unroll
            for (int xx = 0; xx < 4; ++xx) { aU[xx] = (f32x4){0.f, 0.f, 0.f, 0.f}; aW[xx] = (f32x4){0.f, 0.f, 0.f, 0.f}; }
#pragma unroll 1
            for (int j = 0; j <= i; ++j) {
                const float tb = Ts[i * 65 + j] * btS[j], tbe = tb * egS[j];
#pragma unroll
                for (int xx = 0; xx < 4; ++xx) { aU[xx] += *(const LAS f32x4*)(vs + j * P + 4 * t7 + 32 * xx) * tb; aW[xx] += *(const LAS f32x4*)(ks + j * P + 4 * t7 + 32 * xx) * tbe; }
            }
            float* UT = (float*)(blk + CHK_UT);
            bf16* Wp = (bf16*)(blk + CHK_WP) + i * 128;
#pragma unroll
            for (int xx = 0; xx < 4; ++xx) {
                const int c = 4 * t7 + 32 * xx;
#pragma unroll
                for (int e = 0; e < 4; ++e) UT[(c + e) * 64 + i] = aU[xx][e];
                v2u w; w.x = pk2(aW[xx][0], aW[xx][1]); w.y = pk2(aW[xx][2], aW[xx][3]); *(v2u*)(Wp + 32 * xx + 8 * (t7 & 3) + 4 * (t7 >> 2)) = w;
            }
        }
        __syncthreads();
    }
}

constexpr int SEQ_WGS = 16;
constexpr int SQ_WP = 0, SQ_QD = 16384, SQ_KDT = 32768, SQ_QK = 49152, SQ_BUF = 57344;
__device__ __forceinline__ bf16x8 packfrag(const f32x4 lo, const f32x4 hi) { v4u w; w.x = pg8::cvt_pk_bf16(lo[0], lo[1]); w.y = pg8::cvt_pk_bf16(lo[2], lo[3]); w.z = pg8::cvt_pk_bf16(hi[0], hi[1]); w.w = pg8::cvt_pk_bf16(hi[2], hi[3]); return __builtin_bit_cast(bf16x8, w); }
__device__ __forceinline__ void seq_load(v4u (&r)[14], const unsigned char* blk, int lt) {
#pragma unroll
    for (int i = 0; i < 14; ++i) r[i] = *(const v4u*)(blk + (size_t)(lt + 256 * i) * 16);
}
__device__ __forceinline__ void seq_write(LAS unsigned char* buf, const v4u (&r)[14], int lt) {
#pragma unroll
    for (int i = 0; i < 14; ++i) {
        const int id = lt + 256 * i; int dst;
        if (id < 2048) { const int rr = (id & 1023) >> 4, ch = id & 15; dst = (id & ~1023) * 16 + rr * 256 + 16 * (ch ^ (rr & 15)); }
        else { const int rr = (id - 2048) >> 3, ch = id & 7; dst = 32768 + rr * 128 + 16 * (ch ^ (rr & 7)); }
        *(LAS v4u*)(buf + dst) = r[i];
    }
}
__device__ __forceinline__ void seq_compute(LAS unsigned char* buf, f32x4 (&Sacc)[8], const f32x4 (&U)[4], const float gl, float* op0, const int fr, const int fq) {
    bf16x8 sf[4];
#pragma unroll
    for (int s = 0; s < 4; ++s) sf[s] = packfrag(Sacc[2 * s], Sacc[2 * s + 1]);
    f32x4 Vn[4], Oa[4];
#pragma unroll
    for (int tc = 0; tc < 4; ++tc) {
        const int rr = 16 * tc + fr; f32x4 av = (f32x4){0.f, 0.f, 0.f, 0.f}, ao = (f32x4){0.f, 0.f, 0.f, 0.f};
#pragma unroll
        for (int s = 0; s < 4; ++s) {
            const int off = rr * 256 + 16 * ((4 * s + fq) ^ (rr & 15));
            const bf16x8 wf = *(const LAS bf16x8*)(buf + SQ_WP + off), qf = *(const LAS bf16x8*)(buf + SQ_QD + off);
            av = __builtin_amdgcn_mfma_f32_16x16x32_bf16(wf, sf[s], av, 0, 0, 0);
            ao = __builtin_amdgcn_mfma_f32_16x16x32_bf16(qf, sf[s], ao, 0, 0, 0);
        }
        Vn[tc] = U[tc] - av; Oa[tc] = ao;
    }
    bf16x8 vf[2];
    vf[0] = packfrag(Vn[0], Vn[1]); vf[1] = packfrag(Vn[2], Vn[3]);
#pragma unroll
    for (int tc = 0; tc < 4; ++tc) {
        const int rr = 16 * tc + fr;
#pragma unroll
        for (int s = 0; s < 2; ++s) {
            const bf16x8 kf = *(const LAS bf16x8*)(buf + SQ_QK + rr * 128 + 16 * ((4 * s + fq) ^ (rr & 7)));
            Oa[tc] = __builtin_amdgcn_mfma_f32_16x16x32_bf16(kf, vf[s], Oa[tc], 0, 0, 0);
        }
        float* op = op0 + (size_t)(16 * tc) * 512;
#pragma unroll
        for (int j = 0; j < 4; ++j) op[(size_t)j * 512] = Oa[tc][j];
    }
#pragma unroll
    for (int T = 0; T < 8; ++T) {
        const int rr = 16 * T + fr; f32x4 a = Sacc[T] * gl;
#pragma unroll
        for (int s = 0; s < 2; ++s) {
            const bf16x8 kf = *(const LAS bf16x8*)(buf + SQ_KDT + rr * 128 + 16 * ((4 * s + fq) ^ (rr & 7)));
            a = __builtin_amdgcn_mfma_f32_16x16x32_bf16(kf, vf[s], a, 0, 0, 0);
        }
        Sacc[T] = a;
    }
}
#define SEQ_BAR() do { asm volatile("s_waitcnt lgkmcnt(0)" ::: "memory"); __builtin_amdgcn_s_barrier(); asm volatile("" ::: "memory"); } while (0)
__device__ __forceinline__ void p4_delta_seq(Frame& F, int sid) {
    const int lane = F.lane, wave = F.wave, tid = F.tid;
    const int bh = sid >> 1, half = sid & 1, b = bh >> 2, h = bh & 3;
    const int fr = lane & 15, fq = lane >> 4;
    const int v0 = half * 64 + (wave & 3) * 16;
    const unsigned char* cbase = F.ws + WS_CHK + (size_t)(bh * 128) * CHK_STRIDE;
    if (wave >= 4) {
        const int lt = tid - 256;
        v4u RA[14], RB[14];
#define SEQ_LD(R, blk) do { const unsigned char* _b = (blk); _Pragma("unroll") for (int _i = 0; _i < 14; ++_i) asm volatile("global_load_dwordx4 %0, %1, off" : "=v"(R[_i]) : "v"(_b + (size_t)(lt + 256 * _i) * 16) : "memory"); } while (0)
#define SEQ_WAIT(younger) do { if (younger) asm volatile("s_waitcnt vmcnt(14)" ::: "memory"); else asm volatile("s_waitcnt vmcnt(0)" ::: "memory"); } while (0)
        SEQ_LD(RA, cbase); SEQ_LD(RB, cbase + CHK_STRIDE); SEQ_WAIT(true); seq_write(F.lds, RA, lt); SEQ_LD(RA, cbase + 2 * CHK_STRIDE);
        SEQ_BAR();
#pragma unroll 1
        for (int n = 0; n < 128; n += 2) {
            if (n + 1 < 128) { SEQ_WAIT(n + 2 < 128); seq_write(F.lds + ((n + 1) & 1) * SQ_BUF, RB, lt); } if (n + 3 < 128) SEQ_LD(RB, cbase + (size_t)(n + 3) * CHK_STRIDE);
            SEQ_BAR();
            if (n + 2 < 128) { SEQ_WAIT(n + 3 < 128); seq_write(F.lds + (n & 1) * SQ_BUF, RA, lt); } if (n + 4 < 128) SEQ_LD(RA, cbase + (size_t)(n + 4) * CHK_STRIDE);
            SEQ_BAR();
        }
        asm volatile("s_waitcnt vmcnt(0)" ::: "memory");
#undef SEQ_LD
#undef SEQ_WAIT
    } else {
        float* OD = WSP(float, WS_ODELTA);
        f32x4 Sacc[8], Ucur[4], Unxt[4]; float glc, gln;
#pragma unroll
        for (int T = 0; T < 8; ++T) Sacc[T] = (f32x4){0.f, 0.f, 0.f, 0.f};
#pragma unroll
        for (int tc = 0; tc < 4; ++tc) { Ucur[tc] = *(const f32x4*)((const float*)(cbase + CHK_UT) + (size_t)(v0 + fr) * 64 + 4 * fq + 16 * tc);
                                          Unxt[tc] = *(const f32x4*)((const float*)(cbase + CHK_STRIDE + CHK_UT) + (size_t)(v0 + fr) * 64 + 4 * fq + 16 * tc); }
        glc = *(const float*)(cbase + CHK_GL); gln = *(const float*)(cbase + CHK_STRIDE + CHK_GL);
        SEQ_BAR();
#pragma unroll 1
        for (int n = 0; n < 128; ++n) {
            seq_compute(F.lds + (n & 1) * SQ_BUF, Sacc, Ucur, glc, OD + (size_t)(b * SEQ + n * 64 + 4 * fq) * 512 + h * 128 + v0 + fr, fr, fq);
#pragma unroll
            for (int tc = 0; tc < 4; ++tc) Ucur[tc] = Unxt[tc];
            glc = gln;
            if (n + 2 < 128) { const unsigned char* nb = cbase + (size_t)(n + 2) * CHK_STRIDE; gln = *(const float*)(nb + CHK_GL);
#pragma unroll
                for (int tc = 0; tc < 4; ++tc) Unxt[tc] = *(const f32x4*)((const float*)(nb + CHK_UT) + (size_t)(v0 + fr) * 64 + 4 * fq + 16 * tc); }
            SEQ_BAR();
        }
    }
}
#undef SEQ_BAR

__device__ __forceinline__ void p4_indexer(Frame& F, int widx, int nw) {
    const int lane = F.lane, fr = lane & 15, fq = lane >> 4;
    const bf16* QL = WSP(bf16, WS_QL); const bf16* KI = WSP(bf16, WS_KIDX); const float* WI = WSP(float, WS_WIDX); float* SC = WSP(float, WS_BIG);
    for (int task = widx; task < 2 * 4352; task += nw) {
        const int b = task / 4352; int tau = task - b * 4352;
        int g = 0; while (16 * (g + 1) * (g + 2) <= tau) ++g;
        tau -= 16 * g * (g + 1);
        const int qt = 32 * g + tau / (g + 1), seg = tau % (g + 1);
        const int row0 = b * SEQ + 16 * qt;
        bf16x8 Qf[8][2];
#pragma unroll
        for (int hh = 0; hh < 8; ++hh)
#pragma unroll
            for (int s = 0; s < 2; ++s) Qf[hh][s] = *(const bf16x8*)(QL + (size_t)(row0 + fr) * 1536 + 1024 + hh * 64 + 32 * s + 8 * fq);
        f32x4 wv[4][2];
#pragma unroll
        for (int j = 0; j < 4; ++j) { wv[j][0] = *(const f32x4*)(WI + (size_t)(row0 + 4 * fq + j) * 8); wv[j][1] = *(const f32x4*)(WI + (size_t)(row0 + 4 * fq + j) * 8 + 4); }
        const int kt1 = (32 * seg + 31 < qt) ? 32 * seg + 31 : qt;
        for (int kb8 = 32 * seg; kb8 <= kt1; kb8 += 8) {
            bf16x8 kfr[8][2];
#pragma unroll
            for (int x = 0; x < 8; ++x) { const int kt = (kb8 + x <= kt1) ? kb8 + x : kt1; const bf16* kp = KI + (size_t)(b * SEQ + 16 * kt + fr) * 64 + 8 * fq; kfr[x][0] = *(const bf16x8*)kp; kfr[x][1] = *(const bf16x8*)(kp + 32); }
#pragma unroll
            for (int x = 0; x < 8; ++x) {
                const int kt = kb8 + x;
                if (kt <= kt1) {
                    f32x4 isc = (f32x4){0.f, 0.f, 0.f, 0.f};
#pragma unroll
                    for (int hh = 0; hh < 8; ++hh) {
                        f32x4 c = __builtin_amdgcn_mfma_f32_16x16x32_bf16(Qf[hh][0], kfr[x][0], (f32x4){0.f, 0.f, 0.f, 0.f}, 0, 0, 0);
                        c = __builtin_amdgcn_mfma_f32_16x16x32_bf16(Qf[hh][1], kfr[x][1], c, 0, 0, 0);
#pragma unroll
                        for (int j = 0; j < 4; ++j) isc[j] += fmaxf(c[j], 0.f) * wv[j][hh >> 2][hh & 3];
                    }
                    float* sp = SC + (size_t)(row0 + 4 * fq) * 8192 + 16 * kt + fr;
#pragma unroll
                    for (int j = 0; j < 4; ++j) sp[(size_t)j * 8192] = isc[j];
                }
            }
        }
    }
}

__device__ __forceinline__ unsigned long long mask_ge(unsigned x, unsigned t) { unsigned long long m; asm("v_cmp_ge_u32_e64 %0, %1, %2" : "=s"(m) : "v"(x), "s"(t)); return m; }
__device__ __forceinline__ void mask_ge8(unsigned long long (&m)[8], unsigned x0, unsigned x1, unsigned x2, unsigned x3, unsigned x4, unsigned x5, unsigned x6, unsigned x7, unsigned t) {
    asm("v_cmp_ge_u32_e64 %0, %8, %16\n\tv_cmp_ge_u32_e64 %1, %9, %16\n\tv_cmp_ge_u32_e64 %2, %10, %16\n\tv_cmp_ge_u32_e64 %3, %11, %16\n\t"
        "v_cmp_ge_u32_e64 %4, %12, %16\n\tv_cmp_ge_u32_e64 %5, %13, %16\n\tv_cmp_ge_u32_e64 %6, %14, %16\n\tv_cmp_ge_u32_e64 %7, %15, %16"
        : "=&s"(m[0]), "=&s"(m[1]), "=&s"(m[2]), "=&s"(m[3]), "=&s"(m[4]), "=&s"(m[5]), "=&s"(m[6]), "=&s"(m[7])
        : "v"(x0), "v"(x1), "v"(x2), "v"(x3), "v"(x4), "v"(x5), "v"(x6), "v"(x7), "s"(t));
}
__device__ __forceinline__ unsigned long long mask_eq(unsigned x, unsigned t) { unsigned long long m; asm("v_cmp_eq_u32_e64 %0, %1, %2" : "=s"(m) : "v"(x), "s"(t)); return m; }
__device__ __forceinline__ unsigned tk_key(float f) { const unsigned b = __float_as_uint(f); return (b & 0x80000000u) ? ~b : (b | 0x80000000u); }
__device__ __forceinline__ void topk_row_slow(const float* sr, const int n, const int lane, LAS int* sel) {
    const int nseg = (n + 63) >> 6;
    unsigned T = 0u;
    for (int bit = 31; bit >= 0; --bit) {
        const unsigned cnd = T | (1u << bit); int c = 0;
        for (int sg = 0; sg < nseg; ++sg) { const int idx = sg * 64 + lane; const unsigned x = (idx < n) ? tk_key(sr[idx < n ? idx : 0]) : 0u; c += __popcll(__ballot(x >= cnd)); }
        if (c >= 256) T = cnd;
    }
    int cgt = 0;
    for (int sg = 0; sg < nseg; ++sg) { const int idx = sg * 64 + lane; const unsigned x = (idx < n) ? tk_key(sr[idx < n ? idx : 0]) : 0u; cgt += __popcll(__ballot(x > T)); }
    const int need_eq = 256 - cgt; int running = 0, eq_taken = 0;
    const unsigned long long lt = (1ull << lane) - 1ull;
    for (int sg = 0; sg < nseg; ++sg) {
        const int idx = sg * 64 + lane; const unsigned x = (idx < n) ? tk_key(sr[idx < n ? idx : 0]) : 0u;
        const bool gt = x > T, eq = x == T;
        const unsigned long long meq = __ballot(eq);
        const bool take = gt || (eq && (eq_taken + __popcll(meq & lt)) < need_eq);
        const unsigned long long mt = __ballot(take);
        if (take) sel[running + __popcll(mt & lt)] = idx;
        running += __popcll(mt); eq_taken += __popcll(meq);
    }
}
constexpr int TK_CAP = 832;
__device__ __forceinline__ int topk_row(Frame& F, const int row, LAS int* sel, LAS unsigned long long* cand) {
    const int lane = F.lane;
    const float* SC = WSP(float, WS_BIG);
    {
        const int pos = row & (SEQ - 1), n = pos + 1;
        if (n <= 256) {
#pragma unroll
            for (int i = 0; i < 4; ++i) { const int j = 64 * i + lane; sel[j] = (j < n) ? j : 0; }
            return n;
        }
        const int nblk = (n + 1023) >> 10;
        const float* sr = SC + (size_t)row * 8192;
        int lane_l = lane; asm volatile("" : "+v"(lane_l));
        unsigned u[128];
#pragma unroll
        for (int i = 0; i < 64; ++i) u[i] = __float_as_uint((sr + (i >> 4) * 1024)[(i & 15) * 64 + lane_l]);
        if (nblk > 4) {
#pragma unroll
            for (int i = 64; i < 128; ++i) u[i] = __float_as_uint((sr + (i >> 4) * 1024)[(i & 15) * 64 + lane_l]);
        } else {
#pragma unroll
            for (int i = 64; i < 128; ++i) u[i] = 0u;
        }
        asm volatile("" ::: "memory");
#pragma unroll
        for (int i = 0; i < 128; ++i) { const int lim = n - i * 64; const unsigned bits = u[i];
            const unsigned x = (bits & 0x80000000u) ? ~bits : (bits | 0x80000000u);
            u[i] = (lane < lim) ? x : 0u; }
        const unsigned long long ltmask_s = (1ull << lane) - 1ull;
        bool done = false;
        {
            int ns = 0;
#pragma unroll
            for (int k = 0; k < 16; ++k) { int v = n - 512 * k; v = v < 0 ? 0 : (v > 64 ? 64 : v); ns += v; }
            const float mean = 256.0f * (float)ns / (float)n;
            const int rs = (int)(mean + 4.0f * sqrtf(mean) + 5.0f);
            unsigned Ts = 0u;
            for (int bit = 31; bit >= 16; --bit) {
                const unsigned cnd = Ts | (1u << bit); unsigned long long m0[8], m1[8];
                mask_ge8(m0, u[0], u[8], u[16], u[24], u[32], u[40], u[48], u[56], cnd); mask_ge8(m1, u[64], u[72], u[80], u[88], u[96], u[104], u[112], u[120], cnd);
                int c = 0;
#pragma unroll
                for (int i = 0; i < 8; ++i) c += __popcll(m0[i]) + __popcll(m1[i]);
                if (c >= rs) Ts = cnd;
            }
            if (Ts == 0u) Ts = 1u;
            int nc = 0;
#pragma unroll
            for (int bk = 0; bk < 8; ++bk) {
                if (bk < nblk) {
#pragma unroll
                    for (int g8 = 0; g8 < 2; ++g8) {
                        unsigned long long mg[8]; const int b0 = bk * 16 + g8 * 8;
                        mask_ge8(mg, u[b0], u[b0 + 1], u[b0 + 2], u[b0 + 3], u[b0 + 4], u[b0 + 5], u[b0 + 6], u[b0 + 7], Ts);
#pragma unroll
                        for (int i = 0; i < 8; ++i) {
                            const unsigned long long mt = mg[i];
                            if (mt != 0ull) {
                                const int off = nc + __popcll(mt & ltmask_s);
                                if (((mt >> lane) & 1ull) && off < TK_CAP) cand[off] = ((unsigned long long)u[b0 + i] << 32) | (unsigned)((b0 + i) * 64 + lane_l);
                                nc += __popcll(mt);
                            }
                        }
                    }
                }
            }
            if (nc >= 256 && nc <= TK_CAP) {
                unsigned ck[16]; int ci[13];
#pragma unroll
                for (int t = 0; t < 13; ++t) { const int j = lane + 64 * t; const unsigned long long e = (j < nc) ? cand[j] : 0ull; ck[t] = (unsigned)(e >> 32); ci[t] = (int)(unsigned)e; }
                ck[13] = 0u; ck[14] = 0u; ck[15] = 0u;
                unsigned T = 0u;
                for (int bit = 31; bit >= 0; --bit) {
                    const unsigned cnd = T | (1u << bit); unsigned long long m0[8], m1[8];
                    mask_ge8(m0, ck[0], ck[1], ck[2], ck[3], ck[4], ck[5], ck[6], ck[7], cnd); mask_ge8(m1, ck[8], ck[9], ck[10], ck[11], ck[12], ck[13], ck[14], ck[15], cnd);
                    int c = 0;
#pragma unroll
                    for (int i = 0; i < 8; ++i) c += __popcll(m0[i]) + __popcll(m1[i]);
                    if (c >= 256) T = cnd;
                }
                unsigned long long g0[8], g1[8], h0[8], h1[8];
                mask_ge8(g0, ck[0], ck[1], ck[2], ck[3], ck[4], ck[5], ck[6], ck[7], T); mask_ge8(g1, ck[8], ck[9], ck[10], ck[11], ck[12], ck[13], ck[14], ck[15], T);
                mask_ge8(h0, ck[0], ck[1], ck[2], ck[3], ck[4], ck[5], ck[6], ck[7], T + 1u); mask_ge8(h1, ck[8], ck[9], ck[10], ck[11], ck[12], ck[13], ck[14], ck[15], T + 1u);
                int cgt = 0;
#pragma unroll
                for (int t = 0; t < 13; ++t) cgt += __popcll(t < 8 ? h0[t & 7] : h1[t & 7]);
                const int need_eq = 256 - cgt;
                int running = 0, eq_taken = 0;
#pragma unroll
                for (int t = 0; t < 13; ++t) {
                    const unsigned long long mge = (t < 8 ? g0[t & 7] : g1[t & 7]), mgt = (t < 8 ? h0[t & 7] : h1[t & 7]);
                    unsigned long long mt = mge; const unsigned long long me = mge & ~mgt;
                    if (me != 0ull) {
                        const int room = need_eq - eq_taken; unsigned long long keep = 0ull, rest = me;
                        for (int k = 0; k < room && rest != 0ull; ++k) { const unsigned long long low = rest & (~rest + 1ull); keep |= low; rest ^= low; }
                        mt = (mge & ~me) | keep; eq_taken += __popcll(me);
                    }
                    if (mt != 0ull) { if ((mt >> lane) & 1ull) sel[running + __popcll(mt & ltmask_s)] = ci[t]; running += __popcll(mt); }
                }
                done = true;
            }
        }
        if (!done) topk_row_slow(sr, n, lane, sel);
    }
    return 256;
}

__device__ __forceinline__ void p6_sparse_attn(Frame& F) {
    const int lane = F.lane, gw = F.bid * NWAVES + F.wave, NGW = F.G * NWAVES;
    LAS float* ql = (LAS float*)(F.lds + F.wave * 12288);
    LAS float* pp = ql + 1024;
    const bf16* QL = WSP(bf16, WS_QL); const bf16* CKV = WSP(bf16, WS_CKV); const int* SEL = WSP(int, WS_SEL); const int* NSEL = WSP(int, WS_NSEL); bf16* AO = WSP(bf16, WS_AO);
    for (int row = gw; row < M; row += NGW) {
        const int b = row >> 13, n = NSEL[row];
        const int* sel = SEL + (size_t)row * 256;
        {
            float f[8];
            unpack8(*(const v4u*)(QL + (size_t)row * 1536 + 8 * lane), f);
#pragma unroll
            for (int x = 0; x < 8; ++x) ql[8 * lane + x] = f[x];
            unpack8(*(const v4u*)(QL + (size_t)row * 1536 + 512 + 8 * lane), f);
#pragma unroll
            for (int x = 0; x < 8; ++x) ql[512 + 8 * lane + x] = f[x];
        }
        float s[4][8];
#pragma unroll
        for (int kb = 0; kb < 4; ++kb) {
            const int j = 64 * kb + lane; const bool valid = j < n; const int key = valid ? sel[j] : 0;
            const bf16* kr = CKV + (size_t)(b * SEQ + key) * 128;
#pragma unroll
            for (int hh = 0; hh < 8; ++hh) s[kb][hh] = 0.f;
#pragma unroll 4
            for (int r8 = 0; r8 < 16; ++r8) {
                float x[8]; unpack8(*(const v4u*)(kr + 8 * r8), x);
#pragma unroll
                for (int hh = 0; hh < 8; ++hh) { const f32x4 q0 = *(const LAS f32x4*)(ql + hh * 128 + 8 * r8), q1 = *(const LAS f32x4*)(ql + hh * 128 + 8 * r8 + 4);
                    s[kb][hh] += x[0] * q0[0] + x[1] * q0[1] + x[2] * q0[2] + x[3] * q0[3] + x[4] * q1[0] + x[5] * q1[1] + x[6] * q1[2] + x[7] * q1[3]; }
            }
            if (!valid) {
#pragma unroll
                for (int hh = 0; hh < 8; ++hh) s[kb][hh] = -INFINITY;
            }
        }
#pragma unroll
        for (int hh = 0; hh < 8; ++hh) {
            const float mx = wave_max(fmaxf(fmaxf(s[0][hh], s[1][hh]), fmaxf(s[2][hh], s[3][hh])));
            float e[4], l = 0.f;
#pragma unroll
            for (int kb = 0; kb < 4; ++kb) { e[kb] = __expf(s[kb][hh] - mx); l += e[kb]; }
            const float inv = 1.0f / wave_sum(l);
#pragma unroll
            for (int kb = 0; kb < 4; ++kb) pp[(64 * kb + lane) * 8 + hh] = e[kb] * inv;
        }
        float o[8][2];
#pragma unroll
        for (int hh = 0; hh < 8; ++hh) { o[hh][0] = 0.f; o[hh][1] = 0.f; }
        for (int j = 0; j < n; ++j) {
            const int key = sel[j];
            const unsigned kv = *(const unsigned*)(CKV + (size_t)(b * SEQ + key) * 128 + 2 * lane);
            const float lo = bflo(kv), hi = bfhi(kv);
            const f32x4 p0 = *(const LAS f32x4*)(pp + j * 8), p1 = *(const LAS f32x4*)(pp + j * 8 + 4);
#pragma unroll
            for (int hh = 0; hh < 4; ++hh) { o[hh][0] += p0[hh] * lo; o[hh][1] += p0[hh] * hi; o[4 + hh][0] += p1[hh] * lo; o[4 + hh][1] += p1[hh] * hi; }
        }
#pragma unroll
        for (int hh = 0; hh < 8; ++hh) *(unsigned*)(AO + (size_t)row * 1536 + hh * 128 + 2 * lane) = pk2(o[hh][0], o[hh][1]);
    }
}
__device__ __forceinline__ void p6_gdn_out(Frame& F, KArgs A) {
    const int lane = F.lane, gw = F.bid * NWAVES + F.wave, NGW = F.G * NWAVES;
    const f32x4 g0 = *(const f32x4*)(A->in[I_AB_ONG] + 8 * (lane & 15)), g1 = *(const f32x4*)(A->in[I_AB_ONG] + 8 * (lane & 15) + 4);
    for (int row = gw; row < M; row += NGW) {
        const float* op = WSP(float, WS_ODELTA) + (size_t)row * 512 + 8 * lane;
        const f32x4 a = *(const f32x4*)op, b = *(const f32x4*)(op + 4);
        float ss = a[0] * a[0] + a[1] * a[1] + a[2] * a[2] + a[3] * a[3] + b[0] * b[0] + b[1] * b[1] + b[2] * b[2] + b[3] * b[3];
        ss += __shfl_xor(ss, 1); ss += __shfl_xor(ss, 2); ss += __shfl_xor(ss, 4); ss += __shfl_xor(ss, 8);
        const float r = rsqrtf(ss * (1.0f / 128.0f) + 1e-6f);
        float z[8]; unpack8(*(const v4u*)(WSP(bf16, WS_QKVZ) + (size_t)row * 2048 + 1536 + 8 * lane), z);
        float o[8];
#pragma unroll
        for (int i = 0; i < 4; ++i) { o[i] = a[i] * r * g0[i] * siluf(z[i]); o[4 + i] = b[i] * r * g1[i] * siluf(z[4 + i]); }
        *(v4u*)(WSP(bf16, WS_AO) + (size_t)row * 1536 + 1024 + 8 * lane) = pack8f(o);
    }
}

__device__ __forceinline__ void p8_ln_router(Frame& F, KArgs A, int l, float* HOUT, bf16* HB) {
    const int lane = F.lane, tid = F.tid, gw = F.bid * NWAVES + F.wave, NGW = F.G * NWAVES;
    LAS float* wT = (LAS float*)(F.lds);
    LAS float* lg = (LAS float*)(F.lds + WSCR_OFF + F.wave * WSCR_BYTES);
    const float* rw = A->in[I_RW] + (size_t)l * 1024 * 32;
    {
        f32x4 wv[16];
#pragma unroll
        for (int j = 0; j < 16; ++j) wv[j] = *(const f32x4*)(rw + (size_t)(tid + NTHREADS * j) * 4);
#pragma unroll
        for (int j = 0; j < 16; ++j) { const int i4 = tid + NTHREADS * j, k = i4 >> 3, e0 = (i4 & 7) * 4;
            wT[(e0 + 0) * 1028 + k] = wv[j][0]; wT[(e0 + 1) * 1028 + k] = wv[j][1]; wT[(e0 + 2) * 1028 + k] = wv[j][2]; wT[(e0 + 3) * 1028 + k] = wv[j][3]; }
    }
    __syncthreads();
    const float* PRE = WSP(float, WS_PRE);
    const float* lg_g = A->in[I_LNM_G] + (size_t)l * 1024; const float* lg_b = A->in[I_LNM_B] + (size_t)l * 1024;
    const float rb = A->in[I_RB][l * 32 + (lane & 31)];
    int* TOKE = WSP(int, WS_ROUTE); int* TOKPOS = TOKE + M * 4; float* TOKG = (float*)(TOKPOS + M * 4);
    gu32* cnt = F.ctl + CW_CNT + 64 * 32 * l;
    LAS int* lcnt = (LAS int*)(F.lds + MISC_OFF + 512);
    LAS int* lbase = lcnt + 32;
    LAS int* myrt = (LAS int*)(F.lds + WSCR_OFF + F.wave * WSCR_BYTES + 128);
    if (tid < 32) lcnt[tid] = 0;
    __syncthreads();
    int nrow = 0;
    f32x4 lng[4], lnb[4];
#pragma unroll
    for (int j = 0; j < 4; ++j) { lng[j] = *(const f32x4*)(lg_g + 256 * j + 4 * lane); lnb[j] = *(const f32x4*)(lg_b + 256 * j + 4 * lane); }
    for (int row = gw; row < M; row += NGW) {
        f32x4 v[4]; float s = 0.f;
#pragma unroll
        for (int j = 0; j < 4; ++j) { v[j] = *(const f32x4*)(PRE + (size_t)row * 1024 + 256 * j + 4 * lane); s += (v[j][0] + v[j][1]) + (v[j][2] + v[j][3]); }
        const float mean = wave_sum(s) * (1.0f / 1024.0f); float s2 = 0.f;
#pragma unroll
        for (int j = 0; j < 4; ++j) { v[j] = v[j] - mean; s2 += (v[j][0] * v[j][0] + v[j][1] * v[j][1]) + (v[j][2] * v[j][2] + v[j][3] * v[j][3]); }
        const float rstd = rsqrtf(wave_sum(s2) * (1.0f / 1024.0f) + 1e-5f);
#pragma unroll
        for (int j = 0; j < 4; ++j) {
            v[j] = v[j] * rstd * lng[j] + lnb[j];
            *(f32x4*)(HOUT + (size_t)row * 1024 + 256 * j + 4 * lane) = v[j];
            v2u o; o.x = pk2(v[j][0], v[j][1]); o.y = pk2(v[j][2], v[j][3]); *(v2u*)(HB + (size_t)row * 1024 + 256 * j + 4 * lane) = o;
        }
        float part[32];
#pragma unroll
        for (int e = 0; e < 32; ++e) {
            float a = 0.f;
#pragma unroll
            for (int j = 0; j < 4; ++j) { const f32x4 w = *(const LAS f32x4*)(wT + e * 1028 + 256 * j + 4 * lane); a += v[j][0] * w[0] + v[j][1] * w[1] + v[j][2] * w[2] + v[j][3] * w[3]; }
            part[e] = a;
        }
#pragma unroll
        for (int i = 0; i < 16; ++i) { const bool up = (lane & 32) != 0; const float keep = up ? part[i + 16] : part[i], send = up ? part[i] : part[i + 16]; part[i] = keep + __shfl_xor(send, 32); }
#pragma unroll
        for (int i = 0; i < 8; ++i) { const bool up = (lane & 16) != 0; const float keep = up ? part[i + 8] : part[i], send = up ? part[i] : part[i + 8]; part[i] = keep + __shfl_xor(send, 16); }
#pragma unroll
        for (int i = 0; i < 4; ++i) { const bool up = (lane & 8) != 0; const float keep = up ? part[i + 4] : part[i], send = up ? part[i] : part[i + 4]; part[i] = keep + __shfl_xor(send, 8); }
#pragma unroll
        for (int i = 0; i < 2; ++i) { const bool up = (lane & 4) != 0; const float keep = up ? part[i + 2] : part[i], send = up ? part[i] : part[i + 2]; part[i] = keep + __shfl_xor(send, 4); }
        { const bool up = (lane & 2) != 0; const float keep = up ? part[1] : part[0], send = up ? part[0] : part[1]; part[0] = keep + __shfl_xor(send, 2); }
        part[0] += __shfl_xor(part[0], 1);
        const int eidx = ((lane >> 5) & 1) * 16 + ((lane >> 4) & 1) * 8 + ((lane >> 3) & 1) * 4 + ((lane >> 2) & 1) * 2 + ((lane >> 1) & 1);
        if ((lane & 1) == 0) lg[eidx] = part[0];
        float val = (lane < 32) ? lg[lane & 31] + rb : -INFINITY;
        float tl[4]; int te[4];
#pragma unroll
        for (int k = 0; k < 4; ++k) {
            const float mx = wave_max(val);
            const unsigned long long mm = __ballot(val == mx && lane < 32);
            const int idx = __ffsll((long long)mm) - 1;
            tl[k] = mx; te[k] = idx;
            if (lane == idx) val = -INFINITY;
        }
        const float e1 = __expf(tl[1] - tl[0]), e2 = __expf(tl[2] - tl[0]), e3 = __expf(tl[3] - tl[0]);
        const float inv = 1.0f / (1.0f + e1 + e2 + e3);
        if (lane < 4) {
            const int e = lane == 0 ? te[0] : (lane == 1 ? te[1] : (lane == 2 ? te[2] : te[3]));
            const float g = (lane == 0 ? 1.0f : (lane == 1 ? e1 : (lane == 2 ? e2 : e3))) * inv;
            const int lp = __hip_atomic_fetch_add(lcnt + e, 1, __ATOMIC_RELAXED, __HIP_MEMORY_SCOPE_WORKGROUP);
            LAS int* rt = myrt + (nrow * 4 + lane) * 3; rt[0] = e; rt[1] = lp; rt[2] = __float_as_int(g);
        }
        ++nrow;
    }
    __syncthreads();
    if (tid < 32) lbase[tid] = (int)__hip_atomic_fetch_add(cnt + 64 * tid, (unsigned)lcnt[tid], RLX_AGENT);
    __syncthreads();
    if (lane < 4) {
        int j = 0;
        for (int row = gw; row < M; row += NGW, ++j) {
            const LAS int* rt = myrt + (j * 4 + lane) * 3; const int e = rt[0];
            TOKE[(size_t)row * 4 + lane] = e; TOKPOS[(size_t)row * 4 + lane] = lbase[e] + rt[1]; TOKG[(size_t)row * 4 + lane] = __int_as_float(rt[2]);
        }
    }
}

__device__ __forceinline__ void p9_scatter(Frame& F, int l, const bf16* HB, const float* HF) {
    const int lane = F.lane, tid = F.tid, gw = F.bid * NWAVES + F.wave, NGW = F.G * NWAVES;
    LAS int* base = (LAS int*)(F.lds + MISC_OFF + 256);
    int* TOKE = WSP(int, WS_ROUTE); int* TOKPOS = TOKE + M * 4; int* TILE = TOKE + 3 * M * 4;
    if (tid < 32) base[tid] = (int)__hip_atomic_load(F.ctl + CW_CNT + 64 * (32 * l + tid), RLX_AGENT);
    __syncthreads();
    if (tid == 0) {
        int acc = 0;
        for (int e = 0; e < NEXP; ++e) { const int c = base[e]; base[e] = acc; acc += ((c + 255) >> 8) << 8; }
        base[32] = acc >> 8;
    }
    __syncthreads();
    if (F.bid == 0 && tid < 64) {
        const int nT = base[32];
        for (int t = tid; t < NTMAX; t += 64) { int e = 0;
            for (int x = 1; x < NEXP; ++x) if (base[x] <= t * 256) e = x;
            TILE[t] = (t < nT) ? e : 0; }
        if (tid == 0) TILE[NTMAX] = nT;
    }
    bf16* XS = WSP(bf16, WS_XS);
    if (kMoeFp8) {
        unsigned char* XB8 = WSP(unsigned char, WS_XS);
        for (int row = gw; row < M; row += NGW) {
            const float* hp = HF + (size_t)row * 1024 + 16 * lane; v4u o;
#pragma unroll
            for (int q = 0; q < 4; ++q) { const f32x4 v = *(const f32x4*)(hp + 4 * q); unsigned w = 0u; w = __builtin_amdgcn_cvt_pk_fp8_f32(v[0], v[1], w, false); w = __builtin_amdgcn_cvt_pk_fp8_f32(v[2], v[3], w, true); o[q] = w; }
#pragma unroll
            for (int k = 0; k < 4; ++k) { const int slot = base[TOKE[(size_t)row * 4 + k]] + TOKPOS[(size_t)row * 4 + k]; *(v4u*)(XB8 + (size_t)slot * 1024 + 16 * lane) = o; }
        }
        return;
    }
    for (int row = gw; row < M; row += NGW) {
        const v4u a = *(const v4u*)(HB + (size_t)row * 1024 + 8 * lane), b = *(const v4u*)(HB + (size_t)row * 1024 + 512 + 8 * lane);
#pragma unroll
        for (int k = 0; k < 4; ++k) {
            const int slot = base[TOKE[(size_t)row * 4 + k]] + TOKPOS[(size_t)row * 4 + k];
            *(v4u*)(XS + (size_t)slot * 1024 + 8 * lane) = a; *(v4u*)(XS + (size_t)slot * 1024 + 512 + 8 * lane) = b;
        }
    }
}

__device__ __forceinline__ void p12_combine(Frame& F, KArgs A, int l, const float* HIN, float* HOUT, bf16* HB) {
    const int lane = F.lane, tid = F.tid, gw = F.bid * NWAVES + F.wave, NGW = F.G * NWAVES;
    LAS int* base = (LAS int*)(F.lds + MISC_OFF + 256);
    if (tid < 32) base[tid] = (int)__hip_atomic_load(F.ctl + CW_CNT + 64 * (32 * l + tid), RLX_AGENT);
    __syncthreads();
    if (tid == 0) { int acc = 0; for (int e = 0; e < NEXP; ++e) { const int c = base[e]; base[e] = acc; acc += ((c + 255) >> 8) << 8; } }
    __syncthreads();
    const int* TOKE = WSP(int, WS_ROUTE); const int* TOKPOS = TOKE + M * 4; const float* TOKG = (const float*)(TOKPOS + M * 4);
    const bf16* YS = WSP(bf16, WS_YS); const bf16* PLE = WSP(bf16, WS_PLE);
    const float* lg_g = A->in[I_LNF_G] + (size_t)l * 1024; const float* lg_b = A->in[I_LNF_B] + (size_t)l * 1024;
    f32x4 lng[2][2], lnb[2][2];
#pragma unroll
    for (int hf = 0; hf < 2; ++hf) { const int c0 = 512 * hf + 8 * lane; lng[hf][0] = *(const f32x4*)(lg_g + c0); lng[hf][1] = *(const f32x4*)(lg_g + c0 + 4); lnb[hf][0] = *(const f32x4*)(lg_b + c0); lnb[hf][1] = *(const f32x4*)(lg_b + c0 + 4); }
    for (int row = gw; row < M; row += NGW) {
        float x[16];
        {   const f32x4 h0 = *(const f32x4*)(HIN + (size_t)row * 1024 + 8 * lane), h1 = *(const f32x4*)(HIN + (size_t)row * 1024 + 8 * lane + 4);
            const f32x4 h2 = *(const f32x4*)(HIN + (size_t)row * 1024 + 512 + 8 * lane), h3 = *(const f32x4*)(HIN + (size_t)row * 1024 + 512 + 8 * lane + 4);
            float p0[8], p1[8]; unpack8(*(const v4u*)(PLE + (size_t)row * 1024 + 8 * lane), p0); unpack8(*(const v4u*)(PLE + (size_t)row * 1024 + 512 + 8 * lane), p1);
#pragma unroll
            for (int i = 0; i < 4; ++i) { x[i] = ALPHA * h0[i] + p0[i]; x[4 + i] = ALPHA * h1[i] + p0[4 + i]; x[8 + i] = ALPHA * h2[i] + p1[i]; x[12 + i] = ALPHA * h3[i] + p1[4 + i]; }
        }
#pragma unroll
        for (int k = 0; k < 4; ++k) {
            const int slot = base[TOKE[(size_t)row * 4 + k]] + TOKPOS[(size_t)row * 4 + k]; const float g = TOKG[(size_t)row * 4 + k];
            float y0[8], y1[8]; unpack8(*(const v4u*)(YS + (size_t)slot * 1024 + 8 * lane), y0); unpack8(*(const v4u*)(YS + (size_t)slot * 1024 + 512 + 8 * lane), y1);
#pragma unroll
            for (int i = 0; i < 8; ++i) { x[i] += g * y0[i]; x[8 + i] += g * y1[i]; }
        }
        float s = 0.f;
#pragma unroll
        for (int i = 0; i < 16; ++i) s += x[i];
        const float mean = wave_sum(s) * (1.0f / 1024.0f); float s2 = 0.f;
#pragma unroll
        for (int i = 0; i < 16; ++i) { x[i] -= mean; s2 += x[i] * x[i]; }
        const float rstd = rsqrtf(wave_sum(s2) * (1.0f / 1024.0f) + 1e-5f);
#pragma unroll
        for (int hf = 0; hf < 2; ++hf) {
            const int c0 = 512 * hf + 8 * lane;
            const f32x4 g0 = lng[hf][0], g1 = lng[hf][1], b0 = lnb[hf][0], b1 = lnb[hf][1];
            f32x4 o0, o1;
#pragma unroll
            for (int i = 0; i < 4; ++i) { o0[i] = x[8 * hf + i] * rstd * g0[i] + b0[i]; o1[i] = x[8 * hf + 4 + i] * rstd * g1[i] + b1[i]; }
            *(f32x4*)(HOUT + (size_t)row * 1024 + c0) = o0; *(f32x4*)(HOUT + (size_t)row * 1024 + c0 + 4) = o1;
            if (HB) { v4u w; w.x = pk2(o0[0], o0[1]); w.y = pk2(o0[2], o0[3]); w.z = pk2(o1[0], o1[1]); w.w = pk2(o1[2], o1[3]); *(v4u*)(HB + (size_t)row * 1024 + c0) = w; }
        }
    }
}

__device__ __forceinline__ void p14_dilated(Frame& F) {
    const int lane = F.lane, gw = F.bid * NWAVES + F.wave, NGW = F.G * NWAVES;
    LAS float* pe = (LAS float*)(F.lds + F.wave * 2048);
    const bf16* QK = WSP(bf16, WS_QKVZ); bf16* AO = WSP(bf16, WS_AO);
    for (int task = gw; task < M * 12; task += NGW) {
        const int row = task / 12, hh = task - row * 12, b = row >> 13, pos = row & (SEQ - 1);
        float q[64];
#pragma unroll
        for (int c = 0; c < 8; ++c) { float f[8]; unpack8(*(const v4u*)(QK + (size_t)row * 2560 + hh * 64 + 8 * c), f);
#pragma unroll
            for (int x = 0; x < 8; ++x) q[8 * c + x] = f[x]; }
        float s[7];
#pragma unroll
        for (int i = 0; i < 7; ++i) {
            const int e = lane + 64 * i, p = e / 129, m = e - p * 129;
            const int dd = (p == 0) ? 1 : (p == 1 ? 4 : 16);
            const int kpos = pos - m * dd; const bool valid = (e < 387) && (kpos >= 0);
            float a = -INFINITY;
            if (valid) {
                const bf16* kr = QK + (size_t)(b * SEQ + kpos) * 2560 + 768 + hh * 64; a = 0.f;
#pragma unroll
                for (int c = 0; c < 8; ++c) { float f[8]; unpack8(*(const v4u*)(kr + 8 * c), f);
#pragma unroll
                    for (int x = 0; x < 8; ++x) a += q[8 * c + x] * f[x]; }
                a *= 0.125f;
            }
            s[i] = a;
        }
        float mx = s[0];
#pragma unroll
        for (int i = 1; i < 7; ++i) mx = fmaxf(mx, s[i]);
        mx = wave_max(mx);
        float l = 0.f;
#pragma unroll
        for (int i = 0; i < 7; ++i) { const float ev = __expf(s[i] - mx); pe[lane + 64 * i] = ev; l += ev; }
        l = wave_sum(l);
        float o = 0.f;
#pragma unroll
        for (int p = 0; p < 3; ++p) {
            const int dd = (p == 0) ? 1 : (p == 1 ? 4 : 16);
            int mmax = pos / dd; if (mmax > 128) mmax = 128;
            const bf16* vb = QK + (size_t)(b * SEQ + pos) * 2560 + 1536 + hh * 64 + lane;
            for (int m = 0; m <= mmax; ++m) o += pe[p * 129 + m] * bf1(vb[-(ptrdiff_t)m * dd * 2560]);
        }
        AO[(size_t)row * 1024 + hh * 64 + lane] = (bf16)f2bf(o / l);
    }
}
typedef short v4i16_t __attribute__((ext_vector_type(4)));
__device__ __forceinline__ v4i16_t lds_tr16(LAS unsigned char* p) { return __builtin_amdgcn_ds_read_tr16_b64_v4i16((LAS v4i16_t*)p); }
constexpr int DV_PITCH = 144, DV_BUF = 32 * DV_PITCH;
template <int DL  > __device__ __forceinline__ void dil_branch(const bf16* __restrict__ KV, LAS unsigned char* vbuf, const int s0, const int lane,
                                                                                 const bf16x8 (&qf)[2], f32x4 (&O)[4], float& m_run, float& l_run) {
    constexpr int d = 1 << DL, sigma = 16 >> DL, NS = (129 + 15 * sigma + 31) / 32;
    const int fr = lane & 15, fq = lane >> 4;
    const int c = s0 & (d - 1), n0 = s0 >> DL, kstart = n0 - 128;
#define DIL_POS(n) ({ int _p = c + d * (n); _p = _p < 0 ? 0 : (_p > SEQ - 1 ? SEQ - 1 : _p); _p; })
    bf16x8 kf[2][2]; v4u vr[4];
#pragma unroll
    for (int tl = 0; tl < 2; ++tl) { const bf16* kp = KV + (size_t)DIL_POS(kstart + 16 * tl + fr) * 2560 + 768 + 8 * fq; kf[tl][0] = *(const bf16x8*)kp; kf[tl][1] = *(const bf16x8*)(kp + 32); }
#pragma unroll
    for (int i = 0; i < 4; ++i) vr[i] = *(const v4u*)(KV + (size_t)DIL_POS(kstart + (lane >> 3) + 8 * i) * 2560 + 1536 + 8 * (lane & 7));
#pragma unroll 1
    for (int g = 0; g < NS; ++g) {
        LAS unsigned char* vb = vbuf + (g & 1) * DV_BUF;
#pragma unroll
        for (int i = 0; i < 4; ++i) *(LAS v4u*)(vb + ((lane >> 3) + 8 * i) * DV_PITCH + 16 * (lane & 7)) = vr[i];
        bf16x8 kc[2][2];
#pragma unroll
        for (int tl = 0; tl < 2; ++tl) { kc[tl][0] = kf[tl][0]; kc[tl][1] = kf[tl][1]; }
        if (g + 1 < NS) {
            const int kb = kstart + 32 * (g + 1);
#pragma unroll
            for (int tl = 0; tl < 2; ++tl) { const bf16* kp = KV + (size_t)DIL_POS(kb + 16 * tl + fr) * 2560 + 768 + 8 * fq; kf[tl][0] = *(const bf16x8*)kp; kf[tl][1] = *(const bf16x8*)(kp + 32); }
#pragma unroll
            for (int i = 0; i < 4; ++i) vr[i] = *(const v4u*)(KV + (size_t)DIL_POS(kb + (lane >> 3) + 8 * i) * 2560 + 1536 + 8 * (lane & 7));
        }
        float sv[8];
#pragma unroll
        for (int tl = 0; tl < 2; ++tl) {
            f32x4 cc = __builtin_amdgcn_mfma_f32_16x16x32_bf16(kc[tl][0], qf[0], (f32x4){0.f, 0.f, 0.f, 0.f}, 0, 0, 0);
            cc = __builtin_amdgcn_mfma_f32_16x16x32_bf16(kc[tl][1], qf[1], cc, 0, 0, 0);
#pragma unroll
            for (int j = 0; j < 4; ++j) {
                const int rel = 32 * g + 16 * tl + 4 * fq + j;
                const int delta = 128 + sigma * fr - rel;
                const bool ok = (delta >= 0) && (delta <= 128) && (kstart + rel >= 0);
                sv[4 * tl + j] = ok ? cc[j] * 0.125f : -INFINITY;
            }
        }
        float mx = fmaxf(fmaxf(fmaxf(sv[0], sv[1]), fmaxf(sv[2], sv[3])), fmaxf(fmaxf(sv[4], sv[5]), fmaxf(sv[6], sv[7])));
        mx = fmaxf(mx, __shfl_xor(mx, 16)); mx = fmaxf(mx, __shfl_xor(mx, 32));
        const float m_new = fmaxf(m_run, mx);
        if (!__all(m_new == m_run)) {
            const float alpha = __expf(m_run - m_new);
            l_run *= alpha;
#pragma unroll
            for (int j = 0; j < 4; ++j) { const float aj = __shfl(alpha, 4 * fq + j);
#pragma unroll
                for (int dt = 0; dt < 4; ++dt) O[dt][j] *= aj; }
            m_run = m_new;
        }
        float p[8], ps = 0.f;
#pragma unroll
        for (int e = 0; e < 8; ++e) { p[e] = __expf(sv[e] - m_run); ps += p[e]; }
        l_run += ps;
        v4u pw; pw.x = pg8::cvt_pk_bf16(p[0], p[1]); pw.y = pg8::cvt_pk_bf16(p[2], p[3]); pw.z = pg8::cvt_pk_bf16(p[4], p[5]); pw.w = pg8::cvt_pk_bf16(p[6], p[7]);
        const bf16x8 pf = __builtin_bit_cast(bf16x8, pw);
        LAS unsigned char* tb = vb + (4 * fq + ((lane & 15) >> 2)) * DV_PITCH + 8 * (lane & 3);
#pragma unroll
        for (int dt = 0; dt < 4; ++dt) {
            const v4i16_t lo = lds_tr16(tb + 32 * dt), hi = lds_tr16(tb + 16 * DV_PITCH + 32 * dt);
            bf16x8 vf; vf[0] = lo[0]; vf[1] = lo[1]; vf[2] = lo[2]; vf[3] = lo[3]; vf[4] = hi[0]; vf[5] = hi[1]; vf[6] = hi[2]; vf[7] = hi[3];
            O[dt] = __builtin_amdgcn_mfma_f32_16x16x32_bf16(pf, vf, O[dt], 0, 0, 0);
        }
    }
#undef DIL_POS
}
__device__ __forceinline__ void p14_dilated_mfma(Frame& F) {
    const int lane = F.lane, fr = lane & 15, fq = lane >> 4;
    LAS unsigned char* vbuf = F.lds + F.wave * (2 * DV_BUF);
    const bf16* QK = WSP(bf16, WS_QKVZ); bf16* AO = WSP(bf16, WS_AO);
    for (int u = F.bid; u < 24 * 32 * 2; u += F.G) {
        const int bh = u >> 6, blk = (u >> 1) & 31, o = (u & 1) * 8 + F.wave;
        const int b = bh / 12, hh = bh - b * 12, s0 = 256 * blk + o;
        const bf16* KV = QK + (size_t)b * SEQ * 2560 + hh * 64;
        bf16x8 qf[2];
        { const bf16* qp = KV + (size_t)(s0 + 16 * fr) * 2560 + 8 * fq; qf[0] = *(const bf16x8*)qp; qf[1] = *(const bf16x8*)(qp + 32); }
        f32x4 O[4];
#pragma unroll
        for (int dt = 0; dt < 4; ++dt) O[dt] = (f32x4){0.f, 0.f, 0.f, 0.f};
        float m_run = -1e30f, l_run = 0.f;
        dil_branch<4>(KV, vbuf, s0, lane, qf, O, m_run, l_run);
        dil_branch<2>(KV, vbuf, s0, lane, qf, O, m_run, l_run);
        dil_branch<0>(KV, vbuf, s0, lane, qf, O, m_run, l_run);
        float lt = l_run; lt += __shfl_xor(lt, 16); lt += __shfl_xor(lt, 32);
        const float inv = 1.0f / lt;
#pragma unroll
        for (int j = 0; j < 4; ++j) {
            const float ij = __shfl(inv, 4 * fq + j);
            bf16* op = AO + (size_t)(b * SEQ + s0 + 16 * (4 * fq + j)) * 1024 + hh * 64 + fr;
#pragma unroll
            for (int dt = 0; dt < 4; ++dt) op[16 * dt] = (bf16)f2bf(O[dt][j] * ij);
        }
    }
}
constexpr int SA_PITCH = 272, SA_TILE = 32 * SA_PITCH;
__device__ __forceinline__ void sparse_row(Frame& F, const int row, const int n, const LAS int* sel, LAS unsigned char* tile) {
    const int lane = F.lane, fr = lane & 15, fq = lane >> 4;
    const bf16* QL = WSP(bf16, WS_QL); const bf16* CKV = WSP(bf16, WS_CKV); bf16* AO = WSP(bf16, WS_AO);
    {
        const int b = row >> 13;
        const bf16* kvb = CKV + (size_t)b * SEQ * 128;
        bf16x8 qf[4];
#pragma unroll
        for (int s = 0; s < 4; ++s) { const v4u z = (v4u){0u, 0u, 0u, 0u}; qf[s] = (fr < 8) ? *(const bf16x8*)(QL + (size_t)row * 1536 + fr * 128 + 32 * s + 8 * fq) : __builtin_bit_cast(bf16x8, z); }
        f32x4 O[8];
#pragma unroll
        for (int rt = 0; rt < 8; ++rt) O[rt] = (f32x4){0.f, 0.f, 0.f, 0.f};
        float m_run = -1e30f, l_run = 0.f;
        const int nsteps = (n + 31) >> 5;
        v4u vr[8];
        { const int j = lane & 31; const int kidx = (j < n) ? sel[j] : 0;
#pragma unroll
          for (int i = 0; i < 8; ++i) { const int key = __shfl(kidx, (lane >> 4) + 4 * i); vr[i] = *(const v4u*)(kvb + (size_t)key * 128 + 8 * (lane & 15)); } }
#pragma unroll 1
        for (int g = 0; g < nsteps; ++g) {
#pragma unroll
            for (int i = 0; i < 8; ++i) *(LAS v4u*)(tile + ((lane >> 4) + 4 * i) * SA_PITCH + 16 * (lane & 15)) = vr[i];
            if (g + 1 < nsteps) {
                const int j = 32 * (g + 1) + (lane & 31); const int kidx = (j < n) ? sel[j] : 0;
#pragma unroll
                for (int i = 0; i < 8; ++i) { const int key = __shfl(kidx, (lane >> 4) + 4 * i); vr[i] = *(const v4u*)(kvb + (size_t)key * 128 + 8 * (lane & 15)); }
            }
            float sv[8];
#pragma unroll
            for (int tl = 0; tl < 2; ++tl) {
                f32x4 cc = (f32x4){0.f, 0.f, 0.f, 0.f};
#pragma unroll
                for (int s = 0; s < 4; ++s) { const bf16x8 kf = *(const LAS bf16x8*)(tile + (16 * tl + fr) * SA_PITCH + 64 * s + 16 * fq); cc = __builtin_amdgcn_mfma_f32_16x16x32_bf16(kf, qf[s], cc, 0, 0, 0); }
#pragma unroll
                for (int j = 0; j < 4; ++j) sv[4 * tl + j] = (32 * g + 16 * tl + 4 * fq + j < n) ? cc[j] : -INFINITY;
            }
            float mx = fmaxf(fmaxf(fmaxf(sv[0], sv[1]), fmaxf(sv[2], sv[3])), fmaxf(fmaxf(sv[4], sv[5]), fmaxf(sv[6], sv[7])));
            mx = fmaxf(mx, __shfl_xor(mx, 16)); mx = fmaxf(mx, __shfl_xor(mx, 32));
            const float m_new = fmaxf(m_run, mx);
            if (!__all(m_new == m_run)) {
                const float alpha = __expf(m_run - m_new);
                l_run *= alpha;
#pragma unroll
                for (int j = 0; j < 4; ++j) { const float aj = __shfl(alpha, 4 * fq + j);
#pragma unroll
                    for (int rt = 0; rt < 8; ++rt) O[rt][j] *= aj; }
                m_run = m_new;
            }
            float p[8], ps = 0.f;
#pragma unroll
            for (int e = 0; e < 8; ++e) { p[e] = __expf(sv[e] - m_run); ps += p[e]; }
            l_run += ps;
            v4u pw; pw.x = pg8::cvt_pk_bf16(p[0], p[1]); pw.y = pg8::cvt_pk_bf16(p[2], p[3]); pw.z = pg8::cvt_pk_bf16(p[4], p[5]); pw.w = pg8::cvt_pk_bf16(p[6], p[7]);
            const bf16x8 pf = __builtin_bit_cast(bf16x8, pw);
            LAS unsigned char* tb = tile + (4 * fq + ((lane & 15) >> 2)) * SA_PITCH + 8 * (lane & 3);
#pragma unroll
            for (int rt = 0; rt < 8; ++rt) {
                const v4i16_t lo = lds_tr16(tb + 32 * rt), hi = lds_tr16(tb + 16 * SA_PITCH + 32 * rt);
                bf16x8 vf; vf[0] = lo[0]; vf[1] = lo[1]; vf[2] = lo[2]; vf[3] = lo[3]; vf[4] = hi[0]; vf[5] = hi[1]; vf[6] = hi[2]; vf[7] = hi[3];
                O[rt] = __builtin_amdgcn_mfma_f32_16x16x32_bf16(pf, vf, O[rt], 0, 0, 0);
            }
        }
        float lt = l_run; lt += __shfl_xor(lt, 16); lt += __shfl_xor(lt, 32);
        const float inv = 1.0f / lt;
#pragma unroll
        for (int j = 0; j < 4; ++j) {
            const float ij = __shfl(inv, 4 * fq + j);
            if (fq < 2) { bf16* op = AO + (size_t)row * 1536 + (4 * fq + j) * 128 + fr;
#pragma unroll
                for (int rt = 0; rt < 8; ++rt) op[16 * rt] = (bf16)f2bf(O[rt][j] * ij); }
        }
    }
}
__device__ __forceinline__ void p5_topk_attn(Frame& F, const int gw, const int NGW) {
    LAS int* sel = (LAS int*)(F.lds + F.wave * 16384);
    LAS unsigned char* tile = F.lds + F.wave * 16384 + 1024;
    LAS unsigned long long* cand = (LAS unsigned long long*)(F.lds + F.wave * 16384 + 1024 + SA_TILE);
    static_assert(1024 + SA_TILE + TK_CAP * 8 <= 16384, "per-wave LDS");
    for (int rix = gw; rix < M; rix += NGW) {
        const int row = ((rix & 1) ? (M - 1 - (rix >> 1)) : (rix >> 1));
        const int n = __builtin_amdgcn_readfirstlane(topk_row(F, row, sel, cand));
        sparse_row(F, row, n, sel, tile);
    }
}
constexpr int CP_KV_PITCH = 272;
__device__ __forceinline__ void p3_chunk_prep_mfma(Frame& F, KArgs A) {
    int tid = F.tid; asm volatile("" : "+v"(tid));
    const int lane = tid & 63, wave = __builtin_amdgcn_readfirstlane(tid >> 6), fr = lane & 15, fq = lane >> 4;
    LAS unsigned char* kt = F.lds;
    LAS unsigned char* vt = F.lds + 64 * CP_KV_PITCH;
    LAS float* As = (LAS float*)(F.lds + 2 * 64 * CP_KV_PITCH);
    LAS float* Ts = As + 64 * 65;
    LAS float* gcS = Ts + 64 * 68; LAS float* egS = gcS + 64; LAS float* ekS = egS + 64; LAS float* btS = ekS + 64;
    for (int cidx = F.bid; cidx < 1024; cidx += F.G) {
        const int b = cidx >> 9, h = (cidx >> 7) & 3, n = cidx & 127, row0 = b * SEQ + n * 64;
        unsigned char* blk = F.ws + WS_CHK + (size_t)cidx * CHK_STRIDE;
        const bf16* Qg = WSP(bf16, WS_QN) + (size_t)row0 * 512 + h * 128; const bf16* Kg = WSP(bf16, WS_KN) + (size_t)row0 * 512 + h * 128; const bf16* Vg = WSP(bf16, WS_VN) + (size_t)row0 * 512 + h * 128;
        const int ti = wave >> 1;
        float g_in = 0.f, bt_in = 0.f;
        if (tid < 64) { g_in = WSP(float, WS_GG)[(size_t)(row0 + tid) * 4 + h]; bt_in = WSP(float, WS_BETA)[(size_t)(row0 + tid) * 4 + h]; }
        v4u kc[2], vc[2], qc[2];
#pragma unroll
        for (int i = 0; i < 2; ++i) { const int id = tid + 512 * i, r = id >> 4, c = id & 15; kc[i] = *(const v4u*)(Kg + (size_t)r * 512 + 8 * c); vc[i] = *(const v4u*)(Vg + (size_t)r * 512 + 8 * c); qc[i] = *(const v4u*)(Qg + (size_t)r * 512 + 8 * c); }
        bf16x8 ka[4], qa[4], kbf[2][4];
#pragma unroll
        for (int s = 0; s < 4; ++s) { ka[s] = *(const bf16x8*)(Kg + (size_t)(16 * ti + fr) * 512 + 32 * s + 8 * fq); qa[s] = *(const bf16x8*)(Qg + (size_t)(16 * ti + fr) * 512 + 32 * s + 8 * fq);
            kbf[0][s] = *(const bf16x8*)(Kg + (size_t)(16 * (2 * (wave & 1)) + fr) * 512 + 32 * s + 8 * fq); kbf[1][s] = *(const bf16x8*)(Kg + (size_t)(16 * (2 * (wave & 1) + 1) + fr) * 512 + 32 * s + 8 * fq); }
        if (tid < 64) {
            float gc = g_in;
#pragma unroll
            for (int o = 1; o < 64; o <<= 1) { const float t = __shfl_up(gc, o); if (lane >= o) gc += t; }
            const float g63 = __shfl(gc, 63);
            gcS[tid] = gc; egS[tid] = __expf(gc); ekS[tid] = __expf(g63 - gc); btS[tid] = bt_in;
            if (tid == 0) *(float*)(blk + CHK_GL) = __expf(g63);
        }
#pragma unroll
        for (int i = 0; i < 2; ++i) { const int id = tid + 512 * i, r = id >> 4, c = id & 15; *(LAS v4u*)(kt + r * CP_KV_PITCH + 16 * c) = kc[i]; *(LAS v4u*)(vt + r * CP_KV_PITCH + 16 * c) = vc[i]; }
        __syncthreads();
        {
#pragma unroll
            for (int t2 = 0; t2 < 2; ++t2) {
                const int tj = 2 * (wave & 1) + t2;
                f32x4 ck = (f32x4){0.f, 0.f, 0.f, 0.f}, cq = (f32x4){0.f, 0.f, 0.f, 0.f};
#pragma unroll
                for (int s = 0; s < 4; ++s) { ck = __builtin_amdgcn_mfma_f32_16x16x32_bf16(ka[s], kbf[t2][s], ck, 0, 0, 0); cq = __builtin_amdgcn_mfma_f32_16x16x32_bf16(qa[s], kbf[t2][s], cq, 0, 0, 0); }
                const int j = 16 * tj + fr; const float gcj = gcS[j];
                bf16* QKp = (bf16*)(blk + CHK_QK);
#pragma unroll
                for (int jj = 0; jj < 4; ++jj) { const int i = 16 * ti + 4 * fq + jj; const float dec = __expf(j <= i ? gcS[i] - gcj : 0.f);
                    As[i * 65 + j] = (j < i) ? btS[i] * ck[jj] * dec : 0.f;
                    QKp[i * 64 + 32 * (j >> 5) + 8 * ((j >> 2) & 3) + 4 * ((j >> 4) & 1) + (j & 3)] = (bf16)f2bf((j <= i) ? cq[jj] * dec : 0.f); }
            }
        }
        {
#pragma unroll
            for (int x = 0; x < 2; ++x) { const int id = tid + 512 * x, i = id >> 4, d0 = (id & 15) * 8; const float e = egS[i];
                float f[8]; unpack8(qc[x], f);
                bf16* Qd = (bf16*)(blk + CHK_QD) + i * 128 + 32 * (d0 >> 5) + 4 * ((d0 >> 4) & 1);
                const int q0 = (d0 >> 2) & 3;
                v2u w0, w1; w0.x = pk2(f[0] * e, f[1] * e); w0.y = pk2(f[2] * e, f[3] * e); w1.x = pk2(f[4] * e, f[5] * e); w1.y = pk2(f[6] * e, f[7] * e);
                *(v2u*)(Qd + 8 * q0) = w0; *(v2u*)(Qd + 8 * (q0 + 1)) = w1; }
        }
        {
            const int d = tid >> 2, c0 = (tid & 3) * 16, s = c0 >> 5, a = (c0 >> 4) & 1;
            bf16* Kd = (bf16*)(blk + CHK_KDT) + d * 64;
#pragma unroll
            for (int q = 0; q < 4; ++q) { const int c = c0 + 4 * q; float kv[4];
#pragma unroll
                for (int e = 0; e < 4; ++e) kv[e] = bf1(*(const LAS bf16*)(kt + (c + e) * CP_KV_PITCH + 2 * d)) * ekS[c + e];
                v2u w; w.x = pk2(kv[0], kv[1]); w.y = pk2(kv[2], kv[3]); *(v2u*)(Kd + 32 * s + 8 * q + 4 * a) = w; }
        }
        __syncthreads();
        {
            const int c = tid >> 3, part = tid & 7;
            for (int i = 0; i < 64; ++i) {
                float acc = 0.f;
                for (int j = part; j < i; j += 8) acc += As[i * 65 + j] * Ts[j * 68 + c];
                acc += __shfl_xor(acc, 1); acc += __shfl_xor(acc, 2); acc += __shfl_xor(acc, 4);
                if (part == 0) Ts[i * 68 + c] = ((i == c) ? 1.f : 0.f) - acc;
                __builtin_amdgcn_fence(__ATOMIC_RELEASE, "wavefront"); asm volatile("s_waitcnt lgkmcnt(0)" ::: "memory");
            }
        }
        __syncthreads();
        {
            bf16x8 vf[2], kf[2];
            LAS unsigned char* vb = vt + (8 * fq + ((lane & 15) >> 2)) * CP_KV_PITCH + 32 * wave + 8 * (lane & 3);
            LAS unsigned char* kb = kt + (8 * fq + ((lane & 15) >> 2)) * CP_KV_PITCH + 32 * wave + 8 * (lane & 3);
#pragma unroll
            for (int s = 0; s < 2; ++s) {
                const v4i16_t v0 = lds_tr16(vb + (32 * s) * CP_KV_PITCH), v1 = lds_tr16(vb + (32 * s + 4) * CP_KV_PITCH), k0 = lds_tr16(kb + (32 * s) * CP_KV_PITCH), k1 = lds_tr16(kb + (32 * s + 4) * CP_KV_PITCH);
                vf[s][0] = v0[0]; vf[s][1] = v0[1]; vf[s][2] = v0[2]; vf[s][3] = v0[3]; vf[s][4] = v1[0]; vf[s][5] = v1[1]; vf[s][6] = v1[2]; vf[s][7] = v1[3];
                kf[s][0] = k0[0]; kf[s][1] = k0[1]; kf[s][2] = k0[2]; kf[s][3] = k0[3]; kf[s][4] = k1[0]; kf[s][5] = k1[1]; kf[s][6] = k1[2]; kf[s][7] = k1[3];
            }
            float* UT = (float*)(blk + CHK_UT);
            bf16* Wp = (bf16*)(blk + CHK_WP);
#pragma unroll
            for (int ti = 0; ti < 4; ++ti) {
                f32x4 cu = (f32x4){0.f, 0.f, 0.f, 0.f}, cw = (f32x4){0.f, 0.f, 0.f, 0.f};
#pragma unroll
                for (int s = 0; s < 2; ++s) {
                    const LAS float* tr = Ts + (16 * ti + fr) * 68 + 32 * s + 8 * fq;
                    const f32x4 t0 = *(const LAS f32x4*)tr, t1 = *(const LAS f32x4*)(tr + 4);
                    const f32x4 b0 = *(const LAS f32x4*)(btS + 32 * s + 8 * fq), b1 = *(const LAS f32x4*)(btS + 32 * s + 8 * fq + 4), e0 = *(const LAS f32x4*)(egS + 32 * s + 8 * fq), e1 = *(const LAS f32x4*)(egS + 32 * s + 8 * fq + 4);
                    const f32x4 u0 = t0 * b0, u1 = t1 * b1, w0 = u0 * e0, w1 = u1 * e1;
                    cu = __builtin_amdgcn_mfma_f32_16x16x32_bf16(packfrag(u0, u1), vf[s], cu, 0, 0, 0);
                    cw = __builtin_amdgcn_mfma_f32_16x16x32_bf16(packfrag(w0, w1), kf[s], cw, 0, 0, 0);
                }
                *(f32x4*)(UT + (size_t)(16 * wave + fr) * 64 + 16 * ti + 4 * fq) = cu;
#pragma unroll
                for (int jj = 0; jj < 4; ++jj) Wp[(16 * ti + 4 * fq + jj) * 128 + 32 * (wave >> 1) + 8 * (fr >> 2) + 4 * (wave & 1) + (fr & 3)] = (bf16)f2bf(cw[jj]);
            }
        }
        __syncthreads();
    }
}
__device__ __forceinline__ void p14_pool(Frame& F, KArgs A) {
    const int lane = F.lane, tid = F.tid, gw = F.bid * NWAVES + F.wave, NGW = F.G * NWAVES;
    LAS float* pw = (LAS float*)(F.lds + 16384);
    LAS float* dl = (LAS float*)(F.lds + 16384 + 65536 + F.wave * 1024);
    {   f32x4 pv[8];
#pragma unroll
        for (int j = 0; j < 8; ++j) pv[j] = *(const f32x4*)(A->in[I_CD_POOLW] + (size_t)(tid + NTHREADS * j) * 4);
#pragma unroll
        for (int j = 0; j < 8; ++j) *(LAS f32x4*)(pw + (tid + NTHREADS * j) * 4) = pv[j];
    }
    __syncthreads();
    const bf16* QK = WSP(bf16, WS_QKVZ); bf16* AO = WSP(bf16, WS_AO);
    const int gi = lane >> 4, w = 2 << gi;
    float sc[4];
#pragma unroll
    for (int g = 0; g < 4; ++g) sc[g] = A->in[I_CD_POOLS][g * 64 + lane];
    for (int row = gw; row < M; row += NGW) {
        const int pos = row & (SEQ - 1);
        const int cntw = (pos + 1 < w) ? pos + 1 : w;
        float sum[4] = {0.f, 0.f, 0.f, 0.f}, cur[4] = {0.f, 0.f, 0.f, 0.f};
        v2u xw[16];
#pragma unroll
        for (int j = 0; j < 16; ++j) xw[j] = *(const v2u*)(QK + (size_t)(row - (j <= pos ? j : pos)) * 2560 + 2304 + 4 * lane);
#pragma unroll
        for (int j = 0; j < 16; ++j) {
            const float f0 = bflo(xw[j].x), f1 = bfhi(xw[j].x), f2 = bflo(xw[j].y), f3 = bfhi(xw[j].y);
            if (j < cntw) { sum[0] += f0; sum[1] += f1; sum[2] += f2; sum[3] += f3; }
            if (j == 0) { cur[0] = f0; cur[1] = f1; cur[2] = f2; cur[3] = f3; }
        }
        const float inv = 1.0f / (float)cntw;
#pragma unroll
        for (int i = 0; i < 4; ++i) dl[4 * lane + i] = sum[i] * inv - cur[i];
        float o[4] = {0.f, 0.f, 0.f, 0.f};
        for (int c = 0; c < 64; ++c) {
#pragma unroll
            for (int g = 0; g < 4; ++g) o[g] += dl[g * 64 + c] * pw[(g * 64 + c) * 64 + lane];
        }
#pragma unroll
        for (int g = 0; g < 4; ++g) AO[(size_t)row * 1024 + 768 + g * 64 + lane] = (bf16)f2bf(o[g] * sc[g]);
    }
}


#define IN(k) (lo <= (k) && (k) < hi)
#define SEAM(k) do { if (IN(k) && IN((k) + 1)) xcd_barrier(bar); } while (0)
template <int l> __device__ __forceinline__ void layer_tail(Frame& F, const XcdBarrier& bar, const int lo, const int hi) {
    LAS unsigned char* ring = F.lds + RING_OFF;
    const int bid = F.bid, G = F.G;
        const int pb = 8 * l;

        if (IN(7 + pb)) {
            pg8::Gemm g{WSP(bf16, WS_AO), (l == 0) ? WSP(bf16, WS_W_OUTAB) : WSP(bf16, WS_W_OUTCD), M, 1024, (l == 0) ? 1536 : 1024}; pg8::StaticOrder S; S.init(M, 1024, G, bid);
            pg8::Epi<pg8::StPre> E{{(l == 0) ? kargs()->in[I_X] : WSP(float, WS_H2), WSP(float, WS_PRE), ALPHA}};
            pg8::gemm_phase<pg8::Epi<pg8::StPre>, pg8::StaticOrder, true, true>(ring, g, S, E);
        } SEAM(7 + pb);
        if (IN(8 + pb)) { p8_ln_router(F, kargs(), l, WSP(float, WS_H1), WSP(bf16, WS_H1B)); } SEAM(8 + pb);
        if (IN(9 + pb)) {
            p9_scatter(F, l, WSP(bf16, WS_H1B), WSP(float, WS_H1));
            __syncthreads();
            pg8::Gemm g{WSP(bf16, WS_H1B), WSP(bf16, WS_W_PG) + (size_t)l * 1024 * 1024, M, 1024, 1024}; pg8::StaticOrder S; S.init(M, 1024, G, bid);
            pg8::Epi<pg8::StPleGate> E{{WSP(bf16, WS_PP) + (size_t)l * M * 1024, WSP(bf16, WS_PLE)}};
            pg8::gemm_phase<pg8::Epi<pg8::StPleGate>, pg8::StaticOrder, true, true>(ring, g, S, E);
        } SEAM(9 + pb);
        const int* TILE = WSP(int, WS_ROUTE) + 3 * M * 4;
        if (IN(10 + pb)) {
            const int nT = __builtin_amdgcn_readfirstlane(TILE[NTMAX]);
            constexpr int EB = kMoeFp8 ? 1 : 2;
            pg8::Gemm g{WSP(bf16, WS_XS), (const bf16*)(F.ws + WS_W_GU + (size_t)l * NEXP * 2048 * 1024 * EB), PMAX, 2048, 1024 * EB / 2};
            pg8::MoeOrder S{TILE, nT, 8, G, bid, (long)2048 * 1024 * EB};
            pg8::Epi<pg8::StSwiglu<kMoeFp8>> E{{kargs()->in[I_BGU] + (size_t)l * NEXP * 2048, WSP(bf16, WS_HID)}};
            pg8::gemm_phase<pg8::Epi<pg8::StSwiglu<kMoeFp8>>, pg8::MoeOrder, true, true, kMoeFp8 ? kScaleGU : 0u>(ring, g, S, E);
        } SEAM(10 + pb);
        if (IN(11 + pb)) {
            const int nT = __builtin_amdgcn_readfirstlane(TILE[NTMAX]);
            constexpr int EB = kMoeFp8 ? 1 : 2;
            pg8::Gemm g{WSP(bf16, WS_HID), (const bf16*)(F.ws + WS_W_DN + (size_t)l * NEXP * 1024 * 1024 * EB), PMAX, 1024, 1024 * EB / 2};
            pg8::MoeOrder S{TILE, nT, 4, G, bid, (long)1024 * 1024 * EB};
            pg8::Epi<pg8::StDown> E{{kargs()->in[I_BDN] + (size_t)l * NEXP * 1024, WSP(bf16, WS_YS)}};
            pg8::gemm_phase<pg8::Epi<pg8::StDown>, pg8::MoeOrder, true, true, kMoeFp8 ? kScaleDN : 0u>(ring, g, S, E);
        } SEAM(11 + pb);
        if (IN(12 + pb)) { p12_combine(F, kargs(), l, WSP(float, WS_H1), (l == 0) ? WSP(float, WS_H2) : kargs()->out, (l == 0) ? WSP(bf16, WS_XB) : (bf16*)nullptr); }
}
#undef IN
#undef SEAM
__global__ void __launch_bounds__(NTHREADS, 2) mk_fwd(Args args_by_value) {
    const KArgs KA = kargs();
    extern __shared__ __attribute__((aligned(16))) unsigned char lds[];
    Frame F;
    F.lds = (LAS unsigned char*)lds;
    F.tid = threadIdx.x; F.lane = F.tid & 63; F.wave = __builtin_amdgcn_readfirstlane(F.tid >> 6);
    F.G = gridDim.x; F.bid = blockIdx.x; F.ws = KA->ws; F.ctl = (gu32*)(KA->ws + WS_CTL);
    volatile LAS unsigned* MISC = (volatile LAS unsigned*)(F.lds + MISC_OFF);
    { int t0 = threadIdx.x; asm volatile("" : "+v"(t0)); for (int u = t0; u < (LDS_BYTES - MISC_OFF) / 4; u += NTHREADS) MISC[u] = 0u; }
    __syncthreads();
    const bool use_bar = (N_LAUNCHES != NPHASES);
    XcdBarrier bar; bar.bar = (unsigned*)(F.ctl + CW_BAR) + KA->li * XCD_BAR_WORDS; bar.x = 0; bar.st = nullptr; bar.expect = 0;
    XcdBarrier bar2 = bar;
    if (use_bar && F.bid >= SEQ_WGS && F.G > SEQ_WGS) bar2 = xcd_barrier_post((unsigned*)(F.ctl + CW_BAR2), MISC + 10, (unsigned)(F.G - SEQ_WGS));
    if (use_bar) bar = xcd_barrier_post((unsigned*)(F.ctl + CW_BAR) + KA->li * XCD_BAR_WORDS, MISC + 8);
    const int lo = KA->ph_lo, hi = KA->ph_hi;
#define IN(k) (lo <= (k) && (k) < hi)
#define SEAM(k) do { if (IN(k) && IN((k) + 1)) xcd_barrier(bar); } while (0)
    LAS unsigned char* ring = F.lds + RING_OFF;
    const int bid = F.bid, G = F.G;

    if (IN(0)) { p0_prologue(F, kargs()); } SEAM(0);

            if (IN(1)) {
                { pg8::Gemm g{WSP(bf16, WS_XB), WSP(bf16, WS_W_INAB), M, 2560, 1024}; pg8::StaticOrder S; S.init(M, 2560, G, bid);
                  pg8::Epi<pg8::StInAB> E{{WSP(float, WS_SM), WSP(bf16, WS_QKVZ)}};
                  pg8::gemm_phase<pg8::Epi<pg8::StInAB>, pg8::StaticOrder, true, true>(ring, g, S, E); }
                __syncthreads();
                { pg8::Gemm g{WSP(bf16, WS_PB), WSP(bf16, WS_W_PP), 2 * M, 1024, 256}; pg8::BatchOrder S{4, (2 * M / 256) * 4, G, bid, M / 256, (long)1024 * 256 * 2};
                  pg8::Epi<pg8::StBf16> E{{WSP(bf16, WS_PP), 1024}};
                  pg8::gemm_phase<pg8::Epi<pg8::StBf16>, pg8::BatchOrder, true, true>(ring, g, S, E); }
            } SEAM(1);
            if (IN(2)) { p2_prep(F, kargs()); } SEAM(2);
            if (IN(3)) {
                p3_chunk_prep_mfma(F, kargs());
                __syncthreads();
                { pg8::Gemm g{WSP(bf16, WS_CQ), WSP(bf16, WS_W_ABS), M, 1536, 256}; pg8::StaticOrder S; S.init(M, 1536, G, bid);
                  pg8::Epi<pg8::StBf16> E{{WSP(bf16, WS_QL), 1536}};
                  pg8::gemm_phase<pg8::Epi<pg8::StBf16>, pg8::StaticOrder, true, true>(ring, g, S, E); }
            } SEAM(3);
            if (IN(4)) {
                if (bid < SEQ_WGS && G > SEQ_WGS) p4_delta_seq(F, bid);
                else { p4_indexer(F, (bid - SEQ_WGS) * NWAVES + F.wave, (G - SEQ_WGS) * NWAVES);
                    if (use_bar) { xcd_barrier(bar2);
                        p5_topk_attn(F, (bid - SEQ_WGS) * NWAVES + F.wave, (G - SEQ_WGS) * NWAVES); } }
            } SEAM(4);
            if (IN(5)) { if (!use_bar) p5_topk_attn(F, bid * NWAVES + F.wave, G * NWAVES); p6_gdn_out(F, kargs()); } SEAM(5);
    layer_tail<0>(F, bar, lo, hi);
    SEAM(12);
            if (IN(13)) {
                pg8::Gemm g{WSP(bf16, WS_XB), WSP(bf16, WS_W_INCD), M, 2560, 1024}; pg8::StaticOrder S; S.init(M, 2560, G, bid);
                pg8::Epi<pg8::StBf16> E{{WSP(bf16, WS_QKVZ), 2560}};
                pg8::gemm_phase<pg8::Epi<pg8::StBf16>, pg8::StaticOrder, true, true>(ring, g, S, E);
            } SEAM(13);
            if (IN(14)) { p14_dilated_mfma(F); __syncthreads(); p14_pool(F, kargs()); } SEAM(14);
    layer_tail<1>(F, bar, lo, hi);
#undef IN
#undef SEAM
}

extern "C" void kernel_launch(void* const* d_in, const int* in_sizes, int n_in, void* d_out, int out_size, void* d_ws, size_t ws_size, hipStream_t stream) {
    static int grid = 0;
    if (grid == 0) {
        if (n_in != N_IN || in_sizes[0] != M * D || out_size != M * D || ws_size < WS_END) {
            fprintf(stderr, "kernel_launch: built for %d inputs, x/out of %d floats, >= %zu bytes of workspace; got n_in %d, in0 %d, out %d, ws %zu; nothing launched\n", N_IN, M * D, (size_t)WS_END, n_in, n_in > 0 ? in_sizes[0] : -1, out_size, ws_size);
            grid = -1; return; }
        int dev = 0, cus = 0, per_cu = 0;
        if (hipGetDevice(&dev) != hipSuccess || hipDeviceGetAttribute(&cus, hipDeviceAttributeMultiprocessorCount, dev) != hipSuccess) { fprintf(stderr, "kernel_launch: device query failed\n"); grid = -1; return; }
        if (hipFuncSetAttribute((const void*)mk_fwd, hipFuncAttributeMaxDynamicSharedMemorySize, LDS_BYTES) != hipSuccess) { fprintf(stderr, "kernel_launch: hipFuncSetAttribute failed\n"); grid = -1; return; }
        if (hipOccupancyMaxActiveBlocksPerMultiprocessor(&per_cu, (const void*)mk_fwd, NTHREADS, LDS_BYTES) != hipSuccess || per_cu < 1)
            fprintf(stderr, "kernel_launch: note: occupancy query reports %d workgroups per CU\n", per_cu);
        (void)hipGetLastError();
        grid = cus;
    }
    if (grid < 0) return;
    if (hipMemsetAsync((char*)d_ws + WS_CTL, 0, CTL_ZERO_BYTES, stream) != hipSuccess) { fprintf(stderr, "kernel_launch: memset failed\n"); return; }
    Args a{};
    for (int i = 0; i < N_IN; ++i) a.in[i] = (const float*)d_in[i];
    a.out = (float*)d_out; a.ws = (unsigned char*)d_ws;
    for (int li = 0; li < N_LAUNCHES; ++li) {
        if (N_LAUNCHES == NPHASES) { a.ph_lo = li; a.ph_hi = li + 1; } else { a.ph_lo = (int)((long)li * NPHASES / N_LAUNCHES); a.ph_hi = (int)((long)(li + 1) * NPHASES / N_LAUNCHES); }
        a.li = li;
        hipLaunchKernelGGL(mk_fwd, dim3(grid), dim3(NTHREADS), LDS_BYTES, stream, a);
        const hipError_t le = hipPeekAtLastError();
        if (le != hipSuccess) { fprintf(stderr, "kernel_launch: launch %d failed: %s\n", li, hipGetErrorName(le)); break; }
    }
}
```

```cpp
#include <hip/hip_runtime.h>
#include <cstdio>
#include <cstdint>

namespace pg8 {
#define PG8_LAS __attribute__((address_space(3)))
typedef unsigned short bf16_t;
typedef short bf16x8 __attribute__((ext_vector_type(8)));
typedef float f32x4 __attribute__((ext_vector_type(4)));
typedef unsigned u32x4 __attribute__((ext_vector_type(4)));
constexpr int BM = 256, BK = 64, HALF = 128, HTB = HALF * BK * 2  , STAGE_BYTES = 8 * HTB, NXCD = 8, WGM = 8;

__host__ __device__ __forceinline__ int lds_byte(int r, int c) { const int st = (r >> 4) * 2 + (c >> 5), rr = r & 15, cc = c & 31, ob = rr * 64 + cc * 2; return st * 1024 + (ob ^ (((ob >> 9) & 1) << 5)); }
__host__ __device__ __forceinline__ void stage_rc(int b, int& R, int& C) { const int st = b / 1024, sb = b % 1024, swz = sb ^ (((sb >> 9) & 1) << 5); R = (st >> 1) * 16 + swz / 64; C = (st & 1) * 32 + (swz % 64) / 2; }
__host__ __device__ __forceinline__ int perm32(int rho) { const int n = rho >> 4, i = rho & 15; return 8 * (i >> 2) + 4 * n + (i & 3); }

struct Unit { int pm, pn, e; long bofs; };
struct Gemm { const bf16_t* A; const bf16_t* Bt; int M, N, K; };

struct StaticOrder {
    int nM, nN, nwg, G, c;
    __host__ __device__ void init(int M, int N, int G_, int c_) { nM = M / BM; nN = N / BM; nwg = nM * nN; G = G_; c = c_; }
    __host__ __device__ bool next(int i, Unit& u) const {
        const long L = (long)i * G + c; if (L >= nwg) return false;
        int wgid = (int)L; { const int q = nwg / NXCD, r = nwg % NXCD, xcd = wgid % NXCD, off = wgid / NXCD; wgid = (xcd < r ? xcd * (q + 1) : r * (q + 1) + (xcd - r) * q) + off; }
        const int nig = WGM * nN, gid = wgid / nig, fm = gid * WGM, gsz = (nM - fm) < WGM ? (nM - fm) : WGM;
        u.pm = fm + ((wgid % nig) % gsz); u.pn = (wgid % nig) / gsz; u.e = 0; u.bofs = 0; return true;
    }
    __device__ __forceinline__ void a_ready(const Unit&) const {}
    __device__ __forceinline__ void done(const Unit&) const {}
};
struct MoeOrder {
    const int* tile_e; int nT, nN, G, c; long estride;
    __device__ __forceinline__ bool next(int i, Unit& u) const {
        if (G % (8 * nN) == 0) {
            const int rpx = G / (8 * nN), xcd = c & 7, idx = c >> 3;
            u.pm = (i * 8 + xcd) * rpx + idx % rpx; u.pn = idx / rpx;
            if (u.pm >= nT) return false;
        } else {
            const long L = (long)i * G + c; if (L >= (long)nT * nN) return false;
            u.pm = (int)(L / nN); u.pn = (int)(L % nN);
        }
        const int e = tile_e[u.pm]; u.e = e; u.bofs = (long)e * estride; return true;
    }
    __device__ __forceinline__ void a_ready(const Unit&) const {}
    __device__ __forceinline__ void done(const Unit&) const {}
};

struct BatchOrder {
    int nN, nwg, G, c, tiles_per_batch; long bstride;
    __device__ __forceinline__ bool next(int i, Unit& u) const {
        const long L = (long)i * G + c; if (L >= nwg) return false;
        u.pm = (int)(L / nN); u.pn = (int)(L % nN); const int e = u.pm / tiles_per_batch; u.e = e; u.bofs = (long)e * bstride; return true;
    }
    __device__ __forceinline__ void a_ready(const Unit&) const {}
    __device__ __forceinline__ void done(const Unit&) const {}
};

__device__ __forceinline__ unsigned cvt_pk_bf16(float lo, float hi) { unsigned r; asm volatile("v_cvt_pk_bf16_f32 %0, %1, %2" : "=v"(r) : "v"(lo), "v"(hi)); return r; }
__device__ __forceinline__ u32x4 pack8(const f32x4 v0, const f32x4 v1) { u32x4 w; w.x = cvt_pk_bf16(v0[0], v0[1]); w.y = cvt_pk_bf16(v0[2], v0[3]); w.z = cvt_pk_bf16(v1[0], v1[1]); w.w = cvt_pk_bf16(v1[2], v1[3]); return w; }
__device__ __forceinline__ float bf_lo(unsigned w) { return __uint_as_float(w << 16); }
__device__ __forceinline__ float bf_hi(unsigned w) { return __uint_as_float(w & 0xffff0000u); }
__device__ __forceinline__ float sigmoidf_(float x) { return 1.0f / (1.0f + __expf(-x)); }
typedef unsigned u32x2 __attribute__((ext_vector_type(2)));

template <class T> struct Epi {
    static constexpr bool PERM = true, AFTER_DRAIN = false;
    T t;
    __device__ __forceinline__ void operator()(const f32x4 (&acc)[2][2][4][2], const Unit& u, int wr, int wc, int fr, int fq) const {
        const int row0 = u.pm * BM + wr * 64 + fr, col0 = u.pn * BM + wc * 32 + 8 * fq;
        f32x4 cb[2][2];
#pragma unroll
        for (int bj = 0; bj < 2; ++bj) t.colctx(col0 + bj * HALF, u, cb[bj][0], cb[bj][1]);
        f32x4 rc[2][2], rn[2][2];
#pragma unroll
        for (int bj = 0; bj < 2; ++bj) t.rowctx(row0, col0 + bj * HALF, rc[bj][0], rc[bj][1]);
#pragma unroll
        for (int g = 0; g < 8; ++g) {
            const int ai = g >> 2, m = g & 3, row = row0 + ai * HALF + m * 16;
            if (g < 7) { const int nrow = row0 + ((g + 1) >> 2) * HALF + ((g + 1) & 3) * 16;
#pragma unroll
                for (int bj = 0; bj < 2; ++bj) t.rowctx(nrow, col0 + bj * HALF, rn[bj][0], rn[bj][1]); }
#pragma unroll
            for (int bj = 0; bj < 2; ++bj) t.store(row, col0 + bj * HALF, acc[ai][bj][m][0] + cb[bj][0], acc[ai][bj][m][1] + cb[bj][1], u, rc[bj][0], rc[bj][1]);
            asm volatile("" ::: "memory");
#pragma unroll
            for (int bj = 0; bj < 2; ++bj) { rc[bj][0] = rn[bj][0]; rc[bj][1] = rn[bj][1]; }
        }
    }
};
struct StBf16 { bf16_t* O; int ld;
    __device__ __forceinline__ void rowctx(int, int, f32x4& r0, f32x4& r1) const { r0 = (f32x4){0.f, 0.f, 0.f, 0.f}; r1 = r0; }
    __device__ __forceinline__ void colctx(int, const Unit&, f32x4& c0, f32x4& c1) const { c0 = (f32x4){0.f, 0.f, 0.f, 0.f}; c1 = c0; }
    __device__ __forceinline__ void store(int row, int col, f32x4 v0, f32x4 v1, const Unit&, f32x4, f32x4) const { *(u32x4*)(O + (size_t)row * ld + col) = pack8(v0, v1); } };
struct StInAB { float* SM; bf16_t* Q;
    __device__ __forceinline__ void rowctx(int, int, f32x4& r0, f32x4& r1) const { r0 = (f32x4){0.f, 0.f, 0.f, 0.f}; r1 = r0; }
    __device__ __forceinline__ void colctx(int, const Unit&, f32x4& c0, f32x4& c1) const { c0 = (f32x4){0.f, 0.f, 0.f, 0.f}; c1 = c0; }
    __device__ __forceinline__ void store(int row, int col, f32x4 v0, f32x4 v1, const Unit&, f32x4, f32x4) const {
        if (col < 512) { float* p = SM + (size_t)row * 512 + col; *(f32x4*)p = v0; *(f32x4*)(p + 4) = v1; }
        else *(u32x4*)(Q + (size_t)row * 2048 + (col - 512)) = pack8(v0, v1); } };
struct StPre { const float* base; float* P; float alpha;
    __device__ __forceinline__ void colctx(int, const Unit&, f32x4& c0, f32x4& c1) const { c0 = (f32x4){0.f, 0.f, 0.f, 0.f}; c1 = c0; }
    __device__ __forceinline__ void rowctx(int row, int col, f32x4& r0, f32x4& r1) const { const size_t o = (size_t)row * 1024 + col; r0 = *(const f32x4*)(base + o); r1 = *(const f32x4*)(base + o + 4); }
    __device__ __forceinline__ void store(int row, int col, f32x4 v0, f32x4 v1, const Unit&, f32x4 b0, f32x4 b1) const {
        const size_t o = (size_t)row * 1024 + col;
        *(f32x4*)(P + o) = b0 * alpha + v0; *(f32x4*)(P + o + 4) = b1 * alpha + v1; } };
struct StPleGate { const bf16_t* PP; bf16_t* O;
    __device__ __forceinline__ void colctx(int, const Unit&, f32x4& c0, f32x4& c1) const { c0 = (f32x4){0.f, 0.f, 0.f, 0.f}; c1 = c0; }
    __device__ __forceinline__ void rowctx(int row, int col, f32x4& r0, f32x4& r1) const { r0 = *(const f32x4*)(PP + (size_t)row * 1024 + col); r1 = r0; }
    __device__ __forceinline__ void store(int row, int col, f32x4 v0, f32x4 v1, const Unit&, f32x4 pr, f32x4) const {
        const size_t o = (size_t)row * 1024 + col; const u32x4 p = __builtin_bit_cast(u32x4, pr);
        f32x4 r0, r1;
        r0[0] = sigmoidf_(v0[0]) * bf_lo(p.x); r0[1] = sigmoidf_(v0[1]) * bf_hi(p.x); r0[2] = sigmoidf_(v0[2]) * bf_lo(p.y); r0[3] = sigmoidf_(v0[3]) * bf_hi(p.y);
        r1[0] = sigmoidf_(v1[0]) * bf_lo(p.z); r1[1] = sigmoidf_(v1[1]) * bf_hi(p.z); r1[2] = sigmoidf_(v1[2]) * bf_lo(p.w); r1[3] = sigmoidf_(v1[3]) * bf_hi(p.w);
        *(u32x4*)(O + o) = pack8(r0, r1); } };
template <bool F8> struct StSwiglu { const float* bgu; bf16_t* H;
    __device__ __forceinline__ void rowctx(int, int, f32x4& r0, f32x4& r1) const { r0 = (f32x4){0.f, 0.f, 0.f, 0.f}; r1 = r0; }
    __device__ __forceinline__ float act(float g, float u) const { const float gt = fminf(g, 7.0f), up = fminf(fmaxf(u, -7.0f), 7.0f); return (up + 1.0f) * (gt * sigmoidf_(gt * 1.702f)); }
    __device__ __forceinline__ void colctx(int col, const Unit& u, f32x4& c0, f32x4& c1) const { const float* b = bgu + (size_t)u.e * 2048 + col; c0 = *(const f32x4*)b; c1 = *(const f32x4*)(b + 4); }
    __device__ __forceinline__ void store(int row, int col, f32x4 v0, f32x4 v1, const Unit& u, f32x4, f32x4) const {
        if (F8) { unsigned w = 0u; w = __builtin_amdgcn_cvt_pk_fp8_f32(act(v0[0], v0[1]), act(v0[2], v0[3]), w, false); w = __builtin_amdgcn_cvt_pk_fp8_f32(act(v1[0], v1[1]), act(v1[2], v1[3]), w, true);
            *(unsigned*)((unsigned char*)H + (size_t)row * 1024 + (col >> 1)) = w; }
        else { u32x2 w; w.x = cvt_pk_bf16(act(v0[0], v0[1]), act(v0[2], v0[3])); w.y = cvt_pk_bf16(act(v1[0], v1[1]), act(v1[2], v1[3]));
            *(u32x2*)(H + (size_t)row * 1024 + (col >> 1)) = w; } } };
struct StDown { const float* bd; bf16_t* Y;
    __device__ __forceinline__ void rowctx(int, int, f32x4& r0, f32x4& r1) const { r0 = (f32x4){0.f, 0.f, 0.f, 0.f}; r1 = r0; }
    __device__ __forceinline__ void colctx(int col, const Unit& u, f32x4& c0, f32x4& c1) const { const float* b = bd + (size_t)u.e * 1024 + col; c0 = *(const f32x4*)b; c1 = *(const f32x4*)(b + 4); }
    __device__ __forceinline__ void store(int row, int col, f32x4 v0, f32x4 v1, const Unit& u, f32x4, f32x4) const {
        *(u32x4*)(Y + (size_t)row * 1024 + col) = pack8(v0, v1); } };

typedef int i32x8 __attribute__((ext_vector_type(8)));
typedef int i32x4 __attribute__((ext_vector_type(4)));
template <class Epi, class Sched, bool ALIGN_EPI = false, bool SP2 = false, unsigned FP8W = 0u>
__device__ __forceinline__ void gemm_phase(PG8_LAS unsigned char* lds, const Gemm g, const Sched& S, const Epi& E) {
    int tid = threadIdx.x; asm volatile("" : "+v"(tid));
    const int wid = __builtin_amdgcn_readfirstlane(tid >> 6), lane = tid & 63, wr = wid >> 2, wc = wid & 3, fr = lane & 15, fq = lane >> 4;
    int K = g.K; asm volatile("" : "+s"(K));
    const int nt = K / BK;
    unsigned voffA[2], voffB[2];
#pragma unroll
    for (int i = 0; i < 2; ++i) { int R, C; stage_rc(tid * 16 + i * 8192, R, C); const int Rb = Epi::PERM ? ((R & ~31) + perm32(R & 31)) : R;
        voffA[i] = (unsigned)(R * K + C) * 2u; voffB[i] = (unsigned)(Rb * K + C) * 2u; }
    const size_t kstep = (size_t)(BK * 2);
    const size_t hstep = (size_t)HALF * K * 2;
    const size_t tstep = 2 * hstep;
    const unsigned ldsw = (unsigned)wid * 1024u;
    const int aoff = lds_byte(wr * 64 + fr, fq * 8), boff = lds_byte(wc * 32 + fr, fq * 8);
#define PG8_SA(b, h) (((b) * 2 + (h)) * HTB)
#define PG8_SB(b, h) ((4 + (b) * 2 + (h)) * HTB)
#define PG8_STAGE(bufoff, gbase, voff) do { _Pragma("unroll") for (int _i = 0; _i < 2; ++_i) \
        __builtin_amdgcn_global_load_lds((const unsigned*)((const char*)(gbase) + (voff)[_i]), (PG8_LAS unsigned*)(lds + (bufoff) + ldsw + _i * 8192), 16, 0, 0); } while (0)
#define PG8_CAT(lo, hi) __builtin_shufflevector((lo), (hi), 0, 1, 2, 3, 4, 5, 6, 7)
#define PG8_LDA(dst, b, h) do { if constexpr (FP8W != 0u) { _Pragma("unroll") for (int m = 0; m < 4; ++m) dst##8[m] = PG8_CAT(*(const PG8_LAS i32x4*)(lds + PG8_SA(b, h) + aoff + m * 2048), *(const PG8_LAS i32x4*)(lds + PG8_SA(b, h) + aoff + m * 2048 + 1024)); } \
        else { _Pragma("unroll") for (int m = 0; m < 4; ++m) _Pragma("unroll") for (int k = 0; k < 2; ++k) dst[m][k] = *(const PG8_LAS bf16x8*)(lds + PG8_SA(b, h) + aoff + m * 2048 + k * 1024); } } while (0)
#define PG8_LDB(dst, b, h) do { if constexpr (FP8W != 0u) { _Pragma("unroll") for (int n = 0; n < 2; ++n) dst##8[n] = PG8_CAT(*(const PG8_LAS i32x4*)(lds + PG8_SB(b, h) + boff + n * 2048), *(const PG8_LAS i32x4*)(lds + PG8_SB(b, h) + boff + n * 2048 + 1024)); } \
        else { _Pragma("unroll") for (int n = 0; n < 2; ++n) _Pragma("unroll") for (int k = 0; k < 2; ++k) dst[n][k] = *(const PG8_LAS bf16x8*)(lds + PG8_SB(b, h) + boff + n * 2048 + k * 1024); } } while (0)
#define PG8_MMA(ai, bj, At, Bt) do { __builtin_amdgcn_s_setprio(1); _Pragma("unroll") for (int m = 0; m < 4; ++m) _Pragma("unroll") for (int n = 0; n < 2; ++n) { \
        if constexpr (FP8W != 0u) asm volatile("v_mfma_scale_f32_16x16x128_f8f6f4 %0, %1, %2, %0, %3, %4 op_sel_hi:[0,0,0]" : "+v"(acc[ai][bj][m][n]) : "v"(Bt##8[n]), "v"(At##8[m]), "v"(sc_w), "v"(sc_x));   \
        else { _Pragma("unroll") for (int k = 0; k < 2; ++k) acc[ai][bj][m][n] = __builtin_amdgcn_mfma_f32_16x16x32_bf16(Bt[n][k], At[m][k], acc[ai][bj][m][n], 0, 0, 0); } } __builtin_amdgcn_s_setprio(0); } while (0)
#define PG8_WAIT_V(n) asm volatile("s_waitcnt vmcnt(" #n ")" ::: "memory")
#define PG8_WAIT_L(n) asm volatile("s_waitcnt lgkmcnt(" #n ")" ::: "memory")
#define PG8_BAR __builtin_amdgcn_s_barrier()
#define PG8_SCHED __builtin_amdgcn_sched_barrier(0)
    Unit cur, nxt; int ui = 0;
    if (!S.next(0, cur)) return;
    f32x4 acc[2][2][4][2];
#pragma unroll
    for (int a = 0; a < 2; ++a)
#pragma unroll
        for (int b = 0; b < 2; ++b)
#pragma unroll
            for (int m = 0; m < 4; ++m)
#pragma unroll
                for (int n = 0; n < 2; ++n) acc[a][b][m][n] = (f32x4){0.f, 0.f, 0.f, 0.f};
    bf16x8 At[4][2], B0[2][2], B1[2][2];
    int sc_w = (int)FP8W, sc_x = 0x7f7f7f7f; asm volatile("" : "+v"(sc_w), "+v"(sc_x));
    i32x8 At8[4], B08[2], B18[2];
    const char* cA = (const char*)g.A + (size_t)cur.pm * tstep; const char* cB = (const char*)g.Bt + (size_t)cur.pn * tstep + cur.bofs;
    S.a_ready(cur);
    if constexpr (SP2) {
        PG8_STAGE(PG8_SB(0, 0), cB, voffB); PG8_STAGE(PG8_SB(0, 1), cB + hstep, voffB); PG8_STAGE(PG8_SA(0, 0), cA, voffA); PG8_STAGE(PG8_SA(0, 1), cA + hstep, voffA);
        if (wr == 1) PG8_BAR;
        PG8_WAIT_V(2); PG8_BAR;
        PG8_STAGE(PG8_SB(1, 0), cB + kstep, voffB); PG8_STAGE(PG8_SA(1, 0), cA + kstep, voffA); PG8_STAGE(PG8_SB(1, 1), cB + hstep + kstep, voffB);
        PG8_WAIT_V(6); PG8_BAR;
    } else {
        PG8_STAGE(PG8_SB(0, 0), cB, voffB); PG8_STAGE(PG8_SA(0, 0), cA, voffA); PG8_STAGE(PG8_SB(0, 1), cB + hstep, voffB); PG8_STAGE(PG8_SA(0, 1), cA + hstep, voffA);
        if (wr == 1) PG8_BAR;
        PG8_WAIT_V(4); PG8_BAR;
        PG8_STAGE(PG8_SB(1, 0), cB + kstep, voffB); PG8_STAGE(PG8_SA(1, 0), cA + kstep, voffA); PG8_STAGE(PG8_SB(1, 1), cB + hstep + kstep, voffB);
        PG8_WAIT_V(6); PG8_BAR;
    }
    for (;;) {
        const bool has_next = S.next(ui + 1, nxt);
        const char* nA = has_next ? (const char*)g.A + (size_t)nxt.pm * tstep : cA; const char* nB = has_next ? (const char*)g.Bt + (size_t)nxt.pn * tstep + nxt.bofs : cB;
        for (int t = 0; t < nt; t += 2) {
            const bool last = (t == nt - 2);
            const char* a1 = cA + (size_t)(t + 1) * kstep;
            const char* a2 = last ? nA : cA + (size_t)(t + 2) * kstep; const char* b2 = last ? nB : cB + (size_t)(t + 2) * kstep;
            const char* a3 = a2 + kstep; const char* b3 = b2 + kstep;
            if (last && has_next) S.a_ready(nxt);
            if constexpr (SP2) {
            PG8_LDB(B0, 0, 0); PG8_LDB(B1, 0, 1); PG8_SCHED; PG8_LDA(At, 0, 0); PG8_STAGE(PG8_SA(1, 1), a1 + hstep, voffA);
            PG8_WAIT_V(8); PG8_WAIT_L(0); PG8_BAR; PG8_MMA(0, 0, At, B0); PG8_MMA(0, 1, At, B1); PG8_BAR; PG8_SCHED;
            PG8_LDA(At, 0, 1); PG8_STAGE(PG8_SB(0, 0), b2, voffB); PG8_STAGE(PG8_SB(0, 1), b2 + hstep, voffB); PG8_STAGE(PG8_SA(0, 0), a2, voffA);
            PG8_WAIT_V(8); PG8_WAIT_L(0); PG8_BAR; PG8_MMA(1, 0, At, B0); PG8_MMA(1, 1, At, B1); PG8_BAR; PG8_SCHED;
            PG8_LDB(B0, 1, 0); PG8_LDB(B1, 1, 1); PG8_SCHED; PG8_LDA(At, 1, 0); PG8_STAGE(PG8_SA(0, 1), a2 + hstep, voffA);
            PG8_WAIT_V(8); PG8_WAIT_L(0); PG8_BAR; PG8_MMA(0, 0, At, B0); PG8_MMA(0, 1, At, B1); PG8_BAR; PG8_SCHED;
            PG8_LDA(At, 1, 1); PG8_STAGE(PG8_SB(1, 0), b3, voffB); PG8_STAGE(PG8_SB(1, 1), b3 + hstep, voffB); PG8_STAGE(PG8_SA(1, 0), a3, voffA);
            PG8_WAIT_V(8); PG8_WAIT_L(0); PG8_BAR; PG8_MMA(1, 0, At, B0); PG8_MMA(1, 1, At, B1); PG8_BAR; PG8_SCHED;
            } else {
            PG8_LDB(B0, 0, 0); PG8_SCHED; PG8_LDA(At, 0, 0); PG8_STAGE(PG8_SA(1, 1), a1 + hstep, voffA);
            PG8_WAIT_L(8); PG8_BAR; PG8_WAIT_L(0); PG8_MMA(0, 0, At, B0); PG8_BAR; PG8_SCHED;
            PG8_LDB(B1, 0, 1); PG8_STAGE(PG8_SB(0, 0), b2, voffB);
            PG8_BAR; PG8_WAIT_L(0); PG8_MMA(0, 1, At, B1); PG8_BAR;
            PG8_LDA(At, 0, 1); PG8_STAGE(PG8_SA(0, 0), a2, voffA);
            PG8_BAR; PG8_WAIT_L(0); PG8_MMA(1, 0, At, B0); PG8_BAR; PG8_SCHED;
            PG8_STAGE(PG8_SB(0, 1), b2 + hstep, voffB);
            PG8_WAIT_V(6); PG8_BAR; PG8_MMA(1, 1, At, B1); PG8_BAR;
            PG8_LDB(B0, 1, 0); PG8_SCHED; PG8_LDA(At, 1, 0); PG8_STAGE(PG8_SA(0, 1), a2 + hstep, voffA);
            PG8_WAIT_L(8); PG8_BAR; PG8_WAIT_L(0); PG8_MMA(0, 0, At, B0); PG8_BAR; PG8_SCHED;
            PG8_LDB(B1, 1, 1); PG8_STAGE(PG8_SB(1, 0), b3, voffB);
            PG8_BAR; PG8_WAIT_L(0); PG8_MMA(0, 1, At, B1); PG8_BAR;
            PG8_LDA(At, 1, 1); PG8_STAGE(PG8_SA(1, 0), a3, voffA);
            PG8_BAR; PG8_WAIT_L(0); PG8_MMA(1, 0, At, B0); PG8_BAR; PG8_SCHED;
            PG8_STAGE(PG8_SB(1, 1), b3 + hstep, voffB);
            PG8_WAIT_V(6); PG8_BAR; PG8_MMA(1, 1, At, B1); PG8_BAR;
            }
        }
        if constexpr (FP8W != 0u) asm volatile("s_nop 15\n\ts_nop 15" ::: "memory");
        if constexpr (ALIGN_EPI) { if (wr == 0) PG8_BAR; }
        if constexpr (!Epi::AFTER_DRAIN) { E(acc, cur, wr, wc, fr, fq); S.done(cur); }
        if (!has_next) break;
#pragma unroll
        for (int a = 0; a < 2; ++a)
#pragma unroll
            for (int b = 0; b < 2; ++b)
#pragma unroll
                for (int m = 0; m < 4; ++m)
#pragma unroll
                    for (int n = 0; n < 2; ++n) acc[a][b][m][n] = (f32x4){0.f, 0.f, 0.f, 0.f};
        cur = nxt; cA = nA; cB = nB; ++ui;
        if constexpr (ALIGN_EPI) { if (wr == 1) PG8_BAR; }
    }
    PG8_WAIT_V(0);
    if constexpr (!ALIGN_EPI) { if (wr == 0) PG8_BAR; }
    PG8_BAR;
    if constexpr (Epi::AFTER_DRAIN) { E.fused(acc, cur, wr, wc, fr, fq, lds, wid, lane); S.done(cur); }
#undef PG8_SA
#undef PG8_SB
#undef PG8_STAGE
#undef PG8_LDA
#undef PG8_CAT
#undef PG8_LDB
#undef PG8_MMA
#undef PG8_WAIT_V
#undef PG8_WAIT_L
#undef PG8_BAR
#undef PG8_SCHED
}
}

constexpr int NWAVES = 8, NTHREADS = 512;
constexpr int BATCH = 2, SEQ = 8192, M = BATCH * SEQ, D = 1024;
constexpr int NEXP = 32, DEXP = 1024;
constexpr int PMAX = M * 4 + NEXP * 256, NTMAX = PMAX / 256;
constexpr float ALPHA = 1.41421356237f;
constexpr int NPHASES = 21;
#ifndef MOE_FP8
#define MOE_FP8 1
#endif
constexpr bool kMoeFp8 = (MOE_FP8 != 0);
constexpr unsigned kScaleGU = 0x79797979u, kScaleDN = 0x78787878u;
#ifndef MK_N_LAUNCHES
#define MK_N_LAUNCHES 1
#endif
constexpr int N_LAUNCHES = MK_N_LAUNCHES;

enum { I_X = 0, I_P, I_AB_WIN, I_AB_QG, I_AB_KVG, I_AB_WUQ, I_AB_WUK, I_AB_WUV, I_AB_WQIDX, I_AB_KIG, I_AB_KIB, I_AB_CONVW, I_AB_ALOG, I_AB_DTB, I_AB_ONG, I_AB_WOUT,
       I_CD_WIN, I_CD_POOLW, I_CD_POOLS, I_CD_WOUT, I_LNM_G, I_LNM_B, I_RW, I_RB, I_WGU, I_BGU, I_WDN, I_BDN, I_PLE_WP, I_PLE_WG, I_LNF_G, I_LNF_B, N_IN };

constexpr size_t MiB = 1u << 20;
constexpr size_t WS_CTL = 0, CTL_ZERO_BYTES = 1 * MiB;
constexpr size_t WS_W_INAB = 1 * MiB;
constexpr size_t WS_W_ABS = 6 * MiB;
constexpr size_t WS_W_OUTAB = 7 * MiB;
constexpr size_t WS_W_INCD = 10 * MiB;
constexpr size_t WS_W_OUTCD = 15 * MiB;
constexpr size_t WS_W_PG = 17 * MiB;
constexpr size_t WS_W_PP = 21 * MiB;
constexpr size_t WS_W_GU = 22 * MiB;
constexpr size_t WS_W_DN = 278 * MiB;
constexpr size_t WS_XB = 406 * MiB;
constexpr size_t WS_PB = 438 * MiB;
constexpr size_t WS_PP = 454 * MiB;
constexpr size_t WS_SM = 518 * MiB;
constexpr size_t WS_QKVZ = 550 * MiB;
constexpr size_t WS_CQ = 630 * MiB;
constexpr size_t WS_CKV = 638 * MiB;
constexpr size_t WS_KIDX = 642 * MiB;
constexpr size_t WS_WIDX = 644 * MiB;
constexpr size_t WS_BETA = 645 * MiB;
constexpr size_t WS_GG = WS_BETA + 512 * 1024;
constexpr size_t WS_QN = 646 * MiB, WS_KN = 662 * MiB, WS_VN = 678 * MiB;
constexpr size_t WS_QL = 694 * MiB;
constexpr size_t WS_CHK = 742 * MiB;
constexpr size_t WS_SEL = 838 * MiB;
constexpr size_t WS_NSEL = 854 * MiB;
constexpr size_t WS_ODELTA = 855 * MiB;
constexpr size_t WS_AO = 887 * MiB;
constexpr size_t WS_PRE = 935 * MiB;
constexpr size_t WS_H1 = 999 * MiB;
constexpr size_t WS_H2 = 1063 * MiB;
constexpr size_t WS_H1B = 1127 * MiB;
constexpr size_t WS_PLE = 1159 * MiB;
constexpr size_t WS_ROUTE = 1191 * MiB;
constexpr size_t WS_BIG = 1193 * MiB;
constexpr size_t WS_XS = WS_BIG, WS_HID = WS_BIG + 144 * MiB, WS_YS = WS_BIG + 288 * MiB;
constexpr size_t WS_END = WS_BIG + 512 * MiB;
static_assert((size_t)PMAX * 1024 * 2 <= 144 * MiB && WS_END <= 2048 * MiB, "d_ws map");
constexpr size_t CHK_WP = 0, CHK_QD = 16384, CHK_KDT = 32768, CHK_QK = 49152, CHK_UT = 57344, CHK_GL = 90112, CHK_STRIDE = 92160;
static_assert(CHK_STRIDE * 1024 <= 96 * MiB, "chunk operands");
constexpr int CW_TMO = 0, CW_CODE = 1;
constexpr int CW_BAR = 4096;
constexpr int CW_BAR2 = 8192;
constexpr int CW_CNT = 16384;

constexpr int RING_OFF = 0, RING_BYTES = 131072;
constexpr int WSCR_OFF = 132096, WSCR_BYTES = 1024;
constexpr int MISC_OFF = 140288;
constexpr int LDS_BYTES = 147456;

#define GAS __attribute__((address_space(1)))
#define LAS __attribute__((address_space(3)))
typedef unsigned short bf16;
typedef unsigned v4u __attribute__((ext_vector_type(4)));
typedef unsigned v2u __attribute__((ext_vector_type(2)));
typedef float f32x4 __attribute__((ext_vector_type(4)));
typedef short bf16x8 __attribute__((ext_vector_type(8)));
typedef GAS unsigned gu32;
#define RLX_AGENT __ATOMIC_RELAXED, __HIP_MEMORY_SCOPE_AGENT
__device__ __forceinline__ unsigned f2bf(float f) { unsigned u = __builtin_bit_cast(unsigned, f); return (u + 0x7fffu + ((u >> 16) & 1u)) >> 16; }
__device__ __forceinline__ unsigned pk2(float lo, float hi) { return f2bf(lo) | (f2bf(hi) << 16); }
__device__ __forceinline__ float bflo(unsigned w) { return __uint_as_float(w << 16); }
__device__ __forceinline__ float bfhi(unsigned w) { return __uint_as_float(w & 0xffff0000u); }
__device__ __forceinline__ float bf1(bf16 h) { return __uint_as_float(((unsigned)h) << 16); }
__device__ __forceinline__ float sigm(float x) { return 1.0f / (1.0f + __expf(-x)); }
__device__ __forceinline__ float siluf(float x) { return x / (1.0f + __expf(-x)); }
__device__ __forceinline__ float wave_sum(float v) {
#pragma unroll
    for (int o = 1; o < 64; o <<= 1) v += __shfl_xor(v, o);
    return v;
}
__device__ __forceinline__ float wave_max(float v) {
#pragma unroll
    for (int o = 1; o < 64; o <<= 1) v = fmaxf(v, __shfl_xor(v, o));
    return v;
}
__device__ __forceinline__ int wave_sum_i(int v) {
#pragma unroll
    for (int o = 1; o < 64; o <<= 1) v += __shfl_xor(v, o);
    return v;
}
__device__ __forceinline__ void unpack8(const v4u w, float (&f)[8]) { f[0] = bflo(w.x); f[1] = bfhi(w.x); f[2] = bflo(w.y); f[3] = bfhi(w.y); f[4] = bflo(w.z); f[5] = bfhi(w.z); f[6] = bflo(w.w); f[7] = bfhi(w.w); }
__device__ __forceinline__ v4u pack8f(const float (&f)[8]) { v4u w; w.x = pk2(f[0], f[1]); w.y = pk2(f[2], f[3]); w.z = pk2(f[4], f[5]); w.w = pk2(f[6], f[7]); return w; }

#define XB_TMO      128
#define XB_XCNT(j)  (256  + 64 * (j))
#define XB_XSUB(j)  (1280 + 64 * (j))
#define XB_XGEN(j)  (2304 + 64 * (j))
#define XB_TOP      3328
#define XB_TOPGEN   3392
#define XCD_BAR_WORDS 3456
#define XB_SPIN_CAP (1u << 18)

__device__ __forceinline__ unsigned xb_ld(unsigned* p)              { return __hip_atomic_load(p, __ATOMIC_RELAXED, __HIP_MEMORY_SCOPE_AGENT); }
__device__ __forceinline__ unsigned xb_add(unsigned* p, unsigned v) { return __hip_atomic_fetch_add(p, v, __ATOMIC_RELAXED, __HIP_MEMORY_SCOPE_AGENT); }
__device__ __forceinline__ unsigned xb_xcc_id() { return (unsigned)__builtin_amdgcn_s_getreg((3 << 11) | 20) & 0xFu; }
#define XB_SPIN(cond, bar) do { unsigned _sp = 0; while (cond) { __builtin_amdgcn_s_sleep(1); \
    if ((++_sp & 255u) == 0u) { if (xb_ld(&(bar)[XB_TMO])) break; if (_sp > XB_SPIN_CAP) { atomicAdd(&(bar)[XB_TMO], 1u); break; } } } } while (0)

struct XcdBarrier {
    unsigned* bar; unsigned x;
    unsigned expect;
    volatile LAS unsigned* st;
};

__device__ __forceinline__ XcdBarrier xcd_barrier_post(unsigned* bar, volatile LAS unsigned* st, unsigned expect = 0u) {
    XcdBarrier b; b.bar = bar; b.x = xb_xcc_id(); b.st = st; b.expect = expect ? expect : gridDim.x * gridDim.y * gridDim.z;
    if (threadIdx.x == 0) (void)xb_add(&bar[XB_XCNT(b.x)], 1u);
    return b;
}
__device__ __forceinline__ void xcd_barrier_complete(unsigned* bar, unsigned x, unsigned& nloc, unsigned& nx, const unsigned G) {
    unsigned sum, cnt, mine, sp = 0u;
    for (;;) {
        sum = 0u; cnt = 0u; mine = 0u;
#pragma unroll
        for (unsigned j = 0; j < 16; ++j) { const unsigned c = xb_ld(&bar[XB_XCNT(j)]); sum += c; cnt += (c > 0u) ? 1u : 0u; mine = (j == x) ? c : mine; }
        if (sum == G) break;
        __builtin_amdgcn_s_sleep(1);
        if ((++sp & 255u) == 0u) { if (xb_ld(&bar[XB_TMO])) break; if (sp > XB_SPIN_CAP) { atomicAdd(&bar[XB_TMO], 1u); break; } }
    }
    nloc = mine > 0u ? mine : 1u; nx = cnt > 0u ? cnt : 1u;
}

__device__ __forceinline__ void xcd_barrier(const XcdBarrier& b) {
    asm volatile("s_waitcnt vmcnt(0)" ::: "memory");
    __syncthreads();
    if (threadIdx.x == 0) {
        unsigned* bar = b.bar;
        __builtin_amdgcn_s_waitcnt(0);
        unsigned nloc = b.st[0], nx = b.st[1];
        if (nloc == 0u) { xcd_barrier_complete(bar, b.x, nloc, nx, b.expect); b.st[0] = nloc; b.st[1] = nx; }
        const unsigned old = xb_add(&bar[XB_XSUB(b.x)], 1u);
        const unsigned gen = old / nloc;
        if (old + 1u == (gen + 1u) * nloc) {
            __builtin_amdgcn_fence(__ATOMIC_RELEASE, "agent");
            asm volatile("s_waitcnt vmcnt(0)" ::: "memory");
            const unsigned og = xb_add(&bar[XB_TOP], 1u);
            const unsigned tg = og / nx;
            if (og + 1u == (tg + 1u) * nx) xb_add(&bar[XB_TOPGEN], 1u);
            else XB_SPIN(xb_ld(&bar[XB_TOPGEN]) == tg, bar);
            __builtin_amdgcn_fence(__ATOMIC_ACQUIRE, "agent");
            xb_add(&bar[XB_XGEN(b.x)], 1u);
            asm volatile("s_waitcnt vmcnt(0)" ::: "memory");
        } else {
            XB_SPIN(xb_ld(&bar[XB_XGEN(b.x)]) == gen, bar);
            __builtin_amdgcn_fence(__ATOMIC_ACQUIRE, "agent");
            asm volatile("s_waitcnt vmcnt(0)" ::: "memory");
        }
    }
    __syncthreads();
}

struct Args { const float* in[N_IN]; float* out; unsigned char* ws; int ph_lo, ph_hi, li, pad; };
typedef const __attribute__((address_space(4))) Args* KArgs;
__device__ __forceinline__ KArgs kargs() { auto p = __builtin_amdgcn_kernarg_segment_ptr(); asm volatile("" : "+s"(p)); return (KArgs)p; }
struct Frame {
    LAS unsigned char* lds;
    int tid, lane, wave, G, bid;
    unsigned char* ws;
    gu32* ctl;
};
#define WSP(T, off) ((T*)(F.ws + (off)))

struct MapId { __device__ __forceinline__ int operator()(int n) const { return n; } };
struct MapAdd { int off; __device__ __forceinline__ int operator()(int n) const { return n + off; } };
struct MapAB { __device__ __forceinline__ int operator()(int n) const { return n < 456 ? n : (n < 2504 ? n + 56 : n - 2048); } };
template <class Map> __device__ __forceinline__ void wg_transpose_item(const float* W, int N, int ldw, bf16* WT, int ldt, int koff, Map map, LAS float* scr, int item, int tid) {
    const int nblk = (N + 127) >> 7, kb = item / nblk, nb = item - kb * nblk, k0 = kb * 128, n0 = nb * 128;
#pragma unroll
    for (int it = 0; it < 8; ++it) {
        const int row = it * 16 + (tid >> 5), c4 = (tid & 31) * 4, n = n0 + c4;
        f32x4 v = (f32x4){0.f, 0.f, 0.f, 0.f};
        if (n + 3 < N) v = *(const f32x4*)(W + (size_t)(k0 + row) * ldw + n);
        LAS float* s = scr + row * 129 + c4; s[0] = v[0]; s[1] = v[1]; s[2] = v[2]; s[3] = v[3];
    }
    __syncthreads();
#pragma unroll
    for (int j = 0; j < 4; ++j) {
        const int idx = j * 512 + tid, nl = idx >> 4, ch = idx & 15, n = n0 + nl;
        if (n < N) { const LAS float* s = scr + (ch * 8) * 129 + nl;
            v4u o; o.x = pk2(s[0], s[129]); o.y = pk2(s[2 * 129], s[3 * 129]); o.z = pk2(s[4 * 129], s[5 * 129]); o.w = pk2(s[6 * 129], s[7 * 129]);
            *(v4u*)(WT + (size_t)map(n) * ldt + koff + k0 + ch * 8) = o; }
    }
    __syncthreads();
}
__device__ __forceinline__ void wg_transpose_item_fp8(const float* W, int N, int ldw, unsigned char* WT, int ldt, float mul, LAS float* scr, int item, int tid) {
    const int nblk = (N + 127) >> 7, kb = item / nblk, nb = item - kb * nblk, k0 = kb * 128, n0 = nb * 128;
#pragma unroll
    for (int it = 0; it < 8; ++it) {
        const int row = it * 16 + (tid >> 5), c4 = (tid & 31) * 4;
        const f32x4 v = *(const f32x4*)(W + (size_t)(k0 + row) * ldw + n0 + c4);
        LAS float* s = scr + row * 129 + c4; s[0] = v[0]; s[1] = v[1]; s[2] = v[2]; s[3] = v[3];
    }
    __syncthreads();
#pragma unroll
    for (int j = 0; j < 2; ++j) {
        const int idx = j * 512 + tid, nl = idx >> 3, ch = idx & 7;
        const LAS float* s = scr + (ch * 16) * 129 + nl;
        v4u o;
#pragma unroll
        for (int q = 0; q < 4; ++q) { unsigned w = 0u;
            w = __builtin_amdgcn_cvt_pk_fp8_f32(s[(4 * q) * 129] * mul, s[(4 * q + 1) * 129] * mul, w, false);
            w = __builtin_amdgcn_cvt_pk_fp8_f32(s[(4 * q + 2) * 129] * mul, s[(4 * q + 3) * 129] * mul, w, true);
            o[q] = w; }
        *(v4u*)(WT + (size_t)(n0 + nl) * ldt + k0 + ch * 16) = o;
    }
    __syncthreads();
}
struct MoeItem { const float* W; unsigned char* WT; int N; float mul; int k0, n0; };
__device__ __forceinline__ MoeItem moe_item(KArgs A, unsigned char* ws, int it) {
    MoeItem d; int sub;
    if (it < 64 * 128) { const int m = it >> 7; sub = it & 127; d.W = A->in[I_WGU] + (size_t)m * 1024 * 2048; d.N = 2048; d.WT = ws + WS_W_GU + (size_t)m * 2048 * 1024; d.mul = 64.0f; }
    else { it -= 64 * 128; const int m = it >> 6; sub = it & 63; d.W = A->in[I_WDN] + (size_t)m * 1024 * 1024; d.N = 1024; d.WT = ws + WS_W_DN + (size_t)m * 1024 * 1024; d.mul = 128.0f; }
    const int nblk = d.N >> 7, kb = sub / nblk, nb = sub - kb * nblk; d.k0 = kb * 128; d.n0 = nb * 128; return d;
}
__device__ __forceinline__ void p0_moe_fp8(Frame& F, KArgs A) {
    LAS float* scr = (LAS float*)(F.lds + RING_OFF);
    const int tid = F.tid; constexpr int NIT = 64 * 128 + 64 * 64;
    int it = F.bid; if (it >= NIT) return;
    MoeItem cur = moe_item(A, F.ws, it);
    f32x4 r[8];
#pragma unroll
    for (int x = 0; x < 8; ++x) r[x] = __builtin_nontemporal_load((const f32x4*)(cur.W + (size_t)(cur.k0 + x * 16 + (tid >> 5)) * cur.N + cur.n0 + (tid & 31) * 4));
    for (;;) {
#pragma unroll
        for (int x = 0; x < 8; ++x) { LAS float* sp = scr + (x * 16 + (tid >> 5)) * 129 + (tid & 31) * 4; sp[0] = r[x][0]; sp[1] = r[x][1]; sp[2] = r[x][2]; sp[3] = r[x][3]; }
        __syncthreads();
        const int nx = it + F.G; MoeItem nxt = cur;
        if (nx < NIT) { nxt = moe_item(A, F.ws, nx);
#pragma unroll
            for (int x = 0; x < 8; ++x) r[x] = __builtin_nontemporal_load((const f32x4*)(nxt.W + (size_t)(nxt.k0 + x * 16 + (tid >> 5)) * nxt.N + nxt.n0 + (tid & 31) * 4)); }
#pragma unroll
        for (int j = 0; j < 2; ++j) {
            const int idx = j * 512 + tid, nl = idx >> 3, ch = idx & 7;
            const LAS float* sp = scr + (ch * 16) * 129 + nl;
            v4u o;
#pragma unroll
            for (int q = 0; q < 4; ++q) { unsigned w = 0u;
                w = __builtin_amdgcn_cvt_pk_fp8_f32(sp[(4 * q) * 129] * cur.mul, sp[(4 * q + 1) * 129] * cur.mul, w, false);
                w = __builtin_amdgcn_cvt_pk_fp8_f32(sp[(4 * q + 2) * 129] * cur.mul, sp[(4 * q + 3) * 129] * cur.mul, w, true);
                o[q] = w; }
            *(v4u*)(cur.WT + (size_t)(cur.n0 + nl) * 1024 + cur.k0 + ch * 16) = o;
        }
        __syncthreads();
        if (nx >= NIT) break;
        cur = nxt; it = nx;
    }
}
__device__ __forceinline__ void p0_prologue(Frame& F, KArgs A) {
    LAS float* scr = (LAS float*)(F.lds + RING_OFF);
    const int tid = F.tid;
    constexpr int IT_GU = 128, IT_DN = 64;
    constexpr int N_GU = 64 * IT_GU, N_DN = 64 * IT_DN;
    constexpr int N_INAB = 8 * 20, N_INCD = 8 * 20, N_OUTCD = 64, N_PG = 2 * 64, N_PP = 2 * 2 * 8, N_QIDX = 2 * 4, N_OUTB = 4 * 8;
    constexpr int NITEMS = N_GU + N_DN + N_INAB + N_INCD + N_OUTCD + N_PG + N_PP + N_QIDX + N_OUTB;
    if (kMoeFp8) p0_moe_fp8(F, A);
    for (int it = F.bid + (kMoeFp8 ? N_GU + N_DN : 0); it < NITEMS; it += F.G) {
        int r = it;
        if (r < N_GU) { const int m = r / IT_GU;
            if (kMoeFp8) wg_transpose_item_fp8(A->in[I_WGU] + (size_t)m * 1024 * 2048, 2048, 2048, WSP(unsigned char, WS_W_GU) + (size_t)m * 2048 * 1024, 1024, 64.0f, scr, r % IT_GU, tid);
            else wg_transpose_item(A->in[I_WGU] + (size_t)m * 1024 * 2048, 2048, 2048, WSP(bf16, WS_W_GU) + (size_t)m * 2048 * 1024, 1024, 0, MapId{}, scr, r % IT_GU, tid);
            continue; } r -= N_GU;
        if (r < N_DN) { const int m = r / IT_DN;
            if (kMoeFp8) wg_transpose_item_fp8(A->in[I_WDN] + (size_t)m * 1024 * 1024, 1024, 1024, WSP(unsigned char, WS_W_DN) + (size_t)m * 1024 * 1024, 1024, 128.0f, scr, r % IT_DN, tid);
            else wg_transpose_item(A->in[I_WDN] + (size_t)m * 1024 * 1024, 1024, 1024, WSP(bf16, WS_W_DN) + (size_t)m * 1024 * 1024, 1024, 0, MapId{}, scr, r % IT_DN, tid);
            continue; } r -= N_DN;
        if (r < N_INAB) { wg_transpose_item(A->in[I_AB_WIN], 2512, 2512, WSP(bf16, WS_W_INAB), 1024, 0, MapAB{}, scr, r, tid); continue; } r -= N_INAB;
        if (r < N_INCD) { wg_transpose_item(A->in[I_CD_WIN], 2560, 2560, WSP(bf16, WS_W_INCD), 1024, 0, MapId{}, scr, r, tid); continue; } r -= N_INCD;
        if (r < N_OUTCD) { wg_transpose_item(A->in[I_CD_WOUT], 1024, 1024, WSP(bf16, WS_W_OUTCD), 1024, 0, MapId{}, scr, r, tid); continue; } r -= N_OUTCD;
        if (r < N_PG) { const int l = r / 64; wg_transpose_item(A->in[I_PLE_WG] + (size_t)l * 1024 * 1024, 1024, 1024, WSP(bf16, WS_W_PG) + (size_t)l * 1024 * 1024, 1024, 0, MapId{}, scr, r % 64, tid); continue; } r -= N_PG;
        if (r < N_PP) { const int l = r / 16; wg_transpose_item(A->in[I_PLE_WP] + (size_t)l * 256 * 1024, 1024, 1024, WSP(bf16, WS_W_PP) + (size_t)l * 1024 * 256, 256, 0, MapId{}, scr, r % 16, tid); continue; } r -= N_PP;
        if (r < N_QIDX) { wg_transpose_item(A->in[I_AB_WQIDX], 512, 512, WSP(bf16, WS_W_ABS), 256, 0, MapAdd{1024}, scr, r, tid); continue; } r -= N_QIDX;
        wg_transpose_item(A->in[I_AB_WOUT] + (size_t)512 * 1024, 1024, 1024, WSP(bf16, WS_W_OUTAB), 1536, 1024, MapId{}, scr, r, tid);
    }
    const size_t gt = (size_t)F.bid * NTHREADS + tid, GT = (size_t)F.G * NTHREADS;
    for (size_t i = gt; i < (size_t)48 * 1024 / 8; i += GT) *(v4u*)(WSP(bf16, WS_W_INAB) + (size_t)464 * 1024 + i * 8) = (v4u){0u, 0u, 0u, 0u};
    for (size_t i = gt; i < (size_t)1024 * 256; i += GT) {
        const int n = (int)(i >> 8), c = (int)(i & 255), h = n >> 7, r = n & 127;
        const float* a = A->in[I_AB_WUQ] + (size_t)c * 512 + h * 64; const float* b = A->in[I_AB_WUK] + (size_t)r * 512 + h * 64;
        float s = 0.f;
#pragma unroll 8
        for (int d = 0; d < 64; d += 4) { const f32x4 x = *(const f32x4*)(a + d), y = *(const f32x4*)(b + d); s += x[0] * y[0] + x[1] * y[1] + x[2] * y[2] + x[3] * y[3]; }
        WSP(bf16, WS_W_ABS)[i] = (bf16)f2bf(s * 0.125f);
    }
    for (size_t i = gt; i < (size_t)1024 * 1024; i += GT) {
        const int n = (int)(i >> 10), k = (int)(i & 1023), h = k >> 7, r = k & 127;
        const float* a = A->in[I_AB_WUV] + (size_t)r * 512 + h * 64; const float* b = A->in[I_AB_WOUT] + (size_t)(h * 64) * 1024 + n;
        float s = 0.f;
#pragma unroll 8
        for (int v = 0; v < 64; ++v) s += a[v] * b[(size_t)v * 1024];
        WSP(bf16, WS_W_OUTAB)[(size_t)n * 1536 + k] = (bf16)f2bf(s);
    }
    for (size_t i = gt; i < (size_t)M * D / 8; i += GT) { const f32x4 a = *(const f32x4*)(A->in[I_X] + i * 8), b = *(const f32x4*)(A->in[I_X] + i * 8 + 4);
        v4u o; o.x = pk2(a[0], a[1]); o.y = pk2(a[2], a[3]); o.z = pk2(b[0], b[1]); o.w = pk2(b[2], b[3]); *(v4u*)(WSP(bf16, WS_XB) + i * 8) = o; }
    for (size_t i = gt; i < (size_t)2 * M * 256 / 8; i += GT) { const f32x4 a = *(const f32x4*)(A->in[I_P] + i * 8), b = *(const f32x4*)(A->in[I_P] + i * 8 + 4);
        v4u o; o.x = pk2(a[0], a[1]); o.y = pk2(a[2], a[3]); o.z = pk2(b[0], b[1]); o.w = pk2(b[2], b[3]); *(v4u*)(WSP(bf16, WS_PB) + i * 8) = o; }
}

__device__ __forceinline__ void p2_prep(Frame& F, KArgs A) {
    const int lane = F.lane, gw = F.bid * NWAVES + F.wave, NGW = F.G * NWAVES;
    const float* SM = WSP(float, WS_SM); const bf16* QZ = WSP(bf16, WS_QKVZ);
    const f32x4 qg = *(const f32x4*)(A->in[I_AB_QG] + 4 * lane);
    const f32x4 kvg = *(const f32x4*)(A->in[I_AB_KVG] + 4 * (lane & 31));
    const f32x4 kig = *(const f32x4*)(A->in[I_AB_KIG] + 4 * (lane & 15)), kib = *(const f32x4*)(A->in[I_AB_KIB] + 4 * (lane & 15));
    const f32x4 alog = *(const f32x4*)(A->in[I_AB_ALOG]), dtb = *(const f32x4*)(A->in[I_AB_DTB]);
    LAS float* cw = (LAS float*)(F.lds);
    {   f32x4 wv[3]; int t0 = F.tid; asm volatile("" : "+v"(t0));
#pragma unroll
        for (int j = 0; j < 3; ++j) wv[j] = *(const f32x4*)(A->in[I_AB_CONVW] + (size_t)(t0 + NTHREADS * j) * 4);
#pragma unroll
        for (int j = 0; j < 3; ++j) *(LAS f32x4*)(cw + (t0 + NTHREADS * j) * 4) = wv[j];
    }
    __syncthreads();
    for (int row = gw; row < M; row += NGW) {
        const int t = row & (SEQ - 1);
        const f32x4 a = *(const f32x4*)(SM + (size_t)row * 512 + 4 * lane), b = *(const f32x4*)(SM + (size_t)row * 512 + 256 + 4 * lane);
        {
            const float ss = wave_sum(a[0] * a[0] + a[1] * a[1] + a[2] * a[2] + a[3] * a[3]);
            const float r = rsqrtf(ss * (1.0f / 256.0f) + 1e-6f);
            v2u o; o.x = pk2(a[0] * r * qg[0], a[1] * r * qg[1]); o.y = pk2(a[2] * r * qg[2], a[3] * r * qg[3]);
            *(v2u*)(WSP(bf16, WS_CQ) + (size_t)row * 256 + 4 * lane) = o;
        }
        {
            const float ss = wave_sum(lane < 32 ? (b[0] * b[0] + b[1] * b[1] + b[2] * b[2] + b[3] * b[3]) : 0.f);
            const float r = rsqrtf(ss * (1.0f / 128.0f) + 1e-6f);
            if (lane < 32) { v2u o; o.x = pk2(b[0] * r * kvg[0], b[1] * r * kvg[1]); o.y = pk2(b[2] * r * kvg[2], b[3] * r * kvg[3]);
                *(v2u*)(WSP(bf16, WS_CKV) + (size_t)row * 128 + 4 * lane) = o; }
        }
        {
            const bool in = (lane >= 32 && lane < 48);
            const float mean = wave_sum(in ? (b[0] + b[1] + b[2] + b[3]) : 0.f) * (1.0f / 64.0f);
            const f32x4 d = b - mean;
            const float var = wave_sum(in ? (d[0] * d[0] + d[1] * d[1] + d[2] * d[2] + d[3] * d[3]) : 0.f) * (1.0f / 64.0f);
            const float r = rsqrtf(var + 1e-5f);
            if (in) { v2u o; o.x = pk2(d[0] * r * kig[0] + kib[0], d[1] * r * kig[1] + kib[1]); o.y = pk2(d[2] * r * kig[2] + kib[2], d[3] * r * kig[3] + kib[3]);
                *(v2u*)(WSP(bf16, WS_KIDX) + (size_t)row * 64 + 4 * (lane - 32)) = o; }
        }
        if (lane == 48 || lane == 49) *(f32x4*)(WSP(float, WS_WIDX) + (size_t)row * 8 + 4 * (lane - 48)) = b * 0.044194173824159216f;
        if (lane == 50) { f32x4 o; o[0] = sigm(b[0]); o[1] = sigm(b[1]); o[2] = sigm(b[2]); o[3] = sigm(b[3]); *(f32x4*)(WSP(float, WS_BETA) + (size_t)row * 4) = o; }
        if (lane == 51) { f32x4 o;
#pragma unroll
            for (int h = 0; h < 4; ++h) { const float xx = b[h] + dtb[h]; const float sp = xx > 20.f ? xx : log1pf(__expf(xx)); o[h] = -__expf(alog[h]) * sp; }
            *(f32x4*)(WSP(float, WS_GG) + (size_t)row * 4) = o; }
        v4u xr[3][4];
#pragma unroll
        for (int sel = 0; sel < 3; ++sel)
#pragma unroll
            for (int j = 0; j < 4; ++j) { const int back = (t - 3 + j >= 0) ? (3 - j) : 0; xr[sel][j] = *(const v4u*)(QZ + (size_t)(row - back) * 2048 + sel * 512 + 8 * lane); }
#pragma unroll
        for (int sel = 0; sel < 3; ++sel) {
            const int col0 = sel * 512 + 8 * lane;
            float acc[8];
#pragma unroll
            for (int i = 0; i < 8; ++i) acc[i] = 0.f;
#pragma unroll
            for (int j = 0; j < 4; ++j) {
                float xv[8]; unpack8(xr[sel][j], xv);
                const f32x4 w0 = *(const LAS f32x4*)(cw + j * 1536 + col0), w1 = *(const LAS f32x4*)(cw + j * 1536 + col0 + 4);
                const float m = (t - 3 + j >= 0) ? 1.f : 0.f;
#pragma unroll
                for (int i = 0; i < 4; ++i) { acc[i] += w0[i] * m * xv[i]; acc[4 + i] += w1[i] * m * xv[4 + i]; }
            }
            float ss = 0.f;
#pragma unroll
            for (int i = 0; i < 8; ++i) { acc[i] = siluf(acc[i]); ss += acc[i] * acc[i]; }
            if (sel < 2) {
                ss += __shfl_xor(ss, 1); ss += __shfl_xor(ss, 2); ss += __shfl_xor(ss, 4); ss += __shfl_xor(ss, 8);
                const float sc = rsqrtf(ss + 1e-6f) * (sel == 0 ? 0.08838834764831845f : 1.0f);
#pragma unroll
                for (int i = 0; i < 8; ++i) acc[i] *= sc;
            }
            bf16* dst = (sel == 0 ? WSP(bf16, WS_QN) : (sel == 1 ? WSP(bf16, WS_KN) : WSP(bf16, WS_VN))) + (size_t)row * 512 + 8 * lane;
            *(v4u*)dst = pack8f(acc);
        }
    }
}

__device__ __forceinline__ void p3_chunk_prep(Frame& F, KArgs A) {
    int tid = F.tid; asm volatile("" : "+v"(tid));
    const int lane = tid & 63;
    constexpr int P = 132;
    LAS float* qs = (LAS float*)(F.lds); LAS float* ks = qs + 64 * P; LAS float* vs = ks + 64 * P;
    LAS float* As = vs + 64 * P;
    LAS float* gcS = As + 64 * 65; LAS float* egS = gcS + 64; LAS float* ekS = egS + 64; LAS float* btS = ekS + 64;
    LAS float* Ts = qs;
    for (int cidx = F.bid; cidx < 1024; cidx += F.G) {
        const int b = cidx >> 9, h = (cidx >> 7) & 3, n = cidx & 127, row0 = b * SEQ + n * 64;
        unsigned char* blk = F.ws + WS_CHK + (size_t)cidx * CHK_STRIDE;
        if (tid < 64) {
            const float g = WSP(float, WS_GG)[(size_t)(row0 + tid) * 4 + h];
            float gc = g;
#pragma unroll
            for (int o = 1; o < 64; o <<= 1) { const float t = __shfl_up(gc, o); if (lane >= o) gc += t; }
            const float g63 = __shfl(gc, 63);
            gcS[tid] = gc; egS[tid] = __expf(gc); ekS[tid] = __expf(g63 - gc); btS[tid] = WSP(float, WS_BETA)[(size_t)(row0 + tid) * 4 + h];
            if (tid == 0) *(float*)(blk + CHK_GL) = __expf(g63);
        }
#pragma unroll
        for (int i = 0; i < 2; ++i) {
            const int id = tid + 512 * i, r = id >> 4, c8 = (id & 15) * 8; const size_t so = (size_t)(row0 + r) * 512 + h * 128 + c8;
            float f[8];
            unpack8(*(const v4u*)(WSP(bf16, WS_QN) + so), f);
            *(LAS f32x4*)(qs + r * P + c8) = (f32x4){f[0], f[1], f[2], f[3]}; *(LAS f32x4*)(qs + r * P + c8 + 4) = (f32x4){f[4], f[5], f[6], f[7]};
            unpack8(*(const v4u*)(WSP(bf16, WS_KN) + so), f);
            *(LAS f32x4*)(ks + r * P + c8) = (f32x4){f[0], f[1], f[2], f[3]}; *(LAS f32x4*)(ks + r * P + c8 + 4) = (f32x4){f[4], f[5], f[6], f[7]};
            unpack8(*(const v4u*)(WSP(bf16, WS_VN) + so), f);
            *(LAS f32x4*)(vs + r * P + c8) = (f32x4){f[0], f[1], f[2], f[3]}; *(LAS f32x4*)(vs + r * P + c8 + 4) = (f32x4){f[4], f[5], f[6], f[7]};
        }
        __syncthreads();
        {
            const int i = tid >> 3, t7 = tid & 7;
            float aK[8], aQ[8];
#pragma unroll
            for (int x = 0; x < 8; ++x) { aK[x] = 0.f; aQ[x] = 0.f; }
#pragma unroll 1
            for (int d = 0; d < 128; d += 4) {
                const f32x4 ki = *(const LAS f32x4*)(ks + i * P + d), qi = *(const LAS f32x4*)(qs + i * P + d);
#pragma unroll
                for (int x = 0; x < 8; ++x) { const f32x4 kj = *(const LAS f32x4*)(ks + (t7 + 8 * x) * P + d);
                    aK[x] += ki[0] * kj[0] + ki[1] * kj[1] + ki[2] * kj[2] + ki[3] * kj[3]; aQ[x] += qi[0] * kj[0] + qi[1] * kj[1] + qi[2] * kj[2] + qi[3] * kj[3]; }
            }
            const float gci = gcS[i], bti = btS[i];
            bf16* QKp = (bf16*)(blk + CHK_QK) + i * 64;
#pragma unroll
            for (int x = 0; x < 8; ++x) { const int j = t7 + 8 * x; const float dec = __expf(j <= i ? gci - gcS[j] : 0.f);
                As[i * 65 + j] = (j < i) ? bti * aK[x] * dec : 0.f;
                QKp[32 * (j >> 5) + 8 * ((j >> 2) & 3) + 4 * ((j >> 4) & 1) + (j & 3)] = (bf16)f2bf((j <= i) ? aQ[x] * dec : 0.f); }
        }
        {
            const int i = tid >> 3, d0 = (tid & 7) * 16, s = d0 >> 5, a = (d0 >> 4) & 1; const float e = egS[i];
            bf16* Qd = (bf16*)(blk + CHK_QD) + i * 128;
#pragma unroll
            for (int q = 0; q < 4; ++q) { const f32x4 p = *(const LAS f32x4*)(qs + i * P + d0 + 4 * q); v2u w; w.x = pk2(p[0] * e, p[1] * e); w.y = pk2(p[2] * e, p[3] * e); *(v2u*)(Qd + 32 * s + 8 * q + 4 * a) = w; }
        }
        {
            const int d = tid >> 2, c0 = (tid & 3) * 16, s = c0 >> 5, a = (c0 >> 4) & 1;
            bf16* Kd = (bf16*)(blk + CHK_KDT) + d * 64;
#pragma unroll
            for (int q = 0; q < 4; ++q) { const int c = c0 + 4 * q;
                v2u w; w.x = pk2(ks[c * P + d] * ekS[c], ks[(c + 1) * P + d] * ekS[c + 1]); w.y = pk2(ks[(c + 2) * P + d] * ekS[c + 2], ks[(c + 3) * P + d] * ekS[c + 3]);
                *(v2u*)(Kd + 32 * s + 8 * q + 4 * a) = w; }
        }
        __syncthreads();
        {
            const int c = tid >> 3, part = tid & 7;
            for (int i = 0; i < 64; ++i) {
                float acc = 0.f;
                for (int j = part; j < i; j += 8) acc += As[i * 65 + j] * Ts[j * 65 + c];
                acc += __shfl_xor(acc, 1); acc += __shfl_xor(acc, 2); acc += __shfl_xor(acc, 4);
                if (part == 0) Ts[i * 65 + c] = ((i == c) ? 1.f : 0.f) - acc;
                __builtin_amdgcn_fence(__ATOMIC_RELEASE, "wavefront"); asm volatile("s_waitcnt lgkmcnt(0)" ::: "memory");
            }
        }
        __syncthreads();
        {
            const int i = tid >> 3, t7 = tid & 7;
            f32x4 aU[4], aW[4];
#pragma unroll
            for (int xx = 0; xx < 4; ++xx) { aU[xx] = (f32x4){0.f, 0.f, 0.f, 0.f}; aW[xx] = (f32x4){0.f, 0.f, 0.f, 0.f}; }
#pragma unroll 1
            for (int j = 0; j <= i; ++j) {
                const float tb = Ts[i * 65 + j] * btS[j], tbe = tb * egS[j];
#pragma unroll
                for (int xx = 0; xx < 4; ++xx) { aU[xx] += *(const LAS f32x4*)(vs + j * P + 4 * t7 + 32 * xx) * tb; aW[xx] += *(const LAS f32x4*)(ks + j * P + 4 * t7 + 32 * xx) * tbe; }
            }
            float* UT = (float*)(blk + CHK_UT);
            bf16* Wp = (bf16*)(blk + CHK_WP) + i * 128;
#pragma unroll
            for (int xx = 0; xx < 4; ++xx) {
                const int c = 4 * t7 + 32 * xx;
#pragma unroll
                for (int e = 0; e < 4; ++e) UT[(c + e) * 64 + i] = aU[xx][e];
                v2u w; w.x = pk2(aW[xx][0], aW[xx][1]); w.y = pk2(aW[xx][2], aW[xx][3]); *(v2u*)(Wp + 32 * xx + 8 * (t7 & 3) + 4 * (t7 >> 2)) = w;
            }
        }
        __syncthreads();
    }
}

constexpr int SEQ_WGS = 16;
constexpr int SQ_WP = 0, SQ_QD = 16384, SQ_KDT = 32768, SQ_QK = 49152, SQ_BUF = 57344;
__device__ __forceinline__ bf16x8 packfrag(const f32x4 lo, const f32x4 hi) { v4u w; w.x = pg8::cvt_pk_bf16(lo[0], lo[1]); w.y = pg8::cvt_pk_bf16(lo[2], lo[3]); w.z = pg8::cvt_pk_bf16(hi[0], hi[1]); w.w = pg8::cvt_pk_bf16(hi[2], hi[3]); return __builtin_bit_cast(bf16x8, w); }
__device__ __forceinline__ void seq_load(v4u (&r)[14], const unsigned char* blk, int lt) {
#pragma unroll
    for (int i = 0; i < 14; ++i) r[i] = *(const v4u*)(blk + (size_t)(lt + 256 * i) * 16);
}
__device__ __forceinline__ void seq_write(LAS unsigned char* buf, const v4u (&r)[14], int lt) {
#pragma unroll
    for (int i = 0; i < 14; ++i) {
        const int id = lt + 256 * i; int dst;
        if (id < 2048) { const int rr = (id & 1023) >> 4, ch = id & 15; dst = (id & ~1023) * 16 + rr * 256 + 16 * (ch ^ (rr & 15)); }
        else { const int rr = (id - 2048) >> 3, ch = id & 7; dst = 32768 + rr * 128 + 16 * (ch ^ (rr & 7)); }
        *(LAS v4u*)(buf + dst) = r[i];
    }
}
__device__ __forceinline__ void seq_compute(LAS unsigned char* buf, f32x4 (&Sacc)[8], const f32x4 (&U)[4], const float gl, float* op0, const int fr, const int fq) {
    bf16x8 sf[4];
#pragma unroll
    for (int s = 0; s < 4; ++s) sf[s] = packfrag(Sacc[2 * s], Sacc[2 * s + 1]);
    f32x4 Vn[4], Oa[4];
#pragma unroll
    for (int tc = 0; tc < 4; ++tc) {
        const int rr = 16 * tc + fr; f32x4 av = (f32x4){0.f, 0.f, 0.f, 0.f}, ao = (f32x4){0.f, 0.f, 0.f, 0.f};
#pragma unroll
        for (int s = 0; s < 4; ++s) {
            const int off = rr * 256 + 16 * ((4 * s + fq) ^ (rr & 15));
            const bf16x8 wf = *(const LAS bf16x8*)(buf + SQ_WP + off), qf = *(const LAS bf16x8*)(buf + SQ_QD + off);
            av = __builtin_amdgcn_mfma_f32_16x16x32_bf16(wf, sf[s], av, 0, 0, 0);
            ao = __builtin_amdgcn_mfma_f32_16x16x32_bf16(qf, sf[s], ao, 0, 0, 0);
        }
        Vn[tc] = U[tc] - av; Oa[tc] = ao;
    }
    bf16x8 vf[2];
    vf[0] = packfrag(Vn[0], Vn[1]); vf[1] = packfrag(Vn[2], Vn[3]);
#pragma unroll
    for (int tc = 0; tc < 4; ++tc) {
        const int rr = 16 * tc + fr;
#pragma unroll
        for (int s = 0; s < 2; ++s) {
            const bf16x8 kf = *(const LAS bf16x8*)(buf + SQ_QK + rr * 128 + 16 * ((4 * s + fq) ^ (rr & 7)));
            Oa[tc] = __builtin_amdgcn_mfma_f32_16x16x32_bf16(kf, vf[s], Oa[tc], 0, 0, 0);
        }
        float* op = op0 + (size_t)(16 * tc) * 512;
#pragma unroll
        for (int j = 0; j < 4; ++j) op[(size_t)j * 512] = Oa[tc][j];
    }
#pragma unroll
    for (int T = 0; T < 8; ++T) {
        const int rr = 16 * T + fr; f32x4 a = Sacc[T] * gl;
#pragma unroll
        for (int s = 0; s < 2; ++s) {
            const bf16x8 kf = *(const LAS bf16x8*)(buf + SQ_KDT + rr * 128 + 16 * ((4 * s + fq) ^ (rr & 7)));
            a = __builtin_amdgcn_mfma_f32_16x16x32_bf16(kf, vf[s], a, 0, 0, 0);
        }
        Sacc[T] = a;
    }
}
#define SEQ_BAR() do { asm volatile("s_waitcnt lgkmcnt(0)" ::: "memory"); __builtin_amdgcn_s_barrier(); asm volatile("" ::: "memory"); } while (0)
__device__ __forceinline__ void p4_delta_seq(Frame& F, int sid) {
    const int lane = F.lane, wave = F.wave, tid = F.tid;
    const int bh = sid >> 1, half = sid & 1, b = bh >> 2, h = bh & 3;
    const int fr = lane & 15, fq = lane >> 4;
    const int v0 = half * 64 + (wave & 3) * 16;
    const unsigned char* cbase = F.ws + WS_CHK + (size_t)(bh * 128) * CHK_STRIDE;
    if (wave >= 4) {
        const int lt = tid - 256;
        v4u RA[14], RB[14];
#define SEQ_LD(R, blk) do { const unsigned char* _b = (blk); _Pragma("unroll") for (int _i = 0; _i < 14; ++_i) asm volatile("global_load_dwordx4 %0, %1, off" : "=v"(R[_i]) : "v"(_b + (size_t)(lt + 256 * _i) * 16) : "memory"); } while (0)
#define SEQ_WAIT(younger) do { if (younger) asm volatile("s_waitcnt vmcnt(14)" ::: "memory"); else asm volatile("s_waitcnt vmcnt(0)" ::: "memory"); } while (0)
        SEQ_LD(RA, cbase); SEQ_LD(RB, cbase + CHK_STRIDE); SEQ_WAIT(true); seq_write(F.lds, RA, lt); SEQ_LD(RA, cbase + 2 * CHK_STRIDE);
        SEQ_BAR();
#pragma unroll 1
        for (int n = 0; n < 128; n += 2) {
            if (n + 1 < 128) { SEQ_WAIT(n + 2 < 128); seq_write(F.lds + ((n + 1) & 1) * SQ_BUF, RB, lt); } if (n + 3 < 128) SEQ_LD(RB, cbase + (size_t)(n + 3) * CHK_STRIDE);
            SEQ_BAR();
            if (n + 2 < 128) { SEQ_WAIT(n + 3 < 128); seq_write(F.lds + (n & 1) * SQ_BUF, RA, lt); } if (n + 4 < 128) SEQ_LD(RA, cbase + (size_t)(n + 4) * CHK_STRIDE);
            SEQ_BAR();
        }
        asm volatile("s_waitcnt vmcnt(0)" ::: "memory");
#undef SEQ_LD
#undef SEQ_WAIT
    } else {
        float* OD = WSP(float, WS_ODELTA);
        f32x4 Sacc[8], Ucur[4], Unxt[4]; float glc, gln;
#pragma unroll
        for (int T = 0; T < 8; ++T) Sacc[T] = (f32x4){0.f, 0.f, 0.f, 0.f};
#pragma unroll
        for (int tc = 0; tc < 4; ++tc) { Ucur[tc] = *(const f32x4*)((const float*)(cbase + CHK_UT) + (size_t)(v0 + fr) * 64 + 4 * fq + 16 * tc);
                                          Unxt[tc] = *(const f32x4*)((const float*)(cbase + CHK_STRIDE + CHK_UT) + (size_t)(v0 + fr) * 64 + 4 * fq + 16 * tc); }
        glc = *(const float*)(cbase + CHK_GL); gln = *(const float*)(cbase + CHK_STRIDE + CHK_GL);
        SEQ_BAR();
#pragma unroll 1
        for (int n = 0; n < 128; ++n) {
            seq_compute(F.lds + (n & 1) * SQ_BUF, Sacc, Ucur, glc, OD + (size_t)(b * SEQ + n * 64 + 4 * fq) * 512 + h * 128 + v0 + fr, fr, fq);
#pragma unroll
            for (int tc = 0; tc < 4; ++tc) Ucur[tc] = Unxt[tc];
            glc = gln;
            if (n + 2 < 128) { const unsigned char* nb = cbase + (size_t)(n + 2) * CHK_STRIDE; gln = *(const float*)(nb + CHK_GL);
#pragma unroll
                for (int tc = 0; tc < 4; ++tc) Unxt[tc] = *(const f32x4*)((const float*)(nb + CHK_UT) + (size_t)(v0 + fr) * 64 + 4 * fq + 16 * tc); }
            SEQ_BAR();
        }
    }
}
#undef SEQ_BAR

__device__ __forceinline__ float relu1(float x) { float r; asm("v_max_f32_e32 %0, 0, %1" : "=v"(r) : "v"(x)); return r; }
__device__ __forceinline__ void p4_indexer(Frame& F, int widx, int nw) {
    const int lane = F.lane, fr = lane & 15, fq = lane >> 4;
    const bf16* QL = WSP(bf16, WS_QL); const bf16* KI = WSP(bf16, WS_KIDX); const float* WI = WSP(float, WS_WIDX); float* SC = WSP(float, WS_BIG);
    for (int task = widx; task < 2 * 4352; task += nw) {
        const int b = task / 4352; int tau = task - b * 4352;
        int g = 0; while (16 * (g + 1) * (g + 2) <= tau) ++g;
        tau -= 16 * g * (g + 1);
        const int qt = 32 * g + tau / (g + 1), seg = tau % (g + 1);
        const int row0 = b * SEQ + 16 * qt;
        bf16x8 Qf[8][2];
#pragma unroll
        for (int hh = 0; hh < 8; ++hh)
#pragma unroll
            for (int s = 0; s < 2; ++s) Qf[hh][s] = *(const bf16x8*)(QL + (size_t)(row0 + fr) * 1536 + 1024 + hh * 64 + 32 * s + 8 * fq);
        const f32x4 w0 = *(const f32x4*)(WI + (size_t)(row0 + fr) * 8), w1 = *(const f32x4*)(WI + (size_t)(row0 + fr) * 8 + 4);
        const int kt1 = (32 * seg + 31 < qt) ? 32 * seg + 31 : qt;
        for (int kb8 = 32 * seg; kb8 <= kt1; kb8 += 8) {
            bf16x8 kfr[8][2];
#pragma unroll
            for (int x = 0; x < 8; ++x) { const int kt = (kb8 + x <= kt1) ? kb8 + x : kt1; const bf16* kp = KI + (size_t)(b * SEQ + 16 * kt + fr) * 64 + 8 * fq; kfr[x][0] = *(const bf16x8*)kp; kfr[x][1] = *(const bf16x8*)(kp + 32); }
#pragma unroll
            for (int x = 0; x < 8; ++x) asm volatile("" : "+v"(kfr[x][0]), "+v"(kfr[x][1]));
#pragma unroll
            for (int x = 0; x < 8; ++x) {
                const int kt = kb8 + x;
                if (kt <= kt1) {
                    f32x4 isc = (f32x4){0.f, 0.f, 0.f, 0.f}, c[8];
#pragma unroll
                    for (int hh = 0; hh < 8; ++hh) c[hh] = __builtin_amdgcn_mfma_f32_16x16x32_bf16(kfr[x][0], Qf[hh][0], (f32x4){0.f, 0.f, 0.f, 0.f}, 0, 0, 0);
#pragma unroll
                    for (int hh = 0; hh < 8; ++hh) c[hh] = __builtin_amdgcn_mfma_f32_16x16x32_bf16(kfr[x][1], Qf[hh][1], c[hh], 0, 0, 0);
                    __builtin_amdgcn_sched_barrier(0);
#pragma unroll
                    for (int hh = 0; hh < 8; ++hh) { const float wh = (hh < 4) ? w0[hh & 3] : w1[hh & 3];
#pragma unroll
                        for (int j = 0; j < 4; ++j) isc[j] += relu1(c[hh][j]) * wh; }
                    *(f32x4*)(SC + (size_t)(row0 + fr) * 8192 + 16 * kt + 4 * fq) = isc;
                }
            }
        }
    }
}

__device__ __forceinline__ unsigned long long mask_ge(unsigned x, unsigned t) { unsigned long long m; asm("v_cmp_ge_u32_e64 %0, %1, %2" : "=s"(m) : "v"(x), "s"(t)); return m; }
__device__ __forceinline__ void mask_ge8(unsigned long long (&m)[8], unsigned x0, unsigned x1, unsigned x2, unsigned x3, unsigned x4, unsigned x5, unsigned x6, unsigned x7, unsigned t) {
    asm("v_cmp_ge_u32_e64 %0, %8, %16\n\tv_cmp_ge_u32_e64 %1, %9, %16\n\tv_cmp_ge_u32_e64 %2, %10, %16\n\tv_cmp_ge_u32_e64 %3, %11, %16\n\t"
        "v_cmp_ge_u32_e64 %4, %12, %16\n\tv_cmp_ge_u32_e64 %5, %13, %16\n\tv_cmp_ge_u32_e64 %6, %14, %16\n\tv_cmp_ge_u32_e64 %7, %15, %16"
        : "=&s"(m[0]), "=&s"(m[1]), "=&s"(m[2]), "=&s"(m[3]), "=&s"(m[4]), "=&s"(m[5]), "=&s"(m[6]), "=&s"(m[7])
        : "v"(x0), "v"(x1), "v"(x2), "v"(x3), "v"(x4), "v"(x5), "v"(x6), "v"(x7), "s"(t));
}
__device__ __forceinline__ unsigned long long mask_eq(unsigned x, unsigned t) { unsigned long long m; asm("v_cmp_eq_u32_e64 %0, %1, %2" : "=s"(m) : "v"(x), "s"(t)); return m; }
__device__ __forceinline__ unsigned tk_key(float f) { const unsigned b = __float_as_uint(f); return (b & 0x80000000u) ? ~b : (b | 0x80000000u); }
__device__ __forceinline__ void topk_row_slow(const float* sr, const int n, const int lane, LAS int* sel) {
    const int nseg = (n + 63) >> 6;
    unsigned T = 0u;
    for (int bit = 31; bit >= 0; --bit) {
        const unsigned cnd = T | (1u << bit); int c = 0;
        for (int sg = 0; sg < nseg; ++sg) { const int idx = sg * 64 + lane; const unsigned x = (idx < n) ? tk_key(sr[idx < n ? idx : 0]) : 0u; c += __popcll(__ballot(x >= cnd)); }
        if (c >= 256) T = cnd;
    }
    int cgt = 0;
    for (int sg = 0; sg < nseg; ++sg) { const int idx = sg * 64 + lane; const unsigned x = (idx < n) ? tk_key(sr[idx < n ? idx : 0]) : 0u; cgt += __popcll(__ballot(x > T)); }
    const int need_eq = 256 - cgt; int running = 0, eq_taken = 0;
    const unsigned long long lt = (1ull << lane) - 1ull;
    for (int sg = 0; sg < nseg; ++sg) {
        const int idx = sg * 64 + lane; const unsigned x = (idx < n) ? tk_key(sr[idx < n ? idx : 0]) : 0u;
        const bool gt = x > T, eq = x == T;
        const unsigned long long meq = __ballot(eq);
        const bool take = gt || (eq && (eq_taken + __popcll(meq & lt)) < need_eq);
        const unsigned long long mt = __ballot(take);
        if (take) sel[running + __popcll(mt & lt)] = idx;
        running += __popcll(mt); eq_taken += __popcll(meq);
    }
}
constexpr int TK_CAP = 832;
__device__ __forceinline__ int topk_row(Frame& F, const int row, LAS int* sel, LAS unsigned long long* cand) {
    const int lane = F.lane;
    const float* SC = WSP(float, WS_BIG);
    {
        const int pos = row & (SEQ - 1), n = pos + 1;
        if (n <= 256) {
#pragma unroll
            for (int i = 0; i < 4; ++i) { const int j = 64 * i + lane; sel[j] = (j < n) ? j : 0; }
            return n;
        }
        const int nblk = (n + 1023) >> 10;
        const float* sr = SC + (size_t)row * 8192;
        int lane_l = lane; asm volatile("" : "+v"(lane_l));
        unsigned u[128];
#pragma unroll
        for (int i = 0; i < 64; ++i) u[i] = __float_as_uint((sr + (i >> 4) * 1024)[(i & 15) * 64 + lane_l]);
        if (nblk > 4) {
#pragma unroll
            for (int i = 64; i < 128; ++i) u[i] = __float_as_uint((sr + (i >> 4) * 1024)[(i & 15) * 64 + lane_l]);
        } else {
#pragma unroll
            for (int i = 64; i < 128; ++i) u[i] = 0u;
        }
        asm volatile("" ::: "memory");
#pragma unroll
        for (int i = 0; i < 128; ++i) { const int lim = n - i * 64; const unsigned bits = u[i];
            const unsigned x = (bits & 0x80000000u) ? ~bits : (bits | 0x80000000u);
            u[i] = (lane < lim) ? x : 0u; }
        const unsigned long long ltmask_s = (1ull << lane) - 1ull;
        bool done = false;
        {
            int ns = 0;
#pragma unroll
            for (int k = 0; k < 16; ++k) { int v = n - 512 * k; v = v < 0 ? 0 : (v > 64 ? 64 : v); ns += v; }
            const float mean = 256.0f * (float)ns / (float)n;
            const int rs = (int)(mean + 4.0f * sqrtf(mean) + 5.0f);
            unsigned Ts = 0u;
            for (int bit = 31; bit >= 16; --bit) {
                const unsigned cnd = Ts | (1u << bit); unsigned long long m0[8], m1[8];
                mask_ge8(m0, u[0], u[8], u[16], u[24], u[32], u[40], u[48], u[56], cnd); mask_ge8(m1, u[64], u[72], u[80], u[88], u[96], u[104], u[112], u[120], cnd);
                int c = 0;
#pragma unroll
                for (int i = 0; i < 8; ++i) c += __popcll(m0[i]) + __popcll(m1[i]);
                if (c >= rs) Ts = cnd;
            }
            if (Ts == 0u) Ts = 1u;
            int nc = 0;
#pragma unroll
            for (int bk = 0; bk < 8; ++bk) {
                if (bk < nblk) {
#pragma unroll
                    for (int g8 = 0; g8 < 2; ++g8) {
                        unsigned long long mg[8]; const int b0 = bk * 16 + g8 * 8;
                        mask_ge8(mg, u[b0], u[b0 + 1], u[b0 + 2], u[b0 + 3], u[b0 + 4], u[b0 + 5], u[b0 + 6], u[b0 + 7], Ts);
#pragma unroll
                        for (int i = 0; i < 8; ++i) {
                            const unsigned long long mt = mg[i];
                            if (mt != 0ull) {
                                const int off = nc + __popcll(mt & ltmask_s);
                                if (((mt >> lane) & 1ull) && off < TK_CAP) cand[off] = ((unsigned long long)u[b0 + i] << 32) | (unsigned)((b0 + i) * 64 + lane_l);
                                nc += __popcll(mt);
                            }
                        }
                    }
                }
            }
            if (nc >= 256 && nc <= TK_CAP) {
                unsigned ck[16]; int ci[13];
#pragma unroll
                for (int t = 0; t < 13; ++t) { const int j = lane + 64 * t; const unsigned long long e = (j < nc) ? cand[j] : 0ull; ck[t] = (unsigned)(e >> 32); ci[t] = (int)(unsigned)e; }
                ck[13] = 0u; ck[14] = 0u; ck[15] = 0u;
                unsigned T = 0u;
                for (int bit = 31; bit >= 0; --bit) {
                    const unsigned cnd = T | (1u << bit); unsigned long long m0[8], m1[8];
                    mask_ge8(m0, ck[0], ck[1], ck[2], ck[3], ck[4], ck[5], ck[6], ck[7], cnd); mask_ge8(m1, ck[8], ck[9], ck[10], ck[11], ck[12], ck[13], ck[14], ck[15], cnd);
                    int c = 0;
#pragma unroll
                    for (int i = 0; i < 8; ++i) c += __popcll(m0[i]) + __popcll(m1[i]);
                    if (c >= 256) T = cnd;
                }
                unsigned long long g0[8], g1[8], h0[8], h1[8];
                mask_ge8(g0, ck[0], ck[1], ck[2], ck[3], ck[4], ck[5], ck[6], ck[7], T); mask_ge8(g1, ck[8], ck[9], ck[10], ck[11], ck[12], ck[13], ck[14], ck[15], T);
                mask_ge8(h0, ck[0], ck[1], ck[2], ck[3], ck[4], ck[5], ck[6], ck[7], T + 1u); mask_ge8(h1, ck[8], ck[9], ck[10], ck[11], ck[12], ck[13], ck[14], ck[15], T + 1u);
                int cgt = 0;
#pragma unroll
                for (int t = 0; t < 13; ++t) cgt += __popcll(t < 8 ? h0[t & 7] : h1[t & 7]);
                const int need_eq = 256 - cgt;
                int running = 0, eq_taken = 0;
#pragma unroll
                for (int t = 0; t < 13; ++t) {
                    const unsigned long long mge = (t < 8 ? g0[t & 7] : g1[t & 7]), mgt = (t < 8 ? h0[t & 7] : h1[t & 7]);
                    unsigned long long mt = mge; const unsigned long long me = mge & ~mgt;
                    if (me != 0ull) {
                        const int room = need_eq - eq_taken; unsigned long long keep = 0ull, rest = me;
                        for (int k = 0; k < room && rest != 0ull; ++k) { const unsigned long long low = rest & (~rest + 1ull); keep |= low; rest ^= low; }
                        mt = (mge & ~me) | keep; eq_taken += __popcll(me);
                    }
                    if (mt != 0ull) { if ((mt >> lane) & 1ull) sel[running + __popcll(mt & ltmask_s)] = ci[t]; running += __popcll(mt); }
                }
                done = true;
            }
        }
        if (!done) topk_row_slow(sr, n, lane, sel);
    }
    return 256;
}

__device__ __forceinline__ void p6_sparse_attn(Frame& F) {
    const int lane = F.lane, gw = F.bid * NWAVES + F.wave, NGW = F.G * NWAVES;
    LAS float* ql = (LAS float*)(F.lds + F.wave * 12288);
    LAS float* pp = ql + 1024;
    const bf16* QL = WSP(bf16, WS_QL); const bf16* CKV = WSP(bf16, WS_CKV); const int* SEL = WSP(int, WS_SEL); const int* NSEL = WSP(int, WS_NSEL); bf16* AO = WSP(bf16, WS_AO);
    for (int row = gw; row < M; row += NGW) {
        const int b = row >> 13, n = NSEL[row];
        const int* sel = SEL + (size_t)row * 256;
        {
            float f[8];
            unpack8(*(const v4u*)(QL + (size_t)row * 1536 + 8 * lane), f);
#pragma unroll
            for (int x = 0; x < 8; ++x) ql[8 * lane + x] = f[x];
            unpack8(*(const v4u*)(QL + (size_t)row * 1536 + 512 + 8 * lane), f);
#pragma unroll
            for (int x = 0; x < 8; ++x) ql[512 + 8 * lane + x] = f[x];
        }
        float s[4][8];
#pragma unroll
        for (int kb = 0; kb < 4; ++kb) {
            const int j = 64 * kb + lane; const bool valid = j < n; const int key = valid ? sel[j] : 0;
            const bf16* kr = CKV + (size_t)(b * SEQ + key) * 128;
#pragma unroll
            for (int hh = 0; hh < 8; ++hh) s[kb][hh] = 0.f;
#pragma unroll 4
            for (int r8 = 0; r8 < 16; ++r8) {
                float x[8]; unpack8(*(const v4u*)(kr + 8 * r8), x);
#pragma unroll
                for (int hh = 0; hh < 8; ++hh) { const f32x4 q0 = *(const LAS f32x4*)(ql + hh * 128 + 8 * r8), q1 = *(const LAS f32x4*)(ql + hh * 128 + 8 * r8 + 4);
                    s[kb][hh] += x[0] * q0[0] + x[1] * q0[1] + x[2] * q0[2] + x[3] * q0[3] + x[4] * q1[0] + x[5] * q1[1] + x[6] * q1[2] + x[7] * q1[3]; }
            }
            if (!valid) {
#pragma unroll
                for (int hh = 0; hh < 8; ++hh) s[kb][hh] = -INFINITY;
            }
        }
#pragma unroll
        for (int hh = 0; hh < 8; ++hh) {
            const float mx = wave_max(fmaxf(fmaxf(s[0][hh], s[1][hh]), fmaxf(s[2][hh], s[3][hh])));
            float e[4], l = 0.f;
#pragma unroll
            for (int kb = 0; kb < 4; ++kb) { e[kb] = __expf(s[kb][hh] - mx); l += e[kb]; }
            const float inv = 1.0f / wave_sum(l);
#pragma unroll
            for (int kb = 0; kb < 4; ++kb) pp[(64 * kb + lane) * 8 + hh] = e[kb] * inv;
        }
        float o[8][2];
#pragma unroll
        for (int hh = 0; hh < 8; ++hh) { o[hh][0] = 0.f; o[hh][1] = 0.f; }
        for (int j = 0; j < n; ++j) {
            const int key = sel[j];
            const unsigned kv = *(const unsigned*)(CKV + (size_t)(b * SEQ + key) * 128 + 2 * lane);
            const float lo = bflo(kv), hi = bfhi(kv);
            const f32x4 p0 = *(const LAS f32x4*)(pp + j * 8), p1 = *(const LAS f32x4*)(pp + j * 8 + 4);
#pragma unroll
            for (int hh = 0; hh < 4; ++hh) { o[hh][0] += p0[hh] * lo; o[hh][1] += p0[hh] * hi; o[4 + hh][0] += p1[hh] * lo; o[4 + hh][1] += p1[hh] * hi; }
        }
#pragma unroll
        for (int hh = 0; hh < 8; ++hh) *(unsigned*)(AO + (size_t)row * 1536 + hh * 128 + 2 * lane) = pk2(o[hh][0], o[hh][1]);
    }
}
__device__ __forceinline__ void p6_gdn_out(Frame& F, KArgs A) {
    const int lane = F.lane, gw = F.bid * NWAVES + F.wave, NGW = F.G * NWAVES;
    const f32x4 g0 = *(const f32x4*)(A->in[I_AB_ONG] + 8 * (lane & 15)), g1 = *(const f32x4*)(A->in[I_AB_ONG] + 8 * (lane & 15) + 4);
    for (int row = gw; row < M; row += NGW) {
        const float* op = WSP(float, WS_ODELTA) + (size_t)row * 512 + 8 * lane;
        const f32x4 a = *(const f32x4*)op, b = *(const f32x4*)(op + 4);
        float ss = a[0] * a[0] + a[1] * a[1] + a[2] * a[2] + a[3] * a[3] + b[0] * b[0] + b[1] * b[1] + b[2] * b[2] + b[3] * b[3];
        ss += __shfl_xor(ss, 1); ss += __shfl_xor(ss, 2); ss += __shfl_xor(ss, 4); ss += __shfl_xor(ss, 8);
        const float r = rsqrtf(ss * (1.0f / 128.0f) + 1e-6f);
        float z[8]; unpack8(*(const v4u*)(WSP(bf16, WS_QKVZ) + (size_t)row * 2048 + 1536 + 8 * lane), z);
        float o[8];
#pragma unroll
        for (int i = 0; i < 4; ++i) { o[i] = a[i] * r * g0[i] * siluf(z[i]); o[4 + i] = b[i] * r * g1[i] * siluf(z[4 + i]); }
        *(v4u*)(WSP(bf16, WS_AO) + (size_t)row * 1536 + 1024 + 8 * lane) = pack8f(o);
    }
}

__device__ __forceinline__ void p8_ln_router(Frame& F, KArgs A, int l, float* HOUT, bf16* HB) {
    const int lane = F.lane, tid = F.tid, gw = F.bid * NWAVES + F.wave, NGW = F.G * NWAVES;
    LAS float* wT = (LAS float*)(F.lds);
    LAS float* lg = (LAS float*)(F.lds + WSCR_OFF + F.wave * WSCR_BYTES);
    const float* rw = A->in[I_RW] + (size_t)l * 1024 * 32;
    {
        f32x4 wv[16];
#pragma unroll
        for (int j = 0; j < 16; ++j) wv[j] = *(const f32x4*)(rw + (size_t)(tid + NTHREADS * j) * 4);
#pragma unroll
        for (int j = 0; j < 16; ++j) { const int i4 = tid + NTHREADS * j, k = i4 >> 3, e0 = (i4 & 7) * 4;
            wT[(e0 + 0) * 1028 + k] = wv[j][0]; wT[(e0 + 1) * 1028 + k] = wv[j][1]; wT[(e0 + 2) * 1028 + k] = wv[j][2]; wT[(e0 + 3) * 1028 + k] = wv[j][3]; }
    }
    __syncthreads();
    const float* PRE = WSP(float, WS_PRE);
    const float* lg_g = A->in[I_LNM_G] + (size_t)l * 1024; const float* lg_b = A->in[I_LNM_B] + (size_t)l * 1024;
    const float rb = A->in[I_RB][l * 32 + (lane & 31)];
    int* TOKE = WSP(int, WS_ROUTE); int* TOKPOS = TOKE + M * 4; float* TOKG = (float*)(TOKPOS + M * 4);
    gu32* cnt = F.ctl + CW_CNT + 64 * 32 * l;
    LAS int* lcnt = (LAS int*)(F.lds + MISC_OFF + 512);
    LAS int* lbase = lcnt + 32;
    LAS int* myrt = (LAS int*)(F.lds + WSCR_OFF + F.wave * WSCR_BYTES + 128);
    if (tid < 32) lcnt[tid] = 0;
    __syncthreads();
    int nrow = 0;
    f32x4 lng[4], lnb[4];
#pragma unroll
    for (int j = 0; j < 4; ++j) { lng[j] = *(const f32x4*)(lg_g + 256 * j + 4 * lane); lnb[j] = *(const f32x4*)(lg_b + 256 * j + 4 * lane); }
    for (int row = gw; row < M; row += NGW) {
        f32x4 v[4]; float s = 0.f;
#pragma unroll
        for (int j = 0; j < 4; ++j) { v[j] = *(const f32x4*)(PRE + (size_t)row * 1024 + 256 * j + 4 * lane); s += (v[j][0] + v[j][1]) + (v[j][2] + v[j][3]); }
        const float mean = wave_sum(s) * (1.0f / 1024.0f); float s2 = 0.f;
#pragma unroll
        for (int j = 0; j < 4; ++j) { v[j] = v[j] - mean; s2 += (v[j][0] * v[j][0] + v[j][1] * v[j][1]) + (v[j][2] * v[j][2] + v[j][3] * v[j][3]); }
        const float rstd = rsqrtf(wave_sum(s2) * (1.0f / 1024.0f) + 1e-5f);
#pragma unroll
        for (int j = 0; j < 4; ++j) {
            v[j] = v[j] * rstd * lng[j] + lnb[j];
            *(f32x4*)(HOUT + (size_t)row * 1024 + 256 * j + 4 * lane) = v[j];
            v2u o; o.x = pk2(v[j][0], v[j][1]); o.y = pk2(v[j][2], v[j][3]); *(v2u*)(HB + (size_t)row * 1024 + 256 * j + 4 * lane) = o;
        }
        float part[32];
#pragma unroll
        for (int e = 0; e < 32; ++e) {
            float a = 0.f;
#pragma unroll
            for (int j = 0; j < 4; ++j) { const f32x4 w = *(const LAS f32x4*)(wT + e * 1028 + 256 * j + 4 * lane); a += v[j][0] * w[0] + v[j][1] * w[1] + v[j][2] * w[2] + v[j][3] * w[3]; }
            part[e] = a;
        }
#pragma unroll
        for (int i = 0; i < 16; ++i) { const bool up = (lane & 32) != 0; const float keep = up ? part[i + 16] : part[i], send = up ? part[i] : part[i + 16]; part[i] = keep + __shfl_xor(send, 32); }
#pragma unroll
        for (int i = 0; i < 8; ++i) { const bool up = (lane & 16) != 0; const float keep = up ? part[i + 8] : part[i], send = up ? part[i] : part[i + 8]; part[i] = keep + __shfl_xor(send, 16); }
#pragma unroll
        for (int i = 0; i < 4; ++i) { const bool up = (lane & 8) != 0; const float keep = up ? part[i + 4] : part[i], send = up ? part[i] : part[i + 4]; part[i] = keep + __shfl_xor(send, 8); }
#pragma unroll
        for (int i = 0; i < 2; ++i) { const bool up = (lane & 4) != 0; const float keep = up ? part[i + 2] : part[i], send = up ? part[i] : part[i + 2]; part[i] = keep + __shfl_xor(send, 4); }
        { const bool up = (lane & 2) != 0; const float keep = up ? part[1] : part[0], send = up ? part[0] : part[1]; part[0] = keep + __shfl_xor(send, 2); }
        part[0] += __shfl_xor(part[0], 1);
        const int eidx = ((lane >> 5) & 1) * 16 + ((lane >> 4) & 1) * 8 + ((lane >> 3) & 1) * 4 + ((lane >> 2) & 1) * 2 + ((lane >> 1) & 1);
        if ((lane & 1) == 0) lg[eidx] = part[0];
        float val = (lane < 32) ? lg[lane & 31] + rb : -INFINITY;
        float tl[4]; int te[4];
#pragma unroll
        for (int k = 0; k < 4; ++k) {
            const float mx = wave_max(val);
            const unsigned long long mm = __ballot(val == mx && lane < 32);
            const int idx = __ffsll((long long)mm) - 1;
            tl[k] = mx; te[k] = idx;
            if (lane == idx) val = -INFINITY;
        }
        const float e1 = __expf(tl[1] - tl[0]), e2 = __expf(tl[2] - tl[0]), e3 = __expf(tl[3] - tl[0]);
        const float inv = 1.0f / (1.0f + e1 + e2 + e3);
        if (lane < 4) {
            const int e = lane == 0 ? te[0] : (lane == 1 ? te[1] : (lane == 2 ? te[2] : te[3]));
            const float g = (lane == 0 ? 1.0f : (lane == 1 ? e1 : (lane == 2 ? e2 : e3))) * inv;
            const int lp = __hip_atomic_fetch_add(lcnt + e, 1, __ATOMIC_RELAXED, __HIP_MEMORY_SCOPE_WORKGROUP);
            LAS int* rt = myrt + (nrow * 4 + lane) * 3; rt[0] = e; rt[1] = lp; rt[2] = __float_as_int(g);
        }
        ++nrow;
    }
    __syncthreads();
    if (tid < 32) lbase[tid] = (int)__hip_atomic_fetch_add(cnt + 64 * tid, (unsigned)lcnt[tid], RLX_AGENT);
    __syncthreads();
    if (lane < 4) {
        int j = 0;
        for (int row = gw; row < M; row += NGW, ++j) {
            const LAS int* rt = myrt + (j * 4 + lane) * 3; const int e = rt[0];
            TOKE[(size_t)row * 4 + lane] = e; TOKPOS[(size_t)row * 4 + lane] = lbase[e] + rt[1]; TOKG[(size_t)row * 4 + lane] = __int_as_float(rt[2]);
        }
    }
}

__device__ __forceinline__ void p9_scatter(Frame& F, int l, const bf16* HB, const float* HF) {
    const int lane = F.lane, tid = F.tid, gw = F.bid * NWAVES + F.wave, NGW = F.G * NWAVES;
    LAS int* base = (LAS int*)(F.lds + MISC_OFF + 256);
    int* TOKE = WSP(int, WS_ROUTE); int* TOKPOS = TOKE + M * 4; int* TILE = TOKE + 3 * M * 4;
    if (tid < 32) base[tid] = (int)__hip_atomic_load(F.ctl + CW_CNT + 64 * (32 * l + tid), RLX_AGENT);
    __syncthreads();
    if (tid == 0) {
        int acc = 0;
        for (int e = 0; e < NEXP; ++e) { const int c = base[e]; base[e] = acc; acc += ((c + 255) >> 8) << 8; }
        base[32] = acc >> 8;
    }
    __syncthreads();
    if (F.bid == 0 && tid < 64) {
        const int nT = base[32];
        for (int t = tid; t < NTMAX; t += 64) { int e = 0;
            for (int x = 1; x < NEXP; ++x) if (base[x] <= t * 256) e = x;
            TILE[t] = (t < nT) ? e : 0; }
        if (tid == 0) TILE[NTMAX] = nT;
    }
    bf16* XS = WSP(bf16, WS_XS);
    if (kMoeFp8) {
        unsigned char* XB8 = WSP(unsigned char, WS_XS);
        for (int row = gw; row < M; row += NGW) {
            const float* hp = HF + (size_t)row * 1024 + 16 * lane; v4u o;
#pragma unroll
            for (int q = 0; q < 4; ++q) { const f32x4 v = *(const f32x4*)(hp + 4 * q); unsigned w = 0u; w = __builtin_amdgcn_cvt_pk_fp8_f32(v[0], v[1], w, false); w = __builtin_amdgcn_cvt_pk_fp8_f32(v[2], v[3], w, true); o[q] = w; }
#pragma unroll
            for (int k = 0; k < 4; ++k) { const int slot = base[TOKE[(size_t)row * 4 + k]] + TOKPOS[(size_t)row * 4 + k]; *(v4u*)(XB8 + (size_t)slot * 1024 + 16 * lane) = o; }
        }
        return;
    }
    for (int row = gw; row < M; row += NGW) {
        const v4u a = *(const v4u*)(HB + (size_t)row * 1024 + 8 * lane), b = *(const v4u*)(HB + (size_t)row * 1024 + 512 + 8 * lane);
#pragma unroll
        for (int k = 0; k < 4; ++k) {
            const int slot = base[TOKE[(size_t)row * 4 + k]] + TOKPOS[(size_t)row * 4 + k];
            *(v4u*)(XS + (size_t)slot * 1024 + 8 * lane) = a; *(v4u*)(XS + (size_t)slot * 1024 + 512 + 8 * lane) = b;
        }
    }
}

__device__ __forceinline__ void p12_combine(Frame& F, KArgs A, int l, const float* HIN, float* HOUT, bf16* HB) {
    const int lane = F.lane, tid = F.tid, gw = F.bid * NWAVES + F.wave, NGW = F.G * NWAVES;
    LAS int* base = (LAS int*)(F.lds + MISC_OFF + 256);
    if (tid < 32) base[tid] = (int)__hip_atomic_load(F.ctl + CW_CNT + 64 * (32 * l + tid), RLX_AGENT);
    __syncthreads();
    if (tid == 0) { int acc = 0; for (int e = 0; e < NEXP; ++e) { const int c = base[e]; base[e] = acc; acc += ((c + 255) >> 8) << 8; } }
    __syncthreads();
    const int* TOKE = WSP(int, WS_ROUTE); const int* TOKPOS = TOKE + M * 4; const float* TOKG = (const float*)(TOKPOS + M * 4);
    const bf16* YS = WSP(bf16, WS_YS); const bf16* PLE = WSP(bf16, WS_PLE);
    const float* lg_g = A->in[I_LNF_G] + (size_t)l * 1024; const float* lg_b = A->in[I_LNF_B] + (size_t)l * 1024;
    f32x4 lng[2][2], lnb[2][2];
#pragma unroll
    for (int hf = 0; hf < 2; ++hf) { const int c0 = 512 * hf + 8 * lane; lng[hf][0] = *(const f32x4*)(lg_g + c0); lng[hf][1] = *(const f32x4*)(lg_g + c0 + 4); lnb[hf][0] = *(const f32x4*)(lg_b + c0); lnb[hf][1] = *(const f32x4*)(lg_b + c0 + 4); }
    for (int row = gw; row < M; row += NGW) {
        float x[16];
        {   const f32x4 h0 = *(const f32x4*)(HIN + (size_t)row * 1024 + 8 * lane), h1 = *(const f32x4*)(HIN + (size_t)row * 1024 + 8 * lane + 4);
            const f32x4 h2 = *(const f32x4*)(HIN + (size_t)row * 1024 + 512 + 8 * lane), h3 = *(const f32x4*)(HIN + (size_t)row * 1024 + 512 + 8 * lane + 4);
            float p0[8], p1[8]; unpack8(*(const v4u*)(PLE + (size_t)row * 1024 + 8 * lane), p0); unpack8(*(const v4u*)(PLE + (size_t)row * 1024 + 512 + 8 * lane), p1);
#pragma unroll
            for (int i = 0; i < 4; ++i) { x[i] = ALPHA * h0[i] + p0[i]; x[4 + i] = ALPHA * h1[i] + p0[4 + i]; x[8 + i] = ALPHA * h2[i] + p1[i]; x[12 + i] = ALPHA * h3[i] + p1[4 + i]; }
        }
#pragma unroll
        for (int k = 0; k < 4; ++k) {
            const int slot = base[TOKE[(size_t)row * 4 + k]] + TOKPOS[(size_t)row * 4 + k]; const float g = TOKG[(size_t)row * 4 + k];
            float y0[8], y1[8]; unpack8(*(const v4u*)(YS + (size_t)slot * 1024 + 8 * lane), y0); unpack8(*(const v4u*)(YS + (size_t)slot * 1024 + 512 + 8 * lane), y1);
#pragma unroll
            for (int i = 0; i < 8; ++i) { x[i] += g * y0[i]; x[8 + i] += g * y1[i]; }
        }
        float s = 0.f;
#pragma unroll
        for (int i = 0; i < 16; ++i) s += x[i];
        const float mean = wave_sum(s) * (1.0f / 1024.0f); float s2 = 0.f;
#pragma unroll
        for (int i = 0; i < 16; ++i) { x[i] -= mean; s2 += x[i] * x[i]; }
        const float rstd = rsqrtf(wave_sum(s2) * (1.0f / 1024.0f) + 1e-5f);
#pragma unroll
        for (int hf = 0; hf < 2; ++hf) {
            const int c0 = 512 * hf + 8 * lane;
            const f32x4 g0 = lng[hf][0], g1 = lng[hf][1], b0 = lnb[hf][0], b1 = lnb[hf][1];
            f32x4 o0, o1;
#pragma unroll
            for (int i = 0; i < 4; ++i) { o0[i] = x[8 * hf + i] * rstd * g0[i] + b0[i]; o1[i] = x[8 * hf + 4 + i] * rstd * g1[i] + b1[i]; }
            *(f32x4*)(HOUT + (size_t)row * 1024 + c0) = o0; *(f32x4*)(HOUT + (size_t)row * 1024 + c0 + 4) = o1;
            if (HB) { v4u w; w.x = pk2(o0[0], o0[1]); w.y = pk2(o0[2], o0[3]); w.z = pk2(o1[0], o1[1]); w.w = pk2(o1[2], o1[3]); *(v4u*)(HB + (size_t)row * 1024 + c0) = w; }
        }
    }
}

__device__ __forceinline__ void p14_dilated(Frame& F) {
    const int lane = F.lane, gw = F.bid * NWAVES + F.wave, NGW = F.G * NWAVES;
    LAS float* pe = (LAS float*)(F.lds + F.wave * 2048);
    const bf16* QK = WSP(bf16, WS_QKVZ); bf16* AO = WSP(bf16, WS_AO);
    for (int task = gw; task < M * 12; task += NGW) {
        const int row = task / 12, hh = task - row * 12, b = row >> 13, pos = row & (SEQ - 1);
        float q[64];
#pragma unroll
        for (int c = 0; c < 8; ++c) { float f[8]; unpack8(*(const v4u*)(QK + (size_t)row * 2560 + hh * 64 + 8 * c), f);
#pragma unroll
            for (int x = 0; x < 8; ++x) q[8 * c + x] = f[x]; }
        float s[7];
#pragma unroll
        for (int i = 0; i < 7; ++i) {
            const int e = lane + 64 * i, p = e / 129, m = e - p * 129;
            const int dd = (p == 0) ? 1 : (p == 1 ? 4 : 16);
            const int kpos = pos - m * dd; const bool valid = (e < 387) && (kpos >= 0);
            float a = -INFINITY;
            if (valid) {
                const bf16* kr = QK + (size_t)(b * SEQ + kpos) * 2560 + 768 + hh * 64; a = 0.f;
#pragma unroll
                for (int c = 0; c < 8; ++c) { float f[8]; unpack8(*(const v4u*)(kr + 8 * c), f);
#pragma unroll
                    for (int x = 0; x < 8; ++x) a += q[8 * c + x] * f[x]; }
                a *= 0.125f;
            }
            s[i] = a;
        }
        float mx = s[0];
#pragma unroll
        for (int i = 1; i < 7; ++i) mx = fmaxf(mx, s[i]);
        mx = wave_max(mx);
        float l = 0.f;
#pragma unroll
        for (int i = 0; i < 7; ++i) { const float ev = __expf(s[i] - mx); pe[lane + 64 * i] = ev; l += ev; }
        l = wave_sum(l);
        float o = 0.f;
#pragma unroll
        for (int p = 0; p < 3; ++p) {
            const int dd = (p == 0) ? 1 : (p == 1 ? 4 : 16);
            int mmax = pos / dd; if (mmax > 128) mmax = 128;
            const bf16* vb = QK + (size_t)(b * SEQ + pos) * 2560 + 1536 + hh * 64 + lane;
            for (int m = 0; m <= mmax; ++m) o += pe[p * 129 + m] * bf1(vb[-(ptrdiff_t)m * dd * 2560]);
        }
        AO[(size_t)row * 1024 + hh * 64 + lane] = (bf16)f2bf(o / l);
    }
}
typedef short v4i16_t __attribute__((ext_vector_type(4)));
__device__ __forceinline__ v4i16_t lds_tr16(LAS unsigned char* p) { return __builtin_amdgcn_ds_read_tr16_b64_v4i16((LAS v4i16_t*)p); }
constexpr int DV_PITCH = 144, DV_BUF = 32 * DV_PITCH;
template <int DL  > __device__ __forceinline__ void dil_branch(const bf16* __restrict__ KV, LAS unsigned char* vbuf, const int s0, const int lane,
                                                                                 const bf16x8 (&qf)[2], f32x4 (&O)[4], float& m_run, float& l_run) {
    constexpr int d = 1 << DL, sigma = 16 >> DL, NS = (129 + 15 * sigma + 31) / 32;
    const int fr = lane & 15, fq = lane >> 4;
    const int c = s0 & (d - 1), n0 = s0 >> DL, kstart = n0 - 128;
#define DIL_POS(n) ({ int _p = c + d * (n); _p = _p < 0 ? 0 : (_p > SEQ - 1 ? SEQ - 1 : _p); _p; })
    bf16x8 kf[2][2]; v4u vr[4];
#pragma unroll
    for (int tl = 0; tl < 2; ++tl) { const bf16* kp = KV + (size_t)DIL_POS(kstart + 16 * tl + fr) * 2560 + 768 + 8 * fq; kf[tl][0] = *(const bf16x8*)kp; kf[tl][1] = *(const bf16x8*)(kp + 32); }
#pragma unroll
    for (int i = 0; i < 4; ++i) vr[i] = *(const v4u*)(KV + (size_t)DIL_POS(kstart + (lane >> 3) + 8 * i) * 2560 + 1536 + 8 * (lane & 7));
#pragma unroll 1
    for (int g = 0; g < NS; ++g) {
        LAS unsigned char* vb = vbuf + (g & 1) * DV_BUF;
#pragma unroll
        for (int i = 0; i < 4; ++i) *(LAS v4u*)(vb + ((lane >> 3) + 8 * i) * DV_PITCH + 16 * (lane & 7)) = vr[i];
        bf16x8 kc[2][2];
#pragma unroll
        for (int tl = 0; tl < 2; ++tl) { kc[tl][0] = kf[tl][0]; kc[tl][1] = kf[tl][1]; }
        if (g + 1 < NS) {
            const int kb = kstart + 32 * (g + 1);
#pragma unroll
            for (int tl = 0; tl < 2; ++tl) { const bf16* kp = KV + (size_t)DIL_POS(kb + 16 * tl + fr) * 2560 + 768 + 8 * fq; kf[tl][0] = *(const bf16x8*)kp; kf[tl][1] = *(const bf16x8*)(kp + 32); }
#pragma unroll
            for (int i = 0; i < 4; ++i) vr[i] = *(const v4u*)(KV + (size_t)DIL_POS(kb + (lane >> 3) + 8 * i) * 2560 + 1536 + 8 * (lane & 7));
        }
        float sv[8];
#pragma unroll
        for (int tl = 0; tl < 2; ++tl) {
            f32x4 cc = __builtin_amdgcn_mfma_f32_16x16x32_bf16(kc[tl][0], qf[0], (f32x4){0.f, 0.f, 0.f, 0.f}, 0, 0, 0);
            cc = __builtin_amdgcn_mfma_f32_16x16x32_bf16(kc[tl][1], qf[1], cc, 0, 0, 0);
#pragma unroll
            for (int j = 0; j < 4; ++j) {
                const int rel = 32 * g + 16 * tl + 4 * fq + j;
                const int delta = 128 + sigma * fr - rel;
                const bool ok = (delta >= 0) && (delta <= 128) && (kstart + rel >= 0);
                sv[4 * tl + j] = ok ? cc[j] * 0.125f : -INFINITY;
            }
        }
        float mx = fmaxf(fmaxf(fmaxf(sv[0], sv[1]), fmaxf(sv[2], sv[3])), fmaxf(fmaxf(sv[4], sv[5]), fmaxf(sv[6], sv[7])));
        mx = fmaxf(mx, __shfl_xor(mx, 16)); mx = fmaxf(mx, __shfl_xor(mx, 32));
        const float m_new = fmaxf(m_run, mx);
        if (!__all(m_new == m_run)) {
            const float alpha = __expf(m_run - m_new);
            l_run *= alpha;
#pragma unroll
            for (int j = 0; j < 4; ++j) { const float aj = __shfl(alpha, 4 * fq + j);
#pragma unroll
                for (int dt = 0; dt < 4; ++dt) O[dt][j] *= aj; }
            m_run = m_new;
        }
        float p[8], ps = 0.f;
#pragma unroll
        for (int e = 0; e < 8; ++e) { p[e] = __expf(sv[e] - m_run); ps += p[e]; }
        l_run += ps;
        v4u pw; pw.x = pg8::cvt_pk_bf16(p[0], p[1]); pw.y = pg8::cvt_pk_bf16(p[2], p[3]); pw.z = pg8::cvt_pk_bf16(p[4], p[5]); pw.w = pg8::cvt_pk_bf16(p[6], p[7]);
        const bf16x8 pf = __builtin_bit_cast(bf16x8, pw);
        LAS unsigned char* tb = vb + (4 * fq + ((lane & 15) >> 2)) * DV_PITCH + 8 * (lane & 3);
#pragma unroll
        for (int dt = 0; dt < 4; ++dt) {
            const v4i16_t lo = lds_tr16(tb + 32 * dt), hi = lds_tr16(tb + 16 * DV_PITCH + 32 * dt);
            bf16x8 vf; vf[0] = lo[0]; vf[1] = lo[1]; vf[2] = lo[2]; vf[3] = lo[3]; vf[4] = hi[0]; vf[5] = hi[1]; vf[6] = hi[2]; vf[7] = hi[3];
            O[dt] = __builtin_amdgcn_mfma_f32_16x16x32_bf16(pf, vf, O[dt], 0, 0, 0);
        }
    }
#undef DIL_POS
}
__device__ __forceinline__ void p14_dilated_mfma(Frame& F) {
    const int lane = F.lane, fr = lane & 15, fq = lane >> 4;
    LAS unsigned char* vbuf = F.lds + F.wave * (2 * DV_BUF);
    const bf16* QK = WSP(bf16, WS_QKVZ); bf16* AO = WSP(bf16, WS_AO);
    for (int u = F.bid; u < 24 * 32 * 2; u += F.G) {
        const int bh = u >> 6, blk = (u >> 1) & 31, o = (u & 1) * 8 + F.wave;
        const int b = bh / 12, hh = bh - b * 12, s0 = 256 * blk + o;
        const bf16* KV = QK + (size_t)b * SEQ * 2560 + hh * 64;
        bf16x8 qf[2];
        { const bf16* qp = KV + (size_t)(s0 + 16 * fr) * 2560 + 8 * fq; qf[0] = *(const bf16x8*)qp; qf[1] = *(const bf16x8*)(qp + 32); }
        f32x4 O[4];
#pragma unroll
        for (int dt = 0; dt < 4; ++dt) O[dt] = (f32x4){0.f, 0.f, 0.f, 0.f};
        float m_run = -1e30f, l_run = 0.f;
        dil_branch<4>(KV, vbuf, s0, lane, qf, O, m_run, l_run);
        dil_branch<2>(KV, vbuf, s0, lane, qf, O, m_run, l_run);
        dil_branch<0>(KV, vbuf, s0, lane, qf, O, m_run, l_run);
        float lt = l_run; lt += __shfl_xor(lt, 16); lt += __shfl_xor(lt, 32);
        const float inv = 1.0f / lt;
#pragma unroll
        for (int j = 0; j < 4; ++j) {
            const float ij = __shfl(inv, 4 * fq + j);
            bf16* op = AO + (size_t)(b * SEQ + s0 + 16 * (4 * fq + j)) * 1024 + hh * 64 + fr;
#pragma unroll
            for (int dt = 0; dt < 4; ++dt) op[16 * dt] = (bf16)f2bf(O[dt][j] * ij);
        }
    }
}
constexpr int SA_PITCH = 272, SA_TILE = 32 * SA_PITCH;
__device__ __forceinline__ void sparse_row(Frame& F, const int row, const int n, const LAS int* sel, LAS unsigned char* tile) {
    const int lane = F.lane, fr = lane & 15, fq = lane >> 4;
    const bf16* QL = WSP(bf16, WS_QL); const bf16* CKV = WSP(bf16, WS_CKV); bf16* AO = WSP(bf16, WS_AO);
    {
        const int b = row >> 13;
        const bf16* kvb = CKV + (size_t)b * SEQ * 128;
        bf16x8 qf[4];
#pragma unroll
        for (int s = 0; s < 4; ++s) { const v4u z = (v4u){0u, 0u, 0u, 0u}; qf[s] = (fr < 8) ? *(const bf16x8*)(QL + (size_t)row * 1536 + fr * 128 + 32 * s + 8 * fq) : __builtin_bit_cast(bf16x8, z); }
        f32x4 O[8];
#pragma unroll
        for (int rt = 0; rt < 8; ++rt) O[rt] = (f32x4){0.f, 0.f, 0.f, 0.f};
        float m_run = -1e30f, l_run = 0.f;
        const int nsteps = (n + 31) >> 5;
        v4u vr[8];
        { const int j = lane & 31; const int kidx = (j < n) ? sel[j] : 0;
#pragma unroll
          for (int i = 0; i < 8; ++i) { const int key = __shfl(kidx, (lane >> 4) + 4 * i); vr[i] = *(const v4u*)(kvb + (size_t)key * 128 + 8 * (lane & 15)); } }
#pragma unroll 1
        for (int g = 0; g < nsteps; ++g) {
#pragma unroll
            for (int i = 0; i < 8; ++i) *(LAS v4u*)(tile + ((lane >> 4) + 4 * i) * SA_PITCH + 16 * (lane & 15)) = vr[i];
            if (g + 1 < nsteps) {
                const int j = 32 * (g + 1) + (lane & 31); const int kidx = (j < n) ? sel[j] : 0;
#pragma unroll
                for (int i = 0; i < 8; ++i) { const int key = __shfl(kidx, (lane >> 4) + 4 * i); vr[i] = *(const v4u*)(kvb + (size_t)key * 128 + 8 * (lane & 15)); }
            }
            float sv[8];
#pragma unroll
            for (int tl = 0; tl < 2; ++tl) {
                f32x4 cc = (f32x4){0.f, 0.f, 0.f, 0.f};
#pragma unroll
                for (int s = 0; s < 4; ++s) { const bf16x8 kf = *(const LAS bf16x8*)(tile + (16 * tl + fr) * SA_PITCH + 64 * s + 16 * fq); cc = __builtin_amdgcn_mfma_f32_16x16x32_bf16(kf, qf[s], cc, 0, 0, 0); }
#pragma unroll
                for (int j = 0; j < 4; ++j) sv[4 * tl + j] = (32 * g + 16 * tl + 4 * fq + j < n) ? cc[j] : -INFINITY;
            }
            float mx = fmaxf(fmaxf(fmaxf(sv[0], sv[1]), fmaxf(sv[2], sv[3])), fmaxf(fmaxf(sv[4], sv[5]), fmaxf(sv[6], sv[7])));
            mx = fmaxf(mx, __shfl_xor(mx, 16)); mx = fmaxf(mx, __shfl_xor(mx, 32));
            const float m_new = fmaxf(m_run, mx);
            if (!__all(m_new == m_run)) {
                const float alpha = __expf(m_run - m_new);
                l_run *= alpha;
#pragma unroll
                for (int j = 0; j < 4; ++j) { const float aj = __shfl(alpha, 4 * fq + j);
#pragma unroll
                    for (int rt = 0; rt < 8; ++rt) O[rt][j] *= aj; }
                m_run = m_new;
            }
            float p[8], ps = 0.f;
#pragma unroll
            for (int e = 0; e < 8; ++e) { p[e] = __expf(sv[e] - m_run); ps += p[e]; }
            l_run += ps;
            v4u pw; pw.x = pg8::cvt_pk_bf16(p[0], p[1]); pw.y = pg8::cvt_pk_bf16(p[2], p[3]); pw.z = pg8::cvt_pk_bf16(p[4], p[5]); pw.w = pg8::cvt_pk_bf16(p[6], p[7]);
            const bf16x8 pf = __builtin_bit_cast(bf16x8, pw);
            LAS unsigned char* tb = tile + (4 * fq + ((lane & 15) >> 2)) * SA_PITCH + 8 * (lane & 3);
#pragma unroll
            for (int rt = 0; rt < 8; ++rt) {
                const v4i16_t lo = lds_tr16(tb + 32 * rt), hi = lds_tr16(tb + 16 * SA_PITCH + 32 * rt);
                bf16x8 vf; vf[0] = lo[0]; vf[1] = lo[1]; vf[2] = lo[2]; vf[3] = lo[3]; vf[4] = hi[0]; vf[5] = hi[1]; vf[6] = hi[2]; vf[7] = hi[3];
                O[rt] = __builtin_amdgcn_mfma_f32_16x16x32_bf16(pf, vf, O[rt], 0, 0, 0);
            }
        }
        float lt = l_run; lt += __shfl_xor(lt, 16); lt += __shfl_xor(lt, 32);
        const float inv = 1.0f / lt;
#pragma unroll
        for (int j = 0; j < 4; ++j) {
            const float ij = __shfl(inv, 4 * fq + j);
            if (fq < 2) { bf16* op = AO + (size_t)row * 1536 + (4 * fq + j) * 128 + fr;
#pragma unroll
                for (int rt = 0; rt < 8; ++rt) op[16 * rt] = (bf16)f2bf(O[rt][j] * ij); }
        }
    }
}
__device__ __forceinline__ void p5_topk_attn(Frame& F, const int gw, const int NGW) {
    LAS int* sel = (LAS int*)(F.lds + F.wave * 16384);
    LAS unsigned char* tile = F.lds + F.wave * 16384 + 1024;
    LAS unsigned long long* cand = (LAS unsigned long long*)(F.lds + F.wave * 16384 + 1024 + SA_TILE);
    static_assert(1024 + SA_TILE + TK_CAP * 8 <= 16384, "per-wave LDS");
    for (int rix = gw; rix < M; rix += NGW) {
        const int row = ((rix & 1) ? (M - 1 - (rix >> 1)) : (rix >> 1));
        const int n = __builtin_amdgcn_readfirstlane(topk_row(F, row, sel, cand));
        sparse_row(F, row, n, sel, tile);
    }
}
constexpr int CP_KV_PITCH = 272;
__device__ __forceinline__ void p3_chunk_prep_mfma(Frame& F, KArgs A) {
    int tid = F.tid; asm volatile("" : "+v"(tid));
    const int lane = tid & 63, wave = __builtin_amdgcn_readfirstlane(tid >> 6), fr = lane & 15, fq = lane >> 4;
    LAS unsigned char* kt = F.lds;
    LAS unsigned char* vt = F.lds + 64 * CP_KV_PITCH;
    LAS float* As = (LAS float*)(F.lds + 2 * 64 * CP_KV_PITCH);
    LAS float* Ts = As + 64 * 65;
    LAS float* gcS = Ts + 64 * 68; LAS float* egS = gcS + 64; LAS float* ekS = egS + 64; LAS float* btS = ekS + 64;
    for (int cidx = F.bid; cidx < 1024; cidx += F.G) {
        const int b = cidx >> 9, h = (cidx >> 7) & 3, n = cidx & 127, row0 = b * SEQ + n * 64;
        unsigned char* blk = F.ws + WS_CHK + (size_t)cidx * CHK_STRIDE;
        const bf16* Qg = WSP(bf16, WS_QN) + (size_t)row0 * 512 + h * 128; const bf16* Kg = WSP(bf16, WS_KN) + (size_t)row0 * 512 + h * 128; const bf16* Vg = WSP(bf16, WS_VN) + (size_t)row0 * 512 + h * 128;
        const int ti = wave >> 1;
        float g_in = 0.f, bt_in = 0.f;
        if (tid < 64) { g_in = WSP(float, WS_GG)[(size_t)(row0 + tid) * 4 + h]; bt_in = WSP(float, WS_BETA)[(size_t)(row0 + tid) * 4 + h]; }
        v4u kc[2], vc[2], qc[2];
#pragma unroll
        for (int i = 0; i < 2; ++i) { const int id = tid + 512 * i, r = id >> 4, c = id & 15; kc[i] = *(const v4u*)(Kg + (size_t)r * 512 + 8 * c); vc[i] = *(const v4u*)(Vg + (size_t)r * 512 + 8 * c); qc[i] = *(const v4u*)(Qg + (size_t)r * 512 + 8 * c); }
        bf16x8 ka[4], qa[4], kbf[2][4];
#pragma unroll
        for (int s = 0; s < 4; ++s) { ka[s] = *(const bf16x8*)(Kg + (size_t)(16 * ti + fr) * 512 + 32 * s + 8 * fq); qa[s] = *(const bf16x8*)(Qg + (size_t)(16 * ti + fr) * 512 + 32 * s + 8 * fq);
            kbf[0][s] = *(const bf16x8*)(Kg + (size_t)(16 * (2 * (wave & 1)) + fr) * 512 + 32 * s + 8 * fq); kbf[1][s] = *(const bf16x8*)(Kg + (size_t)(16 * (2 * (wave & 1) + 1) + fr) * 512 + 32 * s + 8 * fq); }
        if (tid < 64) {
            float gc = g_in;
#pragma unroll
            for (int o = 1; o < 64; o <<= 1) { const float t = __shfl_up(gc, o); if (lane >= o) gc += t; }
            const float g63 = __shfl(gc, 63);
            gcS[tid] = gc; egS[tid] = __expf(gc); ekS[tid] = __expf(g63 - gc); btS[tid] = bt_in;
            if (tid == 0) *(float*)(blk + CHK_GL) = __expf(g63);
        }
#pragma unroll
        for (int i = 0; i < 2; ++i) { const int id = tid + 512 * i, r = id >> 4, c = id & 15; *(LAS v4u*)(kt + r * CP_KV_PITCH + 16 * c) = kc[i]; *(LAS v4u*)(vt + r * CP_KV_PITCH + 16 * c) = vc[i]; }
        __syncthreads();
        {
#pragma unroll
            for (int t2 = 0; t2 < 2; ++t2) {
                const int tj = 2 * (wave & 1) + t2;
                f32x4 ck = (f32x4){0.f, 0.f, 0.f, 0.f}, cq = (f32x4){0.f, 0.f, 0.f, 0.f};
#pragma unroll
                for (int s = 0; s < 4; ++s) { ck = __builtin_amdgcn_mfma_f32_16x16x32_bf16(ka[s], kbf[t2][s], ck, 0, 0, 0); cq = __builtin_amdgcn_mfma_f32_16x16x32_bf16(qa[s], kbf[t2][s], cq, 0, 0, 0); }
                const int j = 16 * tj + fr; const float gcj = gcS[j];
                bf16* QKp = (bf16*)(blk + CHK_QK);
#pragma unroll
                for (int jj = 0; jj < 4; ++jj) { const int i = 16 * ti + 4 * fq + jj; const float dec = __expf(j <= i ? gcS[i] - gcj : 0.f);
                    As[i * 65 + j] = (j < i) ? btS[i] * ck[jj] * dec : 0.f;
                    QKp[i * 64 + 32 * (j >> 5) + 8 * ((j >> 2) & 3) + 4 * ((j >> 4) & 1) + (j & 3)] = (bf16)f2bf((j <= i) ? cq[jj] * dec : 0.f); }
            }
        }
        {
#pragma unroll
            for (int x = 0; x < 2; ++x) { const int id = tid + 512 * x, i = id >> 4, d0 = (id & 15) * 8; const float e = egS[i];
                float f[8]; unpack8(qc[x], f);
                bf16* Qd = (bf16*)(blk + CHK_QD) + i * 128 + 32 * (d0 >> 5) + 4 * ((d0 >> 4) & 1);
                const int q0 = (d0 >> 2) & 3;
                v2u w0, w1; w0.x = pk2(f[0] * e, f[1] * e); w0.y = pk2(f[2] * e, f[3] * e); w1.x = pk2(f[4] * e, f[5] * e); w1.y = pk2(f[6] * e, f[7] * e);
                *(v2u*)(Qd + 8 * q0) = w0; *(v2u*)(Qd + 8 * (q0 + 1)) = w1; }
        }
        {
            const int d = tid >> 2, c0 = (tid & 3) * 16, s = c0 >> 5, a = (c0 >> 4) & 1;
            bf16* Kd = (bf16*)(blk + CHK_KDT) + d * 64;
#pragma unroll
            for (int q = 0; q < 4; ++q) { const int c = c0 + 4 * q; float kv[4];
#pragma unroll
                for (int e = 0; e < 4; ++e) kv[e] = bf1(*(const LAS bf16*)(kt + (c + e) * CP_KV_PITCH + 2 * d)) * ekS[c + e];
                v2u w; w.x = pk2(kv[0], kv[1]); w.y = pk2(kv[2], kv[3]); *(v2u*)(Kd + 32 * s + 8 * q + 4 * a) = w; }
        }
        __syncthreads();
        {
            const int c = tid >> 3, part = tid & 7;
            for (int i = 0; i < 64; ++i) {
                float acc = 0.f;
                for (int j = part; j < i; j += 8) acc += As[i * 65 + j] * Ts[j * 68 + c];
                acc += __shfl_xor(acc, 1); acc += __shfl_xor(acc, 2); acc += __shfl_xor(acc, 4);
                if (part == 0) Ts[i * 68 + c] = ((i == c) ? 1.f : 0.f) - acc;
                __builtin_amdgcn_fence(__ATOMIC_RELEASE, "wavefront"); asm volatile("s_waitcnt lgkmcnt(0)" ::: "memory");
            }
        }
        __syncthreads();
        {
            bf16x8 vf[2], kf[2];
            LAS unsigned char* vb = vt + (8 * fq + ((lane & 15) >> 2)) * CP_KV_PITCH + 32 * wave + 8 * (lane & 3);
            LAS unsigned char* kb = kt + (8 * fq + ((lane & 15) >> 2)) * CP_KV_PITCH + 32 * wave + 8 * (lane & 3);
#pragma unroll
            for (int s = 0; s < 2; ++s) {
                const v4i16_t v0 = lds_tr16(vb + (32 * s) * CP_KV_PITCH), v1 = lds_tr16(vb + (32 * s + 4) * CP_KV_PITCH), k0 = lds_tr16(kb + (32 * s) * CP_KV_PITCH), k1 = lds_tr16(kb + (32 * s + 4) * CP_KV_PITCH);
                vf[s][0] = v0[0]; vf[s][1] = v0[1]; vf[s][2] = v0[2]; vf[s][3] = v0[3]; vf[s][4] = v1[0]; vf[s][5] = v1[1]; vf[s][6] = v1[2]; vf[s][7] = v1[3];
                kf[s][0] = k0[0]; kf[s][1] = k0[1]; kf[s][2] = k0[2]; kf[s][3] = k0[3]; kf[s][4] = k1[0]; kf[s][5] = k1[1]; kf[s][6] = k1[2]; kf[s][7] = k1[3];
            }
            float* UT = (float*)(blk + CHK_UT);
            bf16* Wp = (bf16*)(blk + CHK_WP);
#pragma unroll
            for (int ti = 0; ti < 4; ++ti) {
                f32x4 cu = (f32x4){0.f, 0.f, 0.f, 0.f}, cw = (f32x4){0.f, 0.f, 0.f, 0.f};
#pragma unroll
                for (int s = 0; s < 2; ++s) {
                    const LAS float* tr = Ts + (16 * ti + fr) * 68 + 32 * s + 8 * fq;
                    const f32x4 t0 = *(const LAS f32x4*)tr, t1 = *(const LAS f32x4*)(tr + 4);
                    const f32x4 b0 = *(const LAS f32x4*)(btS + 32 * s + 8 * fq), b1 = *(const LAS f32x4*)(btS + 32 * s + 8 * fq + 4), e0 = *(const LAS f32x4*)(egS + 32 * s + 8 * fq), e1 = *(const LAS f32x4*)(egS + 32 * s + 8 * fq + 4);
                    const f32x4 u0 = t0 * b0, u1 = t1 * b1, w0 = u0 * e0, w1 = u1 * e1;
                    cu = __builtin_amdgcn_mfma_f32_16x16x32_bf16(packfrag(u0, u1), vf[s], cu, 0, 0, 0);
                    cw = __builtin_amdgcn_mfma_f32_16x16x32_bf16(packfrag(w0, w1), kf[s], cw, 0, 0, 0);
                }
                *(f32x4*)(UT + (size_t)(16 * wave + fr) * 64 + 16 * ti + 4 * fq) = cu;
#pragma unroll
                for (int jj = 0; jj < 4; ++jj) Wp[(16 * ti + 4 * fq + jj) * 128 + 32 * (wave >> 1) + 8 * (fr >> 2) + 4 * (wave & 1) + (fr & 3)] = (bf16)f2bf(cw[jj]);
            }
        }
        __syncthreads();
    }
}
__device__ __forceinline__ void p14_pool(Frame& F, KArgs A) {
    const int lane = F.lane, tid = F.tid, gw = F.bid * NWAVES + F.wave, NGW = F.G * NWAVES;
    LAS float* pw = (LAS float*)(F.lds + 16384);
    LAS float* dl = (LAS float*)(F.lds + 16384 + 65536 + F.wave * 1024);
    {   f32x4 pv[8];
#pragma unroll
        for (int j = 0; j < 8; ++j) pv[j] = *(const f32x4*)(A->in[I_CD_POOLW] + (size_t)(tid + NTHREADS * j) * 4);
#pragma unroll
        for (int j = 0; j < 8; ++j) *(LAS f32x4*)(pw + (tid + NTHREADS * j) * 4) = pv[j];
    }
    __syncthreads();
    const bf16* QK = WSP(bf16, WS_QKVZ); bf16* AO = WSP(bf16, WS_AO);
    const int gi = lane >> 4, w = 2 << gi;
    float sc[4];
#pragma unroll
    for (int g = 0; g < 4; ++g) sc[g] = A->in[I_CD_POOLS][g * 64 + lane];
    for (int row = gw; row < M; row += NGW) {
        const int pos = row & (SEQ - 1);
        const int cntw = (pos + 1 < w) ? pos + 1 : w;
        float sum[4] = {0.f, 0.f, 0.f, 0.f}, cur[4] = {0.f, 0.f, 0.f, 0.f};
        v2u xw[16];
#pragma unroll
        for (int j = 0; j < 16; ++j) xw[j] = *(const v2u*)(QK + (size_t)(row - (j <= pos ? j : pos)) * 2560 + 2304 + 4 * lane);
#pragma unroll
        for (int j = 0; j < 16; ++j) {
            const float f0 = bflo(xw[j].x), f1 = bfhi(xw[j].x), f2 = bflo(xw[j].y), f3 = bfhi(xw[j].y);
            if (j < cntw) { sum[0] += f0; sum[1] += f1; sum[2] += f2; sum[3] += f3; }
            if (j == 0) { cur[0] = f0; cur[1] = f1; cur[2] = f2; cur[3] = f3; }
        }
        const float inv = 1.0f / (float)cntw;
#pragma unroll
        for (int i = 0; i < 4; ++i) dl[4 * lane + i] = sum[i] * inv - cur[i];
        float o[4] = {0.f, 0.f, 0.f, 0.f};
        for (int c = 0; c < 64; ++c) {
#pragma unroll
            for (int g = 0; g < 4; ++g) o[g] += dl[g * 64 + c] * pw[(g * 64 + c) * 64 + lane];
        }
#pragma unroll
        for (int g = 0; g < 4; ++g) AO[(size_t)row * 1024 + 768 + g * 64 + lane] = (bf16)f2bf(o[g] * sc[g]);
    }
}


#define IN(k) (lo <= (k) && (k) < hi)
#define SEAM(k) do { if (IN(k) && IN((k) + 1)) xcd_barrier(bar); } while (0)
template <int l> __device__ __forceinline__ void layer_tail(Frame& F, const XcdBarrier& bar, const int lo, const int hi) {
    LAS unsigned char* ring = F.lds + RING_OFF;
    const int bid = F.bid, G = F.G;
        const int pb = 8 * l;

        if (IN(7 + pb)) {
            pg8::Gemm g{WSP(bf16, WS_AO), (l == 0) ? WSP(bf16, WS_W_OUTAB) : WSP(bf16, WS_W_OUTCD), M, 1024, (l == 0) ? 1536 : 1024}; pg8::StaticOrder S; S.init(M, 1024, G, bid);
            pg8::Epi<pg8::StPre> E{{(l == 0) ? kargs()->in[I_X] : WSP(float, WS_H2), WSP(float, WS_PRE), ALPHA}};
            pg8::gemm_phase<pg8::Epi<pg8::StPre>, pg8::StaticOrder, true, true>(ring, g, S, E);
        } SEAM(7 + pb);
        if (IN(8 + pb)) { p8_ln_router(F, kargs(), l, WSP(float, WS_H1), WSP(bf16, WS_H1B)); } SEAM(8 + pb);
        if (IN(9 + pb)) {
            p9_scatter(F, l, WSP(bf16, WS_H1B), WSP(float, WS_H1));
            __syncthreads();
            pg8::Gemm g{WSP(bf16, WS_H1B), WSP(bf16, WS_W_PG) + (size_t)l * 1024 * 1024, M, 1024, 1024}; pg8::StaticOrder S; S.init(M, 1024, G, bid);
            pg8::Epi<pg8::StPleGate> E{{WSP(bf16, WS_PP) + (size_t)l * M * 1024, WSP(bf16, WS_PLE)}};
            pg8::gemm_phase<pg8::Epi<pg8::StPleGate>, pg8::StaticOrder, true, true>(ring, g, S, E);
        } SEAM(9 + pb);
        const int* TILE = WSP(int, WS_ROUTE) + 3 * M * 4;
        if (IN(10 + pb)) {
            const int nT = __builtin_amdgcn_readfirstlane(TILE[NTMAX]);
            constexpr int EB = kMoeFp8 ? 1 : 2;
            pg8::Gemm g{WSP(bf16, WS_XS), (const bf16*)(F.ws + WS_W_GU + (size_t)l * NEXP * 2048 * 1024 * EB), PMAX, 2048, 1024 * EB / 2};
            pg8::MoeOrder S{TILE, nT, 8, G, bid, (long)2048 * 1024 * EB};
            pg8::Epi<pg8::StSwiglu<kMoeFp8>> E{{kargs()->in[I_BGU] + (size_t)l * NEXP * 2048, WSP(bf16, WS_HID)}};
            pg8::gemm_phase<pg8::Epi<pg8::StSwiglu<kMoeFp8>>, pg8::MoeOrder, true, true, kMoeFp8 ? kScaleGU : 0u>(ring, g, S, E);
        } SEAM(10 + pb);
        if (IN(11 + pb)) {
            const int nT = __builtin_amdgcn_readfirstlane(TILE[NTMAX]);
            constexpr int EB = kMoeFp8 ? 1 : 2;
            pg8::Gemm g{WSP(bf16, WS_HID), (const bf16*)(F.ws + WS_W_DN + (size_t)l * NEXP * 1024 * 1024 * EB), PMAX, 1024, 1024 * EB / 2};
            pg8::MoeOrder S{TILE, nT, 4, G, bid, (long)1024 * 1024 * EB};
            pg8::Epi<pg8::StDown> E{{kargs()->in[I_BDN] + (size_t)l * NEXP * 1024, WSP(bf16, WS_YS)}};
            pg8::gemm_phase<pg8::Epi<pg8::StDown>, pg8::MoeOrder, true, true, kMoeFp8 ? kScaleDN : 0u>(ring, g, S, E);
        } SEAM(11 + pb);
        if (IN(12 + pb)) { p12_combine(F, kargs(), l, WSP(float, WS_H1), (l == 0) ? WSP(float, WS_H2) : kargs()->out, (l == 0) ? WSP(bf16, WS_XB) : (bf16*)nullptr); }
}
#undef IN
#undef SEAM
__global__ void __launch_bounds__(NTHREADS, 2) mk_fwd(Args args_by_value) {
    const KArgs KA = kargs();
    extern __shared__ __attribute__((aligned(16))) unsigned char lds[];
    Frame F;
    F.lds = (LAS unsigned char*)lds;
    F.tid = threadIdx.x; F.lane = F.tid & 63; F.wave = __builtin_amdgcn_readfirstlane(F.tid >> 6);
    F.G = gridDim.x; F.bid = blockIdx.x; F.ws = KA->ws; F.ctl = (gu32*)(KA->ws + WS_CTL);
    volatile LAS unsigned* MISC = (volatile LAS unsigned*)(F.lds + MISC_OFF);
    { int t0 = threadIdx.x; asm volatile("" : "+v"(t0)); for (int u = t0; u < (LDS_BYTES - MISC_OFF) / 4; u += NTHREADS) MISC[u] = 0u; }
    __syncthreads();
    const bool use_bar = (N_LAUNCHES != NPHASES);
    XcdBarrier bar; bar.bar = (unsigned*)(F.ctl + CW_BAR) + KA->li * XCD_BAR_WORDS; bar.x = 0; bar.st = nullptr; bar.expect = 0;
    XcdBarrier bar2 = bar;
    if (use_bar && F.bid >= SEQ_WGS && F.G > SEQ_WGS) bar2 = xcd_barrier_post((unsigned*)(F.ctl + CW_BAR2), MISC + 10, (unsigned)(F.G - SEQ_WGS));
    if (use_bar) bar = xcd_barrier_post((unsigned*)(F.ctl + CW_BAR) + KA->li * XCD_BAR_WORDS, MISC + 8);
    const int lo = KA->ph_lo, hi = KA->ph_hi;
#define IN(k) (lo <= (k) && (k) < hi)
#define SEAM(k) do { if (IN(k) && IN((k) + 1)) xcd_barrier(bar); } while (0)
    LAS unsigned char* ring = F.lds + RING_OFF;
    const int bid = F.bid, G = F.G;

    if (IN(0)) { p0_prologue(F, kargs()); } SEAM(0);

            if (IN(1)) {
                { pg8::Gemm g{WSP(bf16, WS_XB), WSP(bf16, WS_W_INAB), M, 2560, 1024}; pg8::StaticOrder S; S.init(M, 2560, G, bid);
                  pg8::Epi<pg8::StInAB> E{{WSP(float, WS_SM), WSP(bf16, WS_QKVZ)}};
                  pg8::gemm_phase<pg8::Epi<pg8::StInAB>, pg8::StaticOrder, true, true>(ring, g, S, E); }
                __syncthreads();
                { pg8::Gemm g{WSP(bf16, WS_PB), WSP(bf16, WS_W_PP), 2 * M, 1024, 256}; pg8::BatchOrder S{4, (2 * M / 256) * 4, G, bid, M / 256, (long)1024 * 256 * 2};
                  pg8::Epi<pg8::StBf16> E{{WSP(bf16, WS_PP), 1024}};
                  pg8::gemm_phase<pg8::Epi<pg8::StBf16>, pg8::BatchOrder, true, true>(ring, g, S, E); }
            } SEAM(1);
            if (IN(2)) { p2_prep(F, kargs()); } SEAM(2);
            if (IN(3)) {
                p3_chunk_prep_mfma(F, kargs());
                __syncthreads();
                { pg8::Gemm g{WSP(bf16, WS_CQ), WSP(bf16, WS_W_ABS), M, 1536, 256}; pg8::StaticOrder S; S.init(M, 1536, G, bid);
                  pg8::Epi<pg8::StBf16> E{{WSP(bf16, WS_QL), 1536}};
                  pg8::gemm_phase<pg8::Epi<pg8::StBf16>, pg8::StaticOrder, true, true>(ring, g, S, E); }
            } SEAM(3);
            if (IN(4)) {
                if (bid < SEQ_WGS && G > SEQ_WGS) p4_delta_seq(F, bid);
                else { p4_indexer(F, (bid - SEQ_WGS) * NWAVES + F.wave, (G - SEQ_WGS) * NWAVES);
                    if (use_bar) { xcd_barrier(bar2);
                        p5_topk_attn(F, (bid - SEQ_WGS) * NWAVES + F.wave, (G - SEQ_WGS) * NWAVES); } }
            } SEAM(4);
            if (IN(5)) { if (!use_bar) p5_topk_attn(F, bid * NWAVES + F.wave, G * NWAVES); p6_gdn_out(F, kargs()); } SEAM(5);
    layer_tail<0>(F, bar, lo, hi);
    SEAM(12);
            if (IN(13)) {
                pg8::Gemm g{WSP(bf16, WS_XB), WSP(bf16, WS_W_INCD), M, 2560, 1024}; pg8::StaticOrder S; S.init(M, 2560, G, bid);
                pg8::Epi<pg8::StBf16> E{{WSP(bf16, WS_QKVZ), 2560}};
                pg8::gemm_phase<pg8::Epi<pg8::StBf16>, pg8::StaticOrder, true, true>(ring, g, S, E);
            } SEAM(13);
            if (IN(14)) { p14_dilated_mfma(F); __syncthreads(); p14_pool(F, kargs()); } SEAM(14);
    layer_tail<1>(F, bar, lo, hi);
#undef IN
#undef SEAM
}

extern "C" void kernel_launch(void* const* d_in, const int* in_sizes, int n_in, void* d_out, int out_size, void* d_ws, size_t ws_size, hipStream_t stream) {
    static int grid = 0;
    if (grid == 0) {
        if (n_in != N_IN || in_sizes[0] != M * D || out_size != M * D || ws_size < WS_END) {
            fprintf(stderr, "kernel_launch: built for %d inputs, x/out of %d floats, >= %zu bytes of workspace; got n_in %d, in0 %d, out %d, ws %zu; nothing launched\n", N_IN, M * D, (size_t)WS_END, n_in, n_in > 0 ? in_sizes[0] : -1, out_size, ws_size);
            grid = -1; return; }
        int dev = 0, cus = 0, per_cu = 0;
        if (hipGetDevice(&dev) != hipSuccess || hipDeviceGetAttribute(&cus, hipDeviceAttributeMultiprocessorCount, dev) != hipSuccess) { fprintf(stderr, "kernel_launch: device query failed\n"); grid = -1; return; }
        if (hipFuncSetAttribute((const void*)mk_fwd, hipFuncAttributeMaxDynamicSharedMemorySize, LDS_BYTES) != hipSuccess) { fprintf(stderr, "kernel_launch: hipFuncSetAttribute failed\n"); grid = -1; return; }
        if (hipOccupancyMaxActiveBlocksPerMultiprocessor(&per_cu, (const void*)mk_fwd, NTHREADS, LDS_BYTES) != hipSuccess || per_cu < 1)
            fprintf(stderr, "kernel_launch: note: occupancy query reports %d workgroups per CU\n", per_cu);
        (void)hipGetLastError();
        grid = cus;
    }
    if (grid < 0) return;
    if (hipMemsetAsync((char*)d_ws + WS_CTL, 0, CTL_ZERO_BYTES, stream) != hipSuccess) { fprintf(stderr, "kernel_launch: memset failed\n"); return; }
    Args a{};
    for (int i = 0; i < N_IN; ++i) a.in[i] = (const float*)d_in[i];
    a.out = (float*)d_out; a.ws = (unsigned char*)d_ws;
    for (int li = 0; li < N_LAUNCHES; ++li) {
        if (N_LAUNCHES == NPHASES) { a.ph_lo = li; a.ph_hi = li + 1; } else { a.ph_lo = (int)((long)li * NPHASES / N_LAUNCHES); a.ph_hi = (int)((long)(li + 1) * NPHASES / N_LAUNCHES); }
        a.li = li;
        hipLaunchKernelGGL(mk_fwd, dim3(grid), dim3(NTHREADS), LDS_BYTES, stream, a);
        const hipError_t le = hipPeekAtLastError();
        if (le != hipSuccess) { fprintf(stderr, "kernel_launch: launch %d failed: %s\n", li, hipGetErrorName(le)); break; }
    }
}
```

```cpp
#include <hip/hip_runtime.h>
#include <cstdio>
#include <cstdint>

namespace pg8 {
#define PG8_LAS __attribute__((address_space(3)))
typedef unsigned short bf16_t;
typedef short bf16x8 __attribute__((ext_vector_type(8)));
typedef float f32x4 __attribute__((ext_vector_type(4)));
typedef unsigned u32x4 __attribute__((ext_vector_type(4)));
constexpr int BM = 256, BK = 64, HALF = 128, HTB = HALF * BK * 2  , STAGE_BYTES = 8 * HTB, NXCD = 8, WGM = 8;

__host__ __device__ __forceinline__ int lds_byte(int r, int c) { const int st = (r >> 4) * 2 + (c >> 5), rr = r & 15, cc = c & 31, ob = rr * 64 + cc * 2; return st * 1024 + (ob ^ (((ob >> 9) & 1) << 5)); }
__host__ __device__ __forceinline__ void stage_rc(int b, int& R, int& C) { const int st = b / 1024, sb = b % 1024, swz = sb ^ (((sb >> 9) & 1) << 5); R = (st >> 1) * 16 + swz / 64; C = (st & 1) * 32 + (swz % 64) / 2; }
__host__ __device__ __forceinline__ int perm32(int rho) { const int n = rho >> 4, i = rho & 15; return 8 * (i >> 2) + 4 * n + (i & 3); }

struct Unit { int pm, pn, e; long bofs; };
struct Gemm { const bf16_t* A; const bf16_t* Bt; int M, N, K; };

struct StaticOrder {
    int nM, nN, nwg, G, c;
    __host__ __device__ void init(int M, int N, int G_, int c_) { nM = M / BM; nN = N / BM; nwg = nM * nN; G = G_; c = c_; }
    __host__ __device__ bool next(int i, Unit& u) const {
        const long L = (long)i * G + c; if (L >= nwg) return false;
        int wgid = (int)L; { const int q = nwg / NXCD, r = nwg % NXCD, xcd = wgid % NXCD, off = wgid / NXCD; wgid = (xcd < r ? xcd * (q + 1) : r * (q + 1) + (xcd - r) * q) + off; }
        const int nig = WGM * nN, gid = wgid / nig, fm = gid * WGM, gsz = (nM - fm) < WGM ? (nM - fm) : WGM;
        u.pm = fm + ((wgid % nig) % gsz); u.pn = (wgid % nig) / gsz; u.e = 0; u.bofs = 0; return true;
    }
    __device__ __forceinline__ void a_ready(const Unit&) const {}
    __device__ __forceinline__ void done(const Unit&) const {}
};
struct MoeOrder {
    const int* tile_e; int nT, nN, G, c; long estride;
    __device__ __forceinline__ bool next(int i, Unit& u) const {
        if (G % (8 * nN) == 0) {
            const int rpx = G / (8 * nN), xcd = c & 7, idx = c >> 3;
            u.pm = (i * 8 + xcd) * rpx + idx % rpx; u.pn = idx / rpx;
            if (u.pm >= nT) return false;
        } else {
            const long L = (long)i * G + c; if (L >= (long)nT * nN) return false;
            u.pm = (int)(L / nN); u.pn = (int)(L % nN);
        }
        const int e = tile_e[u.pm]; u.e = e; u.bofs = (long)e * estride; return true;
    }
    __device__ __forceinline__ void a_ready(const Unit&) const {}
    __device__ __forceinline__ void done(const Unit&) const {}
};

struct BatchOrder {
    int nN, nwg, G, c, tiles_per_batch; long bstride;
    __device__ __forceinline__ bool next(int i, Unit& u) const {
        const long L = (long)i * G + c; if (L >= nwg) return false;
        u.pm = (int)(L / nN); u.pn = (int)(L % nN); const int e = u.pm / tiles_per_batch; u.e = e; u.bofs = (long)e * bstride; return true;
    }
    __device__ __forceinline__ void a_ready(const Unit&) const {}
    __device__ __forceinline__ void done(const Unit&) const {}
};

__device__ __forceinline__ unsigned cvt_pk_bf16(float lo, float hi) { unsigned r; asm volatile("v_cvt_pk_bf16_f32 %0, %1, %2" : "=v"(r) : "v"(lo), "v"(hi)); return r; }
__device__ __forceinline__ u32x4 pack8(const f32x4 v0, const f32x4 v1) { u32x4 w; w.x = cvt_pk_bf16(v0[0], v0[1]); w.y = cvt_pk_bf16(v0[2], v0[3]); w.z = cvt_pk_bf16(v1[0], v1[1]); w.w = cvt_pk_bf16(v1[2], v1[3]); return w; }
__device__ __forceinline__ float bf_lo(unsigned w) { return __uint_as_float(w << 16); }
__device__ __forceinline__ float bf_hi(unsigned w) { return __uint_as_float(w & 0xffff0000u); }
__device__ __forceinline__ float sigmoidf_(float x) { return 1.0f / (1.0f + __expf(-x)); }
typedef unsigned u32x2 __attribute__((ext_vector_type(2)));

template <class T> struct Epi {
    static constexpr bool PERM = true, AFTER_DRAIN = false;
    T t;
    __device__ __forceinline__ void operator()(const f32x4 (&acc)[2][2][4][2], const Unit& u, int wr, int wc, int fr, int fq) const {
        const int row0 = u.pm * BM + wr * 64 + fr, col0 = u.pn * BM + wc * 32 + 8 * fq;
        f32x4 cb[2][2];
#pragma unroll
        for (int bj = 0; bj < 2; ++bj) t.colctx(col0 + bj * HALF, u, cb[bj][0], cb[bj][1]);
        f32x4 rc[2][2], rn[2][2];
#pragma unroll
        for (int bj = 0; bj < 2; ++bj) t.rowctx(row0, col0 + bj * HALF, rc[bj][0], rc[bj][1]);
#pragma unroll
        for (int g = 0; g < 8; ++g) {
            const int ai = g >> 2, m = g & 3, row = row0 + ai * HALF + m * 16;
            if (g < 7) { const int nrow = row0 + ((g + 1) >> 2) * HALF + ((g + 1) & 3) * 16;
#pragma unroll
                for (int bj = 0; bj < 2; ++bj) t.rowctx(nrow, col0 + bj * HALF, rn[bj][0], rn[bj][1]); }
#pragma unroll
            for (int bj = 0; bj < 2; ++bj) t.store(row, col0 + bj * HALF, acc[ai][bj][m][0] + cb[bj][0], acc[ai][bj][m][1] + cb[bj][1], u, rc[bj][0], rc[bj][1]);
            asm volatile("" ::: "memory");
#pragma unroll
            for (int bj = 0; bj < 2; ++bj) { rc[bj][0] = rn[bj][0]; rc[bj][1] = rn[bj][1]; }
        }
    }
};
struct StBf16 { bf16_t* O; int ld;
    __device__ __forceinline__ void rowctx(int, int, f32x4& r0, f32x4& r1) const { r0 = (f32x4){0.f, 0.f, 0.f, 0.f}; r1 = r0; }
    __device__ __forceinline__ void colctx(int, const Unit&, f32x4& c0, f32x4& c1) const { c0 = (f32x4){0.f, 0.f, 0.f, 0.f}; c1 = c0; }
    __device__ __forceinline__ void store(int row, int col, f32x4 v0, f32x4 v1, const Unit&, f32x4, f32x4) const { *(u32x4*)(O + (size_t)row * ld + col) = pack8(v0, v1); } };
struct StInAB { float* SM; bf16_t* Q;
    __device__ __forceinline__ void rowctx(int, int, f32x4& r0, f32x4& r1) const { r0 = (f32x4){0.f, 0.f, 0.f, 0.f}; r1 = r0; }
    __device__ __forceinline__ void colctx(int, const Unit&, f32x4& c0, f32x4& c1) const { c0 = (f32x4){0.f, 0.f, 0.f, 0.f}; c1 = c0; }
    __device__ __forceinline__ void store(int row, int col, f32x4 v0, f32x4 v1, const Unit&, f32x4, f32x4) const {
        if (col < 512) { float* p = SM + (size_t)row * 512 + col; *(f32x4*)p = v0; *(f32x4*)(p + 4) = v1; }
        else *(u32x4*)(Q + (size_t)row * 2048 + (col - 512)) = pack8(v0, v1); } };
struct StPre { const float* base; float* P; float alpha;
    __device__ __forceinline__ void colctx(int, const Unit&, f32x4& c0, f32x4& c1) const { c0 = (f32x4){0.f, 0.f, 0.f, 0.f}; c1 = c0; }
    __device__ __forceinline__ void rowctx(int row, int col, f32x4& r0, f32x4& r1) const { const size_t o = (size_t)row * 1024 + col; r0 = *(const f32x4*)(base + o); r1 = *(const f32x4*)(base + o + 4); }
    __device__ __forceinline__ void store(int row, int col, f32x4 v0, f32x4 v1, const Unit&, f32x4 b0, f32x4 b1) const {
        const size_t o = (size_t)row * 1024 + col;
        *(f32x4*)(P + o) = b0 * alpha + v0; *(f32x4*)(P + o + 4) = b1 * alpha + v1; } };
struct StPleGate { const bf16_t* PP; bf16_t* O;
    __device__ __forceinline__ void colctx(int, const Unit&, f32x4& c0, f32x4& c1) const { c0 = (f32x4){0.f, 0.f, 0.f, 0.f}; c1 = c0; }
    __device__ __forceinline__ void rowctx(int row, int col, f32x4& r0, f32x4& r1) const { r0 = *(const f32x4*)(PP + (size_t)row * 1024 + col); r1 = r0; }
    __device__ __forceinline__ void store(int row, int col, f32x4 v0, f32x4 v1, const Unit&, f32x4 pr, f32x4) const {
        const size_t o = (size_t)row * 1024 + col; const u32x4 p = __builtin_bit_cast(u32x4, pr);
        f32x4 r0, r1;
        r0[0] = sigmoidf_(v0[0]) * bf_lo(p.x); r0[1] = sigmoidf_(v0[1]) * bf_hi(p.x); r0[2] = sigmoidf_(v0[2]) * bf_lo(p.y); r0[3] = sigmoidf_(v0[3]) * bf_hi(p.y);
        r1[0] = sigmoidf_(v1[0]) * bf_lo(p.z); r1[1] = sigmoidf_(v1[1]) * bf_hi(p.z); r1[2] = sigmoidf_(v1[2]) * bf_lo(p.w); r1[3] = sigmoidf_(v1[3]) * bf_hi(p.w);
        *(u32x4*)(O + o) = pack8(r0, r1); } };
template <bool F8> struct StSwiglu { const float* bgu; bf16_t* H;
    __device__ __forceinline__ void rowctx(int, int, f32x4& r0, f32x4& r1) const { r0 = (f32x4){0.f, 0.f, 0.f, 0.f}; r1 = r0; }
    __device__ __forceinline__ float act(float g, float u) const { const float gt = fminf(g, 7.0f), up = fminf(fmaxf(u, -7.0f), 7.0f); return (up + 1.0f) * (gt * sigmoidf_(gt * 1.702f)); }
    __device__ __forceinline__ void colctx(int col, const Unit& u, f32x4& c0, f32x4& c1) const { const float* b = bgu + (size_t)u.e * 2048 + col; c0 = *(const f32x4*)b; c1 = *(const f32x4*)(b + 4); }
    __device__ __forceinline__ void store(int row, int col, f32x4 v0, f32x4 v1, const Unit& u, f32x4, f32x4) const {
        if (F8) { unsigned w = 0u; w = __builtin_amdgcn_cvt_pk_fp8_f32(act(v0[0], v0[1]), act(v0[2], v0[3]), w, false); w = __builtin_amdgcn_cvt_pk_fp8_f32(act(v1[0], v1[1]), act(v1[2], v1[3]), w, true);
            *(unsigned*)((unsigned char*)H + (size_t)row * 1024 + (col >> 1)) = w; }
        else { u32x2 w; w.x = cvt_pk_bf16(act(v0[0], v0[1]), act(v0[2], v0[3])); w.y = cvt_pk_bf16(act(v1[0], v1[1]), act(v1[2], v1[3]));
            *(u32x2*)(H + (size_t)row * 1024 + (col >> 1)) = w; } } };
struct StDown { const float* bd; bf16_t* Y;
    __device__ __forceinline__ void rowctx(int, int, f32x4& r0, f32x4& r1) const { r0 = (f32x4){0.f, 0.f, 0.f, 0.f}; r1 = r0; }
    __device__ __forceinline__ void colctx(int col, const Unit& u, f32x4& c0, f32x4& c1) const { const float* b = bd + (size_t)u.e * 1024 + col; c0 = *(const f32x4*)b; c1 = *(const f32x4*)(b + 4); }
    __device__ __forceinline__ void store(int row, int col, f32x4 v0, f32x4 v1, const Unit& u, f32x4, f32x4) const {
        *(u32x4*)(Y + (size_t)row * 1024 + col) = pack8(v0, v1); } };

typedef int i32x8 __attribute__((ext_vector_type(8)));
typedef int i32x4 __attribute__((ext_vector_type(4)));
template <class Epi, class Sched, bool ALIGN_EPI = false, bool SP2 = false, unsigned FP8W = 0u>
__device__ __forceinline__ void gemm_phase(PG8_LAS unsigned char* lds, const Gemm g, const Sched& S, const Epi& E) {
    int tid = threadIdx.x; asm volatile("" : "+v"(tid));
    const int wid = __builtin_amdgcn_readfirstlane(tid >> 6), lane = tid & 63, wr = wid >> 2, wc = wid & 3, fr = lane & 15, fq = lane >> 4;
    int K = g.K; asm volatile("" : "+s"(K));
    const int nt = K / BK;
    unsigned voffA[2], voffB[2];
#pragma unroll
    for (int i = 0; i < 2; ++i) { int R, C; stage_rc(tid * 16 + i * 8192, R, C); const int Rb = Epi::PERM ? ((R & ~31) + perm32(R & 31)) : R;
        voffA[i] = (unsigned)(R * K + C) * 2u; voffB[i] = (unsigned)(Rb * K + C) * 2u; }
    const size_t kstep = (size_t)(BK * 2);
    const size_t hstep = (size_t)HALF * K * 2;
    const size_t tstep = 2 * hstep;
    const unsigned ldsw = (unsigned)wid * 1024u;
    const int aoff = lds_byte(wr * 64 + fr, fq * 8), boff = lds_byte(wc * 32 + fr, fq * 8);
#define PG8_SA(b, h) (((b) * 2 + (h)) * HTB)
#define PG8_SB(b, h) ((4 + (b) * 2 + (h)) * HTB)
#define PG8_STAGE(bufoff, gbase, voff) do { _Pragma("unroll") for (int _i = 0; _i < 2; ++_i) \
        __builtin_amdgcn_global_load_lds((const unsigned*)((const char*)(gbase) + (voff)[_i]), (PG8_LAS unsigned*)(lds + (bufoff) + ldsw + _i * 8192), 16, 0, 0); } while (0)
#define PG8_CAT(lo, hi) __builtin_shufflevector((lo), (hi), 0, 1, 2, 3, 4, 5, 6, 7)
#define PG8_LDA(dst, b, h) do { if constexpr (FP8W != 0u) { _Pragma("unroll") for (int m = 0; m < 4; ++m) dst##8[m] = PG8_CAT(*(const PG8_LAS i32x4*)(lds + PG8_SA(b, h) + aoff + m * 2048), *(const PG8_LAS i32x4*)(lds + PG8_SA(b, h) + aoff + m * 2048 + 1024)); } \
        else { _Pragma("unroll") for (int m = 0; m < 4; ++m) _Pragma("unroll") for (int k = 0; k < 2; ++k) dst[m][k] = *(const PG8_LAS bf16x8*)(lds + PG8_SA(b, h) + aoff + m * 2048 + k * 1024); } } while (0)
#define PG8_LDB(dst, b, h) do { if constexpr (FP8W != 0u) { _Pragma("unroll") for (int n = 0; n < 2; ++n) dst##8[n] = PG8_CAT(*(const PG8_LAS i32x4*)(lds + PG8_SB(b, h) + boff + n * 2048), *(const PG8_LAS i32x4*)(lds + PG8_SB(b, h) + boff + n * 2048 + 1024)); } \
        else { _Pragma("unroll") for (int n = 0; n < 2; ++n) _Pragma("unroll") for (int k = 0; k < 2; ++k) dst[n][k] = *(const PG8_LAS bf16x8*)(lds + PG8_SB(b, h) + boff + n * 2048 + k * 1024); } } while (0)
#define PG8_MMA(ai, bj, At, Bt) do { __builtin_amdgcn_s_setprio(1); _Pragma("unroll") for (int m = 0; m < 4; ++m) _Pragma("unroll") for (int n = 0; n < 2; ++n) { \
        if constexpr (FP8W != 0u) asm volatile("v_mfma_scale_f32_16x16x128_f8f6f4 %0, %1, %2, %0, %3, %4 op_sel_hi:[0,0,0]" : "+v"(acc[ai][bj][m][n]) : "v"(Bt##8[n]), "v"(At##8[m]), "v"(sc_w), "v"(sc_x));   \
        else { _Pragma("unroll") for (int k = 0; k < 2; ++k) acc[ai][bj][m][n] = __builtin_amdgcn_mfma_f32_16x16x32_bf16(Bt[n][k], At[m][k], acc[ai][bj][m][n], 0, 0, 0); } } __builtin_amdgcn_s_setprio(0); } while (0)
#define PG8_WAIT_V(n) asm volatile("s_waitcnt vmcnt(" #n ")" ::: "memory")
#define PG8_WAIT_L(n) asm volatile("s_waitcnt lgkmcnt(" #n ")" ::: "memory")
#define PG8_BAR __builtin_amdgcn_s_barrier()
#define PG8_SCHED __builtin_amdgcn_sched_barrier(0)
    Unit cur, nxt; int ui = 0;
    if (!S.next(0, cur)) return;
    f32x4 acc[2][2][4][2];
#pragma unroll
    for (int a = 0; a < 2; ++a)
#pragma unroll
        for (int b = 0; b < 2; ++b)
#pragma unroll
            for (int m = 0; m < 4; ++m)
#pragma unroll
                for (int n = 0; n < 2; ++n) acc[a][b][m][n] = (f32x4){0.f, 0.f, 0.f, 0.f};
    bf16x8 At[4][2], B0[2][2], B1[2][2];
    int sc_w = (int)FP8W, sc_x = 0x7f7f7f7f; asm volatile("" : "+v"(sc_w), "+v"(sc_x));
    i32x8 At8[4], B08[2], B18[2];
    const char* cA = (const char*)g.A + (size_t)cur.pm * tstep; const char* cB = (const char*)g.Bt + (size_t)cur.pn * tstep + cur.bofs;
    S.a_ready(cur);
    if constexpr (SP2) {
        PG8_STAGE(PG8_SB(0, 0), cB, voffB); PG8_STAGE(PG8_SB(0, 1), cB + hstep, voffB); PG8_STAGE(PG8_SA(0, 0), cA, voffA); PG8_STAGE(PG8_SA(0, 1), cA + hstep, voffA);
        if (wr == 1) PG8_BAR;
        PG8_WAIT_V(2); PG8_BAR;
        PG8_STAGE(PG8_SB(1, 0), cB + kstep, voffB); PG8_STAGE(PG8_SA(1, 0), cA + kstep, voffA); PG8_STAGE(PG8_SB(1, 1), cB + hstep + kstep, voffB);
        PG8_WAIT_V(6); PG8_BAR;
    } else {
        PG8_STAGE(PG8_SB(0, 0), cB, voffB); PG8_STAGE(PG8_SA(0, 0), cA, voffA); PG8_STAGE(PG8_SB(0, 1), cB + hstep, voffB); PG8_STAGE(PG8_SA(0, 1), cA + hstep, voffA);
        if (wr == 1) PG8_BAR;
        PG8_WAIT_V(4); PG8_BAR;
        PG8_STAGE(PG8_SB(1, 0), cB + kstep, voffB); PG8_STAGE(PG8_SA(1, 0), cA + kstep, voffA); PG8_STAGE(PG8_SB(1, 1), cB + hstep + kstep, voffB);
        PG8_WAIT_V(6); PG8_BAR;
    }
    for (;;) {
        const bool has_next = S.next(ui + 1, nxt);
        const char* nA = has_next ? (const char*)g.A + (size_t)nxt.pm * tstep : cA; const char* nB = has_next ? (const char*)g.Bt + (size_t)nxt.pn * tstep + nxt.bofs : cB;
        for (int t = 0; t < nt; t += 2) {
            const bool last = (t == nt - 2);
            const char* a1 = cA + (size_t)(t + 1) * kstep;
            const char* a2 = last ? nA : cA + (size_t)(t + 2) * kstep; const char* b2 = last ? nB : cB + (size_t)(t + 2) * kstep;
            const char* a3 = a2 + kstep; const char* b3 = b2 + kstep;
            if (last && has_next) S.a_ready(nxt);
            if constexpr (SP2) {
            PG8_LDB(B0, 0, 0); PG8_LDB(B1, 0, 1); PG8_SCHED; PG8_LDA(At, 0, 0); PG8_STAGE(PG8_SA(1, 1), a1 + hstep, voffA);
            PG8_WAIT_V(8); PG8_WAIT_L(0); PG8_BAR; PG8_MMA(0, 0, At, B0); PG8_MMA(0, 1, At, B1); PG8_BAR; PG8_SCHED;
            PG8_LDA(At, 0, 1); PG8_STAGE(PG8_SB(0, 0), b2, voffB); PG8_STAGE(PG8_SB(0, 1), b2 + hstep, voffB); PG8_STAGE(PG8_SA(0, 0), a2, voffA);
            PG8_WAIT_V(8); PG8_WAIT_L(0); PG8_BAR; PG8_MMA(1, 0, At, B0); PG8_MMA(1, 1, At, B1); PG8_BAR; PG8_SCHED;
            PG8_LDB(B0, 1, 0); PG8_LDB(B1, 1, 1); PG8_SCHED; PG8_LDA(At, 1, 0); PG8_STAGE(PG8_SA(0, 1), a2 + hstep, voffA);
            PG8_WAIT_V(8); PG8_WAIT_L(0); PG8_BAR; PG8_MMA(0, 0, At, B0); PG8_MMA(0, 1, At, B1); PG8_BAR; PG8_SCHED;
            PG8_LDA(At, 1, 1); PG8_STAGE(PG8_SB(1, 0), b3, voffB); PG8_STAGE(PG8_SB(1, 1), b3 + hstep, voffB); PG8_STAGE(PG8_SA(1, 0), a3, voffA);
            PG8_WAIT_V(8); PG8_WAIT_L(0); PG8_BAR; PG8_MMA(1, 0, At, B0); PG8_MMA(1, 1, At, B1); PG8_BAR; PG8_SCHED;
            } else {
            PG8_LDB(B0, 0, 0); PG8_SCHED; PG8_LDA(At, 0, 0); PG8_STAGE(PG8_SA(1, 1), a1 + hstep, voffA);
            PG8_WAIT_L(8); PG8_BAR; PG8_WAIT_L(0); PG8_MMA(0, 0, At, B0); PG8_BAR; PG8_SCHED;
            PG8_LDB(B1, 0, 1); PG8_STAGE(PG8_SB(0, 0), b2, voffB);
            PG8_BAR; PG8_WAIT_L(0); PG8_MMA(0, 1, At, B1); PG8_BAR;
            PG8_LDA(At, 0, 1); PG8_STAGE(PG8_SA(0, 0), a2, voffA);
            PG8_BAR; PG8_WAIT_L(0); PG8_MMA(1, 0, At, B0); PG8_BAR; PG8_SCHED;
            PG8_STAGE(PG8_SB(0, 1), b2 + hstep, voffB);
            PG8_WAIT_V(6); PG8_BAR; PG8_MMA(1, 1, At, B1); PG8_BAR;
            PG8_LDB(B0, 1, 0); PG8_SCHED; PG8_LDA(At, 1, 0); PG8_STAGE(PG8_SA(0, 1), a2 + hstep, voffA);
            PG8_WAIT_L(8); PG8_BAR; PG8_WAIT_L(0); PG8_MMA(0, 0, At, B0); PG8_BAR; PG8_SCHED;
            PG8_LDB(B1, 1, 1); PG8_STAGE(PG8_SB(1, 0), b3, voffB);
            PG8_BAR; PG8_WAIT_L(0); PG8_MMA(0, 1, At, B1); PG8_BAR;
            PG8_LDA(At, 1, 1); PG8_STAGE(PG8_SA(1, 0), a3, voffA);
            PG8_BAR; PG8_WAIT_L(0); PG8_MMA(1, 0, At, B0); PG8_BAR; PG8_SCHED;
            PG8_STAGE(PG8_SB(1, 1), b3 + hstep, voffB);
            PG8_WAIT_V(6); PG8_BAR; PG8_MMA(1, 1, At, B1); PG8_BAR;
            }
        }
        if constexpr (FP8W != 0u) asm volatile("s_nop 15\n\ts_nop 15" ::: "memory");
        if constexpr (ALIGN_EPI) { if (wr == 0) PG8_BAR; }
        if constexpr (!Epi::AFTER_DRAIN) { E(acc, cur, wr, wc, fr, fq); S.done(cur); }
        if (!has_next) break;
#pragma unroll
        for (int a = 0; a < 2; ++a)
#pragma unroll
            for (int b = 0; b < 2; ++b)
#pragma unroll
                for (int m = 0; m < 4; ++m)
#pragma unroll
                    for (int n = 0; n < 2; ++n) acc[a][b][m][n] = (f32x4){0.f, 0.f, 0.f, 0.f};
        cur = nxt; cA = nA; cB = nB; ++ui;
        if constexpr (ALIGN_EPI) { if (wr == 1) PG8_BAR; }
    }
    PG8_WAIT_V(0);
    if constexpr (!ALIGN_EPI) { if (wr == 0) PG8_BAR; }
    PG8_BAR;
    if constexpr (Epi::AFTER_DRAIN) { E.fused(acc, cur, wr, wc, fr, fq, lds, wid, lane); S.done(cur); }
#undef PG8_SA
#undef PG8_SB
#undef PG8_STAGE
#undef PG8_LDA
#undef PG8_CAT
#undef PG8_LDB
#undef PG8_MMA
#undef PG8_WAIT_V
#undef PG8_WAIT_L
#undef PG8_BAR
#undef PG8_SCHED
}
}

constexpr int NWAVES = 8, NTHREADS = 512;
constexpr int BATCH = 2, SEQ = 8192, M = BATCH * SEQ, D = 1024;
constexpr int NEXP = 32, DEXP = 1024;
constexpr int PMAX = M * 4 + NEXP * 256, NTMAX = PMAX / 256;
constexpr float ALPHA = 1.41421356237f;
constexpr int NPHASES = 21;
#ifndef MOE_FP8
#define MOE_FP8 1
#endif
constexpr bool kMoeFp8 = (MOE_FP8 != 0);
constexpr unsigned kScaleGU = 0x79797979u, kScaleDN = 0x78787878u;
#ifndef MK_N_LAUNCHES
#define MK_N_LAUNCHES 1
#endif
constexpr int N_LAUNCHES = MK_N_LAUNCHES;

enum { I_X = 0, I_P, I_AB_WIN, I_AB_QG, I_AB_KVG, I_AB_WUQ, I_AB_WUK, I_AB_WUV, I_AB_WQIDX, I_AB_KIG, I_AB_KIB, I_AB_CONVW, I_AB_ALOG, I_AB_DTB, I_AB_ONG, I_AB_WOUT,
       I_CD_WIN, I_CD_POOLW, I_CD_POOLS, I_CD_WOUT, I_LNM_G, I_LNM_B, I_RW, I_RB, I_WGU, I_BGU, I_WDN, I_BDN, I_PLE_WP, I_PLE_WG, I_LNF_G, I_LNF_B, N_IN };

constexpr size_t MiB = 1u << 20;
constexpr size_t WS_CTL = 0, CTL_ZERO_BYTES = 1 * MiB;
constexpr size_t WS_W_INAB = 1 * MiB;
constexpr size_t WS_W_ABS = 6 * MiB;
constexpr size_t WS_W_OUTAB = 7 * MiB;
constexpr size_t WS_W_INCD = 10 * MiB;
constexpr size_t WS_W_OUTCD = 15 * MiB;
constexpr size_t WS_W_PG = 17 * MiB;
constexpr size_t WS_W_PP = 21 * MiB;
constexpr size_t WS_W_GU = 22 * MiB;
constexpr size_t WS_W_DN = 278 * MiB;
constexpr size_t WS_XB = 406 * MiB;
constexpr size_t WS_PB = 438 * MiB;
constexpr size_t WS_PP = 454 * MiB;
constexpr size_t WS_SM = 518 * MiB;
constexpr size_t WS_QKVZ = 550 * MiB;
constexpr size_t WS_CQ = 630 * MiB;
constexpr size_t WS_CKV = 638 * MiB;
constexpr size_t WS_KIDX = 642 * MiB;
constexpr size_t WS_WIDX = 644 * MiB;
constexpr size_t WS_BETA = 645 * MiB;
constexpr size_t WS_GG = WS_BETA + 512 * 1024;
constexpr size_t WS_QN = 646 * MiB, WS_KN = 662 * MiB, WS_VN = 678 * MiB;
constexpr size_t WS_QL = 694 * MiB;
constexpr size_t WS_CHK = 742 * MiB;
constexpr size_t WS_SEL = 838 * MiB;
constexpr size_t WS_NSEL = 854 * MiB;
constexpr size_t WS_ODELTA = 855 * MiB;
constexpr size_t WS_AO = 887 * MiB;
constexpr size_t WS_PRE = 935 * MiB;
constexpr size_t WS_H1 = 999 * MiB;
constexpr size_t WS_H2 = 1063 * MiB;
constexpr size_t WS_H1B = 1127 * MiB;
constexpr size_t WS_PLE = 1159 * MiB;
constexpr size_t WS_ROUTE = 1191 * MiB;
constexpr size_t WS_BIG = 1193 * MiB;
constexpr size_t WS_XS = WS_BIG, WS_HID = WS_BIG + 144 * MiB, WS_YS = WS_BIG + 288 * MiB;
constexpr size_t WS_END = WS_BIG + 512 * MiB;
static_assert((size_t)PMAX * 1024 * 2 <= 144 * MiB && WS_END <= 2048 * MiB, "d_ws map");
constexpr size_t CHK_WP = 0, CHK_QD = 16384, CHK_KDT = 32768, CHK_QK = 49152, CHK_UT = 57344, CHK_GL = 90112, CHK_STRIDE = 92160;
static_assert(CHK_STRIDE * 1024 <= 96 * MiB, "chunk operands");
constexpr int CW_TMO = 0, CW_CODE = 1;
constexpr int CW_BAR = 4096;
constexpr int CW_BAR2 = 8192;
constexpr int CW_CNT = 16384;

constexpr int RING_OFF = 0, RING_BYTES = 131072;
constexpr int WSCR_OFF = 132096, WSCR_BYTES = 1024;
constexpr int MISC_OFF = 140288;
constexpr int LDS_BYTES = 147456;

#define GAS __attribute__((address_space(1)))
#define LAS __attribute__((address_space(3)))
typedef unsigned short bf16;
typedef unsigned v4u __attribute__((ext_vector_type(4)));
typedef unsigned v2u __attribute__((ext_vector_type(2)));
typedef float f32x4 __attribute__((ext_vector_type(4)));
typedef short bf16x8 __attribute__((ext_vector_type(8)));
typedef GAS unsigned gu32;
#define RLX_AGENT __ATOMIC_RELAXED, __HIP_MEMORY_SCOPE_AGENT
__device__ __forceinline__ unsigned f2bf(float f) { unsigned u = __builtin_bit_cast(unsigned, f); return (u + 0x7fffu + ((u >> 16) & 1u)) >> 16; }
__device__ __forceinline__ unsigned pk2(float lo, float hi) { return f2bf(lo) | (f2bf(hi) << 16); }
__device__ __forceinline__ float bflo(unsigned w) { return __uint_as_float(w << 16); }
__device__ __forceinline__ float bfhi(unsigned w) { return __uint_as_float(w & 0xffff0000u); }
__device__ __forceinline__ float bf1(bf16 h) { return __uint_as_float(((unsigned)h) << 16); }
__device__ __forceinline__ float sigm(float x) { return 1.0f / (1.0f + __expf(-x)); }
__device__ __forceinline__ float siluf(float x) { return x / (1.0f + __expf(-x)); }
__device__ __forceinline__ float wave_sum(float v) {
#pragma unroll
    for (int o = 1; o < 64; o <<= 1) v += __shfl_xor(v, o);
    return v;
}
__device__ __forceinline__ float wave_max(float v) {
#pragma unroll
    for (int o = 1; o < 64; o <<= 1) v = fmaxf(v, __shfl_xor(v, o));
    return v;
}
__device__ __forceinline__ int wave_sum_i(int v) {
#pragma unroll
    for (int o = 1; o < 64; o <<= 1) v += __shfl_xor(v, o);
    return v;
}
__device__ __forceinline__ void unpack8(const v4u w, float (&f)[8]) { f[0] = bflo(w.x); f[1] = bfhi(w.x); f[2] = bflo(w.y); f[3] = bfhi(w.y); f[4] = bflo(w.z); f[5] = bfhi(w.z); f[6] = bflo(w.w); f[7] = bfhi(w.w); }
__device__ __forceinline__ v4u pack8f(const float (&f)[8]) { v4u w; w.x = pk2(f[0], f[1]); w.y = pk2(f[2], f[3]); w.z = pk2(f[4], f[5]); w.w = pk2(f[6], f[7]); return w; }

#define XB_TMO      128
#define XB_XCNT(j)  (256  + 64 * (j))
#define XB_XSUB(j)  (1280 + 64 * (j))
#define XB_XGEN(j)  (2304 + 64 * (j))
#define XB_TOP      3328
#define XB_TOPGEN   3392
#define XCD_BAR_WORDS 3456
#define XB_SPIN_CAP (1u << 18)

__device__ __forceinline__ unsigned xb_ld(unsigned* p)              { return __hip_atomic_load(p, __ATOMIC_RELAXED, __HIP_MEMORY_SCOPE_AGENT); }
__device__ __forceinline__ unsigned xb_add(unsigned* p, unsigned v) { return __hip_atomic_fetch_add(p, v, __ATOMIC_RELAXED, __HIP_MEMORY_SCOPE_AGENT); }
__device__ __forceinline__ unsigned xb_xcc_id() { return (unsigned)__builtin_amdgcn_s_getreg((3 << 11) | 20) & 0xFu; }
#define XB_SPIN(cond, bar) do { unsigned _sp = 0; while (cond) { __builtin_amdgcn_s_sleep(1); \
    if ((++_sp & 255u) == 0u) { if (xb_ld(&(bar)[XB_TMO])) break; if (_sp > XB_SPIN_CAP) { atomicAdd(&(bar)[XB_TMO], 1u); break; } } } } while (0)

struct XcdBarrier {
    unsigned* bar; unsigned x;
    unsigned expect;
    volatile LAS unsigned* st;
};

__device__ __forceinline__ XcdBarrier xcd_barrier_post(unsigned* bar, volatile LAS unsigned* st, unsigned expect = 0u) {
    XcdBarrier b; b.bar = bar; b.x = xb_xcc_id(); b.st = st; b.expect = expect ? expect : gridDim.x * gridDim.y * gridDim.z;
    if (threadIdx.x == 0) (void)xb_add(&bar[XB_XCNT(b.x)], 1u);
    return b;
}
__device__ __forceinline__ void xcd_barrier_complete(unsigned* bar, unsigned x, unsigned& nloc, unsigned& nx, const unsigned G) {
    unsigned sum, cnt, mine, sp = 0u;
    for (;;) {
        sum = 0u; cnt = 0u; mine = 0u;
#pragma unroll
        for (unsigned j = 0; j < 16; ++j) { const unsigned c = xb_ld(&bar[XB_XCNT(j)]); sum += c; cnt += (c > 0u) ? 1u : 0u; mine = (j == x) ? c : mine; }
        if (sum == G) break;
        __builtin_amdgcn_s_sleep(1);
        if ((++sp & 255u) == 0u) { if (xb_ld(&bar[XB_TMO])) break; if (sp > XB_SPIN_CAP) { atomicAdd(&bar[XB_TMO], 1u); break; } }
    }
    nloc = mine > 0u ? mine : 1u; nx = cnt > 0u ? cnt : 1u;
}

__device__ __forceinline__ void xcd_barrier(const XcdBarrier& b) {
    asm volatile("s_waitcnt vmcnt(0)" ::: "memory");
    __syncthreads();
    if (threadIdx.x == 0) {
        unsigned* bar = b.bar;
        __builtin_amdgcn_s_waitcnt(0);
        unsigned nloc = b.st[0], nx = b.st[1];
        if (nloc == 0u) { xcd_barrier_complete(bar, b.x, nloc, nx, b.expect); b.st[0] = nloc; b.st[1] = nx; }
        const unsigned old = xb_add(&bar[XB_XSUB(b.x)], 1u);
        const unsigned gen = old / nloc;
        if (old + 1u == (gen + 1u) * nloc) {
            __builtin_amdgcn_fence(__ATOMIC_RELEASE, "agent");
            asm volatile("s_waitcnt vmcnt(0)" ::: "memory");
            const unsigned og = xb_add(&bar[XB_TOP], 1u);
            const unsigned tg = og / nx;
            if (og + 1u == (tg + 1u) * nx) xb_add(&bar[XB_TOPGEN], 1u);
            else XB_SPIN(xb_ld(&bar[XB_TOPGEN]) == tg, bar);
            __builtin_amdgcn_fence(__ATOMIC_ACQUIRE, "agent");
            xb_add(&bar[XB_XGEN(b.x)], 1u);
            asm volatile("s_waitcnt vmcnt(0)" ::: "memory");
        } else {
            XB_SPIN(xb_ld(&bar[XB_XGEN(b.x)]) == gen, bar);
            __builtin_amdgcn_fence(__ATOMIC_ACQUIRE, "agent");
            asm volatile("s_waitcnt vmcnt(0)" ::: "memory");
        }
    }
    __syncthreads();
}

struct Args { const float* in[N_IN]; float* out; unsigned char* ws; int ph_lo, ph_hi, li, pad; };
typedef const __attribute__((address_space(4))) Args* KArgs;
__device__ __forceinline__ KArgs kargs() { auto p = __builtin_amdgcn_kernarg_segment_ptr(); asm volatile("" : "+s"(p)); return (KArgs)p; }
struct Frame {
    LAS unsigned char* lds;
    int tid, lane, wave, G, bid;
    unsigned char* ws;
    gu32* ctl;
};
#define WSP(T, off) ((T*)(F.ws + (off)))

struct MapId { __device__ __forceinline__ int operator()(int n) const { return n; } };
struct MapAdd { int off; __device__ __forceinline__ int operator()(int n) const { return n + off; } };
struct MapAB { __device__ __forceinline__ int operator()(int n) const { return n < 456 ? n : (n < 2504 ? n + 56 : n - 2048); } };
template <class Map> __device__ __forceinline__ void wg_transpose_item(const float* W, int N, int ldw, bf16* WT, int ldt, int koff, Map map, LAS float* scr, int item, int tid) {
    const int nblk = (N + 127) >> 7, kb = item / nblk, nb = item - kb * nblk, k0 = kb * 128, n0 = nb * 128;
#pragma unroll
    for (int it = 0; it < 8; ++it) {
        const int row = it * 16 + (tid >> 5), c4 = (tid & 31) * 4, n = n0 + c4;
        f32x4 v = (f32x4){0.f, 0.f, 0.f, 0.f};
        if (n + 3 < N) v = *(const f32x4*)(W + (size_t)(k0 + row) * ldw + n);
        LAS float* s = scr + row * 129 + c4; s[0] = v[0]; s[1] = v[1]; s[2] = v[2]; s[3] = v[3];
    }
    __syncthreads();
#pragma unroll
    for (int j = 0; j < 4; ++j) {
        const int idx = j * 512 + tid, nl = idx >> 4, ch = idx & 15, n = n0 + nl;
        if (n < N) { const LAS float* s = scr + (ch * 8) * 129 + nl;
            v4u o; o.x = pk2(s[0], s[129]); o.y = pk2(s[2 * 129], s[3 * 129]); o.z = pk2(s[4 * 129], s[5 * 129]); o.w = pk2(s[6 * 129], s[7 * 129]);
            *(v4u*)(WT + (size_t)map(n) * ldt + koff + k0 + ch * 8) = o; }
    }
    __syncthreads();
}
__device__ __forceinline__ void wg_transpose_item_fp8(const float* W, int N, int ldw, unsigned char* WT, int ldt, float mul, LAS float* scr, int item, int tid) {
    const int nblk = (N + 127) >> 7, kb = item / nblk, nb = item - kb * nblk, k0 = kb * 128, n0 = nb * 128;
#pragma unroll
    for (int it = 0; it < 8; ++it) {
        const int row = it * 16 + (tid >> 5), c4 = (tid & 31) * 4;
        const f32x4 v = *(const f32x4*)(W + (size_t)(k0 + row) * ldw + n0 + c4);
        LAS float* s = scr + row * 129 + c4; s[0] = v[0]; s[1] = v[1]; s[2] = v[2]; s[3] = v[3];
    }
    __syncthreads();
#pragma unroll
    for (int j = 0; j < 2; ++j) {
        const int idx = j * 512 + tid, nl = idx >> 3, ch = idx & 7;
        const LAS float* s = scr + (ch * 16) * 129 + nl;
        v4u o;
#pragma unroll
        for (int q = 0; q < 4; ++q) { unsigned w = 0u;
            w = __builtin_amdgcn_cvt_pk_fp8_f32(s[(4 * q) * 129] * mul, s[(4 * q + 1) * 129] * mul, w, false);
            w = __builtin_amdgcn_cvt_pk_fp8_f32(s[(4 * q + 2) * 129] * mul, s[(4 * q + 3) * 129] * mul, w, true);
            o[q] = w; }
        *(v4u*)(WT + (size_t)(n0 + nl) * ldt + k0 + ch * 16) = o;
    }
    __syncthreads();
}
struct MoeItem { const float* W; unsigned char* WT; int N; float mul; int k0, n0; };
__device__ __forceinline__ MoeItem moe_item(KArgs A, unsigned char* ws, int it) {
    MoeItem d; int sub;
    if (it < 64 * 128) { const int m = it >> 7; sub = it & 127; d.W = A->in[I_WGU] + (size_t)m * 1024 * 2048; d.N = 2048; d.WT = ws + WS_W_GU + (size_t)m * 2048 * 1024; d.mul = 64.0f; }
    else { it -= 64 * 128; const int m = it >> 6; sub = it & 63; d.W = A->in[I_WDN] + (size_t)m * 1024 * 1024; d.N = 1024; d.WT = ws + WS_W_DN + (size_t)m * 1024 * 1024; d.mul = 128.0f; }
    const int nblk = d.N >> 7, kb = sub / nblk, nb = sub - kb * nblk; d.k0 = kb * 128; d.n0 = nb * 128; return d;
}
__device__ __forceinline__ void p0_moe_fp8(Frame& F, KArgs A) {
    LAS float* scr = (LAS float*)(F.lds + RING_OFF);
    const int tid = F.tid; constexpr int NIT = 64 * 128 + 64 * 64;
    int it = F.bid; if (it >= NIT) return;
    MoeItem cur = moe_item(A, F.ws, it);
    f32x4 r[8];
#pragma unroll
    for (int x = 0; x < 8; ++x) r[x] = __builtin_nontemporal_load((const f32x4*)(cur.W + (size_t)(cur.k0 + x * 16 + (tid >> 5)) * cur.N + cur.n0 + (tid & 31) * 4));
    for (;;) {
#pragma unroll
        for (int x = 0; x < 8; ++x) { LAS float* sp = scr + (x * 16 + (tid >> 5)) * 129 + (tid & 31) * 4; sp[0] = r[x][0]; sp[1] = r[x][1]; sp[2] = r[x][2]; sp[3] = r[x][3]; }
        __syncthreads();
        const int nx = it + F.G; MoeItem nxt = cur;
        if (nx < NIT) { nxt = moe_item(A, F.ws, nx);
#pragma unroll
            for (int x = 0; x < 8; ++x) r[x] = __builtin_nontemporal_load((const f32x4*)(nxt.W + (size_t)(nxt.k0 + x * 16 + (tid >> 5)) * nxt.N + nxt.n0 + (tid & 31) * 4)); }
#pragma unroll
        for (int j = 0; j < 2; ++j) {
            const int idx = j * 512 + tid, nl = idx >> 3, ch = idx & 7;
            const LAS float* sp = scr + (ch * 16) * 129 + nl;
            v4u o;
#pragma unroll
            for (int q = 0; q < 4; ++q) { unsigned w = 0u;
                w = __builtin_amdgcn_cvt_pk_fp8_f32(sp[(4 * q) * 129] * cur.mul, sp[(4 * q + 1) * 129] * cur.mul, w, false);
                w = __builtin_amdgcn_cvt_pk_fp8_f32(sp[(4 * q + 2) * 129] * cur.mul, sp[(4 * q + 3) * 129] * cur.mul, w, true);
                o[q] = w; }
            *(v4u*)(cur.WT + (size_t)(cur.n0 + nl) * 1024 + cur.k0 + ch * 16) = o;
        }
        __syncthreads();
        if (nx >= NIT) break;
        cur = nxt; it = nx;
    }
}
__device__ __forceinline__ void p0_prologue(Frame& F, KArgs A) {
    LAS float* scr = (LAS float*)(F.lds + RING_OFF);
    const int tid = F.tid;
    constexpr int IT_GU = 128, IT_DN = 64;
    constexpr int N_GU = 64 * IT_GU, N_DN = 64 * IT_DN;
    constexpr int N_INAB = 8 * 20, N_INCD = 8 * 20, N_OUTCD = 64, N_PG = 2 * 64, N_PP = 2 * 2 * 8, N_QIDX = 2 * 4, N_OUTB = 4 * 8;
    constexpr int NITEMS = N_GU + N_DN + N_INAB + N_INCD + N_OUTCD + N_PG + N_PP + N_QIDX + N_OUTB;
    if (kMoeFp8) p0_moe_fp8(F, A);
    for (int it = F.bid + (kMoeFp8 ? N_GU + N_DN : 0); it < NITEMS; it += F.G) {
        int r = it;
        if (r < N_GU) { const int m = r / IT_GU;
            if (kMoeFp8) wg_transpose_item_fp8(A->in[I_WGU] + (size_t)m * 1024 * 2048, 2048, 2048, WSP(unsigned char, WS_W_GU) + (size_t)m * 2048 * 1024, 1024, 64.0f, scr, r % IT_GU, tid);
            else wg_transpose_item(A->in[I_WGU] + (size_t)m * 1024 * 2048, 2048, 2048, WSP(bf16, WS_W_GU) + (size_t)m * 2048 * 1024, 1024, 0, MapId{}, scr, r % IT_GU, tid);
            continue; } r -= N_GU;
        if (r < N_DN) { const int m = r / IT_DN;
            if (kMoeFp8) wg_transpose_item_fp8(A->in[I_WDN] + (size_t)m * 1024 * 1024, 1024, 1024, WSP(unsigned char, WS_W_DN) + (size_t)m * 1024 * 1024, 1024, 128.0f, scr, r % IT_DN, tid);
            else wg_transpose_item(A->in[I_WDN] + (size_t)m * 1024 * 1024, 1024, 1024, WSP(bf16, WS_W_DN) + (size_t)m * 1024 * 1024, 1024, 0, MapId{}, scr, r % IT_DN, tid);
            continue; } r -= N_DN;
        if (r < N_INAB) { wg_transpose_item(A->in[I_AB_WIN], 2512, 2512, WSP(bf16, WS_W_INAB), 1024, 0, MapAB{}, scr, r, tid); continue; } r -= N_INAB;
        if (r < N_INCD) { wg_transpose_item(A->in[I_CD_WIN], 2560, 2560, WSP(bf16, WS_W_INCD), 1024, 0, MapId{}, scr, r, tid); continue; } r -= N_INCD;
        if (r < N_OUTCD) { wg_transpose_item(A->in[I_CD_WOUT], 1024, 1024, WSP(bf16, WS_W_OUTCD), 1024, 0, MapId{}, scr, r, tid); continue; } r -= N_OUTCD;
        if (r < N_PG) { const int l = r / 64; wg_transpose_item(A->in[I_PLE_WG] + (size_t)l * 1024 * 1024, 1024, 1024, WSP(bf16, WS_W_PG) + (size_t)l * 1024 * 1024, 1024, 0, MapId{}, scr, r % 64, tid); continue; } r -= N_PG;
        if (r < N_PP) { const int l = r / 16; wg_transpose_item(A->in[I_PLE_WP] + (size_t)l * 256 * 1024, 1024, 1024, WSP(bf16, WS_W_PP) + (size_t)l * 1024 * 256, 256, 0, MapId{}, scr, r % 16, tid); continue; } r -= N_PP;
        if (r < N_QIDX) { wg_transpose_item(A->in[I_AB_WQIDX], 512, 512, WSP(bf16, WS_W_ABS), 256, 0, MapAdd{1024}, scr, r, tid); continue; } r -= N_QIDX;
        wg_transpose_item(A->in[I_AB_WOUT] + (size_t)512 * 1024, 1024, 1024, WSP(bf16, WS_W_OUTAB), 1536, 1024, MapId{}, scr, r, tid);
    }
    const size_t gt = (size_t)F.bid * NTHREADS + tid, GT = (size_t)F.G * NTHREADS;
    for (size_t i = gt; i < (size_t)48 * 1024 / 8; i += GT) *(v4u*)(WSP(bf16, WS_W_INAB) + (size_t)464 * 1024 + i * 8) = (v4u){0u, 0u, 0u, 0u};
    for (size_t i = gt; i < (size_t)1024 * 256; i += GT) {
        const int n = (int)(i >> 8), c = (int)(i & 255), h = n >> 7, r = n & 127;
        const float* a = A->in[I_AB_WUQ] + (size_t)c * 512 + h * 64; const float* b = A->in[I_AB_WUK] + (size_t)r * 512 + h * 64;
        float s = 0.f;
#pragma unroll 8
        for (int d = 0; d < 64; d += 4) { const f32x4 x = *(const f32x4*)(a + d), y = *(const f32x4*)(b + d); s += x[0] * y[0] + x[1] * y[1] + x[2] * y[2] + x[3] * y[3]; }
        WSP(bf16, WS_W_ABS)[i] = (bf16)f2bf(s * 0.125f);
    }
    for (size_t i = gt; i < (size_t)1024 * 128; i += GT) {
        const int n = (int)(i & 1023), k0 = (int)(i >> 10) * 8, h = k0 >> 7, r0 = k0 & 127;
        const float* bcol = A->in[I_AB_WOUT] + (size_t)(h * 64) * 1024 + n;
        float acc[8];
#pragma unroll
        for (int x = 0; x < 8; ++x) acc[x] = 0.f;
#pragma unroll 2
        for (int v0 = 0; v0 < 64; v0 += 8) {
            float bv[8];
#pragma unroll
            for (int v = 0; v < 8; ++v) bv[v] = bcol[(size_t)(v0 + v) * 1024];
#pragma unroll
            for (int x = 0; x < 8; ++x) { const float* ar = A->in[I_AB_WUV] + (size_t)(r0 + x) * 512 + h * 64 + v0; const f32x4 a0 = *(const f32x4*)ar, a1 = *(const f32x4*)(ar + 4);
                acc[x] += a0[0] * bv[0] + a0[1] * bv[1] + a0[2] * bv[2] + a0[3] * bv[3] + a1[0] * bv[4] + a1[1] * bv[5] + a1[2] * bv[6] + a1[3] * bv[7]; }
        }
        *(v4u*)(WSP(bf16, WS_W_OUTAB) + (size_t)n * 1536 + k0) = pack8f(acc);
    }
#pragma unroll 4
    for (size_t i = gt; i < (size_t)M * D / 8; i += GT) { const f32x4 a = __builtin_nontemporal_load((const f32x4*)(A->in[I_X] + i * 8)), b = __builtin_nontemporal_load((const f32x4*)(A->in[I_X] + i * 8 + 4));
        v4u o; o.x = pk2(a[0], a[1]); o.y = pk2(a[2], a[3]); o.z = pk2(b[0], b[1]); o.w = pk2(b[2], b[3]); *(v4u*)(WSP(bf16, WS_XB) + i * 8) = o; }
#pragma unroll 4
    for (size_t i = gt; i < (size_t)2 * M * 256 / 8; i += GT) { const f32x4 a = __builtin_nontemporal_load((const f32x4*)(A->in[I_P] + i * 8)), b = __builtin_nontemporal_load((const f32x4*)(A->in[I_P] + i * 8 + 4));
        v4u o; o.x = pk2(a[0], a[1]); o.y = pk2(a[2], a[3]); o.z = pk2(b[0], b[1]); o.w = pk2(b[2], b[3]); *(v4u*)(WSP(bf16, WS_PB) + i * 8) = o; }
}

__device__ __forceinline__ void p2_prep(Frame& F, KArgs A) {
    const int lane = F.lane, gw = F.bid * NWAVES + F.wave, NGW = F.G * NWAVES;
    const float* SM = WSP(float, WS_SM); const bf16* QZ = WSP(bf16, WS_QKVZ);
    const f32x4 qg = *(const f32x4*)(A->in[I_AB_QG] + 4 * lane);
    const f32x4 kvg = *(const f32x4*)(A->in[I_AB_KVG] + 4 * (lane & 31));
    const f32x4 kig = *(const f32x4*)(A->in[I_AB_KIG] + 4 * (lane & 15)), kib = *(const f32x4*)(A->in[I_AB_KIB] + 4 * (lane & 15));
    const f32x4 alog = *(const f32x4*)(A->in[I_AB_ALOG]), dtb = *(const f32x4*)(A->in[I_AB_DTB]);
    LAS float* cw = (LAS float*)(F.lds);
    {   f32x4 wv[3]; int t0 = F.tid; asm volatile("" : "+v"(t0));
#pragma unroll
        for (int j = 0; j < 3; ++j) wv[j] = *(const f32x4*)(A->in[I_AB_CONVW] + (size_t)(t0 + NTHREADS * j) * 4);
#pragma unroll
        for (int j = 0; j < 3; ++j) *(LAS f32x4*)(cw + (t0 + NTHREADS * j) * 4) = wv[j];
    }
    __syncthreads();
    for (int row = gw; row < M; row += NGW) {
        const int t = row & (SEQ - 1);
        const f32x4 a = *(const f32x4*)(SM + (size_t)row * 512 + 4 * lane), b = *(const f32x4*)(SM + (size_t)row * 512 + 256 + 4 * lane);
        {
            const float ss = wave_sum(a[0] * a[0] + a[1] * a[1] + a[2] * a[2] + a[3] * a[3]);
            const float r = rsqrtf(ss * (1.0f / 256.0f) + 1e-6f);
            v2u o; o.x = pk2(a[0] * r * qg[0], a[1] * r * qg[1]); o.y = pk2(a[2] * r * qg[2], a[3] * r * qg[3]);
            *(v2u*)(WSP(bf16, WS_CQ) + (size_t)row * 256 + 4 * lane) = o;
        }
        {
            const float ss = wave_sum(lane < 32 ? (b[0] * b[0] + b[1] * b[1] + b[2] * b[2] + b[3] * b[3]) : 0.f);
            const float r = rsqrtf(ss * (1.0f / 128.0f) + 1e-6f);
            if (lane < 32) { v2u o; o.x = pk2(b[0] * r * kvg[0], b[1] * r * kvg[1]); o.y = pk2(b[2] * r * kvg[2], b[3] * r * kvg[3]);
                *(v2u*)(WSP(bf16, WS_CKV) + (size_t)row * 128 + 4 * lane) = o; }
        }
        {
            const bool in = (lane >= 32 && lane < 48);
            const float mean = wave_sum(in ? (b[0] + b[1] + b[2] + b[3]) : 0.f) * (1.0f / 64.0f);
            const f32x4 d = b - mean;
            const float var = wave_sum(in ? (d[0] * d[0] + d[1] * d[1] + d[2] * d[2] + d[3] * d[3]) : 0.f) * (1.0f / 64.0f);
            const float r = rsqrtf(var + 1e-5f);
            if (in) { v2u o; o.x = pk2(d[0] * r * kig[0] + kib[0], d[1] * r * kig[1] + kib[1]); o.y = pk2(d[2] * r * kig[2] + kib[2], d[3] * r * kig[3] + kib[3]);
                *(v2u*)(WSP(bf16, WS_KIDX) + (size_t)row * 64 + 4 * (lane - 32)) = o; }
        }
        if (lane == 48 || lane == 49) *(f32x4*)(WSP(float, WS_WIDX) + (size_t)row * 8 + 4 * (lane - 48)) = b * 0.044194173824159216f;
        if (lane == 50) { f32x4 o; o[0] = sigm(b[0]); o[1] = sigm(b[1]); o[2] = sigm(b[2]); o[3] = sigm(b[3]); *(f32x4*)(WSP(float, WS_BETA) + (size_t)row * 4) = o; }
        if (lane == 51) { f32x4 o;
#pragma unroll
            for (int h = 0; h < 4; ++h) { const float xx = b[h] + dtb[h]; const float sp = xx > 20.f ? xx : log1pf(__expf(xx)); o[h] = -__expf(alog[h]) * sp; }
            *(f32x4*)(WSP(float, WS_GG) + (size_t)row * 4) = o; }
        v4u xr[3][4];
#pragma unroll
        for (int sel = 0; sel < 3; ++sel)
#pragma unroll
            for (int j = 0; j < 4; ++j) { const int back = (t - 3 + j >= 0) ? (3 - j) : 0; xr[sel][j] = *(const v4u*)(QZ + (size_t)(row - back) * 2048 + sel * 512 + 8 * lane); }
#pragma unroll
        for (int sel = 0; sel < 3; ++sel) {
            const int col0 = sel * 512 + 8 * lane;
            float acc[8];
#pragma unroll
            for (int i = 0; i < 8; ++i) acc[i] = 0.f;
#pragma unroll
            for (int j = 0; j < 4; ++j) {
                float xv[8]; unpack8(xr[sel][j], xv);
                const f32x4 w0 = *(const LAS f32x4*)(cw + j * 1536 + col0), w1 = *(const LAS f32x4*)(cw + j * 1536 + col0 + 4);
                const float m = (t - 3 + j >= 0) ? 1.f : 0.f;
#pragma unroll
                for (int i = 0; i < 4; ++i) { acc[i] += w0[i] * m * xv[i]; acc[4 + i] += w1[i] * m * xv[4 + i]; }
            }
            float ss = 0.f;
#pragma unroll
            for (int i = 0; i < 8; ++i) { acc[i] = siluf(acc[i]); ss += acc[i] * acc[i]; }
            if (sel < 2) {
                ss += __shfl_xor(ss, 1); ss += __shfl_xor(ss, 2); ss += __shfl_xor(ss, 4); ss += __shfl_xor(ss, 8);
                const float sc = rsqrtf(ss + 1e-6f) * (sel == 0 ? 0.08838834764831845f : 1.0f);
#pragma unroll
                for (int i = 0; i < 8; ++i) acc[i] *= sc;
            }
            bf16* dst = (sel == 0 ? WSP(bf16, WS_QN) : (sel == 1 ? WSP(bf16, WS_KN) : WSP(bf16, WS_VN))) + (size_t)row * 512 + 8 * lane;
            *(v4u*)dst = pack8f(acc);
        }
    }
}

constexpr int SEQ_WGS = 16;
constexpr int SQ_WP = 0, SQ_QD = 16384, SQ_KDT = 32768, SQ_QK = 49152, SQ_BUF = 57344;
__device__ __forceinline__ bf16x8 packfrag(const f32x4 lo, const f32x4 hi) { v4u w; w.x = pg8::cvt_pk_bf16(lo[0], lo[1]); w.y = pg8::cvt_pk_bf16(lo[2], lo[3]); w.z = pg8::cvt_pk_bf16(hi[0], hi[1]); w.w = pg8::cvt_pk_bf16(hi[2], hi[3]); return __builtin_bit_cast(bf16x8, w); }
__device__ __forceinline__ void seq_load(v4u (&r)[14], const unsigned char* blk, int lt) {
#pragma unroll
    for (int i = 0; i < 14; ++i) r[i] = *(const v4u*)(blk + (size_t)(lt + 256 * i) * 16);
}
__device__ __forceinline__ void seq_write(LAS unsigned char* buf, const v4u (&r)[14], int lt) {
#pragma unroll
    for (int i = 0; i < 14; ++i) {
        const int id = lt + 256 * i; int dst;
        if (id < 2048) { const int rr = (id & 1023) >> 4, ch = id & 15; dst = (id & ~1023) * 16 + rr * 256 + 16 * (ch ^ (rr & 15)); }
        else { const int rr = (id - 2048) >> 3, ch = id & 7; dst = 32768 + rr * 128 + 16 * (ch ^ (rr & 7)); }
        *(LAS v4u*)(buf + dst) = r[i];
    }
}
__device__ __forceinline__ void seq_compute(LAS unsigned char* buf, f32x4 (&Sacc)[8], const f32x4 (&U)[4], const float gl, float* op0, const int fr, const int fq) {
    bf16x8 sf[4];
#pragma unroll
    for (int s = 0; s < 4; ++s) sf[s] = packfrag(Sacc[2 * s], Sacc[2 * s + 1]);
    f32x4 Vn[4], Oa[4];
#pragma unroll
    for (int tc = 0; tc < 4; ++tc) {
        const int rr = 16 * tc + fr; f32x4 av = (f32x4){0.f, 0.f, 0.f, 0.f}, ao = (f32x4){0.f, 0.f, 0.f, 0.f};
#pragma unroll
        for (int s = 0; s < 4; ++s) {
            const int off = rr * 256 + 16 * ((4 * s + fq) ^ (rr & 15));
            const bf16x8 wf = *(const LAS bf16x8*)(buf + SQ_WP + off), qf = *(const LAS bf16x8*)(buf + SQ_QD + off);
            av = __builtin_amdgcn_mfma_f32_16x16x32_bf16(wf, sf[s], av, 0, 0, 0);
            ao = __builtin_amdgcn_mfma_f32_16x16x32_bf16(qf, sf[s], ao, 0, 0, 0);
        }
        Vn[tc] = U[tc] - av; Oa[tc] = ao;
    }
    bf16x8 vf[2];
    vf[0] = packfrag(Vn[0], Vn[1]); vf[1] = packfrag(Vn[2], Vn[3]);
#pragma unroll
    for (int tc = 0; tc < 4; ++tc) {
        const int rr = 16 * tc + fr;
#pragma unroll
        for (int s = 0; s < 2; ++s) {
            const bf16x8 kf = *(const LAS bf16x8*)(buf + SQ_QK + rr * 128 + 16 * ((4 * s + fq) ^ (rr & 7)));
            Oa[tc] = __builtin_amdgcn_mfma_f32_16x16x32_bf16(kf, vf[s], Oa[tc], 0, 0, 0);
        }
        float* op = op0 + (size_t)(16 * tc) * 512;
#pragma unroll
        for (int j = 0; j < 4; ++j) op[(size_t)j * 512] = Oa[tc][j];
    }
#pragma unroll
    for (int T = 0; T < 8; ++T) {
        const int rr = 16 * T + fr; f32x4 a = Sacc[T] * gl;
#pragma unroll
        for (int s = 0; s < 2; ++s) {
            const bf16x8 kf = *(const LAS bf16x8*)(buf + SQ_KDT + rr * 128 + 16 * ((4 * s + fq) ^ (rr & 7)));
            a = __builtin_amdgcn_mfma_f32_16x16x32_bf16(kf, vf[s], a, 0, 0, 0);
        }
        Sacc[T] = a;
    }
}
#define SEQ_BAR() do { asm volatile("s_waitcnt lgkmcnt(0)" ::: "memory"); __builtin_amdgcn_s_barrier(); asm volatile("" ::: "memory"); } while (0)
__device__ __forceinline__ void p4_delta_seq(Frame& F, int sid) {
    const int lane = F.lane, wave = F.wave, tid = F.tid;
    const int bh = sid >> 1, half = sid & 1, b = bh >> 2, h = bh & 3;
    const int fr = lane & 15, fq = lane >> 4;
    const int v0 = half * 64 + (wave & 3) * 16;
    const unsigned char* cbase = F.ws + WS_CHK + (size_t)(bh * 128) * CHK_STRIDE;
    if (wave >= 4) {
        const int lt = tid - 256;
        v4u RA[14], RB[14];
#define SEQ_LD(R, blk) do { const unsigned char* _b = (blk); _Pragma("unroll") for (int _i = 0; _i < 14; ++_i) asm volatile("global_load_dwordx4 %0, %1, off" : "=v"(R[_i]) : "v"(_b + (size_t)(lt + 256 * _i) * 16) : "memory"); } while (0)
#define SEQ_WAIT(younger) do { if (younger) asm volatile("s_waitcnt vmcnt(14)" ::: "memory"); else asm volatile("s_waitcnt vmcnt(0)" ::: "memory"); } while (0)
        SEQ_LD(RA, cbase); SEQ_LD(RB, cbase + CHK_STRIDE); SEQ_WAIT(true); seq_write(F.lds, RA, lt); SEQ_LD(RA, cbase + 2 * CHK_STRIDE);
        SEQ_BAR();
#pragma unroll 1
        for (int n = 0; n < 128; n += 2) {
            if (n + 1 < 128) { SEQ_WAIT(n + 2 < 128); seq_write(F.lds + ((n + 1) & 1) * SQ_BUF, RB, lt); } if (n + 3 < 128) SEQ_LD(RB, cbase + (size_t)(n + 3) * CHK_STRIDE);
            SEQ_BAR();
            if (n + 2 < 128) { SEQ_WAIT(n + 3 < 128); seq_write(F.lds + (n & 1) * SQ_BUF, RA, lt); } if (n + 4 < 128) SEQ_LD(RA, cbase + (size_t)(n + 4) * CHK_STRIDE);
            SEQ_BAR();
        }
        asm volatile("s_waitcnt vmcnt(0)" ::: "memory");
#undef SEQ_LD
#undef SEQ_WAIT
    } else {
        float* OD = WSP(float, WS_ODELTA);
        f32x4 Sacc[8], Ucur[4], Unxt[4]; float glc, gln;
#pragma unroll
        for (int T = 0; T < 8; ++T) Sacc[T] = (f32x4){0.f, 0.f, 0.f, 0.f};
#pragma unroll
        for (int tc = 0; tc < 4; ++tc) { Ucur[tc] = *(const f32x4*)((const float*)(cbase + CHK_UT) + (size_t)(v0 + fr) * 64 + 4 * fq + 16 * tc);
                                          Unxt[tc] = *(const f32x4*)((const float*)(cbase + CHK_STRIDE + CHK_UT) + (size_t)(v0 + fr) * 64 + 4 * fq + 16 * tc); }
        glc = *(const float*)(cbase + CHK_GL); gln = *(const float*)(cbase + CHK_STRIDE + CHK_GL);
        SEQ_BAR();
#pragma unroll 1
        for (int n = 0; n < 128; ++n) {
            seq_compute(F.lds + (n & 1) * SQ_BUF, Sacc, Ucur, glc, OD + (size_t)(b * SEQ + n * 64 + 4 * fq) * 512 + h * 128 + v0 + fr, fr, fq);
#pragma unroll
            for (int tc = 0; tc < 4; ++tc) Ucur[tc] = Unxt[tc];
            glc = gln;
            if (n + 2 < 128) { const unsigned char* nb = cbase + (size_t)(n + 2) * CHK_STRIDE; gln = *(const float*)(nb + CHK_GL);
#pragma unroll
                for (int tc = 0; tc < 4; ++tc) Unxt[tc] = *(const f32x4*)((const float*)(nb + CHK_UT) + (size_t)(v0 + fr) * 64 + 4 * fq + 16 * tc); }
            SEQ_BAR();
        }
    }
}
#undef SEQ_BAR

__device__ __forceinline__ float relu1(float x) { float r; asm("v_max_f32_e32 %0, 0, %1" : "=v"(r) : "v"(x)); return r; }
__device__ __forceinline__ void p4_indexer(Frame& F, int widx, int nw) {
    const int lane = F.lane, fr = lane & 15, fq = lane >> 4;
    const bf16* QL = WSP(bf16, WS_QL); const bf16* KI = WSP(bf16, WS_KIDX); const float* WI = WSP(float, WS_WIDX); float* SC = WSP(float, WS_BIG);
    for (int task = widx; task < 2 * 4352; task += nw) {
        const int b = task / 4352; int tau = task - b * 4352;
        int g = 0; while (16 * (g + 1) * (g + 2) <= tau) ++g;
        tau -= 16 * g * (g + 1);
        const int qt = 32 * g + tau / (g + 1), seg = tau % (g + 1);
        const int row0 = b * SEQ + 16 * qt;
        bf16x8 Qf[8][2];
#pragma unroll
        for (int hh = 0; hh < 8; ++hh)
#pragma unroll
            for (int s = 0; s < 2; ++s) Qf[hh][s] = *(const bf16x8*)(QL + (size_t)(row0 + fr) * 1536 + 1024 + hh * 64 + 32 * s + 8 * fq);
        const f32x4 w0 = *(const f32x4*)(WI + (size_t)(row0 + fr) * 8), w1 = *(const f32x4*)(WI + (size_t)(row0 + fr) * 8 + 4);
        const int kt1 = (32 * seg + 31 < qt) ? 32 * seg + 31 : qt;
        for (int kb8 = 32 * seg; kb8 <= kt1; kb8 += 8) {
            bf16x8 kfr[8][2];
#pragma unroll
            for (int x = 0; x < 8; ++x) { const int kt = (kb8 + x <= kt1) ? kb8 + x : kt1; const bf16* kp = KI + (size_t)(b * SEQ + 16 * kt + fr) * 64 + 8 * fq; kfr[x][0] = *(const bf16x8*)kp; kfr[x][1] = *(const bf16x8*)(kp + 32); }
#pragma unroll
            for (int x = 0; x < 8; ++x) asm volatile("" : "+v"(kfr[x][0]), "+v"(kfr[x][1]));
#pragma unroll
            for (int x = 0; x < 8; ++x) {
                const int kt = kb8 + x;
                if (kt <= kt1) {
                    f32x4 isc = (f32x4){0.f, 0.f, 0.f, 0.f}, c[8];
#pragma unroll
                    for (int hh = 0; hh < 8; ++hh) c[hh] = __builtin_amdgcn_mfma_f32_16x16x32_bf16(kfr[x][0], Qf[hh][0], (f32x4){0.f, 0.f, 0.f, 0.f}, 0, 0, 0);
#pragma unroll
                    for (int hh = 0; hh < 8; ++hh) c[hh] = __builtin_amdgcn_mfma_f32_16x16x32_bf16(kfr[x][1], Qf[hh][1], c[hh], 0, 0, 0);
                    __builtin_amdgcn_sched_barrier(0);
#pragma unroll
                    for (int hh = 0; hh < 8; ++hh) { const float wh = (hh < 4) ? w0[hh & 3] : w1[hh & 3];
#pragma unroll
                        for (int j = 0; j < 4; ++j) isc[j] += relu1(c[hh][j]) * wh; }
                    *(f32x4*)(SC + (size_t)(row0 + fr) * 8192 + 16 * kt + 4 * fq) = isc;
                }
            }
        }
    }
}

__device__ __forceinline__ void mask_ge8(unsigned long long (&m)[8], unsigned x0, unsigned x1, unsigned x2, unsigned x3, unsigned x4, unsigned x5, unsigned x6, unsigned x7, unsigned t) {
    asm("v_cmp_ge_u32_e64 %0, %8, %16\n\tv_cmp_ge_u32_e64 %1, %9, %16\n\tv_cmp_ge_u32_e64 %2, %10, %16\n\tv_cmp_ge_u32_e64 %3, %11, %16\n\t"
        "v_cmp_ge_u32_e64 %4, %12, %16\n\tv_cmp_ge_u32_e64 %5, %13, %16\n\tv_cmp_ge_u32_e64 %6, %14, %16\n\tv_cmp_ge_u32_e64 %7, %15, %16"
        : "=&s"(m[0]), "=&s"(m[1]), "=&s"(m[2]), "=&s"(m[3]), "=&s"(m[4]), "=&s"(m[5]), "=&s"(m[6]), "=&s"(m[7])
        : "v"(x0), "v"(x1), "v"(x2), "v"(x3), "v"(x4), "v"(x5), "v"(x6), "v"(x7), "s"(t));
}
__device__ __forceinline__ unsigned tk_key(float f) { const unsigned b = __float_as_uint(f); return (b & 0x80000000u) ? ~b : (b | 0x80000000u); }
__device__ __forceinline__ void topk_row_slow(const float* sr, const int n, const int lane, LAS int* sel) {
    const int nseg = (n + 63) >> 6;
    unsigned T = 0u;
    for (int bit = 31; bit >= 0; --bit) {
        const unsigned cnd = T | (1u << bit); int c = 0;
        for (int sg = 0; sg < nseg; ++sg) { const int idx = sg * 64 + lane; const unsigned x = (idx < n) ? tk_key(sr[idx < n ? idx : 0]) : 0u; c += __popcll(__ballot(x >= cnd)); }
        if (c >= 256) T = cnd;
    }
    int cgt = 0;
    for (int sg = 0; sg < nseg; ++sg) { const int idx = sg * 64 + lane; const unsigned x = (idx < n) ? tk_key(sr[idx < n ? idx : 0]) : 0u; cgt += __popcll(__ballot(x > T)); }
    const int need_eq = 256 - cgt; int running = 0, eq_taken = 0;
    const unsigned long long lt = (1ull << lane) - 1ull;
    for (int sg = 0; sg < nseg; ++sg) {
        const int idx = sg * 64 + lane; const unsigned x = (idx < n) ? tk_key(sr[idx < n ? idx : 0]) : 0u;
        const bool gt = x > T, eq = x == T;
        const unsigned long long meq = __ballot(eq);
        const bool take = gt || (eq && (eq_taken + __popcll(meq & lt)) < need_eq);
        const unsigned long long mt = __ballot(take);
        if (take) sel[running + __popcll(mt & lt)] = idx;
        running += __popcll(mt); eq_taken += __popcll(meq);
    }
}
constexpr int TK_CAP = 832;
__device__ __forceinline__ int topk_row(Frame& F, const int row, LAS int* sel, LAS unsigned long long* cand) {
    const int lane = F.lane;
    const float* SC = WSP(float, WS_BIG);
    {
        const int pos = row & (SEQ - 1), n = pos + 1;
        if (n <= 256) {
#pragma unroll
            for (int i = 0; i < 4; ++i) { const int j = 64 * i + lane; sel[j] = (j < n) ? j : 0; }
            return n;
        }
        const int nblk = (n + 1023) >> 10;
        const float* sr = SC + (size_t)row * 8192;
        int lane_l = lane; asm volatile("" : "+v"(lane_l));
        unsigned u[128];
#pragma unroll
        for (int i = 0; i < 64; ++i) u[i] = __float_as_uint((sr + (i >> 4) * 1024)[(i & 15) * 64 + lane_l]);
        if (nblk > 4) {
#pragma unroll
            for (int i = 64; i < 128; ++i) u[i] = __float_as_uint((sr + (i >> 4) * 1024)[(i & 15) * 64 + lane_l]);
        } else {
#pragma unroll
            for (int i = 64; i < 128; ++i) u[i] = 0u;
        }
        asm volatile("" ::: "memory");
#pragma unroll
        for (int i = 0; i < 128; ++i) { const int lim = n - i * 64; const unsigned bits = u[i];
            const unsigned x = (bits & 0x80000000u) ? ~bits : (bits | 0x80000000u);
            u[i] = (lane < lim) ? x : 0u; }
        const unsigned long long ltmask_s = (1ull << lane) - 1ull;
        bool done = false;
        {
            int ns = 0;
#pragma unroll
            for (int k = 0; k < 16; ++k) { int v = n - 512 * k; v = v < 0 ? 0 : (v > 64 ? 64 : v); ns += v; }
            const float mean = 256.0f * (float)ns / (float)n;
            const int rs = (int)(mean + 4.0f * sqrtf(mean) + 5.0f);
            unsigned Ts = 0u;
            for (int bit = 31; bit >= 16; --bit) {
                const unsigned cnd = Ts | (1u << bit); unsigned long long m0[8], m1[8];
                mask_ge8(m0, u[0], u[8], u[16], u[24], u[32], u[40], u[48], u[56], cnd); mask_ge8(m1, u[64], u[72], u[80], u[88], u[96], u[104], u[112], u[120], cnd);
                int c = 0;
#pragma unroll
                for (int i = 0; i < 8; ++i) c += __popcll(m0[i]) + __popcll(m1[i]);
                if (c >= rs) Ts = cnd;
            }
            if (Ts == 0u) Ts = 1u;
            int nc = 0;
#pragma unroll
            for (int bk = 0; bk < 8; ++bk) {
                if (bk < nblk) {
#pragma unroll
                    for (int g8 = 0; g8 < 2; ++g8) {
                        unsigned long long mg[8]; const int b0 = bk * 16 + g8 * 8;
                        mask_ge8(mg, u[b0], u[b0 + 1], u[b0 + 2], u[b0 + 3], u[b0 + 4], u[b0 + 5], u[b0 + 6], u[b0 + 7], Ts);
#pragma unroll
                        for (int i = 0; i < 8; ++i) {
                            const unsigned long long mt = mg[i];
                            if (mt != 0ull) {
                                const int off = nc + __popcll(mt & ltmask_s);
                                if (((mt >> lane) & 1ull) && off < TK_CAP) cand[off] = ((unsigned long long)u[b0 + i] << 32) | (unsigned)((b0 + i) * 64 + lane_l);
                                nc += __popcll(mt);
                            }
                        }
                    }
                }
            }
            if (nc >= 256 && nc <= TK_CAP) {
                unsigned ck[16]; int ci[13];
#pragma unroll
                for (int t = 0; t < 13; ++t) { const int j = lane + 64 * t; const unsigned long long e = (j < nc) ? cand[j] : 0ull; ck[t] = (unsigned)(e >> 32); ci[t] = (int)(unsigned)e; }
                ck[13] = 0u; ck[14] = 0u; ck[15] = 0u;
                unsigned T = 0u;
                for (int bit = 31; bit >= 0; --bit) {
                    const unsigned cnd = T | (1u << bit); unsigned long long m0[8], m1[8];
                    mask_ge8(m0, ck[0], ck[1], ck[2], ck[3], ck[4], ck[5], ck[6], ck[7], cnd); mask_ge8(m1, ck[8], ck[9], ck[10], ck[11], ck[12], ck[13], ck[14], ck[15], cnd);
                    int c = 0;
#pragma unroll
                    for (int i = 0; i < 8; ++i) c += __popcll(m0[i]) + __popcll(m1[i]);
                    if (c >= 256) T = cnd;
                }
                unsigned long long g0[8], g1[8], h0[8], h1[8];
                mask_ge8(g0, ck[0], ck[1], ck[2], ck[3], ck[4], ck[5], ck[6], ck[7], T); mask_ge8(g1, ck[8], ck[9], ck[10], ck[11], ck[12], ck[13], ck[14], ck[15], T);
                mask_ge8(h0, ck[0], ck[1], ck[2], ck[3], ck[4], ck[5], ck[6], ck[7], T + 1u); mask_ge8(h1, ck[8], ck[9], ck[10], ck[11], ck[12], ck[13], ck[14], ck[15], T + 1u);
                int cgt = 0;
#pragma unroll
                for (int t = 0; t < 13; ++t) cgt += __popcll(t < 8 ? h0[t & 7] : h1[t & 7]);
                const int need_eq = 256 - cgt;
                int running = 0, eq_taken = 0;
#pragma unroll
                for (int t = 0; t < 13; ++t) {
                    const unsigned long long mge = (t < 8 ? g0[t & 7] : g1[t & 7]), mgt = (t < 8 ? h0[t & 7] : h1[t & 7]);
                    unsigned long long mt = mge; const unsigned long long me = mge & ~mgt;
                    if (me != 0ull) {
                        const int room = need_eq - eq_taken; unsigned long long keep = 0ull, rest = me;
                        for (int k = 0; k < room && rest != 0ull; ++k) { const unsigned long long low = rest & (~rest + 1ull); keep |= low; rest ^= low; }
                        mt = (mge & ~me) | keep; eq_taken += __popcll(me);
                    }
                    if (mt != 0ull) { if ((mt >> lane) & 1ull) sel[running + __popcll(mt & ltmask_s)] = ci[t]; running += __popcll(mt); }
                }
                done = true;
            }
        }
        if (!done) topk_row_slow(sr, n, lane, sel);
    }
    return 256;
}

__device__ __forceinline__ void p6_gdn_out(Frame& F, KArgs A) {
    const int lane = F.lane, gw = F.bid * NWAVES + F.wave, NGW = F.G * NWAVES;
    const f32x4 g0 = *(const f32x4*)(A->in[I_AB_ONG] + 8 * (lane & 15)), g1 = *(const f32x4*)(A->in[I_AB_ONG] + 8 * (lane & 15) + 4);
    for (int row = gw; row < M; row += NGW) {
        const float* op = WSP(float, WS_ODELTA) + (size_t)row * 512 + 8 * lane;
        const f32x4 a = *(const f32x4*)op, b = *(const f32x4*)(op + 4);
        float ss = a[0] * a[0] + a[1] * a[1] + a[2] * a[2] + a[3] * a[3] + b[0] * b[0] + b[1] * b[1] + b[2] * b[2] + b[3] * b[3];
        ss += __shfl_xor(ss, 1); ss += __shfl_xor(ss, 2); ss += __shfl_xor(ss, 4); ss += __shfl_xor(ss, 8);
        const float r = rsqrtf(ss * (1.0f / 128.0f) + 1e-6f);
        float z[8]; unpack8(*(const v4u*)(WSP(bf16, WS_QKVZ) + (size_t)row * 2048 + 1536 + 8 * lane), z);
        float o[8];
#pragma unroll
        for (int i = 0; i < 4; ++i) { o[i] = a[i] * r * g0[i] * siluf(z[i]); o[4 + i] = b[i] * r * g1[i] * siluf(z[4 + i]); }
        *(v4u*)(WSP(bf16, WS_AO) + (size_t)row * 1536 + 1024 + 8 * lane) = pack8f(o);
    }
}

__device__ __forceinline__ void p8_ln_router(Frame& F, KArgs A, int l, float* HOUT, bf16* HB) {
    const int lane = F.lane, tid = F.tid, gw = F.bid * NWAVES + F.wave, NGW = F.G * NWAVES;
    LAS float* wT = (LAS float*)(F.lds);
    LAS float* lg = (LAS float*)(F.lds + WSCR_OFF + F.wave * WSCR_BYTES);
    const float* rw = A->in[I_RW] + (size_t)l * 1024 * 32;
    {
        f32x4 wv[16];
#pragma unroll
        for (int j = 0; j < 16; ++j) wv[j] = *(const f32x4*)(rw + (size_t)(tid + NTHREADS * j) * 4);
#pragma unroll
        for (int j = 0; j < 16; ++j) { const int i4 = tid + NTHREADS * j, k = i4 >> 3, e0 = (i4 & 7) * 4;
            wT[(e0 + 0) * 1028 + k] = wv[j][0]; wT[(e0 + 1) * 1028 + k] = wv[j][1]; wT[(e0 + 2) * 1028 + k] = wv[j][2]; wT[(e0 + 3) * 1028 + k] = wv[j][3]; }
    }
    __syncthreads();
    const float* PRE = WSP(float, WS_PRE);
    const float* lg_g = A->in[I_LNM_G] + (size_t)l * 1024; const float* lg_b = A->in[I_LNM_B] + (size_t)l * 1024;
    const float rb = A->in[I_RB][l * 32 + (lane & 31)];
    int* TOKE = WSP(int, WS_ROUTE); int* TOKPOS = TOKE + M * 4; float* TOKG = (float*)(TOKPOS + M * 4);
    gu32* cnt = F.ctl + CW_CNT + 64 * 32 * l;
    LAS int* lcnt = (LAS int*)(F.lds + MISC_OFF + 512);
    LAS int* lbase = lcnt + 32;
    LAS int* myrt = (LAS int*)(F.lds + WSCR_OFF + F.wave * WSCR_BYTES + 128);
    if (tid < 32) lcnt[tid] = 0;
    __syncthreads();
    int nrow = 0;
    f32x4 lng[4], lnb[4];
#pragma unroll
    for (int j = 0; j < 4; ++j) { lng[j] = *(const f32x4*)(lg_g + 256 * j + 4 * lane); lnb[j] = *(const f32x4*)(lg_b + 256 * j + 4 * lane); }
    for (int row = gw; row < M; row += NGW) {
        f32x4 v[4]; float s = 0.f;
#pragma unroll
        for (int j = 0; j < 4; ++j) { v[j] = *(const f32x4*)(PRE + (size_t)row * 1024 + 256 * j + 4 * lane); s += (v[j][0] + v[j][1]) + (v[j][2] + v[j][3]); }
        const float mean = wave_sum(s) * (1.0f / 1024.0f); float s2 = 0.f;
#pragma unroll
        for (int j = 0; j < 4; ++j) { v[j] = v[j] - mean; s2 += (v[j][0] * v[j][0] + v[j][1] * v[j][1]) + (v[j][2] * v[j][2] + v[j][3] * v[j][3]); }
        const float rstd = rsqrtf(wave_sum(s2) * (1.0f / 1024.0f) + 1e-5f);
#pragma unroll
        for (int j = 0; j < 4; ++j) {
            v[j] = v[j] * rstd * lng[j] + lnb[j];
            *(f32x4*)(HOUT + (size_t)row * 1024 + 256 * j + 4 * lane) = v[j];
            v2u o; o.x = pk2(v[j][0], v[j][1]); o.y = pk2(v[j][2], v[j][3]); *(v2u*)(HB + (size_t)row * 1024 + 256 * j + 4 * lane) = o;
        }
        float part[32];
#pragma unroll
        for (int e = 0; e < 32; ++e) {
            float a = 0.f;
#pragma unroll
            for (int j = 0; j < 4; ++j) { const f32x4 w = *(const LAS f32x4*)(wT + e * 1028 + 256 * j + 4 * lane); a += v[j][0] * w[0] + v[j][1] * w[1] + v[j][2] * w[2] + v[j][3] * w[3]; }
            part[e] = a;
        }
#pragma unroll
        for (int i = 0; i < 16; ++i) { const bool up = (lane & 32) != 0; const float keep = up ? part[i + 16] : part[i], send = up ? part[i] : part[i + 16]; part[i] = keep + __shfl_xor(send, 32); }
#pragma unroll
        for (int i = 0; i < 8; ++i) { const bool up = (lane & 16) != 0; const float keep = up ? part[i + 8] : part[i], send = up ? part[i] : part[i + 8]; part[i] = keep + __shfl_xor(send, 16); }
#pragma unroll
        for (int i = 0; i < 4; ++i) { const bool up = (lane & 8) != 0; const float keep = up ? part[i + 4] : part[i], send = up ? part[i] : part[i + 4]; part[i] = keep + __shfl_xor(send, 8); }
#pragma unroll
        for (int i = 0; i < 2; ++i) { const bool up = (lane & 4) != 0; const float keep = up ? part[i + 2] : part[i], send = up ? part[i] : part[i + 2]; part[i] = keep + __shfl_xor(send, 4); }
        { const bool up = (lane & 2) != 0; const float keep = up ? part[1] : part[0], send = up ? part[0] : part[1]; part[0] = keep + __shfl_xor(send, 2); }
        part[0] += __shfl_xor(part[0], 1);
        const int eidx = ((lane >> 5) & 1) * 16 + ((lane >> 4) & 1) * 8 + ((lane >> 3) & 1) * 4 + ((lane >> 2) & 1) * 2 + ((lane >> 1) & 1);
        if ((lane & 1) == 0) lg[eidx] = part[0];
        float val = (lane < 32) ? lg[lane & 31] + rb : -INFINITY;
        float tl[4]; int te[4];
#pragma unroll
        for (int k = 0; k < 4; ++k) {
            const float mx = wave_max(val);
            const unsigned long long mm = __ballot(val == mx && lane < 32);
            const int idx = __ffsll((long long)mm) - 1;
            tl[k] = mx; te[k] = idx;
            if (lane == idx) val = -INFINITY;
        }
        const float e1 = __expf(tl[1] - tl[0]), e2 = __expf(tl[2] - tl[0]), e3 = __expf(tl[3] - tl[0]);
        const float inv = 1.0f / (1.0f + e1 + e2 + e3);
        if (lane < 4) {
            const int e = lane == 0 ? te[0] : (lane == 1 ? te[1] : (lane == 2 ? te[2] : te[3]));
            const float g = (lane == 0 ? 1.0f : (lane == 1 ? e1 : (lane == 2 ? e2 : e3))) * inv;
            const int lp = __hip_atomic_fetch_add(lcnt + e, 1, __ATOMIC_RELAXED, __HIP_MEMORY_SCOPE_WORKGROUP);
            LAS int* rt = myrt + (nrow * 4 + lane) * 3; rt[0] = e; rt[1] = lp; rt[2] = __float_as_int(g);
        }
        ++nrow;
    }
    __syncthreads();
    if (tid < 32) lbase[tid] = (int)__hip_atomic_fetch_add(cnt + 64 * tid, (unsigned)lcnt[tid], RLX_AGENT);
    __syncthreads();
    if (lane < 4) {
        int j = 0;
        for (int row = gw; row < M; row += NGW, ++j) {
            const LAS int* rt = myrt + (j * 4 + lane) * 3; const int e = rt[0];
            TOKE[(size_t)row * 4 + lane] = e; TOKPOS[(size_t)row * 4 + lane] = lbase[e] + rt[1]; TOKG[(size_t)row * 4 + lane] = __int_as_float(rt[2]);
        }
    }
}

__device__ __forceinline__ void p9_scatter(Frame& F, int l, const bf16* HB, const float* HF) {
    const int lane = F.lane, tid = F.tid, gw = F.bid * NWAVES + F.wave, NGW = F.G * NWAVES;
    LAS int* base = (LAS int*)(F.lds + MISC_OFF + 256);
    int* TOKE = WSP(int, WS_ROUTE); int* TOKPOS = TOKE + M * 4; int* TILE = TOKE + 3 * M * 4;
    if (tid < 32) base[tid] = (int)__hip_atomic_load(F.ctl + CW_CNT + 64 * (32 * l + tid), RLX_AGENT);
    __syncthreads();
    if (tid == 0) {
        int acc = 0;
        for (int e = 0; e < NEXP; ++e) { const int c = base[e]; base[e] = acc; acc += ((c + 255) >> 8) << 8; }
        base[32] = acc >> 8;
    }
    __syncthreads();
    if (F.bid == 0 && tid < 64) {
        const int nT = base[32];
        for (int t = tid; t < NTMAX; t += 64) { int e = 0;
            for (int x = 1; x < NEXP; ++x) if (base[x] <= t * 256) e = x;
            TILE[t] = (t < nT) ? e : 0; }
        if (tid == 0) TILE[NTMAX] = nT;
    }
    bf16* XS = WSP(bf16, WS_XS);
    if (kMoeFp8) {
        unsigned char* XB8 = WSP(unsigned char, WS_XS);
        for (int row = gw; row < M; row += NGW) {
            const float* hp = HF + (size_t)row * 1024 + 16 * lane; v4u o;
#pragma unroll
            for (int q = 0; q < 4; ++q) { const f32x4 v = *(const f32x4*)(hp + 4 * q); unsigned w = 0u; w = __builtin_amdgcn_cvt_pk_fp8_f32(v[0], v[1], w, false); w = __builtin_amdgcn_cvt_pk_fp8_f32(v[2], v[3], w, true); o[q] = w; }
#pragma unroll
            for (int k = 0; k < 4; ++k) { const int slot = base[TOKE[(size_t)row * 4 + k]] + TOKPOS[(size_t)row * 4 + k]; *(v4u*)(XB8 + (size_t)slot * 1024 + 16 * lane) = o; }
        }
        return;
    }
    for (int row = gw; row < M; row += NGW) {
        const v4u a = *(const v4u*)(HB + (size_t)row * 1024 + 8 * lane), b = *(const v4u*)(HB + (size_t)row * 1024 + 512 + 8 * lane);
#pragma unroll
        for (int k = 0; k < 4; ++k) {
            const int slot = base[TOKE[(size_t)row * 4 + k]] + TOKPOS[(size_t)row * 4 + k];
            *(v4u*)(XS + (size_t)slot * 1024 + 8 * lane) = a; *(v4u*)(XS + (size_t)slot * 1024 + 512 + 8 * lane) = b;
        }
    }
}

__device__ __forceinline__ void p12_combine(Frame& F, KArgs A, int l, const float* HIN, float* HOUT, bf16* HB) {
    const int lane = F.lane, tid = F.tid, gw = F.bid * NWAVES + F.wave, NGW = F.G * NWAVES;
    LAS int* base = (LAS int*)(F.lds + MISC_OFF + 256);
    if (tid < 32) base[tid] = (int)__hip_atomic_load(F.ctl + CW_CNT + 64 * (32 * l + tid), RLX_AGENT);
    __syncthreads();
    if (tid == 0) { int acc = 0; for (int e = 0; e < NEXP; ++e) { const int c = base[e]; base[e] = acc; acc += ((c + 255) >> 8) << 8; } }
    __syncthreads();
    const int* TOKE = WSP(int, WS_ROUTE); const int* TOKPOS = TOKE + M * 4; const float* TOKG = (const float*)(TOKPOS + M * 4);
    const bf16* YS = WSP(bf16, WS_YS); const bf16* PLE = WSP(bf16, WS_PLE);
    const float* lg_g = A->in[I_LNF_G] + (size_t)l * 1024; const float* lg_b = A->in[I_LNF_B] + (size_t)l * 1024;
    f32x4 lng[2][2], lnb[2][2];
#pragma unroll
    for (int hf = 0; hf < 2; ++hf) { const int c0 = 512 * hf + 8 * lane; lng[hf][0] = *(const f32x4*)(lg_g + c0); lng[hf][1] = *(const f32x4*)(lg_g + c0 + 4); lnb[hf][0] = *(const f32x4*)(lg_b + c0); lnb[hf][1] = *(const f32x4*)(lg_b + c0 + 4); }
    for (int row = gw; row < M; row += NGW) {
        float x[16];
        {   const f32x4 h0 = *(const f32x4*)(HIN + (size_t)row * 1024 + 8 * lane), h1 = *(const f32x4*)(HIN + (size_t)row * 1024 + 8 * lane + 4);
            const f32x4 h2 = *(const f32x4*)(HIN + (size_t)row * 1024 + 512 + 8 * lane), h3 = *(const f32x4*)(HIN + (size_t)row * 1024 + 512 + 8 * lane + 4);
            float p0[8], p1[8]; unpack8(*(const v4u*)(PLE + (size_t)row * 1024 + 8 * lane), p0); unpack8(*(const v4u*)(PLE + (size_t)row * 1024 + 512 + 8 * lane), p1);
#pragma unroll
            for (int i = 0; i < 4; ++i) { x[i] = ALPHA * h0[i] + p0[i]; x[4 + i] = ALPHA * h1[i] + p0[4 + i]; x[8 + i] = ALPHA * h2[i] + p1[i]; x[12 + i] = ALPHA * h3[i] + p1[4 + i]; }
        }
#pragma unroll
        for (int k = 0; k < 4; ++k) {
            const int slot = base[TOKE[(size_t)row * 4 + k]] + TOKPOS[(size_t)row * 4 + k]; const float g = TOKG[(size_t)row * 4 + k];
            float y0[8], y1[8]; unpack8(*(const v4u*)(YS + (size_t)slot * 1024 + 8 * lane), y0); unpack8(*(const v4u*)(YS + (size_t)slot * 1024 + 512 + 8 * lane), y1);
#pragma unroll
            for (int i = 0; i < 8; ++i) { x[i] += g * y0[i]; x[8 + i] += g * y1[i]; }
        }
        float s = 0.f;
#pragma unroll
        for (int i = 0; i < 16; ++i) s += x[i];
        const float mean = wave_sum(s) * (1.0f / 1024.0f); float s2 = 0.f;
#pragma unroll
        for (int i = 0; i < 16; ++i) { x[i] -= mean; s2 += x[i] * x[i]; }
        const float rstd = rsqrtf(wave_sum(s2) * (1.0f / 1024.0f) + 1e-5f);
#pragma unroll
        for (int hf = 0; hf < 2; ++hf) {
            const int c0 = 512 * hf + 8 * lane;
            const f32x4 g0 = lng[hf][0], g1 = lng[hf][1], b0 = lnb[hf][0], b1 = lnb[hf][1];
            f32x4 o0, o1;
#pragma unroll
            for (int i = 0; i < 4; ++i) { o0[i] = x[8 * hf + i] * rstd * g0[i] + b0[i]; o1[i] = x[8 * hf + 4 + i] * rstd * g1[i] + b1[i]; }
            *(f32x4*)(HOUT + (size_t)row * 1024 + c0) = o0; *(f32x4*)(HOUT + (size_t)row * 1024 + c0 + 4) = o1;
            if (HB) { v4u w; w.x = pk2(o0[0], o0[1]); w.y = pk2(o0[2], o0[3]); w.z = pk2(o1[0], o1[1]); w.w = pk2(o1[2], o1[3]); *(v4u*)(HB + (size_t)row * 1024 + c0) = w; }
        }
    }
}

typedef short v4i16_t __attribute__((ext_vector_type(4)));
__device__ __forceinline__ v4i16_t lds_tr16(LAS unsigned char* p) { return __builtin_amdgcn_ds_read_tr16_b64_v4i16((LAS v4i16_t*)p); }
constexpr int DV_PITCH = 144, DV_BUF = 32 * DV_PITCH;
template <int DL  > __device__ __forceinline__ void dil_branch(const bf16* __restrict__ KV, LAS unsigned char* vbuf, const int s0, const int lane,
                                                                                 const bf16x8 (&qf)[2], f32x4 (&O)[4], float& m_run, float& l_run) {
    constexpr int d = 1 << DL, sigma = 16 >> DL, NS = (129 + 15 * sigma + 31) / 32;
    const int fr = lane & 15, fq = lane >> 4;
    const int c = s0 & (d - 1), n0 = s0 >> DL, kstart = n0 - 128;
    const int dbase = 128 + sigma * fr - 4 * fq;
    const int dmax = n0 + sigma * fr;
#define DIL_POS(n) ({ int _p = c + d * (n); _p = _p < 0 ? 0 : (_p > SEQ - 1 ? SEQ - 1 : _p); _p; })
    bf16x8 kf[2][2]; v4u vr[4];
#pragma unroll
    for (int tl = 0; tl < 2; ++tl) { const bf16* kp = KV + (size_t)DIL_POS(kstart + 16 * tl + fr) * 2560 + 768 + 8 * fq; kf[tl][0] = *(const bf16x8*)kp; kf[tl][1] = *(const bf16x8*)(kp + 32); }
#pragma unroll
    for (int i = 0; i < 4; ++i) vr[i] = *(const v4u*)(KV + (size_t)DIL_POS(kstart + (lane >> 3) + 8 * i) * 2560 + 1536 + 8 * (lane & 7));
#pragma unroll 1
    for (int g = 0; g < NS; ++g) {
        LAS unsigned char* vb = vbuf + (g & 1) * DV_BUF;
#pragma unroll
        for (int i = 0; i < 4; ++i) *(LAS v4u*)(vb + ((lane >> 3) + 8 * i) * DV_PITCH + 16 * (lane & 7)) = vr[i];
        bf16x8 kc[2][2];
#pragma unroll
        for (int tl = 0; tl < 2; ++tl) { kc[tl][0] = kf[tl][0]; kc[tl][1] = kf[tl][1]; }
        if (g + 1 < NS) {
            const int kb = kstart + 32 * (g + 1);
#pragma unroll
            for (int tl = 0; tl < 2; ++tl) { const bf16* kp = KV + (size_t)DIL_POS(kb + 16 * tl + fr) * 2560 + 768 + 8 * fq; kf[tl][0] = *(const bf16x8*)kp; kf[tl][1] = *(const bf16x8*)(kp + 32); }
#pragma unroll
            for (int i = 0; i < 4; ++i) vr[i] = *(const v4u*)(KV + (size_t)DIL_POS(kb + (lane >> 3) + 8 * i) * 2560 + 1536 + 8 * (lane & 7));
        }
        float sv[8];
#pragma unroll
        for (int tl = 0; tl < 2; ++tl) {
            f32x4 cc = __builtin_amdgcn_mfma_f32_16x16x32_bf16(kc[tl][0], qf[0], (f32x4){0.f, 0.f, 0.f, 0.f}, 0, 0, 0);
            cc = __builtin_amdgcn_mfma_f32_16x16x32_bf16(kc[tl][1], qf[1], cc, 0, 0, 0);
#pragma unroll
            for (int j = 0; j < 4; ++j) {
                const int delta = dbase - (32 * g + 16 * tl + j);
                const bool ok = ((unsigned)delta <= 128u) && (delta <= dmax);
                sv[4 * tl + j] = ok ? cc[j] * 0.18033688011112042f : -INFINITY;
            }
        }
        float mx = fmaxf(fmaxf(fmaxf(sv[0], sv[1]), fmaxf(sv[2], sv[3])), fmaxf(fmaxf(sv[4], sv[5]), fmaxf(sv[6], sv[7])));
        mx = fmaxf(mx, __shfl_xor(mx, 16)); mx = fmaxf(mx, __shfl_xor(mx, 32));
        const float m_new = fmaxf(m_run, mx);
        if (!__all(m_new == m_run)) {
            const float alpha = __builtin_amdgcn_exp2f(m_run - m_new);
            l_run *= alpha;
#pragma unroll
            for (int j = 0; j < 4; ++j) { const float aj = __shfl(alpha, 4 * fq + j);
#pragma unroll
                for (int dt = 0; dt < 4; ++dt) O[dt][j] *= aj; }
            m_run = m_new;
        }
        float p[8], ps = 0.f;
#pragma unroll
        for (int e = 0; e < 8; ++e) { p[e] = __builtin_amdgcn_exp2f(sv[e] - m_run); ps += p[e]; }
        l_run += ps;
        v4u pw; pw.x = pg8::cvt_pk_bf16(p[0], p[1]); pw.y = pg8::cvt_pk_bf16(p[2], p[3]); pw.z = pg8::cvt_pk_bf16(p[4], p[5]); pw.w = pg8::cvt_pk_bf16(p[6], p[7]);
        const bf16x8 pf = __builtin_bit_cast(bf16x8, pw);
        LAS unsigned char* tb = vb + (4 * fq + ((lane & 15) >> 2)) * DV_PITCH + 8 * (lane & 3);
#pragma unroll
        for (int dt = 0; dt < 4; ++dt) {
            const v4i16_t lo = lds_tr16(tb + 32 * dt), hi = lds_tr16(tb + 16 * DV_PITCH + 32 * dt);
            bf16x8 vf; vf[0] = lo[0]; vf[1] = lo[1]; vf[2] = lo[2]; vf[3] = lo[3]; vf[4] = hi[0]; vf[5] = hi[1]; vf[6] = hi[2]; vf[7] = hi[3];
            O[dt] = __builtin_amdgcn_mfma_f32_16x16x32_bf16(pf, vf, O[dt], 0, 0, 0);
        }
    }
#undef DIL_POS
}
__device__ __forceinline__ void p14_dilated_mfma(Frame& F) {
    const int lane = F.lane, fr = lane & 15, fq = lane >> 4;
    LAS unsigned char* vbuf = F.lds + F.wave * (2 * DV_BUF);
    const bf16* QK = WSP(bf16, WS_QKVZ); bf16* AO = WSP(bf16, WS_AO);
    for (int u = F.bid; u < 24 * 32 * 2; u += F.G) {
        const int bh = u >> 6, blk = (u >> 1) & 31, o = (u & 1) * 8 + F.wave;
        const int b = bh / 12, hh = bh - b * 12, s0 = 256 * blk + o;
        const bf16* KV = QK + (size_t)b * SEQ * 2560 + hh * 64;
        bf16x8 qf[2];
        { const bf16* qp = KV + (size_t)(s0 + 16 * fr) * 2560 + 8 * fq; qf[0] = *(const bf16x8*)qp; qf[1] = *(const bf16x8*)(qp + 32); }
        f32x4 O[4];
#pragma unroll
        for (int dt = 0; dt < 4; ++dt) O[dt] = (f32x4){0.f, 0.f, 0.f, 0.f};
        float m_run = -1e30f, l_run = 0.f;
        dil_branch<4>(KV, vbuf, s0, lane, qf, O, m_run, l_run);
        dil_branch<2>(KV, vbuf, s0, lane, qf, O, m_run, l_run);
        dil_branch<0>(KV, vbuf, s0, lane, qf, O, m_run, l_run);
        float lt = l_run; lt += __shfl_xor(lt, 16); lt += __shfl_xor(lt, 32);
        const float inv = 1.0f / lt;
#pragma unroll
        for (int j = 0; j < 4; ++j) {
            const float ij = __shfl(inv, 4 * fq + j);
            bf16* op = AO + (size_t)(b * SEQ + s0 + 16 * (4 * fq + j)) * 1024 + hh * 64 + fr;
#pragma unroll
            for (int dt = 0; dt < 4; ++dt) op[16 * dt] = (bf16)f2bf(O[dt][j] * ij);
        }
    }
}
constexpr int SA_PITCH = 272, SA_TILE = 32 * SA_PITCH;
__device__ __forceinline__ void sparse_row(Frame& F, const int row, const int n, const LAS int* sel, LAS unsigned char* tile) {
    const int lane = F.lane, fr = lane & 15, fq = lane >> 4;
    const bf16* QL = WSP(bf16, WS_QL); const bf16* CKV = WSP(bf16, WS_CKV); bf16* AO = WSP(bf16, WS_AO);
    {
        const int b = row >> 13;
        const bf16* kvb = CKV + (size_t)b * SEQ * 128;
        bf16x8 qf[4];
#pragma unroll
        for (int s = 0; s < 4; ++s) { const v4u z = (v4u){0u, 0u, 0u, 0u}; qf[s] = (fr < 8) ? *(const bf16x8*)(QL + (size_t)row * 1536 + fr * 128 + 32 * s + 8 * fq) : __builtin_bit_cast(bf16x8, z); }
        f32x4 O[8];
#pragma unroll
        for (int rt = 0; rt < 8; ++rt) O[rt] = (f32x4){0.f, 0.f, 0.f, 0.f};
        float m_run = -1e30f, l_run = 0.f;
        const int nsteps = (n + 31) >> 5;
        v4u vr[8];
        { const int j = lane & 31; const int kidx = (j < n) ? sel[j] : 0;
#pragma unroll
          for (int i = 0; i < 8; ++i) { const int key = __shfl(kidx, (lane >> 4) + 4 * i); vr[i] = *(const v4u*)(kvb + (size_t)key * 128 + 8 * (lane & 15)); } }
#pragma unroll 1
        for (int g = 0; g < nsteps; ++g) {
#pragma unroll
            for (int i = 0; i < 8; ++i) *(LAS v4u*)(tile + ((lane >> 4) + 4 * i) * SA_PITCH + 16 * (lane & 15)) = vr[i];
            if (g + 1 < nsteps) {
                const int j = 32 * (g + 1) + (lane & 31); const int kidx = (j < n) ? sel[j] : 0;
#pragma unroll
                for (int i = 0; i < 8; ++i) { const int key = __shfl(kidx, (lane >> 4) + 4 * i); vr[i] = *(const v4u*)(kvb + (size_t)key * 128 + 8 * (lane & 15)); }
            }
            float sv[8];
#pragma unroll
            for (int tl = 0; tl < 2; ++tl) {
                f32x4 cc = (f32x4){0.f, 0.f, 0.f, 0.f};
#pragma unroll
                for (int s = 0; s < 4; ++s) { const bf16x8 kf = *(const LAS bf16x8*)(tile + (16 * tl + fr) * SA_PITCH + 64 * s + 16 * fq); cc = __builtin_amdgcn_mfma_f32_16x16x32_bf16(kf, qf[s], cc, 0, 0, 0); }
#pragma unroll
                for (int j = 0; j < 4; ++j) sv[4 * tl + j] = (32 * g + 16 * tl + 4 * fq + j < n) ? cc[j] : -INFINITY;
            }
            float mx = fmaxf(fmaxf(fmaxf(sv[0], sv[1]), fmaxf(sv[2], sv[3])), fmaxf(fmaxf(sv[4], sv[5]), fmaxf(sv[6], sv[7])));
            mx = fmaxf(mx, __shfl_xor(mx, 16)); mx = fmaxf(mx, __shfl_xor(mx, 32));
            const float m_new = fmaxf(m_run, mx);
            if (!__all(m_new == m_run)) {
                const float alpha = __expf(m_run - m_new);
                l_run *= alpha;
#pragma unroll
                for (int j = 0; j < 4; ++j) { const float aj = __shfl(alpha, 4 * fq + j);
#pragma unroll
                    for (int rt = 0; rt < 8; ++rt) O[rt][j] *= aj; }
                m_run = m_new;
            }
            float p[8], ps = 0.f;
#pragma unroll
            for (int e = 0; e < 8; ++e) { p[e] = __expf(sv[e] - m_run); ps += p[e]; }
            l_run += ps;
            v4u pw; pw.x = pg8::cvt_pk_bf16(p[0], p[1]); pw.y = pg8::cvt_pk_bf16(p[2], p[3]); pw.z = pg8::cvt_pk_bf16(p[4], p[5]); pw.w = pg8::cvt_pk_bf16(p[6], p[7]);
            const bf16x8 pf = __builtin_bit_cast(bf16x8, pw);
            LAS unsigned char* tb = tile + (4 * fq + ((lane & 15) >> 2)) * SA_PITCH + 8 * (lane & 3);
#pragma unroll
            for (int rt = 0; rt < 8; ++rt) {
                const v4i16_t lo = lds_tr16(tb + 32 * rt), hi = lds_tr16(tb + 16 * SA_PITCH + 32 * rt);
                bf16x8 vf; vf[0] = lo[0]; vf[1] = lo[1]; vf[2] = lo[2]; vf[3] = lo[3]; vf[4] = hi[0]; vf[5] = hi[1]; vf[6] = hi[2]; vf[7] = hi[3];
                O[rt] = __builtin_amdgcn_mfma_f32_16x16x32_bf16(pf, vf, O[rt], 0, 0, 0);
            }
        }
        float lt = l_run; lt += __shfl_xor(lt, 16); lt += __shfl_xor(lt, 32);
        const float inv = 1.0f / lt;
#pragma unroll
        for (int j = 0; j < 4; ++j) {
            const float ij = __shfl(inv, 4 * fq + j);
            if (fq < 2) { bf16* op = AO + (size_t)row * 1536 + (4 * fq + j) * 128 + fr;
#pragma unroll
                for (int rt = 0; rt < 8; ++rt) op[16 * rt] = (bf16)f2bf(O[rt][j] * ij); }
        }
    }
}
__device__ __forceinline__ void p5_topk_attn(Frame& F, const int gw, const int NGW) {
    LAS int* sel = (LAS int*)(F.lds + F.wave * 16384);
    LAS unsigned char* tile = F.lds + F.wave * 16384 + 1024;
    LAS unsigned long long* cand = (LAS unsigned long long*)(F.lds + F.wave * 16384 + 1024 + SA_TILE);
    static_assert(1024 + SA_TILE + TK_CAP * 8 <= 16384, "per-wave LDS");
    for (int rix = gw; rix < M; rix += NGW) {
        const int row = ((rix & 1) ? (M - 1 - (rix >> 1)) : (rix >> 1));
        const int n = __builtin_amdgcn_readfirstlane(topk_row(F, row, sel, cand));
        sparse_row(F, row, n, sel, tile);
    }
}
constexpr int CP_KV_PITCH = 272;
__device__ __forceinline__ void p3_chunk_prep_mfma(Frame& F, KArgs A) {
    int tid = F.tid; asm volatile("" : "+v"(tid));
    const int lane = tid & 63, wave = __builtin_amdgcn_readfirstlane(tid >> 6), fr = lane & 15, fq = lane >> 4;
    LAS unsigned char* kt = F.lds;
    LAS unsigned char* vt = F.lds + 64 * CP_KV_PITCH;
    LAS float* As = (LAS float*)(F.lds + 2 * 64 * CP_KV_PITCH);
    LAS float* Ts = As + 64 * 65;
    LAS float* gcS = Ts + 64 * 68; LAS float* egS = gcS + 64; LAS float* ekS = egS + 64; LAS float* btS = ekS + 64;
    for (int cidx = F.bid; cidx < 1024; cidx += F.G) {
        const int b = cidx >> 9, h = (cidx >> 7) & 3, n = cidx & 127, row0 = b * SEQ + n * 64;
        unsigned char* blk = F.ws + WS_CHK + (size_t)cidx * CHK_STRIDE;
        const bf16* Qg = WSP(bf16, WS_QN) + (size_t)row0 * 512 + h * 128; const bf16* Kg = WSP(bf16, WS_KN) + (size_t)row0 * 512 + h * 128; const bf16* Vg = WSP(bf16, WS_VN) + (size_t)row0 * 512 + h * 128;
        const int ti = wave >> 1;
        float g_in = 0.f, bt_in = 0.f;
        if (tid < 64) { g_in = WSP(float, WS_GG)[(size_t)(row0 + tid) * 4 + h]; bt_in = WSP(float, WS_BETA)[(size_t)(row0 + tid) * 4 + h]; }
        v4u kc[2], vc[2], qc[2];
#pragma unroll
        for (int i = 0; i < 2; ++i) { const int id = tid + 512 * i, r = id >> 4, c = id & 15; kc[i] = *(const v4u*)(Kg + (size_t)r * 512 + 8 * c); vc[i] = *(const v4u*)(Vg + (size_t)r * 512 + 8 * c); qc[i] = *(const v4u*)(Qg + (size_t)r * 512 + 8 * c); }
        bf16x8 ka[4], qa[4], kbf[2][4];
#pragma unroll
        for (int s = 0; s < 4; ++s) { ka[s] = *(const bf16x8*)(Kg + (size_t)(16 * ti + fr) * 512 + 32 * s + 8 * fq); qa[s] = *(const bf16x8*)(Qg + (size_t)(16 * ti + fr) * 512 + 32 * s + 8 * fq);
            kbf[0][s] = *(const bf16x8*)(Kg + (size_t)(16 * (2 * (wave & 1)) + fr) * 512 + 32 * s + 8 * fq); kbf[1][s] = *(const bf16x8*)(Kg + (size_t)(16 * (2 * (wave & 1) + 1) + fr) * 512 + 32 * s + 8 * fq); }
        if (tid < 64) {
            float gc = g_in;
#pragma unroll
            for (int o = 1; o < 64; o <<= 1) { const float t = __shfl_up(gc, o); if (lane >= o) gc += t; }
            const float g63 = __shfl(gc, 63);
            gcS[tid] = gc; egS[tid] = __expf(gc); ekS[tid] = __expf(g63 - gc); btS[tid] = bt_in;
            if (tid == 0) *(float*)(blk + CHK_GL) = __expf(g63);
        }
#pragma unroll
        for (int i = 0; i < 2; ++i) { const int id = tid + 512 * i, r = id >> 4, c = id & 15; *(LAS v4u*)(kt + r * CP_KV_PITCH + 16 * c) = kc[i]; *(LAS v4u*)(vt + r * CP_KV_PITCH + 16 * c) = vc[i]; }
        __syncthreads();
        {
#pragma unroll
            for (int t2 = 0; t2 < 2; ++t2) {
                const int tj = 2 * (wave & 1) + t2;
                f32x4 ck = (f32x4){0.f, 0.f, 0.f, 0.f}, cq = (f32x4){0.f, 0.f, 0.f, 0.f};
#pragma unroll
                for (int s = 0; s < 4; ++s) { ck = __builtin_amdgcn_mfma_f32_16x16x32_bf16(ka[s], kbf[t2][s], ck, 0, 0, 0); cq = __builtin_amdgcn_mfma_f32_16x16x32_bf16(qa[s], kbf[t2][s], cq, 0, 0, 0); }
                const int j = 16 * tj + fr; const float gcj = gcS[j];
                bf16* QKp = (bf16*)(blk + CHK_QK);
#pragma unroll
                for (int jj = 0; jj < 4; ++jj) { const int i = 16 * ti + 4 * fq + jj; const float dec = __expf(j <= i ? gcS[i] - gcj : 0.f);
                    As[i * 65 + j] = (j < i) ? btS[i] * ck[jj] * dec : 0.f;
                    QKp[i * 64 + 32 * (j >> 5) + 8 * ((j >> 2) & 3) + 4 * ((j >> 4) & 1) + (j & 3)] = (bf16)f2bf((j <= i) ? cq[jj] * dec : 0.f); }
            }
        }
        {
#pragma unroll
            for (int x = 0; x < 2; ++x) { const int id = tid + 512 * x, i = id >> 4, d0 = (id & 15) * 8; const float e = egS[i];
                float f[8]; unpack8(qc[x], f);
                bf16* Qd = (bf16*)(blk + CHK_QD) + i * 128 + 32 * (d0 >> 5) + 4 * ((d0 >> 4) & 1);
                const int q0 = (d0 >> 2) & 3;
                v2u w0, w1; w0.x = pk2(f[0] * e, f[1] * e); w0.y = pk2(f[2] * e, f[3] * e); w1.x = pk2(f[4] * e, f[5] * e); w1.y = pk2(f[6] * e, f[7] * e);
                *(v2u*)(Qd + 8 * q0) = w0; *(v2u*)(Qd + 8 * (q0 + 1)) = w1; }
        }
        {
            const int d = tid >> 2, c0 = (tid & 3) * 16, s = c0 >> 5, a = (c0 >> 4) & 1;
            bf16* Kd = (bf16*)(blk + CHK_KDT) + d * 64;
#pragma unroll
            for (int q = 0; q < 4; ++q) { const int c = c0 + 4 * q; float kv[4];
#pragma unroll
                for (int e = 0; e < 4; ++e) kv[e] = bf1(*(const LAS bf16*)(kt + (c + e) * CP_KV_PITCH + 2 * d)) * ekS[c + e];
                v2u w; w.x = pk2(kv[0], kv[1]); w.y = pk2(kv[2], kv[3]); *(v2u*)(Kd + 32 * s + 8 * q + 4 * a) = w; }
        }
        __syncthreads();
        {
            const int c = tid >> 3, part = tid & 7;
            for (int i = 0; i < 64; ++i) {
                float acc = 0.f;
                for (int j = part; j < i; j += 8) acc += As[i * 65 + j] * Ts[j * 68 + c];
                acc += __shfl_xor(acc, 1); acc += __shfl_xor(acc, 2); acc += __shfl_xor(acc, 4);
                if (part == 0) Ts[i * 68 + c] = ((i == c) ? 1.f : 0.f) - acc;
                __builtin_amdgcn_fence(__ATOMIC_RELEASE, "wavefront"); asm volatile("s_waitcnt lgkmcnt(0)" ::: "memory");
            }
        }
        __syncthreads();
        {
            bf16x8 vf[2], kf[2];
            LAS unsigned char* vb = vt + (8 * fq + ((lane & 15) >> 2)) * CP_KV_PITCH + 32 * wave + 8 * (lane & 3);
            LAS unsigned char* kb = kt + (8 * fq + ((lane & 15) >> 2)) * CP_KV_PITCH + 32 * wave + 8 * (lane & 3);
#pragma unroll
            for (int s = 0; s < 2; ++s) {
                const v4i16_t v0 = lds_tr16(vb + (32 * s) * CP_KV_PITCH), v1 = lds_tr16(vb + (32 * s + 4) * CP_KV_PITCH), k0 = lds_tr16(kb + (32 * s) * CP_KV_PITCH), k1 = lds_tr16(kb + (32 * s + 4) * CP_KV_PITCH);
                vf[s][0] = v0[0]; vf[s][1] = v0[1]; vf[s][2] = v0[2]; vf[s][3] = v0[3]; vf[s][4] = v1[0]; vf[s][5] = v1[1]; vf[s][6] = v1[2]; vf[s][7] = v1[3];
                kf[s][0] = k0[0]; kf[s][1] = k0[1]; kf[s][2] = k0[2]; kf[s][3] = k0[3]; kf[s][4] = k1[0]; kf[s][5] = k1[1]; kf[s][6] = k1[2]; kf[s][7] = k1[3];
            }
            float* UT = (float*)(blk + CHK_UT);
            bf16* Wp = (bf16*)(blk + CHK_WP);
#pragma unroll
            for (int ti = 0; ti < 4; ++ti) {
                f32x4 cu = (f32x4){0.f, 0.f, 0.f, 0.f}, cw = (f32x4){0.f, 0.f, 0.f, 0.f};
#pragma unroll
                for (int s = 0; s < 2; ++s) {
                    const LAS float* tr = Ts + (16 * ti + fr) * 68 + 32 * s + 8 * fq;
                    const f32x4 t0 = *(const LAS f32x4*)tr, t1 = *(const LAS f32x4*)(tr + 4);
                    const f32x4 b0 = *(const LAS f32x4*)(btS + 32 * s + 8 * fq), b1 = *(const LAS f32x4*)(btS + 32 * s + 8 * fq + 4), e0 = *(const LAS f32x4*)(egS + 32 * s + 8 * fq), e1 = *(const LAS f32x4*)(egS + 32 * s + 8 * fq + 4);
                    const f32x4 u0 = t0 * b0, u1 = t1 * b1, w0 = u0 * e0, w1 = u1 * e1;
                    cu = __builtin_amdgcn_mfma_f32_16x16x32_bf16(packfrag(u0, u1), vf[s], cu, 0, 0, 0);
                    cw = __builtin_amdgcn_mfma_f32_16x16x32_bf16(packfrag(w0, w1), kf[s], cw, 0, 0, 0);
                }
                *(f32x4*)(UT + (size_t)(16 * wave + fr) * 64 + 16 * ti + 4 * fq) = cu;
#pragma unroll
                for (int jj = 0; jj < 4; ++jj) Wp[(16 * ti + 4 * fq + jj) * 128 + 32 * (wave >> 1) + 8 * (fr >> 2) + 4 * (wave & 1) + (fr & 3)] = (bf16)f2bf(cw[jj]);
            }
        }
        __syncthreads();
    }
}
__device__ __forceinline__ void p14_pool(Frame& F, KArgs A) {
    const int lane = F.lane, tid = F.tid, gw = F.bid * NWAVES + F.wave, NGW = F.G * NWAVES;
    LAS float* pw = (LAS float*)(F.lds + 16384);
    LAS float* dl = (LAS float*)(F.lds + 16384 + 65536 + F.wave * 1024);
    {   f32x4 pv[8];
#pragma unroll
        for (int j = 0; j < 8; ++j) pv[j] = *(const f32x4*)(A->in[I_CD_POOLW] + (size_t)(tid + NTHREADS * j) * 4);
#pragma unroll
        for (int j = 0; j < 8; ++j) *(LAS f32x4*)(pw + (tid + NTHREADS * j) * 4) = pv[j];
    }
    __syncthreads();
    const bf16* QK = WSP(bf16, WS_QKVZ); bf16* AO = WSP(bf16, WS_AO);
    const int gi = lane >> 4, w = 2 << gi;
    float sc[4];
#pragma unroll
    for (int g = 0; g < 4; ++g) sc[g] = A->in[I_CD_POOLS][g * 64 + lane];
    for (int row = gw; row < M; row += NGW) {
        const int pos = row & (SEQ - 1);
        const int cntw = (pos + 1 < w) ? pos + 1 : w;
        float sum[4] = {0.f, 0.f, 0.f, 0.f}, cur[4] = {0.f, 0.f, 0.f, 0.f};
        v2u xw[16];
#pragma unroll
        for (int j = 0; j < 16; ++j) xw[j] = *(const v2u*)(QK + (size_t)(row - (j <= pos ? j : pos)) * 2560 + 2304 + 4 * lane);
#pragma unroll
        for (int j = 0; j < 16; ++j) {
            const float f0 = bflo(xw[j].x), f1 = bfhi(xw[j].x), f2 = bflo(xw[j].y), f3 = bfhi(xw[j].y);
            if (j < cntw) { sum[0] += f0; sum[1] += f1; sum[2] += f2; sum[3] += f3; }
            if (j == 0) { cur[0] = f0; cur[1] = f1; cur[2] = f2; cur[3] = f3; }
        }
        const float inv = 1.0f / (float)cntw;
#pragma unroll
        for (int i = 0; i < 4; ++i) dl[4 * lane + i] = sum[i] * inv - cur[i];
        float o[4] = {0.f, 0.f, 0.f, 0.f};
        for (int c = 0; c < 64; ++c) {
#pragma unroll
            for (int g = 0; g < 4; ++g) o[g] += dl[g * 64 + c] * pw[(g * 64 + c) * 64 + lane];
        }
#pragma unroll
        for (int g = 0; g < 4; ++g) AO[(size_t)row * 1024 + 768 + g * 64 + lane] = (bf16)f2bf(o[g] * sc[g]);
    }
}


#define IN(k) (lo <= (k) && (k) < hi)
#define SEAM(k) do { if (IN(k) && IN((k) + 1)) xcd_barrier(bar); } while (0)
template <int l> __device__ __forceinline__ void layer_tail(Frame& F, const XcdBarrier& bar, const int lo, const int hi) {
    LAS unsigned char* ring = F.lds + RING_OFF;
    const int bid = F.bid, G = F.G;
        const int pb = 8 * l;

        if (IN(7 + pb)) {
            pg8::Gemm g{WSP(bf16, WS_AO), (l == 0) ? WSP(bf16, WS_W_OUTAB) : WSP(bf16, WS_W_OUTCD), M, 1024, (l == 0) ? 1536 : 1024}; pg8::StaticOrder S; S.init(M, 1024, G, bid);
            pg8::Epi<pg8::StPre> E{{(l == 0) ? kargs()->in[I_X] : WSP(float, WS_H2), WSP(float, WS_PRE), ALPHA}};
            pg8::gemm_phase<pg8::Epi<pg8::StPre>, pg8::StaticOrder, true, true>(ring, g, S, E);
        } SEAM(7 + pb);
        if (IN(8 + pb)) { p8_ln_router(F, kargs(), l, WSP(float, WS_H1), WSP(bf16, WS_H1B)); } SEAM(8 + pb);
        if (IN(9 + pb)) {
            p9_scatter(F, l, WSP(bf16, WS_H1B), WSP(float, WS_H1));
            __syncthreads();
            pg8::Gemm g{WSP(bf16, WS_H1B), WSP(bf16, WS_W_PG) + (size_t)l * 1024 * 1024, M, 1024, 1024}; pg8::StaticOrder S; S.init(M, 1024, G, bid);
            pg8::Epi<pg8::StPleGate> E{{WSP(bf16, WS_PP) + (size_t)l * M * 1024, WSP(bf16, WS_PLE)}};
            pg8::gemm_phase<pg8::Epi<pg8::StPleGate>, pg8::StaticOrder, true, true>(ring, g, S, E);
        } SEAM(9 + pb);
        const int* TILE = WSP(int, WS_ROUTE) + 3 * M * 4;
        if (IN(10 + pb)) {
            const int nT = __builtin_amdgcn_readfirstlane(TILE[NTMAX]);
            constexpr int EB = kMoeFp8 ? 1 : 2;
            pg8::Gemm g{WSP(bf16, WS_XS), (const bf16*)(F.ws + WS_W_GU + (size_t)l * NEXP * 2048 * 1024 * EB), PMAX, 2048, 1024 * EB / 2};
            pg8::MoeOrder S{TILE, nT, 8, G, bid, (long)2048 * 1024 * EB};
            pg8::Epi<pg8::StSwiglu<kMoeFp8>> E{{kargs()->in[I_BGU] + (size_t)l * NEXP * 2048, WSP(bf16, WS_HID)}};
            pg8::gemm_phase<pg8::Epi<pg8::StSwiglu<kMoeFp8>>, pg8::MoeOrder, true, true, kMoeFp8 ? kScaleGU : 0u>(ring, g, S, E);
        } SEAM(10 + pb);
        if (IN(11 + pb)) {
            const int nT = __builtin_amdgcn_readfirstlane(TILE[NTMAX]);
            constexpr int EB = kMoeFp8 ? 1 : 2;
            pg8::Gemm g{WSP(bf16, WS_HID), (const bf16*)(F.ws + WS_W_DN + (size_t)l * NEXP * 1024 * 1024 * EB), PMAX, 1024, 1024 * EB / 2};
            pg8::MoeOrder S{TILE, nT, 4, G, bid, (long)1024 * 1024 * EB};
            pg8::Epi<pg8::StDown> E{{kargs()->in[I_BDN] + (size_t)l * NEXP * 1024, WSP(bf16, WS_YS)}};
            pg8::gemm_phase<pg8::Epi<pg8::StDown>, pg8::MoeOrder, true, true, kMoeFp8 ? kScaleDN : 0u>(ring, g, S, E);
        } SEAM(11 + pb);
        if (IN(12 + pb)) { p12_combine(F, kargs(), l, WSP(float, WS_H1), (l == 0) ? WSP(float, WS_H2) : kargs()->out, (l == 0) ? WSP(bf16, WS_XB) : (bf16*)nullptr); }
}
#undef IN
#undef SEAM
__global__ void __launch_bounds__(NTHREADS, 2) mk_fwd(Args args_by_value) {
    const KArgs KA = kargs();
    extern __shared__ __attribute__((aligned(16))) unsigned char lds[];
    Frame F;
    F.lds = (LAS unsigned char*)lds;
    F.tid = threadIdx.x; F.lane = F.tid & 63; F.wave = __builtin_amdgcn_readfirstlane(F.tid >> 6);
    F.G = gridDim.x; F.bid = blockIdx.x; F.ws = KA->ws; F.ctl = (gu32*)(KA->ws + WS_CTL);
    volatile LAS unsigned* MISC = (volatile LAS unsigned*)(F.lds + MISC_OFF);
    { int t0 = threadIdx.x; asm volatile("" : "+v"(t0)); for (int u = t0; u < (LDS_BYTES - MISC_OFF) / 4; u += NTHREADS) MISC[u] = 0u; }
    __syncthreads();
    const bool use_bar = (N_LAUNCHES != NPHASES);
    XcdBarrier bar; bar.bar = (unsigned*)(F.ctl + CW_BAR) + KA->li * XCD_BAR_WORDS; bar.x = 0; bar.st = nullptr; bar.expect = 0;
    XcdBarrier bar2 = bar;
    if (use_bar && F.bid >= SEQ_WGS && F.G > SEQ_WGS) bar2 = xcd_barrier_post((unsigned*)(F.ctl + CW_BAR2), MISC + 10, (unsigned)(F.G - SEQ_WGS));
    if (use_bar) bar = xcd_barrier_post((unsigned*)(F.ctl + CW_BAR) + KA->li * XCD_BAR_WORDS, MISC + 8);
    const int lo = KA->ph_lo, hi = KA->ph_hi;
#define IN(k) (lo <= (k) && (k) < hi)
#define SEAM(k) do { if (IN(k) && IN((k) + 1)) xcd_barrier(bar); } while (0)
    LAS unsigned char* ring = F.lds + RING_OFF;
    const int bid = F.bid, G = F.G;

    if (IN(0)) { p0_prologue(F, kargs()); } SEAM(0);

            if (IN(1)) {
                { pg8::Gemm g{WSP(bf16, WS_XB), WSP(bf16, WS_W_INAB), M, 2560, 1024}; pg8::StaticOrder S; S.init(M, 2560, G, bid);
                  pg8::Epi<pg8::StInAB> E{{WSP(float, WS_SM), WSP(bf16, WS_QKVZ)}};
                  pg8::gemm_phase<pg8::Epi<pg8::StInAB>, pg8::StaticOrder, true, true>(ring, g, S, E); }
                __syncthreads();
                { pg8::Gemm g{WSP(bf16, WS_PB), WSP(bf16, WS_W_PP), 2 * M, 1024, 256}; pg8::BatchOrder S{4, (2 * M / 256) * 4, G, bid, M / 256, (long)1024 * 256 * 2};
                  pg8::Epi<pg8::StBf16> E{{WSP(bf16, WS_PP), 1024}};
                  pg8::gemm_phase<pg8::Epi<pg8::StBf16>, pg8::BatchOrder, true, true>(ring, g, S, E); }
            } SEAM(1);
            if (IN(2)) { p2_prep(F, kargs()); } SEAM(2);
            if (IN(3)) {
                p3_chunk_prep_mfma(F, kargs());
                __syncthreads();
                { pg8::Gemm g{WSP(bf16, WS_CQ), WSP(bf16, WS_W_ABS), M, 1536, 256}; pg8::StaticOrder S; S.init(M, 1536, G, bid);
                  pg8::Epi<pg8::StBf16> E{{WSP(bf16, WS_QL), 1536}};
                  pg8::gemm_phase<pg8::Epi<pg8::StBf16>, pg8::StaticOrder, true, true>(ring, g, S, E); }
            } SEAM(3);
            if (IN(4)) {
                if (bid < SEQ_WGS && G > SEQ_WGS) p4_delta_seq(F, bid);
                else { p4_indexer(F, (bid - SEQ_WGS) * NWAVES + F.wave, (G - SEQ_WGS) * NWAVES);
                    if (use_bar) { xcd_barrier(bar2);
                        p5_topk_attn(F, (bid - SEQ_WGS) * NWAVES + F.wave, (G - SEQ_WGS) * NWAVES); } }
            } SEAM(4);
            if (IN(5)) { if (!use_bar) p5_topk_attn(F, bid * NWAVES + F.wave, G * NWAVES); p6_gdn_out(F, kargs()); } SEAM(5);
    layer_tail<0>(F, bar, lo, hi);
    SEAM(12);
            if (IN(13)) {
                pg8::Gemm g{WSP(bf16, WS_XB), WSP(bf16, WS_W_INCD), M, 2560, 1024}; pg8::StaticOrder S; S.init(M, 2560, G, bid);
                pg8::Epi<pg8::StBf16> E{{WSP(bf16, WS_QKVZ), 2560}};
                pg8::gemm_phase<pg8::Epi<pg8::StBf16>, pg8::StaticOrder, true, true>(ring, g, S, E);
            } SEAM(13);
            if (IN(14)) { p14_dilated_mfma(F); __syncthreads(); p14_pool(F, kargs()); } SEAM(14);
    layer_tail<1>(F, bar, lo, hi);
#undef IN
#undef SEAM
}

extern "C" void kernel_launch(void* const* d_in, const int* in_sizes, int n_in, void* d_out, int out_size, void* d_ws, size_t ws_size, hipStream_t stream) {
    static int grid = 0;
    if (grid == 0) {
        if (n_in != N_IN || in_sizes[0] != M * D || out_size != M * D || ws_size < WS_END) {
            fprintf(stderr, "kernel_launch: built for %d inputs, x/out of %d floats, >= %zu bytes of workspace; got n_in %d, in0 %d, out %d, ws %zu; nothing launched\n", N_IN, M * D, (size_t)WS_END, n_in, n_in > 0 ? in_sizes[0] : -1, out_size, ws_size);
            grid = -1; return; }
        int dev = 0, cus = 0, per_cu = 0;
        if (hipGetDevice(&dev) != hipSuccess || hipDeviceGetAttribute(&cus, hipDeviceAttributeMultiprocessorCount, dev) != hipSuccess) { fprintf(stderr, "kernel_launch: device query failed\n"); grid = -1; return; }
        if (hipFuncSetAttribute((const void*)mk_fwd, hipFuncAttributeMaxDynamicSharedMemorySize, LDS_BYTES) != hipSuccess) { fprintf(stderr, "kernel_launch: hipFuncSetAttribute failed\n"); grid = -1; return; }
        if (hipOccupancyMaxActiveBlocksPerMultiprocessor(&per_cu, (const void*)mk_fwd, NTHREADS, LDS_BYTES) != hipSuccess || per_cu < 1)
            fprintf(stderr, "kernel_launch: note: occupancy query reports %d workgroups per CU\n", per_cu);
        (void)hipGetLastError();
        grid = cus;
    }
    if (grid < 0) return;
    if (hipMemsetAsync((char*)d_ws + WS_CTL, 0, CTL_ZERO_BYTES, stream) != hipSuccess) { fprintf(stderr, "kernel_launch: memset failed\n"); return; }
    Args a{};
    for (int i = 0; i < N_IN; ++i) a.in[i] = (const float*)d_in[i];
    a.out = (float*)d_out; a.ws = (unsigned char*)d_ws;
    for (int li = 0; li < N_LAUNCHES; ++li) {
        if (N_LAUNCHES == NPHASES) { a.ph_lo = li; a.ph_hi = li + 1; } else { a.ph_lo = (int)((long)li * NPHASES / N_LAUNCHES); a.ph_hi = (int)((long)(li + 1) * NPHASES / N_LAUNCHES); }
        a.li = li;
        hipLaunchKernelGGL(mk_fwd, dim3(grid), dim3(NTHREADS), LDS_BYTES, stream, a);
        const hipError_t le = hipPeekAtLastError();
        if (le != hipSuccess) { fprintf(stderr, "kernel_launch: launch %d failed: %s\n", li, hipGetErrorName(le)); break; }
    }
}
```

```cpp
#include <hip/hip_runtime.h>
#include <cstdio>
#include <cstdint>

namespace pg8 {
#define PG8_LAS __attribute__((address_space(3)))
typedef unsigned short bf16_t;
typedef short bf16x8 __attribute__((ext_vector_type(8)));
typedef float f32x4 __attribute__((ext_vector_type(4)));
typedef unsigned u32x4 __attribute__((ext_vector_type(4)));
constexpr int BM = 256, BK = 64, HALF = 128, HTB = HALF * BK * 2  , STAGE_BYTES = 8 * HTB, NXCD = 8, WGM = 8;

__host__ __device__ __forceinline__ int lds_byte(int r, int c) { const int st = (r >> 4) * 2 + (c >> 5), rr = r & 15, cc = c & 31, ob = rr * 64 + cc * 2; return st * 1024 + (ob ^ (((ob >> 9) & 1) << 5)); }
__host__ __device__ __forceinline__ void stage_rc(int b, int& R, int& C) { const int st = b / 1024, sb = b % 1024, swz = sb ^ (((sb >> 9) & 1) << 5); R = (st >> 1) * 16 + swz / 64; C = (st & 1) * 32 + (swz % 64) / 2; }
__host__ __device__ __forceinline__ int perm32(int rho) { const int n = rho >> 4, i = rho & 15; return 8 * (i >> 2) + 4 * n + (i & 3); }

struct Unit { int pm, pn, e; long bofs; };
struct Gemm { const bf16_t* A; const bf16_t* Bt; int M, N, K; };

struct StaticOrder {
    int nM, nN, nwg, G, c;
    __host__ __device__ void init(int M, int N, int G_, int c_) { nM = M / BM; nN = N / BM; nwg = nM * nN; G = G_; c = c_; }
    __host__ __device__ bool next(int i, Unit& u) const {
        const long L = (long)i * G + c; if (L >= nwg) return false;
        int wgid = (int)L; { const int q = nwg / NXCD, r = nwg % NXCD, xcd = wgid % NXCD, off = wgid / NXCD; wgid = (xcd < r ? xcd * (q + 1) : r * (q + 1) + (xcd - r) * q) + off; }
        const int nig = WGM * nN, gid = wgid / nig, fm = gid * WGM, gsz = (nM - fm) < WGM ? (nM - fm) : WGM;
        u.pm = fm + ((wgid % nig) % gsz); u.pn = (wgid % nig) / gsz; u.e = 0; u.bofs = 0; return true;
    }
    __device__ __forceinline__ void a_ready(const Unit&) const {}
    __device__ __forceinline__ void done(const Unit&) const {}
};
struct MoeOrder {
    const int* tile_e; int nT, nN, G, c; long estride;
    __device__ __forceinline__ bool next(int i, Unit& u) const {
        if (G % (8 * nN) == 0) {
            const int rpx = G / (8 * nN), xcd = c & 7, idx = c >> 3;
            u.pm = (i * 8 + xcd) * rpx + idx % rpx; u.pn = idx / rpx;
            if (u.pm >= nT) return false;
        } else {
            const long L = (long)i * G + c; if (L >= (long)nT * nN) return false;
            u.pm = (int)(L / nN); u.pn = (int)(L % nN);
        }
        const int e = tile_e[u.pm]; u.e = e; u.bofs = (long)e * estride; return true;
    }
    __device__ __forceinline__ void a_ready(const Unit&) const {}
    __device__ __forceinline__ void done(const Unit&) const {}
};

struct BatchOrder {
    int nN, nwg, G, c, tiles_per_batch; long bstride;
    __device__ __forceinline__ bool next(int i, Unit& u) const {
        const long L = (long)i * G + c; if (L >= nwg) return false;
        u.pm = (int)(L / nN); u.pn = (int)(L % nN); const int e = u.pm / tiles_per_batch; u.e = e; u.bofs = (long)e * bstride; return true;
    }
    __device__ __forceinline__ void a_ready(const Unit&) const {}
    __device__ __forceinline__ void done(const Unit&) const {}
};

__device__ __forceinline__ unsigned cvt_pk_bf16(float lo, float hi) { unsigned r; asm volatile("v_cvt_pk_bf16_f32 %0, %1, %2" : "=v"(r) : "v"(lo), "v"(hi)); return r; }
__device__ __forceinline__ u32x4 pack8(const f32x4 v0, const f32x4 v1) { u32x4 w; w.x = cvt_pk_bf16(v0[0], v0[1]); w.y = cvt_pk_bf16(v0[2], v0[3]); w.z = cvt_pk_bf16(v1[0], v1[1]); w.w = cvt_pk_bf16(v1[2], v1[3]); return w; }
__device__ __forceinline__ float bf_lo(unsigned w) { return __uint_as_float(w << 16); }
__device__ __forceinline__ float bf_hi(unsigned w) { return __uint_as_float(w & 0xffff0000u); }
__device__ __forceinline__ float sigmoidf_(float x) { return 1.0f / (1.0f + __expf(-x)); }
typedef unsigned u32x2 __attribute__((ext_vector_type(2)));

template <class T> struct Epi {
    static constexpr bool PERM = true, AFTER_DRAIN = false;
    T t;
    __device__ __forceinline__ void operator()(const f32x4 (&acc)[2][2][4][2], const Unit& u, int wr, int wc, int fr, int fq) const {
        const int row0 = u.pm * BM + wr * 64 + fr, col0 = u.pn * BM + wc * 32 + 8 * fq;
        f32x4 cb[2][2];
#pragma unroll
        for (int bj = 0; bj < 2; ++bj) t.colctx(col0 + bj * HALF, u, cb[bj][0], cb[bj][1]);
        f32x4 rc[2][2], rn[2][2];
#pragma unroll
        for (int bj = 0; bj < 2; ++bj) t.rowctx(row0, col0 + bj * HALF, rc[bj][0], rc[bj][1]);
#pragma unroll
        for (int g = 0; g < 8; ++g) {
            const int ai = g >> 2, m = g & 3, row = row0 + ai * HALF + m * 16;
            if (g < 7) { const int nrow = row0 + ((g + 1) >> 2) * HALF + ((g + 1) & 3) * 16;
#pragma unroll
                for (int bj = 0; bj < 2; ++bj) t.rowctx(nrow, col0 + bj * HALF, rn[bj][0], rn[bj][1]); }
#pragma unroll
            for (int bj = 0; bj < 2; ++bj) t.store(row, col0 + bj * HALF, acc[ai][bj][m][0] + cb[bj][0], acc[ai][bj][m][1] + cb[bj][1], u, rc[bj][0], rc[bj][1]);
            asm volatile("" ::: "memory");
#pragma unroll
            for (int bj = 0; bj < 2; ++bj) { rc[bj][0] = rn[bj][0]; rc[bj][1] = rn[bj][1]; }
        }
    }
};
struct StBf16 { bf16_t* O; int ld;
    __device__ __forceinline__ void rowctx(int, int, f32x4& r0, f32x4& r1) const { r0 = (f32x4){0.f, 0.f, 0.f, 0.f}; r1 = r0; }
    __device__ __forceinline__ void colctx(int, const Unit&, f32x4& c0, f32x4& c1) const { c0 = (f32x4){0.f, 0.f, 0.f, 0.f}; c1 = c0; }
    __device__ __forceinline__ void store(int row, int col, f32x4 v0, f32x4 v1, const Unit&, f32x4, f32x4) const { *(u32x4*)(O + (size_t)row * ld + col) = pack8(v0, v1); } };
struct StInAB { float* SM; bf16_t* Q;
    __device__ __forceinline__ void rowctx(int, int, f32x4& r0, f32x4& r1) const { r0 = (f32x4){0.f, 0.f, 0.f, 0.f}; r1 = r0; }
    __device__ __forceinline__ void colctx(int, const Unit&, f32x4& c0, f32x4& c1) const { c0 = (f32x4){0.f, 0.f, 0.f, 0.f}; c1 = c0; }
    __device__ __forceinline__ void store(int row, int col, f32x4 v0, f32x4 v1, const Unit&, f32x4, f32x4) const {
        if (col < 512) { float* p = SM + (size_t)row * 512 + col; *(f32x4*)p = v0; *(f32x4*)(p + 4) = v1; }
        else *(u32x4*)(Q + (size_t)row * 2048 + (col - 512)) = pack8(v0, v1); } };
struct StPre { const float* base; float* P; float alpha;
    __device__ __forceinline__ void colctx(int, const Unit&, f32x4& c0, f32x4& c1) const { c0 = (f32x4){0.f, 0.f, 0.f, 0.f}; c1 = c0; }
    __device__ __forceinline__ void rowctx(int row, int col, f32x4& r0, f32x4& r1) const { const size_t o = (size_t)row * 1024 + col; r0 = *(const f32x4*)(base + o); r1 = *(const f32x4*)(base + o + 4); }
    __device__ __forceinline__ void store(int row, int col, f32x4 v0, f32x4 v1, const Unit&, f32x4 b0, f32x4 b1) const {
        const size_t o = (size_t)row * 1024 + col;
        *(f32x4*)(P + o) = b0 * alpha + v0; *(f32x4*)(P + o + 4) = b1 * alpha + v1; } };
struct StPleGate { const bf16_t* PP; bf16_t* O;
    __device__ __forceinline__ void colctx(int, const Unit&, f32x4& c0, f32x4& c1) const { c0 = (f32x4){0.f, 0.f, 0.f, 0.f}; c1 = c0; }
    __device__ __forceinline__ void rowctx(int row, int col, f32x4& r0, f32x4& r1) const { r0 = *(const f32x4*)(PP + (size_t)row * 1024 + col); r1 = r0; }
    __device__ __forceinline__ void store(int row, int col, f32x4 v0, f32x4 v1, const Unit&, f32x4 pr, f32x4) const {
        const size_t o = (size_t)row * 1024 + col; const u32x4 p = __builtin_bit_cast(u32x4, pr);
        f32x4 r0, r1;
        r0[0] = sigmoidf_(v0[0]) * bf_lo(p.x); r0[1] = sigmoidf_(v0[1]) * bf_hi(p.x); r0[2] = sigmoidf_(v0[2]) * bf_lo(p.y); r0[3] = sigmoidf_(v0[3]) * bf_hi(p.y);
        r1[0] = sigmoidf_(v1[0]) * bf_lo(p.z); r1[1] = sigmoidf_(v1[1]) * bf_hi(p.z); r1[2] = sigmoidf_(v1[2]) * bf_lo(p.w); r1[3] = sigmoidf_(v1[3]) * bf_hi(p.w);
        *(u32x4*)(O + o) = pack8(r0, r1); } };
template <bool F8> struct StSwiglu { const float* bgu; bf16_t* H;
    __device__ __forceinline__ void rowctx(int, int, f32x4& r0, f32x4& r1) const { r0 = (f32x4){0.f, 0.f, 0.f, 0.f}; r1 = r0; }
    __device__ __forceinline__ float act(float g, float u) const { const float gt = fminf(g, 7.0f), up = fminf(fmaxf(u, -7.0f), 7.0f); return (up + 1.0f) * (gt * sigmoidf_(gt * 1.702f)); }
    __device__ __forceinline__ void colctx(int col, const Unit& u, f32x4& c0, f32x4& c1) const { const float* b = bgu + (size_t)u.e * 2048 + col; c0 = *(const f32x4*)b; c1 = *(const f32x4*)(b + 4); }
    __device__ __forceinline__ void store(int row, int col, f32x4 v0, f32x4 v1, const Unit& u, f32x4, f32x4) const {
        if (F8) { unsigned w = 0u; w = __builtin_amdgcn_cvt_pk_fp8_f32(act(v0[0], v0[1]), act(v0[2], v0[3]), w, false); w = __builtin_amdgcn_cvt_pk_fp8_f32(act(v1[0], v1[1]), act(v1[2], v1[3]), w, true);
            *(unsigned*)((unsigned char*)H + (size_t)row * 1024 + (col >> 1)) = w; }
        else { u32x2 w; w.x = cvt_pk_bf16(act(v0[0], v0[1]), act(v0[2], v0[3])); w.y = cvt_pk_bf16(act(v1[0], v1[1]), act(v1[2], v1[3]));
            *(u32x2*)(H + (size_t)row * 1024 + (col >> 1)) = w; } } };
struct StDown { const float* bd; bf16_t* Y;
    __device__ __forceinline__ void rowctx(int, int, f32x4& r0, f32x4& r1) const { r0 = (f32x4){0.f, 0.f, 0.f, 0.f}; r1 = r0; }
    __device__ __forceinline__ void colctx(int col, const Unit& u, f32x4& c0, f32x4& c1) const { const float* b = bd + (size_t)u.e * 1024 + col; c0 = *(const f32x4*)b; c1 = *(const f32x4*)(b + 4); }
    __device__ __forceinline__ void store(int row, int col, f32x4 v0, f32x4 v1, const Unit& u, f32x4, f32x4) const {
        *(u32x4*)(Y + (size_t)row * 1024 + col) = pack8(v0, v1); } };

typedef int i32x8 __attribute__((ext_vector_type(8)));
typedef int i32x4 __attribute__((ext_vector_type(4)));
template <class Epi, class Sched, bool ALIGN_EPI = false, bool SP2 = false, unsigned FP8W = 0u>
__device__ __forceinline__ void gemm_phase(PG8_LAS unsigned char* lds, const Gemm g, const Sched& S, const Epi& E) {
    int tid = threadIdx.x; asm volatile("" : "+v"(tid));
    const int wid = __builtin_amdgcn_readfirstlane(tid >> 6), lane = tid & 63, wr = wid >> 2, wc = wid & 3, fr = lane & 15, fq = lane >> 4;
    int K = g.K; asm volatile("" : "+s"(K));
    const int nt = K / BK;
    unsigned voffA[2], voffB[2];
#pragma unroll
    for (int i = 0; i < 2; ++i) { int R, C; stage_rc(tid * 16 + i * 8192, R, C); const int Rb = Epi::PERM ? ((R & ~31) + perm32(R & 31)) : R;
        voffA[i] = (unsigned)(R * K + C) * 2u; voffB[i] = (unsigned)(Rb * K + C) * 2u; }
    const size_t kstep = (size_t)(BK * 2);
    const size_t hstep = (size_t)HALF * K * 2;
    const size_t tstep = 2 * hstep;
    const unsigned ldsw = (unsigned)wid * 1024u;
    const int aoff = lds_byte(wr * 64 + fr, fq * 8), boff = lds_byte(wc * 32 + fr, fq * 8);
#define PG8_SA(b, h) (((b) * 2 + (h)) * HTB)
#define PG8_SB(b, h) ((4 + (b) * 2 + (h)) * HTB)
#define PG8_STAGE(bufoff, gbase, voff) do { _Pragma("unroll") for (int _i = 0; _i < 2; ++_i) \
        __builtin_amdgcn_global_load_lds((const unsigned*)((const char*)(gbase) + (voff)[_i]), (PG8_LAS unsigned*)(lds + (bufoff) + ldsw + _i * 8192), 16, 0, 0); } while (0)
#define PG8_CAT(lo, hi) __builtin_shufflevector((lo), (hi), 0, 1, 2, 3, 4, 5, 6, 7)
#define PG8_LDA(dst, b, h) do { if constexpr (FP8W != 0u) { _Pragma("unroll") for (int m = 0; m < 4; ++m) dst##8[m] = PG8_CAT(*(const PG8_LAS i32x4*)(lds + PG8_SA(b, h) + aoff + m * 2048), *(const PG8_LAS i32x4*)(lds + PG8_SA(b, h) + aoff + m * 2048 + 1024)); } \
        else { _Pragma("unroll") for (int m = 0; m < 4; ++m) _Pragma("unroll") for (int k = 0; k < 2; ++k) dst[m][k] = *(const PG8_LAS bf16x8*)(lds + PG8_SA(b, h) + aoff + m * 2048 + k * 1024); } } while (0)
#define PG8_LDB(dst, b, h) do { if constexpr (FP8W != 0u) { _Pragma("unroll") for (int n = 0; n < 2; ++n) dst##8[n] = PG8_CAT(*(const PG8_LAS i32x4*)(lds + PG8_SB(b, h) + boff + n * 2048), *(const PG8_LAS i32x4*)(lds + PG8_SB(b, h) + boff + n * 2048 + 1024)); } \
        else { _Pragma("unroll") for (int n = 0; n < 2; ++n) _Pragma("unroll") for (int k = 0; k < 2; ++k) dst[n][k] = *(const PG8_LAS bf16x8*)(lds + PG8_SB(b, h) + boff + n * 2048 + k * 1024); } } while (0)
#define PG8_MMA(ai, bj, At, Bt) do { __builtin_amdgcn_s_setprio(1); _Pragma("unroll") for (int m = 0; m < 4; ++m) _Pragma("unroll") for (int n = 0; n < 2; ++n) { \
        if constexpr (FP8W != 0u) asm volatile("v_mfma_scale_f32_16x16x128_f8f6f4 %0, %1, %2, %0, %3, %4 op_sel_hi:[0,0,0]" : "+v"(acc[ai][bj][m][n]) : "v"(Bt##8[n]), "v"(At##8[m]), "v"(sc_w), "v"(sc_x));   \
        else { _Pragma("unroll") for (int k = 0; k < 2; ++k) acc[ai][bj][m][n] = __builtin_amdgcn_mfma_f32_16x16x32_bf16(Bt[n][k], At[m][k], acc[ai][bj][m][n], 0, 0, 0); } } __builtin_amdgcn_s_setprio(0); } while (0)
#define PG8_WAIT_V(n) asm volatile("s_waitcnt vmcnt(" #n ")" ::: "memory")
#define PG8_WAIT_L(n) asm volatile("s_waitcnt lgkmcnt(" #n ")" ::: "memory")
#define PG8_BAR __builtin_amdgcn_s_barrier()
#define PG8_SCHED __builtin_amdgcn_sched_barrier(0)
    Unit cur, nxt; int ui = 0;
    if (!S.next(0, cur)) return;
    f32x4 acc[2][2][4][2];
#pragma unroll
    for (int a = 0; a < 2; ++a)
#pragma unroll
        for (int b = 0; b < 2; ++b)
#pragma unroll
            for (int m = 0; m < 4; ++m)
#pragma unroll
                for (int n = 0; n < 2; ++n) acc[a][b][m][n] = (f32x4){0.f, 0.f, 0.f, 0.f};
    bf16x8 At[4][2], B0[2][2], B1[2][2];
    int sc_w = (int)FP8W, sc_x = 0x7f7f7f7f; asm volatile("" : "+v"(sc_w), "+v"(sc_x));
    i32x8 At8[4], B08[2], B18[2];
    const char* cA = (const char*)g.A + (size_t)cur.pm * tstep; const char* cB = (const char*)g.Bt + (size_t)cur.pn * tstep + cur.bofs;
    S.a_ready(cur);
    if constexpr (SP2) {
        PG8_STAGE(PG8_SB(0, 0), cB, voffB); PG8_STAGE(PG8_SB(0, 1), cB + hstep, voffB); PG8_STAGE(PG8_SA(0, 0), cA, voffA); PG8_STAGE(PG8_SA(0, 1), cA + hstep, voffA);
        if (wr == 1) PG8_BAR;
        PG8_WAIT_V(2); PG8_BAR;
        PG8_STAGE(PG8_SB(1, 0), cB + kstep, voffB); PG8_STAGE(PG8_SA(1, 0), cA + kstep, voffA); PG8_STAGE(PG8_SB(1, 1), cB + hstep + kstep, voffB);
        PG8_WAIT_V(6); PG8_BAR;
    } else {
        PG8_STAGE(PG8_SB(0, 0), cB, voffB); PG8_STAGE(PG8_SA(0, 0), cA, voffA); PG8_STAGE(PG8_SB(0, 1), cB + hstep, voffB); PG8_STAGE(PG8_SA(0, 1), cA + hstep, voffA);
        if (wr == 1) PG8_BAR;
        PG8_WAIT_V(4); PG8_BAR;
        PG8_STAGE(PG8_SB(1, 0), cB + kstep, voffB); PG8_STAGE(PG8_SA(1, 0), cA + kstep, voffA); PG8_STAGE(PG8_SB(1, 1), cB + hstep + kstep, voffB);
        PG8_WAIT_V(6); PG8_BAR;
    }
    for (;;) {
        const bool has_next = S.next(ui + 1, nxt);
        const char* nA = has_next ? (const char*)g.A + (size_t)nxt.pm * tstep : cA; const char* nB = has_next ? (const char*)g.Bt + (size_t)nxt.pn * tstep + nxt.bofs : cB;
        for (int t = 0; t < nt; t += 2) {
            const bool last = (t == nt - 2);
            const char* a1 = cA + (size_t)(t + 1) * kstep;
            const char* a2 = last ? nA : cA + (size_t)(t + 2) * kstep; const char* b2 = last ? nB : cB + (size_t)(t + 2) * kstep;
            const char* a3 = a2 + kstep; const char* b3 = b2 + kstep;
            if (last && has_next) S.a_ready(nxt);
            if constexpr (SP2) {
            PG8_LDB(B0, 0, 0); PG8_LDB(B1, 0, 1); PG8_SCHED; PG8_LDA(At, 0, 0); PG8_STAGE(PG8_SA(1, 1), a1 + hstep, voffA);
            PG8_WAIT_V(8); PG8_WAIT_L(0); PG8_BAR; PG8_MMA(0, 0, At, B0); PG8_MMA(0, 1, At, B1); PG8_BAR; PG8_SCHED;
            PG8_LDA(At, 0, 1); PG8_STAGE(PG8_SB(0, 0), b2, voffB); PG8_STAGE(PG8_SB(0, 1), b2 + hstep, voffB); PG8_STAGE(PG8_SA(0, 0), a2, voffA);
            PG8_WAIT_V(8); PG8_WAIT_L(0); PG8_BAR; PG8_MMA(1, 0, At, B0); PG8_MMA(1, 1, At, B1); PG8_BAR; PG8_SCHED;
            PG8_LDB(B0, 1, 0); PG8_LDB(B1, 1, 1); PG8_SCHED; PG8_LDA(At, 1, 0); PG8_STAGE(PG8_SA(0, 1), a2 + hstep, voffA);
            PG8_WAIT_V(8); PG8_WAIT_L(0); PG8_BAR; PG8_MMA(0, 0, At, B0); PG8_MMA(0, 1, At, B1); PG8_BAR; PG8_SCHED;
            PG8_LDA(At, 1, 1); PG8_STAGE(PG8_SB(1, 0), b3, voffB); PG8_STAGE(PG8_SB(1, 1), b3 + hstep, voffB); PG8_STAGE(PG8_SA(1, 0), a3, voffA);
            PG8_WAIT_V(8); PG8_WAIT_L(0); PG8_BAR; PG8_MMA(1, 0, At, B0); PG8_MMA(1, 1, At, B1); PG8_BAR; PG8_SCHED;
            } else {
            PG8_LDB(B0, 0, 0); PG8_SCHED; PG8_LDA(At, 0, 0); PG8_STAGE(PG8_SA(1, 1), a1 + hstep, voffA);
            PG8_WAIT_L(8); PG8_BAR; PG8_WAIT_L(0); PG8_MMA(0, 0, At, B0); PG8_BAR; PG8_SCHED;
            PG8_LDB(B1, 0, 1); PG8_STAGE(PG8_SB(0, 0), b2, voffB);
            PG8_BAR; PG8_WAIT_L(0); PG8_MMA(0, 1, At, B1); PG8_BAR;
            PG8_LDA(At, 0, 1); PG8_STAGE(PG8_SA(0, 0), a2, voffA);
            PG8_BAR; PG8_WAIT_L(0); PG8_MMA(1, 0, At, B0); PG8_BAR; PG8_SCHED;
            PG8_STAGE(PG8_SB(0, 1), b2 + hstep, voffB);
            PG8_WAIT_V(6); PG8_BAR; PG8_MMA(1, 1, At, B1); PG8_BAR;
            PG8_LDB(B0, 1, 0); PG8_SCHED; PG8_LDA(At, 1, 0); PG8_STAGE(PG8_SA(0, 1), a2 + hstep, voffA);
            PG8_WAIT_L(8); PG8_BAR; PG8_WAIT_L(0); PG8_MMA(0, 0, At, B0); PG8_BAR; PG8_SCHED;
            PG8_LDB(B1, 1, 1); PG8_STAGE(PG8_SB(1, 0), b3, voffB);
            PG8_BAR; PG8_WAIT_L(0); PG8_MMA(0, 1, At, B1); PG8_BAR;
            PG8_LDA(At, 1, 1); PG8_STAGE(PG8_SA(1, 0), a3, voffA);
            PG8_BAR; PG8_WAIT_L(0); PG8_MMA(1, 0, At, B0); PG8_BAR; PG8_SCHED;
            PG8_STAGE(PG8_SB(1, 1), b3 + hstep, voffB);
            PG8_WAIT_V(6); PG8_BAR; PG8_MMA(1, 1, At, B1); PG8_BAR;
            }
        }
        if constexpr (FP8W != 0u) asm volatile("s_nop 15\n\ts_nop 15" ::: "memory");
        if constexpr (ALIGN_EPI) { if (wr == 0) PG8_BAR; }
        if constexpr (!Epi::AFTER_DRAIN) { E(acc, cur, wr, wc, fr, fq); S.done(cur); }
        if (!has_next) break;
#pragma unroll
        for (int a = 0; a < 2; ++a)
#pragma unroll
            for (int b = 0; b < 2; ++b)
#pragma unroll
                for (int m = 0; m < 4; ++m)
#pragma unroll
                    for (int n = 0; n < 2; ++n) acc[a][b][m][n] = (f32x4){0.f, 0.f, 0.f, 0.f};
        cur = nxt; cA = nA; cB = nB; ++ui;
        if constexpr (ALIGN_EPI) { if (wr == 1) PG8_BAR; }
    }
    PG8_WAIT_V(0);
    if constexpr (!ALIGN_EPI) { if (wr == 0) PG8_BAR; }
    PG8_BAR;
    if constexpr (Epi::AFTER_DRAIN) { E.fused(acc, cur, wr, wc, fr, fq, lds, wid, lane); S.done(cur); }
#undef PG8_SA
#undef PG8_SB
#undef PG8_STAGE
#undef PG8_LDA
#undef PG8_CAT
#undef PG8_LDB
#undef PG8_MMA
#undef PG8_WAIT_V
#undef PG8_WAIT_L
#undef PG8_BAR
#undef PG8_SCHED
}
}

constexpr int NWAVES = 8, NTHREADS = 512;
constexpr int BATCH = 2, SEQ = 8192, M = BATCH * SEQ, D = 1024;
constexpr int NEXP = 32, DEXP = 1024;
constexpr int PMAX = M * 4 + NEXP * 256, NTMAX = PMAX / 256;
constexpr float ALPHA = 1.41421356237f;
constexpr int NPHASES = 21;
#ifndef MOE_FP8
#define MOE_FP8 1
#endif
constexpr bool kMoeFp8 = (MOE_FP8 != 0);
constexpr unsigned kScaleGU = 0x79797979u, kScaleDN = 0x78787878u;
#ifndef MK_N_LAUNCHES
#define MK_N_LAUNCHES 1
#endif
constexpr int N_LAUNCHES = MK_N_LAUNCHES;

enum { I_X = 0, I_P, I_AB_WIN, I_AB_QG, I_AB_KVG, I_AB_WUQ, I_AB_WUK, I_AB_WUV, I_AB_WQIDX, I_AB_KIG, I_AB_KIB, I_AB_CONVW, I_AB_ALOG, I_AB_DTB, I_AB_ONG, I_AB_WOUT,
       I_CD_WIN, I_CD_POOLW, I_CD_POOLS, I_CD_WOUT, I_LNM_G, I_LNM_B, I_RW, I_RB, I_WGU, I_BGU, I_WDN, I_BDN, I_PLE_WP, I_PLE_WG, I_LNF_G, I_LNF_B, N_IN };

constexpr size_t MiB = 1u << 20;
constexpr size_t WS_CTL = 0, CTL_ZERO_BYTES = 1 * MiB;
constexpr size_t WS_W_INAB = 1 * MiB;
constexpr size_t WS_W_ABS = 6 * MiB;
constexpr size_t WS_W_OUTAB = 7 * MiB;
constexpr size_t WS_W_INCD = 10 * MiB;
constexpr size_t WS_W_OUTCD = 15 * MiB;
constexpr size_t WS_W_PG = 17 * MiB;
constexpr size_t WS_W_PP = 21 * MiB;
constexpr size_t WS_W_GU = 22 * MiB;
constexpr size_t WS_W_DN = 278 * MiB;
constexpr size_t WS_XB = 406 * MiB;
constexpr size_t WS_PB = 438 * MiB;
constexpr size_t WS_PP = 454 * MiB;
constexpr size_t WS_SM = 518 * MiB;
constexpr size_t WS_QKVZ = 550 * MiB;
constexpr size_t WS_CQ = 630 * MiB;
constexpr size_t WS_CKV = 638 * MiB;
constexpr size_t WS_KIDX = 642 * MiB;
constexpr size_t WS_WIDX = 644 * MiB;
constexpr size_t WS_BETA = 645 * MiB;
constexpr size_t WS_GG = WS_BETA + 512 * 1024;
constexpr size_t WS_QN = 646 * MiB, WS_KN = 662 * MiB, WS_VN = 678 * MiB;
constexpr size_t WS_QL = 694 * MiB;
constexpr size_t WS_CHK = 742 * MiB;
constexpr size_t WS_SEL = 838 * MiB;
constexpr size_t WS_NSEL = 854 * MiB;
constexpr size_t WS_ODELTA = 855 * MiB;
constexpr size_t WS_AO = 887 * MiB;
constexpr size_t WS_PRE = 935 * MiB;
constexpr size_t WS_H1 = 999 * MiB;
constexpr size_t WS_H2 = 1063 * MiB;
constexpr size_t WS_H1B = 1127 * MiB;
constexpr size_t WS_PLE = 1159 * MiB;
constexpr size_t WS_ROUTE = 1191 * MiB;
constexpr size_t WS_BIG = 1193 * MiB;
constexpr size_t WS_XS = WS_BIG, WS_HID = WS_BIG + 144 * MiB, WS_YS = WS_BIG + 288 * MiB;
constexpr size_t WS_END = WS_BIG + 512 * MiB;
static_assert((size_t)PMAX * 1024 * 2 <= 144 * MiB && WS_END <= 2048 * MiB, "d_ws map");
constexpr size_t CHK_WP = 0, CHK_QD = 16384, CHK_KDT = 32768, CHK_QK = 49152, CHK_UT = 57344, CHK_GL = 90112, CHK_STRIDE = 92160;
static_assert(CHK_STRIDE * 1024 <= 96 * MiB, "chunk operands");
constexpr int CW_TMO = 0, CW_CODE = 1;
constexpr int CW_BAR = 4096;
constexpr int CW_BAR2 = 8192;
constexpr int CW_CNT = 16384;

constexpr int RING_OFF = 0, RING_BYTES = 131072;
constexpr int WSCR_OFF = 132096, WSCR_BYTES = 1024;
constexpr int MISC_OFF = 140288;
constexpr int LDS_BYTES = 147456;

#define GAS __attribute__((address_space(1)))
#define LAS __attribute__((address_space(3)))
typedef unsigned short bf16;
typedef unsigned v4u __attribute__((ext_vector_type(4)));
typedef unsigned v2u __attribute__((ext_vector_type(2)));
typedef float f32x4 __attribute__((ext_vector_type(4)));
typedef short bf16x8 __attribute__((ext_vector_type(8)));
typedef GAS unsigned gu32;
#define RLX_AGENT __ATOMIC_RELAXED, __HIP_MEMORY_SCOPE_AGENT
__device__ __forceinline__ unsigned f2bf(float f) { unsigned u = __builtin_bit_cast(unsigned, f); return (u + 0x7fffu + ((u >> 16) & 1u)) >> 16; }
__device__ __forceinline__ unsigned pk2(float lo, float hi) { return f2bf(lo) | (f2bf(hi) << 16); }
__device__ __forceinline__ float bflo(unsigned w) { return __uint_as_float(w << 16); }
__device__ __forceinline__ float bfhi(unsigned w) { return __uint_as_float(w & 0xffff0000u); }
__device__ __forceinline__ float bf1(bf16 h) { return __uint_as_float(((unsigned)h) << 16); }
__device__ __forceinline__ float sigm(float x) { return 1.0f / (1.0f + __expf(-x)); }
__device__ __forceinline__ float siluf(float x) { return x / (1.0f + __expf(-x)); }
__device__ __forceinline__ float wave_sum(float v) {
#pragma unroll
    for (int o = 1; o < 64; o <<= 1) v += __shfl_xor(v, o);
    return v;
}
__device__ __forceinline__ float wave_max(float v) {
#pragma unroll
    for (int o = 1; o < 64; o <<= 1) v = fmaxf(v, __shfl_xor(v, o));
    return v;
}
__device__ __forceinline__ int wave_sum_i(int v) {
#pragma unroll
    for (int o = 1; o < 64; o <<= 1) v += __shfl_xor(v, o);
    return v;
}
__device__ __forceinline__ void unpack8(const v4u w, float (&f)[8]) { f[0] = bflo(w.x); f[1] = bfhi(w.x); f[2] = bflo(w.y); f[3] = bfhi(w.y); f[4] = bflo(w.z); f[5] = bfhi(w.z); f[6] = bflo(w.w); f[7] = bfhi(w.w); }
__device__ __forceinline__ v4u pack8f(const float (&f)[8]) { v4u w; w.x = pk2(f[0], f[1]); w.y = pk2(f[2], f[3]); w.z = pk2(f[4], f[5]); w.w = pk2(f[6], f[7]); return w; }

#define XB_TMO      128
#define XB_XCNT(j)  (256  + 64 * (j))
#define XB_XSUB(j)  (1280 + 64 * (j))
#define XB_XGEN(j)  (2304 + 64 * (j))
#define XB_TOP      3328
#define XB_TOPGEN   3392
#define XCD_BAR_WORDS 3456
#define XB_SPIN_CAP (1u << 18)

__device__ __forceinline__ unsigned xb_ld(unsigned* p)              { return __hip_atomic_load(p, __ATOMIC_RELAXED, __HIP_MEMORY_SCOPE_AGENT); }
__device__ __forceinline__ unsigned xb_add(unsigned* p, unsigned v) { return __hip_atomic_fetch_add(p, v, __ATOMIC_RELAXED, __HIP_MEMORY_SCOPE_AGENT); }
__device__ __forceinline__ unsigned xb_xcc_id() { return (unsigned)__builtin_amdgcn_s_getreg((3 << 11) | 20) & 0xFu; }
#define XB_SPIN(cond, bar) do { unsigned _sp = 0; while (cond) { __builtin_amdgcn_s_sleep(1); \
    if ((++_sp & 255u) == 0u) { if (xb_ld(&(bar)[XB_TMO])) break; if (_sp > XB_SPIN_CAP) { atomicAdd(&(bar)[XB_TMO], 1u); break; } } } } while (0)

struct XcdBarrier {
    unsigned* bar; unsigned x;
    unsigned expect;
    volatile LAS unsigned* st;
};

__device__ __forceinline__ XcdBarrier xcd_barrier_post(unsigned* bar, volatile LAS unsigned* st, unsigned expect = 0u) {
    XcdBarrier b; b.bar = bar; b.x = xb_xcc_id(); b.st = st; b.expect = expect ? expect : gridDim.x * gridDim.y * gridDim.z;
    if (threadIdx.x == 0) (void)xb_add(&bar[XB_XCNT(b.x)], 1u);
    return b;
}
__device__ __forceinline__ void xcd_barrier_complete(unsigned* bar, unsigned x, unsigned& nloc, unsigned& nx, const unsigned G) {
    unsigned sum, cnt, mine, sp = 0u;
    for (;;) {
        sum = 0u; cnt = 0u; mine = 0u;
#pragma unroll
        for (unsigned j = 0; j < 16; ++j) { const unsigned c = xb_ld(&bar[XB_XCNT(j)]); sum += c; cnt += (c > 0u) ? 1u : 0u; mine = (j == x) ? c : mine; }
        if (sum == G) break;
        __builtin_amdgcn_s_sleep(1);
        if ((++sp & 255u) == 0u) { if (xb_ld(&bar[XB_TMO])) break; if (sp > XB_SPIN_CAP) { atomicAdd(&bar[XB_TMO], 1u); break; } }
    }
    nloc = mine > 0u ? mine : 1u; nx = cnt > 0u ? cnt : 1u;
}

__device__ __forceinline__ void xcd_barrier(const XcdBarrier& b) {
    asm volatile("s_waitcnt vmcnt(0)" ::: "memory");
    __syncthreads();
    if (threadIdx.x == 0) {
        unsigned* bar = b.bar;
        __builtin_amdgcn_s_waitcnt(0);
        unsigned nloc = b.st[0], nx = b.st[1];
        if (nloc == 0u) { xcd_barrier_complete(bar, b.x, nloc, nx, b.expect); b.st[0] = nloc; b.st[1] = nx; }
        const unsigned old = xb_add(&bar[XB_XSUB(b.x)], 1u);
        const unsigned gen = old / nloc;
        if (old + 1u == (gen + 1u) * nloc) {
            __builtin_amdgcn_fence(__ATOMIC_RELEASE, "agent");
            asm volatile("s_waitcnt vmcnt(0)" ::: "memory");
            const unsigned og = xb_add(&bar[XB_TOP], 1u);
            const unsigned tg = og / nx;
            if (og + 1u == (tg + 1u) * nx) xb_add(&bar[XB_TOPGEN], 1u);
            else XB_SPIN(xb_ld(&bar[XB_TOPGEN]) == tg, bar);
            __builtin_amdgcn_fence(__ATOMIC_ACQUIRE, "agent");
            xb_add(&bar[XB_XGEN(b.x)], 1u);
            asm volatile("s_waitcnt vmcnt(0)" ::: "memory");
        } else {
            XB_SPIN(xb_ld(&bar[XB_XGEN(b.x)]) == gen, bar);
            __builtin_amdgcn_fence(__ATOMIC_ACQUIRE, "agent");
            asm volatile("s_waitcnt vmcnt(0)" ::: "memory");
        }
    }
    __syncthreads();
}

struct Args { const float* in[N_IN]; float* out; unsigned char* ws; int ph_lo, ph_hi, li, pad; };
typedef const __attribute__((address_space(4))) Args* KArgs;
__device__ __forceinline__ KArgs kargs() { auto p = __builtin_amdgcn_kernarg_segment_ptr(); asm volatile("" : "+s"(p)); return (KArgs)p; }
struct Frame {
    LAS unsigned char* lds;
    int tid, lane, wave, G, bid;
    unsigned char* ws;
    gu32* ctl;
};
#define WSP(T, off) ((T*)(F.ws + (off)))

struct MapId { __device__ __forceinline__ int operator()(int n) const { return n; } };
struct MapAdd { int off; __device__ __forceinline__ int operator()(int n) const { return n + off; } };
struct MapAB { __device__ __forceinline__ int operator()(int n) const { return n < 456 ? n : (n < 2504 ? n + 56 : n - 2048); } };
template <class Map> __device__ __forceinline__ void wg_transpose_item(const float* W, int N, int ldw, bf16* WT, int ldt, int koff, Map map, LAS float* scr, int item, int tid) {
    const int nblk = (N + 127) >> 7, kb = item / nblk, nb = item - kb * nblk, k0 = kb * 128, n0 = nb * 128;
#pragma unroll
    for (int it = 0; it < 8; ++it) {
        const int row = it * 16 + (tid >> 5), c4 = (tid & 31) * 4, n = n0 + c4;
        f32x4 v = (f32x4){0.f, 0.f, 0.f, 0.f};
        if (n + 3 < N) v = *(const f32x4*)(W + (size_t)(k0 + row) * ldw + n);
        LAS float* s = scr + row * 129 + c4; s[0] = v[0]; s[1] = v[1]; s[2] = v[2]; s[3] = v[3];
    }
    __syncthreads();
#pragma unroll
    for (int j = 0; j < 4; ++j) {
        const int idx = j * 512 + tid, nl = idx >> 4, ch = idx & 15, n = n0 + nl;
        if (n < N) { const LAS float* s = scr + (ch * 8) * 129 + nl;
            v4u o; o.x = pk2(s[0], s[129]); o.y = pk2(s[2 * 129], s[3 * 129]); o.z = pk2(s[4 * 129], s[5 * 129]); o.w = pk2(s[6 * 129], s[7 * 129]);
            *(v4u*)(WT + (size_t)map(n) * ldt + koff + k0 + ch * 8) = o; }
    }
    __syncthreads();
}
__device__ __forceinline__ void wg_transpose_item_fp8(const float* W, int N, int ldw, unsigned char* WT, int ldt, float mul, LAS float* scr, int item, int tid) {
    const int nblk = (N + 127) >> 7, kb = item / nblk, nb = item - kb * nblk, k0 = kb * 128, n0 = nb * 128;
#pragma unroll
    for (int it = 0; it < 8; ++it) {
        const int row = it * 16 + (tid >> 5), c4 = (tid & 31) * 4;
        const f32x4 v = *(const f32x4*)(W + (size_t)(k0 + row) * ldw + n0 + c4);
        LAS float* s = scr + row * 129 + c4; s[0] = v[0]; s[1] = v[1]; s[2] = v[2]; s[3] = v[3];
    }
    __syncthreads();
#pragma unroll
    for (int j = 0; j < 2; ++j) {
        const int idx = j * 512 + tid, nl = idx >> 3, ch = idx & 7;
        const LAS float* s = scr + (ch * 16) * 129 + nl;
        v4u o;
#pragma unroll
        for (int q = 0; q < 4; ++q) { unsigned w = 0u;
            w = __builtin_amdgcn_cvt_pk_fp8_f32(s[(4 * q) * 129] * mul, s[(4 * q + 1) * 129] * mul, w, false);
            w = __builtin_amdgcn_cvt_pk_fp8_f32(s[(4 * q + 2) * 129] * mul, s[(4 * q + 3) * 129] * mul, w, true);
            o[q] = w; }
        *(v4u*)(WT + (size_t)(n0 + nl) * ldt + k0 + ch * 16) = o;
    }
    __syncthreads();
}
struct MoeItem { const float* W; unsigned char* WT; int N; float mul; int k0, n0; };
__device__ __forceinline__ MoeItem moe_item(KArgs A, unsigned char* ws, int it) {
    MoeItem d; int sub;
    if (it < 64 * 128) { const int m = it >> 7; sub = it & 127; d.W = A->in[I_WGU] + (size_t)m * 1024 * 2048; d.N = 2048; d.WT = ws + WS_W_GU + (size_t)m * 2048 * 1024; d.mul = 64.0f; }
    else { it -= 64 * 128; const int m = it >> 6; sub = it & 63; d.W = A->in[I_WDN] + (size_t)m * 1024 * 1024; d.N = 1024; d.WT = ws + WS_W_DN + (size_t)m * 1024 * 1024; d.mul = 128.0f; }
    const int nblk = d.N >> 7, kb = sub / nblk, nb = sub - kb * nblk; d.k0 = kb * 128; d.n0 = nb * 128; return d;
}
__device__ __forceinline__ void p0_moe_fp8(Frame& F, KArgs A) {
    LAS float* scr = (LAS float*)(F.lds + RING_OFF);
    const int tid = F.tid; constexpr int NIT = 64 * 128 + 64 * 64;
    int it = F.bid; if (it >= NIT) return;
    MoeItem cur = moe_item(A, F.ws, it);
    f32x4 r[8];
#pragma unroll
    for (int x = 0; x < 8; ++x) r[x] = __builtin_nontemporal_load((const f32x4*)(cur.W + (size_t)(cur.k0 + x * 16 + (tid >> 5)) * cur.N + cur.n0 + (tid & 31) * 4));
    for (;;) {
#pragma unroll
        for (int x = 0; x < 8; ++x) { LAS float* sp = scr + (x * 16 + (tid >> 5)) * 129 + (tid & 31) * 4; sp[0] = r[x][0]; sp[1] = r[x][1]; sp[2] = r[x][2]; sp[3] = r[x][3]; }
        __syncthreads();
        const int nx = it + F.G; MoeItem nxt = cur;
        if (nx < NIT) { nxt = moe_item(A, F.ws, nx);
#pragma unroll
            for (int x = 0; x < 8; ++x) r[x] = __builtin_nontemporal_load((const f32x4*)(nxt.W + (size_t)(nxt.k0 + x * 16 + (tid >> 5)) * nxt.N + nxt.n0 + (tid & 31) * 4)); }
#pragma unroll
        for (int j = 0; j < 2; ++j) {
            const int idx = j * 512 + tid, nl = idx >> 3, ch = idx & 7;
            const LAS float* sp = scr + (ch * 16) * 129 + nl;
            v4u o;
#pragma unroll
            for (int q = 0; q < 4; ++q) { unsigned w = 0u;
                w = __builtin_amdgcn_cvt_pk_fp8_f32(sp[(4 * q) * 129] * cur.mul, sp[(4 * q + 1) * 129] * cur.mul, w, false);
                w = __builtin_amdgcn_cvt_pk_fp8_f32(sp[(4 * q + 2) * 129] * cur.mul, sp[(4 * q + 3) * 129] * cur.mul, w, true);
                o[q] = w; }
            *(v4u*)(cur.WT + (size_t)(cur.n0 + nl) * 1024 + cur.k0 + ch * 16) = o;
        }
        __syncthreads();
        if (nx >= NIT) break;
        cur = nxt; it = nx;
    }
}
__device__ __forceinline__ void p0_prologue(Frame& F, KArgs A) {
    LAS float* scr = (LAS float*)(F.lds + RING_OFF);
    const int tid = F.tid;
    constexpr int IT_GU = 128, IT_DN = 64;
    constexpr int N_GU = 64 * IT_GU, N_DN = 64 * IT_DN;
    constexpr int N_INAB = 8 * 20, N_INCD = 8 * 20, N_OUTCD = 64, N_PG = 2 * 64, N_PP = 2 * 2 * 8, N_QIDX = 2 * 4, N_OUTB = 4 * 8;
    constexpr int NITEMS = N_GU + N_DN + N_INAB + N_INCD + N_OUTCD + N_PG + N_PP + N_QIDX + N_OUTB;
    if (kMoeFp8) p0_moe_fp8(F, A);
    for (int it = F.bid + (kMoeFp8 ? N_GU + N_DN : 0); it < NITEMS; it += F.G) {
        int r = it;
        if (r < N_GU) { const int m = r / IT_GU;
            if (kMoeFp8) wg_transpose_item_fp8(A->in[I_WGU] + (size_t)m * 1024 * 2048, 2048, 2048, WSP(unsigned char, WS_W_GU) + (size_t)m * 2048 * 1024, 1024, 64.0f, scr, r % IT_GU, tid);
            else wg_transpose_item(A->in[I_WGU] + (size_t)m * 1024 * 2048, 2048, 2048, WSP(bf16, WS_W_GU) + (size_t)m * 2048 * 1024, 1024, 0, MapId{}, scr, r % IT_GU, tid);
            continue; } r -= N_GU;
        if (r < N_DN) { const int m = r / IT_DN;
            if (kMoeFp8) wg_transpose_item_fp8(A->in[I_WDN] + (size_t)m * 1024 * 1024, 1024, 1024, WSP(unsigned char, WS_W_DN) + (size_t)m * 1024 * 1024, 1024, 128.0f, scr, r % IT_DN, tid);
            else wg_transpose_item(A->in[I_WDN] + (size_t)m * 1024 * 1024, 1024, 1024, WSP(bf16, WS_W_DN) + (size_t)m * 1024 * 1024, 1024, 0, MapId{}, scr, r % IT_DN, tid);
            continue; } r -= N_DN;
        if (r < N_INAB) { wg_transpose_item(A->in[I_AB_WIN], 2512, 2512, WSP(bf16, WS_W_INAB), 1024, 0, MapAB{}, scr, r, tid); continue; } r -= N_INAB;
        if (r < N_INCD) { wg_transpose_item(A->in[I_CD_WIN], 2560, 2560, WSP(bf16, WS_W_INCD), 1024, 0, MapId{}, scr, r, tid); continue; } r -= N_INCD;
        if (r < N_OUTCD) { wg_transpose_item(A->in[I_CD_WOUT], 1024, 1024, WSP(bf16, WS_W_OUTCD), 1024, 0, MapId{}, scr, r, tid); continue; } r -= N_OUTCD;
        if (r < N_PG) { const int l = r / 64; wg_transpose_item(A->in[I_PLE_WG] + (size_t)l * 1024 * 1024, 1024, 1024, WSP(bf16, WS_W_PG) + (size_t)l * 1024 * 1024, 1024, 0, MapId{}, scr, r % 64, tid); continue; } r -= N_PG;
        if (r < N_PP) { const int l = r / 16; wg_transpose_item(A->in[I_PLE_WP] + (size_t)l * 256 * 1024, 1024, 1024, WSP(bf16, WS_W_PP) + (size_t)l * 1024 * 256, 256, 0, MapId{}, scr, r % 16, tid); continue; } r -= N_PP;
        if (r < N_QIDX) { wg_transpose_item(A->in[I_AB_WQIDX], 512, 512, WSP(bf16, WS_W_ABS), 256, 0, MapAdd{1024}, scr, r, tid); continue; } r -= N_QIDX;
        wg_transpose_item(A->in[I_AB_WOUT] + (size_t)512 * 1024, 1024, 1024, WSP(bf16, WS_W_OUTAB), 1536, 1024, MapId{}, scr, r, tid);
    }
    const size_t gt = (size_t)F.bid * NTHREADS + tid, GT = (size_t)F.G * NTHREADS;
    for (size_t i = gt; i < (size_t)48 * 1024 / 8; i += GT) *(v4u*)(WSP(bf16, WS_W_INAB) + (size_t)464 * 1024 + i * 8) = (v4u){0u, 0u, 0u, 0u};
    for (size_t i = gt; i < (size_t)1024 * 256; i += GT) {
        const int n = (int)(i >> 8), c = (int)(i & 255), h = n >> 7, r = n & 127;
        const float* a = A->in[I_AB_WUQ] + (size_t)c * 512 + h * 64; const float* b = A->in[I_AB_WUK] + (size_t)r * 512 + h * 64;
        float s = 0.f;
#pragma unroll 8
        for (int d = 0; d < 64; d += 4) { const f32x4 x = *(const f32x4*)(a + d), y = *(const f32x4*)(b + d); s += x[0] * y[0] + x[1] * y[1] + x[2] * y[2] + x[3] * y[3]; }
        WSP(bf16, WS_W_ABS)[i] = (bf16)f2bf(s * 0.125f);
    }
    for (size_t i = gt; i < (size_t)1024 * 128; i += GT) {
        const int n = (int)(i & 1023), k0 = (int)(i >> 10) * 8, h = k0 >> 7, r0 = k0 & 127;
        const float* bcol = A->in[I_AB_WOUT] + (size_t)(h * 64) * 1024 + n;
        float acc[8];
#pragma unroll
        for (int x = 0; x < 8; ++x) acc[x] = 0.f;
#pragma unroll 2
        for (int v0 = 0; v0 < 64; v0 += 8) {
            float bv[8];
#pragma unroll
            for (int v = 0; v < 8; ++v) bv[v] = bcol[(size_t)(v0 + v) * 1024];
#pragma unroll
            for (int x = 0; x < 8; ++x) { const float* ar = A->in[I_AB_WUV] + (size_t)(r0 + x) * 512 + h * 64 + v0; const f32x4 a0 = *(const f32x4*)ar, a1 = *(const f32x4*)(ar + 4);
                acc[x] += a0[0] * bv[0] + a0[1] * bv[1] + a0[2] * bv[2] + a0[3] * bv[3] + a1[0] * bv[4] + a1[1] * bv[5] + a1[2] * bv[6] + a1[3] * bv[7]; }
        }
        *(v4u*)(WSP(bf16, WS_W_OUTAB) + (size_t)n * 1536 + k0) = pack8f(acc);
    }
#pragma unroll 4
    for (size_t i = gt; i < (size_t)M * D / 8; i += GT) { const f32x4 a = __builtin_nontemporal_load((const f32x4*)(A->in[I_X] + i * 8)), b = __builtin_nontemporal_load((const f32x4*)(A->in[I_X] + i * 8 + 4));
        v4u o; o.x = pk2(a[0], a[1]); o.y = pk2(a[2], a[3]); o.z = pk2(b[0], b[1]); o.w = pk2(b[2], b[3]); *(v4u*)(WSP(bf16, WS_XB) + i * 8) = o; }
#pragma unroll 4
    for (size_t i = gt; i < (size_t)2 * M * 256 / 8; i += GT) { const f32x4 a = __builtin_nontemporal_load((const f32x4*)(A->in[I_P] + i * 8)), b = __builtin_nontemporal_load((const f32x4*)(A->in[I_P] + i * 8 + 4));
        v4u o; o.x = pk2(a[0], a[1]); o.y = pk2(a[2], a[3]); o.z = pk2(b[0], b[1]); o.w = pk2(b[2], b[3]); *(v4u*)(WSP(bf16, WS_PB) + i * 8) = o; }
}

__device__ __forceinline__ void p2_prep(Frame& F, KArgs A) {
    const int lane = F.lane, gw = F.bid * NWAVES + F.wave, NGW = F.G * NWAVES;
    const float* SM = WSP(float, WS_SM); const bf16* QZ = WSP(bf16, WS_QKVZ);
    const f32x4 qg = *(const f32x4*)(A->in[I_AB_QG] + 4 * lane);
    const f32x4 kvg = *(const f32x4*)(A->in[I_AB_KVG] + 4 * (lane & 31));
    const f32x4 kig = *(const f32x4*)(A->in[I_AB_KIG] + 4 * (lane & 15)), kib = *(const f32x4*)(A->in[I_AB_KIB] + 4 * (lane & 15));
    const f32x4 alog = *(const f32x4*)(A->in[I_AB_ALOG]), dtb = *(const f32x4*)(A->in[I_AB_DTB]);
    LAS float* cw = (LAS float*)(F.lds);
    {   f32x4 wv[3]; int t0 = F.tid; asm volatile("" : "+v"(t0));
#pragma unroll
        for (int j = 0; j < 3; ++j) wv[j] = *(const f32x4*)(A->in[I_AB_CONVW] + (size_t)(t0 + NTHREADS * j) * 4);
#pragma unroll
        for (int j = 0; j < 3; ++j) *(LAS f32x4*)(cw + (t0 + NTHREADS * j) * 4) = wv[j];
    }
    __syncthreads();
    for (int row = gw; row < M; row += NGW) {
        const int t = row & (SEQ - 1);
        const f32x4 a = *(const f32x4*)(SM + (size_t)row * 512 + 4 * lane), b = *(const f32x4*)(SM + (size_t)row * 512 + 256 + 4 * lane);
        {
            const float ss = wave_sum(a[0] * a[0] + a[1] * a[1] + a[2] * a[2] + a[3] * a[3]);
            const float r = rsqrtf(ss * (1.0f / 256.0f) + 1e-6f);
            v2u o; o.x = pk2(a[0] * r * qg[0], a[1] * r * qg[1]); o.y = pk2(a[2] * r * qg[2], a[3] * r * qg[3]);
            *(v2u*)(WSP(bf16, WS_CQ) + (size_t)row * 256 + 4 * lane) = o;
        }
        {
            const float ss = wave_sum(lane < 32 ? (b[0] * b[0] + b[1] * b[1] + b[2] * b[2] + b[3] * b[3]) : 0.f);
            const float r = rsqrtf(ss * (1.0f / 128.0f) + 1e-6f);
            if (lane < 32) { v2u o; o.x = pk2(b[0] * r * kvg[0], b[1] * r * kvg[1]); o.y = pk2(b[2] * r * kvg[2], b[3] * r * kvg[3]);
                *(v2u*)(WSP(bf16, WS_CKV) + (size_t)row * 128 + 4 * lane) = o; }
        }
        {
            const bool in = (lane >= 32 && lane < 48);
            const float mean = wave_sum(in ? (b[0] + b[1] + b[2] + b[3]) : 0.f) * (1.0f / 64.0f);
            const f32x4 d = b - mean;
            const float var = wave_sum(in ? (d[0] * d[0] + d[1] * d[1] + d[2] * d[2] + d[3] * d[3]) : 0.f) * (1.0f / 64.0f);
            const float r = rsqrtf(var + 1e-5f);
            if (in) { v2u o; o.x = pk2(d[0] * r * kig[0] + kib[0], d[1] * r * kig[1] + kib[1]); o.y = pk2(d[2] * r * kig[2] + kib[2], d[3] * r * kig[3] + kib[3]);
                *(v2u*)(WSP(bf16, WS_KIDX) + (size_t)row * 64 + 4 * (lane - 32)) = o; }
        }
        if (lane == 48 || lane == 49) *(f32x4*)(WSP(float, WS_WIDX) + (size_t)row * 8 + 4 * (lane - 48)) = b * 0.044194173824159216f;
        if (lane == 50) { f32x4 o; o[0] = sigm(b[0]); o[1] = sigm(b[1]); o[2] = sigm(b[2]); o[3] = sigm(b[3]); *(f32x4*)(WSP(float, WS_BETA) + (size_t)row * 4) = o; }
        if (lane == 51) { f32x4 o;
#pragma unroll
            for (int h = 0; h < 4; ++h) { const float xx = b[h] + dtb[h]; const float sp = xx > 20.f ? xx : log1pf(__expf(xx)); o[h] = -__expf(alog[h]) * sp; }
            *(f32x4*)(WSP(float, WS_GG) + (size_t)row * 4) = o; }
        v4u xr[3][4];
#pragma unroll
        for (int sel = 0; sel < 3; ++sel)
#pragma unroll
            for (int j = 0; j < 4; ++j) { const int back = (t - 3 + j >= 0) ? (3 - j) : 0; xr[sel][j] = *(const v4u*)(QZ + (size_t)(row - back) * 2048 + sel * 512 + 8 * lane); }
#pragma unroll
        for (int sel = 0; sel < 3; ++sel) {
            const int col0 = sel * 512 + 8 * lane;
            float acc[8];
#pragma unroll
            for (int i = 0; i < 8; ++i) acc[i] = 0.f;
#pragma unroll
            for (int j = 0; j < 4; ++j) {
                float xv[8]; unpack8(xr[sel][j], xv);
                const f32x4 w0 = *(const LAS f32x4*)(cw + j * 1536 + col0), w1 = *(const LAS f32x4*)(cw + j * 1536 + col0 + 4);
                const float m = (t - 3 + j >= 0) ? 1.f : 0.f;
#pragma unroll
                for (int i = 0; i < 4; ++i) { acc[i] += w0[i] * m * xv[i]; acc[4 + i] += w1[i] * m * xv[4 + i]; }
            }
            float ss = 0.f;
#pragma unroll
            for (int i = 0; i < 8; ++i) { acc[i] = siluf(acc[i]); ss += acc[i] * acc[i]; }
            if (sel < 2) {
                ss += __shfl_xor(ss, 1); ss += __shfl_xor(ss, 2); ss += __shfl_xor(ss, 4); ss += __shfl_xor(ss, 8);
                const float sc = rsqrtf(ss + 1e-6f) * (sel == 0 ? 0.08838834764831845f : 1.0f);
#pragma unroll
                for (int i = 0; i < 8; ++i) acc[i] *= sc;
            }
            bf16* dst = (sel == 0 ? WSP(bf16, WS_QN) : (sel == 1 ? WSP(bf16, WS_KN) : WSP(bf16, WS_VN))) + (size_t)row * 512 + 8 * lane;
            *(v4u*)dst = pack8f(acc);
        }
    }
}

constexpr int SEQ_WGS = 16;
constexpr int SQ_WP = 0, SQ_QD = 16384, SQ_KDT = 32768, SQ_QK = 49152, SQ_BUF = 57344;
__device__ __forceinline__ bf16x8 packfrag(const f32x4 lo, const f32x4 hi) { v4u w; w.x = pg8::cvt_pk_bf16(lo[0], lo[1]); w.y = pg8::cvt_pk_bf16(lo[2], lo[3]); w.z = pg8::cvt_pk_bf16(hi[0], hi[1]); w.w = pg8::cvt_pk_bf16(hi[2], hi[3]); return __builtin_bit_cast(bf16x8, w); }
__device__ __forceinline__ void seq_load(v4u (&r)[14], const unsigned char* blk, int lt) {
#pragma unroll
    for (int i = 0; i < 14; ++i) r[i] = *(const v4u*)(blk + (size_t)(lt + 256 * i) * 16);
}
__device__ __forceinline__ void seq_write(LAS unsigned char* buf, const v4u (&r)[14], int lt) {
#pragma unroll
    for (int i = 0; i < 14; ++i) {
        const int id = lt + 256 * i; int dst;
        if (id < 2048) { const int rr = (id & 1023) >> 4, ch = id & 15; dst = (id & ~1023) * 16 + rr * 256 + 16 * (ch ^ (rr & 15)); }
        else { const int rr = (id - 2048) >> 3, ch = id & 7; dst = 32768 + rr * 128 + 16 * (ch ^ (rr & 7)); }
        *(LAS v4u*)(buf + dst) = r[i];
    }
}
__device__ __forceinline__ void seq_compute(LAS unsigned char* buf, f32x4 (&Sacc)[8], const f32x4 (&U)[4], const float gl, float* op0, const int fr, const int fq) {
    bf16x8 sf[4];
#pragma unroll
    for (int s = 0; s < 4; ++s) sf[s] = packfrag(Sacc[2 * s], Sacc[2 * s + 1]);
    f32x4 Vn[4], Oa[4];
#pragma unroll
    for (int tc = 0; tc < 4; ++tc) {
        const int rr = 16 * tc + fr; f32x4 av = (f32x4){0.f, 0.f, 0.f, 0.f}, ao = (f32x4){0.f, 0.f, 0.f, 0.f};
#pragma unroll
        for (int s = 0; s < 4; ++s) {
            const int off = rr * 256 + 16 * ((4 * s + fq) ^ (rr & 15));
            const bf16x8 wf = *(const LAS bf16x8*)(buf + SQ_WP + off), qf = *(const LAS bf16x8*)(buf + SQ_QD + off);
            av = __builtin_amdgcn_mfma_f32_16x16x32_bf16(wf, sf[s], av, 0, 0, 0);
            ao = __builtin_amdgcn_mfma_f32_16x16x32_bf16(qf, sf[s], ao, 0, 0, 0);
        }
        Vn[tc] = U[tc] - av; Oa[tc] = ao;
    }
    bf16x8 vf[2];
    vf[0] = packfrag(Vn[0], Vn[1]); vf[1] = packfrag(Vn[2], Vn[3]);
#pragma unroll
    for (int tc = 0; tc < 4; ++tc) {
        const int rr = 16 * tc + fr;
#pragma unroll
        for (int s = 0; s < 2; ++s) {
            const bf16x8 kf = *(const LAS bf16x8*)(buf + SQ_QK + rr * 128 + 16 * ((4 * s + fq) ^ (rr & 7)));
            Oa[tc] = __builtin_amdgcn_mfma_f32_16x16x32_bf16(kf, vf[s], Oa[tc], 0, 0, 0);
        }
        float* op = op0 + (size_t)(16 * tc) * 512;
#pragma unroll
        for (int j = 0; j < 4; ++j) op[(size_t)j * 512] = Oa[tc][j];
    }
#pragma unroll
    for (int T = 0; T < 8; ++T) {
        const int rr = 16 * T + fr; f32x4 a = Sacc[T] * gl;
#pragma unroll
        for (int s = 0; s < 2; ++s) {
            const bf16x8 kf = *(const LAS bf16x8*)(buf + SQ_KDT + rr * 128 + 16 * ((4 * s + fq) ^ (rr & 7)));
            a = __builtin_amdgcn_mfma_f32_16x16x32_bf16(kf, vf[s], a, 0, 0, 0);
        }
        Sacc[T] = a;
    }
}
#define SEQ_BAR() do { asm volatile("s_waitcnt lgkmcnt(0)" ::: "memory"); __builtin_amdgcn_s_barrier(); asm volatile("" ::: "memory"); } while (0)
__device__ __forceinline__ void p4_delta_seq(Frame& F, int sid) {
    const int lane = F.lane, wave = F.wave, tid = F.tid;
    const int bh = sid >> 1, half = sid & 1, b = bh >> 2, h = bh & 3;
    const int fr = lane & 15, fq = lane >> 4;
    const int v0 = half * 64 + (wave & 3) * 16;
    const unsigned char* cbase = F.ws + WS_CHK + (size_t)(bh * 128) * CHK_STRIDE;
    if (wave >= 4) {
        const int lt = tid - 256;
        v4u RA[14], RB[14];
#define SEQ_LD(R, blk) do { const unsigned char* _b = (blk); _Pragma("unroll") for (int _i = 0; _i < 14; ++_i) asm volatile("global_load_dwordx4 %0, %1, off" : "=v"(R[_i]) : "v"(_b + (size_t)(lt + 256 * _i) * 16) : "memory"); } while (0)
#define SEQ_WAIT(younger) do { if (younger) asm volatile("s_waitcnt vmcnt(14)" ::: "memory"); else asm volatile("s_waitcnt vmcnt(0)" ::: "memory"); } while (0)
        SEQ_LD(RA, cbase); SEQ_LD(RB, cbase + CHK_STRIDE); SEQ_WAIT(true); seq_write(F.lds, RA, lt); SEQ_LD(RA, cbase + 2 * CHK_STRIDE);
        SEQ_BAR();
#pragma unroll 1
        for (int n = 0; n < 128; n += 2) {
            if (n + 1 < 128) { SEQ_WAIT(n + 2 < 128); seq_write(F.lds + ((n + 1) & 1) * SQ_BUF, RB, lt); } if (n + 3 < 128) SEQ_LD(RB, cbase + (size_t)(n + 3) * CHK_STRIDE);
            SEQ_BAR();
            if (n + 2 < 128) { SEQ_WAIT(n + 3 < 128); seq_write(F.lds + (n & 1) * SQ_BUF, RA, lt); } if (n + 4 < 128) SEQ_LD(RA, cbase + (size_t)(n + 4) * CHK_STRIDE);
            SEQ_BAR();
        }
        asm volatile("s_waitcnt vmcnt(0)" ::: "memory");
#undef SEQ_LD
#undef SEQ_WAIT
    } else {
        float* OD = WSP(float, WS_ODELTA);
        f32x4 Sacc[8], Ucur[4], Unxt[4]; float glc, gln;
#pragma unroll
        for (int T = 0; T < 8; ++T) Sacc[T] = (f32x4){0.f, 0.f, 0.f, 0.f};
#pragma unroll
        for (int tc = 0; tc < 4; ++tc) { Ucur[tc] = *(const f32x4*)((const float*)(cbase + CHK_UT) + (size_t)(v0 + fr) * 64 + 4 * fq + 16 * tc);
                                          Unxt[tc] = *(const f32x4*)((const float*)(cbase + CHK_STRIDE + CHK_UT) + (size_t)(v0 + fr) * 64 + 4 * fq + 16 * tc); }
        glc = *(const float*)(cbase + CHK_GL); gln = *(const float*)(cbase + CHK_STRIDE + CHK_GL);
        SEQ_BAR();
#pragma unroll 1
        for (int n = 0; n < 128; ++n) {
            seq_compute(F.lds + (n & 1) * SQ_BUF, Sacc, Ucur, glc, OD + (size_t)(b * SEQ + n * 64 + 4 * fq) * 512 + h * 128 + v0 + fr, fr, fq);
#pragma unroll
            for (int tc = 0; tc < 4; ++tc) Ucur[tc] = Unxt[tc];
            glc = gln;
            if (n + 2 < 128) { const unsigned char* nb = cbase + (size_t)(n + 2) * CHK_STRIDE; gln = *(const float*)(nb + CHK_GL);
#pragma unroll
                for (int tc = 0; tc < 4; ++tc) Unxt[tc] = *(const f32x4*)((const float*)(nb + CHK_UT) + (size_t)(v0 + fr) * 64 + 4 * fq + 16 * tc); }
            SEQ_BAR();
        }
    }
}
#undef SEQ_BAR

__device__ __forceinline__ float relu1(float x) { float r; asm("v_max_f32_e32 %0, 0, %1" : "=v"(r) : "v"(x)); return r; }
__device__ __forceinline__ void p4_indexer(Frame& F, int widx, int nw) {
    const int lane = F.lane, fr = lane & 15, fq = lane >> 4;
    const bf16* QL = WSP(bf16, WS_QL); const bf16* KI = WSP(bf16, WS_KIDX); const float* WI = WSP(float, WS_WIDX); float* SC = WSP(float, WS_BIG);
    for (int task = widx; task < 2 * 4352; task += nw) {
        const int b = task / 4352; int tau = task - b * 4352;
        int g = 0; while (16 * (g + 1) * (g + 2) <= tau) ++g;
        tau -= 16 * g * (g + 1);
        const int qt = 32 * g + tau / (g + 1), seg = tau % (g + 1);
        const int row0 = b * SEQ + 16 * qt;
        bf16x8 Qf[8][2];
#pragma unroll
        for (int hh = 0; hh < 8; ++hh)
#pragma unroll
            for (int s = 0; s < 2; ++s) Qf[hh][s] = *(const bf16x8*)(QL + (size_t)(row0 + fr) * 1536 + 1024 + hh * 64 + 32 * s + 8 * fq);
        const f32x4 w0 = *(const f32x4*)(WI + (size_t)(row0 + fr) * 8), w1 = *(const f32x4*)(WI + (size_t)(row0 + fr) * 8 + 4);
        const int kt1 = (32 * seg + 31 < qt) ? 32 * seg + 31 : qt;
        for (int kb8 = 32 * seg; kb8 <= kt1; kb8 += 8) {
            bf16x8 kfr[8][2];
#pragma unroll
            for (int x = 0; x < 8; ++x) { const int kt = (kb8 + x <= kt1) ? kb8 + x : kt1; const bf16* kp = KI + (size_t)(b * SEQ + 16 * kt + fr) * 64 + 8 * fq; kfr[x][0] = *(const bf16x8*)kp; kfr[x][1] = *(const bf16x8*)(kp + 32); }
#pragma unroll
            for (int x = 0; x < 8; ++x) asm volatile("" : "+v"(kfr[x][0]), "+v"(kfr[x][1]));
#pragma unroll
            for (int x = 0; x < 8; ++x) {
                const int kt = kb8 + x;
                if (kt <= kt1) {
                    f32x4 isc = (f32x4){0.f, 0.f, 0.f, 0.f}, c[8];
#pragma unroll
                    for (int hh = 0; hh < 8; ++hh) c[hh] = __builtin_amdgcn_mfma_f32_16x16x32_bf16(kfr[x][0], Qf[hh][0], (f32x4){0.f, 0.f, 0.f, 0.f}, 0, 0, 0);
#pragma unroll
                    for (int hh = 0; hh < 8; ++hh) c[hh] = __builtin_amdgcn_mfma_f32_16x16x32_bf16(kfr[x][1], Qf[hh][1], c[hh], 0, 0, 0);
                    __builtin_amdgcn_sched_barrier(0);
#pragma unroll
                    for (int hh = 0; hh < 8; ++hh) { const float wh = (hh < 4) ? w0[hh & 3] : w1[hh & 3];
#pragma unroll
                        for (int j = 0; j < 4; ++j) isc[j] += relu1(c[hh][j]) * wh; }
                    *(f32x4*)(SC + (size_t)(row0 + fr) * 8192 + 16 * kt + 4 * fq) = isc;
                }
            }
        }
    }
}

__device__ __forceinline__ void mask_ge8(unsigned long long (&m)[8], unsigned x0, unsigned x1, unsigned x2, unsigned x3, unsigned x4, unsigned x5, unsigned x6, unsigned x7, unsigned t) {
    asm("v_cmp_ge_u32_e64 %0, %8, %16\n\tv_cmp_ge_u32_e64 %1, %9, %16\n\tv_cmp_ge_u32_e64 %2, %10, %16\n\tv_cmp_ge_u32_e64 %3, %11, %16\n\t"
        "v_cmp_ge_u32_e64 %4, %12, %16\n\tv_cmp_ge_u32_e64 %5, %13, %16\n\tv_cmp_ge_u32_e64 %6, %14, %16\n\tv_cmp_ge_u32_e64 %7, %15, %16"
        : "=&s"(m[0]), "=&s"(m[1]), "=&s"(m[2]), "=&s"(m[3]), "=&s"(m[4]), "=&s"(m[5]), "=&s"(m[6]), "=&s"(m[7])
        : "v"(x0), "v"(x1), "v"(x2), "v"(x3), "v"(x4), "v"(x5), "v"(x6), "v"(x7), "s"(t));
}
__device__ __forceinline__ unsigned tk_key(float f) { const unsigned b = __float_as_uint(f); return (b & 0x80000000u) ? ~b : (b | 0x80000000u); }
__device__ __forceinline__ void topk_row_slow(const float* sr, const int n, const int lane, LAS int* sel) {
    const int nseg = (n + 63) >> 6;
    unsigned T = 0u;
    for (int bit = 31; bit >= 0; --bit) {
        const unsigned cnd = T | (1u << bit); int c = 0;
        for (int sg = 0; sg < nseg; ++sg) { const int idx = sg * 64 + lane; const unsigned x = (idx < n) ? tk_key(sr[idx < n ? idx : 0]) : 0u; c += __popcll(__ballot(x >= cnd)); }
        if (c >= 256) T = cnd;
    }
    int cgt = 0;
    for (int sg = 0; sg < nseg; ++sg) { const int idx = sg * 64 + lane; const unsigned x = (idx < n) ? tk_key(sr[idx < n ? idx : 0]) : 0u; cgt += __popcll(__ballot(x > T)); }
    const int need_eq = 256 - cgt; int running = 0, eq_taken = 0;
    const unsigned long long lt = (1ull << lane) - 1ull;
    for (int sg = 0; sg < nseg; ++sg) {
        const int idx = sg * 64 + lane; const unsigned x = (idx < n) ? tk_key(sr[idx < n ? idx : 0]) : 0u;
        const bool gt = x > T, eq = x == T;
        const unsigned long long meq = __ballot(eq);
        const bool take = gt || (eq && (eq_taken + __popcll(meq & lt)) < need_eq);
        const unsigned long long mt = __ballot(take);
        if (take) sel[running + __popcll(mt & lt)] = idx;
        running += __popcll(mt); eq_taken += __popcll(meq);
    }
}
constexpr int TK_CAP = 832;
__device__ __forceinline__ int topk_row(Frame& F, const int row, LAS int* sel, LAS unsigned long long* cand) {
    const int lane = F.lane;
    const float* SC = WSP(float, WS_BIG);
    {
        const int pos = row & (SEQ - 1), n = pos + 1;
        if (n <= 256) {
#pragma unroll
            for (int i = 0; i < 4; ++i) { const int j = 64 * i + lane; sel[j] = (j < n) ? j : 0; }
            return n;
        }
        const int nblk = (n + 1023) >> 10;
        const float* sr = SC + (size_t)row * 8192;
        int lane_l = lane; asm volatile("" : "+v"(lane_l));
        unsigned u[128];
#pragma unroll
        for (int i = 0; i < 64; ++i) u[i] = __float_as_uint((sr + (i >> 4) * 1024)[(i & 15) * 64 + lane_l]);
        if (nblk > 4) {
#pragma unroll
            for (int i = 64; i < 128; ++i) u[i] = __float_as_uint((sr + (i >> 4) * 1024)[(i & 15) * 64 + lane_l]);
        } else {
#pragma unroll
            for (int i = 64; i < 128; ++i) u[i] = 0u;
        }
        asm volatile("" ::: "memory");
#pragma unroll
        for (int i = 0; i < 128; ++i) { const int lim = n - i * 64; const unsigned bits = u[i];
            const unsigned x = (bits & 0x80000000u) ? ~bits : (bits | 0x80000000u);
            u[i] = (lane < lim) ? x : 0u; }
        const unsigned long long ltmask_s = (1ull << lane) - 1ull;
        bool done = false;
        {
            int ns = 0;
#pragma unroll
            for (int k = 0; k < 16; ++k) { int v = n - 512 * k; v = v < 0 ? 0 : (v > 64 ? 64 : v); ns += v; }
            const float mean = 256.0f * (float)ns / (float)n;
            const int rs = (int)(mean + 4.0f * sqrtf(mean) + 5.0f);
            unsigned Ts = 0u;
            for (int bit = 31; bit >= 16; --bit) {
                const unsigned cnd = Ts | (1u << bit); unsigned long long m0[8], m1[8];
                mask_ge8(m0, u[0], u[8], u[16], u[24], u[32], u[40], u[48], u[56], cnd); mask_ge8(m1, u[64], u[72], u[80], u[88], u[96], u[104], u[112], u[120], cnd);
                int c = 0;
#pragma unroll
                for (int i = 0; i < 8; ++i) c += __popcll(m0[i]) + __popcll(m1[i]);
                if (c >= rs) Ts = cnd;
            }
            if (Ts == 0u) Ts = 1u;
            int nc = 0;
#pragma unroll
            for (int bk = 0; bk < 8; ++bk) {
                if (bk < nblk) {
#pragma unroll
                    for (int g8 = 0; g8 < 2; ++g8) {
                        unsigned long long mg[8]; const int b0 = bk * 16 + g8 * 8;
                        mask_ge8(mg, u[b0], u[b0 + 1], u[b0 + 2], u[b0 + 3], u[b0 + 4], u[b0 + 5], u[b0 + 6], u[b0 + 7], Ts);
#pragma unroll
                        for (int i = 0; i < 8; ++i) {
                            const unsigned long long mt = mg[i];
                            if (mt != 0ull) {
                                const int off = nc + __popcll(mt & ltmask_s);
                                if (((mt >> lane) & 1ull) && off < TK_CAP) cand[off] = ((unsigned long long)u[b0 + i] << 32) | (unsigned)((b0 + i) * 64 + lane_l);
                                nc += __popcll(mt);
                            }
                        }
                    }
                }
            }
            if (nc >= 256 && nc <= TK_CAP) {
                unsigned ck[16]; int ci[13];
#pragma unroll
                for (int t = 0; t < 13; ++t) { const int j = lane + 64 * t; const unsigned long long e = (j < nc) ? cand[j] : 0ull; ck[t] = (unsigned)(e >> 32); ci[t] = (int)(unsigned)e; }
                ck[13] = 0u; ck[14] = 0u; ck[15] = 0u;
                unsigned T = 0u;
                for (int bit = 31; bit >= 0; --bit) {
                    const unsigned cnd = T | (1u << bit); unsigned long long m0[8], m1[8];
                    mask_ge8(m0, ck[0], ck[1], ck[2], ck[3], ck[4], ck[5], ck[6], ck[7], cnd); mask_ge8(m1, ck[8], ck[9], ck[10], ck[11], ck[12], ck[13], ck[14], ck[15], cnd);
                    int c = 0;
#pragma unroll
                    for (int i = 0; i < 8; ++i) c += __popcll(m0[i]) + __popcll(m1[i]);
                    if (c >= 256) T = cnd;
                }
                unsigned long long g0[8], g1[8], h0[8], h1[8];
                mask_ge8(g0, ck[0], ck[1], ck[2], ck[3], ck[4], ck[5], ck[6], ck[7], T); mask_ge8(g1, ck[8], ck[9], ck[10], ck[11], ck[12], ck[13], ck[14], ck[15], T);
                mask_ge8(h0, ck[0], ck[1], ck[2], ck[3], ck[4], ck[5], ck[6], ck[7], T + 1u); mask_ge8(h1, ck[8], ck[9], ck[10], ck[11], ck[12], ck[13], ck[14], ck[15], T + 1u);
                int cgt = 0;
#pragma unroll
                for (int t = 0; t < 13; ++t) cgt += __popcll(t < 8 ? h0[t & 7] : h1[t & 7]);
                const int need_eq = 256 - cgt;
                int running = 0, eq_taken = 0;
#pragma unroll
                for (int t = 0; t < 13; ++t) {
                    const unsigned long long mge = (t < 8 ? g0[t & 7] : g1[t & 7]), mgt = (t < 8 ? h0[t & 7] : h1[t & 7]);
                    unsigned long long mt = mge; const unsigned long long me = mge & ~mgt;
                    if (me != 0ull) {
                        const int room = need_eq - eq_taken; unsigned long long keep = 0ull, rest = me;
                        for (int k = 0; k < room && rest != 0ull; ++k) { const unsigned long long low = rest & (~rest + 1ull); keep |= low; rest ^= low; }
                        mt = (mge & ~me) | keep; eq_taken += __popcll(me);
                    }
                    if (mt != 0ull) { if ((mt >> lane) & 1ull) sel[running + __popcll(mt & ltmask_s)] = ci[t]; running += __popcll(mt); }
                }
                done = true;
            }
        }
        if (!done) topk_row_slow(sr, n, lane, sel);
    }
    return 256;
}

__device__ __forceinline__ void p6_gdn_out(Frame& F, KArgs A) {
    const int lane = F.lane, gw = F.bid * NWAVES + F.wave, NGW = F.G * NWAVES;
    const f32x4 g0 = *(const f32x4*)(A->in[I_AB_ONG] + 8 * (lane & 15)), g1 = *(const f32x4*)(A->in[I_AB_ONG] + 8 * (lane & 15) + 4);
    for (int row = gw; row < M; row += NGW) {
        const float* op = WSP(float, WS_ODELTA) + (size_t)row * 512 + 8 * lane;
        const f32x4 a = *(const f32x4*)op, b = *(const f32x4*)(op + 4);
        float ss = a[0] * a[0] + a[1] * a[1] + a[2] * a[2] + a[3] * a[3] + b[0] * b[0] + b[1] * b[1] + b[2] * b[2] + b[3] * b[3];
        ss += __shfl_xor(ss, 1); ss += __shfl_xor(ss, 2); ss += __shfl_xor(ss, 4); ss += __shfl_xor(ss, 8);
        const float r = rsqrtf(ss * (1.0f / 128.0f) + 1e-6f);
        float z[8]; unpack8(*(const v4u*)(WSP(bf16, WS_QKVZ) + (size_t)row * 2048 + 1536 + 8 * lane), z);
        float o[8];
#pragma unroll
        for (int i = 0; i < 4; ++i) { o[i] = a[i] * r * g0[i] * siluf(z[i]); o[4 + i] = b[i] * r * g1[i] * siluf(z[4 + i]); }
        *(v4u*)(WSP(bf16, WS_AO) + (size_t)row * 1536 + 1024 + 8 * lane) = pack8f(o);
    }
}

__device__ __forceinline__ void p8_ln_router(Frame& F, KArgs A, int l, float* HOUT, bf16* HB) {
    const int lane = F.lane, tid = F.tid, gw = F.bid * NWAVES + F.wave, NGW = F.G * NWAVES;
    LAS float* wT = (LAS float*)(F.lds);
    LAS float* lg = (LAS float*)(F.lds + WSCR_OFF + F.wave * WSCR_BYTES);
    const float* rw = A->in[I_RW] + (size_t)l * 1024 * 32;
    {
        f32x4 wv[16];
#pragma unroll
        for (int j = 0; j < 16; ++j) wv[j] = *(const f32x4*)(rw + (size_t)(tid + NTHREADS * j) * 4);
#pragma unroll
        for (int j = 0; j < 16; ++j) { const int i4 = tid + NTHREADS * j, k = i4 >> 3, e0 = (i4 & 7) * 4;
            wT[(e0 + 0) * 1028 + k] = wv[j][0]; wT[(e0 + 1) * 1028 + k] = wv[j][1]; wT[(e0 + 2) * 1028 + k] = wv[j][2]; wT[(e0 + 3) * 1028 + k] = wv[j][3]; }
    }
    __syncthreads();
    const float* PRE = WSP(float, WS_PRE);
    const float* lg_g = A->in[I_LNM_G] + (size_t)l * 1024; const float* lg_b = A->in[I_LNM_B] + (size_t)l * 1024;
    const float rb = A->in[I_RB][l * 32 + (lane & 31)];
    int* TOKE = WSP(int, WS_ROUTE); int* TOKPOS = TOKE + M * 4; float* TOKG = (float*)(TOKPOS + M * 4);
    gu32* cnt = F.ctl + CW_CNT + 64 * 32 * l;
    LAS int* lcnt = (LAS int*)(F.lds + MISC_OFF + 512);
    LAS int* lbase = lcnt + 32;
    LAS int* myrt = (LAS int*)(F.lds + WSCR_OFF + F.wave * WSCR_BYTES + 128);
    if (tid < 32) lcnt[tid] = 0;
    __syncthreads();
    int nrow = 0;
    f32x4 lng[4], lnb[4];
#pragma unroll
    for (int j = 0; j < 4; ++j) { lng[j] = *(const f32x4*)(lg_g + 256 * j + 4 * lane); lnb[j] = *(const f32x4*)(lg_b + 256 * j + 4 * lane); }
    for (int row = gw; row < M; row += NGW) {
        f32x4 v[4]; float s = 0.f;
#pragma unroll
        for (int j = 0; j < 4; ++j) { v[j] = *(const f32x4*)(PRE + (size_t)row * 1024 + 256 * j + 4 * lane); s += (v[j][0] + v[j][1]) + (v[j][2] + v[j][3]); }
        const float mean = wave_sum(s) * (1.0f / 1024.0f); float s2 = 0.f;
#pragma unroll
        for (int j = 0; j < 4; ++j) { v[j] = v[j] - mean; s2 += (v[j][0] * v[j][0] + v[j][1] * v[j][1]) + (v[j][2] * v[j][2] + v[j][3] * v[j][3]); }
        const float rstd = rsqrtf(wave_sum(s2) * (1.0f / 1024.0f) + 1e-5f);
#pragma unroll
        for (int j = 0; j < 4; ++j) {
            v[j] = v[j] * rstd * lng[j] + lnb[j];
            *(f32x4*)(HOUT + (size_t)row * 1024 + 256 * j + 4 * lane) = v[j];
            v2u o; o.x = pk2(v[j][0], v[j][1]); o.y = pk2(v[j][2], v[j][3]); *(v2u*)(HB + (size_t)row * 1024 + 256 * j + 4 * lane) = o;
        }
        float part[32];
#pragma unroll
        for (int e = 0; e < 32; ++e) {
            float a = 0.f;
#pragma unroll
            for (int j = 0; j < 4; ++j) { const f32x4 w = *(const LAS f32x4*)(wT + e * 1028 + 256 * j + 4 * lane); a += v[j][0] * w[0] + v[j][1] * w[1] + v[j][2] * w[2] + v[j][3] * w[3]; }
            part[e] = a;
        }
#pragma unroll
        for (int i = 0; i < 16; ++i) { const bool up = (lane & 32) != 0; const float keep = up ? part[i + 16] : part[i], send = up ? part[i] : part[i + 16]; part[i] = keep + __shfl_xor(send, 32); }
#pragma unroll
        for (int i = 0; i < 8; ++i) { const bool up = (lane & 16) != 0; const float keep = up ? part[i + 8] : part[i], send = up ? part[i] : part[i + 8]; part[i] = keep + __shfl_xor(send, 16); }
#pragma unroll
        for (int i = 0; i < 4; ++i) { const bool up = (lane & 8) != 0; const float keep = up ? part[i + 4] : part[i], send = up ? part[i] : part[i + 4]; part[i] = keep + __shfl_xor(send, 8); }
#pragma unroll
        for (int i = 0; i < 2; ++i) { const bool up = (lane & 4) != 0; const float keep = up ? part[i + 2] : part[i], send = up ? part[i] : part[i + 2]; part[i] = keep + __shfl_xor(send, 4); }
        { const bool up = (lane & 2) != 0; const float keep = up ? part[1] : part[0], send = up ? part[0] : part[1]; part[0] = keep + __shfl_xor(send, 2); }
        part[0] += __shfl_xor(part[0], 1);
        const int eidx = ((lane >> 5) & 1) * 16 + ((lane >> 4) & 1) * 8 + ((lane >> 3) & 1) * 4 + ((lane >> 2) & 1) * 2 + ((lane >> 1) & 1);
        if ((lane & 1) == 0) lg[eidx] = part[0];
        float val = (lane < 32) ? lg[lane & 31] + rb : -INFINITY;
        float tl[4]; int te[4];
#pragma unroll
        for (int k = 0; k < 4; ++k) {
            const float mx = wave_max(val);
            const unsigned long long mm = __ballot(val == mx && lane < 32);
            const int idx = __ffsll((long long)mm) - 1;
            tl[k] = mx; te[k] = idx;
            if (lane == idx) val = -INFINITY;
        }
        const float e1 = __expf(tl[1] - tl[0]), e2 = __expf(tl[2] - tl[0]), e3 = __expf(tl[3] - tl[0]);
        const float inv = 1.0f / (1.0f + e1 + e2 + e3);
        if (lane < 4) {
            const int e = lane == 0 ? te[0] : (lane == 1 ? te[1] : (lane == 2 ? te[2] : te[3]));
            const float g = (lane == 0 ? 1.0f : (lane == 1 ? e1 : (lane == 2 ? e2 : e3))) * inv;
            const int lp = __hip_atomic_fetch_add(lcnt + e, 1, __ATOMIC_RELAXED, __HIP_MEMORY_SCOPE_WORKGROUP);
            LAS int* rt = myrt + (nrow * 4 + lane) * 3; rt[0] = e; rt[1] = lp; rt[2] = __float_as_int(g);
        }
        ++nrow;
    }
    __syncthreads();
    if (tid < 32) lbase[tid] = (int)__hip_atomic_fetch_add(cnt + 64 * tid, (unsigned)lcnt[tid], RLX_AGENT);
    __syncthreads();
    if (lane < 4) {
        int j = 0;
        for (int row = gw; row < M; row += NGW, ++j) {
            const LAS int* rt = myrt + (j * 4 + lane) * 3; const int e = rt[0];
            TOKE[(size_t)row * 4 + lane] = e; TOKPOS[(size_t)row * 4 + lane] = lbase[e] + rt[1]; TOKG[(size_t)row * 4 + lane] = __int_as_float(rt[2]);
        }
    }
}

__device__ __forceinline__ void p9_scatter(Frame& F, int l, const bf16* HB, const float* HF) {
    const int lane = F.lane, tid = F.tid, gw = F.bid * NWAVES + F.wave, NGW = F.G * NWAVES;
    LAS int* base = (LAS int*)(F.lds + MISC_OFF + 256);
    int* TOKE = WSP(int, WS_ROUTE); int* TOKPOS = TOKE + M * 4; int* TILE = TOKE + 3 * M * 4;
    if (tid < 32) base[tid] = (int)__hip_atomic_load(F.ctl + CW_CNT + 64 * (32 * l + tid), RLX_AGENT);
    __syncthreads();
    if (tid == 0) {
        int acc = 0;
        for (int e = 0; e < NEXP; ++e) { const int c = base[e]; base[e] = acc; acc += ((c + 255) >> 8) << 8; }
        base[32] = acc >> 8;
    }
    __syncthreads();
    if (F.bid == 0 && tid < 64) {
        const int nT = base[32];
        for (int t = tid; t < NTMAX; t += 64) { int e = 0;
            for (int x = 1; x < NEXP; ++x) if (base[x] <= t * 256) e = x;
            TILE[t] = (t < nT) ? e : 0; }
        if (tid == 0) TILE[NTMAX] = nT;
    }
    bf16* XS = WSP(bf16, WS_XS);
    if (kMoeFp8) {
        unsigned char* XB8 = WSP(unsigned char, WS_XS);
        for (int row = gw; row < M; row += NGW) {
            const float* hp = HF + (size_t)row * 1024 + 16 * lane; v4u o;
#pragma unroll
            for (int q = 0; q < 4; ++q) { const f32x4 v = *(const f32x4*)(hp + 4 * q); unsigned w = 0u; w = __builtin_amdgcn_cvt_pk_fp8_f32(v[0], v[1], w, false); w = __builtin_amdgcn_cvt_pk_fp8_f32(v[2], v[3], w, true); o[q] = w; }
#pragma unroll
            for (int k = 0; k < 4; ++k) { const int slot = base[TOKE[(size_t)row * 4 + k]] + TOKPOS[(size_t)row * 4 + k]; *(v4u*)(XB8 + (size_t)slot * 1024 + 16 * lane) = o; }
        }
        return;
    }
    for (int row = gw; row < M; row += NGW) {
        const v4u a = *(const v4u*)(HB + (size_t)row * 1024 + 8 * lane), b = *(const v4u*)(HB + (size_t)row * 1024 + 512 + 8 * lane);
#pragma unroll
        for (int k = 0; k < 4; ++k) {
            const int slot = base[TOKE[(size_t)row * 4 + k]] + TOKPOS[(size_t)row * 4 + k];
            *(v4u*)(XS + (size_t)slot * 1024 + 8 * lane) = a; *(v4u*)(XS + (size_t)slot * 1024 + 512 + 8 * lane) = b;
        }
    }
}

__device__ __forceinline__ void p12_combine(Frame& F, KArgs A, int l, const float* HIN, float* HOUT, bf16* HB) {
    const int lane = F.lane, tid = F.tid, gw = F.bid * NWAVES + F.wave, NGW = F.G * NWAVES;
    LAS int* base = (LAS int*)(F.lds + MISC_OFF + 256);
    if (tid < 32) base[tid] = (int)__hip_atomic_load(F.ctl + CW_CNT + 64 * (32 * l + tid), RLX_AGENT);
    __syncthreads();
    if (tid == 0) { int acc = 0; for (int e = 0; e < NEXP; ++e) { const int c = base[e]; base[e] = acc; acc += ((c + 255) >> 8) << 8; } }
    __syncthreads();
    const int* TOKE = WSP(int, WS_ROUTE); const int* TOKPOS = TOKE + M * 4; const float* TOKG = (const float*)(TOKPOS + M * 4);
    const bf16* YS = WSP(bf16, WS_YS); const bf16* PLE = WSP(bf16, WS_PLE);
    const float* lg_g = A->in[I_LNF_G] + (size_t)l * 1024; const float* lg_b = A->in[I_LNF_B] + (size_t)l * 1024;
    f32x4 lng[2][2], lnb[2][2];
#pragma unroll
    for (int hf = 0; hf < 2; ++hf) { const int c0 = 512 * hf + 8 * lane; lng[hf][0] = *(const f32x4*)(lg_g + c0); lng[hf][1] = *(const f32x4*)(lg_g + c0 + 4); lnb[hf][0] = *(const f32x4*)(lg_b + c0); lnb[hf][1] = *(const f32x4*)(lg_b + c0 + 4); }
    for (int row = gw; row < M; row += NGW) {
        float x[16];
        {   const f32x4 h0 = *(const f32x4*)(HIN + (size_t)row * 1024 + 8 * lane), h1 = *(const f32x4*)(HIN + (size_t)row * 1024 + 8 * lane + 4);
            const f32x4 h2 = *(const f32x4*)(HIN + (size_t)row * 1024 + 512 + 8 * lane), h3 = *(const f32x4*)(HIN + (size_t)row * 1024 + 512 + 8 * lane + 4);
            float p0[8], p1[8]; unpack8(*(const v4u*)(PLE + (size_t)row * 1024 + 8 * lane), p0); unpack8(*(const v4u*)(PLE + (size_t)row * 1024 + 512 + 8 * lane), p1);
#pragma unroll
            for (int i = 0; i < 4; ++i) { x[i] = ALPHA * h0[i] + p0[i]; x[4 + i] = ALPHA * h1[i] + p0[4 + i]; x[8 + i] = ALPHA * h2[i] + p1[i]; x[12 + i] = ALPHA * h3[i] + p1[4 + i]; }
        }
#pragma unroll
        for (int k = 0; k < 4; ++k) {
            const int slot = base[TOKE[(size_t)row * 4 + k]] + TOKPOS[(size_t)row * 4 + k]; const float g = TOKG[(size_t)row * 4 + k];
            float y0[8], y1[8]; unpack8(*(const v4u*)(YS + (size_t)slot * 1024 + 8 * lane), y0); unpack8(*(const v4u*)(YS + (size_t)slot * 1024 + 512 + 8 * lane), y1);
#pragma unroll
            for (int i = 0; i < 8; ++i) { x[i] += g * y0[i]; x[8 + i] += g * y1[i]; }
        }
        float s = 0.f;
#pragma unroll
        for (int i = 0; i < 16; ++i) s += x[i];
        const float mean = wave_sum(s) * (1.0f / 1024.0f); float s2 = 0.f;
#pragma unroll
        for (int i = 0; i < 16; ++i) { x[i] -= mean; s2 += x[i] * x[i]; }
        const float rstd = rsqrtf(wave_sum(s2) * (1.0f / 1024.0f) + 1e-5f);
#pragma unroll
        for (int hf = 0; hf < 2; ++hf) {
            const int c0 = 512 * hf + 8 * lane;
            const f32x4 g0 = lng[hf][0], g1 = lng[hf][1], b0 = lnb[hf][0], b1 = lnb[hf][1];
            f32x4 o0, o1;
#pragma unroll
            for (int i = 0; i < 4; ++i) { o0[i] = x[8 * hf + i] * rstd * g0[i] + b0[i]; o1[i] = x[8 * hf + 4 + i] * rstd * g1[i] + b1[i]; }
            *(f32x4*)(HOUT + (size_t)row * 1024 + c0) = o0; *(f32x4*)(HOUT + (size_t)row * 1024 + c0 + 4) = o1;
            if (HB) { v4u w; w.x = pk2(o0[0], o0[1]); w.y = pk2(o0[2], o0[3]); w.z = pk2(o1[0], o1[1]); w.w = pk2(o1[2], o1[3]); *(v4u*)(HB + (size_t)row * 1024 + c0) = w; }
        }
    }
}

typedef short v4i16_t __attribute__((ext_vector_type(4)));
__device__ __forceinline__ v4i16_t lds_tr16(LAS unsigned char* p) { return __builtin_amdgcn_ds_read_tr16_b64_v4i16((LAS v4i16_t*)p); }
constexpr int DV_PITCH = 144, DV_BUF = 32 * DV_PITCH;
template <int DL  > __device__ __forceinline__ void dil_branch(const bf16* __restrict__ KV, LAS unsigned char* vbuf, const int s0, const int lane,
                                                                                 const bf16x8 (&qf)[2], f32x4 (&O)[4], float& m_run, float& l_run) {
    constexpr int d = 1 << DL, sigma = 16 >> DL, NS = (129 + 15 * sigma + 31) / 32;
    const int fr = lane & 15, fq = lane >> 4;
    const int c = s0 & (d - 1), n0 = s0 >> DL, kstart = n0 - 128;
    const int dbase = 128 + sigma * fr - 4 * fq;
    const int dmax = n0 + sigma * fr;
#define DIL_POS(n) ({ int _p = c + d * (n); _p = _p < 0 ? 0 : (_p > SEQ - 1 ? SEQ - 1 : _p); _p; })
    bf16x8 kf[2][2]; v4u vr[4];
#pragma unroll
    for (int tl = 0; tl < 2; ++tl) { const bf16* kp = KV + (size_t)DIL_POS(kstart + 16 * tl + fr) * 2560 + 768 + 8 * fq; kf[tl][0] = *(const bf16x8*)kp; kf[tl][1] = *(const bf16x8*)(kp + 32); }
#pragma unroll
    for (int i = 0; i < 4; ++i) vr[i] = *(const v4u*)(KV + (size_t)DIL_POS(kstart + (lane >> 3) + 8 * i) * 2560 + 1536 + 8 * (lane & 7));
#pragma unroll 1
    for (int g = 0; g < NS; ++g) {
        LAS unsigned char* vb = vbuf + (g & 1) * DV_BUF;
#pragma unroll
        for (int i = 0; i < 4; ++i) *(LAS v4u*)(vb + ((lane >> 3) + 8 * i) * DV_PITCH + 16 * (lane & 7)) = vr[i];
        bf16x8 kc[2][2];
#pragma unroll
        for (int tl = 0; tl < 2; ++tl) { kc[tl][0] = kf[tl][0]; kc[tl][1] = kf[tl][1]; }
        if (g + 1 < NS) {
            const int kb = kstart + 32 * (g + 1);
#pragma unroll
            for (int tl = 0; tl < 2; ++tl) { const bf16* kp = KV + (size_t)DIL_POS(kb + 16 * tl + fr) * 2560 + 768 + 8 * fq; kf[tl][0] = *(const bf16x8*)kp; kf[tl][1] = *(const bf16x8*)(kp + 32); }
#pragma unroll
            for (int i = 0; i < 4; ++i) vr[i] = *(const v4u*)(KV + (size_t)DIL_POS(kb + (lane >> 3) + 8 * i) * 2560 + 1536 + 8 * (lane & 7));
        }
        float sv[8];
#pragma unroll
        for (int tl = 0; tl < 2; ++tl) {
            f32x4 cc = __builtin_amdgcn_mfma_f32_16x16x32_bf16(kc[tl][0], qf[0], (f32x4){0.f, 0.f, 0.f, 0.f}, 0, 0, 0);
            cc = __builtin_amdgcn_mfma_f32_16x16x32_bf16(kc[tl][1], qf[1], cc, 0, 0, 0);
#pragma unroll
            for (int j = 0; j < 4; ++j) {
                const int delta = dbase - (32 * g + 16 * tl + j);
                const bool ok = ((unsigned)delta <= 128u) && (delta <= dmax);
                sv[4 * tl + j] = ok ? cc[j] * 0.18033688011112042f : -INFINITY;
            }
        }
        float mx = fmaxf(fmaxf(fmaxf(sv[0], sv[1]), fmaxf(sv[2], sv[3])), fmaxf(fmaxf(sv[4], sv[5]), fmaxf(sv[6], sv[7])));
        mx = fmaxf(mx, __shfl_xor(mx, 16)); mx = fmaxf(mx, __shfl_xor(mx, 32));
        const float m_new = fmaxf(m_run, mx);
        if (!__all(m_new == m_run)) {
            const float alpha = __builtin_amdgcn_exp2f(m_run - m_new);
            l_run *= alpha;
#pragma unroll
            for (int j = 0; j < 4; ++j) { const float aj = __shfl(alpha, 4 * fq + j);
#pragma unroll
                for (int dt = 0; dt < 4; ++dt) O[dt][j] *= aj; }
            m_run = m_new;
        }
        float p[8], ps = 0.f;
#pragma unroll
        for (int e = 0; e < 8; ++e) { p[e] = __builtin_amdgcn_exp2f(sv[e] - m_run); ps += p[e]; }
        l_run += ps;
        v4u pw; pw.x = pg8::cvt_pk_bf16(p[0], p[1]); pw.y = pg8::cvt_pk_bf16(p[2], p[3]); pw.z = pg8::cvt_pk_bf16(p[4], p[5]); pw.w = pg8::cvt_pk_bf16(p[6], p[7]);
        const bf16x8 pf = __builtin_bit_cast(bf16x8, pw);
        LAS unsigned char* tb = vb + (4 * fq + ((lane & 15) >> 2)) * DV_PITCH + 8 * (lane & 3);
#pragma unroll
        for (int dt = 0; dt < 4; ++dt) {
            const v4i16_t lo = lds_tr16(tb + 32 * dt), hi = lds_tr16(tb + 16 * DV_PITCH + 32 * dt);
            bf16x8 vf; vf[0] = lo[0]; vf[1] = lo[1]; vf[2] = lo[2]; vf[3] = lo[3]; vf[4] = hi[0]; vf[5] = hi[1]; vf[6] = hi[2]; vf[7] = hi[3];
            O[dt] = __builtin_amdgcn_mfma_f32_16x16x32_bf16(pf, vf, O[dt], 0, 0, 0);
        }
    }
#undef DIL_POS
}
__device__ __forceinline__ void p14_dilated_mfma(Frame& F) {
    const int lane = F.lane, fr = lane & 15, fq = lane >> 4;
    LAS unsigned char* vbuf = F.lds + F.wave * (2 * DV_BUF);
    const bf16* QK = WSP(bf16, WS_QKVZ); bf16* AO = WSP(bf16, WS_AO);
    for (int u = F.bid; u < 24 * 32 * 2; u += F.G) {
        const int bh = u >> 6, blk = (u >> 1) & 31, o = (u & 1) * 8 + F.wave;
        const int b = bh / 12, hh = bh - b * 12, s0 = 256 * blk + o;
        const bf16* KV = QK + (size_t)b * SEQ * 2560 + hh * 64;
        bf16x8 qf[2];
        { const bf16* qp = KV + (size_t)(s0 + 16 * fr) * 2560 + 8 * fq; qf[0] = *(const bf16x8*)qp; qf[1] = *(const bf16x8*)(qp + 32); }
        f32x4 O[4];
#pragma unroll
        for (int dt = 0; dt < 4; ++dt) O[dt] = (f32x4){0.f, 0.f, 0.f, 0.f};
        float m_run = -1e30f, l_run = 0.f;
        dil_branch<4>(KV, vbuf, s0, lane, qf, O, m_run, l_run);
        dil_branch<2>(KV, vbuf, s0, lane, qf, O, m_run, l_run);
        dil_branch<0>(KV, vbuf, s0, lane, qf, O, m_run, l_run);
        float lt = l_run; lt += __shfl_xor(lt, 16); lt += __shfl_xor(lt, 32);
        const float inv = 1.0f / lt;
#pragma unroll
        for (int j = 0; j < 4; ++j) {
            const float ij = __shfl(inv, 4 * fq + j);
            bf16* op = AO + (size_t)(b * SEQ + s0 + 16 * (4 * fq + j)) * 1024 + hh * 64 + fr;
#pragma unroll
            for (int dt = 0; dt < 4; ++dt) op[16 * dt] = (bf16)f2bf(O[dt][j] * ij);
        }
    }
}
constexpr int SA_PITCH = 272, SA_TILE = 32 * SA_PITCH;
__device__ __forceinline__ void sparse_row(Frame& F, const int row, const int n, const LAS int* sel, LAS unsigned char* tile) {
    const int lane = F.lane, fr = lane & 15, fq = lane >> 4;
    const bf16* QL = WSP(bf16, WS_QL); const bf16* CKV = WSP(bf16, WS_CKV); bf16* AO = WSP(bf16, WS_AO);
    {
        const int b = row >> 13;
        const bf16* kvb = CKV + (size_t)b * SEQ * 128;
        bf16x8 qf[4];
#pragma unroll
        for (int s = 0; s < 4; ++s) { const v4u z = (v4u){0u, 0u, 0u, 0u}; qf[s] = (fr < 8) ? *(const bf16x8*)(QL + (size_t)row * 1536 + fr * 128 + 32 * s + 8 * fq) : __builtin_bit_cast(bf16x8, z); }
        f32x4 O[8];
#pragma unroll
        for (int rt = 0; rt < 8; ++rt) O[rt] = (f32x4){0.f, 0.f, 0.f, 0.f};
        float m_run = -1e30f, l_run = 0.f;
        const int nsteps = (n + 31) >> 5;
        v4u vr[8];
        { const int j = lane & 31; const int kidx = (j < n) ? sel[j] : 0;
#pragma unroll
          for (int i = 0; i < 8; ++i) { const int key = __shfl(kidx, (lane >> 4) + 4 * i); vr[i] = *(const v4u*)(kvb + (size_t)key * 128 + 8 * (lane & 15)); } }
#pragma unroll 1
        for (int g = 0; g < nsteps; ++g) {
#pragma unroll
            for (int i = 0; i < 8; ++i) *(LAS v4u*)(tile + ((lane >> 4) + 4 * i) * SA_PITCH + 16 * (lane & 15)) = vr[i];
            if (g + 1 < nsteps) {
                const int j = 32 * (g + 1) + (lane & 31); const int kidx = (j < n) ? sel[j] : 0;
#pragma unroll
                for (int i = 0; i < 8; ++i) { const int key = __shfl(kidx, (lane >> 4) + 4 * i); vr[i] = *(const v4u*)(kvb + (size_t)key * 128 + 8 * (lane & 15)); }
            }
            float sv[8];
#pragma unroll
            for (int tl = 0; tl < 2; ++tl) {
                f32x4 cc = (f32x4){0.f, 0.f, 0.f, 0.f};
#pragma unroll
                for (int s = 0; s < 4; ++s) { const bf16x8 kf = *(const LAS bf16x8*)(tile + (16 * tl + fr) * SA_PITCH + 64 * s + 16 * fq); cc = __builtin_amdgcn_mfma_f32_16x16x32_bf16(kf, qf[s], cc, 0, 0, 0); }
#pragma unroll
                for (int j = 0; j < 4; ++j) sv[4 * tl + j] = (32 * g + 16 * tl + 4 * fq + j < n) ? cc[j] : -INFINITY;
            }
            float mx = fmaxf(fmaxf(fmaxf(sv[0], sv[1]), fmaxf(sv[2], sv[3])), fmaxf(fmaxf(sv[4], sv[5]), fmaxf(sv[6], sv[7])));
            mx = fmaxf(mx, __shfl_xor(mx, 16)); mx = fmaxf(mx, __shfl_xor(mx, 32));
            const float m_new = fmaxf(m_run, mx);
            if (!__all(m_new == m_run)) {
                const float alpha = __expf(m_run - m_new);
                l_run *= alpha;
#pragma unroll
                for (int j = 0; j < 4; ++j) { const float aj = __shfl(alpha, 4 * fq + j);
#pragma unroll
                    for (int rt = 0; rt < 8; ++rt) O[rt][j] *= aj; }
                m_run = m_new;
            }
            float p[8], ps = 0.f;
#pragma unroll
            for (int e = 0; e < 8; ++e) { p[e] = __expf(sv[e] - m_run); ps += p[e]; }
            l_run += ps;
            v4u pw; pw.x = pg8::cvt_pk_bf16(p[0], p[1]); pw.y = pg8::cvt_pk_bf16(p[2], p[3]); pw.z = pg8::cvt_pk_bf16(p[4], p[5]); pw.w = pg8::cvt_pk_bf16(p[6], p[7]);
            const bf16x8 pf = __builtin_bit_cast(bf16x8, pw);
            LAS unsigned char* tb = tile + (4 * fq + ((lane & 15) >> 2)) * SA_PITCH + 8 * (lane & 3);
#pragma unroll
            for (int rt = 0; rt < 8; ++rt) {
                const v4i16_t lo = lds_tr16(tb + 32 * rt), hi = lds_tr16(tb + 16 * SA_PITCH + 32 * rt);
                bf16x8 vf; vf[0] = lo[0]; vf[1] = lo[1]; vf[2] = lo[2]; vf[3] = lo[3]; vf[4] = hi[0]; vf[5] = hi[1]; vf[6] = hi[2]; vf[7] = hi[3];
                O[rt] = __builtin_amdgcn_mfma_f32_16x16x32_bf16(pf, vf, O[rt], 0, 0, 0);
            }
        }
        float lt = l_run; lt += __shfl_xor(lt, 16); lt += __shfl_xor(lt, 32);
        const float inv = 1.0f / lt;
#pragma unroll
        for (int j = 0; j < 4; ++j) {
            const float ij = __shfl(inv, 4 * fq + j);
            if (fq < 2) { bf16* op = AO + (size_t)row * 1536 + (4 * fq + j) * 128 + fr;
#pragma unroll
                for (int rt = 0; rt < 8; ++rt) op[16 * rt] = (bf16)f2bf(O[rt][j] * ij); }
        }
    }
}
__device__ __forceinline__ void p5_topk_attn(Frame& F, const int gw, const int NGW) {
    LAS int* sel = (LAS int*)(F.lds + F.wave * 16384);
    LAS unsigned char* tile = F.lds + F.wave * 16384 + 1024;
    LAS unsigned long long* cand = (LAS unsigned long long*)(F.lds + F.wave * 16384 + 1024 + SA_TILE);
    static_assert(1024 + SA_TILE + TK_CAP * 8 <= 16384, "per-wave LDS");
    for (int rix = gw; rix < M; rix += NGW) {
        const int row = ((rix & 1) ? (M - 1 - (rix >> 1)) : (rix >> 1));
        const int n = __builtin_amdgcn_readfirstlane(topk_row(F, row, sel, cand));
        sparse_row(F, row, n, sel, tile);
    }
}
constexpr int CP_KV_PITCH = 272;
__device__ __forceinline__ void p3_chunk_prep_mfma(Frame& F, KArgs A) {
    int tid = F.tid; asm volatile("" : "+v"(tid));
    const int lane = tid & 63, wave = __builtin_amdgcn_readfirstlane(tid >> 6), fr = lane & 15, fq = lane >> 4;
    LAS unsigned char* kt = F.lds;
    LAS unsigned char* vt = F.lds + 64 * CP_KV_PITCH;
    LAS float* As = (LAS float*)(F.lds + 2 * 64 * CP_KV_PITCH);
    LAS float* Ts = As + 64 * 65;
    LAS float* gcS = Ts + 64 * 68; LAS float* egS = gcS + 64; LAS float* ekS = egS + 64; LAS float* btS = ekS + 64;
    for (int cidx = F.bid; cidx < 1024; cidx += F.G) {
        const int b = cidx >> 9, h = (cidx >> 7) & 3, n = cidx & 127, row0 = b * SEQ + n * 64;
        unsigned char* blk = F.ws + WS_CHK + (size_t)cidx * CHK_STRIDE;
        const bf16* Qg = WSP(bf16, WS_QN) + (size_t)row0 * 512 + h * 128; const bf16* Kg = WSP(bf16, WS_KN) + (size_t)row0 * 512 + h * 128; const bf16* Vg = WSP(bf16, WS_VN) + (size_t)row0 * 512 + h * 128;
        const int ti = wave >> 1;
        float g_in = 0.f, bt_in = 0.f;
        if (tid < 64) { g_in = WSP(float, WS_GG)[(size_t)(row0 + tid) * 4 + h]; bt_in = WSP(float, WS_BETA)[(size_t)(row0 + tid) * 4 + h]; }
        v4u kc[2], vc[2], qc[2];
#pragma unroll
        for (int i = 0; i < 2; ++i) { const int id = tid + 512 * i, r = id >> 4, c = id & 15; kc[i] = *(const v4u*)(Kg + (size_t)r * 512 + 8 * c); vc[i] = *(const v4u*)(Vg + (size_t)r * 512 + 8 * c); qc[i] = *(const v4u*)(Qg + (size_t)r * 512 + 8 * c); }
        bf16x8 ka[4], qa[4], kbf[2][4];
#pragma unroll
        for (int s = 0; s < 4; ++s) { ka[s] = *(const bf16x8*)(Kg + (size_t)(16 * ti + fr) * 512 + 32 * s + 8 * fq); qa[s] = *(const bf16x8*)(Qg + (size_t)(16 * ti + fr) * 512 + 32 * s + 8 * fq);
            kbf[0][s] = *(const bf16x8*)(Kg + (size_t)(16 * (2 * (wave & 1)) + fr) * 512 + 32 * s + 8 * fq); kbf[1][s] = *(const bf16x8*)(Kg + (size_t)(16 * (2 * (wave & 1) + 1) + fr) * 512 + 32 * s + 8 * fq); }
        if (tid < 64) {
            float gc = g_in;
#pragma unroll
            for (int o = 1; o < 64; o <<= 1) { const float t = __shfl_up(gc, o); if (lane >= o) gc += t; }
            const float g63 = __shfl(gc, 63);
            gcS[tid] = gc; egS[tid] = __expf(gc); ekS[tid] = __expf(g63 - gc); btS[tid] = bt_in;
            if (tid == 0) *(float*)(blk + CHK_GL) = __expf(g63);
        }
#pragma unroll
        for (int i = 0; i < 2; ++i) { const int id = tid + 512 * i, r = id >> 4, c = id & 15; *(LAS v4u*)(kt + r * CP_KV_PITCH + 16 * c) = kc[i]; *(LAS v4u*)(vt + r * CP_KV_PITCH + 16 * c) = vc[i]; }
        __syncthreads();
        {
#pragma unroll
            for (int t2 = 0; t2 < 2; ++t2) {
                const int tj = 2 * (wave & 1) + t2;
                f32x4 ck = (f32x4){0.f, 0.f, 0.f, 0.f}, cq = (f32x4){0.f, 0.f, 0.f, 0.f};
#pragma unroll
                for (int s = 0; s < 4; ++s) { ck = __builtin_amdgcn_mfma_f32_16x16x32_bf16(ka[s], kbf[t2][s], ck, 0, 0, 0); cq = __builtin_amdgcn_mfma_f32_16x16x32_bf16(qa[s], kbf[t2][s], cq, 0, 0, 0); }
                const int j = 16 * tj + fr; const float gcj = gcS[j];
                bf16* QKp = (bf16*)(blk + CHK_QK);
#pragma unroll
                for (int jj = 0; jj < 4; ++jj) { const int i = 16 * ti + 4 * fq + jj; const float dec = __expf(j <= i ? gcS[i] - gcj : 0.f);
                    As[i * 65 + j] = (j < i) ? btS[i] * ck[jj] * dec : 0.f;
                    QKp[i * 64 + 32 * (j >> 5) + 8 * ((j >> 2) & 3) + 4 * ((j >> 4) & 1) + (j & 3)] = (bf16)f2bf((j <= i) ? cq[jj] * dec : 0.f); }
            }
        }
        {
#pragma unroll
            for (int x = 0; x < 2; ++x) { const int id = tid + 512 * x, i = id >> 4, d0 = (id & 15) * 8; const float e = egS[i];
                float f[8]; unpack8(qc[x], f);
                bf16* Qd = (bf16*)(blk + CHK_QD) + i * 128 + 32 * (d0 >> 5) + 4 * ((d0 >> 4) & 1);
                const int q0 = (d0 >> 2) & 3;
                v2u w0, w1; w0.x = pk2(f[0] * e, f[1] * e); w0.y = pk2(f[2] * e, f[3] * e); w1.x = pk2(f[4] * e, f[5] * e); w1.y = pk2(f[6] * e, f[7] * e);
                *(v2u*)(Qd + 8 * q0) = w0; *(v2u*)(Qd + 8 * (q0 + 1)) = w1; }
        }
        {
            const int d = tid >> 2, c0 = (tid & 3) * 16, s = c0 >> 5, a = (c0 >> 4) & 1;
            bf16* Kd = (bf16*)(blk + CHK_KDT) + d * 64;
#pragma unroll
            for (int q = 0; q < 4; ++q) { const int c = c0 + 4 * q; float kv[4];
#pragma unroll
                for (int e = 0; e < 4; ++e) kv[e] = bf1(*(const LAS bf16*)(kt + (c + e) * CP_KV_PITCH + 2 * d)) * ekS[c + e];
                v2u w; w.x = pk2(kv[0], kv[1]); w.y = pk2(kv[2], kv[3]); *(v2u*)(Kd + 32 * s + 8 * q + 4 * a) = w; }
        }
        __syncthreads();
        {
            const int c = tid >> 3, part = tid & 7;
            for (int i = 0; i < 64; ++i) {
                float acc = 0.f;
                for (int j = part; j < i; j += 8) acc += As[i * 65 + j] * Ts[j * 68 + c];
                acc += __shfl_xor(acc, 1); acc += __shfl_xor(acc, 2); acc += __shfl_xor(acc, 4);
                if (part == 0) Ts[i * 68 + c] = ((i == c) ? 1.f : 0.f) - acc;
                __builtin_amdgcn_fence(__ATOMIC_RELEASE, "wavefront"); asm volatile("s_waitcnt lgkmcnt(0)" ::: "memory");
            }
        }
        __syncthreads();
        {
            bf16x8 vf[2], kf[2];
            LAS unsigned char* vb = vt + (8 * fq + ((lane & 15) >> 2)) * CP_KV_PITCH + 32 * wave + 8 * (lane & 3);
            LAS unsigned char* kb = kt + (8 * fq + ((lane & 15) >> 2)) * CP_KV_PITCH + 32 * wave + 8 * (lane & 3);
#pragma unroll
            for (int s = 0; s < 2; ++s) {
                const v4i16_t v0 = lds_tr16(vb + (32 * s) * CP_KV_PITCH), v1 = lds_tr16(vb + (32 * s + 4) * CP_KV_PITCH), k0 = lds_tr16(kb + (32 * s) * CP_KV_PITCH), k1 = lds_tr16(kb + (32 * s + 4) * CP_KV_PITCH);
                vf[s][0] = v0[0]; vf[s][1] = v0[1]; vf[s][2] = v0[2]; vf[s][3] = v0[3]; vf[s][4] = v1[0]; vf[s][5] = v1[1]; vf[s][6] = v1[2]; vf[s][7] = v1[3];
                kf[s][0] = k0[0]; kf[s][1] = k0[1]; kf[s][2] = k0[2]; kf[s][3] = k0[3]; kf[s][4] = k1[0]; kf[s][5] = k1[1]; kf[s][6] = k1[2]; kf[s][7] = k1[3];
            }
            float* UT = (float*)(blk + CHK_UT);
            bf16* Wp = (bf16*)(blk + CHK_WP);
#pragma unroll
            for (int ti = 0; ti < 4; ++ti) {
                f32x4 cu = (f32x4){0.f, 0.f, 0.f, 0.f}, cw = (f32x4){0.f, 0.f, 0.f, 0.f};
#pragma unroll
                for (int s = 0; s < 2; ++s) {
                    const LAS float* tr = Ts + (16 * ti + fr) * 68 + 32 * s + 8 * fq;
                    const f32x4 t0 = *(const LAS f32x4*)tr, t1 = *(const LAS f32x4*)(tr + 4);
                    const f32x4 b0 = *(const LAS f32x4*)(btS + 32 * s + 8 * fq), b1 = *(const LAS f32x4*)(btS + 32 * s + 8 * fq + 4), e0 = *(const LAS f32x4*)(egS + 32 * s + 8 * fq), e1 = *(const LAS f32x4*)(egS + 32 * s + 8 * fq + 4);
                    const f32x4 u0 = t0 * b0, u1 = t1 * b1, w0 = u0 * e0, w1 = u1 * e1;
                    cu = __builtin_amdgcn_mfma_f32_16x16x32_bf16(packfrag(u0, u1), vf[s], cu, 0, 0, 0);
                    cw = __builtin_amdgcn_mfma_f32_16x16x32_bf16(packfrag(w0, w1), kf[s], cw, 0, 0, 0);
                }
                *(f32x4*)(UT + (size_t)(16 * wave + fr) * 64 + 16 * ti + 4 * fq) = cu;
#pragma unroll
                for (int jj = 0; jj < 4; ++jj) Wp[(16 * ti + 4 * fq + jj) * 128 + 32 * (wave >> 1) + 8 * (fr >> 2) + 4 * (wave & 1) + (fr & 3)] = (bf16)f2bf(cw[jj]);
            }
        }
        __syncthreads();
    }
}
__device__ __forceinline__ void p14_pool(Frame& F, KArgs A) {
    const int lane = F.lane, tid = F.tid, gw = F.bid * NWAVES + F.wave, NGW = F.G * NWAVES;
    LAS float* pw = (LAS float*)(F.lds + 16384);
    LAS float* dl = (LAS float*)(F.lds + 16384 + 65536 + F.wave * 1024);
    {   f32x4 pv[8];
#pragma unroll
        for (int j = 0; j < 8; ++j) pv[j] = *(const f32x4*)(A->in[I_CD_POOLW] + (size_t)(tid + NTHREADS * j) * 4);
#pragma unroll
        for (int j = 0; j < 8; ++j) *(LAS f32x4*)(pw + (tid + NTHREADS * j) * 4) = pv[j];
    }
    __syncthreads();
    const bf16* QK = WSP(bf16, WS_QKVZ); bf16* AO = WSP(bf16, WS_AO);
    const int gi = lane >> 4, w = 2 << gi;
    float sc[4];
#pragma unroll
    for (int g = 0; g < 4; ++g) sc[g] = A->in[I_CD_POOLS][g * 64 + lane];
    for (int row = gw; row < M; row += NGW) {
        const int pos = row & (SEQ - 1);
        const int cntw = (pos + 1 < w) ? pos + 1 : w;
        float sum[4] = {0.f, 0.f, 0.f, 0.f}, cur[4] = {0.f, 0.f, 0.f, 0.f};
        v2u xw[16];
#pragma unroll
        for (int j = 0; j < 16; ++j) xw[j] = *(const v2u*)(QK + (size_t)(row - (j <= pos ? j : pos)) * 2560 + 2304 + 4 * lane);
#pragma unroll
        for (int j = 0; j < 16; ++j) {
            const float f0 = bflo(xw[j].x), f1 = bfhi(xw[j].x), f2 = bflo(xw[j].y), f3 = bfhi(xw[j].y);
            if (j < cntw) { sum[0] += f0; sum[1] += f1; sum[2] += f2; sum[3] += f3; }
            if (j == 0) { cur[0] = f0; cur[1] = f1; cur[2] = f2; cur[3] = f3; }
        }
        const float inv = 1.0f / (float)cntw;
#pragma unroll
        for (int i = 0; i < 4; ++i) dl[4 * lane + i] = sum[i] * inv - cur[i];
        float o[4] = {0.f, 0.f, 0.f, 0.f};
        for (int c = 0; c < 64; ++c) {
#pragma unroll
            for (int g = 0; g < 4; ++g) o[g] += dl[g * 64 + c] * pw[(g * 64 + c) * 64 + lane];
        }
#pragma unroll
        for (int g = 0; g < 4; ++g) AO[(size_t)row * 1024 + 768 + g * 64 + lane] = (bf16)f2bf(o[g] * sc[g]);
    }
}


#define IN(k) (lo <= (k) && (k) < hi)
#define SEAM(k) do { if (IN(k) && IN((k) + 1)) xcd_barrier(bar); } while (0)
template <int l> __device__ __forceinline__ void layer_tail(Frame& F, const XcdBarrier& bar, const int lo, const int hi) {
    LAS unsigned char* ring = F.lds + RING_OFF;
    const int bid = F.bid, G = F.G;
        const int pb = 8 * l;

        if (IN(7 + pb)) {
            pg8::Gemm g{WSP(bf16, WS_AO), (l == 0) ? WSP(bf16, WS_W_OUTAB) : WSP(bf16, WS_W_OUTCD), M, 1024, (l == 0) ? 1536 : 1024}; pg8::StaticOrder S; S.init(M, 1024, G, bid);
            pg8::Epi<pg8::StPre> E{{(l == 0) ? kargs()->in[I_X] : WSP(float, WS_H2), WSP(float, WS_PRE), ALPHA}};
            pg8::gemm_phase<pg8::Epi<pg8::StPre>, pg8::StaticOrder, true, true>(ring, g, S, E);
        } SEAM(7 + pb);
        if (IN(8 + pb)) { p8_ln_router(F, kargs(), l, WSP(float, WS_H1), WSP(bf16, WS_H1B)); } SEAM(8 + pb);
        if (IN(9 + pb)) {
            p9_scatter(F, l, WSP(bf16, WS_H1B), WSP(float, WS_H1));
            __syncthreads();
            pg8::Gemm g{WSP(bf16, WS_H1B), WSP(bf16, WS_W_PG) + (size_t)l * 1024 * 1024, M, 1024, 1024}; pg8::StaticOrder S; S.init(M, 1024, G, bid);
            pg8::Epi<pg8::StPleGate> E{{WSP(bf16, WS_PP) + (size_t)l * M * 1024, WSP(bf16, WS_PLE)}};
            pg8::gemm_phase<pg8::Epi<pg8::StPleGate>, pg8::StaticOrder, true, true>(ring, g, S, E);
        } SEAM(9 + pb);
        const int* TILE = WSP(int, WS_ROUTE) + 3 * M * 4;
        if (IN(10 + pb)) {
            const int nT = __builtin_amdgcn_readfirstlane(TILE[NTMAX]);
            constexpr int EB = kMoeFp8 ? 1 : 2;
            pg8::Gemm g{WSP(bf16, WS_XS), (const bf16*)(F.ws + WS_W_GU + (size_t)l * NEXP * 2048 * 1024 * EB), PMAX, 2048, 1024 * EB / 2};
            pg8::MoeOrder S{TILE, nT, 8, G, bid, (long)2048 * 1024 * EB};
            pg8::Epi<pg8::StSwiglu<kMoeFp8>> E{{kargs()->in[I_BGU] + (size_t)l * NEXP * 2048, WSP(bf16, WS_HID)}};
            pg8::gemm_phase<pg8::Epi<pg8::StSwiglu<kMoeFp8>>, pg8::MoeOrder, true, false, kMoeFp8 ? kScaleGU : 0u>(ring, g, S, E);
        } SEAM(10 + pb);
        if (IN(11 + pb)) {
            const int nT = __builtin_amdgcn_readfirstlane(TILE[NTMAX]);
            constexpr int EB = kMoeFp8 ? 1 : 2;
            pg8::Gemm g{WSP(bf16, WS_HID), (const bf16*)(F.ws + WS_W_DN + (size_t)l * NEXP * 1024 * 1024 * EB), PMAX, 1024, 1024 * EB / 2};
            pg8::MoeOrder S{TILE, nT, 4, G, bid, (long)1024 * 1024 * EB};
            pg8::Epi<pg8::StDown> E{{kargs()->in[I_BDN] + (size_t)l * NEXP * 1024, WSP(bf16, WS_YS)}};
            pg8::gemm_phase<pg8::Epi<pg8::StDown>, pg8::MoeOrder, true, false, kMoeFp8 ? kScaleDN : 0u>(ring, g, S, E);
        } SEAM(11 + pb);
        if (IN(12 + pb)) { p12_combine(F, kargs(), l, WSP(float, WS_H1), (l == 0) ? WSP(float, WS_H2) : kargs()->out, (l == 0) ? WSP(bf16, WS_XB) : (bf16*)nullptr); }
}
#undef IN
#undef SEAM
__global__ void __launch_bounds__(NTHREADS, 2) mk_fwd(Args args_by_value) {
    const KArgs KA = kargs();
    extern __shared__ __attribute__((aligned(16))) unsigned char lds[];
    Frame F;
    F.lds = (LAS unsigned char*)lds;
    F.tid = threadIdx.x; F.lane = F.tid & 63; F.wave = __builtin_amdgcn_readfirstlane(F.tid >> 6);
    F.G = gridDim.x; F.bid = blockIdx.x; F.ws = KA->ws; F.ctl = (gu32*)(KA->ws + WS_CTL);
    volatile LAS unsigned* MISC = (volatile LAS unsigned*)(F.lds + MISC_OFF);
    { int t0 = threadIdx.x; asm volatile("" : "+v"(t0)); for (int u = t0; u < (LDS_BYTES - MISC_OFF) / 4; u += NTHREADS) MISC[u] = 0u; }
    __syncthreads();
    const bool use_bar = (N_LAUNCHES != NPHASES);
    XcdBarrier bar; bar.bar = (unsigned*)(F.ctl + CW_BAR) + KA->li * XCD_BAR_WORDS; bar.x = 0; bar.st = nullptr; bar.expect = 0;
    XcdBarrier bar2 = bar;
    if (use_bar && F.bid >= SEQ_WGS && F.G > SEQ_WGS) bar2 = xcd_barrier_post((unsigned*)(F.ctl + CW_BAR2), MISC + 10, (unsigned)(F.G - SEQ_WGS));
    if (use_bar) bar = xcd_barrier_post((unsigned*)(F.ctl + CW_BAR) + KA->li * XCD_BAR_WORDS, MISC + 8);
    const int lo = KA->ph_lo, hi = KA->ph_hi;
#define IN(k) (lo <= (k) && (k) < hi)
#define SEAM(k) do { if (IN(k) && IN((k) + 1)) xcd_barrier(bar); } while (0)
    LAS unsigned char* ring = F.lds + RING_OFF;
    const int bid = F.bid, G = F.G;

    if (IN(0)) { p0_prologue(F, kargs()); } SEAM(0);

            if (IN(1)) {
                { pg8::Gemm g{WSP(bf16, WS_XB), WSP(bf16, WS_W_INAB), M, 2560, 1024}; pg8::StaticOrder S; S.init(M, 2560, G, bid);
                  pg8::Epi<pg8::StInAB> E{{WSP(float, WS_SM), WSP(bf16, WS_QKVZ)}};
                  pg8::gemm_phase<pg8::Epi<pg8::StInAB>, pg8::StaticOrder, true, true>(ring, g, S, E); }
                __syncthreads();
                { pg8::Gemm g{WSP(bf16, WS_PB), WSP(bf16, WS_W_PP), 2 * M, 1024, 256}; pg8::BatchOrder S{4, (2 * M / 256) * 4, G, bid, M / 256, (long)1024 * 256 * 2};
                  pg8::Epi<pg8::StBf16> E{{WSP(bf16, WS_PP), 1024}};
                  pg8::gemm_phase<pg8::Epi<pg8::StBf16>, pg8::BatchOrder, true, true>(ring, g, S, E); }
            } SEAM(1);
            if (IN(2)) { p2_prep(F, kargs()); } SEAM(2);
            if (IN(3)) {
                p3_chunk_prep_mfma(F, kargs());
                __syncthreads();
                { pg8::Gemm g{WSP(bf16, WS_CQ), WSP(bf16, WS_W_ABS), M, 1536, 256}; pg8::StaticOrder S; S.init(M, 1536, G, bid);
                  pg8::Epi<pg8::StBf16> E{{WSP(bf16, WS_QL), 1536}};
                  pg8::gemm_phase<pg8::Epi<pg8::StBf16>, pg8::StaticOrder, true, true>(ring, g, S, E); }
            } SEAM(3);
            if (IN(4)) {
                if (bid < SEQ_WGS && G > SEQ_WGS) p4_delta_seq(F, bid);
                else { p4_indexer(F, (bid - SEQ_WGS) * NWAVES + F.wave, (G - SEQ_WGS) * NWAVES);
                    if (use_bar) { xcd_barrier(bar2);
                        p5_topk_attn(F, (bid - SEQ_WGS) * NWAVES + F.wave, (G - SEQ_WGS) * NWAVES); } }
            } SEAM(4);
            if (IN(5)) { if (!use_bar) p5_topk_attn(F, bid * NWAVES + F.wave, G * NWAVES); p6_gdn_out(F, kargs()); } SEAM(5);
    layer_tail<0>(F, bar, lo, hi);
    SEAM(12);
            if (IN(13)) {
                pg8::Gemm g{WSP(bf16, WS_XB), WSP(bf16, WS_W_INCD), M, 2560, 1024}; pg8::StaticOrder S; S.init(M, 2560, G, bid);
                pg8::Epi<pg8::StBf16> E{{WSP(bf16, WS_QKVZ), 2560}};
                pg8::gemm_phase<pg8::Epi<pg8::StBf16>, pg8::StaticOrder, true, true>(ring, g, S, E);
            } SEAM(13);
            if (IN(14)) { p14_dilated_mfma(F); __syncthreads(); p14_pool(F, kargs()); } SEAM(14);
    layer_tail<1>(F, bar, lo, hi);
#undef IN
#undef SEAM
}

extern "C" void kernel_launch(void* const* d_in, const int* in_sizes, int n_in, void* d_out, int out_size, void* d_ws, size_t ws_size, hipStream_t stream) {
    static int grid = 0;
    if (grid == 0) {
        if (n_in != N_IN || in_sizes[0] != M * D || out_size != M * D || ws_size < WS_END) {
            fprintf(stderr, "kernel_launch: built for %d inputs, x/out of %d floats, >= %zu bytes of workspace; got n_in %d, in0 %d, out %d, ws %zu; nothing launched\n", N_IN, M * D, (size_t)WS_END, n_in, n_in > 0 ? in_sizes[0] : -1, out_size, ws_size);
            grid = -1; return; }
        int dev = 0, cus = 0, per_cu = 0;
        if (hipGetDevice(&dev) != hipSuccess || hipDeviceGetAttribute(&cus, hipDeviceAttributeMultiprocessorCount, dev) != hipSuccess) { fprintf(stderr, "kernel_launch: device query failed\n"); grid = -1; return; }
        if (hipFuncSetAttribute((const void*)mk_fwd, hipFuncAttributeMaxDynamicSharedMemorySize, LDS_BYTES) != hipSuccess) { fprintf(stderr, "kernel_launch: hipFuncSetAttribute failed\n"); grid = -1; return; }
        if (hipOccupancyMaxActiveBlocksPerMultiprocessor(&per_cu, (const void*)mk_fwd, NTHREADS, LDS_BYTES) != hipSuccess || per_cu < 1)
            fprintf(stderr, "kernel_launch: note: occupancy query reports %d workgroups per CU\n", per_cu);
        (void)hipGetLastError();
        grid = cus;
    }
    if (grid < 0) return;
    if (hipMemsetAsync((char*)d_ws + WS_CTL, 0, CTL_ZERO_BYTES, stream) != hipSuccess) { fprintf(stderr, "kernel_launch: memset failed\n"); return; }
    Args a{};
    for (int i = 0; i < N_IN; ++i) a.in[i] = (const float*)d_in[i];
    a.out = (float*)d_out; a.ws = (unsigned char*)d_ws;
    for (int li = 0; li < N_LAUNCHES; ++li) {
        if (N_LAUNCHES == NPHASES) { a.ph_lo = li; a.ph_hi = li + 1; } else { a.ph_lo = (int)((long)li * NPHASES / N_LAUNCHES); a.ph_hi = (int)((long)(li + 1) * NPHASES / N_LAUNCHES); }
        a.li = li;
        hipLaunchKernelGGL(mk_fwd, dim3(grid), dim3(NTHREADS), LDS_BYTES, stream, a);
        const hipError_t le = hipPeekAtLastError();
        if (le != hipSuccess) { fprintf(stderr, "kernel_launch: launch %d failed: %s\n", li, hipGetErrorName(le)); break; }
    }
}
```

```cpp
#include <hip/hip_runtime.h>
#include <cstdio>
#include <cstdint>

namespace pg8 {
#define PG8_LAS __attribute__((address_space(3)))
typedef unsigned short bf16_t;
typedef short bf16x8 __attribute__((ext_vector_type(8)));
typedef float f32x4 __attribute__((ext_vector_type(4)));
typedef unsigned u32x4 __attribute__((ext_vector_type(4)));
constexpr int BM = 256, BK = 64, HALF = 128, HTB = HALF * BK * 2  , STAGE_BYTES = 8 * HTB, NXCD = 8, WGM = 8;

__host__ __device__ __forceinline__ int lds_byte(int r, int c) { const int st = (r >> 4) * 2 + (c >> 5), rr = r & 15, cc = c & 31, ob = rr * 64 + cc * 2; return st * 1024 + (ob ^ (((ob >> 9) & 1) << 5)); }
__host__ __device__ __forceinline__ void stage_rc(int b, int& R, int& C) { const int st = b / 1024, sb = b % 1024, swz = sb ^ (((sb >> 9) & 1) << 5); R = (st >> 1) * 16 + swz / 64; C = (st & 1) * 32 + (swz % 64) / 2; }
__host__ __device__ __forceinline__ int perm32(int rho) { const int n = rho >> 4, i = rho & 15; return 8 * (i >> 2) + 4 * n + (i & 3); }

struct Unit { int pm, pn, e; long bofs; };
struct Gemm { const bf16_t* A; const bf16_t* Bt; int M, N, K; };

struct StaticOrder {
    int nM, nN, nwg, G, c;
    __host__ __device__ void init(int M, int N, int G_, int c_) { nM = M / BM; nN = N / BM; nwg = nM * nN; G = G_; c = c_; }
    __host__ __device__ bool next(int i, Unit& u) const {
        const long L = (long)i * G + c; if (L >= nwg) return false;
        int wgid = (int)L; { const int q = nwg / NXCD, r = nwg % NXCD, xcd = wgid % NXCD, off = wgid / NXCD; wgid = (xcd < r ? xcd * (q + 1) : r * (q + 1) + (xcd - r) * q) + off; }
        const int nig = WGM * nN, gid = wgid / nig, fm = gid * WGM, gsz = (nM - fm) < WGM ? (nM - fm) : WGM;
        u.pm = fm + ((wgid % nig) % gsz); u.pn = (wgid % nig) / gsz; u.e = 0; u.bofs = 0; return true;
    }
    __device__ __forceinline__ void a_ready(const Unit&) const {}
    __device__ __forceinline__ void done(const Unit&) const {}
};
struct MoeOrder {
    const int* tile_e; int nT, nN, G, c; long estride;
    __device__ __forceinline__ bool next(int i, Unit& u) const {
        if (G % (8 * nN) == 0) {
            const int rpx = G / (8 * nN), xcd = c & 7, idx = c >> 3;
            u.pm = (i * 8 + xcd) * rpx + idx % rpx; u.pn = idx / rpx;
            if (u.pm >= nT) return false;
        } else {
            const long L = (long)i * G + c; if (L >= (long)nT * nN) return false;
            u.pm = (int)(L / nN); u.pn = (int)(L % nN);
        }
        const int e = tile_e[u.pm]; u.e = e; u.bofs = (long)e * estride; return true;
    }
    __device__ __forceinline__ void a_ready(const Unit&) const {}
    __device__ __forceinline__ void done(const Unit&) const {}
};

struct BatchOrder {
    int nN, nwg, G, c, tiles_per_batch; long bstride;
    __device__ __forceinline__ bool next(int i, Unit& u) const {
        const long L = (long)i * G + c; if (L >= nwg) return false;
        u.pm = (int)(L / nN); u.pn = (int)(L % nN); const int e = u.pm / tiles_per_batch; u.e = e; u.bofs = (long)e * bstride; return true;
    }
    __device__ __forceinline__ void a_ready(const Unit&) const {}
    __device__ __forceinline__ void done(const Unit&) const {}
};

__device__ __forceinline__ unsigned cvt_pk_bf16(float lo, float hi) { unsigned r; asm volatile("v_cvt_pk_bf16_f32 %0, %1, %2" : "=v"(r) : "v"(lo), "v"(hi)); return r; }
__device__ __forceinline__ u32x4 pack8(const f32x4 v0, const f32x4 v1) { u32x4 w; w.x = cvt_pk_bf16(v0[0], v0[1]); w.y = cvt_pk_bf16(v0[2], v0[3]); w.z = cvt_pk_bf16(v1[0], v1[1]); w.w = cvt_pk_bf16(v1[2], v1[3]); return w; }
__device__ __forceinline__ float bf_lo(unsigned w) { return __uint_as_float(w << 16); }
__device__ __forceinline__ float bf_hi(unsigned w) { return __uint_as_float(w & 0xffff0000u); }
__device__ __forceinline__ float sigmoidf_(float x) { return __builtin_amdgcn_rcpf(1.0f + __builtin_amdgcn_exp2f(x * -1.4426950408889634f)); }
typedef unsigned u32x2 __attribute__((ext_vector_type(2)));

template <class T> struct Epi {
    static constexpr bool PERM = true, AFTER_DRAIN = false;
    T t;
    __device__ __forceinline__ void operator()(const f32x4 (&acc)[2][2][4][2], const Unit& u, int wr, int wc, int fr, int fq) const {
        const int row0 = u.pm * BM + wr * 64 + fr, col0 = u.pn * BM + wc * 32 + 8 * fq;
        f32x4 cb[2][2];
#pragma unroll
        for (int bj = 0; bj < 2; ++bj) t.colctx(col0 + bj * HALF, u, cb[bj][0], cb[bj][1]);
        f32x4 rc[2][2], rn[2][2];
#pragma unroll
        for (int bj = 0; bj < 2; ++bj) t.rowctx(row0, col0 + bj * HALF, rc[bj][0], rc[bj][1]);
#pragma unroll
        for (int g = 0; g < 8; ++g) {
            const int ai = g >> 2, m = g & 3, row = row0 + ai * HALF + m * 16;
            if (g < 7) { const int nrow = row0 + ((g + 1) >> 2) * HALF + ((g + 1) & 3) * 16;
#pragma unroll
                for (int bj = 0; bj < 2; ++bj) t.rowctx(nrow, col0 + bj * HALF, rn[bj][0], rn[bj][1]); }
#pragma unroll
            for (int bj = 0; bj < 2; ++bj) t.store(row, col0 + bj * HALF, acc[ai][bj][m][0] + cb[bj][0], acc[ai][bj][m][1] + cb[bj][1], u, rc[bj][0], rc[bj][1]);
            asm volatile("" ::: "memory");
#pragma unroll
            for (int bj = 0; bj < 2; ++bj) { rc[bj][0] = rn[bj][0]; rc[bj][1] = rn[bj][1]; }
        }
    }
};
struct StBf16 { bf16_t* O; int ld;
    __device__ __forceinline__ void rowctx(int, int, f32x4& r0, f32x4& r1) const { r0 = (f32x4){0.f, 0.f, 0.f, 0.f}; r1 = r0; }
    __device__ __forceinline__ void colctx(int, const Unit&, f32x4& c0, f32x4& c1) const { c0 = (f32x4){0.f, 0.f, 0.f, 0.f}; c1 = c0; }
    __device__ __forceinline__ void store(int row, int col, f32x4 v0, f32x4 v1, const Unit&, f32x4, f32x4) const { *(u32x4*)(O + (size_t)row * ld + col) = pack8(v0, v1); } };
struct StInAB { float* SM; bf16_t* Q;
    __device__ __forceinline__ void rowctx(int, int, f32x4& r0, f32x4& r1) const { r0 = (f32x4){0.f, 0.f, 0.f, 0.f}; r1 = r0; }
    __device__ __forceinline__ void colctx(int, const Unit&, f32x4& c0, f32x4& c1) const { c0 = (f32x4){0.f, 0.f, 0.f, 0.f}; c1 = c0; }
    __device__ __forceinline__ void store(int row, int col, f32x4 v0, f32x4 v1, const Unit&, f32x4, f32x4) const {
        if (col < 512) { float* p = SM + (size_t)row * 512 + col; *(f32x4*)p = v0; *(f32x4*)(p + 4) = v1; }
        else *(u32x4*)(Q + (size_t)row * 2048 + (col - 512)) = pack8(v0, v1); } };
struct StPre { const float* base; float* P; float alpha;
    __device__ __forceinline__ void colctx(int, const Unit&, f32x4& c0, f32x4& c1) const { c0 = (f32x4){0.f, 0.f, 0.f, 0.f}; c1 = c0; }
    __device__ __forceinline__ void rowctx(int row, int col, f32x4& r0, f32x4& r1) const { const size_t o = (size_t)row * 1024 + col; r0 = *(const f32x4*)(base + o); r1 = *(const f32x4*)(base + o + 4); }
    __device__ __forceinline__ void store(int row, int col, f32x4 v0, f32x4 v1, const Unit&, f32x4 b0, f32x4 b1) const {
        const size_t o = (size_t)row * 1024 + col;
        *(f32x4*)(P + o) = b0 * alpha + v0; *(f32x4*)(P + o + 4) = b1 * alpha + v1; } };
struct StPleGate { const bf16_t* PP; bf16_t* O;
    __device__ __forceinline__ void colctx(int, const Unit&, f32x4& c0, f32x4& c1) const { c0 = (f32x4){0.f, 0.f, 0.f, 0.f}; c1 = c0; }
    __device__ __forceinline__ void rowctx(int row, int col, f32x4& r0, f32x4& r1) const { r0 = *(const f32x4*)(PP + (size_t)row * 1024 + col); r1 = r0; }
    __device__ __forceinline__ void store(int row, int col, f32x4 v0, f32x4 v1, const Unit&, f32x4 pr, f32x4) const {
        const size_t o = (size_t)row * 1024 + col; const u32x4 p = __builtin_bit_cast(u32x4, pr);
        f32x4 r0, r1;
        r0[0] = sigmoidf_(v0[0]) * bf_lo(p.x); r0[1] = sigmoidf_(v0[1]) * bf_hi(p.x); r0[2] = sigmoidf_(v0[2]) * bf_lo(p.y); r0[3] = sigmoidf_(v0[3]) * bf_hi(p.y);
        r1[0] = sigmoidf_(v1[0]) * bf_lo(p.z); r1[1] = sigmoidf_(v1[1]) * bf_hi(p.z); r1[2] = sigmoidf_(v1[2]) * bf_lo(p.w); r1[3] = sigmoidf_(v1[3]) * bf_hi(p.w);
        *(u32x4*)(O + o) = pack8(r0, r1); } };
template <bool F8> struct StSwiglu { const float* bgu; bf16_t* H;
    __device__ __forceinline__ void rowctx(int, int, f32x4& r0, f32x4& r1) const { r0 = (f32x4){0.f, 0.f, 0.f, 0.f}; r1 = r0; }
    __device__ __forceinline__ float act(float g, float u) const { const float gt = __builtin_amdgcn_fmed3f(g, -INFINITY, 7.0f), up = __builtin_amdgcn_fmed3f(u, -7.0f, 7.0f);
        return (up + 1.0f) * (gt * __builtin_amdgcn_rcpf(1.0f + __builtin_amdgcn_exp2f(gt * -2.4554669595930157f))); }
    __device__ __forceinline__ void colctx(int col, const Unit& u, f32x4& c0, f32x4& c1) const { const float* b = bgu + (size_t)u.e * 2048 + col; c0 = *(const f32x4*)b; c1 = *(const f32x4*)(b + 4); }
    __device__ __forceinline__ void store(int row, int col, f32x4 v0, f32x4 v1, const Unit& u, f32x4, f32x4) const {
        if (F8) { unsigned w = 0u; w = __builtin_amdgcn_cvt_pk_fp8_f32(act(v0[0], v0[1]), act(v0[2], v0[3]), w, false); w = __builtin_amdgcn_cvt_pk_fp8_f32(act(v1[0], v1[1]), act(v1[2], v1[3]), w, true);
            *(unsigned*)((unsigned char*)H + (size_t)row * 1024 + (col >> 1)) = w; }
        else { u32x2 w; w.x = cvt_pk_bf16(act(v0[0], v0[1]), act(v0[2], v0[3])); w.y = cvt_pk_bf16(act(v1[0], v1[1]), act(v1[2], v1[3]));
            *(u32x2*)(H + (size_t)row * 1024 + (col >> 1)) = w; } } };
struct StDown { const float* bd; bf16_t* Y;
    __device__ __forceinline__ void rowctx(int, int, f32x4& r0, f32x4& r1) const { r0 = (f32x4){0.f, 0.f, 0.f, 0.f}; r1 = r0; }
    __device__ __forceinline__ void colctx(int col, const Unit& u, f32x4& c0, f32x4& c1) const { const float* b = bd + (size_t)u.e * 1024 + col; c0 = *(const f32x4*)b; c1 = *(const f32x4*)(b + 4); }
    __device__ __forceinline__ void store(int row, int col, f32x4 v0, f32x4 v1, const Unit& u, f32x4, f32x4) const {
        *(u32x4*)(Y + (size_t)row * 1024 + col) = pack8(v0, v1); } };

typedef int i32x8 __attribute__((ext_vector_type(8)));
typedef int i32x4 __attribute__((ext_vector_type(4)));
template <class Epi, class Sched, bool ALIGN_EPI = false, bool SP2 = false, unsigned FP8W = 0u>
__device__ __forceinline__ void gemm_phase(PG8_LAS unsigned char* lds, const Gemm g, const Sched& S, const Epi& E) {
    int tid = threadIdx.x; asm volatile("" : "+v"(tid));
    const int wid = __builtin_amdgcn_readfirstlane(tid >> 6), lane = tid & 63, wr = wid >> 2, wc = wid & 3, fr = lane & 15, fq = lane >> 4;
    int K = g.K; asm volatile("" : "+s"(K));
    const int nt = K / BK;
    unsigned voffA[2], voffB[2];
#pragma unroll
    for (int i = 0; i < 2; ++i) { int R, C; stage_rc(tid * 16 + i * 8192, R, C); const int Rb = Epi::PERM ? ((R & ~31) + perm32(R & 31)) : R;
        voffA[i] = (unsigned)(R * K + C) * 2u; voffB[i] = (unsigned)(Rb * K + C) * 2u; }
    const size_t kstep = (size_t)(BK * 2);
    const size_t hstep = (size_t)HALF * K * 2;
    const size_t tstep = 2 * hstep;
    const unsigned ldsw = (unsigned)wid * 1024u;
    const int aoff = lds_byte(wr * 64 + fr, fq * 8), boff = lds_byte(wc * 32 + fr, fq * 8);
#define PG8_SA(b, h) (((b) * 2 + (h)) * HTB)
#define PG8_SB(b, h) ((4 + (b) * 2 + (h)) * HTB)
#define PG8_STAGE(bufoff, gbase, voff) do { _Pragma("unroll") for (int _i = 0; _i < 2; ++_i) \
        __builtin_amdgcn_global_load_lds((const unsigned*)((const char*)(gbase) + (voff)[_i]), (PG8_LAS unsigned*)(lds + (bufoff) + ldsw + _i * 8192), 16, 0, 0); } while (0)
#define PG8_CAT(lo, hi) __builtin_shufflevector((lo), (hi), 0, 1, 2, 3, 4, 5, 6, 7)
#define PG8_LDA(dst, b, h) do { if constexpr (FP8W != 0u) { _Pragma("unroll") for (int m = 0; m < 4; ++m) dst##8[m] = PG8_CAT(*(const PG8_LAS i32x4*)(lds + PG8_SA(b, h) + aoff + m * 2048), *(const PG8_LAS i32x4*)(lds + PG8_SA(b, h) + aoff + m * 2048 + 1024)); } \
        else { _Pragma("unroll") for (int m = 0; m < 4; ++m) _Pragma("unroll") for (int k = 0; k < 2; ++k) dst[m][k] = *(const PG8_LAS bf16x8*)(lds + PG8_SA(b, h) + aoff + m * 2048 + k * 1024); } } while (0)
#define PG8_LDB(dst, b, h) do { if constexpr (FP8W != 0u) { _Pragma("unroll") for (int n = 0; n < 2; ++n) dst##8[n] = PG8_CAT(*(const PG8_LAS i32x4*)(lds + PG8_SB(b, h) + boff + n * 2048), *(const PG8_LAS i32x4*)(lds + PG8_SB(b, h) + boff + n * 2048 + 1024)); } \
        else { _Pragma("unroll") for (int n = 0; n < 2; ++n) _Pragma("unroll") for (int k = 0; k < 2; ++k) dst[n][k] = *(const PG8_LAS bf16x8*)(lds + PG8_SB(b, h) + boff + n * 2048 + k * 1024); } } while (0)
#define PG8_MMA(ai, bj, At, Bt) do { __builtin_amdgcn_s_setprio(1); _Pragma("unroll") for (int m = 0; m < 4; ++m) _Pragma("unroll") for (int n = 0; n < 2; ++n) { \
        if constexpr (FP8W != 0u) asm volatile("v_mfma_scale_f32_16x16x128_f8f6f4 %0, %1, %2, %0, %3, %4 op_sel_hi:[0,0,0]" : "+v"(acc[ai][bj][m][n]) : "v"(Bt##8[n]), "v"(At##8[m]), "v"(sc_w), "v"(sc_x));   \
        else { _Pragma("unroll") for (int k = 0; k < 2; ++k) acc[ai][bj][m][n] = __builtin_amdgcn_mfma_f32_16x16x32_bf16(Bt[n][k], At[m][k], acc[ai][bj][m][n], 0, 0, 0); } } __builtin_amdgcn_s_setprio(0); } while (0)
#define PG8_WAIT_V(n) asm volatile("s_waitcnt vmcnt(" #n ")" ::: "memory")
#define PG8_WAIT_L(n) asm volatile("s_waitcnt lgkmcnt(" #n ")" ::: "memory")
#define PG8_BAR __builtin_amdgcn_s_barrier()
#define PG8_SCHED __builtin_amdgcn_sched_barrier(0)
    Unit cur, nxt; int ui = 0;
    if (!S.next(0, cur)) return;
    f32x4 acc[2][2][4][2];
#pragma unroll
    for (int a = 0; a < 2; ++a)
#pragma unroll
        for (int b = 0; b < 2; ++b)
#pragma unroll
            for (int m = 0; m < 4; ++m)
#pragma unroll
                for (int n = 0; n < 2; ++n) acc[a][b][m][n] = (f32x4){0.f, 0.f, 0.f, 0.f};
    bf16x8 At[4][2], B0[2][2], B1[2][2];
    int sc_w = (int)FP8W, sc_x = 0x7f7f7f7f; asm volatile("" : "+v"(sc_w), "+v"(sc_x));
    i32x8 At8[4], B08[2], B18[2];
    const char* cA = (const char*)g.A + (size_t)cur.pm * tstep; const char* cB = (const char*)g.Bt + (size_t)cur.pn * tstep + cur.bofs;
    S.a_ready(cur);
    if constexpr (SP2) {
        PG8_STAGE(PG8_SB(0, 0), cB, voffB); PG8_STAGE(PG8_SB(0, 1), cB + hstep, voffB); PG8_STAGE(PG8_SA(0, 0), cA, voffA); PG8_STAGE(PG8_SA(0, 1), cA + hstep, voffA);
        if (wr == 1) PG8_BAR;
        PG8_WAIT_V(2); PG8_BAR;
        PG8_STAGE(PG8_SB(1, 0), cB + kstep, voffB); PG8_STAGE(PG8_SA(1, 0), cA + kstep, voffA); PG8_STAGE(PG8_SB(1, 1), cB + hstep + kstep, voffB);
        PG8_WAIT_V(6); PG8_BAR;
    } else {
        PG8_STAGE(PG8_SB(0, 0), cB, voffB); PG8_STAGE(PG8_SA(0, 0), cA, voffA); PG8_STAGE(PG8_SB(0, 1), cB + hstep, voffB); PG8_STAGE(PG8_SA(0, 1), cA + hstep, voffA);
        if (wr == 1) PG8_BAR;
        PG8_WAIT_V(4); PG8_BAR;
        PG8_STAGE(PG8_SB(1, 0), cB + kstep, voffB); PG8_STAGE(PG8_SA(1, 0), cA + kstep, voffA); PG8_STAGE(PG8_SB(1, 1), cB + hstep + kstep, voffB);
        PG8_WAIT_V(6); PG8_BAR;
    }
    for (;;) {
        const bool has_next = S.next(ui + 1, nxt);
        const char* nA = has_next ? (const char*)g.A + (size_t)nxt.pm * tstep : cA; const char* nB = has_next ? (const char*)g.Bt + (size_t)nxt.pn * tstep + nxt.bofs : cB;
        for (int t = 0; t < nt; t += 2) {
            const bool last = (t == nt - 2);
            const char* a1 = cA + (size_t)(t + 1) * kstep;
            const char* a2 = last ? nA : cA + (size_t)(t + 2) * kstep; const char* b2 = last ? nB : cB + (size_t)(t + 2) * kstep;
            const char* a3 = a2 + kstep; const char* b3 = b2 + kstep;
            if (last && has_next) S.a_ready(nxt);
            if constexpr (SP2) {
            PG8_LDB(B0, 0, 0); PG8_LDB(B1, 0, 1); PG8_SCHED; PG8_LDA(At, 0, 0); PG8_STAGE(PG8_SA(1, 1), a1 + hstep, voffA);
            PG8_WAIT_V(8); PG8_WAIT_L(0); PG8_BAR; PG8_MMA(0, 0, At, B0); PG8_MMA(0, 1, At, B1); PG8_BAR; PG8_SCHED;
            PG8_LDA(At, 0, 1); PG8_STAGE(PG8_SB(0, 0), b2, voffB); PG8_STAGE(PG8_SB(0, 1), b2 + hstep, voffB); PG8_STAGE(PG8_SA(0, 0), a2, voffA);
            PG8_WAIT_V(8); PG8_WAIT_L(0); PG8_BAR; PG8_MMA(1, 0, At, B0); PG8_MMA(1, 1, At, B1); PG8_BAR; PG8_SCHED;
            PG8_LDB(B0, 1, 0); PG8_LDB(B1, 1, 1); PG8_SCHED; PG8_LDA(At, 1, 0); PG8_STAGE(PG8_SA(0, 1), a2 + hstep, voffA);
            PG8_WAIT_V(8); PG8_WAIT_L(0); PG8_BAR; PG8_MMA(0, 0, At, B0); PG8_MMA(0, 1, At, B1); PG8_BAR; PG8_SCHED;
            PG8_LDA(At, 1, 1); PG8_STAGE(PG8_SB(1, 0), b3, voffB); PG8_STAGE(PG8_SB(1, 1), b3 + hstep, voffB); PG8_STAGE(PG8_SA(1, 0), a3, voffA);
            PG8_WAIT_V(8); PG8_WAIT_L(0); PG8_BAR; PG8_MMA(1, 0, At, B0); PG8_MMA(1, 1, At, B1); PG8_BAR; PG8_SCHED;
            } else {
            PG8_LDB(B0, 0, 0); PG8_SCHED; PG8_LDA(At, 0, 0); PG8_STAGE(PG8_SA(1, 1), a1 + hstep, voffA);
            PG8_WAIT_L(8); PG8_BAR; PG8_WAIT_L(0); PG8_MMA(0, 0, At, B0); PG8_BAR; PG8_SCHED;
            PG8_LDB(B1, 0, 1); PG8_STAGE(PG8_SB(0, 0), b2, voffB);
            PG8_BAR; PG8_WAIT_L(0); PG8_MMA(0, 1, At, B1); PG8_BAR;
            PG8_LDA(At, 0, 1); PG8_STAGE(PG8_SA(0, 0), a2, voffA);
            PG8_BAR; PG8_WAIT_L(0); PG8_MMA(1, 0, At, B0); PG8_BAR; PG8_SCHED;
            PG8_STAGE(PG8_SB(0, 1), b2 + hstep, voffB);
            PG8_WAIT_V(6); PG8_BAR; PG8_MMA(1, 1, At, B1); PG8_BAR;
            PG8_LDB(B0, 1, 0); PG8_SCHED; PG8_LDA(At, 1, 0); PG8_STAGE(PG8_SA(0, 1), a2 + hstep, voffA);
            PG8_WAIT_L(8); PG8_BAR; PG8_WAIT_L(0); PG8_MMA(0, 0, At, B0); PG8_BAR; PG8_SCHED;
            PG8_LDB(B1, 1, 1); PG8_STAGE(PG8_SB(1, 0), b3, voffB);
            PG8_BAR; PG8_WAIT_L(0); PG8_MMA(0, 1, At, B1); PG8_BAR;
            PG8_LDA(At, 1, 1); PG8_STAGE(PG8_SA(1, 0), a3, voffA);
            PG8_BAR; PG8_WAIT_L(0); PG8_MMA(1, 0, At, B0); PG8_BAR; PG8_SCHED;
            PG8_STAGE(PG8_SB(1, 1), b3 + hstep, voffB);
            PG8_WAIT_V(6); PG8_BAR; PG8_MMA(1, 1, At, B1); PG8_BAR;
            }
        }
        if constexpr (FP8W != 0u) asm volatile("s_nop 15\n\ts_nop 15" ::: "memory");
        if constexpr (ALIGN_EPI) { if (wr == 0) PG8_BAR; }
        if constexpr (!Epi::AFTER_DRAIN) { E(acc, cur, wr, wc, fr, fq); S.done(cur); }
        if (!has_next) break;
#pragma unroll
        for (int a = 0; a < 2; ++a)
#pragma unroll
            for (int b = 0; b < 2; ++b)
#pragma unroll
                for (int m = 0; m < 4; ++m)
#pragma unroll
                    for (int n = 0; n < 2; ++n) acc[a][b][m][n] = (f32x4){0.f, 0.f, 0.f, 0.f};
        cur = nxt; cA = nA; cB = nB; ++ui;
        if constexpr (ALIGN_EPI) { if (wr == 1) PG8_BAR; }
    }
    PG8_WAIT_V(0);
    if constexpr (!ALIGN_EPI) { if (wr == 0) PG8_BAR; }
    PG8_BAR;
    if constexpr (Epi::AFTER_DRAIN) { E.fused(acc, cur, wr, wc, fr, fq, lds, wid, lane); S.done(cur); }
#undef PG8_SA
#undef PG8_SB
#undef PG8_STAGE
#undef PG8_LDA
#undef PG8_CAT
#undef PG8_LDB
#undef PG8_MMA
#undef PG8_WAIT_V
#undef PG8_WAIT_L
#undef PG8_BAR
#undef PG8_SCHED
}
}

constexpr int NWAVES = 8, NTHREADS = 512;
constexpr int BATCH = 2, SEQ = 8192, M = BATCH * SEQ, D = 1024;
constexpr int NEXP = 32, DEXP = 1024;
constexpr int PMAX = M * 4 + NEXP * 256, NTMAX = PMAX / 256;
constexpr float ALPHA = 1.41421356237f;
constexpr int NPHASES = 21;
#ifndef MOE_FP8
#define MOE_FP8 1
#endif
constexpr bool kMoeFp8 = (MOE_FP8 != 0);
constexpr unsigned kScaleGU = 0x79797979u, kScaleDN = 0x78787878u;
#ifndef MK_N_LAUNCHES
#define MK_N_LAUNCHES 1
#endif
constexpr int N_LAUNCHES = MK_N_LAUNCHES;

enum { I_X = 0, I_P, I_AB_WIN, I_AB_QG, I_AB_KVG, I_AB_WUQ, I_AB_WUK, I_AB_WUV, I_AB_WQIDX, I_AB_KIG, I_AB_KIB, I_AB_CONVW, I_AB_ALOG, I_AB_DTB, I_AB_ONG, I_AB_WOUT,
       I_CD_WIN, I_CD_POOLW, I_CD_POOLS, I_CD_WOUT, I_LNM_G, I_LNM_B, I_RW, I_RB, I_WGU, I_BGU, I_WDN, I_BDN, I_PLE_WP, I_PLE_WG, I_LNF_G, I_LNF_B, N_IN };

constexpr size_t MiB = 1u << 20;
constexpr size_t WS_CTL = 0, CTL_ZERO_BYTES = 1 * MiB;
constexpr size_t WS_W_INAB = 1 * MiB;
constexpr size_t WS_W_ABS = 6 * MiB;
constexpr size_t WS_W_OUTAB = 7 * MiB;
constexpr size_t WS_W_INCD = 10 * MiB;
constexpr size_t WS_W_OUTCD = 15 * MiB;
constexpr size_t WS_W_PG = 17 * MiB;
constexpr size_t WS_W_PP = 21 * MiB;
constexpr size_t WS_W_GU = 22 * MiB;
constexpr size_t WS_W_DN = 278 * MiB;
constexpr size_t WS_XB = 406 * MiB;
constexpr size_t WS_PB = 438 * MiB;
constexpr size_t WS_PP = 454 * MiB;
constexpr size_t WS_SM = 518 * MiB;
constexpr size_t WS_QKVZ = 550 * MiB;
constexpr size_t WS_CQ = 630 * MiB;
constexpr size_t WS_CKV = 638 * MiB;
constexpr size_t WS_KIDX = 642 * MiB;
constexpr size_t WS_WIDX = 644 * MiB;
constexpr size_t WS_BETA = 645 * MiB;
constexpr size_t WS_GG = WS_BETA + 512 * 1024;
constexpr size_t WS_QN = 646 * MiB, WS_KN = 662 * MiB, WS_VN = 678 * MiB;
constexpr size_t WS_QL = 694 * MiB;
constexpr size_t WS_CHK = 742 * MiB;
constexpr size_t WS_SEL = 838 * MiB;
constexpr size_t WS_NSEL = 854 * MiB;
constexpr size_t WS_ODELTA = 855 * MiB;
constexpr size_t WS_AO = 887 * MiB;
constexpr size_t WS_PRE = 935 * MiB;
constexpr size_t WS_H1 = 999 * MiB;
constexpr size_t WS_H2 = 1063 * MiB;
constexpr size_t WS_H1B = 1127 * MiB;
constexpr size_t WS_PLE = 1159 * MiB;
constexpr size_t WS_ROUTE = 1191 * MiB;
constexpr size_t WS_BIG = 1193 * MiB;
constexpr size_t WS_XS = WS_BIG, WS_HID = WS_BIG + 144 * MiB, WS_YS = WS_BIG + 288 * MiB;
constexpr size_t WS_END = WS_BIG + 512 * MiB;
static_assert((size_t)PMAX * 1024 * 2 <= 144 * MiB && WS_END <= 2048 * MiB, "d_ws map");
constexpr size_t CHK_WP = 0, CHK_QD = 16384, CHK_KDT = 32768, CHK_QK = 49152, CHK_UT = 57344, CHK_GL = 90112, CHK_STRIDE = 92160;
static_assert(CHK_STRIDE * 1024 <= 96 * MiB, "chunk operands");
constexpr int CW_TMO = 0, CW_CODE = 1;
constexpr int CW_BAR = 4096;
constexpr int CW_BAR2 = 8192;
constexpr int CW_CNT = 16384;

constexpr int RING_OFF = 0, RING_BYTES = 131072;
constexpr int WSCR_OFF = 132096, WSCR_BYTES = 1024;
constexpr int MISC_OFF = 140288;
constexpr int LDS_BYTES = 147456;

#define GAS __attribute__((address_space(1)))
#define LAS __attribute__((address_space(3)))
typedef unsigned short bf16;
typedef unsigned v4u __attribute__((ext_vector_type(4)));
typedef unsigned v2u __attribute__((ext_vector_type(2)));
typedef float f32x4 __attribute__((ext_vector_type(4)));
typedef short bf16x8 __attribute__((ext_vector_type(8)));
typedef GAS unsigned gu32;
#define RLX_AGENT __ATOMIC_RELAXED, __HIP_MEMORY_SCOPE_AGENT
__device__ __forceinline__ unsigned f2bf(float f) { unsigned u = __builtin_bit_cast(unsigned, f); return (u + 0x7fffu + ((u >> 16) & 1u)) >> 16; }
__device__ __forceinline__ unsigned pk2(float lo, float hi) { return f2bf(lo) | (f2bf(hi) << 16); }
__device__ __forceinline__ float bflo(unsigned w) { return __uint_as_float(w << 16); }
__device__ __forceinline__ float bfhi(unsigned w) { return __uint_as_float(w & 0xffff0000u); }
__device__ __forceinline__ float bf1(bf16 h) { return __uint_as_float(((unsigned)h) << 16); }
__device__ __forceinline__ float sigm(float x) { return __builtin_amdgcn_rcpf(1.0f + __builtin_amdgcn_exp2f(x * -1.4426950408889634f)); }
__device__ __forceinline__ float siluf(float x) { return x * __builtin_amdgcn_rcpf(1.0f + __builtin_amdgcn_exp2f(x * -1.4426950408889634f)); }
__device__ __forceinline__ float wave_sum(float v) {
#pragma unroll
    for (int o = 1; o < 64; o <<= 1) v += __shfl_xor(v, o);
    return v;
}
__device__ __forceinline__ float wave_max(float v) {
#pragma unroll
    for (int o = 1; o < 64; o <<= 1) v = fmaxf(v, __shfl_xor(v, o));
    return v;
}
__device__ __forceinline__ int wave_sum_i(int v) {
#pragma unroll
    for (int o = 1; o < 64; o <<= 1) v += __shfl_xor(v, o);
    return v;
}
__device__ __forceinline__ void unpack8(const v4u w, float (&f)[8]) { f[0] = bflo(w.x); f[1] = bfhi(w.x); f[2] = bflo(w.y); f[3] = bfhi(w.y); f[4] = bflo(w.z); f[5] = bfhi(w.z); f[6] = bflo(w.w); f[7] = bfhi(w.w); }
__device__ __forceinline__ v4u pack8f(const float (&f)[8]) { v4u w; w.x = pk2(f[0], f[1]); w.y = pk2(f[2], f[3]); w.z = pk2(f[4], f[5]); w.w = pk2(f[6], f[7]); return w; }

#define XB_TMO      128
#define XB_XCNT(j)  (256  + 64 * (j))
#define XB_XSUB(j)  (1280 + 64 * (j))
#define XB_XGEN(j)  (2304 + 64 * (j))
#define XB_TOP      3328
#define XB_TOPGEN   3392
#define XCD_BAR_WORDS 3456
#define XB_SPIN_CAP (1u << 18)

__device__ __forceinline__ unsigned xb_ld(unsigned* p)              { return __hip_atomic_load(p, __ATOMIC_RELAXED, __HIP_MEMORY_SCOPE_AGENT); }
__device__ __forceinline__ unsigned xb_add(unsigned* p, unsigned v) { return __hip_atomic_fetch_add(p, v, __ATOMIC_RELAXED, __HIP_MEMORY_SCOPE_AGENT); }
__device__ __forceinline__ unsigned xb_xcc_id() { return (unsigned)__builtin_amdgcn_s_getreg((3 << 11) | 20) & 0xFu; }
#define XB_SPIN(cond, bar) do { unsigned _sp = 0; while (cond) { __builtin_amdgcn_s_sleep(1); \
    if ((++_sp & 255u) == 0u) { if (xb_ld(&(bar)[XB_TMO])) break; if (_sp > XB_SPIN_CAP) { atomicAdd(&(bar)[XB_TMO], 1u); break; } } } } while (0)

struct XcdBarrier {
    unsigned* bar; unsigned x;
    unsigned expect;
    volatile LAS unsigned* st;
};

__device__ __forceinline__ XcdBarrier xcd_barrier_post(unsigned* bar, volatile LAS unsigned* st, unsigned expect = 0u) {
    XcdBarrier b; b.bar = bar; b.x = xb_xcc_id(); b.st = st; b.expect = expect ? expect : gridDim.x * gridDim.y * gridDim.z;
    if (threadIdx.x == 0) (void)xb_add(&bar[XB_XCNT(b.x)], 1u);
    return b;
}
__device__ __forceinline__ void xcd_barrier_complete(unsigned* bar, unsigned x, unsigned& nloc, unsigned& nx, const unsigned G) {
    unsigned sum, cnt, mine, sp = 0u;
    for (;;) {
        sum = 0u; cnt = 0u; mine = 0u;
#pragma unroll
        for (unsigned j = 0; j < 16; ++j) { const unsigned c = xb_ld(&bar[XB_XCNT(j)]); sum += c; cnt += (c > 0u) ? 1u : 0u; mine = (j == x) ? c : mine; }
        if (sum == G) break;
        __builtin_amdgcn_s_sleep(1);
        if ((++sp & 255u) == 0u) { if (xb_ld(&bar[XB_TMO])) break; if (sp > XB_SPIN_CAP) { atomicAdd(&bar[XB_TMO], 1u); break; } }
    }
    nloc = mine > 0u ? mine : 1u; nx = cnt > 0u ? cnt : 1u;
}

__device__ __forceinline__ void xcd_barrier(const XcdBarrier& b) {
    asm volatile("s_waitcnt vmcnt(0)" ::: "memory");
    __syncthreads();
    if (threadIdx.x == 0) {
        unsigned* bar = b.bar;
        __builtin_amdgcn_s_waitcnt(0);
        unsigned nloc = b.st[0], nx = b.st[1];
        if (nloc == 0u) { xcd_barrier_complete(bar, b.x, nloc, nx, b.expect); b.st[0] = nloc; b.st[1] = nx; }
        const unsigned old = xb_add(&bar[XB_XSUB(b.x)], 1u);
        const unsigned gen = old / nloc;
        if (old + 1u == (gen + 1u) * nloc) {
            __builtin_amdgcn_fence(__ATOMIC_RELEASE, "agent");
            asm volatile("s_waitcnt vmcnt(0)" ::: "memory");
            const unsigned og = xb_add(&bar[XB_TOP], 1u);
            const unsigned tg = og / nx;
            if (og + 1u == (tg + 1u) * nx) xb_add(&bar[XB_TOPGEN], 1u);
            else XB_SPIN(xb_ld(&bar[XB_TOPGEN]) == tg, bar);
            __builtin_amdgcn_fence(__ATOMIC_ACQUIRE, "agent");
            xb_add(&bar[XB_XGEN(b.x)], 1u);
            asm volatile("s_waitcnt vmcnt(0)" ::: "memory");
        } else {
            XB_SPIN(xb_ld(&bar[XB_XGEN(b.x)]) == gen, bar);
            __builtin_amdgcn_fence(__ATOMIC_ACQUIRE, "agent");
            asm volatile("s_waitcnt vmcnt(0)" ::: "memory");
        }
    }
    __syncthreads();
}

struct Args { const float* in[N_IN]; float* out; unsigned char* ws; int ph_lo, ph_hi, li, pad; };
typedef const __attribute__((address_space(4))) Args* KArgs;
__device__ __forceinline__ KArgs kargs() { auto p = __builtin_amdgcn_kernarg_segment_ptr(); asm volatile("" : "+s"(p)); return (KArgs)p; }
struct Frame {
    LAS unsigned char* lds;
    int tid, lane, wave, G, bid;
    unsigned char* ws;
    gu32* ctl;
};
#define WSP(T, off) ((T*)(F.ws + (off)))

struct MapId { __device__ __forceinline__ int operator()(int n) const { return n; } };
struct MapAdd { int off; __device__ __forceinline__ int operator()(int n) const { return n + off; } };
struct MapAB { __device__ __forceinline__ int operator()(int n) const { return n < 456 ? n : (n < 2504 ? n + 56 : n - 2048); } };
template <class Map> __device__ __forceinline__ void wg_transpose_item(const float* W, int N, int ldw, bf16* WT, int ldt, int koff, Map map, LAS float* scr, int item, int tid) {
    const int nblk = (N + 127) >> 7, kb = item / nblk, nb = item - kb * nblk, k0 = kb * 128, n0 = nb * 128;
#pragma unroll
    for (int it = 0; it < 8; ++it) {
        const int row = it * 16 + (tid >> 5), c4 = (tid & 31) * 4, n = n0 + c4;
        f32x4 v = (f32x4){0.f, 0.f, 0.f, 0.f};
        if (n + 3 < N) v = *(const f32x4*)(W + (size_t)(k0 + row) * ldw + n);
        LAS float* s = scr + row * 129 + c4; s[0] = v[0]; s[1] = v[1]; s[2] = v[2]; s[3] = v[3];
    }
    __syncthreads();
#pragma unroll
    for (int j = 0; j < 4; ++j) {
        const int idx = j * 512 + tid, nl = idx >> 4, ch = idx & 15, n = n0 + nl;
        if (n < N) { const LAS float* s = scr + (ch * 8) * 129 + nl;
            v4u o; o.x = pk2(s[0], s[129]); o.y = pk2(s[2 * 129], s[3 * 129]); o.z = pk2(s[4 * 129], s[5 * 129]); o.w = pk2(s[6 * 129], s[7 * 129]);
            *(v4u*)(WT + (size_t)map(n) * ldt + koff + k0 + ch * 8) = o; }
    }
    __syncthreads();
}
__device__ __forceinline__ void wg_transpose_item_fp8(const float* W, int N, int ldw, unsigned char* WT, int ldt, float mul, LAS float* scr, int item, int tid) {
    const int nblk = (N + 127) >> 7, kb = item / nblk, nb = item - kb * nblk, k0 = kb * 128, n0 = nb * 128;
#pragma unroll
    for (int it = 0; it < 8; ++it) {
        const int row = it * 16 + (tid >> 5), c4 = (tid & 31) * 4;
        const f32x4 v = *(const f32x4*)(W + (size_t)(k0 + row) * ldw + n0 + c4);
        LAS float* s = scr + row * 129 + c4; s[0] = v[0]; s[1] = v[1]; s[2] = v[2]; s[3] = v[3];
    }
    __syncthreads();
#pragma unroll
    for (int j = 0; j < 2; ++j) {
        const int idx = j * 512 + tid, nl = idx >> 3, ch = idx & 7;
        const LAS float* s = scr + (ch * 16) * 129 + nl;
        v4u o;
#pragma unroll
        for (int q = 0; q < 4; ++q) { unsigned w = 0u;
            w = __builtin_amdgcn_cvt_pk_fp8_f32(s[(4 * q) * 129] * mul, s[(4 * q + 1) * 129] * mul, w, false);
            w = __builtin_amdgcn_cvt_pk_fp8_f32(s[(4 * q + 2) * 129] * mul, s[(4 * q + 3) * 129] * mul, w, true);
            o[q] = w; }
        *(v4u*)(WT + (size_t)(n0 + nl) * ldt + k0 + ch * 16) = o;
    }
    __syncthreads();
}
struct MoeItem { const float* W; unsigned char* WT; int N; float mul; int k0, n0; };
__device__ __forceinline__ MoeItem moe_item(KArgs A, unsigned char* ws, int it) {
    MoeItem d; int sub;
    if (it < 64 * 128) { const int m = it >> 7; sub = it & 127; d.W = A->in[I_WGU] + (size_t)m * 1024 * 2048; d.N = 2048; d.WT = ws + WS_W_GU + (size_t)m * 2048 * 1024; d.mul = 64.0f; }
    else { it -= 64 * 128; const int m = it >> 6; sub = it & 63; d.W = A->in[I_WDN] + (size_t)m * 1024 * 1024; d.N = 1024; d.WT = ws + WS_W_DN + (size_t)m * 1024 * 1024; d.mul = 128.0f; }
    const int nblk = d.N >> 7, kb = sub / nblk, nb = sub - kb * nblk; d.k0 = kb * 128; d.n0 = nb * 128; return d;
}
__device__ __forceinline__ void p0_moe_fp8(Frame& F, KArgs A) {
    LAS float* scr = (LAS float*)(F.lds + RING_OFF);
    const int tid = F.tid; constexpr int NIT = 64 * 128 + 64 * 64;
    int it = F.bid; if (it >= NIT) return;
    MoeItem cur = moe_item(A, F.ws, it);
    f32x4 r[8];
#pragma unroll
    for (int x = 0; x < 8; ++x) r[x] = __builtin_nontemporal_load((const f32x4*)(cur.W + (size_t)(cur.k0 + x * 16 + (tid >> 5)) * cur.N + cur.n0 + (tid & 31) * 4));
    for (;;) {
#pragma unroll
        for (int x = 0; x < 8; ++x) { LAS float* sp = scr + (x * 16 + (tid >> 5)) * 129 + (tid & 31) * 4; sp[0] = r[x][0]; sp[1] = r[x][1]; sp[2] = r[x][2]; sp[3] = r[x][3]; }
        __syncthreads();
        const int nx = it + F.G; MoeItem nxt = cur;
        if (nx < NIT) { nxt = moe_item(A, F.ws, nx);
#pragma unroll
            for (int x = 0; x < 8; ++x) r[x] = __builtin_nontemporal_load((const f32x4*)(nxt.W + (size_t)(nxt.k0 + x * 16 + (tid >> 5)) * nxt.N + nxt.n0 + (tid & 31) * 4)); }
#pragma unroll
        for (int j = 0; j < 2; ++j) {
            const int idx = j * 512 + tid, nl = idx >> 3, ch = idx & 7;
            const LAS float* sp = scr + (ch * 16) * 129 + nl;
            v4u o;
#pragma unroll
            for (int q = 0; q < 4; ++q) { unsigned w = 0u;
                w = __builtin_amdgcn_cvt_pk_fp8_f32(sp[(4 * q) * 129] * cur.mul, sp[(4 * q + 1) * 129] * cur.mul, w, false);
                w = __builtin_amdgcn_cvt_pk_fp8_f32(sp[(4 * q + 2) * 129] * cur.mul, sp[(4 * q + 3) * 129] * cur.mul, w, true);
                o[q] = w; }
            *(v4u*)(cur.WT + (size_t)(cur.n0 + nl) * 1024 + cur.k0 + ch * 16) = o;
        }
        __syncthreads();
        if (nx >= NIT) break;
        cur = nxt; it = nx;
    }
}
__device__ __forceinline__ void p0_prologue(Frame& F, KArgs A) {
    LAS float* scr = (LAS float*)(F.lds + RING_OFF);
    const int tid = F.tid;
    constexpr int IT_GU = 128, IT_DN = 64;
    constexpr int N_GU = 64 * IT_GU, N_DN = 64 * IT_DN;
    constexpr int N_INAB = 8 * 20, N_INCD = 8 * 20, N_OUTCD = 64, N_PG = 2 * 64, N_PP = 2 * 2 * 8, N_QIDX = 2 * 4, N_OUTB = 4 * 8;
    constexpr int NITEMS = N_GU + N_DN + N_INAB + N_INCD + N_OUTCD + N_PG + N_PP + N_QIDX + N_OUTB;
    if (kMoeFp8) p0_moe_fp8(F, A);
    for (int it = F.bid + (kMoeFp8 ? N_GU + N_DN : 0); it < NITEMS; it += F.G) {
        int r = it;
        if (r < N_GU) { const int m = r / IT_GU;
            if (kMoeFp8) wg_transpose_item_fp8(A->in[I_WGU] + (size_t)m * 1024 * 2048, 2048, 2048, WSP(unsigned char, WS_W_GU) + (size_t)m * 2048 * 1024, 1024, 64.0f, scr, r % IT_GU, tid);
            else wg_transpose_item(A->in[I_WGU] + (size_t)m * 1024 * 2048, 2048, 2048, WSP(bf16, WS_W_GU) + (size_t)m * 2048 * 1024, 1024, 0, MapId{}, scr, r % IT_GU, tid);
            continue; } r -= N_GU;
        if (r < N_DN) { const int m = r / IT_DN;
            if (kMoeFp8) wg_transpose_item_fp8(A->in[I_WDN] + (size_t)m * 1024 * 1024, 1024, 1024, WSP(unsigned char, WS_W_DN) + (size_t)m * 1024 * 1024, 1024, 128.0f, scr, r % IT_DN, tid);
            else wg_transpose_item(A->in[I_WDN] + (size_t)m * 1024 * 1024, 1024, 1024, WSP(bf16, WS_W_DN) + (size_t)m * 1024 * 1024, 1024, 0, MapId{}, scr, r % IT_DN, tid);
            continue; } r -= N_DN;
        if (r < N_INAB) { wg_transpose_item(A->in[I_AB_WIN], 2512, 2512, WSP(bf16, WS_W_INAB), 1024, 0, MapAB{}, scr, r, tid); continue; } r -= N_INAB;
        if (r < N_INCD) { wg_transpose_item(A->in[I_CD_WIN], 2560, 2560, WSP(bf16, WS_W_INCD), 1024, 0, MapId{}, scr, r, tid); continue; } r -= N_INCD;
        if (r < N_OUTCD) { wg_transpose_item(A->in[I_CD_WOUT], 1024, 1024, WSP(bf16, WS_W_OUTCD), 1024, 0, MapId{}, scr, r, tid); continue; } r -= N_OUTCD;
        if (r < N_PG) { const int l = r / 64; wg_transpose_item(A->in[I_PLE_WG] + (size_t)l * 1024 * 1024, 1024, 1024, WSP(bf16, WS_W_PG) + (size_t)l * 1024 * 1024, 1024, 0, MapId{}, scr, r % 64, tid); continue; } r -= N_PG;
        if (r < N_PP) { const int l = r / 16; wg_transpose_item(A->in[I_PLE_WP] + (size_t)l * 256 * 1024, 1024, 1024, WSP(bf16, WS_W_PP) + (size_t)l * 1024 * 256, 256, 0, MapId{}, scr, r % 16, tid); continue; } r -= N_PP;
        if (r < N_QIDX) { wg_transpose_item(A->in[I_AB_WQIDX], 512, 512, WSP(bf16, WS_W_ABS), 256, 0, MapAdd{1024}, scr, r, tid); continue; } r -= N_QIDX;
        wg_transpose_item(A->in[I_AB_WOUT] + (size_t)512 * 1024, 1024, 1024, WSP(bf16, WS_W_OUTAB), 1536, 1024, MapId{}, scr, r, tid);
    }
    const size_t gt = (size_t)F.bid * NTHREADS + tid, GT = (size_t)F.G * NTHREADS;
    for (size_t i = gt; i < (size_t)48 * 1024 / 8; i += GT) *(v4u*)(WSP(bf16, WS_W_INAB) + (size_t)464 * 1024 + i * 8) = (v4u){0u, 0u, 0u, 0u};
    for (size_t i = gt; i < (size_t)1024 * 256; i += GT) {
        const int n = (int)(i >> 8), c = (int)(i & 255), h = n >> 7, r = n & 127;
        const float* a = A->in[I_AB_WUQ] + (size_t)c * 512 + h * 64; const float* b = A->in[I_AB_WUK] + (size_t)r * 512 + h * 64;
        float s = 0.f;
#pragma unroll 8
        for (int d = 0; d < 64; d += 4) { const f32x4 x = *(const f32x4*)(a + d), y = *(const f32x4*)(b + d); s += x[0] * y[0] + x[1] * y[1] + x[2] * y[2] + x[3] * y[3]; }
        WSP(bf16, WS_W_ABS)[i] = (bf16)f2bf(s * 0.125f);
    }
    for (size_t i = gt; i < (size_t)1024 * 128; i += GT) {
        const int n = (int)(i & 1023), k0 = (int)(i >> 10) * 8, h = k0 >> 7, r0 = k0 & 127;
        const float* bcol = A->in[I_AB_WOUT] + (size_t)(h * 64) * 1024 + n;
        float acc[8];
#pragma unroll
        for (int x = 0; x < 8; ++x) acc[x] = 0.f;
#pragma unroll 2
        for (int v0 = 0; v0 < 64; v0 += 8) {
            float bv[8];
#pragma unroll
            for (int v = 0; v < 8; ++v) bv[v] = bcol[(size_t)(v0 + v) * 1024];
#pragma unroll
            for (int x = 0; x < 8; ++x) { const float* ar = A->in[I_AB_WUV] + (size_t)(r0 + x) * 512 + h * 64 + v0; const f32x4 a0 = *(const f32x4*)ar, a1 = *(const f32x4*)(ar + 4);
                acc[x] += a0[0] * bv[0] + a0[1] * bv[1] + a0[2] * bv[2] + a0[3] * bv[3] + a1[0] * bv[4] + a1[1] * bv[5] + a1[2] * bv[6] + a1[3] * bv[7]; }
        }
        *(v4u*)(WSP(bf16, WS_W_OUTAB) + (size_t)n * 1536 + k0) = pack8f(acc);
    }
#pragma unroll 4
    for (size_t i = gt; i < (size_t)M * D / 8; i += GT) { const f32x4 a = __builtin_nontemporal_load((const f32x4*)(A->in[I_X] + i * 8)), b = __builtin_nontemporal_load((const f32x4*)(A->in[I_X] + i * 8 + 4));
        v4u o; o.x = pk2(a[0], a[1]); o.y = pk2(a[2], a[3]); o.z = pk2(b[0], b[1]); o.w = pk2(b[2], b[3]); *(v4u*)(WSP(bf16, WS_XB) + i * 8) = o; }
#pragma unroll 4
    for (size_t i = gt; i < (size_t)2 * M * 256 / 8; i += GT) { const f32x4 a = __builtin_nontemporal_load((const f32x4*)(A->in[I_P] + i * 8)), b = __builtin_nontemporal_load((const f32x4*)(A->in[I_P] + i * 8 + 4));
        v4u o; o.x = pk2(a[0], a[1]); o.y = pk2(a[2], a[3]); o.z = pk2(b[0], b[1]); o.w = pk2(b[2], b[3]); *(v4u*)(WSP(bf16, WS_PB) + i * 8) = o; }
}

__device__ __forceinline__ void p2_prep(Frame& F, KArgs A) {
    const int lane = F.lane, gw = F.bid * NWAVES + F.wave, NGW = F.G * NWAVES;
    const float* SM = WSP(float, WS_SM); const bf16* QZ = WSP(bf16, WS_QKVZ);
    const f32x4 qg = *(const f32x4*)(A->in[I_AB_QG] + 4 * lane);
    const f32x4 kvg = *(const f32x4*)(A->in[I_AB_KVG] + 4 * (lane & 31));
    const f32x4 kig = *(const f32x4*)(A->in[I_AB_KIG] + 4 * (lane & 15)), kib = *(const f32x4*)(A->in[I_AB_KIB] + 4 * (lane & 15));
    const f32x4 alog = *(const f32x4*)(A->in[I_AB_ALOG]), dtb = *(const f32x4*)(A->in[I_AB_DTB]);
    LAS float* cw = (LAS float*)(F.lds);
    {   f32x4 wv[3]; int t0 = F.tid; asm volatile("" : "+v"(t0));
#pragma unroll
        for (int j = 0; j < 3; ++j) wv[j] = *(const f32x4*)(A->in[I_AB_CONVW] + (size_t)(t0 + NTHREADS * j) * 4);
#pragma unroll
        for (int j = 0; j < 3; ++j) *(LAS f32x4*)(cw + (t0 + NTHREADS * j) * 4) = wv[j];
    }
    __syncthreads();
    for (int row = gw; row < M; row += NGW) {
        const int t = row & (SEQ - 1);
        const f32x4 a = *(const f32x4*)(SM + (size_t)row * 512 + 4 * lane), b = *(const f32x4*)(SM + (size_t)row * 512 + 256 + 4 * lane);
        {
            const float ss = wave_sum(a[0] * a[0] + a[1] * a[1] + a[2] * a[2] + a[3] * a[3]);
            const float r = rsqrtf(ss * (1.0f / 256.0f) + 1e-6f);
            v2u o; o.x = pk2(a[0] * r * qg[0], a[1] * r * qg[1]); o.y = pk2(a[2] * r * qg[2], a[3] * r * qg[3]);
            *(v2u*)(WSP(bf16, WS_CQ) + (size_t)row * 256 + 4 * lane) = o;
        }
        {
            const float ss = wave_sum(lane < 32 ? (b[0] * b[0] + b[1] * b[1] + b[2] * b[2] + b[3] * b[3]) : 0.f);
            const float r = rsqrtf(ss * (1.0f / 128.0f) + 1e-6f);
            if (lane < 32) { v2u o; o.x = pk2(b[0] * r * kvg[0], b[1] * r * kvg[1]); o.y = pk2(b[2] * r * kvg[2], b[3] * r * kvg[3]);
                *(v2u*)(WSP(bf16, WS_CKV) + (size_t)row * 128 + 4 * lane) = o; }
        }
        {
            const bool in = (lane >= 32 && lane < 48);
            const float mean = wave_sum(in ? (b[0] + b[1] + b[2] + b[3]) : 0.f) * (1.0f / 64.0f);
            const f32x4 d = b - mean;
            const float var = wave_sum(in ? (d[0] * d[0] + d[1] * d[1] + d[2] * d[2] + d[3] * d[3]) : 0.f) * (1.0f / 64.0f);
            const float r = rsqrtf(var + 1e-5f);
            if (in) { v2u o; o.x = pk2(d[0] * r * kig[0] + kib[0], d[1] * r * kig[1] + kib[1]); o.y = pk2(d[2] * r * kig[2] + kib[2], d[3] * r * kig[3] + kib[3]);
                *(v2u*)(WSP(bf16, WS_KIDX) + (size_t)row * 64 + 4 * (lane - 32)) = o; }
        }
        if (lane == 48 || lane == 49) *(f32x4*)(WSP(float, WS_WIDX) + (size_t)row * 8 + 4 * (lane - 48)) = b * 0.044194173824159216f;
        if (lane == 50) { f32x4 o; o[0] = sigm(b[0]); o[1] = sigm(b[1]); o[2] = sigm(b[2]); o[3] = sigm(b[3]); *(f32x4*)(WSP(float, WS_BETA) + (size_t)row * 4) = o; }
        if (lane == 51) { f32x4 o;
#pragma unroll
            for (int h = 0; h < 4; ++h) { const float xx = b[h] + dtb[h]; const float sp = xx > 20.f ? xx : log1pf(__expf(xx)); o[h] = -__expf(alog[h]) * sp; }
            *(f32x4*)(WSP(float, WS_GG) + (size_t)row * 4) = o; }
        v4u xr[3][4];
#pragma unroll
        for (int sel = 0; sel < 3; ++sel)
#pragma unroll
            for (int j = 0; j < 4; ++j) { const int back = (t - 3 + j >= 0) ? (3 - j) : 0; xr[sel][j] = *(const v4u*)(QZ + (size_t)(row - back) * 2048 + sel * 512 + 8 * lane); }
#pragma unroll
        for (int sel = 0; sel < 3; ++sel) {
            const int col0 = sel * 512 + 8 * lane;
            float acc[8];
#pragma unroll
            for (int i = 0; i < 8; ++i) acc[i] = 0.f;
#pragma unroll
            for (int j = 0; j < 4; ++j) {
                float xv[8]; unpack8(xr[sel][j], xv);
                const f32x4 w0 = *(const LAS f32x4*)(cw + j * 1536 + col0), w1 = *(const LAS f32x4*)(cw + j * 1536 + col0 + 4);
                const float m = (t - 3 + j >= 0) ? 1.f : 0.f;
#pragma unroll
                for (int i = 0; i < 4; ++i) { acc[i] += w0[i] * m * xv[i]; acc[4 + i] += w1[i] * m * xv[4 + i]; }
            }
            float ss = 0.f;
#pragma unroll
            for (int i = 0; i < 8; ++i) { acc[i] = siluf(acc[i]); ss += acc[i] * acc[i]; }
            if (sel < 2) {
                ss += __shfl_xor(ss, 1); ss += __shfl_xor(ss, 2); ss += __shfl_xor(ss, 4); ss += __shfl_xor(ss, 8);
                const float sc = rsqrtf(ss + 1e-6f) * (sel == 0 ? 0.08838834764831845f : 1.0f);
#pragma unroll
                for (int i = 0; i < 8; ++i) acc[i] *= sc;
            }
            bf16* dst = (sel == 0 ? WSP(bf16, WS_QN) : (sel == 1 ? WSP(bf16, WS_KN) : WSP(bf16, WS_VN))) + (size_t)row * 512 + 8 * lane;
            *(v4u*)dst = pack8f(acc);
        }
    }
}

constexpr int SEQ_WGS = 16;
constexpr int SQ_WP = 0, SQ_QD = 16384, SQ_KDT = 32768, SQ_QK = 49152, SQ_BUF = 57344;
__device__ __forceinline__ bf16x8 packfrag(const f32x4 lo, const f32x4 hi) { v4u w; w.x = pg8::cvt_pk_bf16(lo[0], lo[1]); w.y = pg8::cvt_pk_bf16(lo[2], lo[3]); w.z = pg8::cvt_pk_bf16(hi[0], hi[1]); w.w = pg8::cvt_pk_bf16(hi[2], hi[3]); return __builtin_bit_cast(bf16x8, w); }
__device__ __forceinline__ void seq_load(v4u (&r)[14], const unsigned char* blk, int lt) {
#pragma unroll
    for (int i = 0; i < 14; ++i) r[i] = *(const v4u*)(blk + (size_t)(lt + 256 * i) * 16);
}
__device__ __forceinline__ void seq_write(LAS unsigned char* buf, const v4u (&r)[14], int lt) {
#pragma unroll
    for (int i = 0; i < 14; ++i) {
        const int id = lt + 256 * i; int dst;
        if (id < 2048) { const int rr = (id & 1023) >> 4, ch = id & 15; dst = (id & ~1023) * 16 + rr * 256 + 16 * (ch ^ (rr & 15)); }
        else { const int rr = (id - 2048) >> 3, ch = id & 7; dst = 32768 + rr * 128 + 16 * (ch ^ (rr & 7)); }
        *(LAS v4u*)(buf + dst) = r[i];
    }
}
__device__ __forceinline__ void seq_compute(LAS unsigned char* buf, f32x4 (&Sacc)[8], const f32x4 (&U)[4], const float gl, float* op0, const int fr, const int fq) {
    bf16x8 sf[4];
#pragma unroll
    for (int s = 0; s < 4; ++s) sf[s] = packfrag(Sacc[2 * s], Sacc[2 * s + 1]);
    f32x4 Vn[4], Oa[4];
#pragma unroll
    for (int tc = 0; tc < 4; ++tc) {
        const int rr = 16 * tc + fr; f32x4 av = (f32x4){0.f, 0.f, 0.f, 0.f}, ao = (f32x4){0.f, 0.f, 0.f, 0.f};
#pragma unroll
        for (int s = 0; s < 4; ++s) {
            const int off = rr * 256 + 16 * ((4 * s + fq) ^ (rr & 15));
            const bf16x8 wf = *(const LAS bf16x8*)(buf + SQ_WP + off), qf = *(const LAS bf16x8*)(buf + SQ_QD + off);
            av = __builtin_amdgcn_mfma_f32_16x16x32_bf16(wf, sf[s], av, 0, 0, 0);
            ao = __builtin_amdgcn_mfma_f32_16x16x32_bf16(qf, sf[s], ao, 0, 0, 0);
        }
        Vn[tc] = U[tc] - av; Oa[tc] = ao;
    }
    bf16x8 vf[2];
    vf[0] = packfrag(Vn[0], Vn[1]); vf[1] = packfrag(Vn[2], Vn[3]);
#pragma unroll
    for (int tc = 0; tc < 4; ++tc) {
        const int rr = 16 * tc + fr;
#pragma unroll
        for (int s = 0; s < 2; ++s) {
            const bf16x8 kf = *(const LAS bf16x8*)(buf + SQ_QK + rr * 128 + 16 * ((4 * s + fq) ^ (rr & 7)));
            Oa[tc] = __builtin_amdgcn_mfma_f32_16x16x32_bf16(kf, vf[s], Oa[tc], 0, 0, 0);
        }
        float* op = op0 + (size_t)(16 * tc) * 512;
#pragma unroll
        for (int j = 0; j < 4; ++j) op[(size_t)j * 512] = Oa[tc][j];
    }
#pragma unroll
    for (int T = 0; T < 8; ++T) {
        const int rr = 16 * T + fr; f32x4 a = Sacc[T] * gl;
#pragma unroll
        for (int s = 0; s < 2; ++s) {
            const bf16x8 kf = *(const LAS bf16x8*)(buf + SQ_KDT + rr * 128 + 16 * ((4 * s + fq) ^ (rr & 7)));
            a = __builtin_amdgcn_mfma_f32_16x16x32_bf16(kf, vf[s], a, 0, 0, 0);
        }
        Sacc[T] = a;
    }
}
#define SEQ_BAR() do { asm volatile("s_waitcnt lgkmcnt(0)" ::: "memory"); __builtin_amdgcn_s_barrier(); asm volatile("" ::: "memory"); } while (0)
__device__ __forceinline__ void p4_delta_seq(Frame& F, int sid) {
    const int lane = F.lane, wave = F.wave, tid = F.tid;
    const int bh = sid >> 1, half = sid & 1, b = bh >> 2, h = bh & 3;
    const int fr = lane & 15, fq = lane >> 4;
    const int v0 = half * 64 + (wave & 3) * 16;
    const unsigned char* cbase = F.ws + WS_CHK + (size_t)(bh * 128) * CHK_STRIDE;
    if (wave >= 4) {
        const int lt = tid - 256;
        v4u RA[14], RB[14];
#define SEQ_LD(R, blk) do { const unsigned char* _b = (blk); _Pragma("unroll") for (int _i = 0; _i < 14; ++_i) asm volatile("global_load_dwordx4 %0, %1, off" : "=v"(R[_i]) : "v"(_b + (size_t)(lt + 256 * _i) * 16) : "memory"); } while (0)
#define SEQ_WAIT(younger) do { if (younger) asm volatile("s_waitcnt vmcnt(14)" ::: "memory"); else asm volatile("s_waitcnt vmcnt(0)" ::: "memory"); } while (0)
        SEQ_LD(RA, cbase); SEQ_LD(RB, cbase + CHK_STRIDE); SEQ_WAIT(true); seq_write(F.lds, RA, lt); SEQ_LD(RA, cbase + 2 * CHK_STRIDE);
        SEQ_BAR();
#pragma unroll 1
        for (int n = 0; n < 128; n += 2) {
            if (n + 1 < 128) { SEQ_WAIT(n + 2 < 128); seq_write(F.lds + ((n + 1) & 1) * SQ_BUF, RB, lt); } if (n + 3 < 128) SEQ_LD(RB, cbase + (size_t)(n + 3) * CHK_STRIDE);
            SEQ_BAR();
            if (n + 2 < 128) { SEQ_WAIT(n + 3 < 128); seq_write(F.lds + (n & 1) * SQ_BUF, RA, lt); } if (n + 4 < 128) SEQ_LD(RA, cbase + (size_t)(n + 4) * CHK_STRIDE);
            SEQ_BAR();
        }
        asm volatile("s_waitcnt vmcnt(0)" ::: "memory");
#undef SEQ_LD
#undef SEQ_WAIT
    } else {
        float* OD = WSP(float, WS_ODELTA);
        f32x4 Sacc[8], Ucur[4], Unxt[4]; float glc, gln;
#pragma unroll
        for (int T = 0; T < 8; ++T) Sacc[T] = (f32x4){0.f, 0.f, 0.f, 0.f};
#pragma unroll
        for (int tc = 0; tc < 4; ++tc) { Ucur[tc] = *(const f32x4*)((const float*)(cbase + CHK_UT) + (size_t)(v0 + fr) * 64 + 4 * fq + 16 * tc);
                                          Unxt[tc] = *(const f32x4*)((const float*)(cbase + CHK_STRIDE + CHK_UT) + (size_t)(v0 + fr) * 64 + 4 * fq + 16 * tc); }
        glc = *(const float*)(cbase + CHK_GL); gln = *(const float*)(cbase + CHK_STRIDE + CHK_GL);
        SEQ_BAR();
#pragma unroll 1
        for (int n = 0; n < 128; ++n) {
            seq_compute(F.lds + (n & 1) * SQ_BUF, Sacc, Ucur, glc, OD + (size_t)(b * SEQ + n * 64 + 4 * fq) * 512 + h * 128 + v0 + fr, fr, fq);
#pragma unroll
            for (int tc = 0; tc < 4; ++tc) Ucur[tc] = Unxt[tc];
            glc = gln;
            if (n + 2 < 128) { const unsigned char* nb = cbase + (size_t)(n + 2) * CHK_STRIDE; gln = *(const float*)(nb + CHK_GL);
#pragma unroll
                for (int tc = 0; tc < 4; ++tc) Unxt[tc] = *(const f32x4*)((const float*)(nb + CHK_UT) + (size_t)(v0 + fr) * 64 + 4 * fq + 16 * tc); }
            SEQ_BAR();
        }
    }
}
#undef SEQ_BAR

__device__ __forceinline__ float relu1(float x) { float r; asm("v_max_f32_e32 %0, 0, %1" : "=v"(r) : "v"(x)); return r; }
__device__ __forceinline__ void p4_indexer(Frame& F, int widx, int nw) {
    const int lane = F.lane, fr = lane & 15, fq = lane >> 4;
    const bf16* QL = WSP(bf16, WS_QL); const bf16* KI = WSP(bf16, WS_KIDX); const float* WI = WSP(float, WS_WIDX); float* SC = WSP(float, WS_BIG);
    for (int task = widx; task < 2 * 4352; task += nw) {
        const int b = task / 4352; int tau = task - b * 4352;
        int g = 0; while (16 * (g + 1) * (g + 2) <= tau) ++g;
        tau -= 16 * g * (g + 1);
        const int qt = 32 * g + tau / (g + 1), seg = tau % (g + 1);
        const int row0 = b * SEQ + 16 * qt;
        bf16x8 Qf[8][2];
#pragma unroll
        for (int hh = 0; hh < 8; ++hh)
#pragma unroll
            for (int s = 0; s < 2; ++s) Qf[hh][s] = *(const bf16x8*)(QL + (size_t)(row0 + fr) * 1536 + 1024 + hh * 64 + 32 * s + 8 * fq);
        const f32x4 w0 = *(const f32x4*)(WI + (size_t)(row0 + fr) * 8), w1 = *(const f32x4*)(WI + (size_t)(row0 + fr) * 8 + 4);
        const int kt1 = (32 * seg + 31 < qt) ? 32 * seg + 31 : qt;
        for (int kb8 = 32 * seg; kb8 <= kt1; kb8 += 8) {
            bf16x8 kfr[8][2];
#pragma unroll
            for (int x = 0; x < 8; ++x) { const int kt = (kb8 + x <= kt1) ? kb8 + x : kt1; const bf16* kp = KI + (size_t)(b * SEQ + 16 * kt + fr) * 64 + 8 * fq; kfr[x][0] = *(const bf16x8*)kp; kfr[x][1] = *(const bf16x8*)(kp + 32); }
#pragma unroll
            for (int x = 0; x < 8; ++x) asm volatile("" : "+v"(kfr[x][0]), "+v"(kfr[x][1]));
#pragma unroll
            for (int x = 0; x < 8; ++x) {
                const int kt = kb8 + x;
                if (kt <= kt1) {
                    f32x4 isc = (f32x4){0.f, 0.f, 0.f, 0.f}, c[8];
#pragma unroll
                    for (int hh = 0; hh < 8; ++hh) c[hh] = __builtin_amdgcn_mfma_f32_16x16x32_bf16(kfr[x][0], Qf[hh][0], (f32x4){0.f, 0.f, 0.f, 0.f}, 0, 0, 0);
#pragma unroll
                    for (int hh = 0; hh < 8; ++hh) c[hh] = __builtin_amdgcn_mfma_f32_16x16x32_bf16(kfr[x][1], Qf[hh][1], c[hh], 0, 0, 0);
                    __builtin_amdgcn_sched_barrier(0);
#pragma unroll
                    for (int hh = 0; hh < 8; ++hh) { const float wh = (hh < 4) ? w0[hh & 3] : w1[hh & 3];
#pragma unroll
                        for (int j = 0; j < 4; ++j) isc[j] += relu1(c[hh][j]) * wh; }
                    *(f32x4*)(SC + (size_t)(row0 + fr) * 8192 + 16 * kt + 4 * fq) = isc;
                }
            }
        }
    }
}

__device__ __forceinline__ void mask_ge8(unsigned long long (&m)[8], unsigned x0, unsigned x1, unsigned x2, unsigned x3, unsigned x4, unsigned x5, unsigned x6, unsigned x7, unsigned t) {
    asm("v_cmp_ge_u32_e64 %0, %8, %16\n\tv_cmp_ge_u32_e64 %1, %9, %16\n\tv_cmp_ge_u32_e64 %2, %10, %16\n\tv_cmp_ge_u32_e64 %3, %11, %16\n\t"
        "v_cmp_ge_u32_e64 %4, %12, %16\n\tv_cmp_ge_u32_e64 %5, %13, %16\n\tv_cmp_ge_u32_e64 %6, %14, %16\n\tv_cmp_ge_u32_e64 %7, %15, %16"
        : "=&s"(m[0]), "=&s"(m[1]), "=&s"(m[2]), "=&s"(m[3]), "=&s"(m[4]), "=&s"(m[5]), "=&s"(m[6]), "=&s"(m[7])
        : "v"(x0), "v"(x1), "v"(x2), "v"(x3), "v"(x4), "v"(x5), "v"(x6), "v"(x7), "s"(t));
}
__device__ __forceinline__ unsigned tk_key(float f) { const unsigned b = __float_as_uint(f); return (b & 0x80000000u) ? ~b : (b | 0x80000000u); }
__device__ __forceinline__ void topk_row_slow(const float* sr, const int n, const int lane, LAS int* sel) {
    const int nseg = (n + 63) >> 6;
    unsigned T = 0u;
    for (int bit = 31; bit >= 0; --bit) {
        const unsigned cnd = T | (1u << bit); int c = 0;
        for (int sg = 0; sg < nseg; ++sg) { const int idx = sg * 64 + lane; const unsigned x = (idx < n) ? tk_key(sr[idx < n ? idx : 0]) : 0u; c += __popcll(__ballot(x >= cnd)); }
        if (c >= 256) T = cnd;
    }
    int cgt = 0;
    for (int sg = 0; sg < nseg; ++sg) { const int idx = sg * 64 + lane; const unsigned x = (idx < n) ? tk_key(sr[idx < n ? idx : 0]) : 0u; cgt += __popcll(__ballot(x > T)); }
    const int need_eq = 256 - cgt; int running = 0, eq_taken = 0;
    const unsigned long long lt = (1ull << lane) - 1ull;
    for (int sg = 0; sg < nseg; ++sg) {
        const int idx = sg * 64 + lane; const unsigned x = (idx < n) ? tk_key(sr[idx < n ? idx : 0]) : 0u;
        const bool gt = x > T, eq = x == T;
        const unsigned long long meq = __ballot(eq);
        const bool take = gt || (eq && (eq_taken + __popcll(meq & lt)) < need_eq);
        const unsigned long long mt = __ballot(take);
        if (take) sel[running + __popcll(mt & lt)] = idx;
        running += __popcll(mt); eq_taken += __popcll(meq);
    }
}
constexpr int TK_CAP = 832;
__device__ __forceinline__ int topk_row(Frame& F, const int row, LAS int* sel, LAS unsigned long long* cand) {
    const int lane = F.lane;
    const float* SC = WSP(float, WS_BIG);
    {
        const int pos = row & (SEQ - 1), n = pos + 1;
        if (n <= 256) {
#pragma unroll
            for (int i = 0; i < 4; ++i) { const int j = 64 * i + lane; sel[j] = (j < n) ? j : 0; }
            return n;
        }
        const int nblk = (n + 1023) >> 10;
        const float* sr = SC + (size_t)row * 8192;
        int lane_l = lane; asm volatile("" : "+v"(lane_l));
        unsigned u[128];
#pragma unroll
        for (int i = 0; i < 64; ++i) u[i] = __float_as_uint((sr + (i >> 4) * 1024)[(i & 15) * 64 + lane_l]);
        if (nblk > 4) {
#pragma unroll
            for (int i = 64; i < 128; ++i) u[i] = __float_as_uint((sr + (i >> 4) * 1024)[(i & 15) * 64 + lane_l]);
        } else {
#pragma unroll
            for (int i = 64; i < 128; ++i) u[i] = 0u;
        }
        asm volatile("" ::: "memory");
#pragma unroll
        for (int i = 0; i < 128; ++i) { const int lim = n - i * 64; const unsigned bits = u[i];
            const unsigned x = (bits & 0x80000000u) ? ~bits : (bits | 0x80000000u);
            u[i] = (lane < lim) ? x : 0u; }
        const unsigned long long ltmask_s = (1ull << lane) - 1ull;
        bool done = false;
        {
            int ns = 0;
#pragma unroll
            for (int k = 0; k < 16; ++k) { int v = n - 512 * k; v = v < 0 ? 0 : (v > 64 ? 64 : v); ns += v; }
            const float mean = 256.0f * (float)ns / (float)n;
            const int rs = (int)(mean + 4.0f * sqrtf(mean) + 5.0f);
            unsigned Ts = 0u;
            for (int bit = 31; bit >= 16; --bit) {
                const unsigned cnd = Ts | (1u << bit); unsigned long long m0[8], m1[8];
                mask_ge8(m0, u[0], u[8], u[16], u[24], u[32], u[40], u[48], u[56], cnd); mask_ge8(m1, u[64], u[72], u[80], u[88], u[96], u[104], u[112], u[120], cnd);
                int c = 0;
#pragma unroll
                for (int i = 0; i < 8; ++i) c += __popcll(m0[i]) + __popcll(m1[i]);
                if (c >= rs) Ts = cnd;
            }
            if (Ts == 0u) Ts = 1u;
            int nc = 0;
#pragma unroll
            for (int bk = 0; bk < 8; ++bk) {
                if (bk < nblk) {
#pragma unroll
                    for (int g8 = 0; g8 < 2; ++g8) {
                        unsigned long long mg[8]; const int b0 = bk * 16 + g8 * 8;
                        mask_ge8(mg, u[b0], u[b0 + 1], u[b0 + 2], u[b0 + 3], u[b0 + 4], u[b0 + 5], u[b0 + 6], u[b0 + 7], Ts);
#pragma unroll
                        for (int i = 0; i < 8; ++i) {
                            const unsigned long long mt = mg[i];
                            if (mt != 0ull) {
                                const int off = nc + __popcll(mt & ltmask_s);
                                if (((mt >> lane) & 1ull) && off < TK_CAP) cand[off] = ((unsigned long long)u[b0 + i] << 32) | (unsigned)((b0 + i) * 64 + lane_l);
                                nc += __popcll(mt);
                            }
                        }
                    }
                }
            }
            if (nc >= 256 && nc <= TK_CAP) {
                unsigned ck[16]; int ci[13];
#pragma unroll
                for (int t = 0; t < 13; ++t) { const int j = lane + 64 * t; const unsigned long long e = (j < nc) ? cand[j] : 0ull; ck[t] = (unsigned)(e >> 32); ci[t] = (int)(unsigned)e; }
                ck[13] = 0u; ck[14] = 0u; ck[15] = 0u;
                unsigned T = 0u;
                for (int bit = 31; bit >= 0; --bit) {
                    const unsigned cnd = T | (1u << bit); unsigned long long m0[8], m1[8];
                    mask_ge8(m0, ck[0], ck[1], ck[2], ck[3], ck[4], ck[5], ck[6], ck[7], cnd); mask_ge8(m1, ck[8], ck[9], ck[10], ck[11], ck[12], ck[13], ck[14], ck[15], cnd);
                    int c = 0;
#pragma unroll
                    for (int i = 0; i < 8; ++i) c += __popcll(m0[i]) + __popcll(m1[i]);
                    if (c >= 256) T = cnd;
                }
                unsigned long long g0[8], g1[8], h0[8], h1[8];
                mask_ge8(g0, ck[0], ck[1], ck[2], ck[3], ck[4], ck[5], ck[6], ck[7], T); mask_ge8(g1, ck[8], ck[9], ck[10], ck[11], ck[12], ck[13], ck[14], ck[15], T);
                mask_ge8(h0, ck[0], ck[1], ck[2], ck[3], ck[4], ck[5], ck[6], ck[7], T + 1u); mask_ge8(h1, ck[8], ck[9], ck[10], ck[11], ck[12], ck[13], ck[14], ck[15], T + 1u);
                int cgt = 0;
#pragma unroll
                for (int t = 0; t < 13; ++t) cgt += __popcll(t < 8 ? h0[t & 7] : h1[t & 7]);
                const int need_eq = 256 - cgt;
                int running = 0, eq_taken = 0;
#pragma unroll
                for (int t = 0; t < 13; ++t) {
                    const unsigned long long mge = (t < 8 ? g0[t & 7] : g1[t & 7]), mgt = (t < 8 ? h0[t & 7] : h1[t & 7]);
                    unsigned long long mt = mge; const unsigned long long me = mge & ~mgt;
                    if (me != 0ull) {
                        const int room = need_eq - eq_taken; unsigned long long keep = 0ull, rest = me;
                        for (int k = 0; k < room && rest != 0ull; ++k) { const unsigned long long low = rest & (~rest + 1ull); keep |= low; rest ^= low; }
                        mt = (mge & ~me) | keep; eq_taken += __popcll(me);
                    }
                    if (mt != 0ull) { if ((mt >> lane) & 1ull) sel[running + __popcll(mt & ltmask_s)] = ci[t]; running += __popcll(mt); }
                }
                done = true;
            }
        }
        if (!done) topk_row_slow(sr, n, lane, sel);
    }
    return 256;
}

__device__ __forceinline__ void p6_gdn_out(Frame& F, KArgs A) {
    const int lane = F.lane, gw = F.bid * NWAVES + F.wave, NGW = F.G * NWAVES;
    const f32x4 g0 = *(const f32x4*)(A->in[I_AB_ONG] + 8 * (lane & 15)), g1 = *(const f32x4*)(A->in[I_AB_ONG] + 8 * (lane & 15) + 4);
    for (int row = gw; row < M; row += NGW) {
        const float* op = WSP(float, WS_ODELTA) + (size_t)row * 512 + 8 * lane;
        const f32x4 a = *(const f32x4*)op, b = *(const f32x4*)(op + 4);
        float ss = a[0] * a[0] + a[1] * a[1] + a[2] * a[2] + a[3] * a[3] + b[0] * b[0] + b[1] * b[1] + b[2] * b[2] + b[3] * b[3];
        ss += __shfl_xor(ss, 1); ss += __shfl_xor(ss, 2); ss += __shfl_xor(ss, 4); ss += __shfl_xor(ss, 8);
        const float r = rsqrtf(ss * (1.0f / 128.0f) + 1e-6f);
        float z[8]; unpack8(*(const v4u*)(WSP(bf16, WS_QKVZ) + (size_t)row * 2048 + 1536 + 8 * lane), z);
        float o[8];
#pragma unroll
        for (int i = 0; i < 4; ++i) { o[i] = a[i] * r * g0[i] * siluf(z[i]); o[4 + i] = b[i] * r * g1[i] * siluf(z[4 + i]); }
        *(v4u*)(WSP(bf16, WS_AO) + (size_t)row * 1536 + 1024 + 8 * lane) = pack8f(o);
    }
}

__device__ __forceinline__ void p8_ln_router(Frame& F, KArgs A, int l, float* HOUT, bf16* HB) {
    const int lane = F.lane, tid = F.tid, gw = F.bid * NWAVES + F.wave, NGW = F.G * NWAVES;
    LAS float* wT = (LAS float*)(F.lds);
    LAS float* lg = (LAS float*)(F.lds + WSCR_OFF + F.wave * WSCR_BYTES);
    const float* rw = A->in[I_RW] + (size_t)l * 1024 * 32;
    {
        f32x4 wv[16];
#pragma unroll
        for (int j = 0; j < 16; ++j) wv[j] = *(const f32x4*)(rw + (size_t)(tid + NTHREADS * j) * 4);
#pragma unroll
        for (int j = 0; j < 16; ++j) { const int i4 = tid + NTHREADS * j, k = i4 >> 3, e0 = (i4 & 7) * 4;
            wT[(e0 + 0) * 1028 + k] = wv[j][0]; wT[(e0 + 1) * 1028 + k] = wv[j][1]; wT[(e0 + 2) * 1028 + k] = wv[j][2]; wT[(e0 + 3) * 1028 + k] = wv[j][3]; }
    }
    __syncthreads();
    const float* PRE = WSP(float, WS_PRE);
    const float* lg_g = A->in[I_LNM_G] + (size_t)l * 1024; const float* lg_b = A->in[I_LNM_B] + (size_t)l * 1024;
    const float rb = A->in[I_RB][l * 32 + (lane & 31)];
    int* TOKE = WSP(int, WS_ROUTE); int* TOKPOS = TOKE + M * 4; float* TOKG = (float*)(TOKPOS + M * 4);
    gu32* cnt = F.ctl + CW_CNT + 64 * 32 * l;
    LAS int* lcnt = (LAS int*)(F.lds + MISC_OFF + 512);
    LAS int* lbase = lcnt + 32;
    LAS int* myrt = (LAS int*)(F.lds + WSCR_OFF + F.wave * WSCR_BYTES + 128);
    if (tid < 32) lcnt[tid] = 0;
    __syncthreads();
    int nrow = 0;
    f32x4 lng[4], lnb[4];
#pragma unroll
    for (int j = 0; j < 4; ++j) { lng[j] = *(const f32x4*)(lg_g + 256 * j + 4 * lane); lnb[j] = *(const f32x4*)(lg_b + 256 * j + 4 * lane); }
    for (int row = gw; row < M; row += NGW) {
        f32x4 v[4]; float s = 0.f;
#pragma unroll
        for (int j = 0; j < 4; ++j) { v[j] = *(const f32x4*)(PRE + (size_t)row * 1024 + 256 * j + 4 * lane); s += (v[j][0] + v[j][1]) + (v[j][2] + v[j][3]); }
        const float mean = wave_sum(s) * (1.0f / 1024.0f); float s2 = 0.f;
#pragma unroll
        for (int j = 0; j < 4; ++j) { v[j] = v[j] - mean; s2 += (v[j][0] * v[j][0] + v[j][1] * v[j][1]) + (v[j][2] * v[j][2] + v[j][3] * v[j][3]); }
        const float rstd = rsqrtf(wave_sum(s2) * (1.0f / 1024.0f) + 1e-5f);
#pragma unroll
        for (int j = 0; j < 4; ++j) {
            v[j] = v[j] * rstd * lng[j] + lnb[j];
            *(f32x4*)(HOUT + (size_t)row * 1024 + 256 * j + 4 * lane) = v[j];
            v2u o; o.x = pk2(v[j][0], v[j][1]); o.y = pk2(v[j][2], v[j][3]); *(v2u*)(HB + (size_t)row * 1024 + 256 * j + 4 * lane) = o;
        }
        float part[32];
#pragma unroll
        for (int e = 0; e < 32; ++e) {
            float a = 0.f;
#pragma unroll
            for (int j = 0; j < 4; ++j) { const f32x4 w = *(const LAS f32x4*)(wT + e * 1028 + 256 * j + 4 * lane); a += v[j][0] * w[0] + v[j][1] * w[1] + v[j][2] * w[2] + v[j][3] * w[3]; }
            part[e] = a;
        }
#pragma unroll
        for (int i = 0; i < 16; ++i) { const bool up = (lane & 32) != 0; const float keep = up ? part[i + 16] : part[i], send = up ? part[i] : part[i + 16]; part[i] = keep + __shfl_xor(send, 32); }
#pragma unroll
        for (int i = 0; i < 8; ++i) { const bool up = (lane & 16) != 0; const float keep = up ? part[i + 8] : part[i], send = up ? part[i] : part[i + 8]; part[i] = keep + __shfl_xor(send, 16); }
#pragma unroll
        for (int i = 0; i < 4; ++i) { const bool up = (lane & 8) != 0; const float keep = up ? part[i + 4] : part[i], send = up ? part[i] : part[i + 4]; part[i] = keep + __shfl_xor(send, 8); }
#pragma unroll
        for (int i = 0; i < 2; ++i) { const bool up = (lane & 4) != 0; const float keep = up ? part[i + 2] : part[i], send = up ? part[i] : part[i + 2]; part[i] = keep + __shfl_xor(send, 4); }
        { const bool up = (lane & 2) != 0; const float keep = up ? part[1] : part[0], send = up ? part[0] : part[1]; part[0] = keep + __shfl_xor(send, 2); }
        part[0] += __shfl_xor(part[0], 1);
        const int eidx = ((lane >> 5) & 1) * 16 + ((lane >> 4) & 1) * 8 + ((lane >> 3) & 1) * 4 + ((lane >> 2) & 1) * 2 + ((lane >> 1) & 1);
        if ((lane & 1) == 0) lg[eidx] = part[0];
        float val = (lane < 32) ? lg[lane & 31] + rb : -INFINITY;
        float tl[4]; int te[4];
#pragma unroll
        for (int k = 0; k < 4; ++k) {
            const float mx = wave_max(val);
            const unsigned long long mm = __ballot(val == mx && lane < 32);
            const int idx = __ffsll((long long)mm) - 1;
            tl[k] = mx; te[k] = idx;
            if (lane == idx) val = -INFINITY;
        }
        const float e1 = __expf(tl[1] - tl[0]), e2 = __expf(tl[2] - tl[0]), e3 = __expf(tl[3] - tl[0]);
        const float inv = 1.0f / (1.0f + e1 + e2 + e3);
        if (lane < 4) {
            const int e = lane == 0 ? te[0] : (lane == 1 ? te[1] : (lane == 2 ? te[2] : te[3]));
            const float g = (lane == 0 ? 1.0f : (lane == 1 ? e1 : (lane == 2 ? e2 : e3))) * inv;
            const int lp = __hip_atomic_fetch_add(lcnt + e, 1, __ATOMIC_RELAXED, __HIP_MEMORY_SCOPE_WORKGROUP);
            LAS int* rt = myrt + (nrow * 4 + lane) * 3; rt[0] = e; rt[1] = lp; rt[2] = __float_as_int(g);
        }
        ++nrow;
    }
    __syncthreads();
    if (tid < 32) lbase[tid] = (int)__hip_atomic_fetch_add(cnt + 64 * tid, (unsigned)lcnt[tid], RLX_AGENT);
    __syncthreads();
    if (lane < 4) {
        int j = 0;
        for (int row = gw; row < M; row += NGW, ++j) {
            const LAS int* rt = myrt + (j * 4 + lane) * 3; const int e = rt[0];
            TOKE[(size_t)row * 4 + lane] = e; TOKPOS[(size_t)row * 4 + lane] = lbase[e] + rt[1]; TOKG[(size_t)row * 4 + lane] = __int_as_float(rt[2]);
        }
    }
}

__device__ __forceinline__ void p9_scatter(Frame& F, int l, const bf16* HB, const float* HF) {
    const int lane = F.lane, tid = F.tid, gw = F.bid * NWAVES + F.wave, NGW = F.G * NWAVES;
    LAS int* base = (LAS int*)(F.lds + MISC_OFF + 256);
    int* TOKE = WSP(int, WS_ROUTE); int* TOKPOS = TOKE + M * 4; int* TILE = TOKE + 3 * M * 4;
    if (tid < 32) base[tid] = (int)__hip_atomic_load(F.ctl + CW_CNT + 64 * (32 * l + tid), RLX_AGENT);
    __syncthreads();
    if (tid == 0) {
        int acc = 0;
        for (int e = 0; e < NEXP; ++e) { const int c = base[e]; base[e] = acc; acc += ((c + 255) >> 8) << 8; }
        base[32] = acc >> 8;
    }
    __syncthreads();
    if (F.bid == 0 && tid < 64) {
        const int nT = base[32];
        for (int t = tid; t < NTMAX; t += 64) { int e = 0;
            for (int x = 1; x < NEXP; ++x) if (base[x] <= t * 256) e = x;
            TILE[t] = (t < nT) ? e : 0; }
        if (tid == 0) TILE[NTMAX] = nT;
    }
    bf16* XS = WSP(bf16, WS_XS);
    if (kMoeFp8) {
        unsigned char* XB8 = WSP(unsigned char, WS_XS);
        for (int row = gw; row < M; row += NGW) {
            const float* hp = HF + (size_t)row * 1024 + 16 * lane; v4u o;
#pragma unroll
            for (int q = 0; q < 4; ++q) { const f32x4 v = *(const f32x4*)(hp + 4 * q); unsigned w = 0u; w = __builtin_amdgcn_cvt_pk_fp8_f32(v[0], v[1], w, false); w = __builtin_amdgcn_cvt_pk_fp8_f32(v[2], v[3], w, true); o[q] = w; }
#pragma unroll
            for (int k = 0; k < 4; ++k) { const int slot = base[TOKE[(size_t)row * 4 + k]] + TOKPOS[(size_t)row * 4 + k]; *(v4u*)(XB8 + (size_t)slot * 1024 + 16 * lane) = o; }
        }
        return;
    }
    for (int row = gw; row < M; row += NGW) {
        const v4u a = *(const v4u*)(HB + (size_t)row * 1024 + 8 * lane), b = *(const v4u*)(HB + (size_t)row * 1024 + 512 + 8 * lane);
#pragma unroll
        for (int k = 0; k < 4; ++k) {
            const int slot = base[TOKE[(size_t)row * 4 + k]] + TOKPOS[(size_t)row * 4 + k];
            *(v4u*)(XS + (size_t)slot * 1024 + 8 * lane) = a; *(v4u*)(XS + (size_t)slot * 1024 + 512 + 8 * lane) = b;
        }
    }
}

__device__ __forceinline__ void p12_combine(Frame& F, KArgs A, int l, const float* HIN, float* HOUT, bf16* HB) {
    const int lane = F.lane, tid = F.tid, gw = F.bid * NWAVES + F.wave, NGW = F.G * NWAVES;
    LAS int* base = (LAS int*)(F.lds + MISC_OFF + 256);
    if (tid < 32) base[tid] = (int)__hip_atomic_load(F.ctl + CW_CNT + 64 * (32 * l + tid), RLX_AGENT);
    __syncthreads();
    if (tid == 0) { int acc = 0; for (int e = 0; e < NEXP; ++e) { const int c = base[e]; base[e] = acc; acc += ((c + 255) >> 8) << 8; } }
    __syncthreads();
    const int* TOKE = WSP(int, WS_ROUTE); const int* TOKPOS = TOKE + M * 4; const float* TOKG = (const float*)(TOKPOS + M * 4);
    const bf16* YS = WSP(bf16, WS_YS); const bf16* PLE = WSP(bf16, WS_PLE);
    const float* lg_g = A->in[I_LNF_G] + (size_t)l * 1024; const float* lg_b = A->in[I_LNF_B] + (size_t)l * 1024;
    f32x4 lng[2][2], lnb[2][2];
#pragma unroll
    for (int hf = 0; hf < 2; ++hf) { const int c0 = 512 * hf + 8 * lane; lng[hf][0] = *(const f32x4*)(lg_g + c0); lng[hf][1] = *(const f32x4*)(lg_g + c0 + 4); lnb[hf][0] = *(const f32x4*)(lg_b + c0); lnb[hf][1] = *(const f32x4*)(lg_b + c0 + 4); }
    for (int row = gw; row < M; row += NGW) {
        float x[16];
        {   const f32x4 h0 = *(const f32x4*)(HIN + (size_t)row * 1024 + 8 * lane), h1 = *(const f32x4*)(HIN + (size_t)row * 1024 + 8 * lane + 4);
            const f32x4 h2 = *(const f32x4*)(HIN + (size_t)row * 1024 + 512 + 8 * lane), h3 = *(const f32x4*)(HIN + (size_t)row * 1024 + 512 + 8 * lane + 4);
            float p0[8], p1[8]; unpack8(*(const v4u*)(PLE + (size_t)row * 1024 + 8 * lane), p0); unpack8(*(const v4u*)(PLE + (size_t)row * 1024 + 512 + 8 * lane), p1);
#pragma unroll
            for (int i = 0; i < 4; ++i) { x[i] = ALPHA * h0[i] + p0[i]; x[4 + i] = ALPHA * h1[i] + p0[4 + i]; x[8 + i] = ALPHA * h2[i] + p1[i]; x[12 + i] = ALPHA * h3[i] + p1[4 + i]; }
        }
#pragma unroll
        for (int k = 0; k < 4; ++k) {
            const int slot = base[TOKE[(size_t)row * 4 + k]] + TOKPOS[(size_t)row * 4 + k]; const float g = TOKG[(size_t)row * 4 + k];
            float y0[8], y1[8]; unpack8(*(const v4u*)(YS + (size_t)slot * 1024 + 8 * lane), y0); unpack8(*(const v4u*)(YS + (size_t)slot * 1024 + 512 + 8 * lane), y1);
#pragma unroll
            for (int i = 0; i < 8; ++i) { x[i] += g * y0[i]; x[8 + i] += g * y1[i]; }
        }
        float s = 0.f;
#pragma unroll
        for (int i = 0; i < 16; ++i) s += x[i];
        const float mean = wave_sum(s) * (1.0f / 1024.0f); float s2 = 0.f;
#pragma unroll
        for (int i = 0; i < 16; ++i) { x[i] -= mean; s2 += x[i] * x[i]; }
        const float rstd = rsqrtf(wave_sum(s2) * (1.0f / 1024.0f) + 1e-5f);
#pragma unroll
        for (int hf = 0; hf < 2; ++hf) {
            const int c0 = 512 * hf + 8 * lane;
            const f32x4 g0 = lng[hf][0], g1 = lng[hf][1], b0 = lnb[hf][0], b1 = lnb[hf][1];
            f32x4 o0, o1;
#pragma unroll
            for (int i = 0; i < 4; ++i) { o0[i] = x[8 * hf + i] * rstd * g0[i] + b0[i]; o1[i] = x[8 * hf + 4 + i] * rstd * g1[i] + b1[i]; }
            *(f32x4*)(HOUT + (size_t)row * 1024 + c0) = o0; *(f32x4*)(HOUT + (size_t)row * 1024 + c0 + 4) = o1;
            if (HB) { v4u w; w.x = pk2(o0[0], o0[1]); w.y = pk2(o0[2], o0[3]); w.z = pk2(o1[0], o1[1]); w.w = pk2(o1[2], o1[3]); *(v4u*)(HB + (size_t)row * 1024 + c0) = w; }
        }
    }
}

typedef short v4i16_t __attribute__((ext_vector_type(4)));
__device__ __forceinline__ v4i16_t lds_tr16(LAS unsigned char* p) { return __builtin_amdgcn_ds_read_tr16_b64_v4i16((LAS v4i16_t*)p); }
constexpr int DV_PITCH = 144, DV_BUF = 32 * DV_PITCH;
template <int DL  > __device__ __forceinline__ void dil_branch(const bf16* __restrict__ KV, LAS unsigned char* vbuf, const int s0, const int lane,
                                                                                 const bf16x8 (&qf)[2], f32x4 (&O)[4], float& m_run, float& l_run) {
    constexpr int d = 1 << DL, sigma = 16 >> DL, NS = (129 + 15 * sigma + 31) / 32;
    const int fr = lane & 15, fq = lane >> 4;
    const int c = s0 & (d - 1), n0 = s0 >> DL, kstart = n0 - 128;
    const int dbase = 128 + sigma * fr - 4 * fq;
    const int dmax = n0 + sigma * fr;
#define DIL_POS(n) ({ int _p = c + d * (n); _p = _p < 0 ? 0 : (_p > SEQ - 1 ? SEQ - 1 : _p); _p; })
    bf16x8 kf[2][2]; v4u vr[4];
#pragma unroll
    for (int tl = 0; tl < 2; ++tl) { const bf16* kp = KV + (size_t)DIL_POS(kstart + 16 * tl + fr) * 2560 + 768 + 8 * fq; kf[tl][0] = *(const bf16x8*)kp; kf[tl][1] = *(const bf16x8*)(kp + 32); }
#pragma unroll
    for (int i = 0; i < 4; ++i) vr[i] = *(const v4u*)(KV + (size_t)DIL_POS(kstart + (lane >> 3) + 8 * i) * 2560 + 1536 + 8 * (lane & 7));
#pragma unroll 1
    for (int g = 0; g < NS; ++g) {
        LAS unsigned char* vb = vbuf + (g & 1) * DV_BUF;
#pragma unroll
        for (int i = 0; i < 4; ++i) *(LAS v4u*)(vb + ((lane >> 3) + 8 * i) * DV_PITCH + 16 * (lane & 7)) = vr[i];
        bf16x8 kc[2][2];
#pragma unroll
        for (int tl = 0; tl < 2; ++tl) { kc[tl][0] = kf[tl][0]; kc[tl][1] = kf[tl][1]; }
        if (g + 1 < NS) {
            const int kb = kstart + 32 * (g + 1);
#pragma unroll
            for (int tl = 0; tl < 2; ++tl) { const bf16* kp = KV + (size_t)DIL_POS(kb + 16 * tl + fr) * 2560 + 768 + 8 * fq; kf[tl][0] = *(const bf16x8*)kp; kf[tl][1] = *(const bf16x8*)(kp + 32); }
#pragma unroll
            for (int i = 0; i < 4; ++i) vr[i] = *(const v4u*)(KV + (size_t)DIL_POS(kb + (lane >> 3) + 8 * i) * 2560 + 1536 + 8 * (lane & 7));
        }
        float sv[8];
#pragma unroll
        for (int tl = 0; tl < 2; ++tl) {
            f32x4 cc = __builtin_amdgcn_mfma_f32_16x16x32_bf16(kc[tl][0], qf[0], (f32x4){0.f, 0.f, 0.f, 0.f}, 0, 0, 0);
            cc = __builtin_amdgcn_mfma_f32_16x16x32_bf16(kc[tl][1], qf[1], cc, 0, 0, 0);
#pragma unroll
            for (int j = 0; j < 4; ++j) {
                const int delta = dbase - (32 * g + 16 * tl + j);
                const bool ok = ((unsigned)delta <= 128u) && (delta <= dmax);
                sv[4 * tl + j] = ok ? cc[j] * 0.18033688011112042f : -INFINITY;
            }
        }
        float mx = fmaxf(fmaxf(fmaxf(sv[0], sv[1]), fmaxf(sv[2], sv[3])), fmaxf(fmaxf(sv[4], sv[5]), fmaxf(sv[6], sv[7])));
        mx = fmaxf(mx, __shfl_xor(mx, 16)); mx = fmaxf(mx, __shfl_xor(mx, 32));
        const float m_new = fmaxf(m_run, mx);
        if (!__all(m_new == m_run)) {
            const float alpha = __builtin_amdgcn_exp2f(m_run - m_new);
            l_run *= alpha;
#pragma unroll
            for (int j = 0; j < 4; ++j) { const float aj = __shfl(alpha, 4 * fq + j);
#pragma unroll
                for (int dt = 0; dt < 4; ++dt) O[dt][j] *= aj; }
            m_run = m_new;
        }
        float p[8], ps = 0.f;
#pragma unroll
        for (int e = 0; e < 8; ++e) { p[e] = __builtin_amdgcn_exp2f(sv[e] - m_run); ps += p[e]; }
        l_run += ps;
        v4u pw; pw.x = pg8::cvt_pk_bf16(p[0], p[1]); pw.y = pg8::cvt_pk_bf16(p[2], p[3]); pw.z = pg8::cvt_pk_bf16(p[4], p[5]); pw.w = pg8::cvt_pk_bf16(p[6], p[7]);
        const bf16x8 pf = __builtin_bit_cast(bf16x8, pw);
        LAS unsigned char* tb = vb + (4 * fq + ((lane & 15) >> 2)) * DV_PITCH + 8 * (lane & 3);
#pragma unroll
        for (int dt = 0; dt < 4; ++dt) {
            const v4i16_t lo = lds_tr16(tb + 32 * dt), hi = lds_tr16(tb + 16 * DV_PITCH + 32 * dt);
            bf16x8 vf; vf[0] = lo[0]; vf[1] = lo[1]; vf[2] = lo[2]; vf[3] = lo[3]; vf[4] = hi[0]; vf[5] = hi[1]; vf[6] = hi[2]; vf[7] = hi[3];
            O[dt] = __builtin_amdgcn_mfma_f32_16x16x32_bf16(pf, vf, O[dt], 0, 0, 0);
        }
    }
#undef DIL_POS
}
__device__ __forceinline__ void p14_dilated_mfma(Frame& F) {
    const int lane = F.lane, fr = lane & 15, fq = lane >> 4;
    LAS unsigned char* vbuf = F.lds + F.wave * (2 * DV_BUF);
    const bf16* QK = WSP(bf16, WS_QKVZ); bf16* AO = WSP(bf16, WS_AO);
    for (int u = F.bid; u < 24 * 32 * 2; u += F.G) {
        const int bh = u >> 6, blk = (u >> 1) & 31, o = (u & 1) * 8 + F.wave;
        const int b = bh / 12, hh = bh - b * 12, s0 = 256 * blk + o;
        const bf16* KV = QK + (size_t)b * SEQ * 2560 + hh * 64;
        bf16x8 qf[2];
        { const bf16* qp = KV + (size_t)(s0 + 16 * fr) * 2560 + 8 * fq; qf[0] = *(const bf16x8*)qp; qf[1] = *(const bf16x8*)(qp + 32); }
        f32x4 O[4];
#pragma unroll
        for (int dt = 0; dt < 4; ++dt) O[dt] = (f32x4){0.f, 0.f, 0.f, 0.f};
        float m_run = -1e30f, l_run = 0.f;
        dil_branch<4>(KV, vbuf, s0, lane, qf, O, m_run, l_run);
        dil_branch<2>(KV, vbuf, s0, lane, qf, O, m_run, l_run);
        dil_branch<0>(KV, vbuf, s0, lane, qf, O, m_run, l_run);
        float lt = l_run; lt += __shfl_xor(lt, 16); lt += __shfl_xor(lt, 32);
        const float inv = __builtin_amdgcn_rcpf(lt);
#pragma unroll
        for (int j = 0; j < 4; ++j) {
            const float ij = __shfl(inv, 4 * fq + j);
            bf16* op = AO + (size_t)(b * SEQ + s0 + 16 * (4 * fq + j)) * 1024 + hh * 64 + fr;
#pragma unroll
            for (int dt = 0; dt < 4; ++dt) op[16 * dt] = (bf16)f2bf(O[dt][j] * ij);
        }
    }
}
constexpr int SA_PITCH = 272, SA_TILE = 32 * SA_PITCH;
__device__ __forceinline__ void sparse_row(Frame& F, const int row, const int n, const LAS int* sel, LAS unsigned char* tile) {
    const int lane = F.lane, fr = lane & 15, fq = lane >> 4;
    const bf16* QL = WSP(bf16, WS_QL); const bf16* CKV = WSP(bf16, WS_CKV); bf16* AO = WSP(bf16, WS_AO);
    {
        const int b = row >> 13;
        const bf16* kvb = CKV + (size_t)b * SEQ * 128;
        bf16x8 qf[4];
#pragma unroll
        for (int s = 0; s < 4; ++s) { const v4u z = (v4u){0u, 0u, 0u, 0u}; qf[s] = (fr < 8) ? *(const bf16x8*)(QL + (size_t)row * 1536 + fr * 128 + 32 * s + 8 * fq) : __builtin_bit_cast(bf16x8, z); }
        f32x4 O[8];
#pragma unroll
        for (int rt = 0; rt < 8; ++rt) O[rt] = (f32x4){0.f, 0.f, 0.f, 0.f};
        float m_run = -1e30f, l_run = 0.f;
        const int nsteps = (n + 31) >> 5;
        v4u vr[8];
        { const int j = lane & 31; const int kidx = (j < n) ? sel[j] : 0;
#pragma unroll
          for (int i = 0; i < 8; ++i) { const int key = __shfl(kidx, (lane >> 4) + 4 * i); vr[i] = *(const v4u*)(kvb + (size_t)key * 128 + 8 * (lane & 15)); } }
#pragma unroll 1
        for (int g = 0; g < nsteps; ++g) {
#pragma unroll
            for (int i = 0; i < 8; ++i) *(LAS v4u*)(tile + ((lane >> 4) + 4 * i) * SA_PITCH + 16 * (lane & 15)) = vr[i];
            if (g + 1 < nsteps) {
                const int j = 32 * (g + 1) + (lane & 31); const int kidx = (j < n) ? sel[j] : 0;
#pragma unroll
                for (int i = 0; i < 8; ++i) { const int key = __shfl(kidx, (lane >> 4) + 4 * i); vr[i] = *(const v4u*)(kvb + (size_t)key * 128 + 8 * (lane & 15)); }
            }
            float sv[8];
#pragma unroll
            for (int tl = 0; tl < 2; ++tl) {
                f32x4 cc = (f32x4){0.f, 0.f, 0.f, 0.f};
#pragma unroll
                for (int s = 0; s < 4; ++s) { const bf16x8 kf = *(const LAS bf16x8*)(tile + (16 * tl + fr) * SA_PITCH + 64 * s + 16 * fq); cc = __builtin_amdgcn_mfma_f32_16x16x32_bf16(kf, qf[s], cc, 0, 0, 0); }
#pragma unroll
                for (int j = 0; j < 4; ++j) sv[4 * tl + j] = (32 * g + 16 * tl + 4 * fq + j < n) ? cc[j] : -INFINITY;
            }
            float mx = fmaxf(fmaxf(fmaxf(sv[0], sv[1]), fmaxf(sv[2], sv[3])), fmaxf(fmaxf(sv[4], sv[5]), fmaxf(sv[6], sv[7])));
            mx = fmaxf(mx, __shfl_xor(mx, 16)); mx = fmaxf(mx, __shfl_xor(mx, 32));
            const float m_new = fmaxf(m_run, mx);
            if (!__all(m_new == m_run)) {
                const float alpha = __expf(m_run - m_new);
                l_run *= alpha;
#pragma unroll
                for (int j = 0; j < 4; ++j) { const float aj = __shfl(alpha, 4 * fq + j);
#pragma unroll
                    for (int rt = 0; rt < 8; ++rt) O[rt][j] *= aj; }
                m_run = m_new;
            }
            float p[8], ps = 0.f;
#pragma unroll
            for (int e = 0; e < 8; ++e) { p[e] = __expf(sv[e] - m_run); ps += p[e]; }
            l_run += ps;
            v4u pw; pw.x = pg8::cvt_pk_bf16(p[0], p[1]); pw.y = pg8::cvt_pk_bf16(p[2], p[3]); pw.z = pg8::cvt_pk_bf16(p[4], p[5]); pw.w = pg8::cvt_pk_bf16(p[6], p[7]);
            const bf16x8 pf = __builtin_bit_cast(bf16x8, pw);
            LAS unsigned char* tb = tile + (4 * fq + ((lane & 15) >> 2)) * SA_PITCH + 8 * (lane & 3);
#pragma unroll
            for (int rt = 0; rt < 8; ++rt) {
                const v4i16_t lo = lds_tr16(tb + 32 * rt), hi = lds_tr16(tb + 16 * SA_PITCH + 32 * rt);
                bf16x8 vf; vf[0] = lo[0]; vf[1] = lo[1]; vf[2] = lo[2]; vf[3] = lo[3]; vf[4] = hi[0]; vf[5] = hi[1]; vf[6] = hi[2]; vf[7] = hi[3];
                O[rt] = __builtin_amdgcn_mfma_f32_16x16x32_bf16(pf, vf, O[rt], 0, 0, 0);
            }
        }
        float lt = l_run; lt += __shfl_xor(lt, 16); lt += __shfl_xor(lt, 32);
        const float inv = __builtin_amdgcn_rcpf(lt);
#pragma unroll
        for (int j = 0; j < 4; ++j) {
            const float ij = __shfl(inv, 4 * fq + j);
            if (fq < 2) { bf16* op = AO + (size_t)row * 1536 + (4 * fq + j) * 128 + fr;
#pragma unroll
                for (int rt = 0; rt < 8; ++rt) op[16 * rt] = (bf16)f2bf(O[rt][j] * ij); }
        }
    }
}
__device__ __forceinline__ void p5_topk_attn(Frame& F, const int gw, const int NGW) {
    LAS int* sel = (LAS int*)(F.lds + F.wave * 16384);
    LAS unsigned char* tile = F.lds + F.wave * 16384 + 1024;
    LAS unsigned long long* cand = (LAS unsigned long long*)(F.lds + F.wave * 16384 + 1024 + SA_TILE);
    static_assert(1024 + SA_TILE + TK_CAP * 8 <= 16384, "per-wave LDS");
    for (int rix = gw; rix < M; rix += NGW) {
        const int row = ((rix & 1) ? (M - 1 - (rix >> 1)) : (rix >> 1));
        const int n = __builtin_amdgcn_readfirstlane(topk_row(F, row, sel, cand));
        sparse_row(F, row, n, sel, tile);
    }
}
constexpr int CP_KV_PITCH = 272;
__device__ __forceinline__ void p3_chunk_prep_mfma(Frame& F, KArgs A) {
    int tid = F.tid; asm volatile("" : "+v"(tid));
    const int lane = tid & 63, wave = __builtin_amdgcn_readfirstlane(tid >> 6), fr = lane & 15, fq = lane >> 4;
    LAS unsigned char* kt = F.lds;
    LAS unsigned char* vt = F.lds + 64 * CP_KV_PITCH;
    LAS float* As = (LAS float*)(F.lds + 2 * 64 * CP_KV_PITCH);
    LAS float* Ts = As + 64 * 65;
    LAS float* gcS = Ts + 64 * 68; LAS float* egS = gcS + 64; LAS float* ekS = egS + 64; LAS float* btS = ekS + 64;
    for (int cidx = F.bid; cidx < 1024; cidx += F.G) {
        const int b = cidx >> 9, h = (cidx >> 7) & 3, n = cidx & 127, row0 = b * SEQ + n * 64;
        unsigned char* blk = F.ws + WS_CHK + (size_t)cidx * CHK_STRIDE;
        const bf16* Qg = WSP(bf16, WS_QN) + (size_t)row0 * 512 + h * 128; const bf16* Kg = WSP(bf16, WS_KN) + (size_t)row0 * 512 + h * 128; const bf16* Vg = WSP(bf16, WS_VN) + (size_t)row0 * 512 + h * 128;
        const int ti = wave >> 1;
        float g_in = 0.f, bt_in = 0.f;
        if (tid < 64) { g_in = WSP(float, WS_GG)[(size_t)(row0 + tid) * 4 + h]; bt_in = WSP(float, WS_BETA)[(size_t)(row0 + tid) * 4 + h]; }
        v4u kc[2], vc[2], qc[2];
#pragma unroll
        for (int i = 0; i < 2; ++i) { const int id = tid + 512 * i, r = id >> 4, c = id & 15; kc[i] = *(const v4u*)(Kg + (size_t)r * 512 + 8 * c); vc[i] = *(const v4u*)(Vg + (size_t)r * 512 + 8 * c); qc[i] = *(const v4u*)(Qg + (size_t)r * 512 + 8 * c); }
        bf16x8 ka[4], qa[4], kbf[2][4];
#pragma unroll
        for (int s = 0; s < 4; ++s) { ka[s] = *(const bf16x8*)(Kg + (size_t)(16 * ti + fr) * 512 + 32 * s + 8 * fq); qa[s] = *(const bf16x8*)(Qg + (size_t)(16 * ti + fr) * 512 + 32 * s + 8 * fq);
            kbf[0][s] = *(const bf16x8*)(Kg + (size_t)(16 * (2 * (wave & 1)) + fr) * 512 + 32 * s + 8 * fq); kbf[1][s] = *(const bf16x8*)(Kg + (size_t)(16 * (2 * (wave & 1) + 1) + fr) * 512 + 32 * s + 8 * fq); }
        if (tid < 64) {
            float gc = g_in;
#pragma unroll
            for (int o = 1; o < 64; o <<= 1) { const float t = __shfl_up(gc, o); if (lane >= o) gc += t; }
            const float g63 = __shfl(gc, 63);
            gcS[tid] = gc; egS[tid] = __expf(gc); ekS[tid] = __expf(g63 - gc); btS[tid] = bt_in;
            if (tid == 0) *(float*)(blk + CHK_GL) = __expf(g63);
        }
#pragma unroll
        for (int i = 0; i < 2; ++i) { const int id = tid + 512 * i, r = id >> 4, c = id & 15; *(LAS v4u*)(kt + r * CP_KV_PITCH + 16 * c) = kc[i]; *(LAS v4u*)(vt + r * CP_KV_PITCH + 16 * c) = vc[i]; }
        __syncthreads();
        {
#pragma unroll
            for (int t2 = 0; t2 < 2; ++t2) {
                const int tj = 2 * (wave & 1) + t2;
                f32x4 ck = (f32x4){0.f, 0.f, 0.f, 0.f}, cq = (f32x4){0.f, 0.f, 0.f, 0.f};
#pragma unroll
                for (int s = 0; s < 4; ++s) { ck = __builtin_amdgcn_mfma_f32_16x16x32_bf16(ka[s], kbf[t2][s], ck, 0, 0, 0); cq = __builtin_amdgcn_mfma_f32_16x16x32_bf16(qa[s], kbf[t2][s], cq, 0, 0, 0); }
                const int j = 16 * tj + fr; const float gcj = gcS[j];
                bf16* QKp = (bf16*)(blk + CHK_QK);
#pragma unroll
                for (int jj = 0; jj < 4; ++jj) { const int i = 16 * ti + 4 * fq + jj; const float dec = __expf(j <= i ? gcS[i] - gcj : 0.f);
                    As[i * 65 + j] = (j < i) ? btS[i] * ck[jj] * dec : 0.f;
                    QKp[i * 64 + 32 * (j >> 5) + 8 * ((j >> 2) & 3) + 4 * ((j >> 4) & 1) + (j & 3)] = (bf16)f2bf((j <= i) ? cq[jj] * dec : 0.f); }
            }
        }
        {
#pragma unroll
            for (int x = 0; x < 2; ++x) { const int id = tid + 512 * x, i = id >> 4, d0 = (id & 15) * 8; const float e = egS[i];
                float f[8]; unpack8(qc[x], f);
                bf16* Qd = (bf16*)(blk + CHK_QD) + i * 128 + 32 * (d0 >> 5) + 4 * ((d0 >> 4) & 1);
                const int q0 = (d0 >> 2) & 3;
                v2u w0, w1; w0.x = pk2(f[0] * e, f[1] * e); w0.y = pk2(f[2] * e, f[3] * e); w1.x = pk2(f[4] * e, f[5] * e); w1.y = pk2(f[6] * e, f[7] * e);
                *(v2u*)(Qd + 8 * q0) = w0; *(v2u*)(Qd + 8 * (q0 + 1)) = w1; }
        }
        {
            const int d = tid >> 2, c0 = (tid & 3) * 16, s = c0 >> 5, a = (c0 >> 4) & 1;
            bf16* Kd = (bf16*)(blk + CHK_KDT) + d * 64;
#pragma unroll
            for (int q = 0; q < 4; ++q) { const int c = c0 + 4 * q; float kv[4];
#pragma unroll
                for (int e = 0; e < 4; ++e) kv[e] = bf1(*(const LAS bf16*)(kt + (c + e) * CP_KV_PITCH + 2 * d)) * ekS[c + e];
                v2u w; w.x = pk2(kv[0], kv[1]); w.y = pk2(kv[2], kv[3]); *(v2u*)(Kd + 32 * s + 8 * q + 4 * a) = w; }
        }
        __syncthreads();
        {
            const int c = tid >> 3, part = tid & 7;
            for (int i = 0; i < 64; ++i) {
                float acc = 0.f;
                for (int j = part; j < i; j += 8) acc += As[i * 65 + j] * Ts[j * 68 + c];
                acc += __shfl_xor(acc, 1); acc += __shfl_xor(acc, 2); acc += __shfl_xor(acc, 4);
                if (part == 0) Ts[i * 68 + c] = ((i == c) ? 1.f : 0.f) - acc;
                __builtin_amdgcn_fence(__ATOMIC_RELEASE, "wavefront"); asm volatile("s_waitcnt lgkmcnt(0)" ::: "memory");
            }
        }
        __syncthreads();
        {
            bf16x8 vf[2], kf[2];
            LAS unsigned char* vb = vt + (8 * fq + ((lane & 15) >> 2)) * CP_KV_PITCH + 32 * wave + 8 * (lane & 3);
            LAS unsigned char* kb = kt + (8 * fq + ((lane & 15) >> 2)) * CP_KV_PITCH + 32 * wave + 8 * (lane & 3);
#pragma unroll
            for (int s = 0; s < 2; ++s) {
                const v4i16_t v0 = lds_tr16(vb + (32 * s) * CP_KV_PITCH), v1 = lds_tr16(vb + (32 * s + 4) * CP_KV_PITCH), k0 = lds_tr16(kb + (32 * s) * CP_KV_PITCH), k1 = lds_tr16(kb + (32 * s + 4) * CP_KV_PITCH);
                vf[s][0] = v0[0]; vf[s][1] = v0[1]; vf[s][2] = v0[2]; vf[s][3] = v0[3]; vf[s][4] = v1[0]; vf[s][5] = v1[1]; vf[s][6] = v1[2]; vf[s][7] = v1[3];
                kf[s][0] = k0[0]; kf[s][1] = k0[1]; kf[s][2] = k0[2]; kf[s][3] = k0[3]; kf[s][4] = k1[0]; kf[s][5] = k1[1]; kf[s][6] = k1[2]; kf[s][7] = k1[3];
            }
            float* UT = (float*)(blk + CHK_UT);
            bf16* Wp = (bf16*)(blk + CHK_WP);
#pragma unroll
            for (int ti = 0; ti < 4; ++ti) {
                f32x4 cu = (f32x4){0.f, 0.f, 0.f, 0.f}, cw = (f32x4){0.f, 0.f, 0.f, 0.f};
#pragma unroll
                for (int s = 0; s < 2; ++s) {
                    const LAS float* tr = Ts + (16 * ti + fr) * 68 + 32 * s + 8 * fq;
                    const f32x4 t0 = *(const LAS f32x4*)tr, t1 = *(const LAS f32x4*)(tr + 4);
                    const f32x4 b0 = *(const LAS f32x4*)(btS + 32 * s + 8 * fq), b1 = *(const LAS f32x4*)(btS + 32 * s + 8 * fq + 4), e0 = *(const LAS f32x4*)(egS + 32 * s + 8 * fq), e1 = *(const LAS f32x4*)(egS + 32 * s + 8 * fq + 4);
                    const f32x4 u0 = t0 * b0, u1 = t1 * b1, w0 = u0 * e0, w1 = u1 * e1;
                    cu = __builtin_amdgcn_mfma_f32_16x16x32_bf16(packfrag(u0, u1), vf[s], cu, 0, 0, 0);
                    cw = __builtin_amdgcn_mfma_f32_16x16x32_bf16(packfrag(w0, w1), kf[s], cw, 0, 0, 0);
                }
                *(f32x4*)(UT + (size_t)(16 * wave + fr) * 64 + 16 * ti + 4 * fq) = cu;
#pragma unroll
                for (int jj = 0; jj < 4; ++jj) Wp[(16 * ti + 4 * fq + jj) * 128 + 32 * (wave >> 1) + 8 * (fr >> 2) + 4 * (wave & 1) + (fr & 3)] = (bf16)f2bf(cw[jj]);
            }
        }
        __syncthreads();
    }
}
__device__ __forceinline__ void p14_pool(Frame& F, KArgs A) {
    const int lane = F.lane, tid = F.tid, gw = F.bid * NWAVES + F.wave, NGW = F.G * NWAVES;
    LAS float* pw = (LAS float*)(F.lds + 16384);
    LAS float* dl = (LAS float*)(F.lds + 16384 + 65536 + F.wave * 1024);
    {   f32x4 pv[8];
#pragma unroll
        for (int j = 0; j < 8; ++j) pv[j] = *(const f32x4*)(A->in[I_CD_POOLW] + (size_t)(tid + NTHREADS * j) * 4);
#pragma unroll
        for (int j = 0; j < 8; ++j) *(LAS f32x4*)(pw + (tid + NTHREADS * j) * 4) = pv[j];
    }
    __syncthreads();
    const bf16* QK = WSP(bf16, WS_QKVZ); bf16* AO = WSP(bf16, WS_AO);
    const int gi = lane >> 4, w = 2 << gi;
    float sc[4];
#pragma unroll
    for (int g = 0; g < 4; ++g) sc[g] = A->in[I_CD_POOLS][g * 64 + lane];
    for (int row = gw; row < M; row += NGW) {
        const int pos = row & (SEQ - 1);
        const int cntw = (pos + 1 < w) ? pos + 1 : w;
        float sum[4] = {0.f, 0.f, 0.f, 0.f}, cur[4] = {0.f, 0.f, 0.f, 0.f};
        v2u xw[16];
#pragma unroll
        for (int j = 0; j < 16; ++j) xw[j] = *(const v2u*)(QK + (size_t)(row - (j <= pos ? j : pos)) * 2560 + 2304 + 4 * lane);
#pragma unroll
        for (int j = 0; j < 16; ++j) {
            const float f0 = bflo(xw[j].x), f1 = bfhi(xw[j].x), f2 = bflo(xw[j].y), f3 = bfhi(xw[j].y);
            if (j < cntw) { sum[0] += f0; sum[1] += f1; sum[2] += f2; sum[3] += f3; }
            if (j == 0) { cur[0] = f0; cur[1] = f1; cur[2] = f2; cur[3] = f3; }
        }
        const float inv = 1.0f / (float)cntw;
#pragma unroll
        for (int i = 0; i < 4; ++i) dl[4 * lane + i] = sum[i] * inv - cur[i];
        float o[4] = {0.f, 0.f, 0.f, 0.f};
        for (int c = 0; c < 64; ++c) {
#pragma unroll
            for (int g = 0; g < 4; ++g) o[g] += dl[g * 64 + c] * pw[(g * 64 + c) * 64 + lane];
        }
#pragma unroll
        for (int g = 0; g < 4; ++g) AO[(size_t)row * 1024 + 768 + g * 64 + lane] = (bf16)f2bf(o[g] * sc[g]);
    }
}


#define IN(k) (lo <= (k) && (k) < hi)
#define SEAM(k) do { if (IN(k) && IN((k) + 1)) xcd_barrier(bar); } while (0)
template <int l> __device__ __forceinline__ void layer_tail(Frame& F, const XcdBarrier& bar, const int lo, const int hi) {
    LAS unsigned char* ring = F.lds + RING_OFF;
    const int bid = F.bid, G = F.G;
        const int pb = 8 * l;

        if (IN(7 + pb)) {
            pg8::Gemm g{WSP(bf16, WS_AO), (l == 0) ? WSP(bf16, WS_W_OUTAB) : WSP(bf16, WS_W_OUTCD), M, 1024, (l == 0) ? 1536 : 1024}; pg8::StaticOrder S; S.init(M, 1024, G, bid);
            pg8::Epi<pg8::StPre> E{{(l == 0) ? kargs()->in[I_X] : WSP(float, WS_H2), WSP(float, WS_PRE), ALPHA}};
            pg8::gemm_phase<pg8::Epi<pg8::StPre>, pg8::StaticOrder, true, true>(ring, g, S, E);
        } SEAM(7 + pb);
        if (IN(8 + pb)) { p8_ln_router(F, kargs(), l, WSP(float, WS_H1), WSP(bf16, WS_H1B)); } SEAM(8 + pb);
        if (IN(9 + pb)) {
            p9_scatter(F, l, WSP(bf16, WS_H1B), WSP(float, WS_H1));
            __syncthreads();
            pg8::Gemm g{WSP(bf16, WS_H1B), WSP(bf16, WS_W_PG) + (size_t)l * 1024 * 1024, M, 1024, 1024}; pg8::StaticOrder S; S.init(M, 1024, G, bid);
            pg8::Epi<pg8::StPleGate> E{{WSP(bf16, WS_PP) + (size_t)l * M * 1024, WSP(bf16, WS_PLE)}};
            pg8::gemm_phase<pg8::Epi<pg8::StPleGate>, pg8::StaticOrder, true, true>(ring, g, S, E);
        } SEAM(9 + pb);
        const int* TILE = WSP(int, WS_ROUTE) + 3 * M * 4;
        if (IN(10 + pb)) {
            const int nT = __builtin_amdgcn_readfirstlane(TILE[NTMAX]);
            constexpr int EB = kMoeFp8 ? 1 : 2;
            pg8::Gemm g{WSP(bf16, WS_XS), (const bf16*)(F.ws + WS_W_GU + (size_t)l * NEXP * 2048 * 1024 * EB), PMAX, 2048, 1024 * EB / 2};
            pg8::MoeOrder S{TILE, nT, 8, G, bid, (long)2048 * 1024 * EB};
            pg8::Epi<pg8::StSwiglu<kMoeFp8>> E{{kargs()->in[I_BGU] + (size_t)l * NEXP * 2048, WSP(bf16, WS_HID)}};
            pg8::gemm_phase<pg8::Epi<pg8::StSwiglu<kMoeFp8>>, pg8::MoeOrder, true, false, kMoeFp8 ? kScaleGU : 0u>(ring, g, S, E);
        } SEAM(10 + pb);
        if (IN(11 + pb)) {
            const int nT = __builtin_amdgcn_readfirstlane(TILE[NTMAX]);
            constexpr int EB = kMoeFp8 ? 1 : 2;
            pg8::Gemm g{WSP(bf16, WS_HID), (const bf16*)(F.ws + WS_W_DN + (size_t)l * NEXP * 1024 * 1024 * EB), PMAX, 1024, 1024 * EB / 2};
            pg8::MoeOrder S{TILE, nT, 4, G, bid, (long)1024 * 1024 * EB};
            pg8::Epi<pg8::StDown> E{{kargs()->in[I_BDN] + (size_t)l * NEXP * 1024, WSP(bf16, WS_YS)}};
            pg8::gemm_phase<pg8::Epi<pg8::StDown>, pg8::MoeOrder, true, false, kMoeFp8 ? kScaleDN : 0u>(ring, g, S, E);
        } SEAM(11 + pb);
        if (IN(12 + pb)) { p12_combine(F, kargs(), l, WSP(float, WS_H1), (l == 0) ? WSP(float, WS_H2) : kargs()->out, (l == 0) ? WSP(bf16, WS_XB) : (bf16*)nullptr); }
}
#undef IN
#undef SEAM
__global__ void __launch_bounds__(NTHREADS, 2) mk_fwd(Args args_by_value) {
    const KArgs KA = kargs();
    extern __shared__ __attribute__((aligned(16))) unsigned char lds[];
    Frame F;
    F.lds = (LAS unsigned char*)lds;
    F.tid = threadIdx.x; F.lane = F.tid & 63; F.wave = __builtin_amdgcn_readfirstlane(F.tid >> 6);
    F.G = gridDim.x; F.bid = blockIdx.x; F.ws = KA->ws; F.ctl = (gu32*)(KA->ws + WS_CTL);
    volatile LAS unsigned* MISC = (volatile LAS unsigned*)(F.lds + MISC_OFF);
    { int t0 = threadIdx.x; asm volatile("" : "+v"(t0)); for (int u = t0; u < (LDS_BYTES - MISC_OFF) / 4; u += NTHREADS) MISC[u] = 0u; }
    __syncthreads();
    const bool use_bar = (N_LAUNCHES != NPHASES);
    XcdBarrier bar; bar.bar = (unsigned*)(F.ctl + CW_BAR) + KA->li * XCD_BAR_WORDS; bar.x = 0; bar.st = nullptr; bar.expect = 0;
    XcdBarrier bar2 = bar;
    if (use_bar && F.bid >= SEQ_WGS && F.G > SEQ_WGS) bar2 = xcd_barrier_post((unsigned*)(F.ctl + CW_BAR2), MISC + 10, (unsigned)(F.G - SEQ_WGS));
    if (use_bar) bar = xcd_barrier_post((unsigned*)(F.ctl + CW_BAR) + KA->li * XCD_BAR_WORDS, MISC + 8);
    const int lo = KA->ph_lo, hi = KA->ph_hi;
#define IN(k) (lo <= (k) && (k) < hi)
#define SEAM(k) do { if (IN(k) && IN((k) + 1)) xcd_barrier(bar); } while (0)
    LAS unsigned char* ring = F.lds + RING_OFF;
    const int bid = F.bid, G = F.G;

    if (IN(0)) { p0_prologue(F, kargs()); } SEAM(0);

            if (IN(1)) {
                { pg8::Gemm g{WSP(bf16, WS_XB), WSP(bf16, WS_W_INAB), M, 2560, 1024}; pg8::StaticOrder S; S.init(M, 2560, G, bid);
                  pg8::Epi<pg8::StInAB> E{{WSP(float, WS_SM), WSP(bf16, WS_QKVZ)}};
                  pg8::gemm_phase<pg8::Epi<pg8::StInAB>, pg8::StaticOrder, true, true>(ring, g, S, E); }
                __syncthreads();
                { pg8::Gemm g{WSP(bf16, WS_PB), WSP(bf16, WS_W_PP), 2 * M, 1024, 256}; pg8::BatchOrder S{4, (2 * M / 256) * 4, G, bid, M / 256, (long)1024 * 256 * 2};
                  pg8::Epi<pg8::StBf16> E{{WSP(bf16, WS_PP), 1024}};
                  pg8::gemm_phase<pg8::Epi<pg8::StBf16>, pg8::BatchOrder, true, true>(ring, g, S, E); }
            } SEAM(1);
            if (IN(2)) { p2_prep(F, kargs()); } SEAM(2);
            if (IN(3)) {
                p3_chunk_prep_mfma(F, kargs());
                __syncthreads();
                { pg8::Gemm g{WSP(bf16, WS_CQ), WSP(bf16, WS_W_ABS), M, 1536, 256}; pg8::StaticOrder S; S.init(M, 1536, G, bid);
                  pg8::Epi<pg8::StBf16> E{{WSP(bf16, WS_QL), 1536}};
                  pg8::gemm_phase<pg8::Epi<pg8::StBf16>, pg8::StaticOrder, true, true>(ring, g, S, E); }
            } SEAM(3);
            if (IN(4)) {
                if (bid < SEQ_WGS && G > SEQ_WGS) p4_delta_seq(F, bid);
                else { p4_indexer(F, (bid - SEQ_WGS) * NWAVES + F.wave, (G - SEQ_WGS) * NWAVES);
                    if (use_bar) { xcd_barrier(bar2);
                        p5_topk_attn(F, (bid - SEQ_WGS) * NWAVES + F.wave, (G - SEQ_WGS) * NWAVES); } }
            } SEAM(4);
            if (IN(5)) { if (!use_bar) p5_topk_attn(F, bid * NWAVES + F.wave, G * NWAVES); p6_gdn_out(F, kargs()); } SEAM(5);
    layer_tail<0>(F, bar, lo, hi);
    SEAM(12);
            if (IN(13)) {
                pg8::Gemm g{WSP(bf16, WS_XB), WSP(bf16, WS_W_INCD), M, 2560, 1024}; pg8::StaticOrder S; S.init(M, 2560, G, bid);
                pg8::Epi<pg8::StBf16> E{{WSP(bf16, WS_QKVZ), 2560}};
                pg8::gemm_phase<pg8::Epi<pg8::StBf16>, pg8::StaticOrder, true, true>(ring, g, S, E);
            } SEAM(13);
            if (IN(14)) { p14_dilated_mfma(F); __syncthreads(); p14_pool(F, kargs()); } SEAM(14);
    layer_tail<1>(F, bar, lo, hi);
#undef IN
#undef SEAM
}

extern "C" void kernel_launch(void* const* d_in, const int* in_sizes, int n_in, void* d_out, int out_size, void* d_ws, size_t ws_size, hipStream_t stream) {
    static int grid = 0;
    if (grid == 0) {
        if (n_in != N_IN || in_sizes[0] != M * D || out_size != M * D || ws_size < WS_END) {
            fprintf(stderr, "kernel_launch: built for %d inputs, x/out of %d floats, >= %zu bytes of workspace; got n_in %d, in0 %d, out %d, ws %zu; nothing launched\n", N_IN, M * D, (size_t)WS_END, n_in, n_in > 0 ? in_sizes[0] : -1, out_size, ws_size);
            grid = -1; return; }
        int dev = 0, cus = 0, per_cu = 0;
        if (hipGetDevice(&dev) != hipSuccess || hipDeviceGetAttribute(&cus, hipDeviceAttributeMultiprocessorCount, dev) != hipSuccess) { fprintf(stderr, "kernel_launch: device query failed\n"); grid = -1; return; }
        if (hipFuncSetAttribute((const void*)mk_fwd, hipFuncAttributeMaxDynamicSharedMemorySize, LDS_BYTES) != hipSuccess) { fprintf(stderr, "kernel_launch: hipFuncSetAttribute failed\n"); grid = -1; return; }
        if (hipOccupancyMaxActiveBlocksPerMultiprocessor(&per_cu, (const void*)mk_fwd, NTHREADS, LDS_BYTES) != hipSuccess || per_cu < 1)
            fprintf(stderr, "kernel_launch: note: occupancy query reports %d workgroups per CU\n", per_cu);
        (void)hipGetLastError();
        grid = cus;
    }
    if (grid < 0) return;
    if (hipMemsetAsync((char*)d_ws + WS_CTL, 0, CTL_ZERO_BYTES, stream) != hipSuccess) { fprintf(stderr, "kernel_launch: memset failed\n"); return; }
    Args a{};
    for (int i = 0; i < N_IN; ++i) a.in[i] = (const float*)d_in[i];
    a.out = (float*)d_out; a.ws = (unsigned char*)d_ws;
    for (int li = 0; li < N_LAUNCHES; ++li) {
        if (N_LAUNCHES == NPHASES) { a.ph_lo = li; a.ph_hi = li + 1; } else { a.ph_lo = (int)((long)li * NPHASES / N_LAUNCHES); a.ph_hi = (int)((long)(li + 1) * NPHASES / N_LAUNCHES); }
        a.li = li;
        hipLaunchKernelGGL(mk_fwd, dim3(grid), dim3(NTHREADS), LDS_BYTES, stream, a);
        const hipError_t le = hipPeekAtLastError();
        if (le != hipSuccess) { fprintf(stderr, "kernel_launch: launch %d failed: %s\n", li, hipGetErrorName(le)); break; }
    }
}
```

```cpp
#include <hip/hip_runtime.h>
#include <cstdio>
#include <cstdint>

namespace pg8 {
#define PG8_LAS __attribute__((address_space(3)))
typedef unsigned short bf16_t;
typedef short bf16x8 __attribute__((ext_vector_type(8)));
typedef float f32x4 __attribute__((ext_vector_type(4)));
typedef unsigned u32x4 __attribute__((ext_vector_type(4)));
constexpr int BM = 256, BK = 64, HALF = 128, HTB = HALF * BK * 2  , STAGE_BYTES = 8 * HTB, NXCD = 8, WGM = 8;

__host__ __device__ __forceinline__ int lds_byte(int r, int c) { const int st = (r >> 4) * 2 + (c >> 5), rr = r & 15, cc = c & 31, ob = rr * 64 + cc * 2; return st * 1024 + (ob ^ (((ob >> 9) & 1) << 5)); }
__host__ __device__ __forceinline__ void stage_rc(int b, int& R, int& C) { const int st = b / 1024, sb = b % 1024, swz = sb ^ (((sb >> 9) & 1) << 5); R = (st >> 1) * 16 + swz / 64; C = (st & 1) * 32 + (swz % 64) / 2; }
__host__ __device__ __forceinline__ int perm32(int rho) { const int n = rho >> 4, i = rho & 15; return 8 * (i >> 2) + 4 * n + (i & 3); }

struct Unit { int pm, pn, e; long bofs; };
struct Gemm { const bf16_t* A; const bf16_t* Bt; int M, N, K; };

struct StaticOrder {
    int nM, nN, nwg, G, c;
    __host__ __device__ void init(int M, int N, int G_, int c_) { nM = M / BM; nN = N / BM; nwg = nM * nN; G = G_; c = c_; }
    __host__ __device__ bool next(int i, Unit& u) const {
        const long L = (long)i * G + c; if (L >= nwg) return false;
        int wgid = (int)L; { const int q = nwg / NXCD, r = nwg % NXCD, xcd = wgid % NXCD, off = wgid / NXCD; wgid = (xcd < r ? xcd * (q + 1) : r * (q + 1) + (xcd - r) * q) + off; }
        const int nig = WGM * nN, gid = wgid / nig, fm = gid * WGM, gsz = (nM - fm) < WGM ? (nM - fm) : WGM;
        u.pm = fm + ((wgid % nig) % gsz); u.pn = (wgid % nig) / gsz; u.e = 0; u.bofs = 0; return true;
    }
    __device__ __forceinline__ void a_ready(const Unit&) const {}
    __device__ __forceinline__ void done(const Unit&) const {}
};
struct MoeOrder {
    const int* tile_e; int nT, nN, G, c; long estride;
    __device__ __forceinline__ bool next(int i, Unit& u) const {
        if (G % (8 * nN) == 0) {
            const int rpx = G / (8 * nN), xcd = c & 7, idx = c >> 3;
            u.pm = (i * 8 + xcd) * rpx + idx % rpx; u.pn = idx / rpx;
            if (u.pm >= nT) return false;
        } else {
            const long L = (long)i * G + c; if (L >= (long)nT * nN) return false;
            u.pm = (int)(L / nN); u.pn = (int)(L % nN);
        }
        const int e = tile_e[u.pm]; u.e = e; u.bofs = (long)e * estride; return true;
    }
    __device__ __forceinline__ void a_ready(const Unit&) const {}
    __device__ __forceinline__ void done(const Unit&) const {}
};

struct BatchOrder {
    int nN, nwg, G, c, tiles_per_batch; long bstride;
    __device__ __forceinline__ bool next(int i, Unit& u) const {
        const long L = (long)i * G + c; if (L >= nwg) return false;
        u.pm = (int)(L / nN); u.pn = (int)(L % nN); const int e = u.pm / tiles_per_batch; u.e = e; u.bofs = (long)e * bstride; return true;
    }
    __device__ __forceinline__ void a_ready(const Unit&) const {}
    __device__ __forceinline__ void done(const Unit&) const {}
};

typedef float f32x2c __attribute__((ext_vector_type(2)));
typedef __bf16 bf16x2c __attribute__((ext_vector_type(2)));
__device__ __forceinline__ unsigned cvt_pk_bf16(float lo, float hi) { const f32x2c v = {lo, hi}; const bf16x2c b = __builtin_convertvector(v, bf16x2c); return __builtin_bit_cast(unsigned, b); }
__device__ __forceinline__ u32x4 pack8(const f32x4 v0, const f32x4 v1) { u32x4 w; w.x = cvt_pk_bf16(v0[0], v0[1]); w.y = cvt_pk_bf16(v0[2], v0[3]); w.z = cvt_pk_bf16(v1[0], v1[1]); w.w = cvt_pk_bf16(v1[2], v1[3]); return w; }
__device__ __forceinline__ float bf_lo(unsigned w) { return __uint_as_float(w << 16); }
__device__ __forceinline__ float bf_hi(unsigned w) { return __uint_as_float(w & 0xffff0000u); }
__device__ __forceinline__ float sigmoidf_(float x) { return __builtin_amdgcn_rcpf(1.0f + __builtin_amdgcn_exp2f(x * -1.4426950408889634f)); }
typedef unsigned u32x2 __attribute__((ext_vector_type(2)));

template <class T> struct Epi {
    static constexpr bool PERM = true, AFTER_DRAIN = false;
    T t;
    __device__ __forceinline__ void operator()(const f32x4 (&acc)[2][2][4][2], const Unit& u, int wr, int wc, int fr, int fq) const {
        const int row0 = u.pm * BM + wr * 64 + fr, col0 = u.pn * BM + wc * 32 + 8 * fq;
        f32x4 cb[2][2];
#pragma unroll
        for (int bj = 0; bj < 2; ++bj) t.colctx(col0 + bj * HALF, u, cb[bj][0], cb[bj][1]);
        f32x4 rc[2][2], rn[2][2];
#pragma unroll
        for (int bj = 0; bj < 2; ++bj) t.rowctx(row0, col0 + bj * HALF, rc[bj][0], rc[bj][1]);
#pragma unroll
        for (int g = 0; g < 8; ++g) {
            const int ai = g >> 2, m = g & 3, row = row0 + ai * HALF + m * 16;
            if (g < 7) { const int nrow = row0 + ((g + 1) >> 2) * HALF + ((g + 1) & 3) * 16;
#pragma unroll
                for (int bj = 0; bj < 2; ++bj) t.rowctx(nrow, col0 + bj * HALF, rn[bj][0], rn[bj][1]); }
#pragma unroll
            for (int bj = 0; bj < 2; ++bj) t.store(row, col0 + bj * HALF, acc[ai][bj][m][0] + cb[bj][0], acc[ai][bj][m][1] + cb[bj][1], u, rc[bj][0], rc[bj][1]);
            asm volatile("" ::: "memory");
#pragma unroll
            for (int bj = 0; bj < 2; ++bj) { rc[bj][0] = rn[bj][0]; rc[bj][1] = rn[bj][1]; }
        }
    }
};
struct StBf16 { bf16_t* O; int ld;
    __device__ __forceinline__ void rowctx(int, int, f32x4& r0, f32x4& r1) const { r0 = (f32x4){0.f, 0.f, 0.f, 0.f}; r1 = r0; }
    __device__ __forceinline__ void colctx(int, const Unit&, f32x4& c0, f32x4& c1) const { c0 = (f32x4){0.f, 0.f, 0.f, 0.f}; c1 = c0; }
    __device__ __forceinline__ void store(int row, int col, f32x4 v0, f32x4 v1, const Unit&, f32x4, f32x4) const { *(u32x4*)(O + (size_t)row * ld + col) = pack8(v0, v1); } };
struct StInAB { float* SM; bf16_t* Q;
    __device__ __forceinline__ void rowctx(int, int, f32x4& r0, f32x4& r1) const { r0 = (f32x4){0.f, 0.f, 0.f, 0.f}; r1 = r0; }
    __device__ __forceinline__ void colctx(int, const Unit&, f32x4& c0, f32x4& c1) const { c0 = (f32x4){0.f, 0.f, 0.f, 0.f}; c1 = c0; }
    __device__ __forceinline__ void store(int row, int col, f32x4 v0, f32x4 v1, const Unit&, f32x4, f32x4) const {
        if (col < 512) { float* p = SM + (size_t)row * 512 + col; *(f32x4*)p = v0; *(f32x4*)(p + 4) = v1; }
        else *(u32x4*)(Q + (size_t)row * 2048 + (col - 512)) = pack8(v0, v1); } };
struct StPre { const float* base; float* P; float alpha;
    __device__ __forceinline__ void colctx(int, const Unit&, f32x4& c0, f32x4& c1) const { c0 = (f32x4){0.f, 0.f, 0.f, 0.f}; c1 = c0; }
    __device__ __forceinline__ void rowctx(int row, int col, f32x4& r0, f32x4& r1) const { const size_t o = (size_t)row * 1024 + col; r0 = *(const f32x4*)(base + o); r1 = *(const f32x4*)(base + o + 4); }
    __device__ __forceinline__ void store(int row, int col, f32x4 v0, f32x4 v1, const Unit&, f32x4 b0, f32x4 b1) const {
        const size_t o = (size_t)row * 1024 + col;
        *(f32x4*)(P + o) = b0 * alpha + v0; *(f32x4*)(P + o + 4) = b1 * alpha + v1; } };
struct StPleGate { const bf16_t* PP; bf16_t* O;
    __device__ __forceinline__ void colctx(int, const Unit&, f32x4& c0, f32x4& c1) const { c0 = (f32x4){0.f, 0.f, 0.f, 0.f}; c1 = c0; }
    __device__ __forceinline__ void rowctx(int row, int col, f32x4& r0, f32x4& r1) const { r0 = *(const f32x4*)(PP + (size_t)row * 1024 + col); r1 = r0; }
    __device__ __forceinline__ void store(int row, int col, f32x4 v0, f32x4 v1, const Unit&, f32x4 pr, f32x4) const {
        const size_t o = (size_t)row * 1024 + col; const u32x4 p = __builtin_bit_cast(u32x4, pr);
        f32x4 r0, r1;
        r0[0] = sigmoidf_(v0[0]) * bf_lo(p.x); r0[1] = sigmoidf_(v0[1]) * bf_hi(p.x); r0[2] = sigmoidf_(v0[2]) * bf_lo(p.y); r0[3] = sigmoidf_(v0[3]) * bf_hi(p.y);
        r1[0] = sigmoidf_(v1[0]) * bf_lo(p.z); r1[1] = sigmoidf_(v1[1]) * bf_hi(p.z); r1[2] = sigmoidf_(v1[2]) * bf_lo(p.w); r1[3] = sigmoidf_(v1[3]) * bf_hi(p.w);
        *(u32x4*)(O + o) = pack8(r0, r1); } };
template <bool F8> struct StSwiglu { const float* bgu; bf16_t* H;
    __device__ __forceinline__ void rowctx(int, int, f32x4& r0, f32x4& r1) const { r0 = (f32x4){0.f, 0.f, 0.f, 0.f}; r1 = r0; }
    __device__ __forceinline__ float act(float g, float u) const { const float gt = __builtin_amdgcn_fmed3f(g, -INFINITY, 7.0f), up = __builtin_amdgcn_fmed3f(u, -7.0f, 7.0f);
        return (up + 1.0f) * (gt * __builtin_amdgcn_rcpf(1.0f + __builtin_amdgcn_exp2f(gt * -2.4554669595930157f))); }
    __device__ __forceinline__ void colctx(int col, const Unit& u, f32x4& c0, f32x4& c1) const { const float* b = bgu + (size_t)u.e * 2048 + col; c0 = *(const f32x4*)b; c1 = *(const f32x4*)(b + 4); }
    __device__ __forceinline__ void store(int row, int col, f32x4 v0, f32x4 v1, const Unit& u, f32x4, f32x4) const {
        if (F8) { unsigned w = 0u; w = __builtin_amdgcn_cvt_pk_fp8_f32(act(v0[0], v0[1]), act(v0[2], v0[3]), w, false); w = __builtin_amdgcn_cvt_pk_fp8_f32(act(v1[0], v1[1]), act(v1[2], v1[3]), w, true);
            *(unsigned*)((unsigned char*)H + (size_t)row * 1024 + (col >> 1)) = w; }
        else { u32x2 w; w.x = cvt_pk_bf16(act(v0[0], v0[1]), act(v0[2], v0[3])); w.y = cvt_pk_bf16(act(v1[0], v1[1]), act(v1[2], v1[3]));
            *(u32x2*)(H + (size_t)row * 1024 + (col >> 1)) = w; } } };
struct StDown { const float* bd; bf16_t* Y;
    __device__ __forceinline__ void rowctx(int, int, f32x4& r0, f32x4& r1) const { r0 = (f32x4){0.f, 0.f, 0.f, 0.f}; r1 = r0; }
    __device__ __forceinline__ void colctx(int col, const Unit& u, f32x4& c0, f32x4& c1) const { const float* b = bd + (size_t)u.e * 1024 + col; c0 = *(const f32x4*)b; c1 = *(const f32x4*)(b + 4); }
    __device__ __forceinline__ void store(int row, int col, f32x4 v0, f32x4 v1, const Unit& u, f32x4, f32x4) const {
        *(u32x4*)(Y + (size_t)row * 1024 + col) = pack8(v0, v1); } };

typedef int i32x8 __attribute__((ext_vector_type(8)));
typedef int i32x4 __attribute__((ext_vector_type(4)));
template <class Epi, class Sched, bool ALIGN_EPI = false, bool SP2 = false, unsigned FP8W = 0u>
__device__ __forceinline__ void gemm_phase(PG8_LAS unsigned char* lds, const Gemm g, const Sched& S, const Epi& E) {
    int tid = threadIdx.x; asm volatile("" : "+v"(tid));
    const int wid = __builtin_amdgcn_readfirstlane(tid >> 6), lane = tid & 63, wr = wid >> 2, wc = wid & 3, fr = lane & 15, fq = lane >> 4;
    int K = g.K; asm volatile("" : "+s"(K));
    const int nt = K / BK;
    unsigned voffA[2], voffB[2];
#pragma unroll
    for (int i = 0; i < 2; ++i) { int R, C; stage_rc(tid * 16 + i * 8192, R, C); const int Rb = Epi::PERM ? ((R & ~31) + perm32(R & 31)) : R;
        voffA[i] = (unsigned)(R * K + C) * 2u; voffB[i] = (unsigned)(Rb * K + C) * 2u; }
    const size_t kstep = (size_t)(BK * 2);
    const size_t hstep = (size_t)HALF * K * 2;
    const size_t tstep = 2 * hstep;
    const unsigned ldsw = (unsigned)wid * 1024u;
    const int aoff = lds_byte(wr * 64 + fr, fq * 8), boff = lds_byte(wc * 32 + fr, fq * 8);
#define PG8_SA(b, h) (((b) * 2 + (h)) * HTB)
#define PG8_SB(b, h) ((4 + (b) * 2 + (h)) * HTB)
#define PG8_STAGE(bufoff, gbase, voff) do { _Pragma("unroll") for (int _i = 0; _i < 2; ++_i) \
        __builtin_amdgcn_global_load_lds((const unsigned*)((const char*)(gbase) + (voff)[_i]), (PG8_LAS unsigned*)(lds + (bufoff) + ldsw + _i * 8192), 16, 0, 0); } while (0)
#define PG8_CAT(lo, hi) __builtin_shufflevector((lo), (hi), 0, 1, 2, 3, 4, 5, 6, 7)
#define PG8_LDA(dst, b, h) do { if constexpr (FP8W != 0u) { _Pragma("unroll") for (int m = 0; m < 4; ++m) dst##8[m] = PG8_CAT(*(const PG8_LAS i32x4*)(lds + PG8_SA(b, h) + aoff + m * 2048), *(const PG8_LAS i32x4*)(lds + PG8_SA(b, h) + aoff + m * 2048 + 1024)); } \
        else { _Pragma("unroll") for (int m = 0; m < 4; ++m) _Pragma("unroll") for (int k = 0; k < 2; ++k) dst[m][k] = *(const PG8_LAS bf16x8*)(lds + PG8_SA(b, h) + aoff + m * 2048 + k * 1024); } } while (0)
#define PG8_LDB(dst, b, h) do { if constexpr (FP8W != 0u) { _Pragma("unroll") for (int n = 0; n < 2; ++n) dst##8[n] = PG8_CAT(*(const PG8_LAS i32x4*)(lds + PG8_SB(b, h) + boff + n * 2048), *(const PG8_LAS i32x4*)(lds + PG8_SB(b, h) + boff + n * 2048 + 1024)); } \
        else { _Pragma("unroll") for (int n = 0; n < 2; ++n) _Pragma("unroll") for (int k = 0; k < 2; ++k) dst[n][k] = *(const PG8_LAS bf16x8*)(lds + PG8_SB(b, h) + boff + n * 2048 + k * 1024); } } while (0)
#define PG8_MMA(ai, bj, At, Bt) do { __builtin_amdgcn_s_setprio(1); _Pragma("unroll") for (int m = 0; m < 4; ++m) _Pragma("unroll") for (int n = 0; n < 2; ++n) { \
        if constexpr (FP8W != 0u) asm volatile("v_mfma_scale_f32_16x16x128_f8f6f4 %0, %1, %2, %0, %3, %4 op_sel_hi:[0,0,0]" : "+v"(acc[ai][bj][m][n]) : "v"(Bt##8[n]), "v"(At##8[m]), "v"(sc_w), "v"(sc_x));   \
        else { _Pragma("unroll") for (int k = 0; k < 2; ++k) acc[ai][bj][m][n] = __builtin_amdgcn_mfma_f32_16x16x32_bf16(Bt[n][k], At[m][k], acc[ai][bj][m][n], 0, 0, 0); } } __builtin_amdgcn_s_setprio(0); } while (0)
#define PG8_WAIT_V(n) asm volatile("s_waitcnt vmcnt(" #n ")" ::: "memory")
#define PG8_WAIT_L(n) asm volatile("s_waitcnt lgkmcnt(" #n ")" ::: "memory")
#define PG8_BAR __builtin_amdgcn_s_barrier()
#define PG8_SCHED __builtin_amdgcn_sched_barrier(0)
    Unit cur, nxt; int ui = 0;
    if (!S.next(0, cur)) return;
    f32x4 acc[2][2][4][2];
#pragma unroll
    for (int a = 0; a < 2; ++a)
#pragma unroll
        for (int b = 0; b < 2; ++b)
#pragma unroll
            for (int m = 0; m < 4; ++m)
#pragma unroll
                for (int n = 0; n < 2; ++n) acc[a][b][m][n] = (f32x4){0.f, 0.f, 0.f, 0.f};
    bf16x8 At[4][2], B0[2][2], B1[2][2];
    int sc_w = (int)FP8W, sc_x = 0x7f7f7f7f; asm volatile("" : "+v"(sc_w), "+v"(sc_x));
    i32x8 At8[4], B08[2], B18[2];
    const char* cA = (const char*)g.A + (size_t)cur.pm * tstep; const char* cB = (const char*)g.Bt + (size_t)cur.pn * tstep + cur.bofs;
    S.a_ready(cur);
    if constexpr (SP2) {
        PG8_STAGE(PG8_SB(0, 0), cB, voffB); PG8_STAGE(PG8_SB(0, 1), cB + hstep, voffB); PG8_STAGE(PG8_SA(0, 0), cA, voffA); PG8_STAGE(PG8_SA(0, 1), cA + hstep, voffA);
        if (wr == 1) PG8_BAR;
        PG8_WAIT_V(2); PG8_BAR;
        PG8_STAGE(PG8_SB(1, 0), cB + kstep, voffB); PG8_STAGE(PG8_SA(1, 0), cA + kstep, voffA); PG8_STAGE(PG8_SB(1, 1), cB + hstep + kstep, voffB);
        PG8_WAIT_V(6); PG8_BAR;
    } else {
        PG8_STAGE(PG8_SB(0, 0), cB, voffB); PG8_STAGE(PG8_SA(0, 0), cA, voffA); PG8_STAGE(PG8_SB(0, 1), cB + hstep, voffB); PG8_STAGE(PG8_SA(0, 1), cA + hstep, voffA);
        if (wr == 1) PG8_BAR;
        PG8_WAIT_V(4); PG8_BAR;
        PG8_STAGE(PG8_SB(1, 0), cB + kstep, voffB); PG8_STAGE(PG8_SA(1, 0), cA + kstep, voffA); PG8_STAGE(PG8_SB(1, 1), cB + hstep + kstep, voffB);
        PG8_WAIT_V(6); PG8_BAR;
    }
    for (;;) {
        const bool has_next = S.next(ui + 1, nxt);
        const char* nA = has_next ? (const char*)g.A + (size_t)nxt.pm * tstep : cA; const char* nB = has_next ? (const char*)g.Bt + (size_t)nxt.pn * tstep + nxt.bofs : cB;
        for (int t = 0; t < nt; t += 2) {
            const bool last = (t == nt - 2);
            const char* a1 = cA + (size_t)(t + 1) * kstep;
            const char* a2 = last ? nA : cA + (size_t)(t + 2) * kstep; const char* b2 = last ? nB : cB + (size_t)(t + 2) * kstep;
            const char* a3 = a2 + kstep; const char* b3 = b2 + kstep;
            if (last && has_next) S.a_ready(nxt);
            if constexpr (SP2) {
            PG8_LDB(B0, 0, 0); PG8_LDB(B1, 0, 1); PG8_SCHED; PG8_LDA(At, 0, 0); PG8_STAGE(PG8_SA(1, 1), a1 + hstep, voffA);
            PG8_WAIT_V(8); PG8_WAIT_L(0); PG8_BAR; PG8_MMA(0, 0, At, B0); PG8_MMA(0, 1, At, B1); PG8_BAR; PG8_SCHED;
            PG8_LDA(At, 0, 1); PG8_STAGE(PG8_SB(0, 0), b2, voffB); PG8_STAGE(PG8_SB(0, 1), b2 + hstep, voffB); PG8_STAGE(PG8_SA(0, 0), a2, voffA);
            PG8_WAIT_V(8); PG8_WAIT_L(0); PG8_BAR; PG8_MMA(1, 0, At, B0); PG8_MMA(1, 1, At, B1); PG8_BAR; PG8_SCHED;
            PG8_LDB(B0, 1, 0); PG8_LDB(B1, 1, 1); PG8_SCHED; PG8_LDA(At, 1, 0); PG8_STAGE(PG8_SA(0, 1), a2 + hstep, voffA);
            PG8_WAIT_V(8); PG8_WAIT_L(0); PG8_BAR; PG8_MMA(0, 0, At, B0); PG8_MMA(0, 1, At, B1); PG8_BAR; PG8_SCHED;
            PG8_LDA(At, 1, 1); PG8_STAGE(PG8_SB(1, 0), b3, voffB); PG8_STAGE(PG8_SB(1, 1), b3 + hstep, voffB); PG8_STAGE(PG8_SA(1, 0), a3, voffA);
            PG8_WAIT_V(8); PG8_WAIT_L(0); PG8_BAR; PG8_MMA(1, 0, At, B0); PG8_MMA(1, 1, At, B1); PG8_BAR; PG8_SCHED;
            } else {
            PG8_LDB(B0, 0, 0); PG8_SCHED; PG8_LDA(At, 0, 0); PG8_STAGE(PG8_SA(1, 1), a1 + hstep, voffA);
            PG8_WAIT_L(8); PG8_BAR; PG8_WAIT_L(0); PG8_MMA(0, 0, At, B0); PG8_BAR; PG8_SCHED;
            PG8_LDB(B1, 0, 1); PG8_STAGE(PG8_SB(0, 0), b2, voffB);
            PG8_BAR; PG8_WAIT_L(0); PG8_MMA(0, 1, At, B1); PG8_BAR;
            PG8_LDA(At, 0, 1); PG8_STAGE(PG8_SA(0, 0), a2, voffA);
            PG8_BAR; PG8_WAIT_L(0); PG8_MMA(1, 0, At, B0); PG8_BAR; PG8_SCHED;
            PG8_STAGE(PG8_SB(0, 1), b2 + hstep, voffB);
            PG8_WAIT_V(6); PG8_BAR; PG8_MMA(1, 1, At, B1); PG8_BAR;
            PG8_LDB(B0, 1, 0); PG8_SCHED; PG8_LDA(At, 1, 0); PG8_STAGE(PG8_SA(0, 1), a2 + hstep, voffA);
            PG8_WAIT_L(8); PG8_BAR; PG8_WAIT_L(0); PG8_MMA(0, 0, At, B0); PG8_BAR; PG8_SCHED;
            PG8_LDB(B1, 1, 1); PG8_STAGE(PG8_SB(1, 0), b3, voffB);
            PG8_BAR; PG8_WAIT_L(0); PG8_MMA(0, 1, At, B1); PG8_BAR;
            PG8_LDA(At, 1, 1); PG8_STAGE(PG8_SA(1, 0), a3, voffA);
            PG8_BAR; PG8_WAIT_L(0); PG8_MMA(1, 0, At, B0); PG8_BAR; PG8_SCHED;
            PG8_STAGE(PG8_SB(1, 1), b3 + hstep, voffB);
            PG8_WAIT_V(6); PG8_BAR; PG8_MMA(1, 1, At, B1); PG8_BAR;
            }
        }
        if constexpr (FP8W != 0u) asm volatile("s_nop 15\n\ts_nop 15" ::: "memory");
        if constexpr (ALIGN_EPI) { if (wr == 0) PG8_BAR; }
        if constexpr (!Epi::AFTER_DRAIN) { E(acc, cur, wr, wc, fr, fq); S.done(cur); }
        if (!has_next) break;
#pragma unroll
        for (int a = 0; a < 2; ++a)
#pragma unroll
            for (int b = 0; b < 2; ++b)
#pragma unroll
                for (int m = 0; m < 4; ++m)
#pragma unroll
                    for (int n = 0; n < 2; ++n) acc[a][b][m][n] = (f32x4){0.f, 0.f, 0.f, 0.f};
        cur = nxt; cA = nA; cB = nB; ++ui;
        if constexpr (ALIGN_EPI) { if (wr == 1) PG8_BAR; }
    }
    PG8_WAIT_V(0);
    if constexpr (!ALIGN_EPI) { if (wr == 0) PG8_BAR; }
    PG8_BAR;
    if constexpr (Epi::AFTER_DRAIN) { E.fused(acc, cur, wr, wc, fr, fq, lds, wid, lane); S.done(cur); }
#undef PG8_SA
#undef PG8_SB
#undef PG8_STAGE
#undef PG8_LDA
#undef PG8_CAT
#undef PG8_LDB
#undef PG8_MMA
#undef PG8_WAIT_V
#undef PG8_WAIT_L
#undef PG8_BAR
#undef PG8_SCHED
}
}

constexpr int NWAVES = 8, NTHREADS = 512;
constexpr int BATCH = 2, SEQ = 8192, M = BATCH * SEQ, D = 1024;
constexpr int NEXP = 32, DEXP = 1024;
constexpr int PMAX = M * 4 + NEXP * 256, NTMAX = PMAX / 256;
constexpr float ALPHA = 1.41421356237f;
constexpr int NPHASES = 21;
#ifndef MOE_FP8
#define MOE_FP8 1
#endif
constexpr bool kMoeFp8 = (MOE_FP8 != 0);
constexpr unsigned kScaleGU = 0x79797979u, kScaleDN = 0x78787878u;
#ifndef MK_N_LAUNCHES
#define MK_N_LAUNCHES 1
#endif
constexpr int N_LAUNCHES = MK_N_LAUNCHES;

enum { I_X = 0, I_P, I_AB_WIN, I_AB_QG, I_AB_KVG, I_AB_WUQ, I_AB_WUK, I_AB_WUV, I_AB_WQIDX, I_AB_KIG, I_AB_KIB, I_AB_CONVW, I_AB_ALOG, I_AB_DTB, I_AB_ONG, I_AB_WOUT,
       I_CD_WIN, I_CD_POOLW, I_CD_POOLS, I_CD_WOUT, I_LNM_G, I_LNM_B, I_RW, I_RB, I_WGU, I_BGU, I_WDN, I_BDN, I_PLE_WP, I_PLE_WG, I_LNF_G, I_LNF_B, N_IN };

constexpr size_t MiB = 1u << 20;
constexpr size_t WS_CTL = 0, CTL_ZERO_BYTES = 1 * MiB;
constexpr size_t WS_W_INAB = 1 * MiB;
constexpr size_t WS_W_ABS = 6 * MiB;
constexpr size_t WS_W_OUTAB = 7 * MiB;
constexpr size_t WS_W_INCD = 10 * MiB;
constexpr size_t WS_W_OUTCD = 15 * MiB;
constexpr size_t WS_W_PG = 17 * MiB;
constexpr size_t WS_W_PP = 21 * MiB;
constexpr size_t WS_W_GU = 22 * MiB;
constexpr size_t WS_W_DN = 278 * MiB;
constexpr size_t WS_XB = 406 * MiB;
constexpr size_t WS_PB = 438 * MiB;
constexpr size_t WS_PP = 454 * MiB;
constexpr size_t WS_SM = 518 * MiB;
constexpr size_t WS_QKVZ = 550 * MiB;
constexpr size_t WS_CQ = 630 * MiB;
constexpr size_t WS_CKV = 638 * MiB;
constexpr size_t WS_KIDX = 642 * MiB;
constexpr size_t WS_WIDX = 644 * MiB;
constexpr size_t WS_BETA = 645 * MiB;
constexpr size_t WS_GG = WS_BETA + 512 * 1024;
constexpr size_t WS_QN = 646 * MiB, WS_KN = 662 * MiB, WS_VN = 678 * MiB;
constexpr size_t WS_QL = 694 * MiB;
constexpr size_t WS_CHK = 742 * MiB;
constexpr size_t WS_SEL = 838 * MiB;
constexpr size_t WS_NSEL = 854 * MiB;
constexpr size_t WS_ODELTA = 855 * MiB;
constexpr size_t WS_AO = 887 * MiB;
constexpr size_t WS_PRE = 935 * MiB;
constexpr size_t WS_H1 = 999 * MiB;
constexpr size_t WS_H2 = 1063 * MiB;
constexpr size_t WS_H1B = 1127 * MiB;
constexpr size_t WS_PLE = 1159 * MiB;
constexpr size_t WS_ROUTE = 1191 * MiB;
constexpr size_t WS_BIG = 1193 * MiB;
constexpr size_t WS_XS = WS_BIG, WS_HID = WS_BIG + 144 * MiB, WS_YS = WS_BIG + 288 * MiB;
constexpr size_t WS_END = WS_BIG + 512 * MiB;
static_assert((size_t)PMAX * 1024 * 2 <= 144 * MiB && WS_END <= 2048 * MiB, "d_ws map");
constexpr size_t CHK_WP = 0, CHK_QD = 16384, CHK_KDT = 32768, CHK_QK = 49152, CHK_UT = 57344, CHK_GL = 90112, CHK_STRIDE = 92160;
static_assert(CHK_STRIDE * 1024 <= 96 * MiB, "chunk operands");
constexpr int CW_TMO = 0, CW_CODE = 1;
constexpr int CW_BAR = 4096;
constexpr int CW_BAR2 = 8192;
constexpr int CW_CNT = 16384;

constexpr int RING_OFF = 0, RING_BYTES = 131072;
constexpr int WSCR_OFF = 132096, WSCR_BYTES = 1024;
constexpr int MISC_OFF = 140288;
constexpr int LDS_BYTES = 147456;

#define GAS __attribute__((address_space(1)))
#define LAS __attribute__((address_space(3)))
typedef unsigned short bf16;
typedef unsigned v4u __attribute__((ext_vector_type(4)));
typedef unsigned v2u __attribute__((ext_vector_type(2)));
typedef float f32x4 __attribute__((ext_vector_type(4)));
typedef short bf16x8 __attribute__((ext_vector_type(8)));
typedef GAS unsigned gu32;
#define RLX_AGENT __ATOMIC_RELAXED, __HIP_MEMORY_SCOPE_AGENT
typedef float f32x2_t __attribute__((ext_vector_type(2)));
typedef __bf16 bf16x2_t __attribute__((ext_vector_type(2)));
__device__ __forceinline__ unsigned pk2(float lo, float hi) { const f32x2_t v = {lo, hi}; const bf16x2_t b = __builtin_convertvector(v, bf16x2_t); return __builtin_bit_cast(unsigned, b); }
__device__ __forceinline__ unsigned f2bf(float f) { return pk2(f, 0.f) & 0xffffu; }
__device__ __forceinline__ float bflo(unsigned w) { return __uint_as_float(w << 16); }
__device__ __forceinline__ float bfhi(unsigned w) { return __uint_as_float(w & 0xffff0000u); }
__device__ __forceinline__ float bf1(bf16 h) { return __uint_as_float(((unsigned)h) << 16); }
__device__ __forceinline__ float sigm(float x) { return __builtin_amdgcn_rcpf(1.0f + __builtin_amdgcn_exp2f(x * -1.4426950408889634f)); }
__device__ __forceinline__ float siluf(float x) { return x * __builtin_amdgcn_rcpf(1.0f + __builtin_amdgcn_exp2f(x * -1.4426950408889634f)); }
__device__ __forceinline__ float wave_sum(float v) {
#pragma unroll
    for (int o = 1; o < 64; o <<= 1) v += __shfl_xor(v, o);
    return v;
}
__device__ __forceinline__ float wave_max(float v) {
#pragma unroll
    for (int o = 1; o < 64; o <<= 1) v = fmaxf(v, __shfl_xor(v, o));
    return v;
}
__device__ __forceinline__ int wave_sum_i(int v) {
#pragma unroll
    for (int o = 1; o < 64; o <<= 1) v += __shfl_xor(v, o);
    return v;
}
__device__ __forceinline__ void unpack8(const v4u w, float (&f)[8]) { f[0] = bflo(w.x); f[1] = bfhi(w.x); f[2] = bflo(w.y); f[3] = bfhi(w.y); f[4] = bflo(w.z); f[5] = bfhi(w.z); f[6] = bflo(w.w); f[7] = bfhi(w.w); }
__device__ __forceinline__ v4u pack8f(const float (&f)[8]) { v4u w; w.x = pk2(f[0], f[1]); w.y = pk2(f[2], f[3]); w.z = pk2(f[4], f[5]); w.w = pk2(f[6], f[7]); return w; }

#define XB_TMO      128
#define XB_XCNT(j)  (256  + 64 * (j))
#define XB_XSUB(j)  (1280 + 64 * (j))
#define XB_XGEN(j)  (2304 + 64 * (j))
#define XB_TOP      3328
#define XB_TOPGEN   3392
#define XCD_BAR_WORDS 3456
#define XB_SPIN_CAP (1u << 18)

__device__ __forceinline__ unsigned xb_ld(unsigned* p)              { return __hip_atomic_load(p, __ATOMIC_RELAXED, __HIP_MEMORY_SCOPE_AGENT); }
__device__ __forceinline__ unsigned xb_add(unsigned* p, unsigned v) { return __hip_atomic_fetch_add(p, v, __ATOMIC_RELAXED, __HIP_MEMORY_SCOPE_AGENT); }
__device__ __forceinline__ unsigned xb_xcc_id() { return (unsigned)__builtin_amdgcn_s_getreg((3 << 11) | 20) & 0xFu; }
#define XB_SPIN(cond, bar) do { unsigned _sp = 0; while (cond) { __builtin_amdgcn_s_sleep(1); \
    if ((++_sp & 255u) == 0u) { if (xb_ld(&(bar)[XB_TMO])) break; if (_sp > XB_SPIN_CAP) { atomicAdd(&(bar)[XB_TMO], 1u); break; } } } } while (0)

struct XcdBarrier {
    unsigned* bar; unsigned x;
    unsigned expect;
    volatile LAS unsigned* st;
};

__device__ __forceinline__ XcdBarrier xcd_barrier_post(unsigned* bar, volatile LAS unsigned* st, unsigned expect = 0u) {
    XcdBarrier b; b.bar = bar; b.x = xb_xcc_id(); b.st = st; b.expect = expect ? expect : gridDim.x * gridDim.y * gridDim.z;
    if (threadIdx.x == 0) (void)xb_add(&bar[XB_XCNT(b.x)], 1u);
    return b;
}
__device__ __forceinline__ void xcd_barrier_complete(unsigned* bar, unsigned x, unsigned& nloc, unsigned& nx, const unsigned G) {
    unsigned sum, cnt, mine, sp = 0u;
    for (;;) {
        sum = 0u; cnt = 0u; mine = 0u;
#pragma unroll
        for (unsigned j = 0; j < 16; ++j) { const unsigned c = xb_ld(&bar[XB_XCNT(j)]); sum += c; cnt += (c > 0u) ? 1u : 0u; mine = (j == x) ? c : mine; }
        if (sum == G) break;
        __builtin_amdgcn_s_sleep(1);
        if ((++sp & 255u) == 0u) { if (xb_ld(&bar[XB_TMO])) break; if (sp > XB_SPIN_CAP) { atomicAdd(&bar[XB_TMO], 1u); break; } }
    }
    nloc = mine > 0u ? mine : 1u; nx = cnt > 0u ? cnt : 1u;
}

__device__ __forceinline__ void xcd_barrier(const XcdBarrier& b) {
    asm volatile("s_waitcnt vmcnt(0)" ::: "memory");
    __syncthreads();
    if (threadIdx.x == 0) {
        unsigned* bar = b.bar;
        __builtin_amdgcn_s_waitcnt(0);
        unsigned nloc = b.st[0], nx = b.st[1];
        if (nloc == 0u) { xcd_barrier_complete(bar, b.x, nloc, nx, b.expect); b.st[0] = nloc; b.st[1] = nx; }
        const unsigned old = xb_add(&bar[XB_XSUB(b.x)], 1u);
        const unsigned gen = old / nloc;
        if (old + 1u == (gen + 1u) * nloc) {
            __builtin_amdgcn_fence(__ATOMIC_RELEASE, "agent");
            asm volatile("s_waitcnt vmcnt(0)" ::: "memory");
            const unsigned og = xb_add(&bar[XB_TOP], 1u);
            const unsigned tg = og / nx;
            if (og + 1u == (tg + 1u) * nx) xb_add(&bar[XB_TOPGEN], 1u);
            else XB_SPIN(xb_ld(&bar[XB_TOPGEN]) == tg, bar);
            __builtin_amdgcn_fence(__ATOMIC_ACQUIRE, "agent");
            xb_add(&bar[XB_XGEN(b.x)], 1u);
            asm volatile("s_waitcnt vmcnt(0)" ::: "memory");
        } else {
            XB_SPIN(xb_ld(&bar[XB_XGEN(b.x)]) == gen, bar);
            __builtin_amdgcn_fence(__ATOMIC_ACQUIRE, "agent");
            asm volatile("s_waitcnt vmcnt(0)" ::: "memory");
        }
    }
    __syncthreads();
}

struct Args { const float* in[N_IN]; float* out; unsigned char* ws; int ph_lo, ph_hi, li, pad; };
typedef const __attribute__((address_space(4))) Args* KArgs;
__device__ __forceinline__ KArgs kargs() { auto p = __builtin_amdgcn_kernarg_segment_ptr(); asm volatile("" : "+s"(p)); return (KArgs)p; }
struct Frame {
    LAS unsigned char* lds;
    int tid, lane, wave, G, bid;
    unsigned char* ws;
    gu32* ctl;
};
#define WSP(T, off) ((T*)(F.ws + (off)))

struct MapId { __device__ __forceinline__ int operator()(int n) const { return n; } };
struct MapAdd { int off; __device__ __forceinline__ int operator()(int n) const { return n + off; } };
struct MapAB { __device__ __forceinline__ int operator()(int n) const { return n < 456 ? n : (n < 2504 ? n + 56 : n - 2048); } };
template <class Map> __device__ __forceinline__ void wg_transpose_item(const float* W, int N, int ldw, bf16* WT, int ldt, int koff, Map map, LAS float* scr, int item, int tid) {
    const int nblk = (N + 127) >> 7, kb = item / nblk, nb = item - kb * nblk, k0 = kb * 128, n0 = nb * 128;
#pragma unroll
    for (int it = 0; it < 8; ++it) {
        const int row = it * 16 + (tid >> 5), c4 = (tid & 31) * 4, n = n0 + c4;
        f32x4 v = (f32x4){0.f, 0.f, 0.f, 0.f};
        if (n + 3 < N) v = *(const f32x4*)(W + (size_t)(k0 + row) * ldw + n);
        LAS float* s = scr + row * 129 + c4; s[0] = v[0]; s[1] = v[1]; s[2] = v[2]; s[3] = v[3];
    }
    __syncthreads();
#pragma unroll
    for (int j = 0; j < 4; ++j) {
        const int idx = j * 512 + tid, nl = idx >> 4, ch = idx & 15, n = n0 + nl;
        if (n < N) { const LAS float* s = scr + (ch * 8) * 129 + nl;
            v4u o; o.x = pk2(s[0], s[129]); o.y = pk2(s[2 * 129], s[3 * 129]); o.z = pk2(s[4 * 129], s[5 * 129]); o.w = pk2(s[6 * 129], s[7 * 129]);
            *(v4u*)(WT + (size_t)map(n) * ldt + koff + k0 + ch * 8) = o; }
    }
    __syncthreads();
}
__device__ __forceinline__ void wg_transpose_item_fp8(const float* W, int N, int ldw, unsigned char* WT, int ldt, float mul, LAS float* scr, int item, int tid) {
    const int nblk = (N + 127) >> 7, kb = item / nblk, nb = item - kb * nblk, k0 = kb * 128, n0 = nb * 128;
#pragma unroll
    for (int it = 0; it < 8; ++it) {
        const int row = it * 16 + (tid >> 5), c4 = (tid & 31) * 4;
        const f32x4 v = *(const f32x4*)(W + (size_t)(k0 + row) * ldw + n0 + c4);
        LAS float* s = scr + row * 129 + c4; s[0] = v[0]; s[1] = v[1]; s[2] = v[2]; s[3] = v[3];
    }
    __syncthreads();
#pragma unroll
    for (int j = 0; j < 2; ++j) {
        const int idx = j * 512 + tid, nl = idx >> 3, ch = idx & 7;
        const LAS float* s = scr + (ch * 16) * 129 + nl;
        v4u o;
#pragma unroll
        for (int q = 0; q < 4; ++q) { unsigned w = 0u;
            w = __builtin_amdgcn_cvt_pk_fp8_f32(s[(4 * q) * 129] * mul, s[(4 * q + 1) * 129] * mul, w, false);
            w = __builtin_amdgcn_cvt_pk_fp8_f32(s[(4 * q + 2) * 129] * mul, s[(4 * q + 3) * 129] * mul, w, true);
            o[q] = w; }
        *(v4u*)(WT + (size_t)(n0 + nl) * ldt + k0 + ch * 16) = o;
    }
    __syncthreads();
}
struct MoeItem { const float* W; unsigned char* WT; int N; float mul; int k0, n0; };
__device__ __forceinline__ MoeItem moe_item(KArgs A, unsigned char* ws, int it) {
    MoeItem d; int sub;
    if (it < 64 * 128) { const int m = it >> 7; sub = it & 127; d.W = A->in[I_WGU] + (size_t)m * 1024 * 2048; d.N = 2048; d.WT = ws + WS_W_GU + (size_t)m * 2048 * 1024; d.mul = 64.0f; }
    else { it -= 64 * 128; const int m = it >> 6; sub = it & 63; d.W = A->in[I_WDN] + (size_t)m * 1024 * 1024; d.N = 1024; d.WT = ws + WS_W_DN + (size_t)m * 1024 * 1024; d.mul = 128.0f; }
    const int nblk = d.N >> 7, kb = sub / nblk, nb = sub - kb * nblk; d.k0 = kb * 128; d.n0 = nb * 128; return d;
}
__device__ __forceinline__ void p0_moe_fp8(Frame& F, KArgs A) {
    LAS float* scr = (LAS float*)(F.lds + RING_OFF);
    const int tid = F.tid; constexpr int NIT = 64 * 128 + 64 * 64;
    int it = F.bid; if (it >= NIT) return;
    MoeItem cur = moe_item(A, F.ws, it);
    f32x4 r[8];
#pragma unroll
    for (int x = 0; x < 8; ++x) r[x] = __builtin_nontemporal_load((const f32x4*)(cur.W + (size_t)(cur.k0 + x * 16 + (tid >> 5)) * cur.N + cur.n0 + (tid & 31) * 4));
    for (;;) {
#pragma unroll
        for (int x = 0; x < 8; ++x) { LAS float* sp = scr + (x * 16 + (tid >> 5)) * 129 + (tid & 31) * 4; sp[0] = r[x][0]; sp[1] = r[x][1]; sp[2] = r[x][2]; sp[3] = r[x][3]; }
        __syncthreads();
        const int nx = it + F.G; MoeItem nxt = cur;
        if (nx < NIT) { nxt = moe_item(A, F.ws, nx);
#pragma unroll
            for (int x = 0; x < 8; ++x) r[x] = __builtin_nontemporal_load((const f32x4*)(nxt.W + (size_t)(nxt.k0 + x * 16 + (tid >> 5)) * nxt.N + nxt.n0 + (tid & 31) * 4)); }
#pragma unroll
        for (int j = 0; j < 2; ++j) {
            const int idx = j * 512 + tid, nl = idx >> 3, ch = idx & 7;
            const LAS float* sp = scr + (ch * 16) * 129 + nl;
            v4u o;
#pragma unroll
            for (int q = 0; q < 4; ++q) { unsigned w = 0u;
                w = __builtin_amdgcn_cvt_pk_fp8_f32(sp[(4 * q) * 129] * cur.mul, sp[(4 * q + 1) * 129] * cur.mul, w, false);
                w = __builtin_amdgcn_cvt_pk_fp8_f32(sp[(4 * q + 2) * 129] * cur.mul, sp[(4 * q + 3) * 129] * cur.mul, w, true);
                o[q] = w; }
            *(v4u*)(cur.WT + (size_t)(cur.n0 + nl) * 1024 + cur.k0 + ch * 16) = o;
        }
        __syncthreads();
        if (nx >= NIT) break;
        cur = nxt; it = nx;
    }
}
__device__ __forceinline__ void p0_prologue(Frame& F, KArgs A) {
    LAS float* scr = (LAS float*)(F.lds + RING_OFF);
    const int tid = F.tid;
    constexpr int IT_GU = 128, IT_DN = 64;
    constexpr int N_GU = 64 * IT_GU, N_DN = 64 * IT_DN;
    constexpr int N_INAB = 8 * 20, N_INCD = 8 * 20, N_OUTCD = 64, N_PG = 2 * 64, N_PP = 2 * 2 * 8, N_QIDX = 2 * 4, N_OUTB = 4 * 8;
    constexpr int NITEMS = N_GU + N_DN + N_INAB + N_INCD + N_OUTCD + N_PG + N_PP + N_QIDX + N_OUTB;
    if (kMoeFp8) p0_moe_fp8(F, A);
    for (int it = F.bid + (kMoeFp8 ? N_GU + N_DN : 0); it < NITEMS; it += F.G) {
        int r = it;
        if (r < N_GU) { const int m = r / IT_GU;
            if (kMoeFp8) wg_transpose_item_fp8(A->in[I_WGU] + (size_t)m * 1024 * 2048, 2048, 2048, WSP(unsigned char, WS_W_GU) + (size_t)m * 2048 * 1024, 1024, 64.0f, scr, r % IT_GU, tid);
            else wg_transpose_item(A->in[I_WGU] + (size_t)m * 1024 * 2048, 2048, 2048, WSP(bf16, WS_W_GU) + (size_t)m * 2048 * 1024, 1024, 0, MapId{}, scr, r % IT_GU, tid);
            continue; } r -= N_GU;
        if (r < N_DN) { const int m = r / IT_DN;
            if (kMoeFp8) wg_transpose_item_fp8(A->in[I_WDN] + (size_t)m * 1024 * 1024, 1024, 1024, WSP(unsigned char, WS_W_DN) + (size_t)m * 1024 * 1024, 1024, 128.0f, scr, r % IT_DN, tid);
            else wg_transpose_item(A->in[I_WDN] + (size_t)m * 1024 * 1024, 1024, 1024, WSP(bf16, WS_W_DN) + (size_t)m * 1024 * 1024, 1024, 0, MapId{}, scr, r % IT_DN, tid);
            continue; } r -= N_DN;
        if (r < N_INAB) { wg_transpose_item(A->in[I_AB_WIN], 2512, 2512, WSP(bf16, WS_W_INAB), 1024, 0, MapAB{}, scr, r, tid); continue; } r -= N_INAB;
        if (r < N_INCD) { wg_transpose_item(A->in[I_CD_WIN], 2560, 2560, WSP(bf16, WS_W_INCD), 1024, 0, MapId{}, scr, r, tid); continue; } r -= N_INCD;
        if (r < N_OUTCD) { wg_transpose_item(A->in[I_CD_WOUT], 1024, 1024, WSP(bf16, WS_W_OUTCD), 1024, 0, MapId{}, scr, r, tid); continue; } r -= N_OUTCD;
        if (r < N_PG) { const int l = r / 64; wg_transpose_item(A->in[I_PLE_WG] + (size_t)l * 1024 * 1024, 1024, 1024, WSP(bf16, WS_W_PG) + (size_t)l * 1024 * 1024, 1024, 0, MapId{}, scr, r % 64, tid); continue; } r -= N_PG;
        if (r < N_PP) { const int l = r / 16; wg_transpose_item(A->in[I_PLE_WP] + (size_t)l * 256 * 1024, 1024, 1024, WSP(bf16, WS_W_PP) + (size_t)l * 1024 * 256, 256, 0, MapId{}, scr, r % 16, tid); continue; } r -= N_PP;
        if (r < N_QIDX) { wg_transpose_item(A->in[I_AB_WQIDX], 512, 512, WSP(bf16, WS_W_ABS), 256, 0, MapAdd{1024}, scr, r, tid); continue; } r -= N_QIDX;
        wg_transpose_item(A->in[I_AB_WOUT] + (size_t)512 * 1024, 1024, 1024, WSP(bf16, WS_W_OUTAB), 1536, 1024, MapId{}, scr, r, tid);
    }
    const size_t gt = (size_t)F.bid * NTHREADS + tid, GT = (size_t)F.G * NTHREADS;
    for (size_t i = gt; i < (size_t)48 * 1024 / 8; i += GT) *(v4u*)(WSP(bf16, WS_W_INAB) + (size_t)464 * 1024 + i * 8) = (v4u){0u, 0u, 0u, 0u};
    for (size_t i = gt; i < (size_t)1024 * 256; i += GT) {
        const int n = (int)(i >> 8), c = (int)(i & 255), h = n >> 7, r = n & 127;
        const float* a = A->in[I_AB_WUQ] + (size_t)c * 512 + h * 64; const float* b = A->in[I_AB_WUK] + (size_t)r * 512 + h * 64;
        float s = 0.f;
#pragma unroll 8
        for (int d = 0; d < 64; d += 4) { const f32x4 x = *(const f32x4*)(a + d), y = *(const f32x4*)(b + d); s += x[0] * y[0] + x[1] * y[1] + x[2] * y[2] + x[3] * y[3]; }
        WSP(bf16, WS_W_ABS)[i] = (bf16)f2bf(s * 0.125f);
    }
    for (size_t i = gt; i < (size_t)1024 * 128; i += GT) {
        const int n = (int)(i & 1023), k0 = (int)(i >> 10) * 8, h = k0 >> 7, r0 = k0 & 127;
        const float* bcol = A->in[I_AB_WOUT] + (size_t)(h * 64) * 1024 + n;
        float acc[8];
#pragma unroll
        for (int x = 0; x < 8; ++x) acc[x] = 0.f;
#pragma unroll 2
        for (int v0 = 0; v0 < 64; v0 += 8) {
            float bv[8];
#pragma unroll
            for (int v = 0; v < 8; ++v) bv[v] = bcol[(size_t)(v0 + v) * 1024];
#pragma unroll
            for (int x = 0; x < 8; ++x) { const float* ar = A->in[I_AB_WUV] + (size_t)(r0 + x) * 512 + h * 64 + v0; const f32x4 a0 = *(const f32x4*)ar, a1 = *(const f32x4*)(ar + 4);
                acc[x] += a0[0] * bv[0] + a0[1] * bv[1] + a0[2] * bv[2] + a0[3] * bv[3] + a1[0] * bv[4] + a1[1] * bv[5] + a1[2] * bv[6] + a1[3] * bv[7]; }
        }
        *(v4u*)(WSP(bf16, WS_W_OUTAB) + (size_t)n * 1536 + k0) = pack8f(acc);
    }
#pragma unroll 4
    for (size_t i = gt; i < (size_t)M * D / 8; i += GT) { const f32x4 a = __builtin_nontemporal_load((const f32x4*)(A->in[I_X] + i * 8)), b = __builtin_nontemporal_load((const f32x4*)(A->in[I_X] + i * 8 + 4));
        v4u o; o.x = pk2(a[0], a[1]); o.y = pk2(a[2], a[3]); o.z = pk2(b[0], b[1]); o.w = pk2(b[2], b[3]); *(v4u*)(WSP(bf16, WS_XB) + i * 8) = o; }
#pragma unroll 4
    for (size_t i = gt; i < (size_t)2 * M * 256 / 8; i += GT) { const f32x4 a = __builtin_nontemporal_load((const f32x4*)(A->in[I_P] + i * 8)), b = __builtin_nontemporal_load((const f32x4*)(A->in[I_P] + i * 8 + 4));
        v4u o; o.x = pk2(a[0], a[1]); o.y = pk2(a[2], a[3]); o.z = pk2(b[0], b[1]); o.w = pk2(b[2], b[3]); *(v4u*)(WSP(bf16, WS_PB) + i * 8) = o; }
}

__device__ __forceinline__ void p2_prep(Frame& F, KArgs A) {
    const int lane = F.lane, gw = F.bid * NWAVES + F.wave, NGW = F.G * NWAVES;
    const float* SM = WSP(float, WS_SM); const bf16* QZ = WSP(bf16, WS_QKVZ);
    const f32x4 qg = *(const f32x4*)(A->in[I_AB_QG] + 4 * lane);
    const f32x4 kvg = *(const f32x4*)(A->in[I_AB_KVG] + 4 * (lane & 31));
    const f32x4 kig = *(const f32x4*)(A->in[I_AB_KIG] + 4 * (lane & 15)), kib = *(const f32x4*)(A->in[I_AB_KIB] + 4 * (lane & 15));
    const f32x4 alog = *(const f32x4*)(A->in[I_AB_ALOG]), dtb = *(const f32x4*)(A->in[I_AB_DTB]);
    LAS float* cw = (LAS float*)(F.lds);
    {   f32x4 wv[3]; int t0 = F.tid; asm volatile("" : "+v"(t0));
#pragma unroll
        for (int j = 0; j < 3; ++j) wv[j] = *(const f32x4*)(A->in[I_AB_CONVW] + (size_t)(t0 + NTHREADS * j) * 4);
#pragma unroll
        for (int j = 0; j < 3; ++j) *(LAS f32x4*)(cw + (t0 + NTHREADS * j) * 4) = wv[j];
    }
    __syncthreads();
    for (int row = gw; row < M; row += NGW) {
        const int t = row & (SEQ - 1);
        const f32x4 a = *(const f32x4*)(SM + (size_t)row * 512 + 4 * lane), b = *(const f32x4*)(SM + (size_t)row * 512 + 256 + 4 * lane);
        {
            const float ss = wave_sum(a[0] * a[0] + a[1] * a[1] + a[2] * a[2] + a[3] * a[3]);
            const float r = rsqrtf(ss * (1.0f / 256.0f) + 1e-6f);
            v2u o; o.x = pk2(a[0] * r * qg[0], a[1] * r * qg[1]); o.y = pk2(a[2] * r * qg[2], a[3] * r * qg[3]);
            *(v2u*)(WSP(bf16, WS_CQ) + (size_t)row * 256 + 4 * lane) = o;
        }
        {
            const float ss = wave_sum(lane < 32 ? (b[0] * b[0] + b[1] * b[1] + b[2] * b[2] + b[3] * b[3]) : 0.f);
            const float r = rsqrtf(ss * (1.0f / 128.0f) + 1e-6f);
            if (lane < 32) { v2u o; o.x = pk2(b[0] * r * kvg[0], b[1] * r * kvg[1]); o.y = pk2(b[2] * r * kvg[2], b[3] * r * kvg[3]);
                *(v2u*)(WSP(bf16, WS_CKV) + (size_t)row * 128 + 4 * lane) = o; }
        }
        {
            const bool in = (lane >= 32 && lane < 48);
            const float mean = wave_sum(in ? (b[0] + b[1] + b[2] + b[3]) : 0.f) * (1.0f / 64.0f);
            const f32x4 d = b - mean;
            const float var = wave_sum(in ? (d[0] * d[0] + d[1] * d[1] + d[2] * d[2] + d[3] * d[3]) : 0.f) * (1.0f / 64.0f);
            const float r = rsqrtf(var + 1e-5f);
            if (in) { v2u o; o.x = pk2(d[0] * r * kig[0] + kib[0], d[1] * r * kig[1] + kib[1]); o.y = pk2(d[2] * r * kig[2] + kib[2], d[3] * r * kig[3] + kib[3]);
                *(v2u*)(WSP(bf16, WS_KIDX) + (size_t)row * 64 + 4 * (lane - 32)) = o; }
        }
        if (lane == 48 || lane == 49) *(f32x4*)(WSP(float, WS_WIDX) + (size_t)row * 8 + 4 * (lane - 48)) = b * 0.044194173824159216f;
        if (lane == 50) { f32x4 o; o[0] = sigm(b[0]); o[1] = sigm(b[1]); o[2] = sigm(b[2]); o[3] = sigm(b[3]); *(f32x4*)(WSP(float, WS_BETA) + (size_t)row * 4) = o; }
        if (lane == 51) { f32x4 o;
#pragma unroll
            for (int h = 0; h < 4; ++h) { const float xx = b[h] + dtb[h]; const float sp = xx > 20.f ? xx : log1pf(__expf(xx)); o[h] = -__expf(alog[h]) * sp; }
            *(f32x4*)(WSP(float, WS_GG) + (size_t)row * 4) = o; }
        v4u xr[3][4];
#pragma unroll
        for (int sel = 0; sel < 3; ++sel)
#pragma unroll
            for (int j = 0; j < 4; ++j) { const int back = (t - 3 + j >= 0) ? (3 - j) : 0; xr[sel][j] = *(const v4u*)(QZ + (size_t)(row - back) * 2048 + sel * 512 + 8 * lane); }
#pragma unroll
        for (int sel = 0; sel < 3; ++sel) {
            const int col0 = sel * 512 + 8 * lane;
            float acc[8];
#pragma unroll
            for (int i = 0; i < 8; ++i) acc[i] = 0.f;
#pragma unroll
            for (int j = 0; j < 4; ++j) {
                float xv[8]; unpack8(xr[sel][j], xv);
                const f32x4 w0 = *(const LAS f32x4*)(cw + j * 1536 + col0), w1 = *(const LAS f32x4*)(cw + j * 1536 + col0 + 4);
                const float m = (t - 3 + j >= 0) ? 1.f : 0.f;
#pragma unroll
                for (int i = 0; i < 4; ++i) { acc[i] += w0[i] * m * xv[i]; acc[4 + i] += w1[i] * m * xv[4 + i]; }
            }
            float ss = 0.f;
#pragma unroll
            for (int i = 0; i < 8; ++i) { acc[i] = siluf(acc[i]); ss += acc[i] * acc[i]; }
            if (sel < 2) {
                ss += __shfl_xor(ss, 1); ss += __shfl_xor(ss, 2); ss += __shfl_xor(ss, 4); ss += __shfl_xor(ss, 8);
                const float sc = rsqrtf(ss + 1e-6f) * (sel == 0 ? 0.08838834764831845f : 1.0f);
#pragma unroll
                for (int i = 0; i < 8; ++i) acc[i] *= sc;
            }
            bf16* dst = (sel == 0 ? WSP(bf16, WS_QN) : (sel == 1 ? WSP(bf16, WS_KN) : WSP(bf16, WS_VN))) + (size_t)row * 512 + 8 * lane;
            *(v4u*)dst = pack8f(acc);
        }
    }
}

constexpr int SEQ_WGS = 16;
constexpr int SQ_WP = 0, SQ_QD = 16384, SQ_KDT = 32768, SQ_QK = 49152, SQ_BUF = 57344;
__device__ __forceinline__ bf16x8 packfrag(const f32x4 lo, const f32x4 hi) { v4u w; w.x = pg8::cvt_pk_bf16(lo[0], lo[1]); w.y = pg8::cvt_pk_bf16(lo[2], lo[3]); w.z = pg8::cvt_pk_bf16(hi[0], hi[1]); w.w = pg8::cvt_pk_bf16(hi[2], hi[3]); return __builtin_bit_cast(bf16x8, w); }
__device__ __forceinline__ void seq_load(v4u (&r)[14], const unsigned char* blk, int lt) {
#pragma unroll
    for (int i = 0; i < 14; ++i) r[i] = *(const v4u*)(blk + (size_t)(lt + 256 * i) * 16);
}
__device__ __forceinline__ void seq_write(LAS unsigned char* buf, const v4u (&r)[14], int lt) {
#pragma unroll
    for (int i = 0; i < 14; ++i) {
        const int id = lt + 256 * i; int dst;
        if (id < 2048) { const int rr = (id & 1023) >> 4, ch = id & 15; dst = (id & ~1023) * 16 + rr * 256 + 16 * (ch ^ (rr & 15)); }
        else { const int rr = (id - 2048) >> 3, ch = id & 7; dst = 32768 + rr * 128 + 16 * (ch ^ (rr & 7)); }
        *(LAS v4u*)(buf + dst) = r[i];
    }
}
__device__ __forceinline__ void seq_compute(LAS unsigned char* buf, f32x4 (&Sacc)[8], const f32x4 (&U)[4], const float gl, float* op0, const int fr, const int fq) {
    bf16x8 sf[4];
#pragma unroll
    for (int s = 0; s < 4; ++s) sf[s] = packfrag(Sacc[2 * s], Sacc[2 * s + 1]);
    f32x4 Vn[4], Oa[4];
#pragma unroll
    for (int tc = 0; tc < 4; ++tc) {
        const int rr = 16 * tc + fr; f32x4 av = (f32x4){0.f, 0.f, 0.f, 0.f}, ao = (f32x4){0.f, 0.f, 0.f, 0.f};
#pragma unroll
        for (int s = 0; s < 4; ++s) {
            const int off = rr * 256 + 16 * ((4 * s + fq) ^ (rr & 15));
            const bf16x8 wf = *(const LAS bf16x8*)(buf + SQ_WP + off), qf = *(const LAS bf16x8*)(buf + SQ_QD + off);
            av = __builtin_amdgcn_mfma_f32_16x16x32_bf16(wf, sf[s], av, 0, 0, 0);
            ao = __builtin_amdgcn_mfma_f32_16x16x32_bf16(qf, sf[s], ao, 0, 0, 0);
        }
        Vn[tc] = U[tc] - av; Oa[tc] = ao;
    }
    bf16x8 vf[2];
    vf[0] = packfrag(Vn[0], Vn[1]); vf[1] = packfrag(Vn[2], Vn[3]);
#pragma unroll
    for (int tc = 0; tc < 4; ++tc) {
        const int rr = 16 * tc + fr;
#pragma unroll
        for (int s = 0; s < 2; ++s) {
            const bf16x8 kf = *(const LAS bf16x8*)(buf + SQ_QK + rr * 128 + 16 * ((4 * s + fq) ^ (rr & 7)));
            Oa[tc] = __builtin_amdgcn_mfma_f32_16x16x32_bf16(kf, vf[s], Oa[tc], 0, 0, 0);
        }
        float* op = op0 + (size_t)(16 * tc) * 512;
#pragma unroll
        for (int j = 0; j < 4; ++j) op[(size_t)j * 512] = Oa[tc][j];
    }
#pragma unroll
    for (int T = 0; T < 8; ++T) {
        const int rr = 16 * T + fr; f32x4 a = Sacc[T] * gl;
#pragma unroll
        for (int s = 0; s < 2; ++s) {
            const bf16x8 kf = *(const LAS bf16x8*)(buf + SQ_KDT + rr * 128 + 16 * ((4 * s + fq) ^ (rr & 7)));
            a = __builtin_amdgcn_mfma_f32_16x16x32_bf16(kf, vf[s], a, 0, 0, 0);
        }
        Sacc[T] = a;
    }
}
#define SEQ_BAR() do { asm volatile("s_waitcnt lgkmcnt(0)" ::: "memory"); __builtin_amdgcn_s_barrier(); asm volatile("" ::: "memory"); } while (0)
__device__ __forceinline__ void p4_delta_seq(Frame& F, int sid) {
    const int lane = F.lane, wave = F.wave, tid = F.tid;
    const int bh = sid >> 1, half = sid & 1, b = bh >> 2, h = bh & 3;
    const int fr = lane & 15, fq = lane >> 4;
    const int v0 = half * 64 + (wave & 3) * 16;
    const unsigned char* cbase = F.ws + WS_CHK + (size_t)(bh * 128) * CHK_STRIDE;
    if (wave >= 4) {
        const int lt = tid - 256;
        v4u RA[14], RB[14];
#define SEQ_LD(R, blk) do { const unsigned char* _b = (blk); _Pragma("unroll") for (int _i = 0; _i < 14; ++_i) asm volatile("global_load_dwordx4 %0, %1, off" : "=v"(R[_i]) : "v"(_b + (size_t)(lt + 256 * _i) * 16) : "memory"); } while (0)
#define SEQ_WAIT(younger) do { if (younger) asm volatile("s_waitcnt vmcnt(14)" ::: "memory"); else asm volatile("s_waitcnt vmcnt(0)" ::: "memory"); } while (0)
        SEQ_LD(RA, cbase); SEQ_LD(RB, cbase + CHK_STRIDE); SEQ_WAIT(true); seq_write(F.lds, RA, lt); SEQ_LD(RA, cbase + 2 * CHK_STRIDE);
        SEQ_BAR();
#pragma unroll 1
        for (int n = 0; n < 128; n += 2) {
            if (n + 1 < 128) { SEQ_WAIT(n + 2 < 128); seq_write(F.lds + ((n + 1) & 1) * SQ_BUF, RB, lt); } if (n + 3 < 128) SEQ_LD(RB, cbase + (size_t)(n + 3) * CHK_STRIDE);
            SEQ_BAR();
            if (n + 2 < 128) { SEQ_WAIT(n + 3 < 128); seq_write(F.lds + (n & 1) * SQ_BUF, RA, lt); } if (n + 4 < 128) SEQ_LD(RA, cbase + (size_t)(n + 4) * CHK_STRIDE);
            SEQ_BAR();
        }
        asm volatile("s_waitcnt vmcnt(0)" ::: "memory");
#undef SEQ_LD
#undef SEQ_WAIT
    } else {
        float* OD = WSP(float, WS_ODELTA);
        f32x4 Sacc[8], Ucur[4], Unxt[4]; float glc, gln;
#pragma unroll
        for (int T = 0; T < 8; ++T) Sacc[T] = (f32x4){0.f, 0.f, 0.f, 0.f};
#pragma unroll
        for (int tc = 0; tc < 4; ++tc) { Ucur[tc] = *(const f32x4*)((const float*)(cbase + CHK_UT) + (size_t)(v0 + fr) * 64 + 4 * fq + 16 * tc);
                                          Unxt[tc] = *(const f32x4*)((const float*)(cbase + CHK_STRIDE + CHK_UT) + (size_t)(v0 + fr) * 64 + 4 * fq + 16 * tc); }
        glc = *(const float*)(cbase + CHK_GL); gln = *(const float*)(cbase + CHK_STRIDE + CHK_GL);
        SEQ_BAR();
#pragma unroll 1
        for (int n = 0; n < 128; ++n) {
            seq_compute(F.lds + (n & 1) * SQ_BUF, Sacc, Ucur, glc, OD + (size_t)(b * SEQ + n * 64 + 4 * fq) * 512 + h * 128 + v0 + fr, fr, fq);
#pragma unroll
            for (int tc = 0; tc < 4; ++tc) Ucur[tc] = Unxt[tc];
            glc = gln;
            if (n + 2 < 128) { const unsigned char* nb = cbase + (size_t)(n + 2) * CHK_STRIDE; gln = *(const float*)(nb + CHK_GL);
#pragma unroll
                for (int tc = 0; tc < 4; ++tc) Unxt[tc] = *(const f32x4*)((const float*)(nb + CHK_UT) + (size_t)(v0 + fr) * 64 + 4 * fq + 16 * tc); }
            SEQ_BAR();
        }
    }
}
#undef SEQ_BAR

__device__ __forceinline__ float relu1(float x) { return __builtin_amdgcn_fmed3f(x, 0.f, INFINITY); }
__device__ __forceinline__ void p4_indexer(Frame& F, int widx, int nw) {
    const int lane = F.lane, fr = lane & 15, fq = lane >> 4;
    const bf16* QL = WSP(bf16, WS_QL); const bf16* KI = WSP(bf16, WS_KIDX); const float* WI = WSP(float, WS_WIDX); float* SC = WSP(float, WS_BIG);
    for (int task = widx; task < 2 * 4352; task += nw) {
        const int b = task / 4352; int tau = task - b * 4352;
        int g = 0; while (16 * (g + 1) * (g + 2) <= tau) ++g;
        tau -= 16 * g * (g + 1);
        const int qt = 32 * g + tau / (g + 1), seg = tau % (g + 1);
        const int row0 = b * SEQ + 16 * qt;
        bf16x8 Qf[8][2];
#pragma unroll
        for (int hh = 0; hh < 8; ++hh)
#pragma unroll
            for (int s = 0; s < 2; ++s) Qf[hh][s] = *(const bf16x8*)(QL + (size_t)(row0 + fr) * 1536 + 1024 + hh * 64 + 32 * s + 8 * fq);
        const f32x4 w0 = *(const f32x4*)(WI + (size_t)(row0 + fr) * 8), w1 = *(const f32x4*)(WI + (size_t)(row0 + fr) * 8 + 4);
        const int kt1 = (32 * seg + 31 < qt) ? 32 * seg + 31 : qt;
        for (int kb8 = 32 * seg; kb8 <= kt1; kb8 += 8) {
            bf16x8 kfr[8][2];
#pragma unroll
            for (int x = 0; x < 8; ++x) { const int kt = (kb8 + x <= kt1) ? kb8 + x : kt1; const bf16* kp = KI + (size_t)(b * SEQ + 16 * kt + fr) * 64 + 8 * fq; kfr[x][0] = *(const bf16x8*)kp; kfr[x][1] = *(const bf16x8*)(kp + 32); }
#pragma unroll
            for (int x = 0; x < 8; ++x) asm volatile("" : "+v"(kfr[x][0]), "+v"(kfr[x][1]));
#pragma unroll
            for (int x = 0; x < 8; ++x) {
                const int kt = kb8 + x;
                if (kt <= kt1) {
                    f32x4 isc = (f32x4){0.f, 0.f, 0.f, 0.f}, c[8];
#pragma unroll
                    for (int hh = 0; hh < 8; ++hh) c[hh] = __builtin_amdgcn_mfma_f32_16x16x32_bf16(kfr[x][0], Qf[hh][0], (f32x4){0.f, 0.f, 0.f, 0.f}, 0, 0, 0);
#pragma unroll
                    for (int hh = 0; hh < 8; ++hh) c[hh] = __builtin_amdgcn_mfma_f32_16x16x32_bf16(kfr[x][1], Qf[hh][1], c[hh], 0, 0, 0);
                    __builtin_amdgcn_sched_barrier(0);
#pragma unroll
                    for (int hh = 0; hh < 8; ++hh) { const float wh = (hh < 4) ? w0[hh & 3] : w1[hh & 3];
#pragma unroll
                        for (int j = 0; j < 4; ++j) isc[j] += relu1(c[hh][j]) * wh; }
                    *(f32x4*)(SC + (size_t)(row0 + fr) * 8192 + 16 * kt + 4 * fq) = isc;
                }
            }
        }
    }
}

__device__ __forceinline__ void mask_ge8(unsigned long long (&m)[8], unsigned x0, unsigned x1, unsigned x2, unsigned x3, unsigned x4, unsigned x5, unsigned x6, unsigned x7, unsigned t) {
    asm("v_cmp_ge_u32_e64 %0, %8, %16\n\tv_cmp_ge_u32_e64 %1, %9, %16\n\tv_cmp_ge_u32_e64 %2, %10, %16\n\tv_cmp_ge_u32_e64 %3, %11, %16\n\t"
        "v_cmp_ge_u32_e64 %4, %12, %16\n\tv_cmp_ge_u32_e64 %5, %13, %16\n\tv_cmp_ge_u32_e64 %6, %14, %16\n\tv_cmp_ge_u32_e64 %7, %15, %16"
        : "=&s"(m[0]), "=&s"(m[1]), "=&s"(m[2]), "=&s"(m[3]), "=&s"(m[4]), "=&s"(m[5]), "=&s"(m[6]), "=&s"(m[7])
        : "v"(x0), "v"(x1), "v"(x2), "v"(x3), "v"(x4), "v"(x5), "v"(x6), "v"(x7), "s"(t));
}
__device__ __forceinline__ unsigned tk_key(float f) { const unsigned b = __float_as_uint(f); return (b & 0x80000000u) ? ~b : (b | 0x80000000u); }
__device__ __forceinline__ void topk_row_slow(const float* sr, const int n, const int lane, LAS int* sel) {
    const int nseg = (n + 63) >> 6;
    unsigned T = 0u;
    for (int bit = 31; bit >= 0; --bit) {
        const unsigned cnd = T | (1u << bit); int c = 0;
        for (int sg = 0; sg < nseg; ++sg) { const int idx = sg * 64 + lane; const unsigned x = (idx < n) ? tk_key(sr[idx < n ? idx : 0]) : 0u; c += __popcll(__ballot(x >= cnd)); }
        if (c >= 256) T = cnd;
    }
    int cgt = 0;
    for (int sg = 0; sg < nseg; ++sg) { const int idx = sg * 64 + lane; const unsigned x = (idx < n) ? tk_key(sr[idx < n ? idx : 0]) : 0u; cgt += __popcll(__ballot(x > T)); }
    const int need_eq = 256 - cgt; int running = 0, eq_taken = 0;
    const unsigned long long lt = (1ull << lane) - 1ull;
    for (int sg = 0; sg < nseg; ++sg) {
        const int idx = sg * 64 + lane; const unsigned x = (idx < n) ? tk_key(sr[idx < n ? idx : 0]) : 0u;
        const bool gt = x > T, eq = x == T;
        const unsigned long long meq = __ballot(eq);
        const bool take = gt || (eq && (eq_taken + __popcll(meq & lt)) < need_eq);
        const unsigned long long mt = __ballot(take);
        if (take) sel[running + __popcll(mt & lt)] = idx;
        running += __popcll(mt); eq_taken += __popcll(meq);
    }
}
constexpr int TK_CAP = 832;
__device__ __forceinline__ int topk_row(Frame& F, const int row, LAS int* sel, LAS unsigned long long* cand) {
    const int lane = F.lane;
    const float* SC = WSP(float, WS_BIG);
    {
        const int pos = row & (SEQ - 1), n = pos + 1;
        if (n <= 256) {
#pragma unroll
            for (int i = 0; i < 4; ++i) { const int j = 64 * i + lane; sel[j] = (j < n) ? j : 0; }
            return n;
        }
        const int nblk = (n + 1023) >> 10;
        const float* sr = SC + (size_t)row * 8192;
        int lane_l = lane; asm volatile("" : "+v"(lane_l));
        unsigned u[128];
#pragma unroll
        for (int i = 0; i < 64; ++i) u[i] = __float_as_uint((sr + (i >> 4) * 1024)[(i & 15) * 64 + lane_l]);
        if (nblk > 4) {
#pragma unroll
            for (int i = 64; i < 128; ++i) u[i] = __float_as_uint((sr + (i >> 4) * 1024)[(i & 15) * 64 + lane_l]);
        } else {
#pragma unroll
            for (int i = 64; i < 128; ++i) u[i] = 0u;
        }
        asm volatile("" ::: "memory");
#pragma unroll
        for (int i = 0; i < 128; ++i) { const int lim = n - i * 64; const unsigned bits = u[i];
            const unsigned x = (bits & 0x80000000u) ? ~bits : (bits | 0x80000000u);
            u[i] = (lane < lim) ? x : 0u; }
        const unsigned long long ltmask_s = (1ull << lane) - 1ull;
        bool done = false;
        {
            int ns = 0;
#pragma unroll
            for (int k = 0; k < 16; ++k) { int v = n - 512 * k; v = v < 0 ? 0 : (v > 64 ? 64 : v); ns += v; }
            const float mean = 256.0f * (float)ns / (float)n;
            const int rs = (int)(mean + 4.0f * sqrtf(mean) + 5.0f);
            unsigned Ts = 0u;
            for (int bit = 31; bit >= 16; --bit) {
                const unsigned cnd = Ts | (1u << bit); unsigned long long m0[8], m1[8];
                mask_ge8(m0, u[0], u[8], u[16], u[24], u[32], u[40], u[48], u[56], cnd); mask_ge8(m1, u[64], u[72], u[80], u[88], u[96], u[104], u[112], u[120], cnd);
                int c = 0;
#pragma unroll
                for (int i = 0; i < 8; ++i) c += __popcll(m0[i]) + __popcll(m1[i]);
                if (c >= rs) Ts = cnd;
            }
            if (Ts == 0u) Ts = 1u;
            int nc = 0;
#pragma unroll
            for (int bk = 0; bk < 8; ++bk) {
                if (bk < nblk) {
#pragma unroll
                    for (int g8 = 0; g8 < 2; ++g8) {
                        unsigned long long mg[8]; const int b0 = bk * 16 + g8 * 8;
                        mask_ge8(mg, u[b0], u[b0 + 1], u[b0 + 2], u[b0 + 3], u[b0 + 4], u[b0 + 5], u[b0 + 6], u[b0 + 7], Ts);
#pragma unroll
                        for (int i = 0; i < 8; ++i) {
                            const unsigned long long mt = mg[i];
                            if (mt != 0ull) {
                                const int off = nc + __popcll(mt & ltmask_s);
                                if (((mt >> lane) & 1ull) && off < TK_CAP) cand[off] = ((unsigned long long)u[b0 + i] << 32) | (unsigned)((b0 + i) * 64 + lane_l);
                                nc += __popcll(mt);
                            }
                        }
                    }
                }
            }
            if (nc >= 256 && nc <= TK_CAP) {
                unsigned ck[16]; int ci[13];
#pragma unroll
                for (int t = 0; t < 13; ++t) { const int j = lane + 64 * t; const unsigned long long e = (j < nc) ? cand[j] : 0ull; ck[t] = (unsigned)(e >> 32); ci[t] = (int)(unsigned)e; }
                ck[13] = 0u; ck[14] = 0u; ck[15] = 0u;
                unsigned T = 0u;
                for (int bit = 31; bit >= 0; --bit) {
                    const unsigned cnd = T | (1u << bit); unsigned long long m0[8], m1[8];
                    mask_ge8(m0, ck[0], ck[1], ck[2], ck[3], ck[4], ck[5], ck[6], ck[7], cnd); mask_ge8(m1, ck[8], ck[9], ck[10], ck[11], ck[12], ck[13], ck[14], ck[15], cnd);
                    int c = 0;
#pragma unroll
                    for (int i = 0; i < 8; ++i) c += __popcll(m0[i]) + __popcll(m1[i]);
                    if (c >= 256) T = cnd;
                }
                unsigned long long g0[8], g1[8], h0[8], h1[8];
                mask_ge8(g0, ck[0], ck[1], ck[2], ck[3], ck[4], ck[5], ck[6], ck[7], T); mask_ge8(g1, ck[8], ck[9], ck[10], ck[11], ck[12], ck[13], ck[14], ck[15], T);
                mask_ge8(h0, ck[0], ck[1], ck[2], ck[3], ck[4], ck[5], ck[6], ck[7], T + 1u); mask_ge8(h1, ck[8], ck[9], ck[10], ck[11], ck[12], ck[13], ck[14], ck[15], T + 1u);
                int cgt = 0;
#pragma unroll
                for (int t = 0; t < 13; ++t) cgt += __popcll(t < 8 ? h0[t & 7] : h1[t & 7]);
                const int need_eq = 256 - cgt;
                int running = 0, eq_taken = 0;
#pragma unroll
                for (int t = 0; t < 13; ++t) {
                    const unsigned long long mge = (t < 8 ? g0[t & 7] : g1[t & 7]), mgt = (t < 8 ? h0[t & 7] : h1[t & 7]);
                    unsigned long long mt = mge; const unsigned long long me = mge & ~mgt;
                    if (me != 0ull) {
                        const int room = need_eq - eq_taken; unsigned long long keep = 0ull, rest = me;
                        for (int k = 0; k < room && rest != 0ull; ++k) { const unsigned long long low = rest & (~rest + 1ull); keep |= low; rest ^= low; }
                        mt = (mge & ~me) | keep; eq_taken += __popcll(me);
                    }
                    if (mt != 0ull) { if ((mt >> lane) & 1ull) sel[running + __popcll(mt & ltmask_s)] = ci[t]; running += __popcll(mt); }
                }
                done = true;
            }
        }
        if (!done) topk_row_slow(sr, n, lane, sel);
    }
    return 256;
}

__device__ __forceinline__ void p6_gdn_out(Frame& F, KArgs A) {
    const int lane = F.lane, gw = F.bid * NWAVES + F.wave, NGW = F.G * NWAVES;
    const f32x4 g0 = *(const f32x4*)(A->in[I_AB_ONG] + 8 * (lane & 15)), g1 = *(const f32x4*)(A->in[I_AB_ONG] + 8 * (lane & 15) + 4);
    for (int row = gw; row < M; row += NGW) {
        const float* op = WSP(float, WS_ODELTA) + (size_t)row * 512 + 8 * lane;
        const f32x4 a = *(const f32x4*)op, b = *(const f32x4*)(op + 4);
        float ss = a[0] * a[0] + a[1] * a[1] + a[2] * a[2] + a[3] * a[3] + b[0] * b[0] + b[1] * b[1] + b[2] * b[2] + b[3] * b[3];
        ss += __shfl_xor(ss, 1); ss += __shfl_xor(ss, 2); ss += __shfl_xor(ss, 4); ss += __shfl_xor(ss, 8);
        const float r = rsqrtf(ss * (1.0f / 128.0f) + 1e-6f);
        float z[8]; unpack8(*(const v4u*)(WSP(bf16, WS_QKVZ) + (size_t)row * 2048 + 1536 + 8 * lane), z);
        float o[8];
#pragma unroll
        for (int i = 0; i < 4; ++i) { o[i] = a[i] * r * g0[i] * siluf(z[i]); o[4 + i] = b[i] * r * g1[i] * siluf(z[4 + i]); }
        *(v4u*)(WSP(bf16, WS_AO) + (size_t)row * 1536 + 1024 + 8 * lane) = pack8f(o);
    }
}

__device__ __forceinline__ void p8_ln_router(Frame& F, KArgs A, int l, float* HOUT, bf16* HB) {
    const int lane = F.lane, tid = F.tid, gw = F.bid * NWAVES + F.wave, NGW = F.G * NWAVES;
    LAS float* wT = (LAS float*)(F.lds);
    LAS float* lg = (LAS float*)(F.lds + WSCR_OFF + F.wave * WSCR_BYTES);
    const float* rw = A->in[I_RW] + (size_t)l * 1024 * 32;
    {
        f32x4 wv[16];
#pragma unroll
        for (int j = 0; j < 16; ++j) wv[j] = *(const f32x4*)(rw + (size_t)(tid + NTHREADS * j) * 4);
#pragma unroll
        for (int j = 0; j < 16; ++j) { const int i4 = tid + NTHREADS * j, k = i4 >> 3, e0 = (i4 & 7) * 4;
            wT[(e0 + 0) * 1028 + k] = wv[j][0]; wT[(e0 + 1) * 1028 + k] = wv[j][1]; wT[(e0 + 2) * 1028 + k] = wv[j][2]; wT[(e0 + 3) * 1028 + k] = wv[j][3]; }
    }
    __syncthreads();
    const float* PRE = WSP(float, WS_PRE);
    const float* lg_g = A->in[I_LNM_G] + (size_t)l * 1024; const float* lg_b = A->in[I_LNM_B] + (size_t)l * 1024;
    const float rb = A->in[I_RB][l * 32 + (lane & 31)];
    int* TOKE = WSP(int, WS_ROUTE); int* TOKPOS = TOKE + M * 4; float* TOKG = (float*)(TOKPOS + M * 4);
    gu32* cnt = F.ctl + CW_CNT + 64 * 32 * l;
    LAS int* lcnt = (LAS int*)(F.lds + MISC_OFF + 512);
    LAS int* lbase = lcnt + 32;
    LAS int* myrt = (LAS int*)(F.lds + WSCR_OFF + F.wave * WSCR_BYTES + 128);
    if (tid < 32) lcnt[tid] = 0;
    __syncthreads();
    int nrow = 0;
    f32x4 lng[4], lnb[4];
#pragma unroll
    for (int j = 0; j < 4; ++j) { lng[j] = *(const f32x4*)(lg_g + 256 * j + 4 * lane); lnb[j] = *(const f32x4*)(lg_b + 256 * j + 4 * lane); }
    for (int row = gw; row < M; row += NGW) {
        f32x4 v[4]; float s = 0.f;
#pragma unroll
        for (int j = 0; j < 4; ++j) { v[j] = *(const f32x4*)(PRE + (size_t)row * 1024 + 256 * j + 4 * lane); s += (v[j][0] + v[j][1]) + (v[j][2] + v[j][3]); }
        const float mean = wave_sum(s) * (1.0f / 1024.0f); float s2 = 0.f;
#pragma unroll
        for (int j = 0; j < 4; ++j) { v[j] = v[j] - mean; s2 += (v[j][0] * v[j][0] + v[j][1] * v[j][1]) + (v[j][2] * v[j][2] + v[j][3] * v[j][3]); }
        const float rstd = rsqrtf(wave_sum(s2) * (1.0f / 1024.0f) + 1e-5f);
#pragma unroll
        for (int j = 0; j < 4; ++j) {
            v[j] = v[j] * rstd * lng[j] + lnb[j];
            *(f32x4*)(HOUT + (size_t)row * 1024 + 256 * j + 4 * lane) = v[j];
            v2u o; o.x = pk2(v[j][0], v[j][1]); o.y = pk2(v[j][2], v[j][3]); *(v2u*)(HB + (size_t)row * 1024 + 256 * j + 4 * lane) = o;
        }
        float part[32];
#pragma unroll
        for (int e = 0; e < 32; ++e) {
            float a = 0.f;
#pragma unroll
            for (int j = 0; j < 4; ++j) { const f32x4 w = *(const LAS f32x4*)(wT + e * 1028 + 256 * j + 4 * lane); a += v[j][0] * w[0] + v[j][1] * w[1] + v[j][2] * w[2] + v[j][3] * w[3]; }
            part[e] = a;
        }
#pragma unroll
        for (int i = 0; i < 16; ++i) { const bool up = (lane & 32) != 0; const float keep = up ? part[i + 16] : part[i], send = up ? part[i] : part[i + 16]; part[i] = keep + __shfl_xor(send, 32); }
#pragma unroll
        for (int i = 0; i < 8; ++i) { const bool up = (lane & 16) != 0; const float keep = up ? part[i + 8] : part[i], send = up ? part[i] : part[i + 8]; part[i] = keep + __shfl_xor(send, 16); }
#pragma unroll
        for (int i = 0; i < 4; ++i) { const bool up = (lane & 8) != 0; const float keep = up ? part[i + 4] : part[i], send = up ? part[i] : part[i + 4]; part[i] = keep + __shfl_xor(send, 8); }
#pragma unroll
        for (int i = 0; i < 2; ++i) { const bool up = (lane & 4) != 0; const float keep = up ? part[i + 2] : part[i], send = up ? part[i] : part[i + 2]; part[i] = keep + __shfl_xor(send, 4); }
        { const bool up = (lane & 2) != 0; const float keep = up ? part[1] : part[0], send = up ? part[0] : part[1]; part[0] = keep + __shfl_xor(send, 2); }
        part[0] += __shfl_xor(part[0], 1);
        const int eidx = ((lane >> 5) & 1) * 16 + ((lane >> 4) & 1) * 8 + ((lane >> 3) & 1) * 4 + ((lane >> 2) & 1) * 2 + ((lane >> 1) & 1);
        if ((lane & 1) == 0) lg[eidx] = part[0];
        float val = (lane < 32) ? lg[lane & 31] + rb : -INFINITY;
        float tl[4]; int te[4];
#pragma unroll
        for (int k = 0; k < 4; ++k) {
            const float mx = wave_max(val);
            const unsigned long long mm = __ballot(val == mx && lane < 32);
            const int idx = __ffsll((long long)mm) - 1;
            tl[k] = mx; te[k] = idx;
            if (lane == idx) val = -INFINITY;
        }
        const float e1 = __expf(tl[1] - tl[0]), e2 = __expf(tl[2] - tl[0]), e3 = __expf(tl[3] - tl[0]);
        const float inv = 1.0f / (1.0f + e1 + e2 + e3);
        if (lane < 4) {
            const int e = lane == 0 ? te[0] : (lane == 1 ? te[1] : (lane == 2 ? te[2] : te[3]));
            const float g = (lane == 0 ? 1.0f : (lane == 1 ? e1 : (lane == 2 ? e2 : e3))) * inv;
            const int lp = __hip_atomic_fetch_add(lcnt + e, 1, __ATOMIC_RELAXED, __HIP_MEMORY_SCOPE_WORKGROUP);
            LAS int* rt = myrt + (nrow * 4 + lane) * 3; rt[0] = e; rt[1] = lp; rt[2] = __float_as_int(g);
        }
        ++nrow;
    }
    __syncthreads();
    if (tid < 32) lbase[tid] = (int)__hip_atomic_fetch_add(cnt + 64 * tid, (unsigned)lcnt[tid], RLX_AGENT);
    __syncthreads();
    if (lane < 4) {
        int j = 0;
        for (int row = gw; row < M; row += NGW, ++j) {
            const LAS int* rt = myrt + (j * 4 + lane) * 3; const int e = rt[0];
            TOKE[(size_t)row * 4 + lane] = e; TOKPOS[(size_t)row * 4 + lane] = lbase[e] + rt[1]; TOKG[(size_t)row * 4 + lane] = __int_as_float(rt[2]);
        }
    }
}

__device__ __forceinline__ void p9_scatter(Frame& F, int l, const bf16* HB, const float* HF) {
    const int lane = F.lane, tid = F.tid, gw = F.bid * NWAVES + F.wave, NGW = F.G * NWAVES;
    LAS int* base = (LAS int*)(F.lds + MISC_OFF + 256);
    int* TOKE = WSP(int, WS_ROUTE); int* TOKPOS = TOKE + M * 4; int* TILE = TOKE + 3 * M * 4;
    if (tid < 32) base[tid] = (int)__hip_atomic_load(F.ctl + CW_CNT + 64 * (32 * l + tid), RLX_AGENT);
    __syncthreads();
    if (tid == 0) {
        int acc = 0;
        for (int e = 0; e < NEXP; ++e) { const int c = base[e]; base[e] = acc; acc += ((c + 255) >> 8) << 8; }
        base[32] = acc >> 8;
    }
    __syncthreads();
    if (F.bid == 0 && tid < 64) {
        const int nT = base[32];
        for (int t = tid; t < NTMAX; t += 64) { int e = 0;
            for (int x = 1; x < NEXP; ++x) if (base[x] <= t * 256) e = x;
            TILE[t] = (t < nT) ? e : 0; }
        if (tid == 0) TILE[NTMAX] = nT;
    }
    bf16* XS = WSP(bf16, WS_XS);
    if (kMoeFp8) {
        unsigned char* XB8 = WSP(unsigned char, WS_XS);
        for (int row = gw; row < M; row += NGW) {
            const float* hp = HF + (size_t)row * 1024 + 16 * lane; v4u o;
#pragma unroll
            for (int q = 0; q < 4; ++q) { const f32x4 v = *(const f32x4*)(hp + 4 * q); unsigned w = 0u; w = __builtin_amdgcn_cvt_pk_fp8_f32(v[0], v[1], w, false); w = __builtin_amdgcn_cvt_pk_fp8_f32(v[2], v[3], w, true); o[q] = w; }
#pragma unroll
            for (int k = 0; k < 4; ++k) { const int slot = base[TOKE[(size_t)row * 4 + k]] + TOKPOS[(size_t)row * 4 + k]; *(v4u*)(XB8 + (size_t)slot * 1024 + 16 * lane) = o; }
        }
        return;
    }
    for (int row = gw; row < M; row += NGW) {
        const v4u a = *(const v4u*)(HB + (size_t)row * 1024 + 8 * lane), b = *(const v4u*)(HB + (size_t)row * 1024 + 512 + 8 * lane);
#pragma unroll
        for (int k = 0; k < 4; ++k) {
            const int slot = base[TOKE[(size_t)row * 4 + k]] + TOKPOS[(size_t)row * 4 + k];
            *(v4u*)(XS + (size_t)slot * 1024 + 8 * lane) = a; *(v4u*)(XS + (size_t)slot * 1024 + 512 + 8 * lane) = b;
        }
    }
}

__device__ __forceinline__ void p12_combine(Frame& F, KArgs A, int l, const float* HIN, float* HOUT, bf16* HB) {
    const int lane = F.lane, tid = F.tid, gw = F.bid * NWAVES + F.wave, NGW = F.G * NWAVES;
    LAS int* base = (LAS int*)(F.lds + MISC_OFF + 256);
    if (tid < 32) base[tid] = (int)__hip_atomic_load(F.ctl + CW_CNT + 64 * (32 * l + tid), RLX_AGENT);
    __syncthreads();
    if (tid == 0) { int acc = 0; for (int e = 0; e < NEXP; ++e) { const int c = base[e]; base[e] = acc; acc += ((c + 255) >> 8) << 8; } }
    __syncthreads();
    const int* TOKE = WSP(int, WS_ROUTE); const int* TOKPOS = TOKE + M * 4; const float* TOKG = (const float*)(TOKPOS + M * 4);
    const bf16* YS = WSP(bf16, WS_YS); const bf16* PLE = WSP(bf16, WS_PLE);
    const float* lg_g = A->in[I_LNF_G] + (size_t)l * 1024; const float* lg_b = A->in[I_LNF_B] + (size_t)l * 1024;
    f32x4 lng[2][2], lnb[2][2];
#pragma unroll
    for (int hf = 0; hf < 2; ++hf) { const int c0 = 512 * hf + 8 * lane; lng[hf][0] = *(const f32x4*)(lg_g + c0); lng[hf][1] = *(const f32x4*)(lg_g + c0 + 4); lnb[hf][0] = *(const f32x4*)(lg_b + c0); lnb[hf][1] = *(const f32x4*)(lg_b + c0 + 4); }
    for (int row = gw; row < M; row += NGW) {
        float x[16];
        {   const f32x4 h0 = *(const f32x4*)(HIN + (size_t)row * 1024 + 8 * lane), h1 = *(const f32x4*)(HIN + (size_t)row * 1024 + 8 * lane + 4);
            const f32x4 h2 = *(const f32x4*)(HIN + (size_t)row * 1024 + 512 + 8 * lane), h3 = *(const f32x4*)(HIN + (size_t)row * 1024 + 512 + 8 * lane + 4);
            float p0[8], p1[8]; unpack8(*(const v4u*)(PLE + (size_t)row * 1024 + 8 * lane), p0); unpack8(*(const v4u*)(PLE + (size_t)row * 1024 + 512 + 8 * lane), p1);
#pragma unroll
            for (int i = 0; i < 4; ++i) { x[i] = ALPHA * h0[i] + p0[i]; x[4 + i] = ALPHA * h1[i] + p0[4 + i]; x[8 + i] = ALPHA * h2[i] + p1[i]; x[12 + i] = ALPHA * h3[i] + p1[4 + i]; }
        }
#pragma unroll
        for (int k = 0; k < 4; ++k) {
            const int slot = base[TOKE[(size_t)row * 4 + k]] + TOKPOS[(size_t)row * 4 + k]; const float g = TOKG[(size_t)row * 4 + k];
            float y0[8], y1[8]; unpack8(*(const v4u*)(YS + (size_t)slot * 1024 + 8 * lane), y0); unpack8(*(const v4u*)(YS + (size_t)slot * 1024 + 512 + 8 * lane), y1);
#pragma unroll
            for (int i = 0; i < 8; ++i) { x[i] += g * y0[i]; x[8 + i] += g * y1[i]; }
        }
        float s = 0.f;
#pragma unroll
        for (int i = 0; i < 16; ++i) s += x[i];
        const float mean = wave_sum(s) * (1.0f / 1024.0f); float s2 = 0.f;
#pragma unroll
        for (int i = 0; i < 16; ++i) { x[i] -= mean; s2 += x[i] * x[i]; }
        const float rstd = rsqrtf(wave_sum(s2) * (1.0f / 1024.0f) + 1e-5f);
#pragma unroll
        for (int hf = 0; hf < 2; ++hf) {
            const int c0 = 512 * hf + 8 * lane;
            const f32x4 g0 = lng[hf][0], g1 = lng[hf][1], b0 = lnb[hf][0], b1 = lnb[hf][1];
            f32x4 o0, o1;
#pragma unroll
            for (int i = 0; i < 4; ++i) { o0[i] = x[8 * hf + i] * rstd * g0[i] + b0[i]; o1[i] = x[8 * hf + 4 + i] * rstd * g1[i] + b1[i]; }
            *(f32x4*)(HOUT + (size_t)row * 1024 + c0) = o0; *(f32x4*)(HOUT + (size_t)row * 1024 + c0 + 4) = o1;
            if (HB) { v4u w; w.x = pk2(o0[0], o0[1]); w.y = pk2(o0[2], o0[3]); w.z = pk2(o1[0], o1[1]); w.w = pk2(o1[2], o1[3]); *(v4u*)(HB + (size_t)row * 1024 + c0) = w; }
        }
    }
}

typedef short v4i16_t __attribute__((ext_vector_type(4)));
__device__ __forceinline__ v4i16_t lds_tr16(LAS unsigned char* p) { return __builtin_amdgcn_ds_read_tr16_b64_v4i16((LAS v4i16_t*)p); }
constexpr int DV_PITCH = 144, DV_BUF = 32 * DV_PITCH;
template <int DL  > __device__ __forceinline__ void dil_branch(const bf16* __restrict__ KV, LAS unsigned char* vbuf, const int s0, const int lane,
                                                                                 const bf16x8 (&qf)[2], f32x4 (&O)[4], float& m_run, float& l_run) {
    constexpr int d = 1 << DL, sigma = 16 >> DL, NS = (129 + 15 * sigma + 31) / 32;
    const int fr = lane & 15, fq = lane >> 4;
    const int c = s0 & (d - 1), n0 = s0 >> DL, kstart = n0 - 128;
    const int dbase = 128 + sigma * fr - 4 * fq;
    const int dmax = n0 + sigma * fr;
#define DIL_POS(n) ({ int _p = c + d * (n); _p = _p < 0 ? 0 : (_p > SEQ - 1 ? SEQ - 1 : _p); _p; })
    bf16x8 kf[2][2]; v4u vr[4];
#pragma unroll
    for (int tl = 0; tl < 2; ++tl) { const bf16* kp = KV + (size_t)DIL_POS(kstart + 16 * tl + fr) * 2560 + 768 + 8 * fq; kf[tl][0] = *(const bf16x8*)kp; kf[tl][1] = *(const bf16x8*)(kp + 32); }
#pragma unroll
    for (int i = 0; i < 4; ++i) vr[i] = *(const v4u*)(KV + (size_t)DIL_POS(kstart + (lane >> 3) + 8 * i) * 2560 + 1536 + 8 * (lane & 7));
#pragma unroll 1
    for (int g = 0; g < NS; ++g) {
        LAS unsigned char* vb = vbuf + (g & 1) * DV_BUF;
#pragma unroll
        for (int i = 0; i < 4; ++i) *(LAS v4u*)(vb + ((lane >> 3) + 8 * i) * DV_PITCH + 16 * (lane & 7)) = vr[i];
        bf16x8 kc[2][2];
#pragma unroll
        for (int tl = 0; tl < 2; ++tl) { kc[tl][0] = kf[tl][0]; kc[tl][1] = kf[tl][1]; }
        if (g + 1 < NS) {
            const int kb = kstart + 32 * (g + 1);
#pragma unroll
            for (int tl = 0; tl < 2; ++tl) { const bf16* kp = KV + (size_t)DIL_POS(kb + 16 * tl + fr) * 2560 + 768 + 8 * fq; kf[tl][0] = *(const bf16x8*)kp; kf[tl][1] = *(const bf16x8*)(kp + 32); }
#pragma unroll
            for (int i = 0; i < 4; ++i) vr[i] = *(const v4u*)(KV + (size_t)DIL_POS(kb + (lane >> 3) + 8 * i) * 2560 + 1536 + 8 * (lane & 7));
        }
        float sv[8];
#pragma unroll
        for (int tl = 0; tl < 2; ++tl) {
            f32x4 cc = __builtin_amdgcn_mfma_f32_16x16x32_bf16(kc[tl][0], qf[0], (f32x4){0.f, 0.f, 0.f, 0.f}, 0, 0, 0);
            cc = __builtin_amdgcn_mfma_f32_16x16x32_bf16(kc[tl][1], qf[1], cc, 0, 0, 0);
#pragma unroll
            for (int j = 0; j < 4; ++j) {
                const int delta = dbase - (32 * g + 16 * tl + j);
                const bool ok = ((unsigned)delta <= 128u) && (delta <= dmax);
                sv[4 * tl + j] = ok ? cc[j] * 0.18033688011112042f : -INFINITY;
            }
        }
        float mx = fmaxf(fmaxf(fmaxf(sv[0], sv[1]), fmaxf(sv[2], sv[3])), fmaxf(fmaxf(sv[4], sv[5]), fmaxf(sv[6], sv[7])));
        mx = fmaxf(mx, __shfl_xor(mx, 16)); mx = fmaxf(mx, __shfl_xor(mx, 32));
        const float m_new = fmaxf(m_run, mx);
        if (!__all(m_new == m_run)) {
            const float alpha = __builtin_amdgcn_exp2f(m_run - m_new);
            l_run *= alpha;
#pragma unroll
            for (int j = 0; j < 4; ++j) { const float aj = __shfl(alpha, 4 * fq + j);
#pragma unroll
                for (int dt = 0; dt < 4; ++dt) O[dt][j] *= aj; }
            m_run = m_new;
        }
        float p[8], ps = 0.f;
#pragma unroll
        for (int e = 0; e < 8; ++e) { p[e] = __builtin_amdgcn_exp2f(sv[e] - m_run); ps += p[e]; }
        l_run += ps;
        v4u pw; pw.x = pg8::cvt_pk_bf16(p[0], p[1]); pw.y = pg8::cvt_pk_bf16(p[2], p[3]); pw.z = pg8::cvt_pk_bf16(p[4], p[5]); pw.w = pg8::cvt_pk_bf16(p[6], p[7]);
        const bf16x8 pf = __builtin_bit_cast(bf16x8, pw);
        LAS unsigned char* tb = vb + (4 * fq + ((lane & 15) >> 2)) * DV_PITCH + 8 * (lane & 3);
#pragma unroll
        for (int dt = 0; dt < 4; ++dt) {
            const v4i16_t lo = lds_tr16(tb + 32 * dt), hi = lds_tr16(tb + 16 * DV_PITCH + 32 * dt);
            bf16x8 vf; vf[0] = lo[0]; vf[1] = lo[1]; vf[2] = lo[2]; vf[3] = lo[3]; vf[4] = hi[0]; vf[5] = hi[1]; vf[6] = hi[2]; vf[7] = hi[3];
            O[dt] = __builtin_amdgcn_mfma_f32_16x16x32_bf16(pf, vf, O[dt], 0, 0, 0);
        }
    }
#undef DIL_POS
}
__device__ __forceinline__ void p14_dilated_mfma(Frame& F) {
    const int lane = F.lane, fr = lane & 15, fq = lane >> 4;
    LAS unsigned char* vbuf = F.lds + F.wave * (2 * DV_BUF);
    const bf16* QK = WSP(bf16, WS_QKVZ); bf16* AO = WSP(bf16, WS_AO);
    for (int u = F.bid; u < 24 * 32 * 2; u += F.G) {
        const int bh = u >> 6, blk = (u >> 1) & 31, o = (u & 1) * 8 + F.wave;
        const int b = bh / 12, hh = bh - b * 12, s0 = 256 * blk + o;
        const bf16* KV = QK + (size_t)b * SEQ * 2560 + hh * 64;
        bf16x8 qf[2];
        { const bf16* qp = KV + (size_t)(s0 + 16 * fr) * 2560 + 8 * fq; qf[0] = *(const bf16x8*)qp; qf[1] = *(const bf16x8*)(qp + 32); }
        f32x4 O[4];
#pragma unroll
        for (int dt = 0; dt < 4; ++dt) O[dt] = (f32x4){0.f, 0.f, 0.f, 0.f};
        float m_run = -1e30f, l_run = 0.f;
        dil_branch<4>(KV, vbuf, s0, lane, qf, O, m_run, l_run);
        dil_branch<2>(KV, vbuf, s0, lane, qf, O, m_run, l_run);
        dil_branch<0>(KV, vbuf, s0, lane, qf, O, m_run, l_run);
        float lt = l_run; lt += __shfl_xor(lt, 16); lt += __shfl_xor(lt, 32);
        const float inv = __builtin_amdgcn_rcpf(lt);
#pragma unroll
        for (int j = 0; j < 4; ++j) {
            const float ij = __shfl(inv, 4 * fq + j);
            bf16* op = AO + (size_t)(b * SEQ + s0 + 16 * (4 * fq + j)) * 1024 + hh * 64 + fr;
#pragma unroll
            for (int dt = 0; dt < 4; ++dt) op[16 * dt] = (bf16)f2bf(O[dt][j] * ij);
        }
    }
}
constexpr int SA_PITCH = 272, SA_TILE = 32 * SA_PITCH;
__device__ __forceinline__ void sparse_row(Frame& F, const int row, const int n, const LAS int* sel, LAS unsigned char* tile) {
    const int lane = F.lane, fr = lane & 15, fq = lane >> 4;
    const bf16* QL = WSP(bf16, WS_QL); const bf16* CKV = WSP(bf16, WS_CKV); bf16* AO = WSP(bf16, WS_AO);
    {
        const int b = row >> 13;
        const bf16* kvb = CKV + (size_t)b * SEQ * 128;
        bf16x8 qf[4];
#pragma unroll
        for (int s = 0; s < 4; ++s) { const v4u z = (v4u){0u, 0u, 0u, 0u}; qf[s] = (fr < 8) ? *(const bf16x8*)(QL + (size_t)row * 1536 + fr * 128 + 32 * s + 8 * fq) : __builtin_bit_cast(bf16x8, z); }
        f32x4 O[8];
#pragma unroll
        for (int rt = 0; rt < 8; ++rt) O[rt] = (f32x4){0.f, 0.f, 0.f, 0.f};
        float m_run = -1e30f, l_run = 0.f;
        const int nsteps = (n + 31) >> 5;
        v4u vr[8];
        { const int j = lane & 31; const int kidx = (j < n) ? sel[j] : 0;
#pragma unroll
          for (int i = 0; i < 8; ++i) { const int key = __shfl(kidx, (lane >> 4) + 4 * i); vr[i] = *(const v4u*)(kvb + (size_t)key * 128 + 8 * (lane & 15)); } }
#pragma unroll 1
        for (int g = 0; g < nsteps; ++g) {
#pragma unroll
            for (int i = 0; i < 8; ++i) *(LAS v4u*)(tile + ((lane >> 4) + 4 * i) * SA_PITCH + 16 * (lane & 15)) = vr[i];
            if (g + 1 < nsteps) {
                const int j = 32 * (g + 1) + (lane & 31); const int kidx = (j < n) ? sel[j] : 0;
#pragma unroll
                for (int i = 0; i < 8; ++i) { const int key = __shfl(kidx, (lane >> 4) + 4 * i); vr[i] = *(const v4u*)(kvb + (size_t)key * 128 + 8 * (lane & 15)); }
            }
            float sv[8];
#pragma unroll
            for (int tl = 0; tl < 2; ++tl) {
                f32x4 cc = (f32x4){0.f, 0.f, 0.f, 0.f};
#pragma unroll
                for (int s = 0; s < 4; ++s) { const bf16x8 kf = *(const LAS bf16x8*)(tile + (16 * tl + fr) * SA_PITCH + 64 * s + 16 * fq); cc = __builtin_amdgcn_mfma_f32_16x16x32_bf16(kf, qf[s], cc, 0, 0, 0); }
#pragma unroll
                for (int j = 0; j < 4; ++j) sv[4 * tl + j] = (32 * g + 16 * tl + 4 * fq + j < n) ? cc[j] : -INFINITY;
            }
            float mx = fmaxf(fmaxf(fmaxf(sv[0], sv[1]), fmaxf(sv[2], sv[3])), fmaxf(fmaxf(sv[4], sv[5]), fmaxf(sv[6], sv[7])));
            mx = fmaxf(mx, __shfl_xor(mx, 16)); mx = fmaxf(mx, __shfl_xor(mx, 32));
            const float m_new = fmaxf(m_run, mx);
            if (!__all(m_new == m_run)) {
                const float alpha = __expf(m_run - m_new);
                l_run *= alpha;
#pragma unroll
                for (int j = 0; j < 4; ++j) { const float aj = __shfl(alpha, 4 * fq + j);
#pragma unroll
                    for (int rt = 0; rt < 8; ++rt) O[rt][j] *= aj; }
                m_run = m_new;
            }
            float p[8], ps = 0.f;
#pragma unroll
            for (int e = 0; e < 8; ++e) { p[e] = __expf(sv[e] - m_run); ps += p[e]; }
            l_run += ps;
            v4u pw; pw.x = pg8::cvt_pk_bf16(p[0], p[1]); pw.y = pg8::cvt_pk_bf16(p[2], p[3]); pw.z = pg8::cvt_pk_bf16(p[4], p[5]); pw.w = pg8::cvt_pk_bf16(p[6], p[7]);
            const bf16x8 pf = __builtin_bit_cast(bf16x8, pw);
            LAS unsigned char* tb = tile + (4 * fq + ((lane & 15) >> 2)) * SA_PITCH + 8 * (lane & 3);
#pragma unroll
            for (int rt = 0; rt < 8; ++rt) {
                const v4i16_t lo = lds_tr16(tb + 32 * rt), hi = lds_tr16(tb + 16 * SA_PITCH + 32 * rt);
                bf16x8 vf; vf[0] = lo[0]; vf[1] = lo[1]; vf[2] = lo[2]; vf[3] = lo[3]; vf[4] = hi[0]; vf[5] = hi[1]; vf[6] = hi[2]; vf[7] = hi[3];
                O[rt] = __builtin_amdgcn_mfma_f32_16x16x32_bf16(pf, vf, O[rt], 0, 0, 0);
            }
        }
        float lt = l_run; lt += __shfl_xor(lt, 16); lt += __shfl_xor(lt, 32);
        const float inv = __builtin_amdgcn_rcpf(lt);
#pragma unroll
        for (int j = 0; j < 4; ++j) {
            const float ij = __shfl(inv, 4 * fq + j);
            if (fq < 2) { bf16* op = AO + (size_t)row * 1536 + (4 * fq + j) * 128 + fr;
#pragma unroll
                for (int rt = 0; rt < 8; ++rt) op[16 * rt] = (bf16)f2bf(O[rt][j] * ij); }
        }
    }
}
__device__ __forceinline__ void p5_topk_attn(Frame& F, const int gw, const int NGW) {
    LAS int* sel = (LAS int*)(F.lds + F.wave * 16384);
    LAS unsigned char* tile = F.lds + F.wave * 16384 + 1024;
    LAS unsigned long long* cand = (LAS unsigned long long*)(F.lds + F.wave * 16384 + 1024 + SA_TILE);
    static_assert(1024 + SA_TILE + TK_CAP * 8 <= 16384, "per-wave LDS");
    for (int rix = gw; rix < M; rix += NGW) {
        const int row = ((rix & 1) ? (M - 1 - (rix >> 1)) : (rix >> 1));
        const int n = __builtin_amdgcn_readfirstlane(topk_row(F, row, sel, cand));
        sparse_row(F, row, n, sel, tile);
    }
}
constexpr int CP_KV_PITCH = 272;
__device__ __forceinline__ void p3_chunk_prep_mfma(Frame& F, KArgs A) {
    int tid = F.tid; asm volatile("" : "+v"(tid));
    const int lane = tid & 63, wave = __builtin_amdgcn_readfirstlane(tid >> 6), fr = lane & 15, fq = lane >> 4;
    LAS unsigned char* kt = F.lds;
    LAS unsigned char* vt = F.lds + 64 * CP_KV_PITCH;
    LAS float* As = (LAS float*)(F.lds + 2 * 64 * CP_KV_PITCH);
    LAS float* Ts = As + 64 * 65;
    LAS float* gcS = Ts + 64 * 68; LAS float* egS = gcS + 64; LAS float* ekS = egS + 64; LAS float* btS = ekS + 64;
    for (int cidx = F.bid; cidx < 1024; cidx += F.G) {
        const int b = cidx >> 9, h = (cidx >> 7) & 3, n = cidx & 127, row0 = b * SEQ + n * 64;
        unsigned char* blk = F.ws + WS_CHK + (size_t)cidx * CHK_STRIDE;
        const bf16* Qg = WSP(bf16, WS_QN) + (size_t)row0 * 512 + h * 128; const bf16* Kg = WSP(bf16, WS_KN) + (size_t)row0 * 512 + h * 128; const bf16* Vg = WSP(bf16, WS_VN) + (size_t)row0 * 512 + h * 128;
        const int ti = wave >> 1;
        float g_in = 0.f, bt_in = 0.f;
        if (tid < 64) { g_in = WSP(float, WS_GG)[(size_t)(row0 + tid) * 4 + h]; bt_in = WSP(float, WS_BETA)[(size_t)(row0 + tid) * 4 + h]; }
        v4u kc[2], vc[2], qc[2];
#pragma unroll
        for (int i = 0; i < 2; ++i) { const int id = tid + 512 * i, r = id >> 4, c = id & 15; kc[i] = *(const v4u*)(Kg + (size_t)r * 512 + 8 * c); vc[i] = *(const v4u*)(Vg + (size_t)r * 512 + 8 * c); qc[i] = *(const v4u*)(Qg + (size_t)r * 512 + 8 * c); }
        bf16x8 ka[4], qa[4], kbf[2][4];
#pragma unroll
        for (int s = 0; s < 4; ++s) { ka[s] = *(const bf16x8*)(Kg + (size_t)(16 * ti + fr) * 512 + 32 * s + 8 * fq); qa[s] = *(const bf16x8*)(Qg + (size_t)(16 * ti + fr) * 512 + 32 * s + 8 * fq);
            kbf[0][s] = *(const bf16x8*)(Kg + (size_t)(16 * (2 * (wave & 1)) + fr) * 512 + 32 * s + 8 * fq); kbf[1][s] = *(const bf16x8*)(Kg + (size_t)(16 * (2 * (wave & 1) + 1) + fr) * 512 + 32 * s + 8 * fq); }
        if (tid < 64) {
            float gc = g_in;
#pragma unroll
            for (int o = 1; o < 64; o <<= 1) { const float t = __shfl_up(gc, o); if (lane >= o) gc += t; }
            const float g63 = __shfl(gc, 63);
            gcS[tid] = gc; egS[tid] = __expf(gc); ekS[tid] = __expf(g63 - gc); btS[tid] = bt_in;
            if (tid == 0) *(float*)(blk + CHK_GL) = __expf(g63);
        }
#pragma unroll
        for (int i = 0; i < 2; ++i) { const int id = tid + 512 * i, r = id >> 4, c = id & 15; *(LAS v4u*)(kt + r * CP_KV_PITCH + 16 * c) = kc[i]; *(LAS v4u*)(vt + r * CP_KV_PITCH + 16 * c) = vc[i]; }
        __syncthreads();
        {
#pragma unroll
            for (int t2 = 0; t2 < 2; ++t2) {
                const int tj = 2 * (wave & 1) + t2;
                f32x4 ck = (f32x4){0.f, 0.f, 0.f, 0.f}, cq = (f32x4){0.f, 0.f, 0.f, 0.f};
#pragma unroll
                for (int s = 0; s < 4; ++s) { ck = __builtin_amdgcn_mfma_f32_16x16x32_bf16(ka[s], kbf[t2][s], ck, 0, 0, 0); cq = __builtin_amdgcn_mfma_f32_16x16x32_bf16(qa[s], kbf[t2][s], cq, 0, 0, 0); }
                const int j = 16 * tj + fr; const float gcj = gcS[j];
                bf16* QKp = (bf16*)(blk + CHK_QK);
#pragma unroll
                for (int jj = 0; jj < 4; ++jj) { const int i = 16 * ti + 4 * fq + jj; const float dec = __expf(j <= i ? gcS[i] - gcj : 0.f);
                    As[i * 65 + j] = (j < i) ? btS[i] * ck[jj] * dec : 0.f;
                    QKp[i * 64 + 32 * (j >> 5) + 8 * ((j >> 2) & 3) + 4 * ((j >> 4) & 1) + (j & 3)] = (bf16)f2bf((j <= i) ? cq[jj] * dec : 0.f); }
            }
        }
        {
#pragma unroll
            for (int x = 0; x < 2; ++x) { const int id = tid + 512 * x, i = id >> 4, d0 = (id & 15) * 8; const float e = egS[i];
                float f[8]; unpack8(qc[x], f);
                bf16* Qd = (bf16*)(blk + CHK_QD) + i * 128 + 32 * (d0 >> 5) + 4 * ((d0 >> 4) & 1);
                const int q0 = (d0 >> 2) & 3;
                v2u w0, w1; w0.x = pk2(f[0] * e, f[1] * e); w0.y = pk2(f[2] * e, f[3] * e); w1.x = pk2(f[4] * e, f[5] * e); w1.y = pk2(f[6] * e, f[7] * e);
                *(v2u*)(Qd + 8 * q0) = w0; *(v2u*)(Qd + 8 * (q0 + 1)) = w1; }
        }
        {
            const int d = tid >> 2, c0 = (tid & 3) * 16, s = c0 >> 5, a = (c0 >> 4) & 1;
            bf16* Kd = (bf16*)(blk + CHK_KDT) + d * 64;
#pragma unroll
            for (int q = 0; q < 4; ++q) { const int c = c0 + 4 * q; float kv[4];
#pragma unroll
                for (int e = 0; e < 4; ++e) kv[e] = bf1(*(const LAS bf16*)(kt + (c + e) * CP_KV_PITCH + 2 * d)) * ekS[c + e];
                v2u w; w.x = pk2(kv[0], kv[1]); w.y = pk2(kv[2], kv[3]); *(v2u*)(Kd + 32 * s + 8 * q + 4 * a) = w; }
        }
        __syncthreads();
        {
            const int c = tid >> 3, part = tid & 7;
            for (int i = 0; i < 64; ++i) {
                float acc = 0.f;
                for (int j = part; j < i; j += 8) acc += As[i * 65 + j] * Ts[j * 68 + c];
                acc += __shfl_xor(acc, 1); acc += __shfl_xor(acc, 2); acc += __shfl_xor(acc, 4);
                if (part == 0) Ts[i * 68 + c] = ((i == c) ? 1.f : 0.f) - acc;
                __builtin_amdgcn_fence(__ATOMIC_RELEASE, "wavefront"); asm volatile("s_waitcnt lgkmcnt(0)" ::: "memory");
            }
        }
        __syncthreads();
        {
            bf16x8 vf[2], kf[2];
            LAS unsigned char* vb = vt + (8 * fq + ((lane & 15) >> 2)) * CP_KV_PITCH + 32 * wave + 8 * (lane & 3);
            LAS unsigned char* kb = kt + (8 * fq + ((lane & 15) >> 2)) * CP_KV_PITCH + 32 * wave + 8 * (lane & 3);
#pragma unroll
            for (int s = 0; s < 2; ++s) {
                const v4i16_t v0 = lds_tr16(vb + (32 * s) * CP_KV_PITCH), v1 = lds_tr16(vb + (32 * s + 4) * CP_KV_PITCH), k0 = lds_tr16(kb + (32 * s) * CP_KV_PITCH), k1 = lds_tr16(kb + (32 * s + 4) * CP_KV_PITCH);
                vf[s][0] = v0[0]; vf[s][1] = v0[1]; vf[s][2] = v0[2]; vf[s][3] = v0[3]; vf[s][4] = v1[0]; vf[s][5] = v1[1]; vf[s][6] = v1[2]; vf[s][7] = v1[3];
                kf[s][0] = k0[0]; kf[s][1] = k0[1]; kf[s][2] = k0[2]; kf[s][3] = k0[3]; kf[s][4] = k1[0]; kf[s][5] = k1[1]; kf[s][6] = k1[2]; kf[s][7] = k1[3];
            }
            float* UT = (float*)(blk + CHK_UT);
            bf16* Wp = (bf16*)(blk + CHK_WP);
#pragma unroll
            for (int ti = 0; ti < 4; ++ti) {
                f32x4 cu = (f32x4){0.f, 0.f, 0.f, 0.f}, cw = (f32x4){0.f, 0.f, 0.f, 0.f};
#pragma unroll
                for (int s = 0; s < 2; ++s) {
                    const LAS float* tr = Ts + (16 * ti + fr) * 68 + 32 * s + 8 * fq;
                    const f32x4 t0 = *(const LAS f32x4*)tr, t1 = *(const LAS f32x4*)(tr + 4);
                    const f32x4 b0 = *(const LAS f32x4*)(btS + 32 * s + 8 * fq), b1 = *(const LAS f32x4*)(btS + 32 * s + 8 * fq + 4), e0 = *(const LAS f32x4*)(egS + 32 * s + 8 * fq), e1 = *(const LAS f32x4*)(egS + 32 * s + 8 * fq + 4);
                    const f32x4 u0 = t0 * b0, u1 = t1 * b1, w0 = u0 * e0, w1 = u1 * e1;
                    cu = __builtin_amdgcn_mfma_f32_16x16x32_bf16(packfrag(u0, u1), vf[s], cu, 0, 0, 0);
                    cw = __builtin_amdgcn_mfma_f32_16x16x32_bf16(packfrag(w0, w1), kf[s], cw, 0, 0, 0);
                }
                *(f32x4*)(UT + (size_t)(16 * wave + fr) * 64 + 16 * ti + 4 * fq) = cu;
#pragma unroll
                for (int jj = 0; jj < 4; ++jj) Wp[(16 * ti + 4 * fq + jj) * 128 + 32 * (wave >> 1) + 8 * (fr >> 2) + 4 * (wave & 1) + (fr & 3)] = (bf16)f2bf(cw[jj]);
            }
        }
        __syncthreads();
    }
}
__device__ __forceinline__ void p14_pool(Frame& F, KArgs A) {
    const int lane = F.lane, tid = F.tid, gw = F.bid * NWAVES + F.wave, NGW = F.G * NWAVES;
    LAS float* pw = (LAS float*)(F.lds + 16384);
    LAS float* dl = (LAS float*)(F.lds + 16384 + 65536 + F.wave * 1024);
    {   f32x4 pv[8];
#pragma unroll
        for (int j = 0; j < 8; ++j) pv[j] = *(const f32x4*)(A->in[I_CD_POOLW] + (size_t)(tid + NTHREADS * j) * 4);
#pragma unroll
        for (int j = 0; j < 8; ++j) *(LAS f32x4*)(pw + (tid + NTHREADS * j) * 4) = pv[j];
    }
    __syncthreads();
    const bf16* QK = WSP(bf16, WS_QKVZ); bf16* AO = WSP(bf16, WS_AO);
    const int gi = lane >> 4, w = 2 << gi;
    float sc[4];
#pragma unroll
    for (int g = 0; g < 4; ++g) sc[g] = A->in[I_CD_POOLS][g * 64 + lane];
    for (int row = gw; row < M; row += NGW) {
        const int pos = row & (SEQ - 1);
        const int cntw = (pos + 1 < w) ? pos + 1 : w;
        float sum[4] = {0.f, 0.f, 0.f, 0.f}, cur[4] = {0.f, 0.f, 0.f, 0.f};
        v2u xw[16];
#pragma unroll
        for (int j = 0; j < 16; ++j) xw[j] = *(const v2u*)(QK + (size_t)(row - (j <= pos ? j : pos)) * 2560 + 2304 + 4 * lane);
#pragma unroll
        for (int j = 0; j < 16; ++j) {
            const float f0 = bflo(xw[j].x), f1 = bfhi(xw[j].x), f2 = bflo(xw[j].y), f3 = bfhi(xw[j].y);
            if (j < cntw) { sum[0] += f0; sum[1] += f1; sum[2] += f2; sum[3] += f3; }
            if (j == 0) { cur[0] = f0; cur[1] = f1; cur[2] = f2; cur[3] = f3; }
        }
        const float inv = 1.0f / (float)cntw;
#pragma unroll
        for (int i = 0; i < 4; ++i) dl[4 * lane + i] = sum[i] * inv - cur[i];
        float o[4] = {0.f, 0.f, 0.f, 0.f};
        for (int c = 0; c < 64; ++c) {
#pragma unroll
            for (int g = 0; g < 4; ++g) o[g] += dl[g * 64 + c] * pw[(g * 64 + c) * 64 + lane];
        }
#pragma unroll
        for (int g = 0; g < 4; ++g) AO[(size_t)row * 1024 + 768 + g * 64 + lane] = (bf16)f2bf(o[g] * sc[g]);
    }
}


#define IN(k) (lo <= (k) && (k) < hi)
#define SEAM(k) do { if (IN(k) && IN((k) + 1)) xcd_barrier(bar); } while (0)
template <int l> __device__ __forceinline__ void layer_tail(Frame& F, const XcdBarrier& bar, const int lo, const int hi) {
    LAS unsigned char* ring = F.lds + RING_OFF;
    const int bid = F.bid, G = F.G;
        const int pb = 8 * l;

        if (IN(7 + pb)) {
            pg8::Gemm g{WSP(bf16, WS_AO), (l == 0) ? WSP(bf16, WS_W_OUTAB) : WSP(bf16, WS_W_OUTCD), M, 1024, (l == 0) ? 1536 : 1024}; pg8::StaticOrder S; S.init(M, 1024, G, bid);
            pg8::Epi<pg8::StPre> E{{(l == 0) ? kargs()->in[I_X] : WSP(float, WS_H2), WSP(float, WS_PRE), ALPHA}};
            pg8::gemm_phase<pg8::Epi<pg8::StPre>, pg8::StaticOrder, true, true>(ring, g, S, E);
        } SEAM(7 + pb);
        if (IN(8 + pb)) { p8_ln_router(F, kargs(), l, WSP(float, WS_H1), WSP(bf16, WS_H1B)); } SEAM(8 + pb);
        if (IN(9 + pb)) {
            p9_scatter(F, l, WSP(bf16, WS_H1B), WSP(float, WS_H1));
            __syncthreads();
            pg8::Gemm g{WSP(bf16, WS_H1B), WSP(bf16, WS_W_PG) + (size_t)l * 1024 * 1024, M, 1024, 1024}; pg8::StaticOrder S; S.init(M, 1024, G, bid);
            pg8::Epi<pg8::StPleGate> E{{WSP(bf16, WS_PP) + (size_t)l * M * 1024, WSP(bf16, WS_PLE)}};
            pg8::gemm_phase<pg8::Epi<pg8::StPleGate>, pg8::StaticOrder, true, true>(ring, g, S, E);
        } SEAM(9 + pb);
        const int* TILE = WSP(int, WS_ROUTE) + 3 * M * 4;
        if (IN(10 + pb)) {
            const int nT = __builtin_amdgcn_readfirstlane(TILE[NTMAX]);
            constexpr int EB = kMoeFp8 ? 1 : 2;
            pg8::Gemm g{WSP(bf16, WS_XS), (const bf16*)(F.ws + WS_W_GU + (size_t)l * NEXP * 2048 * 1024 * EB), PMAX, 2048, 1024 * EB / 2};
            pg8::MoeOrder S{TILE, nT, 8, G, bid, (long)2048 * 1024 * EB};
            pg8::Epi<pg8::StSwiglu<kMoeFp8>> E{{kargs()->in[I_BGU] + (size_t)l * NEXP * 2048, WSP(bf16, WS_HID)}};
            pg8::gemm_phase<pg8::Epi<pg8::StSwiglu<kMoeFp8>>, pg8::MoeOrder, true, false, kMoeFp8 ? kScaleGU : 0u>(ring, g, S, E);
        } SEAM(10 + pb);
        if (IN(11 + pb)) {
            const int nT = __builtin_amdgcn_readfirstlane(TILE[NTMAX]);
            constexpr int EB = kMoeFp8 ? 1 : 2;
            pg8::Gemm g{WSP(bf16, WS_HID), (const bf16*)(F.ws + WS_W_DN + (size_t)l * NEXP * 1024 * 1024 * EB), PMAX, 1024, 1024 * EB / 2};
            pg8::MoeOrder S{TILE, nT, 4, G, bid, (long)1024 * 1024 * EB};
            pg8::Epi<pg8::StDown> E{{kargs()->in[I_BDN] + (size_t)l * NEXP * 1024, WSP(bf16, WS_YS)}};
            pg8::gemm_phase<pg8::Epi<pg8::StDown>, pg8::MoeOrder, true, false, kMoeFp8 ? kScaleDN : 0u>(ring, g, S, E);
        } SEAM(11 + pb);
        if (IN(12 + pb)) { p12_combine(F, kargs(), l, WSP(float, WS_H1), (l == 0) ? WSP(float, WS_H2) : kargs()->out, (l == 0) ? WSP(bf16, WS_XB) : (bf16*)nullptr); }
}
#undef IN
#undef SEAM
__global__ void __launch_bounds__(NTHREADS, 2) mk_fwd(Args args_by_value) {
    const KArgs KA = kargs();
    extern __shared__ __attribute__((aligned(16))) unsigned char lds[];
    Frame F;
    F.lds = (LAS unsigned char*)lds;
    F.tid = threadIdx.x; F.lane = F.tid & 63; F.wave = __builtin_amdgcn_readfirstlane(F.tid >> 6);
    F.G = gridDim.x; F.bid = blockIdx.x; F.ws = KA->ws; F.ctl = (gu32*)(KA->ws + WS_CTL);
    volatile LAS unsigned* MISC = (volatile LAS unsigned*)(F.lds + MISC_OFF);
    { int t0 = threadIdx.x; asm volatile("" : "+v"(t0)); for (int u = t0; u < (LDS_BYTES - MISC_OFF) / 4; u += NTHREADS) MISC[u] = 0u; }
    __syncthreads();
    const bool use_bar = (N_LAUNCHES != NPHASES);
    XcdBarrier bar; bar.bar = (unsigned*)(F.ctl + CW_BAR) + KA->li * XCD_BAR_WORDS; bar.x = 0; bar.st = nullptr; bar.expect = 0;
    XcdBarrier bar2 = bar;
    if (use_bar && F.bid >= SEQ_WGS && F.G > SEQ_WGS) bar2 = xcd_barrier_post((unsigned*)(F.ctl + CW_BAR2), MISC + 10, (unsigned)(F.G - SEQ_WGS));
    if (use_bar) bar = xcd_barrier_post((unsigned*)(F.ctl + CW_BAR) + KA->li * XCD_BAR_WORDS, MISC + 8);
    const int lo = KA->ph_lo, hi = KA->ph_hi;
#define IN(k) (lo <= (k) && (k) < hi)
#define SEAM(k) do { if (IN(k) && IN((k) + 1)) xcd_barrier(bar); } while (0)
    LAS unsigned char* ring = F.lds + RING_OFF;
    const int bid = F.bid, G = F.G;

    if (IN(0)) { p0_prologue(F, kargs()); } SEAM(0);

            if (IN(1)) {
                { pg8::Gemm g{WSP(bf16, WS_XB), WSP(bf16, WS_W_INAB), M, 2560, 1024}; pg8::StaticOrder S; S.init(M, 2560, G, bid);
                  pg8::Epi<pg8::StInAB> E{{WSP(float, WS_SM), WSP(bf16, WS_QKVZ)}};
                  pg8::gemm_phase<pg8::Epi<pg8::StInAB>, pg8::StaticOrder, true, true>(ring, g, S, E); }
                __syncthreads();
                { pg8::Gemm g{WSP(bf16, WS_PB), WSP(bf16, WS_W_PP), 2 * M, 1024, 256}; pg8::BatchOrder S{4, (2 * M / 256) * 4, G, bid, M / 256, (long)1024 * 256 * 2};
                  pg8::Epi<pg8::StBf16> E{{WSP(bf16, WS_PP), 1024}};
                  pg8::gemm_phase<pg8::Epi<pg8::StBf16>, pg8::BatchOrder, true, true>(ring, g, S, E); }
            } SEAM(1);
            if (IN(2)) { p2_prep(F, kargs()); } SEAM(2);
            if (IN(3)) {
                p3_chunk_prep_mfma(F, kargs());
                __syncthreads();
                { pg8::Gemm g{WSP(bf16, WS_CQ), WSP(bf16, WS_W_ABS), M, 1536, 256}; pg8::StaticOrder S; S.init(M, 1536, G, bid);
                  pg8::Epi<pg8::StBf16> E{{WSP(bf16, WS_QL), 1536}};
                  pg8::gemm_phase<pg8::Epi<pg8::StBf16>, pg8::StaticOrder, true, true>(ring, g, S, E); }
            } SEAM(3);
            if (IN(4)) {
                if (bid < SEQ_WGS && G > SEQ_WGS) p4_delta_seq(F, bid);
                else { p4_indexer(F, (bid - SEQ_WGS) * NWAVES + F.wave, (G - SEQ_WGS) * NWAVES);
                    if (use_bar) { xcd_barrier(bar2);
                        p5_topk_attn(F, (bid - SEQ_WGS) * NWAVES + F.wave, (G - SEQ_WGS) * NWAVES); } }
            } SEAM(4);
            if (IN(5)) { if (!use_bar) p5_topk_attn(F, bid * NWAVES + F.wave, G * NWAVES); p6_gdn_out(F, kargs()); } SEAM(5);
    layer_tail<0>(F, bar, lo, hi);
    SEAM(12);
            if (IN(13)) {
                pg8::Gemm g{WSP(bf16, WS_XB), WSP(bf16, WS_W_INCD), M, 2560, 1024}; pg8::StaticOrder S; S.init(M, 2560, G, bid);
                pg8::Epi<pg8::StBf16> E{{WSP(bf16, WS_QKVZ), 2560}};
                pg8::gemm_phase<pg8::Epi<pg8::StBf16>, pg8::StaticOrder, true, true>(ring, g, S, E);
            } SEAM(13);
            if (IN(14)) { p14_dilated_mfma(F); __syncthreads(); p14_pool(F, kargs()); } SEAM(14);
    layer_tail<1>(F, bar, lo, hi);
#undef IN
#undef SEAM
}

extern "C" void kernel_launch(void* const* d_in, const int* in_sizes, int n_in, void* d_out, int out_size, void* d_ws, size_t ws_size, hipStream_t stream) {
    static int grid = 0;
    if (grid == 0) {
        if (n_in != N_IN || in_sizes[0] != M * D || out_size != M * D || ws_size < WS_END) {
            fprintf(stderr, "kernel_launch: built for %d inputs, x/out of %d floats, >= %zu bytes of workspace; got n_in %d, in0 %d, out %d, ws %zu; nothing launched\n", N_IN, M * D, (size_t)WS_END, n_in, n_in > 0 ? in_sizes[0] : -1, out_size, ws_size);
            grid = -1; return; }
        int dev = 0, cus = 0, per_cu = 0;
        if (hipGetDevice(&dev) != hipSuccess || hipDeviceGetAttribute(&cus, hipDeviceAttributeMultiprocessorCount, dev) != hipSuccess) { fprintf(stderr, "kernel_launch: device query failed\n"); grid = -1; return; }
        if (hipFuncSetAttribute((const void*)mk_fwd, hipFuncAttributeMaxDynamicSharedMemorySize, LDS_BYTES) != hipSuccess) { fprintf(stderr, "kernel_launch: hipFuncSetAttribute failed\n"); grid = -1; return; }
        if (hipOccupancyMaxActiveBlocksPerMultiprocessor(&per_cu, (const void*)mk_fwd, NTHREADS, LDS_BYTES) != hipSuccess || per_cu < 1)
            fprintf(stderr, "kernel_launch: note: occupancy query reports %d workgroups per CU\n", per_cu);
        (void)hipGetLastError();
        grid = cus;
    }
    if (grid < 0) return;
    if (hipMemsetAsync((char*)d_ws + WS_CTL, 0, CTL_ZERO_BYTES, stream) != hipSuccess) { fprintf(stderr, "kernel_launch: memset failed\n"); return; }
    Args a{};
    for (int i = 0; i < N_IN; ++i) a.in[i] = (const float*)d_in[i];
    a.out = (float*)d_out; a.ws = (unsigned char*)d_ws;
    for (int li = 0; li < N_LAUNCHES; ++li) {
        if (N_LAUNCHES == NPHASES) { a.ph_lo = li; a.ph_hi = li + 1; } else { a.ph_lo = (int)((long)li * NPHASES / N_LAUNCHES); a.ph_hi = (int)((long)(li + 1) * NPHASES / N_LAUNCHES); }
        a.li = li;
        hipLaunchKernelGGL(mk_fwd, dim3(grid), dim3(NTHREADS), LDS_BYTES, stream, a);
        const hipError_t le = hipPeekAtLastError();
        if (le != hipSuccess) { fprintf(stderr, "kernel_launch: launch %d failed: %s\n", li, hipGetErrorName(le)); break; }
    }
}
```

```cpp
#include <hip/hip_runtime.h>
#include <cstdio>
#include <cstdint>

namespace pg8 {
#define PG8_LAS __attribute__((address_space(3)))
typedef unsigned short bf16_t;
typedef short bf16x8 __attribute__((ext_vector_type(8)));
typedef float f32x4 __attribute__((ext_vector_type(4)));
typedef unsigned u32x4 __attribute__((ext_vector_type(4)));
constexpr int BM = 256, BK = 64, HALF = 128, HTB = HALF * BK * 2  , STAGE_BYTES = 8 * HTB, NXCD = 8, WGM = 8;

__host__ __device__ __forceinline__ int lds_byte(int r, int c) { const int st = (r >> 4) * 2 + (c >> 5), rr = r & 15, cc = c & 31, ob = rr * 64 + cc * 2; return st * 1024 + (ob ^ (((ob >> 9) & 1) << 5)); }
__host__ __device__ __forceinline__ void stage_rc(int b, int& R, int& C) { const int st = b / 1024, sb = b % 1024, swz = sb ^ (((sb >> 9) & 1) << 5); R = (st >> 1) * 16 + swz / 64; C = (st & 1) * 32 + (swz % 64) / 2; }
__host__ __device__ __forceinline__ int perm32(int rho) { const int n = rho >> 4, i = rho & 15; return 8 * (i >> 2) + 4 * n + (i & 3); }

struct Unit { int pm, pn, e; long bofs; };
struct Gemm { const bf16_t* A; const bf16_t* Bt; int M, N, K; };

struct StaticOrder {
    int nM, nN, nwg, G, c;
    __host__ __device__ void init(int M, int N, int G_, int c_) { nM = M / BM; nN = N / BM; nwg = nM * nN; G = G_; c = c_; }
    __host__ __device__ bool next(int i, Unit& u) const {
        const long L = (long)i * G + c; if (L >= nwg) return false;
        int wgid = (int)L; { const int q = nwg / NXCD, r = nwg % NXCD, xcd = wgid % NXCD, off = wgid / NXCD; wgid = (xcd < r ? xcd * (q + 1) : r * (q + 1) + (xcd - r) * q) + off; }
        const int nig = WGM * nN, gid = wgid / nig, fm = gid * WGM, gsz = (nM - fm) < WGM ? (nM - fm) : WGM;
        u.pm = fm + ((wgid % nig) % gsz); u.pn = (wgid % nig) / gsz; u.e = 0; u.bofs = 0; return true;
    }
    __device__ __forceinline__ void a_ready(const Unit&) const {}
    __device__ __forceinline__ void done(const Unit&) const {}
};
struct MoeOrder {
    const int* tile_e; int nT, nN, G, c; long estride;
    __device__ __forceinline__ bool next(int i, Unit& u) const {
        if (G % (8 * nN) == 0) {
            const int rpx = G / (8 * nN), xcd = c & 7, idx = c >> 3;
            u.pm = (i * 8 + xcd) * rpx + idx % rpx; u.pn = idx / rpx;
            if (u.pm >= nT) return false;
        } else {
            const long L = (long)i * G + c; if (L >= (long)nT * nN) return false;
            u.pm = (int)(L / nN); u.pn = (int)(L % nN);
        }
        const int e = tile_e[u.pm]; u.e = e; u.bofs = (long)e * estride; return true;
    }
    __device__ __forceinline__ void a_ready(const Unit&) const {}
    __device__ __forceinline__ void done(const Unit&) const {}
};

struct BatchOrder {
    int nN, nwg, G, c, tiles_per_batch; long bstride;
    __device__ __forceinline__ bool next(int i, Unit& u) const {
        const long L = (long)i * G + c; if (L >= nwg) return false;
        u.pm = (int)(L / nN); u.pn = (int)(L % nN); const int e = u.pm / tiles_per_batch; u.e = e; u.bofs = (long)e * bstride; return true;
    }
    __device__ __forceinline__ void a_ready(const Unit&) const {}
    __device__ __forceinline__ void done(const Unit&) const {}
};

typedef float f32x2c __attribute__((ext_vector_type(2)));
typedef __bf16 bf16x2c __attribute__((ext_vector_type(2)));
__device__ __forceinline__ unsigned cvt_pk_bf16(float lo, float hi) { const f32x2c v = {lo, hi}; const bf16x2c b = __builtin_convertvector(v, bf16x2c); return __builtin_bit_cast(unsigned, b); }
__device__ __forceinline__ u32x4 pack8(const f32x4 v0, const f32x4 v1) { u32x4 w; w.x = cvt_pk_bf16(v0[0], v0[1]); w.y = cvt_pk_bf16(v0[2], v0[3]); w.z = cvt_pk_bf16(v1[0], v1[1]); w.w = cvt_pk_bf16(v1[2], v1[3]); return w; }
__device__ __forceinline__ float bf_lo(unsigned w) { return __uint_as_float(w << 16); }
__device__ __forceinline__ float bf_hi(unsigned w) { return __uint_as_float(w & 0xffff0000u); }
__device__ __forceinline__ float sigmoidf_(float x) { return __builtin_amdgcn_rcpf(1.0f + __builtin_amdgcn_exp2f(x * -1.4426950408889634f)); }
typedef unsigned u32x2 __attribute__((ext_vector_type(2)));

template <class T> struct Epi {
    static constexpr bool PERM = true, AFTER_DRAIN = false;
    T t;
    __device__ __forceinline__ void operator()(const f32x4 (&acc)[2][2][4][2], const Unit& u, int wr, int wc, int fr, int fq) const {
        const int row0 = u.pm * BM + wr * 64 + fr, col0 = u.pn * BM + wc * 32 + 8 * fq;
        f32x4 cb[2][2];
#pragma unroll
        for (int bj = 0; bj < 2; ++bj) t.colctx(col0 + bj * HALF, u, cb[bj][0], cb[bj][1]);
        f32x4 rc[2][2], rn[2][2];
#pragma unroll
        for (int bj = 0; bj < 2; ++bj) t.rowctx(row0, col0 + bj * HALF, rc[bj][0], rc[bj][1]);
#pragma unroll
        for (int g = 0; g < 8; ++g) {
            const int ai = g >> 2, m = g & 3, row = row0 + ai * HALF + m * 16;
            if (g < 7) { const int nrow = row0 + ((g + 1) >> 2) * HALF + ((g + 1) & 3) * 16;
#pragma unroll
                for (int bj = 0; bj < 2; ++bj) t.rowctx(nrow, col0 + bj * HALF, rn[bj][0], rn[bj][1]); }
#pragma unroll
            for (int bj = 0; bj < 2; ++bj) t.store(row, col0 + bj * HALF, acc[ai][bj][m][0] + cb[bj][0], acc[ai][bj][m][1] + cb[bj][1], u, rc[bj][0], rc[bj][1]);
            asm volatile("" ::: "memory");
#pragma unroll
            for (int bj = 0; bj < 2; ++bj) { rc[bj][0] = rn[bj][0]; rc[bj][1] = rn[bj][1]; }
        }
    }
};
struct StBf16 { bf16_t* O; int ld;
    __device__ __forceinline__ void rowctx(int, int, f32x4& r0, f32x4& r1) const { r0 = (f32x4){0.f, 0.f, 0.f, 0.f}; r1 = r0; }
    __device__ __forceinline__ void colctx(int, const Unit&, f32x4& c0, f32x4& c1) const { c0 = (f32x4){0.f, 0.f, 0.f, 0.f}; c1 = c0; }
    __device__ __forceinline__ void store(int row, int col, f32x4 v0, f32x4 v1, const Unit&, f32x4, f32x4) const { *(u32x4*)(O + (size_t)row * ld + col) = pack8(v0, v1); } };
struct StInAB { float* SM; bf16_t* Q;
    __device__ __forceinline__ void rowctx(int, int, f32x4& r0, f32x4& r1) const { r0 = (f32x4){0.f, 0.f, 0.f, 0.f}; r1 = r0; }
    __device__ __forceinline__ void colctx(int, const Unit&, f32x4& c0, f32x4& c1) const { c0 = (f32x4){0.f, 0.f, 0.f, 0.f}; c1 = c0; }
    __device__ __forceinline__ void store(int row, int col, f32x4 v0, f32x4 v1, const Unit&, f32x4, f32x4) const {
        if (col < 512) { float* p = SM + (size_t)row * 512 + col; *(f32x4*)p = v0; *(f32x4*)(p + 4) = v1; }
        else *(u32x4*)(Q + (size_t)row * 2048 + (col - 512)) = pack8(v0, v1); } };
struct StPre { const float* base; float* P; float alpha;
    __device__ __forceinline__ void colctx(int, const Unit&, f32x4& c0, f32x4& c1) const { c0 = (f32x4){0.f, 0.f, 0.f, 0.f}; c1 = c0; }
    __device__ __forceinline__ void rowctx(int row, int col, f32x4& r0, f32x4& r1) const { const size_t o = (size_t)row * 1024 + col; r0 = *(const f32x4*)(base + o); r1 = *(const f32x4*)(base + o + 4); }
    __device__ __forceinline__ void store(int row, int col, f32x4 v0, f32x4 v1, const Unit&, f32x4 b0, f32x4 b1) const {
        const size_t o = (size_t)row * 1024 + col;
        *(f32x4*)(P + o) = b0 * alpha + v0; *(f32x4*)(P + o + 4) = b1 * alpha + v1; } };
struct StPleGate { const bf16_t* PP; bf16_t* O;
    __device__ __forceinline__ void colctx(int, const Unit&, f32x4& c0, f32x4& c1) const { c0 = (f32x4){0.f, 0.f, 0.f, 0.f}; c1 = c0; }
    __device__ __forceinline__ void rowctx(int row, int col, f32x4& r0, f32x4& r1) const { r0 = *(const f32x4*)(PP + (size_t)row * 1024 + col); r1 = r0; }
    __device__ __forceinline__ void store(int row, int col, f32x4 v0, f32x4 v1, const Unit&, f32x4 pr, f32x4) const {
        const size_t o = (size_t)row * 1024 + col; const u32x4 p = __builtin_bit_cast(u32x4, pr);
        f32x4 r0, r1;
        r0[0] = sigmoidf_(v0[0]) * bf_lo(p.x); r0[1] = sigmoidf_(v0[1]) * bf_hi(p.x); r0[2] = sigmoidf_(v0[2]) * bf_lo(p.y); r0[3] = sigmoidf_(v0[3]) * bf_hi(p.y);
        r1[0] = sigmoidf_(v1[0]) * bf_lo(p.z); r1[1] = sigmoidf_(v1[1]) * bf_hi(p.z); r1[2] = sigmoidf_(v1[2]) * bf_lo(p.w); r1[3] = sigmoidf_(v1[3]) * bf_hi(p.w);
        *(u32x4*)(O + o) = pack8(r0, r1); } };
template <bool F8> struct StSwiglu { const float* bgu; bf16_t* H;
    __device__ __forceinline__ void rowctx(int, int, f32x4& r0, f32x4& r1) const { r0 = (f32x4){0.f, 0.f, 0.f, 0.f}; r1 = r0; }
    __device__ __forceinline__ float act(float g, float u) const { const float gt = __builtin_amdgcn_fmed3f(g, -INFINITY, 7.0f), up = __builtin_amdgcn_fmed3f(u, -7.0f, 7.0f);
        return (up + 1.0f) * (gt * __builtin_amdgcn_rcpf(1.0f + __builtin_amdgcn_exp2f(gt * -2.4554669595930157f))); }
    __device__ __forceinline__ void colctx(int col, const Unit& u, f32x4& c0, f32x4& c1) const { const float* b = bgu + (size_t)u.e * 2048 + col; c0 = *(const f32x4*)b; c1 = *(const f32x4*)(b + 4); }
    __device__ __forceinline__ void store(int row, int col, f32x4 v0, f32x4 v1, const Unit& u, f32x4, f32x4) const {
        if (F8) { unsigned w = 0u; w = __builtin_amdgcn_cvt_pk_fp8_f32(act(v0[0], v0[1]), act(v0[2], v0[3]), w, false); w = __builtin_amdgcn_cvt_pk_fp8_f32(act(v1[0], v1[1]), act(v1[2], v1[3]), w, true);
            *(unsigned*)((unsigned char*)H + (size_t)row * 1024 + (col >> 1)) = w; }
        else { u32x2 w; w.x = cvt_pk_bf16(act(v0[0], v0[1]), act(v0[2], v0[3])); w.y = cvt_pk_bf16(act(v1[0], v1[1]), act(v1[2], v1[3]));
            *(u32x2*)(H + (size_t)row * 1024 + (col >> 1)) = w; } } };
struct StDown { const float* bd; bf16_t* Y;
    __device__ __forceinline__ void rowctx(int, int, f32x4& r0, f32x4& r1) const { r0 = (f32x4){0.f, 0.f, 0.f, 0.f}; r1 = r0; }
    __device__ __forceinline__ void colctx(int col, const Unit& u, f32x4& c0, f32x4& c1) const { const float* b = bd + (size_t)u.e * 1024 + col; c0 = *(const f32x4*)b; c1 = *(const f32x4*)(b + 4); }
    __device__ __forceinline__ void store(int row, int col, f32x4 v0, f32x4 v1, const Unit& u, f32x4, f32x4) const {
        *(u32x4*)(Y + (size_t)row * 1024 + col) = pack8(v0, v1); } };

typedef int i32x8 __attribute__((ext_vector_type(8)));
typedef int i32x4 __attribute__((ext_vector_type(4)));
template <class Epi, class Sched, bool ALIGN_EPI = false, bool SP2 = false, unsigned FP8W = 0u>
__device__ __forceinline__ void gemm_phase(PG8_LAS unsigned char* lds, const Gemm g, const Sched& S, const Epi& E) {
    int tid = threadIdx.x; asm volatile("" : "+v"(tid));
    const int wid = __builtin_amdgcn_readfirstlane(tid >> 6), lane = tid & 63, wr = wid >> 2, wc = wid & 3, fr = lane & 15, fq = lane >> 4;
    int K = g.K; asm volatile("" : "+s"(K));
    const int nt = K / BK;
    unsigned voffA[2], voffB[2];
#pragma unroll
    for (int i = 0; i < 2; ++i) { int R, C; stage_rc(tid * 16 + i * 8192, R, C); const int Rb = Epi::PERM ? ((R & ~31) + perm32(R & 31)) : R;
        voffA[i] = (unsigned)(R * K + C) * 2u; voffB[i] = (unsigned)(Rb * K + C) * 2u; }
    const size_t kstep = (size_t)(BK * 2);
    const size_t hstep = (size_t)HALF * K * 2;
    const size_t tstep = 2 * hstep;
    const unsigned ldsw = (unsigned)wid * 1024u;
    const int aoff = lds_byte(wr * 64 + fr, fq * 8), boff = lds_byte(wc * 32 + fr, fq * 8);
#define PG8_SA(b, h) (((b) * 2 + (h)) * HTB)
#define PG8_SB(b, h) ((4 + (b) * 2 + (h)) * HTB)
#define PG8_STAGE(bufoff, gbase, voff) do { _Pragma("unroll") for (int _i = 0; _i < 2; ++_i) \
        __builtin_amdgcn_global_load_lds((const unsigned*)((const char*)(gbase) + (voff)[_i]), (PG8_LAS unsigned*)(lds + (bufoff) + ldsw + _i * 8192), 16, 0, 0); } while (0)
#define PG8_CAT(lo, hi) __builtin_shufflevector((lo), (hi), 0, 1, 2, 3, 4, 5, 6, 7)
#define PG8_LDA(dst, b, h) do { if constexpr (FP8W != 0u) { _Pragma("unroll") for (int m = 0; m < 4; ++m) dst##8[m] = PG8_CAT(*(const PG8_LAS i32x4*)(lds + PG8_SA(b, h) + aoff + m * 2048), *(const PG8_LAS i32x4*)(lds + PG8_SA(b, h) + aoff + m * 2048 + 1024)); } \
        else { _Pragma("unroll") for (int m = 0; m < 4; ++m) _Pragma("unroll") for (int k = 0; k < 2; ++k) dst[m][k] = *(const PG8_LAS bf16x8*)(lds + PG8_SA(b, h) + aoff + m * 2048 + k * 1024); } } while (0)
#define PG8_LDB(dst, b, h) do { if constexpr (FP8W != 0u) { _Pragma("unroll") for (int n = 0; n < 2; ++n) dst##8[n] = PG8_CAT(*(const PG8_LAS i32x4*)(lds + PG8_SB(b, h) + boff + n * 2048), *(const PG8_LAS i32x4*)(lds + PG8_SB(b, h) + boff + n * 2048 + 1024)); } \
        else { _Pragma("unroll") for (int n = 0; n < 2; ++n) _Pragma("unroll") for (int k = 0; k < 2; ++k) dst[n][k] = *(const PG8_LAS bf16x8*)(lds + PG8_SB(b, h) + boff + n * 2048 + k * 1024); } } while (0)
#define PG8_MMA(ai, bj, At, Bt) do { __builtin_amdgcn_s_setprio(1); _Pragma("unroll") for (int m = 0; m < 4; ++m) _Pragma("unroll") for (int n = 0; n < 2; ++n) { \
        if constexpr (FP8W != 0u) asm volatile("v_mfma_scale_f32_16x16x128_f8f6f4 %0, %1, %2, %0, %3, %4 op_sel_hi:[0,0,0]" : "+v"(acc[ai][bj][m][n]) : "v"(Bt##8[n]), "v"(At##8[m]), "v"(sc_w), "v"(sc_x));   \
        else { _Pragma("unroll") for (int k = 0; k < 2; ++k) acc[ai][bj][m][n] = __builtin_amdgcn_mfma_f32_16x16x32_bf16(Bt[n][k], At[m][k], acc[ai][bj][m][n], 0, 0, 0); } } __builtin_amdgcn_s_setprio(0); } while (0)
#define PG8_WAIT_V(n) asm volatile("s_waitcnt vmcnt(" #n ")" ::: "memory")
#define PG8_WAIT_L(n) asm volatile("s_waitcnt lgkmcnt(" #n ")" ::: "memory")
#define PG8_BAR __builtin_amdgcn_s_barrier()
#define PG8_SCHED __builtin_amdgcn_sched_barrier(0)
    Unit cur, nxt; int ui = 0;
    if (!S.next(0, cur)) return;
    f32x4 acc[2][2][4][2];
#pragma unroll
    for (int a = 0; a < 2; ++a)
#pragma unroll
        for (int b = 0; b < 2; ++b)
#pragma unroll
            for (int m = 0; m < 4; ++m)
#pragma unroll
                for (int n = 0; n < 2; ++n) acc[a][b][m][n] = (f32x4){0.f, 0.f, 0.f, 0.f};
    bf16x8 At[4][2], B0[2][2], B1[2][2];
    int sc_w = (int)FP8W, sc_x = 0x7f7f7f7f; asm volatile("" : "+v"(sc_w), "+v"(sc_x));
    i32x8 At8[4], B08[2], B18[2];
    const char* cA = (const char*)g.A + (size_t)cur.pm * tstep; const char* cB = (const char*)g.Bt + (size_t)cur.pn * tstep + cur.bofs;
    S.a_ready(cur);
    if constexpr (SP2) {
        PG8_STAGE(PG8_SB(0, 0), cB, voffB); PG8_STAGE(PG8_SB(0, 1), cB + hstep, voffB); PG8_STAGE(PG8_SA(0, 0), cA, voffA); PG8_STAGE(PG8_SA(0, 1), cA + hstep, voffA);
        if (wr == 1) PG8_BAR;
        PG8_WAIT_V(2); PG8_BAR;
        PG8_STAGE(PG8_SB(1, 0), cB + kstep, voffB); PG8_STAGE(PG8_SA(1, 0), cA + kstep, voffA); PG8_STAGE(PG8_SB(1, 1), cB + hstep + kstep, voffB);
        PG8_WAIT_V(6); PG8_BAR;
    } else {
        PG8_STAGE(PG8_SB(0, 0), cB, voffB); PG8_STAGE(PG8_SA(0, 0), cA, voffA); PG8_STAGE(PG8_SB(0, 1), cB + hstep, voffB); PG8_STAGE(PG8_SA(0, 1), cA + hstep, voffA);
        if (wr == 1) PG8_BAR;
        PG8_WAIT_V(4); PG8_BAR;
        PG8_STAGE(PG8_SB(1, 0), cB + kstep, voffB); PG8_STAGE(PG8_SA(1, 0), cA + kstep, voffA); PG8_STAGE(PG8_SB(1, 1), cB + hstep + kstep, voffB);
        PG8_WAIT_V(6); PG8_BAR;
    }
    for (;;) {
        const bool has_next = S.next(ui + 1, nxt);
        const char* nA = has_next ? (const char*)g.A + (size_t)nxt.pm * tstep : cA; const char* nB = has_next ? (const char*)g.Bt + (size_t)nxt.pn * tstep + nxt.bofs : cB;
        for (int t = 0; t < nt; t += 2) {
            const bool last = (t == nt - 2);
            const char* a1 = cA + (size_t)(t + 1) * kstep;
            const char* a2 = last ? nA : cA + (size_t)(t + 2) * kstep; const char* b2 = last ? nB : cB + (size_t)(t + 2) * kstep;
            const char* a3 = a2 + kstep; const char* b3 = b2 + kstep;
            if (last && has_next) S.a_ready(nxt);
            if constexpr (SP2) {
            PG8_LDB(B0, 0, 0); PG8_LDB(B1, 0, 1); PG8_SCHED; PG8_LDA(At, 0, 0); PG8_STAGE(PG8_SA(1, 1), a1 + hstep, voffA);
            PG8_WAIT_V(8); PG8_WAIT_L(0); PG8_BAR; PG8_MMA(0, 0, At, B0); PG8_MMA(0, 1, At, B1); PG8_BAR; PG8_SCHED;
            PG8_LDA(At, 0, 1); PG8_STAGE(PG8_SB(0, 0), b2, voffB); PG8_STAGE(PG8_SB(0, 1), b2 + hstep, voffB); PG8_STAGE(PG8_SA(0, 0), a2, voffA);
            PG8_WAIT_V(8); PG8_WAIT_L(0); PG8_BAR; PG8_MMA(1, 0, At, B0); PG8_MMA(1, 1, At, B1); PG8_BAR; PG8_SCHED;
            PG8_LDB(B0, 1, 0); PG8_LDB(B1, 1, 1); PG8_SCHED; PG8_LDA(At, 1, 0); PG8_STAGE(PG8_SA(0, 1), a2 + hstep, voffA);
            PG8_WAIT_V(8); PG8_WAIT_L(0); PG8_BAR; PG8_MMA(0, 0, At, B0); PG8_MMA(0, 1, At, B1); PG8_BAR; PG8_SCHED;
            PG8_LDA(At, 1, 1); PG8_STAGE(PG8_SB(1, 0), b3, voffB); PG8_STAGE(PG8_SB(1, 1), b3 + hstep, voffB); PG8_STAGE(PG8_SA(1, 0), a3, voffA);
            PG8_WAIT_V(8); PG8_WAIT_L(0); PG8_BAR; PG8_MMA(1, 0, At, B0); PG8_MMA(1, 1, At, B1); PG8_BAR; PG8_SCHED;
            } else {
            PG8_LDB(B0, 0, 0); PG8_SCHED; PG8_LDA(At, 0, 0); PG8_STAGE(PG8_SA(1, 1), a1 + hstep, voffA);
            PG8_WAIT_L(8); PG8_BAR; PG8_WAIT_L(0); PG8_MMA(0, 0, At, B0); PG8_BAR; PG8_SCHED;
            PG8_LDB(B1, 0, 1); PG8_STAGE(PG8_SB(0, 0), b2, voffB);
            PG8_BAR; PG8_WAIT_L(0); PG8_MMA(0, 1, At, B1); PG8_BAR;
            PG8_LDA(At, 0, 1); PG8_STAGE(PG8_SA(0, 0), a2, voffA);
            PG8_BAR; PG8_WAIT_L(0); PG8_MMA(1, 0, At, B0); PG8_BAR; PG8_SCHED;
            PG8_STAGE(PG8_SB(0, 1), b2 + hstep, voffB);
            PG8_WAIT_V(6); PG8_BAR; PG8_MMA(1, 1, At, B1); PG8_BAR;
            PG8_LDB(B0, 1, 0); PG8_SCHED; PG8_LDA(At, 1, 0); PG8_STAGE(PG8_SA(0, 1), a2 + hstep, voffA);
            PG8_WAIT_L(8); PG8_BAR; PG8_WAIT_L(0); PG8_MMA(0, 0, At, B0); PG8_BAR; PG8_SCHED;
            PG8_LDB(B1, 1, 1); PG8_STAGE(PG8_SB(1, 0), b3, voffB);
            PG8_BAR; PG8_WAIT_L(0); PG8_MMA(0, 1, At, B1); PG8_BAR;
            PG8_LDA(At, 1, 1); PG8_STAGE(PG8_SA(1, 0), a3, voffA);
            PG8_BAR; PG8_WAIT_L(0); PG8_MMA(1, 0, At, B0); PG8_BAR; PG8_SCHED;
            PG8_STAGE(PG8_SB(1, 1), b3 + hstep, voffB);
            PG8_WAIT_V(6); PG8_BAR; PG8_MMA(1, 1, At, B1); PG8_BAR;
            }
        }
        if constexpr (FP8W != 0u) asm volatile("s_nop 15\n\ts_nop 15" ::: "memory");
        if constexpr (ALIGN_EPI) { if (wr == 0) PG8_BAR; }
        if constexpr (!Epi::AFTER_DRAIN) { E(acc, cur, wr, wc, fr, fq); S.done(cur); }
        if (!has_next) break;
#pragma unroll
        for (int a = 0; a < 2; ++a)
#pragma unroll
            for (int b = 0; b < 2; ++b)
#pragma unroll
                for (int m = 0; m < 4; ++m)
#pragma unroll
                    for (int n = 0; n < 2; ++n) acc[a][b][m][n] = (f32x4){0.f, 0.f, 0.f, 0.f};
        cur = nxt; cA = nA; cB = nB; ++ui;
        if constexpr (ALIGN_EPI) { if (wr == 1) PG8_BAR; }
    }
    PG8_WAIT_V(0);
    if constexpr (!ALIGN_EPI) { if (wr == 0) PG8_BAR; }
    PG8_BAR;
    if constexpr (Epi::AFTER_DRAIN) { E.fused(acc, cur, wr, wc, fr, fq, lds, wid, lane); S.done(cur); }
#undef PG8_SA
#undef PG8_SB
#undef PG8_STAGE
#undef PG8_LDA
#undef PG8_CAT
#undef PG8_LDB
#undef PG8_MMA
#undef PG8_WAIT_V
#undef PG8_WAIT_L
#undef PG8_BAR
#undef PG8_SCHED
}
}

constexpr int NWAVES = 8, NTHREADS = 512;
constexpr int BATCH = 2, SEQ = 8192, M = BATCH * SEQ, D = 1024;
constexpr int NEXP = 32, DEXP = 1024;
constexpr int PMAX = M * 4 + NEXP * 256, NTMAX = PMAX / 256;
constexpr float ALPHA = 1.41421356237f;
constexpr int NPHASES = 21;
#ifndef MOE_FP8
#define MOE_FP8 1
#endif
constexpr bool kMoeFp8 = (MOE_FP8 != 0);
constexpr unsigned kScaleGU = 0x79797979u, kScaleDN = 0x78787878u;
#ifndef MK_N_LAUNCHES
#define MK_N_LAUNCHES 1
#endif
constexpr int N_LAUNCHES = MK_N_LAUNCHES;

enum { I_X = 0, I_P, I_AB_WIN, I_AB_QG, I_AB_KVG, I_AB_WUQ, I_AB_WUK, I_AB_WUV, I_AB_WQIDX, I_AB_KIG, I_AB_KIB, I_AB_CONVW, I_AB_ALOG, I_AB_DTB, I_AB_ONG, I_AB_WOUT,
       I_CD_WIN, I_CD_POOLW, I_CD_POOLS, I_CD_WOUT, I_LNM_G, I_LNM_B, I_RW, I_RB, I_WGU, I_BGU, I_WDN, I_BDN, I_PLE_WP, I_PLE_WG, I_LNF_G, I_LNF_B, N_IN };

constexpr size_t MiB = 1u << 20;
constexpr size_t WS_CTL = 0, CTL_ZERO_BYTES = 1 * MiB;
constexpr size_t WS_W_INAB = 1 * MiB;
constexpr size_t WS_W_ABS = 6 * MiB;
constexpr size_t WS_W_OUTAB = 7 * MiB;
constexpr size_t WS_W_INCD = 10 * MiB;
constexpr size_t WS_W_OUTCD = 15 * MiB;
constexpr size_t WS_W_PG = 17 * MiB;
constexpr size_t WS_W_PP = 21 * MiB;
constexpr size_t WS_W_GU = 22 * MiB;
constexpr size_t WS_W_DN = 278 * MiB;
constexpr size_t WS_XB = 406 * MiB;
constexpr size_t WS_PB = 438 * MiB;
constexpr size_t WS_PP = 454 * MiB;
constexpr size_t WS_SM = 518 * MiB;
constexpr size_t WS_QKVZ = 550 * MiB;
constexpr size_t WS_CQ = 630 * MiB;
constexpr size_t WS_CKV = 638 * MiB;
constexpr size_t WS_KIDX = 642 * MiB;
constexpr size_t WS_WIDX = 644 * MiB;
constexpr size_t WS_BETA = 645 * MiB;
constexpr size_t WS_GG = WS_BETA + 512 * 1024;
constexpr size_t WS_QN = 646 * MiB, WS_KN = 662 * MiB, WS_VN = 678 * MiB;
constexpr size_t WS_QL = 694 * MiB;
constexpr size_t WS_CHK = 742 * MiB;
constexpr size_t WS_SEL = 838 * MiB;
constexpr size_t WS_NSEL = 854 * MiB;
constexpr size_t WS_ODELTA = 855 * MiB;
constexpr size_t WS_AO = 887 * MiB;
constexpr size_t WS_PRE = 935 * MiB;
constexpr size_t WS_H1 = 999 * MiB;
constexpr size_t WS_H2 = 1063 * MiB;
constexpr size_t WS_H1B = 1127 * MiB;
constexpr size_t WS_PLE = 1159 * MiB;
constexpr size_t WS_ROUTE = 1191 * MiB;
constexpr size_t WS_BIG = 1193 * MiB;
constexpr size_t WS_XS = WS_BIG, WS_HID = WS_BIG + 144 * MiB, WS_YS = WS_BIG + 288 * MiB;
constexpr size_t WS_END = WS_BIG + 512 * MiB;
static_assert((size_t)PMAX * 1024 * 2 <= 144 * MiB && WS_END <= 2048 * MiB, "d_ws map");
constexpr size_t CHK_WP = 0, CHK_QD = 16384, CHK_KDT = 32768, CHK_QK = 49152, CHK_UT = 57344, CHK_GL = 90112, CHK_STRIDE = 92160;
static_assert(CHK_STRIDE * 1024 <= 96 * MiB, "chunk operands");
constexpr int CW_TMO = 0, CW_CODE = 1;
constexpr int CW_BAR = 4096;
constexpr int CW_BAR2 = 8192;
constexpr int CW_CNT = 16384;

constexpr int RING_OFF = 0, RING_BYTES = 131072;
constexpr int WSCR_OFF = 132096, WSCR_BYTES = 1024;
constexpr int MISC_OFF = 140288;
constexpr int LDS_BYTES = 147456;

#define GAS __attribute__((address_space(1)))
#define LAS __attribute__((address_space(3)))
typedef unsigned short bf16;
typedef unsigned v4u __attribute__((ext_vector_type(4)));
typedef unsigned v2u __attribute__((ext_vector_type(2)));
typedef float f32x4 __attribute__((ext_vector_type(4)));
typedef short bf16x8 __attribute__((ext_vector_type(8)));
typedef GAS unsigned gu32;
#define RLX_AGENT __ATOMIC_RELAXED, __HIP_MEMORY_SCOPE_AGENT
typedef float f32x2_t __attribute__((ext_vector_type(2)));
typedef __bf16 bf16x2_t __attribute__((ext_vector_type(2)));
__device__ __forceinline__ unsigned pk2(float lo, float hi) { const f32x2_t v = {lo, hi}; const bf16x2_t b = __builtin_convertvector(v, bf16x2_t); return __builtin_bit_cast(unsigned, b); }
__device__ __forceinline__ unsigned f2bf(float f) { return pk2(f, 0.f) & 0xffffu; }
__device__ __forceinline__ float bflo(unsigned w) { return __uint_as_float(w << 16); }
__device__ __forceinline__ float bfhi(unsigned w) { return __uint_as_float(w & 0xffff0000u); }
__device__ __forceinline__ float bf1(bf16 h) { return __uint_as_float(((unsigned)h) << 16); }
__device__ __forceinline__ float sigm(float x) { return __builtin_amdgcn_rcpf(1.0f + __builtin_amdgcn_exp2f(x * -1.4426950408889634f)); }
__device__ __forceinline__ float siluf(float x) { return x * __builtin_amdgcn_rcpf(1.0f + __builtin_amdgcn_exp2f(x * -1.4426950408889634f)); }
__device__ __forceinline__ float wave_sum(float v) {
#pragma unroll
    for (int o = 1; o < 64; o <<= 1) v += __shfl_xor(v, o);
    return v;
}
__device__ __forceinline__ float wave_max(float v) {
#pragma unroll
    for (int o = 1; o < 64; o <<= 1) v = fmaxf(v, __shfl_xor(v, o));
    return v;
}
__device__ __forceinline__ int wave_sum_i(int v) {
#pragma unroll
    for (int o = 1; o < 64; o <<= 1) v += __shfl_xor(v, o);
    return v;
}
__device__ __forceinline__ void unpack8(const v4u w, float (&f)[8]) { f[0] = bflo(w.x); f[1] = bfhi(w.x); f[2] = bflo(w.y); f[3] = bfhi(w.y); f[4] = bflo(w.z); f[5] = bfhi(w.z); f[6] = bflo(w.w); f[7] = bfhi(w.w); }
__device__ __forceinline__ v4u pack8f(const float (&f)[8]) { v4u w; w.x = pk2(f[0], f[1]); w.y = pk2(f[2], f[3]); w.z = pk2(f[4], f[5]); w.w = pk2(f[6], f[7]); return w; }

#define XB_TMO      128
#define XB_XCNT(j)  (256  + 64 * (j))
#define XB_XSUB(j)  (1280 + 64 * (j))
#define XB_XGEN(j)  (2304 + 64 * (j))
#define XB_TOP      3328
#define XB_TOPGEN   3392
#define XCD_BAR_WORDS 3456
#define XB_SPIN_CAP (1u << 18)

__device__ __forceinline__ unsigned xb_ld(unsigned* p)              { return __hip_atomic_load(p, __ATOMIC_RELAXED, __HIP_MEMORY_SCOPE_AGENT); }
__device__ __forceinline__ unsigned xb_add(unsigned* p, unsigned v) { return __hip_atomic_fetch_add(p, v, __ATOMIC_RELAXED, __HIP_MEMORY_SCOPE_AGENT); }
__device__ __forceinline__ unsigned xb_xcc_id() { return (unsigned)__builtin_amdgcn_s_getreg((3 << 11) | 20) & 0xFu; }
#define XB_SPIN(cond, bar) do { unsigned _sp = 0; while (cond) { __builtin_amdgcn_s_sleep(1); \
    if ((++_sp & 255u) == 0u) { if (xb_ld(&(bar)[XB_TMO])) break; if (_sp > XB_SPIN_CAP) { atomicAdd(&(bar)[XB_TMO], 1u); break; } } } } while (0)

struct XcdBarrier {
    unsigned* bar; unsigned x;
    unsigned expect;
    volatile LAS unsigned* st;
};

__device__ __forceinline__ XcdBarrier xcd_barrier_post(unsigned* bar, volatile LAS unsigned* st, unsigned expect = 0u) {
    XcdBarrier b; b.bar = bar; b.x = xb_xcc_id(); b.st = st; b.expect = expect ? expect : gridDim.x * gridDim.y * gridDim.z;
    if (threadIdx.x == 0) (void)xb_add(&bar[XB_XCNT(b.x)], 1u);
    return b;
}
__device__ __forceinline__ void xcd_barrier_complete(unsigned* bar, unsigned x, unsigned& nloc, unsigned& nx, const unsigned G) {
    unsigned sum, cnt, mine, sp = 0u;
    for (;;) {
        sum = 0u; cnt = 0u; mine = 0u;
#pragma unroll
        for (unsigned j = 0; j < 16; ++j) { const unsigned c = xb_ld(&bar[XB_XCNT(j)]); sum += c; cnt += (c > 0u) ? 1u : 0u; mine = (j == x) ? c : mine; }
        if (sum == G) break;
        __builtin_amdgcn_s_sleep(1);
        if ((++sp & 255u) == 0u) { if (xb_ld(&bar[XB_TMO])) break; if (sp > XB_SPIN_CAP) { atomicAdd(&bar[XB_TMO], 1u); break; } }
    }
    nloc = mine > 0u ? mine : 1u; nx = cnt > 0u ? cnt : 1u;
}

__device__ __forceinline__ void xcd_barrier(const XcdBarrier& b) {
    asm volatile("s_waitcnt vmcnt(0)" ::: "memory");
    __syncthreads();
    if (threadIdx.x == 0) {
        unsigned* bar = b.bar;
        __builtin_amdgcn_s_waitcnt(0);
        unsigned nloc = b.st[0], nx = b.st[1];
        if (nloc == 0u) { xcd_barrier_complete(bar, b.x, nloc, nx, b.expect); b.st[0] = nloc; b.st[1] = nx; }
        const unsigned old = xb_add(&bar[XB_XSUB(b.x)], 1u);
        const unsigned gen = old / nloc;
        if (old + 1u == (gen + 1u) * nloc) {
            __builtin_amdgcn_fence(__ATOMIC_RELEASE, "agent");
            asm volatile("s_waitcnt vmcnt(0)" ::: "memory");
            const unsigned og = xb_add(&bar[XB_TOP], 1u);
            const unsigned tg = og / nx;
            if (og + 1u == (tg + 1u) * nx) xb_add(&bar[XB_TOPGEN], 1u);
            else XB_SPIN(xb_ld(&bar[XB_TOPGEN]) == tg, bar);
            __builtin_amdgcn_fence(__ATOMIC_ACQUIRE, "agent");
            xb_add(&bar[XB_XGEN(b.x)], 1u);
            asm volatile("s_waitcnt vmcnt(0)" ::: "memory");
        } else {
            XB_SPIN(xb_ld(&bar[XB_XGEN(b.x)]) == gen, bar);
            __builtin_amdgcn_fence(__ATOMIC_ACQUIRE, "agent");
            asm volatile("s_waitcnt vmcnt(0)" ::: "memory");
        }
    }
    __syncthreads();
}

struct Args { const float* in[N_IN]; float* out; unsigned char* ws; int ph_lo, ph_hi, li, pad; };
typedef const __attribute__((address_space(4))) Args* KArgs;
__device__ __forceinline__ KArgs kargs() { auto p = __builtin_amdgcn_kernarg_segment_ptr(); asm volatile("" : "+s"(p)); return (KArgs)p; }
struct Frame {
    LAS unsigned char* lds;
    int tid, lane, wave, G, bid;
    unsigned char* ws;
    gu32* ctl;
};
#define WSP(T, off) ((T*)(F.ws + (off)))

struct MapId { __device__ __forceinline__ int operator()(int n) const { return n; } };
struct MapAdd { int off; __device__ __forceinline__ int operator()(int n) const { return n + off; } };
struct MapAB { __device__ __forceinline__ int operator()(int n) const { return n < 456 ? n : (n < 2504 ? n + 56 : n - 2048); } };
template <class Map> __device__ __forceinline__ void wg_transpose_item(const float* W, int N, int ldw, bf16* WT, int ldt, int koff, Map map, LAS float* scr, int item, int tid) {
    const int nblk = (N + 127) >> 7, kb = item / nblk, nb = item - kb * nblk, k0 = kb * 128, n0 = nb * 128;
#pragma unroll
    for (int it = 0; it < 8; ++it) {
        const int row = it * 16 + (tid >> 5), c4 = (tid & 31) * 4, n = n0 + c4;
        f32x4 v = (f32x4){0.f, 0.f, 0.f, 0.f};
        if (n + 3 < N) v = *(const f32x4*)(W + (size_t)(k0 + row) * ldw + n);
        LAS float* s = scr + row * 129 + c4; s[0] = v[0]; s[1] = v[1]; s[2] = v[2]; s[3] = v[3];
    }
    __syncthreads();
#pragma unroll
    for (int j = 0; j < 4; ++j) {
        const int idx = j * 512 + tid, nl = idx >> 4, ch = idx & 15, n = n0 + nl;
        if (n < N) { const LAS float* s = scr + (ch * 8) * 129 + nl;
            v4u o; o.x = pk2(s[0], s[129]); o.y = pk2(s[2 * 129], s[3 * 129]); o.z = pk2(s[4 * 129], s[5 * 129]); o.w = pk2(s[6 * 129], s[7 * 129]);
            *(v4u*)(WT + (size_t)map(n) * ldt + koff + k0 + ch * 8) = o; }
    }
    __syncthreads();
}
__device__ __forceinline__ void wg_transpose_item_fp8(const float* W, int N, int ldw, unsigned char* WT, int ldt, float mul, LAS float* scr, int item, int tid) {
    const int nblk = (N + 127) >> 7, kb = item / nblk, nb = item - kb * nblk, k0 = kb * 128, n0 = nb * 128;
#pragma unroll
    for (int it = 0; it < 8; ++it) {
        const int row = it * 16 + (tid >> 5), c4 = (tid & 31) * 4;
        const f32x4 v = *(const f32x4*)(W + (size_t)(k0 + row) * ldw + n0 + c4);
        LAS float* s = scr + row * 129 + c4; s[0] = v[0]; s[1] = v[1]; s[2] = v[2]; s[3] = v[3];
    }
    __syncthreads();
#pragma unroll
    for (int j = 0; j < 2; ++j) {
        const int idx = j * 512 + tid, nl = idx >> 3, ch = idx & 7;
        const LAS float* s = scr + (ch * 16) * 129 + nl;
        v4u o;
#pragma unroll
        for (int q = 0; q < 4; ++q) { unsigned w = 0u;
            w = __builtin_amdgcn_cvt_pk_fp8_f32(s[(4 * q) * 129] * mul, s[(4 * q + 1) * 129] * mul, w, false);
            w = __builtin_amdgcn_cvt_pk_fp8_f32(s[(4 * q + 2) * 129] * mul, s[(4 * q + 3) * 129] * mul, w, true);
            o[q] = w; }
        *(v4u*)(WT + (size_t)(n0 + nl) * ldt + k0 + ch * 16) = o;
    }
    __syncthreads();
}
struct MoeItem { const float* W; unsigned char* WT; int N; float mul; int k0, n0; };
__device__ __forceinline__ MoeItem moe_item(KArgs A, unsigned char* ws, int it) {
    MoeItem d; int sub;
    if (it < 64 * 128) { const int m = it >> 7; sub = it & 127; d.W = A->in[I_WGU] + (size_t)m * 1024 * 2048; d.N = 2048; d.WT = ws + WS_W_GU + (size_t)m * 2048 * 1024; d.mul = 64.0f; }
    else { it -= 64 * 128; const int m = it >> 6; sub = it & 63; d.W = A->in[I_WDN] + (size_t)m * 1024 * 1024; d.N = 1024; d.WT = ws + WS_W_DN + (size_t)m * 1024 * 1024; d.mul = 128.0f; }
    const int nblk = d.N >> 7, kb = sub / nblk, nb = sub - kb * nblk; d.k0 = kb * 128; d.n0 = nb * 128; return d;
}
__device__ __forceinline__ void p0_moe_fp8(Frame& F, KArgs A) {
    LAS float* scr = (LAS float*)(F.lds + RING_OFF);
    const int tid = F.tid; constexpr int NIT = 64 * 128 + 64 * 64;
    int it = F.bid; if (it >= NIT) return;
    MoeItem cur = moe_item(A, F.ws, it);
    f32x4 r[8];
#pragma unroll
    for (int x = 0; x < 8; ++x) r[x] = __builtin_nontemporal_load((const f32x4*)(cur.W + (size_t)(cur.k0 + x * 16 + (tid >> 5)) * cur.N + cur.n0 + (tid & 31) * 4));
    for (;;) {
#pragma unroll
        for (int x = 0; x < 8; ++x) { LAS float* sp = scr + (x * 16 + (tid >> 5)) * 129 + (tid & 31) * 4; sp[0] = r[x][0]; sp[1] = r[x][1]; sp[2] = r[x][2]; sp[3] = r[x][3]; }
        __syncthreads();
        const int nx = it + F.G; MoeItem nxt = cur;
        if (nx < NIT) { nxt = moe_item(A, F.ws, nx);
#pragma unroll
            for (int x = 0; x < 8; ++x) r[x] = __builtin_nontemporal_load((const f32x4*)(nxt.W + (size_t)(nxt.k0 + x * 16 + (tid >> 5)) * nxt.N + nxt.n0 + (tid & 31) * 4)); }
#pragma unroll
        for (int j = 0; j < 2; ++j) {
            const int idx = j * 512 + tid, nl = idx >> 3, ch = idx & 7;
            const LAS float* sp = scr + (ch * 16) * 129 + nl;
            v4u o;
#pragma unroll
            for (int q = 0; q < 4; ++q) { unsigned w = 0u;
                w = __builtin_amdgcn_cvt_pk_fp8_f32(sp[(4 * q) * 129] * cur.mul, sp[(4 * q + 1) * 129] * cur.mul, w, false);
                w = __builtin_amdgcn_cvt_pk_fp8_f32(sp[(4 * q + 2) * 129] * cur.mul, sp[(4 * q + 3) * 129] * cur.mul, w, true);
                o[q] = w; }
            *(v4u*)(cur.WT + (size_t)(cur.n0 + nl) * 1024 + cur.k0 + ch * 16) = o;
        }
        __syncthreads();
        if (nx >= NIT) break;
        cur = nxt; it = nx;
    }
}
__device__ __forceinline__ void p0_prologue(Frame& F, KArgs A) {
    LAS float* scr = (LAS float*)(F.lds + RING_OFF);
    const int tid = F.tid;
    constexpr int IT_GU = 128, IT_DN = 64;
    constexpr int N_GU = 64 * IT_GU, N_DN = 64 * IT_DN;
    constexpr int N_INAB = 8 * 20, N_INCD = 8 * 20, N_OUTCD = 64, N_PG = 2 * 64, N_PP = 2 * 2 * 8, N_QIDX = 2 * 4, N_OUTB = 4 * 8;
    constexpr int NITEMS = N_GU + N_DN + N_INAB + N_INCD + N_OUTCD + N_PG + N_PP + N_QIDX + N_OUTB;
    if (kMoeFp8) p0_moe_fp8(F, A);
    for (int it = F.bid + (kMoeFp8 ? N_GU + N_DN : 0); it < NITEMS; it += F.G) {
        int r = it;
        if (r < N_GU) { const int m = r / IT_GU;
            if (kMoeFp8) wg_transpose_item_fp8(A->in[I_WGU] + (size_t)m * 1024 * 2048, 2048, 2048, WSP(unsigned char, WS_W_GU) + (size_t)m * 2048 * 1024, 1024, 64.0f, scr, r % IT_GU, tid);
            else wg_transpose_item(A->in[I_WGU] + (size_t)m * 1024 * 2048, 2048, 2048, WSP(bf16, WS_W_GU) + (size_t)m * 2048 * 1024, 1024, 0, MapId{}, scr, r % IT_GU, tid);
            continue; } r -= N_GU;
        if (r < N_DN) { const int m = r / IT_DN;
            if (kMoeFp8) wg_transpose_item_fp8(A->in[I_WDN] + (size_t)m * 1024 * 1024, 1024, 1024, WSP(unsigned char, WS_W_DN) + (size_t)m * 1024 * 1024, 1024, 128.0f, scr, r % IT_DN, tid);
            else wg_transpose_item(A->in[I_WDN] + (size_t)m * 1024 * 1024, 1024, 1024, WSP(bf16, WS_W_DN) + (size_t)m * 1024 * 1024, 1024, 0, MapId{}, scr, r % IT_DN, tid);
            continue; } r -= N_DN;
        if (r < N_INAB) { wg_transpose_item(A->in[I_AB_WIN], 2512, 2512, WSP(bf16, WS_W_INAB), 1024, 0, MapAB{}, scr, r, tid); continue; } r -= N_INAB;
        if (r < N_INCD) { wg_transpose_item(A->in[I_CD_WIN], 2560, 2560, WSP(bf16, WS_W_INCD), 1024, 0, MapId{}, scr, r, tid); continue; } r -= N_INCD;
        if (r < N_OUTCD) { wg_transpose_item(A->in[I_CD_WOUT], 1024, 1024, WSP(bf16, WS_W_OUTCD), 1024, 0, MapId{}, scr, r, tid); continue; } r -= N_OUTCD;
        if (r < N_PG) { const int l = r / 64; wg_transpose_item(A->in[I_PLE_WG] + (size_t)l * 1024 * 1024, 1024, 1024, WSP(bf16, WS_W_PG) + (size_t)l * 1024 * 1024, 1024, 0, MapId{}, scr, r % 64, tid); continue; } r -= N_PG;
        if (r < N_PP) { const int l = r / 16; wg_transpose_item(A->in[I_PLE_WP] + (size_t)l * 256 * 1024, 1024, 1024, WSP(bf16, WS_W_PP) + (size_t)l * 1024 * 256, 256, 0, MapId{}, scr, r % 16, tid); continue; } r -= N_PP;
        if (r < N_QIDX) { wg_transpose_item(A->in[I_AB_WQIDX], 512, 512, WSP(bf16, WS_W_ABS), 256, 0, MapAdd{1024}, scr, r, tid); continue; } r -= N_QIDX;
        wg_transpose_item(A->in[I_AB_WOUT] + (size_t)512 * 1024, 1024, 1024, WSP(bf16, WS_W_OUTAB), 1536, 1024, MapId{}, scr, r, tid);
    }
    const size_t gt = (size_t)F.bid * NTHREADS + tid, GT = (size_t)F.G * NTHREADS;
    for (size_t i = gt; i < (size_t)48 * 1024 / 8; i += GT) *(v4u*)(WSP(bf16, WS_W_INAB) + (size_t)464 * 1024 + i * 8) = (v4u){0u, 0u, 0u, 0u};
    for (size_t i = gt; i < (size_t)1024 * 256; i += GT) {
        const int n = (int)(i >> 8), c = (int)(i & 255), h = n >> 7, r = n & 127;
        const float* a = A->in[I_AB_WUQ] + (size_t)c * 512 + h * 64; const float* b = A->in[I_AB_WUK] + (size_t)r * 512 + h * 64;
        float s = 0.f;
#pragma unroll 8
        for (int d = 0; d < 64; d += 4) { const f32x4 x = *(const f32x4*)(a + d), y = *(const f32x4*)(b + d); s += x[0] * y[0] + x[1] * y[1] + x[2] * y[2] + x[3] * y[3]; }
        WSP(bf16, WS_W_ABS)[i] = (bf16)f2bf(s * 0.125f);
    }
    for (size_t i = gt; i < (size_t)1024 * 128; i += GT) {
        const int n = (int)(i & 1023), k0 = (int)(i >> 10) * 8, h = k0 >> 7, r0 = k0 & 127;
        const float* bcol = A->in[I_AB_WOUT] + (size_t)(h * 64) * 1024 + n;
        float acc[8];
#pragma unroll
        for (int x = 0; x < 8; ++x) acc[x] = 0.f;
#pragma unroll 2
        for (int v0 = 0; v0 < 64; v0 += 8) {
            float bv[8];
#pragma unroll
            for (int v = 0; v < 8; ++v) bv[v] = bcol[(size_t)(v0 + v) * 1024];
#pragma unroll
            for (int x = 0; x < 8; ++x) { const float* ar = A->in[I_AB_WUV] + (size_t)(r0 + x) * 512 + h * 64 + v0; const f32x4 a0 = *(const f32x4*)ar, a1 = *(const f32x4*)(ar + 4);
                acc[x] += a0[0] * bv[0] + a0[1] * bv[1] + a0[2] * bv[2] + a0[3] * bv[3] + a1[0] * bv[4] + a1[1] * bv[5] + a1[2] * bv[6] + a1[3] * bv[7]; }
        }
        *(v4u*)(WSP(bf16, WS_W_OUTAB) + (size_t)n * 1536 + k0) = pack8f(acc);
    }
#pragma unroll 4
    for (size_t i = gt; i < (size_t)M * D / 8; i += GT) { const f32x4 a = __builtin_nontemporal_load((const f32x4*)(A->in[I_X] + i * 8)), b = __builtin_nontemporal_load((const f32x4*)(A->in[I_X] + i * 8 + 4));
        v4u o; o.x = pk2(a[0], a[1]); o.y = pk2(a[2], a[3]); o.z = pk2(b[0], b[1]); o.w = pk2(b[2], b[3]); *(v4u*)(WSP(bf16, WS_XB) + i * 8) = o; }
#pragma unroll 4
    for (size_t i = gt; i < (size_t)2 * M * 256 / 8; i += GT) { const f32x4 a = __builtin_nontemporal_load((const f32x4*)(A->in[I_P] + i * 8)), b = __builtin_nontemporal_load((const f32x4*)(A->in[I_P] + i * 8 + 4));
        v4u o; o.x = pk2(a[0], a[1]); o.y = pk2(a[2], a[3]); o.z = pk2(b[0], b[1]); o.w = pk2(b[2], b[3]); *(v4u*)(WSP(bf16, WS_PB) + i * 8) = o; }
}

__device__ __forceinline__ void p2_prep(Frame& F, KArgs A) {
    const int lane = F.lane, gw = F.bid * NWAVES + F.wave, NGW = F.G * NWAVES;
    const float* SM = WSP(float, WS_SM); const bf16* QZ = WSP(bf16, WS_QKVZ);
    const f32x4 qg = *(const f32x4*)(A->in[I_AB_QG] + 4 * lane);
    const f32x4 kvg = *(const f32x4*)(A->in[I_AB_KVG] + 4 * (lane & 31));
    const f32x4 kig = *(const f32x4*)(A->in[I_AB_KIG] + 4 * (lane & 15)), kib = *(const f32x4*)(A->in[I_AB_KIB] + 4 * (lane & 15));
    const f32x4 alog = *(const f32x4*)(A->in[I_AB_ALOG]), dtb = *(const f32x4*)(A->in[I_AB_DTB]);
    LAS float* cw = (LAS float*)(F.lds);
    {   f32x4 wv[3]; int t0 = F.tid; asm volatile("" : "+v"(t0));
#pragma unroll
        for (int j = 0; j < 3; ++j) wv[j] = *(const f32x4*)(A->in[I_AB_CONVW] + (size_t)(t0 + NTHREADS * j) * 4);
#pragma unroll
        for (int j = 0; j < 3; ++j) *(LAS f32x4*)(cw + (t0 + NTHREADS * j) * 4) = wv[j];
    }
    __syncthreads();
    for (int row = gw; row < M; row += NGW) {
        const int t = row & (SEQ - 1);
        const f32x4 a = *(const f32x4*)(SM + (size_t)row * 512 + 4 * lane), b = *(const f32x4*)(SM + (size_t)row * 512 + 256 + 4 * lane);
        {
            const float ss = wave_sum(a[0] * a[0] + a[1] * a[1] + a[2] * a[2] + a[3] * a[3]);
            const float r = rsqrtf(ss * (1.0f / 256.0f) + 1e-6f);
            v2u o; o.x = pk2(a[0] * r * qg[0], a[1] * r * qg[1]); o.y = pk2(a[2] * r * qg[2], a[3] * r * qg[3]);
            *(v2u*)(WSP(bf16, WS_CQ) + (size_t)row * 256 + 4 * lane) = o;
        }
        {
            const float ss = wave_sum(lane < 32 ? (b[0] * b[0] + b[1] * b[1] + b[2] * b[2] + b[3] * b[3]) : 0.f);
            const float r = rsqrtf(ss * (1.0f / 128.0f) + 1e-6f);
            if (lane < 32) { v2u o; o.x = pk2(b[0] * r * kvg[0], b[1] * r * kvg[1]); o.y = pk2(b[2] * r * kvg[2], b[3] * r * kvg[3]);
                *(v2u*)(WSP(bf16, WS_CKV) + (size_t)row * 128 + 4 * lane) = o; }
        }
        {
            const bool in = (lane >= 32 && lane < 48);
            const float mean = wave_sum(in ? (b[0] + b[1] + b[2] + b[3]) : 0.f) * (1.0f / 64.0f);
            const f32x4 d = b - mean;
            const float var = wave_sum(in ? (d[0] * d[0] + d[1] * d[1] + d[2] * d[2] + d[3] * d[3]) : 0.f) * (1.0f / 64.0f);
            const float r = rsqrtf(var + 1e-5f);
            if (in) { v2u o; o.x = pk2(d[0] * r * kig[0] + kib[0], d[1] * r * kig[1] + kib[1]); o.y = pk2(d[2] * r * kig[2] + kib[2], d[3] * r * kig[3] + kib[3]);
                *(v2u*)(WSP(bf16, WS_KIDX) + (size_t)row * 64 + 4 * (lane - 32)) = o; }
        }
        if (lane == 48 || lane == 49) *(f32x4*)(WSP(float, WS_WIDX) + (size_t)row * 8 + 4 * (lane - 48)) = b * 0.044194173824159216f;
        if (lane == 50) { f32x4 o; o[0] = sigm(b[0]); o[1] = sigm(b[1]); o[2] = sigm(b[2]); o[3] = sigm(b[3]); *(f32x4*)(WSP(float, WS_BETA) + (size_t)row * 4) = o; }
        if (lane == 51) { f32x4 o;
#pragma unroll
            for (int h = 0; h < 4; ++h) { const float xx = b[h] + dtb[h]; const float sp = xx > 20.f ? xx : log1pf(__expf(xx)); o[h] = -__expf(alog[h]) * sp; }
            *(f32x4*)(WSP(float, WS_GG) + (size_t)row * 4) = o; }
        v4u xr[3][4];
#pragma unroll
        for (int sel = 0; sel < 3; ++sel)
#pragma unroll
            for (int j = 0; j < 4; ++j) { const int back = (t - 3 + j >= 0) ? (3 - j) : 0; xr[sel][j] = *(const v4u*)(QZ + (size_t)(row - back) * 2048 + sel * 512 + 8 * lane); }
#pragma unroll
        for (int sel = 0; sel < 3; ++sel) {
            const int col0 = sel * 512 + 8 * lane;
            float acc[8];
#pragma unroll
            for (int i = 0; i < 8; ++i) acc[i] = 0.f;
#pragma unroll
            for (int j = 0; j < 4; ++j) {
                float xv[8]; unpack8(xr[sel][j], xv);
                const f32x4 w0 = *(const LAS f32x4*)(cw + j * 1536 + col0), w1 = *(const LAS f32x4*)(cw + j * 1536 + col0 + 4);
                const float m = (t - 3 + j >= 0) ? 1.f : 0.f;
#pragma unroll
                for (int i = 0; i < 4; ++i) { acc[i] += w0[i] * m * xv[i]; acc[4 + i] += w1[i] * m * xv[4 + i]; }
            }
            float ss = 0.f;
#pragma unroll
            for (int i = 0; i < 8; ++i) { acc[i] = siluf(acc[i]); ss += acc[i] * acc[i]; }
            if (sel < 2) {
                ss += __shfl_xor(ss, 1); ss += __shfl_xor(ss, 2); ss += __shfl_xor(ss, 4); ss += __shfl_xor(ss, 8);
                const float sc = rsqrtf(ss + 1e-6f) * (sel == 0 ? 0.08838834764831845f : 1.0f);
#pragma unroll
                for (int i = 0; i < 8; ++i) acc[i] *= sc;
            }
            bf16* dst = (sel == 0 ? WSP(bf16, WS_QN) : (sel == 1 ? WSP(bf16, WS_KN) : WSP(bf16, WS_VN))) + (size_t)row * 512 + 8 * lane;
            *(v4u*)dst = pack8f(acc);
        }
    }
}

constexpr int SEQ_WGS = 16;
constexpr int SQ_WP = 0, SQ_QD = 16384, SQ_KDT = 32768, SQ_QK = 49152, SQ_BUF = 57344;
__device__ __forceinline__ bf16x8 packfrag(const f32x4 lo, const f32x4 hi) { v4u w; w.x = pg8::cvt_pk_bf16(lo[0], lo[1]); w.y = pg8::cvt_pk_bf16(lo[2], lo[3]); w.z = pg8::cvt_pk_bf16(hi[0], hi[1]); w.w = pg8::cvt_pk_bf16(hi[2], hi[3]); return __builtin_bit_cast(bf16x8, w); }
__device__ __forceinline__ void seq_load(v4u (&r)[14], const unsigned char* blk, int lt) {
#pragma unroll
    for (int i = 0; i < 14; ++i) r[i] = *(const v4u*)(blk + (size_t)(lt + 256 * i) * 16);
}
__device__ __forceinline__ void seq_write(LAS unsigned char* buf, const v4u (&r)[14], int lt) {
#pragma unroll
    for (int i = 0; i < 14; ++i) {
        const int id = lt + 256 * i; int dst;
        if (id < 2048) { const int rr = (id & 1023) >> 4, ch = id & 15; dst = (id & ~1023) * 16 + rr * 256 + 16 * (ch ^ (rr & 15)); }
        else { const int rr = (id - 2048) >> 3, ch = id & 7; dst = 32768 + rr * 128 + 16 * (ch ^ (rr & 7)); }
        *(LAS v4u*)(buf + dst) = r[i];
    }
}
__device__ __forceinline__ void seq_compute(LAS unsigned char* buf, f32x4 (&Sacc)[8], const f32x4 (&U)[4], const float gl, float* op0, const int fr, const int fq) {
    bf16x8 sf[4];
#pragma unroll
    for (int s = 0; s < 4; ++s) sf[s] = packfrag(Sacc[2 * s], Sacc[2 * s + 1]);
    f32x4 Vn[4], Oa[4];
#pragma unroll
    for (int tc = 0; tc < 4; ++tc) {
        const int rr = 16 * tc + fr; f32x4 av = (f32x4){0.f, 0.f, 0.f, 0.f}, ao = (f32x4){0.f, 0.f, 0.f, 0.f};
#pragma unroll
        for (int s = 0; s < 4; ++s) {
            const int off = rr * 256 + 16 * ((4 * s + fq) ^ (rr & 15));
            const bf16x8 wf = *(const LAS bf16x8*)(buf + SQ_WP + off), qf = *(const LAS bf16x8*)(buf + SQ_QD + off);
            av = __builtin_amdgcn_mfma_f32_16x16x32_bf16(wf, sf[s], av, 0, 0, 0);
            ao = __builtin_amdgcn_mfma_f32_16x16x32_bf16(qf, sf[s], ao, 0, 0, 0);
        }
        Vn[tc] = U[tc] - av; Oa[tc] = ao;
    }
    bf16x8 vf[2];
    vf[0] = packfrag(Vn[0], Vn[1]); vf[1] = packfrag(Vn[2], Vn[3]);
#pragma unroll
    for (int tc = 0; tc < 4; ++tc) {
        const int rr = 16 * tc + fr;
#pragma unroll
        for (int s = 0; s < 2; ++s) {
            const bf16x8 kf = *(const LAS bf16x8*)(buf + SQ_QK + rr * 128 + 16 * ((4 * s + fq) ^ (rr & 7)));
            Oa[tc] = __builtin_amdgcn_mfma_f32_16x16x32_bf16(kf, vf[s], Oa[tc], 0, 0, 0);
        }
        float* op = op0 + (size_t)(16 * tc) * 512;
#pragma unroll
        for (int j = 0; j < 4; ++j) op[(size_t)j * 512] = Oa[tc][j];
    }
#pragma unroll
    for (int T = 0; T < 8; ++T) {
        const int rr = 16 * T + fr; f32x4 a = Sacc[T] * gl;
#pragma unroll
        for (int s = 0; s < 2; ++s) {
            const bf16x8 kf = *(const LAS bf16x8*)(buf + SQ_KDT + rr * 128 + 16 * ((4 * s + fq) ^ (rr & 7)));
            a = __builtin_amdgcn_mfma_f32_16x16x32_bf16(kf, vf[s], a, 0, 0, 0);
        }
        Sacc[T] = a;
    }
}
#define SEQ_BAR() do { asm volatile("s_waitcnt lgkmcnt(0)" ::: "memory"); __builtin_amdgcn_s_barrier(); asm volatile("" ::: "memory"); } while (0)
__device__ __forceinline__ void p4_delta_seq(Frame& F, int sid) {
    const int lane = F.lane, wave = F.wave, tid = F.tid;
    const int bh = sid >> 1, half = sid & 1, b = bh >> 2, h = bh & 3;
    const int fr = lane & 15, fq = lane >> 4;
    const int v0 = half * 64 + (wave & 3) * 16;
    const unsigned char* cbase = F.ws + WS_CHK + (size_t)(bh * 128) * CHK_STRIDE;
    if (wave >= 4) {
        const int lt = tid - 256;
        v4u RA[14], RB[14];
#define SEQ_LD(R, blk) do { const unsigned char* _b = (blk); _Pragma("unroll") for (int _i = 0; _i < 14; ++_i) asm volatile("global_load_dwordx4 %0, %1, off" : "=v"(R[_i]) : "v"(_b + (size_t)(lt + 256 * _i) * 16) : "memory"); } while (0)
#define SEQ_WAIT(younger) do { if (younger) asm volatile("s_waitcnt vmcnt(14)" ::: "memory"); else asm volatile("s_waitcnt vmcnt(0)" ::: "memory"); } while (0)
        SEQ_LD(RA, cbase); SEQ_LD(RB, cbase + CHK_STRIDE); SEQ_WAIT(true); seq_write(F.lds, RA, lt); SEQ_LD(RA, cbase + 2 * CHK_STRIDE);
        SEQ_BAR();
#pragma unroll 1
        for (int n = 0; n < 128; n += 2) {
            if (n + 1 < 128) { SEQ_WAIT(n + 2 < 128); seq_write(F.lds + ((n + 1) & 1) * SQ_BUF, RB, lt); } if (n + 3 < 128) SEQ_LD(RB, cbase + (size_t)(n + 3) * CHK_STRIDE);
            SEQ_BAR();
            if (n + 2 < 128) { SEQ_WAIT(n + 3 < 128); seq_write(F.lds + (n & 1) * SQ_BUF, RA, lt); } if (n + 4 < 128) SEQ_LD(RA, cbase + (size_t)(n + 4) * CHK_STRIDE);
            SEQ_BAR();
        }
        asm volatile("s_waitcnt vmcnt(0)" ::: "memory");
#undef SEQ_LD
#undef SEQ_WAIT
    } else {
        float* OD = WSP(float, WS_ODELTA);
        f32x4 Sacc[8], Ucur[4], Unxt[4]; float glc, gln;
#pragma unroll
        for (int T = 0; T < 8; ++T) Sacc[T] = (f32x4){0.f, 0.f, 0.f, 0.f};
#pragma unroll
        for (int tc = 0; tc < 4; ++tc) { Ucur[tc] = *(const f32x4*)((const float*)(cbase + CHK_UT) + (size_t)(v0 + fr) * 64 + 4 * fq + 16 * tc);
                                          Unxt[tc] = *(const f32x4*)((const float*)(cbase + CHK_STRIDE + CHK_UT) + (size_t)(v0 + fr) * 64 + 4 * fq + 16 * tc); }
        glc = *(const float*)(cbase + CHK_GL); gln = *(const float*)(cbase + CHK_STRIDE + CHK_GL);
        SEQ_BAR();
#pragma unroll 1
        for (int n = 0; n < 128; ++n) {
            seq_compute(F.lds + (n & 1) * SQ_BUF, Sacc, Ucur, glc, OD + (size_t)(b * SEQ + n * 64 + 4 * fq) * 512 + h * 128 + v0 + fr, fr, fq);
#pragma unroll
            for (int tc = 0; tc < 4; ++tc) Ucur[tc] = Unxt[tc];
            glc = gln;
            if (n + 2 < 128) { const unsigned char* nb = cbase + (size_t)(n + 2) * CHK_STRIDE; gln = *(const float*)(nb + CHK_GL);
#pragma unroll
                for (int tc = 0; tc < 4; ++tc) Unxt[tc] = *(const f32x4*)((const float*)(nb + CHK_UT) + (size_t)(v0 + fr) * 64 + 4 * fq + 16 * tc); }
            SEQ_BAR();
        }
    }
}
#undef SEQ_BAR

__device__ __forceinline__ float relu1(float x) { return __builtin_amdgcn_fmed3f(x, 0.f, INFINITY); }
__device__ __forceinline__ void p4_indexer(Frame& F, int widx, int nw) {
    const int lane = F.lane, fr = lane & 15, fq = lane >> 4;
    const bf16* QL = WSP(bf16, WS_QL); const bf16* KI = WSP(bf16, WS_KIDX); const float* WI = WSP(float, WS_WIDX); float* SC = WSP(float, WS_BIG);
    for (int task = widx; task < 2 * 4352; task += nw) {
        const int b = task / 4352; int tau = task - b * 4352;
        int g = 0; while (16 * (g + 1) * (g + 2) <= tau) ++g;
        tau -= 16 * g * (g + 1);
        const int qt = 32 * g + tau / (g + 1), seg = tau % (g + 1);
        const int row0 = b * SEQ + 16 * qt;
        bf16x8 Qf[8][2];
#pragma unroll
        for (int hh = 0; hh < 8; ++hh)
#pragma unroll
            for (int s = 0; s < 2; ++s) Qf[hh][s] = *(const bf16x8*)(QL + (size_t)(row0 + fr) * 1536 + 1024 + hh * 64 + 32 * s + 8 * fq);
        const f32x4 w0 = *(const f32x4*)(WI + (size_t)(row0 + fr) * 8), w1 = *(const f32x4*)(WI + (size_t)(row0 + fr) * 8 + 4);
        const int kt1 = (32 * seg + 31 < qt) ? 32 * seg + 31 : qt;
        for (int kb8 = 32 * seg; kb8 <= kt1; kb8 += 8) {
            bf16x8 kfr[8][2];
#pragma unroll
            for (int x = 0; x < 8; ++x) { const int kt = (kb8 + x <= kt1) ? kb8 + x : kt1; const bf16* kp = KI + (size_t)(b * SEQ + 16 * kt + fr) * 64 + 8 * fq; kfr[x][0] = *(const bf16x8*)kp; kfr[x][1] = *(const bf16x8*)(kp + 32); }
#pragma unroll
            for (int x = 0; x < 8; ++x) asm volatile("" : "+v"(kfr[x][0]), "+v"(kfr[x][1]));
#pragma unroll
            for (int x = 0; x < 8; ++x) {
                const int kt = kb8 + x;
                if (kt <= kt1) {
                    f32x4 isc = (f32x4){0.f, 0.f, 0.f, 0.f}, c[8];
#pragma unroll
                    for (int hh = 0; hh < 8; ++hh) c[hh] = __builtin_amdgcn_mfma_f32_16x16x32_bf16(kfr[x][0], Qf[hh][0], (f32x4){0.f, 0.f, 0.f, 0.f}, 0, 0, 0);
#pragma unroll
                    for (int hh = 0; hh < 8; ++hh) c[hh] = __builtin_amdgcn_mfma_f32_16x16x32_bf16(kfr[x][1], Qf[hh][1], c[hh], 0, 0, 0);
                    __builtin_amdgcn_sched_barrier(0);
#pragma unroll
                    for (int hh = 0; hh < 8; ++hh) { const float wh = (hh < 4) ? w0[hh & 3] : w1[hh & 3];
#pragma unroll
                        for (int j = 0; j < 4; ++j) isc[j] += relu1(c[hh][j]) * wh; }
                    *(f32x4*)(SC + (size_t)(row0 + fr) * 8192 + 16 * kt + 4 * fq) = isc;
                }
            }
        }
    }
}

__device__ __forceinline__ void mask_ge8(unsigned long long (&m)[8], unsigned x0, unsigned x1, unsigned x2, unsigned x3, unsigned x4, unsigned x5, unsigned x6, unsigned x7, unsigned t) {
    asm("v_cmp_ge_u32_e64 %0, %8, %16\n\tv_cmp_ge_u32_e64 %1, %9, %16\n\tv_cmp_ge_u32_e64 %2, %10, %16\n\tv_cmp_ge_u32_e64 %3, %11, %16\n\t"
        "v_cmp_ge_u32_e64 %4, %12, %16\n\tv_cmp_ge_u32_e64 %5, %13, %16\n\tv_cmp_ge_u32_e64 %6, %14, %16\n\tv_cmp_ge_u32_e64 %7, %15, %16"
        : "=&s"(m[0]), "=&s"(m[1]), "=&s"(m[2]), "=&s"(m[3]), "=&s"(m[4]), "=&s"(m[5]), "=&s"(m[6]), "=&s"(m[7])
        : "v"(x0), "v"(x1), "v"(x2), "v"(x3), "v"(x4), "v"(x5), "v"(x6), "v"(x7), "s"(t));
}
__device__ __forceinline__ unsigned tk_key(float f) { const unsigned b = __float_as_uint(f); return (b & 0x80000000u) ? ~b : (b | 0x80000000u); }
__device__ __forceinline__ void topk_row_slow(const float* sr, const int n, const int lane, LAS int* sel) {
    const int nseg = (n + 63) >> 6;
    unsigned T = 0u;
    for (int bit = 31; bit >= 0; --bit) {
        const unsigned cnd = T | (1u << bit); int c = 0;
        for (int sg = 0; sg < nseg; ++sg) { const int idx = sg * 64 + lane; const unsigned x = (idx < n) ? tk_key(sr[idx < n ? idx : 0]) : 0u; c += __popcll(__ballot(x >= cnd)); }
        if (c >= 256) T = cnd;
    }
    int cgt = 0;
    for (int sg = 0; sg < nseg; ++sg) { const int idx = sg * 64 + lane; const unsigned x = (idx < n) ? tk_key(sr[idx < n ? idx : 0]) : 0u; cgt += __popcll(__ballot(x > T)); }
    const int need_eq = 256 - cgt; int running = 0, eq_taken = 0;
    const unsigned long long lt = (1ull << lane) - 1ull;
    for (int sg = 0; sg < nseg; ++sg) {
        const int idx = sg * 64 + lane; const unsigned x = (idx < n) ? tk_key(sr[idx < n ? idx : 0]) : 0u;
        const bool gt = x > T, eq = x == T;
        const unsigned long long meq = __ballot(eq);
        const bool take = gt || (eq && (eq_taken + __popcll(meq & lt)) < need_eq);
        const unsigned long long mt = __ballot(take);
        if (take) sel[running + __popcll(mt & lt)] = idx;
        running += __popcll(mt); eq_taken += __popcll(meq);
    }
}
constexpr int TK_CAP = 832;
__device__ __forceinline__ int topk_row(Frame& F, const int row, LAS int* sel, LAS unsigned long long* cand) {
    const int lane = F.lane;
    const float* SC = WSP(float, WS_BIG);
    {
        const int pos = row & (SEQ - 1), n = pos + 1;
        if (n <= 256) {
#pragma unroll
            for (int i = 0; i < 4; ++i) { const int j = 64 * i + lane; sel[j] = (j < n) ? j : 0; }
            return n;
        }
        const int nblk = (n + 1023) >> 10;
        const float* sr = SC + (size_t)row * 8192;
        int lane_l = lane; asm volatile("" : "+v"(lane_l));
        unsigned u[128];
#pragma unroll
        for (int i = 0; i < 64; ++i) u[i] = __float_as_uint((sr + (i >> 4) * 1024)[(i & 15) * 64 + lane_l]);
        if (nblk > 4) {
#pragma unroll
            for (int i = 64; i < 128; ++i) u[i] = __float_as_uint((sr + (i >> 4) * 1024)[(i & 15) * 64 + lane_l]);
        } else {
#pragma unroll
            for (int i = 64; i < 128; ++i) u[i] = 0u;
        }
        asm volatile("" ::: "memory");
#pragma unroll
        for (int i = 0; i < 128; ++i) { const int lim = n - i * 64; const unsigned bits = u[i];
            const unsigned x = (bits & 0x80000000u) ? ~bits : (bits | 0x80000000u);
            u[i] = (lane < lim) ? x : 0u; }
        const unsigned long long ltmask_s = (1ull << lane) - 1ull;
        bool done = false;
        {
            int ns = 0;
#pragma unroll
            for (int k = 0; k < 16; ++k) { int v = n - 512 * k; v = v < 0 ? 0 : (v > 64 ? 64 : v); ns += v; }
            const float mean = 256.0f * (float)ns / (float)n;
            const int rs = (int)(mean + 4.0f * sqrtf(mean) + 5.0f);
            unsigned Ts = 0u;
            for (int bit = 31; bit >= 16; --bit) {
                const unsigned cnd = Ts | (1u << bit); unsigned long long m0[8], m1[8];
                mask_ge8(m0, u[0], u[8], u[16], u[24], u[32], u[40], u[48], u[56], cnd); mask_ge8(m1, u[64], u[72], u[80], u[88], u[96], u[104], u[112], u[120], cnd);
                int c = 0;
#pragma unroll
                for (int i = 0; i < 8; ++i) c += __popcll(m0[i]) + __popcll(m1[i]);
                if (c >= rs) Ts = cnd;
            }
            if (Ts == 0u) Ts = 1u;
            int nc = 0;
#pragma unroll
            for (int bk = 0; bk < 8; ++bk) {
                if (bk < nblk) {
#pragma unroll
                    for (int g8 = 0; g8 < 2; ++g8) {
                        unsigned long long mg[8]; const int b0 = bk * 16 + g8 * 8;
                        mask_ge8(mg, u[b0], u[b0 + 1], u[b0 + 2], u[b0 + 3], u[b0 + 4], u[b0 + 5], u[b0 + 6], u[b0 + 7], Ts);
#pragma unroll
                        for (int i = 0; i < 8; ++i) {
                            const unsigned long long mt = mg[i];
                            if (mt != 0ull) {
                                const int off = nc + __popcll(mt & ltmask_s);
                                if (((mt >> lane) & 1ull) && off < TK_CAP) cand[off] = ((unsigned long long)u[b0 + i] << 32) | (unsigned)((b0 + i) * 64 + lane_l);
                                nc += __popcll(mt);
                            }
                        }
                    }
                }
            }
            if (nc >= 256 && nc <= TK_CAP) {
                unsigned ck[16]; int ci[13];
#pragma unroll
                for (int t = 0; t < 13; ++t) { const int j = lane + 64 * t; const unsigned long long e = (j < nc) ? cand[j] : 0ull; ck[t] = (unsigned)(e >> 32); ci[t] = (int)(unsigned)e; }
                ck[13] = 0u; ck[14] = 0u; ck[15] = 0u;
                unsigned T = 0u;
                for (int bit = 31; bit >= 0; --bit) {
                    const unsigned cnd = T | (1u << bit); unsigned long long m0[8], m1[8];
                    mask_ge8(m0, ck[0], ck[1], ck[2], ck[3], ck[4], ck[5], ck[6], ck[7], cnd); mask_ge8(m1, ck[8], ck[9], ck[10], ck[11], ck[12], ck[13], ck[14], ck[15], cnd);
                    int c = 0;
#pragma unroll
                    for (int i = 0; i < 8; ++i) c += __popcll(m0[i]) + __popcll(m1[i]);
                    if (c >= 256) T = cnd;
                }
                unsigned long long g0[8], g1[8], h0[8], h1[8];
                mask_ge8(g0, ck[0], ck[1], ck[2], ck[3], ck[4], ck[5], ck[6], ck[7], T); mask_ge8(g1, ck[8], ck[9], ck[10], ck[11], ck[12], ck[13], ck[14], ck[15], T);
                mask_ge8(h0, ck[0], ck[1], ck[2], ck[3], ck[4], ck[5], ck[6], ck[7], T + 1u); mask_ge8(h1, ck[8], ck[9], ck[10], ck[11], ck[12], ck[13], ck[14], ck[15], T + 1u);
                int cgt = 0;
#pragma unroll
                for (int t = 0; t < 13; ++t) cgt += __popcll(t < 8 ? h0[t & 7] : h1[t & 7]);
                const int need_eq = 256 - cgt;
                int running = 0, eq_taken = 0;
#pragma unroll
                for (int t = 0; t < 13; ++t) {
                    const unsigned long long mge = (t < 8 ? g0[t & 7] : g1[t & 7]), mgt = (t < 8 ? h0[t & 7] : h1[t & 7]);
                    unsigned long long mt = mge; const unsigned long long me = mge & ~mgt;
                    if (me != 0ull) {
                        const int room = need_eq - eq_taken; unsigned long long keep = 0ull, rest = me;
                        for (int k = 0; k < room && rest != 0ull; ++k) { const unsigned long long low = rest & (~rest + 1ull); keep |= low; rest ^= low; }
                        mt = (mge & ~me) | keep; eq_taken += __popcll(me);
                    }
                    if (mt != 0ull) { if ((mt >> lane) & 1ull) sel[running + __popcll(mt & ltmask_s)] = ci[t]; running += __popcll(mt); }
                }
                done = true;
            }
        }
        if (!done) topk_row_slow(sr, n, lane, sel);
    }
    return 256;
}

__device__ __forceinline__ void p6_gdn_out(Frame& F, KArgs A) {
    const int lane = F.lane, gw = F.bid * NWAVES + F.wave, NGW = F.G * NWAVES;
    const f32x4 g0 = *(const f32x4*)(A->in[I_AB_ONG] + 8 * (lane & 15)), g1 = *(const f32x4*)(A->in[I_AB_ONG] + 8 * (lane & 15) + 4);
    for (int row = gw; row < M; row += NGW) {
        const float* op = WSP(float, WS_ODELTA) + (size_t)row * 512 + 8 * lane;
        const f32x4 a = *(const f32x4*)op, b = *(const f32x4*)(op + 4);
        float ss = a[0] * a[0] + a[1] * a[1] + a[2] * a[2] + a[3] * a[3] + b[0] * b[0] + b[1] * b[1] + b[2] * b[2] + b[3] * b[3];
        ss += __shfl_xor(ss, 1); ss += __shfl_xor(ss, 2); ss += __shfl_xor(ss, 4); ss += __shfl_xor(ss, 8);
        const float r = rsqrtf(ss * (1.0f / 128.0f) + 1e-6f);
        float z[8]; unpack8(*(const v4u*)(WSP(bf16, WS_QKVZ) + (size_t)row * 2048 + 1536 + 8 * lane), z);
        float o[8];
#pragma unroll
        for (int i = 0; i < 4; ++i) { o[i] = a[i] * r * g0[i] * siluf(z[i]); o[4 + i] = b[i] * r * g1[i] * siluf(z[4 + i]); }
        *(v4u*)(WSP(bf16, WS_AO) + (size_t)row * 1536 + 1024 + 8 * lane) = pack8f(o);
    }
}

__device__ __forceinline__ void p8_ln_router(Frame& F, KArgs A, int l, float* HOUT, bf16* HB) {
    const int lane = F.lane, tid = F.tid, gw = F.bid * NWAVES + F.wave, NGW = F.G * NWAVES;
    LAS float* wT = (LAS float*)(F.lds);
    LAS float* lg = (LAS float*)(F.lds + WSCR_OFF + F.wave * WSCR_BYTES);
    const float* rw = A->in[I_RW] + (size_t)l * 1024 * 32;
    {
        f32x4 wv[16];
#pragma unroll
        for (int j = 0; j < 16; ++j) wv[j] = *(const f32x4*)(rw + (size_t)(tid + NTHREADS * j) * 4);
#pragma unroll
        for (int j = 0; j < 16; ++j) { const int i4 = tid + NTHREADS * j, k = i4 >> 3, e0 = (i4 & 7) * 4;
            wT[(e0 + 0) * 1028 + k] = wv[j][0]; wT[(e0 + 1) * 1028 + k] = wv[j][1]; wT[(e0 + 2) * 1028 + k] = wv[j][2]; wT[(e0 + 3) * 1028 + k] = wv[j][3]; }
    }
    __syncthreads();
    const float* PRE = WSP(float, WS_PRE);
    const float* lg_g = A->in[I_LNM_G] + (size_t)l * 1024; const float* lg_b = A->in[I_LNM_B] + (size_t)l * 1024;
    const float rb = A->in[I_RB][l * 32 + (lane & 31)];
    int* TOKE = WSP(int, WS_ROUTE); int* TOKPOS = TOKE + M * 4; float* TOKG = (float*)(TOKPOS + M * 4);
    gu32* cnt = F.ctl + CW_CNT + 64 * 32 * l;
    LAS int* lcnt = (LAS int*)(F.lds + MISC_OFF + 512);
    LAS int* lbase = lcnt + 32;
    LAS int* myrt = (LAS int*)(F.lds + WSCR_OFF + F.wave * WSCR_BYTES + 128);
    if (tid < 32) lcnt[tid] = 0;
    __syncthreads();
    int nrow = 0;
    f32x4 lng[4], lnb[4];
#pragma unroll
    for (int j = 0; j < 4; ++j) { lng[j] = *(const f32x4*)(lg_g + 256 * j + 4 * lane); lnb[j] = *(const f32x4*)(lg_b + 256 * j + 4 * lane); }
    for (int row = gw; row < M; row += NGW) {
        f32x4 v[4]; float s = 0.f;
#pragma unroll
        for (int j = 0; j < 4; ++j) { v[j] = *(const f32x4*)(PRE + (size_t)row * 1024 + 256 * j + 4 * lane); s += (v[j][0] + v[j][1]) + (v[j][2] + v[j][3]); }
        const float mean = wave_sum(s) * (1.0f / 1024.0f); float s2 = 0.f;
#pragma unroll
        for (int j = 0; j < 4; ++j) { v[j] = v[j] - mean; s2 += (v[j][0] * v[j][0] + v[j][1] * v[j][1]) + (v[j][2] * v[j][2] + v[j][3] * v[j][3]); }
        const float rstd = rsqrtf(wave_sum(s2) * (1.0f / 1024.0f) + 1e-5f);
#pragma unroll
        for (int j = 0; j < 4; ++j) {
            v[j] = v[j] * rstd * lng[j] + lnb[j];
            *(f32x4*)(HOUT + (size_t)row * 1024 + 256 * j + 4 * lane) = v[j];
            v2u o; o.x = pk2(v[j][0], v[j][1]); o.y = pk2(v[j][2], v[j][3]); *(v2u*)(HB + (size_t)row * 1024 + 256 * j + 4 * lane) = o;
        }
        float part[32];
#pragma unroll
        for (int e = 0; e < 32; ++e) {
            float a = 0.f;
#pragma unroll
            for (int j = 0; j < 4; ++j) { const f32x4 w = *(const LAS f32x4*)(wT + e * 1028 + 256 * j + 4 * lane); a += v[j][0] * w[0] + v[j][1] * w[1] + v[j][2] * w[2] + v[j][3] * w[3]; }
            part[e] = a;
        }
#pragma unroll
        for (int i = 0; i < 16; ++i) { const bool up = (lane & 32) != 0; const float keep = up ? part[i + 16] : part[i], send = up ? part[i] : part[i + 16]; part[i] = keep + __shfl_xor(send, 32); }
#pragma unroll
        for (int i = 0; i < 8; ++i) { const bool up = (lane & 16) != 0; const float keep = up ? part[i + 8] : part[i], send = up ? part[i] : part[i + 8]; part[i] = keep + __shfl_xor(send, 16); }
#pragma unroll
        for (int i = 0; i < 4; ++i) { const bool up = (lane & 8) != 0; const float keep = up ? part[i + 4] : part[i], send = up ? part[i] : part[i + 4]; part[i] = keep + __shfl_xor(send, 8); }
#pragma unroll
        for (int i = 0; i < 2; ++i) { const bool up = (lane & 4) != 0; const float keep = up ? part[i + 2] : part[i], send = up ? part[i] : part[i + 2]; part[i] = keep + __shfl_xor(send, 4); }
        { const bool up = (lane & 2) != 0; const float keep = up ? part[1] : part[0], send = up ? part[0] : part[1]; part[0] = keep + __shfl_xor(send, 2); }
        part[0] += __shfl_xor(part[0], 1);
        const int eidx = ((lane >> 5) & 1) * 16 + ((lane >> 4) & 1) * 8 + ((lane >> 3) & 1) * 4 + ((lane >> 2) & 1) * 2 + ((lane >> 1) & 1);
        if ((lane & 1) == 0) lg[eidx] = part[0];
        float val = (lane < 32) ? lg[lane & 31] + rb : -INFINITY;
        float tl[4]; int te[4];
#pragma unroll
        for (int k = 0; k < 4; ++k) {
            const float mx = wave_max(val);
            const unsigned long long mm = __ballot(val == mx && lane < 32);
            const int idx = __ffsll((long long)mm) - 1;
            tl[k] = mx; te[k] = idx;
            if (lane == idx) val = -INFINITY;
        }
        const float e1 = __expf(tl[1] - tl[0]), e2 = __expf(tl[2] - tl[0]), e3 = __expf(tl[3] - tl[0]);
        const float inv = 1.0f / (1.0f + e1 + e2 + e3);
        if (lane < 4) {
            const int e = lane == 0 ? te[0] : (lane == 1 ? te[1] : (lane == 2 ? te[2] : te[3]));
            const float g = (lane == 0 ? 1.0f : (lane == 1 ? e1 : (lane == 2 ? e2 : e3))) * inv;
            const int lp = __hip_atomic_fetch_add(lcnt + e, 1, __ATOMIC_RELAXED, __HIP_MEMORY_SCOPE_WORKGROUP);
            LAS int* rt = myrt + (nrow * 4 + lane) * 3; rt[0] = e; rt[1] = lp; rt[2] = __float_as_int(g);
        }
        ++nrow;
    }
    __syncthreads();
    if (tid < 32) lbase[tid] = (int)__hip_atomic_fetch_add(cnt + 64 * tid, (unsigned)lcnt[tid], RLX_AGENT);
    __syncthreads();
    if (lane < 4) {
        int j = 0;
        for (int row = gw; row < M; row += NGW, ++j) {
            const LAS int* rt = myrt + (j * 4 + lane) * 3; const int e = rt[0];
            TOKE[(size_t)row * 4 + lane] = e; TOKPOS[(size_t)row * 4 + lane] = lbase[e] + rt[1]; TOKG[(size_t)row * 4 + lane] = __int_as_float(rt[2]);
        }
    }
}

__device__ __forceinline__ void p9_scatter(Frame& F, int l, const bf16* HB, const float* HF) {
    const int lane = F.lane, tid = F.tid, gw = F.bid * NWAVES + F.wave, NGW = F.G * NWAVES;
    LAS int* base = (LAS int*)(F.lds + MISC_OFF + 256);
    int* TOKE = WSP(int, WS_ROUTE); int* TOKPOS = TOKE + M * 4; int* TILE = TOKE + 3 * M * 4;
    if (tid < 32) base[tid] = (int)__hip_atomic_load(F.ctl + CW_CNT + 64 * (32 * l + tid), RLX_AGENT);
    __syncthreads();
    if (tid == 0) {
        int acc = 0;
        for (int e = 0; e < NEXP; ++e) { const int c = base[e]; base[e] = acc; acc += ((c + 255) >> 8) << 8; }
        base[32] = acc >> 8;
    }
    __syncthreads();
    if (F.bid == 0 && tid < 64) {
        const int nT = base[32];
        for (int t = tid; t < NTMAX; t += 64) { int e = 0;
            for (int x = 1; x < NEXP; ++x) if (base[x] <= t * 256) e = x;
            TILE[t] = (t < nT) ? e : 0; }
        if (tid == 0) TILE[NTMAX] = nT;
    }
    bf16* XS = WSP(bf16, WS_XS);
    if (kMoeFp8) {
        unsigned char* XB8 = WSP(unsigned char, WS_XS);
        for (int row = gw; row < M; row += NGW) {
            const float* hp = HF + (size_t)row * 1024 + 16 * lane; v4u o;
#pragma unroll
            for (int q = 0; q < 4; ++q) { const f32x4 v = *(const f32x4*)(hp + 4 * q); unsigned w = 0u; w = __builtin_amdgcn_cvt_pk_fp8_f32(v[0], v[1], w, false); w = __builtin_amdgcn_cvt_pk_fp8_f32(v[2], v[3], w, true); o[q] = w; }
#pragma unroll
            for (int k = 0; k < 4; ++k) { const int slot = base[TOKE[(size_t)row * 4 + k]] + TOKPOS[(size_t)row * 4 + k]; *(v4u*)(XB8 + (size_t)slot * 1024 + 16 * lane) = o; }
        }
        return;
    }
    for (int row = gw; row < M; row += NGW) {
        const v4u a = *(const v4u*)(HB + (size_t)row * 1024 + 8 * lane), b = *(const v4u*)(HB + (size_t)row * 1024 + 512 + 8 * lane);
#pragma unroll
        for (int k = 0; k < 4; ++k) {
            const int slot = base[TOKE[(size_t)row * 4 + k]] + TOKPOS[(size_t)row * 4 + k];
            *(v4u*)(XS + (size_t)slot * 1024 + 8 * lane) = a; *(v4u*)(XS + (size_t)slot * 1024 + 512 + 8 * lane) = b;
        }
    }
}

__device__ __forceinline__ void p12_combine(Frame& F, KArgs A, int l, const float* HIN, float* HOUT, bf16* HB) {
    const int lane = F.lane, tid = F.tid, gw = F.bid * NWAVES + F.wave, NGW = F.G * NWAVES;
    LAS int* base = (LAS int*)(F.lds + MISC_OFF + 256);
    if (tid < 32) base[tid] = (int)__hip_atomic_load(F.ctl + CW_CNT + 64 * (32 * l + tid), RLX_AGENT);
    __syncthreads();
    if (tid == 0) { int acc = 0; for (int e = 0; e < NEXP; ++e) { const int c = base[e]; base[e] = acc; acc += ((c + 255) >> 8) << 8; } }
    __syncthreads();
    const int* TOKE = WSP(int, WS_ROUTE); const int* TOKPOS = TOKE + M * 4; const float* TOKG = (const float*)(TOKPOS + M * 4);
    const bf16* YS = WSP(bf16, WS_YS); const bf16* PLE = WSP(bf16, WS_PLE);
    const float* lg_g = A->in[I_LNF_G] + (size_t)l * 1024; const float* lg_b = A->in[I_LNF_B] + (size_t)l * 1024;
    f32x4 lng[2][2], lnb[2][2];
#pragma unroll
    for (int hf = 0; hf < 2; ++hf) { const int c0 = 512 * hf + 8 * lane; lng[hf][0] = *(const f32x4*)(lg_g + c0); lng[hf][1] = *(const f32x4*)(lg_g + c0 + 4); lnb[hf][0] = *(const f32x4*)(lg_b + c0); lnb[hf][1] = *(const f32x4*)(lg_b + c0 + 4); }
    for (int row = gw; row < M; row += NGW) {
        float x[16];
        {   const f32x4 h0 = *(const f32x4*)(HIN + (size_t)row * 1024 + 8 * lane), h1 = *(const f32x4*)(HIN + (size_t)row * 1024 + 8 * lane + 4);
            const f32x4 h2 = *(const f32x4*)(HIN + (size_t)row * 1024 + 512 + 8 * lane), h3 = *(const f32x4*)(HIN + (size_t)row * 1024 + 512 + 8 * lane + 4);
            float p0[8], p1[8]; unpack8(*(const v4u*)(PLE + (size_t)row * 1024 + 8 * lane), p0); unpack8(*(const v4u*)(PLE + (size_t)row * 1024 + 512 + 8 * lane), p1);
#pragma unroll
            for (int i = 0; i < 4; ++i) { x[i] = ALPHA * h0[i] + p0[i]; x[4 + i] = ALPHA * h1[i] + p0[4 + i]; x[8 + i] = ALPHA * h2[i] + p1[i]; x[12 + i] = ALPHA * h3[i] + p1[4 + i]; }
        }
#pragma unroll
        for (int k = 0; k < 4; ++k) {
            const int slot = base[TOKE[(size_t)row * 4 + k]] + TOKPOS[(size_t)row * 4 + k]; const float g = TOKG[(size_t)row * 4 + k];
            float y0[8], y1[8]; unpack8(*(const v4u*)(YS + (size_t)slot * 1024 + 8 * lane), y0); unpack8(*(const v4u*)(YS + (size_t)slot * 1024 + 512 + 8 * lane), y1);
#pragma unroll
            for (int i = 0; i < 8; ++i) { x[i] += g * y0[i]; x[8 + i] += g * y1[i]; }
        }
        float s = 0.f;
#pragma unroll
        for (int i = 0; i < 16; ++i) s += x[i];
        const float mean = wave_sum(s) * (1.0f / 1024.0f); float s2 = 0.f;
#pragma unroll
        for (int i = 0; i < 16; ++i) { x[i] -= mean; s2 += x[i] * x[i]; }
        const float rstd = rsqrtf(wave_sum(s2) * (1.0f / 1024.0f) + 1e-5f);
#pragma unroll
        for (int hf = 0; hf < 2; ++hf) {
            const int c0 = 512 * hf + 8 * lane;
            const f32x4 g0 = lng[hf][0], g1 = lng[hf][1], b0 = lnb[hf][0], b1 = lnb[hf][1];
            f32x4 o0, o1;
#pragma unroll
            for (int i = 0; i < 4; ++i) { o0[i] = x[8 * hf + i] * rstd * g0[i] + b0[i]; o1[i] = x[8 * hf + 4 + i] * rstd * g1[i] + b1[i]; }
            *(f32x4*)(HOUT + (size_t)row * 1024 + c0) = o0; *(f32x4*)(HOUT + (size_t)row * 1024 + c0 + 4) = o1;
            if (HB) { v4u w; w.x = pk2(o0[0], o0[1]); w.y = pk2(o0[2], o0[3]); w.z = pk2(o1[0], o1[1]); w.w = pk2(o1[2], o1[3]); *(v4u*)(HB + (size_t)row * 1024 + c0) = w; }
        }
    }
}

typedef short v4i16_t __attribute__((ext_vector_type(4)));
__device__ __forceinline__ v4i16_t lds_tr16(LAS unsigned char* p) { return __builtin_amdgcn_ds_read_tr16_b64_v4i16((LAS v4i16_t*)p); }
constexpr int DV_PITCH = 144, DV_BUF = 32 * DV_PITCH;
template <int DL  , int SIGMA  > __device__ __forceinline__ void dil_branch(const bf16* __restrict__ KV, LAS unsigned char* vbuf, const int s0, const int lane,
                                                                                 const bf16x8 (&qf)[2], f32x4 (&O)[4], float& m_run, float& l_run) {
    constexpr int d = 1 << DL, sigma = SIGMA, NS = (129 + 15 * sigma + 31) / 32;
    const int fr = lane & 15, fq = lane >> 4;
    const int c = s0 & (d - 1), n0 = s0 >> DL, kstart = n0 - 128;
    const int dbase = 128 + sigma * fr - 4 * fq;
    const int dmax = n0 + sigma * fr;
#define DIL_POS(n) ({ int _p = c + d * (n); _p = _p < 0 ? 0 : (_p > SEQ - 1 ? SEQ - 1 : _p); _p; })
    bf16x8 kf[2][2]; v4u vr[4];
#pragma unroll
    for (int tl = 0; tl < 2; ++tl) { const bf16* kp = KV + (size_t)DIL_POS(kstart + 16 * tl + fr) * 2560 + 768 + 8 * fq; kf[tl][0] = *(const bf16x8*)kp; kf[tl][1] = *(const bf16x8*)(kp + 32); }
#pragma unroll
    for (int i = 0; i < 4; ++i) vr[i] = *(const v4u*)(KV + (size_t)DIL_POS(kstart + (lane >> 3) + 8 * i) * 2560 + 1536 + 8 * (lane & 7));
#pragma unroll 1
    for (int g = 0; g < NS; ++g) {
        LAS unsigned char* vb = vbuf;
#pragma unroll
        for (int i = 0; i < 4; ++i) *(LAS v4u*)(vb + ((lane >> 3) + 8 * i) * DV_PITCH + 16 * (lane & 7)) = vr[i];
        bf16x8 kc[2][2];
#pragma unroll
        for (int tl = 0; tl < 2; ++tl) { kc[tl][0] = kf[tl][0]; kc[tl][1] = kf[tl][1]; }
        if (g + 1 < NS) {
            const int kb = kstart + 32 * (g + 1);
#pragma unroll
            for (int tl = 0; tl < 2; ++tl) { const bf16* kp = KV + (size_t)DIL_POS(kb + 16 * tl + fr) * 2560 + 768 + 8 * fq; kf[tl][0] = *(const bf16x8*)kp; kf[tl][1] = *(const bf16x8*)(kp + 32); }
#pragma unroll
            for (int i = 0; i < 4; ++i) vr[i] = *(const v4u*)(KV + (size_t)DIL_POS(kb + (lane >> 3) + 8 * i) * 2560 + 1536 + 8 * (lane & 7));
        }
        float sv[8];
#pragma unroll
        for (int tl = 0; tl < 2; ++tl) {
            f32x4 cc = __builtin_amdgcn_mfma_f32_16x16x32_bf16(kc[tl][0], qf[0], (f32x4){0.f, 0.f, 0.f, 0.f}, 0, 0, 0);
            cc = __builtin_amdgcn_mfma_f32_16x16x32_bf16(kc[tl][1], qf[1], cc, 0, 0, 0);
#pragma unroll
            for (int j = 0; j < 4; ++j) {
                const int delta = dbase - (32 * g + 16 * tl + j);
                const bool ok = ((unsigned)delta <= 128u) && (delta <= dmax);
                sv[4 * tl + j] = ok ? cc[j] * 0.18033688011112042f : -INFINITY;
            }
        }
        float mx = fmaxf(fmaxf(fmaxf(sv[0], sv[1]), fmaxf(sv[2], sv[3])), fmaxf(fmaxf(sv[4], sv[5]), fmaxf(sv[6], sv[7])));
        mx = fmaxf(mx, __shfl_xor(mx, 16)); mx = fmaxf(mx, __shfl_xor(mx, 32));
        const float m_new = fmaxf(m_run, mx);
        if (!__all(m_new == m_run)) {
            const float alpha = __builtin_amdgcn_exp2f(m_run - m_new);
            l_run *= alpha;
#pragma unroll
            for (int j = 0; j < 4; ++j) { const float aj = __shfl(alpha, 4 * fq + j);
#pragma unroll
                for (int dt = 0; dt < 4; ++dt) O[dt][j] *= aj; }
            m_run = m_new;
        }
        float p[8], ps = 0.f;
#pragma unroll
        for (int e = 0; e < 8; ++e) { p[e] = __builtin_amdgcn_exp2f(sv[e] - m_run); ps += p[e]; }
        l_run += ps;
        v4u pw; pw.x = pg8::cvt_pk_bf16(p[0], p[1]); pw.y = pg8::cvt_pk_bf16(p[2], p[3]); pw.z = pg8::cvt_pk_bf16(p[4], p[5]); pw.w = pg8::cvt_pk_bf16(p[6], p[7]);
        const bf16x8 pf = __builtin_bit_cast(bf16x8, pw);
        LAS unsigned char* tb = vb + (4 * fq + ((lane & 15) >> 2)) * DV_PITCH + 8 * (lane & 3);
#pragma unroll
        for (int dt = 0; dt < 4; ++dt) {
            const v4i16_t lo = lds_tr16(tb + 32 * dt), hi = lds_tr16(tb + 16 * DV_PITCH + 32 * dt);
            bf16x8 vf; vf[0] = lo[0]; vf[1] = lo[1]; vf[2] = lo[2]; vf[3] = lo[3]; vf[4] = hi[0]; vf[5] = hi[1]; vf[6] = hi[2]; vf[7] = hi[3];
            O[dt] = __builtin_amdgcn_mfma_f32_16x16x32_bf16(pf, vf, O[dt], 0, 0, 0);
        }
    }
#undef DIL_POS
}
constexpr int HND_OFF = 8 * DV_BUF, HND_PITCH = 66;
static_assert(HND_OFF + 256 * HND_PITCH * 4 <= MISC_OFF, "dilated attention LDS map");
__device__ __forceinline__ void p14_dilated_mfma(Frame& F) {
    const int lane = F.lane, fr = lane & 15, fq = lane >> 4;
    LAS unsigned char* vbuf = F.lds + F.wave * DV_BUF;
    LAS float* hnd = (LAS float*)(F.lds + HND_OFF);
    const bf16* QK = WSP(bf16, WS_QKVZ); bf16* AO = WSP(bf16, WS_AO);
    for (int u = F.bid; u < 24 * 32; u += F.G) {
        const int bh = u >> 5, blk = u & 31;
        const int b = bh / 12, hh = bh - b * 12;
        const bf16* KV = QK + (size_t)b * SEQ * 2560 + hh * 64;
#pragma unroll 1
        for (int i = 0; i < 2; ++i) {
            const int run = 2 * F.wave + i, s0 = 256 * blk + 16 * run;
            bf16x8 qf[2];
            { const bf16* qp = KV + (size_t)(s0 + fr) * 2560 + 8 * fq; qf[0] = *(const bf16x8*)qp; qf[1] = *(const bf16x8*)(qp + 32); }
            f32x4 O[4];
#pragma unroll
            for (int dt = 0; dt < 4; ++dt) O[dt] = (f32x4){0.f, 0.f, 0.f, 0.f};
            float m_run = -1e30f, l_run = 0.f;
            dil_branch<0, 1>(KV, vbuf, s0, lane, qf, O, m_run, l_run);
            float lt = l_run; lt += __shfl_xor(lt, 16); lt += __shfl_xor(lt, 32);
#pragma unroll
            for (int j = 0; j < 4; ++j)
#pragma unroll
                for (int dt = 0; dt < 4; ++dt) hnd[(16 * run + 4 * fq + j) * HND_PITCH + 16 * dt + fr] = O[dt][j];
            if (fq == 0) { hnd[(16 * run + fr) * HND_PITCH + 64] = m_run; hnd[(16 * run + fr) * HND_PITCH + 65] = lt; }
        }
        __syncthreads();
#pragma unroll 1
        for (int i = 0; i < 2; ++i) {
            const int o = 2 * F.wave + i, s0 = 256 * blk + o;
            bf16x8 qf[2];
            { const bf16* qp = KV + (size_t)(s0 + 16 * fr) * 2560 + 8 * fq; qf[0] = *(const bf16x8*)qp; qf[1] = *(const bf16x8*)(qp + 32); }
            f32x4 O[4];
#pragma unroll
            for (int j = 0; j < 4; ++j)
#pragma unroll
                for (int dt = 0; dt < 4; ++dt) O[dt][j] = hnd[(o + 16 * (4 * fq + j)) * HND_PITCH + 16 * dt + fr];
            float m_run = hnd[(o + 16 * fr) * HND_PITCH + 64], l_run = (fq == 0) ? hnd[(o + 16 * fr) * HND_PITCH + 65] : 0.f;
            dil_branch<4, 1>(KV, vbuf, s0, lane, qf, O, m_run, l_run);
            dil_branch<2, 4>(KV, vbuf, s0, lane, qf, O, m_run, l_run);
            float lt = l_run; lt += __shfl_xor(lt, 16); lt += __shfl_xor(lt, 32);
            const float inv = __builtin_amdgcn_rcpf(lt);
#pragma unroll
            for (int j = 0; j < 4; ++j) {
                const float ij = __shfl(inv, 4 * fq + j);
                bf16* op = AO + (size_t)(b * SEQ + s0 + 16 * (4 * fq + j)) * 1024 + hh * 64 + fr;
#pragma unroll
                for (int dt = 0; dt < 4; ++dt) op[16 * dt] = (bf16)f2bf(O[dt][j] * ij);
            }
        }
        __syncthreads();
    }
}
constexpr int SA_PITCH = 272, SA_TILE = 32 * SA_PITCH;
__device__ __forceinline__ void sparse_row(Frame& F, const int row, const int n, const LAS int* sel, LAS unsigned char* tile) {
    const int lane = F.lane, fr = lane & 15, fq = lane >> 4;
    const bf16* QL = WSP(bf16, WS_QL); const bf16* CKV = WSP(bf16, WS_CKV); bf16* AO = WSP(bf16, WS_AO);
    {
        const int b = row >> 13;
        const bf16* kvb = CKV + (size_t)b * SEQ * 128;
        bf16x8 qf[4];
#pragma unroll
        for (int s = 0; s < 4; ++s) { const v4u z = (v4u){0u, 0u, 0u, 0u}; qf[s] = (fr < 8) ? *(const bf16x8*)(QL + (size_t)row * 1536 + fr * 128 + 32 * s + 8 * fq) : __builtin_bit_cast(bf16x8, z); }
        f32x4 O[8];
#pragma unroll
        for (int rt = 0; rt < 8; ++rt) O[rt] = (f32x4){0.f, 0.f, 0.f, 0.f};
        float m_run = -1e30f, l_run = 0.f;
        const int nsteps = (n + 31) >> 5;
        v4u vr[8];
        { const int j = lane & 31; const int kidx = (j < n) ? sel[j] : 0;
#pragma unroll
          for (int i = 0; i < 8; ++i) { const int key = __shfl(kidx, (lane >> 4) + 4 * i); vr[i] = *(const v4u*)(kvb + (size_t)key * 128 + 8 * (lane & 15)); } }
#pragma unroll 1
        for (int g = 0; g < nsteps; ++g) {
#pragma unroll
            for (int i = 0; i < 8; ++i) *(LAS v4u*)(tile + ((lane >> 4) + 4 * i) * SA_PITCH + 16 * (lane & 15)) = vr[i];
            if (g + 1 < nsteps) {
                const int j = 32 * (g + 1) + (lane & 31); const int kidx = (j < n) ? sel[j] : 0;
#pragma unroll
                for (int i = 0; i < 8; ++i) { const int key = __shfl(kidx, (lane >> 4) + 4 * i); vr[i] = *(const v4u*)(kvb + (size_t)key * 128 + 8 * (lane & 15)); }
            }
            float sv[8];
#pragma unroll
            for (int tl = 0; tl < 2; ++tl) {
                f32x4 cc = (f32x4){0.f, 0.f, 0.f, 0.f};
#pragma unroll
                for (int s = 0; s < 4; ++s) { const bf16x8 kf = *(const LAS bf16x8*)(tile + (16 * tl + fr) * SA_PITCH + 64 * s + 16 * fq); cc = __builtin_amdgcn_mfma_f32_16x16x32_bf16(kf, qf[s], cc, 0, 0, 0); }
#pragma unroll
                for (int j = 0; j < 4; ++j) sv[4 * tl + j] = (32 * g + 16 * tl + 4 * fq + j < n) ? cc[j] : -INFINITY;
            }
            float mx = fmaxf(fmaxf(fmaxf(sv[0], sv[1]), fmaxf(sv[2], sv[3])), fmaxf(fmaxf(sv[4], sv[5]), fmaxf(sv[6], sv[7])));
            mx = fmaxf(mx, __shfl_xor(mx, 16)); mx = fmaxf(mx, __shfl_xor(mx, 32));
            const float m_new = fmaxf(m_run, mx);
            if (!__all(m_new == m_run)) {
                const float alpha = __expf(m_run - m_new);
                l_run *= alpha;
#pragma unroll
                for (int j = 0; j < 4; ++j) { const float aj = __shfl(alpha, 4 * fq + j);
#pragma unroll
                    for (int rt = 0; rt < 8; ++rt) O[rt][j] *= aj; }
                m_run = m_new;
            }
            float p[8], ps = 0.f;
#pragma unroll
            for (int e = 0; e < 8; ++e) { p[e] = __expf(sv[e] - m_run); ps += p[e]; }
            l_run += ps;
            v4u pw; pw.x = pg8::cvt_pk_bf16(p[0], p[1]); pw.y = pg8::cvt_pk_bf16(p[2], p[3]); pw.z = pg8::cvt_pk_bf16(p[4], p[5]); pw.w = pg8::cvt_pk_bf16(p[6], p[7]);
            const bf16x8 pf = __builtin_bit_cast(bf16x8, pw);
            LAS unsigned char* tb = tile + (4 * fq + ((lane & 15) >> 2)) * SA_PITCH + 8 * (lane & 3);
#pragma unroll
            for (int rt = 0; rt < 8; ++rt) {
                const v4i16_t lo = lds_tr16(tb + 32 * rt), hi = lds_tr16(tb + 16 * SA_PITCH + 32 * rt);
                bf16x8 vf; vf[0] = lo[0]; vf[1] = lo[1]; vf[2] = lo[2]; vf[3] = lo[3]; vf[4] = hi[0]; vf[5] = hi[1]; vf[6] = hi[2]; vf[7] = hi[3];
                O[rt] = __builtin_amdgcn_mfma_f32_16x16x32_bf16(pf, vf, O[rt], 0, 0, 0);
            }
        }
        float lt = l_run; lt += __shfl_xor(lt, 16); lt += __shfl_xor(lt, 32);
        const float inv = __builtin_amdgcn_rcpf(lt);
#pragma unroll
        for (int j = 0; j < 4; ++j) {
            const float ij = __shfl(inv, 4 * fq + j);
            if (fq < 2) { bf16* op = AO + (size_t)row * 1536 + (4 * fq + j) * 128 + fr;
#pragma unroll
                for (int rt = 0; rt < 8; ++rt) op[16 * rt] = (bf16)f2bf(O[rt][j] * ij); }
        }
    }
}
__device__ __forceinline__ void p5_topk_attn(Frame& F, const int gw, const int NGW) {
    LAS int* sel = (LAS int*)(F.lds + F.wave * 16384);
    LAS unsigned char* tile = F.lds + F.wave * 16384 + 1024;
    LAS unsigned long long* cand = (LAS unsigned long long*)(F.lds + F.wave * 16384 + 1024 + SA_TILE);
    static_assert(1024 + SA_TILE + TK_CAP * 8 <= 16384, "per-wave LDS");
    for (int rix = gw; rix < M; rix += NGW) {
        const int row = ((rix & 1) ? (M - 1 - (rix >> 1)) : (rix >> 1));
        const int n = __builtin_amdgcn_readfirstlane(topk_row(F, row, sel, cand));
        sparse_row(F, row, n, sel, tile);
    }
}
constexpr int CP_KV_PITCH = 272;
__device__ __forceinline__ void p3_chunk_prep_mfma(Frame& F, KArgs A) {
    int tid = F.tid; asm volatile("" : "+v"(tid));
    const int lane = tid & 63, wave = __builtin_amdgcn_readfirstlane(tid >> 6), fr = lane & 15, fq = lane >> 4;
    LAS unsigned char* kt = F.lds;
    LAS unsigned char* vt = F.lds + 64 * CP_KV_PITCH;
    LAS float* As = (LAS float*)(F.lds + 2 * 64 * CP_KV_PITCH);
    LAS float* Ts = As + 64 * 65;
    LAS float* gcS = Ts + 64 * 68; LAS float* egS = gcS + 64; LAS float* ekS = egS + 64; LAS float* btS = ekS + 64;
    for (int cidx = F.bid; cidx < 1024; cidx += F.G) {
        const int b = cidx >> 9, h = (cidx >> 7) & 3, n = cidx & 127, row0 = b * SEQ + n * 64;
        unsigned char* blk = F.ws + WS_CHK + (size_t)cidx * CHK_STRIDE;
        const bf16* Qg = WSP(bf16, WS_QN) + (size_t)row0 * 512 + h * 128; const bf16* Kg = WSP(bf16, WS_KN) + (size_t)row0 * 512 + h * 128; const bf16* Vg = WSP(bf16, WS_VN) + (size_t)row0 * 512 + h * 128;
        const int ti = wave >> 1;
        float g_in = 0.f, bt_in = 0.f;
        if (tid < 64) { g_in = WSP(float, WS_GG)[(size_t)(row0 + tid) * 4 + h]; bt_in = WSP(float, WS_BETA)[(size_t)(row0 + tid) * 4 + h]; }
        v4u kc[2], vc[2], qc[2];
#pragma unroll
        for (int i = 0; i < 2; ++i) { const int id = tid + 512 * i, r = id >> 4, c = id & 15; kc[i] = *(const v4u*)(Kg + (size_t)r * 512 + 8 * c); vc[i] = *(const v4u*)(Vg + (size_t)r * 512 + 8 * c); qc[i] = *(const v4u*)(Qg + (size_t)r * 512 + 8 * c); }
        bf16x8 ka[4], qa[4], kbf[2][4];
#pragma unroll
        for (int s = 0; s < 4; ++s) { ka[s] = *(const bf16x8*)(Kg + (size_t)(16 * ti + fr) * 512 + 32 * s + 8 * fq); qa[s] = *(const bf16x8*)(Qg + (size_t)(16 * ti + fr) * 512 + 32 * s + 8 * fq);
            kbf[0][s] = *(const bf16x8*)(Kg + (size_t)(16 * (2 * (wave & 1)) + fr) * 512 + 32 * s + 8 * fq); kbf[1][s] = *(const bf16x8*)(Kg + (size_t)(16 * (2 * (wave & 1) + 1) + fr) * 512 + 32 * s + 8 * fq); }
        if (tid < 64) {
            float gc = g_in;
#pragma unroll
            for (int o = 1; o < 64; o <<= 1) { const float t = __shfl_up(gc, o); if (lane >= o) gc += t; }
            const float g63 = __shfl(gc, 63);
            gcS[tid] = gc; egS[tid] = __expf(gc); ekS[tid] = __expf(g63 - gc); btS[tid] = bt_in;
            if (tid == 0) *(float*)(blk + CHK_GL) = __expf(g63);
        }
#pragma unroll
        for (int i = 0; i < 2; ++i) { const int id = tid + 512 * i, r = id >> 4, c = id & 15; *(LAS v4u*)(kt + r * CP_KV_PITCH + 16 * c) = kc[i]; *(LAS v4u*)(vt + r * CP_KV_PITCH + 16 * c) = vc[i]; }
        __syncthreads();
        {
#pragma unroll
            for (int t2 = 0; t2 < 2; ++t2) {
                const int tj = 2 * (wave & 1) + t2;
                f32x4 ck = (f32x4){0.f, 0.f, 0.f, 0.f}, cq = (f32x4){0.f, 0.f, 0.f, 0.f};
#pragma unroll
                for (int s = 0; s < 4; ++s) { ck = __builtin_amdgcn_mfma_f32_16x16x32_bf16(ka[s], kbf[t2][s], ck, 0, 0, 0); cq = __builtin_amdgcn_mfma_f32_16x16x32_bf16(qa[s], kbf[t2][s], cq, 0, 0, 0); }
                const int j = 16 * tj + fr; const float gcj = gcS[j];
                bf16* QKp = (bf16*)(blk + CHK_QK);
#pragma unroll
                for (int jj = 0; jj < 4; ++jj) { const int i = 16 * ti + 4 * fq + jj; const float dec = __expf(j <= i ? gcS[i] - gcj : 0.f);
                    As[i * 65 + j] = (j < i) ? btS[i] * ck[jj] * dec : 0.f;
                    QKp[i * 64 + 32 * (j >> 5) + 8 * ((j >> 2) & 3) + 4 * ((j >> 4) & 1) + (j & 3)] = (bf16)f2bf((j <= i) ? cq[jj] * dec : 0.f); }
            }
        }
        {
#pragma unroll
            for (int x = 0; x < 2; ++x) { const int id = tid + 512 * x, i = id >> 4, d0 = (id & 15) * 8; const float e = egS[i];
                float f[8]; unpack8(qc[x], f);
                bf16* Qd = (bf16*)(blk + CHK_QD) + i * 128 + 32 * (d0 >> 5) + 4 * ((d0 >> 4) & 1);
                const int q0 = (d0 >> 2) & 3;
                v2u w0, w1; w0.x = pk2(f[0] * e, f[1] * e); w0.y = pk2(f[2] * e, f[3] * e); w1.x = pk2(f[4] * e, f[5] * e); w1.y = pk2(f[6] * e, f[7] * e);
                *(v2u*)(Qd + 8 * q0) = w0; *(v2u*)(Qd + 8 * (q0 + 1)) = w1; }
        }
        {
            const int d = tid >> 2, c0 = (tid & 3) * 16, s = c0 >> 5, a = (c0 >> 4) & 1;
            bf16* Kd = (bf16*)(blk + CHK_KDT) + d * 64;
#pragma unroll
            for (int q = 0; q < 4; ++q) { const int c = c0 + 4 * q; float kv[4];
#pragma unroll
                for (int e = 0; e < 4; ++e) kv[e] = bf1(*(const LAS bf16*)(kt + (c + e) * CP_KV_PITCH + 2 * d)) * ekS[c + e];
                v2u w; w.x = pk2(kv[0], kv[1]); w.y = pk2(kv[2], kv[3]); *(v2u*)(Kd + 32 * s + 8 * q + 4 * a) = w; }
        }
        __syncthreads();
        {
            const int c = tid >> 3, part = tid & 7;
            for (int i = 0; i < 64; ++i) {
                float acc = 0.f;
                for (int j = part; j < i; j += 8) acc += As[i * 65 + j] * Ts[j * 68 + c];
                acc += __shfl_xor(acc, 1); acc += __shfl_xor(acc, 2); acc += __shfl_xor(acc, 4);
                if (part == 0) Ts[i * 68 + c] = ((i == c) ? 1.f : 0.f) - acc;
                __builtin_amdgcn_fence(__ATOMIC_RELEASE, "wavefront"); asm volatile("s_waitcnt lgkmcnt(0)" ::: "memory");
            }
        }
        __syncthreads();
        {
            bf16x8 vf[2], kf[2];
            LAS unsigned char* vb = vt + (8 * fq + ((lane & 15) >> 2)) * CP_KV_PITCH + 32 * wave + 8 * (lane & 3);
            LAS unsigned char* kb = kt + (8 * fq + ((lane & 15) >> 2)) * CP_KV_PITCH + 32 * wave + 8 * (lane & 3);
#pragma unroll
            for (int s = 0; s < 2; ++s) {
                const v4i16_t v0 = lds_tr16(vb + (32 * s) * CP_KV_PITCH), v1 = lds_tr16(vb + (32 * s + 4) * CP_KV_PITCH), k0 = lds_tr16(kb + (32 * s) * CP_KV_PITCH), k1 = lds_tr16(kb + (32 * s + 4) * CP_KV_PITCH);
                vf[s][0] = v0[0]; vf[s][1] = v0[1]; vf[s][2] = v0[2]; vf[s][3] = v0[3]; vf[s][4] = v1[0]; vf[s][5] = v1[1]; vf[s][6] = v1[2]; vf[s][7] = v1[3];
                kf[s][0] = k0[0]; kf[s][1] = k0[1]; kf[s][2] = k0[2]; kf[s][3] = k0[3]; kf[s][4] = k1[0]; kf[s][5] = k1[1]; kf[s][6] = k1[2]; kf[s][7] = k1[3];
            }
            float* UT = (float*)(blk + CHK_UT);
            bf16* Wp = (bf16*)(blk + CHK_WP);
#pragma unroll
            for (int ti = 0; ti < 4; ++ti) {
                f32x4 cu = (f32x4){0.f, 0.f, 0.f, 0.f}, cw = (f32x4){0.f, 0.f, 0.f, 0.f};
#pragma unroll
                for (int s = 0; s < 2; ++s) {
                    const LAS float* tr = Ts + (16 * ti + fr) * 68 + 32 * s + 8 * fq;
                    const f32x4 t0 = *(const LAS f32x4*)tr, t1 = *(const LAS f32x4*)(tr + 4);
                    const f32x4 b0 = *(const LAS f32x4*)(btS + 32 * s + 8 * fq), b1 = *(const LAS f32x4*)(btS + 32 * s + 8 * fq + 4), e0 = *(const LAS f32x4*)(egS + 32 * s + 8 * fq), e1 = *(const LAS f32x4*)(egS + 32 * s + 8 * fq + 4);
                    const f32x4 u0 = t0 * b0, u1 = t1 * b1, w0 = u0 * e0, w1 = u1 * e1;
                    cu = __builtin_amdgcn_mfma_f32_16x16x32_bf16(packfrag(u0, u1), vf[s], cu, 0, 0, 0);
                    cw = __builtin_amdgcn_mfma_f32_16x16x32_bf16(packfrag(w0, w1), kf[s], cw, 0, 0, 0);
                }
                *(f32x4*)(UT + (size_t)(16 * wave + fr) * 64 + 16 * ti + 4 * fq) = cu;
#pragma unroll
                for (int jj = 0; jj < 4; ++jj) Wp[(16 * ti + 4 * fq + jj) * 128 + 32 * (wave >> 1) + 8 * (fr >> 2) + 4 * (wave & 1) + (fr & 3)] = (bf16)f2bf(cw[jj]);
            }
        }
        __syncthreads();
    }
}
__device__ __forceinline__ void p14_pool(Frame& F, KArgs A) {
    const int lane = F.lane, tid = F.tid, gw = F.bid * NWAVES + F.wave, NGW = F.G * NWAVES;
    LAS float* pw = (LAS float*)(F.lds + 16384);
    LAS float* dl = (LAS float*)(F.lds + 16384 + 65536 + F.wave * 1024);
    {   f32x4 pv[8];
#pragma unroll
        for (int j = 0; j < 8; ++j) pv[j] = *(const f32x4*)(A->in[I_CD_POOLW] + (size_t)(tid + NTHREADS * j) * 4);
#pragma unroll
        for (int j = 0; j < 8; ++j) *(LAS f32x4*)(pw + (tid + NTHREADS * j) * 4) = pv[j];
    }
    __syncthreads();
    const bf16* QK = WSP(bf16, WS_QKVZ); bf16* AO = WSP(bf16, WS_AO);
    const int gi = lane >> 4, w = 2 << gi;
    float sc[4];
#pragma unroll
    for (int g = 0; g < 4; ++g) sc[g] = A->in[I_CD_POOLS][g * 64 + lane];
    for (int row = gw; row < M; row += NGW) {
        const int pos = row & (SEQ - 1);
        const int cntw = (pos + 1 < w) ? pos + 1 : w;
        float sum[4] = {0.f, 0.f, 0.f, 0.f}, cur[4] = {0.f, 0.f, 0.f, 0.f};
        v2u xw[16];
#pragma unroll
        for (int j = 0; j < 16; ++j) xw[j] = *(const v2u*)(QK + (size_t)(row - (j <= pos ? j : pos)) * 2560 + 2304 + 4 * lane);
#pragma unroll
        for (int j = 0; j < 16; ++j) {
            const float f0 = bflo(xw[j].x), f1 = bfhi(xw[j].x), f2 = bflo(xw[j].y), f3 = bfhi(xw[j].y);
            if (j < cntw) { sum[0] += f0; sum[1] += f1; sum[2] += f2; sum[3] += f3; }
            if (j == 0) { cur[0] = f0; cur[1] = f1; cur[2] = f2; cur[3] = f3; }
        }
        const float inv = 1.0f / (float)cntw;
#pragma unroll
        for (int i = 0; i < 4; ++i) dl[4 * lane + i] = sum[i] * inv - cur[i];
        float o[4] = {0.f, 0.f, 0.f, 0.f};
        for (int c = 0; c < 64; ++c) {
#pragma unroll
            for (int g = 0; g < 4; ++g) o[g] += dl[g * 64 + c] * pw[(g * 64 + c) * 64 + lane];
        }
#pragma unroll
        for (int g = 0; g < 4; ++g) AO[(size_t)row * 1024 + 768 + g * 64 + lane] = (bf16)f2bf(o[g] * sc[g]);
    }
}


#define IN(k) (lo <= (k) && (k) < hi)
#define SEAM(k) do { if (IN(k) && IN((k) + 1)) xcd_barrier(bar); } while (0)
template <int l> __device__ __forceinline__ void layer_tail(Frame& F, const XcdBarrier& bar, const int lo, const int hi) {
    LAS unsigned char* ring = F.lds + RING_OFF;
    const int bid = F.bid, G = F.G;
        const int pb = 8 * l;

        if (IN(7 + pb)) {
            pg8::Gemm g{WSP(bf16, WS_AO), (l == 0) ? WSP(bf16, WS_W_OUTAB) : WSP(bf16, WS_W_OUTCD), M, 1024, (l == 0) ? 1536 : 1024}; pg8::StaticOrder S; S.init(M, 1024, G, bid);
            pg8::Epi<pg8::StPre> E{{(l == 0) ? kargs()->in[I_X] : WSP(float, WS_H2), WSP(float, WS_PRE), ALPHA}};
            pg8::gemm_phase<pg8::Epi<pg8::StPre>, pg8::StaticOrder, true, true>(ring, g, S, E);
        } SEAM(7 + pb);
        if (IN(8 + pb)) { p8_ln_router(F, kargs(), l, WSP(float, WS_H1), WSP(bf16, WS_H1B)); } SEAM(8 + pb);
        if (IN(9 + pb)) {
            p9_scatter(F, l, WSP(bf16, WS_H1B), WSP(float, WS_H1));
            __syncthreads();
            pg8::Gemm g{WSP(bf16, WS_H1B), WSP(bf16, WS_W_PG) + (size_t)l * 1024 * 1024, M, 1024, 1024}; pg8::StaticOrder S; S.init(M, 1024, G, bid);
            pg8::Epi<pg8::StPleGate> E{{WSP(bf16, WS_PP) + (size_t)l * M * 1024, WSP(bf16, WS_PLE)}};
            pg8::gemm_phase<pg8::Epi<pg8::StPleGate>, pg8::StaticOrder, true, true>(ring, g, S, E);
        } SEAM(9 + pb);
        const int* TILE = WSP(int, WS_ROUTE) + 3 * M * 4;
        if (IN(10 + pb)) {
            const int nT = __builtin_amdgcn_readfirstlane(TILE[NTMAX]);
            constexpr int EB = kMoeFp8 ? 1 : 2;
            pg8::Gemm g{WSP(bf16, WS_XS), (const bf16*)(F.ws + WS_W_GU + (size_t)l * NEXP * 2048 * 1024 * EB), PMAX, 2048, 1024 * EB / 2};
            pg8::MoeOrder S{TILE, nT, 8, G, bid, (long)2048 * 1024 * EB};
            pg8::Epi<pg8::StSwiglu<kMoeFp8>> E{{kargs()->in[I_BGU] + (size_t)l * NEXP * 2048, WSP(bf16, WS_HID)}};
            pg8::gemm_phase<pg8::Epi<pg8::StSwiglu<kMoeFp8>>, pg8::MoeOrder, true, false, kMoeFp8 ? kScaleGU : 0u>(ring, g, S, E);
        } SEAM(10 + pb);
        if (IN(11 + pb)) {
            const int nT = __builtin_amdgcn_readfirstlane(TILE[NTMAX]);
            constexpr int EB = kMoeFp8 ? 1 : 2;
            pg8::Gemm g{WSP(bf16, WS_HID), (const bf16*)(F.ws + WS_W_DN + (size_t)l * NEXP * 1024 * 1024 * EB), PMAX, 1024, 1024 * EB / 2};
            pg8::MoeOrder S{TILE, nT, 4, G, bid, (long)1024 * 1024 * EB};
            pg8::Epi<pg8::StDown> E{{kargs()->in[I_BDN] + (size_t)l * NEXP * 1024, WSP(bf16, WS_YS)}};
            pg8::gemm_phase<pg8::Epi<pg8::StDown>, pg8::MoeOrder, true, false, kMoeFp8 ? kScaleDN : 0u>(ring, g, S, E);
        } SEAM(11 + pb);
        if (IN(12 + pb)) { p12_combine(F, kargs(), l, WSP(float, WS_H1), (l == 0) ? WSP(float, WS_H2) : kargs()->out, (l == 0) ? WSP(bf16, WS_XB) : (bf16*)nullptr); }
}
#undef IN
#undef SEAM
__global__ void __launch_bounds__(NTHREADS, 2) mk_fwd(Args args_by_value) {
    const KArgs KA = kargs();
    extern __shared__ __attribute__((aligned(16))) unsigned char lds[];
    Frame F;
    F.lds = (LAS unsigned char*)lds;
    F.tid = threadIdx.x; F.lane = F.tid & 63; F.wave = __builtin_amdgcn_readfirstlane(F.tid >> 6);
    F.G = gridDim.x; F.bid = blockIdx.x; F.ws = KA->ws; F.ctl = (gu32*)(KA->ws + WS_CTL);
    volatile LAS unsigned* MISC = (volatile LAS unsigned*)(F.lds + MISC_OFF);
    { int t0 = threadIdx.x; asm volatile("" : "+v"(t0)); for (int u = t0; u < (LDS_BYTES - MISC_OFF) / 4; u += NTHREADS) MISC[u] = 0u; }
    __syncthreads();
    const bool use_bar = (N_LAUNCHES != NPHASES);
    XcdBarrier bar; bar.bar = (unsigned*)(F.ctl + CW_BAR) + KA->li * XCD_BAR_WORDS; bar.x = 0; bar.st = nullptr; bar.expect = 0;
    XcdBarrier bar2 = bar;
    if (use_bar && F.bid >= SEQ_WGS && F.G > SEQ_WGS) bar2 = xcd_barrier_post((unsigned*)(F.ctl + CW_BAR2), MISC + 10, (unsigned)(F.G - SEQ_WGS));
    if (use_bar) bar = xcd_barrier_post((unsigned*)(F.ctl + CW_BAR) + KA->li * XCD_BAR_WORDS, MISC + 8);
    const int lo = KA->ph_lo, hi = KA->ph_hi;
#define IN(k) (lo <= (k) && (k) < hi)
#define SEAM(k) do { if (IN(k) && IN((k) + 1)) xcd_barrier(bar); } while (0)
    LAS unsigned char* ring = F.lds + RING_OFF;
    const int bid = F.bid, G = F.G;

    if (IN(0)) { p0_prologue(F, kargs()); } SEAM(0);

            if (IN(1)) {
                { pg8::Gemm g{WSP(bf16, WS_XB), WSP(bf16, WS_W_INAB), M, 2560, 1024}; pg8::StaticOrder S; S.init(M, 2560, G, bid);
                  pg8::Epi<pg8::StInAB> E{{WSP(float, WS_SM), WSP(bf16, WS_QKVZ)}};
                  pg8::gemm_phase<pg8::Epi<pg8::StInAB>, pg8::StaticOrder, true, true>(ring, g, S, E); }
                __syncthreads();
                { pg8::Gemm g{WSP(bf16, WS_PB), WSP(bf16, WS_W_PP), 2 * M, 1024, 256}; pg8::BatchOrder S{4, (2 * M / 256) * 4, G, bid, M / 256, (long)1024 * 256 * 2};
                  pg8::Epi<pg8::StBf16> E{{WSP(bf16, WS_PP), 1024}};
                  pg8::gemm_phase<pg8::Epi<pg8::StBf16>, pg8::BatchOrder, true, true>(ring, g, S, E); }
            } SEAM(1);
            if (IN(2)) { p2_prep(F, kargs()); } SEAM(2);
            if (IN(3)) {
                p3_chunk_prep_mfma(F, kargs());
                __syncthreads();
                { pg8::Gemm g{WSP(bf16, WS_CQ), WSP(bf16, WS_W_ABS), M, 1536, 256}; pg8::StaticOrder S; S.init(M, 1536, G, bid);
                  pg8::Epi<pg8::StBf16> E{{WSP(bf16, WS_QL), 1536}};
                  pg8::gemm_phase<pg8::Epi<pg8::StBf16>, pg8::StaticOrder, true, true>(ring, g, S, E); }
            } SEAM(3);
            if (IN(4)) {
                if (bid < SEQ_WGS && G > SEQ_WGS) p4_delta_seq(F, bid);
                else { p4_indexer(F, (bid - SEQ_WGS) * NWAVES + F.wave, (G - SEQ_WGS) * NWAVES);
                    if (use_bar) { xcd_barrier(bar2);
                        p5_topk_attn(F, (bid - SEQ_WGS) * NWAVES + F.wave, (G - SEQ_WGS) * NWAVES); } }
            } SEAM(4);
            if (IN(5)) { if (!use_bar) p5_topk_attn(F, bid * NWAVES + F.wave, G * NWAVES); p6_gdn_out(F, kargs()); } SEAM(5);
    layer_tail<0>(F, bar, lo, hi);
    SEAM(12);
            if (IN(13)) {
                pg8::Gemm g{WSP(bf16, WS_XB), WSP(bf16, WS_W_INCD), M, 2560, 1024}; pg8::StaticOrder S; S.init(M, 2560, G, bid);
                pg8::Epi<pg8::StBf16> E{{WSP(bf16, WS_QKVZ), 2560}};
                pg8::gemm_phase<pg8::Epi<pg8::StBf16>, pg8::StaticOrder, true, true>(ring, g, S, E);
            } SEAM(13);
            if (IN(14)) { p14_dilated_mfma(F); __syncthreads(); p14_pool(F, kargs()); } SEAM(14);
    layer_tail<1>(F, bar, lo, hi);
#undef IN
#undef SEAM
}

extern "C" void kernel_launch(void* const* d_in, const int* in_sizes, int n_in, void* d_out, int out_size, void* d_ws, size_t ws_size, hipStream_t stream) {
    static int grid = 0;
    if (grid == 0) {
        if (n_in != N_IN || in_sizes[0] != M * D || out_size != M * D || ws_size < WS_END) {
            fprintf(stderr, "kernel_launch: built for %d inputs, x/out of %d floats, >= %zu bytes of workspace; got n_in %d, in0 %d, out %d, ws %zu; nothing launched\n", N_IN, M * D, (size_t)WS_END, n_in, n_in > 0 ? in_sizes[0] : -1, out_size, ws_size);
            grid = -1; return; }
        int dev = 0, cus = 0, per_cu = 0;
        if (hipGetDevice(&dev) != hipSuccess || hipDeviceGetAttribute(&cus, hipDeviceAttributeMultiprocessorCount, dev) != hipSuccess) { fprintf(stderr, "kernel_launch: device query failed\n"); grid = -1; return; }
        if (hipFuncSetAttribute((const void*)mk_fwd, hipFuncAttributeMaxDynamicSharedMemorySize, LDS_BYTES) != hipSuccess) { fprintf(stderr, "kernel_launch: hipFuncSetAttribute failed\n"); grid = -1; return; }
        if (hipOccupancyMaxActiveBlocksPerMultiprocessor(&per_cu, (const void*)mk_fwd, NTHREADS, LDS_BYTES) != hipSuccess || per_cu < 1)
            fprintf(stderr, "kernel_launch: note: occupancy query reports %d workgroups per CU\n", per_cu);
        (void)hipGetLastError();
        grid = cus;
    }
    if (grid < 0) return;
    if (hipMemsetAsync((char*)d_ws + WS_CTL, 0, CTL_ZERO_BYTES, stream) != hipSuccess) { fprintf(stderr, "kernel_launch: memset failed\n"); return; }
    Args a{};
    for (int i = 0; i < N_IN; ++i) a.in[i] = (const float*)d_in[i];
    a.out = (float*)d_out; a.ws = (unsigned char*)d_ws;
    for (int li = 0; li < N_LAUNCHES; ++li) {
        if (N_LAUNCHES == NPHASES) { a.ph_lo = li; a.ph_hi = li + 1; } else { a.ph_lo = (int)((long)li * NPHASES / N_LAUNCHES); a.ph_hi = (int)((long)(li + 1) * NPHASES / N_LAUNCHES); }
        a.li = li;
        hipLaunchKernelGGL(mk_fwd, dim3(grid), dim3(NTHREADS), LDS_BYTES, stream, a);
        const hipError_t le = hipPeekAtLastError();
        if (le != hipSuccess) { fprintf(stderr, "kernel_launch: launch %d failed: %s\n", li, hipGetErrorName(le)); break; }
    }
}
```

```cpp
#include <hip/hip_runtime.h>
#include <cstdio>
#include <cstdint>

namespace pg8 {
#define PG8_LAS __attribute__((address_space(3)))
typedef unsigned short bf16_t;
typedef short bf16x8 __attribute__((ext_vector_type(8)));
typedef float f32x4 __attribute__((ext_vector_type(4)));
typedef unsigned u32x4 __attribute__((ext_vector_type(4)));
constexpr int BM = 256, BK = 64, HALF = 128, HTB = HALF * BK * 2  , STAGE_BYTES = 8 * HTB, NXCD = 8, WGM = 8;

__host__ __device__ __forceinline__ int lds_byte(int r, int c) { const int st = (r >> 4) * 2 + (c >> 5), rr = r & 15, cc = c & 31, ob = rr * 64 + cc * 2; return st * 1024 + (ob ^ (((ob >> 9) & 1) << 5)); }
__host__ __device__ __forceinline__ void stage_rc(int b, int& R, int& C) { const int st = b / 1024, sb = b % 1024, swz = sb ^ (((sb >> 9) & 1) << 5); R = (st >> 1) * 16 + swz / 64; C = (st & 1) * 32 + (swz % 64) / 2; }
__host__ __device__ __forceinline__ int perm32(int rho) { const int n = rho >> 4, i = rho & 15; return 8 * (i >> 2) + 4 * n + (i & 3); }

struct Unit { int pm, pn, e; long bofs; };
struct Gemm { const bf16_t* A; const bf16_t* Bt; int M, N, K; };

struct StaticOrder {
    int nM, nN, nwg, G, c;
    __host__ __device__ void init(int M, int N, int G_, int c_) { nM = M / BM; nN = N / BM; nwg = nM * nN; G = G_; c = c_; }
    __host__ __device__ bool next(int i, Unit& u) const {
        const long L = (long)i * G + c; if (L >= nwg) return false;
        int wgid = (int)L; { const int q = nwg / NXCD, r = nwg % NXCD, xcd = wgid % NXCD, off = wgid / NXCD; wgid = (xcd < r ? xcd * (q + 1) : r * (q + 1) + (xcd - r) * q) + off; }
        const int nig = WGM * nN, gid = wgid / nig, fm = gid * WGM, gsz = (nM - fm) < WGM ? (nM - fm) : WGM;
        u.pm = fm + ((wgid % nig) % gsz); u.pn = (wgid % nig) / gsz; u.e = 0; u.bofs = 0; return true;
    }
    __device__ __forceinline__ void a_ready(const Unit&) const {}
    __device__ __forceinline__ void done(const Unit&) const {}
};
struct MoeOrder {
    const int* tile_e; int nT, nN, G, c; long estride;
    __device__ __forceinline__ bool next(int i, Unit& u) const {
        if (G % (8 * nN) == 0) {
            const int rpx = G / (8 * nN), xcd = c & 7, idx = c >> 3;
            u.pm = (i * 8 + xcd) * rpx + idx % rpx; u.pn = idx / rpx;
            if (u.pm >= nT) return false;
        } else {
            const long L = (long)i * G + c; if (L >= (long)nT * nN) return false;
            u.pm = (int)(L / nN); u.pn = (int)(L % nN);
        }
        const int e = tile_e[u.pm]; u.e = e; u.bofs = (long)e * estride; return true;
    }
    __device__ __forceinline__ void a_ready(const Unit&) const {}
    __device__ __forceinline__ void done(const Unit&) const {}
};

struct BatchOrder {
    int nN, nwg, G, c, tiles_per_batch; long bstride;
    __device__ __forceinline__ bool next(int i, Unit& u) const {
        const long L = (long)i * G + c; if (L >= nwg) return false;
        u.pm = (int)(L / nN); u.pn = (int)(L % nN); const int e = u.pm / tiles_per_batch; u.e = e; u.bofs = (long)e * bstride; return true;
    }
    __device__ __forceinline__ void a_ready(const Unit&) const {}
    __device__ __forceinline__ void done(const Unit&) const {}
};

typedef float f32x2c __attribute__((ext_vector_type(2)));
typedef __bf16 bf16x2c __attribute__((ext_vector_type(2)));
__device__ __forceinline__ unsigned cvt_pk_bf16(float lo, float hi) { const f32x2c v = {lo, hi}; const bf16x2c b = __builtin_convertvector(v, bf16x2c); return __builtin_bit_cast(unsigned, b); }
__device__ __forceinline__ u32x4 pack8(const f32x4 v0, const f32x4 v1) { u32x4 w; w.x = cvt_pk_bf16(v0[0], v0[1]); w.y = cvt_pk_bf16(v0[2], v0[3]); w.z = cvt_pk_bf16(v1[0], v1[1]); w.w = cvt_pk_bf16(v1[2], v1[3]); return w; }
__device__ __forceinline__ float bf_lo(unsigned w) { return __uint_as_float(w << 16); }
__device__ __forceinline__ float bf_hi(unsigned w) { return __uint_as_float(w & 0xffff0000u); }
__device__ __forceinline__ float sigmoidf_(float x) { return __builtin_amdgcn_rcpf(1.0f + __builtin_amdgcn_exp2f(x * -1.4426950408889634f)); }
typedef unsigned u32x2 __attribute__((ext_vector_type(2)));

template <class T> struct Epi {
    static constexpr bool PERM = true, AFTER_DRAIN = false;
    T t;
    __device__ __forceinline__ void operator()(const f32x4 (&acc)[2][2][4][2], const Unit& u, int wr, int wc, int fr, int fq) const {
        const int row0 = u.pm * BM + wr * 64 + fr, col0 = u.pn * BM + wc * 32 + 8 * fq;
        f32x4 cb[2][2];
#pragma unroll
        for (int bj = 0; bj < 2; ++bj) t.colctx(col0 + bj * HALF, u, cb[bj][0], cb[bj][1]);
        f32x4 rc[2][2], rn[2][2];
#pragma unroll
        for (int bj = 0; bj < 2; ++bj) t.rowctx(row0, col0 + bj * HALF, rc[bj][0], rc[bj][1]);
#pragma unroll
        for (int g = 0; g < 8; ++g) {
            const int ai = g >> 2, m = g & 3, row = row0 + ai * HALF + m * 16;
            if (g < 7) { const int nrow = row0 + ((g + 1) >> 2) * HALF + ((g + 1) & 3) * 16;
#pragma unroll
                for (int bj = 0; bj < 2; ++bj) t.rowctx(nrow, col0 + bj * HALF, rn[bj][0], rn[bj][1]); }
#pragma unroll
            for (int bj = 0; bj < 2; ++bj) t.store(row, col0 + bj * HALF, acc[ai][bj][m][0] + cb[bj][0], acc[ai][bj][m][1] + cb[bj][1], u, rc[bj][0], rc[bj][1]);
            asm volatile("" ::: "memory");
#pragma unroll
            for (int bj = 0; bj < 2; ++bj) { rc[bj][0] = rn[bj][0]; rc[bj][1] = rn[bj][1]; }
        }
    }
};
struct StBf16 { bf16_t* O; int ld;
    __device__ __forceinline__ void rowctx(int, int, f32x4& r0, f32x4& r1) const { r0 = (f32x4){0.f, 0.f, 0.f, 0.f}; r1 = r0; }
    __device__ __forceinline__ void colctx(int, const Unit&, f32x4& c0, f32x4& c1) const { c0 = (f32x4){0.f, 0.f, 0.f, 0.f}; c1 = c0; }
    __device__ __forceinline__ void store(int row, int col, f32x4 v0, f32x4 v1, const Unit&, f32x4, f32x4) const { *(u32x4*)(O + (size_t)row * ld + col) = pack8(v0, v1); } };
struct StInAB { float* SM; bf16_t* Q;
    __device__ __forceinline__ void rowctx(int, int, f32x4& r0, f32x4& r1) const { r0 = (f32x4){0.f, 0.f, 0.f, 0.f}; r1 = r0; }
    __device__ __forceinline__ void colctx(int, const Unit&, f32x4& c0, f32x4& c1) const { c0 = (f32x4){0.f, 0.f, 0.f, 0.f}; c1 = c0; }
    __device__ __forceinline__ void store(int row, int col, f32x4 v0, f32x4 v1, const Unit&, f32x4, f32x4) const {
        if (col < 512) { float* p = SM + (size_t)row * 512 + col; *(f32x4*)p = v0; *(f32x4*)(p + 4) = v1; }
        else *(u32x4*)(Q + (size_t)row * 2048 + (col - 512)) = pack8(v0, v1); } };
struct StPre { const float* base; float* P; float alpha;
    __device__ __forceinline__ void colctx(int, const Unit&, f32x4& c0, f32x4& c1) const { c0 = (f32x4){0.f, 0.f, 0.f, 0.f}; c1 = c0; }
    __device__ __forceinline__ void rowctx(int row, int col, f32x4& r0, f32x4& r1) const { const size_t o = (size_t)row * 1024 + col; r0 = *(const f32x4*)(base + o); r1 = *(const f32x4*)(base + o + 4); }
    __device__ __forceinline__ void store(int row, int col, f32x4 v0, f32x4 v1, const Unit&, f32x4 b0, f32x4 b1) const {
        const size_t o = (size_t)row * 1024 + col;
        *(f32x4*)(P + o) = b0 * alpha + v0; *(f32x4*)(P + o + 4) = b1 * alpha + v1; } };
struct StPleGate { const bf16_t* PP; bf16_t* O;
    __device__ __forceinline__ void colctx(int, const Unit&, f32x4& c0, f32x4& c1) const { c0 = (f32x4){0.f, 0.f, 0.f, 0.f}; c1 = c0; }
    __device__ __forceinline__ void rowctx(int row, int col, f32x4& r0, f32x4& r1) const { r0 = *(const f32x4*)(PP + (size_t)row * 1024 + col); r1 = r0; }
    __device__ __forceinline__ void store(int row, int col, f32x4 v0, f32x4 v1, const Unit&, f32x4 pr, f32x4) const {
        const size_t o = (size_t)row * 1024 + col; const u32x4 p = __builtin_bit_cast(u32x4, pr);
        f32x4 r0, r1;
        r0[0] = sigmoidf_(v0[0]) * bf_lo(p.x); r0[1] = sigmoidf_(v0[1]) * bf_hi(p.x); r0[2] = sigmoidf_(v0[2]) * bf_lo(p.y); r0[3] = sigmoidf_(v0[3]) * bf_hi(p.y);
        r1[0] = sigmoidf_(v1[0]) * bf_lo(p.z); r1[1] = sigmoidf_(v1[1]) * bf_hi(p.z); r1[2] = sigmoidf_(v1[2]) * bf_lo(p.w); r1[3] = sigmoidf_(v1[3]) * bf_hi(p.w);
        *(u32x4*)(O + o) = pack8(r0, r1); } };
template <bool F8> struct StSwiglu { const float* bgu; bf16_t* H;
    __device__ __forceinline__ void rowctx(int, int, f32x4& r0, f32x4& r1) const { r0 = (f32x4){0.f, 0.f, 0.f, 0.f}; r1 = r0; }
    __device__ __forceinline__ float act(float g, float u) const { const float gt = __builtin_amdgcn_fmed3f(g, -INFINITY, 7.0f), up = __builtin_amdgcn_fmed3f(u, -7.0f, 7.0f);
        return (up + 1.0f) * (gt * __builtin_amdgcn_rcpf(1.0f + __builtin_amdgcn_exp2f(gt * -2.4554669595930157f))); }
    __device__ __forceinline__ void colctx(int col, const Unit& u, f32x4& c0, f32x4& c1) const { const float* b = bgu + (size_t)u.e * 2048 + col; c0 = *(const f32x4*)b; c1 = *(const f32x4*)(b + 4); }
    __device__ __forceinline__ void store(int row, int col, f32x4 v0, f32x4 v1, const Unit& u, f32x4, f32x4) const {
        if (F8) { unsigned w = 0u; w = __builtin_amdgcn_cvt_pk_fp8_f32(act(v0[0], v0[1]), act(v0[2], v0[3]), w, false); w = __builtin_amdgcn_cvt_pk_fp8_f32(act(v1[0], v1[1]), act(v1[2], v1[3]), w, true);
            *(unsigned*)((unsigned char*)H + (size_t)row * 1024 + (col >> 1)) = w; }
        else { u32x2 w; w.x = cvt_pk_bf16(act(v0[0], v0[1]), act(v0[2], v0[3])); w.y = cvt_pk_bf16(act(v1[0], v1[1]), act(v1[2], v1[3]));
            *(u32x2*)(H + (size_t)row * 1024 + (col >> 1)) = w; } } };
struct StDown { const float* bd; bf16_t* Y;
    __device__ __forceinline__ void rowctx(int, int, f32x4& r0, f32x4& r1) const { r0 = (f32x4){0.f, 0.f, 0.f, 0.f}; r1 = r0; }
    __device__ __forceinline__ void colctx(int col, const Unit& u, f32x4& c0, f32x4& c1) const { const float* b = bd + (size_t)u.e * 1024 + col; c0 = *(const f32x4*)b; c1 = *(const f32x4*)(b + 4); }
    __device__ __forceinline__ void store(int row, int col, f32x4 v0, f32x4 v1, const Unit& u, f32x4, f32x4) const {
        *(u32x4*)(Y + (size_t)row * 1024 + col) = pack8(v0, v1); } };

typedef int i32x8 __attribute__((ext_vector_type(8)));
typedef int i32x4 __attribute__((ext_vector_type(4)));
template <class Epi, class Sched, bool ALIGN_EPI = false, bool SP2 = false, unsigned FP8W = 0u>
__device__ __forceinline__ void gemm_phase(PG8_LAS unsigned char* lds, const Gemm g, const Sched& S, const Epi& E) {
    int tid = threadIdx.x; asm volatile("" : "+v"(tid));
    const int wid = __builtin_amdgcn_readfirstlane(tid >> 6), lane = tid & 63, wr = wid >> 2, wc = wid & 3, fr = lane & 15, fq = lane >> 4;
    int K = g.K; asm volatile("" : "+s"(K));
    const int nt = K / BK;
    unsigned voffA[2], voffB[2];
#pragma unroll
    for (int i = 0; i < 2; ++i) { int R, C; stage_rc(tid * 16 + i * 8192, R, C); const int Rb = Epi::PERM ? ((R & ~31) + perm32(R & 31)) : R;
        voffA[i] = (unsigned)(R * K + C) * 2u; voffB[i] = (unsigned)(Rb * K + C) * 2u; }
    const size_t kstep = (size_t)(BK * 2);
    const size_t hstep = (size_t)HALF * K * 2;
    const size_t tstep = 2 * hstep;
    const unsigned ldsw = (unsigned)wid * 1024u;
    const int aoff = lds_byte(wr * 64 + fr, fq * 8), boff = lds_byte(wc * 32 + fr, fq * 8);
#define PG8_SA(b, h) (((b) * 2 + (h)) * HTB)
#define PG8_SB(b, h) ((4 + (b) * 2 + (h)) * HTB)
#define PG8_STAGE(bufoff, gbase, voff) do { _Pragma("unroll") for (int _i = 0; _i < 2; ++_i) \
        __builtin_amdgcn_global_load_lds((const unsigned*)((const char*)(gbase) + (voff)[_i]), (PG8_LAS unsigned*)(lds + (bufoff) + ldsw + _i * 8192), 16, 0, 0); } while (0)
#define PG8_CAT(lo, hi) __builtin_shufflevector((lo), (hi), 0, 1, 2, 3, 4, 5, 6, 7)
#define PG8_LDA(dst, b, h) do { if constexpr (FP8W != 0u) { _Pragma("unroll") for (int m = 0; m < 4; ++m) dst##8[m] = PG8_CAT(*(const PG8_LAS i32x4*)(lds + PG8_SA(b, h) + aoff + m * 2048), *(const PG8_LAS i32x4*)(lds + PG8_SA(b, h) + aoff + m * 2048 + 1024)); } \
        else { _Pragma("unroll") for (int m = 0; m < 4; ++m) _Pragma("unroll") for (int k = 0; k < 2; ++k) dst[m][k] = *(const PG8_LAS bf16x8*)(lds + PG8_SA(b, h) + aoff + m * 2048 + k * 1024); } } while (0)
#define PG8_LDB(dst, b, h) do { if constexpr (FP8W != 0u) { _Pragma("unroll") for (int n = 0; n < 2; ++n) dst##8[n] = PG8_CAT(*(const PG8_LAS i32x4*)(lds + PG8_SB(b, h) + boff + n * 2048), *(const PG8_LAS i32x4*)(lds + PG8_SB(b, h) + boff + n * 2048 + 1024)); } \
        else { _Pragma("unroll") for (int n = 0; n < 2; ++n) _Pragma("unroll") for (int k = 0; k < 2; ++k) dst[n][k] = *(const PG8_LAS bf16x8*)(lds + PG8_SB(b, h) + boff + n * 2048 + k * 1024); } } while (0)
#define PG8_MMA(ai, bj, At, Bt) do { __builtin_amdgcn_s_setprio(1); _Pragma("unroll") for (int m = 0; m < 4; ++m) _Pragma("unroll") for (int n = 0; n < 2; ++n) { \
        if constexpr (FP8W != 0u) asm volatile("v_mfma_scale_f32_16x16x128_f8f6f4 %0, %1, %2, %0, %3, %4 op_sel_hi:[0,0,0]" : "+v"(acc[ai][bj][m][n]) : "v"(Bt##8[n]), "v"(At##8[m]), "v"(sc_w), "v"(sc_x));   \
        else { _Pragma("unroll") for (int k = 0; k < 2; ++k) acc[ai][bj][m][n] = __builtin_amdgcn_mfma_f32_16x16x32_bf16(Bt[n][k], At[m][k], acc[ai][bj][m][n], 0, 0, 0); } } __builtin_amdgcn_s_setprio(0); } while (0)
#define PG8_WAIT_V(n) asm volatile("s_waitcnt vmcnt(" #n ")" ::: "memory")
#define PG8_WAIT_L(n) asm volatile("s_waitcnt lgkmcnt(" #n ")" ::: "memory")
#define PG8_BAR __builtin_amdgcn_s_barrier()
#define PG8_SCHED __builtin_amdgcn_sched_barrier(0)
    Unit cur, nxt; int ui = 0;
    if (!S.next(0, cur)) return;
    f32x4 acc[2][2][4][2];
#pragma unroll
    for (int a = 0; a < 2; ++a)
#pragma unroll
        for (int b = 0; b < 2; ++b)
#pragma unroll
            for (int m = 0; m < 4; ++m)
#pragma unroll
                for (int n = 0; n < 2; ++n) acc[a][b][m][n] = (f32x4){0.f, 0.f, 0.f, 0.f};
    bf16x8 At[4][2], B0[2][2], B1[2][2];
    int sc_w = (int)FP8W, sc_x = 0x7f7f7f7f; asm volatile("" : "+v"(sc_w), "+v"(sc_x));
    i32x8 At8[4], B08[2], B18[2];
    const char* cA = (const char*)g.A + (size_t)cur.pm * tstep; const char* cB = (const char*)g.Bt + (size_t)cur.pn * tstep + cur.bofs;
    S.a_ready(cur);
    if constexpr (SP2) {
        PG8_STAGE(PG8_SB(0, 0), cB, voffB); PG8_STAGE(PG8_SB(0, 1), cB + hstep, voffB); PG8_STAGE(PG8_SA(0, 0), cA, voffA); PG8_STAGE(PG8_SA(0, 1), cA + hstep, voffA);
        if (wr == 1) PG8_BAR;
        PG8_WAIT_V(2); PG8_BAR;
        PG8_STAGE(PG8_SB(1, 0), cB + kstep, voffB); PG8_STAGE(PG8_SA(1, 0), cA + kstep, voffA); PG8_STAGE(PG8_SB(1, 1), cB + hstep + kstep, voffB);
        PG8_WAIT_V(6); PG8_BAR;
    } else {
        PG8_STAGE(PG8_SB(0, 0), cB, voffB); PG8_STAGE(PG8_SA(0, 0), cA, voffA); PG8_STAGE(PG8_SB(0, 1), cB + hstep, voffB); PG8_STAGE(PG8_SA(0, 1), cA + hstep, voffA);
        if (wr == 1) PG8_BAR;
        PG8_WAIT_V(4); PG8_BAR;
        PG8_STAGE(PG8_SB(1, 0), cB + kstep, voffB); PG8_STAGE(PG8_SA(1, 0), cA + kstep, voffA); PG8_STAGE(PG8_SB(1, 1), cB + hstep + kstep, voffB);
        PG8_WAIT_V(6); PG8_BAR;
    }
    for (;;) {
        const bool has_next = S.next(ui + 1, nxt);
        const char* nA = has_next ? (const char*)g.A + (size_t)nxt.pm * tstep : cA; const char* nB = has_next ? (const char*)g.Bt + (size_t)nxt.pn * tstep + nxt.bofs : cB;
        for (int t = 0; t < nt; t += 2) {
            const bool last = (t == nt - 2);
            const char* a1 = cA + (size_t)(t + 1) * kstep;
            const char* a2 = last ? nA : cA + (size_t)(t + 2) * kstep; const char* b2 = last ? nB : cB + (size_t)(t + 2) * kstep;
            const char* a3 = a2 + kstep; const char* b3 = b2 + kstep;
            if (last && has_next) S.a_ready(nxt);
            if constexpr (SP2) {
            PG8_LDB(B0, 0, 0); PG8_LDB(B1, 0, 1); PG8_SCHED; PG8_LDA(At, 0, 0); PG8_STAGE(PG8_SA(1, 1), a1 + hstep, voffA);
            PG8_WAIT_V(8); PG8_WAIT_L(0); PG8_BAR; PG8_MMA(0, 0, At, B0); PG8_MMA(0, 1, At, B1); PG8_BAR; PG8_SCHED;
            PG8_LDA(At, 0, 1); PG8_STAGE(PG8_SB(0, 0), b2, voffB); PG8_STAGE(PG8_SB(0, 1), b2 + hstep, voffB); PG8_STAGE(PG8_SA(0, 0), a2, voffA);
            PG8_WAIT_V(8); PG8_WAIT_L(0); PG8_BAR; PG8_MMA(1, 0, At, B0); PG8_MMA(1, 1, At, B1); PG8_BAR; PG8_SCHED;
            PG8_LDB(B0, 1, 0); PG8_LDB(B1, 1, 1); PG8_SCHED; PG8_LDA(At, 1, 0); PG8_STAGE(PG8_SA(0, 1), a2 + hstep, voffA);
            PG8_WAIT_V(8); PG8_WAIT_L(0); PG8_BAR; PG8_MMA(0, 0, At, B0); PG8_MMA(0, 1, At, B1); PG8_BAR; PG8_SCHED;
            PG8_LDA(At, 1, 1); PG8_STAGE(PG8_SB(1, 0), b3, voffB); PG8_STAGE(PG8_SB(1, 1), b3 + hstep, voffB); PG8_STAGE(PG8_SA(1, 0), a3, voffA);
            PG8_WAIT_V(8); PG8_WAIT_L(0); PG8_BAR; PG8_MMA(1, 0, At, B0); PG8_MMA(1, 1, At, B1); PG8_BAR; PG8_SCHED;
            } else {
            PG8_LDB(B0, 0, 0); PG8_SCHED; PG8_LDA(At, 0, 0); PG8_STAGE(PG8_SA(1, 1), a1 + hstep, voffA);
            PG8_WAIT_L(8); PG8_BAR; PG8_WAIT_L(0); PG8_MMA(0, 0, At, B0); PG8_BAR; PG8_SCHED;
            PG8_LDB(B1, 0, 1); PG8_STAGE(PG8_SB(0, 0), b2, voffB);
            PG8_BAR; PG8_WAIT_L(0); PG8_MMA(0, 1, At, B1); PG8_BAR;
            PG8_LDA(At, 0, 1); PG8_STAGE(PG8_SA(0, 0), a2, voffA);
            PG8_BAR; PG8_WAIT_L(0); PG8_MMA(1, 0, At, B0); PG8_BAR; PG8_SCHED;
            PG8_STAGE(PG8_SB(0, 1), b2 + hstep, voffB);
            PG8_WAIT_V(6); PG8_BAR; PG8_MMA(1, 1, At, B1); PG8_BAR;
            PG8_LDB(B0, 1, 0); PG8_SCHED; PG8_LDA(At, 1, 0); PG8_STAGE(PG8_SA(0, 1), a2 + hstep, voffA);
            PG8_WAIT_L(8); PG8_BAR; PG8_WAIT_L(0); PG8_MMA(0, 0, At, B0); PG8_BAR; PG8_SCHED;
            PG8_LDB(B1, 1, 1); PG8_STAGE(PG8_SB(1, 0), b3, voffB);
            PG8_BAR; PG8_WAIT_L(0); PG8_MMA(0, 1, At, B1); PG8_BAR;
            PG8_LDA(At, 1, 1); PG8_STAGE(PG8_SA(1, 0), a3, voffA);
            PG8_BAR; PG8_WAIT_L(0); PG8_MMA(1, 0, At, B0); PG8_BAR; PG8_SCHED;
            PG8_STAGE(PG8_SB(1, 1), b3 + hstep, voffB);
            PG8_WAIT_V(6); PG8_BAR; PG8_MMA(1, 1, At, B1); PG8_BAR;
            }
        }
        if constexpr (FP8W != 0u) asm volatile("s_nop 15\n\ts_nop 15" ::: "memory");
        if constexpr (ALIGN_EPI) { if (wr == 0) PG8_BAR; }
        if constexpr (!Epi::AFTER_DRAIN) { E(acc, cur, wr, wc, fr, fq); S.done(cur); }
        if (!has_next) break;
#pragma unroll
        for (int a = 0; a < 2; ++a)
#pragma unroll
            for (int b = 0; b < 2; ++b)
#pragma unroll
                for (int m = 0; m < 4; ++m)
#pragma unroll
                    for (int n = 0; n < 2; ++n) acc[a][b][m][n] = (f32x4){0.f, 0.f, 0.f, 0.f};
        cur = nxt; cA = nA; cB = nB; ++ui;
        if constexpr (ALIGN_EPI) { if (wr == 1) PG8_BAR; }
    }
    PG8_WAIT_V(0);
    if constexpr (!ALIGN_EPI) { if (wr == 0) PG8_BAR; }
    PG8_BAR;
    if constexpr (Epi::AFTER_DRAIN) { E.fused(acc, cur, wr, wc, fr, fq, lds, wid, lane); S.done(cur); }
#undef PG8_SA
#undef PG8_SB
#undef PG8_STAGE
#undef PG8_LDA
#undef PG8_CAT
#undef PG8_LDB
#undef PG8_MMA
#undef PG8_WAIT_V
#undef PG8_WAIT_L
#undef PG8_BAR
#undef PG8_SCHED
}
}

constexpr int NWAVES = 8, NTHREADS = 512;
constexpr int BATCH = 2, SEQ = 8192, M = BATCH * SEQ, D = 1024;
constexpr int NEXP = 32, DEXP = 1024;
constexpr int PMAX = M * 4 + NEXP * 256, NTMAX = PMAX / 256;
constexpr float ALPHA = 1.41421356237f;
constexpr int NPHASES = 21;
#ifndef MOE_FP8
#define MOE_FP8 1
#endif
constexpr bool kMoeFp8 = (MOE_FP8 != 0);
constexpr unsigned kScaleGU = 0x79797979u, kScaleDN = 0x78787878u;
#ifndef MK_N_LAUNCHES
#define MK_N_LAUNCHES 1
#endif
constexpr int N_LAUNCHES = MK_N_LAUNCHES;

enum { I_X = 0, I_P, I_AB_WIN, I_AB_QG, I_AB_KVG, I_AB_WUQ, I_AB_WUK, I_AB_WUV, I_AB_WQIDX, I_AB_KIG, I_AB_KIB, I_AB_CONVW, I_AB_ALOG, I_AB_DTB, I_AB_ONG, I_AB_WOUT,
       I_CD_WIN, I_CD_POOLW, I_CD_POOLS, I_CD_WOUT, I_LNM_G, I_LNM_B, I_RW, I_RB, I_WGU, I_BGU, I_WDN, I_BDN, I_PLE_WP, I_PLE_WG, I_LNF_G, I_LNF_B, N_IN };

constexpr size_t MiB = 1u << 20;
constexpr size_t WS_CTL = 0, CTL_ZERO_BYTES = 1 * MiB;
constexpr size_t WS_W_INAB = 1 * MiB;
constexpr size_t WS_W_ABS = 6 * MiB;
constexpr size_t WS_W_OUTAB = 7 * MiB;
constexpr size_t WS_W_INCD = 10 * MiB;
constexpr size_t WS_W_OUTCD = 15 * MiB;
constexpr size_t WS_W_PG = 17 * MiB;
constexpr size_t WS_W_PP = 21 * MiB;
constexpr size_t WS_W_GU = 22 * MiB;
constexpr size_t WS_W_DN = 278 * MiB;
constexpr size_t WS_XB = 406 * MiB;
constexpr size_t WS_PB = 438 * MiB;
constexpr size_t WS_PP = 454 * MiB;
constexpr size_t WS_SM = 518 * MiB;
constexpr size_t WS_QKVZ = 550 * MiB;
constexpr size_t WS_CQ = 630 * MiB;
constexpr size_t WS_CKV = 638 * MiB;
constexpr size_t WS_KIDX = 642 * MiB;
constexpr size_t WS_WIDX = 644 * MiB;
constexpr size_t WS_BETA = 645 * MiB;
constexpr size_t WS_GG = WS_BETA + 512 * 1024;
constexpr size_t WS_QN = 646 * MiB, WS_KN = 662 * MiB, WS_VN = 678 * MiB;
constexpr size_t WS_QL = 694 * MiB;
constexpr size_t WS_CHK = 742 * MiB;
constexpr size_t WS_SEL = 838 * MiB;
constexpr size_t WS_NSEL = 854 * MiB;
constexpr size_t WS_ODELTA = 855 * MiB;
constexpr size_t WS_AO = 887 * MiB;
constexpr size_t WS_PRE = 935 * MiB;
constexpr size_t WS_H1 = 999 * MiB;
constexpr size_t WS_H2 = 1063 * MiB;
constexpr size_t WS_H1B = 1127 * MiB;
constexpr size_t WS_PLE = 1159 * MiB;
constexpr size_t WS_ROUTE = 1191 * MiB;
constexpr size_t WS_BIG = 1193 * MiB;
constexpr size_t WS_XS = WS_BIG, WS_HID = WS_BIG + 144 * MiB, WS_YS = WS_BIG + 288 * MiB;
constexpr size_t WS_END = WS_BIG + 512 * MiB;
static_assert((size_t)PMAX * 1024 * 2 <= 144 * MiB && WS_END <= 2048 * MiB, "d_ws map");
constexpr size_t CHK_WP = 0, CHK_QD = 16384, CHK_KDT = 32768, CHK_QK = 49152, CHK_UT = 57344, CHK_GL = 90112, CHK_STRIDE = 92160;
static_assert(CHK_STRIDE * 1024 <= 96 * MiB, "chunk operands");
constexpr int CW_TMO = 0, CW_CODE = 1;
constexpr int CW_BAR = 4096;
constexpr int CW_BAR2 = 8192;
constexpr int CW_CNT = 16384;

constexpr int RING_OFF = 0, RING_BYTES = 131072;
constexpr int WSCR_OFF = 132096, WSCR_BYTES = 1024;
constexpr int MISC_OFF = 140288;
constexpr int LDS_BYTES = 147456;

#define GAS __attribute__((address_space(1)))
#define LAS __attribute__((address_space(3)))
typedef unsigned short bf16;
typedef unsigned v4u __attribute__((ext_vector_type(4)));
typedef unsigned v2u __attribute__((ext_vector_type(2)));
typedef float f32x4 __attribute__((ext_vector_type(4)));
typedef short bf16x8 __attribute__((ext_vector_type(8)));
typedef GAS unsigned gu32;
#define RLX_AGENT __ATOMIC_RELAXED, __HIP_MEMORY_SCOPE_AGENT
typedef float f32x2_t __attribute__((ext_vector_type(2)));
typedef __bf16 bf16x2_t __attribute__((ext_vector_type(2)));
__device__ __forceinline__ unsigned pk2(float lo, float hi) { const f32x2_t v = {lo, hi}; const bf16x2_t b = __builtin_convertvector(v, bf16x2_t); return __builtin_bit_cast(unsigned, b); }
__device__ __forceinline__ unsigned f2bf(float f) { return pk2(f, 0.f) & 0xffffu; }
__device__ __forceinline__ float bflo(unsigned w) { return __uint_as_float(w << 16); }
__device__ __forceinline__ float bfhi(unsigned w) { return __uint_as_float(w & 0xffff0000u); }
__device__ __forceinline__ float bf1(bf16 h) { return __uint_as_float(((unsigned)h) << 16); }
__device__ __forceinline__ float sigm(float x) { return __builtin_amdgcn_rcpf(1.0f + __builtin_amdgcn_exp2f(x * -1.4426950408889634f)); }
__device__ __forceinline__ float siluf(float x) { return x * __builtin_amdgcn_rcpf(1.0f + __builtin_amdgcn_exp2f(x * -1.4426950408889634f)); }
__device__ __forceinline__ float wave_sum(float v) {
#pragma unroll
    for (int o = 1; o < 64; o <<= 1) v += __shfl_xor(v, o);
    return v;
}
__device__ __forceinline__ float wave_max(float v) {
#pragma unroll
    for (int o = 1; o < 64; o <<= 1) v = fmaxf(v, __shfl_xor(v, o));
    return v;
}
__device__ __forceinline__ int wave_sum_i(int v) {
#pragma unroll
    for (int o = 1; o < 64; o <<= 1) v += __shfl_xor(v, o);
    return v;
}
__device__ __forceinline__ void unpack8(const v4u w, float (&f)[8]) { f[0] = bflo(w.x); f[1] = bfhi(w.x); f[2] = bflo(w.y); f[3] = bfhi(w.y); f[4] = bflo(w.z); f[5] = bfhi(w.z); f[6] = bflo(w.w); f[7] = bfhi(w.w); }
__device__ __forceinline__ v4u pack8f(const float (&f)[8]) { v4u w; w.x = pk2(f[0], f[1]); w.y = pk2(f[2], f[3]); w.z = pk2(f[4], f[5]); w.w = pk2(f[6], f[7]); return w; }

#define XB_TMO      128
#define XB_XCNT(j)  (256  + 64 * (j))
#define XB_XSUB(j)  (1280 + 64 * (j))
#define XB_XGEN(j)  (2304 + 64 * (j))
#define XB_TOP      3328
#define XB_TOPGEN   3392
#define XCD_BAR_WORDS 3456
#define XB_SPIN_CAP (1u << 18)

__device__ __forceinline__ unsigned xb_ld(unsigned* p)              { return __hip_atomic_load(p, __ATOMIC_RELAXED, __HIP_MEMORY_SCOPE_AGENT); }
__device__ __forceinline__ unsigned xb_add(unsigned* p, unsigned v) { return __hip_atomic_fetch_add(p, v, __ATOMIC_RELAXED, __HIP_MEMORY_SCOPE_AGENT); }
__device__ __forceinline__ unsigned xb_xcc_id() { return (unsigned)__builtin_amdgcn_s_getreg((3 << 11) | 20) & 0xFu; }
#define XB_SPIN(cond, bar) do { unsigned _sp = 0; while (cond) { __builtin_amdgcn_s_sleep(1); \
    if ((++_sp & 255u) == 0u) { if (xb_ld(&(bar)[XB_TMO])) break; if (_sp > XB_SPIN_CAP) { atomicAdd(&(bar)[XB_TMO], 1u); break; } } } } while (0)

struct XcdBarrier {
    unsigned* bar; unsigned x;
    unsigned expect;
    volatile LAS unsigned* st;
};

__device__ __forceinline__ XcdBarrier xcd_barrier_post(unsigned* bar, volatile LAS unsigned* st, unsigned expect = 0u) {
    XcdBarrier b; b.bar = bar; b.x = xb_xcc_id(); b.st = st; b.expect = expect ? expect : gridDim.x * gridDim.y * gridDim.z;
    if (threadIdx.x == 0) (void)xb_add(&bar[XB_XCNT(b.x)], 1u);
    return b;
}
__device__ __forceinline__ void xcd_barrier_complete(unsigned* bar, unsigned x, unsigned& nloc, unsigned& nx, const unsigned G) {
    unsigned sum, cnt, mine, sp = 0u;
    for (;;) {
        sum = 0u; cnt = 0u; mine = 0u;
#pragma unroll
        for (unsigned j = 0; j < 16; ++j) { const unsigned c = xb_ld(&bar[XB_XCNT(j)]); sum += c; cnt += (c > 0u) ? 1u : 0u; mine = (j == x) ? c : mine; }
        if (sum == G) break;
        __builtin_amdgcn_s_sleep(1);
        if ((++sp & 255u) == 0u) { if (xb_ld(&bar[XB_TMO])) break; if (sp > XB_SPIN_CAP) { atomicAdd(&bar[XB_TMO], 1u); break; } }
    }
    nloc = mine > 0u ? mine : 1u; nx = cnt > 0u ? cnt : 1u;
}

__device__ __forceinline__ void xcd_barrier(const XcdBarrier& b) {
    asm volatile("s_waitcnt vmcnt(0)" ::: "memory");
    __syncthreads();
    if (threadIdx.x == 0) {
        unsigned* bar = b.bar;
        __builtin_amdgcn_s_waitcnt(0);
        unsigned nloc = b.st[0], nx = b.st[1];
        if (nloc == 0u) { xcd_barrier_complete(bar, b.x, nloc, nx, b.expect); b.st[0] = nloc; b.st[1] = nx; }
        const unsigned old = xb_add(&bar[XB_XSUB(b.x)], 1u);
        const unsigned gen = old / nloc;
        if (old + 1u == (gen + 1u) * nloc) {
            __builtin_amdgcn_fence(__ATOMIC_RELEASE, "agent");
            asm volatile("s_waitcnt vmcnt(0)" ::: "memory");
            const unsigned og = xb_add(&bar[XB_TOP], 1u);
            const unsigned tg = og / nx;
            if (og + 1u == (tg + 1u) * nx) xb_add(&bar[XB_TOPGEN], 1u);
            else XB_SPIN(xb_ld(&bar[XB_TOPGEN]) == tg, bar);
            __builtin_amdgcn_fence(__ATOMIC_ACQUIRE, "agent");
            xb_add(&bar[XB_XGEN(b.x)], 1u);
            asm volatile("s_waitcnt vmcnt(0)" ::: "memory");
        } else {
            XB_SPIN(xb_ld(&bar[XB_XGEN(b.x)]) == gen, bar);
            __builtin_amdgcn_fence(__ATOMIC_ACQUIRE, "agent");
            asm volatile("s_waitcnt vmcnt(0)" ::: "memory");
        }
    }
    __syncthreads();
}

struct Args { const float* in[N_IN]; float* out; unsigned char* ws; int ph_lo, ph_hi, li, pad; };
typedef const __attribute__((address_space(4))) Args* KArgs;
__device__ __forceinline__ KArgs kargs() { auto p = __builtin_amdgcn_kernarg_segment_ptr(); asm volatile("" : "+s"(p)); return (KArgs)p; }
struct Frame {
    LAS unsigned char* lds;
    int tid, lane, wave, G, bid;
    unsigned char* ws;
    gu32* ctl;
};
#define WSP(T, off) ((T*)(F.ws + (off)))

struct MapId { __device__ __forceinline__ int operator()(int n) const { return n; } };
struct MapAdd { int off; __device__ __forceinline__ int operator()(int n) const { return n + off; } };
struct MapAB { __device__ __forceinline__ int operator()(int n) const { return n < 456 ? n : (n < 2504 ? n + 56 : n - 2048); } };
template <class Map> __device__ __forceinline__ void wg_transpose_item(const float* W, int N, int ldw, bf16* WT, int ldt, int koff, Map map, LAS float* scr, int item, int tid) {
    const int nblk = (N + 127) >> 7, kb = item / nblk, nb = item - kb * nblk, k0 = kb * 128, n0 = nb * 128;
#pragma unroll
    for (int it = 0; it < 8; ++it) {
        const int row = it * 16 + (tid >> 5), c4 = (tid & 31) * 4, n = n0 + c4;
        f32x4 v = (f32x4){0.f, 0.f, 0.f, 0.f};
        if (n + 3 < N) v = *(const f32x4*)(W + (size_t)(k0 + row) * ldw + n);
        LAS float* s = scr + row * 129 + c4; s[0] = v[0]; s[1] = v[1]; s[2] = v[2]; s[3] = v[3];
    }
    __syncthreads();
#pragma unroll
    for (int j = 0; j < 4; ++j) {
        const int idx = j * 512 + tid, nl = idx >> 4, ch = idx & 15, n = n0 + nl;
        if (n < N) { const LAS float* s = scr + (ch * 8) * 129 + nl;
            v4u o; o.x = pk2(s[0], s[129]); o.y = pk2(s[2 * 129], s[3 * 129]); o.z = pk2(s[4 * 129], s[5 * 129]); o.w = pk2(s[6 * 129], s[7 * 129]);
            *(v4u*)(WT + (size_t)map(n) * ldt + koff + k0 + ch * 8) = o; }
    }
    __syncthreads();
}
__device__ __forceinline__ void wg_transpose_item_fp8(const float* W, int N, int ldw, unsigned char* WT, int ldt, float mul, LAS float* scr, int item, int tid) {
    const int nblk = (N + 127) >> 7, kb = item / nblk, nb = item - kb * nblk, k0 = kb * 128, n0 = nb * 128;
#pragma unroll
    for (int it = 0; it < 8; ++it) {
        const int row = it * 16 + (tid >> 5), c4 = (tid & 31) * 4;
        const f32x4 v = *(const f32x4*)(W + (size_t)(k0 + row) * ldw + n0 + c4);
        LAS float* s = scr + row * 129 + c4; s[0] = v[0]; s[1] = v[1]; s[2] = v[2]; s[3] = v[3];
    }
    __syncthreads();
#pragma unroll
    for (int j = 0; j < 2; ++j) {
        const int idx = j * 512 + tid, nl = idx >> 3, ch = idx & 7;
        const LAS float* s = scr + (ch * 16) * 129 + nl;
        v4u o;
#pragma unroll
        for (int q = 0; q < 4; ++q) { unsigned w = 0u;
            w = __builtin_amdgcn_cvt_pk_fp8_f32(s[(4 * q) * 129] * mul, s[(4 * q + 1) * 129] * mul, w, false);
            w = __builtin_amdgcn_cvt_pk_fp8_f32(s[(4 * q + 2) * 129] * mul, s[(4 * q + 3) * 129] * mul, w, true);
            o[q] = w; }
        *(v4u*)(WT + (size_t)(n0 + nl) * ldt + k0 + ch * 16) = o;
    }
    __syncthreads();
}
struct MoeItem { const float* W; unsigned char* WT; int N; float mul; int k0, n0; };
__device__ __forceinline__ MoeItem moe_item(KArgs A, unsigned char* ws, int it) {
    MoeItem d; int sub;
    if (it < 64 * 128) { const int m = it >> 7; sub = it & 127; d.W = A->in[I_WGU] + (size_t)m * 1024 * 2048; d.N = 2048; d.WT = ws + WS_W_GU + (size_t)m * 2048 * 1024; d.mul = 64.0f; }
    else { it -= 64 * 128; const int m = it >> 6; sub = it & 63; d.W = A->in[I_WDN] + (size_t)m * 1024 * 1024; d.N = 1024; d.WT = ws + WS_W_DN + (size_t)m * 1024 * 1024; d.mul = 128.0f; }
    const int nblk = d.N >> 7, kb = sub / nblk, nb = sub - kb * nblk; d.k0 = kb * 128; d.n0 = nb * 128; return d;
}
__device__ __forceinline__ void p0_moe_fp8(Frame& F, KArgs A) {
    LAS float* scr = (LAS float*)(F.lds + RING_OFF);
    const int tid = F.tid; constexpr int NIT = 64 * 128 + 64 * 64;
    int it = F.bid; if (it >= NIT) return;
    MoeItem cur = moe_item(A, F.ws, it);
    f32x4 r[8];
#pragma unroll
    for (int x = 0; x < 8; ++x) r[x] = __builtin_nontemporal_load((const f32x4*)(cur.W + (size_t)(cur.k0 + x * 16 + (tid >> 5)) * cur.N + cur.n0 + (tid & 31) * 4));
    for (;;) {
#pragma unroll
        for (int x = 0; x < 8; ++x) { LAS float* sp = scr + (x * 16 + (tid >> 5)) * 129 + (tid & 31) * 4; sp[0] = r[x][0]; sp[1] = r[x][1]; sp[2] = r[x][2]; sp[3] = r[x][3]; }
        __syncthreads();
        const int nx = it + F.G; MoeItem nxt = cur;
        if (nx < NIT) { nxt = moe_item(A, F.ws, nx);
#pragma unroll
            for (int x = 0; x < 8; ++x) r[x] = __builtin_nontemporal_load((const f32x4*)(nxt.W + (size_t)(nxt.k0 + x * 16 + (tid >> 5)) * nxt.N + nxt.n0 + (tid & 31) * 4)); }
#pragma unroll
        for (int j = 0; j < 2; ++j) {
            const int idx = j * 512 + tid, nl = idx >> 3, ch = idx & 7;
            const LAS float* sp = scr + (ch * 16) * 129 + nl;
            v4u o;
#pragma unroll
            for (int q = 0; q < 4; ++q) { unsigned w = 0u;
                w = __builtin_amdgcn_cvt_pk_fp8_f32(sp[(4 * q) * 129] * cur.mul, sp[(4 * q + 1) * 129] * cur.mul, w, false);
                w = __builtin_amdgcn_cvt_pk_fp8_f32(sp[(4 * q + 2) * 129] * cur.mul, sp[(4 * q + 3) * 129] * cur.mul, w, true);
                o[q] = w; }
            *(v4u*)(cur.WT + (size_t)(cur.n0 + nl) * 1024 + cur.k0 + ch * 16) = o;
        }
        __syncthreads();
        if (nx >= NIT) break;
        cur = nxt; it = nx;
    }
}
__device__ __forceinline__ void p0_prologue(Frame& F, KArgs A) {
    LAS float* scr = (LAS float*)(F.lds + RING_OFF);
    const int tid = F.tid;
    constexpr int IT_GU = 128, IT_DN = 64;
    constexpr int N_GU = 64 * IT_GU, N_DN = 64 * IT_DN;
    constexpr int N_INAB = 8 * 20, N_INCD = 8 * 20, N_OUTCD = 64, N_PG = 2 * 64, N_PP = 2 * 2 * 8, N_QIDX = 2 * 4, N_OUTB = 4 * 8;
    constexpr int NITEMS = N_GU + N_DN + N_INAB + N_INCD + N_OUTCD + N_PG + N_PP + N_QIDX + N_OUTB;
    if (kMoeFp8) p0_moe_fp8(F, A);
    for (int it = F.bid + (kMoeFp8 ? N_GU + N_DN : 0); it < NITEMS; it += F.G) {
        int r = it;
        if (r < N_GU) { const int m = r / IT_GU;
            if (kMoeFp8) wg_transpose_item_fp8(A->in[I_WGU] + (size_t)m * 1024 * 2048, 2048, 2048, WSP(unsigned char, WS_W_GU) + (size_t)m * 2048 * 1024, 1024, 64.0f, scr, r % IT_GU, tid);
            else wg_transpose_item(A->in[I_WGU] + (size_t)m * 1024 * 2048, 2048, 2048, WSP(bf16, WS_W_GU) + (size_t)m * 2048 * 1024, 1024, 0, MapId{}, scr, r % IT_GU, tid);
            continue; } r -= N_GU;
        if (r < N_DN) { const int m = r / IT_DN;
            if (kMoeFp8) wg_transpose_item_fp8(A->in[I_WDN] + (size_t)m * 1024 * 1024, 1024, 1024, WSP(unsigned char, WS_W_DN) + (size_t)m * 1024 * 1024, 1024, 128.0f, scr, r % IT_DN, tid);
            else wg_transpose_item(A->in[I_WDN] + (size_t)m * 1024 * 1024, 1024, 1024, WSP(bf16, WS_W_DN) + (size_t)m * 1024 * 1024, 1024, 0, MapId{}, scr, r % IT_DN, tid);
            continue; } r -= N_DN;
        if (r < N_INAB) { wg_transpose_item(A->in[I_AB_WIN], 2512, 2512, WSP(bf16, WS_W_INAB), 1024, 0, MapAB{}, scr, r, tid); continue; } r -= N_INAB;
        if (r < N_INCD) { wg_transpose_item(A->in[I_CD_WIN], 2560, 2560, WSP(bf16, WS_W_INCD), 1024, 0, MapId{}, scr, r, tid); continue; } r -= N_INCD;
        if (r < N_OUTCD) { wg_transpose_item(A->in[I_CD_WOUT], 1024, 1024, WSP(bf16, WS_W_OUTCD), 1024, 0, MapId{}, scr, r, tid); continue; } r -= N_OUTCD;
        if (r < N_PG) { const int l = r / 64; wg_transpose_item(A->in[I_PLE_WG] + (size_t)l * 1024 * 1024, 1024, 1024, WSP(bf16, WS_W_PG) + (size_t)l * 1024 * 1024, 1024, 0, MapId{}, scr, r % 64, tid); continue; } r -= N_PG;
        if (r < N_PP) { const int l = r / 16; wg_transpose_item(A->in[I_PLE_WP] + (size_t)l * 256 * 1024, 1024, 1024, WSP(bf16, WS_W_PP) + (size_t)l * 1024 * 256, 256, 0, MapId{}, scr, r % 16, tid); continue; } r -= N_PP;
        if (r < N_QIDX) { wg_transpose_item(A->in[I_AB_WQIDX], 512, 512, WSP(bf16, WS_W_ABS), 256, 0, MapAdd{1024}, scr, r, tid); continue; } r -= N_QIDX;
        wg_transpose_item(A->in[I_AB_WOUT] + (size_t)512 * 1024, 1024, 1024, WSP(bf16, WS_W_OUTAB), 1536, 1024, MapId{}, scr, r, tid);
    }
    const size_t gt = (size_t)F.bid * NTHREADS + tid, GT = (size_t)F.G * NTHREADS;
    for (size_t i = gt; i < (size_t)48 * 1024 / 8; i += GT) *(v4u*)(WSP(bf16, WS_W_INAB) + (size_t)464 * 1024 + i * 8) = (v4u){0u, 0u, 0u, 0u};
    for (size_t i = gt; i < (size_t)1024 * 256; i += GT) {
        const int n = (int)(i >> 8), c = (int)(i & 255), h = n >> 7, r = n & 127;
        const float* a = A->in[I_AB_WUQ] + (size_t)c * 512 + h * 64; const float* b = A->in[I_AB_WUK] + (size_t)r * 512 + h * 64;
        float s = 0.f;
#pragma unroll 8
        for (int d = 0; d < 64; d += 4) { const f32x4 x = *(const f32x4*)(a + d), y = *(const f32x4*)(b + d); s += x[0] * y[0] + x[1] * y[1] + x[2] * y[2] + x[3] * y[3]; }
        WSP(bf16, WS_W_ABS)[i] = (bf16)f2bf(s * 0.125f);
    }
    for (size_t i = gt; i < (size_t)1024 * 128; i += GT) {
        const int n = (int)(i & 1023), k0 = (int)(i >> 10) * 8, h = k0 >> 7, r0 = k0 & 127;
        const float* bcol = A->in[I_AB_WOUT] + (size_t)(h * 64) * 1024 + n;
        float acc[8];
#pragma unroll
        for (int x = 0; x < 8; ++x) acc[x] = 0.f;
#pragma unroll 2
        for (int v0 = 0; v0 < 64; v0 += 8) {
            float bv[8];
#pragma unroll
            for (int v = 0; v < 8; ++v) bv[v] = bcol[(size_t)(v0 + v) * 1024];
#pragma unroll
            for (int x = 0; x < 8; ++x) { const float* ar = A->in[I_AB_WUV] + (size_t)(r0 + x) * 512 + h * 64 + v0; const f32x4 a0 = *(const f32x4*)ar, a1 = *(const f32x4*)(ar + 4);
                acc[x] += a0[0] * bv[0] + a0[1] * bv[1] + a0[2] * bv[2] + a0[3] * bv[3] + a1[0] * bv[4] + a1[1] * bv[5] + a1[2] * bv[6] + a1[3] * bv[7]; }
        }
        *(v4u*)(WSP(bf16, WS_W_OUTAB) + (size_t)n * 1536 + k0) = pack8f(acc);
    }
#pragma unroll 4
    for (size_t i = gt; i < (size_t)M * D / 8; i += GT) { const f32x4 a = __builtin_nontemporal_load((const f32x4*)(A->in[I_X] + i * 8)), b = __builtin_nontemporal_load((const f32x4*)(A->in[I_X] + i * 8 + 4));
        v4u o; o.x = pk2(a[0], a[1]); o.y = pk2(a[2], a[3]); o.z = pk2(b[0], b[1]); o.w = pk2(b[2], b[3]); *(v4u*)(WSP(bf16, WS_XB) + i * 8) = o; }
#pragma unroll 4
    for (size_t i = gt; i < (size_t)2 * M * 256 / 8; i += GT) { const f32x4 a = __builtin_nontemporal_load((const f32x4*)(A->in[I_P] + i * 8)), b = __builtin_nontemporal_load((const f32x4*)(A->in[I_P] + i * 8 + 4));
        v4u o; o.x = pk2(a[0], a[1]); o.y = pk2(a[2], a[3]); o.z = pk2(b[0], b[1]); o.w = pk2(b[2], b[3]); *(v4u*)(WSP(bf16, WS_PB) + i * 8) = o; }
}

__device__ __forceinline__ void p2_prep(Frame& F, KArgs A) {
    const int lane = F.lane, gw = F.bid * NWAVES + F.wave, NGW = F.G * NWAVES;
    const float* SM = WSP(float, WS_SM); const bf16* QZ = WSP(bf16, WS_QKVZ);
    const f32x4 qg = *(const f32x4*)(A->in[I_AB_QG] + 4 * lane);
    const f32x4 kvg = *(const f32x4*)(A->in[I_AB_KVG] + 4 * (lane & 31));
    const f32x4 kig = *(const f32x4*)(A->in[I_AB_KIG] + 4 * (lane & 15)), kib = *(const f32x4*)(A->in[I_AB_KIB] + 4 * (lane & 15));
    const f32x4 alog = *(const f32x4*)(A->in[I_AB_ALOG]), dtb = *(const f32x4*)(A->in[I_AB_DTB]);
    LAS float* cw = (LAS float*)(F.lds);
    {   f32x4 wv[3]; int t0 = F.tid; asm volatile("" : "+v"(t0));
#pragma unroll
        for (int j = 0; j < 3; ++j) wv[j] = *(const f32x4*)(A->in[I_AB_CONVW] + (size_t)(t0 + NTHREADS * j) * 4);
#pragma unroll
        for (int j = 0; j < 3; ++j) *(LAS f32x4*)(cw + (t0 + NTHREADS * j) * 4) = wv[j];
    }
    __syncthreads();
    for (int row = gw; row < M; row += NGW) {
        const int t = row & (SEQ - 1);
        const f32x4 a = *(const f32x4*)(SM + (size_t)row * 512 + 4 * lane), b = *(const f32x4*)(SM + (size_t)row * 512 + 256 + 4 * lane);
        {
            const float ss = wave_sum(a[0] * a[0] + a[1] * a[1] + a[2] * a[2] + a[3] * a[3]);
            const float r = rsqrtf(ss * (1.0f / 256.0f) + 1e-6f);
            v2u o; o.x = pk2(a[0] * r * qg[0], a[1] * r * qg[1]); o.y = pk2(a[2] * r * qg[2], a[3] * r * qg[3]);
            *(v2u*)(WSP(bf16, WS_CQ) + (size_t)row * 256 + 4 * lane) = o;
        }
        {
            const float ss = wave_sum(lane < 32 ? (b[0] * b[0] + b[1] * b[1] + b[2] * b[2] + b[3] * b[3]) : 0.f);
            const float r = rsqrtf(ss * (1.0f / 128.0f) + 1e-6f);
            if (lane < 32) { v2u o; o.x = pk2(b[0] * r * kvg[0], b[1] * r * kvg[1]); o.y = pk2(b[2] * r * kvg[2], b[3] * r * kvg[3]);
                *(v2u*)(WSP(bf16, WS_CKV) + (size_t)row * 128 + 4 * lane) = o; }
        }
        {
            const bool in = (lane >= 32 && lane < 48);
            const float mean = wave_sum(in ? (b[0] + b[1] + b[2] + b[3]) : 0.f) * (1.0f / 64.0f);
            const f32x4 d = b - mean;
            const float var = wave_sum(in ? (d[0] * d[0] + d[1] * d[1] + d[2] * d[2] + d[3] * d[3]) : 0.f) * (1.0f / 64.0f);
            const float r = rsqrtf(var + 1e-5f);
            if (in) { v2u o; o.x = pk2(d[0] * r * kig[0] + kib[0], d[1] * r * kig[1] + kib[1]); o.y = pk2(d[2] * r * kig[2] + kib[2], d[3] * r * kig[3] + kib[3]);
                *(v2u*)(WSP(bf16, WS_KIDX) + (size_t)row * 64 + 4 * (lane - 32)) = o; }
        }
        if (lane == 48 || lane == 49) *(f32x4*)(WSP(float, WS_WIDX) + (size_t)row * 8 + 4 * (lane - 48)) = b * 0.044194173824159216f;
        if (lane == 50) { f32x4 o; o[0] = sigm(b[0]); o[1] = sigm(b[1]); o[2] = sigm(b[2]); o[3] = sigm(b[3]); *(f32x4*)(WSP(float, WS_BETA) + (size_t)row * 4) = o; }
        if (lane == 51) { f32x4 o;
#pragma unroll
            for (int h = 0; h < 4; ++h) { const float xx = b[h] + dtb[h]; const float sp = xx > 20.f ? xx : log1pf(__expf(xx)); o[h] = -__expf(alog[h]) * sp; }
            *(f32x4*)(WSP(float, WS_GG) + (size_t)row * 4) = o; }
        v4u xr[3][4];
#pragma unroll
        for (int sel = 0; sel < 3; ++sel)
#pragma unroll
            for (int j = 0; j < 4; ++j) { const int back = (t - 3 + j >= 0) ? (3 - j) : 0; xr[sel][j] = *(const v4u*)(QZ + (size_t)(row - back) * 2048 + sel * 512 + 8 * lane); }
#pragma unroll
        for (int sel = 0; sel < 3; ++sel) {
            const int col0 = sel * 512 + 8 * lane;
            float acc[8];
#pragma unroll
            for (int i = 0; i < 8; ++i) acc[i] = 0.f;
#pragma unroll
            for (int j = 0; j < 4; ++j) {
                float xv[8]; unpack8(xr[sel][j], xv);
                const f32x4 w0 = *(const LAS f32x4*)(cw + j * 1536 + col0), w1 = *(const LAS f32x4*)(cw + j * 1536 + col0 + 4);
                const float m = (t - 3 + j >= 0) ? 1.f : 0.f;
#pragma unroll
                for (int i = 0; i < 4; ++i) { acc[i] += w0[i] * m * xv[i]; acc[4 + i] += w1[i] * m * xv[4 + i]; }
            }
            float ss = 0.f;
#pragma unroll
            for (int i = 0; i < 8; ++i) { acc[i] = siluf(acc[i]); ss += acc[i] * acc[i]; }
            if (sel < 2) {
                ss += __shfl_xor(ss, 1); ss += __shfl_xor(ss, 2); ss += __shfl_xor(ss, 4); ss += __shfl_xor(ss, 8);
                const float sc = rsqrtf(ss + 1e-6f) * (sel == 0 ? 0.08838834764831845f : 1.0f);
#pragma unroll
                for (int i = 0; i < 8; ++i) acc[i] *= sc;
            }
            bf16* dst = (sel == 0 ? WSP(bf16, WS_QN) : (sel == 1 ? WSP(bf16, WS_KN) : WSP(bf16, WS_VN))) + (size_t)row * 512 + 8 * lane;
            *(v4u*)dst = pack8f(acc);
        }
    }
}

constexpr int SEQ_WGS = 16;
constexpr int SQ_WP = 0, SQ_QD = 16384, SQ_KDT = 32768, SQ_QK = 49152, SQ_BUF = 57344;
__device__ __forceinline__ bf16x8 packfrag(const f32x4 lo, const f32x4 hi) { v4u w; w.x = pg8::cvt_pk_bf16(lo[0], lo[1]); w.y = pg8::cvt_pk_bf16(lo[2], lo[3]); w.z = pg8::cvt_pk_bf16(hi[0], hi[1]); w.w = pg8::cvt_pk_bf16(hi[2], hi[3]); return __builtin_bit_cast(bf16x8, w); }
__device__ __forceinline__ void seq_load(v4u (&r)[14], const unsigned char* blk, int lt) {
#pragma unroll
    for (int i = 0; i < 14; ++i) r[i] = *(const v4u*)(blk + (size_t)(lt + 256 * i) * 16);
}
__device__ __forceinline__ void seq_write(LAS unsigned char* buf, const v4u (&r)[14], int lt) {
#pragma unroll
    for (int i = 0; i < 14; ++i) {
        const int id = lt + 256 * i; int dst;
        if (id < 2048) { const int rr = (id & 1023) >> 4, ch = id & 15; dst = (id & ~1023) * 16 + rr * 256 + 16 * (ch ^ (rr & 15)); }
        else { const int rr = (id - 2048) >> 3, ch = id & 7; dst = 32768 + rr * 128 + 16 * (ch ^ (rr & 7)); }
        *(LAS v4u*)(buf + dst) = r[i];
    }
}
__device__ __forceinline__ void seq_compute(LAS unsigned char* buf, f32x4 (&Sacc)[8], const f32x4 (&U)[4], const float gl, float* op0, const int fr, const int fq) {
    bf16x8 sf[4];
#pragma unroll
    for (int s = 0; s < 4; ++s) sf[s] = packfrag(Sacc[2 * s], Sacc[2 * s + 1]);
    f32x4 Vn[4], Oa[4];
#pragma unroll
    for (int tc = 0; tc < 4; ++tc) {
        const int rr = 16 * tc + fr; f32x4 av = (f32x4){0.f, 0.f, 0.f, 0.f}, ao = (f32x4){0.f, 0.f, 0.f, 0.f};
#pragma unroll
        for (int s = 0; s < 4; ++s) {
            const int off = rr * 256 + 16 * ((4 * s + fq) ^ (rr & 15));
            const bf16x8 wf = *(const LAS bf16x8*)(buf + SQ_WP + off), qf = *(const LAS bf16x8*)(buf + SQ_QD + off);
            av = __builtin_amdgcn_mfma_f32_16x16x32_bf16(wf, sf[s], av, 0, 0, 0);
            ao = __builtin_amdgcn_mfma_f32_16x16x32_bf16(qf, sf[s], ao, 0, 0, 0);
        }
        Vn[tc] = U[tc] - av; Oa[tc] = ao;
    }
    bf16x8 vf[2];
    vf[0] = packfrag(Vn[0], Vn[1]); vf[1] = packfrag(Vn[2], Vn[3]);
#pragma unroll
    for (int tc = 0; tc < 4; ++tc) {
        const int rr = 16 * tc + fr;
#pragma unroll
        for (int s = 0; s < 2; ++s) {
            const bf16x8 kf = *(const LAS bf16x8*)(buf + SQ_QK + rr * 128 + 16 * ((4 * s + fq) ^ (rr & 7)));
            Oa[tc] = __builtin_amdgcn_mfma_f32_16x16x32_bf16(kf, vf[s], Oa[tc], 0, 0, 0);
        }
        float* op = op0 + (size_t)(16 * tc) * 512;
#pragma unroll
        for (int j = 0; j < 4; ++j) op[(size_t)j * 512] = Oa[tc][j];
    }
#pragma unroll
    for (int T = 0; T < 8; ++T) {
        const int rr = 16 * T + fr; f32x4 a = Sacc[T] * gl;
#pragma unroll
        for (int s = 0; s < 2; ++s) {
            const bf16x8 kf = *(const LAS bf16x8*)(buf + SQ_KDT + rr * 128 + 16 * ((4 * s + fq) ^ (rr & 7)));
            a = __builtin_amdgcn_mfma_f32_16x16x32_bf16(kf, vf[s], a, 0, 0, 0);
        }
        Sacc[T] = a;
    }
}
#define SEQ_BAR() do { asm volatile("s_waitcnt lgkmcnt(0)" ::: "memory"); __builtin_amdgcn_s_barrier(); asm volatile("" ::: "memory"); } while (0)
__device__ __forceinline__ void p4_delta_seq(Frame& F, int sid) {
    const int lane = F.lane, wave = F.wave, tid = F.tid;
    const int bh = sid >> 1, half = sid & 1, b = bh >> 2, h = bh & 3;
    const int fr = lane & 15, fq = lane >> 4;
    const int v0 = half * 64 + (wave & 3) * 16;
    const unsigned char* cbase = F.ws + WS_CHK + (size_t)(bh * 128) * CHK_STRIDE;
    if (wave >= 4) {
        const int lt = tid - 256;
        v4u RA[14], RB[14];
#define SEQ_LD(R, blk) do { const unsigned char* _b = (blk); _Pragma("unroll") for (int _i = 0; _i < 14; ++_i) asm volatile("global_load_dwordx4 %0, %1, off" : "=v"(R[_i]) : "v"(_b + (size_t)(lt + 256 * _i) * 16) : "memory"); } while (0)
#define SEQ_WAIT(younger) do { if (younger) asm volatile("s_waitcnt vmcnt(14)" ::: "memory"); else asm volatile("s_waitcnt vmcnt(0)" ::: "memory"); } while (0)
        SEQ_LD(RA, cbase); SEQ_LD(RB, cbase + CHK_STRIDE); SEQ_WAIT(true); seq_write(F.lds, RA, lt); SEQ_LD(RA, cbase + 2 * CHK_STRIDE);
        SEQ_BAR();
#pragma unroll 1
        for (int n = 0; n < 128; n += 2) {
            if (n + 1 < 128) { SEQ_WAIT(n + 2 < 128); seq_write(F.lds + ((n + 1) & 1) * SQ_BUF, RB, lt); } if (n + 3 < 128) SEQ_LD(RB, cbase + (size_t)(n + 3) * CHK_STRIDE);
            SEQ_BAR();
            if (n + 2 < 128) { SEQ_WAIT(n + 3 < 128); seq_write(F.lds + (n & 1) * SQ_BUF, RA, lt); } if (n + 4 < 128) SEQ_LD(RA, cbase + (size_t)(n + 4) * CHK_STRIDE);
            SEQ_BAR();
        }
        asm volatile("s_waitcnt vmcnt(0)" ::: "memory");
#undef SEQ_LD
#undef SEQ_WAIT
    } else {
        float* OD = WSP(float, WS_ODELTA);
        f32x4 Sacc[8], Ucur[4], Unxt[4]; float glc, gln;
#pragma unroll
        for (int T = 0; T < 8; ++T) Sacc[T] = (f32x4){0.f, 0.f, 0.f, 0.f};
#pragma unroll
        for (int tc = 0; tc < 4; ++tc) { Ucur[tc] = *(const f32x4*)((const float*)(cbase + CHK_UT) + (size_t)(v0 + fr) * 64 + 4 * fq + 16 * tc);
                                          Unxt[tc] = *(const f32x4*)((const float*)(cbase + CHK_STRIDE + CHK_UT) + (size_t)(v0 + fr) * 64 + 4 * fq + 16 * tc); }
        glc = *(const float*)(cbase + CHK_GL); gln = *(const float*)(cbase + CHK_STRIDE + CHK_GL);
        SEQ_BAR();
#pragma unroll 1
        for (int n = 0; n < 128; ++n) {
            seq_compute(F.lds + (n & 1) * SQ_BUF, Sacc, Ucur, glc, OD + (size_t)(b * SEQ + n * 64 + 4 * fq) * 512 + h * 128 + v0 + fr, fr, fq);
#pragma unroll
            for (int tc = 0; tc < 4; ++tc) Ucur[tc] = Unxt[tc];
            glc = gln;
            if (n + 2 < 128) { const unsigned char* nb = cbase + (size_t)(n + 2) * CHK_STRIDE; gln = *(const float*)(nb + CHK_GL);
#pragma unroll
                for (int tc = 0; tc < 4; ++tc) Unxt[tc] = *(const f32x4*)((const float*)(nb + CHK_UT) + (size_t)(v0 + fr) * 64 + 4 * fq + 16 * tc); }
            SEQ_BAR();
        }
    }
}
#undef SEQ_BAR

__device__ __forceinline__ float relu1(float x) { return __builtin_amdgcn_fmed3f(x, 0.f, INFINITY); }
__device__ __forceinline__ void p4_indexer(Frame& F, int widx, int nw) {
    const int lane = F.lane, fr = lane & 15, fq = lane >> 4;
    const bf16* QL = WSP(bf16, WS_QL); const bf16* KI = WSP(bf16, WS_KIDX); const float* WI = WSP(float, WS_WIDX); float* SC = WSP(float, WS_BIG);
    for (int task = widx; task < 2 * 4352; task += nw) {
        const int b = task / 4352; int tau = task - b * 4352;
        int g = 0; while (16 * (g + 1) * (g + 2) <= tau) ++g;
        tau -= 16 * g * (g + 1);
        const int qt = 32 * g + tau / (g + 1), seg = tau % (g + 1);
        const int row0 = b * SEQ + 16 * qt;
        bf16x8 Qf[8][2];
#pragma unroll
        for (int hh = 0; hh < 8; ++hh)
#pragma unroll
            for (int s = 0; s < 2; ++s) Qf[hh][s] = *(const bf16x8*)(QL + (size_t)(row0 + fr) * 1536 + 1024 + hh * 64 + 32 * s + 8 * fq);
        const f32x4 w0 = *(const f32x4*)(WI + (size_t)(row0 + fr) * 8), w1 = *(const f32x4*)(WI + (size_t)(row0 + fr) * 8 + 4);
        const int kt1 = (32 * seg + 31 < qt) ? 32 * seg + 31 : qt;
        for (int kb8 = 32 * seg; kb8 <= kt1; kb8 += 8) {
            bf16x8 kfr[8][2];
#pragma unroll
            for (int x = 0; x < 8; ++x) { const int kt = (kb8 + x <= kt1) ? kb8 + x : kt1; const bf16* kp = KI + (size_t)(b * SEQ + 16 * kt + fr) * 64 + 8 * fq; kfr[x][0] = *(const bf16x8*)kp; kfr[x][1] = *(const bf16x8*)(kp + 32); }
#pragma unroll
            for (int x = 0; x < 8; ++x) asm volatile("" : "+v"(kfr[x][0]), "+v"(kfr[x][1]));
#pragma unroll
            for (int x = 0; x < 8; ++x) {
                const int kt = kb8 + x;
                if (kt <= kt1) {
                    f32x4 isc = (f32x4){0.f, 0.f, 0.f, 0.f}, c[8];
#pragma unroll
                    for (int hh = 0; hh < 8; ++hh) c[hh] = __builtin_amdgcn_mfma_f32_16x16x32_bf16(kfr[x][0], Qf[hh][0], (f32x4){0.f, 0.f, 0.f, 0.f}, 0, 0, 0);
#pragma unroll
                    for (int hh = 0; hh < 8; ++hh) c[hh] = __builtin_amdgcn_mfma_f32_16x16x32_bf16(kfr[x][1], Qf[hh][1], c[hh], 0, 0, 0);
                    __builtin_amdgcn_sched_barrier(0);
#pragma unroll
                    for (int hh = 0; hh < 8; ++hh) { const float wh = (hh < 4) ? w0[hh & 3] : w1[hh & 3];
#pragma unroll
                        for (int j = 0; j < 4; ++j) isc[j] += relu1(c[hh][j]) * wh; }
                    *(f32x4*)(SC + (size_t)(row0 + fr) * 8192 + 16 * kt + 4 * fq) = isc;
                }
            }
        }
    }
}

__device__ __forceinline__ void mask_ge8(unsigned long long (&m)[8], unsigned x0, unsigned x1, unsigned x2, unsigned x3, unsigned x4, unsigned x5, unsigned x6, unsigned x7, unsigned t) {
    asm("v_cmp_ge_u32_e64 %0, %8, %16\n\tv_cmp_ge_u32_e64 %1, %9, %16\n\tv_cmp_ge_u32_e64 %2, %10, %16\n\tv_cmp_ge_u32_e64 %3, %11, %16\n\t"
        "v_cmp_ge_u32_e64 %4, %12, %16\n\tv_cmp_ge_u32_e64 %5, %13, %16\n\tv_cmp_ge_u32_e64 %6, %14, %16\n\tv_cmp_ge_u32_e64 %7, %15, %16"
        : "=&s"(m[0]), "=&s"(m[1]), "=&s"(m[2]), "=&s"(m[3]), "=&s"(m[4]), "=&s"(m[5]), "=&s"(m[6]), "=&s"(m[7])
        : "v"(x0), "v"(x1), "v"(x2), "v"(x3), "v"(x4), "v"(x5), "v"(x6), "v"(x7), "s"(t));
}
__device__ __forceinline__ unsigned tk_key(float f) { const unsigned b = __float_as_uint(f); return (b & 0x80000000u) ? ~b : (b | 0x80000000u); }
__device__ __forceinline__ void topk_row_slow(const float* sr, const int n, const int lane, LAS int* sel) {
    const int nseg = (n + 63) >> 6;
    unsigned T = 0u;
    for (int bit = 31; bit >= 0; --bit) {
        const unsigned cnd = T | (1u << bit); int c = 0;
        for (int sg = 0; sg < nseg; ++sg) { const int idx = sg * 64 + lane; const unsigned x = (idx < n) ? tk_key(sr[idx < n ? idx : 0]) : 0u; c += __popcll(__ballot(x >= cnd)); }
        if (c >= 256) T = cnd;
    }
    int cgt = 0;
    for (int sg = 0; sg < nseg; ++sg) { const int idx = sg * 64 + lane; const unsigned x = (idx < n) ? tk_key(sr[idx < n ? idx : 0]) : 0u; cgt += __popcll(__ballot(x > T)); }
    const int need_eq = 256 - cgt; int running = 0, eq_taken = 0;
    const unsigned long long lt = (1ull << lane) - 1ull;
    for (int sg = 0; sg < nseg; ++sg) {
        const int idx = sg * 64 + lane; const unsigned x = (idx < n) ? tk_key(sr[idx < n ? idx : 0]) : 0u;
        const bool gt = x > T, eq = x == T;
        const unsigned long long meq = __ballot(eq);
        const bool take = gt || (eq && (eq_taken + __popcll(meq & lt)) < need_eq);
        const unsigned long long mt = __ballot(take);
        if (take) sel[running + __popcll(mt & lt)] = idx;
        running += __popcll(mt); eq_taken += __popcll(meq);
    }
}
constexpr int TK_CAP = 832;
__device__ __forceinline__ int topk_row(Frame& F, const int row, LAS int* sel, LAS unsigned long long* cand) {
    const int lane = F.lane;
    const float* SC = WSP(float, WS_BIG);
    {
        const int pos = row & (SEQ - 1), n = pos + 1;
        if (n <= 256) {
#pragma unroll
            for (int i = 0; i < 4; ++i) { const int j = 64 * i + lane; sel[j] = (j < n) ? j : 0; }
            return n;
        }
        const int nblk = (n + 1023) >> 10;
        const float* sr = SC + (size_t)row * 8192;
        int lane_l = lane; asm volatile("" : "+v"(lane_l));
        unsigned u[128];
#pragma unroll
        for (int i = 0; i < 64; ++i) u[i] = __float_as_uint((sr + (i >> 4) * 1024)[(i & 15) * 64 + lane_l]);
        if (nblk > 4) {
#pragma unroll
            for (int i = 64; i < 128; ++i) u[i] = __float_as_uint((sr + (i >> 4) * 1024)[(i & 15) * 64 + lane_l]);
        } else {
#pragma unroll
            for (int i = 64; i < 128; ++i) u[i] = 0u;
        }
        asm volatile("" ::: "memory");
#pragma unroll
        for (int i = 0; i < 128; ++i) { const int lim = n - i * 64; const unsigned bits = u[i];
            const unsigned x = (bits & 0x80000000u) ? ~bits : (bits | 0x80000000u);
            u[i] = (lane < lim) ? x : 0u; }
        const unsigned long long ltmask_s = (1ull << lane) - 1ull;
        bool done = false;
        {
            int ns = 0;
#pragma unroll
            for (int k = 0; k < 16; ++k) { int v = n - 512 * k; v = v < 0 ? 0 : (v > 64 ? 64 : v); ns += v; }
            const float mean = 256.0f * (float)ns / (float)n;
            const int rs = (int)(mean + 4.0f * sqrtf(mean) + 5.0f);
            unsigned Ts = 0u;
            for (int bit = 31; bit >= 16; --bit) {
                const unsigned cnd = Ts | (1u << bit); unsigned long long m0[8], m1[8];
                mask_ge8(m0, u[0], u[8], u[16], u[24], u[32], u[40], u[48], u[56], cnd); mask_ge8(m1, u[64], u[72], u[80], u[88], u[96], u[104], u[112], u[120], cnd);
                int c = 0;
#pragma unroll
                for (int i = 0; i < 8; ++i) c += __popcll(m0[i]) + __popcll(m1[i]);
                if (c >= rs) Ts = cnd;
            }
            if (Ts == 0u) Ts = 1u;
            int nc = 0;
#pragma unroll
            for (int bk = 0; bk < 8; ++bk) {
                if (bk < nblk) {
#pragma unroll
                    for (int g8 = 0; g8 < 2; ++g8) {
                        unsigned long long mg[8]; const int b0 = bk * 16 + g8 * 8;
                        mask_ge8(mg, u[b0], u[b0 + 1], u[b0 + 2], u[b0 + 3], u[b0 + 4], u[b0 + 5], u[b0 + 6], u[b0 + 7], Ts);
#pragma unroll
                        for (int i = 0; i < 8; ++i) {
                            const unsigned long long mt = mg[i];
                            if (mt != 0ull) {
                                const int off = nc + __popcll(mt & ltmask_s);
                                if (((mt >> lane) & 1ull) && off < TK_CAP) cand[off] = ((unsigned long long)u[b0 + i] << 32) | (unsigned)((b0 + i) * 64 + lane_l);
                                nc += __popcll(mt);
                            }
                        }
                    }
                }
            }
            if (nc >= 256 && nc <= TK_CAP) {
                unsigned ck[16]; int ci[13];
#pragma unroll
                for (int t = 0; t < 13; ++t) { const int j = lane + 64 * t; const unsigned long long e = (j < nc) ? cand[j] : 0ull; ck[t] = (unsigned)(e >> 32); ci[t] = (int)(unsigned)e; }
                ck[13] = 0u; ck[14] = 0u; ck[15] = 0u;
                unsigned T = 0u;
                for (int bit = 31; bit >= 0; --bit) {
                    const unsigned cnd = T | (1u << bit); unsigned long long m0[8], m1[8];
                    mask_ge8(m0, ck[0], ck[1], ck[2], ck[3], ck[4], ck[5], ck[6], ck[7], cnd); mask_ge8(m1, ck[8], ck[9], ck[10], ck[11], ck[12], ck[13], ck[14], ck[15], cnd);
                    int c = 0;
#pragma unroll
                    for (int i = 0; i < 8; ++i) c += __popcll(m0[i]) + __popcll(m1[i]);
                    if (c >= 256) T = cnd;
                }
                unsigned long long g0[8], g1[8], h0[8], h1[8];
                mask_ge8(g0, ck[0], ck[1], ck[2], ck[3], ck[4], ck[5], ck[6], ck[7], T); mask_ge8(g1, ck[8], ck[9], ck[10], ck[11], ck[12], ck[13], ck[14], ck[15], T);
                mask_ge8(h0, ck[0], ck[1], ck[2], ck[3], ck[4], ck[5], ck[6], ck[7], T + 1u); mask_ge8(h1, ck[8], ck[9], ck[10], ck[11], ck[12], ck[13], ck[14], ck[15], T + 1u);
                int cgt = 0;
#pragma unroll
                for (int t = 0; t < 13; ++t) cgt += __popcll(t < 8 ? h0[t & 7] : h1[t & 7]);
                const int need_eq = 256 - cgt;
                int running = 0, eq_taken = 0;
#pragma unroll
                for (int t = 0; t < 13; ++t) {
                    const unsigned long long mge = (t < 8 ? g0[t & 7] : g1[t & 7]), mgt = (t < 8 ? h0[t & 7] : h1[t & 7]);
                    unsigned long long mt = mge; const unsigned long long me = mge & ~mgt;
                    if (me != 0ull) {
                        const int room = need_eq - eq_taken; unsigned long long keep = 0ull, rest = me;
                        for (int k = 0; k < room && rest != 0ull; ++k) { const unsigned long long low = rest & (~rest + 1ull); keep |= low; rest ^= low; }
                        mt = (mge & ~me) | keep; eq_taken += __popcll(me);
                    }
                    if (mt != 0ull) { if ((mt >> lane) & 1ull) sel[running + __popcll(mt & ltmask_s)] = ci[t]; running += __popcll(mt); }
                }
                done = true;
            }
        }
        if (!done) topk_row_slow(sr, n, lane, sel);
    }
    return 256;
}

__device__ __forceinline__ void p6_gdn_out(Frame& F, KArgs A) {
    const int lane = F.lane, gw = F.bid * NWAVES + F.wave, NGW = F.G * NWAVES;
    const f32x4 g0 = *(const f32x4*)(A->in[I_AB_ONG] + 8 * (lane & 15)), g1 = *(const f32x4*)(A->in[I_AB_ONG] + 8 * (lane & 15) + 4);
    for (int row = gw; row < M; row += NGW) {
        const float* op = WSP(float, WS_ODELTA) + (size_t)row * 512 + 8 * lane;
        const f32x4 a = *(const f32x4*)op, b = *(const f32x4*)(op + 4);
        float ss = a[0] * a[0] + a[1] * a[1] + a[2] * a[2] + a[3] * a[3] + b[0] * b[0] + b[1] * b[1] + b[2] * b[2] + b[3] * b[3];
        ss += __shfl_xor(ss, 1); ss += __shfl_xor(ss, 2); ss += __shfl_xor(ss, 4); ss += __shfl_xor(ss, 8);
        const float r = rsqrtf(ss * (1.0f / 128.0f) + 1e-6f);
        float z[8]; unpack8(*(const v4u*)(WSP(bf16, WS_QKVZ) + (size_t)row * 2048 + 1536 + 8 * lane), z);
        float o[8];
#pragma unroll
        for (int i = 0; i < 4; ++i) { o[i] = a[i] * r * g0[i] * siluf(z[i]); o[4 + i] = b[i] * r * g1[i] * siluf(z[4 + i]); }
        *(v4u*)(WSP(bf16, WS_AO) + (size_t)row * 1536 + 1024 + 8 * lane) = pack8f(o);
    }
}

__device__ __forceinline__ void p8_ln_router(Frame& F, KArgs A, int l, float* HOUT, bf16* HB) {
    const int lane = F.lane, tid = F.tid, gw = F.bid * NWAVES + F.wave, NGW = F.G * NWAVES;
    LAS float* wT = (LAS float*)(F.lds);
    LAS float* lg = (LAS float*)(F.lds + WSCR_OFF + F.wave * WSCR_BYTES);
    const float* rw = A->in[I_RW] + (size_t)l * 1024 * 32;
    {
        f32x4 wv[16];
#pragma unroll
        for (int j = 0; j < 16; ++j) wv[j] = *(const f32x4*)(rw + (size_t)(tid + NTHREADS * j) * 4);
#pragma unroll
        for (int j = 0; j < 16; ++j) { const int i4 = tid + NTHREADS * j, k = i4 >> 3, e0 = (i4 & 7) * 4;
            wT[(e0 + 0) * 1028 + k] = wv[j][0]; wT[(e0 + 1) * 1028 + k] = wv[j][1]; wT[(e0 + 2) * 1028 + k] = wv[j][2]; wT[(e0 + 3) * 1028 + k] = wv[j][3]; }
    }
    __syncthreads();
    const float* PRE = WSP(float, WS_PRE);
    const float* lg_g = A->in[I_LNM_G] + (size_t)l * 1024; const float* lg_b = A->in[I_LNM_B] + (size_t)l * 1024;
    const float rb = A->in[I_RB][l * 32 + (lane & 31)];
    int* TOKE = WSP(int, WS_ROUTE); int* TOKPOS = TOKE + M * 4; float* TOKG = (float*)(TOKPOS + M * 4);
    gu32* cnt = F.ctl + CW_CNT + 64 * 32 * l;
    LAS int* lcnt = (LAS int*)(F.lds + MISC_OFF + 512);
    LAS int* lbase = lcnt + 32;
    LAS int* myrt = (LAS int*)(F.lds + WSCR_OFF + F.wave * WSCR_BYTES + 128);
    if (tid < 32) lcnt[tid] = 0;
    __syncthreads();
    int nrow = 0;
    f32x4 lng[4], lnb[4];
#pragma unroll
    for (int j = 0; j < 4; ++j) { lng[j] = *(const f32x4*)(lg_g + 256 * j + 4 * lane); lnb[j] = *(const f32x4*)(lg_b + 256 * j + 4 * lane); }
    for (int row = gw; row < M; row += NGW) {
        f32x4 v[4]; float s = 0.f;
#pragma unroll
        for (int j = 0; j < 4; ++j) { v[j] = *(const f32x4*)(PRE + (size_t)row * 1024 + 256 * j + 4 * lane); s += (v[j][0] + v[j][1]) + (v[j][2] + v[j][3]); }
        const float mean = wave_sum(s) * (1.0f / 1024.0f); float s2 = 0.f;
#pragma unroll
        for (int j = 0; j < 4; ++j) { v[j] = v[j] - mean; s2 += (v[j][0] * v[j][0] + v[j][1] * v[j][1]) + (v[j][2] * v[j][2] + v[j][3] * v[j][3]); }
        const float rstd = rsqrtf(wave_sum(s2) * (1.0f / 1024.0f) + 1e-5f);
#pragma unroll
        for (int j = 0; j < 4; ++j) {
            v[j] = v[j] * rstd * lng[j] + lnb[j];
            v2u o; o.x = pk2(v[j][0], v[j][1]); o.y = pk2(v[j][2], v[j][3]); *(v2u*)(HB + (size_t)row * 1024 + 256 * j + 4 * lane) = o;
        }
        float part[32];
#pragma unroll
        for (int e = 0; e < 32; ++e) {
            float a = 0.f;
#pragma unroll
            for (int j = 0; j < 4; ++j) { const f32x4 w = *(const LAS f32x4*)(wT + e * 1028 + 256 * j + 4 * lane); a += v[j][0] * w[0] + v[j][1] * w[1] + v[j][2] * w[2] + v[j][3] * w[3]; }
            part[e] = a;
        }
#pragma unroll
        for (int i = 0; i < 16; ++i) { const bool up = (lane & 32) != 0; const float keep = up ? part[i + 16] : part[i], send = up ? part[i] : part[i + 16]; part[i] = keep + __shfl_xor(send, 32); }
#pragma unroll
        for (int i = 0; i < 8; ++i) { const bool up = (lane & 16) != 0; const float keep = up ? part[i + 8] : part[i], send = up ? part[i] : part[i + 8]; part[i] = keep + __shfl_xor(send, 16); }
#pragma unroll
        for (int i = 0; i < 4; ++i) { const bool up = (lane & 8) != 0; const float keep = up ? part[i + 4] : part[i], send = up ? part[i] : part[i + 4]; part[i] = keep + __shfl_xor(send, 8); }
#pragma unroll
        for (int i = 0; i < 2; ++i) { const bool up = (lane & 4) != 0; const float keep = up ? part[i + 2] : part[i], send = up ? part[i] : part[i + 2]; part[i] = keep + __shfl_xor(send, 4); }
        { const bool up = (lane & 2) != 0; const float keep = up ? part[1] : part[0], send = up ? part[0] : part[1]; part[0] = keep + __shfl_xor(send, 2); }
        part[0] += __shfl_xor(part[0], 1);
        const int eidx = ((lane >> 5) & 1) * 16 + ((lane >> 4) & 1) * 8 + ((lane >> 3) & 1) * 4 + ((lane >> 2) & 1) * 2 + ((lane >> 1) & 1);
        if ((lane & 1) == 0) lg[eidx] = part[0];
        float val = (lane < 32) ? lg[lane & 31] + rb : -INFINITY;
        float tl[4]; int te[4];
#pragma unroll
        for (int k = 0; k < 4; ++k) {
            const float mx = wave_max(val);
            const unsigned long long mm = __ballot(val == mx && lane < 32);
            const int idx = __ffsll((long long)mm) - 1;
            tl[k] = mx; te[k] = idx;
            if (lane == idx) val = -INFINITY;
        }
        const float e1 = __expf(tl[1] - tl[0]), e2 = __expf(tl[2] - tl[0]), e3 = __expf(tl[3] - tl[0]);
        const float inv = 1.0f / (1.0f + e1 + e2 + e3);
        if (lane < 4) {
            const int e = lane == 0 ? te[0] : (lane == 1 ? te[1] : (lane == 2 ? te[2] : te[3]));
            const float g = (lane == 0 ? 1.0f : (lane == 1 ? e1 : (lane == 2 ? e2 : e3))) * inv;
            const int lp = __hip_atomic_fetch_add(lcnt + e, 1, __ATOMIC_RELAXED, __HIP_MEMORY_SCOPE_WORKGROUP);
            LAS int* rt = myrt + (nrow * 4 + lane) * 3; rt[0] = e; rt[1] = lp; rt[2] = __float_as_int(g);
        }
        ++nrow;
    }
    __syncthreads();
    if (tid < 32) lbase[tid] = (int)__hip_atomic_fetch_add(cnt + 64 * tid, (unsigned)lcnt[tid], RLX_AGENT);
    __syncthreads();
    if (lane < 4) {
        int j = 0;
        for (int row = gw; row < M; row += NGW, ++j) {
            const LAS int* rt = myrt + (j * 4 + lane) * 3; const int e = rt[0];
            TOKE[(size_t)row * 4 + lane] = e; TOKPOS[(size_t)row * 4 + lane] = lbase[e] + rt[1]; TOKG[(size_t)row * 4 + lane] = __int_as_float(rt[2]);
        }
    }
}

__device__ __forceinline__ void p9_scatter(Frame& F, int l, const bf16* HB, const float* HF) {
    const int lane = F.lane, tid = F.tid, gw = F.bid * NWAVES + F.wave, NGW = F.G * NWAVES;
    LAS int* base = (LAS int*)(F.lds + MISC_OFF + 256);
    int* TOKE = WSP(int, WS_ROUTE); int* TOKPOS = TOKE + M * 4; int* TILE = TOKE + 3 * M * 4;
    if (tid < 32) base[tid] = (int)__hip_atomic_load(F.ctl + CW_CNT + 64 * (32 * l + tid), RLX_AGENT);
    __syncthreads();
    if (tid == 0) {
        int acc = 0;
        for (int e = 0; e < NEXP; ++e) { const int c = base[e]; base[e] = acc; acc += ((c + 255) >> 8) << 8; }
        base[32] = acc >> 8;
    }
    __syncthreads();
    if (F.bid == 0 && tid < 64) {
        const int nT = base[32];
        for (int t = tid; t < NTMAX; t += 64) { int e = 0;
            for (int x = 1; x < NEXP; ++x) if (base[x] <= t * 256) e = x;
            TILE[t] = (t < nT) ? e : 0; }
        if (tid == 0) TILE[NTMAX] = nT;
    }
    bf16* XS = WSP(bf16, WS_XS);
    if (kMoeFp8) {
        unsigned char* XB8 = WSP(unsigned char, WS_XS);
        for (int row = gw; row < M; row += NGW) {
            const bf16* hp = HB + (size_t)row * 1024 + 16 * lane; v4u o; float f[16];
            unpack8(*(const v4u*)hp, *(float (*)[8])&f[0]); unpack8(*(const v4u*)(hp + 8), *(float (*)[8])&f[8]);
#pragma unroll
            for (int q = 0; q < 4; ++q) { unsigned w = 0u; w = __builtin_amdgcn_cvt_pk_fp8_f32(f[4 * q], f[4 * q + 1], w, false); w = __builtin_amdgcn_cvt_pk_fp8_f32(f[4 * q + 2], f[4 * q + 3], w, true); o[q] = w; }
#pragma unroll
            for (int k = 0; k < 4; ++k) { const int slot = base[TOKE[(size_t)row * 4 + k]] + TOKPOS[(size_t)row * 4 + k]; *(v4u*)(XB8 + (size_t)slot * 1024 + 16 * lane) = o; }
        }
        return;
    }
    for (int row = gw; row < M; row += NGW) {
        const v4u a = *(const v4u*)(HB + (size_t)row * 1024 + 8 * lane), b = *(const v4u*)(HB + (size_t)row * 1024 + 512 + 8 * lane);
#pragma unroll
        for (int k = 0; k < 4; ++k) {
            const int slot = base[TOKE[(size_t)row * 4 + k]] + TOKPOS[(size_t)row * 4 + k];
            *(v4u*)(XS + (size_t)slot * 1024 + 8 * lane) = a; *(v4u*)(XS + (size_t)slot * 1024 + 512 + 8 * lane) = b;
        }
    }
}

__device__ __forceinline__ void p12_combine(Frame& F, KArgs A, int l, const bf16* HINB, float* HOUT, bf16* HB) {
    const int lane = F.lane, tid = F.tid, gw = F.bid * NWAVES + F.wave, NGW = F.G * NWAVES;
    LAS int* base = (LAS int*)(F.lds + MISC_OFF + 256);
    if (tid < 32) base[tid] = (int)__hip_atomic_load(F.ctl + CW_CNT + 64 * (32 * l + tid), RLX_AGENT);
    __syncthreads();
    if (tid == 0) { int acc = 0; for (int e = 0; e < NEXP; ++e) { const int c = base[e]; base[e] = acc; acc += ((c + 255) >> 8) << 8; } }
    __syncthreads();
    const int* TOKE = WSP(int, WS_ROUTE); const int* TOKPOS = TOKE + M * 4; const float* TOKG = (const float*)(TOKPOS + M * 4);
    const bf16* YS = WSP(bf16, WS_YS); const bf16* PLE = WSP(bf16, WS_PLE);
    const float* lg_g = A->in[I_LNF_G] + (size_t)l * 1024; const float* lg_b = A->in[I_LNF_B] + (size_t)l * 1024;
    f32x4 lng[2][2], lnb[2][2];
#pragma unroll
    for (int hf = 0; hf < 2; ++hf) { const int c0 = 512 * hf + 8 * lane; lng[hf][0] = *(const f32x4*)(lg_g + c0); lng[hf][1] = *(const f32x4*)(lg_g + c0 + 4); lnb[hf][0] = *(const f32x4*)(lg_b + c0); lnb[hf][1] = *(const f32x4*)(lg_b + c0 + 4); }
    for (int row = gw; row < M; row += NGW) {
        float x[16];
        {   float h0[8], h1[8]; unpack8(*(const v4u*)(HINB + (size_t)row * 1024 + 8 * lane), h0); unpack8(*(const v4u*)(HINB + (size_t)row * 1024 + 512 + 8 * lane), h1);
            float p0[8], p1[8]; unpack8(*(const v4u*)(PLE + (size_t)row * 1024 + 8 * lane), p0); unpack8(*(const v4u*)(PLE + (size_t)row * 1024 + 512 + 8 * lane), p1);
#pragma unroll
            for (int i = 0; i < 8; ++i) { x[i] = ALPHA * h0[i] + p0[i]; x[8 + i] = ALPHA * h1[i] + p1[i]; }
        }
#pragma unroll
        for (int k = 0; k < 4; ++k) {
            const int slot = base[TOKE[(size_t)row * 4 + k]] + TOKPOS[(size_t)row * 4 + k]; const float g = TOKG[(size_t)row * 4 + k];
            float y0[8], y1[8]; unpack8(*(const v4u*)(YS + (size_t)slot * 1024 + 8 * lane), y0); unpack8(*(const v4u*)(YS + (size_t)slot * 1024 + 512 + 8 * lane), y1);
#pragma unroll
            for (int i = 0; i < 8; ++i) { x[i] += g * y0[i]; x[8 + i] += g * y1[i]; }
        }
        float s = 0.f;
#pragma unroll
        for (int i = 0; i < 16; ++i) s += x[i];
        const float mean = wave_sum(s) * (1.0f / 1024.0f); float s2 = 0.f;
#pragma unroll
        for (int i = 0; i < 16; ++i) { x[i] -= mean; s2 += x[i] * x[i]; }
        const float rstd = rsqrtf(wave_sum(s2) * (1.0f / 1024.0f) + 1e-5f);
#pragma unroll
        for (int hf = 0; hf < 2; ++hf) {
            const int c0 = 512 * hf + 8 * lane;
            const f32x4 g0 = lng[hf][0], g1 = lng[hf][1], b0 = lnb[hf][0], b1 = lnb[hf][1];
            f32x4 o0, o1;
#pragma unroll
            for (int i = 0; i < 4; ++i) { o0[i] = x[8 * hf + i] * rstd * g0[i] + b0[i]; o1[i] = x[8 * hf + 4 + i] * rstd * g1[i] + b1[i]; }
            *(f32x4*)(HOUT + (size_t)row * 1024 + c0) = o0; *(f32x4*)(HOUT + (size_t)row * 1024 + c0 + 4) = o1;
            if (HB) { v4u w; w.x = pk2(o0[0], o0[1]); w.y = pk2(o0[2], o0[3]); w.z = pk2(o1[0], o1[1]); w.w = pk2(o1[2], o1[3]); *(v4u*)(HB + (size_t)row * 1024 + c0) = w; }
        }
    }
}

typedef short v4i16_t __attribute__((ext_vector_type(4)));
__device__ __forceinline__ v4i16_t lds_tr16(LAS unsigned char* p) { return __builtin_amdgcn_ds_read_tr16_b64_v4i16((LAS v4i16_t*)p); }
constexpr int DV_PITCH = 144, DV_BUF = 32 * DV_PITCH;
template <int DL  , int SIGMA  > __device__ __forceinline__ void dil_branch(const bf16* __restrict__ KV, LAS unsigned char* vbuf, const int s0, const int lane,
                                                                                 const bf16x8 (&qf)[2], f32x4 (&O)[4], float& m_run, float& l_run) {
    constexpr int d = 1 << DL, sigma = SIGMA, NS = (129 + 15 * sigma + 31) / 32;
    const int fr = lane & 15, fq = lane >> 4;
    const int c = s0 & (d - 1), n0 = s0 >> DL, kstart = n0 - 128;
    const int dbase = 128 + sigma * fr - 4 * fq;
    const int dmax = n0 + sigma * fr;
#define DIL_POS(n) ({ int _p = c + d * (n); _p = _p < 0 ? 0 : (_p > SEQ - 1 ? SEQ - 1 : _p); _p; })
    bf16x8 kf[2][2]; v4u vr[4];
#pragma unroll
    for (int tl = 0; tl < 2; ++tl) { const bf16* kp = KV + (size_t)DIL_POS(kstart + 16 * tl + fr) * 2560 + 768 + 8 * fq; kf[tl][0] = *(const bf16x8*)kp; kf[tl][1] = *(const bf16x8*)(kp + 32); }
#pragma unroll
    for (int i = 0; i < 4; ++i) vr[i] = *(const v4u*)(KV + (size_t)DIL_POS(kstart + (lane >> 3) + 8 * i) * 2560 + 1536 + 8 * (lane & 7));
#pragma unroll 1
    for (int g = 0; g < NS; ++g) {
        LAS unsigned char* vb = vbuf;
#pragma unroll
        for (int i = 0; i < 4; ++i) *(LAS v4u*)(vb + ((lane >> 3) + 8 * i) * DV_PITCH + 16 * (lane & 7)) = vr[i];
        bf16x8 kc[2][2];
#pragma unroll
        for (int tl = 0; tl < 2; ++tl) { kc[tl][0] = kf[tl][0]; kc[tl][1] = kf[tl][1]; }
        if (g + 1 < NS) {
            const int kb = kstart + 32 * (g + 1);
#pragma unroll
            for (int tl = 0; tl < 2; ++tl) { const bf16* kp = KV + (size_t)DIL_POS(kb + 16 * tl + fr) * 2560 + 768 + 8 * fq; kf[tl][0] = *(const bf16x8*)kp; kf[tl][1] = *(const bf16x8*)(kp + 32); }
#pragma unroll
            for (int i = 0; i < 4; ++i) vr[i] = *(const v4u*)(KV + (size_t)DIL_POS(kb + (lane >> 3) + 8 * i) * 2560 + 1536 + 8 * (lane & 7));
        }
        float sv[8];
#pragma unroll
        for (int tl = 0; tl < 2; ++tl) {
            f32x4 cc = __builtin_amdgcn_mfma_f32_16x16x32_bf16(kc[tl][0], qf[0], (f32x4){0.f, 0.f, 0.f, 0.f}, 0, 0, 0);
            cc = __builtin_amdgcn_mfma_f32_16x16x32_bf16(kc[tl][1], qf[1], cc, 0, 0, 0);
#pragma unroll
            for (int j = 0; j < 4; ++j) {
                const int delta = dbase - (32 * g + 16 * tl + j);
                const bool ok = ((unsigned)delta <= 128u) && (delta <= dmax);
                sv[4 * tl + j] = ok ? cc[j] * 0.18033688011112042f : -INFINITY;
            }
        }
        float mx = fmaxf(fmaxf(fmaxf(sv[0], sv[1]), fmaxf(sv[2], sv[3])), fmaxf(fmaxf(sv[4], sv[5]), fmaxf(sv[6], sv[7])));
        mx = fmaxf(mx, __shfl_xor(mx, 16)); mx = fmaxf(mx, __shfl_xor(mx, 32));
        const float m_new = fmaxf(m_run, mx);
        if (!__all(m_new == m_run)) {
            const float alpha = __builtin_amdgcn_exp2f(m_run - m_new);
            l_run *= alpha;
#pragma unroll
            for (int j = 0; j < 4; ++j) { const float aj = __shfl(alpha, 4 * fq + j);
#pragma unroll
                for (int dt = 0; dt < 4; ++dt) O[dt][j] *= aj; }
            m_run = m_new;
        }
        float p[8], ps = 0.f;
#pragma unroll
        for (int e = 0; e < 8; ++e) { p[e] = __builtin_amdgcn_exp2f(sv[e] - m_run); ps += p[e]; }
        l_run += ps;
        v4u pw; pw.x = pg8::cvt_pk_bf16(p[0], p[1]); pw.y = pg8::cvt_pk_bf16(p[2], p[3]); pw.z = pg8::cvt_pk_bf16(p[4], p[5]); pw.w = pg8::cvt_pk_bf16(p[6], p[7]);
        const bf16x8 pf = __builtin_bit_cast(bf16x8, pw);
        LAS unsigned char* tb = vb + (4 * fq + ((lane & 15) >> 2)) * DV_PITCH + 8 * (lane & 3);
#pragma unroll
        for (int dt = 0; dt < 4; ++dt) {
            const v4i16_t lo = lds_tr16(tb + 32 * dt), hi = lds_tr16(tb + 16 * DV_PITCH + 32 * dt);
            bf16x8 vf; vf[0] = lo[0]; vf[1] = lo[1]; vf[2] = lo[2]; vf[3] = lo[3]; vf[4] = hi[0]; vf[5] = hi[1]; vf[6] = hi[2]; vf[7] = hi[3];
            O[dt] = __builtin_amdgcn_mfma_f32_16x16x32_bf16(pf, vf, O[dt], 0, 0, 0);
        }
    }
#undef DIL_POS
}
constexpr int HND_OFF = 8 * DV_BUF, HND_PITCH = 66;
static_assert(HND_OFF + 256 * HND_PITCH * 4 <= MISC_OFF, "dilated attention LDS map");
__device__ __forceinline__ void p14_dilated_mfma(Frame& F) {
    const int lane = F.lane, fr = lane & 15, fq = lane >> 4;
    LAS unsigned char* vbuf = F.lds + F.wave * DV_BUF;
    LAS float* hnd = (LAS float*)(F.lds + HND_OFF);
    const bf16* QK = WSP(bf16, WS_QKVZ); bf16* AO = WSP(bf16, WS_AO);
    for (int u = F.bid; u < 24 * 32; u += F.G) {
        const int bh = u >> 5, blk = u & 31;
        const int b = bh / 12, hh = bh - b * 12;
        const bf16* KV = QK + (size_t)b * SEQ * 2560 + hh * 64;
#pragma unroll 1
        for (int i = 0; i < 2; ++i) {
            const int run = 2 * F.wave + i, s0 = 256 * blk + 16 * run;
            bf16x8 qf[2];
            { const bf16* qp = KV + (size_t)(s0 + fr) * 2560 + 8 * fq; qf[0] = *(const bf16x8*)qp; qf[1] = *(const bf16x8*)(qp + 32); }
            f32x4 O[4];
#pragma unroll
            for (int dt = 0; dt < 4; ++dt) O[dt] = (f32x4){0.f, 0.f, 0.f, 0.f};
            float m_run = -1e30f, l_run = 0.f;
            dil_branch<0, 1>(KV, vbuf, s0, lane, qf, O, m_run, l_run);
            float lt = l_run; lt += __shfl_xor(lt, 16); lt += __shfl_xor(lt, 32);
#pragma unroll
            for (int j = 0; j < 4; ++j)
#pragma unroll
                for (int dt = 0; dt < 4; ++dt) hnd[(16 * run + 4 * fq + j) * HND_PITCH + 16 * dt + fr] = O[dt][j];
            if (fq == 0) { hnd[(16 * run + fr) * HND_PITCH + 64] = m_run; hnd[(16 * run + fr) * HND_PITCH + 65] = lt; }
        }
        __syncthreads();
#pragma unroll 1
        for (int i = 0; i < 2; ++i) {
            const int o = 2 * F.wave + i, s0 = 256 * blk + o;
            bf16x8 qf[2];
            { const bf16* qp = KV + (size_t)(s0 + 16 * fr) * 2560 + 8 * fq; qf[0] = *(const bf16x8*)qp; qf[1] = *(const bf16x8*)(qp + 32); }
            f32x4 O[4];
#pragma unroll
            for (int j = 0; j < 4; ++j)
#pragma unroll
                for (int dt = 0; dt < 4; ++dt) O[dt][j] = hnd[(o + 16 * (4 * fq + j)) * HND_PITCH + 16 * dt + fr];
            float m_run = hnd[(o + 16 * fr) * HND_PITCH + 64], l_run = (fq == 0) ? hnd[(o + 16 * fr) * HND_PITCH + 65] : 0.f;
            dil_branch<4, 1>(KV, vbuf, s0, lane, qf, O, m_run, l_run);
            dil_branch<2, 4>(KV, vbuf, s0, lane, qf, O, m_run, l_run);
            float lt = l_run; lt += __shfl_xor(lt, 16); lt += __shfl_xor(lt, 32);
            const float inv = __builtin_amdgcn_rcpf(lt);
#pragma unroll
            for (int j = 0; j < 4; ++j) {
                const float ij = __shfl(inv, 4 * fq + j);
                bf16* op = AO + (size_t)(b * SEQ + s0 + 16 * (4 * fq + j)) * 1024 + hh * 64 + fr;
#pragma unroll
                for (int dt = 0; dt < 4; ++dt) op[16 * dt] = (bf16)f2bf(O[dt][j] * ij);
            }
        }
        __syncthreads();
    }
}
constexpr int SA_PITCH = 272, SA_TILE = 32 * SA_PITCH;
__device__ __forceinline__ void sparse_row(Frame& F, const int row, const int n, const LAS int* sel, LAS unsigned char* tile) {
    const int lane = F.lane, fr = lane & 15, fq = lane >> 4;
    const bf16* QL = WSP(bf16, WS_QL); const bf16* CKV = WSP(bf16, WS_CKV); bf16* AO = WSP(bf16, WS_AO);
    {
        const int b = row >> 13;
        const bf16* kvb = CKV + (size_t)b * SEQ * 128;
        bf16x8 qf[4];
#pragma unroll
        for (int s = 0; s < 4; ++s) { const v4u z = (v4u){0u, 0u, 0u, 0u}; qf[s] = (fr < 8) ? *(const bf16x8*)(QL + (size_t)row * 1536 + fr * 128 + 32 * s + 8 * fq) : __builtin_bit_cast(bf16x8, z); }
        f32x4 O[8];
#pragma unroll
        for (int rt = 0; rt < 8; ++rt) O[rt] = (f32x4){0.f, 0.f, 0.f, 0.f};
        float m_run = -1e30f, l_run = 0.f;
        const int nsteps = (n + 31) >> 5;
        v4u vr[8];
        { const int j = lane & 31; const int kidx = (j < n) ? sel[j] : 0;
#pragma unroll
          for (int i = 0; i < 8; ++i) { const int key = __shfl(kidx, (lane >> 4) + 4 * i); vr[i] = *(const v4u*)(kvb + (size_t)key * 128 + 8 * (lane & 15)); } }
#pragma unroll 1
        for (int g = 0; g < nsteps; ++g) {
#pragma unroll
            for (int i = 0; i < 8; ++i) *(LAS v4u*)(tile + ((lane >> 4) + 4 * i) * SA_PITCH + 16 * (lane & 15)) = vr[i];
            if (g + 1 < nsteps) {
                const int j = 32 * (g + 1) + (lane & 31); const int kidx = (j < n) ? sel[j] : 0;
#pragma unroll
                for (int i = 0; i < 8; ++i) { const int key = __shfl(kidx, (lane >> 4) + 4 * i); vr[i] = *(const v4u*)(kvb + (size_t)key * 128 + 8 * (lane & 15)); }
            }
            float sv[8];
#pragma unroll
            for (int tl = 0; tl < 2; ++tl) {
                f32x4 cc = (f32x4){0.f, 0.f, 0.f, 0.f};
#pragma unroll
                for (int s = 0; s < 4; ++s) { const bf16x8 kf = *(const LAS bf16x8*)(tile + (16 * tl + fr) * SA_PITCH + 64 * s + 16 * fq); cc = __builtin_amdgcn_mfma_f32_16x16x32_bf16(kf, qf[s], cc, 0, 0, 0); }
#pragma unroll
                for (int j = 0; j < 4; ++j) sv[4 * tl + j] = (32 * g + 16 * tl + 4 * fq + j < n) ? cc[j] : -INFINITY;
            }
            float mx = fmaxf(fmaxf(fmaxf(sv[0], sv[1]), fmaxf(sv[2], sv[3])), fmaxf(fmaxf(sv[4], sv[5]), fmaxf(sv[6], sv[7])));
            mx = fmaxf(mx, __shfl_xor(mx, 16)); mx = fmaxf(mx, __shfl_xor(mx, 32));
            const float m_new = fmaxf(m_run, mx);
            if (!__all(m_new == m_run)) {
                const float alpha = __expf(m_run - m_new);
                l_run *= alpha;
#pragma unroll
                for (int j = 0; j < 4; ++j) { const float aj = __shfl(alpha, 4 * fq + j);
#pragma unroll
                    for (int rt = 0; rt < 8; ++rt) O[rt][j] *= aj; }
                m_run = m_new;
            }
            float p[8], ps = 0.f;
#pragma unroll
            for (int e = 0; e < 8; ++e) { p[e] = __expf(sv[e] - m_run); ps += p[e]; }
            l_run += ps;
            v4u pw; pw.x = pg8::cvt_pk_bf16(p[0], p[1]); pw.y = pg8::cvt_pk_bf16(p[2], p[3]); pw.z = pg8::cvt_pk_bf16(p[4], p[5]); pw.w = pg8::cvt_pk_bf16(p[6], p[7]);
            const bf16x8 pf = __builtin_bit_cast(bf16x8, pw);
            LAS unsigned char* tb = tile + (4 * fq + ((lane & 15) >> 2)) * SA_PITCH + 8 * (lane & 3);
#pragma unroll
            for (int rt = 0; rt < 8; ++rt) {
                const v4i16_t lo = lds_tr16(tb + 32 * rt), hi = lds_tr16(tb + 16 * SA_PITCH + 32 * rt);
                bf16x8 vf; vf[0] = lo[0]; vf[1] = lo[1]; vf[2] = lo[2]; vf[3] = lo[3]; vf[4] = hi[0]; vf[5] = hi[1]; vf[6] = hi[2]; vf[7] = hi[3];
                O[rt] = __builtin_amdgcn_mfma_f32_16x16x32_bf16(pf, vf, O[rt], 0, 0, 0);
            }
        }
        float lt = l_run; lt += __shfl_xor(lt, 16); lt += __shfl_xor(lt, 32);
        const float inv = __builtin_amdgcn_rcpf(lt);
#pragma unroll
        for (int j = 0; j < 4; ++j) {
            const float ij = __shfl(inv, 4 * fq + j);
            if (fq < 2) { bf16* op = AO + (size_t)row * 1536 + (4 * fq + j) * 128 + fr;
#pragma unroll
                for (int rt = 0; rt < 8; ++rt) op[16 * rt] = (bf16)f2bf(O[rt][j] * ij); }
        }
    }
}
__device__ __forceinline__ void p5_topk_attn(Frame& F, const int gw, const int NGW) {
    LAS int* sel = (LAS int*)(F.lds + F.wave * 16384);
    LAS unsigned char* tile = F.lds + F.wave * 16384 + 1024;
    LAS unsigned long long* cand = (LAS unsigned long long*)(F.lds + F.wave * 16384 + 1024 + SA_TILE);
    static_assert(1024 + SA_TILE + TK_CAP * 8 <= 16384, "per-wave LDS");
    for (int rix = gw; rix < M; rix += NGW) {
        const int row = ((rix & 1) ? (M - 1 - (rix >> 1)) : (rix >> 1));
        const int n = __builtin_amdgcn_readfirstlane(topk_row(F, row, sel, cand));
        sparse_row(F, row, n, sel, tile);
    }
}
constexpr int CP_KV_PITCH = 272;
__device__ __forceinline__ void p3_chunk_prep_mfma(Frame& F, KArgs A) {
    int tid = F.tid; asm volatile("" : "+v"(tid));
    const int lane = tid & 63, wave = __builtin_amdgcn_readfirstlane(tid >> 6), fr = lane & 15, fq = lane >> 4;
    LAS unsigned char* kt = F.lds;
    LAS unsigned char* vt = F.lds + 64 * CP_KV_PITCH;
    LAS float* As = (LAS float*)(F.lds + 2 * 64 * CP_KV_PITCH);
    LAS float* Ts = As + 64 * 65;
    LAS float* gcS = Ts + 64 * 68; LAS float* egS = gcS + 64; LAS float* ekS = egS + 64; LAS float* btS = ekS + 64;
    for (int cidx = F.bid; cidx < 1024; cidx += F.G) {
        const int b = cidx >> 9, h = (cidx >> 7) & 3, n = cidx & 127, row0 = b * SEQ + n * 64;
        unsigned char* blk = F.ws + WS_CHK + (size_t)cidx * CHK_STRIDE;
        const bf16* Qg = WSP(bf16, WS_QN) + (size_t)row0 * 512 + h * 128; const bf16* Kg = WSP(bf16, WS_KN) + (size_t)row0 * 512 + h * 128; const bf16* Vg = WSP(bf16, WS_VN) + (size_t)row0 * 512 + h * 128;
        const int ti = wave >> 1;
        float g_in = 0.f, bt_in = 0.f;
        if (tid < 64) { g_in = WSP(float, WS_GG)[(size_t)(row0 + tid) * 4 + h]; bt_in = WSP(float, WS_BETA)[(size_t)(row0 + tid) * 4 + h]; }
        v4u kc[2], vc[2], qc[2];
#pragma unroll
        for (int i = 0; i < 2; ++i) { const int id = tid + 512 * i, r = id >> 4, c = id & 15; kc[i] = *(const v4u*)(Kg + (size_t)r * 512 + 8 * c); vc[i] = *(const v4u*)(Vg + (size_t)r * 512 + 8 * c); qc[i] = *(const v4u*)(Qg + (size_t)r * 512 + 8 * c); }
        bf16x8 ka[4], qa[4], kbf[2][4];
#pragma unroll
        for (int s = 0; s < 4; ++s) { ka[s] = *(const bf16x8*)(Kg + (size_t)(16 * ti + fr) * 512 + 32 * s + 8 * fq); qa[s] = *(const bf16x8*)(Qg + (size_t)(16 * ti + fr) * 512 + 32 * s + 8 * fq);
            kbf[0][s] = *(const bf16x8*)(Kg + (size_t)(16 * (2 * (wave & 1)) + fr) * 512 + 32 * s + 8 * fq); kbf[1][s] = *(const bf16x8*)(Kg + (size_t)(16 * (2 * (wave & 1) + 1) + fr) * 512 + 32 * s + 8 * fq); }
        if (tid < 64) {
            float gc = g_in;
#pragma unroll
            for (int o = 1; o < 64; o <<= 1) { const float t = __shfl_up(gc, o); if (lane >= o) gc += t; }
            const float g63 = __shfl(gc, 63);
            gcS[tid] = gc; egS[tid] = __expf(gc); ekS[tid] = __expf(g63 - gc); btS[tid] = bt_in;
            if (tid == 0) *(float*)(blk + CHK_GL) = __expf(g63);
        }
#pragma unroll
        for (int i = 0; i < 2; ++i) { const int id = tid + 512 * i, r = id >> 4, c = id & 15; *(LAS v4u*)(kt + r * CP_KV_PITCH + 16 * c) = kc[i]; *(LAS v4u*)(vt + r * CP_KV_PITCH + 16 * c) = vc[i]; }
        __syncthreads();
        {
#pragma unroll
            for (int t2 = 0; t2 < 2; ++t2) {
                const int tj = 2 * (wave & 1) + t2;
                f32x4 ck = (f32x4){0.f, 0.f, 0.f, 0.f}, cq = (f32x4){0.f, 0.f, 0.f, 0.f};
#pragma unroll
                for (int s = 0; s < 4; ++s) { ck = __builtin_amdgcn_mfma_f32_16x16x32_bf16(ka[s], kbf[t2][s], ck, 0, 0, 0); cq = __builtin_amdgcn_mfma_f32_16x16x32_bf16(qa[s], kbf[t2][s], cq, 0, 0, 0); }
                const int j = 16 * tj + fr; const float gcj = gcS[j];
                bf16* QKp = (bf16*)(blk + CHK_QK);
#pragma unroll
                for (int jj = 0; jj < 4; ++jj) { const int i = 16 * ti + 4 * fq + jj; const float dec = __expf(j <= i ? gcS[i] - gcj : 0.f);
                    As[i * 65 + j] = (j < i) ? btS[i] * ck[jj] * dec : 0.f;
                    QKp[i * 64 + 32 * (j >> 5) + 8 * ((j >> 2) & 3) + 4 * ((j >> 4) & 1) + (j & 3)] = (bf16)f2bf((j <= i) ? cq[jj] * dec : 0.f); }
            }
        }
        {
#pragma unroll
            for (int x = 0; x < 2; ++x) { const int id = tid + 512 * x, i = id >> 4, d0 = (id & 15) * 8; const float e = egS[i];
                float f[8]; unpack8(qc[x], f);
                bf16* Qd = (bf16*)(blk + CHK_QD) + i * 128 + 32 * (d0 >> 5) + 4 * ((d0 >> 4) & 1);
                const int q0 = (d0 >> 2) & 3;
                v2u w0, w1; w0.x = pk2(f[0] * e, f[1] * e); w0.y = pk2(f[2] * e, f[3] * e); w1.x = pk2(f[4] * e, f[5] * e); w1.y = pk2(f[6] * e, f[7] * e);
                *(v2u*)(Qd + 8 * q0) = w0; *(v2u*)(Qd + 8 * (q0 + 1)) = w1; }
        }
        {
            const int d = tid >> 2, c0 = (tid & 3) * 16, s = c0 >> 5, a = (c0 >> 4) & 1;
            bf16* Kd = (bf16*)(blk + CHK_KDT) + d * 64;
#pragma unroll
            for (int q = 0; q < 4; ++q) { const int c = c0 + 4 * q; float kv[4];
#pragma unroll
                for (int e = 0; e < 4; ++e) kv[e] = bf1(*(const LAS bf16*)(kt + (c + e) * CP_KV_PITCH + 2 * d)) * ekS[c + e];
                v2u w; w.x = pk2(kv[0], kv[1]); w.y = pk2(kv[2], kv[3]); *(v2u*)(Kd + 32 * s + 8 * q + 4 * a) = w; }
        }
        __syncthreads();
        {
            const int c = tid >> 3, part = tid & 7;
            for (int i = 0; i < 64; ++i) {
                float acc = 0.f;
                for (int j = part; j < i; j += 8) acc += As[i * 65 + j] * Ts[j * 68 + c];
                acc += __shfl_xor(acc, 1); acc += __shfl_xor(acc, 2); acc += __shfl_xor(acc, 4);
                if (part == 0) Ts[i * 68 + c] = ((i == c) ? 1.f : 0.f) - acc;
                __builtin_amdgcn_fence(__ATOMIC_RELEASE, "wavefront"); asm volatile("s_waitcnt lgkmcnt(0)" ::: "memory");
            }
        }
        __syncthreads();
        {
            bf16x8 vf[2], kf[2];
            LAS unsigned char* vb = vt + (8 * fq + ((lane & 15) >> 2)) * CP_KV_PITCH + 32 * wave + 8 * (lane & 3);
            LAS unsigned char* kb = kt + (8 * fq + ((lane & 15) >> 2)) * CP_KV_PITCH + 32 * wave + 8 * (lane & 3);
#pragma unroll
            for (int s = 0; s < 2; ++s) {
                const v4i16_t v0 = lds_tr16(vb + (32 * s) * CP_KV_PITCH), v1 = lds_tr16(vb + (32 * s + 4) * CP_KV_PITCH), k0 = lds_tr16(kb + (32 * s) * CP_KV_PITCH), k1 = lds_tr16(kb + (32 * s + 4) * CP_KV_PITCH);
                vf[s][0] = v0[0]; vf[s][1] = v0[1]; vf[s][2] = v0[2]; vf[s][3] = v0[3]; vf[s][4] = v1[0]; vf[s][5] = v1[1]; vf[s][6] = v1[2]; vf[s][7] = v1[3];
                kf[s][0] = k0[0]; kf[s][1] = k0[1]; kf[s][2] = k0[2]; kf[s][3] = k0[3]; kf[s][4] = k1[0]; kf[s][5] = k1[1]; kf[s][6] = k1[2]; kf[s][7] = k1[3];
            }
            float* UT = (float*)(blk + CHK_UT);
            bf16* Wp = (bf16*)(blk + CHK_WP);
#pragma unroll
            for (int ti = 0; ti < 4; ++ti) {
                f32x4 cu = (f32x4){0.f, 0.f, 0.f, 0.f}, cw = (f32x4){0.f, 0.f, 0.f, 0.f};
#pragma unroll
                for (int s = 0; s < 2; ++s) {
                    const LAS float* tr = Ts + (16 * ti + fr) * 68 + 32 * s + 8 * fq;
                    const f32x4 t0 = *(const LAS f32x4*)tr, t1 = *(const LAS f32x4*)(tr + 4);
                    const f32x4 b0 = *(const LAS f32x4*)(btS + 32 * s + 8 * fq), b1 = *(const LAS f32x4*)(btS + 32 * s + 8 * fq + 4), e0 = *(const LAS f32x4*)(egS + 32 * s + 8 * fq), e1 = *(const LAS f32x4*)(egS + 32 * s + 8 * fq + 4);
                    const f32x4 u0 = t0 * b0, u1 = t1 * b1, w0 = u0 * e0, w1 = u1 * e1;
                    cu = __builtin_amdgcn_mfma_f32_16x16x32_bf16(packfrag(u0, u1), vf[s], cu, 0, 0, 0);
                    cw = __builtin_amdgcn_mfma_f32_16x16x32_bf16(packfrag(w0, w1), kf[s], cw, 0, 0, 0);
                }
                *(f32x4*)(UT + (size_t)(16 * wave + fr) * 64 + 16 * ti + 4 * fq) = cu;
#pragma unroll
                for (int jj = 0; jj < 4; ++jj) Wp[(16 * ti + 4 * fq + jj) * 128 + 32 * (wave >> 1) + 8 * (fr >> 2) + 4 * (wave & 1) + (fr & 3)] = (bf16)f2bf(cw[jj]);
            }
        }
        __syncthreads();
    }
}
__device__ __forceinline__ void p14_pool(Frame& F, KArgs A) {
    const int lane = F.lane, tid = F.tid, gw = F.bid * NWAVES + F.wave, NGW = F.G * NWAVES;
    LAS float* pw = (LAS float*)(F.lds + 16384);
    LAS float* dl = (LAS float*)(F.lds + 16384 + 65536 + F.wave * 1024);
    {   f32x4 pv[8];
#pragma unroll
        for (int j = 0; j < 8; ++j) pv[j] = *(const f32x4*)(A->in[I_CD_POOLW] + (size_t)(tid + NTHREADS * j) * 4);
#pragma unroll
        for (int j = 0; j < 8; ++j) *(LAS f32x4*)(pw + (tid + NTHREADS * j) * 4) = pv[j];
    }
    __syncthreads();
    const bf16* QK = WSP(bf16, WS_QKVZ); bf16* AO = WSP(bf16, WS_AO);
    const int gi = lane >> 4, w = 2 << gi;
    float sc[4];
#pragma unroll
    for (int g = 0; g < 4; ++g) sc[g] = A->in[I_CD_POOLS][g * 64 + lane];
    for (int row = gw; row < M; row += NGW) {
        const int pos = row & (SEQ - 1);
        const int cntw = (pos + 1 < w) ? pos + 1 : w;
        float sum[4] = {0.f, 0.f, 0.f, 0.f}, cur[4] = {0.f, 0.f, 0.f, 0.f};
        v2u xw[16];
#pragma unroll
        for (int j = 0; j < 16; ++j) xw[j] = *(const v2u*)(QK + (size_t)(row - (j <= pos ? j : pos)) * 2560 + 2304 + 4 * lane);
#pragma unroll
        for (int j = 0; j < 16; ++j) {
            const float f0 = bflo(xw[j].x), f1 = bfhi(xw[j].x), f2 = bflo(xw[j].y), f3 = bfhi(xw[j].y);
            if (j < cntw) { sum[0] += f0; sum[1] += f1; sum[2] += f2; sum[3] += f3; }
            if (j == 0) { cur[0] = f0; cur[1] = f1; cur[2] = f2; cur[3] = f3; }
        }
        const float inv = 1.0f / (float)cntw;
#pragma unroll
        for (int i = 0; i < 4; ++i) dl[4 * lane + i] = sum[i] * inv - cur[i];
        float o[4] = {0.f, 0.f, 0.f, 0.f};
        for (int c = 0; c < 64; ++c) {
#pragma unroll
            for (int g = 0; g < 4; ++g) o[g] += dl[g * 64 + c] * pw[(g * 64 + c) * 64 + lane];
        }
#pragma unroll
        for (int g = 0; g < 4; ++g) AO[(size_t)row * 1024 + 768 + g * 64 + lane] = (bf16)f2bf(o[g] * sc[g]);
    }
}


#define IN(k) (lo <= (k) && (k) < hi)
#define SEAM(k) do { if (IN(k) && IN((k) + 1)) xcd_barrier(bar); } while (0)
template <int l> __device__ __forceinline__ void layer_tail(Frame& F, const XcdBarrier& bar, const int lo, const int hi) {
    LAS unsigned char* ring = F.lds + RING_OFF;
    const int bid = F.bid, G = F.G;
        const int pb = 8 * l;

        if (IN(7 + pb)) {
            pg8::Gemm g{WSP(bf16, WS_AO), (l == 0) ? WSP(bf16, WS_W_OUTAB) : WSP(bf16, WS_W_OUTCD), M, 1024, (l == 0) ? 1536 : 1024}; pg8::StaticOrder S; S.init(M, 1024, G, bid);
            pg8::Epi<pg8::StPre> E{{(l == 0) ? kargs()->in[I_X] : WSP(float, WS_H2), WSP(float, WS_PRE), ALPHA}};
            pg8::gemm_phase<pg8::Epi<pg8::StPre>, pg8::StaticOrder, true, true>(ring, g, S, E);
        } SEAM(7 + pb);
        if (IN(8 + pb)) { p8_ln_router(F, kargs(), l, WSP(float, WS_H1), WSP(bf16, WS_H1B)); } SEAM(8 + pb);
        if (IN(9 + pb)) {
            p9_scatter(F, l, WSP(bf16, WS_H1B), WSP(float, WS_H1));
            __syncthreads();
            pg8::Gemm g{WSP(bf16, WS_H1B), WSP(bf16, WS_W_PG) + (size_t)l * 1024 * 1024, M, 1024, 1024}; pg8::StaticOrder S; S.init(M, 1024, G, bid);
            pg8::Epi<pg8::StPleGate> E{{WSP(bf16, WS_PP) + (size_t)l * M * 1024, WSP(bf16, WS_PLE)}};
            pg8::gemm_phase<pg8::Epi<pg8::StPleGate>, pg8::StaticOrder, true, true>(ring, g, S, E);
        } SEAM(9 + pb);
        const int* TILE = WSP(int, WS_ROUTE) + 3 * M * 4;
        if (IN(10 + pb)) {
            const int nT = __builtin_amdgcn_readfirstlane(TILE[NTMAX]);
            constexpr int EB = kMoeFp8 ? 1 : 2;
            pg8::Gemm g{WSP(bf16, WS_XS), (const bf16*)(F.ws + WS_W_GU + (size_t)l * NEXP * 2048 * 1024 * EB), PMAX, 2048, 1024 * EB / 2};
            pg8::MoeOrder S{TILE, nT, 8, G, bid, (long)2048 * 1024 * EB};
            pg8::Epi<pg8::StSwiglu<kMoeFp8>> E{{kargs()->in[I_BGU] + (size_t)l * NEXP * 2048, WSP(bf16, WS_HID)}};
            pg8::gemm_phase<pg8::Epi<pg8::StSwiglu<kMoeFp8>>, pg8::MoeOrder, true, false, kMoeFp8 ? kScaleGU : 0u>(ring, g, S, E);
        } SEAM(10 + pb);
        if (IN(11 + pb)) {
            const int nT = __builtin_amdgcn_readfirstlane(TILE[NTMAX]);
            constexpr int EB = kMoeFp8 ? 1 : 2;
            pg8::Gemm g{WSP(bf16, WS_HID), (const bf16*)(F.ws + WS_W_DN + (size_t)l * NEXP * 1024 * 1024 * EB), PMAX, 1024, 1024 * EB / 2};
            pg8::MoeOrder S{TILE, nT, 4, G, bid, (long)1024 * 1024 * EB};
            pg8::Epi<pg8::StDown> E{{kargs()->in[I_BDN] + (size_t)l * NEXP * 1024, WSP(bf16, WS_YS)}};
            pg8::gemm_phase<pg8::Epi<pg8::StDown>, pg8::MoeOrder, true, false, kMoeFp8 ? kScaleDN : 0u>(ring, g, S, E);
        } SEAM(11 + pb);
        if (IN(12 + pb)) { p12_combine(F, kargs(), l, WSP(bf16, WS_H1B), (l == 0) ? WSP(float, WS_H2) : kargs()->out, (l == 0) ? WSP(bf16, WS_XB) : (bf16*)nullptr); }
}
#undef IN
#undef SEAM
__global__ void __launch_bounds__(NTHREADS, 2) mk_fwd(Args args_by_value) {
    const KArgs KA = kargs();
    extern __shared__ __attribute__((aligned(16))) unsigned char lds[];
    Frame F;
    F.lds = (LAS unsigned char*)lds;
    F.tid = threadIdx.x; F.lane = F.tid & 63; F.wave = __builtin_amdgcn_readfirstlane(F.tid >> 6);
    F.G = gridDim.x; F.bid = blockIdx.x; F.ws = KA->ws; F.ctl = (gu32*)(KA->ws + WS_CTL);
    volatile LAS unsigned* MISC = (volatile LAS unsigned*)(F.lds + MISC_OFF);
    { int t0 = threadIdx.x; asm volatile("" : "+v"(t0)); for (int u = t0; u < (LDS_BYTES - MISC_OFF) / 4; u += NTHREADS) MISC[u] = 0u; }
    __syncthreads();
    const bool use_bar = (N_LAUNCHES != NPHASES);
    XcdBarrier bar; bar.bar = (unsigned*)(F.ctl + CW_BAR) + KA->li * XCD_BAR_WORDS; bar.x = 0; bar.st = nullptr; bar.expect = 0;
    XcdBarrier bar2 = bar;
    if (use_bar && F.bid >= SEQ_WGS && F.G > SEQ_WGS) bar2 = xcd_barrier_post((unsigned*)(F.ctl + CW_BAR2), MISC + 10, (unsigned)(F.G - SEQ_WGS));
    if (use_bar) bar = xcd_barrier_post((unsigned*)(F.ctl + CW_BAR) + KA->li * XCD_BAR_WORDS, MISC + 8);
    const int lo = KA->ph_lo, hi = KA->ph_hi;
#define IN(k) (lo <= (k) && (k) < hi)
#define SEAM(k) do { if (IN(k) && IN((k) + 1)) xcd_barrier(bar); } while (0)
    LAS unsigned char* ring = F.lds + RING_OFF;
    const int bid = F.bid, G = F.G;

    if (IN(0)) { p0_prologue(F, kargs()); } SEAM(0);

            if (IN(1)) {
                { pg8::Gemm g{WSP(bf16, WS_XB), WSP(bf16, WS_W_INAB), M, 2560, 1024}; pg8::StaticOrder S; S.init(M, 2560, G, bid);
                  pg8::Epi<pg8::StInAB> E{{WSP(float, WS_SM), WSP(bf16, WS_QKVZ)}};
                  pg8::gemm_phase<pg8::Epi<pg8::StInAB>, pg8::StaticOrder, true, true>(ring, g, S, E); }
                __syncthreads();
                { pg8::Gemm g{WSP(bf16, WS_PB), WSP(bf16, WS_W_PP), 2 * M, 1024, 256}; pg8::BatchOrder S{4, (2 * M / 256) * 4, G, bid, M / 256, (long)1024 * 256 * 2};
                  pg8::Epi<pg8::StBf16> E{{WSP(bf16, WS_PP), 1024}};
                  pg8::gemm_phase<pg8::Epi<pg8::StBf16>, pg8::BatchOrder, true, true>(ring, g, S, E); }
            } SEAM(1);
            if (IN(2)) { p2_prep(F, kargs()); } SEAM(2);
            if (IN(3)) {
                p3_chunk_prep_mfma(F, kargs());
                __syncthreads();
                { pg8::Gemm g{WSP(bf16, WS_CQ), WSP(bf16, WS_W_ABS), M, 1536, 256}; pg8::StaticOrder S; S.init(M, 1536, G, bid);
                  pg8::Epi<pg8::StBf16> E{{WSP(bf16, WS_QL), 1536}};
                  pg8::gemm_phase<pg8::Epi<pg8::StBf16>, pg8::StaticOrder, true, true>(ring, g, S, E); }
            } SEAM(3);
            if (IN(4)) {
                if (bid < SEQ_WGS && G > SEQ_WGS) p4_delta_seq(F, bid);
                else { p4_indexer(F, (bid - SEQ_WGS) * NWAVES + F.wave, (G - SEQ_WGS) * NWAVES);
                    if (use_bar) { xcd_barrier(bar2);
                        p5_topk_attn(F, (bid - SEQ_WGS) * NWAVES + F.wave, (G - SEQ_WGS) * NWAVES); } }
            } SEAM(4);
            if (IN(5)) { if (!use_bar) p5_topk_attn(F, bid * NWAVES + F.wave, G * NWAVES); p6_gdn_out(F, kargs()); } SEAM(5);
    layer_tail<0>(F, bar, lo, hi);
    SEAM(12);
            if (IN(13)) {
                pg8::Gemm g{WSP(bf16, WS_XB), WSP(bf16, WS_W_INCD), M, 2560, 1024}; pg8::StaticOrder S; S.init(M, 2560, G, bid);
                pg8::Epi<pg8::StBf16> E{{WSP(bf16, WS_QKVZ), 2560}};
                pg8::gemm_phase<pg8::Epi<pg8::StBf16>, pg8::StaticOrder, true, true>(ring, g, S, E);
            } SEAM(13);
            if (IN(14)) { p14_dilated_mfma(F); __syncthreads(); p14_pool(F, kargs()); } SEAM(14);
    layer_tail<1>(F, bar, lo, hi);
#undef IN
#undef SEAM
}

extern "C" void kernel_launch(void* const* d_in, const int* in_sizes, int n_in, void* d_out, int out_size, void* d_ws, size_t ws_size, hipStream_t stream) {
    static int grid = 0;
    if (grid == 0) {
        if (n_in != N_IN || in_sizes[0] != M * D || out_size != M * D || ws_size < WS_END) {
            fprintf(stderr, "kernel_launch: built for %d inputs, x/out of %d floats, >= %zu bytes of workspace; got n_in %d, in0 %d, out %d, ws %zu; nothing launched\n", N_IN, M * D, (size_t)WS_END, n_in, n_in > 0 ? in_sizes[0] : -1, out_size, ws_size);
            grid = -1; return; }
        int dev = 0, cus = 0, per_cu = 0;
        if (hipGetDevice(&dev) != hipSuccess || hipDeviceGetAttribute(&cus, hipDeviceAttributeMultiprocessorCount, dev) != hipSuccess) { fprintf(stderr, "kernel_launch: device query failed\n"); grid = -1; return; }
        if (hipFuncSetAttribute((const void*)mk_fwd, hipFuncAttributeMaxDynamicSharedMemorySize, LDS_BYTES) != hipSuccess) { fprintf(stderr, "kernel_launch: hipFuncSetAttribute failed\n"); grid = -1; return; }
        if (hipOccupancyMaxActiveBlocksPerMultiprocessor(&per_cu, (const void*)mk_fwd, NTHREADS, LDS_BYTES) != hipSuccess || per_cu < 1)
            fprintf(stderr, "kernel_launch: note: occupancy query reports %d workgroups per CU\n", per_cu);
        (void)hipGetLastError();
        grid = cus;
    }
    if (grid < 0) return;
    if (hipMemsetAsync((char*)d_ws + WS_CTL, 0, CTL_ZERO_BYTES, stream) != hipSuccess) { fprintf(stderr, "kernel_launch: memset failed\n"); return; }
    Args a{};
    for (int i = 0; i < N_IN; ++i) a.in[i] = (const float*)d_in[i];
    a.out = (float*)d_out; a.ws = (unsigned char*)d_ws;
    for (int li = 0; li < N_LAUNCHES; ++li) {
        if (N_LAUNCHES == NPHASES) { a.ph_lo = li; a.ph_hi = li + 1; } else { a.ph_lo = (int)((long)li * NPHASES / N_LAUNCHES); a.ph_hi = (int)((long)(li + 1) * NPHASES / N_LAUNCHES); }
        a.li = li;
        hipLaunchKernelGGL(mk_fwd, dim3(grid), dim3(NTHREADS), LDS_BYTES, stream, a);
        const hipError_t le = hipPeekAtLastError();
        if (le != hipSuccess) { fprintf(stderr, "kernel_launch: launch %d failed: %s\n", li, hipGetErrorName(le)); break; }
    }
}
```

```cpp
#include <hip/hip_runtime.h>
#include <cstdio>
#include <cstdint>

namespace pg8 {
#define PG8_LAS __attribute__((address_space(3)))
typedef unsigned short bf16_t;
typedef short bf16x8 __attribute__((ext_vector_type(8)));
typedef float f32x4 __attribute__((ext_vector_type(4)));
typedef unsigned u32x4 __attribute__((ext_vector_type(4)));
constexpr int BM = 256, BK = 64, HALF = 128, HTB = HALF * BK * 2  , STAGE_BYTES = 8 * HTB, NXCD = 8, WGM = 8;

__host__ __device__ __forceinline__ int lds_byte(int r, int c) { const int st = (r >> 4) * 2 + (c >> 5), rr = r & 15, cc = c & 31, ob = rr * 64 + cc * 2; return st * 1024 + (ob ^ (((ob >> 9) & 1) << 5)); }
__host__ __device__ __forceinline__ void stage_rc(int b, int& R, int& C) { const int st = b / 1024, sb = b % 1024, swz = sb ^ (((sb >> 9) & 1) << 5); R = (st >> 1) * 16 + swz / 64; C = (st & 1) * 32 + (swz % 64) / 2; }
__host__ __device__ __forceinline__ int perm32(int rho) { const int n = rho >> 4, i = rho & 15; return 8 * (i >> 2) + 4 * n + (i & 3); }

struct Unit { int pm, pn, e; long bofs; };
struct Gemm { const bf16_t* A; const bf16_t* Bt; int M, N, K; const int* rowmap; int ids_off; };

struct StaticOrder {
    int nM, nN, nwg, G, c;
    __host__ __device__ void init(int M, int N, int G_, int c_) { nM = M / BM; nN = N / BM; nwg = nM * nN; G = G_; c = c_; }
    __host__ __device__ bool next(int i, Unit& u) const {
        const long L = (long)i * G + c; if (L >= nwg) return false;
        int wgid = (int)L; { const int q = nwg / NXCD, r = nwg % NXCD, xcd = wgid % NXCD, off = wgid / NXCD; wgid = (xcd < r ? xcd * (q + 1) : r * (q + 1) + (xcd - r) * q) + off; }
        const int nig = WGM * nN, gid = wgid / nig, fm = gid * WGM, gsz = (nM - fm) < WGM ? (nM - fm) : WGM;
        u.pm = fm + ((wgid % nig) % gsz); u.pn = (wgid % nig) / gsz; u.e = 0; u.bofs = 0; return true;
    }
    __device__ __forceinline__ void a_ready(const Unit&) const {}
    __device__ __forceinline__ void done(const Unit&) const {}
};
struct MoeOrder {
    const int* tile_e; int nT, nN, G, c; long estride;
    __device__ __forceinline__ bool next(int i, Unit& u) const {
        if (G % (8 * nN) == 0) {
            const int rpx = G / (8 * nN), xcd = c & 7, idx = c >> 3;
            u.pm = (i * 8 + xcd) * rpx + idx % rpx; u.pn = idx / rpx;
            if (u.pm >= nT) return false;
        } else {
            const long L = (long)i * G + c; if (L >= (long)nT * nN) return false;
            u.pm = (int)(L / nN); u.pn = (int)(L % nN);
        }
        const int e = tile_e[u.pm]; u.e = e; u.bofs = (long)e * estride; return true;
    }
    __device__ __forceinline__ void a_ready(const Unit&) const {}
    __device__ __forceinline__ void done(const Unit&) const {}
};

struct BatchOrder {
    int nN, nwg, G, c, tiles_per_batch; long bstride;
    __device__ __forceinline__ bool next(int i, Unit& u) const {
        const long L = (long)i * G + c; if (L >= nwg) return false;
        u.pm = (int)(L / nN); u.pn = (int)(L % nN); const int e = u.pm / tiles_per_batch; u.e = e; u.bofs = (long)e * bstride; return true;
    }
    __device__ __forceinline__ void a_ready(const Unit&) const {}
    __device__ __forceinline__ void done(const Unit&) const {}
};

typedef float f32x2c __attribute__((ext_vector_type(2)));
typedef __bf16 bf16x2c __attribute__((ext_vector_type(2)));
__device__ __forceinline__ unsigned cvt_pk_bf16(float lo, float hi) { const f32x2c v = {lo, hi}; const bf16x2c b = __builtin_convertvector(v, bf16x2c); return __builtin_bit_cast(unsigned, b); }
__device__ __forceinline__ u32x4 pack8(const f32x4 v0, const f32x4 v1) { u32x4 w; w.x = cvt_pk_bf16(v0[0], v0[1]); w.y = cvt_pk_bf16(v0[2], v0[3]); w.z = cvt_pk_bf16(v1[0], v1[1]); w.w = cvt_pk_bf16(v1[2], v1[3]); return w; }
__device__ __forceinline__ float bf_lo(unsigned w) { return __uint_as_float(w << 16); }
__device__ __forceinline__ float bf_hi(unsigned w) { return __uint_as_float(w & 0xffff0000u); }
__device__ __forceinline__ float sigmoidf_(float x) { return __builtin_amdgcn_rcpf(1.0f + __builtin_amdgcn_exp2f(x * -1.4426950408889634f)); }
typedef unsigned u32x2 __attribute__((ext_vector_type(2)));

template <class T> struct Epi {
    static constexpr bool PERM = true, AFTER_DRAIN = false;
    T t;
    __device__ __forceinline__ void operator()(const f32x4 (&acc)[2][2][4][2], const Unit& u, int wr, int wc, int fr, int fq) const {
        const int row0 = u.pm * BM + wr * 64 + fr, col0 = u.pn * BM + wc * 32 + 8 * fq;
        f32x4 cb[2][2];
#pragma unroll
        for (int bj = 0; bj < 2; ++bj) t.colctx(col0 + bj * HALF, u, cb[bj][0], cb[bj][1]);
        f32x4 rc[2][2], rn[2][2];
#pragma unroll
        for (int bj = 0; bj < 2; ++bj) t.rowctx(row0, col0 + bj * HALF, rc[bj][0], rc[bj][1]);
#pragma unroll
        for (int g = 0; g < 8; ++g) {
            const int ai = g >> 2, m = g & 3, row = row0 + ai * HALF + m * 16;
            if (g < 7) { const int nrow = row0 + ((g + 1) >> 2) * HALF + ((g + 1) & 3) * 16;
#pragma unroll
                for (int bj = 0; bj < 2; ++bj) t.rowctx(nrow, col0 + bj * HALF, rn[bj][0], rn[bj][1]); }
#pragma unroll
            for (int bj = 0; bj < 2; ++bj) t.store(row, col0 + bj * HALF, acc[ai][bj][m][0] + cb[bj][0], acc[ai][bj][m][1] + cb[bj][1], u, rc[bj][0], rc[bj][1]);
            asm volatile("" ::: "memory");
#pragma unroll
            for (int bj = 0; bj < 2; ++bj) { rc[bj][0] = rn[bj][0]; rc[bj][1] = rn[bj][1]; }
        }
    }
};
struct StBf16 { bf16_t* O; int ld;
    __device__ __forceinline__ void rowctx(int, int, f32x4& r0, f32x4& r1) const { r0 = (f32x4){0.f, 0.f, 0.f, 0.f}; r1 = r0; }
    __device__ __forceinline__ void colctx(int, const Unit&, f32x4& c0, f32x4& c1) const { c0 = (f32x4){0.f, 0.f, 0.f, 0.f}; c1 = c0; }
    __device__ __forceinline__ void store(int row, int col, f32x4 v0, f32x4 v1, const Unit&, f32x4, f32x4) const { *(u32x4*)(O + (size_t)row * ld + col) = pack8(v0, v1); } };
struct StInAB { float* SM; bf16_t* Q;
    __device__ __forceinline__ void rowctx(int, int, f32x4& r0, f32x4& r1) const { r0 = (f32x4){0.f, 0.f, 0.f, 0.f}; r1 = r0; }
    __device__ __forceinline__ void colctx(int, const Unit&, f32x4& c0, f32x4& c1) const { c0 = (f32x4){0.f, 0.f, 0.f, 0.f}; c1 = c0; }
    __device__ __forceinline__ void store(int row, int col, f32x4 v0, f32x4 v1, const Unit&, f32x4, f32x4) const {
        if (col < 512) { float* p = SM + (size_t)row * 512 + col; *(f32x4*)p = v0; *(f32x4*)(p + 4) = v1; }
        else *(u32x4*)(Q + (size_t)row * 2048 + (col - 512)) = pack8(v0, v1); } };
struct StPre { const float* base; float* P; float alpha;
    __device__ __forceinline__ void colctx(int, const Unit&, f32x4& c0, f32x4& c1) const { c0 = (f32x4){0.f, 0.f, 0.f, 0.f}; c1 = c0; }
    __device__ __forceinline__ void rowctx(int row, int col, f32x4& r0, f32x4& r1) const { const size_t o = (size_t)row * 1024 + col; r0 = *(const f32x4*)(base + o); r1 = *(const f32x4*)(base + o + 4); }
    __device__ __forceinline__ void store(int row, int col, f32x4 v0, f32x4 v1, const Unit&, f32x4 b0, f32x4 b1) const {
        const size_t o = (size_t)row * 1024 + col;
        *(f32x4*)(P + o) = b0 * alpha + v0; *(f32x4*)(P + o + 4) = b1 * alpha + v1; } };
struct StPleGate { const bf16_t* PP; bf16_t* O;
    __device__ __forceinline__ void colctx(int, const Unit&, f32x4& c0, f32x4& c1) const { c0 = (f32x4){0.f, 0.f, 0.f, 0.f}; c1 = c0; }
    __device__ __forceinline__ void rowctx(int row, int col, f32x4& r0, f32x4& r1) const { r0 = *(const f32x4*)(PP + (size_t)row * 1024 + col); r1 = r0; }
    __device__ __forceinline__ void store(int row, int col, f32x4 v0, f32x4 v1, const Unit&, f32x4 pr, f32x4) const {
        const size_t o = (size_t)row * 1024 + col; const u32x4 p = __builtin_bit_cast(u32x4, pr);
        f32x4 r0, r1;
        r0[0] = sigmoidf_(v0[0]) * bf_lo(p.x); r0[1] = sigmoidf_(v0[1]) * bf_hi(p.x); r0[2] = sigmoidf_(v0[2]) * bf_lo(p.y); r0[3] = sigmoidf_(v0[3]) * bf_hi(p.y);
        r1[0] = sigmoidf_(v1[0]) * bf_lo(p.z); r1[1] = sigmoidf_(v1[1]) * bf_hi(p.z); r1[2] = sigmoidf_(v1[2]) * bf_lo(p.w); r1[3] = sigmoidf_(v1[3]) * bf_hi(p.w);
        *(u32x4*)(O + o) = pack8(r0, r1); } };
template <bool F8> struct StSwiglu { const float* bgu; bf16_t* H;
    __device__ __forceinline__ void rowctx(int, int, f32x4& r0, f32x4& r1) const { r0 = (f32x4){0.f, 0.f, 0.f, 0.f}; r1 = r0; }
    __device__ __forceinline__ float act(float g, float u) const { const float gt = __builtin_amdgcn_fmed3f(g, -INFINITY, 7.0f), up = __builtin_amdgcn_fmed3f(u, -7.0f, 7.0f);
        return (up + 1.0f) * (gt * __builtin_amdgcn_rcpf(1.0f + __builtin_amdgcn_exp2f(gt * -2.4554669595930157f))); }
    __device__ __forceinline__ void colctx(int col, const Unit& u, f32x4& c0, f32x4& c1) const { const float* b = bgu + (size_t)u.e * 2048 + col; c0 = *(const f32x4*)b; c1 = *(const f32x4*)(b + 4); }
    __device__ __forceinline__ void store(int row, int col, f32x4 v0, f32x4 v1, const Unit& u, f32x4, f32x4) const {
        if (F8) { unsigned w = 0u; w = __builtin_amdgcn_cvt_pk_fp8_f32(act(v0[0], v0[1]), act(v0[2], v0[3]), w, false); w = __builtin_amdgcn_cvt_pk_fp8_f32(act(v1[0], v1[1]), act(v1[2], v1[3]), w, true);
            *(unsigned*)((unsigned char*)H + (size_t)row * 1024 + (col >> 1)) = w; }
        else { u32x2 w; w.x = cvt_pk_bf16(act(v0[0], v0[1]), act(v0[2], v0[3])); w.y = cvt_pk_bf16(act(v1[0], v1[1]), act(v1[2], v1[3]));
            *(u32x2*)(H + (size_t)row * 1024 + (col >> 1)) = w; } } };
struct StDown { const float* bd; bf16_t* Y;
    __device__ __forceinline__ void rowctx(int, int, f32x4& r0, f32x4& r1) const { r0 = (f32x4){0.f, 0.f, 0.f, 0.f}; r1 = r0; }
    __device__ __forceinline__ void colctx(int col, const Unit& u, f32x4& c0, f32x4& c1) const { const float* b = bd + (size_t)u.e * 1024 + col; c0 = *(const f32x4*)b; c1 = *(const f32x4*)(b + 4); }
    __device__ __forceinline__ void store(int row, int col, f32x4 v0, f32x4 v1, const Unit& u, f32x4, f32x4) const {
        *(u32x4*)(Y + (size_t)row * 1024 + col) = pack8(v0, v1); } };

typedef int i32x8 __attribute__((ext_vector_type(8)));
typedef int i32x4 __attribute__((ext_vector_type(4)));
template <class Epi, class Sched, bool ALIGN_EPI = false, bool SP2 = false, unsigned FP8W = 0u, bool GATHER = false>
__device__ __forceinline__ void gemm_phase(PG8_LAS unsigned char* lds, const Gemm g, const Sched& S, const Epi& E) {
    int tid = threadIdx.x; asm volatile("" : "+v"(tid));
    const int wid = __builtin_amdgcn_readfirstlane(tid >> 6), lane = tid & 63, wr = wid >> 2, wc = wid & 3, fr = lane & 15, fq = lane >> 4;
    int K = g.K; asm volatile("" : "+s"(K));
    const int nt = K / BK;
    unsigned voffA[2], voffB[2], colA[2]; int rowA[2];
#pragma unroll
    for (int i = 0; i < 2; ++i) { int R, C; stage_rc(tid * 16 + i * 8192, R, C); const int Rb = Epi::PERM ? ((R & ~31) + perm32(R & 31)) : R;
        voffA[i] = (unsigned)(R * K + C) * 2u; voffB[i] = (unsigned)(Rb * K + C) * 2u; rowA[i] = R; colA[i] = (unsigned)C * 2u; }
    static_assert(!(GATHER && SP2), "gather mode: 8-phase schedule only");
    unsigned vA[2][2];
    PG8_LAS int* idl = (PG8_LAS int*)(lds + g.ids_off);
    const size_t kstep = (size_t)(BK * 2);
    const size_t hstep = (size_t)HALF * K * 2;
    const size_t tstep = 2 * hstep;
    const unsigned ldsw = (unsigned)wid * 1024u;
    const int aoff = lds_byte(wr * 64 + fr, fq * 8), boff = lds_byte(wc * 32 + fr, fq * 8);
#define PG8_SA(b, h) (((b) * 2 + (h)) * HTB)
#define PG8_SB(b, h) ((4 + (b) * 2 + (h)) * HTB)
#define PG8_STAGE(bufoff, gbase, voff) do { _Pragma("unroll") for (int _i = 0; _i < 2; ++_i) \
        __builtin_amdgcn_global_load_lds((const unsigned*)((const char*)(gbase) + (voff)[_i]), (PG8_LAS unsigned*)(lds + (bufoff) + ldsw + _i * 8192), 16, 0, 0); } while (0)
#define PG8_STAGE_A(bufoff, base, h) do { if constexpr (GATHER) PG8_STAGE(bufoff, base, vA[h]); else PG8_STAGE(bufoff, (base) + (h) * hstep, voffA); } while (0)
#define PG8_CAT(lo, hi) __builtin_shufflevector((lo), (hi), 0, 1, 2, 3, 4, 5, 6, 7)
#define PG8_LDA(dst, b, h) do { if constexpr (FP8W != 0u) { _Pragma("unroll") for (int m = 0; m < 4; ++m) dst##8[m] = PG8_CAT(*(const PG8_LAS i32x4*)(lds + PG8_SA(b, h) + aoff + m * 2048), *(const PG8_LAS i32x4*)(lds + PG8_SA(b, h) + aoff + m * 2048 + 1024)); } \
        else { _Pragma("unroll") for (int m = 0; m < 4; ++m) _Pragma("unroll") for (int k = 0; k < 2; ++k) dst[m][k] = *(const PG8_LAS bf16x8*)(lds + PG8_SA(b, h) + aoff + m * 2048 + k * 1024); } } while (0)
#define PG8_LDB(dst, b, h) do { if constexpr (FP8W != 0u) { _Pragma("unroll") for (int n = 0; n < 2; ++n) dst##8[n] = PG8_CAT(*(const PG8_LAS i32x4*)(lds + PG8_SB(b, h) + boff + n * 2048), *(const PG8_LAS i32x4*)(lds + PG8_SB(b, h) + boff + n * 2048 + 1024)); } \
        else { _Pragma("unroll") for (int n = 0; n < 2; ++n) _Pragma("unroll") for (int k = 0; k < 2; ++k) dst[n][k] = *(const PG8_LAS bf16x8*)(lds + PG8_SB(b, h) + boff + n * 2048 + k * 1024); } } while (0)
#define PG8_MMA(ai, bj, At, Bt) do { __builtin_amdgcn_s_setprio(1); _Pragma("unroll") for (int m = 0; m < 4; ++m) _Pragma("unroll") for (int n = 0; n < 2; ++n) { \
        if constexpr (FP8W != 0u) asm volatile("v_mfma_scale_f32_16x16x128_f8f6f4 %0, %1, %2, %0, %3, %4 op_sel_hi:[0,0,0]" : "+v"(acc[ai][bj][m][n]) : "v"(Bt##8[n]), "v"(At##8[m]), "v"(sc_w), "v"(sc_x));   \
        else { _Pragma("unroll") for (int k = 0; k < 2; ++k) acc[ai][bj][m][n] = __builtin_amdgcn_mfma_f32_16x16x32_bf16(Bt[n][k], At[m][k], acc[ai][bj][m][n], 0, 0, 0); } } __builtin_amdgcn_s_setprio(0); } while (0)
#define PG8_WAIT_V(n) asm volatile("s_waitcnt vmcnt(" #n ")" ::: "memory")
#define PG8_WAIT_L(n) asm volatile("s_waitcnt lgkmcnt(" #n ")" ::: "memory")
#define PG8_BAR __builtin_amdgcn_s_barrier()
#define PG8_SCHED __builtin_amdgcn_sched_barrier(0)
    Unit cur, nxt; int ui = 0;
    if (!S.next(0, cur)) return;
    f32x4 acc[2][2][4][2];
#pragma unroll
    for (int a = 0; a < 2; ++a)
#pragma unroll
        for (int b = 0; b < 2; ++b)
#pragma unroll
            for (int m = 0; m < 4; ++m)
#pragma unroll
                for (int n = 0; n < 2; ++n) acc[a][b][m][n] = (f32x4){0.f, 0.f, 0.f, 0.f};
    bf16x8 At[4][2], B0[2][2], B1[2][2];
    int sc_w = (int)FP8W, sc_x = 0x7f7f7f7f; asm volatile("" : "+v"(sc_w), "+v"(sc_x));
    i32x8 At8[4], B08[2], B18[2];
    const char* cA = (const char*)g.A + (GATHER ? (size_t)0 : (size_t)cur.pm * tstep); const char* cB = (const char*)g.Bt + (size_t)cur.pn * tstep + cur.bofs;
    S.a_ready(cur);
    if constexpr (GATHER) {
#pragma unroll
        for (int h = 0; h < 2; ++h)
#pragma unroll
            for (int i = 0; i < 2; ++i) vA[h][i] = (unsigned)(g.rowmap[256 * cur.pm + 128 * h + rowA[i]] & 16383) * (unsigned)(K * 2) + colA[i];
    }
    if constexpr (SP2) {
        PG8_STAGE(PG8_SB(0, 0), cB, voffB); PG8_STAGE(PG8_SB(0, 1), cB + hstep, voffB); PG8_STAGE(PG8_SA(0, 0), cA, voffA); PG8_STAGE(PG8_SA(0, 1), cA + hstep, voffA);
        if (wr == 1) PG8_BAR;
        PG8_WAIT_V(2); PG8_BAR;
        PG8_STAGE(PG8_SB(1, 0), cB + kstep, voffB); PG8_STAGE(PG8_SA(1, 0), cA + kstep, voffA); PG8_STAGE(PG8_SB(1, 1), cB + hstep + kstep, voffB);
        PG8_WAIT_V(6); PG8_BAR;
    } else {
        PG8_STAGE(PG8_SB(0, 0), cB, voffB); PG8_STAGE_A(PG8_SA(0, 0), cA, 0); PG8_STAGE(PG8_SB(0, 1), cB + hstep, voffB); PG8_STAGE_A(PG8_SA(0, 1), cA, 1);
        if (wr == 1) PG8_BAR;
        PG8_WAIT_V(4); PG8_BAR;
        PG8_STAGE(PG8_SB(1, 0), cB + kstep, voffB); PG8_STAGE_A(PG8_SA(1, 0), cA + kstep, 0); PG8_STAGE(PG8_SB(1, 1), cB + hstep + kstep, voffB);
        PG8_WAIT_V(6); PG8_BAR;
    }
    for (;;) {
        const bool has_next = S.next(ui + 1, nxt);
        if constexpr (GATHER) {
            if (has_next && wid < 4) __builtin_amdgcn_global_load_lds((const unsigned*)(g.rowmap + 256 * nxt.pm + tid), (PG8_LAS unsigned*)((PG8_LAS unsigned char*)idl + wid * 256), 4, 0, 0);
        }
        const char* nA = GATHER ? (const char*)g.A : has_next ? (const char*)g.A + (size_t)nxt.pm * tstep : cA; const char* nB = has_next ? (const char*)g.Bt + (size_t)nxt.pn * tstep + nxt.bofs : cB;
        for (int t = 0; t < nt; t += 2) {
            const bool last = (t == nt - 2);
            const char* a1 = cA + (size_t)(t + 1) * kstep;
            const char* a2 = last ? nA : cA + (size_t)(t + 2) * kstep; const char* b2 = last ? nB : cB + (size_t)(t + 2) * kstep;
            const char* a3 = a2 + kstep; const char* b3 = b2 + kstep;
            if (last && has_next) S.a_ready(nxt);
            if constexpr (SP2) {
            PG8_LDB(B0, 0, 0); PG8_LDB(B1, 0, 1); PG8_SCHED; PG8_LDA(At, 0, 0); PG8_STAGE(PG8_SA(1, 1), a1 + hstep, voffA);
            PG8_WAIT_V(8); PG8_WAIT_L(0); PG8_BAR; PG8_MMA(0, 0, At, B0); PG8_MMA(0, 1, At, B1); PG8_BAR; PG8_SCHED;
            PG8_LDA(At, 0, 1); PG8_STAGE(PG8_SB(0, 0), b2, voffB); PG8_STAGE(PG8_SB(0, 1), b2 + hstep, voffB); PG8_STAGE(PG8_SA(0, 0), a2, voffA);
            PG8_WAIT_V(8); PG8_WAIT_L(0); PG8_BAR; PG8_MMA(1, 0, At, B0); PG8_MMA(1, 1, At, B1); PG8_BAR; PG8_SCHED;
            PG8_LDB(B0, 1, 0); PG8_LDB(B1, 1, 1); PG8_SCHED; PG8_LDA(At, 1, 0); PG8_STAGE(PG8_SA(0, 1), a2 + hstep, voffA);
            PG8_WAIT_V(8); PG8_WAIT_L(0); PG8_BAR; PG8_MMA(0, 0, At, B0); PG8_MMA(0, 1, At, B1); PG8_BAR; PG8_SCHED;
            PG8_LDA(At, 1, 1); PG8_STAGE(PG8_SB(1, 0), b3, voffB); PG8_STAGE(PG8_SB(1, 1), b3 + hstep, voffB); PG8_STAGE(PG8_SA(1, 0), a3, voffA);
            PG8_WAIT_V(8); PG8_WAIT_L(0); PG8_BAR; PG8_MMA(1, 0, At, B0); PG8_MMA(1, 1, At, B1); PG8_BAR; PG8_SCHED;
            } else {
            PG8_LDB(B0, 0, 0); PG8_SCHED; PG8_LDA(At, 0, 0); PG8_STAGE_A(PG8_SA(1, 1), a1, 1);
            PG8_WAIT_L(8); PG8_BAR; PG8_WAIT_L(0); PG8_MMA(0, 0, At, B0); PG8_BAR; PG8_SCHED;
            if constexpr (GATHER) {
                if (last && has_next) {
#pragma unroll
                    for (int h = 0; h < 2; ++h)
#pragma unroll
                        for (int i = 0; i < 2; ++i) vA[h][i] = (unsigned)(idl[128 * h + rowA[i]] & 16383) * (unsigned)(K * 2) + colA[i];
                }
                PG8_SCHED;
            }
            PG8_LDB(B1, 0, 1); PG8_STAGE(PG8_SB(0, 0), b2, voffB);
            PG8_BAR; PG8_WAIT_L(0); PG8_MMA(0, 1, At, B1); PG8_BAR;
            PG8_LDA(At, 0, 1); PG8_STAGE_A(PG8_SA(0, 0), a2, 0);
            PG8_BAR; PG8_WAIT_L(0); PG8_MMA(1, 0, At, B0); PG8_BAR; PG8_SCHED;
            PG8_STAGE(PG8_SB(0, 1), b2 + hstep, voffB);
            PG8_WAIT_V(6); PG8_BAR; PG8_MMA(1, 1, At, B1); PG8_BAR;
            PG8_LDB(B0, 1, 0); PG8_SCHED; PG8_LDA(At, 1, 0); PG8_STAGE_A(PG8_SA(0, 1), a2, 1);
            PG8_WAIT_L(8); PG8_BAR; PG8_WAIT_L(0); PG8_MMA(0, 0, At, B0); PG8_BAR; PG8_SCHED;
            PG8_LDB(B1, 1, 1); PG8_STAGE(PG8_SB(1, 0), b3, voffB);
            PG8_BAR; PG8_WAIT_L(0); PG8_MMA(0, 1, At, B1); PG8_BAR;
            PG8_LDA(At, 1, 1); PG8_STAGE_A(PG8_SA(1, 0), a3, 0);
            PG8_BAR; PG8_WAIT_L(0); PG8_MMA(1, 0, At, B0); PG8_BAR; PG8_SCHED;
            PG8_STAGE(PG8_SB(1, 1), b3 + hstep, voffB);
            PG8_WAIT_V(6); PG8_BAR; PG8_MMA(1, 1, At, B1); PG8_BAR;
            }
        }
        if constexpr (FP8W != 0u) asm volatile("s_nop 15\n\ts_nop 15" ::: "memory");
        if constexpr (ALIGN_EPI) { if (wr == 0) PG8_BAR; }
        if constexpr (!Epi::AFTER_DRAIN) { E(acc, cur, wr, wc, fr, fq); S.done(cur); }
        if (!has_next) break;
#pragma unroll
        for (int a = 0; a < 2; ++a)
#pragma unroll
            for (int b = 0; b < 2; ++b)
#pragma unroll
                for (int m = 0; m < 4; ++m)
#pragma unroll
                    for (int n = 0; n < 2; ++n) acc[a][b][m][n] = (f32x4){0.f, 0.f, 0.f, 0.f};
        cur = nxt; cA = nA; cB = nB; ++ui;
        if constexpr (ALIGN_EPI) { if (wr == 1) PG8_BAR; }
    }
    PG8_WAIT_V(0);
    if constexpr (!ALIGN_EPI) { if (wr == 0) PG8_BAR; }
    PG8_BAR;
    if constexpr (Epi::AFTER_DRAIN) { E.fused(acc, cur, wr, wc, fr, fq, lds, wid, lane); S.done(cur); }
#undef PG8_SA
#undef PG8_SB
#undef PG8_STAGE
#undef PG8_STAGE_A
#undef PG8_LDA
#undef PG8_CAT
#undef PG8_LDB
#undef PG8_MMA
#undef PG8_WAIT_V
#undef PG8_WAIT_L
#undef PG8_BAR
#undef PG8_SCHED
}
}

constexpr int NWAVES = 8, NTHREADS = 512;
constexpr int BATCH = 2, SEQ = 8192, M = BATCH * SEQ, D = 1024;
constexpr int NEXP = 32, DEXP = 1024;
constexpr int PMAX = M * 4 + NEXP * 256, NTMAX = PMAX / 256;
constexpr float ALPHA = 1.41421356237f;
constexpr int NPHASES = 21;
#ifndef MOE_FP8
#define MOE_FP8 1
#endif
constexpr bool kMoeFp8 = (MOE_FP8 != 0);
constexpr unsigned kScaleGU = 0x79797979u, kScaleDN = 0x78787878u;
#ifndef MK_N_LAUNCHES
#define MK_N_LAUNCHES 1
#endif
constexpr int N_LAUNCHES = MK_N_LAUNCHES;

enum { I_X = 0, I_P, I_AB_WIN, I_AB_QG, I_AB_KVG, I_AB_WUQ, I_AB_WUK, I_AB_WUV, I_AB_WQIDX, I_AB_KIG, I_AB_KIB, I_AB_CONVW, I_AB_ALOG, I_AB_DTB, I_AB_ONG, I_AB_WOUT,
       I_CD_WIN, I_CD_POOLW, I_CD_POOLS, I_CD_WOUT, I_LNM_G, I_LNM_B, I_RW, I_RB, I_WGU, I_BGU, I_WDN, I_BDN, I_PLE_WP, I_PLE_WG, I_LNF_G, I_LNF_B, N_IN };

constexpr size_t MiB = 1u << 20;
constexpr size_t WS_CTL = 0, CTL_ZERO_BYTES = 1 * MiB;
constexpr size_t WS_W_INAB = 1 * MiB;
constexpr size_t WS_W_ABS = 6 * MiB;
constexpr size_t WS_W_OUTAB = 7 * MiB;
constexpr size_t WS_W_INCD = 10 * MiB;
constexpr size_t WS_W_OUTCD = 15 * MiB;
constexpr size_t WS_W_PG = 17 * MiB;
constexpr size_t WS_W_PP = 21 * MiB;
constexpr size_t WS_W_GU = 22 * MiB;
constexpr size_t WS_W_DN = 278 * MiB;
constexpr size_t WS_XB = 406 * MiB;
constexpr size_t WS_PB = 438 * MiB;
constexpr size_t WS_PP = 454 * MiB;
constexpr size_t WS_SM = 518 * MiB;
constexpr size_t WS_QKVZ = 550 * MiB;
constexpr size_t WS_CQ = 630 * MiB;
constexpr size_t WS_CKV = 638 * MiB;
constexpr size_t WS_KIDX = 642 * MiB;
constexpr size_t WS_WIDX = 644 * MiB;
constexpr size_t WS_BETA = 645 * MiB;
constexpr size_t WS_GG = WS_BETA + 512 * 1024;
constexpr size_t WS_QN = 646 * MiB, WS_KN = 662 * MiB, WS_VN = 678 * MiB;
constexpr size_t WS_QL = 694 * MiB;
constexpr size_t WS_CHK = 742 * MiB;
constexpr size_t WS_SEL = 838 * MiB;
constexpr size_t WS_NSEL = 854 * MiB;
constexpr size_t WS_ODELTA = 855 * MiB;
constexpr size_t WS_AO = 887 * MiB;
constexpr size_t WS_PRE = 935 * MiB;
constexpr size_t WS_H1 = 999 * MiB;
constexpr size_t WS_H2 = 1063 * MiB;
constexpr size_t WS_H1B = 1127 * MiB;
constexpr size_t WS_PLE = 1159 * MiB;
constexpr size_t WS_ROUTE = 1191 * MiB;
constexpr size_t WS_BIG = 1193 * MiB;
constexpr size_t WS_XS = WS_BIG, WS_HID = WS_BIG + 144 * MiB, WS_YS = WS_BIG + 288 * MiB;
constexpr size_t WS_END = WS_BIG + 512 * MiB;
static_assert((size_t)PMAX * 1024 * 2 <= 144 * MiB && WS_END <= 2048 * MiB, "d_ws map");
constexpr size_t CHK_WP = 0, CHK_QD = 16384, CHK_KDT = 32768, CHK_QK = 49152, CHK_UT = 57344, CHK_GL = 90112, CHK_STRIDE = 92160;
static_assert(CHK_STRIDE * 1024 <= 96 * MiB, "chunk operands");
constexpr int CW_TMO = 0, CW_CODE = 1;
constexpr int CW_BAR = 4096;
constexpr int CW_BAR2 = 8192;
constexpr int CW_CNT = 16384;

constexpr int RING_OFF = 0, RING_BYTES = 131072;
constexpr int WSCR_OFF = 132096, WSCR_BYTES = 1024;
constexpr int MISC_OFF = 140288;
constexpr int LDS_BYTES = 147456;

#define GAS __attribute__((address_space(1)))
#define LAS __attribute__((address_space(3)))
typedef unsigned short bf16;
typedef unsigned v4u __attribute__((ext_vector_type(4)));
typedef unsigned v2u __attribute__((ext_vector_type(2)));
typedef float f32x4 __attribute__((ext_vector_type(4)));
typedef short bf16x8 __attribute__((ext_vector_type(8)));
typedef GAS unsigned gu32;
#define RLX_AGENT __ATOMIC_RELAXED, __HIP_MEMORY_SCOPE_AGENT
typedef float f32x2_t __attribute__((ext_vector_type(2)));
typedef __bf16 bf16x2_t __attribute__((ext_vector_type(2)));
__device__ __forceinline__ unsigned pk2(float lo, float hi) { const f32x2_t v = {lo, hi}; const bf16x2_t b = __builtin_convertvector(v, bf16x2_t); return __builtin_bit_cast(unsigned, b); }
__device__ __forceinline__ unsigned f2bf(float f) { return pk2(f, 0.f) & 0xffffu; }
__device__ __forceinline__ float bflo(unsigned w) { return __uint_as_float(w << 16); }
__device__ __forceinline__ float bfhi(unsigned w) { return __uint_as_float(w & 0xffff0000u); }
__device__ __forceinline__ float bf1(bf16 h) { return __uint_as_float(((unsigned)h) << 16); }
__device__ __forceinline__ float sigm(float x) { return __builtin_amdgcn_rcpf(1.0f + __builtin_amdgcn_exp2f(x * -1.4426950408889634f)); }
__device__ __forceinline__ float siluf(float x) { return x * __builtin_amdgcn_rcpf(1.0f + __builtin_amdgcn_exp2f(x * -1.4426950408889634f)); }
__device__ __forceinline__ float wave_sum(float v) {
#pragma unroll
    for (int o = 1; o < 64; o <<= 1) v += __shfl_xor(v, o);
    return v;
}
__device__ __forceinline__ float wave_max(float v) {
#pragma unroll
    for (int o = 1; o < 64; o <<= 1) v = fmaxf(v, __shfl_xor(v, o));
    return v;
}
__device__ __forceinline__ int wave_sum_i(int v) {
#pragma unroll
    for (int o = 1; o < 64; o <<= 1) v += __shfl_xor(v, o);
    return v;
}
__device__ __forceinline__ void unpack8(const v4u w, float (&f)[8]) { f[0] = bflo(w.x); f[1] = bfhi(w.x); f[2] = bflo(w.y); f[3] = bfhi(w.y); f[4] = bflo(w.z); f[5] = bfhi(w.z); f[6] = bflo(w.w); f[7] = bfhi(w.w); }
__device__ __forceinline__ v4u pack8f(const float (&f)[8]) { v4u w; w.x = pk2(f[0], f[1]); w.y = pk2(f[2], f[3]); w.z = pk2(f[4], f[5]); w.w = pk2(f[6], f[7]); return w; }

#define XB_TMO      128
#define XB_XCNT(j)  (256  + 64 * (j))
#define XB_XSUB(j)  (1280 + 64 * (j))
#define XB_XGEN(j)  (2304 + 64 * (j))
#define XB_TOP      3328
#define XB_TOPGEN   3392
#define XCD_BAR_WORDS 3456
#define XB_SPIN_CAP (1u << 18)

__device__ __forceinline__ unsigned xb_ld(unsigned* p)              { return __hip_atomic_load(p, __ATOMIC_RELAXED, __HIP_MEMORY_SCOPE_AGENT); }
__device__ __forceinline__ unsigned xb_add(unsigned* p, unsigned v) { return __hip_atomic_fetch_add(p, v, __ATOMIC_RELAXED, __HIP_MEMORY_SCOPE_AGENT); }
__device__ __forceinline__ unsigned xb_xcc_id() { return (unsigned)__builtin_amdgcn_s_getreg((3 << 11) | 20) & 0xFu; }
#define XB_SPIN(cond, bar) do { unsigned _sp = 0; while (cond) { __builtin_amdgcn_s_sleep(1); \
    if ((++_sp & 255u) == 0u) { if (xb_ld(&(bar)[XB_TMO])) break; if (_sp > XB_SPIN_CAP) { atomicAdd(&(bar)[XB_TMO], 1u); break; } } } } while (0)

struct XcdBarrier {
    unsigned* bar; unsigned x;
    unsigned expect;
    volatile LAS unsigned* st;
};

__device__ __forceinline__ XcdBarrier xcd_barrier_post(unsigned* bar, volatile LAS unsigned* st, unsigned expect = 0u) {
    XcdBarrier b; b.bar = bar; b.x = xb_xcc_id(); b.st = st; b.expect = expect ? expect : gridDim.x * gridDim.y * gridDim.z;
    if (threadIdx.x == 0) (void)xb_add(&bar[XB_XCNT(b.x)], 1u);
    return b;
}
__device__ __forceinline__ void xcd_barrier_complete(unsigned* bar, unsigned x, unsigned& nloc, unsigned& nx, const unsigned G) {
    unsigned sum, cnt, mine, sp = 0u;
    for (;;) {
        sum = 0u; cnt = 0u; mine = 0u;
#pragma unroll
        for (unsigned j = 0; j < 16; ++j) { const unsigned c = xb_ld(&bar[XB_XCNT(j)]); sum += c; cnt += (c > 0u) ? 1u : 0u; mine = (j == x) ? c : mine; }
        if (sum == G) break;
        __builtin_amdgcn_s_sleep(1);
        if ((++sp & 255u) == 0u) { if (xb_ld(&bar[XB_TMO])) break; if (sp > XB_SPIN_CAP) { atomicAdd(&bar[XB_TMO], 1u); break; } }
    }
    nloc = mine > 0u ? mine : 1u; nx = cnt > 0u ? cnt : 1u;
}

__device__ __forceinline__ void xcd_barrier(const XcdBarrier& b) {
    asm volatile("s_waitcnt vmcnt(0)" ::: "memory");
    __syncthreads();
    if (threadIdx.x == 0) {
        unsigned* bar = b.bar;
        __builtin_amdgcn_s_waitcnt(0);
        unsigned nloc = b.st[0], nx = b.st[1];
        if (nloc == 0u) { xcd_barrier_complete(bar, b.x, nloc, nx, b.expect); b.st[0] = nloc; b.st[1] = nx; }
        const unsigned old = xb_add(&bar[XB_XSUB(b.x)], 1u);
        const unsigned gen = old / nloc;
        if (old + 1u == (gen + 1u) * nloc) {
            __builtin_amdgcn_fence(__ATOMIC_RELEASE, "agent");
            asm volatile("s_waitcnt vmcnt(0)" ::: "memory");
            const unsigned og = xb_add(&bar[XB_TOP], 1u);
            const unsigned tg = og / nx;
            if (og + 1u == (tg + 1u) * nx) xb_add(&bar[XB_TOPGEN], 1u);
            else XB_SPIN(xb_ld(&bar[XB_TOPGEN]) == tg, bar);
            __builtin_amdgcn_fence(__ATOMIC_ACQUIRE, "agent");
            xb_add(&bar[XB_XGEN(b.x)], 1u);
            asm volatile("s_waitcnt vmcnt(0)" ::: "memory");
        } else {
            XB_SPIN(xb_ld(&bar[XB_XGEN(b.x)]) == gen, bar);
            __builtin_amdgcn_fence(__ATOMIC_ACQUIRE, "agent");
            asm volatile("s_waitcnt vmcnt(0)" ::: "memory");
        }
    }
    __syncthreads();
}

struct Args { const float* in[N_IN]; float* out; unsigned char* ws; int ph_lo, ph_hi, li, pad; };
typedef const __attribute__((address_space(4))) Args* KArgs;
__device__ __forceinline__ KArgs kargs() { auto p = __builtin_amdgcn_kernarg_segment_ptr(); asm volatile("" : "+s"(p)); return (KArgs)p; }
struct Frame {
    LAS unsigned char* lds;
    int tid, lane, wave, G, bid;
    unsigned char* ws;
    gu32* ctl;
};
#define WSP(T, off) ((T*)(F.ws + (off)))

struct MapId { __device__ __forceinline__ int operator()(int n) const { return n; } };
struct MapAdd { int off; __device__ __forceinline__ int operator()(int n) const { return n + off; } };
struct MapAB { __device__ __forceinline__ int operator()(int n) const { return n < 456 ? n : (n < 2504 ? n + 56 : n - 2048); } };
template <class Map> __device__ __forceinline__ void wg_transpose_item(const float* W, int N, int ldw, bf16* WT, int ldt, int koff, Map map, LAS float* scr, int item, int tid) {
    const int nblk = (N + 127) >> 7, kb = item / nblk, nb = item - kb * nblk, k0 = kb * 128, n0 = nb * 128;
#pragma unroll
    for (int it = 0; it < 8; ++it) {
        const int row = it * 16 + (tid >> 5), c4 = (tid & 31) * 4, n = n0 + c4;
        f32x4 v = (f32x4){0.f, 0.f, 0.f, 0.f};
        if (n + 3 < N) v = *(const f32x4*)(W + (size_t)(k0 + row) * ldw + n);
        LAS float* s = scr + row * 129 + c4; s[0] = v[0]; s[1] = v[1]; s[2] = v[2]; s[3] = v[3];
    }
    __syncthreads();
#pragma unroll
    for (int j = 0; j < 4; ++j) {
        const int idx = j * 512 + tid, nl = idx >> 4, ch = idx & 15, n = n0 + nl;
        if (n < N) { const LAS float* s = scr + (ch * 8) * 129 + nl;
            v4u o; o.x = pk2(s[0], s[129]); o.y = pk2(s[2 * 129], s[3 * 129]); o.z = pk2(s[4 * 129], s[5 * 129]); o.w = pk2(s[6 * 129], s[7 * 129]);
            *(v4u*)(WT + (size_t)map(n) * ldt + koff + k0 + ch * 8) = o; }
    }
    __syncthreads();
}
__device__ __forceinline__ void wg_transpose_item_fp8(const float* W, int N, int ldw, unsigned char* WT, int ldt, float mul, LAS float* scr, int item, int tid) {
    const int nblk = (N + 127) >> 7, kb = item / nblk, nb = item - kb * nblk, k0 = kb * 128, n0 = nb * 128;
#pragma unroll
    for (int it = 0; it < 8; ++it) {
        const int row = it * 16 + (tid >> 5), c4 = (tid & 31) * 4;
        const f32x4 v = *(const f32x4*)(W + (size_t)(k0 + row) * ldw + n0 + c4);
        LAS float* s = scr + row * 129 + c4; s[0] = v[0]; s[1] = v[1]; s[2] = v[2]; s[3] = v[3];
    }
    __syncthreads();
#pragma unroll
    for (int j = 0; j < 2; ++j) {
        const int idx = j * 512 + tid, nl = idx >> 3, ch = idx & 7;
        const LAS float* s = scr + (ch * 16) * 129 + nl;
        v4u o;
#pragma unroll
        for (int q = 0; q < 4; ++q) { unsigned w = 0u;
            w = __builtin_amdgcn_cvt_pk_fp8_f32(s[(4 * q) * 129] * mul, s[(4 * q + 1) * 129] * mul, w, false);
            w = __builtin_amdgcn_cvt_pk_fp8_f32(s[(4 * q + 2) * 129] * mul, s[(4 * q + 3) * 129] * mul, w, true);
            o[q] = w; }
        *(v4u*)(WT + (size_t)(n0 + nl) * ldt + k0 + ch * 16) = o;
    }
    __syncthreads();
}
struct MoeItem { const float* W; unsigned char* WT; int N; float mul; int k0, n0; };
__device__ __forceinline__ MoeItem moe_item(KArgs A, unsigned char* ws, int it) {
    MoeItem d; int sub;
    if (it < 64 * 128) { const int m = it >> 7; sub = it & 127; d.W = A->in[I_WGU] + (size_t)m * 1024 * 2048; d.N = 2048; d.WT = ws + WS_W_GU + (size_t)m * 2048 * 1024; d.mul = 64.0f; }
    else { it -= 64 * 128; const int m = it >> 6; sub = it & 63; d.W = A->in[I_WDN] + (size_t)m * 1024 * 1024; d.N = 1024; d.WT = ws + WS_W_DN + (size_t)m * 1024 * 1024; d.mul = 128.0f; }
    const int nblk = d.N >> 7, kb = sub / nblk, nb = sub - kb * nblk; d.k0 = kb * 128; d.n0 = nb * 128; return d;
}
__device__ __forceinline__ void p0_moe_fp8(Frame& F, KArgs A) {
    LAS float* scr = (LAS float*)(F.lds + RING_OFF);
    const int tid = F.tid; constexpr int NIT = 64 * 128 + 64 * 64;
    int it = F.bid; if (it >= NIT) return;
    MoeItem cur = moe_item(A, F.ws, it);
    f32x4 r[8];
#pragma unroll
    for (int x = 0; x < 8; ++x) r[x] = __builtin_nontemporal_load((const f32x4*)(cur.W + (size_t)(cur.k0 + x * 16 + (tid >> 5)) * cur.N + cur.n0 + (tid & 31) * 4));
    for (;;) {
#pragma unroll
        for (int x = 0; x < 8; ++x) { LAS float* sp = scr + (x * 16 + (tid >> 5)) * 129 + (tid & 31) * 4; sp[0] = r[x][0]; sp[1] = r[x][1]; sp[2] = r[x][2]; sp[3] = r[x][3]; }
        __syncthreads();
        const int nx = it + F.G; MoeItem nxt = cur;
        if (nx < NIT) { nxt = moe_item(A, F.ws, nx);
#pragma unroll
            for (int x = 0; x < 8; ++x) r[x] = __builtin_nontemporal_load((const f32x4*)(nxt.W + (size_t)(nxt.k0 + x * 16 + (tid >> 5)) * nxt.N + nxt.n0 + (tid & 31) * 4)); }
#pragma unroll
        for (int j = 0; j < 2; ++j) {
            const int idx = j * 512 + tid, nl = idx >> 3, ch = idx & 7;
            const LAS float* sp = scr + (ch * 16) * 129 + nl;
            v4u o;
#pragma unroll
            for (int q = 0; q < 4; ++q) { unsigned w = 0u;
                w = __builtin_amdgcn_cvt_pk_fp8_f32(sp[(4 * q) * 129] * cur.mul, sp[(4 * q + 1) * 129] * cur.mul, w, false);
                w = __builtin_amdgcn_cvt_pk_fp8_f32(sp[(4 * q + 2) * 129] * cur.mul, sp[(4 * q + 3) * 129] * cur.mul, w, true);
                o[q] = w; }
            *(v4u*)(cur.WT + (size_t)(cur.n0 + nl) * 1024 + cur.k0 + ch * 16) = o;
        }
        __syncthreads();
        if (nx >= NIT) break;
        cur = nxt; it = nx;
    }
}
__device__ __forceinline__ void p0_prologue(Frame& F, KArgs A) {
    LAS float* scr = (LAS float*)(F.lds + RING_OFF);
    const int tid = F.tid;
    constexpr int IT_GU = 128, IT_DN = 64;
    constexpr int N_GU = 64 * IT_GU, N_DN = 64 * IT_DN;
    constexpr int N_INAB = 8 * 20, N_INCD = 8 * 20, N_OUTCD = 64, N_PG = 2 * 64, N_PP = 2 * 2 * 8, N_QIDX = 2 * 4, N_OUTB = 4 * 8;
    constexpr int NITEMS = N_GU + N_DN + N_INAB + N_INCD + N_OUTCD + N_PG + N_PP + N_QIDX + N_OUTB;
    if (kMoeFp8) p0_moe_fp8(F, A);
    for (int it = F.bid + (kMoeFp8 ? N_GU + N_DN : 0); it < NITEMS; it += F.G) {
        int r = it;
        if (r < N_GU) { const int m = r / IT_GU;
            if (kMoeFp8) wg_transpose_item_fp8(A->in[I_WGU] + (size_t)m * 1024 * 2048, 2048, 2048, WSP(unsigned char, WS_W_GU) + (size_t)m * 2048 * 1024, 1024, 64.0f, scr, r % IT_GU, tid);
            else wg_transpose_item(A->in[I_WGU] + (size_t)m * 1024 * 2048, 2048, 2048, WSP(bf16, WS_W_GU) + (size_t)m * 2048 * 1024, 1024, 0, MapId{}, scr, r % IT_GU, tid);
            continue; } r -= N_GU;
        if (r < N_DN) { const int m = r / IT_DN;
            if (kMoeFp8) wg_transpose_item_fp8(A->in[I_WDN] + (size_t)m * 1024 * 1024, 1024, 1024, WSP(unsigned char, WS_W_DN) + (size_t)m * 1024 * 1024, 1024, 128.0f, scr, r % IT_DN, tid);
            else wg_transpose_item(A->in[I_WDN] + (size_t)m * 1024 * 1024, 1024, 1024, WSP(bf16, WS_W_DN) + (size_t)m * 1024 * 1024, 1024, 0, MapId{}, scr, r % IT_DN, tid);
            continue; } r -= N_DN;
        if (r < N_INAB) { wg_transpose_item(A->in[I_AB_WIN], 2512, 2512, WSP(bf16, WS_W_INAB), 1024, 0, MapAB{}, scr, r, tid); continue; } r -= N_INAB;
        if (r < N_INCD) { wg_transpose_item(A->in[I_CD_WIN], 2560, 2560, WSP(bf16, WS_W_INCD), 1024, 0, MapId{}, scr, r, tid); continue; } r -= N_INCD;
        if (r < N_OUTCD) { wg_transpose_item(A->in[I_CD_WOUT], 1024, 1024, WSP(bf16, WS_W_OUTCD), 1024, 0, MapId{}, scr, r, tid); continue; } r -= N_OUTCD;
        if (r < N_PG) { const int l = r / 64; wg_transpose_item(A->in[I_PLE_WG] + (size_t)l * 1024 * 1024, 1024, 1024, WSP(bf16, WS_W_PG) + (size_t)l * 1024 * 1024, 1024, 0, MapId{}, scr, r % 64, tid); continue; } r -= N_PG;
        if (r < N_PP) { const int l = r / 16; wg_transpose_item(A->in[I_PLE_WP] + (size_t)l * 256 * 1024, 1024, 1024, WSP(bf16, WS_W_PP) + (size_t)l * 1024 * 256, 256, 0, MapId{}, scr, r % 16, tid); continue; } r -= N_PP;
        if (r < N_QIDX) { wg_transpose_item(A->in[I_AB_WQIDX], 512, 512, WSP(bf16, WS_W_ABS), 256, 0, MapAdd{1024}, scr, r, tid); continue; } r -= N_QIDX;
        wg_transpose_item(A->in[I_AB_WOUT] + (size_t)512 * 1024, 1024, 1024, WSP(bf16, WS_W_OUTAB), 1536, 1024, MapId{}, scr, r, tid);
    }
    const size_t gt = (size_t)F.bid * NTHREADS + tid, GT = (size_t)F.G * NTHREADS;
    for (size_t i = gt; i < (size_t)48 * 1024 / 8; i += GT) *(v4u*)(WSP(bf16, WS_W_INAB) + (size_t)464 * 1024 + i * 8) = (v4u){0u, 0u, 0u, 0u};
    for (size_t i = gt; i < (size_t)1024 * 256; i += GT) {
        const int n = (int)(i >> 8), c = (int)(i & 255), h = n >> 7, r = n & 127;
        const float* a = A->in[I_AB_WUQ] + (size_t)c * 512 + h * 64; const float* b = A->in[I_AB_WUK] + (size_t)r * 512 + h * 64;
        float s = 0.f;
#pragma unroll 8
        for (int d = 0; d < 64; d += 4) { const f32x4 x = *(const f32x4*)(a + d), y = *(const f32x4*)(b + d); s += x[0] * y[0] + x[1] * y[1] + x[2] * y[2] + x[3] * y[3]; }
        WSP(bf16, WS_W_ABS)[i] = (bf16)f2bf(s * 0.125f);
    }
    for (size_t i = gt; i < (size_t)1024 * 128; i += GT) {
        const int n = (int)(i & 1023), k0 = (int)(i >> 10) * 8, h = k0 >> 7, r0 = k0 & 127;
        const float* bcol = A->in[I_AB_WOUT] + (size_t)(h * 64) * 1024 + n;
        float acc[8];
#pragma unroll
        for (int x = 0; x < 8; ++x) acc[x] = 0.f;
#pragma unroll 2
        for (int v0 = 0; v0 < 64; v0 += 8) {
            float bv[8];
#pragma unroll
            for (int v = 0; v < 8; ++v) bv[v] = bcol[(size_t)(v0 + v) * 1024];
#pragma unroll
            for (int x = 0; x < 8; ++x) { const float* ar = A->in[I_AB_WUV] + (size_t)(r0 + x) * 512 + h * 64 + v0; const f32x4 a0 = *(const f32x4*)ar, a1 = *(const f32x4*)(ar + 4);
                acc[x] += a0[0] * bv[0] + a0[1] * bv[1] + a0[2] * bv[2] + a0[3] * bv[3] + a1[0] * bv[4] + a1[1] * bv[5] + a1[2] * bv[6] + a1[3] * bv[7]; }
        }
        *(v4u*)(WSP(bf16, WS_W_OUTAB) + (size_t)n * 1536 + k0) = pack8f(acc);
    }
#pragma unroll 4
    for (size_t i = gt; i < (size_t)M * D / 8; i += GT) { const f32x4 a = __builtin_nontemporal_load((const f32x4*)(A->in[I_X] + i * 8)), b = __builtin_nontemporal_load((const f32x4*)(A->in[I_X] + i * 8 + 4));
        v4u o; o.x = pk2(a[0], a[1]); o.y = pk2(a[2], a[3]); o.z = pk2(b[0], b[1]); o.w = pk2(b[2], b[3]); *(v4u*)(WSP(bf16, WS_XB) + i * 8) = o; }
#pragma unroll 4
    for (size_t i = gt; i < (size_t)2 * M * 256 / 8; i += GT) { const f32x4 a = __builtin_nontemporal_load((const f32x4*)(A->in[I_P] + i * 8)), b = __builtin_nontemporal_load((const f32x4*)(A->in[I_P] + i * 8 + 4));
        v4u o; o.x = pk2(a[0], a[1]); o.y = pk2(a[2], a[3]); o.z = pk2(b[0], b[1]); o.w = pk2(b[2], b[3]); *(v4u*)(WSP(bf16, WS_PB) + i * 8) = o; }
}

__device__ __forceinline__ void p2_prep(Frame& F, KArgs A) {
    const int lane = F.lane, gw = F.bid * NWAVES + F.wave, NGW = F.G * NWAVES;
    const float* SM = WSP(float, WS_SM); const bf16* QZ = WSP(bf16, WS_QKVZ);
    const f32x4 qg = *(const f32x4*)(A->in[I_AB_QG] + 4 * lane);
    const f32x4 kvg = *(const f32x4*)(A->in[I_AB_KVG] + 4 * (lane & 31));
    const f32x4 kig = *(const f32x4*)(A->in[I_AB_KIG] + 4 * (lane & 15)), kib = *(const f32x4*)(A->in[I_AB_KIB] + 4 * (lane & 15));
    const f32x4 alog = *(const f32x4*)(A->in[I_AB_ALOG]), dtb = *(const f32x4*)(A->in[I_AB_DTB]);
    LAS float* cw = (LAS float*)(F.lds);
    {   f32x4 wv[3]; int t0 = F.tid; asm volatile("" : "+v"(t0));
#pragma unroll
        for (int j = 0; j < 3; ++j) wv[j] = *(const f32x4*)(A->in[I_AB_CONVW] + (size_t)(t0 + NTHREADS * j) * 4);
#pragma unroll
        for (int j = 0; j < 3; ++j) *(LAS f32x4*)(cw + (t0 + NTHREADS * j) * 4) = wv[j];
    }
    __syncthreads();
    for (int row = gw; row < M; row += NGW) {
        const int t = row & (SEQ - 1);
        const f32x4 a = *(const f32x4*)(SM + (size_t)row * 512 + 4 * lane), b = *(const f32x4*)(SM + (size_t)row * 512 + 256 + 4 * lane);
        {
            const float ss = wave_sum(a[0] * a[0] + a[1] * a[1] + a[2] * a[2] + a[3] * a[3]);
            const float r = rsqrtf(ss * (1.0f / 256.0f) + 1e-6f);
            v2u o; o.x = pk2(a[0] * r * qg[0], a[1] * r * qg[1]); o.y = pk2(a[2] * r * qg[2], a[3] * r * qg[3]);
            *(v2u*)(WSP(bf16, WS_CQ) + (size_t)row * 256 + 4 * lane) = o;
        }
        {
            const float ss = wave_sum(lane < 32 ? (b[0] * b[0] + b[1] * b[1] + b[2] * b[2] + b[3] * b[3]) : 0.f);
            const float r = rsqrtf(ss * (1.0f / 128.0f) + 1e-6f);
            if (lane < 32) { v2u o; o.x = pk2(b[0] * r * kvg[0], b[1] * r * kvg[1]); o.y = pk2(b[2] * r * kvg[2], b[3] * r * kvg[3]);
                *(v2u*)(WSP(bf16, WS_CKV) + (size_t)row * 128 + 4 * lane) = o; }
        }
        {
            const bool in = (lane >= 32 && lane < 48);
            const float mean = wave_sum(in ? (b[0] + b[1] + b[2] + b[3]) : 0.f) * (1.0f / 64.0f);
            const f32x4 d = b - mean;
            const float var = wave_sum(in ? (d[0] * d[0] + d[1] * d[1] + d[2] * d[2] + d[3] * d[3]) : 0.f) * (1.0f / 64.0f);
            const float r = rsqrtf(var + 1e-5f);
            if (in) { v2u o; o.x = pk2(d[0] * r * kig[0] + kib[0], d[1] * r * kig[1] + kib[1]); o.y = pk2(d[2] * r * kig[2] + kib[2], d[3] * r * kig[3] + kib[3]);
                *(v2u*)(WSP(bf16, WS_KIDX) + (size_t)row * 64 + 4 * (lane - 32)) = o; }
        }
        if (lane == 48 || lane == 49) *(f32x4*)(WSP(float, WS_WIDX) + (size_t)row * 8 + 4 * (lane - 48)) = b * 0.044194173824159216f;
        if (lane == 50) { f32x4 o; o[0] = sigm(b[0]); o[1] = sigm(b[1]); o[2] = sigm(b[2]); o[3] = sigm(b[3]); *(f32x4*)(WSP(float, WS_BETA) + (size_t)row * 4) = o; }
        if (lane == 51) { f32x4 o;
#pragma unroll
            for (int h = 0; h < 4; ++h) { const float xx = b[h] + dtb[h]; const float sp = xx > 20.f ? xx : log1pf(__expf(xx)); o[h] = -__expf(alog[h]) * sp; }
            *(f32x4*)(WSP(float, WS_GG) + (size_t)row * 4) = o; }
        v4u xr[3][4];
#pragma unroll
        for (int sel = 0; sel < 3; ++sel)
#pragma unroll
            for (int j = 0; j < 4; ++j) { const int back = (t - 3 + j >= 0) ? (3 - j) : 0; xr[sel][j] = *(const v4u*)(QZ + (size_t)(row - back) * 2048 + sel * 512 + 8 * lane); }
#pragma unroll
        for (int sel = 0; sel < 3; ++sel) {
            const int col0 = sel * 512 + 8 * lane;
            float acc[8];
#pragma unroll
            for (int i = 0; i < 8; ++i) acc[i] = 0.f;
#pragma unroll
            for (int j = 0; j < 4; ++j) {
                float xv[8]; unpack8(xr[sel][j], xv);
                const f32x4 w0 = *(const LAS f32x4*)(cw + j * 1536 + col0), w1 = *(const LAS f32x4*)(cw + j * 1536 + col0 + 4);
                const float m = (t - 3 + j >= 0) ? 1.f : 0.f;
#pragma unroll
                for (int i = 0; i < 4; ++i) { acc[i] += w0[i] * m * xv[i]; acc[4 + i] += w1[i] * m * xv[4 + i]; }
            }
            float ss = 0.f;
#pragma unroll
            for (int i = 0; i < 8; ++i) { acc[i] = siluf(acc[i]); ss += acc[i] * acc[i]; }
            if (sel < 2) {
                ss += __shfl_xor(ss, 1); ss += __shfl_xor(ss, 2); ss += __shfl_xor(ss, 4); ss += __shfl_xor(ss, 8);
                const float sc = rsqrtf(ss + 1e-6f) * (sel == 0 ? 0.08838834764831845f : 1.0f);
#pragma unroll
                for (int i = 0; i < 8; ++i) acc[i] *= sc;
            }
            bf16* dst = (sel == 0 ? WSP(bf16, WS_QN) : (sel == 1 ? WSP(bf16, WS_KN) : WSP(bf16, WS_VN))) + (size_t)row * 512 + 8 * lane;
            *(v4u*)dst = pack8f(acc);
        }
    }
}

constexpr int SEQ_WGS = 16;
constexpr int SQ_WP = 0, SQ_QD = 16384, SQ_KDT = 32768, SQ_QK = 49152, SQ_BUF = 57344;
__device__ __forceinline__ bf16x8 packfrag(const f32x4 lo, const f32x4 hi) { v4u w; w.x = pg8::cvt_pk_bf16(lo[0], lo[1]); w.y = pg8::cvt_pk_bf16(lo[2], lo[3]); w.z = pg8::cvt_pk_bf16(hi[0], hi[1]); w.w = pg8::cvt_pk_bf16(hi[2], hi[3]); return __builtin_bit_cast(bf16x8, w); }
__device__ __forceinline__ void seq_load(v4u (&r)[14], const unsigned char* blk, int lt) {
#pragma unroll
    for (int i = 0; i < 14; ++i) r[i] = *(const v4u*)(blk + (size_t)(lt + 256 * i) * 16);
}
__device__ __forceinline__ void seq_write(LAS unsigned char* buf, const v4u (&r)[14], int lt) {
#pragma unroll
    for (int i = 0; i < 14; ++i) {
        const int id = lt + 256 * i; int dst;
        if (id < 2048) { const int rr = (id & 1023) >> 4, ch = id & 15; dst = (id & ~1023) * 16 + rr * 256 + 16 * (ch ^ (rr & 15)); }
        else { const int rr = (id - 2048) >> 3, ch = id & 7; dst = 32768 + rr * 128 + 16 * (ch ^ (rr & 7)); }
        *(LAS v4u*)(buf + dst) = r[i];
    }
}
__device__ __forceinline__ void seq_compute(LAS unsigned char* buf, f32x4 (&Sacc)[8], const f32x4 (&U)[4], const float gl, float* op0, const int fr, const int fq) {
    bf16x8 sf[4];
#pragma unroll
    for (int s = 0; s < 4; ++s) sf[s] = packfrag(Sacc[2 * s], Sacc[2 * s + 1]);
    f32x4 Vn[4], Oa[4];
#pragma unroll
    for (int tc = 0; tc < 4; ++tc) {
        const int rr = 16 * tc + fr; f32x4 av = (f32x4){0.f, 0.f, 0.f, 0.f}, ao = (f32x4){0.f, 0.f, 0.f, 0.f};
#pragma unroll
        for (int s = 0; s < 4; ++s) {
            const int off = rr * 256 + 16 * ((4 * s + fq) ^ (rr & 15));
            const bf16x8 wf = *(const LAS bf16x8*)(buf + SQ_WP + off), qf = *(const LAS bf16x8*)(buf + SQ_QD + off);
            av = __builtin_amdgcn_mfma_f32_16x16x32_bf16(wf, sf[s], av, 0, 0, 0);
            ao = __builtin_amdgcn_mfma_f32_16x16x32_bf16(qf, sf[s], ao, 0, 0, 0);
        }
        Vn[tc] = U[tc] - av; Oa[tc] = ao;
    }
    bf16x8 vf[2];
    vf[0] = packfrag(Vn[0], Vn[1]); vf[1] = packfrag(Vn[2], Vn[3]);
#pragma unroll
    for (int tc = 0; tc < 4; ++tc) {
        const int rr = 16 * tc + fr;
#pragma unroll
        for (int s = 0; s < 2; ++s) {
            const bf16x8 kf = *(const LAS bf16x8*)(buf + SQ_QK + rr * 128 + 16 * ((4 * s + fq) ^ (rr & 7)));
            Oa[tc] = __builtin_amdgcn_mfma_f32_16x16x32_bf16(kf, vf[s], Oa[tc], 0, 0, 0);
        }
        float* op = op0 + (size_t)(16 * tc) * 512;
#pragma unroll
        for (int j = 0; j < 4; ++j) op[(size_t)j * 512] = Oa[tc][j];
    }
#pragma unroll
    for (int T = 0; T < 8; ++T) {
        const int rr = 16 * T + fr; f32x4 a = Sacc[T] * gl;
#pragma unroll
        for (int s = 0; s < 2; ++s) {
            const bf16x8 kf = *(const LAS bf16x8*)(buf + SQ_KDT + rr * 128 + 16 * ((4 * s + fq) ^ (rr & 7)));
            a = __builtin_amdgcn_mfma_f32_16x16x32_bf16(kf, vf[s], a, 0, 0, 0);
        }
        Sacc[T] = a;
    }
}
#define SEQ_BAR() do { asm volatile("s_waitcnt lgkmcnt(0)" ::: "memory"); __builtin_amdgcn_s_barrier(); asm volatile("" ::: "memory"); } while (0)
__device__ __forceinline__ void p4_delta_seq(Frame& F, int sid) {
    const int lane = F.lane, wave = F.wave, tid = F.tid;
    const int bh = sid >> 1, half = sid & 1, b = bh >> 2, h = bh & 3;
    const int fr = lane & 15, fq = lane >> 4;
    const int v0 = half * 64 + (wave & 3) * 16;
    const unsigned char* cbase = F.ws + WS_CHK + (size_t)(bh * 128) * CHK_STRIDE;
    if (wave >= 4) {
        const int lt = tid - 256;
        v4u RA[14], RB[14];
#define SEQ_LD(R, blk) do { const unsigned char* _b = (blk); _Pragma("unroll") for (int _i = 0; _i < 14; ++_i) asm volatile("global_load_dwordx4 %0, %1, off" : "=v"(R[_i]) : "v"(_b + (size_t)(lt + 256 * _i) * 16) : "memory"); } while (0)
#define SEQ_WAIT(younger) do { if (younger) asm volatile("s_waitcnt vmcnt(14)" ::: "memory"); else asm volatile("s_waitcnt vmcnt(0)" ::: "memory"); } while (0)
        SEQ_LD(RA, cbase); SEQ_LD(RB, cbase + CHK_STRIDE); SEQ_WAIT(true); seq_write(F.lds, RA, lt); SEQ_LD(RA, cbase + 2 * CHK_STRIDE);
        SEQ_BAR();
#pragma unroll 1
        for (int n = 0; n < 128; n += 2) {
            if (n + 1 < 128) { SEQ_WAIT(n + 2 < 128); seq_write(F.lds + ((n + 1) & 1) * SQ_BUF, RB, lt); } if (n + 3 < 128) SEQ_LD(RB, cbase + (size_t)(n + 3) * CHK_STRIDE);
            SEQ_BAR();
            if (n + 2 < 128) { SEQ_WAIT(n + 3 < 128); seq_write(F.lds + (n & 1) * SQ_BUF, RA, lt); } if (n + 4 < 128) SEQ_LD(RA, cbase + (size_t)(n + 4) * CHK_STRIDE);
            SEQ_BAR();
        }
        asm volatile("s_waitcnt vmcnt(0)" ::: "memory");
#undef SEQ_LD
#undef SEQ_WAIT
    } else {
        float* OD = WSP(float, WS_ODELTA);
        f32x4 Sacc[8], Ucur[4], Unxt[4]; float glc, gln;
#pragma unroll
        for (int T = 0; T < 8; ++T) Sacc[T] = (f32x4){0.f, 0.f, 0.f, 0.f};
#pragma unroll
        for (int tc = 0; tc < 4; ++tc) { Ucur[tc] = *(const f32x4*)((const float*)(cbase + CHK_UT) + (size_t)(v0 + fr) * 64 + 4 * fq + 16 * tc);
                                          Unxt[tc] = *(const f32x4*)((const float*)(cbase + CHK_STRIDE + CHK_UT) + (size_t)(v0 + fr) * 64 + 4 * fq + 16 * tc); }
        glc = *(const float*)(cbase + CHK_GL); gln = *(const float*)(cbase + CHK_STRIDE + CHK_GL);
        SEQ_BAR();
#pragma unroll 1
        for (int n = 0; n < 128; ++n) {
            seq_compute(F.lds + (n & 1) * SQ_BUF, Sacc, Ucur, glc, OD + (size_t)(b * SEQ + n * 64 + 4 * fq) * 512 + h * 128 + v0 + fr, fr, fq);
#pragma unroll
            for (int tc = 0; tc < 4; ++tc) Ucur[tc] = Unxt[tc];
            glc = gln;
            if (n + 2 < 128) { const unsigned char* nb = cbase + (size_t)(n + 2) * CHK_STRIDE; gln = *(const float*)(nb + CHK_GL);
#pragma unroll
                for (int tc = 0; tc < 4; ++tc) Unxt[tc] = *(const f32x4*)((const float*)(nb + CHK_UT) + (size_t)(v0 + fr) * 64 + 4 * fq + 16 * tc); }
            SEQ_BAR();
        }
    }
}
#undef SEQ_BAR

__device__ __forceinline__ float relu1(float x) { return __builtin_amdgcn_fmed3f(x, 0.f, INFINITY); }
__device__ __forceinline__ void p4_indexer(Frame& F, int widx, int nw) {
    const int lane = F.lane, fr = lane & 15, fq = lane >> 4;
    const bf16* QL = WSP(bf16, WS_QL); const bf16* KI = WSP(bf16, WS_KIDX); const float* WI = WSP(float, WS_WIDX); float* SC = WSP(float, WS_BIG);
    for (int task = widx; task < 2 * 4352; task += nw) {
        const int b = task / 4352; int tau = task - b * 4352;
        int g = 0; while (16 * (g + 1) * (g + 2) <= tau) ++g;
        tau -= 16 * g * (g + 1);
        const int qt = 32 * g + tau / (g + 1), seg = tau % (g + 1);
        const int row0 = b * SEQ + 16 * qt;
        bf16x8 Qf[8][2];
#pragma unroll
        for (int hh = 0; hh < 8; ++hh)
#pragma unroll
            for (int s = 0; s < 2; ++s) Qf[hh][s] = *(const bf16x8*)(QL + (size_t)(row0 + fr) * 1536 + 1024 + hh * 64 + 32 * s + 8 * fq);
        const f32x4 w0 = *(const f32x4*)(WI + (size_t)(row0 + fr) * 8), w1 = *(const f32x4*)(WI + (size_t)(row0 + fr) * 8 + 4);
        const int kt1 = (32 * seg + 31 < qt) ? 32 * seg + 31 : qt;
        for (int kb8 = 32 * seg; kb8 <= kt1; kb8 += 8) {
            bf16x8 kfr[8][2];
#pragma unroll
            for (int x = 0; x < 8; ++x) { const int kt = (kb8 + x <= kt1) ? kb8 + x : kt1; const bf16* kp = KI + (size_t)(b * SEQ + 16 * kt + fr) * 64 + 8 * fq; kfr[x][0] = *(const bf16x8*)kp; kfr[x][1] = *(const bf16x8*)(kp + 32); }
#pragma unroll
            for (int x = 0; x < 8; ++x) asm volatile("" : "+v"(kfr[x][0]), "+v"(kfr[x][1]));
#pragma unroll
            for (int x = 0; x < 8; ++x) {
                const int kt = kb8 + x;
                if (kt <= kt1) {
                    f32x4 isc = (f32x4){0.f, 0.f, 0.f, 0.f}, c[8];
#pragma unroll
                    for (int hh = 0; hh < 8; ++hh) c[hh] = __builtin_amdgcn_mfma_f32_16x16x32_bf16(kfr[x][0], Qf[hh][0], (f32x4){0.f, 0.f, 0.f, 0.f}, 0, 0, 0);
#pragma unroll
                    for (int hh = 0; hh < 8; ++hh) c[hh] = __builtin_amdgcn_mfma_f32_16x16x32_bf16(kfr[x][1], Qf[hh][1], c[hh], 0, 0, 0);
                    __builtin_amdgcn_sched_barrier(0);
#pragma unroll
                    for (int hh = 0; hh < 8; ++hh) { const float wh = (hh < 4) ? w0[hh & 3] : w1[hh & 3];
#pragma unroll
                        for (int j = 0; j < 4; ++j) isc[j] += relu1(c[hh][j]) * wh; }
                    *(f32x4*)(SC + (size_t)(row0 + fr) * 8192 + 16 * kt + 4 * fq) = isc;
                }
            }
        }
    }
}

__device__ __forceinline__ void mask_ge8(unsigned long long (&m)[8], unsigned x0, unsigned x1, unsigned x2, unsigned x3, unsigned x4, unsigned x5, unsigned x6, unsigned x7, unsigned t) {
    asm("v_cmp_ge_u32_e64 %0, %8, %16\n\tv_cmp_ge_u32_e64 %1, %9, %16\n\tv_cmp_ge_u32_e64 %2, %10, %16\n\tv_cmp_ge_u32_e64 %3, %11, %16\n\t"
        "v_cmp_ge_u32_e64 %4, %12, %16\n\tv_cmp_ge_u32_e64 %5, %13, %16\n\tv_cmp_ge_u32_e64 %6, %14, %16\n\tv_cmp_ge_u32_e64 %7, %15, %16"
        : "=&s"(m[0]), "=&s"(m[1]), "=&s"(m[2]), "=&s"(m[3]), "=&s"(m[4]), "=&s"(m[5]), "=&s"(m[6]), "=&s"(m[7])
        : "v"(x0), "v"(x1), "v"(x2), "v"(x3), "v"(x4), "v"(x5), "v"(x6), "v"(x7), "s"(t));
}
__device__ __forceinline__ unsigned tk_key(float f) { const unsigned b = __float_as_uint(f); return (b & 0x80000000u) ? ~b : (b | 0x80000000u); }
__device__ __forceinline__ void topk_row_slow(const float* sr, const int n, const int lane, LAS int* sel) {
    const int nseg = (n + 63) >> 6;
    unsigned T = 0u;
    for (int bit = 31; bit >= 0; --bit) {
        const unsigned cnd = T | (1u << bit); int c = 0;
        for (int sg = 0; sg < nseg; ++sg) { const int idx = sg * 64 + lane; const unsigned x = (idx < n) ? tk_key(sr[idx < n ? idx : 0]) : 0u; c += __popcll(__ballot(x >= cnd)); }
        if (c >= 256) T = cnd;
    }
    int cgt = 0;
    for (int sg = 0; sg < nseg; ++sg) { const int idx = sg * 64 + lane; const unsigned x = (idx < n) ? tk_key(sr[idx < n ? idx : 0]) : 0u; cgt += __popcll(__ballot(x > T)); }
    const int need_eq = 256 - cgt; int running = 0, eq_taken = 0;
    const unsigned long long lt = (1ull << lane) - 1ull;
    for (int sg = 0; sg < nseg; ++sg) {
        const int idx = sg * 64 + lane; const unsigned x = (idx < n) ? tk_key(sr[idx < n ? idx : 0]) : 0u;
        const bool gt = x > T, eq = x == T;
        const unsigned long long meq = __ballot(eq);
        const bool take = gt || (eq && (eq_taken + __popcll(meq & lt)) < need_eq);
        const unsigned long long mt = __ballot(take);
        if (take) sel[running + __popcll(mt & lt)] = idx;
        running += __popcll(mt); eq_taken += __popcll(meq);
    }
}
constexpr int TK_CAP = 832;
__device__ __forceinline__ int topk_row(Frame& F, const int row, LAS int* sel, LAS unsigned long long* cand) {
    const int lane = F.lane;
    const float* SC = WSP(float, WS_BIG);
    {
        const int pos = row & (SEQ - 1), n = pos + 1;
        if (n <= 256) {
#pragma unroll
            for (int i = 0; i < 4; ++i) { const int j = 64 * i + lane; sel[j] = (j < n) ? j : 0; }
            return n;
        }
        const int nblk = (n + 1023) >> 10;
        const float* sr = SC + (size_t)row * 8192;
        int lane_l = lane; asm volatile("" : "+v"(lane_l));
        unsigned u[128];
#pragma unroll
        for (int i = 0; i < 64; ++i) u[i] = __float_as_uint((sr + (i >> 4) * 1024)[(i & 15) * 64 + lane_l]);
        if (nblk > 4) {
#pragma unroll
            for (int i = 64; i < 128; ++i) u[i] = __float_as_uint((sr + (i >> 4) * 1024)[(i & 15) * 64 + lane_l]);
        } else {
#pragma unroll
            for (int i = 64; i < 128; ++i) u[i] = 0u;
        }
        asm volatile("" ::: "memory");
#pragma unroll
        for (int i = 0; i < 128; ++i) { const int lim = n - i * 64; const unsigned bits = u[i];
            const unsigned x = (bits & 0x80000000u) ? ~bits : (bits | 0x80000000u);
            u[i] = (lane < lim) ? x : 0u; }
        const unsigned long long ltmask_s = (1ull << lane) - 1ull;
        bool done = false;
        {
            int ns = 0;
#pragma unroll
            for (int k = 0; k < 16; ++k) { int v = n - 512 * k; v = v < 0 ? 0 : (v > 64 ? 64 : v); ns += v; }
            const float mean = 256.0f * (float)ns / (float)n;
            const int rs = (int)(mean + 4.0f * sqrtf(mean) + 5.0f);
            unsigned Ts = 0u;
            for (int bit = 31; bit >= 16; --bit) {
                const unsigned cnd = Ts | (1u << bit); unsigned long long m0[8], m1[8];
                mask_ge8(m0, u[0], u[8], u[16], u[24], u[32], u[40], u[48], u[56], cnd); mask_ge8(m1, u[64], u[72], u[80], u[88], u[96], u[104], u[112], u[120], cnd);
                int c = 0;
#pragma unroll
                for (int i = 0; i < 8; ++i) c += __popcll(m0[i]) + __popcll(m1[i]);
                if (c >= rs) Ts = cnd;
            }
            if (Ts == 0u) Ts = 1u;
            int nc = 0;
#pragma unroll
            for (int bk = 0; bk < 8; ++bk) {
                if (bk < nblk) {
#pragma unroll
                    for (int g8 = 0; g8 < 2; ++g8) {
                        unsigned long long mg[8]; const int b0 = bk * 16 + g8 * 8;
                        mask_ge8(mg, u[b0], u[b0 + 1], u[b0 + 2], u[b0 + 3], u[b0 + 4], u[b0 + 5], u[b0 + 6], u[b0 + 7], Ts);
#pragma unroll
                        for (int i = 0; i < 8; ++i) {
                            const unsigned long long mt = mg[i];
                            if (mt != 0ull) {
                                const int off = nc + __popcll(mt & ltmask_s);
                                if (((mt >> lane) & 1ull) && off < TK_CAP) cand[off] = ((unsigned long long)u[b0 + i] << 32) | (unsigned)((b0 + i) * 64 + lane_l);
                                nc += __popcll(mt);
                            }
                        }
                    }
                }
            }
            if (nc >= 256 && nc <= TK_CAP) {
                unsigned ck[16]; int ci[13];
#pragma unroll
                for (int t = 0; t < 13; ++t) { const int j = lane + 64 * t; const unsigned long long e = (j < nc) ? cand[j] : 0ull; ck[t] = (unsigned)(e >> 32); ci[t] = (int)(unsigned)e; }
                ck[13] = 0u; ck[14] = 0u; ck[15] = 0u;
                unsigned T = 0u;
                for (int bit = 31; bit >= 0; --bit) {
                    const unsigned cnd = T | (1u << bit); unsigned long long m0[8], m1[8];
                    mask_ge8(m0, ck[0], ck[1], ck[2], ck[3], ck[4], ck[5], ck[6], ck[7], cnd); mask_ge8(m1, ck[8], ck[9], ck[10], ck[11], ck[12], ck[13], ck[14], ck[15], cnd);
                    int c = 0;
#pragma unroll
                    for (int i = 0; i < 8; ++i) c += __popcll(m0[i]) + __popcll(m1[i]);
                    if (c >= 256) T = cnd;
                }
                unsigned long long g0[8], g1[8], h0[8], h1[8];
                mask_ge8(g0, ck[0], ck[1], ck[2], ck[3], ck[4], ck[5], ck[6], ck[7], T); mask_ge8(g1, ck[8], ck[9], ck[10], ck[11], ck[12], ck[13], ck[14], ck[15], T);
                mask_ge8(h0, ck[0], ck[1], ck[2], ck[3], ck[4], ck[5], ck[6], ck[7], T + 1u); mask_ge8(h1, ck[8], ck[9], ck[10], ck[11], ck[12], ck[13], ck[14], ck[15], T + 1u);
                int cgt = 0;
#pragma unroll
                for (int t = 0; t < 13; ++t) cgt += __popcll(t < 8 ? h0[t & 7] : h1[t & 7]);
                const int need_eq = 256 - cgt;
                int running = 0, eq_taken = 0;
#pragma unroll
                for (int t = 0; t < 13; ++t) {
                    const unsigned long long mge = (t < 8 ? g0[t & 7] : g1[t & 7]), mgt = (t < 8 ? h0[t & 7] : h1[t & 7]);
                    unsigned long long mt = mge; const unsigned long long me = mge & ~mgt;
                    if (me != 0ull) {
                        const int room = need_eq - eq_taken; unsigned long long keep = 0ull, rest = me;
                        for (int k = 0; k < room && rest != 0ull; ++k) { const unsigned long long low = rest & (~rest + 1ull); keep |= low; rest ^= low; }
                        mt = (mge & ~me) | keep; eq_taken += __popcll(me);
                    }
                    if (mt != 0ull) { if ((mt >> lane) & 1ull) sel[running + __popcll(mt & ltmask_s)] = ci[t]; running += __popcll(mt); }
                }
                done = true;
            }
        }
        if (!done) topk_row_slow(sr, n, lane, sel);
    }
    return 256;
}

__device__ __forceinline__ void p6_gdn_out(Frame& F, KArgs A) {
    const int lane = F.lane, gw = F.bid * NWAVES + F.wave, NGW = F.G * NWAVES;
    const f32x4 g0 = *(const f32x4*)(A->in[I_AB_ONG] + 8 * (lane & 15)), g1 = *(const f32x4*)(A->in[I_AB_ONG] + 8 * (lane & 15) + 4);
    for (int row = gw; row < M; row += NGW) {
        const float* op = WSP(float, WS_ODELTA) + (size_t)row * 512 + 8 * lane;
        const f32x4 a = *(const f32x4*)op, b = *(const f32x4*)(op + 4);
        float ss = a[0] * a[0] + a[1] * a[1] + a[2] * a[2] + a[3] * a[3] + b[0] * b[0] + b[1] * b[1] + b[2] * b[2] + b[3] * b[3];
        ss += __shfl_xor(ss, 1); ss += __shfl_xor(ss, 2); ss += __shfl_xor(ss, 4); ss += __shfl_xor(ss, 8);
        const float r = rsqrtf(ss * (1.0f / 128.0f) + 1e-6f);
        float z[8]; unpack8(*(const v4u*)(WSP(bf16, WS_QKVZ) + (size_t)row * 2048 + 1536 + 8 * lane), z);
        float o[8];
#pragma unroll
        for (int i = 0; i < 4; ++i) { o[i] = a[i] * r * g0[i] * siluf(z[i]); o[4 + i] = b[i] * r * g1[i] * siluf(z[4 + i]); }
        *(v4u*)(WSP(bf16, WS_AO) + (size_t)row * 1536 + 1024 + 8 * lane) = pack8f(o);
    }
}

__device__ __forceinline__ void p8_ln_router(Frame& F, KArgs A, int l, float* HOUT, bf16* HB) {
    const int lane = F.lane, tid = F.tid, gw = F.bid * NWAVES + F.wave, NGW = F.G * NWAVES;
    LAS float* wT = (LAS float*)(F.lds);
    LAS float* lg = (LAS float*)(F.lds + WSCR_OFF + F.wave * WSCR_BYTES);
    const float* rw = A->in[I_RW] + (size_t)l * 1024 * 32;
    {
        f32x4 wv[16];
#pragma unroll
        for (int j = 0; j < 16; ++j) wv[j] = *(const f32x4*)(rw + (size_t)(tid + NTHREADS * j) * 4);
#pragma unroll
        for (int j = 0; j < 16; ++j) { const int i4 = tid + NTHREADS * j, k = i4 >> 3, e0 = (i4 & 7) * 4;
            wT[(e0 + 0) * 1028 + k] = wv[j][0]; wT[(e0 + 1) * 1028 + k] = wv[j][1]; wT[(e0 + 2) * 1028 + k] = wv[j][2]; wT[(e0 + 3) * 1028 + k] = wv[j][3]; }
    }
    __syncthreads();
    const float* PRE = WSP(float, WS_PRE); unsigned char* H8 = WSP(unsigned char, WS_XS);
    const float* lg_g = A->in[I_LNM_G] + (size_t)l * 1024; const float* lg_b = A->in[I_LNM_B] + (size_t)l * 1024;
    const float rb = A->in[I_RB][l * 32 + (lane & 31)];
    int* TOKE = WSP(int, WS_ROUTE); int* TOKPOS = TOKE + M * 4; float* TOKG = (float*)(TOKPOS + M * 4);
    gu32* cnt = F.ctl + CW_CNT + 64 * 32 * l;
    LAS int* lcnt = (LAS int*)(F.lds + MISC_OFF + 512);
    LAS int* lbase = lcnt + 32;
    LAS int* myrt = (LAS int*)(F.lds + WSCR_OFF + F.wave * WSCR_BYTES + 128);
    if (tid < 32) lcnt[tid] = 0;
    __syncthreads();
    int nrow = 0;
    f32x4 lng[4], lnb[4];
#pragma unroll
    for (int j = 0; j < 4; ++j) { lng[j] = *(const f32x4*)(lg_g + 256 * j + 4 * lane); lnb[j] = *(const f32x4*)(lg_b + 256 * j + 4 * lane); }
    for (int row = gw; row < M; row += NGW) {
        f32x4 v[4]; float s = 0.f;
#pragma unroll
        for (int j = 0; j < 4; ++j) { v[j] = *(const f32x4*)(PRE + (size_t)row * 1024 + 256 * j + 4 * lane); s += (v[j][0] + v[j][1]) + (v[j][2] + v[j][3]); }
        const float mean = wave_sum(s) * (1.0f / 1024.0f); float s2 = 0.f;
#pragma unroll
        for (int j = 0; j < 4; ++j) { v[j] = v[j] - mean; s2 += (v[j][0] * v[j][0] + v[j][1] * v[j][1]) + (v[j][2] * v[j][2] + v[j][3] * v[j][3]); }
        const float rstd = rsqrtf(wave_sum(s2) * (1.0f / 1024.0f) + 1e-5f);
#pragma unroll
        for (int j = 0; j < 4; ++j) {
            v[j] = v[j] * rstd * lng[j] + lnb[j];
            v2u o; o.x = pk2(v[j][0], v[j][1]); o.y = pk2(v[j][2], v[j][3]); *(v2u*)(HB + (size_t)row * 1024 + 256 * j + 4 * lane) = o;
            if (kMoeFp8) { unsigned w = 0u; w = __builtin_amdgcn_cvt_pk_fp8_f32(v[j][0], v[j][1], w, false); w = __builtin_amdgcn_cvt_pk_fp8_f32(v[j][2], v[j][3], w, true); *(unsigned*)(H8 + (size_t)row * 1024 + 256 * j + 4 * lane) = w; }
        }
        float part[32];
#pragma unroll
        for (int e = 0; e < 32; ++e) {
            float a = 0.f;
#pragma unroll
            for (int j = 0; j < 4; ++j) { const f32x4 w = *(const LAS f32x4*)(wT + e * 1028 + 256 * j + 4 * lane); a += v[j][0] * w[0] + v[j][1] * w[1] + v[j][2] * w[2] + v[j][3] * w[3]; }
            part[e] = a;
        }
#pragma unroll
        for (int i = 0; i < 16; ++i) { const bool up = (lane & 32) != 0; const float keep = up ? part[i + 16] : part[i], send = up ? part[i] : part[i + 16]; part[i] = keep + __shfl_xor(send, 32); }
#pragma unroll
        for (int i = 0; i < 8; ++i) { const bool up = (lane & 16) != 0; const float keep = up ? part[i + 8] : part[i], send = up ? part[i] : part[i + 8]; part[i] = keep + __shfl_xor(send, 16); }
#pragma unroll
        for (int i = 0; i < 4; ++i) { const bool up = (lane & 8) != 0; const float keep = up ? part[i + 4] : part[i], send = up ? part[i] : part[i + 4]; part[i] = keep + __shfl_xor(send, 8); }
#pragma unroll
        for (int i = 0; i < 2; ++i) { const bool up = (lane & 4) != 0; const float keep = up ? part[i + 2] : part[i], send = up ? part[i] : part[i + 2]; part[i] = keep + __shfl_xor(send, 4); }
        { const bool up = (lane & 2) != 0; const float keep = up ? part[1] : part[0], send = up ? part[0] : part[1]; part[0] = keep + __shfl_xor(send, 2); }
        part[0] += __shfl_xor(part[0], 1);
        const int eidx = ((lane >> 5) & 1) * 16 + ((lane >> 4) & 1) * 8 + ((lane >> 3) & 1) * 4 + ((lane >> 2) & 1) * 2 + ((lane >> 1) & 1);
        if ((lane & 1) == 0) lg[eidx] = part[0];
        float val = (lane < 32) ? lg[lane & 31] + rb : -INFINITY;
        float tl[4]; int te[4];
#pragma unroll
        for (int k = 0; k < 4; ++k) {
            const float mx = wave_max(val);
            const unsigned long long mm = __ballot(val == mx && lane < 32);
            const int idx = __ffsll((long long)mm) - 1;
            tl[k] = mx; te[k] = idx;
            if (lane == idx) val = -INFINITY;
        }
        const float e1 = __expf(tl[1] - tl[0]), e2 = __expf(tl[2] - tl[0]), e3 = __expf(tl[3] - tl[0]);
        const float inv = 1.0f / (1.0f + e1 + e2 + e3);
        if (lane < 4) {
            const int e = lane == 0 ? te[0] : (lane == 1 ? te[1] : (lane == 2 ? te[2] : te[3]));
            const float g = (lane == 0 ? 1.0f : (lane == 1 ? e1 : (lane == 2 ? e2 : e3))) * inv;
            const int lp = __hip_atomic_fetch_add(lcnt + e, 1, __ATOMIC_RELAXED, __HIP_MEMORY_SCOPE_WORKGROUP);
            LAS int* rt = myrt + (nrow * 4 + lane) * 3; rt[0] = e; rt[1] = lp; rt[2] = __float_as_int(g);
        }
        ++nrow;
    }
    __syncthreads();
    if (tid < 32) lbase[tid] = (int)__hip_atomic_fetch_add(cnt + 64 * tid, (unsigned)lcnt[tid], RLX_AGENT);
    __syncthreads();
    if (lane < 4) {
        int j = 0;
        for (int row = gw; row < M; row += NGW, ++j) {
            const LAS int* rt = myrt + (j * 4 + lane) * 3; const int e = rt[0];
            TOKE[(size_t)row * 4 + lane] = e; TOKPOS[(size_t)row * 4 + lane] = lbase[e] + rt[1]; TOKG[(size_t)row * 4 + lane] = __int_as_float(rt[2]);
        }
    }
}

__device__ __forceinline__ void p9_scatter(Frame& F, int l, const bf16* HB, const float* HF) {
    const int lane = F.lane, tid = F.tid, gw = F.bid * NWAVES + F.wave, NGW = F.G * NWAVES;
    LAS int* base = (LAS int*)(F.lds + MISC_OFF + 256);
    int* TOKE = WSP(int, WS_ROUTE); int* TOKPOS = TOKE + M * 4; int* TILE = TOKE + 3 * M * 4;
    if (tid < 32) base[tid] = (int)__hip_atomic_load(F.ctl + CW_CNT + 64 * (32 * l + tid), RLX_AGENT);
    __syncthreads();
    if (tid == 0) {
        int acc = 0;
        for (int e = 0; e < NEXP; ++e) { const int c = base[e]; base[e] = acc; acc += ((c + 255) >> 8) << 8; }
        base[32] = acc >> 8;
    }
    __syncthreads();
    if (F.bid == 0 && tid < 64) {
        const int nT = base[32];
        for (int t = tid; t < NTMAX; t += 64) { int e = 0;
            for (int x = 1; x < NEXP; ++x) if (base[x] <= t * 256) e = x;
            TILE[t] = (t < nT) ? e : 0; }
        if (tid == 0) TILE[NTMAX] = nT;
    }
    bf16* XS = WSP(bf16, WS_XS);
    if (kMoeFp8) {
        int* SLOTTOK = TOKE + 3 * M * 4 + NTMAX + 64;
        for (int idx = F.bid * NTHREADS + tid; idx < M * 4; idx += F.G * NTHREADS) SLOTTOK[base[TOKE[idx]] + TOKPOS[idx]] = idx >> 2;
        return;
    }
    for (int row = gw; row < M; row += NGW) {
        const v4u a = *(const v4u*)(HB + (size_t)row * 1024 + 8 * lane), b = *(const v4u*)(HB + (size_t)row * 1024 + 512 + 8 * lane);
#pragma unroll
        for (int k = 0; k < 4; ++k) {
            const int slot = base[TOKE[(size_t)row * 4 + k]] + TOKPOS[(size_t)row * 4 + k];
            *(v4u*)(XS + (size_t)slot * 1024 + 8 * lane) = a; *(v4u*)(XS + (size_t)slot * 1024 + 512 + 8 * lane) = b;
        }
    }
}

__device__ __forceinline__ void p12_combine(Frame& F, KArgs A, int l, const bf16* HINB, float* HOUT, bf16* HB) {
    const int lane = F.lane, tid = F.tid, gw = F.bid * NWAVES + F.wave, NGW = F.G * NWAVES;
    LAS int* base = (LAS int*)(F.lds + MISC_OFF + 256);
    if (tid < 32) base[tid] = (int)__hip_atomic_load(F.ctl + CW_CNT + 64 * (32 * l + tid), RLX_AGENT);
    __syncthreads();
    if (tid == 0) { int acc = 0; for (int e = 0; e < NEXP; ++e) { const int c = base[e]; base[e] = acc; acc += ((c + 255) >> 8) << 8; } }
    __syncthreads();
    const int* TOKE = WSP(int, WS_ROUTE); const int* TOKPOS = TOKE + M * 4; const float* TOKG = (const float*)(TOKPOS + M * 4);
    const bf16* YS = WSP(bf16, WS_YS); const bf16* PLE = WSP(bf16, WS_PLE);
    const float* lg_g = A->in[I_LNF_G] + (size_t)l * 1024; const float* lg_b = A->in[I_LNF_B] + (size_t)l * 1024;
    f32x4 lng[2][2], lnb[2][2];
#pragma unroll
    for (int hf = 0; hf < 2; ++hf) { const int c0 = 512 * hf + 8 * lane; lng[hf][0] = *(const f32x4*)(lg_g + c0); lng[hf][1] = *(const f32x4*)(lg_g + c0 + 4); lnb[hf][0] = *(const f32x4*)(lg_b + c0); lnb[hf][1] = *(const f32x4*)(lg_b + c0 + 4); }
    for (int row = gw; row < M; row += NGW) {
        float x[16];
        {   float h0[8], h1[8]; unpack8(*(const v4u*)(HINB + (size_t)row * 1024 + 8 * lane), h0); unpack8(*(const v4u*)(HINB + (size_t)row * 1024 + 512 + 8 * lane), h1);
            float p0[8], p1[8]; unpack8(*(const v4u*)(PLE + (size_t)row * 1024 + 8 * lane), p0); unpack8(*(const v4u*)(PLE + (size_t)row * 1024 + 512 + 8 * lane), p1);
#pragma unroll
            for (int i = 0; i < 8; ++i) { x[i] = ALPHA * h0[i] + p0[i]; x[8 + i] = ALPHA * h1[i] + p1[i]; }
        }
#pragma unroll
        for (int k = 0; k < 4; ++k) {
            const int slot = base[TOKE[(size_t)row * 4 + k]] + TOKPOS[(size_t)row * 4 + k]; const float g = TOKG[(size_t)row * 4 + k];
            float y0[8], y1[8]; unpack8(*(const v4u*)(YS + (size_t)slot * 1024 + 8 * lane), y0); unpack8(*(const v4u*)(YS + (size_t)slot * 1024 + 512 + 8 * lane), y1);
#pragma unroll
            for (int i = 0; i < 8; ++i) { x[i] += g * y0[i]; x[8 + i] += g * y1[i]; }
        }
        float s = 0.f;
#pragma unroll
        for (int i = 0; i < 16; ++i) s += x[i];
        const float mean = wave_sum(s) * (1.0f / 1024.0f); float s2 = 0.f;
#pragma unroll
        for (int i = 0; i < 16; ++i) { x[i] -= mean; s2 += x[i] * x[i]; }
        const float rstd = rsqrtf(wave_sum(s2) * (1.0f / 1024.0f) + 1e-5f);
#pragma unroll
        for (int hf = 0; hf < 2; ++hf) {
            const int c0 = 512 * hf + 8 * lane;
            const f32x4 g0 = lng[hf][0], g1 = lng[hf][1], b0 = lnb[hf][0], b1 = lnb[hf][1];
            f32x4 o0, o1;
#pragma unroll
            for (int i = 0; i < 4; ++i) { o0[i] = x[8 * hf + i] * rstd * g0[i] + b0[i]; o1[i] = x[8 * hf + 4 + i] * rstd * g1[i] + b1[i]; }
            *(f32x4*)(HOUT + (size_t)row * 1024 + c0) = o0; *(f32x4*)(HOUT + (size_t)row * 1024 + c0 + 4) = o1;
            if (HB) { v4u w; w.x = pk2(o0[0], o0[1]); w.y = pk2(o0[2], o0[3]); w.z = pk2(o1[0], o1[1]); w.w = pk2(o1[2], o1[3]); *(v4u*)(HB + (size_t)row * 1024 + c0) = w; }
        }
    }
}

typedef short v4i16_t __attribute__((ext_vector_type(4)));
__device__ __forceinline__ v4i16_t lds_tr16(LAS unsigned char* p) { return __builtin_amdgcn_ds_read_tr16_b64_v4i16((LAS v4i16_t*)p); }
constexpr int DV_PITCH = 144, DV_BUF = 32 * DV_PITCH;
template <int DL  , int SIGMA  > __device__ __forceinline__ void dil_branch(const bf16* __restrict__ KV, LAS unsigned char* vbuf, const int s0, const int lane,
                                                                                 const bf16x8 (&qf)[2], f32x4 (&O)[4], float& m_run, float& l_run) {
    constexpr int d = 1 << DL, sigma = SIGMA, NS = (129 + 15 * sigma + 31) / 32;
    const int fr = lane & 15, fq = lane >> 4;
    const int c = s0 & (d - 1), n0 = s0 >> DL, kstart = n0 - 128;
    const int dbase = 128 + sigma * fr - 4 * fq;
    const int dmax = n0 + sigma * fr;
#define DIL_POS(n) ({ int _p = c + d * (n); _p = _p < 0 ? 0 : (_p > SEQ - 1 ? SEQ - 1 : _p); _p; })
    bf16x8 kf[2][2]; v4u vr[4];
#pragma unroll
    for (int tl = 0; tl < 2; ++tl) { const bf16* kp = KV + (size_t)DIL_POS(kstart + 16 * tl + fr) * 2560 + 768 + 8 * fq; kf[tl][0] = *(const bf16x8*)kp; kf[tl][1] = *(const bf16x8*)(kp + 32); }
#pragma unroll
    for (int i = 0; i < 4; ++i) vr[i] = *(const v4u*)(KV + (size_t)DIL_POS(kstart + (lane >> 3) + 8 * i) * 2560 + 1536 + 8 * (lane & 7));
#pragma unroll 1
    for (int g = 0; g < NS; ++g) {
        LAS unsigned char* vb = vbuf;
#pragma unroll
        for (int i = 0; i < 4; ++i) *(LAS v4u*)(vb + ((lane >> 3) + 8 * i) * DV_PITCH + 16 * (lane & 7)) = vr[i];
        bf16x8 kc[2][2];
#pragma unroll
        for (int tl = 0; tl < 2; ++tl) { kc[tl][0] = kf[tl][0]; kc[tl][1] = kf[tl][1]; }
        if (g + 1 < NS) {
            const int kb = kstart + 32 * (g + 1);
#pragma unroll
            for (int tl = 0; tl < 2; ++tl) { const bf16* kp = KV + (size_t)DIL_POS(kb + 16 * tl + fr) * 2560 + 768 + 8 * fq; kf[tl][0] = *(const bf16x8*)kp; kf[tl][1] = *(const bf16x8*)(kp + 32); }
#pragma unroll
            for (int i = 0; i < 4; ++i) vr[i] = *(const v4u*)(KV + (size_t)DIL_POS(kb + (lane >> 3) + 8 * i) * 2560 + 1536 + 8 * (lane & 7));
        }
        float sv[8];
#pragma unroll
        for (int tl = 0; tl < 2; ++tl) {
            f32x4 cc = __builtin_amdgcn_mfma_f32_16x16x32_bf16(kc[tl][0], qf[0], (f32x4){0.f, 0.f, 0.f, 0.f}, 0, 0, 0);
            cc = __builtin_amdgcn_mfma_f32_16x16x32_bf16(kc[tl][1], qf[1], cc, 0, 0, 0);
#pragma unroll
            for (int j = 0; j < 4; ++j) {
                const int delta = dbase - (32 * g + 16 * tl + j);
                const bool ok = ((unsigned)delta <= 128u) && (delta <= dmax);
                sv[4 * tl + j] = ok ? cc[j] * 0.18033688011112042f : -INFINITY;
            }
        }
        float mx = fmaxf(fmaxf(fmaxf(sv[0], sv[1]), fmaxf(sv[2], sv[3])), fmaxf(fmaxf(sv[4], sv[5]), fmaxf(sv[6], sv[7])));
        mx = fmaxf(mx, __shfl_xor(mx, 16)); mx = fmaxf(mx, __shfl_xor(mx, 32));
        const float m_new = fmaxf(m_run, mx);
        if (!__all(m_new == m_run)) {
            const float alpha = __builtin_amdgcn_exp2f(m_run - m_new);
            l_run *= alpha;
#pragma unroll
            for (int j = 0; j < 4; ++j) { const float aj = __shfl(alpha, 4 * fq + j);
#pragma unroll
                for (int dt = 0; dt < 4; ++dt) O[dt][j] *= aj; }
            m_run = m_new;
        }
        float p[8], ps = 0.f;
#pragma unroll
        for (int e = 0; e < 8; ++e) { p[e] = __builtin_amdgcn_exp2f(sv[e] - m_run); ps += p[e]; }
        l_run += ps;
        v4u pw; pw.x = pg8::cvt_pk_bf16(p[0], p[1]); pw.y = pg8::cvt_pk_bf16(p[2], p[3]); pw.z = pg8::cvt_pk_bf16(p[4], p[5]); pw.w = pg8::cvt_pk_bf16(p[6], p[7]);
        const bf16x8 pf = __builtin_bit_cast(bf16x8, pw);
        LAS unsigned char* tb = vb + (4 * fq + ((lane & 15) >> 2)) * DV_PITCH + 8 * (lane & 3);
#pragma unroll
        for (int dt = 0; dt < 4; ++dt) {
            const v4i16_t lo = lds_tr16(tb + 32 * dt), hi = lds_tr16(tb + 16 * DV_PITCH + 32 * dt);
            bf16x8 vf; vf[0] = lo[0]; vf[1] = lo[1]; vf[2] = lo[2]; vf[3] = lo[3]; vf[4] = hi[0]; vf[5] = hi[1]; vf[6] = hi[2]; vf[7] = hi[3];
            O[dt] = __builtin_amdgcn_mfma_f32_16x16x32_bf16(pf, vf, O[dt], 0, 0, 0);
        }
    }
#undef DIL_POS
}
constexpr int HND_OFF = 8 * DV_BUF, HND_PITCH = 66;
static_assert(HND_OFF + 256 * HND_PITCH * 4 <= MISC_OFF, "dilated attention LDS map");
__device__ __forceinline__ void p14_dilated_mfma(Frame& F) {
    const int lane = F.lane, fr = lane & 15, fq = lane >> 4;
    LAS unsigned char* vbuf = F.lds + F.wave * DV_BUF;
    LAS float* hnd = (LAS float*)(F.lds + HND_OFF);
    const bf16* QK = WSP(bf16, WS_QKVZ); bf16* AO = WSP(bf16, WS_AO);
    for (int u = F.bid; u < 24 * 32; u += F.G) {
        const int bh = u >> 5, blk = u & 31;
        const int b = bh / 12, hh = bh - b * 12;
        const bf16* KV = QK + (size_t)b * SEQ * 2560 + hh * 64;
#pragma unroll 1
        for (int i = 0; i < 2; ++i) {
            const int run = 2 * F.wave + i, s0 = 256 * blk + 16 * run;
            bf16x8 qf[2];
            { const bf16* qp = KV + (size_t)(s0 + fr) * 2560 + 8 * fq; qf[0] = *(const bf16x8*)qp; qf[1] = *(const bf16x8*)(qp + 32); }
            f32x4 O[4];
#pragma unroll
            for (int dt = 0; dt < 4; ++dt) O[dt] = (f32x4){0.f, 0.f, 0.f, 0.f};
            float m_run = -1e30f, l_run = 0.f;
            dil_branch<0, 1>(KV, vbuf, s0, lane, qf, O, m_run, l_run);
            float lt = l_run; lt += __shfl_xor(lt, 16); lt += __shfl_xor(lt, 32);
#pragma unroll
            for (int j = 0; j < 4; ++j)
#pragma unroll
                for (int dt = 0; dt < 4; ++dt) hnd[(16 * run + 4 * fq + j) * HND_PITCH + 16 * dt + fr] = O[dt][j];
            if (fq == 0) { hnd[(16 * run + fr) * HND_PITCH + 64] = m_run; hnd[(16 * run + fr) * HND_PITCH + 65] = lt; }
        }
        __syncthreads();
#pragma unroll 1
        for (int i = 0; i < 2; ++i) {
            const int o = 2 * F.wave + i, s0 = 256 * blk + o;
            bf16x8 qf[2];
            { const bf16* qp = KV + (size_t)(s0 + 16 * fr) * 2560 + 8 * fq; qf[0] = *(const bf16x8*)qp; qf[1] = *(const bf16x8*)(qp + 32); }
            f32x4 O[4];
#pragma unroll
            for (int j = 0; j < 4; ++j)
#pragma unroll
                for (int dt = 0; dt < 4; ++dt) O[dt][j] = hnd[(o + 16 * (4 * fq + j)) * HND_PITCH + 16 * dt + fr];
            float m_run = hnd[(o + 16 * fr) * HND_PITCH + 64], l_run = (fq == 0) ? hnd[(o + 16 * fr) * HND_PITCH + 65] : 0.f;
            dil_branch<4, 1>(KV, vbuf, s0, lane, qf, O, m_run, l_run);
            dil_branch<2, 4>(KV, vbuf, s0, lane, qf, O, m_run, l_run);
            float lt = l_run; lt += __shfl_xor(lt, 16); lt += __shfl_xor(lt, 32);
            const float inv = __builtin_amdgcn_rcpf(lt);
#pragma unroll
            for (int j = 0; j < 4; ++j) {
                const float ij = __shfl(inv, 4 * fq + j);
                bf16* op = AO + (size_t)(b * SEQ + s0 + 16 * (4 * fq + j)) * 1024 + hh * 64 + fr;
#pragma unroll
                for (int dt = 0; dt < 4; ++dt) op[16 * dt] = (bf16)f2bf(O[dt][j] * ij);
            }
        }
        __syncthreads();
    }
}
constexpr int SA_PITCH = 272, SA_TILE = 32 * SA_PITCH;
__device__ __forceinline__ void sparse_row(Frame& F, const int row, const int n, const LAS int* sel, LAS unsigned char* tile) {
    const int lane = F.lane, fr = lane & 15, fq = lane >> 4;
    const bf16* QL = WSP(bf16, WS_QL); const bf16* CKV = WSP(bf16, WS_CKV); bf16* AO = WSP(bf16, WS_AO);
    {
        const int b = row >> 13;
        const bf16* kvb = CKV + (size_t)b * SEQ * 128;
        bf16x8 qf[4];
#pragma unroll
        for (int s = 0; s < 4; ++s) { const v4u z = (v4u){0u, 0u, 0u, 0u}; qf[s] = (fr < 8) ? *(const bf16x8*)(QL + (size_t)row * 1536 + fr * 128 + 32 * s + 8 * fq) : __builtin_bit_cast(bf16x8, z); }
        f32x4 O[8];
#pragma unroll
        for (int rt = 0; rt < 8; ++rt) O[rt] = (f32x4){0.f, 0.f, 0.f, 0.f};
        float m_run = -1e30f, l_run = 0.f;
        const int nsteps = (n + 31) >> 5;
        v4u vr[8];
        { const int j = lane & 31; const int kidx = (j < n) ? sel[j] : 0;
#pragma unroll
          for (int i = 0; i < 8; ++i) { const int key = __shfl(kidx, (lane >> 4) + 4 * i); vr[i] = *(const v4u*)(kvb + (size_t)key * 128 + 8 * (lane & 15)); } }
#pragma unroll 1
        for (int g = 0; g < nsteps; ++g) {
#pragma unroll
            for (int i = 0; i < 8; ++i) *(LAS v4u*)(tile + ((lane >> 4) + 4 * i) * SA_PITCH + 16 * (lane & 15)) = vr[i];
            if (g + 1 < nsteps) {
                const int j = 32 * (g + 1) + (lane & 31); const int kidx = (j < n) ? sel[j] : 0;
#pragma unroll
                for (int i = 0; i < 8; ++i) { const int key = __shfl(kidx, (lane >> 4) + 4 * i); vr[i] = *(const v4u*)(kvb + (size_t)key * 128 + 8 * (lane & 15)); }
            }
            float sv[8];
#pragma unroll
            for (int tl = 0; tl < 2; ++tl) {
                f32x4 cc = (f32x4){0.f, 0.f, 0.f, 0.f};
#pragma unroll
                for (int s = 0; s < 4; ++s) { const bf16x8 kf = *(const LAS bf16x8*)(tile + (16 * tl + fr) * SA_PITCH + 64 * s + 16 * fq); cc = __builtin_amdgcn_mfma_f32_16x16x32_bf16(kf, qf[s], cc, 0, 0, 0); }
#pragma unroll
                for (int j = 0; j < 4; ++j) sv[4 * tl + j] = (32 * g + 16 * tl + 4 * fq + j < n) ? cc[j] : -INFINITY;
            }
            float mx = fmaxf(fmaxf(fmaxf(sv[0], sv[1]), fmaxf(sv[2], sv[3])), fmaxf(fmaxf(sv[4], sv[5]), fmaxf(sv[6], sv[7])));
            mx = fmaxf(mx, __shfl_xor(mx, 16)); mx = fmaxf(mx, __shfl_xor(mx, 32));
            const float m_new = fmaxf(m_run, mx);
            if (!__all(m_new == m_run)) {
                const float alpha = __expf(m_run - m_new);
                l_run *= alpha;
#pragma unroll
                for (int j = 0; j < 4; ++j) { const float aj = __shfl(alpha, 4 * fq + j);
#pragma unroll
                    for (int rt = 0; rt < 8; ++rt) O[rt][j] *= aj; }
                m_run = m_new;
            }
            float p[8], ps = 0.f;
#pragma unroll
            for (int e = 0; e < 8; ++e) { p[e] = __expf(sv[e] - m_run); ps += p[e]; }
            l_run += ps;
            v4u pw; pw.x = pg8::cvt_pk_bf16(p[0], p[1]); pw.y = pg8::cvt_pk_bf16(p[2], p[3]); pw.z = pg8::cvt_pk_bf16(p[4], p[5]); pw.w = pg8::cvt_pk_bf16(p[6], p[7]);
            const bf16x8 pf = __builtin_bit_cast(bf16x8, pw);
            LAS unsigned char* tb = tile + (4 * fq + ((lane & 15) >> 2)) * SA_PITCH + 8 * (lane & 3);
#pragma unroll
            for (int rt = 0; rt < 8; ++rt) {
                const v4i16_t lo = lds_tr16(tb + 32 * rt), hi = lds_tr16(tb + 16 * SA_PITCH + 32 * rt);
                bf16x8 vf; vf[0] = lo[0]; vf[1] = lo[1]; vf[2] = lo[2]; vf[3] = lo[3]; vf[4] = hi[0]; vf[5] = hi[1]; vf[6] = hi[2]; vf[7] = hi[3];
                O[rt] = __builtin_amdgcn_mfma_f32_16x16x32_bf16(pf, vf, O[rt], 0, 0, 0);
            }
        }
        float lt = l_run; lt += __shfl_xor(lt, 16); lt += __shfl_xor(lt, 32);
        const float inv = __builtin_amdgcn_rcpf(lt);
#pragma unroll
        for (int j = 0; j < 4; ++j) {
            const float ij = __shfl(inv, 4 * fq + j);
            if (fq < 2) { bf16* op = AO + (size_t)row * 1536 + (4 * fq + j) * 128 + fr;
#pragma unroll
                for (int rt = 0; rt < 8; ++rt) op[16 * rt] = (bf16)f2bf(O[rt][j] * ij); }
        }
    }
}
__device__ __forceinline__ void p5_topk_attn(Frame& F, const int gw, const int NGW) {
    LAS int* sel = (LAS int*)(F.lds + F.wave * 16384);
    LAS unsigned char* tile = F.lds + F.wave * 16384 + 1024;
    LAS unsigned long long* cand = (LAS unsigned long long*)(F.lds + F.wave * 16384 + 1024 + SA_TILE);
    static_assert(1024 + SA_TILE + TK_CAP * 8 <= 16384, "per-wave LDS");
    for (int rix = gw; rix < M; rix += NGW) {
        const int row = ((rix & 1) ? (M - 1 - (rix >> 1)) : (rix >> 1));
        const int n = __builtin_amdgcn_readfirstlane(topk_row(F, row, sel, cand));
        sparse_row(F, row, n, sel, tile);
    }
}
constexpr int CP_KV_PITCH = 272;
__device__ __forceinline__ void p3_chunk_prep_mfma(Frame& F, KArgs A) {
    int tid = F.tid; asm volatile("" : "+v"(tid));
    const int lane = tid & 63, wave = __builtin_amdgcn_readfirstlane(tid >> 6), fr = lane & 15, fq = lane >> 4;
    LAS unsigned char* kt = F.lds;
    LAS unsigned char* vt = F.lds + 64 * CP_KV_PITCH;
    LAS float* As = (LAS float*)(F.lds + 2 * 64 * CP_KV_PITCH);
    LAS float* Ts = As + 64 * 65;
    LAS float* gcS = Ts + 64 * 68; LAS float* egS = gcS + 64; LAS float* ekS = egS + 64; LAS float* btS = ekS + 64;
    for (int cidx = F.bid; cidx < 1024; cidx += F.G) {
        const int b = cidx >> 9, h = (cidx >> 7) & 3, n = cidx & 127, row0 = b * SEQ + n * 64;
        unsigned char* blk = F.ws + WS_CHK + (size_t)cidx * CHK_STRIDE;
        const bf16* Qg = WSP(bf16, WS_QN) + (size_t)row0 * 512 + h * 128; const bf16* Kg = WSP(bf16, WS_KN) + (size_t)row0 * 512 + h * 128; const bf16* Vg = WSP(bf16, WS_VN) + (size_t)row0 * 512 + h * 128;
        const int ti = wave >> 1;
        float g_in = 0.f, bt_in = 0.f;
        if (tid < 64) { g_in = WSP(float, WS_GG)[(size_t)(row0 + tid) * 4 + h]; bt_in = WSP(float, WS_BETA)[(size_t)(row0 + tid) * 4 + h]; }
        v4u kc[2], vc[2], qc[2];
#pragma unroll
        for (int i = 0; i < 2; ++i) { const int id = tid + 512 * i, r = id >> 4, c = id & 15; kc[i] = *(const v4u*)(Kg + (size_t)r * 512 + 8 * c); vc[i] = *(const v4u*)(Vg + (size_t)r * 512 + 8 * c); qc[i] = *(const v4u*)(Qg + (size_t)r * 512 + 8 * c); }
        bf16x8 ka[4], qa[4], kbf[2][4];
#pragma unroll
        for (int s = 0; s < 4; ++s) { ka[s] = *(const bf16x8*)(Kg + (size_t)(16 * ti + fr) * 512 + 32 * s + 8 * fq); qa[s] = *(const bf16x8*)(Qg + (size_t)(16 * ti + fr) * 512 + 32 * s + 8 * fq);
            kbf[0][s] = *(const bf16x8*)(Kg + (size_t)(16 * (2 * (wave & 1)) + fr) * 512 + 32 * s + 8 * fq); kbf[1][s] = *(const bf16x8*)(Kg + (size_t)(16 * (2 * (wave & 1) + 1) + fr) * 512 + 32 * s + 8 * fq); }
        if (tid < 64) {
            float gc = g_in;
#pragma unroll
            for (int o = 1; o < 64; o <<= 1) { const float t = __shfl_up(gc, o); if (lane >= o) gc += t; }
            const float g63 = __shfl(gc, 63);
            gcS[tid] = gc; egS[tid] = __expf(gc); ekS[tid] = __expf(g63 - gc); btS[tid] = bt_in;
            if (tid == 0) *(float*)(blk + CHK_GL) = __expf(g63);
        }
#pragma unroll
        for (int i = 0; i < 2; ++i) { const int id = tid + 512 * i, r = id >> 4, c = id & 15; *(LAS v4u*)(kt + r * CP_KV_PITCH + 16 * c) = kc[i]; *(LAS v4u*)(vt + r * CP_KV_PITCH + 16 * c) = vc[i]; }
        __syncthreads();
        {
#pragma unroll
            for (int t2 = 0; t2 < 2; ++t2) {
                const int tj = 2 * (wave & 1) + t2;
                f32x4 ck = (f32x4){0.f, 0.f, 0.f, 0.f}, cq = (f32x4){0.f, 0.f, 0.f, 0.f};
#pragma unroll
                for (int s = 0; s < 4; ++s) { ck = __builtin_amdgcn_mfma_f32_16x16x32_bf16(ka[s], kbf[t2][s], ck, 0, 0, 0); cq = __builtin_amdgcn_mfma_f32_16x16x32_bf16(qa[s], kbf[t2][s], cq, 0, 0, 0); }
                const int j = 16 * tj + fr; const float gcj = gcS[j];
                bf16* QKp = (bf16*)(blk + CHK_QK);
#pragma unroll
                for (int jj = 0; jj < 4; ++jj) { const int i = 16 * ti + 4 * fq + jj; const float dec = __expf(j <= i ? gcS[i] - gcj : 0.f);
                    As[i * 65 + j] = (j < i) ? btS[i] * ck[jj] * dec : 0.f;
                    QKp[i * 64 + 32 * (j >> 5) + 8 * ((j >> 2) & 3) + 4 * ((j >> 4) & 1) + (j & 3)] = (bf16)f2bf((j <= i) ? cq[jj] * dec : 0.f); }
            }
        }
        {
#pragma unroll
            for (int x = 0; x < 2; ++x) { const int id = tid + 512 * x, i = id >> 4, d0 = (id & 15) * 8; const float e = egS[i];
                float f[8]; unpack8(qc[x], f);
                bf16* Qd = (bf16*)(blk + CHK_QD) + i * 128 + 32 * (d0 >> 5) + 4 * ((d0 >> 4) & 1);
                const int q0 = (d0 >> 2) & 3;
                v2u w0, w1; w0.x = pk2(f[0] * e, f[1] * e); w0.y = pk2(f[2] * e, f[3] * e); w1.x = pk2(f[4] * e, f[5] * e); w1.y = pk2(f[6] * e, f[7] * e);
                *(v2u*)(Qd + 8 * q0) = w0; *(v2u*)(Qd + 8 * (q0 + 1)) = w1; }
        }
        {
            const int d = tid >> 2, c0 = (tid & 3) * 16, s = c0 >> 5, a = (c0 >> 4) & 1;
            bf16* Kd = (bf16*)(blk + CHK_KDT) + d * 64;
#pragma unroll
            for (int q = 0; q < 4; ++q) { const int c = c0 + 4 * q; float kv[4];
#pragma unroll
                for (int e = 0; e < 4; ++e) kv[e] = bf1(*(const LAS bf16*)(kt + (c + e) * CP_KV_PITCH + 2 * d)) * ekS[c + e];
                v2u w; w.x = pk2(kv[0], kv[1]); w.y = pk2(kv[2], kv[3]); *(v2u*)(Kd + 32 * s + 8 * q + 4 * a) = w; }
        }
        __syncthreads();
        {
            const int c = tid >> 3, part = tid & 7;
            for (int i = 0; i < 64; ++i) {
                float acc = 0.f;
                for (int j = part; j < i; j += 8) acc += As[i * 65 + j] * Ts[j * 68 + c];
                acc += __shfl_xor(acc, 1); acc += __shfl_xor(acc, 2); acc += __shfl_xor(acc, 4);
                if (part == 0) Ts[i * 68 + c] = ((i == c) ? 1.f : 0.f) - acc;
                __builtin_amdgcn_fence(__ATOMIC_RELEASE, "wavefront"); asm volatile("s_waitcnt lgkmcnt(0)" ::: "memory");
            }
        }
        __syncthreads();
        {
            bf16x8 vf[2], kf[2];
            LAS unsigned char* vb = vt + (8 * fq + ((lane & 15) >> 2)) * CP_KV_PITCH + 32 * wave + 8 * (lane & 3);
            LAS unsigned char* kb = kt + (8 * fq + ((lane & 15) >> 2)) * CP_KV_PITCH + 32 * wave + 8 * (lane & 3);
#pragma unroll
            for (int s = 0; s < 2; ++s) {
                const v4i16_t v0 = lds_tr16(vb + (32 * s) * CP_KV_PITCH), v1 = lds_tr16(vb + (32 * s + 4) * CP_KV_PITCH), k0 = lds_tr16(kb + (32 * s) * CP_KV_PITCH), k1 = lds_tr16(kb + (32 * s + 4) * CP_KV_PITCH);
                vf[s][0] = v0[0]; vf[s][1] = v0[1]; vf[s][2] = v0[2]; vf[s][3] = v0[3]; vf[s][4] = v1[0]; vf[s][5] = v1[1]; vf[s][6] = v1[2]; vf[s][7] = v1[3];
                kf[s][0] = k0[0]; kf[s][1] = k0[1]; kf[s][2] = k0[2]; kf[s][3] = k0[3]; kf[s][4] = k1[0]; kf[s][5] = k1[1]; kf[s][6] = k1[2]; kf[s][7] = k1[3];
            }
            float* UT = (float*)(blk + CHK_UT);
            bf16* Wp = (bf16*)(blk + CHK_WP);
#pragma unroll
            for (int ti = 0; ti < 4; ++ti) {
                f32x4 cu = (f32x4){0.f, 0.f, 0.f, 0.f}, cw = (f32x4){0.f, 0.f, 0.f, 0.f};
#pragma unroll
                for (int s = 0; s < 2; ++s) {
                    const LAS float* tr = Ts + (16 * ti + fr) * 68 + 32 * s + 8 * fq;
                    const f32x4 t0 = *(const LAS f32x4*)tr, t1 = *(const LAS f32x4*)(tr + 4);
                    const f32x4 b0 = *(const LAS f32x4*)(btS + 32 * s + 8 * fq), b1 = *(const LAS f32x4*)(btS + 32 * s + 8 * fq + 4), e0 = *(const LAS f32x4*)(egS + 32 * s + 8 * fq), e1 = *(const LAS f32x4*)(egS + 32 * s + 8 * fq + 4);
                    const f32x4 u0 = t0 * b0, u1 = t1 * b1, w0 = u0 * e0, w1 = u1 * e1;
                    cu = __builtin_amdgcn_mfma_f32_16x16x32_bf16(packfrag(u0, u1), vf[s], cu, 0, 0, 0);
                    cw = __builtin_amdgcn_mfma_f32_16x16x32_bf16(packfrag(w0, w1), kf[s], cw, 0, 0, 0);
                }
                *(f32x4*)(UT + (size_t)(16 * wave + fr) * 64 + 16 * ti + 4 * fq) = cu;
#pragma unroll
                for (int jj = 0; jj < 4; ++jj) Wp[(16 * ti + 4 * fq + jj) * 128 + 32 * (wave >> 1) + 8 * (fr >> 2) + 4 * (wave & 1) + (fr & 3)] = (bf16)f2bf(cw[jj]);
            }
        }
        __syncthreads();
    }
}
__device__ __forceinline__ void p14_pool(Frame& F, KArgs A) {
    const int lane = F.lane, tid = F.tid, gw = F.bid * NWAVES + F.wave, NGW = F.G * NWAVES;
    LAS float* pw = (LAS float*)(F.lds + 16384);
    LAS float* dl = (LAS float*)(F.lds + 16384 + 65536 + F.wave * 1024);
    {   f32x4 pv[8];
#pragma unroll
        for (int j = 0; j < 8; ++j) pv[j] = *(const f32x4*)(A->in[I_CD_POOLW] + (size_t)(tid + NTHREADS * j) * 4);
#pragma unroll
        for (int j = 0; j < 8; ++j) *(LAS f32x4*)(pw + (tid + NTHREADS * j) * 4) = pv[j];
    }
    __syncthreads();
    const bf16* QK = WSP(bf16, WS_QKVZ); bf16* AO = WSP(bf16, WS_AO);
    const int gi = lane >> 4, w = 2 << gi;
    float sc[4];
#pragma unroll
    for (int g = 0; g < 4; ++g) sc[g] = A->in[I_CD_POOLS][g * 64 + lane];
    for (int row = gw; row < M; row += NGW) {
        const int pos = row & (SEQ - 1);
        const int cntw = (pos + 1 < w) ? pos + 1 : w;
        float sum[4] = {0.f, 0.f, 0.f, 0.f}, cur[4] = {0.f, 0.f, 0.f, 0.f};
        v2u xw[16];
#pragma unroll
        for (int j = 0; j < 16; ++j) xw[j] = *(const v2u*)(QK + (size_t)(row - (j <= pos ? j : pos)) * 2560 + 2304 + 4 * lane);
#pragma unroll
        for (int j = 0; j < 16; ++j) {
            const float f0 = bflo(xw[j].x), f1 = bfhi(xw[j].x), f2 = bflo(xw[j].y), f3 = bfhi(xw[j].y);
            if (j < cntw) { sum[0] += f0; sum[1] += f1; sum[2] += f2; sum[3] += f3; }
            if (j == 0) { cur[0] = f0; cur[1] = f1; cur[2] = f2; cur[3] = f3; }
        }
        const float inv = 1.0f / (float)cntw;
#pragma unroll
        for (int i = 0; i < 4; ++i) dl[4 * lane + i] = sum[i] * inv - cur[i];
        float o[4] = {0.f, 0.f, 0.f, 0.f};
        for (int c = 0; c < 64; ++c) {
#pragma unroll
            for (int g = 0; g < 4; ++g) o[g] += dl[g * 64 + c] * pw[(g * 64 + c) * 64 + lane];
        }
#pragma unroll
        for (int g = 0; g < 4; ++g) AO[(size_t)row * 1024 + 768 + g * 64 + lane] = (bf16)f2bf(o[g] * sc[g]);
    }
}


#define IN(k) (lo <= (k) && (k) < hi)
#define SEAM(k) do { if (IN(k) && IN((k) + 1)) xcd_barrier(bar); } while (0)
template <int l> __device__ __forceinline__ void layer_tail(Frame& F, const XcdBarrier& bar, const int lo, const int hi) {
    LAS unsigned char* ring = F.lds + RING_OFF;
    const int bid = F.bid, G = F.G;
        const int pb = 8 * l;

        if (IN(7 + pb)) {
            pg8::Gemm g{WSP(bf16, WS_AO), (l == 0) ? WSP(bf16, WS_W_OUTAB) : WSP(bf16, WS_W_OUTCD), M, 1024, (l == 0) ? 1536 : 1024}; pg8::StaticOrder S; S.init(M, 1024, G, bid);
            pg8::Epi<pg8::StPre> E{{(l == 0) ? kargs()->in[I_X] : WSP(float, WS_H2), WSP(float, WS_PRE), ALPHA}};
            pg8::gemm_phase<pg8::Epi<pg8::StPre>, pg8::StaticOrder, true, true>(ring, g, S, E);
        } SEAM(7 + pb);
        if (IN(8 + pb)) { p8_ln_router(F, kargs(), l, WSP(float, WS_H1), WSP(bf16, WS_H1B)); } SEAM(8 + pb);
        if (IN(9 + pb)) {
            p9_scatter(F, l, WSP(bf16, WS_H1B), WSP(float, WS_H1));
            __syncthreads();
            pg8::Gemm g{WSP(bf16, WS_H1B), WSP(bf16, WS_W_PG) + (size_t)l * 1024 * 1024, M, 1024, 1024}; pg8::StaticOrder S; S.init(M, 1024, G, bid);
            pg8::Epi<pg8::StPleGate> E{{WSP(bf16, WS_PP) + (size_t)l * M * 1024, WSP(bf16, WS_PLE)}};
            pg8::gemm_phase<pg8::Epi<pg8::StPleGate>, pg8::StaticOrder, true, true>(ring, g, S, E);
        } SEAM(9 + pb);
        const int* TILE = WSP(int, WS_ROUTE) + 3 * M * 4;
        if (IN(10 + pb)) {
            const int nT = __builtin_amdgcn_readfirstlane(TILE[NTMAX]);
            constexpr int EB = kMoeFp8 ? 1 : 2;
            pg8::Gemm g{WSP(bf16, WS_XS), (const bf16*)(F.ws + WS_W_GU + (size_t)l * NEXP * 2048 * 1024 * EB), PMAX, 2048, 1024 * EB / 2, TILE + NTMAX + 64, MISC_OFF + 2048};
            pg8::MoeOrder S{TILE, nT, 8, G, bid, (long)2048 * 1024 * EB};
            pg8::Epi<pg8::StSwiglu<kMoeFp8>> E{{kargs()->in[I_BGU] + (size_t)l * NEXP * 2048, WSP(bf16, WS_HID)}};
            pg8::gemm_phase<pg8::Epi<pg8::StSwiglu<kMoeFp8>>, pg8::MoeOrder, true, false, kMoeFp8 ? kScaleGU : 0u, kMoeFp8>(ring, g, S, E);
        } SEAM(10 + pb);
        if (IN(11 + pb)) {
            const int nT = __builtin_amdgcn_readfirstlane(TILE[NTMAX]);
            constexpr int EB = kMoeFp8 ? 1 : 2;
            pg8::Gemm g{WSP(bf16, WS_HID), (const bf16*)(F.ws + WS_W_DN + (size_t)l * NEXP * 1024 * 1024 * EB), PMAX, 1024, 1024 * EB / 2};
            pg8::MoeOrder S{TILE, nT, 4, G, bid, (long)1024 * 1024 * EB};
            pg8::Epi<pg8::StDown> E{{kargs()->in[I_BDN] + (size_t)l * NEXP * 1024, WSP(bf16, WS_YS)}};
            pg8::gemm_phase<pg8::Epi<pg8::StDown>, pg8::MoeOrder, true, false, kMoeFp8 ? kScaleDN : 0u>(ring, g, S, E);
        } SEAM(11 + pb);
        if (IN(12 + pb)) { p12_combine(F, kargs(), l, WSP(bf16, WS_H1B), (l == 0) ? WSP(float, WS_H2) : kargs()->out, (l == 0) ? WSP(bf16, WS_XB) : (bf16*)nullptr); }
}
#undef IN
#undef SEAM
__global__ void __launch_bounds__(NTHREADS, 2) mk_fwd(Args args_by_value) {
    const KArgs KA = kargs();
    extern __shared__ __attribute__((aligned(16))) unsigned char lds[];
    Frame F;
    F.lds = (LAS unsigned char*)lds;
    F.tid = threadIdx.x; F.lane = F.tid & 63; F.wave = __builtin_amdgcn_readfirstlane(F.tid >> 6);
    F.G = gridDim.x; F.bid = blockIdx.x; F.ws = KA->ws; F.ctl = (gu32*)(KA->ws + WS_CTL);
    volatile LAS unsigned* MISC = (volatile LAS unsigned*)(F.lds + MISC_OFF);
    { int t0 = threadIdx.x; asm volatile("" : "+v"(t0)); for (int u = t0; u < (LDS_BYTES - MISC_OFF) / 4; u += NTHREADS) MISC[u] = 0u; }
    __syncthreads();
    const bool use_bar = (N_LAUNCHES != NPHASES);
    XcdBarrier bar; bar.bar = (unsigned*)(F.ctl + CW_BAR) + KA->li * XCD_BAR_WORDS; bar.x = 0; bar.st = nullptr; bar.expect = 0;
    XcdBarrier bar2 = bar;
    if (use_bar && F.bid >= SEQ_WGS && F.G > SEQ_WGS) bar2 = xcd_barrier_post((unsigned*)(F.ctl + CW_BAR2), MISC + 10, (unsigned)(F.G - SEQ_WGS));
    if (use_bar) bar = xcd_barrier_post((unsigned*)(F.ctl + CW_BAR) + KA->li * XCD_BAR_WORDS, MISC + 8);
    const int lo = KA->ph_lo, hi = KA->ph_hi;
#define IN(k) (lo <= (k) && (k) < hi)
#define SEAM(k) do { if (IN(k) && IN((k) + 1)) xcd_barrier(bar); } while (0)
    LAS unsigned char* ring = F.lds + RING_OFF;
    const int bid = F.bid, G = F.G;

    if (IN(0)) { p0_prologue(F, kargs()); } SEAM(0);

            if (IN(1)) {
                { pg8::Gemm g{WSP(bf16, WS_XB), WSP(bf16, WS_W_INAB), M, 2560, 1024}; pg8::StaticOrder S; S.init(M, 2560, G, bid);
                  pg8::Epi<pg8::StInAB> E{{WSP(float, WS_SM), WSP(bf16, WS_QKVZ)}};
                  pg8::gemm_phase<pg8::Epi<pg8::StInAB>, pg8::StaticOrder, true, true>(ring, g, S, E); }
                __syncthreads();
                { pg8::Gemm g{WSP(bf16, WS_PB), WSP(bf16, WS_W_PP), 2 * M, 1024, 256}; pg8::BatchOrder S{4, (2 * M / 256) * 4, G, bid, M / 256, (long)1024 * 256 * 2};
                  pg8::Epi<pg8::StBf16> E{{WSP(bf16, WS_PP), 1024}};
                  pg8::gemm_phase<pg8::Epi<pg8::StBf16>, pg8::BatchOrder, true, true>(ring, g, S, E); }
            } SEAM(1);
            if (IN(2)) { p2_prep(F, kargs()); } SEAM(2);
            if (IN(3)) {
                p3_chunk_prep_mfma(F, kargs());
                __syncthreads();
                { pg8::Gemm g{WSP(bf16, WS_CQ), WSP(bf16, WS_W_ABS), M, 1536, 256}; pg8::StaticOrder S; S.init(M, 1536, G, bid);
                  pg8::Epi<pg8::StBf16> E{{WSP(bf16, WS_QL), 1536}};
                  pg8::gemm_phase<pg8::Epi<pg8::StBf16>, pg8::StaticOrder, true, true>(ring, g, S, E); }
            } SEAM(3);
            if (IN(4)) {
                if (bid < SEQ_WGS && G > SEQ_WGS) p4_delta_seq(F, bid);
                else { p4_indexer(F, (bid - SEQ_WGS) * NWAVES + F.wave, (G - SEQ_WGS) * NWAVES);
                    if (use_bar) { xcd_barrier(bar2);
                        p5_topk_attn(F, (bid - SEQ_WGS) * NWAVES + F.wave, (G - SEQ_WGS) * NWAVES); } }
            } SEAM(4);
            if (IN(5)) { if (!use_bar) p5_topk_attn(F, bid * NWAVES + F.wave, G * NWAVES); p6_gdn_out(F, kargs()); } SEAM(5);
    layer_tail<0>(F, bar, lo, hi);
    SEAM(12);
            if (IN(13)) {
                pg8::Gemm g{WSP(bf16, WS_XB), WSP(bf16, WS_W_INCD), M, 2560, 1024}; pg8::StaticOrder S; S.init(M, 2560, G, bid);
                pg8::Epi<pg8::StBf16> E{{WSP(bf16, WS_QKVZ), 2560}};
                pg8::gemm_phase<pg8::Epi<pg8::StBf16>, pg8::StaticOrder, true, true>(ring, g, S, E);
            } SEAM(13);
            if (IN(14)) { p14_dilated_mfma(F); __syncthreads(); p14_pool(F, kargs()); } SEAM(14);
    layer_tail<1>(F, bar, lo, hi);
#undef IN
#undef SEAM
}

extern "C" void kernel_launch(void* const* d_in, const int* in_sizes, int n_in, void* d_out, int out_size, void* d_ws, size_t ws_size, hipStream_t stream) {
    static int grid = 0;
    if (grid == 0) {
        if (n_in != N_IN || in_sizes[0] != M * D || out_size != M * D || ws_size < WS_END) {
            fprintf(stderr, "kernel_launch: built for %d inputs, x/out of %d floats, >= %zu bytes of workspace; got n_in %d, in0 %d, out %d, ws %zu; nothing launched\n", N_IN, M * D, (size_t)WS_END, n_in, n_in > 0 ? in_sizes[0] : -1, out_size, ws_size);
            grid = -1; return; }
        int dev = 0, cus = 0, per_cu = 0;
        if (hipGetDevice(&dev) != hipSuccess || hipDeviceGetAttribute(&cus, hipDeviceAttributeMultiprocessorCount, dev) != hipSuccess) { fprintf(stderr, "kernel_launch: device query failed\n"); grid = -1; return; }
        if (hipFuncSetAttribute((const void*)mk_fwd, hipFuncAttributeMaxDynamicSharedMemorySize, LDS_BYTES) != hipSuccess) { fprintf(stderr, "kernel_launch: hipFuncSetAttribute failed\n"); grid = -1; return; }
        if (hipOccupancyMaxActiveBlocksPerMultiprocessor(&per_cu, (const void*)mk_fwd, NTHREADS, LDS_BYTES) != hipSuccess || per_cu < 1)
            fprintf(stderr, "kernel_launch: note: occupancy query reports %d workgroups per CU\n", per_cu);
        (void)hipGetLastError();
        grid = cus;
    }
    if (grid < 0) return;
    if (hipMemsetAsync((char*)d_ws + WS_CTL, 0, CTL_ZERO_BYTES, stream) != hipSuccess) { fprintf(stderr, "kernel_launch: memset failed\n"); return; }
    Args a{};
    for (int i = 0; i < N_IN; ++i) a.in[i] = (const float*)d_in[i];
    a.out = (float*)d_out; a.ws = (unsigned char*)d_ws;
    for (int li = 0; li < N_LAUNCHES; ++li) {
        if (N_LAUNCHES == NPHASES) { a.ph_lo = li; a.ph_hi = li + 1; } else { a.ph_lo = (int)((long)li * NPHASES / N_LAUNCHES); a.ph_hi = (int)((long)(li + 1) * NPHASES / N_LAUNCHES); }
        a.li = li;
        hipLaunchKernelGGL(mk_fwd, dim3(grid), dim3(NTHREADS), LDS_BYTES, stream, a);
        const hipError_t le = hipPeekAtLastError();
        if (le != hipSuccess) { fprintf(stderr, "kernel_launch: launch %d failed: %s\n", li, hipGetErrorName(le)); break; }
    }
}
```

```cpp
#include <hip/hip_runtime.h>
#include <cstdio>
#include <cstdint>

namespace pg8 {
#define PG8_LAS __attribute__((address_space(3)))
typedef unsigned short bf16_t;
typedef short bf16x8 __attribute__((ext_vector_type(8)));
typedef float f32x4 __attribute__((ext_vector_type(4)));
typedef unsigned u32x4 __attribute__((ext_vector_type(4)));
constexpr int BM = 256, BK = 64, HALF = 128, HTB = HALF * BK * 2  , STAGE_BYTES = 8 * HTB, NXCD = 8, WGM = 8;

__host__ __device__ __forceinline__ int lds_byte(int r, int c) { const int st = (r >> 4) * 2 + (c >> 5), rr = r & 15, cc = c & 31, ob = rr * 64 + cc * 2; return st * 1024 + (ob ^ (((ob >> 9) & 1) << 5)); }
__host__ __device__ __forceinline__ void stage_rc(int b, int& R, int& C) { const int st = b / 1024, sb = b % 1024, swz = sb ^ (((sb >> 9) & 1) << 5); R = (st >> 1) * 16 + swz / 64; C = (st & 1) * 32 + (swz % 64) / 2; }
__host__ __device__ __forceinline__ int perm32(int rho) { const int n = rho >> 4, i = rho & 15; return 8 * (i >> 2) + 4 * n + (i & 3); }

struct Unit { int pm, pn, e; long bofs; };
struct Gemm { const bf16_t* A; const bf16_t* Bt; int M, N, K; const int* rowmap; int ids_off; int bias_off; };

struct StaticOrder {
    int nM, nN, nwg, G, c;
    __host__ __device__ void init(int M, int N, int G_, int c_) { nM = M / BM; nN = N / BM; nwg = nM * nN; G = G_; c = c_; }
    __host__ __device__ bool next(int i, Unit& u) const {
        const long L = (long)i * G + c; if (L >= nwg) return false;
        int wgid = (int)L; { const int q = nwg / NXCD, r = nwg % NXCD, xcd = wgid % NXCD, off = wgid / NXCD; wgid = (xcd < r ? xcd * (q + 1) : r * (q + 1) + (xcd - r) * q) + off; }
        const int nig = WGM * nN, gid = wgid / nig, fm = gid * WGM, gsz = (nM - fm) < WGM ? (nM - fm) : WGM;
        u.pm = fm + ((wgid % nig) % gsz); u.pn = (wgid % nig) / gsz; u.e = 0; u.bofs = 0; return true;
    }
    __device__ __forceinline__ void a_ready(const Unit&) const {}
    __device__ __forceinline__ void done(const Unit&) const {}
};
struct MoeOrder {
    const int* tile_e; int nT, nN, G, c; long estride;
    __device__ __forceinline__ bool next(int i, Unit& u) const {
        if (G % (8 * nN) == 0) {
            const int rpx = G / (8 * nN), xcd = c & 7, idx = c >> 3;
            u.pm = (i * 8 + xcd) * rpx + idx % rpx; u.pn = idx / rpx;
            if (u.pm >= nT) return false;
        } else {
            const long L = (long)i * G + c; if (L >= (long)nT * nN) return false;
            u.pm = (int)(L / nN); u.pn = (int)(L % nN);
        }
        const int e = tile_e[u.pm]; u.e = e; u.bofs = (long)e * estride; return true;
    }
    __device__ __forceinline__ void a_ready(const Unit&) const {}
    __device__ __forceinline__ void done(const Unit&) const {}
};

struct BatchOrder {
    int nN, nwg, G, c, tiles_per_batch; long bstride; int light; int ofs;
    __device__ __forceinline__ bool next(int i, Unit& u) const {
        long L;
        if (light > 0) { if (c < light) { if (i > 0) return false; L = nwg - light + c; } else { L = (long)i * (G - light) + (c - light); if (L >= nwg - light) return false; } }
        else { L = (long)i * G + c; if (L < 0 || L >= nwg) return false; }
        L += ofs; u.pm = (int)(L / nN); u.pn = (int)(L % nN); const int e = u.pm / tiles_per_batch; u.e = e; u.bofs = (long)e * bstride; return true;
    }
    __device__ __forceinline__ void a_ready(const Unit&) const {}
    __device__ __forceinline__ void done(const Unit&) const {}
};

typedef float f32x2c __attribute__((ext_vector_type(2)));
typedef __bf16 bf16x2c __attribute__((ext_vector_type(2)));
__device__ __forceinline__ unsigned cvt_pk_bf16(float lo, float hi) { const f32x2c v = {lo, hi}; const bf16x2c b = __builtin_convertvector(v, bf16x2c); return __builtin_bit_cast(unsigned, b); }
__device__ __forceinline__ u32x4 pack8(const f32x4 v0, const f32x4 v1) { u32x4 w; w.x = cvt_pk_bf16(v0[0], v0[1]); w.y = cvt_pk_bf16(v0[2], v0[3]); w.z = cvt_pk_bf16(v1[0], v1[1]); w.w = cvt_pk_bf16(v1[2], v1[3]); return w; }
__device__ __forceinline__ float bf_lo(unsigned w) { return __uint_as_float(w << 16); }
__device__ __forceinline__ float bf_hi(unsigned w) { return __uint_as_float(w & 0xffff0000u); }
__device__ __forceinline__ float sigmoidf_(float x) { return __builtin_amdgcn_rcpf(1.0f + __builtin_amdgcn_exp2f(x * -1.4426950408889634f)); }
typedef unsigned u32x2 __attribute__((ext_vector_type(2)));

template <class T> struct Epi {
    static constexpr bool PERM = true, AFTER_DRAIN = false, ACC_BIAS = T::ACC_BIAS;
    T t;
    __device__ __forceinline__ void operator()(const f32x4 (&acc)[2][2][4][2], const Unit& u, int wr, int wc, int fr, int fq) const {
        const int row0 = u.pm * BM + wr * 64 + fr, col0 = u.pn * BM + wc * 64 + 16 * fq;
        f32x4 cb[2][2];
#pragma unroll
        for (int bj = 0; bj < 2; ++bj) t.colctx(col0 + bj * 8, u, cb[bj][0], cb[bj][1]);
        f32x4 rc[2][2], rn[2][2];
#pragma unroll
        for (int bj = 0; bj < 2; ++bj) t.rowctx(row0, col0 + bj * 8, rc[bj][0], rc[bj][1]);
#pragma unroll
        for (int g = 0; g < 8; ++g) {
            const int ai = g >> 2, m = g & 3, row = row0 + ai * HALF + m * 16;
            if (g < 7) { const int nrow = row0 + ((g + 1) >> 2) * HALF + ((g + 1) & 3) * 16;
#pragma unroll
                for (int bj = 0; bj < 2; ++bj) t.rowctx(nrow, col0 + bj * 8, rn[bj][0], rn[bj][1]); }
            if constexpr (T::PAIR) t.store16(row, col0, acc[ai][0][m][0] + cb[0][0], acc[ai][0][m][1] + cb[0][1], acc[ai][1][m][0] + cb[1][0], acc[ai][1][m][1] + cb[1][1], u);
            else {
#pragma unroll
            for (int bj = 0; bj < 2; ++bj) t.store(row, col0 + bj * 8, acc[ai][bj][m][0] + cb[bj][0], acc[ai][bj][m][1] + cb[bj][1], u, rc[bj][0], rc[bj][1]); }
            asm volatile("" ::: "memory");
#pragma unroll
            for (int bj = 0; bj < 2; ++bj) { rc[bj][0] = rn[bj][0]; rc[bj][1] = rn[bj][1]; }
        }
    }
};
struct StBf16 { static constexpr bool PAIR = false, ACC_BIAS = false; __device__ __forceinline__ const float* bias_ptr(const Unit&) const { return nullptr; } bf16_t* O; int ld;
    __device__ __forceinline__ void rowctx(int, int, f32x4& r0, f32x4& r1) const { r0 = (f32x4){0.f, 0.f, 0.f, 0.f}; r1 = r0; }
    __device__ __forceinline__ void colctx(int, const Unit&, f32x4& c0, f32x4& c1) const { c0 = (f32x4){0.f, 0.f, 0.f, 0.f}; c1 = c0; }
    __device__ __forceinline__ void store(int row, int col, f32x4 v0, f32x4 v1, const Unit&, f32x4, f32x4) const { *(u32x4*)(O + (size_t)row * ld + col) = pack8(v0, v1); } };
struct StInAB { static constexpr bool PAIR = false, ACC_BIAS = false; __device__ __forceinline__ const float* bias_ptr(const Unit&) const { return nullptr; } float* SM; bf16_t* Q;
    __device__ __forceinline__ void rowctx(int, int, f32x4& r0, f32x4& r1) const { r0 = (f32x4){0.f, 0.f, 0.f, 0.f}; r1 = r0; }
    __device__ __forceinline__ void colctx(int, const Unit&, f32x4& c0, f32x4& c1) const { c0 = (f32x4){0.f, 0.f, 0.f, 0.f}; c1 = c0; }
    __device__ __forceinline__ void store(int row, int col, f32x4 v0, f32x4 v1, const Unit&, f32x4, f32x4) const {
        if (col < 512) { float* p = SM + (size_t)row * 512 + col; *(f32x4*)p = v0; *(f32x4*)(p + 4) = v1; }
        else *(u32x4*)(Q + (size_t)row * 2048 + (col - 512)) = pack8(v0, v1); } };
struct StPre { static constexpr bool PAIR = false, ACC_BIAS = false; __device__ __forceinline__ const float* bias_ptr(const Unit&) const { return nullptr; } const float* base; float* P; float alpha;
    __device__ __forceinline__ void colctx(int, const Unit&, f32x4& c0, f32x4& c1) const { c0 = (f32x4){0.f, 0.f, 0.f, 0.f}; c1 = c0; }
    __device__ __forceinline__ void rowctx(int row, int col, f32x4& r0, f32x4& r1) const { const size_t o = (size_t)row * 1024 + col; r0 = *(const f32x4*)(base + o); r1 = *(const f32x4*)(base + o + 4); }
    __device__ __forceinline__ void store(int row, int col, f32x4 v0, f32x4 v1, const Unit&, f32x4 b0, f32x4 b1) const {
        const size_t o = (size_t)row * 1024 + col;
        *(f32x4*)(P + o) = b0 * alpha + v0; *(f32x4*)(P + o + 4) = b1 * alpha + v1; } };
struct StPleGate { static constexpr bool PAIR = false, ACC_BIAS = false; __device__ __forceinline__ const float* bias_ptr(const Unit&) const { return nullptr; } const bf16_t* PP; bf16_t* O;
    __device__ __forceinline__ void colctx(int, const Unit&, f32x4& c0, f32x4& c1) const { c0 = (f32x4){0.f, 0.f, 0.f, 0.f}; c1 = c0; }
    __device__ __forceinline__ void rowctx(int row, int col, f32x4& r0, f32x4& r1) const { r0 = *(const f32x4*)(PP + (size_t)row * 1024 + col); r1 = r0; }
    __device__ __forceinline__ void store(int row, int col, f32x4 v0, f32x4 v1, const Unit&, f32x4 pr, f32x4) const {
        const size_t o = (size_t)row * 1024 + col; const u32x4 p = __builtin_bit_cast(u32x4, pr);
        f32x4 r0, r1;
        r0[0] = sigmoidf_(v0[0]) * bf_lo(p.x); r0[1] = sigmoidf_(v0[1]) * bf_hi(p.x); r0[2] = sigmoidf_(v0[2]) * bf_lo(p.y); r0[3] = sigmoidf_(v0[3]) * bf_hi(p.y);
        r1[0] = sigmoidf_(v1[0]) * bf_lo(p.z); r1[1] = sigmoidf_(v1[1]) * bf_hi(p.z); r1[2] = sigmoidf_(v1[2]) * bf_lo(p.w); r1[3] = sigmoidf_(v1[3]) * bf_hi(p.w);
        *(u32x4*)(O + o) = pack8(r0, r1); } };
template <bool F8> struct StSwiglu { static constexpr bool PAIR = F8, ACC_BIAS = true; const float* bgu; bf16_t* H;
    __device__ __forceinline__ const float* bias_ptr(const Unit& u) const { return bgu + (size_t)u.e * 2048 + u.pn * BM; }
    __device__ __forceinline__ void rowctx(int, int, f32x4& r0, f32x4& r1) const { r0 = (f32x4){0.f, 0.f, 0.f, 0.f}; r1 = r0; }
    __device__ __forceinline__ float act(float g, float u) const { const float gt = __builtin_amdgcn_fmed3f(g, -INFINITY, 7.0f), up = __builtin_amdgcn_fmed3f(u, -7.0f, 7.0f);
        return (up + 1.0f) * (gt * __builtin_amdgcn_rcpf(1.0f + __builtin_amdgcn_exp2f(gt * -2.4554669595930157f))); }
    __device__ __forceinline__ void colctx(int, const Unit&, f32x4& c0, f32x4& c1) const { c0 = (f32x4){0.f, 0.f, 0.f, 0.f}; c1 = c0; }
    __device__ __forceinline__ void store(int row, int col, f32x4 v0, f32x4 v1, const Unit& u, f32x4, f32x4) const {
        if (F8) { unsigned w = 0u; w = __builtin_amdgcn_cvt_pk_fp8_f32(act(v0[0], v0[1]), act(v0[2], v0[3]), w, false); w = __builtin_amdgcn_cvt_pk_fp8_f32(act(v1[0], v1[1]), act(v1[2], v1[3]), w, true);
            *(unsigned*)((unsigned char*)H + (size_t)row * 1024 + (col >> 1)) = w; }
        else { u32x2 w; w.x = cvt_pk_bf16(act(v0[0], v0[1]), act(v0[2], v0[3])); w.y = cvt_pk_bf16(act(v1[0], v1[1]), act(v1[2], v1[3]));
            *(u32x2*)(H + (size_t)row * 1024 + (col >> 1)) = w; } }
    __device__ __forceinline__ f32x2c act2(float g0, float u0, float g1, float u1) const {
        f32x2c gt, up; gt[0] = __builtin_amdgcn_fmed3f(g0, -INFINITY, 7.0f); gt[1] = __builtin_amdgcn_fmed3f(g1, -INFINITY, 7.0f); up[0] = __builtin_amdgcn_fmed3f(u0, -7.0f, 7.0f); up[1] = __builtin_amdgcn_fmed3f(u1, -7.0f, 7.0f);
        const f32x2c t = gt * -2.4554669595930157f; f32x2c e; e[0] = __builtin_amdgcn_exp2f(t[0]); e[1] = __builtin_amdgcn_exp2f(t[1]);
        const f32x2c d = e + 1.0f; f32x2c r; r[0] = __builtin_amdgcn_rcpf(d[0]); r[1] = __builtin_amdgcn_rcpf(d[1]);
        return (up + 1.0f) * (gt * r); }
    __device__ __forceinline__ void store16(int row, int col, f32x4 a0, f32x4 a1, f32x4 b0, f32x4 b1, const Unit& u) const {
        u32x2 w; unsigned x = 0u, y = 0u;
        { const f32x2c p = act2(a0[0], a0[1], a0[2], a0[3]), q = act2(a1[0], a1[1], a1[2], a1[3]); x = __builtin_amdgcn_cvt_pk_fp8_f32(p[0], p[1], x, false); x = __builtin_amdgcn_cvt_pk_fp8_f32(q[0], q[1], x, true); }
        { const f32x2c p = act2(b0[0], b0[1], b0[2], b0[3]), q = act2(b1[0], b1[1], b1[2], b1[3]); y = __builtin_amdgcn_cvt_pk_fp8_f32(p[0], p[1], y, false); y = __builtin_amdgcn_cvt_pk_fp8_f32(q[0], q[1], y, true); }
        w.x = x; w.y = y; *(u32x2*)((unsigned char*)H + (size_t)row * 1024 + (col >> 1)) = w; } };
template <bool F8> struct StDown { static constexpr bool PAIR = F8, ACC_BIAS = true; const float* bd; bf16_t* Y;
    __device__ __forceinline__ const float* bias_ptr(const Unit& u) const { return bd + (size_t)u.e * 1024 + u.pn * BM; }
    __device__ __forceinline__ void rowctx(int, int, f32x4& r0, f32x4& r1) const { r0 = (f32x4){0.f, 0.f, 0.f, 0.f}; r1 = r0; }
    __device__ __forceinline__ void colctx(int, const Unit&, f32x4& c0, f32x4& c1) const { c0 = (f32x4){0.f, 0.f, 0.f, 0.f}; c1 = c0; }
    __device__ __forceinline__ void store(int row, int col, f32x4 v0, f32x4 v1, const Unit& u, f32x4, f32x4) const {
        if (F8) { u32x2 w; unsigned a = 0u, b = 0u;
            a = __builtin_amdgcn_cvt_pk_fp8_f32(v0[0], v0[1], a, false); a = __builtin_amdgcn_cvt_pk_fp8_f32(v0[2], v0[3], a, true);
            b = __builtin_amdgcn_cvt_pk_fp8_f32(v1[0], v1[1], b, false); b = __builtin_amdgcn_cvt_pk_fp8_f32(v1[2], v1[3], b, true);
            w.x = a; w.y = b; *(u32x2*)((unsigned char*)Y + (size_t)row * 1024 + col) = w; }
        else *(u32x4*)(Y + (size_t)row * 1024 + col) = pack8(v0, v1); }
    __device__ __forceinline__ void store16(int row, int col, f32x4 a0, f32x4 a1, f32x4 b0, f32x4 b1, const Unit& u) const {
        u32x4 w; unsigned x = 0u;
        x = __builtin_amdgcn_cvt_pk_fp8_f32(a0[0], a0[1], 0u, false); x = __builtin_amdgcn_cvt_pk_fp8_f32(a0[2], a0[3], x, true); w.x = x;
        x = __builtin_amdgcn_cvt_pk_fp8_f32(a1[0], a1[1], 0u, false); x = __builtin_amdgcn_cvt_pk_fp8_f32(a1[2], a1[3], x, true); w.y = x;
        x = __builtin_amdgcn_cvt_pk_fp8_f32(b0[0], b0[1], 0u, false); x = __builtin_amdgcn_cvt_pk_fp8_f32(b0[2], b0[3], x, true); w.z = x;
        x = __builtin_amdgcn_cvt_pk_fp8_f32(b1[0], b1[1], 0u, false); x = __builtin_amdgcn_cvt_pk_fp8_f32(b1[2], b1[3], x, true); w.w = x;
        *(u32x4*)((unsigned char*)Y + (size_t)row * 1024 + col) = w; } };

typedef int i32x8 __attribute__((ext_vector_type(8)));
typedef int i32x4 __attribute__((ext_vector_type(4)));
template <class Epi, class Sched, bool ALIGN_EPI = false, bool SP2 = false, unsigned FP8W = 0u, bool GATHER = false>
__device__ __forceinline__ void gemm_phase(PG8_LAS unsigned char* lds, const Gemm g, const Sched& S, const Epi& E) {
    int tid = threadIdx.x; asm volatile("" : "+v"(tid));
    const int wid = __builtin_amdgcn_readfirstlane(tid >> 6), lane = tid & 63, wr = wid >> 2, wc = wid & 3, fr = lane & 15, fq = lane >> 4;
    int K = g.K; asm volatile("" : "+s"(K));
    const int nt = K / BK;
    unsigned voffA[2], voffB[2], colA[2]; int rowA[2];
#pragma unroll
    for (int i = 0; i < 2; ++i) { int R, C; stage_rc(tid * 16 + i * 8192, R, C); const int Rb = Epi::PERM ? ((R & ~31) + perm32(R & 31)) : R;
        voffA[i] = (unsigned)(R * K + C) * 2u; voffB[i] = Epi::PERM ? (unsigned)((64 * (Rb >> 5) + 16 * ((Rb >> 3) & 3) + (Rb & 7)) * K + C) * 2u : (unsigned)(Rb * K + C) * 2u; rowA[i] = R;     colA[i] = (unsigned)C * 2u; }
    static_assert(!(GATHER && SP2), "gather mode: 8-phase schedule only");
    unsigned vA[2][2];
    PG8_LAS int* idl = (PG8_LAS int*)(lds + g.ids_off);
    const size_t kstep = (size_t)(BK * 2);
    const size_t hstep = (size_t)HALF * K * 2;
    const size_t tstep = 2 * hstep;
    const size_t hstepB = Epi::PERM ? (size_t)8 * K * 2 : hstep;
    const unsigned ldsw = (unsigned)wid * 1024u;
    const int aoff = lds_byte(wr * 64 + fr, fq * 8), boff = lds_byte(wc * 32 + fr, fq * 8);
#define PG8_SA(b, h) (((b) * 2 + (h)) * HTB)
#define PG8_SB(b, h) ((4 + (b) * 2 + (h)) * HTB)
#define PG8_STAGE(bufoff, gbase, voff) do { _Pragma("unroll") for (int _i = 0; _i < 2; ++_i) \
        __builtin_amdgcn_global_load_lds((const unsigned*)((const char*)(gbase) + (voff)[_i]), (PG8_LAS unsigned*)(lds + (bufoff) + ldsw + _i * 8192), 16, 0, 0); } while (0)
#define PG8_STAGE_A(bufoff, base, h) do { if constexpr (GATHER) PG8_STAGE(bufoff, base, vA[h]); else PG8_STAGE(bufoff, (base) + (h) * hstep, voffA); } while (0)
#define PG8_CAT(lo, hi) __builtin_shufflevector((lo), (hi), 0, 1, 2, 3, 4, 5, 6, 7)
#define PG8_LDA(dst, b, h) do { if constexpr (FP8W != 0u) { _Pragma("unroll") for (int m = 0; m < 4; ++m) dst##8[m] = PG8_CAT(*(const PG8_LAS i32x4*)(lds + PG8_SA(b, h) + aoff + m * 2048), *(const PG8_LAS i32x4*)(lds + PG8_SA(b, h) + aoff + m * 2048 + 1024)); } \
        else { _Pragma("unroll") for (int m = 0; m < 4; ++m) _Pragma("unroll") for (int k = 0; k < 2; ++k) dst[m][k] = *(const PG8_LAS bf16x8*)(lds + PG8_SA(b, h) + aoff + m * 2048 + k * 1024); } } while (0)
#define PG8_LDB(dst, b, h) do { if constexpr (FP8W != 0u) { _Pragma("unroll") for (int n = 0; n < 2; ++n) dst##8[n] = PG8_CAT(*(const PG8_LAS i32x4*)(lds + PG8_SB(b, h) + boff + n * 2048), *(const PG8_LAS i32x4*)(lds + PG8_SB(b, h) + boff + n * 2048 + 1024)); } \
        else { _Pragma("unroll") for (int n = 0; n < 2; ++n) _Pragma("unroll") for (int k = 0; k < 2; ++k) dst[n][k] = *(const PG8_LAS bf16x8*)(lds + PG8_SB(b, h) + boff + n * 2048 + k * 1024); } } while (0)
#define PG8_MMA(ai, bj, At, Bt) do { __builtin_amdgcn_s_setprio(1); _Pragma("unroll") for (int m = 0; m < 4; ++m) _Pragma("unroll") for (int n = 0; n < 2; ++n) { \
        if constexpr (FP8W != 0u) asm volatile("v_mfma_scale_f32_16x16x128_f8f6f4 %0, %1, %2, %0, %3, %4 op_sel_hi:[0,0,0]" : "+v"(acc[ai][bj][m][n]) : "v"(Bt##8[n]), "v"(At##8[m]), "v"(sc_w), "v"(sc_x));   \
        else { _Pragma("unroll") for (int k = 0; k < 2; ++k) acc[ai][bj][m][n] = __builtin_amdgcn_mfma_f32_16x16x32_bf16(Bt[n][k], At[m][k], acc[ai][bj][m][n], 0, 0, 0); } } __builtin_amdgcn_s_setprio(0); } while (0)
#define PG8_WAIT_V(n) asm volatile("s_waitcnt vmcnt(" #n ")" ::: "memory")
#define PG8_WAIT_L(n) asm volatile("s_waitcnt lgkmcnt(" #n ")" ::: "memory")
#define PG8_BAR __builtin_amdgcn_s_barrier()
#define PG8_SCHED __builtin_amdgcn_sched_barrier(0)
    Unit cur, nxt; int ui = 0;
    if (!S.next(0, cur)) return;
    f32x4 acc[2][2][4][2];
    PG8_LAS float* biasl = (PG8_LAS float*)(lds + g.bias_off);
    {   f32x4 bz[2][2];
#pragma unroll
        for (int b = 0; b < 2; ++b)
#pragma unroll
            for (int n = 0; n < 2; ++n) { if constexpr (Epi::ACC_BIAS) bz[b][n] = *(const f32x4*)(E.t.bias_ptr(cur) + wc * 64 + 16 * fq + 8 * b + 4 * n); else bz[b][n] = (f32x4){0.f, 0.f, 0.f, 0.f}; }
#pragma unroll
        for (int a = 0; a < 2; ++a)
#pragma unroll
            for (int b = 0; b < 2; ++b)
#pragma unroll
                for (int m = 0; m < 4; ++m)
#pragma unroll
                    for (int n = 0; n < 2; ++n) acc[a][b][m][n] = bz[b][n];
    }
    bf16x8 At[4][2], B0[2][2], B1[2][2];
    int sc_w = (int)FP8W, sc_x = 0x7f7f7f7f; asm volatile("" : "+v"(sc_w), "+v"(sc_x));
    i32x8 At8[4], B08[2], B18[2];
    const char* cA = (const char*)g.A + (GATHER ? (size_t)0 : (size_t)cur.pm * tstep); const char* cB = (const char*)g.Bt + (size_t)cur.pn * tstep + cur.bofs;
    S.a_ready(cur);
    if constexpr (GATHER) {
#pragma unroll
        for (int h = 0; h < 2; ++h)
#pragma unroll
            for (int i = 0; i < 2; ++i) vA[h][i] = (unsigned)(g.rowmap[256 * cur.pm + 128 * h + rowA[i]] & 16383) * (unsigned)(K * 2) + colA[i];
    }
    if constexpr (SP2) {
        PG8_STAGE(PG8_SB(0, 0), cB, voffB); PG8_STAGE(PG8_SB(0, 1), cB + hstepB, voffB); PG8_STAGE(PG8_SA(0, 0), cA, voffA); PG8_STAGE(PG8_SA(0, 1), cA + hstep, voffA);
        if (wr == 1) PG8_BAR;
        PG8_WAIT_V(2); PG8_BAR;
        PG8_STAGE(PG8_SB(1, 0), cB + kstep, voffB); PG8_STAGE(PG8_SA(1, 0), cA + kstep, voffA); PG8_STAGE(PG8_SB(1, 1), cB + hstepB + kstep, voffB);
        PG8_WAIT_V(6); PG8_BAR;
    } else {
        PG8_STAGE(PG8_SB(0, 0), cB, voffB); PG8_STAGE_A(PG8_SA(0, 0), cA, 0); PG8_STAGE(PG8_SB(0, 1), cB + hstepB, voffB); PG8_STAGE_A(PG8_SA(0, 1), cA, 1);
        if (wr == 1) PG8_BAR;
        PG8_WAIT_V(4); PG8_BAR;
        PG8_STAGE(PG8_SB(1, 0), cB + kstep, voffB); PG8_STAGE_A(PG8_SA(1, 0), cA + kstep, 0); PG8_STAGE(PG8_SB(1, 1), cB + hstepB + kstep, voffB);
        PG8_WAIT_V(6); PG8_BAR;
    }
    for (;;) {
        const bool has_next = S.next(ui + 1, nxt);
        if constexpr (GATHER) {
            if (has_next && wid < 4) __builtin_amdgcn_global_load_lds((const unsigned*)(g.rowmap + 256 * nxt.pm + tid), (PG8_LAS unsigned*)((PG8_LAS unsigned char*)idl + wid * 256), 4, 0, 0);
        }
        if constexpr (Epi::ACC_BIAS) {
            if (has_next && wid < 4) __builtin_amdgcn_global_load_lds((const unsigned*)(E.t.bias_ptr(nxt) + tid), (PG8_LAS unsigned*)((PG8_LAS unsigned char*)biasl + ((ui + 1) & 1) * 1024 + wid * 256), 4, 0, 0);
        }
        const char* nA = GATHER ? (const char*)g.A : has_next ? (const char*)g.A + (size_t)nxt.pm * tstep : cA; const char* nB = has_next ? (const char*)g.Bt + (size_t)nxt.pn * tstep + nxt.bofs : cB;
        for (int t = 0; t < nt; t += 2) {
            const bool last = (t == nt - 2);
            const char* a1 = cA + (size_t)(t + 1) * kstep;
            const char* a2 = last ? nA : cA + (size_t)(t + 2) * kstep; const char* b2 = last ? nB : cB + (size_t)(t + 2) * kstep;
            const char* a3 = a2 + kstep; const char* b3 = b2 + kstep;
            if (last && has_next) S.a_ready(nxt);
            if constexpr (SP2) {
            PG8_LDB(B0, 0, 0); PG8_LDB(B1, 0, 1); PG8_SCHED; PG8_LDA(At, 0, 0); PG8_STAGE(PG8_SA(1, 1), a1 + hstep, voffA);
            PG8_WAIT_V(8); PG8_WAIT_L(0); PG8_BAR; PG8_MMA(0, 0, At, B0); PG8_MMA(0, 1, At, B1); PG8_BAR; PG8_SCHED;
            PG8_LDA(At, 0, 1); PG8_STAGE(PG8_SB(0, 0), b2, voffB); PG8_STAGE(PG8_SB(0, 1), b2 + hstepB, voffB); PG8_STAGE(PG8_SA(0, 0), a2, voffA);
            PG8_WAIT_V(8); PG8_WAIT_L(0); PG8_BAR; PG8_MMA(1, 0, At, B0); PG8_MMA(1, 1, At, B1); PG8_BAR; PG8_SCHED;
            PG8_LDB(B0, 1, 0); PG8_LDB(B1, 1, 1); PG8_SCHED; PG8_LDA(At, 1, 0); PG8_STAGE(PG8_SA(0, 1), a2 + hstep, voffA);
            PG8_WAIT_V(8); PG8_WAIT_L(0); PG8_BAR; PG8_MMA(0, 0, At, B0); PG8_MMA(0, 1, At, B1); PG8_BAR; PG8_SCHED;
            PG8_LDA(At, 1, 1); PG8_STAGE(PG8_SB(1, 0), b3, voffB); PG8_STAGE(PG8_SB(1, 1), b3 + hstepB, voffB); PG8_STAGE(PG8_SA(1, 0), a3, voffA);
            PG8_WAIT_V(8); PG8_WAIT_L(0); PG8_BAR; PG8_MMA(1, 0, At, B0); PG8_MMA(1, 1, At, B1); PG8_BAR; PG8_SCHED;
            } else {
            PG8_LDB(B0, 0, 0); PG8_SCHED; PG8_LDA(At, 0, 0); PG8_STAGE_A(PG8_SA(1, 1), a1, 1);
            PG8_WAIT_L(8); PG8_BAR; PG8_WAIT_L(0); PG8_MMA(0, 0, At, B0); PG8_BAR; PG8_SCHED;
            if constexpr (GATHER) {
                if (last && has_next) {
#pragma unroll
                    for (int h = 0; h < 2; ++h)
#pragma unroll
                        for (int i = 0; i < 2; ++i) vA[h][i] = (unsigned)(idl[128 * h + rowA[i]] & 16383) * (unsigned)(K * 2) + colA[i];
                }
                PG8_SCHED;
            }
            PG8_LDB(B1, 0, 1); PG8_STAGE(PG8_SB(0, 0), b2, voffB);
            PG8_BAR; PG8_WAIT_L(0); PG8_MMA(0, 1, At, B1); PG8_BAR;
            PG8_LDA(At, 0, 1); PG8_STAGE_A(PG8_SA(0, 0), a2, 0);
            PG8_BAR; PG8_WAIT_L(0); PG8_MMA(1, 0, At, B0); PG8_BAR; PG8_SCHED;
            PG8_STAGE(PG8_SB(0, 1), b2 + hstepB, voffB);
            PG8_WAIT_V(6); PG8_BAR; PG8_MMA(1, 1, At, B1); PG8_BAR;
            PG8_LDB(B0, 1, 0); PG8_SCHED; PG8_LDA(At, 1, 0); PG8_STAGE_A(PG8_SA(0, 1), a2, 1);
            PG8_WAIT_L(8); PG8_BAR; PG8_WAIT_L(0); PG8_MMA(0, 0, At, B0); PG8_BAR; PG8_SCHED;
            PG8_LDB(B1, 1, 1); PG8_STAGE(PG8_SB(1, 0), b3, voffB);
            PG8_BAR; PG8_WAIT_L(0); PG8_MMA(0, 1, At, B1); PG8_BAR;
            PG8_LDA(At, 1, 1); PG8_STAGE_A(PG8_SA(1, 0), a3, 0);
            PG8_BAR; PG8_WAIT_L(0); PG8_MMA(1, 0, At, B0); PG8_BAR; PG8_SCHED;
            PG8_STAGE(PG8_SB(1, 1), b3 + hstepB, voffB);
            PG8_WAIT_V(6); PG8_BAR; PG8_MMA(1, 1, At, B1); PG8_BAR;
            }
        }
        if constexpr (FP8W != 0u) asm volatile("s_nop 15\n\ts_nop 15" ::: "memory");
        if constexpr (ALIGN_EPI) { if (wr == 0) PG8_BAR; }
        if constexpr (!Epi::AFTER_DRAIN) { E(acc, cur, wr, wc, fr, fq); S.done(cur); }
        if (!has_next) break;
        {   f32x4 bz[2][2];
#pragma unroll
            for (int b = 0; b < 2; ++b)
#pragma unroll
                for (int n = 0; n < 2; ++n) { if constexpr (Epi::ACC_BIAS) bz[b][n] = *(const PG8_LAS f32x4*)(biasl + ((ui + 1) & 1) * 256 + wc * 64 + 16 * fq + 8 * b + 4 * n); else bz[b][n] = (f32x4){0.f, 0.f, 0.f, 0.f}; }
#pragma unroll
            for (int a = 0; a < 2; ++a)
#pragma unroll
                for (int b = 0; b < 2; ++b)
#pragma unroll
                    for (int m = 0; m < 4; ++m)
#pragma unroll
                        for (int n = 0; n < 2; ++n) acc[a][b][m][n] = bz[b][n];
        }
        cur = nxt; cA = nA; cB = nB; ++ui;
        if constexpr (ALIGN_EPI) { if (wr == 1) PG8_BAR; }
    }
    PG8_WAIT_V(0);
    if constexpr (!ALIGN_EPI) { if (wr == 0) PG8_BAR; }
    PG8_BAR;
    if constexpr (Epi::AFTER_DRAIN) { E.fused(acc, cur, wr, wc, fr, fq, lds, wid, lane); S.done(cur); }
#undef PG8_SA
#undef PG8_SB
#undef PG8_STAGE
#undef PG8_STAGE_A
#undef PG8_LDA
#undef PG8_CAT
#undef PG8_LDB
#undef PG8_MMA
#undef PG8_WAIT_V
#undef PG8_WAIT_L
#undef PG8_BAR
#undef PG8_SCHED
}
}

constexpr int NWAVES = 8, NTHREADS = 512;
constexpr int BATCH = 2, SEQ = 8192, M = BATCH * SEQ, D = 1024;
constexpr int NEXP = 32, DEXP = 1024;
constexpr int PMAX = M * 4 + NEXP * 256, NTMAX = PMAX / 256;
constexpr float ALPHA = 1.41421356237f;
constexpr int NPHASES = 21;
#ifndef MOE_FP8
#define MOE_FP8 1
#endif
constexpr bool kMoeFp8 = (MOE_FP8 != 0);
constexpr unsigned kScaleGU = 0x79797979u, kScaleDN = 0x78787878u;
#ifndef MK_N_LAUNCHES
#define MK_N_LAUNCHES 1
#endif
constexpr int N_LAUNCHES = MK_N_LAUNCHES;

enum { I_X = 0, I_P, I_AB_WIN, I_AB_QG, I_AB_KVG, I_AB_WUQ, I_AB_WUK, I_AB_WUV, I_AB_WQIDX, I_AB_KIG, I_AB_KIB, I_AB_CONVW, I_AB_ALOG, I_AB_DTB, I_AB_ONG, I_AB_WOUT,
       I_CD_WIN, I_CD_POOLW, I_CD_POOLS, I_CD_WOUT, I_LNM_G, I_LNM_B, I_RW, I_RB, I_WGU, I_BGU, I_WDN, I_BDN, I_PLE_WP, I_PLE_WG, I_LNF_G, I_LNF_B, N_IN };

constexpr size_t MiB = 1u << 20;
constexpr size_t WS_CTL = 0, CTL_ZERO_BYTES = 1 * MiB;
constexpr size_t WS_W_INAB = 1 * MiB;
constexpr size_t WS_W_ABS = 6 * MiB;
constexpr size_t WS_W_OUTAB = 7 * MiB;
constexpr size_t WS_W_INCD = 10 * MiB;
constexpr size_t WS_W_OUTCD = 15 * MiB;
constexpr size_t WS_W_PG = 17 * MiB;
constexpr size_t WS_W_PP = 21 * MiB;
constexpr size_t WS_W_GU = 22 * MiB;
constexpr size_t WS_W_DN = 278 * MiB;
constexpr size_t WS_XB = 406 * MiB;
constexpr size_t WS_PB = 438 * MiB;
constexpr size_t WS_PP = 454 * MiB;
constexpr size_t WS_SM = 518 * MiB;
constexpr size_t WS_QKVZ = 550 * MiB;
constexpr size_t WS_CQ = 630 * MiB;
constexpr size_t WS_CKV = 638 * MiB;
constexpr size_t WS_KIDX = 642 * MiB;
constexpr size_t WS_WIDX = 644 * MiB;
constexpr size_t WS_BETA = 645 * MiB;
constexpr size_t WS_GG = WS_BETA + 512 * 1024;
constexpr size_t WS_QN = 646 * MiB, WS_KN = 662 * MiB, WS_VN = 678 * MiB;
constexpr size_t WS_QL = 694 * MiB;
constexpr size_t WS_CHK = 742 * MiB;
constexpr size_t WS_SEL = 838 * MiB;
constexpr size_t WS_NSEL = 854 * MiB;
constexpr size_t WS_ODELTA = 855 * MiB;
constexpr size_t WS_AO = 887 * MiB;
constexpr size_t WS_PRE = 935 * MiB;
constexpr size_t WS_H1 = 999 * MiB;
constexpr size_t WS_H2 = 1063 * MiB;
constexpr size_t WS_H1B = 1127 * MiB;
constexpr size_t WS_PLE = 1159 * MiB;
constexpr size_t WS_ROUTE = 1191 * MiB;
constexpr size_t WS_BIG = 1193 * MiB;
constexpr size_t WS_XS = WS_BIG, WS_HID = WS_BIG + 144 * MiB, WS_YS = WS_BIG + 288 * MiB;
constexpr size_t WS_END = WS_BIG + 512 * MiB;
static_assert((size_t)PMAX * 1024 * 2 <= 144 * MiB && WS_END <= 2048 * MiB, "d_ws map");
constexpr size_t CHK_WP = 0, CHK_QD = 16384, CHK_KDT = 32768, CHK_QK = 49152, CHK_UT = 57344, CHK_GL = 90112, CHK_STRIDE = 92160;
static_assert(CHK_STRIDE * 1024 <= 96 * MiB, "chunk operands");
constexpr int CW_TMO = 0, CW_CODE = 1;
constexpr int CW_BAR = 4096;
constexpr int CW_BAR2 = 8192;
constexpr int CW_DQ = 12288, CW_DDONE = 12288 + 64;
constexpr int CW_CNT = 16384;

constexpr int RING_OFF = 0, RING_BYTES = 131072;
constexpr int WSCR_OFF = 132096, WSCR_BYTES = 1024;
constexpr int MISC_OFF = 140288;
constexpr int LDS_BYTES = 147456;

#define GAS __attribute__((address_space(1)))
#define LAS __attribute__((address_space(3)))
typedef unsigned short bf16;
typedef unsigned v4u __attribute__((ext_vector_type(4)));
typedef unsigned v2u __attribute__((ext_vector_type(2)));
typedef float f32x4 __attribute__((ext_vector_type(4)));
typedef short bf16x8 __attribute__((ext_vector_type(8)));
typedef GAS unsigned gu32;
#define RLX_AGENT __ATOMIC_RELAXED, __HIP_MEMORY_SCOPE_AGENT
typedef float f32x2_t __attribute__((ext_vector_type(2)));
typedef __bf16 bf16x2_t __attribute__((ext_vector_type(2)));
__device__ __forceinline__ unsigned pk2(float lo, float hi) { const f32x2_t v = {lo, hi}; const bf16x2_t b = __builtin_convertvector(v, bf16x2_t); return __builtin_bit_cast(unsigned, b); }
__device__ __forceinline__ unsigned f2bf(float f) { return pk2(f, 0.f) & 0xffffu; }
__device__ __forceinline__ float bflo(unsigned w) { return __uint_as_float(w << 16); }
__device__ __forceinline__ float bfhi(unsigned w) { return __uint_as_float(w & 0xffff0000u); }
__device__ __forceinline__ float bf1(bf16 h) { return __uint_as_float(((unsigned)h) << 16); }
__device__ __forceinline__ float sigm(float x) { return __builtin_amdgcn_rcpf(1.0f + __builtin_amdgcn_exp2f(x * -1.4426950408889634f)); }
__device__ __forceinline__ float siluf(float x) { return x * __builtin_amdgcn_rcpf(1.0f + __builtin_amdgcn_exp2f(x * -1.4426950408889634f)); }
__device__ __forceinline__ float wave_sum(float v) {
#pragma unroll
    for (int o = 1; o < 64; o <<= 1) v += __shfl_xor(v, o);
    return v;
}
__device__ __forceinline__ float wave_max(float v) {
#pragma unroll
    for (int o = 1; o < 64; o <<= 1) v = fmaxf(v, __shfl_xor(v, o));
    return v;
}
__device__ __forceinline__ int wave_sum_i(int v) {
#pragma unroll
    for (int o = 1; o < 64; o <<= 1) v += __shfl_xor(v, o);
    return v;
}
__device__ __forceinline__ void unpack8(const v4u w, float (&f)[8]) { f[0] = bflo(w.x); f[1] = bfhi(w.x); f[2] = bflo(w.y); f[3] = bfhi(w.y); f[4] = bflo(w.z); f[5] = bfhi(w.z); f[6] = bflo(w.w); f[7] = bfhi(w.w); }
__device__ __forceinline__ v4u pack8f(const float (&f)[8]) { v4u w; w.x = pk2(f[0], f[1]); w.y = pk2(f[2], f[3]); w.z = pk2(f[4], f[5]); w.w = pk2(f[6], f[7]); return w; }

#define XB_TMO      128
#define XB_XCNT(j)  (256  + 64 * (j))
#define XB_XSUB(j)  (1280 + 64 * (j))
#define XB_XGEN(j)  (2304 + 64 * (j))
#define XB_TOP      3328
#define XB_TOPGEN   3392
#define XCD_BAR_WORDS 3456
#define XB_SPIN_CAP (1u << 18)

__device__ __forceinline__ unsigned xb_ld(unsigned* p)              { return __hip_atomic_load(p, __ATOMIC_RELAXED, __HIP_MEMORY_SCOPE_AGENT); }
__device__ __forceinline__ unsigned xb_add(unsigned* p, unsigned v) { return __hip_atomic_fetch_add(p, v, __ATOMIC_RELAXED, __HIP_MEMORY_SCOPE_AGENT); }
__device__ __forceinline__ unsigned xb_xcc_id() { return (unsigned)__builtin_amdgcn_s_getreg((3 << 11) | 20) & 0xFu; }
#define XB_SPIN(cond, bar) do { unsigned _sp = 0; while (cond) { __builtin_amdgcn_s_sleep(1); \
    if ((++_sp & 255u) == 0u) { if (xb_ld(&(bar)[XB_TMO])) break; if (_sp > XB_SPIN_CAP) { atomicAdd(&(bar)[XB_TMO], 1u); break; } } } } while (0)

struct XcdBarrier {
    unsigned* bar; unsigned x;
    unsigned expect;
    volatile LAS unsigned* st;
};

__device__ __forceinline__ XcdBarrier xcd_barrier_post(unsigned* bar, volatile LAS unsigned* st, unsigned expect = 0u) {
    XcdBarrier b; b.bar = bar; b.x = xb_xcc_id(); b.st = st; b.expect = expect ? expect : gridDim.x * gridDim.y * gridDim.z;
    if (threadIdx.x == 0) (void)xb_add(&bar[XB_XCNT(b.x)], 1u);
    return b;
}
__device__ __forceinline__ void xcd_barrier_complete(unsigned* bar, unsigned x, unsigned& nloc, unsigned& nx, const unsigned G) {
    unsigned sum, cnt, mine, sp = 0u;
    for (;;) {
        sum = 0u; cnt = 0u; mine = 0u;
#pragma unroll
        for (unsigned j = 0; j < 16; ++j) { const unsigned c = xb_ld(&bar[XB_XCNT(j)]); sum += c; cnt += (c > 0u) ? 1u : 0u; mine = (j == x) ? c : mine; }
        if (sum == G) break;
        __builtin_amdgcn_s_sleep(1);
        if ((++sp & 255u) == 0u) { if (xb_ld(&bar[XB_TMO])) break; if (sp > XB_SPIN_CAP) { atomicAdd(&bar[XB_TMO], 1u); break; } }
    }
    nloc = mine > 0u ? mine : 1u; nx = cnt > 0u ? cnt : 1u;
}

__device__ __forceinline__ void xcd_barrier(const XcdBarrier& b) {
    asm volatile("s_waitcnt vmcnt(0)" ::: "memory");
    __syncthreads();
    if (threadIdx.x == 0) {
        unsigned* bar = b.bar;
        __builtin_amdgcn_s_waitcnt(0);
        unsigned nloc = b.st[0], nx = b.st[1];
        if (nloc == 0u) { xcd_barrier_complete(bar, b.x, nloc, nx, b.expect); b.st[0] = nloc; b.st[1] = nx; }
        const unsigned old = xb_add(&bar[XB_XSUB(b.x)], 1u);
        const unsigned gen = old / nloc;
        if (old + 1u == (gen + 1u) * nloc) {
            __builtin_amdgcn_fence(__ATOMIC_RELEASE, "agent");
            asm volatile("s_waitcnt vmcnt(0)" ::: "memory");
            const unsigned og = xb_add(&bar[XB_TOP], 1u);
            const unsigned tg = og / nx;
            if (og + 1u == (tg + 1u) * nx) xb_add(&bar[XB_TOPGEN], 1u);
            else XB_SPIN(xb_ld(&bar[XB_TOPGEN]) == tg, bar);
            __builtin_amdgcn_fence(__ATOMIC_ACQUIRE, "agent");
            xb_add(&bar[XB_XGEN(b.x)], 1u);
            asm volatile("s_waitcnt vmcnt(0)" ::: "memory");
        } else {
            XB_SPIN(xb_ld(&bar[XB_XGEN(b.x)]) == gen, bar);
            __builtin_amdgcn_fence(__ATOMIC_ACQUIRE, "agent");
            asm volatile("s_waitcnt vmcnt(0)" ::: "memory");
        }
    }
    __syncthreads();
}

struct Args { const float* in[N_IN]; float* out; unsigned char* ws; int ph_lo, ph_hi, li, pad; };
typedef const __attribute__((address_space(4))) Args* KArgs;
__device__ __forceinline__ KArgs kargs() { auto p = __builtin_amdgcn_kernarg_segment_ptr(); asm volatile("" : "+s"(p)); return (KArgs)p; }
struct Frame {
    LAS unsigned char* lds;
    int tid, lane, wave, G, bid;
    unsigned char* ws;
    gu32* ctl;
};
#define WSP(T, off) ((T*)(F.ws + (off)))

struct MapId { __device__ __forceinline__ int operator()(int n) const { return n; } };
struct MapAdd { int off; __device__ __forceinline__ int operator()(int n) const { return n + off; } };
struct MapAB { __device__ __forceinline__ int operator()(int n) const { return n < 456 ? n : (n < 2504 ? n + 56 : n - 2048); } };
template <class Map> __device__ __forceinline__ void wg_transpose_item(const float* W, int N, int ldw, bf16* WT, int ldt, int koff, Map map, LAS float* scr, int item, int tid) {
    const int nblk = (N + 127) >> 7, kb = item / nblk, nb = item - kb * nblk, k0 = kb * 128, n0 = nb * 128;
#pragma unroll
    for (int it = 0; it < 8; ++it) {
        const int row = it * 16 + (tid >> 5), c4 = (tid & 31) * 4, n = n0 + c4;
        f32x4 v = (f32x4){0.f, 0.f, 0.f, 0.f};
        if (n + 3 < N) v = *(const f32x4*)(W + (size_t)(k0 + row) * ldw + n);
        LAS float* s = scr + row * 129 + c4; s[0] = v[0]; s[1] = v[1]; s[2] = v[2]; s[3] = v[3];
    }
    __syncthreads();
#pragma unroll
    for (int j = 0; j < 4; ++j) {
        const int idx = j * 512 + tid, nl = idx >> 4, ch = idx & 15, n = n0 + nl;
        if (n < N) { const LAS float* s = scr + (ch * 8) * 129 + nl;
            v4u o; o.x = pk2(s[0], s[129]); o.y = pk2(s[2 * 129], s[3 * 129]); o.z = pk2(s[4 * 129], s[5 * 129]); o.w = pk2(s[6 * 129], s[7 * 129]);
            *(v4u*)(WT + (size_t)map(n) * ldt + koff + k0 + ch * 8) = o; }
    }
    __syncthreads();
}
__device__ __forceinline__ void wg_transpose_item_fp8(const float* W, int N, int ldw, unsigned char* WT, int ldt, float mul, LAS float* scr, int item, int tid) {
    const int nblk = (N + 127) >> 7, kb = item / nblk, nb = item - kb * nblk, k0 = kb * 128, n0 = nb * 128;
#pragma unroll
    for (int it = 0; it < 8; ++it) {
        const int row = it * 16 + (tid >> 5), c4 = (tid & 31) * 4;
        const f32x4 v = *(const f32x4*)(W + (size_t)(k0 + row) * ldw + n0 + c4);
        LAS float* s = scr + row * 129 + c4; s[0] = v[0]; s[1] = v[1]; s[2] = v[2]; s[3] = v[3];
    }
    __syncthreads();
#pragma unroll
    for (int j = 0; j < 2; ++j) {
        const int idx = j * 512 + tid, nl = idx >> 3, ch = idx & 7;
        const LAS float* s = scr + (ch * 16) * 129 + nl;
        v4u o;
#pragma unroll
        for (int q = 0; q < 4; ++q) { unsigned w = 0u;
            w = __builtin_amdgcn_cvt_pk_fp8_f32(s[(4 * q) * 129] * mul, s[(4 * q + 1) * 129] * mul, w, false);
            w = __builtin_amdgcn_cvt_pk_fp8_f32(s[(4 * q + 2) * 129] * mul, s[(4 * q + 3) * 129] * mul, w, true);
            o[q] = w; }
        *(v4u*)(WT + (size_t)(n0 + nl) * ldt + k0 + ch * 16) = o;
    }
    __syncthreads();
}
struct MoeItem { const float* W; unsigned char* WT; int N; float mul; int k0, n0; };
__device__ __forceinline__ MoeItem moe_item(KArgs A, unsigned char* ws, int it) {
    MoeItem d; int sub;
    if (it < 64 * 128) { const int m = it >> 7; sub = it & 127; d.W = A->in[I_WGU] + (size_t)m * 1024 * 2048; d.N = 2048; d.WT = ws + WS_W_GU + (size_t)m * 2048 * 1024; d.mul = 64.0f; }
    else { it -= 64 * 128; const int m = it >> 6; sub = it & 63; d.W = A->in[I_WDN] + (size_t)m * 1024 * 1024; d.N = 1024; d.WT = ws + WS_W_DN + (size_t)m * 1024 * 1024; d.mul = 128.0f; }
    const int nblk = d.N >> 7, kb = sub / nblk, nb = sub - kb * nblk; d.k0 = kb * 128; d.n0 = nb * 128; return d;
}
constexpr int N_MOE_NOW = 32 * 128 + 32 * 64, N_MOE_DEF = 32 * 128 + 32 * 64;
__device__ __forceinline__ int moe_now_item(int j) { return j < 32 * 128 ? j : j + 32 * 128; }
__device__ __forceinline__ int moe_def_item_l1(int j) { return j < 32 * 128 ? 32 * 128 + j : 64 * 128 + 32 * 64 + (j - 32 * 128); }
__device__ __forceinline__ void p0_moe_fp8(Frame& F, KArgs A, const bool all) {
    LAS float* scr = (LAS float*)(F.lds + RING_OFF);
    const int tid = F.tid; const int NIT = all ? 64 * 128 + 64 * 64 : N_MOE_NOW;
#define MOE_IT(j) (all ? (j) : moe_now_item(j))
    int it = F.bid; if (it >= NIT) return;
    MoeItem cur = moe_item(A, F.ws, MOE_IT(it));
    f32x4 r[8];
#pragma unroll
    for (int x = 0; x < 8; ++x) r[x] = __builtin_nontemporal_load((const f32x4*)(cur.W + (size_t)(cur.k0 + x * 16 + (tid >> 5)) * cur.N + cur.n0 + (tid & 31) * 4));
    for (;;) {
#pragma unroll
        for (int x = 0; x < 8; ++x) { LAS float* sp = scr + (x * 16 + (tid >> 5)) * 129 + (tid & 31) * 4; sp[0] = r[x][0]; sp[1] = r[x][1]; sp[2] = r[x][2]; sp[3] = r[x][3]; }
        __syncthreads();
        const int nx = it + F.G; MoeItem nxt = cur;
        if (nx < NIT) { nxt = moe_item(A, F.ws, MOE_IT(nx));
#pragma unroll
            for (int x = 0; x < 8; ++x) r[x] = __builtin_nontemporal_load((const f32x4*)(nxt.W + (size_t)(nxt.k0 + x * 16 + (tid >> 5)) * nxt.N + nxt.n0 + (tid & 31) * 4)); }
#pragma unroll
        for (int j = 0; j < 2; ++j) {
            const int idx = j * 512 + tid, nl = idx >> 3, ch = idx & 7;
            const LAS float* sp = scr + (ch * 16) * 129 + nl;
            v4u o;
#pragma unroll
            for (int q = 0; q < 4; ++q) { unsigned w = 0u;
                w = __builtin_amdgcn_cvt_pk_fp8_f32(sp[(4 * q) * 129] * cur.mul, sp[(4 * q + 1) * 129] * cur.mul, w, false);
                w = __builtin_amdgcn_cvt_pk_fp8_f32(sp[(4 * q + 2) * 129] * cur.mul, sp[(4 * q + 3) * 129] * cur.mul, w, true);
                o[q] = w; }
            *(v4u*)(cur.WT + (size_t)(cur.n0 + nl) * 1024 + cur.k0 + ch * 16) = o;
        }
        __syncthreads();
        if (nx >= NIT) break;
        cur = nxt; it = nx;
    }
}
#undef MOE_IT
constexpr int N_MOE_Q = N_MOE_NOW + N_MOE_DEF;
__device__ __forceinline__ int moe_def_item(int j) { return j < N_MOE_NOW ? moe_now_item(j) : moe_def_item_l1(j - N_MOE_NOW); }
__device__ __forceinline__ bool defer_work(Frame& F, KArgs A, const int count, const int limit = N_MOE_Q) {
    LAS float* scr = (LAS float*)(F.lds + RING_OFF);
    volatile LAS int* jb = (volatile LAS int*)(F.lds + MISC_OFF + 1024);
    const int tid = F.tid;
    if (count == 0) return false;
    __syncthreads();
    if (tid == 0) { const int j = (int)__hip_atomic_fetch_add(F.ctl + CW_DQ, 1u, RLX_AGENT); jb[0] = (j < N_MOE_Q) ? j : -1; }
    __syncthreads();
    int j = jb[0];
    if (j < 0) return false;
    MoeItem cur = moe_item(A, F.ws, moe_def_item(j));
    f32x4 r[8];
#pragma unroll
    for (int x = 0; x < 8; ++x) r[x] = __builtin_nontemporal_load((const f32x4*)(cur.W + (size_t)(cur.k0 + x * 16 + (tid >> 5)) * cur.N + cur.n0 + (tid & 31) * 4));
    for (int k = 1;; ++k) {
        if (tid == 0) { int jn = -1; if ((count < 0 || k < count) && j < limit) { jn = (int)__hip_atomic_fetch_add(F.ctl + CW_DQ, 1u, RLX_AGENT); if (jn >= N_MOE_Q) jn = -1; } jb[k & 1] = jn; }
#pragma unroll
        for (int x = 0; x < 8; ++x) { LAS float* sp = scr + (x * 16 + (tid >> 5)) * 129 + (tid & 31) * 4; sp[0] = r[x][0]; sp[1] = r[x][1]; sp[2] = r[x][2]; sp[3] = r[x][3]; }
        __syncthreads();
        const int jn = jb[k & 1]; MoeItem nxt = cur;
        if (jn >= 0) { nxt = moe_item(A, F.ws, moe_def_item(jn));
#pragma unroll
            for (int x = 0; x < 8; ++x) r[x] = __builtin_nontemporal_load((const f32x4*)(nxt.W + (size_t)(nxt.k0 + x * 16 + (tid >> 5)) * nxt.N + nxt.n0 + (tid & 31) * 4)); }
#pragma unroll
        for (int jj = 0; jj < 2; ++jj) {
            const int idx = jj * 512 + tid, nl = idx >> 3, ch = idx & 7;
            const LAS float* sp = scr + (ch * 16) * 129 + nl;
            v4u o;
#pragma unroll
            for (int q = 0; q < 4; ++q) { unsigned w = 0u;
                w = __builtin_amdgcn_cvt_pk_fp8_f32(sp[(4 * q) * 129] * cur.mul, sp[(4 * q + 1) * 129] * cur.mul, w, false);
                w = __builtin_amdgcn_cvt_pk_fp8_f32(sp[(4 * q + 2) * 129] * cur.mul, sp[(4 * q + 3) * 129] * cur.mul, w, true);
                o[q] = w; }
            __builtin_nontemporal_store(o, (v4u*)(cur.WT + (size_t)(cur.n0 + nl) * 1024 + cur.k0 + ch * 16));
        }
        __syncthreads();
        if (jn < 0) break;
        cur = nxt; j = jn;
    }
    return true;
}
__device__ __forceinline__ void xcd_barrier_working(const XcdBarrier& b, Frame& F, KArgs A) {
    volatile LAS int* fl = (volatile LAS int*)(F.lds + MISC_OFF + 1024 + 16);
    asm volatile("s_waitcnt vmcnt(0)" ::: "memory");
    __syncthreads();
    if (threadIdx.x == 0) {
        unsigned* bar = b.bar;
        __builtin_amdgcn_s_waitcnt(0);
        unsigned nloc = b.st[0], nx = b.st[1];
        if (nloc == 0u) { xcd_barrier_complete(bar, b.x, nloc, nx, b.expect); b.st[0] = nloc; b.st[1] = nx; }
        const unsigned old = xb_add(&bar[XB_XSUB(b.x)], 1u);
        const unsigned gen = old / nloc;
        if (old + 1u == (gen + 1u) * nloc) {
            __builtin_amdgcn_fence(__ATOMIC_RELEASE, "agent");
            asm volatile("s_waitcnt vmcnt(0)" ::: "memory");
            const unsigned og = xb_add(&bar[XB_TOP], 1u);
            const unsigned tg = og / nx;
            if (og + 1u == (tg + 1u) * nx) xb_add(&bar[XB_TOPGEN], 1u);
            else XB_SPIN(xb_ld(&bar[XB_TOPGEN]) == tg, bar);
            __builtin_amdgcn_fence(__ATOMIC_ACQUIRE, "agent");
            xb_add(&bar[XB_XGEN(b.x)], 1u);
            asm volatile("s_waitcnt vmcnt(0)" ::: "memory");
            fl[0] = 0; fl[2] = 0;
        } else { fl[0] = 1; fl[1] = (int)gen; fl[2] = 1; }
    }
    for (;;) {
        __syncthreads();
        const int waiting = fl[0];
        __syncthreads();
        if (!waiting) break;
        const bool did = defer_work(F, A, 1);
        if (threadIdx.x == 0) {
            if (!did) { XB_SPIN(xb_ld(&b.bar[XB_XGEN(b.x)]) == (unsigned)fl[1], b.bar); fl[0] = 0; }
            else if (xb_ld(&b.bar[XB_XGEN(b.x)]) != (unsigned)fl[1]) fl[0] = 0;
        }
    }
    if (threadIdx.x == 0 && fl[2]) { __builtin_amdgcn_fence(__ATOMIC_ACQUIRE, "agent"); asm volatile("s_waitcnt vmcnt(0)" ::: "memory"); }
    __syncthreads();
}
__device__ __forceinline__ bool moe_short_wg(const int nT, const int nN, const int G, const int c) {
    if (G % (8 * nN) != 0) return false;
    const int rpx = G / (8 * nN), xcd = c & 7, idx = c >> 3;
    const int maxu = (nT + 8 * rpx - 1) / (8 * rpx);
    int mine = 0;
    for (int i = 0; i < maxu; ++i) mine += ((i * 8 + xcd) * rpx + idx % rpx < nT) ? 1 : 0;
    return mine < maxu;
}
__device__ __forceinline__ void p0_prologue(Frame& F, KArgs A, const bool moe_all) {
    LAS float* scr = (LAS float*)(F.lds + RING_OFF);
    const int tid = F.tid;
    constexpr int IT_GU = 128, IT_DN = 64;
    constexpr int N_GU = 64 * IT_GU, N_DN = 64 * IT_DN;
    constexpr int N_INAB = 8 * 20, N_INCD = 8 * 20, N_OUTCD = 64, N_PG = 2 * 64, N_PP = 2 * 2 * 8, N_QIDX = 2 * 4, N_OUTB = 4 * 8;
    constexpr int NITEMS = N_GU + N_DN + N_INAB + N_INCD + N_OUTCD + N_PG + N_PP + N_QIDX + N_OUTB;
    if (kMoeFp8 && moe_all) p0_moe_fp8(F, A, true);
    for (int it = F.bid + (kMoeFp8 ? N_GU + N_DN : 0); it < NITEMS; it += F.G) {
        int r = it;
        if (r < N_GU) { const int m = r / IT_GU;
            if (kMoeFp8) wg_transpose_item_fp8(A->in[I_WGU] + (size_t)m * 1024 * 2048, 2048, 2048, WSP(unsigned char, WS_W_GU) + (size_t)m * 2048 * 1024, 1024, 64.0f, scr, r % IT_GU, tid);
            else wg_transpose_item(A->in[I_WGU] + (size_t)m * 1024 * 2048, 2048, 2048, WSP(bf16, WS_W_GU) + (size_t)m * 2048 * 1024, 1024, 0, MapId{}, scr, r % IT_GU, tid);
            continue; } r -= N_GU;
        if (r < N_DN) { const int m = r / IT_DN;
            if (kMoeFp8) wg_transpose_item_fp8(A->in[I_WDN] + (size_t)m * 1024 * 1024, 1024, 1024, WSP(unsigned char, WS_W_DN) + (size_t)m * 1024 * 1024, 1024, 128.0f, scr, r % IT_DN, tid);
            else wg_transpose_item(A->in[I_WDN] + (size_t)m * 1024 * 1024, 1024, 1024, WSP(bf16, WS_W_DN) + (size_t)m * 1024 * 1024, 1024, 0, MapId{}, scr, r % IT_DN, tid);
            continue; } r -= N_DN;
        if (r < N_INAB) { wg_transpose_item(A->in[I_AB_WIN], 2512, 2512, WSP(bf16, WS_W_INAB), 1024, 0, MapAB{}, scr, r, tid); continue; } r -= N_INAB;
        if (r < N_INCD) { wg_transpose_item(A->in[I_CD_WIN], 2560, 2560, WSP(bf16, WS_W_INCD), 1024, 0, MapId{}, scr, r, tid); continue; } r -= N_INCD;
        if (r < N_OUTCD) { wg_transpose_item(A->in[I_CD_WOUT], 1024, 1024, WSP(bf16, WS_W_OUTCD), 1024, 0, MapId{}, scr, r, tid); continue; } r -= N_OUTCD;
        if (r < N_PG) { const int l = r / 64; wg_transpose_item(A->in[I_PLE_WG] + (size_t)l * 1024 * 1024, 1024, 1024, WSP(bf16, WS_W_PG) + (size_t)l * 1024 * 1024, 1024, 0, MapId{}, scr, r % 64, tid); continue; } r -= N_PG;
        if (r < N_PP) { const int l = r / 16; wg_transpose_item(A->in[I_PLE_WP] + (size_t)l * 256 * 1024, 1024, 1024, WSP(bf16, WS_W_PP) + (size_t)l * 1024 * 256, 256, 0, MapId{}, scr, r % 16, tid); continue; } r -= N_PP;
        if (r < N_QIDX) { wg_transpose_item(A->in[I_AB_WQIDX], 512, 512, WSP(bf16, WS_W_ABS), 256, 0, MapAdd{1024}, scr, r, tid); continue; } r -= N_QIDX;
        wg_transpose_item(A->in[I_AB_WOUT] + (size_t)512 * 1024, 1024, 1024, WSP(bf16, WS_W_OUTAB), 1536, 1024, MapId{}, scr, r, tid);
    }
    const size_t gt = (size_t)F.bid * NTHREADS + tid, GT = (size_t)F.G * NTHREADS;
    for (size_t i = gt; i < (size_t)48 * 1024 / 8; i += GT) *(v4u*)(WSP(bf16, WS_W_INAB) + (size_t)464 * 1024 + i * 8) = (v4u){0u, 0u, 0u, 0u};
    for (size_t i = gt; i < (size_t)1024 * 256; i += GT) {
        const int n = (int)(i >> 8), c = (int)(i & 255), h = n >> 7, r = n & 127;
        const float* a = A->in[I_AB_WUQ] + (size_t)c * 512 + h * 64; const float* b = A->in[I_AB_WUK] + (size_t)r * 512 + h * 64;
        float s = 0.f;
#pragma unroll 8
        for (int d = 0; d < 64; d += 4) { const f32x4 x = *(const f32x4*)(a + d), y = *(const f32x4*)(b + d); s += x[0] * y[0] + x[1] * y[1] + x[2] * y[2] + x[3] * y[3]; }
        WSP(bf16, WS_W_ABS)[i] = (bf16)f2bf(s * (0.125f * 1.4426950408889634f));
    }
    for (size_t i = gt; i < (size_t)1024 * 128; i += GT) {
        const int n = (int)(i & 1023), k0 = (int)(i >> 10) * 8, h = k0 >> 7, r0 = k0 & 127;
        const float* bcol = A->in[I_AB_WOUT] + (size_t)(h * 64) * 1024 + n;
        float acc[8];
#pragma unroll
        for (int x = 0; x < 8; ++x) acc[x] = 0.f;
#pragma unroll 2
        for (int v0 = 0; v0 < 64; v0 += 8) {
            float bv[8];
#pragma unroll
            for (int v = 0; v < 8; ++v) bv[v] = bcol[(size_t)(v0 + v) * 1024];
#pragma unroll
            for (int x = 0; x < 8; ++x) { const float* ar = A->in[I_AB_WUV] + (size_t)(r0 + x) * 512 + h * 64 + v0; const f32x4 a0 = *(const f32x4*)ar, a1 = *(const f32x4*)(ar + 4);
                acc[x] += a0[0] * bv[0] + a0[1] * bv[1] + a0[2] * bv[2] + a0[3] * bv[3] + a1[0] * bv[4] + a1[1] * bv[5] + a1[2] * bv[6] + a1[3] * bv[7]; }
        }
        *(v4u*)(WSP(bf16, WS_W_OUTAB) + (size_t)n * 1536 + k0) = pack8f(acc);
    }
#pragma unroll 4
    for (size_t i = gt; i < (size_t)M * D / 8; i += GT) { const f32x4 a = __builtin_nontemporal_load((const f32x4*)(A->in[I_X] + i * 8)), b = __builtin_nontemporal_load((const f32x4*)(A->in[I_X] + i * 8 + 4));
        v4u o; o.x = pk2(a[0], a[1]); o.y = pk2(a[2], a[3]); o.z = pk2(b[0], b[1]); o.w = pk2(b[2], b[3]); *(v4u*)(WSP(bf16, WS_XB) + i * 8) = o; }
#pragma unroll 4
    for (size_t i = gt; i < (size_t)2 * M * 256 / 8; i += GT) { const f32x4 a = __builtin_nontemporal_load((const f32x4*)(A->in[I_P] + i * 8)), b = __builtin_nontemporal_load((const f32x4*)(A->in[I_P] + i * 8 + 4));
        v4u o; o.x = pk2(a[0], a[1]); o.y = pk2(a[2], a[3]); o.z = pk2(b[0], b[1]); o.w = pk2(b[2], b[3]); *(v4u*)(WSP(bf16, WS_PB) + i * 8) = o; }
}

__device__ __forceinline__ void p2_prep(Frame& F, KArgs A) {
    const int lane = F.lane, gw = F.bid * NWAVES + F.wave, NGW = F.G * NWAVES;
    const float* SM = WSP(float, WS_SM); const bf16* QZ = WSP(bf16, WS_QKVZ);
    const f32x4 qg = *(const f32x4*)(A->in[I_AB_QG] + 4 * lane);
    const f32x4 kvg = *(const f32x4*)(A->in[I_AB_KVG] + 4 * (lane & 31));
    const f32x4 kig = *(const f32x4*)(A->in[I_AB_KIG] + 4 * (lane & 15)), kib = *(const f32x4*)(A->in[I_AB_KIB] + 4 * (lane & 15));
    const f32x4 alog = *(const f32x4*)(A->in[I_AB_ALOG]), dtb = *(const f32x4*)(A->in[I_AB_DTB]);
    LAS float* cw = (LAS float*)(F.lds);
    {   f32x4 wv[3]; int t0 = F.tid; asm volatile("" : "+v"(t0));
#pragma unroll
        for (int j = 0; j < 3; ++j) wv[j] = *(const f32x4*)(A->in[I_AB_CONVW] + (size_t)(t0 + NTHREADS * j) * 4);
#pragma unroll
        for (int j = 0; j < 3; ++j) *(LAS f32x4*)(cw + (t0 + NTHREADS * j) * 4) = wv[j];
    }
    __syncthreads();
    for (int row = gw; row < M; row += NGW) {
        const int t = row & (SEQ - 1);
        const f32x4 a = *(const f32x4*)(SM + (size_t)row * 512 + 4 * lane), b = *(const f32x4*)(SM + (size_t)row * 512 + 256 + 4 * lane);
        {
            const float ss = wave_sum(a[0] * a[0] + a[1] * a[1] + a[2] * a[2] + a[3] * a[3]);
            const float r = rsqrtf(ss * (1.0f / 256.0f) + 1e-6f);
            v2u o; o.x = pk2(a[0] * r * qg[0], a[1] * r * qg[1]); o.y = pk2(a[2] * r * qg[2], a[3] * r * qg[3]);
            *(v2u*)(WSP(bf16, WS_CQ) + (size_t)row * 256 + 4 * lane) = o;
        }
        {
            const float ss = wave_sum(lane < 32 ? (b[0] * b[0] + b[1] * b[1] + b[2] * b[2] + b[3] * b[3]) : 0.f);
            const float r = rsqrtf(ss * (1.0f / 128.0f) + 1e-6f);
            if (lane < 32) { v2u o; o.x = pk2(b[0] * r * kvg[0], b[1] * r * kvg[1]); o.y = pk2(b[2] * r * kvg[2], b[3] * r * kvg[3]);
                *(v2u*)(WSP(bf16, WS_CKV) + (size_t)row * 128 + 4 * lane) = o; }
        }
        {
            const bool in = (lane >= 32 && lane < 48);
            const float mean = wave_sum(in ? (b[0] + b[1] + b[2] + b[3]) : 0.f) * (1.0f / 64.0f);
            const f32x4 d = b - mean;
            const float var = wave_sum(in ? (d[0] * d[0] + d[1] * d[1] + d[2] * d[2] + d[3] * d[3]) : 0.f) * (1.0f / 64.0f);
            const float r = rsqrtf(var + 1e-5f);
            if (in) { v2u o; o.x = pk2(d[0] * r * kig[0] + kib[0], d[1] * r * kig[1] + kib[1]); o.y = pk2(d[2] * r * kig[2] + kib[2], d[3] * r * kig[3] + kib[3]);
                *(v2u*)(WSP(bf16, WS_KIDX) + (size_t)row * 64 + 4 * (lane - 32)) = o; }
        }
        if (lane == 48 || lane == 49) *(f32x4*)(WSP(float, WS_WIDX) + (size_t)row * 8 + 4 * (lane - 48)) = b * 0.044194173824159216f;
        if (lane == 50) { f32x4 o; o[0] = sigm(b[0]); o[1] = sigm(b[1]); o[2] = sigm(b[2]); o[3] = sigm(b[3]); *(f32x4*)(WSP(float, WS_BETA) + (size_t)row * 4) = o; }
        if (lane == 51) { f32x4 o;
#pragma unroll
            for (int h = 0; h < 4; ++h) { const float xx = b[h] + dtb[h]; const float sp = xx > 20.f ? xx : log1pf(__expf(xx)); o[h] = -__expf(alog[h]) * sp; }
            *(f32x4*)(WSP(float, WS_GG) + (size_t)row * 4) = o; }
        v4u xr[3][4];
#pragma unroll
        for (int sel = 0; sel < 3; ++sel)
#pragma unroll
            for (int j = 0; j < 4; ++j) { const int back = (t - 3 + j >= 0) ? (3 - j) : 0; xr[sel][j] = *(const v4u*)(QZ + (size_t)(row - back) * 2048 + sel * 512 + 8 * lane); }
#pragma unroll
        for (int sel = 0; sel < 3; ++sel) {
            const int col0 = sel * 512 + 8 * lane;
            float acc[8];
#pragma unroll
            for (int i = 0; i < 8; ++i) acc[i] = 0.f;
#pragma unroll
            for (int j = 0; j < 4; ++j) {
                float xv[8]; unpack8(xr[sel][j], xv);
                const f32x4 w0 = *(const LAS f32x4*)(cw + j * 1536 + col0), w1 = *(const LAS f32x4*)(cw + j * 1536 + col0 + 4);
                const float m = (t - 3 + j >= 0) ? 1.f : 0.f;
#pragma unroll
                for (int i = 0; i < 4; ++i) { acc[i] += w0[i] * m * xv[i]; acc[4 + i] += w1[i] * m * xv[4 + i]; }
            }
            float ss = 0.f;
#pragma unroll
            for (int i = 0; i < 8; ++i) { acc[i] = siluf(acc[i]); ss += acc[i] * acc[i]; }
            if (sel < 2) {
                ss += __shfl_xor(ss, 1); ss += __shfl_xor(ss, 2); ss += __shfl_xor(ss, 4); ss += __shfl_xor(ss, 8);
                const float sc = rsqrtf(ss + 1e-6f) * (sel == 0 ? 0.08838834764831845f : 1.0f);
#pragma unroll
                for (int i = 0; i < 8; ++i) acc[i] *= sc;
            }
            bf16* dst = (sel == 0 ? WSP(bf16, WS_QN) : (sel == 1 ? WSP(bf16, WS_KN) : WSP(bf16, WS_VN))) + (size_t)row * 512 + 8 * lane;
            *(v4u*)dst = pack8f(acc);
        }
    }
}

constexpr int SEQ_WGS = 16;
constexpr int SQ_WP = 0, SQ_QD = 16384, SQ_KDT = 32768, SQ_QK = 49152, SQ_BUF = 57344;
__device__ __forceinline__ bf16x8 packfrag(const f32x4 lo, const f32x4 hi) { v4u w; w.x = pg8::cvt_pk_bf16(lo[0], lo[1]); w.y = pg8::cvt_pk_bf16(lo[2], lo[3]); w.z = pg8::cvt_pk_bf16(hi[0], hi[1]); w.w = pg8::cvt_pk_bf16(hi[2], hi[3]); return __builtin_bit_cast(bf16x8, w); }
__device__ __forceinline__ void seq_load(v4u (&r)[14], const unsigned char* blk, int lt) {
#pragma unroll
    for (int i = 0; i < 14; ++i) r[i] = *(const v4u*)(blk + (size_t)(lt + 256 * i) * 16);
}
__device__ __forceinline__ void seq_write(LAS unsigned char* buf, const v4u (&r)[14], int lt) {
#pragma unroll
    for (int i = 0; i < 14; ++i) {
        const int id = lt + 256 * i; int dst;
        if (id < 2048) { const int rr = (id & 1023) >> 4, ch = id & 15; dst = (id & ~1023) * 16 + rr * 256 + 16 * (ch ^ (rr & 15)); }
        else { const int rr = (id - 2048) >> 3, ch = id & 7; dst = 32768 + rr * 128 + 16 * (ch ^ (rr & 7)); }
        *(LAS v4u*)(buf + dst) = r[i];
    }
}
__device__ __forceinline__ void seq_compute(LAS unsigned char* buf, f32x4 (&Sacc)[8], const f32x4 (&U)[4], const float gl, float* op0, const int fr, const int fq) {
    bf16x8 sf[4];
#pragma unroll
    for (int s = 0; s < 4; ++s) sf[s] = packfrag(Sacc[2 * s], Sacc[2 * s + 1]);
    f32x4 Vn[4], Oa[4];
#pragma unroll
    for (int tc = 0; tc < 4; ++tc) {
        const int rr = 16 * tc + fr; f32x4 av = (f32x4){0.f, 0.f, 0.f, 0.f}, ao = (f32x4){0.f, 0.f, 0.f, 0.f};
#pragma unroll
        for (int s = 0; s < 4; ++s) {
            const int off = rr * 256 + 16 * ((4 * s + fq) ^ (rr & 15));
            const bf16x8 wf = *(const LAS bf16x8*)(buf + SQ_WP + off), qf = *(const LAS bf16x8*)(buf + SQ_QD + off);
            av = __builtin_amdgcn_mfma_f32_16x16x32_bf16(wf, sf[s], av, 0, 0, 0);
            ao = __builtin_amdgcn_mfma_f32_16x16x32_bf16(qf, sf[s], ao, 0, 0, 0);
        }
        Vn[tc] = U[tc] - av; Oa[tc] = ao;
    }
    bf16x8 vf[2];
    vf[0] = packfrag(Vn[0], Vn[1]); vf[1] = packfrag(Vn[2], Vn[3]);
#pragma unroll
    for (int tc = 0; tc < 4; ++tc) {
        const int rr = 16 * tc + fr;
#pragma unroll
        for (int s = 0; s < 2; ++s) {
            const bf16x8 kf = *(const LAS bf16x8*)(buf + SQ_QK + rr * 128 + 16 * ((4 * s + fq) ^ (rr & 7)));
            Oa[tc] = __builtin_amdgcn_mfma_f32_16x16x32_bf16(kf, vf[s], Oa[tc], 0, 0, 0);
        }
        float* op = op0 + (size_t)(16 * tc) * 512;
#pragma unroll
        for (int j = 0; j < 4; ++j) op[(size_t)j * 512] = Oa[tc][j];
    }
#pragma unroll
    for (int T = 0; T < 8; ++T) {
        const int rr = 16 * T + fr; f32x4 a = Sacc[T] * gl;
#pragma unroll
        for (int s = 0; s < 2; ++s) {
            const bf16x8 kf = *(const LAS bf16x8*)(buf + SQ_KDT + rr * 128 + 16 * ((4 * s + fq) ^ (rr & 7)));
            a = __builtin_amdgcn_mfma_f32_16x16x32_bf16(kf, vf[s], a, 0, 0, 0);
        }
        Sacc[T] = a;
    }
}
#define SEQ_BAR() do { asm volatile("s_waitcnt lgkmcnt(0)" ::: "memory"); __builtin_amdgcn_s_barrier(); asm volatile("" ::: "memory"); } while (0)
__device__ __forceinline__ void p4_delta_seq(Frame& F, int sid) {
    const int lane = F.lane, wave = F.wave, tid = F.tid;
    const int bh = sid >> 1, half = sid & 1, b = bh >> 2, h = bh & 3;
    const int fr = lane & 15, fq = lane >> 4;
    const int v0 = half * 64 + (wave & 3) * 16;
    const unsigned char* cbase = F.ws + WS_CHK + (size_t)(bh * 128) * CHK_STRIDE;
    if (wave >= 4) {
        const int lt = tid - 256;
        v4u RA[14], RB[14];
#define SEQ_LD(R, blk) do { const unsigned char* _b = (blk); _Pragma("unroll") for (int _i = 0; _i < 14; ++_i) asm volatile("global_load_dwordx4 %0, %1, off" : "=v"(R[_i]) : "v"(_b + (size_t)(lt + 256 * _i) * 16) : "memory"); } while (0)
#define SEQ_WAIT(younger) do { if (younger) asm volatile("s_waitcnt vmcnt(14)" ::: "memory"); else asm volatile("s_waitcnt vmcnt(0)" ::: "memory"); } while (0)
        SEQ_LD(RA, cbase); SEQ_LD(RB, cbase + CHK_STRIDE); SEQ_WAIT(true); seq_write(F.lds, RA, lt); SEQ_LD(RA, cbase + 2 * CHK_STRIDE);
        SEQ_BAR();
#pragma unroll 1
        for (int n = 0; n < 128; n += 2) {
            if (n + 1 < 128) { SEQ_WAIT(n + 2 < 128); seq_write(F.lds + ((n + 1) & 1) * SQ_BUF, RB, lt); } if (n + 3 < 128) SEQ_LD(RB, cbase + (size_t)(n + 3) * CHK_STRIDE);
            SEQ_BAR();
            if (n + 2 < 128) { SEQ_WAIT(n + 3 < 128); seq_write(F.lds + (n & 1) * SQ_BUF, RA, lt); } if (n + 4 < 128) SEQ_LD(RA, cbase + (size_t)(n + 4) * CHK_STRIDE);
            SEQ_BAR();
        }
        asm volatile("s_waitcnt vmcnt(0)" ::: "memory");
#undef SEQ_LD
#undef SEQ_WAIT
    } else {
        float* OD = WSP(float, WS_ODELTA);
        f32x4 Sacc[8], Ucur[4], Unxt[4]; float glc, gln;
#pragma unroll
        for (int T = 0; T < 8; ++T) Sacc[T] = (f32x4){0.f, 0.f, 0.f, 0.f};
#pragma unroll
        for (int tc = 0; tc < 4; ++tc) { Ucur[tc] = *(const f32x4*)((const float*)(cbase + CHK_UT) + (size_t)(v0 + fr) * 64 + 4 * fq + 16 * tc);
                                          Unxt[tc] = *(const f32x4*)((const float*)(cbase + CHK_STRIDE + CHK_UT) + (size_t)(v0 + fr) * 64 + 4 * fq + 16 * tc); }
        glc = *(const float*)(cbase + CHK_GL); gln = *(const float*)(cbase + CHK_STRIDE + CHK_GL);
        SEQ_BAR();
#pragma unroll 1
        for (int n = 0; n < 128; ++n) {
            seq_compute(F.lds + (n & 1) * SQ_BUF, Sacc, Ucur, glc, OD + (size_t)(b * SEQ + n * 64 + 4 * fq) * 512 + h * 128 + v0 + fr, fr, fq);
#pragma unroll
            for (int tc = 0; tc < 4; ++tc) Ucur[tc] = Unxt[tc];
            glc = gln;
            if (n + 2 < 128) { const unsigned char* nb = cbase + (size_t)(n + 2) * CHK_STRIDE; gln = *(const float*)(nb + CHK_GL);
#pragma unroll
                for (int tc = 0; tc < 4; ++tc) Unxt[tc] = *(const f32x4*)((const float*)(nb + CHK_UT) + (size_t)(v0 + fr) * 64 + 4 * fq + 16 * tc); }
            SEQ_BAR();
        }
    }
}
#undef SEQ_BAR

__device__ __forceinline__ float relu1(float x) { return __builtin_amdgcn_fmed3f(x, 0.f, INFINITY); }
__device__ __forceinline__ void p4_indexer(Frame& F, int widx, int nw) {
    const int lane = F.lane, fr = lane & 15, fq = lane >> 4;
    const bf16* QL = WSP(bf16, WS_QL); const bf16* KI = WSP(bf16, WS_KIDX); const float* WI = WSP(float, WS_WIDX); unsigned short* SC = WSP(unsigned short, WS_BIG);
    for (int task = widx; task < 2 * 4352; task += nw) {
        const int b = task / 4352; int tau = task - b * 4352;
        int g = 0; while (16 * (g + 1) * (g + 2) <= tau) ++g;
        tau -= 16 * g * (g + 1);
        const int qt = 32 * g + tau / (g + 1), seg = tau % (g + 1);
        const int row0 = b * SEQ + 16 * qt;
        bf16x8 Qf[8][2];
#pragma unroll
        for (int hh = 0; hh < 8; ++hh)
#pragma unroll
            for (int s = 0; s < 2; ++s) Qf[hh][s] = *(const bf16x8*)(QL + (size_t)(row0 + fr) * 1536 + 1024 + hh * 64 + 32 * s + 8 * fq);
        const f32x4 w0 = *(const f32x4*)(WI + (size_t)(row0 + fr) * 8), w1 = *(const f32x4*)(WI + (size_t)(row0 + fr) * 8 + 4);
        const int kt1 = ((32 * seg + 31 < qt) ? 32 * seg + 31 : qt) | 3;
        for (int kb8 = 32 * seg; kb8 <= kt1; kb8 += 8) {
            bf16x8 kfr[8][2];
#pragma unroll
            for (int x = 0; x < 8; ++x) { const int g64 = (kb8 + x <= kt1) ? ((kb8 + x) >> 2) : (kt1 >> 2); const bf16* kp = KI + (size_t)(b * SEQ + 64 * g64 + 16 * (fr >> 2) + 4 * (x & 3) + (fr & 3)) * 64 + 8 * fq; kfr[x][0] = *(const bf16x8*)kp; kfr[x][1] = *(const bf16x8*)(kp + 32); }
#pragma unroll
            for (int x = 0; x < 8; ++x) asm volatile("" : "+v"(kfr[x][0]), "+v"(kfr[x][1]));
#pragma unroll
            for (int gq = 0; gq < 2; ++gq) {
                if (kb8 + 4 * gq <= kt1) {
                    v4u k0, k1;
#pragma unroll
                    for (int xs = 0; xs < 4; ++xs) {
                        const int x = 4 * gq + xs;
                        f32x4 isc, c[8]; pg8::f32x2c i01 = (pg8::f32x2c){0.f, 0.f}, i23 = (pg8::f32x2c){0.f, 0.f};
#pragma unroll
                        for (int hh = 0; hh < 8; ++hh) c[hh] = __builtin_amdgcn_mfma_f32_16x16x32_bf16(kfr[x][0], Qf[hh][0], (f32x4){0.f, 0.f, 0.f, 0.f}, 0, 0, 0);
#pragma unroll
                        for (int hh = 0; hh < 8; ++hh) c[hh] = __builtin_amdgcn_mfma_f32_16x16x32_bf16(kfr[x][1], Qf[hh][1], c[hh], 0, 0, 0);
                        __builtin_amdgcn_sched_barrier(0);
#pragma unroll
                        for (int hh = 0; hh < 8; ++hh) { const float wh = (hh < 4) ? w0[hh & 3] : w1[hh & 3];
                            pg8::f32x2c r01, r23; r01[0] = relu1(c[hh][0]); r01[1] = relu1(c[hh][1]); r23[0] = relu1(c[hh][2]); r23[1] = relu1(c[hh][3]);
                            i01 += r01 * wh; i23 += r23 * wh; }
                        isc[0] = i01[0]; isc[1] = i01[1]; isc[2] = i23[0]; isc[3] = i23[1];
                        unsigned ka = __builtin_bit_cast(unsigned, __builtin_amdgcn_cvt_pkrtz(isc[0], isc[1])), kb = __builtin_bit_cast(unsigned, __builtin_amdgcn_cvt_pkrtz(isc[2], isc[3]));
                        ka ^= (((ka >> 15) & 0x00010001u) * 0xffffu) | 0x80008000u; kb ^= (((kb >> 15) & 0x00010001u) * 0xffffu) | 0x80008000u;
                        if (xs == 0) { k0.x = ka; k0.y = kb; } else if (xs == 1) { k0.z = ka; k0.w = kb; } else if (xs == 2) { k1.x = ka; k1.y = kb; } else { k1.z = ka; k1.w = kb; }
                    }
                    unsigned short* dst = SC + (size_t)(row0 + fr) * 8192 + 16 * (kb8 + 4 * gq) + 16 * fq;
                    *(v4u*)dst = k0; *(v4u*)(dst + 8) = k1;
                }
            }
        }
    }
}

__device__ __forceinline__ void mask_ge8(unsigned long long (&m)[8], unsigned x0, unsigned x1, unsigned x2, unsigned x3, unsigned x4, unsigned x5, unsigned x6, unsigned x7, unsigned t) {
    asm("v_cmp_ge_u32_e64 %0, %8, %16\n\tv_cmp_ge_u32_e64 %1, %9, %16\n\tv_cmp_ge_u32_e64 %2, %10, %16\n\tv_cmp_ge_u32_e64 %3, %11, %16\n\t"
        "v_cmp_ge_u32_e64 %4, %12, %16\n\tv_cmp_ge_u32_e64 %5, %13, %16\n\tv_cmp_ge_u32_e64 %6, %14, %16\n\tv_cmp_ge_u32_e64 %7, %15, %16"
        : "=&s"(m[0]), "=&s"(m[1]), "=&s"(m[2]), "=&s"(m[3]), "=&s"(m[4]), "=&s"(m[5]), "=&s"(m[6]), "=&s"(m[7])
        : "v"(x0), "v"(x1), "v"(x2), "v"(x3), "v"(x4), "v"(x5), "v"(x6), "v"(x7), "s"(t));
}
__device__ __forceinline__ unsigned tk_key(float f) { const unsigned b = __float_as_uint(f); return (b & 0x80000000u) ? ~b : (b | 0x80000000u); }
__device__ __forceinline__ void topk_row_slow(const unsigned short* sr, const int n, const int lane, LAS int* sel) {
    const int nseg = (n + 63) >> 6;
    unsigned T = 0u;
    for (int bit = 31; bit >= 16; --bit) {
        const unsigned cnd = T | (1u << bit); int c = 0;
        for (int sg = 0; sg < nseg; ++sg) { const int idx = sg * 64 + lane; const unsigned x = (idx < n) ? ((unsigned)sr[idx < n ? idx : 0] << 16) : 0u; c += __popcll(__ballot(x >= cnd)); }
        if (c >= 256) T = cnd;
    }
    int cgt = 0;
    for (int sg = 0; sg < nseg; ++sg) { const int idx = sg * 64 + lane; const unsigned x = (idx < n) ? ((unsigned)sr[idx < n ? idx : 0] << 16) : 0u; cgt += __popcll(__ballot(x > T)); }
    const int need_eq = 256 - cgt; int running = 0, eq_taken = 0;
    const unsigned long long lt = (1ull << lane) - 1ull;
    for (int sg = 0; sg < nseg; ++sg) {
        const int idx = sg * 64 + lane; const unsigned x = (idx < n) ? ((unsigned)sr[idx < n ? idx : 0] << 16) : 0u;
        const bool gt = x > T, eq = x == T;
        const unsigned long long meq = __ballot(eq);
        const bool take = gt || (eq && (eq_taken + __popcll(meq & lt)) < need_eq);
        const unsigned long long mt = __ballot(take);
        if (take) sel[running + __popcll(mt & lt)] = idx;
        running += __popcll(mt); eq_taken += __popcll(meq);
    }
}
constexpr int TK_CAP = 832;
__device__ __forceinline__ void compact8(unsigned k0, unsigned k1, unsigned k2, unsigned k3, unsigned k4, unsigned k5, unsigned k6, unsigned k7, const unsigned ts, const unsigned ix0, const unsigned sb, unsigned& bv, int& nc) {
    unsigned t, ix; int st; unsigned long long sv;
    static_assert(TK_CAP == 832, "clamp literal below");
    asm volatile("s_mov_b64 %[sv], exec\n\t"
        "v_cmp_le_u32_e32 vcc, %[ts], %[k0]\n\t"
        "s_bcnt1_i32_b64 %[st], vcc\n\t"
        "v_mbcnt_lo_u32_b32 %[t], vcc_lo, %[bv]\n\t"
        "v_mbcnt_hi_u32_b32 %[t], vcc_hi, %[t]\n\t"
        "v_min_u32_e32 %[t], 831, %[t]\n\t"
        "v_lshl_add_u32 %[t], %[t], 3, %[sb]\n\t"
        "v_add_u32_e32 %[ix], 0, %[ix0]\n\t"
        "s_mov_b64 exec, vcc\n\t"
        "ds_write2_b32 %[t], %[ix], %[k0] offset1:1\n\t"
        "s_mov_b64 exec, %[sv]\n\t"
        "v_add_u32_e32 %[bv], %[st], %[bv]\n\t"
        "s_add_i32 %[nc], %[nc], %[st]\n\t"
        "v_cmp_le_u32_e32 vcc, %[ts], %[k1]\n\t"
        "s_bcnt1_i32_b64 %[st], vcc\n\t"
        "v_mbcnt_lo_u32_b32 %[t], vcc_lo, %[bv]\n\t"
        "v_mbcnt_hi_u32_b32 %[t], vcc_hi, %[t]\n\t"
        "v_min_u32_e32 %[t], 831, %[t]\n\t"
        "v_lshl_add_u32 %[t], %[t], 3, %[sb]\n\t"
        "v_add_u32_e32 %[ix], 64, %[ix0]\n\t"
        "s_mov_b64 exec, vcc\n\t"
        "ds_write2_b32 %[t], %[ix], %[k1] offset1:1\n\t"
        "s_mov_b64 exec, %[sv]\n\t"
        "v_add_u32_e32 %[bv], %[st], %[bv]\n\t"
        "s_add_i32 %[nc], %[nc], %[st]\n\t"
        "v_cmp_le_u32_e32 vcc, %[ts], %[k2]\n\t"
        "s_bcnt1_i32_b64 %[st], vcc\n\t"
        "v_mbcnt_lo_u32_b32 %[t], vcc_lo, %[bv]\n\t"
        "v_mbcnt_hi_u32_b32 %[t], vcc_hi, %[t]\n\t"
        "v_min_u32_e32 %[t], 831, %[t]\n\t"
        "v_lshl_add_u32 %[t], %[t], 3, %[sb]\n\t"
        "v_add_u32_e32 %[ix], 128, %[ix0]\n\t"
        "s_mov_b64 exec, vcc\n\t"
        "ds_write2_b32 %[t], %[ix], %[k2] offset1:1\n\t"
        "s_mov_b64 exec, %[sv]\n\t"
        "v_add_u32_e32 %[bv], %[st], %[bv]\n\t"
        "s_add_i32 %[nc], %[nc], %[st]\n\t"
        "v_cmp_le_u32_e32 vcc, %[ts], %[k3]\n\t"
        "s_bcnt1_i32_b64 %[st], vcc\n\t"
        "v_mbcnt_lo_u32_b32 %[t], vcc_lo, %[bv]\n\t"
        "v_mbcnt_hi_u32_b32 %[t], vcc_hi, %[t]\n\t"
        "v_min_u32_e32 %[t], 831, %[t]\n\t"
        "v_lshl_add_u32 %[t], %[t], 3, %[sb]\n\t"
        "v_add_u32_e32 %[ix], 192, %[ix0]\n\t"
        "s_mov_b64 exec, vcc\n\t"
        "ds_write2_b32 %[t], %[ix], %[k3] offset1:1\n\t"
        "s_mov_b64 exec, %[sv]\n\t"
        "v_add_u32_e32 %[bv], %[st], %[bv]\n\t"
        "s_add_i32 %[nc], %[nc], %[st]\n\t"
        "v_cmp_le_u32_e32 vcc, %[ts], %[k4]\n\t"
        "s_bcnt1_i32_b64 %[st], vcc\n\t"
        "v_mbcnt_lo_u32_b32 %[t], vcc_lo, %[bv]\n\t"
        "v_mbcnt_hi_u32_b32 %[t], vcc_hi, %[t]\n\t"
        "v_min_u32_e32 %[t], 831, %[t]\n\t"
        "v_lshl_add_u32 %[t], %[t], 3, %[sb]\n\t"
        "v_add_u32_e32 %[ix], 256, %[ix0]\n\t"
        "s_mov_b64 exec, vcc\n\t"
        "ds_write2_b32 %[t], %[ix], %[k4] offset1:1\n\t"
        "s_mov_b64 exec, %[sv]\n\t"
        "v_add_u32_e32 %[bv], %[st], %[bv]\n\t"
        "s_add_i32 %[nc], %[nc], %[st]\n\t"
        "v_cmp_le_u32_e32 vcc, %[ts], %[k5]\n\t"
        "s_bcnt1_i32_b64 %[st], vcc\n\t"
        "v_mbcnt_lo_u32_b32 %[t], vcc_lo, %[bv]\n\t"
        "v_mbcnt_hi_u32_b32 %[t], vcc_hi, %[t]\n\t"
        "v_min_u32_e32 %[t], 831, %[t]\n\t"
        "v_lshl_add_u32 %[t], %[t], 3, %[sb]\n\t"
        "v_add_u32_e32 %[ix], 320, %[ix0]\n\t"
        "s_mov_b64 exec, vcc\n\t"
        "ds_write2_b32 %[t], %[ix], %[k5] offset1:1\n\t"
        "s_mov_b64 exec, %[sv]\n\t"
        "v_add_u32_e32 %[bv], %[st], %[bv]\n\t"
        "s_add_i32 %[nc], %[nc], %[st]\n\t"
        "v_cmp_le_u32_e32 vcc, %[ts], %[k6]\n\t"
        "s_bcnt1_i32_b64 %[st], vcc\n\t"
        "v_mbcnt_lo_u32_b32 %[t], vcc_lo, %[bv]\n\t"
        "v_mbcnt_hi_u32_b32 %[t], vcc_hi, %[t]\n\t"
        "v_min_u32_e32 %[t], 831, %[t]\n\t"
        "v_lshl_add_u32 %[t], %[t], 3, %[sb]\n\t"
        "v_add_u32_e32 %[ix], 384, %[ix0]\n\t"
        "s_mov_b64 exec, vcc\n\t"
        "ds_write2_b32 %[t], %[ix], %[k6] offset1:1\n\t"
        "s_mov_b64 exec, %[sv]\n\t"
        "v_add_u32_e32 %[bv], %[st], %[bv]\n\t"
        "s_add_i32 %[nc], %[nc], %[st]\n\t"
        "v_cmp_le_u32_e32 vcc, %[ts], %[k7]\n\t"
        "s_bcnt1_i32_b64 %[st], vcc\n\t"
        "v_mbcnt_lo_u32_b32 %[t], vcc_lo, %[bv]\n\t"
        "v_mbcnt_hi_u32_b32 %[t], vcc_hi, %[t]\n\t"
        "v_min_u32_e32 %[t], 831, %[t]\n\t"
        "v_lshl_add_u32 %[t], %[t], 3, %[sb]\n\t"
        "v_add_u32_e32 %[ix], 448, %[ix0]\n\t"
        "s_mov_b64 exec, vcc\n\t"
        "ds_write2_b32 %[t], %[ix], %[k7] offset1:1\n\t"
        "s_mov_b64 exec, %[sv]\n\t"
        "v_add_u32_e32 %[bv], %[st], %[bv]\n\t"
        "s_add_i32 %[nc], %[nc], %[st]"
        : [t] "=&v"(t), [ix] "=&v"(ix), [st] "=&s"(st), [sv] "=&s"(sv), [bv] "+v"(bv), [nc] "+s"(nc)
        : [k0] "v"(k0), [k1] "v"(k1), [k2] "v"(k2), [k3] "v"(k3), [k4] "v"(k4), [k5] "v"(k5), [k6] "v"(k6), [k7] "v"(k7), [ts] "s"(ts), [ix0] "v"(ix0), [sb] "s"(sb)
        : "vcc", "scc", "memory");
}
__device__ __forceinline__ void mask_ge5(unsigned long long (&m)[8], unsigned x0, unsigned x1, unsigned x2, unsigned x3, unsigned x4, unsigned t) {
    asm("v_cmp_ge_u32_e64 %0, %5, %10\n\tv_cmp_ge_u32_e64 %1, %6, %10\n\tv_cmp_ge_u32_e64 %2, %7, %10\n\tv_cmp_ge_u32_e64 %3, %8, %10\n\tv_cmp_ge_u32_e64 %4, %9, %10"
        : "=&s"(m[0]), "=&s"(m[1]), "=&s"(m[2]), "=&s"(m[3]), "=&s"(m[4])
        : "v"(x0), "v"(x1), "v"(x2), "v"(x3), "v"(x4), "s"(t));
}
template <int NR> __device__ __forceinline__ void topk_select(const LAS unsigned long long* cand, const int nc, LAS int* sel, const int lane, const unsigned long long ltmask_s) {
    unsigned ck[NR]; int ci[NR];
#pragma unroll
    for (int t = 0; t < NR; ++t) { const int j = lane + 64 * t; const unsigned long long e = (j < nc) ? cand[j] : 0ull; ck[t] = (unsigned)(e >> 32); ci[t] = (int)(unsigned)e; }
    auto masks = [&](unsigned long long (&m0)[8], unsigned long long (&m1)[8], const unsigned thr) {
        mask_ge8(m0, ck[0], ck[1], ck[2], ck[3], ck[4], ck[5], ck[6], ck[7], thr);
        if constexpr (NR == 13) mask_ge5(m1, ck[8], ck[9], ck[10], ck[11], ck[12], thr);
    };
    unsigned T = 0u; bool hit = false;
    for (int bit = 31; bit >= 16; --bit) {
        const unsigned cnd = T | (1u << bit); unsigned long long m0[8], m1[8];
        masks(m0, m1, cnd);
        int c = 0;
#pragma unroll
        for (int i = 0; i < NR; ++i) c += __popcll(i < 8 ? m0[i & 7] : m1[i & 7]);
        if (c >= 256) { T = cnd; if (c == 256) { hit = true; break; } }
    }
    if (hit) {
        unsigned mn = 0xffffffffu;
#pragma unroll
        for (int t = 0; t < NR; ++t) { const unsigned k = (ck[t] >= T) ? ck[t] : 0xffffffffu; mn = k < mn ? k : mn; }
#pragma unroll
        for (int o = 32; o >= 1; o >>= 1) { const unsigned other = (unsigned)__shfl_xor((int)mn, o); mn = other < mn ? other : mn; }
        T = (unsigned)__builtin_amdgcn_readfirstlane((int)mn);
    }
    unsigned long long g0[8], g1[8], h0[8], h1[8];
    masks(g0, g1, T); masks(h0, h1, T + 1u);
    int cgt = 0;
#pragma unroll
    for (int t = 0; t < NR; ++t) cgt += __popcll(t < 8 ? h0[t & 7] : h1[t & 7]);
    const int need_eq = 256 - cgt;
    int running = 0, eq_taken = 0;
#pragma unroll
    for (int t = 0; t < NR; ++t) {
        const unsigned long long mge = (t < 8 ? g0[t & 7] : g1[t & 7]), mgt = (t < 8 ? h0[t & 7] : h1[t & 7]);
        unsigned long long mt = mge; const unsigned long long me = mge & ~mgt;
        if (me != 0ull) {
            const int room = need_eq - eq_taken; unsigned long long keep = 0ull, rest = me;
            for (int k = 0; k < room && rest != 0ull; ++k) { const unsigned long long low = rest & (~rest + 1ull); keep |= low; rest ^= low; }
            mt = (mge & ~me) | keep; eq_taken += __popcll(me);
        }
        if (mt != 0ull) { if ((mt >> lane) & 1ull) sel[running + __popcll(mt & ltmask_s)] = ci[t]; running += __popcll(mt); }
    }
}
template <int NB> __device__ __forceinline__ bool topk_fast(const unsigned short* sr, const int n, const int nblk, const int lane, LAS int* sel, LAS unsigned long long* cand) {
    constexpr int NR = 16 * NB;
    int lane_l = lane; asm volatile("" : "+v"(lane_l));
    unsigned u[NR];
#pragma unroll
    for (int i = 0; i < NR; ++i) u[i] = (unsigned)(sr + (i >> 4) * 1024)[(i & 15) * 64 + lane_l];
    asm volatile("" ::: "memory");
#pragma unroll
    for (int i = 0; i < NR; ++i) { const int lim = n - i * 64;
        u[i] = (lane < lim) ? (u[i] << 16) : 0u; }
    const unsigned long long ltmask_s = (1ull << lane) - 1ull;
    int ns = 0;
#pragma unroll
    for (int k = 0; k < 2 * NB; ++k) { int v = n - 512 * k; v = v < 0 ? 0 : (v > 64 ? 64 : v); ns += v; }
    const float mean = 256.0f * (float)ns / (float)n;
    const int rs = (int)(mean + 4.0f * sqrtf(mean) + 5.0f);
    unsigned Ts = 0u;
    for (int bit = 31; bit >= 16; --bit) {
        const unsigned cnd = Ts | (1u << bit); unsigned long long m0[8], m1[8];
        mask_ge8(m0, u[0], u[8], u[16], u[24], u[32], u[40], u[48], u[56], cnd);
        if constexpr (NB == 8) mask_ge8(m1, u[NR - 64], u[NR - 56], u[NR - 48], u[NR - 40], u[NR - 32], u[NR - 24], u[NR - 16], u[NR - 8], cnd);
        int c = 0;
#pragma unroll
        for (int i = 0; i < 8; ++i) { c += __popcll(m0[i]); if constexpr (NB == 8) c += __popcll(m1[i]); }
        if (c >= rs) Ts = cnd;
    }
    if (Ts == 0u) Ts = 1u;
    int nc = 0; unsigned bv = 0u;
    const unsigned sb = __builtin_amdgcn_readfirstlane((unsigned)(size_t)cand);
#pragma unroll
    for (int bk = 0; bk < NB; ++bk) {
        if (bk < nblk) {
#pragma unroll
            for (int g8 = 0; g8 < 2; ++g8) { const int b0 = bk * 16 + g8 * 8;
                compact8(u[b0], u[b0 + 1], u[b0 + 2], u[b0 + 3], u[b0 + 4], u[b0 + 5], u[b0 + 6], u[b0 + 7], Ts, (unsigned)(b0 * 64 + lane_l), sb, bv, nc); }
        }
    }
    if (nc < 256 || nc > TK_CAP) return false;
    if (nc <= 512) topk_select<8>(cand, nc, sel, lane, ltmask_s); else topk_select<13>(cand, nc, sel, lane, ltmask_s);
    return true;
}
__device__ __forceinline__ int topk_row(Frame& F, const int row, LAS int* sel, LAS unsigned long long* cand) {
    const int lane = F.lane;
    const unsigned short* SC = WSP(unsigned short, WS_BIG);
    const int pos = row & (SEQ - 1), n = pos + 1;
    if (n <= 256) {
#pragma unroll
        for (int i = 0; i < 4; ++i) { const int j = 64 * i + lane; sel[j] = (j < n) ? j : 0; }
        return n;
    }
    const int nblk = (n + 1023) >> 10;
    const unsigned short* sr = SC + (size_t)row * 8192;
    const bool done = (nblk > 4) ? topk_fast<8>(sr, n, nblk, lane, sel, cand) : topk_fast<4>(sr, n, nblk, lane, sel, cand);
    if (!done) topk_row_slow(sr, n, lane, sel);
    return 256;
}

__device__ __forceinline__ void p6_gdn_out(Frame& F, KArgs A) {
    const int lane = F.lane, gw = F.bid * NWAVES + F.wave, NGW = F.G * NWAVES;
    const f32x4 g0 = *(const f32x4*)(A->in[I_AB_ONG] + 8 * (lane & 15)), g1 = *(const f32x4*)(A->in[I_AB_ONG] + 8 * (lane & 15) + 4);
    for (int row = gw; row < M; row += NGW) {
        const float* op = WSP(float, WS_ODELTA) + (size_t)row * 512 + 8 * lane;
        const f32x4 a = *(const f32x4*)op, b = *(const f32x4*)(op + 4);
        float ss = a[0] * a[0] + a[1] * a[1] + a[2] * a[2] + a[3] * a[3] + b[0] * b[0] + b[1] * b[1] + b[2] * b[2] + b[3] * b[3];
        ss += __shfl_xor(ss, 1); ss += __shfl_xor(ss, 2); ss += __shfl_xor(ss, 4); ss += __shfl_xor(ss, 8);
        const float r = rsqrtf(ss * (1.0f / 128.0f) + 1e-6f);
        float z[8]; unpack8(*(const v4u*)(WSP(bf16, WS_QKVZ) + (size_t)row * 2048 + 1536 + 8 * lane), z);
        float o[8];
#pragma unroll
        for (int i = 0; i < 4; ++i) { o[i] = a[i] * r * g0[i] * siluf(z[i]); o[4 + i] = b[i] * r * g1[i] * siluf(z[4 + i]); }
        *(v4u*)(WSP(bf16, WS_AO) + (size_t)row * 1536 + 1024 + 8 * lane) = pack8f(o);
    }
}

__device__ __forceinline__ void p8_ln_router(Frame& F, KArgs A, int l, float* HOUT, bf16* HB) {
    const int lane = F.lane, tid = F.tid, gw = F.bid * NWAVES + F.wave, NGW = F.G * NWAVES;
    LAS float* wT = (LAS float*)(F.lds);
    LAS float* lg = (LAS float*)(F.lds + WSCR_OFF + F.wave * WSCR_BYTES);
    const float* rw = A->in[I_RW] + (size_t)l * 1024 * 32;
    {
        f32x4 wv[16];
#pragma unroll
        for (int j = 0; j < 16; ++j) wv[j] = *(const f32x4*)(rw + (size_t)(tid + NTHREADS * j) * 4);
#pragma unroll
        for (int j = 0; j < 16; ++j) { const int i4 = tid + NTHREADS * j, k = i4 >> 3, e0 = (i4 & 7) * 4;
            wT[(e0 + 0) * 1028 + k] = wv[j][0]; wT[(e0 + 1) * 1028 + k] = wv[j][1]; wT[(e0 + 2) * 1028 + k] = wv[j][2]; wT[(e0 + 3) * 1028 + k] = wv[j][3]; }
    }
    __syncthreads();
    const float* PRE = WSP(float, WS_PRE); unsigned char* H8 = WSP(unsigned char, WS_XS);
    const float* lg_g = A->in[I_LNM_G] + (size_t)l * 1024; const float* lg_b = A->in[I_LNM_B] + (size_t)l * 1024;
    const float rb = A->in[I_RB][l * 32 + (lane & 31)];
    int* TOKE = WSP(int, WS_ROUTE); int* TOKPOS = TOKE + M * 4; float* TOKG = (float*)(TOKPOS + M * 4);
    gu32* cnt = F.ctl + CW_CNT + 64 * 32 * l;
    LAS int* lcnt = (LAS int*)(F.lds + MISC_OFF + 512);
    LAS int* lbase = lcnt + 32;
    LAS int* myrt = (LAS int*)(F.lds + WSCR_OFF + F.wave * WSCR_BYTES + 128);
    if (tid < 32) lcnt[tid] = 0;
    __syncthreads();
    int nrow = 0;
    f32x4 lng[4], lnb[4];
#pragma unroll
    for (int j = 0; j < 4; ++j) { lng[j] = *(const f32x4*)(lg_g + 256 * j + 4 * lane); lnb[j] = *(const f32x4*)(lg_b + 256 * j + 4 * lane); }
    typedef float f2_t __attribute__((ext_vector_type(2)));
    for (int rowA = gw; rowA < M; rowA += 2 * NGW) {
        const bool hasB = rowA + NGW < M; int rows[2]; rows[0] = rowA; rows[1] = hasB ? rowA + NGW : rowA;
        f32x4 v[2][4];
#pragma unroll
        for (int r = 0; r < 2; ++r)
#pragma unroll
            for (int j = 0; j < 4; ++j) v[r][j] = *(const f32x4*)(PRE + (size_t)rows[r] * 1024 + 256 * j + 4 * lane);
#pragma unroll
        for (int r = 0; r < 2; ++r) {
            float s = 0.f;
#pragma unroll
            for (int j = 0; j < 4; ++j) s += (v[r][j][0] + v[r][j][1]) + (v[r][j][2] + v[r][j][3]);
            const float mean = wave_sum(s) * (1.0f / 1024.0f); float s2 = 0.f;
#pragma unroll
            for (int j = 0; j < 4; ++j) { v[r][j] = v[r][j] - mean; s2 += (v[r][j][0] * v[r][j][0] + v[r][j][1] * v[r][j][1]) + (v[r][j][2] * v[r][j][2] + v[r][j][3] * v[r][j][3]); }
            const float rstd = rsqrtf(wave_sum(s2) * (1.0f / 1024.0f) + 1e-5f);
#pragma unroll
            for (int j = 0; j < 4; ++j) {
                v[r][j] = v[r][j] * rstd * lng[j] + lnb[j];
                if (r == 0 || hasB) {
                    v2u o; o.x = pk2(v[r][j][0], v[r][j][1]); o.y = pk2(v[r][j][2], v[r][j][3]); *(v2u*)(HB + (size_t)rows[r] * 1024 + 256 * j + 4 * lane) = o;
                    if (kMoeFp8) { unsigned w = 0u; w = __builtin_amdgcn_cvt_pk_fp8_f32(v[r][j][0], v[r][j][1], w, false); w = __builtin_amdgcn_cvt_pk_fp8_f32(v[r][j][2], v[r][j][3], w, true); *(unsigned*)(H8 + (size_t)rows[r] * 1024 + 256 * j + 4 * lane) = w; }
                }
            }
        }
        f2_t vv[4][4];
#pragma unroll
        for (int j = 0; j < 4; ++j)
#pragma unroll
            for (int k = 0; k < 4; ++k) { vv[j][k][0] = v[0][j][k]; vv[j][k][1] = v[1][j][k]; }
        float q[32];
#pragma unroll
        for (int e = 0; e < 32; ++e) {
            f2_t a = (f2_t){0.f, 0.f};
#pragma unroll
            for (int j = 0; j < 4; ++j) { const f32x4 w = *(const LAS f32x4*)(wT + e * 1028 + 256 * j + 4 * lane);
                a += vv[j][0] * w[0]; a += vv[j][1] * w[1]; a += vv[j][2] * w[2]; a += vv[j][3] * w[3]; }
            const bool up = (lane & 32) != 0; const float keep = up ? a[1] : a[0], send = up ? a[0] : a[1];
            q[e] = keep + __shfl_xor(send, 32);
        }
#pragma unroll
        for (int i = 0; i < 16; ++i) { const bool up = (lane & 16) != 0; const float keep = up ? q[i + 16] : q[i], send = up ? q[i] : q[i + 16]; q[i] = keep + __shfl_xor(send, 16); }
#pragma unroll
        for (int i = 0; i < 8; ++i) { const bool up = (lane & 8) != 0; const float keep = up ? q[i + 8] : q[i], send = up ? q[i] : q[i + 8]; q[i] = keep + __shfl_xor(send, 8); }
#pragma unroll
        for (int i = 0; i < 4; ++i) { const bool up = (lane & 4) != 0; const float keep = up ? q[i + 4] : q[i], send = up ? q[i] : q[i + 4]; q[i] = keep + __shfl_xor(send, 4); }
#pragma unroll
        for (int i = 0; i < 2; ++i) { const bool up = (lane & 2) != 0; const float keep = up ? q[i + 2] : q[i], send = up ? q[i] : q[i + 2]; q[i] = keep + __shfl_xor(send, 2); }
        { const bool up = (lane & 1) != 0; const float keep = up ? q[1] : q[0], send = up ? q[0] : q[1]; q[0] = keep + __shfl_xor(send, 1); }
        float val = q[0] + rb;
        float tl[4]; int te[4];
#pragma unroll
        for (int k = 0; k < 4; ++k) {
            float mx = val;
            mx = fmaxf(mx, __shfl_xor(mx, 16)); mx = fmaxf(mx, __shfl_xor(mx, 8)); mx = fmaxf(mx, __shfl_xor(mx, 4)); mx = fmaxf(mx, __shfl_xor(mx, 2)); mx = fmaxf(mx, __shfl_xor(mx, 1));
            const unsigned long long mm = __ballot(val == mx);
            const unsigned hm = (unsigned)(mm >> (lane & 32));
            const int idx = __ffs((int)hm) - 1;
            tl[k] = mx; te[k] = idx;
            if ((lane & 31) == idx) val = -INFINITY;
        }
        const float e1 = __expf(tl[1] - tl[0]), e2 = __expf(tl[2] - tl[0]), e3 = __expf(tl[3] - tl[0]);
        const float inv = 1.0f / (1.0f + e1 + e2 + e3);
        const int kk = lane & 31, rr = lane >> 5;
        if (kk < 4 && (rr == 0 || hasB)) {
            const int e = kk == 0 ? te[0] : (kk == 1 ? te[1] : (kk == 2 ? te[2] : te[3]));
            const float g = (kk == 0 ? 1.0f : (kk == 1 ? e1 : (kk == 2 ? e2 : e3))) * inv;
            const int lp = __hip_atomic_fetch_add(lcnt + e, 1, __ATOMIC_RELAXED, __HIP_MEMORY_SCOPE_WORKGROUP);
            LAS int* rt = myrt + ((nrow + rr) * 4 + kk) * 3; rt[0] = e; rt[1] = lp; rt[2] = __float_as_int(g);
        }
        nrow += hasB ? 2 : 1;
    }
    __syncthreads();
    if (tid < 32) lbase[tid] = (int)__hip_atomic_fetch_add(cnt + 64 * tid, (unsigned)lcnt[tid], RLX_AGENT);
    __syncthreads();
    if (lane < 4) {
        int j = 0;
        for (int row = gw; row < M; row += NGW, ++j) {
            const LAS int* rt = myrt + (j * 4 + lane) * 3; const int e = rt[0];
            TOKE[(size_t)row * 4 + lane] = e; TOKPOS[(size_t)row * 4 + lane] = lbase[e] + rt[1]; TOKG[(size_t)row * 4 + lane] = __int_as_float(rt[2]);
        }
    }
}

__device__ __forceinline__ void p9_scatter(Frame& F, int l, const bf16* HB, const float* HF) {
    const int lane = F.lane, tid = F.tid, gw = F.bid * NWAVES + F.wave, NGW = F.G * NWAVES;
    LAS int* base = (LAS int*)(F.lds + MISC_OFF + 256);
    int* TOKE = WSP(int, WS_ROUTE); int* TOKPOS = TOKE + M * 4; int* TILE = TOKE + 3 * M * 4;
    if (tid < 32) base[tid] = (int)__hip_atomic_load(F.ctl + CW_CNT + 64 * (32 * l + tid), RLX_AGENT);
    __syncthreads();
    if (tid == 0) {
        int acc = 0;
        for (int e = 0; e < NEXP; ++e) { const int c = base[e]; base[e] = acc; acc += ((c + 255) >> 8) << 8; }
        base[32] = acc >> 8;
    }
    __syncthreads();
    if (F.bid == 0 && tid < 64) {
        const int nT = base[32];
        for (int t = tid; t < NTMAX; t += 64) { int e = 0;
            for (int x = 1; x < NEXP; ++x) if (base[x] <= t * 256) e = x;
            TILE[t] = (t < nT) ? e : 0; }
        if (tid == 0) TILE[NTMAX] = nT;
    }
    bf16* XS = WSP(bf16, WS_XS);
    if (kMoeFp8) {
        int* SLOTTOK = TOKE + 3 * M * 4 + NTMAX + 64;
        for (int idx = F.bid * NTHREADS + tid; idx < M * 4; idx += F.G * NTHREADS) SLOTTOK[base[TOKE[idx]] + TOKPOS[idx]] = idx >> 2;
        return;
    }
    for (int row = gw; row < M; row += NGW) {
        const v4u a = *(const v4u*)(HB + (size_t)row * 1024 + 8 * lane), b = *(const v4u*)(HB + (size_t)row * 1024 + 512 + 8 * lane);
#pragma unroll
        for (int k = 0; k < 4; ++k) {
            const int slot = base[TOKE[(size_t)row * 4 + k]] + TOKPOS[(size_t)row * 4 + k];
            *(v4u*)(XS + (size_t)slot * 1024 + 8 * lane) = a; *(v4u*)(XS + (size_t)slot * 1024 + 512 + 8 * lane) = b;
        }
    }
}

__device__ __forceinline__ void p12_combine(Frame& F, KArgs A, int l, const bf16* HINB, float* HOUT, bf16* HB) {
    const int lane = F.lane, tid = F.tid, gw = F.bid * NWAVES + F.wave, NGW = F.G * NWAVES;
    LAS int* base = (LAS int*)(F.lds + MISC_OFF + 256);
    if (tid < 32) base[tid] = (int)__hip_atomic_load(F.ctl + CW_CNT + 64 * (32 * l + tid), RLX_AGENT);
    __syncthreads();
    if (tid == 0) { int acc = 0; for (int e = 0; e < NEXP; ++e) { const int c = base[e]; base[e] = acc; acc += ((c + 255) >> 8) << 8; } }
    __syncthreads();
    const int* TOKE = WSP(int, WS_ROUTE); const int* TOKPOS = TOKE + M * 4; const float* TOKG = (const float*)(TOKPOS + M * 4);
    const bf16* YS = WSP(bf16, WS_YS); const bf16* PLE = WSP(bf16, WS_PLE);
    const float* lg_g = A->in[I_LNF_G] + (size_t)l * 1024; const float* lg_b = A->in[I_LNF_B] + (size_t)l * 1024;
    f32x4 lng[2][2], lnb[2][2];
#pragma unroll
    for (int hf = 0; hf < 2; ++hf) { const int c0 = 512 * hf + 8 * lane; lng[hf][0] = *(const f32x4*)(lg_g + c0); lng[hf][1] = *(const f32x4*)(lg_g + c0 + 4); lnb[hf][0] = *(const f32x4*)(lg_b + c0); lnb[hf][1] = *(const f32x4*)(lg_b + c0 + 4); }
    for (int row = gw; row < M; row += NGW) {
        typedef float f2v __attribute__((ext_vector_type(2)));
        f2v xx[8];
        {   float h0[8], h1[8]; unpack8(*(const v4u*)(HINB + (size_t)row * 1024 + 8 * lane), h0); unpack8(*(const v4u*)(HINB + (size_t)row * 1024 + 512 + 8 * lane), h1);
            float p0[8], p1[8]; unpack8(*(const v4u*)(PLE + (size_t)row * 1024 + 8 * lane), p0); unpack8(*(const v4u*)(PLE + (size_t)row * 1024 + 512 + 8 * lane), p1);
#pragma unroll
            for (int i = 0; i < 4; ++i) { xx[i] = (f2v){h0[2 * i], h0[2 * i + 1]} * ALPHA + (f2v){p0[2 * i], p0[2 * i + 1]}; xx[4 + i] = (f2v){h1[2 * i], h1[2 * i + 1]} * ALPHA + (f2v){p1[2 * i], p1[2 * i + 1]}; }
        }
#pragma unroll
        for (int k = 0; k < 4; ++k) {
            const int slot = base[TOKE[(size_t)row * 4 + k]] + TOKPOS[(size_t)row * 4 + k]; const float g = TOKG[(size_t)row * 4 + k];
            float y0[8], y1[8];
            if (kMoeFp8 && true) { const unsigned char* yp = (const unsigned char*)YS + (size_t)slot * 1024 + 8 * lane; const v2u wa = *(const v2u*)yp, wb = *(const v2u*)(yp + 512);
                typedef float f2_t __attribute__((ext_vector_type(2)));
                f2_t t;
                t = __builtin_amdgcn_cvt_pk_f32_fp8(wa.x, false); xx[0] += t * g; t = __builtin_amdgcn_cvt_pk_f32_fp8(wa.x, true); xx[1] += t * g;
                t = __builtin_amdgcn_cvt_pk_f32_fp8(wa.y, false); xx[2] += t * g; t = __builtin_amdgcn_cvt_pk_f32_fp8(wa.y, true); xx[3] += t * g;
                t = __builtin_amdgcn_cvt_pk_f32_fp8(wb.x, false); xx[4] += t * g; t = __builtin_amdgcn_cvt_pk_f32_fp8(wb.x, true); xx[5] += t * g;
                t = __builtin_amdgcn_cvt_pk_f32_fp8(wb.y, false); xx[6] += t * g; t = __builtin_amdgcn_cvt_pk_f32_fp8(wb.y, true); xx[7] += t * g; }
            else { unpack8(*(const v4u*)(YS + (size_t)slot * 1024 + 8 * lane), y0); unpack8(*(const v4u*)(YS + (size_t)slot * 1024 + 512 + 8 * lane), y1);
#pragma unroll
                for (int i = 0; i < 4; ++i) { xx[i] += (f2v){y0[2 * i], y0[2 * i + 1]} * g; xx[4 + i] += (f2v){y1[2 * i], y1[2 * i + 1]} * g; } }
        }
        f2v sv2 = xx[0];
#pragma unroll
        for (int i = 1; i < 8; ++i) sv2 += xx[i];
        const float mean = wave_sum(sv2[0] + sv2[1]) * (1.0f / 1024.0f); f2v q2 = (f2v){0.f, 0.f};
#pragma unroll
        for (int i = 0; i < 8; ++i) { xx[i] = xx[i] - mean; q2 += xx[i] * xx[i]; }
        const float rstd = rsqrtf(wave_sum(q2[0] + q2[1]) * (1.0f / 1024.0f) + 1e-5f);
        float x[16];
#pragma unroll
        for (int i = 0; i < 8; ++i) { x[2 * i] = xx[i][0]; x[2 * i + 1] = xx[i][1]; }
#pragma unroll
        for (int hf = 0; hf < 2; ++hf) {
            const int c0 = 512 * hf + 8 * lane;
            const f32x4 g0 = lng[hf][0], g1 = lng[hf][1], b0 = lnb[hf][0], b1 = lnb[hf][1];
            f32x4 o0, o1;
#pragma unroll
            for (int i = 0; i < 4; ++i) { o0[i] = x[8 * hf + i] * rstd * g0[i] + b0[i]; o1[i] = x[8 * hf + 4 + i] * rstd * g1[i] + b1[i]; }
            *(f32x4*)(HOUT + (size_t)row * 1024 + c0) = o0; *(f32x4*)(HOUT + (size_t)row * 1024 + c0 + 4) = o1;
            if (HB) { v4u w; w.x = pk2(o0[0], o0[1]); w.y = pk2(o0[2], o0[3]); w.z = pk2(o1[0], o1[1]); w.w = pk2(o1[2], o1[3]); *(v4u*)(HB + (size_t)row * 1024 + c0) = w; }
        }
    }
}

typedef short v4i16_t __attribute__((ext_vector_type(4)));
__device__ __forceinline__ v4i16_t lds_tr16(LAS unsigned char* p) { return __builtin_amdgcn_ds_read_tr16_b64_v4i16((LAS v4i16_t*)p); }
constexpr int DV_PITCH = 144, DV_BUF = 32 * DV_PITCH;
template <int DL  , int SIGMA  > __device__ __forceinline__ void dil_branch(const bf16* __restrict__ KV, LAS unsigned char* vbuf, const int s0, const int lane,
                                                                                 const bf16x8 (&qf)[2], f32x4 (&O)[4], float& m_run, float& l_run) {
    constexpr int d = 1 << DL, sigma = SIGMA, NS = (129 + 15 * sigma + 31) / 32;
    const int fr = lane & 15, fq = lane >> 4;
    const int c = s0 & (d - 1), n0 = s0 >> DL, kstart = n0 - 128;
    const int dbase = 128 + sigma * fr - 4 * fq;
    const int dmax = n0 + sigma * fr;
#define DIL_POS(n) ({ int _p = c + d * (n); _p = _p < 0 ? 0 : (_p > SEQ - 1 ? SEQ - 1 : _p); _p; })
    bf16x8 kf[2][2]; v4u vr[4];
#pragma unroll
    for (int tl = 0; tl < 2; ++tl) { const bf16* kp = KV + (size_t)DIL_POS(kstart + 16 * tl + fr) * 2560 + 768 + 8 * fq; kf[tl][0] = *(const bf16x8*)kp; kf[tl][1] = *(const bf16x8*)(kp + 32); }
#pragma unroll
    for (int i = 0; i < 4; ++i) vr[i] = *(const v4u*)(KV + (size_t)DIL_POS(kstart + (lane >> 3) + 8 * i) * 2560 + 1536 + 8 * (lane & 7));
#pragma unroll 1
    for (int g = 0; g < NS; ++g) {
        LAS unsigned char* vb = vbuf;
#pragma unroll
        for (int i = 0; i < 4; ++i) *(LAS v4u*)(vb + ((lane >> 3) + 8 * i) * DV_PITCH + 16 * (lane & 7)) = vr[i];
        bf16x8 kc[2][2];
#pragma unroll
        for (int tl = 0; tl < 2; ++tl) { kc[tl][0] = kf[tl][0]; kc[tl][1] = kf[tl][1]; }
        if (g + 1 < NS) {
            const int kb = kstart + 32 * (g + 1);
#pragma unroll
            for (int tl = 0; tl < 2; ++tl) { const bf16* kp = KV + (size_t)DIL_POS(kb + 16 * tl + fr) * 2560 + 768 + 8 * fq; kf[tl][0] = *(const bf16x8*)kp; kf[tl][1] = *(const bf16x8*)(kp + 32); }
#pragma unroll
            for (int i = 0; i < 4; ++i) vr[i] = *(const v4u*)(KV + (size_t)DIL_POS(kb + (lane >> 3) + 8 * i) * 2560 + 1536 + 8 * (lane & 7));
        }
        float sv[8];
#pragma unroll
        for (int tl = 0; tl < 2; ++tl) {
            f32x4 cc = __builtin_amdgcn_mfma_f32_16x16x32_bf16(kc[tl][0], qf[0], (f32x4){0.f, 0.f, 0.f, 0.f}, 0, 0, 0);
            cc = __builtin_amdgcn_mfma_f32_16x16x32_bf16(kc[tl][1], qf[1], cc, 0, 0, 0);
#pragma unroll
            for (int j = 0; j < 4; ++j) {
                const int delta = dbase - (32 * g + 16 * tl + j);
                const bool ok = ((unsigned)delta <= 128u) && (delta <= dmax);
                sv[4 * tl + j] = ok ? cc[j] * 0.18033688011112042f : -INFINITY;
            }
        }
        float mx = fmaxf(fmaxf(fmaxf(sv[0], sv[1]), fmaxf(sv[2], sv[3])), fmaxf(fmaxf(sv[4], sv[5]), fmaxf(sv[6], sv[7])));
        mx = fmaxf(mx, __shfl_xor(mx, 16)); mx = fmaxf(mx, __shfl_xor(mx, 32));
        const float m_new = fmaxf(m_run, mx);
        if (!__all(m_new == m_run)) {
            const float alpha = __builtin_amdgcn_exp2f(m_run - m_new);
            l_run *= alpha;
#pragma unroll
            for (int j = 0; j < 4; ++j) { const float aj = __shfl(alpha, 4 * fq + j);
#pragma unroll
                for (int dt = 0; dt < 4; ++dt) O[dt][j] *= aj; }
            m_run = m_new;
        }
        float p[8], ps = 0.f;
#pragma unroll
        for (int e = 0; e < 8; ++e) { p[e] = __builtin_amdgcn_exp2f(sv[e] - m_run); ps += p[e]; }
        l_run += ps;
        v4u pw; pw.x = pg8::cvt_pk_bf16(p[0], p[1]); pw.y = pg8::cvt_pk_bf16(p[2], p[3]); pw.z = pg8::cvt_pk_bf16(p[4], p[5]); pw.w = pg8::cvt_pk_bf16(p[6], p[7]);
        const bf16x8 pf = __builtin_bit_cast(bf16x8, pw);
        LAS unsigned char* tb = vb + (4 * fq + ((lane & 15) >> 2)) * DV_PITCH + 8 * (lane & 3);
#pragma unroll
        for (int dt = 0; dt < 4; ++dt) {
            const v4i16_t lo = lds_tr16(tb + 32 * dt), hi = lds_tr16(tb + 16 * DV_PITCH + 32 * dt);
            bf16x8 vf; vf[0] = lo[0]; vf[1] = lo[1]; vf[2] = lo[2]; vf[3] = lo[3]; vf[4] = hi[0]; vf[5] = hi[1]; vf[6] = hi[2]; vf[7] = hi[3];
            O[dt] = __builtin_amdgcn_mfma_f32_16x16x32_bf16(pf, vf, O[dt], 0, 0, 0);
        }
    }
#undef DIL_POS
}
constexpr int HND_OFF = 8 * DV_BUF, HND_PITCH = 66;
static_assert(HND_OFF + 256 * HND_PITCH * 4 <= MISC_OFF, "dilated attention LDS map");
__device__ __forceinline__ void p14_dilated_mfma(Frame& F) {
    const int lane = F.lane, fr = lane & 15, fq = lane >> 4;
    LAS unsigned char* vbuf = F.lds + F.wave * DV_BUF;
    LAS float* hnd = (LAS float*)(F.lds + HND_OFF);
    const bf16* QK = WSP(bf16, WS_QKVZ); bf16* AO = WSP(bf16, WS_AO);
    for (int u = F.bid; u < 24 * 32; u += F.G) {
        const int bh = u >> 5, blk = u & 31;
        const int b = bh / 12, hh = bh - b * 12;
        const bf16* KV = QK + (size_t)b * SEQ * 2560 + hh * 64;
#pragma unroll 1
        for (int i = 0; i < 2; ++i) {
            const int run = 2 * F.wave + i, s0 = 256 * blk + 16 * run;
            bf16x8 qf[2];
            { const bf16* qp = KV + (size_t)(s0 + fr) * 2560 + 8 * fq; qf[0] = *(const bf16x8*)qp; qf[1] = *(const bf16x8*)(qp + 32); }
            f32x4 O[4];
#pragma unroll
            for (int dt = 0; dt < 4; ++dt) O[dt] = (f32x4){0.f, 0.f, 0.f, 0.f};
            float m_run = -1e30f, l_run = 0.f;
            dil_branch<0, 1>(KV, vbuf, s0, lane, qf, O, m_run, l_run);
            float lt = l_run; lt += __shfl_xor(lt, 16); lt += __shfl_xor(lt, 32);
#pragma unroll
            for (int j = 0; j < 4; ++j)
#pragma unroll
                for (int dt = 0; dt < 4; ++dt) hnd[(16 * run + 4 * fq + j) * HND_PITCH + 16 * dt + fr] = O[dt][j];
            if (fq == 0) { hnd[(16 * run + fr) * HND_PITCH + 64] = m_run; hnd[(16 * run + fr) * HND_PITCH + 65] = lt; }
        }
        __syncthreads();
#pragma unroll 1
        for (int i = 0; i < 2; ++i) {
            const int o = 2 * F.wave + i, s0 = 256 * blk + o;
            bf16x8 qf[2];
            { const bf16* qp = KV + (size_t)(s0 + 16 * fr) * 2560 + 8 * fq; qf[0] = *(const bf16x8*)qp; qf[1] = *(const bf16x8*)(qp + 32); }
            f32x4 O[4];
#pragma unroll
            for (int j = 0; j < 4; ++j)
#pragma unroll
                for (int dt = 0; dt < 4; ++dt) O[dt][j] = hnd[(o + 16 * (4 * fq + j)) * HND_PITCH + 16 * dt + fr];
            float m_run = hnd[(o + 16 * fr) * HND_PITCH + 64], l_run = (fq == 0) ? hnd[(o + 16 * fr) * HND_PITCH + 65] : 0.f;
            dil_branch<4, 1>(KV, vbuf, s0, lane, qf, O, m_run, l_run);
            dil_branch<2, 4>(KV, vbuf, s0, lane, qf, O, m_run, l_run);
            float lt = l_run; lt += __shfl_xor(lt, 16); lt += __shfl_xor(lt, 32);
            const float inv = __builtin_amdgcn_rcpf(lt);
#pragma unroll
            for (int j = 0; j < 4; ++j) {
                const float ij = __shfl(inv, 4 * fq + j);
                bf16* op = AO + (size_t)(b * SEQ + s0 + 16 * (4 * fq + j)) * 1024 + hh * 64 + fr;
#pragma unroll
                for (int dt = 0; dt < 4; ++dt) op[16 * dt] = (bf16)f2bf(O[dt][j] * ij);
            }
        }
        __syncthreads();
    }
}
constexpr int SA_PITCH = 288, SA_TILE = 32 * SA_PITCH;
#define SA_ROW(r) ((r) * SA_PITCH + (((r) >> 3) & 1) * 16)
__device__ __forceinline__ void sparse_row(Frame& F, const int row, const int n, const LAS int* sel, LAS unsigned char* tile) {
    const int lane = F.lane, fr = lane & 15, fq = lane >> 4;
    const bf16* QL = WSP(bf16, WS_QL); const bf16* CKV = WSP(bf16, WS_CKV); bf16* AO = WSP(bf16, WS_AO);
    {
        const int b = row >> 13;
        const bf16* kvb = CKV + (size_t)b * SEQ * 128;
        bf16x8 qf[4];
#pragma unroll
        for (int s = 0; s < 4; ++s) { const v4u z = (v4u){0u, 0u, 0u, 0u}; qf[s] = (fr < 8) ? *(const bf16x8*)(QL + (size_t)row * 1536 + fr * 128 + 32 * s + 8 * fq) : __builtin_bit_cast(bf16x8, z); }
        f32x4 O[8];
#pragma unroll
        for (int rt = 0; rt < 8; ++rt) O[rt] = (f32x4){0.f, 0.f, 0.f, 0.f};
        float m_run = -1e30f, l_run = 0.f;
        const int nsteps = (n + 31) >> 5;
        v4u vr[8];
        { const int j = lane & 31; const int kidx = (j < n) ? sel[j] : 0;
#pragma unroll
          for (int i = 0; i < 8; ++i) { const int key = __shfl(kidx, (lane >> 4) + 4 * i); vr[i] = *(const v4u*)(kvb + (size_t)key * 128 + 8 * (lane & 15)); } }
#pragma unroll 1
        for (int g = 0; g < nsteps; ++g) {
#pragma unroll
            for (int i = 0; i < 8; ++i) *(LAS v4u*)(tile + SA_ROW((lane >> 4) + 4 * i) + 16 * (lane & 15)) = vr[i];
            if (g + 1 < nsteps) {
                const int j = 32 * (g + 1) + (lane & 31); const int kidx = (j < n) ? sel[j] : 0;
#pragma unroll
                for (int i = 0; i < 8; ++i) { const int key = __shfl(kidx, (lane >> 4) + 4 * i); vr[i] = *(const v4u*)(kvb + (size_t)key * 128 + 8 * (lane & 15)); }
            }
            float sv[8];
#pragma unroll
            for (int tl = 0; tl < 2; ++tl) {
                f32x4 cc = (f32x4){0.f, 0.f, 0.f, 0.f};
#pragma unroll
                for (int s = 0; s < 4; ++s) { const bf16x8 kf = *(const LAS bf16x8*)(tile + SA_ROW(16 * tl + fr) + 64 * s + 16 * fq); cc = __builtin_amdgcn_mfma_f32_16x16x32_bf16(kf, qf[s], cc, 0, 0, 0); }
#pragma unroll
                for (int j = 0; j < 4; ++j) sv[4 * tl + j] = (32 * g + 16 * tl + 4 * fq + j < n) ? cc[j] : -INFINITY;
            }
            float mx = fmaxf(fmaxf(fmaxf(sv[0], sv[1]), fmaxf(sv[2], sv[3])), fmaxf(fmaxf(sv[4], sv[5]), fmaxf(sv[6], sv[7])));
            mx = fmaxf(mx, __shfl_xor(mx, 16)); mx = fmaxf(mx, __shfl_xor(mx, 32));
            const float m_new = fmaxf(m_run, mx);
            if (!__all(m_new == m_run)) {
                const float alpha = __builtin_amdgcn_exp2f(m_run - m_new);
                l_run *= alpha;
#pragma unroll
                for (int j = 0; j < 4; ++j) { const float aj = __shfl(alpha, 4 * fq + j);
#pragma unroll
                    for (int rt = 0; rt < 8; ++rt) O[rt][j] *= aj; }
                m_run = m_new;
            }
            float p[8], ps = 0.f;
#pragma unroll
            for (int e = 0; e < 8; ++e) { p[e] = __builtin_amdgcn_exp2f(sv[e] - m_run); ps += p[e]; }
            l_run += ps;
            v4u pw; pw.x = pg8::cvt_pk_bf16(p[0], p[1]); pw.y = pg8::cvt_pk_bf16(p[2], p[3]); pw.z = pg8::cvt_pk_bf16(p[4], p[5]); pw.w = pg8::cvt_pk_bf16(p[6], p[7]);
            const bf16x8 pf = __builtin_bit_cast(bf16x8, pw);
            LAS unsigned char* tb = tile + SA_ROW(4 * fq + ((lane & 15) >> 2)) + 8 * (lane & 3);
#pragma unroll
            for (int rt = 0; rt < 8; ++rt) {
                const v4i16_t lo = lds_tr16(tb + 32 * rt), hi = lds_tr16(tb + 16 * SA_PITCH + 32 * rt);
                bf16x8 vf; vf[0] = lo[0]; vf[1] = lo[1]; vf[2] = lo[2]; vf[3] = lo[3]; vf[4] = hi[0]; vf[5] = hi[1]; vf[6] = hi[2]; vf[7] = hi[3];
                O[rt] = __builtin_amdgcn_mfma_f32_16x16x32_bf16(pf, vf, O[rt], 0, 0, 0);
            }
        }
        float lt = l_run; lt += __shfl_xor(lt, 16); lt += __shfl_xor(lt, 32);
        const float inv = __builtin_amdgcn_rcpf(lt);
#pragma unroll
        for (int j = 0; j < 4; ++j) {
            const float ij = __shfl(inv, 4 * fq + j);
            if (fq < 2) { bf16* op = AO + (size_t)row * 1536 + (4 * fq + j) * 128 + fr;
#pragma unroll
                for (int rt = 0; rt < 8; ++rt) op[16 * rt] = (bf16)f2bf(O[rt][j] * ij); }
        }
    }
}
__device__ __forceinline__ void p5_topk_attn(Frame& F, const int gw, const int NGW) {
    LAS int* sel = (LAS int*)(F.lds + F.wave * 16384);
    LAS unsigned char* tile = F.lds + F.wave * 16384 + 1024;
    LAS unsigned long long* cand = (LAS unsigned long long*)(F.lds + F.wave * 16384 + 16384 - TK_CAP * 8);
    static_assert(1024 + SA_TILE <= 16384 && 1024 + TK_CAP * 8 <= 16384, "per-wave LDS");
    for (int rix = gw; rix < M; rix += NGW) {
        const int row = ((rix & 1) ? (M - 1 - (rix >> 1)) : (rix >> 1));
        const int n = __builtin_amdgcn_readfirstlane(topk_row(F, row, sel, cand));
        sparse_row(F, row, n, sel, tile);
    }
}
constexpr int CP_KV_PITCH = 272;
__device__ __forceinline__ void p3_chunk_prep_mfma(Frame& F, KArgs A) {
    int tid = F.tid; asm volatile("" : "+v"(tid));
    const int lane = tid & 63, wave = __builtin_amdgcn_readfirstlane(tid >> 6), fr = lane & 15, fq = lane >> 4;
    LAS unsigned char* kt = F.lds;
    LAS unsigned char* vt = F.lds + 64 * CP_KV_PITCH;
    LAS float* As = (LAS float*)(F.lds + 2 * 64 * CP_KV_PITCH);
    LAS float* Ts = As + 64 * 65;
    LAS float* Ps = Ts + 64 * 68;
    LAS float* gcS = Ps + 64 * 68; LAS float* egS = gcS + 64; LAS float* ekS = egS + 64; LAS float* btS = ekS + 64;
    for (int cidx = F.bid; cidx < 1024; cidx += F.G) {
        const int b = cidx >> 9, h = (cidx >> 7) & 3, n = cidx & 127, row0 = b * SEQ + n * 64;
        unsigned char* blk = F.ws + WS_CHK + (size_t)cidx * CHK_STRIDE;
        const bf16* Qg = WSP(bf16, WS_QN) + (size_t)row0 * 512 + h * 128; const bf16* Kg = WSP(bf16, WS_KN) + (size_t)row0 * 512 + h * 128; const bf16* Vg = WSP(bf16, WS_VN) + (size_t)row0 * 512 + h * 128;
        const int ti = wave >> 1;
        float g_in = 0.f, bt_in = 0.f;
        if (tid < 64) { g_in = WSP(float, WS_GG)[(size_t)(row0 + tid) * 4 + h]; bt_in = WSP(float, WS_BETA)[(size_t)(row0 + tid) * 4 + h]; }
        v4u kc[2], vc[2], qc[2];
#pragma unroll
        for (int i = 0; i < 2; ++i) { const int id = tid + 512 * i, r = id >> 4, c = id & 15; kc[i] = *(const v4u*)(Kg + (size_t)r * 512 + 8 * c); vc[i] = *(const v4u*)(Vg + (size_t)r * 512 + 8 * c); qc[i] = *(const v4u*)(Qg + (size_t)r * 512 + 8 * c); }
        bf16x8 ka[4], qa[4], kbf[2][4];
#pragma unroll
        for (int s = 0; s < 4; ++s) { ka[s] = *(const bf16x8*)(Kg + (size_t)(16 * ti + fr) * 512 + 32 * s + 8 * fq); qa[s] = *(const bf16x8*)(Qg + (size_t)(16 * ti + fr) * 512 + 32 * s + 8 * fq);
            kbf[0][s] = *(const bf16x8*)(Kg + (size_t)(16 * (2 * (wave & 1)) + fr) * 512 + 32 * s + 8 * fq); kbf[1][s] = *(const bf16x8*)(Kg + (size_t)(16 * (2 * (wave & 1) + 1) + fr) * 512 + 32 * s + 8 * fq); }
        if (tid < 64) {
            float gc = g_in;
#pragma unroll
            for (int o = 1; o < 64; o <<= 1) { const float t = __shfl_up(gc, o); if (lane >= o) gc += t; }
            const float g63 = __shfl(gc, 63);
            gcS[tid] = gc; egS[tid] = __expf(gc); ekS[tid] = __expf(g63 - gc); btS[tid] = bt_in;
            if (tid == 0) *(float*)(blk + CHK_GL) = __expf(g63);
        }
#pragma unroll
        for (int i = 0; i < 2; ++i) { const int id = tid + 512 * i, r = id >> 4, c = id & 15; *(LAS v4u*)(kt + r * CP_KV_PITCH + 16 * c) = kc[i]; *(LAS v4u*)(vt + r * CP_KV_PITCH + 16 * c) = vc[i]; }
        __syncthreads();
        {
#pragma unroll
            for (int t2 = 0; t2 < 2; ++t2) {
                const int tj = 2 * (wave & 1) + t2;
                f32x4 ck = (f32x4){0.f, 0.f, 0.f, 0.f}, cq = (f32x4){0.f, 0.f, 0.f, 0.f};
#pragma unroll
                for (int s = 0; s < 4; ++s) { ck = __builtin_amdgcn_mfma_f32_16x16x32_bf16(ka[s], kbf[t2][s], ck, 0, 0, 0); cq = __builtin_amdgcn_mfma_f32_16x16x32_bf16(qa[s], kbf[t2][s], cq, 0, 0, 0); }
                const int j = 16 * tj + fr; const float gcj = gcS[j];
                LAS bf16* QKp = (LAS bf16*)Ps;
#pragma unroll
                for (int jj = 0; jj < 4; ++jj) { const int i = 16 * ti + 4 * fq + jj; const float dec = __expf(j <= i ? gcS[i] - gcj : 0.f);
                    As[i * 65 + j] = (j < i) ? btS[i] * ck[jj] * dec : 0.f;
                    QKp[i * 64 + 32 * (j >> 5) + 8 * ((j >> 2) & 3) + 4 * ((j >> 4) & 1) + (j & 3)] = (bf16)f2bf((j <= i) ? cq[jj] * dec : 0.f); }
            }
        }
        {
#pragma unroll
            for (int x = 0; x < 2; ++x) { const int id = tid + 512 * x, i = id >> 4, d0 = (id & 15) * 8; const float e = egS[i];
                float f[8]; unpack8(qc[x], f);
                bf16* Qd = (bf16*)(blk + CHK_QD) + i * 128 + 32 * (d0 >> 5) + 4 * ((d0 >> 4) & 1);
                const int q0 = (d0 >> 2) & 3;
                v2u w0, w1; w0.x = pk2(f[0] * e, f[1] * e); w0.y = pk2(f[2] * e, f[3] * e); w1.x = pk2(f[4] * e, f[5] * e); w1.y = pk2(f[6] * e, f[7] * e);
                *(v2u*)(Qd + 8 * q0) = w0; *(v2u*)(Qd + 8 * (q0 + 1)) = w1; }
        }
        {
            const int d = tid >> 2, c0 = (tid & 3) * 16, s = c0 >> 5, a = (c0 >> 4) & 1;
            bf16* Kd = (bf16*)(blk + CHK_KDT) + d * 64;
#pragma unroll
            for (int q = 0; q < 4; ++q) { const int c = c0 + 4 * q; float kv[4];
#pragma unroll
                for (int e = 0; e < 4; ++e) kv[e] = bf1(*(const LAS bf16*)(kt + (c + e) * CP_KV_PITCH + 2 * d)) * ekS[c + e];
                v2u w; w.x = pk2(kv[0], kv[1]); w.y = pk2(kv[2], kv[3]); *(v2u*)(Kd + 32 * s + 8 * q + 4 * a) = w; }
        }
        __syncthreads();
        *(v4u*)((bf16*)(blk + CHK_QK) + tid * 8) = *(const LAS v4u*)((LAS bf16*)Ps + tid * 8);
        {
            const int c = tid >> 3, part = tid & 7, d16 = (c >> 4) * 16, cl = c & 15;
#pragma unroll
            for (int x = 0; x < 3; ++x) { const int id = tid + 512 * x, blk6 = id >> 8, rr = (id >> 4) & 15, cc = id & 15;
                const int rb = (blk6 < 3) ? 0 : (blk6 < 5 ? 1 : 2), cb = (blk6 < 3) ? blk6 + 1 : (blk6 < 5 ? blk6 - 1 : 3);
                Ts[(16 * rb + rr) * 68 + 16 * cb + cc] = 0.f; }
            for (int i = 0; i < 16; ++i) {
                float acc = 0.f;
                for (int j = part; j < i; j += 8) acc += As[(d16 + i) * 65 + d16 + j] * Ts[(d16 + j) * 68 + c];
                acc += __shfl_xor(acc, 1); acc += __shfl_xor(acc, 2); acc += __shfl_xor(acc, 4);
                if (part == 0) Ts[(d16 + i) * 68 + c] = ((i == cl) ? 1.f : 0.f) - acc;
                __builtin_amdgcn_fence(__ATOMIC_RELEASE, "wavefront"); asm volatile("s_waitcnt lgkmcnt(0)" ::: "memory");
            }
            __syncthreads();
            {
                const int pr = tid >> 8, r = 32 * pr + 16 + ((tid >> 4) & 15), cc = 32 * pr + (tid & 15);
                float p = 0.f;
#pragma unroll
                for (int j = 0; j < 16; ++j) p += As[r * 65 + 32 * pr + j] * Ts[(32 * pr + j) * 68 + cc];
                Ps[r * 68 + cc] = p;
                __syncthreads();
                float x = 0.f;
#pragma unroll
                for (int j = 0; j < 16; ++j) x += Ts[r * 68 + 32 * pr + 16 + j] * Ps[(32 * pr + 16 + j) * 68 + cc];
                Ts[r * 68 + cc] = -x;
            }
            __syncthreads();
            {
                const int r = 32 + (tid >> 4), c0 = (tid & 15) * 2;
                float p0 = 0.f, p1 = 0.f;
#pragma unroll 8
                for (int j = 0; j < 32; ++j) { const float a = As[r * 65 + j]; p0 += a * Ts[j * 68 + c0]; p1 += a * Ts[j * 68 + c0 + 1]; }
                Ps[r * 68 + c0] = p0; Ps[r * 68 + c0 + 1] = p1;
                __syncthreads();
                float x0 = 0.f, x1 = 0.f;
#pragma unroll 8
                for (int j = 32; j < 64; ++j) { const float t = Ts[r * 68 + j]; x0 += t * Ps[j * 68 + c0]; x1 += t * Ps[j * 68 + c0 + 1]; }
                __syncthreads();
                Ts[r * 68 + c0] = -x0; Ts[r * 68 + c0 + 1] = -x1;
            }
        }
        __syncthreads();
        {
            bf16x8 vf[2], kf[2];
            LAS unsigned char* vb = vt + (8 * fq + ((lane & 15) >> 2)) * CP_KV_PITCH + 32 * wave + 8 * (lane & 3);
            LAS unsigned char* kb = kt + (8 * fq + ((lane & 15) >> 2)) * CP_KV_PITCH + 32 * wave + 8 * (lane & 3);
#pragma unroll
            for (int s = 0; s < 2; ++s) {
                const v4i16_t v0 = lds_tr16(vb + (32 * s) * CP_KV_PITCH), v1 = lds_tr16(vb + (32 * s + 4) * CP_KV_PITCH), k0 = lds_tr16(kb + (32 * s) * CP_KV_PITCH), k1 = lds_tr16(kb + (32 * s + 4) * CP_KV_PITCH);
                vf[s][0] = v0[0]; vf[s][1] = v0[1]; vf[s][2] = v0[2]; vf[s][3] = v0[3]; vf[s][4] = v1[0]; vf[s][5] = v1[1]; vf[s][6] = v1[2]; vf[s][7] = v1[3];
                kf[s][0] = k0[0]; kf[s][1] = k0[1]; kf[s][2] = k0[2]; kf[s][3] = k0[3]; kf[s][4] = k1[0]; kf[s][5] = k1[1]; kf[s][6] = k1[2]; kf[s][7] = k1[3];
            }
            float* UT = (float*)(blk + CHK_UT);
            bf16* Wp = (bf16*)(blk + CHK_WP);
#pragma unroll
            for (int ti = 0; ti < 4; ++ti) {
                f32x4 cu = (f32x4){0.f, 0.f, 0.f, 0.f}, cw = (f32x4){0.f, 0.f, 0.f, 0.f};
#pragma unroll
                for (int s = 0; s < 2; ++s) {
                    const LAS float* tr = Ts + (16 * ti + fr) * 68 + 32 * s + 8 * fq;
                    const f32x4 t0 = *(const LAS f32x4*)tr, t1 = *(const LAS f32x4*)(tr + 4);
                    const f32x4 b0 = *(const LAS f32x4*)(btS + 32 * s + 8 * fq), b1 = *(const LAS f32x4*)(btS + 32 * s + 8 * fq + 4), e0 = *(const LAS f32x4*)(egS + 32 * s + 8 * fq), e1 = *(const LAS f32x4*)(egS + 32 * s + 8 * fq + 4);
                    const f32x4 u0 = t0 * b0, u1 = t1 * b1, w0 = u0 * e0, w1 = u1 * e1;
                    cu = __builtin_amdgcn_mfma_f32_16x16x32_bf16(packfrag(u0, u1), vf[s], cu, 0, 0, 0);
                    cw = __builtin_amdgcn_mfma_f32_16x16x32_bf16(packfrag(w0, w1), kf[s], cw, 0, 0, 0);
                }
                *(f32x4*)(UT + (size_t)(16 * wave + fr) * 64 + 16 * ti + 4 * fq) = cu;
#pragma unroll
                for (int jj = 0; jj < 4; ++jj) ((LAS bf16*)As)[(16 * ti + 4 * fq + jj) * 128 + 32 * (wave >> 1) + 8 * (fr >> 2) + 4 * (wave & 1) + (fr & 3)] = (bf16)f2bf(cw[jj]);
            }
        }
        __syncthreads();
        {
            bf16* Wp = (bf16*)(blk + CHK_WP);
#pragma unroll
            for (int x = 0; x < 2; ++x) *(v4u*)(Wp + (tid + 512 * x) * 8) = *(const LAS v4u*)((LAS bf16*)As + (tid + 512 * x) * 8);
        }
    }
}
__device__ __forceinline__ void p14_pool(Frame& F, KArgs A) {
    const int lane = F.lane, tid = F.tid, gw = F.bid * NWAVES + F.wave, NGW = F.G * NWAVES;
    LAS float* pw = (LAS float*)(F.lds + 16384);
    LAS float* dl = (LAS float*)(F.lds + 16384 + 65536 + F.wave * 4096);
    {   f32x4 pv[8];
#pragma unroll
        for (int j = 0; j < 8; ++j) pv[j] = *(const f32x4*)(A->in[I_CD_POOLW] + (size_t)(tid + NTHREADS * j) * 4);
#pragma unroll
        for (int j = 0; j < 8; ++j) *(LAS f32x4*)(pw + (tid + NTHREADS * j) * 4) = pv[j];
    }
    __syncthreads();
    const bf16* QK = WSP(bf16, WS_QKVZ); bf16* AO = WSP(bf16, WS_AO);
    const int gi = lane >> 4, w = 2 << gi;
    const int rs = lane >> 4, n4 = lane & 15;
    f32x4 sc4[4];
#pragma unroll
    for (int g = 0; g < 4; ++g) sc4[g] = *(const f32x4*)(A->in[I_CD_POOLS] + g * 64 + 4 * n4);
    for (int row0 = gw; row0 < M; row0 += 4 * NGW) {
#pragma unroll 1
        for (int q = 0; q < 4; ++q) {
            const int rowq = row0 + q * NGW, row = (rowq < M) ? rowq : row0;
            const int pos = row & (SEQ - 1);
            const int cntw = (pos + 1 < w) ? pos + 1 : w;
            float sum[4] = {0.f, 0.f, 0.f, 0.f}, cur[4] = {0.f, 0.f, 0.f, 0.f};
            v2u xw[16];
#pragma unroll
            for (int j = 0; j < 16; ++j) xw[j] = *(const v2u*)(QK + (size_t)(row - (j <= pos ? j : pos)) * 2560 + 2304 + 4 * lane);
#pragma unroll
            for (int j = 0; j < 16; ++j) {
                const float f0 = bflo(xw[j].x), f1 = bfhi(xw[j].x), f2 = bflo(xw[j].y), f3 = bfhi(xw[j].y);
                if (j < cntw) { sum[0] += f0; sum[1] += f1; sum[2] += f2; sum[3] += f3; }
                if (j == 0) { cur[0] = f0; cur[1] = f1; cur[2] = f2; cur[3] = f3; }
            }
            const float inv = __builtin_amdgcn_rcpf((float)cntw);
            f32x4 dv; dv[0] = sum[0] * inv - cur[0]; dv[1] = sum[1] * inv - cur[1]; dv[2] = sum[2] * inv - cur[2]; dv[3] = sum[3] * inv - cur[3];
            *(LAS f32x4*)(dl + q * 256 + 4 * lane) = dv;
        }
        f32x4 o[4];
#pragma unroll
        for (int g = 0; g < 4; ++g) o[g] = (f32x4){0.f, 0.f, 0.f, 0.f};
#pragma unroll
        for (int g = 0; g < 4; ++g) {
#pragma unroll 16
            for (int c = 0; c < 64; ++c) { const float a = dl[rs * 256 + g * 64 + c]; const f32x4 wv = *(const LAS f32x4*)(pw + (g * 64 + c) * 64 + 4 * n4); o[g] += wv * a; }
        }
        const int rowo = row0 + rs * NGW;
        if (rowo < M) {
#pragma unroll
            for (int g = 0; g < 4; ++g) { const f32x4 r = o[g] * sc4[g]; v2u pk; pk.x = pk2(r[0], r[1]); pk.y = pk2(r[2], r[3]); *(v2u*)(AO + (size_t)rowo * 1024 + 768 + g * 64 + 4 * n4) = pk; }
        }
    }
}


#define IN(k) (lo <= (k) && (k) < hi)
#define SEAM(k) do { if (IN(k) && IN((k) + 1)) { if (defer) xcd_barrier_working(bar, F, kargs()); else xcd_barrier(bar); } } while (0)
template <int l> __device__ __forceinline__ void layer_tail(Frame& F, const XcdBarrier& bar, const int lo, const int hi, const bool defer) {
    LAS unsigned char* ring = F.lds + RING_OFF;
    const int bid = F.bid, G = F.G;
        const int pb = 8 * l;

        if (IN(7 + pb)) {
            pg8::Gemm g{WSP(bf16, WS_AO), (l == 0) ? WSP(bf16, WS_W_OUTAB) : WSP(bf16, WS_W_OUTCD), M, 1024, (l == 0) ? 1536 : 1024}; pg8::StaticOrder S; S.init(M, 1024, G, bid);
            pg8::Epi<pg8::StPre> E{{(l == 0) ? kargs()->in[I_X] : WSP(float, WS_H2), WSP(float, WS_PRE), ALPHA}};
            pg8::gemm_phase<pg8::Epi<pg8::StPre>, pg8::StaticOrder, true, true>(ring, g, S, E);
        } SEAM(7 + pb);
        if (IN(8 + pb)) { p8_ln_router(F, kargs(), l, WSP(float, WS_H1), WSP(bf16, WS_H1B)); } SEAM(8 + pb);
        if (IN(9 + pb)) {
            p9_scatter(F, l, WSP(bf16, WS_H1B), WSP(float, WS_H1));
            __syncthreads();
            pg8::Gemm g{WSP(bf16, WS_H1B), WSP(bf16, WS_W_PG) + (size_t)l * 1024 * 1024, M, 1024, 1024}; pg8::StaticOrder S; S.init(M, 1024, G, bid);
            pg8::Epi<pg8::StPleGate> E{{WSP(bf16, WS_PP) + (size_t)l * M * 1024, WSP(bf16, WS_PLE)}};
            pg8::gemm_phase<pg8::Epi<pg8::StPleGate>, pg8::StaticOrder, true, true>(ring, g, S, E);
            if (defer) defer_work(F, kargs(), -1, (l == 0) ? N_MOE_NOW : N_MOE_Q);
        } SEAM(9 + pb);
        const int* TILE = WSP(int, WS_ROUTE) + 3 * M * 4;
        if (IN(10 + pb)) {
            const int nT = __builtin_amdgcn_readfirstlane(TILE[NTMAX]);
            constexpr int EB = kMoeFp8 ? 1 : 2;
            pg8::Gemm g{WSP(bf16, WS_XS), (const bf16*)(F.ws + WS_W_GU + (size_t)l * NEXP * 2048 * 1024 * EB), PMAX, 2048, 1024 * EB / 2, TILE + NTMAX + 64, MISC_OFF + 2048, MISC_OFF + 3072};
            pg8::MoeOrder S{TILE, nT, 8, G, bid, (long)2048 * 1024 * EB};
            pg8::Epi<pg8::StSwiglu<kMoeFp8>> E{{kargs()->in[I_BGU] + (size_t)l * NEXP * 2048, WSP(bf16, WS_HID)}};
            pg8::gemm_phase<pg8::Epi<pg8::StSwiglu<kMoeFp8>>, pg8::MoeOrder, true, false, kMoeFp8 ? kScaleGU : 0u, kMoeFp8>(ring, g, S, E);
        } SEAM(10 + pb);
        if (IN(11 + pb)) {
            const int nT = __builtin_amdgcn_readfirstlane(TILE[NTMAX]);
            constexpr int EB = kMoeFp8 ? 1 : 2;
            pg8::Gemm g{WSP(bf16, WS_HID), (const bf16*)(F.ws + WS_W_DN + (size_t)l * NEXP * 1024 * 1024 * EB), PMAX, 1024, 1024 * EB / 2, nullptr, 0, MISC_OFF + 3072};
            pg8::MoeOrder S{TILE, nT, 4, G, bid, (long)1024 * 1024 * EB};
            pg8::Epi<pg8::StDown<kMoeFp8>> E{{kargs()->in[I_BDN] + (size_t)l * NEXP * 1024, WSP(bf16, WS_YS)}};
            pg8::gemm_phase<pg8::Epi<pg8::StDown<kMoeFp8>>, pg8::MoeOrder, true, false, kMoeFp8 ? kScaleDN : 0u>(ring, g, S, E);
        } SEAM(11 + pb);
        if (IN(12 + pb)) { p12_combine(F, kargs(), l, WSP(bf16, WS_H1B), (l == 0) ? WSP(float, WS_H2) : kargs()->out, (l == 0) ? WSP(bf16, WS_XB) : (bf16*)nullptr); }
}
#undef IN
#undef SEAM
__global__ void __launch_bounds__(NTHREADS, 2) mk_fwd(Args args_by_value) {
    const KArgs KA = kargs();
    extern __shared__ __attribute__((aligned(16))) unsigned char lds[];
    Frame F;
    F.lds = (LAS unsigned char*)lds;
    F.tid = threadIdx.x; F.lane = F.tid & 63; F.wave = __builtin_amdgcn_readfirstlane(F.tid >> 6);
    F.G = gridDim.x; F.bid = blockIdx.x; F.ws = KA->ws; F.ctl = (gu32*)(KA->ws + WS_CTL);
    volatile LAS unsigned* MISC = (volatile LAS unsigned*)(F.lds + MISC_OFF);
    { int t0 = threadIdx.x; asm volatile("" : "+v"(t0)); for (int u = t0; u < (LDS_BYTES - MISC_OFF) / 4; u += NTHREADS) MISC[u] = 0u; }
    __syncthreads();
    const bool use_bar = (N_LAUNCHES != NPHASES);
    XcdBarrier bar; bar.bar = (unsigned*)(F.ctl + CW_BAR) + KA->li * XCD_BAR_WORDS; bar.x = 0; bar.st = nullptr; bar.expect = 0;
    XcdBarrier bar2 = bar;
    if (use_bar && F.bid >= SEQ_WGS && F.G > SEQ_WGS) bar2 = xcd_barrier_post((unsigned*)(F.ctl + CW_BAR2), MISC + 10, (unsigned)(F.G - SEQ_WGS));
    if (use_bar) bar = xcd_barrier_post((unsigned*)(F.ctl + CW_BAR) + KA->li * XCD_BAR_WORDS, MISC + 8);
    const int lo = KA->ph_lo, hi = KA->ph_hi;
#define IN(k) (lo <= (k) && (k) < hi)
#define SEAM(k) do { if (IN(k) && IN((k) + 1)) { if (defer) xcd_barrier_working(bar, F, kargs()); else xcd_barrier(bar); } } while (0)
    LAS unsigned char* ring = F.lds + RING_OFF;
    const int bid = F.bid, G = F.G;

    const bool defer = use_bar && kMoeFp8;
    if (IN(0)) { p0_prologue(F, kargs(), !defer); } SEAM(0);

            if (IN(1)) {
                { pg8::Gemm g{WSP(bf16, WS_XB), WSP(bf16, WS_W_INAB), M, 2560, 1024}; pg8::StaticOrder S; S.init(M, 2560, G, bid);
                  pg8::Epi<pg8::StInAB> E{{WSP(float, WS_SM), WSP(bf16, WS_QKVZ)}};
                  pg8::gemm_phase<pg8::Epi<pg8::StInAB>, pg8::StaticOrder, true, true>(ring, g, S, E); }
                __syncthreads();
                { pg8::Gemm g{WSP(bf16, WS_PB), WSP(bf16, WS_W_PP), 2 * M, 1024, 256}; const bool split = (G == 256);
                  pg8::BatchOrder S{4, split ? (bid >= 128 ? 256 : 0) : (2 * M / 256) * 4, split ? 128 : G, split ? bid - 128 : bid, M / 256, (long)1024 * 256 * 2, 0, 0};
                  pg8::Epi<pg8::StBf16> E{{WSP(bf16, WS_PP), 1024}};
                  pg8::gemm_phase<pg8::Epi<pg8::StBf16>, pg8::BatchOrder, true, true>(ring, g, S, E); }
            } SEAM(1);
            if (IN(2)) { p2_prep(F, kargs()); } SEAM(2);
            if (IN(3)) {
                p3_chunk_prep_mfma(F, kargs());
                __syncthreads();
                { pg8::Gemm g{WSP(bf16, WS_CQ), WSP(bf16, WS_W_ABS), M, 1536, 256}; pg8::StaticOrder S; S.init(M, 1536, G, bid);
                  pg8::Epi<pg8::StBf16> E{{WSP(bf16, WS_QL), 1536}};
                  pg8::gemm_phase<pg8::Epi<pg8::StBf16>, pg8::StaticOrder, true, true>(ring, g, S, E); }
            } SEAM(3);
            if (IN(4)) {
                if (bid < SEQ_WGS && G > SEQ_WGS) p4_delta_seq(F, bid);
                else { p4_indexer(F, (bid - SEQ_WGS) * NWAVES + F.wave, (G - SEQ_WGS) * NWAVES);
                    if (use_bar) { if (defer) xcd_barrier_working(bar2, F, kargs()); else xcd_barrier(bar2);
                        p5_topk_attn(F, (bid - SEQ_WGS) * NWAVES + F.wave, (G - SEQ_WGS) * NWAVES); } }
            } SEAM(4);
            if (IN(5)) { if (!use_bar) p5_topk_attn(F, bid * NWAVES + F.wave, G * NWAVES); p6_gdn_out(F, kargs()); } SEAM(5);
    layer_tail<0>(F, bar, lo, hi, defer);
    SEAM(12);
            if (IN(13)) {
                pg8::Gemm g{WSP(bf16, WS_XB), WSP(bf16, WS_W_INCD), M, 2560, 1024}; pg8::StaticOrder S; S.init(M, 2560, G, bid);
                pg8::Epi<pg8::StBf16> E{{WSP(bf16, WS_QKVZ), 2560}};
                pg8::gemm_phase<pg8::Epi<pg8::StBf16>, pg8::StaticOrder, true, true>(ring, g, S, E);
                if (G == 256) {
                    __syncthreads();
                    pg8::Gemm g2{WSP(bf16, WS_PB), WSP(bf16, WS_W_PP), 2 * M, 1024, 256}; pg8::BatchOrder S2{4, bid >= 128 ? 256 : 0, 128, bid - 128, M / 256, (long)1024 * 256 * 2, 0, 256};
                    pg8::Epi<pg8::StBf16> E2{{WSP(bf16, WS_PP), 1024}};
                    pg8::gemm_phase<pg8::Epi<pg8::StBf16>, pg8::BatchOrder, true, true>(ring, g2, S2, E2);
                }
            } SEAM(13);
            if (IN(14)) { p14_dilated_mfma(F); __syncthreads(); p14_pool(F, kargs()); } SEAM(14);
    layer_tail<1>(F, bar, lo, hi, defer);
#undef IN
#undef SEAM
}

extern "C" void kernel_launch(void* const* d_in, const int* in_sizes, int n_in, void* d_out, int out_size, void* d_ws, size_t ws_size, hipStream_t stream) {
    static int grid = 0;
    if (grid == 0) {
        if (n_in != N_IN || in_sizes[0] != M * D || out_size != M * D || ws_size < WS_END) {
            fprintf(stderr, "kernel_launch: built for %d inputs, x/out of %d floats, >= %zu bytes of workspace; got n_in %d, in0 %d, out %d, ws %zu; nothing launched\n", N_IN, M * D, (size_t)WS_END, n_in, n_in > 0 ? in_sizes[0] : -1, out_size, ws_size);
            grid = -1; return; }
        int dev = 0, cus = 0, per_cu = 0;
        if (hipGetDevice(&dev) != hipSuccess || hipDeviceGetAttribute(&cus, hipDeviceAttributeMultiprocessorCount, dev) != hipSuccess) { fprintf(stderr, "kernel_launch: device query failed\n"); grid = -1; return; }
        if (hipFuncSetAttribute((const void*)mk_fwd, hipFuncAttributeMaxDynamicSharedMemorySize, LDS_BYTES) != hipSuccess) { fprintf(stderr, "kernel_launch: hipFuncSetAttribute failed\n"); grid = -1; return; }
        if (hipOccupancyMaxActiveBlocksPerMultiprocessor(&per_cu, (const void*)mk_fwd, NTHREADS, LDS_BYTES) != hipSuccess || per_cu < 1)
            fprintf(stderr, "kernel_launch: note: occupancy query reports %d workgroups per CU\n", per_cu);
        (void)hipGetLastError();
        grid = cus;
    }
    if (grid < 0) return;
    if (hipMemsetAsync((char*)d_ws + WS_CTL, 0, CTL_ZERO_BYTES, stream) != hipSuccess) { fprintf(stderr, "kernel_launch: memset failed\n"); return; }
    Args a{};
    for (int i = 0; i < N_IN; ++i) a.in[i] = (const float*)d_in[i];
    a.out = (float*)d_out; a.ws = (unsigned char*)d_ws;
    for (int li = 0; li < N_LAUNCHES; ++li) {
        if (N_LAUNCHES == NPHASES) { a.ph_lo = li; a.ph_hi = li + 1; } else { a.ph_lo = (int)((long)li * NPHASES / N_LAUNCHES); a.ph_hi = (int)((long)(li + 1) * NPHASES / N_LAUNCHES); }
        a.li = li;
        hipLaunchKernelGGL(mk_fwd, dim3(grid), dim3(NTHREADS), LDS_BYTES, stream, a);
        const hipError_t le = hipPeekAtLastError();
        if (le != hipSuccess) { fprintf(stderr, "kernel_launch: launch %d failed: %s\n", li, hipGetErrorName(le)); break; }
    }
}
```
